# Optimizing an MI355X kernel written in HIP

```python
import jax, jax.numpy as jnp
from jax import lax
import numpy as np

D_MODEL = 1024
BATCH = 16
SEQ = 256
DEPTH = 4
DEC_BATCH = 8
DEC_SEQ = 2048
PAST_LEN = 256

GRID_W = 64
N_EVEN = (DEPTH + 1) // 2
N_ODD = DEPTH // 2
D_FF = 4 * D_MODEL
EPS = 1e-6
ROPE_BASE = 10000.0
CHUNK = 64
Q_BLOCK = 128
H_A = 4
DK_A = 64
DV_A = 128
GATE_RANK = 16
GATE_NORM = 16.0
H_B = 4
DK_B = 64
DV_B = 128
H_C = 8
Q_LORA = 256
KV_LORA = 256
QK_NOPE = 128
QK_ROPE = 64
V_HEAD_C = 128
A_QK = H_A * DK_A
A_V = H_A * DV_A
B_QK = H_B * DK_B
B_V = H_B * DV_B
EVEN_SPLITS = (A_QK, A_QK, A_V, A_V, 2 * GATE_RANK, B_QK, B_QK, B_V, B_V)
EVEN_IN = 2 * A_QK + 2 * A_V + 2 * GATE_RANK + 2 * B_QK + 2 * B_V
EVEN_OUT = A_V + B_V
ODD_SPLITS = (Q_LORA, KV_LORA, QK_ROPE)
ODD_IN = Q_LORA + KV_LORA + QK_ROPE

kernel_name = 'hybrid_gla_retnet_mla_diffusion_step'


def rms_norm(x, g=None):
    xf = x.astype(jnp.float32)
    y = xf * lax.rsqrt(jnp.mean(jnp.square(xf), axis=-1, keepdims=True) + EPS)
    if g is not None:
        y = y * g.astype(jnp.float32)
    return y.astype(x.dtype)


def split_cols(x, sizes):
    return jnp.split(x, np.cumsum(sizes)[:-1].tolist(), axis=-1)


def ada_mod(cond, w_ada, b_ada):
    m = jnp.einsum('bd,de->be', jax.nn.silu(cond), w_ada) + b_ada
    return jnp.split(m[:, None, :], 6, axis=-1)


def pre_norm_mod(x, g, shift, scale):
    return rms_norm(x, g) * (1.0 + scale) + shift


def post_norm_residual(x, y, g, gate):
    return x + gate * rms_norm(y, g)


def sq_relu_mlp(h, w1, w2):
    u = jax.nn.relu(jnp.einsum('bld,df->blf', h, w1))
    return jnp.einsum('blf,fd->bld', jnp.square(u), w2)


def axial_rope(rows, rot_dim):
    row = jnp.repeat(jnp.arange(rows), GRID_W).astype(jnp.float32)
    col = jnp.tile(jnp.arange(GRID_W), rows).astype(jnp.float32)
    n_freq = rot_dim // 4
    inv = ROPE_BASE ** (-jnp.arange(n_freq, dtype=jnp.float32) / n_freq)
    ang = jnp.concatenate([row[:, None] * inv, col[:, None] * inv], axis=-1)
    return jnp.cos(ang), jnp.sin(ang)


def apply_rope(x, cos, sin):
    half = x.shape[-1] // 2
    xf = x.astype(jnp.float32)
    x1, x2 = xf[..., :half], xf[..., half:]
    c, s = cos[None, :, None, :], sin[None, :, None, :]
    return jnp.concatenate([x1 * c - x2 * s, x1 * s + x2 * c], axis=-1).astype(x.dtype)


def chunked_gated_scan(q, k, v, log_a, s0):
    nb, L, H, _ = q.shape
    dv = v.shape[-1]
    n = L // CHUNK

    def to_chunks(t):
        t = t.astype(jnp.float32).reshape(nb, n, CHUNK, H, t.shape[-1])
        return jnp.transpose(t, (1, 0, 3, 2, 4))

    qc, kc, vc, gc = to_chunks(q), to_chunks(k), to_chunks(v), to_chunks(log_a)
    causal_in_chunk = jnp.tril(jnp.ones((CHUNK, CHUNK), dtype=bool))

    def step(S, inp):
        qi, ki, vi, gi = inp
        b = jnp.cumsum(gi, axis=2)
        b_last = b[:, :, -1:, :]
        q_dec = qi * jnp.exp(b)
        k_inv = ki * jnp.exp(-b)
        a = jnp.where(causal_in_chunk, jnp.einsum('bhik,bhjk->bhij', q_dec, k_inv), 0.0)
        o = jnp.einsum('bhik,bhkv->bhiv', q_dec, S) + jnp.einsum('bhij,bhjv->bhiv', a, vi)
        k_up = ki * jnp.exp(b_last - b)
        S_new = jnp.exp(b_last[:, :, 0, :])[..., None] * S + jnp.einsum('bhjk,bhjv->bhkv', k_up, vi)
        return S_new, o

    S_fin, oc = lax.scan(step, s0.astype(jnp.float32), (qc, kc, vc, gc))
    o = jnp.transpose(oc, (1, 0, 3, 2, 4)).reshape(nb, L, H, dv)
    return o.astype(q.dtype), S_fin


def bidir_scan(q, k, v, log_a_fwd, log_a_bwd, s_fwd, s_bwd):
    flip = lambda t: jnp.flip(t, axis=1)
    o_f, S_f = chunked_gated_scan(q, k, v, log_a_fwd, s_fwd)
    o_b, S_b = chunked_gated_scan(flip(q), flip(k), flip(v), flip(log_a_bwd), s_bwd)
    return o_f + flip(o_b), S_f, S_b


def even_mixer(h, w_in, w_gk2, b_gk2, gla_norm, ret_decay, w_out, s_gla, s_ret, rope):
    nb, L, _ = h.shape
    proj = jnp.einsum('bld,de->ble', h, w_in)
    qa, ka, va, ga, gk_lr, qb, kb, vb, gb = split_cols(proj, EVEN_SPLITS)
    qa = qa.reshape(nb, L, H_A, DK_A) * DK_A ** -0.5
    ka = ka.reshape(nb, L, H_A, DK_A)
    va = va.reshape(nb, L, H_A, DV_A)
    gate_pre = jnp.einsum('bldr,drk->bldk', gk_lr.reshape(nb, L, 2, GATE_RANK), w_gk2) + b_gk2
    log_a = (jax.nn.log_sigmoid(gate_pre.astype(jnp.float32)) / GATE_NORM).reshape(nb, L, 2, H_A, DK_A)
    o_a, sa_f, sa_b = bidir_scan(qa, ka, va, log_a[:, :, 0], log_a[:, :, 1], s_gla[:, 0], s_gla[:, 1])
    o_a = rms_norm(o_a, gla_norm).reshape(nb, L, A_V) * jax.nn.silu(ga)
    qb = qb.reshape(nb, L, H_B, DK_B)
    kb = kb.reshape(nb, L, H_B, DK_B) * DK_B ** -0.5
    vb = vb.reshape(nb, L, H_B, DV_B)
    if rope is not None:
        qb, kb = apply_rope(qb, *rope), apply_rope(kb, *rope)
    log_g = -jnp.exp(ret_decay.astype(jnp.float32))
    g_f = jnp.broadcast_to(log_g[0][:, None], (nb, L, H_B, DK_B))
    g_b = jnp.broadcast_to(log_g[1][:, None], (nb, L, H_B, DK_B))
    o_b, sb_f, sb_b = bidir_scan(qb, kb, vb, g_f, g_b, s_ret[:, 0], s_ret[:, 1])
    o_b = rms_norm(o_b).reshape(nb, L, B_V) * jax.nn.silu(gb)
    y = jnp.einsum('ble,ed->bld', jnp.concatenate([o_a, o_b], axis=-1), w_out)
    return y, jnp.stack([sa_f, sa_b], axis=1), jnp.stack([sb_f, sb_b], axis=1)


def blocked_attention(q, k, v):
    nb, Lq, H, dq = q.shape
    dv = v.shape[-1]
    scale = dq ** -0.5
    kf, vf = k.astype(jnp.float32), v.astype(jnp.float32)
    qblocks = jnp.moveaxis(q.reshape(nb, Lq // Q_BLOCK, Q_BLOCK, H, dq), 1, 0)

    def one_block(qi):
        s = jnp.einsum('bqhd,bkhd->bhqk', qi.astype(jnp.float32), kf) * scale
        p = jax.nn.softmax(s, axis=-1)
        return jnp.einsum('bhqk,bkhv->bqhv', p, vf).astype(q.dtype)

    out = lax.map(one_block, qblocks)
    return jnp.moveaxis(out, 0, 1).reshape(nb, Lq, H, dv)


def mla_expand(ckv, kpe, w_kv_b, rope):
    nb, L, _ = ckv.shape
    kv = jnp.einsum('blr,re->ble', ckv, w_kv_b).reshape(nb, L, H_C, QK_NOPE + V_HEAD_C)
    k_pe = kpe[:, :, None, :]
    if rope is not None:
        k_pe = apply_rope(k_pe, *rope)
    k = jnp.concatenate([kv[..., :QK_NOPE], jnp.broadcast_to(k_pe, (nb, L, H_C, QK_ROPE))], axis=-1)
    return k, kv[..., QK_NOPE:]


def mla_mixer(h, w_in, q_a_norm, w_q_b, kv_a_norm, w_kv_b, w_out, rope, ckv_ctx=None, kpe_ctx=None):
    nb, L, _ = h.shape
    q_lat, ckv, kpe = split_cols(jnp.einsum('bld,de->ble', h, w_in), ODD_SPLITS)
    q = jnp.einsum('blr,re->ble', rms_norm(q_lat, q_a_norm), w_q_b).reshape(nb, L, H_C, QK_NOPE + QK_ROPE)
    ckv = rms_norm(ckv, kv_a_norm)
    k, v = mla_expand(ckv, kpe, w_kv_b, rope)
    if rope is not None:
        q = jnp.concatenate([q[..., :QK_NOPE], apply_rope(q[..., QK_NOPE:], *rope)], axis=-1)
    if ckv_ctx is not None:
        k_c, v_c = mla_expand(ckv_ctx, kpe_ctx, w_kv_b, None)
        k = jnp.concatenate([k_c, k], axis=1)
        v = jnp.concatenate([v_c, v], axis=1)
    o = blocked_attention(q, k, v)
    y = jnp.einsum('ble,ed->bld', o.reshape(nb, L, H_C * V_HEAD_C), w_out)
    return y, ckv, kpe


def setup_inputs(seed: int = 0) -> dict:
    key = jax.random.key(seed)
    ks = iter(jax.random.split(key, 32))
    nrm = lambda shape, scale: jax.random.normal(next(ks), shape, jnp.float32) * scale
    gain = lambda shape: 1.0 + nrm(shape, 0.05)
    decay_init = jnp.log(-jnp.log1p(-(2.0 ** (-5.0 - jnp.arange(H_B, dtype=jnp.float32)))))
    return {
        'x_prompt': nrm((BATCH, SEQ, D_MODEL), 1.0),
        'x_sample': nrm((DEC_BATCH, DEC_SEQ, D_MODEL), 1.0),
        'cache_ckv': nrm((DEC_BATCH, N_ODD, PAST_LEN, KV_LORA), 1.0),
        'cache_kpe': nrm((DEC_BATCH, N_ODD, PAST_LEN, QK_ROPE), 1.0),
        'state_gla': nrm((DEC_BATCH, N_EVEN, 2, H_A, DK_A, DV_A), 1.0),
        'state_ret': nrm((DEC_BATCH, N_EVEN, 2, H_B, DK_B, DV_B), 1.0),
        'c': nrm((DEC_BATCH, D_MODEL), 1.0),
        'c_ctx': nrm((D_MODEL,), 1.0),
        'w_ada': nrm((DEPTH, D_MODEL, 6 * D_MODEL), 0.5 * D_MODEL ** -0.5),
        'b_ada': nrm((DEPTH, 6 * D_MODEL), 0.02),
        'norm_mix_pre': gain((DEPTH, D_MODEL)),
        'norm_mix_post': gain((DEPTH, D_MODEL)),
        'norm_mlp_pre': gain((DEPTH, D_MODEL)),
        'norm_mlp_post': gain((DEPTH, D_MODEL)),
        'w_in_even': nrm((N_EVEN, D_MODEL, EVEN_IN), D_MODEL ** -0.5),
        'w_gk2': nrm((N_EVEN, 2, GATE_RANK, A_QK), GATE_RANK ** -0.5),
        'b_gk2': nrm((N_EVEN, 2, A_QK), 0.1),
        'gla_norm': gain((N_EVEN, DV_A)),
        'ret_decay': decay_init + nrm((N_EVEN, 2, H_B), 0.05),
        'w_out_even': nrm((N_EVEN, EVEN_OUT, D_MODEL), EVEN_OUT ** -0.5),
        'w_in_odd': nrm((N_ODD, D_MODEL, ODD_IN), D_MODEL ** -0.5),
        'q_a_norm': gain((N_ODD, Q_LORA)),
        'w_q_b': nrm((N_ODD, Q_LORA, H_C * (QK_NOPE + QK_ROPE)), Q_LORA ** -0.5),
        'kv_a_norm': gain((N_ODD, KV_LORA)),
        'w_kv_b': nrm((N_ODD, KV_LORA, H_C * (QK_NOPE + V_HEAD_C)), KV_LORA ** -0.5),
        'w_out_odd': nrm((N_ODD, H_C * V_HEAD_C, D_MODEL), (H_C * V_HEAD_C) ** -0.5),
        'w_mlp1': nrm((DEPTH, D_MODEL, D_FF), D_MODEL ** -0.5),
        'w_mlp2': nrm((DEPTH, D_FF, D_MODEL), D_FF ** -0.5),
    }


def reference(x_prompt, x_sample, cache_ckv, cache_kpe, state_gla, state_ret, c, c_ctx,
              w_ada, b_ada, norm_mix_pre, norm_mix_post, norm_mlp_pre, norm_mlp_post,
              w_in_even, w_gk2, b_gk2, gla_norm, ret_decay, w_out_even,
              w_in_odd, q_a_norm, w_q_b, kv_a_norm, w_kv_b, w_out_odd,
              w_mlp1, w_mlp2):
    n_lat = x_sample.shape[1]
    rows = n_lat // GRID_W
    rope_ret = axial_rope(rows, DK_B)
    rope_mla = axial_rope(rows, QK_ROPE)
    nb_ctx = x_prompt.shape[0]
    zero_gla = jnp.zeros((nb_ctx, 2, H_A, DK_A, DV_A), jnp.float32)
    zero_ret = jnp.zeros((nb_ctx, 2, H_B, DK_B, DV_B), jnp.float32)

    xc, xl = x_prompt, x_sample
    new_ckv, new_kpe, new_gla, new_ret = [], [], [], []
    for l in range(DEPTH):
        i = l // 2
        sh1c, sc1c, gt1c, sh2c, sc2c, gt2c = ada_mod(c_ctx[None, :], w_ada[l], b_ada[l])
        sh1l, sc1l, gt1l, sh2l, sc2l, gt2l = ada_mod(c, w_ada[l], b_ada[l])
        hc = pre_norm_mod(xc, norm_mix_pre[l], sh1c, sc1c)
        hl = pre_norm_mod(xl, norm_mix_pre[l], sh1l, sc1l)
        if l % 2 == 0:
            ew = (w_in_even[i], w_gk2[i], b_gk2[i], gla_norm[i], ret_decay[i], w_out_even[i])
            yc, sg, sr = even_mixer(hc, *ew, zero_gla, zero_ret, None)
            yl, _, _ = even_mixer(hl, *ew, state_gla[:, i], state_ret[:, i], rope_ret)
            new_gla.append(sg)
            new_ret.append(sr)
        else:
            ow = (w_in_odd[i], q_a_norm[i], w_q_b[i], kv_a_norm[i], w_kv_b[i], w_out_odd[i])
            yc, ckv_c, kpe_c = mla_mixer(hc, *ow, None)
            yl, _, _ = mla_mixer(hl, *ow, rope_mla, cache_ckv[:, i], cache_kpe[:, i])
            new_ckv.append(ckv_c)
            new_kpe.append(kpe_c)
        xc = post_norm_residual(xc, yc, norm_mix_post[l], gt1c)
        xl = post_norm_residual(xl, yl, norm_mix_post[l], gt1l)
        hc = pre_norm_mod(xc, norm_mlp_pre[l], sh2c, sc2c)
        hl = pre_norm_mod(xl, norm_mlp_pre[l], sh2l, sc2l)
        xc = post_norm_residual(xc, sq_relu_mlp(hc, w_mlp1[l], w_mlp2[l]), norm_mlp_post[l], gt2c)
        xl = post_norm_residual(xl, sq_relu_mlp(hl, w_mlp1[l], w_mlp2[l]), norm_mlp_post[l], gt2l)

    return (xc, xl, jnp.stack(new_ckv, axis=1), jnp.stack(new_kpe, axis=1),
            jnp.stack(new_gla, axis=1), jnp.stack(new_ret, axis=1))
```

```cpp
#include <hip/hip_runtime.h>
#include <hip/hip_bf16.h>
#include <cstdio>
#include <cstdint>
namespace pg8 {
#define PG8_LAS __attribute__((address_space(3)))
typedef unsigned short bf16_t;
typedef short bf16x8 __attribute__((ext_vector_type(8)));
typedef float f32x4 __attribute__((ext_vector_type(4)));
typedef unsigned u32x4 __attribute__((ext_vector_type(4)));
constexpr int BM = 256, BK = 64, HALF = 128, HTB = HALF * BK * 2  , STAGE_BYTES = 8 * HTB, NXCD = 8, WGM = 8;

__host__ __device__ __forceinline__ int lds_byte(int r, int c) { const int st = (r >> 4) * 2 + (c >> 5), rr = r & 15, cc = c & 31, ob = rr * 64 + cc * 2; return st * 1024 + (ob ^ (((ob >> 9) & 1) << 5)); }
__host__ __device__ __forceinline__ void stage_rc(int b, int& R, int& C) { const int st = b / 1024, sb = b % 1024, swz = sb ^ (((sb >> 9) & 1) << 5); R = (st >> 1) * 16 + swz / 64; C = (st & 1) * 32 + (swz % 64) / 2; }
__host__ __device__ __forceinline__ int perm32(int rho) { const int n = rho >> 4, i = rho & 15; return 8 * (i >> 2) + 4 * n + (i & 3); }

struct Unit { int pm, pn; };
struct Gemm { const bf16_t* A; const bf16_t* Bt; int M, N, K; };

struct StaticOrder {
    int nM, nN, nwg, G, c;
    __host__ __device__ void init(int M, int N, int G_, int c_) { nM = M / BM; nN = N / BM; nwg = nM * nN; G = G_; c = c_; }
    __host__ __device__ bool next(int i, Unit& u) const {
        const long L = (long)i * G + c; if (L >= nwg) return false;
        int wgid = (int)L; { const int q = nwg / NXCD, r = nwg % NXCD, xcd = wgid % NXCD, off = wgid / NXCD; wgid = (xcd < r ? xcd * (q + 1) : r * (q + 1) + (xcd - r) * q) + off; }
        const int nig = WGM * nN, gid = wgid / nig, fm = gid * WGM, gsz = (nM - fm) < WGM ? (nM - fm) : WGM;
        u.pm = fm + ((wgid % nig) % gsz); u.pn = (wgid % nig) / gsz; return true;
    }
    __device__ __forceinline__ void a_ready(const Unit&) const {}
    __device__ __forceinline__ void done(const Unit&) const {}
};


__device__ __forceinline__ unsigned cvt_pk_bf16(float lo, float hi) { unsigned r; asm volatile("v_cvt_pk_bf16_f32 %0, %1, %2" : "=v"(r) : "v"(lo), "v"(hi)); return r; }

template <int ACT> struct EpiBf16 {
    static constexpr bool PERM = true, AFTER_DRAIN = false;
    bf16_t* O; int ldc;
    __device__ __forceinline__ void operator()(const f32x4 (&acc)[2][2][4][2], const Unit& u, int wr, int wc, int fr, int fq) const {
        const int row0 = u.pm * BM + wr * 64 + fr; const int col0 = u.pn * BM + wc * 32 + 8 * fq;
#pragma unroll
        for (int ai = 0; ai < 2; ++ai)
#pragma unroll
            for (int m = 0; m < 4; ++m) { bf16_t* rowp = O + (size_t)(row0 + ai * HALF + m * 16) * ldc + col0;
#pragma unroll
                for (int bj = 0; bj < 2; ++bj) { f32x4 v0 = acc[ai][bj][m][0], v1 = acc[ai][bj][m][1];
                    if (ACT == 1) {
#pragma unroll
                        for (int j = 0; j < 4; ++j) { const float a = fmaxf(v0[j], 0.f), b = fmaxf(v1[j], 0.f); v0[j] = a * a; v1[j] = b * b; } }
                    u32x4 w; w.x = cvt_pk_bf16(v0[0], v0[1]); w.y = cvt_pk_bf16(v0[2], v0[3]); w.z = cvt_pk_bf16(v1[0], v1[1]); w.w = cvt_pk_bf16(v1[2], v1[3]);
                    *(u32x4*)(rowp + bj * HALF) = w; } }
    }
};
struct EpiYss {
    static constexpr bool PERM = true, AFTER_DRAIN = false;
    bf16_t* Y; float* SS;
    __device__ __forceinline__ void operator()(const f32x4 (&acc)[2][2][4][2], const Unit& u, int wr, int wc, int fr, int fq) const {
        const int row0 = u.pm * BM + wr * 64 + fr; const int col0 = u.pn * BM + wc * 32 + 8 * fq;
#pragma unroll
        for (int ai = 0; ai < 2; ++ai)
#pragma unroll
            for (int m = 0; m < 4; ++m) { const int row = row0 + ai * HALF + m * 16; bf16_t* rowp = Y + (size_t)row * 1024 + col0; float s = 0.f;
#pragma unroll
                for (int bj = 0; bj < 2; ++bj) { const f32x4 v0 = acc[ai][bj][m][0], v1 = acc[ai][bj][m][1];
                    s += (v0[0] * v0[0] + v0[1] * v0[1]) + (v0[2] * v0[2] + v0[3] * v0[3]) + (v1[0] * v1[0] + v1[1] * v1[1]) + (v1[2] * v1[2] + v1[3] * v1[3]);
                    u32x4 w; w.x = cvt_pk_bf16(v0[0], v0[1]); w.y = cvt_pk_bf16(v0[2], v0[3]); w.z = cvt_pk_bf16(v1[0], v1[1]); w.w = cvt_pk_bf16(v1[2], v1[3]);
                    *(u32x4*)(rowp + bj * HALF) = w; }
                s += __shfl_xor(s, 16); s += __shfl_xor(s, 32);
                if (fq == 0) SS[(size_t)row * 16 + u.pn * 4 + wc] = s; }
    }
};
struct EpiOddIn {
    static constexpr bool PERM = false, AFTER_DRAIN = true;
    bf16_t* QN; bf16_t* ACKV; float* KPERAW; float* out_ckv; float* out_kpe; const float* gq; const float* gkv; int li;
    __device__ __forceinline__ void fused(f32x4 (&acc)[2][2][4][2], const Unit& u, int wr, int wc, int fr, int fq, PG8_LAS unsigned char* lds, int wid, int lane) const {
        PG8_LAS float* P = (PG8_LAS float*)lds;
        if (u.pn < 2) {
#pragma unroll
            for (int ai = 0; ai < 2; ++ai)
#pragma unroll
                for (int m = 0; m < 4; ++m) { float s = 0.f;
#pragma unroll
                    for (int bj = 0; bj < 2; ++bj)
#pragma unroll
                        for (int n = 0; n < 2; ++n) { const f32x4 x = acc[ai][bj][m][n]; s += (x[0] * x[0] + x[1] * x[1]) + (x[2] * x[2] + x[3] * x[3]); }
                    s += __shfl_xor(s, 16); s += __shfl_xor(s, 32);
                    if (fq == 0) P[(ai * HALF + wr * 64 + m * 16 + fr) * 4 + wc] = s; }
        }
        asm volatile("s_waitcnt lgkmcnt(0)" ::: "memory"); __builtin_amdgcn_s_barrier(); asm volatile("" ::: "memory");
        if (u.pn < 2) {
            const float* gv = u.pn == 0 ? gq : gkv;
#pragma unroll
            for (int ai = 0; ai < 2; ++ai)
#pragma unroll
                for (int m = 0; m < 4; ++m) { const int r = ai * HALF + wr * 64 + m * 16 + fr; const int grow = u.pm * BM + r;
                    const float tot = (P[r * 4 + 0] + P[r * 4 + 1]) + (P[r * 4 + 2] + P[r * 4 + 3]);
                    const float rstd = 1.0f / sqrtf(tot * (1.0f / 256.0f) + 1e-6f);
                    const int drow = grow < 4096 ? grow : 4096 + ((grow - 4096) >> 11) * 2304 + 256 + ((grow - 4096) & 2047);
#pragma unroll
                    for (int bj = 0; bj < 2; ++bj)
#pragma unroll
                        for (int n = 0; n < 2; ++n) { const int col = bj * HALF + wc * 32 + n * 16 + 4 * fq; const f32x4 g = *(const f32x4*)(gv + col);
                            const f32x4 v = acc[ai][bj][m][n] * rstd * g;
                            unsigned long long w = (unsigned long long)cvt_pk_bf16(v[0], v[1]) | ((unsigned long long)cvt_pk_bf16(v[2], v[3]) << 32);
                            if (u.pn == 0) *(unsigned long long*)(QN + (size_t)grow * 256 + col) = w;
                            else { *(unsigned long long*)(ACKV + (size_t)drow * 256 + col) = w;
                                   if (grow < 4096) *(f32x4*)(out_ckv + ((size_t)((grow >> 8) * 2 + li) * 256 + (grow & 255)) * 256 + col) = v; } } }
        } else if (wc < 2) {
#pragma unroll
            for (int ai = 0; ai < 2; ++ai)
#pragma unroll
                for (int m = 0; m < 4; ++m) { const int r = ai * HALF + wr * 64 + m * 16 + fr; const int grow = u.pm * BM + r;
#pragma unroll
                    for (int n = 0; n < 2; ++n) { const int col = wc * 32 + n * 16 + 4 * fq; const f32x4 v = acc[ai][0][m][n];
                        *(f32x4*)(KPERAW + (size_t)grow * 64 + col) = v;
                        if (grow < 4096) *(f32x4*)(out_kpe + ((size_t)((grow >> 8) * 2 + li) * 256 + (grow & 255)) * 64 + col) = v; } }
        }
    }
};

template <class Epi, class Sched, bool ALIGN_EPI = false, bool SP2 = false>
__device__ __forceinline__ void gemm_phase(PG8_LAS unsigned char* lds, const Gemm g, const Sched& S, const Epi& E, const int tid) {
    const int  wid = __builtin_amdgcn_readfirstlane(tid >> 6), lane = tid & 63, wr = wid >> 2, wc = wid & 3, fr = lane & 15, fq = lane >> 4;
    const int K = g.K, nt = K / BK;
    unsigned voffA[2], voffB[2];
#pragma unroll
    for (int i = 0; i < 2; ++i) { int R, C; stage_rc(tid * 16 + i * 8192, R, C); const int Rb = Epi::PERM ? ((R & ~31) + perm32(R & 31)) : R;
        voffA[i] = (unsigned)(R * K + C) * 2u; voffB[i] = (unsigned)(Rb * K + C) * 2u; }
    const size_t kstep = (size_t)(BK * 2);
    const size_t hstep = (size_t)HALF * K * 2;
    const size_t tstep = 2 * hstep;
    const unsigned ldsw = (unsigned)wid * 1024u;
    const int aoff = lds_byte(wr * 64 + fr, fq * 8), boff = lds_byte(wc * 32 + fr, fq * 8);
#define PG8_SA(b, h) (((b) * 2 + (h)) * HTB)
#define PG8_SB(b, h) ((4 + (b) * 2 + (h)) * HTB)
#define PG8_STAGE(bufoff, gbase, voff) do { _Pragma("unroll") for (int _i = 0; _i < 2; ++_i) \
        __builtin_amdgcn_global_load_lds((const unsigned*)((const char*)(gbase) + (voff)[_i]), (PG8_LAS unsigned*)(lds + (bufoff) + ldsw + _i * 8192), 16, 0, 0); } while (0)
#define PG8_LDA(dst, b, h) do { _Pragma("unroll") for (int m = 0; m < 4; ++m) _Pragma("unroll") for (int k = 0; k < 2; ++k) dst[m][k] = *(const PG8_LAS bf16x8*)(lds + PG8_SA(b, h) + aoff + m * 2048 + k * 1024); } while (0)
#define PG8_LDB(dst, b, h) do { _Pragma("unroll") for (int n = 0; n < 2; ++n) _Pragma("unroll") for (int k = 0; k < 2; ++k) dst[n][k] = *(const PG8_LAS bf16x8*)(lds + PG8_SB(b, h) + boff + n * 2048 + k * 1024); } while (0)
#define PG8_MMA(ai, bj, At, Bt) do { __builtin_amdgcn_s_setprio(1); _Pragma("unroll") for (int m = 0; m < 4; ++m) _Pragma("unroll") for (int n = 0; n < 2; ++n) _Pragma("unroll") for (int k = 0; k < 2; ++k) \
        acc[ai][bj][m][n] = __builtin_amdgcn_mfma_f32_16x16x32_bf16(Bt[n][k], At[m][k], acc[ai][bj][m][n], 0, 0, 0); __builtin_amdgcn_s_setprio(0); } while (0)
#define PG8_WAIT_V(n) asm volatile("s_waitcnt vmcnt(" #n ")" ::: "memory")
#define PG8_WAIT_L(n) asm volatile("s_waitcnt lgkmcnt(" #n ")" ::: "memory")
#define PG8_BAR __builtin_amdgcn_s_barrier()
#define PG8_SCHED __builtin_amdgcn_sched_barrier(0)
    Unit cur, nxt; int ui = 0;
    if (!S.next(0, cur)) return;
    f32x4 acc[2][2][4][2];
#pragma unroll
    for (int a = 0; a < 2; ++a)
#pragma unroll
        for (int b = 0; b < 2; ++b)
#pragma unroll
            for (int m = 0; m < 4; ++m)
#pragma unroll
                for (int n = 0; n < 2; ++n) acc[a][b][m][n] = (f32x4){0.f, 0.f, 0.f, 0.f};
    bf16x8 At[4][2], B0[2][2], B1[2][2];
    const char* cA = (const char*)g.A + (size_t)cur.pm * tstep; const char* cB = (const char*)g.Bt + (size_t)cur.pn * tstep;
    S.a_ready(cur);
    if constexpr (SP2) {
        PG8_STAGE(PG8_SB(0, 0), cB, voffB); PG8_STAGE(PG8_SB(0, 1), cB + hstep, voffB); PG8_STAGE(PG8_SA(0, 0), cA, voffA); PG8_STAGE(PG8_SA(0, 1), cA + hstep, voffA);
        if (wr == 1) PG8_BAR;
        PG8_WAIT_V(2); PG8_BAR;
        PG8_STAGE(PG8_SB(1, 0), cB + kstep, voffB); PG8_STAGE(PG8_SA(1, 0), cA + kstep, voffA); PG8_STAGE(PG8_SB(1, 1), cB + hstep + kstep, voffB);
        PG8_WAIT_V(6); PG8_BAR;
    } else {
        PG8_STAGE(PG8_SB(0, 0), cB, voffB); PG8_STAGE(PG8_SA(0, 0), cA, voffA); PG8_STAGE(PG8_SB(0, 1), cB + hstep, voffB); PG8_STAGE(PG8_SA(0, 1), cA + hstep, voffA);
        if (wr == 1) PG8_BAR;
        PG8_WAIT_V(4); PG8_BAR;
        PG8_STAGE(PG8_SB(1, 0), cB + kstep, voffB); PG8_STAGE(PG8_SA(1, 0), cA + kstep, voffA); PG8_STAGE(PG8_SB(1, 1), cB + hstep + kstep, voffB);
        PG8_WAIT_V(6); PG8_BAR;
    }
    for (;;) {
        const bool has_next = S.next(ui + 1, nxt);
        const char* nA = has_next ? (const char*)g.A + (size_t)nxt.pm * tstep : cA; const char* nB = has_next ? (const char*)g.Bt + (size_t)nxt.pn * tstep : cB;
        for (int t = 0; t < nt; t += 2) {
            const bool last = (t == nt - 2);
            const char* a1 = cA + (size_t)(t + 1) * kstep;
            const char* a2 = last ? nA : cA + (size_t)(t + 2) * kstep; const char* b2 = last ? nB : cB + (size_t)(t + 2) * kstep;
            const char* a3 = a2 + kstep; const char* b3 = b2 + kstep;
            if (last && has_next) S.a_ready(nxt);
            if constexpr (SP2) {
            PG8_LDB(B0, 0, 0); PG8_LDB(B1, 0, 1); PG8_SCHED; PG8_LDA(At, 0, 0); PG8_STAGE(PG8_SA(1, 1), a1 + hstep, voffA);
            PG8_WAIT_V(8); PG8_WAIT_L(0); PG8_BAR; PG8_MMA(0, 0, At, B0); PG8_MMA(0, 1, At, B1); PG8_BAR; PG8_SCHED;
            PG8_LDA(At, 0, 1); PG8_STAGE(PG8_SB(0, 0), b2, voffB); PG8_STAGE(PG8_SB(0, 1), b2 + hstep, voffB); PG8_STAGE(PG8_SA(0, 0), a2, voffA);
            PG8_WAIT_V(8); PG8_WAIT_L(0); PG8_BAR; PG8_MMA(1, 0, At, B0); PG8_MMA(1, 1, At, B1); PG8_BAR; PG8_SCHED;
            PG8_LDB(B0, 1, 0); PG8_LDB(B1, 1, 1); PG8_SCHED; PG8_LDA(At, 1, 0); PG8_STAGE(PG8_SA(0, 1), a2 + hstep, voffA);
            PG8_WAIT_V(8); PG8_WAIT_L(0); PG8_BAR; PG8_MMA(0, 0, At, B0); PG8_MMA(0, 1, At, B1); PG8_BAR; PG8_SCHED;
            PG8_LDA(At, 1, 1); PG8_STAGE(PG8_SB(1, 0), b3, voffB); PG8_STAGE(PG8_SB(1, 1), b3 + hstep, voffB); PG8_STAGE(PG8_SA(1, 0), a3, voffA);
            PG8_WAIT_V(8); PG8_WAIT_L(0); PG8_BAR; PG8_MMA(1, 0, At, B0); PG8_MMA(1, 1, At, B1); PG8_BAR; PG8_SCHED;
            } else {
            PG8_LDB(B0, 0, 0); PG8_SCHED; PG8_LDA(At, 0, 0); PG8_STAGE(PG8_SA(1, 1), a1 + hstep, voffA);
            PG8_WAIT_L(8); PG8_BAR; PG8_WAIT_L(0); PG8_MMA(0, 0, At, B0); PG8_BAR; PG8_SCHED;
            PG8_LDB(B1, 0, 1); PG8_STAGE(PG8_SB(0, 0), b2, voffB);
            PG8_BAR; PG8_WAIT_L(0); PG8_MMA(0, 1, At, B1); PG8_BAR;
            PG8_LDA(At, 0, 1); PG8_STAGE(PG8_SA(0, 0), a2, voffA);
            PG8_BAR; PG8_WAIT_L(0); PG8_MMA(1, 0, At, B0); PG8_BAR; PG8_SCHED;
            PG8_STAGE(PG8_SB(0, 1), b2 + hstep, voffB);
            PG8_WAIT_V(6); PG8_BAR; PG8_MMA(1, 1, At, B1); PG8_BAR;
            PG8_LDB(B0, 1, 0); PG8_SCHED; PG8_LDA(At, 1, 0); PG8_STAGE(PG8_SA(0, 1), a2 + hstep, voffA);
            PG8_WAIT_L(8); PG8_BAR; PG8_WAIT_L(0); PG8_MMA(0, 0, At, B0); PG8_BAR; PG8_SCHED;
            PG8_LDB(B1, 1, 1); PG8_STAGE(PG8_SB(1, 0), b3, voffB);
            PG8_BAR; PG8_WAIT_L(0); PG8_MMA(0, 1, At, B1); PG8_BAR;
            PG8_LDA(At, 1, 1); PG8_STAGE(PG8_SA(1, 0), a3, voffA);
            PG8_BAR; PG8_WAIT_L(0); PG8_MMA(1, 0, At, B0); PG8_BAR; PG8_SCHED;
            PG8_STAGE(PG8_SB(1, 1), b3 + hstep, voffB);
            PG8_WAIT_V(6); PG8_BAR; PG8_MMA(1, 1, At, B1); PG8_BAR;
            }
        }
        if constexpr (ALIGN_EPI) { if (wr == 0) PG8_BAR; }
        if constexpr (!Epi::AFTER_DRAIN) { E(acc, cur, wr, wc, fr, fq); S.done(cur); }
        if (!has_next) break;
#pragma unroll
        for (int a = 0; a < 2; ++a)
#pragma unroll
            for (int b = 0; b < 2; ++b)
#pragma unroll
                for (int m = 0; m < 4; ++m)
#pragma unroll
                    for (int n = 0; n < 2; ++n) acc[a][b][m][n] = (f32x4){0.f, 0.f, 0.f, 0.f};
        cur = nxt; cA = nA; cB = nB; ++ui;
        if constexpr (ALIGN_EPI) { if (wr == 1) PG8_BAR; }
    }
    PG8_WAIT_V(0);
    if constexpr (!ALIGN_EPI) { if (wr == 0) PG8_BAR; }
    PG8_BAR;
    if constexpr (Epi::AFTER_DRAIN) { E.fused(acc, cur, wr, wc, fr, fq, lds, wid, lane); S.done(cur); }
#undef PG8_SA
#undef PG8_SB
#undef PG8_STAGE
#undef PG8_LDA
#undef PG8_LDB
#undef PG8_MMA
#undef PG8_WAIT_V
#undef PG8_WAIT_L
#undef PG8_BAR
#undef PG8_SCHED
}
}

constexpr int NWAVES = 8;
constexpr int D = 1024, FF = 4096, M_CTX = 4096, M_LAT = 16384, M = M_CTX + M_LAT;
constexpr int L_LAT = 2048, L_CTX = 256, PAST = 256, LKV = PAST + L_LAT;
constexpr int MKV = M_CTX + 8 * LKV;
constexpr int EVEN_N = 3104, EVEN_NP = 3328, ODD_N = 576, ODD_NP = 768;
constexpr float EPS = 1e-6f;
constexpr int PC_QA = 0, PC_KA = 256, PC_VA = 512, PC_GA = 1024, PC_QB = 1536, PC_KB = 1792, PC_VB = 2048, PC_GB = 2560, PC_GK = 3072;
constexpr size_t OUT_Y = 0, OUT_CKV = 20971520, OUT_KPE = 23068672, OUT_SGLA = 23592960, OUT_SRET = 25690112;

constexpr size_t MiB = 1u << 20;
constexpr size_t WS_CTL = 0, CTL_ZERO_BYTES = 64 * 1024;
constexpr size_t WS_MOD = 1 * MiB;
constexpr size_t WS_ROPE = 2 * MiB;
constexpr size_t WS_SS = 3 * MiB;
constexpr size_t WS_KPE = 5 * MiB;
constexpr size_t WS_ACKV = 11 * MiB;
constexpr size_t WS_WINE = 35 * MiB;
constexpr size_t WS_WOUTE = 48 * MiB;
constexpr size_t WS_WINO = 52 * MiB;
constexpr size_t WS_WQB = 55 * MiB;
constexpr size_t WS_WKVB = 57 * MiB;
constexpr size_t WS_WOUTO = 59 * MiB;
constexpr size_t WS_W1 = 63 * MiB;
constexpr size_t WS_W2 = 95 * MiB;
constexpr size_t WS_HB = 127 * MiB;
constexpr size_t WS_Y = 167 * MiB;
constexpr size_t WS_BIG = 207 * MiB;
constexpr size_t WS_Q = WS_BIG, WS_KV = WS_BIG + 60 * MiB, WS_QN = WS_BIG + 148 * MiB;
constexpr size_t WS_END = 367 * MiB;

constexpr int RING_BYTES = 131072;
constexpr int LDS_MISC = 155648;
constexpr int LDS_BYTES = 163840;

#define GAS __attribute__((address_space(1)))
#define LAS __attribute__((address_space(3)))
typedef unsigned short bf16;
typedef unsigned v4u __attribute__((ext_vector_type(4)));
typedef unsigned v2u __attribute__((ext_vector_type(2)));
typedef float f32x4 __attribute__((ext_vector_type(4)));
typedef float f32x16 __attribute__((ext_vector_type(16)));
typedef short bf16x8 __attribute__((ext_vector_type(8)));
typedef short s16x4 __attribute__((ext_vector_type(4)));
#define LDS_WAIT() asm volatile("s_waitcnt lgkmcnt(0)" ::: "memory")
#define VM_WAIT() asm volatile("s_waitcnt vmcnt(0)" ::: "memory")
__device__ __forceinline__ unsigned f2bf(float f) { unsigned u = __builtin_bit_cast(unsigned, f); return (u + 0x7fffu + ((u >> 16) & 1u)) >> 16; }
__device__ __forceinline__ unsigned pk2(float lo, float hi) { return f2bf(lo) | (f2bf(hi) << 16); }
__device__ __forceinline__ float bflo(unsigned w) { return __builtin_bit_cast(float, w << 16); }
__device__ __forceinline__ float bfhi(unsigned w) { return __builtin_bit_cast(float, w & 0xffff0000u); }
__device__ __forceinline__ float wave_sum(float v) {
#pragma unroll
    for (int o = 1; o < 64; o <<= 1) v += __shfl_xor(v, o);
    return v;
}
__device__ __forceinline__ float siluf(float x) { return x / (1.0f + __expf(-x)); }

#define XB_TMO      128
#define XB_XCNT(j)  (256  + 64 * (j))
#define XB_XSUB(j)  (1280 + 64 * (j))
#define XB_XGEN(j)  (2304 + 64 * (j))
#define XB_TOP      3328
#define XB_TOPGEN   3392
#define XCD_BAR_WORDS 3456
#define XB_SPIN_CAP (1u << 20)
__device__ __forceinline__ unsigned xb_ld(unsigned* p)              { return __hip_atomic_load(p, __ATOMIC_RELAXED, __HIP_MEMORY_SCOPE_AGENT); }
__device__ __forceinline__ unsigned xb_add(unsigned* p, unsigned v) { return __hip_atomic_fetch_add(p, v, __ATOMIC_RELAXED, __HIP_MEMORY_SCOPE_AGENT); }
__device__ __forceinline__ unsigned xb_xcc_id() { return (unsigned)__builtin_amdgcn_s_getreg((3 << 11) | 20) & 0xFu; }
#define XB_SPIN(cond, bar) do { unsigned _sp = 0; while (cond) { __builtin_amdgcn_s_sleep(1); \
    if ((++_sp & 255u) == 0u) { if (xb_ld(&(bar)[XB_TMO])) break; if (_sp > XB_SPIN_CAP) { atomicAdd(&(bar)[XB_TMO], 1u); break; } } } } while (0)
struct XcdBarrier { unsigned* bar; unsigned x; volatile LAS unsigned* st; };
__device__ __forceinline__ XcdBarrier xcd_barrier_post(unsigned* bar, volatile LAS unsigned* st) {
    XcdBarrier b; b.bar = bar; b.x = xb_xcc_id(); b.st = st;
    if (threadIdx.x == 0) (void)xb_add(&bar[XB_XCNT(b.x)], 1u);
    return b;
}
__device__ __forceinline__ void xcd_barrier_complete(unsigned* bar, unsigned x, unsigned& nloc, unsigned& nx) {
    const unsigned G = gridDim.x * gridDim.y * gridDim.z;
    unsigned sum, cnt, mine, sp = 0u;
    for (;;) {
        sum = 0u; cnt = 0u; mine = 0u;
#pragma unroll
        for (unsigned j = 0; j < 16; ++j) { const unsigned c = xb_ld(&bar[XB_XCNT(j)]); sum += c; cnt += (c > 0u) ? 1u : 0u; mine = (j == x) ? c : mine; }
        if (sum == G) break;
        __builtin_amdgcn_s_sleep(1);
        if ((++sp & 255u) == 0u) { if (xb_ld(&bar[XB_TMO])) break; if (sp > XB_SPIN_CAP) { atomicAdd(&bar[XB_TMO], 1u); break; } }
    }
    nloc = mine > 0u ? mine : 1u; nx = cnt > 0u ? cnt : 1u;
}
__device__ __forceinline__ void xcd_barrier(const XcdBarrier& b) {
    asm volatile("s_waitcnt vmcnt(0)" ::: "memory");
    __syncthreads();
    if (threadIdx.x == 0) {
        unsigned* bar = b.bar;
        __builtin_amdgcn_s_waitcnt(0);
        unsigned nloc = b.st[0], nx = b.st[1];
        if (nloc == 0u) { xcd_barrier_complete(bar, b.x, nloc, nx); b.st[0] = nloc; b.st[1] = nx; }
        const unsigned old = xb_add(&bar[XB_XSUB(b.x)], 1u);
        const unsigned gen = old / nloc;
        if (old + 1u == (gen + 1u) * nloc) {
            __builtin_amdgcn_fence(__ATOMIC_RELEASE, "agent");
            asm volatile("s_waitcnt vmcnt(0)" ::: "memory");
            const unsigned og = xb_add(&bar[XB_TOP], 1u);
            const unsigned tg = og / nx;
            if (og + 1u == (tg + 1u) * nx) xb_add(&bar[XB_TOPGEN], 1u);
            else XB_SPIN(xb_ld(&bar[XB_TOPGEN]) == tg, bar);
            __builtin_amdgcn_fence(__ATOMIC_ACQUIRE, "agent");
            xb_add(&bar[XB_XGEN(b.x)], 1u);
            asm volatile("s_waitcnt vmcnt(0)" ::: "memory");
        } else {
            XB_SPIN(xb_ld(&bar[XB_XGEN(b.x)]) == gen, bar);
            __builtin_amdgcn_fence(__ATOMIC_ACQUIRE, "agent");
            asm volatile("s_waitcnt vmcnt(0)" ::: "memory");
        }
    }
    __syncthreads();
}

struct Params { const float* in[28]; float* out; unsigned char* ws; int ph_lo, ph_hi, use_bar, pad; };
enum { I_XP = 0, I_XS, I_CCKV, I_CKPE, I_SGLA, I_SRET, I_C, I_CCTX, I_WADA, I_BADA, I_NMIXPRE, I_NMIXPOST, I_NMLPPRE, I_NMLPPOST,
       I_WINE, I_WGK2, I_BGK2, I_GLAN, I_RDEC, I_WOUTE, I_WINO, I_QAN, I_WQB, I_KVAN, I_WKVB, I_WOUTO, I_W1, I_W2 };
struct Frame { LAS unsigned char* lds; int tid, lane, wave, vcu, G, bid; };
constexpr int LDS_PT = LDS_MISC + 256;
__device__ __forceinline__ const void* ldp(LAS unsigned char* lds, int i) {
    const volatile LAS unsigned* p = (const volatile LAS unsigned*)(lds + LDS_PT) + 2 * i;
    const unsigned lo = __builtin_amdgcn_readfirstlane(p[0]), hi = __builtin_amdgcn_readfirstlane(p[1]);
    return (const void*)(((unsigned long long)hi << 32) | lo);
}
#define PIN(i) ((const float*)ldp(F.lds, (i)))
#define POUT ((float*)ldp(F.lds, 28))
#define PWS ((unsigned char*)ldp(F.lds, 29))

__device__ __forceinline__ void p0_transpose_item(const float* W, int K, int N, bf16* WT, int kb, int n0, int dn0, LAS float* scr, int lane) {
    const int k0 = 64 * kb;
#pragma unroll 8
    for (int i = 0; i < 32; ++i) { const int kk = 2 * i + (lane >> 5); scr[kk * 33 + (lane & 31)] = W[(size_t)(k0 + kk) * N + n0 + (lane & 31)]; }
    LDS_WAIT(); asm volatile("" ::: "memory");
    const int c = lane & 7;
#pragma unroll
    for (int j = 0; j < 4; ++j) { const int n = (lane >> 3) + 8 * j; const LAS float* s = scr + (8 * c) * 33 + n;
        v4u o; o.x = pk2(s[0 * 33], s[1 * 33]); o.y = pk2(s[2 * 33], s[3 * 33]); o.z = pk2(s[4 * 33], s[5 * 33]); o.w = pk2(s[6 * 33], s[7 * 33]);
        *(GAS v4u*)(WT + (size_t)(dn0 + n) * K + k0 + 8 * c) = o; }
    LDS_WAIT(); asm volatile("" ::: "memory");
}
__device__ __forceinline__ int even_col_map(int n0) { return n0 < 1536 ? n0 : (n0 < 1568 ? 3072 + (n0 - 1536) : n0 - 32); }

__device__ __forceinline__ void p0_prologue(Frame& F, const Params& P) {
    unsigned char* ws = PWS;
    LAS float* scr = (LAS float*)(F.lds + F.wave * 16384);
    const int gw = F.vcu * NWAVES + F.wave, NGW = F.G * NWAVES;
    {
        LAS float* S = (LAS float*)(F.lds);
        LAS float* R = (LAS float*)(F.lds + 40960);
        { const float* cp_ = PIN(I_C); const float* cc_ = PIN(I_CCTX);
          for (int i = F.tid; i < 9 * 1024; i += 512) { const int n = i >> 10, d = i & 1023; const float cv = n < 8 ? cp_[n * 1024 + d] : cc_[d]; S[i] = siluf(cv); } }
        const float* wada_ = PIN(I_WADA); const float* bada_ = PIN(I_BADA);
        __syncthreads();
        for (int u = F.vcu; u < 256; u += F.G) {
            const int l = u >> 6, cb = (u & 63) * 96;
            if (F.tid < 384) {
                const int c4 = (F.tid % 24) * 4, part = F.tid / 24;
                const float* Wp = wada_ + ((size_t)l * 1024 + part * 64) * 6144 + cb + c4;
                f32x4 a[9];
#pragma unroll
                for (int n = 0; n < 9; ++n) a[n] = (f32x4){0.f, 0.f, 0.f, 0.f};
#pragma unroll 4
                for (int d = 0; d < 64; ++d) { const f32x4 w = *(const f32x4*)(Wp + (size_t)d * 6144);
#pragma unroll
                    for (int n = 0; n < 9; ++n) a[n] += w * S[n * 1024 + part * 64 + d]; }
#pragma unroll
                for (int n = 0; n < 9; ++n) *(LAS f32x4*)(R + (part * 9 + n) * 96 + c4) = a[n];
            }
            __syncthreads();
            for (int i = F.tid; i < 9 * 96; i += 512) { const int n = i / 96, c = i % 96; float s = 0.f;
#pragma unroll
                for (int p = 0; p < 16; ++p) s += R[(p * 9 + n) * 96 + c];
                ((float*)(ws + WS_MOD))[((size_t)l * 9 + n) * 6144 + cb + c] = s + bada_[l * 6144 + cb + c]; }
            __syncthreads();
        }
    }
    {
        int it = gw;
        const int I_E = (1024 / 64) * (EVEN_N / 32), I_OE = 16 * 32, I_O = 16 * (ODD_N / 32), I_QB = 4 * 48, I_KVB = 4 * 64, I_M1 = 16 * 128, I_M2 = 64 * 32;
        const int T_E = 2 * I_E, T_OE = 2 * I_OE, T_O = 2 * I_O, T_QB = 2 * I_QB, T_KVB = 2 * I_KVB, T_OO = 2 * I_OE, T_M1 = 4 * I_M1, T_M2 = 4 * I_M2;
        const int TOTAL = T_E + T_OE + T_O + T_QB + T_KVB + T_OO + T_M1 + T_M2;
        for (; it < TOTAL; it += NGW) {
            int r = it;
            if (r < T_E) { const int l = r / I_E, q = r % I_E, nb = EVEN_N / 32, kb = q / nb, n0 = (q % nb) * 32;
                p0_transpose_item(PIN(I_WINE) + (size_t)l * 1024 * EVEN_N, 1024, EVEN_N, (bf16*)(ws + WS_WINE) + (size_t)l * EVEN_NP * 1024, kb, n0, even_col_map(n0), scr, F.lane); continue; } r -= T_E;
            if (r < T_OE) { const int l = r / I_OE, q = r % I_OE, kb = q / 32, n0 = (q % 32) * 32;
                p0_transpose_item(PIN(I_WOUTE) + (size_t)l * 1024 * 1024, 1024, 1024, (bf16*)(ws + WS_WOUTE) + (size_t)l * 1024 * 1024, kb, n0, n0, scr, F.lane); continue; } r -= T_OE;
            if (r < T_O) { const int l = r / I_O, q = r % I_O, nb = ODD_N / 32, kb = q / nb, n0 = (q % nb) * 32;
                p0_transpose_item(PIN(I_WINO) + (size_t)l * 1024 * ODD_N, 1024, ODD_N, (bf16*)(ws + WS_WINO) + (size_t)l * ODD_NP * 1024, kb, n0, n0, scr, F.lane); continue; } r -= T_O;
            if (r < T_QB) { const int l = r / I_QB, q = r % I_QB, kb = q / 48, n0 = (q % 48) * 32;
                p0_transpose_item(PIN(I_WQB) + (size_t)l * 256 * 1536, 256, 1536, (bf16*)(ws + WS_WQB) + (size_t)l * 1536 * 256, kb, n0, n0, scr, F.lane); continue; } r -= T_QB;
            if (r < T_KVB) { const int l = r / I_KVB, q = r % I_KVB, kb = q / 64, n0 = (q % 64) * 32;
                p0_transpose_item(PIN(I_WKVB) + (size_t)l * 256 * 2048, 256, 2048, (bf16*)(ws + WS_WKVB) + (size_t)l * 2048 * 256, kb, n0, n0, scr, F.lane); continue; } r -= T_KVB;
            if (r < T_OO) { const int l = r / I_OE, q = r % I_OE, kb = q / 32, n0 = (q % 32) * 32;
                p0_transpose_item(PIN(I_WOUTO) + (size_t)l * 1024 * 1024, 1024, 1024, (bf16*)(ws + WS_WOUTO) + (size_t)l * 1024 * 1024, kb, n0, n0, scr, F.lane); continue; } r -= T_OO;
            if (r < T_M1) { const int l = r / I_M1, q = r % I_M1, kb = q / 128, n0 = (q % 128) * 32;
                p0_transpose_item(PIN(I_W1) + (size_t)l * 1024 * 4096, 1024, 4096, (bf16*)(ws + WS_W1) + (size_t)l * 4096 * 1024, kb, n0, n0, scr, F.lane); continue; } r -= T_M1;
            { const int l = r / I_M2, q = r % I_M2, kb = q / 32, n0 = (q % 32) * 32;
                p0_transpose_item(PIN(I_W2) + (size_t)l * 4096 * 1024, 4096, 1024, (bf16*)(ws + WS_W2) + (size_t)l * 1024 * 4096, kb, n0, n0, scr, F.lane); }
        }
    }
    const int gt = F.vcu * 512 + F.tid, NGT = F.G * 512;
    for (int i = gt; i < 2 * 224 * 128; i += NGT) { const int l = i / (224 * 128), q = i % (224 * 128); *(GAS v4u*)((bf16*)(ws + WS_WINE) + ((size_t)l * EVEN_NP + EVEN_N) * 1024 + (size_t)q * 8) = (v4u){0u, 0u, 0u, 0u}; }
    for (int i = gt; i < 2 * 192 * 128; i += NGT) { const int l = i / (192 * 128), q = i % (192 * 128); *(GAS v4u*)((bf16*)(ws + WS_WINO) + ((size_t)l * ODD_NP + ODD_N) * 1024 + (size_t)q * 8) = (v4u){0u, 0u, 0u, 0u}; }
    const float* cckv_ = PIN(I_CCKV); const float* ckpe_ = PIN(I_CKPE);
    for (int i = gt; i < 8 * 2 * 256 * 32; i += NGT) { const int c8 = i & 31, t = (i >> 5) & 255, li = (i >> 13) & 1, b = i >> 14;
        const float* s = cckv_ + (size_t)i * 8; const f32x4 a = *(const f32x4*)s, c = *(const f32x4*)(s + 4);
        *(GAS v4u*)((bf16*)(ws + WS_ACKV) + ((size_t)li * MKV + 4096 + b * LKV + t) * 256 + c8 * 8) = (v4u){pk2(a[0], a[1]), pk2(a[2], a[3]), pk2(c[0], c[1]), pk2(c[2], c[3])}; }
    for (int i = gt; i < 8 * 2 * 256 * 8; i += NGT) { const int c8 = i & 7, t = (i >> 3) & 255, li = (i >> 11) & 1, b = i >> 12;
        const float* s = ckpe_ + (size_t)i * 8; const f32x4 a = *(const f32x4*)s, c = *(const f32x4*)(s + 4);
        *(GAS v4u*)((bf16*)(ws + WS_KPE) + ((size_t)li * MKV + 4096 + b * LKV + t) * 64 + c8 * 8) = (v4u){pk2(a[0], a[1]), pk2(a[2], a[3]), pk2(c[0], c[1]), pk2(c[2], c[3])}; }
    for (int i = gt; i < 2048 * 32; i += NGT) { const int t = i >> 5, j = i & 31; const float inv = powf(10000.0f, -(float)(j & 15) / 16.0f);
        const float ang = (float)(j < 16 ? (t >> 6) : (t & 63)) * inv;
        ((float*)(ws + WS_ROPE))[i] = cosf(ang); ((float*)(ws + WS_ROPE))[65536 + i] = sinf(ang); }
}

__device__ __forceinline__ void row_pass(Frame& F, const float* xa, const float* xb, float* xout, const bf16* Y, const float* SS, const float* g_post, const float* gate,
                                         const float* g_pre, const float* scale, const float* shift, bf16* H, bool has_post, bool has_pre) {
    const int gw = F.vcu * NWAVES + F.wave, NGW = F.G * NWAVES, l4 = F.lane * 4;
    for (int row = gw; row < M; row += NGW) {
        const int n = row < M_CTX ? 8 : ((row - M_CTX) >> 11);
        const float* xr = row < M_CTX ? xa + (size_t)row * D : xb + (size_t)(row - M_CTX) * D;
        f32x4 v[4];
#pragma unroll
        for (int j = 0; j < 4; ++j) v[j] = *(const f32x4*)(xr + l4 + 256 * j);
        if (has_post) {
            const f32x4 s0 = *(const f32x4*)(SS + (size_t)row * 16), s1 = *(const f32x4*)(SS + (size_t)row * 16 + 4), s2 = *(const f32x4*)(SS + (size_t)row * 16 + 8), s3 = *(const f32x4*)(SS + (size_t)row * 16 + 12);
            const f32x4 st = (s0 + s1) + (s2 + s3);
            const float rstd = 1.0f / sqrtf(((st[0] + st[1]) + (st[2] + st[3])) * (1.0f / 1024.0f) + EPS);
#pragma unroll
            for (int j = 0; j < 4; ++j) { const int c = l4 + 256 * j; const v2u yw = *(const v2u*)(Y + (size_t)row * D + c);
                const f32x4 yv = (f32x4){bflo(yw.x), bfhi(yw.x), bflo(yw.y), bfhi(yw.y)};
                const f32x4 gp = *(const f32x4*)(g_post + c), gt = *(const f32x4*)(gate + (size_t)n * 6144 + c);
                v[j] = v[j] + gt * ((yv * rstd) * gp);
                *(f32x4*)(xout + (size_t)row * D + c) = v[j]; }
        }
        if (has_pre) {
            float s = 0.f;
#pragma unroll
            for (int j = 0; j < 4; ++j) s += (v[j][0] * v[j][0] + v[j][1] * v[j][1]) + (v[j][2] * v[j][2] + v[j][3] * v[j][3]);
            const float rstd = 1.0f / sqrtf(wave_sum(s) * (1.0f / 1024.0f) + EPS);
#pragma unroll
            for (int j = 0; j < 4; ++j) { const int c = l4 + 256 * j;
                const f32x4 gp = *(const f32x4*)(g_pre + c), sc = *(const f32x4*)(scale + (size_t)n * 6144 + c), sh = *(const f32x4*)(shift + (size_t)n * 6144 + c);
                const f32x4 h = ((v[j] * rstd) * gp) * (1.0f + sc) + sh;
                *(v2u*)(H + (size_t)row * D + c) = (v2u){pk2(h[0], h[1]), pk2(h[2], h[3])}; }
        }
    }
}

__device__ __forceinline__ int crow(int r, int hi) { return (r & 3) + 8 * (r >> 2) + 4 * hi; }
__device__ __forceinline__ unsigned cvtpk(float lo, float hi) { unsigned r; asm volatile("v_cvt_pk_bf16_f32 %0, %1, %2" : "=v"(r) : "v"(lo), "v"(hi)); return r; }
#define SBAR() __builtin_amdgcn_sched_barrier(0)
__device__ __forceinline__ int vst_row(int k, int NB) { const int kk = (k & ~0xC) | ((k & 4) << 1) | ((k & 8) >> 1); return (kk >> 3) * NB * 512 + (kk & 7) * 64; }
__device__ __forceinline__ int vst(int k, int c, int NB) { return vst_row(k, NB) + (c >> 5) * 512 + (c & 31) * 2; }
__device__ __forceinline__ int v_rd_base(int lane) { return ((lane & 3) << 3) | (((lane >> 2) & 3) << 6) | (((lane >> 4) & 1) << 5) | (((lane >> 5) & 1) << 8); }
template <int OFF> __device__ __forceinline__ s16x4 tr_read(unsigned vb) { s16x4 r; asm volatile("ds_read_b64_tr_b16 %0, %1 offset:%2" : "=&v"(r) : "v"(vb), "i"(OFF) : "memory"); return r; }
#define PKF(L, H) ((bf16x8){L[0], L[1], L[2], L[3], H[0], H[1], H[2], H[3]})
#define PK4(P, BASE, OUT) do { unsigned a0_ = cvtpk(P[BASE + 0], P[BASE + 1]), a1_ = cvtpk(P[BASE + 2], P[BASE + 3]);   \
    unsigned b0_ = cvtpk(P[BASE + 4], P[BASE + 5]), b1_ = cvtpk(P[BASE + 6], P[BASE + 7]);                              \
    auto r0_ = __builtin_amdgcn_permlane32_swap(a0_, b0_, false, false); auto r1_ = __builtin_amdgcn_permlane32_swap(a1_, b1_, false, false); \
    v4u w_ = {r0_[0], r1_[0], r0_[1], r1_[1]}; OUT = __builtin_bit_cast(bf16x8, w_); } while (0)
__device__ __forceinline__ float logsig(float x) { return fminf(x, 0.f) - __logf(1.0f + __expf(-fabsf(x))); }

constexpr int SC_QD = 0, SC_KI = 8192, SC_VT = 16384, SC_ST = 32768, SC_BT = 49152, SC_GK = 65536, SC_TOT = 69632, SC_DL = 70656, SC_W2 = 70912, SC_GRP = 75264;
__device__ __forceinline__ void scan_phase(Frame& F, const Params& P, int li) {
    unsigned char* ws = PWS;
    const bf16* PROJ = (const bf16*)(ws + WS_BIG);
    bf16* OF = (bf16*)(ws + WS_Y);
    bf16* OB = (bf16*)(ws + WS_HB);
    const float* ROPE = (const float*)(ws + WS_ROPE);
    const int lane = F.lane, r32 = lane & 31, hi = lane >> 5;
    const int dir = F.wave >> 2, wq = F.wave & 3, tg = F.tid & 255, ri = wq >> 1, dh = wq & 1;
    LAS unsigned char* G = F.lds + dir * SC_GRP;
    const unsigned gaddr = (unsigned)(uintptr_t)G;
    for (int u = F.vcu; u < 192; u += F.G) {
        __syncthreads();
        const bool lat = u < 64; const int sb = lat ? (u >> 3) : ((u - 64) >> 3), hh = lat ? (u & 7) : ((u - 64) & 7);
        const int L = lat ? L_LAT : L_CTX, row0 = lat ? M_CTX + sb * L_LAT : sb * L_CTX, NC = L / 64;
        const bool gla = hh < 4; const int h = hh & 3;
        const int qc = (gla ? PC_QA : PC_QB) + h * 64, kc = (gla ? PC_KA : PC_KB) + h * 64, vc = (gla ? PC_VA : PC_VB) + h * 128, gkc = PC_GK + dir * 16;
        const float* rdec_p = PIN(I_RDEC); const float* wgk2_p = PIN(I_WGK2); const float* bgk2_p = PIN(I_BGK2);
        const float lgr = gla ? 0.f : -__expf(rdec_p[(li * 2 + dir) * 4 + h]);
        if (gla) { LAS float* W2 = (LAS float*)(G + SC_W2);
            for (int i = tg; i < 16 * 64; i += 256) W2[i] = wgk2_p[((size_t)(li * 2 + dir) * 16 + (i >> 6)) * 256 + h * 64 + (i & 63)];
            if (tg < 64) W2[1024 + tg] = bgk2_p[(li * 2 + dir) * 256 + h * 64 + tg]; }
        f32x16 sacc[2];
        { const float* S0 = lat ? (gla ? PIN(I_SGLA) : PIN(I_SRET)) + ((size_t)((sb * 2 + li) * 2 + dir) * 4 + h) * 8192 : nullptr;
#pragma unroll
          for (int d = 0; d < 2; ++d)
#pragma unroll
            for (int r = 0; r < 16; ++r) { const int dk = 32 * ri + crow(r, hi), dv = 32 * (2 * dh + d) + r32;
                const float s0 = lat ? S0[dk * 128 + dv] : 0.f; sacc[d][r] = s0;
                *(LAS unsigned short*)(G + SC_ST + (hi + 4 * ri) * 2048 + (2 * dh + d) * 512 + r32 * 2 + ((r >> 3) & 1) * 4096 + ((r & 3) + 4 * ((r >> 2) & 1)) * 64) = (unsigned short)f2bf(s0); } }
        const int sti = tg >> 2, c8 = tg & 3;
        v4u pq0, pq1, pk0, pk1, pv[4]; v2u pgk;
#define SC_TOK(s) (dir == 0 ? 64 * (s) + sti : L - 1 - (64 * (s) + sti))
#define SC_LOAD(s) do { const bf16* rp = PROJ + (size_t)(row0 + SC_TOK(s)) * EVEN_NP; \
        pq0 = *(const v4u*)(rp + qc + 8 * c8); pq1 = *(const v4u*)(rp + qc + 32 + 8 * c8); pk0 = *(const v4u*)(rp + kc + 8 * c8); pk1 = *(const v4u*)(rp + kc + 32 + 8 * c8); \
        _Pragma("unroll") for (int m_ = 0; m_ < 4; ++m_) pv[m_] = *(const v4u*)(rp + vc + c8 * 32 + 8 * m_); \
        if (gla) pgk = *(const v2u*)(rp + gkc + 4 * c8); } while (0)
        SC_LOAD(0);
        for (int s = 0; s < NC; ++s) {
            int tid_o = F.tid; asm volatile("" : "+v"(tid_o));
            const int lane = tid_o & 63, r32 = lane & 31, hi = lane >> 5, tg = tid_o & 255, sti = tg >> 2, c8 = tg & 3;
            const int tok = SC_TOK(s);
            float bq[16];
            if (gla) {
                { LAS float* GK = (LAS float*)(G + SC_GK) + sti * 16 + 4 * c8; GK[0] = bflo(pgk.x); GK[1] = bfhi(pgk.x); GK[2] = bflo(pgk.y); GK[3] = bfhi(pgk.y); }
                LDS_WAIT(); __syncthreads();
                const int k = tg & 63, tq = tg >> 6; float cs[16]; float run = 0.f;
                float w2[16]; const LAS float* W2 = (const LAS float*)(G + SC_W2);
#pragma unroll
                for (int r = 0; r < 16; ++r) w2[r] = W2[r * 64 + k];
                const float bias2 = W2[1024 + k];
#pragma unroll
                for (int j = 0; j < 16; ++j) { const LAS f32x4* gp = (const LAS f32x4*)((LAS float*)(G + SC_GK) + (16 * tq + j) * 16);
                    const f32x4 g0 = gp[0], g1 = gp[1], g2 = gp[2], g3 = gp[3];
                    float a = bias2;
                    a += g0[0] * w2[0] + g0[1] * w2[1] + g0[2] * w2[2] + g0[3] * w2[3];
                    a += g1[0] * w2[4] + g1[1] * w2[5] + g1[2] * w2[6] + g1[3] * w2[7];
                    a += g2[0] * w2[8] + g2[1] * w2[9] + g2[2] * w2[10] + g2[3] * w2[11];
                    a += g3[0] * w2[12] + g3[1] * w2[13] + g3[2] * w2[14] + g3[3] * w2[15];
                    run += logsig(a) * (1.0f / 16.0f); cs[j] = run; }
                ((LAS float*)(G + SC_TOT))[tq * 64 + k] = run;
                LDS_WAIT(); __syncthreads();
                float pre = 0.f;
#pragma unroll
                for (int q = 0; q < 3; ++q) pre += (q < tq) ? ((LAS float*)(G + SC_TOT))[q * 64 + k] : 0.f;
#pragma unroll
                for (int j = 0; j < 16; ++j) ((LAS float*)(G + SC_BT))[(16 * tq + j) * 64 + k] = pre + cs[j];
                if (tq == 3) ((LAS float*)(G + SC_DL))[k] = __expf(pre + cs[15]);
                LDS_WAIT(); __syncthreads();
            } else { __syncthreads(); }
            {
                float q[16], kk[16];
#define UNPK(dst, o, W_) do { const v4u w_ = (W_); dst[o + 0] = bflo(w_[0]); dst[o + 1] = bfhi(w_[0]); dst[o + 2] = bflo(w_[1]); dst[o + 3] = bfhi(w_[1]); dst[o + 4] = bflo(w_[2]); dst[o + 5] = bfhi(w_[2]); dst[o + 6] = bflo(w_[3]); dst[o + 7] = bfhi(w_[3]); } while (0)
                UNPK(q, 0, pq0); UNPK(q, 8, pq1); UNPK(kk, 0, pk0); UNPK(kk, 8, pk1);
                if (gla) {
                    const LAS f32x4* b0 = (const LAS f32x4*)((LAS float*)(G + SC_BT) + sti * 64 + 8 * c8); const LAS f32x4* b1 = (const LAS f32x4*)((LAS float*)(G + SC_BT) + sti * 64 + 32 + 8 * c8);
                    const f32x4 x0 = b0[0], x1 = b0[1], x2 = b1[0], x3 = b1[1];
#pragma unroll
                    for (int e = 0; e < 4; ++e) { bq[e] = x0[e]; bq[4 + e] = x1[e]; bq[8 + e] = x2[e]; bq[12 + e] = x3[e]; }
#pragma unroll
                    for (int e = 0; e < 16; ++e) { const float eb = __expf(bq[e]); q[e] *= 0.125f * eb; kk[e] *= 1.0f / eb; }
                } else {
                    if (lat) {
                        const float* cp = ROPE + (size_t)tok * 32 + 8 * c8; const float* sp = cp + 65536;
#pragma unroll
                        for (int e = 0; e < 8; ++e) { const float c = cp[e], sn = sp[e];
                            const float q1 = q[e], q2 = q[8 + e]; q[e] = q1 * c - q2 * sn; q[8 + e] = q1 * sn + q2 * c;
                            const float k1 = kk[e], k2 = kk[8 + e]; kk[e] = k1 * c - k2 * sn; kk[8 + e] = k1 * sn + k2 * c; }
                    }
                    const float bb = (float)(sti + 1) * lgr, eb = __expf(bb), ek = 0.125f / eb;
#pragma unroll
                    for (int e = 0; e < 16; ++e) { q[e] *= eb; kk[e] *= ek; }
                }
                *(LAS v4u*)(G + SC_QD + vst(sti, 8 * c8, 2)) = (v4u){pk2(q[0], q[1]), pk2(q[2], q[3]), pk2(q[4], q[5]), pk2(q[6], q[7])};
                *(LAS v4u*)(G + SC_QD + vst(sti, 32 + 8 * c8, 2)) = (v4u){pk2(q[8], q[9]), pk2(q[10], q[11]), pk2(q[12], q[13]), pk2(q[14], q[15])};
                *(LAS v4u*)(G + SC_KI + vst(sti, 8 * c8, 2)) = (v4u){pk2(kk[0], kk[1]), pk2(kk[2], kk[3]), pk2(kk[4], kk[5]), pk2(kk[6], kk[7])};
                *(LAS v4u*)(G + SC_KI + vst(sti, 32 + 8 * c8, 2)) = (v4u){pk2(kk[8], kk[9]), pk2(kk[10], kk[11]), pk2(kk[12], kk[13]), pk2(kk[14], kk[15])};
#pragma unroll
                for (int m = 0; m < 4; ++m) *(LAS v4u*)(G + SC_VT + vst(sti, c8 * 32 + 8 * m, 4)) = pv[m];
            }
            LDS_WAIT(); __syncthreads();
            bf16x8 qf[4]; bf16x8 pa0, pa1, pa2, pa3;
            { const int qb_ = vst_row(32 * ri + r32, 2) + 16 * hi;
              qf[0] = *(const LAS bf16x8*)(G + SC_QD + qb_); qf[1] = *(const LAS bf16x8*)(G + SC_QD + qb_ + 32); qf[2] = *(const LAS bf16x8*)(G + SC_QD + qb_ + 512); qf[3] = *(const LAS bf16x8*)(G + SC_QD + qb_ + 544); }
            { f32x16 p0 = {}, p1 = {};
              const int kb0 = vst_row(r32, 2) + 16 * hi, kb1 = vst_row(32 + r32, 2) + 16 * hi;
              { const bf16x8 a0 = *(const LAS bf16x8*)(G + SC_KI + kb0), a1 = *(const LAS bf16x8*)(G + SC_KI + kb0 + 32), a2 = *(const LAS bf16x8*)(G + SC_KI + kb0 + 512), a3 = *(const LAS bf16x8*)(G + SC_KI + kb0 + 544);
                p0 = __builtin_amdgcn_mfma_f32_32x32x16_bf16(a0, qf[0], p0, 0, 0, 0); p0 = __builtin_amdgcn_mfma_f32_32x32x16_bf16(a1, qf[1], p0, 0, 0, 0);
                p0 = __builtin_amdgcn_mfma_f32_32x32x16_bf16(a2, qf[2], p0, 0, 0, 0); p0 = __builtin_amdgcn_mfma_f32_32x32x16_bf16(a3, qf[3], p0, 0, 0, 0); }
              if (ri == 1) {
                  const bf16x8 c0 = *(const LAS bf16x8*)(G + SC_KI + kb1), c1 = *(const LAS bf16x8*)(G + SC_KI + kb1 + 32), c2 = *(const LAS bf16x8*)(G + SC_KI + kb1 + 512), c3 = *(const LAS bf16x8*)(G + SC_KI + kb1 + 544);
                  p1 = __builtin_amdgcn_mfma_f32_32x32x16_bf16(c0, qf[0], p1, 0, 0, 0); p1 = __builtin_amdgcn_mfma_f32_32x32x16_bf16(c1, qf[1], p1, 0, 0, 0);
                  p1 = __builtin_amdgcn_mfma_f32_32x32x16_bf16(c2, qf[2], p1, 0, 0, 0); p1 = __builtin_amdgcn_mfma_f32_32x32x16_bf16(c3, qf[3], p1, 0, 0, 0); }
#pragma unroll
              for (int r = 0; r < 16; ++r) { const bool keep = crow(r, hi) <= r32; if (ri == 0) { p0[r] = keep ? p0[r] : 0.f; } else { p1[r] = keep ? p1[r] : 0.f; } }
              PK4(p0, 0, pa0); PK4(p0, 8, pa1); PK4(p1, 0, pa2); PK4(p1, 8, pa3); }
            const unsigned vb = gaddr + SC_VT + v_rd_base(lane) + dh * 1024, sbv = gaddr + SC_ST + v_rd_base(lane) + dh * 1024;
#define SC_FR4(dst, base, d) do { const s16x4 l0_ = tr_read<(d) * 512>(base), h0_ = tr_read<(d) * 512 + 2048>(base), l1_ = tr_read<(d) * 512 + 4096>(base), h1_ = tr_read<(d) * 512 + 4096 + 2048>(base); \
              const s16x4 l2_ = tr_read<(d) * 512 + 8192>(base), h2_ = tr_read<(d) * 512 + 8192 + 2048>(base), l3_ = tr_read<(d) * 512 + 12288>(base), h3_ = tr_read<(d) * 512 + 12288 + 2048>(base); \
              asm volatile("s_waitcnt lgkmcnt(0)" ::: "memory"); SBAR(); \
              dst[0] = PKF(l0_, h0_); dst[1] = PKF(l1_, h1_); dst[2] = PKF(l2_, h2_); dst[3] = PKF(l3_, h3_); } while (0)
#define SC_OBLK(d) do { bf16x8 vf_[4], sf_[4]; SC_FR4(vf_, vb, d); SC_FR4(sf_, sbv, d); f32x16 o_ = {}; \
              o_ = __builtin_amdgcn_mfma_f32_32x32x16_bf16(pa0, vf_[0], o_, 0, 0, 0); o_ = __builtin_amdgcn_mfma_f32_32x32x16_bf16(pa1, vf_[1], o_, 0, 0, 0); \
              if (ri == 1) { o_ = __builtin_amdgcn_mfma_f32_32x32x16_bf16(pa2, vf_[2], o_, 0, 0, 0); o_ = __builtin_amdgcn_mfma_f32_32x32x16_bf16(pa3, vf_[3], o_, 0, 0, 0); } \
              o_ = __builtin_amdgcn_mfma_f32_32x32x16_bf16(qf[0], sf_[0], o_, 0, 0, 0); o_ = __builtin_amdgcn_mfma_f32_32x32x16_bf16(qf[1], sf_[1], o_, 0, 0, 0); \
              o_ = __builtin_amdgcn_mfma_f32_32x32x16_bf16(qf[2], sf_[2], o_, 0, 0, 0); o_ = __builtin_amdgcn_mfma_f32_32x32x16_bf16(qf[3], sf_[3], o_, 0, 0, 0); \
              bf16* dst_ = dir == 0 ? OF : OB; \
              _Pragma("unroll") for (int r = 0; r < 16; ++r) { const int i_ = 32 * ri + crow(r, hi); const int t_ = dir == 0 ? 64 * s + i_ : L - 1 - (64 * s + i_); \
                  dst_[(size_t)(row0 + t_) * D + hh * 128 + 64 * dh + 32 * (d) + r32] = (bf16)f2bf(o_[r]); } SBAR(); } while (0)
            SC_OBLK(0); SC_OBLK(1);
            __syncthreads();
            if (s + 1 < NC) SC_LOAD(s + 1);
            { const unsigned kt = gaddr + SC_KI + v_rd_base(lane) + ri * 512;
              bf16x8 kf[4];
              { const s16x4 l0_ = tr_read<0>(kt), h0_ = tr_read<1024>(kt), l1_ = tr_read<2048>(kt), h1_ = tr_read<2048 + 1024>(kt), l2_ = tr_read<4096>(kt), h2_ = tr_read<4096 + 1024>(kt), l3_ = tr_read<6144>(kt), h3_ = tr_read<6144 + 1024>(kt);
                asm volatile("s_waitcnt lgkmcnt(0)" ::: "memory"); SBAR();
                kf[0] = PKF(l0_, h0_); kf[1] = PKF(l1_, h1_); kf[2] = PKF(l2_, h2_); kf[3] = PKF(l3_, h3_); }
              const float dlu = gla ? 0.f : __expf(64.0f * lgr);
              const int stb_ = (hi + 4 * ri) * 2048 + (2 * dh) * 512 + r32 * 2;
#define SC_SBLK(d) do { bf16x8 vf_[4]; SC_FR4(vf_, vb, d); \
              _Pragma("unroll") for (int ks = 0; ks < 4; ++ks) sacc[d] = __builtin_amdgcn_mfma_f32_32x32x16_bf16(kf[ks], vf_[ks], sacc[d], 0, 0, 0); \
              _Pragma("unroll") for (int r = 0; r < 16; ++r) { const int dk = 32 * ri + crow(r, hi); const float dl = gla ? ((LAS float*)(G + SC_DL))[dk] : dlu; \
                  sacc[d][r] *= dl; *(LAS unsigned short*)(G + SC_ST + stb_ + (d) * 512 + ((r >> 3) & 1) * 4096 + ((r & 3) + 4 * ((r >> 2) & 1)) * 64) = (unsigned short)f2bf(sacc[d][r]); } SBAR(); } while (0)
              SC_SBLK(0); SC_SBLK(1); }
        }
        if (!lat) { float* SO = POUT + (gla ? OUT_SGLA : OUT_SRET) + ((size_t)((sb * 2 + li) * 2 + dir) * 4 + h) * 8192;
#pragma unroll
            for (int d = 0; d < 2; ++d)
#pragma unroll
                for (int r = 0; r < 16; ++r) SO[(32 * ri + crow(r, hi)) * 128 + 32 * (2 * dh + d) + r32] = sacc[d][r]; }
        VM_WAIT(); __syncthreads();
        { const int gcol = (gla ? PC_GA : PC_GB) + h * 128, dv = (lane & 15) * 8;
          f32x4 gn0 = (f32x4){1.f, 1.f, 1.f, 1.f}, gn1 = gn0;
          if (gla) { const float* gp_ = PIN(I_GLAN); gn0 = *(const f32x4*)(gp_ + li * 128 + dv); gn1 = *(const f32x4*)(gp_ + li * 128 + dv + 4); }
          for (int t = F.wave * 4 + (lane >> 4); t < L; t += 32) {
              const size_t off = (size_t)(row0 + t) * D + hh * 128 + dv;
              const v4u a = *(const v4u*)(OF + off), b = *(const v4u*)(OB + off), g = *(const v4u*)(PROJ + (size_t)(row0 + t) * EVEN_NP + gcol + dv);
              float x[8], gg[8];
              x[0] = bflo(a.x) + bflo(b.x); x[1] = bfhi(a.x) + bfhi(b.x); x[2] = bflo(a.y) + bflo(b.y); x[3] = bfhi(a.y) + bfhi(b.y);
              x[4] = bflo(a.z) + bflo(b.z); x[5] = bfhi(a.z) + bfhi(b.z); x[6] = bflo(a.w) + bflo(b.w); x[7] = bfhi(a.w) + bfhi(b.w);
              gg[0] = bflo(g.x); gg[1] = bfhi(g.x); gg[2] = bflo(g.y); gg[3] = bfhi(g.y); gg[4] = bflo(g.z); gg[5] = bfhi(g.z); gg[6] = bflo(g.w); gg[7] = bfhi(g.w);
              float ss = 0.f;
#pragma unroll
              for (int e = 0; e < 8; ++e) ss += x[e] * x[e];
              ss += __shfl_xor(ss, 1); ss += __shfl_xor(ss, 2); ss += __shfl_xor(ss, 4); ss += __shfl_xor(ss, 8);
              const float rstd = 1.0f / sqrtf(ss * (1.0f / 128.0f) + EPS);
#pragma unroll
              for (int e = 0; e < 8; ++e) x[e] = x[e] * rstd * (e < 4 ? gn0[e] : gn1[e - 4]) * siluf(gg[e]);
              *(v4u*)(OB + off) = (v4u){pk2(x[0], x[1]), pk2(x[2], x[3]), pk2(x[4], x[5]), pk2(x[6], x[7])};
          } }
    }
#undef SC_TOK
#undef SC_LOAD
#undef UNPK
#undef SC_FR4
#undef SC_OBLK
#undef SC_SBLK
}

__device__ __forceinline__ void kpe_pass(Frame& F, const Params& P, int li) {
    unsigned char* ws = PWS;
    const float* KR = (const float*)(ws + WS_Y); const float* ROPE = (const float*)(ws + WS_ROPE);
    bf16* KPE = (bf16*)(ws + WS_KPE) + (size_t)li * MKV * 64;
    const int gt = F.vcu * 512 + F.tid, NGT = F.G * 512;
    for (int i = gt; i < M * 4; i += NGT) {
        const int row = i >> 2, c8 = i & 3;
        const float* s = KR + (size_t)row * 64 + 8 * c8;
        f32x4 a0 = *(const f32x4*)s, a1 = *(const f32x4*)(s + 4), b0 = *(const f32x4*)(s + 32), b1 = *(const f32x4*)(s + 36);
        int drow = row;
        if (row >= M_CTX) { const int lb = (row - M_CTX) >> 11, t = (row - M_CTX) & 2047; drow = M_CTX + lb * LKV + PAST + t;
            const float* cp = ROPE + (size_t)t * 32 + 8 * c8; const float* sp = cp + 65536;
            const f32x4 c0 = *(const f32x4*)cp, c1 = *(const f32x4*)(cp + 4), s0 = *(const f32x4*)sp, s1 = *(const f32x4*)(sp + 4);
            const f32x4 x0 = a0 * c0 - b0 * s0, x1 = a1 * c1 - b1 * s1, y0 = a0 * s0 + b0 * c0, y1 = a1 * s1 + b1 * c1;
            a0 = x0; a1 = x1; b0 = y0; b1 = y1; }
        bf16* d = KPE + (size_t)drow * 64 + 8 * c8;
        *(v4u*)d = (v4u){pk2(a0[0], a0[1]), pk2(a0[2], a0[3]), pk2(a1[0], a1[1]), pk2(a1[2], a1[3])};
        *(v4u*)(d + 32) = (v4u){pk2(b0[0], b0[1]), pk2(b0[2], b0[3]), pk2(b1[0], b1[1]), pk2(b1[2], b1[3])};
    }
}

constexpr float ATT_SCALE = 0.07216878364870322f;
constexpr float ATT_THR = 8.f;
constexpr int AT_V = 0, AT_KN = 32768, AT_KP = 65536, AT_WS = 81920, AT_VB = 16384, AT_KNB = 16384, AT_KPB = 8192;
#define KSWZ(row, colB) ((row) * 256 + ((colB) ^ (((row) & 7) << 4)))
#define KPSWZ(row, colB) ((row) * 128 + ((colB) ^ (((row) & 7) << 4)))
__device__ __forceinline__ void at_partialSM(f32x16& p0, f32x16& p1, float& m_reg, float& mn, float& alpha) {
    constexpr float C = ATT_SCALE * 1.4426950408889634f;
    float pmax = p0[0];
#pragma unroll
    for (int r = 1; r < 16; ++r) pmax = fmaxf(pmax, p0[r]);
#pragma unroll
    for (int r = 0; r < 16; ++r) pmax = fmaxf(pmax, p1[r]);
    { auto rr = __builtin_amdgcn_permlane32_swap(__float_as_uint(pmax), __float_as_uint(pmax), false, false); pmax = fmaxf(__uint_as_float(rr[0]), __uint_as_float(rr[1])); }
    if (__builtin_expect(__all(pmax - m_reg <= ATT_THR / ATT_SCALE), 1)) { mn = m_reg; alpha = 1.f; }
    else { mn = fmaxf(m_reg, pmax); alpha = __builtin_amdgcn_exp2f((m_reg - mn) * C); m_reg = mn; }
    const float mnC = -mn * C;
#pragma unroll
    for (int r = 0; r < 16; ++r) p0[r] = fmaf(p0[r], C, mnC);
#pragma unroll
    for (int r = 0; r < 16; ++r) p1[r] = fmaf(p1[r], C, mnC);
#pragma unroll
    for (int r = 0; r < 16; ++r) p0[r] = __builtin_amdgcn_exp2f(p0[r]);
}
__device__ __forceinline__ void at_finishSM(f32x16& p0, f32x16& p1, float alpha, float& l_reg, bf16x8& pa0, bf16x8& pa1, bf16x8& pa2, bf16x8& pa3) {
#pragma unroll
    for (int r = 0; r < 16; ++r) p1[r] = __builtin_amdgcn_exp2f(p1[r]);
    float ps = 0;
#pragma unroll
    for (int r = 0; r < 16; ++r) ps += p0[r];
#pragma unroll
    for (int r = 0; r < 16; ++r) ps += p1[r];
    { auto rr = __builtin_amdgcn_permlane32_swap(__float_as_uint(ps), __float_as_uint(ps), false, false); ps = __uint_as_float(rr[0]) + __uint_as_float(rr[1]); }
    l_reg = l_reg * alpha + ps;
    PK4(p0, 0, pa0); PK4(p0, 8, pa1); PK4(p1, 0, pa2); PK4(p1, 8, pa3);
}
__device__ __forceinline__ void at_qkt(f32x16& p0, f32x16& p1, const LAS unsigned char* Kn, const LAS unsigned char* Kp, const bf16x8* qr, const int* kb, const int* pb) {
    p0 = f32x16{}; p1 = f32x16{};
#pragma unroll
    for (int d0 = 0; d0 < 8; ++d0) {
        const bf16x8 b0 = *(const LAS bf16x8*)(Kn + kb[d0 & 3] + 128 * (d0 >> 2)), b1 = *(const LAS bf16x8*)(Kn + kb[d0 & 3] + 128 * (d0 >> 2) + 8192);
        p0 = __builtin_amdgcn_mfma_f32_32x32x16_bf16(b0, qr[d0], p0, 0, 0, 0);
        p1 = __builtin_amdgcn_mfma_f32_32x32x16_bf16(b1, qr[d0], p1, 0, 0, 0); }
#pragma unroll
    for (int d0 = 0; d0 < 4; ++d0) {
        const bf16x8 b0 = *(const LAS bf16x8*)(Kp + pb[d0]), b1 = *(const LAS bf16x8*)(Kp + pb[d0] + 4096);
        p0 = __builtin_amdgcn_mfma_f32_32x32x16_bf16(b0, qr[8 + d0], p0, 0, 0, 0);
        p1 = __builtin_amdgcn_mfma_f32_32x32x16_bf16(b1, qr[8 + d0], p1, 0, 0, 0); }
}
template <int D0> __device__ __forceinline__ void at_pv_one(f32x16& od, unsigned vb, bf16x8 pa0, bf16x8 pa1, bf16x8 pa2, bf16x8 pa3) {
    const s16x4 l0 = tr_read<D0 * 512>(vb), h0 = tr_read<D0 * 512 + 2048>(vb), l1 = tr_read<D0 * 512 + 4096>(vb), h1 = tr_read<D0 * 512 + 4096 + 2048>(vb);
    const s16x4 l2 = tr_read<D0 * 512 + 8192>(vb), h2 = tr_read<D0 * 512 + 8192 + 2048>(vb), l3 = tr_read<D0 * 512 + 12288>(vb), h3 = tr_read<D0 * 512 + 12288 + 2048>(vb);
    asm volatile("s_waitcnt lgkmcnt(0)" ::: "memory"); SBAR();
    od = __builtin_amdgcn_mfma_f32_32x32x16_bf16(pa0, PKF(l0, h0), od, 0, 0, 0);
    od = __builtin_amdgcn_mfma_f32_32x32x16_bf16(pa1, PKF(l1, h1), od, 0, 0, 0);
    od = __builtin_amdgcn_mfma_f32_32x32x16_bf16(pa2, PKF(l2, h2), od, 0, 0, 0);
    od = __builtin_amdgcn_mfma_f32_32x32x16_bf16(pa3, PKF(l3, h3), od, 0, 0, 0);
}
__device__ __forceinline__ void at_pv(f32x16* o, unsigned vb, bf16x8 pa0, bf16x8 pa1, bf16x8 pa2, bf16x8 pa3) {
    at_pv_one<0>(o[0], vb, pa0, pa1, pa2, pa3); at_pv_one<1>(o[1], vb, pa0, pa1, pa2, pa3); at_pv_one<2>(o[2], vb, pa0, pa1, pa2, pa3); at_pv_one<3>(o[3], vb, pa0, pa1, pa2, pa3);
}
__device__ __forceinline__ void attn_unit(Frame& F, const bf16* Qrow0  , const bf16* KVh  , const bf16* KPEs  ,
                                          bf16* Orow0, int nkeys, const float* ROPE, int tpos0  ) {
    LAS unsigned char* lds = F.lds;
    const int tid = F.tid, wid = F.wave, lane = F.lane, r32 = lane & 31, hi = lane >> 5;
    LAS float* wsf = (LAS float*)(lds + AT_WS) + wid * 64; LAS float* li_l = wsf; LAS float* al_l = wsf + 32;
    float m_reg = -1e30f, l_reg = 0; f32x16 o[4] = {}; bf16x8 qr[12];
    { const bf16* Qw = Qrow0 + (size_t)(wid * 32 + r32) * 1536 + hi * 8;
#pragma unroll
      for (int d0 = 0; d0 < 12; ++d0) qr[d0] = *(const bf16x8*)(Qw + d0 * 16);
      if (tpos0 >= 0) {
          const int t = tpos0 + wid * 32 + r32;
#pragma unroll
          for (int half = 0; half < 2; ++half) {
              const float* cp = ROPE + (size_t)t * 32 + 16 * half + 8 * hi; const float* sp = cp + 65536;
              const v4u xa = __builtin_bit_cast(v4u, qr[8 + half]), xb = __builtin_bit_cast(v4u, qr[10 + half]);
              float x1[8], x2[8];
              x1[0] = bflo(xa.x); x1[1] = bfhi(xa.x); x1[2] = bflo(xa.y); x1[3] = bfhi(xa.y); x1[4] = bflo(xa.z); x1[5] = bfhi(xa.z); x1[6] = bflo(xa.w); x1[7] = bfhi(xa.w);
              x2[0] = bflo(xb.x); x2[1] = bfhi(xb.x); x2[2] = bflo(xb.y); x2[3] = bfhi(xb.y); x2[4] = bflo(xb.z); x2[5] = bfhi(xb.z); x2[6] = bflo(xb.w); x2[7] = bfhi(xb.w);
              float y1[8], y2[8];
#pragma unroll
              for (int j = 0; j < 8; ++j) { const float c = cp[j], s = sp[j]; y1[j] = x1[j] * c - x2[j] * s; y2[j] = x1[j] * s + x2[j] * c; }
              const v4u wa = {pk2(y1[0], y1[1]), pk2(y1[2], y1[3]), pk2(y1[4], y1[5]), pk2(y1[6], y1[7])}, wb = {pk2(y2[0], y2[1]), pk2(y2[2], y2[3]), pk2(y2[4], y2[5]), pk2(y2[6], y2[7])};
              if (half == 0) { qr[8] = __builtin_bit_cast(bf16x8, wa); qr[10] = __builtin_bit_cast(bf16x8, wb); } else { qr[9] = __builtin_bit_cast(bf16x8, wa); qr[11] = __builtin_bit_cast(bf16x8, wb); }
          }
      } }
    const unsigned vb0 = (unsigned)(uintptr_t)(lds + AT_V) + v_rd_base(lane);
#define AT_OPQ() int l_ = lane; asm volatile("" : "+v"(l_))
#define AT_KADDR() int kbs[4], pbs[4]; { AT_OPQ(); _Pragma("unroll") for (int b = 0; b < 4; ++b) { const int x = (32 * b + 16 * (l_ >> 5)) ^ ((l_ & 7) << 4); kbs[b] = (l_ & 31) * 256 + x; pbs[b] = (l_ & 31) * 128 + x; } }
#define AT_GLDS(gp, ldsoff) __builtin_amdgcn_global_load_lds((const unsigned*)(gp), (LAS unsigned*)(lds + (ldsoff)), 16, 0, 0)
#define AT_DMA_K(t, b) do { AT_OPQ(); const char* kb_ = (const char*)KVh + (size_t)(t) * (64 * 4096); const char* pb_ = (const char*)KPEs + (size_t)(t) * (64 * 128); \
    const int row0_ = 4 * wid + (l_ >> 4), cB0_ = ((l_ & 15) * 16) ^ ((row0_ & 7) << 4), row1_ = row0_ + 32, rowp_ = 8 * wid + (l_ >> 3), cBp_ = ((l_ & 7) * 16) ^ ((rowp_ & 7) << 4); \
    AT_GLDS(kb_ + (unsigned)(row0_ * 4096 + cB0_), AT_KN + (b) * AT_KNB + wid * 1024); AT_GLDS(kb_ + (unsigned)(row1_ * 4096 + cB0_), AT_KN + (b) * AT_KNB + (wid + 8) * 1024); \
    AT_GLDS(pb_ + (unsigned)(rowp_ * 128 + cBp_), AT_KP + (b) * AT_KPB + wid * 1024); } while (0)
#define AT_DMA_V(t, b) do { AT_OPQ(); const char* vb_ = (const char*)KVh + (size_t)(t) * (64 * 4096); \
    const int st_ = 2 * wid + (l_ >> 5), kk_ = (st_ >> 2) * 8 + ((l_ & 31) >> 2), key_ = (kk_ & ~0xC) | ((kk_ & 4) << 1) | ((kk_ & 8) >> 1), col_ = (st_ & 3) * 32 + (l_ & 3) * 8; \
    AT_GLDS(vb_ + (unsigned)(key_ * 4096 + (128 + col_) * 2), AT_V + (b) * AT_VB + wid * 1024); AT_GLDS(vb_ + (unsigned)((key_ + 32) * 4096 + (128 + col_) * 2), AT_V + (b) * AT_VB + (wid + 8) * 1024); } while (0)
#define AT_RESC(a) do { if (__any((a) < 1.f)) { if (hi == 0) al_l[r32] = (a); asm volatile("s_waitcnt lgkmcnt(0)" ::: "memory"); \
    _Pragma("unroll") for (int d = 0; d < 4; ++d) _Pragma("unroll") for (int r = 0; r < 16; ++r) o[d][r] *= al_l[crow(r, hi)]; } } while (0)
#define AT_SYNC() do { VM_WAIT(); __syncthreads(); } while (0)
    f32x16 pA0, pA1, pB0, pB1; float mnA, mnB, alA, alB; bf16x8 pa0, pa1, pa2, pa3; const int NT = nkeys / 64;
    const LAS unsigned char* Kn0 = lds + AT_KN; const LAS unsigned char* Kn1 = lds + AT_KN + AT_KNB; const LAS unsigned char* Kp0 = lds + AT_KP; const LAS unsigned char* Kp1 = lds + AT_KP + AT_KPB;
    AT_DMA_K(0, 0); AT_SYNC();
    AT_DMA_K(1, 1); AT_DMA_V(0, 0);
    { AT_KADDR(); at_qkt(pA0, pA1, Kn0, Kp0, qr, kbs, pbs); } at_partialSM(pA0, pA1, m_reg, mnA, alA);
    AT_SYNC();
    for (int j = 1; j + 1 < NT; j += 2) {
        AT_DMA_K(j + 1, 0); AT_DMA_V(j, 1);
        SBAR(); { AT_KADDR(); at_qkt(pB0, pB1, Kn1, Kp1, qr, kbs, pbs); }
        at_finishSM(pA0, pA1, alA, l_reg, pa0, pa1, pa2, pa3); SBAR();
        at_pv(o, vb0, pa0, pa1, pa2, pa3); at_partialSM(pB0, pB1, m_reg, mnB, alB);
        AT_RESC(alB); AT_SYNC();
        AT_DMA_K(j + 2, 1); AT_DMA_V(j + 1, 0);
        SBAR(); { AT_KADDR(); at_qkt(pA0, pA1, Kn0, Kp0, qr, kbs, pbs); }
        at_finishSM(pB0, pB1, alB, l_reg, pa0, pa1, pa2, pa3); SBAR();
        at_pv(o, vb0 + AT_VB, pa0, pa1, pa2, pa3); at_partialSM(pA0, pA1, m_reg, mnA, alA);
        AT_RESC(alA); AT_SYNC();
    }
    AT_DMA_V(NT - 1, 1);
    SBAR(); { AT_KADDR(); at_qkt(pB0, pB1, Kn1, Kp1, qr, kbs, pbs); }
    at_finishSM(pA0, pA1, alA, l_reg, pa0, pa1, pa2, pa3); SBAR();
    at_pv(o, vb0, pa0, pa1, pa2, pa3); at_partialSM(pB0, pB1, m_reg, mnB, alB);
    AT_RESC(alB); AT_SYNC();
    at_finishSM(pB0, pB1, alB, l_reg, pa0, pa1, pa2, pa3); SBAR();
    at_pv(o, vb0 + AT_VB, pa0, pa1, pa2, pa3);
    if (hi == 0) li_l[r32] = l_reg; asm volatile("s_waitcnt lgkmcnt(0)" ::: "memory");
    float rli[16];
#pragma unroll
    for (int r = 0; r < 16; ++r) rli[r] = __builtin_amdgcn_rcpf(li_l[crow(r, hi)]);
    bf16* Ow = Orow0 + (size_t)(wid * 32) * D;
#pragma unroll
    for (int r = 0; r < 16; ++r) { const int orow = crow(r, hi);
#pragma unroll
        for (int d0 = 0; d0 < 4; ++d0) Ow[(size_t)orow * D + d0 * 32 + r32] = (bf16)f2bf(o[d0][r] * rli[r]); }
#undef AT_GLDS
#undef AT_OPQ
#undef AT_KADDR
#undef AT_DMA_K
#undef AT_DMA_V
#undef AT_RESC
#undef AT_SYNC
}
__device__ __forceinline__ void attn_phase(Frame& F, const Params& P, int li) {
    unsigned char* ws = PWS;
    const bf16* Q = (const bf16*)(ws + WS_Q); const bf16* KV = (const bf16*)(ws + WS_KV); const bf16* KPE = (const bf16*)(ws + WS_KPE) + (size_t)li * MKV * 64;
    bf16* OB = (bf16*)(ws + WS_HB); const float* ROPE = (const float*)(ws + WS_ROPE);
    for (int u = F.vcu; u < 256 + 128; u += F.G) {
        for (int k = 0; k < 2; ++k) {
            int qrow0, kvrow0, nkeys, h, tpos0;
            if (u < 256) { const int id = 2 * u + k, lb = id >> 6, qb = id & 7; h = (id >> 3) & 7; qrow0 = M_CTX + lb * L_LAT + qb * 256; kvrow0 = M_CTX + lb * LKV; nkeys = LKV; tpos0 = qb * 256; }
            else { if (k == 1) break; const int id = u - 256, b = id >> 3; h = id & 7; qrow0 = b * L_CTX; kvrow0 = b * L_CTX; nkeys = L_CTX; tpos0 = -1; }
            __syncthreads();
            attn_unit(F, Q + (size_t)qrow0 * 1536 + h * 192, KV + (size_t)kvrow0 * 2048 + h * 256, KPE + (size_t)kvrow0 * 64, OB + (size_t)qrow0 * D + h * 128, nkeys, ROPE, tpos0);
        }
    }
}

constexpr int N_PHASES = 2 + 2 * 15;
__global__ void __launch_bounds__(NWAVES * 64, 2) hyb_fwd(Params P) {
    extern __shared__ __attribute__((aligned(16))) unsigned char lds_raw[];
    Frame F;
    F.lds = (LAS unsigned char*)lds_raw;
    F.tid = threadIdx.x; F.lane = F.tid & 63; F.wave = __builtin_amdgcn_readfirstlane(F.tid >> 6);
    F.G = gridDim.x; { const int bx = blockIdx.x; F.vcu = (F.G % 8 == 0) ? (bx % 8) * (F.G / 8) + bx / 8 : bx; }
    volatile LAS unsigned* MISC = (volatile LAS unsigned*)(F.lds + LDS_MISC);
    if (F.tid < 64) MISC[F.tid] = 0u;
    if (F.tid < 30) { const unsigned long long v = F.tid < 28 ? (unsigned long long)P.in[F.tid] : (F.tid == 28 ? (unsigned long long)P.out : (unsigned long long)P.ws);
        volatile LAS unsigned* pt = (volatile LAS unsigned*)(F.lds + LDS_PT) + 2 * F.tid; pt[0] = (unsigned)v; pt[1] = (unsigned)(v >> 32); }
    __syncthreads();
    const int use_bar = P.use_bar, ph_hi = P.ph_hi;
    XcdBarrier bar; bar.bar = (unsigned*)(PWS + WS_CTL) + 4096; bar.x = 0; bar.st = nullptr;
    if (use_bar) bar = xcd_barrier_post((unsigned*)(PWS + WS_CTL) + 4096, MISC + 8);

    for (int ph = P.ph_lo; ph < ph_hi; ++ph) {
#define REFRESH_ID() do { int t_ = threadIdx.x; asm volatile("" : "+v"(t_)); F.tid = t_; F.lane = t_ & 63; F.wave = __builtin_amdgcn_readfirstlane(t_ >> 6); \
          int g_ = gridDim.x, b_ = blockIdx.x; asm volatile("" : "+s"(g_), "+s"(b_)); F.G = g_; F.vcu = (g_ % 8 == 0) ? (b_ % 8) * (g_ / 8) + b_ / 8 : b_; F.bid = b_; } while (0)
        REFRESH_ID();
        unsigned char* ws = PWS;
        float* XO = POUT + OUT_Y;
        bf16* HB = (bf16*)(ws + WS_HB); bf16* YB = (bf16*)(ws + WS_Y); float* SS = (float*)(ws + WS_SS);
        const float* MOD = (const float*)(ws + WS_MOD);
        if (ph == 0) { p0_prologue(F, P); }
        else if (ph == 1) {
            const float* m0 = MOD;
            row_pass(F, PIN(I_XP), PIN(I_XS), nullptr, nullptr, nullptr, nullptr, nullptr, PIN(I_NMIXPRE), m0 + 1024, m0, HB, false, true);
        } else {
            const int q = ph - 2, pair = q / 15, r = q % 15; const bool odd = r >= 7; const int l = 2 * pair + (odd ? 1 : 0), k = odd ? r - 7 : r;
            const float* ml = MOD + (size_t)l * 9 * 6144;
            const int kind = odd ? (k == 0 ? 10 : k == 1 ? 11 : k == 2 ? 12 : k - 1) : k;
            if (kind == 0) {
                pg8::Gemm g{HB, (const bf16*)(ws + WS_WINE) + (size_t)pair * EVEN_NP * 1024, M, EVEN_NP, 1024}; pg8::StaticOrder S; S.init(M, EVEN_NP, F.G, F.bid);
                pg8::EpiBf16<0> E{(bf16*)(ws + WS_BIG), EVEN_NP};
                pg8::gemm_phase<pg8::EpiBf16<0>, pg8::StaticOrder, true, true>(F.lds, g, S, E, F.tid);
            } else if (kind == 1) {
                scan_phase(F, P, pair);
            } else if (kind == 2) {
                const bf16* W = odd ? (const bf16*)(ws + WS_WOUTO) + (size_t)pair * 1024 * 1024 : (const bf16*)(ws + WS_WOUTE) + (size_t)pair * 1024 * 1024;
                pg8::Gemm g{HB, W, M, 1024, 1024}; pg8::StaticOrder S; S.init(M, 1024, F.G, F.bid);
                pg8::EpiYss E{YB, SS};
                pg8::gemm_phase<pg8::EpiYss, pg8::StaticOrder, true, true>(F.lds, g, S, E, F.tid);
            } else if (kind == 3) {
                const float* xa = l == 0 ? PIN(I_XP) : XO; const float* xb = l == 0 ? PIN(I_XS) : XO + (size_t)M_CTX * D;
                row_pass(F, xa, xb, XO, YB, SS, PIN(I_NMIXPOST) + l * 1024, ml + 2048, PIN(I_NMLPPRE) + l * 1024, ml + 4096, ml + 3072, HB, true, true);
            } else if (kind == 4) {
                pg8::Gemm g{HB, (const bf16*)(ws + WS_W1) + (size_t)l * 4096 * 1024, M, FF, 1024}; pg8::StaticOrder S; S.init(M, FF, F.G, F.bid);
                pg8::EpiBf16<1> E{(bf16*)(ws + WS_BIG), FF};
                pg8::gemm_phase<pg8::EpiBf16<1>, pg8::StaticOrder, true, true>(F.lds, g, S, E, F.tid);
            } else if (kind == 5) {
                pg8::Gemm g{(const bf16*)(ws + WS_BIG), (const bf16*)(ws + WS_W2) + (size_t)l * 1024 * 4096, M, 1024, FF}; pg8::StaticOrder S; S.init(M, 1024, F.G, F.bid);
                pg8::EpiYss E{YB, SS};
                pg8::gemm_phase<pg8::EpiYss, pg8::StaticOrder, true, true>(F.lds, g, S, E, F.tid);
            } else if (kind == 6) {
                const bool last = l == 3; const float* mn = ml + 9 * 6144; const int ln = last ? 3 : l + 1;
                row_pass(F, XO, XO + (size_t)M_CTX * D, XO, YB, SS, PIN(I_NMLPPOST) + l * 1024, ml + 5120, PIN(I_NMIXPRE) + ln * 1024, mn + 1024, mn, HB, true, !last);
            } else if (kind == 10) {
                pg8::Gemm g{HB, (const bf16*)(ws + WS_WINO) + (size_t)pair * ODD_NP * 1024, M, ODD_NP, 1024}; pg8::StaticOrder S; S.init(M, ODD_NP, F.G, F.bid);
                pg8::EpiOddIn E{(bf16*)(ws + WS_QN), (bf16*)(ws + WS_ACKV) + (size_t)pair * MKV * 256, (float*)(ws + WS_Y), POUT + OUT_CKV, POUT + OUT_KPE,
                                PIN(I_QAN) + pair * 256, PIN(I_KVAN) + pair * 256, pair};
                pg8::gemm_phase<pg8::EpiOddIn, pg8::StaticOrder, false, true>(F.lds, g, S, E, F.tid);
            } else if (kind == 11) {
                kpe_pass(F, P, pair); REFRESH_ID();
                { pg8::Gemm g{(const bf16*)(ws + WS_QN), (const bf16*)(ws + WS_WQB) + (size_t)pair * 1536 * 256, M, 1536, 256}; pg8::StaticOrder S; S.init(M, 1536, F.G, F.bid);
                  pg8::EpiBf16<0> E{(bf16*)(ws + WS_Q), 1536};
                  pg8::gemm_phase<pg8::EpiBf16<0>, pg8::StaticOrder, true, true>(F.lds, g, S, E, F.tid); }
                REFRESH_ID();
                { pg8::Gemm g{(const bf16*)(ws + WS_ACKV) + (size_t)pair * MKV * 256, (const bf16*)(ws + WS_WKVB) + (size_t)pair * 2048 * 256, MKV, 2048, 256}; pg8::StaticOrder S; S.init(MKV, 2048, F.G, F.bid);
                  pg8::EpiBf16<0> E{(bf16*)(ws + WS_KV), 2048};
                  pg8::gemm_phase<pg8::EpiBf16<0>, pg8::StaticOrder, true, true>(F.lds, g, S, E, F.tid); }
            } else if (kind == 12) {
                attn_phase(F, P, pair);
            }
        }
        if (ph + 1 < ph_hi) { if (use_bar) { bar.bar = (unsigned*)(PWS + WS_CTL) + 4096; xcd_barrier(bar); } else { VM_WAIT(); __syncthreads(); } }
    }
}

#ifndef HYB_N_LAUNCHES
#define HYB_N_LAUNCHES 1
#endif
extern "C" void kernel_launch(void* const* d_in, const int* in_sizes, int n_in, void* d_out, int out_size, void* d_ws, size_t ws_size, hipStream_t stream) {
    static int grid = 0;
    if (grid == 0) {
        if (n_in != 28 || out_size != 27787264 || ws_size < WS_END) { fprintf(stderr, "kernel_launch: unexpected shapes: n_in %d out %d ws %zu (need >= %zu)\n", n_in, out_size, ws_size, (size_t)WS_END); grid = -1; return; }
        int dev = 0, cus = 0, per_cu = 0;
        if (hipGetDevice(&dev) != hipSuccess || hipDeviceGetAttribute(&cus, hipDeviceAttributeMultiprocessorCount, dev) != hipSuccess) { grid = -1; return; }
        if (hipFuncSetAttribute((const void*)hyb_fwd, hipFuncAttributeMaxDynamicSharedMemorySize, LDS_BYTES) != hipSuccess) { fprintf(stderr, "kernel_launch: hipFuncSetAttribute failed\n"); grid = -1; return; }
        if (hipOccupancyMaxActiveBlocksPerMultiprocessor(&per_cu, (const void*)hyb_fwd, NWAVES * 64, LDS_BYTES) != hipSuccess || per_cu < 1) { fprintf(stderr, "kernel_launch: occupancy query reports %d\n", per_cu); }
        (void)hipGetLastError();
        grid = cus;
    }
    if (grid < 0) return;
    (void)hipMemsetAsync((char*)d_ws + WS_CTL, 0, CTL_ZERO_BYTES, stream);
    Params a{};
    for (int i = 0; i < 28; ++i) a.in[i] = (const float*)d_in[i];
    a.out = (float*)d_out; a.ws = (unsigned char*)d_ws;
#if HYB_N_LAUNCHES == 1
    a.ph_lo = 0; a.ph_hi = N_PHASES; a.use_bar = 1; a.pad = 0;
    hipLaunchKernelGGL(hyb_fwd, dim3(grid), dim3(NWAVES * 64), LDS_BYTES, stream, a);
#else
    for (int ph = 0; ph < N_PHASES; ++ph) { a.ph_lo = ph; a.ph_hi = ph + 1; a.use_bar = 0; a.pad = 0;
        hipLaunchKernelGGL(hyb_fwd, dim3(grid), dim3(NWAVES * 64), LDS_BYTES, stream, a); }
#endif
    const hipError_t le = hipPeekAtLastError();
    if (le != hipSuccess) fprintf(stderr, "kernel_launch: launch failed: %s\n", hipGetErrorName(le));
}
```

```cpp
#include <hip/hip_runtime.h>
#include <hip/hip_bf16.h>
#include <cstdio>
#include <cstdint>
namespace pg8 {
#define PG8_LAS __attribute__((address_space(3)))
typedef unsigned short bf16_t;
typedef short bf16x8 __attribute__((ext_vector_type(8)));
typedef float f32x4 __attribute__((ext_vector_type(4)));
typedef unsigned u32x4 __attribute__((ext_vector_type(4)));
constexpr int BM = 256, BK = 64, HALF = 128, HTB = HALF * BK * 2  , STAGE_BYTES = 8 * HTB, NXCD = 8, WGM = 8;

__host__ __device__ __forceinline__ int lds_byte(int r, int c) { const int st = (r >> 4) * 2 + (c >> 5), rr = r & 15, cc = c & 31, ob = rr * 64 + cc * 2; return st * 1024 + (ob ^ (((ob >> 9) & 1) << 5)); }
__host__ __device__ __forceinline__ void stage_rc(int b, int& R, int& C) { const int st = b / 1024, sb = b % 1024, swz = sb ^ (((sb >> 9) & 1) << 5); R = (st >> 1) * 16 + swz / 64; C = (st & 1) * 32 + (swz % 64) / 2; }
__host__ __device__ __forceinline__ int perm32(int rho) { const int n = rho >> 4, i = rho & 15; return 8 * (i >> 2) + 4 * n + (i & 3); }

struct Unit { int pm, pn; };
struct Gemm { const bf16_t* A; const bf16_t* Bt; int M, N, K; };

struct StaticOrder {
    int nM, nN, nwg, G, c;
    __host__ __device__ void init(int M, int N, int G_, int c_) { nM = M / BM; nN = N / BM; nwg = nM * nN; G = G_; c = c_; }
    __host__ __device__ bool next(int i, Unit& u) const {
        const long L = (long)i * G + c; if (L >= nwg) return false;
        int wgid = (int)L; { const int q = nwg / NXCD, r = nwg % NXCD, xcd = wgid % NXCD, off = wgid / NXCD; wgid = (xcd < r ? xcd * (q + 1) : r * (q + 1) + (xcd - r) * q) + off; }
        const int nig = WGM * nN, gid = wgid / nig, fm = gid * WGM, gsz = (nM - fm) < WGM ? (nM - fm) : WGM;
        u.pm = fm + ((wgid % nig) % gsz); u.pn = (wgid % nig) / gsz; return true;
    }
    __device__ __forceinline__ void a_ready(const Unit&) const {}
    __device__ __forceinline__ void done(const Unit&) const {}
};


__device__ __forceinline__ unsigned cvt_pk_bf16(float lo, float hi) { unsigned r; asm volatile("v_cvt_pk_bf16_f32 %0, %1, %2" : "=v"(r) : "v"(lo), "v"(hi)); return r; }

template <int ACT> struct EpiBf16 {
    static constexpr bool PERM = true, AFTER_DRAIN = false;
    bf16_t* O; int ldc;
    __device__ __forceinline__ void operator()(const f32x4 (&acc)[2][2][4][2], const Unit& u, int wr, int wc, int fr, int fq) const {
        const int row0 = u.pm * BM + wr * 64 + fr; const int col0 = u.pn * BM + wc * 32 + 8 * fq;
#pragma unroll
        for (int ai = 0; ai < 2; ++ai)
#pragma unroll
            for (int m = 0; m < 4; ++m) { bf16_t* rowp = O + (size_t)(row0 + ai * HALF + m * 16) * ldc + col0;
#pragma unroll
                for (int bj = 0; bj < 2; ++bj) { f32x4 v0 = acc[ai][bj][m][0], v1 = acc[ai][bj][m][1];
                    if (ACT == 1) {
#pragma unroll
                        for (int j = 0; j < 4; ++j) { const float a = fmaxf(v0[j], 0.f), b = fmaxf(v1[j], 0.f); v0[j] = a * a; v1[j] = b * b; } }
                    u32x4 w; w.x = cvt_pk_bf16(v0[0], v0[1]); w.y = cvt_pk_bf16(v0[2], v0[3]); w.z = cvt_pk_bf16(v1[0], v1[1]); w.w = cvt_pk_bf16(v1[2], v1[3]);
                    *(u32x4*)(rowp + bj * HALF) = w; } }
    }
};
struct EpiYss {
    static constexpr bool PERM = true, AFTER_DRAIN = false;
    bf16_t* Y; float* SS;
    __device__ __forceinline__ void operator()(const f32x4 (&acc)[2][2][4][2], const Unit& u, int wr, int wc, int fr, int fq) const {
        const int row0 = u.pm * BM + wr * 64 + fr; const int col0 = u.pn * BM + wc * 32 + 8 * fq;
#pragma unroll
        for (int ai = 0; ai < 2; ++ai)
#pragma unroll
            for (int m = 0; m < 4; ++m) { const int row = row0 + ai * HALF + m * 16; bf16_t* rowp = Y + (size_t)row * 1024 + col0; float s = 0.f;
#pragma unroll
                for (int bj = 0; bj < 2; ++bj) { const f32x4 v0 = acc[ai][bj][m][0], v1 = acc[ai][bj][m][1];
                    s += (v0[0] * v0[0] + v0[1] * v0[1]) + (v0[2] * v0[2] + v0[3] * v0[3]) + (v1[0] * v1[0] + v1[1] * v1[1]) + (v1[2] * v1[2] + v1[3] * v1[3]);
                    u32x4 w; w.x = cvt_pk_bf16(v0[0], v0[1]); w.y = cvt_pk_bf16(v0[2], v0[3]); w.z = cvt_pk_bf16(v1[0], v1[1]); w.w = cvt_pk_bf16(v1[2], v1[3]);
                    *(u32x4*)(rowp + bj * HALF) = w; }
                s += __shfl_xor(s, 16); s += __shfl_xor(s, 32);
                if (fq == 0) SS[(size_t)row * 16 + u.pn * 4 + wc] = s; }
    }
};
struct EpiOddIn {
    static constexpr bool PERM = false, AFTER_DRAIN = true;
    bf16_t* QN; bf16_t* ACKV; float* KPERAW; float* out_ckv; float* out_kpe; const float* gq; const float* gkv; int li;
    __device__ __forceinline__ void fused(f32x4 (&acc)[2][2][4][2], const Unit& u, int wr, int wc, int fr, int fq, PG8_LAS unsigned char* lds, int wid, int lane) const {
        PG8_LAS float* P = (PG8_LAS float*)lds;
        if (u.pn < 2) {
#pragma unroll
            for (int ai = 0; ai < 2; ++ai)
#pragma unroll
                for (int m = 0; m < 4; ++m) { float s = 0.f;
#pragma unroll
                    for (int bj = 0; bj < 2; ++bj)
#pragma unroll
                        for (int n = 0; n < 2; ++n) { const f32x4 x = acc[ai][bj][m][n]; s += (x[0] * x[0] + x[1] * x[1]) + (x[2] * x[2] + x[3] * x[3]); }
                    s += __shfl_xor(s, 16); s += __shfl_xor(s, 32);
                    if (fq == 0) P[(ai * HALF + wr * 64 + m * 16 + fr) * 4 + wc] = s; }
        }
        asm volatile("s_waitcnt lgkmcnt(0)" ::: "memory"); __builtin_amdgcn_s_barrier(); asm volatile("" ::: "memory");
        if (u.pn < 2) {
            const float* gv = u.pn == 0 ? gq : gkv;
#pragma unroll
            for (int ai = 0; ai < 2; ++ai)
#pragma unroll
                for (int m = 0; m < 4; ++m) { const int r = ai * HALF + wr * 64 + m * 16 + fr; const int grow = u.pm * BM + r;
                    const float tot = (P[r * 4 + 0] + P[r * 4 + 1]) + (P[r * 4 + 2] + P[r * 4 + 3]);
                    const float rstd = 1.0f / sqrtf(tot * (1.0f / 256.0f) + 1e-6f);
                    const int drow = grow < 4096 ? grow : 4096 + ((grow - 4096) >> 11) * 2304 + 256 + ((grow - 4096) & 2047);
#pragma unroll
                    for (int bj = 0; bj < 2; ++bj)
#pragma unroll
                        for (int n = 0; n < 2; ++n) { const int col = bj * HALF + wc * 32 + n * 16 + 4 * fq; const f32x4 g = *(const f32x4*)(gv + col);
                            const f32x4 v = acc[ai][bj][m][n] * rstd * g;
                            unsigned long long w = (unsigned long long)cvt_pk_bf16(v[0], v[1]) | ((unsigned long long)cvt_pk_bf16(v[2], v[3]) << 32);
                            if (u.pn == 0) *(unsigned long long*)(QN + (size_t)grow * 256 + col) = w;
                            else { *(unsigned long long*)(ACKV + (size_t)drow * 256 + col) = w;
                                   if (grow < 4096) *(f32x4*)(out_ckv + ((size_t)((grow >> 8) * 2 + li) * 256 + (grow & 255)) * 256 + col) = v; } } }
        } else if (wc < 2) {
#pragma unroll
            for (int ai = 0; ai < 2; ++ai)
#pragma unroll
                for (int m = 0; m < 4; ++m) { const int r = ai * HALF + wr * 64 + m * 16 + fr; const int grow = u.pm * BM + r;
#pragma unroll
                    for (int n = 0; n < 2; ++n) { const int col = wc * 32 + n * 16 + 4 * fq; const f32x4 v = acc[ai][0][m][n];
                        *(f32x4*)(KPERAW + (size_t)grow * 64 + col) = v;
                        if (grow < 4096) *(f32x4*)(out_kpe + ((size_t)((grow >> 8) * 2 + li) * 256 + (grow & 255)) * 64 + col) = v; } }
        }
    }
};

template <class Epi, class Sched, bool ALIGN_EPI = false, bool SP2 = false>
__device__ __forceinline__ void gemm_phase(PG8_LAS unsigned char* lds, const Gemm g, const Sched& S, const Epi& E, const int tid) {
    const int  wid = __builtin_amdgcn_readfirstlane(tid >> 6), lane = tid & 63, wr = wid >> 2, wc = wid & 3, fr = lane & 15, fq = lane >> 4;
    const int K = g.K, nt = K / BK;
    unsigned voffA[2], voffB[2];
#pragma unroll
    for (int i = 0; i < 2; ++i) { int R, C; stage_rc(tid * 16 + i * 8192, R, C); const int Rb = Epi::PERM ? ((R & ~31) + perm32(R & 31)) : R;
        voffA[i] = (unsigned)(R * K + C) * 2u; voffB[i] = (unsigned)(Rb * K + C) * 2u; }
    const size_t kstep = (size_t)(BK * 2);
    const size_t hstep = (size_t)HALF * K * 2;
    const size_t tstep = 2 * hstep;
    const unsigned ldsw = (unsigned)wid * 1024u;
    const int aoff = lds_byte(wr * 64 + fr, fq * 8), boff = lds_byte(wc * 32 + fr, fq * 8);
#define PG8_SA(b, h) (((b) * 2 + (h)) * HTB)
#define PG8_SB(b, h) ((4 + (b) * 2 + (h)) * HTB)
#define PG8_STAGE(bufoff, gbase, voff) do { _Pragma("unroll") for (int _i = 0; _i < 2; ++_i) \
        __builtin_amdgcn_global_load_lds((const unsigned*)((const char*)(gbase) + (voff)[_i]), (PG8_LAS unsigned*)(lds + (bufoff) + ldsw + _i * 8192), 16, 0, 0); } while (0)
#define PG8_LDA(dst, b, h) do { _Pragma("unroll") for (int m = 0; m < 4; ++m) _Pragma("unroll") for (int k = 0; k < 2; ++k) dst[m][k] = *(const PG8_LAS bf16x8*)(lds + PG8_SA(b, h) + aoff + m * 2048 + k * 1024); } while (0)
#define PG8_LDB(dst, b, h) do { _Pragma("unroll") for (int n = 0; n < 2; ++n) _Pragma("unroll") for (int k = 0; k < 2; ++k) dst[n][k] = *(const PG8_LAS bf16x8*)(lds + PG8_SB(b, h) + boff + n * 2048 + k * 1024); } while (0)
#define PG8_MMA(ai, bj, At, Bt) do { __builtin_amdgcn_s_setprio(1); _Pragma("unroll") for (int m = 0; m < 4; ++m) _Pragma("unroll") for (int n = 0; n < 2; ++n) _Pragma("unroll") for (int k = 0; k < 2; ++k) \
        acc[ai][bj][m][n] = __builtin_amdgcn_mfma_f32_16x16x32_bf16(Bt[n][k], At[m][k], acc[ai][bj][m][n], 0, 0, 0); __builtin_amdgcn_s_setprio(0); } while (0)
#define PG8_WAIT_V(n) asm volatile("s_waitcnt vmcnt(" #n ")" ::: "memory")
#define PG8_WAIT_L(n) asm volatile("s_waitcnt lgkmcnt(" #n ")" ::: "memory")
#define PG8_BAR __builtin_amdgcn_s_barrier()
#define PG8_SCHED __builtin_amdgcn_sched_barrier(0)
    Unit cur, nxt; int ui = 0;
    if (!S.next(0, cur)) return;
    f32x4 acc[2][2][4][2];
#pragma unroll
    for (int a = 0; a < 2; ++a)
#pragma unroll
        for (int b = 0; b < 2; ++b)
#pragma unroll
            for (int m = 0; m < 4; ++m)
#pragma unroll
                for (int n = 0; n < 2; ++n) acc[a][b][m][n] = (f32x4){0.f, 0.f, 0.f, 0.f};
    bf16x8 At[4][2], B0[2][2], B1[2][2];
    const char* cA = (const char*)g.A + (size_t)cur.pm * tstep; const char* cB = (const char*)g.Bt + (size_t)cur.pn * tstep;
    S.a_ready(cur);
    if constexpr (SP2) {
        PG8_STAGE(PG8_SB(0, 0), cB, voffB); PG8_STAGE(PG8_SB(0, 1), cB + hstep, voffB); PG8_STAGE(PG8_SA(0, 0), cA, voffA); PG8_STAGE(PG8_SA(0, 1), cA + hstep, voffA);
        if (wr == 1) PG8_BAR;
        PG8_WAIT_V(2); PG8_BAR;
        PG8_STAGE(PG8_SB(1, 0), cB + kstep, voffB); PG8_STAGE(PG8_SA(1, 0), cA + kstep, voffA); PG8_STAGE(PG8_SB(1, 1), cB + hstep + kstep, voffB);
        PG8_WAIT_V(6); PG8_BAR;
    } else {
        PG8_STAGE(PG8_SB(0, 0), cB, voffB); PG8_STAGE(PG8_SA(0, 0), cA, voffA); PG8_STAGE(PG8_SB(0, 1), cB + hstep, voffB); PG8_STAGE(PG8_SA(0, 1), cA + hstep, voffA);
        if (wr == 1) PG8_BAR;
        PG8_WAIT_V(4); PG8_BAR;
        PG8_STAGE(PG8_SB(1, 0), cB + kstep, voffB); PG8_STAGE(PG8_SA(1, 0), cA + kstep, voffA); PG8_STAGE(PG8_SB(1, 1), cB + hstep + kstep, voffB);
        PG8_WAIT_V(6); PG8_BAR;
    }
    for (;;) {
        const bool has_next = S.next(ui + 1, nxt);
        const char* nA = has_next ? (const char*)g.A + (size_t)nxt.pm * tstep : cA; const char* nB = has_next ? (const char*)g.Bt + (size_t)nxt.pn * tstep : cB;
        for (int t = 0; t < nt; t += 2) {
            const bool last = (t == nt - 2);
            const char* a1 = cA + (size_t)(t + 1) * kstep;
            const char* a2 = last ? nA : cA + (size_t)(t + 2) * kstep; const char* b2 = last ? nB : cB + (size_t)(t + 2) * kstep;
            const char* a3 = a2 + kstep; const char* b3 = b2 + kstep;
            if (last && has_next) S.a_ready(nxt);
            if constexpr (SP2) {
            PG8_LDB(B0, 0, 0); PG8_LDB(B1, 0, 1); PG8_SCHED; PG8_LDA(At, 0, 0); PG8_STAGE(PG8_SA(1, 1), a1 + hstep, voffA);
            PG8_WAIT_V(8); PG8_WAIT_L(0); PG8_BAR; PG8_MMA(0, 0, At, B0); PG8_MMA(0, 1, At, B1); PG8_BAR; PG8_SCHED;
            PG8_LDA(At, 0, 1); PG8_STAGE(PG8_SB(0, 0), b2, voffB); PG8_STAGE(PG8_SB(0, 1), b2 + hstep, voffB); PG8_STAGE(PG8_SA(0, 0), a2, voffA);
            PG8_WAIT_V(8); PG8_WAIT_L(0); PG8_BAR; PG8_MMA(1, 0, At, B0); PG8_MMA(1, 1, At, B1); PG8_BAR; PG8_SCHED;
            PG8_LDB(B0, 1, 0); PG8_LDB(B1, 1, 1); PG8_SCHED; PG8_LDA(At, 1, 0); PG8_STAGE(PG8_SA(0, 1), a2 + hstep, voffA);
            PG8_WAIT_V(8); PG8_WAIT_L(0); PG8_BAR; PG8_MMA(0, 0, At, B0); PG8_MMA(0, 1, At, B1); PG8_BAR; PG8_SCHED;
            PG8_LDA(At, 1, 1); PG8_STAGE(PG8_SB(1, 0), b3, voffB); PG8_STAGE(PG8_SB(1, 1), b3 + hstep, voffB); PG8_STAGE(PG8_SA(1, 0), a3, voffA);
            PG8_WAIT_V(8); PG8_WAIT_L(0); PG8_BAR; PG8_MMA(1, 0, At, B0); PG8_MMA(1, 1, At, B1); PG8_BAR; PG8_SCHED;
            } else {
            PG8_LDB(B0, 0, 0); PG8_SCHED; PG8_LDA(At, 0, 0); PG8_STAGE(PG8_SA(1, 1), a1 + hstep, voffA);
            PG8_WAIT_L(8); PG8_BAR; PG8_WAIT_L(0); PG8_MMA(0, 0, At, B0); PG8_BAR; PG8_SCHED;
            PG8_LDB(B1, 0, 1); PG8_STAGE(PG8_SB(0, 0), b2, voffB);
            PG8_BAR; PG8_WAIT_L(0); PG8_MMA(0, 1, At, B1); PG8_BAR;
            PG8_LDA(At, 0, 1); PG8_STAGE(PG8_SA(0, 0), a2, voffA);
            PG8_BAR; PG8_WAIT_L(0); PG8_MMA(1, 0, At, B0); PG8_BAR; PG8_SCHED;
            PG8_STAGE(PG8_SB(0, 1), b2 + hstep, voffB);
            PG8_WAIT_V(6); PG8_BAR; PG8_MMA(1, 1, At, B1); PG8_BAR;
            PG8_LDB(B0, 1, 0); PG8_SCHED; PG8_LDA(At, 1, 0); PG8_STAGE(PG8_SA(0, 1), a2 + hstep, voffA);
            PG8_WAIT_L(8); PG8_BAR; PG8_WAIT_L(0); PG8_MMA(0, 0, At, B0); PG8_BAR; PG8_SCHED;
            PG8_LDB(B1, 1, 1); PG8_STAGE(PG8_SB(1, 0), b3, voffB);
            PG8_BAR; PG8_WAIT_L(0); PG8_MMA(0, 1, At, B1); PG8_BAR;
            PG8_LDA(At, 1, 1); PG8_STAGE(PG8_SA(1, 0), a3, voffA);
            PG8_BAR; PG8_WAIT_L(0); PG8_MMA(1, 0, At, B0); PG8_BAR; PG8_SCHED;
            PG8_STAGE(PG8_SB(1, 1), b3 + hstep, voffB);
            PG8_WAIT_V(6); PG8_BAR; PG8_MMA(1, 1, At, B1); PG8_BAR;
            }
        }
        if constexpr (ALIGN_EPI) { if (wr == 0) PG8_BAR; }
        if constexpr (!Epi::AFTER_DRAIN) { E(acc, cur, wr, wc, fr, fq); S.done(cur); }
        if (!has_next) break;
#pragma unroll
        for (int a = 0; a < 2; ++a)
#pragma unroll
            for (int b = 0; b < 2; ++b)
#pragma unroll
                for (int m = 0; m < 4; ++m)
#pragma unroll
                    for (int n = 0; n < 2; ++n) acc[a][b][m][n] = (f32x4){0.f, 0.f, 0.f, 0.f};
        cur = nxt; cA = nA; cB = nB; ++ui;
        if constexpr (ALIGN_EPI) { if (wr == 1) PG8_BAR; }
    }
    PG8_WAIT_V(0);
    if constexpr (!ALIGN_EPI) { if (wr == 0) PG8_BAR; }
    PG8_BAR;
    if constexpr (Epi::AFTER_DRAIN) { E.fused(acc, cur, wr, wc, fr, fq, lds, wid, lane); S.done(cur); }
#undef PG8_SA
#undef PG8_SB
#undef PG8_STAGE
#undef PG8_LDA
#undef PG8_LDB
#undef PG8_MMA
#undef PG8_WAIT_V
#undef PG8_WAIT_L
#undef PG8_BAR
#undef PG8_SCHED
}
}

constexpr int NWAVES = 8;
constexpr int D = 1024, FF = 4096, M_CTX = 4096, M_LAT = 16384, M = M_CTX + M_LAT;
constexpr int L_LAT = 2048, L_CTX = 256, PAST = 256, LKV = PAST + L_LAT;
constexpr int MKV = M_CTX + 8 * LKV;
constexpr int EVEN_N = 3104, EVEN_NP = 3328, ODD_N = 576, ODD_NP = 768;
constexpr float EPS = 1e-6f;
constexpr int PC_QA = 0, PC_KA = 256, PC_VA = 512, PC_GA = 1024, PC_QB = 1536, PC_KB = 1792, PC_VB = 2048, PC_GB = 2560, PC_GK = 3072;
constexpr size_t OUT_Y = 0, OUT_CKV = 20971520, OUT_KPE = 23068672, OUT_SGLA = 23592960, OUT_SRET = 25690112;

constexpr size_t MiB = 1u << 20;
constexpr size_t WS_CTL = 0, CTL_ZERO_BYTES = 64 * 1024;
constexpr size_t WS_MOD = 1 * MiB;
constexpr size_t WS_ROPE = 2 * MiB;
constexpr size_t WS_SS = 3 * MiB;
constexpr size_t WS_KPE = 5 * MiB;
constexpr size_t WS_ACKV = 11 * MiB;
constexpr size_t WS_WINE = 35 * MiB;
constexpr size_t WS_WOUTE = 48 * MiB;
constexpr size_t WS_WINO = 52 * MiB;
constexpr size_t WS_WQB = 55 * MiB;
constexpr size_t WS_WKVB = 57 * MiB;
constexpr size_t WS_WOUTO = 59 * MiB;
constexpr size_t WS_W1 = 63 * MiB;
constexpr size_t WS_W2 = 95 * MiB;
constexpr size_t WS_HB = 127 * MiB;
constexpr size_t WS_Y = 167 * MiB;
constexpr size_t WS_BIG = 207 * MiB;
constexpr size_t WS_Q = WS_BIG, WS_KV = WS_BIG + 60 * MiB, WS_QN = WS_BIG + 148 * MiB;
constexpr size_t WS_END = 367 * MiB;

constexpr int RING_BYTES = 131072;
constexpr int LDS_MISC = 155648;
constexpr int LDS_BYTES = 163840;

#define GAS __attribute__((address_space(1)))
#define LAS __attribute__((address_space(3)))
typedef unsigned short bf16;
typedef unsigned v4u __attribute__((ext_vector_type(4)));
typedef unsigned v2u __attribute__((ext_vector_type(2)));
typedef float f32x4 __attribute__((ext_vector_type(4)));
typedef float f32x16 __attribute__((ext_vector_type(16)));
typedef short bf16x8 __attribute__((ext_vector_type(8)));
typedef short s16x4 __attribute__((ext_vector_type(4)));
#define LDS_WAIT() asm volatile("s_waitcnt lgkmcnt(0)" ::: "memory")
#define VM_WAIT() asm volatile("s_waitcnt vmcnt(0)" ::: "memory")
__device__ __forceinline__ unsigned f2bf(float f) { unsigned u = __builtin_bit_cast(unsigned, f); return (u + 0x7fffu + ((u >> 16) & 1u)) >> 16; }
__device__ __forceinline__ unsigned pk2(float lo, float hi) { return f2bf(lo) | (f2bf(hi) << 16); }
__device__ __forceinline__ float bflo(unsigned w) { return __builtin_bit_cast(float, w << 16); }
__device__ __forceinline__ float bfhi(unsigned w) { return __builtin_bit_cast(float, w & 0xffff0000u); }
__device__ __forceinline__ float wave_sum(float v) {
#pragma unroll
    for (int o = 1; o < 64; o <<= 1) v += __shfl_xor(v, o);
    return v;
}
__device__ __forceinline__ float siluf(float x) { return x * __builtin_amdgcn_rcpf(1.0f + __expf(-x)); }

#define XB_TMO      128
#define XB_XCNT(j)  (256  + 64 * (j))
#define XB_XSUB(j)  (1280 + 64 * (j))
#define XB_XGEN(j)  (2304 + 64 * (j))
#define XB_TOP      3328
#define XB_TOPGEN   3392
#define XCD_BAR_WORDS 3456
#define XB_SPIN_CAP (1u << 20)
__device__ __forceinline__ unsigned xb_ld(unsigned* p)              { return __hip_atomic_load(p, __ATOMIC_RELAXED, __HIP_MEMORY_SCOPE_AGENT); }
__device__ __forceinline__ unsigned xb_add(unsigned* p, unsigned v) { return __hip_atomic_fetch_add(p, v, __ATOMIC_RELAXED, __HIP_MEMORY_SCOPE_AGENT); }
__device__ __forceinline__ unsigned xb_xcc_id() { return (unsigned)__builtin_amdgcn_s_getreg((3 << 11) | 20) & 0xFu; }
#define XB_SPIN(cond, bar) do { unsigned _sp = 0; while (cond) { __builtin_amdgcn_s_sleep(1); \
    if ((++_sp & 255u) == 0u) { if (xb_ld(&(bar)[XB_TMO])) break; if (_sp > XB_SPIN_CAP) { atomicAdd(&(bar)[XB_TMO], 1u); break; } } } } while (0)
struct XcdBarrier { unsigned* bar; unsigned x; volatile LAS unsigned* st; };
__device__ __forceinline__ XcdBarrier xcd_barrier_post(unsigned* bar, volatile LAS unsigned* st) {
    XcdBarrier b; b.bar = bar; b.x = xb_xcc_id(); b.st = st;
    if (threadIdx.x == 0) (void)xb_add(&bar[XB_XCNT(b.x)], 1u);
    return b;
}
__device__ __forceinline__ void xcd_barrier_complete(unsigned* bar, unsigned x, unsigned& nloc, unsigned& nx) {
    const unsigned G = gridDim.x * gridDim.y * gridDim.z;
    unsigned sum, cnt, mine, sp = 0u;
    for (;;) {
        sum = 0u; cnt = 0u; mine = 0u;
#pragma unroll
        for (unsigned j = 0; j < 16; ++j) { const unsigned c = xb_ld(&bar[XB_XCNT(j)]); sum += c; cnt += (c > 0u) ? 1u : 0u; mine = (j == x) ? c : mine; }
        if (sum == G) break;
        __builtin_amdgcn_s_sleep(1);
        if ((++sp & 255u) == 0u) { if (xb_ld(&bar[XB_TMO])) break; if (sp > XB_SPIN_CAP) { atomicAdd(&bar[XB_TMO], 1u); break; } }
    }
    nloc = mine > 0u ? mine : 1u; nx = cnt > 0u ? cnt : 1u;
}
__device__ __forceinline__ void xcd_barrier(const XcdBarrier& b) {
    asm volatile("s_waitcnt vmcnt(0)" ::: "memory");
    __syncthreads();
    if (threadIdx.x == 0) {
        unsigned* bar = b.bar;
        __builtin_amdgcn_s_waitcnt(0);
        unsigned nloc = b.st[0], nx = b.st[1];
        if (nloc == 0u) { xcd_barrier_complete(bar, b.x, nloc, nx); b.st[0] = nloc; b.st[1] = nx; }
        const unsigned old = xb_add(&bar[XB_XSUB(b.x)], 1u);
        const unsigned gen = old / nloc;
        if (old + 1u == (gen + 1u) * nloc) {
            __builtin_amdgcn_fence(__ATOMIC_RELEASE, "agent");
            asm volatile("s_waitcnt vmcnt(0)" ::: "memory");
            const unsigned og = xb_add(&bar[XB_TOP], 1u);
            const unsigned tg = og / nx;
            if (og + 1u == (tg + 1u) * nx) xb_add(&bar[XB_TOPGEN], 1u);
            else XB_SPIN(xb_ld(&bar[XB_TOPGEN]) == tg, bar);
            __builtin_amdgcn_fence(__ATOMIC_ACQUIRE, "agent");
            xb_add(&bar[XB_XGEN(b.x)], 1u);
            asm volatile("s_waitcnt vmcnt(0)" ::: "memory");
        } else {
            XB_SPIN(xb_ld(&bar[XB_XGEN(b.x)]) == gen, bar);
            __builtin_amdgcn_fence(__ATOMIC_ACQUIRE, "agent");
            asm volatile("s_waitcnt vmcnt(0)" ::: "memory");
        }
    }
    __syncthreads();
}

struct Params { const float* in[28]; float* out; unsigned char* ws; int ph_lo, ph_hi, use_bar, pad; };
enum { I_XP = 0, I_XS, I_CCKV, I_CKPE, I_SGLA, I_SRET, I_C, I_CCTX, I_WADA, I_BADA, I_NMIXPRE, I_NMIXPOST, I_NMLPPRE, I_NMLPPOST,
       I_WINE, I_WGK2, I_BGK2, I_GLAN, I_RDEC, I_WOUTE, I_WINO, I_QAN, I_WQB, I_KVAN, I_WKVB, I_WOUTO, I_W1, I_W2 };
struct Frame { LAS unsigned char* lds; int tid, lane, wave, vcu, G, bid; };
constexpr int LDS_PT = LDS_MISC + 256;
__device__ __forceinline__ const void* ldp(LAS unsigned char* lds, int i) {
    const volatile LAS unsigned* p = (const volatile LAS unsigned*)(lds + LDS_PT) + 2 * i;
    const unsigned lo = __builtin_amdgcn_readfirstlane(p[0]), hi = __builtin_amdgcn_readfirstlane(p[1]);
    return (const void*)(const GAS void*)(((unsigned long long)hi << 32) | lo);
}
#define PIN(i) ((const float*)ldp(F.lds, (i)))
#define POUT ((float*)ldp(F.lds, 28))
#define PWS ((unsigned char*)ldp(F.lds, 29))

__device__ __forceinline__ void p0_transpose_item(const float* W, int K, int N, bf16* WT, int kb, int n0, int dn0, LAS float* scr, int lane) {
    const int k0 = 64 * kb;
#pragma unroll 8
    for (int i = 0; i < 32; ++i) { const int kk = 2 * i + (lane >> 5); scr[kk * 33 + (lane & 31)] = W[(size_t)(k0 + kk) * N + n0 + (lane & 31)]; }
    LDS_WAIT(); asm volatile("" ::: "memory");
    const int c = lane & 7;
#pragma unroll
    for (int j = 0; j < 4; ++j) { const int n = (lane >> 3) + 8 * j; const LAS float* s = scr + (8 * c) * 33 + n;
        v4u o; o.x = pk2(s[0 * 33], s[1 * 33]); o.y = pk2(s[2 * 33], s[3 * 33]); o.z = pk2(s[4 * 33], s[5 * 33]); o.w = pk2(s[6 * 33], s[7 * 33]);
        *(GAS v4u*)(WT + (size_t)(dn0 + n) * K + k0 + 8 * c) = o; }
    LDS_WAIT(); asm volatile("" ::: "memory");
}
__device__ __forceinline__ int even_col_map(int n0) { return n0 < 1536 ? n0 : (n0 < 1568 ? 3072 + (n0 - 1536) : n0 - 32); }

__device__ __forceinline__ void p0_prologue(Frame& F, const Params& P) {
    unsigned char* ws = PWS;
    LAS float* scr = (LAS float*)(F.lds + F.wave * 16384);
    const int gw = F.vcu * NWAVES + F.wave, NGW = F.G * NWAVES;
    {
        LAS float* S = (LAS float*)(F.lds);
        LAS float* R = (LAS float*)(F.lds + 40960);
        { const float* cp_ = PIN(I_C); const float* cc_ = PIN(I_CCTX);
          for (int i = F.tid; i < 9 * 1024; i += 512) { const int n = i >> 10, d = i & 1023; const float cv = n < 8 ? cp_[n * 1024 + d] : cc_[d]; S[i] = siluf(cv); } }
        const float* wada_ = PIN(I_WADA); const float* bada_ = PIN(I_BADA);
        __syncthreads();
        for (int u = F.vcu; u < 256; u += F.G) {
            const int l = u >> 6, cb = (u & 63) * 96;
            if (F.tid < 384) {
                const int c4 = (F.tid % 24) * 4, part = F.tid / 24;
                const float* Wp = wada_ + ((size_t)l * 1024 + part * 64) * 6144 + cb + c4;
                f32x4 a[9];
#pragma unroll
                for (int n = 0; n < 9; ++n) a[n] = (f32x4){0.f, 0.f, 0.f, 0.f};
#pragma unroll 4
                for (int d = 0; d < 64; ++d) { const f32x4 w = *(const f32x4*)(Wp + (size_t)d * 6144);
#pragma unroll
                    for (int n = 0; n < 9; ++n) a[n] += w * S[n * 1024 + part * 64 + d]; }
#pragma unroll
                for (int n = 0; n < 9; ++n) *(LAS f32x4*)(R + (part * 9 + n) * 96 + c4) = a[n];
            }
            __syncthreads();
            for (int i = F.tid; i < 9 * 96; i += 512) { const int n = i / 96, c = i % 96; float s = 0.f;
#pragma unroll
                for (int p = 0; p < 16; ++p) s += R[(p * 9 + n) * 96 + c];
                ((float*)(ws + WS_MOD))[((size_t)l * 9 + n) * 6144 + cb + c] = s + bada_[l * 6144 + cb + c]; }
            __syncthreads();
        }
    }
    {
        int it = gw;
        const int I_E = (1024 / 64) * (EVEN_N / 32), I_OE = 16 * 32, I_O = 16 * (ODD_N / 32), I_QB = 4 * 48, I_KVB = 4 * 64, I_M1 = 16 * 128, I_M2 = 64 * 32;
        const int T_E = 2 * I_E, T_OE = 2 * I_OE, T_O = 2 * I_O, T_QB = 2 * I_QB, T_KVB = 2 * I_KVB, T_OO = 2 * I_OE, T_M1 = 4 * I_M1, T_M2 = 4 * I_M2;
        const int TOTAL = T_E + T_OE + T_O + T_QB + T_KVB + T_OO + T_M1 + T_M2;
        for (; it < TOTAL; it += NGW) {
            int r = it;
            if (r < T_E) { const int l = r / I_E, q = r % I_E, nb = EVEN_N / 32, kb = q / nb, n0 = (q % nb) * 32;
                p0_transpose_item(PIN(I_WINE) + (size_t)l * 1024 * EVEN_N, 1024, EVEN_N, (bf16*)(ws + WS_WINE) + (size_t)l * EVEN_NP * 1024, kb, n0, even_col_map(n0), scr, F.lane); continue; } r -= T_E;
            if (r < T_OE) { const int l = r / I_OE, q = r % I_OE, kb = q / 32, n0 = (q % 32) * 32;
                p0_transpose_item(PIN(I_WOUTE) + (size_t)l * 1024 * 1024, 1024, 1024, (bf16*)(ws + WS_WOUTE) + (size_t)l * 1024 * 1024, kb, n0, n0, scr, F.lane); continue; } r -= T_OE;
            if (r < T_O) { const int l = r / I_O, q = r % I_O, nb = ODD_N / 32, kb = q / nb, n0 = (q % nb) * 32;
                p0_transpose_item(PIN(I_WINO) + (size_t)l * 1024 * ODD_N, 1024, ODD_N, (bf16*)(ws + WS_WINO) + (size_t)l * ODD_NP * 1024, kb, n0, n0, scr, F.lane); continue; } r -= T_O;
            if (r < T_QB) { const int l = r / I_QB, q = r % I_QB, kb = q / 48, n0 = (q % 48) * 32;
                p0_transpose_item(PIN(I_WQB) + (size_t)l * 256 * 1536, 256, 1536, (bf16*)(ws + WS_WQB) + (size_t)l * 1536 * 256, kb, n0, n0, scr, F.lane); continue; } r -= T_QB;
            if (r < T_KVB) { const int l = r / I_KVB, q = r % I_KVB, kb = q / 64, n0 = (q % 64) * 32;
                p0_transpose_item(PIN(I_WKVB) + (size_t)l * 256 * 2048, 256, 2048, (bf16*)(ws + WS_WKVB) + (size_t)l * 2048 * 256, kb, n0, n0, scr, F.lane); continue; } r -= T_KVB;
            if (r < T_OO) { const int l = r / I_OE, q = r % I_OE, kb = q / 32, n0 = (q % 32) * 32;
                p0_transpose_item(PIN(I_WOUTO) + (size_t)l * 1024 * 1024, 1024, 1024, (bf16*)(ws + WS_WOUTO) + (size_t)l * 1024 * 1024, kb, n0, n0, scr, F.lane); continue; } r -= T_OO;
            if (r < T_M1) { const int l = r / I_M1, q = r % I_M1, kb = q / 128, n0 = (q % 128) * 32;
                p0_transpose_item(PIN(I_W1) + (size_t)l * 1024 * 4096, 1024, 4096, (bf16*)(ws + WS_W1) + (size_t)l * 4096 * 1024, kb, n0, n0, scr, F.lane); continue; } r -= T_M1;
            { const int l = r / I_M2, q = r % I_M2, kb = q / 32, n0 = (q % 32) * 32;
                p0_transpose_item(PIN(I_W2) + (size_t)l * 4096 * 1024, 4096, 1024, (bf16*)(ws + WS_W2) + (size_t)l * 1024 * 4096, kb, n0, n0, scr, F.lane); }
        }
    }
    const int gt = F.vcu * 512 + F.tid, NGT = F.G * 512;
    for (int i = gt; i < 2 * 224 * 128; i += NGT) { const int l = i / (224 * 128), q = i % (224 * 128); *(GAS v4u*)((bf16*)(ws + WS_WINE) + ((size_t)l * EVEN_NP + EVEN_N) * 1024 + (size_t)q * 8) = (v4u){0u, 0u, 0u, 0u}; }
    for (int i = gt; i < 2 * 192 * 128; i += NGT) { const int l = i / (192 * 128), q = i % (192 * 128); *(GAS v4u*)((bf16*)(ws + WS_WINO) + ((size_t)l * ODD_NP + ODD_N) * 1024 + (size_t)q * 8) = (v4u){0u, 0u, 0u, 0u}; }
    const float* cckv_ = PIN(I_CCKV); const float* ckpe_ = PIN(I_CKPE);
    for (int i = gt; i < 8 * 2 * 256 * 32; i += NGT) { const int c8 = i & 31, t = (i >> 5) & 255, li = (i >> 13) & 1, b = i >> 14;
        const float* s = cckv_ + (size_t)i * 8; const f32x4 a = *(const f32x4*)s, c = *(const f32x4*)(s + 4);
        *(GAS v4u*)((bf16*)(ws + WS_ACKV) + ((size_t)li * MKV + 4096 + b * LKV + t) * 256 + c8 * 8) = (v4u){pk2(a[0], a[1]), pk2(a[2], a[3]), pk2(c[0], c[1]), pk2(c[2], c[3])}; }
    for (int i = gt; i < 8 * 2 * 256 * 8; i += NGT) { const int c8 = i & 7, t = (i >> 3) & 255, li = (i >> 11) & 1, b = i >> 12;
        const float* s = ckpe_ + (size_t)i * 8; const f32x4 a = *(const f32x4*)s, c = *(const f32x4*)(s + 4);
        *(GAS v4u*)((bf16*)(ws + WS_KPE) + ((size_t)li * MKV + 4096 + b * LKV + t) * 64 + c8 * 8) = (v4u){pk2(a[0], a[1]), pk2(a[2], a[3]), pk2(c[0], c[1]), pk2(c[2], c[3])}; }
    for (int i = gt; i < 2048 * 32; i += NGT) { const int t = i >> 5, j = i & 31; const float inv = powf(10000.0f, -(float)(j & 15) / 16.0f);
        const float ang = (float)(j < 16 ? (t >> 6) : (t & 63)) * inv;
        ((float*)(ws + WS_ROPE))[i] = cosf(ang); ((float*)(ws + WS_ROPE))[65536 + i] = sinf(ang); }
}

__device__ __forceinline__ void row_pass(Frame& F, const float* xa, const float* xb, float* xout, const bf16* Y, const float* SS, const float* g_post, const float* gate,
                                         const float* g_pre, const float* scale, const float* shift, bf16* H, bool has_post, bool has_pre) {
    const int gw = F.vcu * NWAVES + F.wave, NGW = F.G * NWAVES, l4 = F.lane * 4;
    for (int row = gw; row < M; row += NGW) {
        const int n = row < M_CTX ? 8 : ((row - M_CTX) >> 11);
        const float* xr = row < M_CTX ? xa + (size_t)row * D : xb + (size_t)(row - M_CTX) * D;
        f32x4 v[4];
#pragma unroll
        for (int j = 0; j < 4; ++j) v[j] = *(const f32x4*)(xr + l4 + 256 * j);
        if (has_post) {
            const f32x4 s0 = *(const f32x4*)(SS + (size_t)row * 16), s1 = *(const f32x4*)(SS + (size_t)row * 16 + 4), s2 = *(const f32x4*)(SS + (size_t)row * 16 + 8), s3 = *(const f32x4*)(SS + (size_t)row * 16 + 12);
            const f32x4 st = (s0 + s1) + (s2 + s3);
            const float rstd = 1.0f / sqrtf(((st[0] + st[1]) + (st[2] + st[3])) * (1.0f / 1024.0f) + EPS);
#pragma unroll
            for (int j = 0; j < 4; ++j) { const int c = l4 + 256 * j; const v2u yw = *(const v2u*)(Y + (size_t)row * D + c);
                const f32x4 yv = (f32x4){bflo(yw.x), bfhi(yw.x), bflo(yw.y), bfhi(yw.y)};
                const f32x4 gp = *(const f32x4*)(g_post + c), gt = *(const f32x4*)(gate + (size_t)n * 6144 + c);
                v[j] = v[j] + gt * ((yv * rstd) * gp);
                *(f32x4*)(xout + (size_t)row * D + c) = v[j]; }
        }
        if (has_pre) {
            float s = 0.f;
#pragma unroll
            for (int j = 0; j < 4; ++j) s += (v[j][0] * v[j][0] + v[j][1] * v[j][1]) + (v[j][2] * v[j][2] + v[j][3] * v[j][3]);
            const float rstd = 1.0f / sqrtf(wave_sum(s) * (1.0f / 1024.0f) + EPS);
#pragma unroll
            for (int j = 0; j < 4; ++j) { const int c = l4 + 256 * j;
                const f32x4 gp = *(const f32x4*)(g_pre + c), sc = *(const f32x4*)(scale + (size_t)n * 6144 + c), sh = *(const f32x4*)(shift + (size_t)n * 6144 + c);
                const f32x4 h = ((v[j] * rstd) * gp) * (1.0f + sc) + sh;
                *(v2u*)(H + (size_t)row * D + c) = (v2u){pk2(h[0], h[1]), pk2(h[2], h[3])}; }
        }
    }
}

__device__ __forceinline__ int crow(int r, int hi) { return (r & 3) + 8 * (r >> 2) + 4 * hi; }
__device__ __forceinline__ unsigned cvtpk(float lo, float hi) { unsigned r; asm volatile("v_cvt_pk_bf16_f32 %0, %1, %2" : "=v"(r) : "v"(lo), "v"(hi)); return r; }
#define SBAR() __builtin_amdgcn_sched_barrier(0)
__device__ __forceinline__ int vst_row(int k, int NB) { const int kk = (k & ~0xC) | ((k & 4) << 1) | ((k & 8) >> 1); return (kk >> 3) * NB * 512 + (kk & 7) * 64; }
__device__ __forceinline__ int vst(int k, int c, int NB) { return vst_row(k, NB) + (c >> 5) * 512 + (c & 31) * 2; }
__device__ __forceinline__ int v_rd_base(int lane) { return ((lane & 3) << 3) | (((lane >> 2) & 3) << 6) | (((lane >> 4) & 1) << 5) | (((lane >> 5) & 1) << 8); }
template <int OFF> __device__ __forceinline__ s16x4 tr_read(unsigned vb) { s16x4 r; asm volatile("ds_read_b64_tr_b16 %0, %1 offset:%2" : "=&v"(r) : "v"(vb), "i"(OFF) : "memory"); return r; }
#define PKF(L, H) ((bf16x8){L[0], L[1], L[2], L[3], H[0], H[1], H[2], H[3]})
#define PK4(P, BASE, OUT) do { unsigned a0_ = cvtpk(P[BASE + 0], P[BASE + 1]), a1_ = cvtpk(P[BASE + 2], P[BASE + 3]);   \
    unsigned b0_ = cvtpk(P[BASE + 4], P[BASE + 5]), b1_ = cvtpk(P[BASE + 6], P[BASE + 7]);                              \
    auto r0_ = __builtin_amdgcn_permlane32_swap(a0_, b0_, false, false); auto r1_ = __builtin_amdgcn_permlane32_swap(a1_, b1_, false, false); \
    v4u w_ = {r0_[0], r1_[0], r0_[1], r1_[1]}; OUT = __builtin_bit_cast(bf16x8, w_); } while (0)
__device__ __forceinline__ float logsig(float x) { return fminf(x, 0.f) - __logf(1.0f + __expf(-fabsf(x))); }

constexpr int SC_QD = 0, SC_KI = 8192, SC_VT = 16384, SC_ST = 32768, SC_BT = 49152, SC_GK = 65536, SC_TOT = 69632, SC_DL = 70656, SC_W2 = 70912, SC_GRP = 75264;
__device__ __forceinline__ void scan_phase(Frame& F, const Params& P, int li) {
    unsigned char* ws = PWS;
    const bf16* PROJ = (const bf16*)(ws + WS_BIG);
    bf16* OF = (bf16*)(ws + WS_Y);
    bf16* OB = (bf16*)(ws + WS_HB);
    const float* ROPE = (const float*)(ws + WS_ROPE);
    const int lane = F.lane, r32 = lane & 31, hi = lane >> 5;
    const int dir = F.wave >> 2, wq = F.wave & 3, tg = F.tid & 255, ri = wq >> 1, dh = wq & 1;
    LAS unsigned char* G = F.lds + dir * SC_GRP;
    const unsigned gaddr = (unsigned)(uintptr_t)G;
    for (int u = F.bid; u < 192; u += F.G) {
        __syncthreads();
        const bool lat = u < 64; const int sb = lat ? (u >> 3) : ((u - 64) >> 3), hh = lat ? (u & 7) : ((u - 64) & 7);
        const int L = lat ? L_LAT : L_CTX, row0 = lat ? M_CTX + sb * L_LAT : sb * L_CTX, NC = L / 64;
        const bool gla = hh < 4; const int h = hh & 3;
        const int qc = (gla ? PC_QA : PC_QB) + h * 64, kc = (gla ? PC_KA : PC_KB) + h * 64, vc = (gla ? PC_VA : PC_VB) + h * 128, gkc = PC_GK + dir * 16;
        const float* rdec_p = PIN(I_RDEC); const float* wgk2_p = PIN(I_WGK2); const float* bgk2_p = PIN(I_BGK2);
        const float lgr = gla ? 0.f : -__expf(rdec_p[(li * 2 + dir) * 4 + h]);
        if (gla) { LAS float* W2 = (LAS float*)(G + SC_W2);
            for (int i = tg; i < 16 * 64; i += 256) W2[i] = wgk2_p[((size_t)(li * 2 + dir) * 16 + (i >> 6)) * 256 + h * 64 + (i & 63)];
            if (tg < 64) W2[1024 + tg] = bgk2_p[(li * 2 + dir) * 256 + h * 64 + tg]; }
        f32x16 sacc[2];
        { const float* S0 = (gla ? PIN(I_SGLA) : PIN(I_SRET)) + ((size_t)((sb * 2 + li) * 2 + dir) * 4 + h) * 8192;
          if (lat) {
#pragma unroll
            for (int d = 0; d < 2; ++d)
#pragma unroll
              for (int r = 0; r < 16; ++r) sacc[d][r] = S0[(32 * ri + crow(r, hi)) * 128 + 32 * (2 * dh + d) + r32];
          } else { sacc[0] = f32x16{}; sacc[1] = f32x16{}; }
#pragma unroll
          for (int d = 0; d < 2; ++d)
#pragma unroll
            for (int r = 0; r < 16; ++r)
                *(LAS unsigned short*)(G + SC_ST + (hi + 4 * ri) * 2048 + (2 * dh + d) * 512 + r32 * 2 + ((r >> 3) & 1) * 4096 + ((r & 3) + 4 * ((r >> 2) & 1)) * 64) = (unsigned short)f2bf(sacc[d][r]);
          if (!gla && tg < 64) ((LAS float*)(G + SC_DL))[tg] = __expf(64.0f * lgr); }
        const int sti = tg >> 2, c8 = tg & 3;
        v4u pq0, pq1, pk0, pk1, pv[4]; v2u pgk;
#define SC_TOK(s) (dir == 0 ? 64 * (s) + sti : L - 1 - (64 * (s) + sti))
#define SC_LOAD(s) do { const unsigned ro_ = (unsigned)(row0 + SC_TOK(s)) * (unsigned)(EVEN_NP * 2); const char* pc_ = (const char*)PROJ; \
        pq0 = *(const v4u*)(pc_ + (ro_ + (unsigned)(qc + 8 * c8) * 2u)); pq1 = *(const v4u*)(pc_ + (ro_ + (unsigned)(qc + 32 + 8 * c8) * 2u)); \
        pk0 = *(const v4u*)(pc_ + (ro_ + (unsigned)(kc + 8 * c8) * 2u)); pk1 = *(const v4u*)(pc_ + (ro_ + (unsigned)(kc + 32 + 8 * c8) * 2u)); \
        _Pragma("unroll") for (int m_ = 0; m_ < 4; ++m_) pv[m_] = *(const v4u*)(pc_ + (ro_ + (unsigned)(vc + c8 * 32 + 8 * m_) * 2u)); \
        if (gla) pgk = *(const v2u*)(pc_ + (ro_ + (unsigned)(gkc + 4 * c8) * 2u)); } while (0)
        SC_LOAD(0);
        for (int s = 0; s < NC; ++s) {
            int tid_o = F.tid; asm volatile("" : "+v"(tid_o));
            const int lane = tid_o & 63, r32 = lane & 31, hi = lane >> 5, tg = tid_o & 255, sti = tg >> 2, c8 = tg & 3;
            const int tok = SC_TOK(s);
            float bq[16];
            if (gla) {
                { LAS float* GK = (LAS float*)(G + SC_GK) + sti * 16 + 4 * c8; GK[0] = bflo(pgk.x); GK[1] = bfhi(pgk.x); GK[2] = bflo(pgk.y); GK[3] = bfhi(pgk.y); }
                LDS_WAIT(); __syncthreads();
                const int k = tg & 63, tq = tg >> 6; float cs[16]; float run = 0.f;
                float w2[16]; const LAS float* W2 = (const LAS float*)(G + SC_W2);
#pragma unroll
                for (int r = 0; r < 16; ++r) w2[r] = W2[r * 64 + k];
                const float bias2 = W2[1024 + k];
#pragma unroll
                for (int j = 0; j < 16; ++j) { const LAS f32x4* gp = (const LAS f32x4*)((LAS float*)(G + SC_GK) + (16 * tq + j) * 16);
                    const f32x4 g0 = gp[0], g1 = gp[1], g2 = gp[2], g3 = gp[3];
                    float a = bias2;
                    a += g0[0] * w2[0] + g0[1] * w2[1] + g0[2] * w2[2] + g0[3] * w2[3];
                    a += g1[0] * w2[4] + g1[1] * w2[5] + g1[2] * w2[6] + g1[3] * w2[7];
                    a += g2[0] * w2[8] + g2[1] * w2[9] + g2[2] * w2[10] + g2[3] * w2[11];
                    a += g3[0] * w2[12] + g3[1] * w2[13] + g3[2] * w2[14] + g3[3] * w2[15];
                    run += logsig(a) * (1.0f / 16.0f); cs[j] = run; }
                ((LAS float*)(G + SC_TOT))[tq * 64 + k] = run;
                LDS_WAIT(); __syncthreads();
                float pre = 0.f;
#pragma unroll
                for (int q = 0; q < 3; ++q) { const float tv = ((LAS float*)(G + SC_TOT))[q * 64 + k]; pre += (q < tq) ? tv : 0.f; }
#pragma unroll
                for (int j = 0; j < 16; ++j) ((LAS float*)(G + SC_BT))[(16 * tq + j) * 64 + k] = pre + cs[j];
                if (tq == 3) ((LAS float*)(G + SC_DL))[k] = __expf(pre + cs[15]);
                LDS_WAIT(); __syncthreads();
            } else { __syncthreads(); }
            {
                float q[16], kk[16];
#define UNPK(dst, o, W_) do { const v4u w_ = (W_); dst[o + 0] = bflo(w_[0]); dst[o + 1] = bfhi(w_[0]); dst[o + 2] = bflo(w_[1]); dst[o + 3] = bfhi(w_[1]); dst[o + 4] = bflo(w_[2]); dst[o + 5] = bfhi(w_[2]); dst[o + 6] = bflo(w_[3]); dst[o + 7] = bfhi(w_[3]); } while (0)
                UNPK(q, 0, pq0); UNPK(q, 8, pq1); UNPK(kk, 0, pk0); UNPK(kk, 8, pk1);
                if (gla) {
                    const LAS f32x4* b0 = (const LAS f32x4*)((LAS float*)(G + SC_BT) + sti * 64 + 8 * c8); const LAS f32x4* b1 = (const LAS f32x4*)((LAS float*)(G + SC_BT) + sti * 64 + 32 + 8 * c8);
                    const f32x4 x0 = b0[0], x1 = b0[1], x2 = b1[0], x3 = b1[1];
#pragma unroll
                    for (int e = 0; e < 4; ++e) { bq[e] = x0[e]; bq[4 + e] = x1[e]; bq[8 + e] = x2[e]; bq[12 + e] = x3[e]; }
#pragma unroll
                    for (int e = 0; e < 16; ++e) { const float eb = __expf(bq[e]); q[e] *= 0.125f * eb; kk[e] *= __builtin_amdgcn_rcpf(eb); }
                } else {
                    if (lat) {
                        const float* cp = ROPE + (size_t)tok * 32 + 8 * c8; const float* sp = cp + 65536;
#pragma unroll
                        for (int e = 0; e < 8; ++e) { const float c = cp[e], sn = sp[e];
                            const float q1 = q[e], q2 = q[8 + e]; q[e] = q1 * c - q2 * sn; q[8 + e] = q1 * sn + q2 * c;
                            const float k1 = kk[e], k2 = kk[8 + e]; kk[e] = k1 * c - k2 * sn; kk[8 + e] = k1 * sn + k2 * c; }
                    }
                    const float bb = (float)(sti + 1) * lgr, eb = __expf(bb), ek = 0.125f * __builtin_amdgcn_rcpf(eb);
#pragma unroll
                    for (int e = 0; e < 16; ++e) { q[e] *= eb; kk[e] *= ek; }
                }
                *(LAS v4u*)(G + SC_QD + vst(sti, 8 * c8, 2)) = (v4u){pk2(q[0], q[1]), pk2(q[2], q[3]), pk2(q[4], q[5]), pk2(q[6], q[7])};
                *(LAS v4u*)(G + SC_QD + vst(sti, 32 + 8 * c8, 2)) = (v4u){pk2(q[8], q[9]), pk2(q[10], q[11]), pk2(q[12], q[13]), pk2(q[14], q[15])};
                *(LAS v4u*)(G + SC_KI + vst(sti, 8 * c8, 2)) = (v4u){pk2(kk[0], kk[1]), pk2(kk[2], kk[3]), pk2(kk[4], kk[5]), pk2(kk[6], kk[7])};
                *(LAS v4u*)(G + SC_KI + vst(sti, 32 + 8 * c8, 2)) = (v4u){pk2(kk[8], kk[9]), pk2(kk[10], kk[11]), pk2(kk[12], kk[13]), pk2(kk[14], kk[15])};
#pragma unroll
                for (int m = 0; m < 4; ++m) *(LAS v4u*)(G + SC_VT + vst(sti, c8 * 32 + 8 * m, 4)) = pv[m];
            }
            LDS_WAIT(); __syncthreads();
            bf16x8 qf[4]; bf16x8 pa0, pa1, pa2, pa3;
            { const int qb_ = vst_row(32 * ri + r32, 2) + 16 * hi;
              qf[0] = *(const LAS bf16x8*)(G + SC_QD + qb_); qf[1] = *(const LAS bf16x8*)(G + SC_QD + qb_ + 32); qf[2] = *(const LAS bf16x8*)(G + SC_QD + qb_ + 512); qf[3] = *(const LAS bf16x8*)(G + SC_QD + qb_ + 544); }
            { f32x16 p0 = {}, p1 = {};
              const int kb0 = vst_row(r32, 2) + 16 * hi, kb1 = vst_row(32 + r32, 2) + 16 * hi;
              { const bf16x8 a0 = *(const LAS bf16x8*)(G + SC_KI + kb0), a1 = *(const LAS bf16x8*)(G + SC_KI + kb0 + 32), a2 = *(const LAS bf16x8*)(G + SC_KI + kb0 + 512), a3 = *(const LAS bf16x8*)(G + SC_KI + kb0 + 544);
                p0 = __builtin_amdgcn_mfma_f32_32x32x16_bf16(a0, qf[0], p0, 0, 0, 0); p0 = __builtin_amdgcn_mfma_f32_32x32x16_bf16(a1, qf[1], p0, 0, 0, 0);
                p0 = __builtin_amdgcn_mfma_f32_32x32x16_bf16(a2, qf[2], p0, 0, 0, 0); p0 = __builtin_amdgcn_mfma_f32_32x32x16_bf16(a3, qf[3], p0, 0, 0, 0); }
              if (ri == 1) {
                  const bf16x8 c0 = *(const LAS bf16x8*)(G + SC_KI + kb1), c1 = *(const LAS bf16x8*)(G + SC_KI + kb1 + 32), c2 = *(const LAS bf16x8*)(G + SC_KI + kb1 + 512), c3 = *(const LAS bf16x8*)(G + SC_KI + kb1 + 544);
                  p1 = __builtin_amdgcn_mfma_f32_32x32x16_bf16(c0, qf[0], p1, 0, 0, 0); p1 = __builtin_amdgcn_mfma_f32_32x32x16_bf16(c1, qf[1], p1, 0, 0, 0);
                  p1 = __builtin_amdgcn_mfma_f32_32x32x16_bf16(c2, qf[2], p1, 0, 0, 0); p1 = __builtin_amdgcn_mfma_f32_32x32x16_bf16(c3, qf[3], p1, 0, 0, 0); }
#pragma unroll
              for (int r = 0; r < 16; ++r) { const bool keep = crow(r, hi) <= r32; if (ri == 0) { p0[r] = keep ? p0[r] : 0.f; } else { p1[r] = keep ? p1[r] : 0.f; } }
              PK4(p0, 0, pa0); PK4(p0, 8, pa1); PK4(p1, 0, pa2); PK4(p1, 8, pa3); }
            const unsigned vb = gaddr + SC_VT + v_rd_base(lane) + dh * 1024, sbv = gaddr + SC_ST + v_rd_base(lane) + dh * 1024;
#define SC_FR4(dst, base, d) do { const s16x4 l0_ = tr_read<(d) * 512>(base), h0_ = tr_read<(d) * 512 + 2048>(base), l1_ = tr_read<(d) * 512 + 4096>(base), h1_ = tr_read<(d) * 512 + 4096 + 2048>(base); \
              const s16x4 l2_ = tr_read<(d) * 512 + 8192>(base), h2_ = tr_read<(d) * 512 + 8192 + 2048>(base), l3_ = tr_read<(d) * 512 + 12288>(base), h3_ = tr_read<(d) * 512 + 12288 + 2048>(base); \
              asm volatile("s_waitcnt lgkmcnt(0)" ::: "memory"); SBAR(); \
              dst[0] = PKF(l0_, h0_); dst[1] = PKF(l1_, h1_); dst[2] = PKF(l2_, h2_); dst[3] = PKF(l3_, h3_); } while (0)
#define SC_OBLK(d) do { bf16x8 vf_[4], sf_[4]; SC_FR4(vf_, vb, d); SC_FR4(sf_, sbv, d); f32x16 o_ = {}; \
              o_ = __builtin_amdgcn_mfma_f32_32x32x16_bf16(pa0, vf_[0], o_, 0, 0, 0); o_ = __builtin_amdgcn_mfma_f32_32x32x16_bf16(pa1, vf_[1], o_, 0, 0, 0); \
              if (ri == 1) { o_ = __builtin_amdgcn_mfma_f32_32x32x16_bf16(pa2, vf_[2], o_, 0, 0, 0); o_ = __builtin_amdgcn_mfma_f32_32x32x16_bf16(pa3, vf_[3], o_, 0, 0, 0); } \
              o_ = __builtin_amdgcn_mfma_f32_32x32x16_bf16(qf[0], sf_[0], o_, 0, 0, 0); o_ = __builtin_amdgcn_mfma_f32_32x32x16_bf16(qf[1], sf_[1], o_, 0, 0, 0); \
              o_ = __builtin_amdgcn_mfma_f32_32x32x16_bf16(qf[2], sf_[2], o_, 0, 0, 0); o_ = __builtin_amdgcn_mfma_f32_32x32x16_bf16(qf[3], sf_[3], o_, 0, 0, 0); \
              char* dst_ = (char*)(dir == 0 ? OF : OB); \
              _Pragma("unroll") for (int r = 0; r < 16; ++r) { const int i_ = 32 * ri + crow(r, hi); const int t_ = dir == 0 ? 64 * s + i_ : L - 1 - (64 * s + i_); \
                  *(bf16*)(dst_ + ((unsigned)(row0 + t_) * (unsigned)(D * 2) + (unsigned)(hh * 128 + 64 * dh + 32 * (d) + r32) * 2u)) = (bf16)f2bf(o_[r]); } SBAR(); } while (0)
            SC_OBLK(0); SC_OBLK(1);
            __syncthreads();
            if (s + 1 < NC) SC_LOAD(s + 1);
            { const unsigned kt = gaddr + SC_KI + v_rd_base(lane) + ri * 512;
              bf16x8 kf[4];
              { const s16x4 l0_ = tr_read<0>(kt), h0_ = tr_read<1024>(kt), l1_ = tr_read<2048>(kt), h1_ = tr_read<2048 + 1024>(kt), l2_ = tr_read<4096>(kt), h2_ = tr_read<4096 + 1024>(kt), l3_ = tr_read<6144>(kt), h3_ = tr_read<6144 + 1024>(kt);
                asm volatile("s_waitcnt lgkmcnt(0)" ::: "memory"); SBAR();
                kf[0] = PKF(l0_, h0_); kf[1] = PKF(l1_, h1_); kf[2] = PKF(l2_, h2_); kf[3] = PKF(l3_, h3_); }
              const int stb_ = (hi + 4 * ri) * 2048 + (2 * dh) * 512 + r32 * 2;
#define SC_SBLK(d) do { bf16x8 vf_[4]; SC_FR4(vf_, vb, d); \
              _Pragma("unroll") for (int ks = 0; ks < 4; ++ks) sacc[d] = __builtin_amdgcn_mfma_f32_32x32x16_bf16(kf[ks], vf_[ks], sacc[d], 0, 0, 0); \
              _Pragma("unroll") for (int r = 0; r < 16; ++r) { const int dk = 32 * ri + crow(r, hi); const float dl = ((LAS float*)(G + SC_DL))[dk]; \
                  sacc[d][r] *= dl; *(LAS unsigned short*)(G + SC_ST + stb_ + (d) * 512 + ((r >> 3) & 1) * 4096 + ((r & 3) + 4 * ((r >> 2) & 1)) * 64) = (unsigned short)f2bf(sacc[d][r]); } SBAR(); } while (0)
              SC_SBLK(0); SC_SBLK(1); }
        }
        if (!lat) { int l2 = F.lane; asm volatile("" : "+v"(l2)); const int r32 = l2 & 31, hi = l2 >> 5; float* SO = POUT + (gla ? OUT_SGLA : OUT_SRET) + ((size_t)((sb * 2 + li) * 2 + dir) * 4 + h) * 8192;
#pragma unroll
            for (int d = 0; d < 2; ++d)
#pragma unroll
                for (int r = 0; r < 16; ++r) SO[(32 * ri + crow(r, hi)) * 128 + 32 * (2 * dh + d) + r32] = sacc[d][r]; }
        VM_WAIT(); __syncthreads();
        { int l3 = F.lane; asm volatile("" : "+v"(l3));
          const int gcol = (gla ? PC_GA : PC_GB) + h * 128, dv = (l3 & 15) * 8;
          f32x4 gn0 = (f32x4){1.f, 1.f, 1.f, 1.f}, gn1 = gn0;
          if (gla) { const float* gp_ = PIN(I_GLAN); gn0 = *(const f32x4*)(gp_ + li * 128 + dv); gn1 = *(const f32x4*)(gp_ + li * 128 + dv + 4); }
          for (int t0 = F.wave * 4 + (l3 >> 4); t0 < L; t0 += 128) {
              v4u a[4], b[4], g[4];
#pragma unroll
              for (int i = 0; i < 4; ++i) { const unsigned off = ((unsigned)(row0 + t0 + 32 * i) * (unsigned)D + (unsigned)(hh * 128 + dv)) * 2u;
                  a[i] = *(const v4u*)((const char*)OF + off); b[i] = *(const v4u*)((const char*)OB + off);
                  g[i] = *(const v4u*)((const char*)PROJ + ((unsigned)(row0 + t0 + 32 * i) * (unsigned)EVEN_NP + (unsigned)(gcol + dv)) * 2u); }
#pragma unroll
              for (int i = 0; i < 4; ++i) { const unsigned off = ((unsigned)(row0 + t0 + 32 * i) * (unsigned)D + (unsigned)(hh * 128 + dv)) * 2u;
                  float x[8], gg[8];
                  x[0] = bflo(a[i].x) + bflo(b[i].x); x[1] = bfhi(a[i].x) + bfhi(b[i].x); x[2] = bflo(a[i].y) + bflo(b[i].y); x[3] = bfhi(a[i].y) + bfhi(b[i].y);
                  x[4] = bflo(a[i].z) + bflo(b[i].z); x[5] = bfhi(a[i].z) + bfhi(b[i].z); x[6] = bflo(a[i].w) + bflo(b[i].w); x[7] = bfhi(a[i].w) + bfhi(b[i].w);
                  gg[0] = bflo(g[i].x); gg[1] = bfhi(g[i].x); gg[2] = bflo(g[i].y); gg[3] = bfhi(g[i].y); gg[4] = bflo(g[i].z); gg[5] = bfhi(g[i].z); gg[6] = bflo(g[i].w); gg[7] = bfhi(g[i].w);
                  float ss = 0.f;
#pragma unroll
                  for (int e = 0; e < 8; ++e) ss += x[e] * x[e];
                  ss += __shfl_xor(ss, 1); ss += __shfl_xor(ss, 2); ss += __shfl_xor(ss, 4); ss += __shfl_xor(ss, 8);
                  const float rstd = __builtin_amdgcn_rsqf(ss * (1.0f / 128.0f) + EPS);
#pragma unroll
                  for (int e = 0; e < 8; ++e) x[e] = x[e] * rstd * (e < 4 ? gn0[e] : gn1[e - 4]) * siluf(gg[e]);
                  *(v4u*)((char*)OB + off) = (v4u){pk2(x[0], x[1]), pk2(x[2], x[3]), pk2(x[4], x[5]), pk2(x[6], x[7])}; }
          } }
    }
#undef SC_TOK
#undef SC_LOAD
#undef UNPK
#undef SC_FR4
#undef SC_OBLK
#undef SC_SBLK
}

__device__ __forceinline__ void kpe_pass(Frame& F, const Params& P, int li) {
    unsigned char* ws = PWS;
    const float* KR = (const float*)(ws + WS_Y); const float* ROPE = (const float*)(ws + WS_ROPE);
    bf16* KPE = (bf16*)(ws + WS_KPE) + (size_t)li * MKV * 64;
    const int gt = F.vcu * 512 + F.tid, NGT = F.G * 512;
    for (int i = gt; i < M * 4; i += NGT) {
        const int row = i >> 2, c8 = i & 3;
        const float* s = KR + (size_t)row * 64 + 8 * c8;
        f32x4 a0 = *(const f32x4*)s, a1 = *(const f32x4*)(s + 4), b0 = *(const f32x4*)(s + 32), b1 = *(const f32x4*)(s + 36);
        int drow = row;
        if (row >= M_CTX) { const int lb = (row - M_CTX) >> 11, t = (row - M_CTX) & 2047; drow = M_CTX + lb * LKV + PAST + t;
            const float* cp = ROPE + (size_t)t * 32 + 8 * c8; const float* sp = cp + 65536;
            const f32x4 c0 = *(const f32x4*)cp, c1 = *(const f32x4*)(cp + 4), s0 = *(const f32x4*)sp, s1 = *(const f32x4*)(sp + 4);
            const f32x4 x0 = a0 * c0 - b0 * s0, x1 = a1 * c1 - b1 * s1, y0 = a0 * s0 + b0 * c0, y1 = a1 * s1 + b1 * c1;
            a0 = x0; a1 = x1; b0 = y0; b1 = y1; }
        bf16* d = KPE + (size_t)drow * 64 + 8 * c8;
        *(v4u*)d = (v4u){pk2(a0[0], a0[1]), pk2(a0[2], a0[3]), pk2(a1[0], a1[1]), pk2(a1[2], a1[3])};
        *(v4u*)(d + 32) = (v4u){pk2(b0[0], b0[1]), pk2(b0[2], b0[3]), pk2(b1[0], b1[1]), pk2(b1[2], b1[3])};
    }
}

constexpr float ATT_SCALE = 0.07216878364870322f;
constexpr float ATT_THR = 8.f;
constexpr int AT_V = 0, AT_KN = 32768, AT_KP = 65536, AT_WS = 81920, AT_VB = 16384, AT_KNB = 16384, AT_KPB = 8192;
#define KSWZ(row, colB) ((row) * 256 + ((colB) ^ (((row) & 7) << 4)))
#define KPSWZ(row, colB) ((row) * 128 + ((colB) ^ (((row) & 7) << 4)))
__device__ __forceinline__ void at_partialSM(f32x16& p0, f32x16& p1, float& m_reg, float& mn, float& alpha) {
    constexpr float C = ATT_SCALE * 1.4426950408889634f;
    float pmax = p0[0];
#pragma unroll
    for (int r = 1; r < 16; ++r) pmax = fmaxf(pmax, p0[r]);
#pragma unroll
    for (int r = 0; r < 16; ++r) pmax = fmaxf(pmax, p1[r]);
    { auto rr = __builtin_amdgcn_permlane32_swap(__float_as_uint(pmax), __float_as_uint(pmax), false, false); pmax = fmaxf(__uint_as_float(rr[0]), __uint_as_float(rr[1])); }
    if (__builtin_expect(__all(pmax - m_reg <= ATT_THR / ATT_SCALE), 1)) { mn = m_reg; alpha = 1.f; }
    else { mn = fmaxf(m_reg, pmax); alpha = __builtin_amdgcn_exp2f((m_reg - mn) * C); m_reg = mn; }
    const float mnC = -mn * C;
#pragma unroll
    for (int r = 0; r < 16; ++r) p0[r] = fmaf(p0[r], C, mnC);
#pragma unroll
    for (int r = 0; r < 16; ++r) p1[r] = fmaf(p1[r], C, mnC);
#pragma unroll
    for (int r = 0; r < 16; ++r) p0[r] = __builtin_amdgcn_exp2f(p0[r]);
}
__device__ __forceinline__ void at_finishSM(f32x16& p0, f32x16& p1, float alpha, float& l_reg, bf16x8& pa0, bf16x8& pa1, bf16x8& pa2, bf16x8& pa3) {
#pragma unroll
    for (int r = 0; r < 16; ++r) p1[r] = __builtin_amdgcn_exp2f(p1[r]);
    float ps = 0;
#pragma unroll
    for (int r = 0; r < 16; ++r) ps += p0[r];
#pragma unroll
    for (int r = 0; r < 16; ++r) ps += p1[r];
    { auto rr = __builtin_amdgcn_permlane32_swap(__float_as_uint(ps), __float_as_uint(ps), false, false); ps = __uint_as_float(rr[0]) + __uint_as_float(rr[1]); }
    l_reg = l_reg * alpha + ps;
    PK4(p0, 0, pa0); PK4(p0, 8, pa1); PK4(p1, 0, pa2); PK4(p1, 8, pa3);
}
__device__ __forceinline__ void at_qkt(f32x16& p0, f32x16& p1, const LAS unsigned char* Kn, const LAS unsigned char* Kp, const bf16x8* qr, const int* kb, const int* pb) {
    p0 = f32x16{}; p1 = f32x16{};
#pragma unroll
    for (int d0 = 0; d0 < 8; ++d0) {
        const bf16x8 b0 = *(const LAS bf16x8*)(Kn + kb[d0 & 3] + 128 * (d0 >> 2)), b1 = *(const LAS bf16x8*)(Kn + kb[d0 & 3] + 128 * (d0 >> 2) + 8192);
        p0 = __builtin_amdgcn_mfma_f32_32x32x16_bf16(b0, qr[d0], p0, 0, 0, 0);
        p1 = __builtin_amdgcn_mfma_f32_32x32x16_bf16(b1, qr[d0], p1, 0, 0, 0); }
#pragma unroll
    for (int d0 = 0; d0 < 4; ++d0) {
        const bf16x8 b0 = *(const LAS bf16x8*)(Kp + pb[d0]), b1 = *(const LAS bf16x8*)(Kp + pb[d0] + 4096);
        p0 = __builtin_amdgcn_mfma_f32_32x32x16_bf16(b0, qr[8 + d0], p0, 0, 0, 0);
        p1 = __builtin_amdgcn_mfma_f32_32x32x16_bf16(b1, qr[8 + d0], p1, 0, 0, 0); }
}
template <int D0> __device__ __forceinline__ void at_pv_one(f32x16& od, unsigned vb, bf16x8 pa0, bf16x8 pa1, bf16x8 pa2, bf16x8 pa3) {
    const s16x4 l0 = tr_read<D0 * 512>(vb), h0 = tr_read<D0 * 512 + 2048>(vb), l1 = tr_read<D0 * 512 + 4096>(vb), h1 = tr_read<D0 * 512 + 4096 + 2048>(vb);
    const s16x4 l2 = tr_read<D0 * 512 + 8192>(vb), h2 = tr_read<D0 * 512 + 8192 + 2048>(vb), l3 = tr_read<D0 * 512 + 12288>(vb), h3 = tr_read<D0 * 512 + 12288 + 2048>(vb);
    asm volatile("s_waitcnt lgkmcnt(0)" ::: "memory"); SBAR();
    od = __builtin_amdgcn_mfma_f32_32x32x16_bf16(pa0, PKF(l0, h0), od, 0, 0, 0);
    od = __builtin_amdgcn_mfma_f32_32x32x16_bf16(pa1, PKF(l1, h1), od, 0, 0, 0);
    od = __builtin_amdgcn_mfma_f32_32x32x16_bf16(pa2, PKF(l2, h2), od, 0, 0, 0);
    od = __builtin_amdgcn_mfma_f32_32x32x16_bf16(pa3, PKF(l3, h3), od, 0, 0, 0);
}
__device__ __forceinline__ void at_pv(f32x16* o, unsigned vb, bf16x8 pa0, bf16x8 pa1, bf16x8 pa2, bf16x8 pa3) {
    at_pv_one<0>(o[0], vb, pa0, pa1, pa2, pa3); at_pv_one<1>(o[1], vb, pa0, pa1, pa2, pa3); at_pv_one<2>(o[2], vb, pa0, pa1, pa2, pa3); at_pv_one<3>(o[3], vb, pa0, pa1, pa2, pa3);
}
__device__ __forceinline__ void attn_unit(Frame& F, const bf16* Qrow0  , const bf16* KVh  , const bf16* KPEs  ,
                                          bf16* Orow0, int nkeys, const float* ROPE, int tpos0  ) {
    LAS unsigned char* lds = F.lds;
    const int tid = F.tid, wid = F.wave, lane = F.lane, r32 = lane & 31, hi = lane >> 5;
    LAS float* wsf = (LAS float*)(lds + AT_WS) + wid * 64; LAS float* li_l = wsf; LAS float* al_l = wsf + 32;
    float m_reg = -1e30f, l_reg = 0; f32x16 o[4] = {}; bf16x8 qr[12];
    { const bf16* Qw = Qrow0 + (size_t)(wid * 32 + r32) * 1536 + hi * 8;
#pragma unroll
      for (int d0 = 0; d0 < 12; ++d0) qr[d0] = *(const bf16x8*)(Qw + d0 * 16);
      if (tpos0 >= 0) {
          const int t = tpos0 + wid * 32 + r32;
#pragma unroll
          for (int half = 0; half < 2; ++half) {
              const float* cp = ROPE + (size_t)t * 32 + 16 * half + 8 * hi; const float* sp = cp + 65536;
              const v4u xa = __builtin_bit_cast(v4u, qr[8 + half]), xb = __builtin_bit_cast(v4u, qr[10 + half]);
              float x1[8], x2[8];
              x1[0] = bflo(xa.x); x1[1] = bfhi(xa.x); x1[2] = bflo(xa.y); x1[3] = bfhi(xa.y); x1[4] = bflo(xa.z); x1[5] = bfhi(xa.z); x1[6] = bflo(xa.w); x1[7] = bfhi(xa.w);
              x2[0] = bflo(xb.x); x2[1] = bfhi(xb.x); x2[2] = bflo(xb.y); x2[3] = bfhi(xb.y); x2[4] = bflo(xb.z); x2[5] = bfhi(xb.z); x2[6] = bflo(xb.w); x2[7] = bfhi(xb.w);
              float y1[8], y2[8];
#pragma unroll
              for (int j = 0; j < 8; ++j) { const float c = cp[j], s = sp[j]; y1[j] = x1[j] * c - x2[j] * s; y2[j] = x1[j] * s + x2[j] * c; }
              const v4u wa = {pk2(y1[0], y1[1]), pk2(y1[2], y1[3]), pk2(y1[4], y1[5]), pk2(y1[6], y1[7])}, wb = {pk2(y2[0], y2[1]), pk2(y2[2], y2[3]), pk2(y2[4], y2[5]), pk2(y2[6], y2[7])};
              if (half == 0) { qr[8] = __builtin_bit_cast(bf16x8, wa); qr[10] = __builtin_bit_cast(bf16x8, wb); } else { qr[9] = __builtin_bit_cast(bf16x8, wa); qr[11] = __builtin_bit_cast(bf16x8, wb); }
          }
      } }
    const unsigned vb0 = (unsigned)(uintptr_t)(lds + AT_V) + v_rd_base(lane);
#define AT_OPQ() int l_ = lane; asm volatile("" : "+v"(l_))
#define AT_KADDR() int kbs[4], pbs[4]; { AT_OPQ(); _Pragma("unroll") for (int b = 0; b < 4; ++b) { const int x = (32 * b + 16 * (l_ >> 5)) ^ ((l_ & 7) << 4); kbs[b] = (l_ & 31) * 256 + x; pbs[b] = (l_ & 31) * 128 + x; } }
#define AT_GLDS(gp, ldsoff) __builtin_amdgcn_global_load_lds((const unsigned*)(gp), (LAS unsigned*)(lds + (ldsoff)), 16, 0, 0)
#define AT_DMA_K(t, b) do { AT_OPQ(); const char* kb_ = (const char*)KVh + (size_t)(t) * (64 * 4096); const char* pb_ = (const char*)KPEs + (size_t)(t) * (64 * 128); \
    const int row0_ = 4 * wid + (l_ >> 4), cB0_ = ((l_ & 15) * 16) ^ ((row0_ & 7) << 4), row1_ = row0_ + 32, rowp_ = 8 * wid + (l_ >> 3), cBp_ = ((l_ & 7) * 16) ^ ((rowp_ & 7) << 4); \
    AT_GLDS(kb_ + (unsigned)(row0_ * 4096 + cB0_), AT_KN + (b) * AT_KNB + wid * 1024); AT_GLDS(kb_ + (unsigned)(row1_ * 4096 + cB0_), AT_KN + (b) * AT_KNB + (wid + 8) * 1024); \
    AT_GLDS(pb_ + (unsigned)(rowp_ * 128 + cBp_), AT_KP + (b) * AT_KPB + wid * 1024); } while (0)
#define AT_DMA_V(t, b) do { AT_OPQ(); const char* vb_ = (const char*)KVh + (size_t)(t) * (64 * 4096); \
    const int st_ = 2 * wid + (l_ >> 5), kk_ = (st_ >> 2) * 8 + ((l_ & 31) >> 2), key_ = (kk_ & ~0xC) | ((kk_ & 4) << 1) | ((kk_ & 8) >> 1), col_ = (st_ & 3) * 32 + (l_ & 3) * 8; \
    AT_GLDS(vb_ + (unsigned)(key_ * 4096 + (128 + col_) * 2), AT_V + (b) * AT_VB + wid * 1024); AT_GLDS(vb_ + (unsigned)((key_ + 32) * 4096 + (128 + col_) * 2), AT_V + (b) * AT_VB + (wid + 8) * 1024); } while (0)
#define AT_RESC(a) do { if (__any((a) < 1.f)) { if (hi == 0) al_l[r32] = (a); asm volatile("s_waitcnt lgkmcnt(0)" ::: "memory"); \
    _Pragma("unroll") for (int d = 0; d < 4; ++d) _Pragma("unroll") for (int r = 0; r < 16; ++r) o[d][r] *= al_l[crow(r, hi)]; } } while (0)
#define AT_SYNC() do { VM_WAIT(); __syncthreads(); } while (0)
    f32x16 pA0, pA1, pB0, pB1; float mnA, mnB, alA, alB; bf16x8 pa0, pa1, pa2, pa3; const int NT = nkeys / 64;
    const LAS unsigned char* Kn0 = lds + AT_KN; const LAS unsigned char* Kn1 = lds + AT_KN + AT_KNB; const LAS unsigned char* Kp0 = lds + AT_KP; const LAS unsigned char* Kp1 = lds + AT_KP + AT_KPB;
    AT_DMA_K(0, 0); AT_SYNC();
    AT_DMA_K(1, 1); AT_DMA_V(0, 0);
    { AT_KADDR(); at_qkt(pA0, pA1, Kn0, Kp0, qr, kbs, pbs); } at_partialSM(pA0, pA1, m_reg, mnA, alA);
    AT_SYNC();
    for (int j = 1; j + 1 < NT; j += 2) {
        AT_DMA_K(j + 1, 0); AT_DMA_V(j, 1);
        SBAR(); { AT_KADDR(); at_qkt(pB0, pB1, Kn1, Kp1, qr, kbs, pbs); }
        at_finishSM(pA0, pA1, alA, l_reg, pa0, pa1, pa2, pa3); SBAR();
        at_pv(o, vb0, pa0, pa1, pa2, pa3); at_partialSM(pB0, pB1, m_reg, mnB, alB);
        AT_RESC(alB); AT_SYNC();
        AT_DMA_K(j + 2, 1); AT_DMA_V(j + 1, 0);
        SBAR(); { AT_KADDR(); at_qkt(pA0, pA1, Kn0, Kp0, qr, kbs, pbs); }
        at_finishSM(pB0, pB1, alB, l_reg, pa0, pa1, pa2, pa3); SBAR();
        at_pv(o, vb0 + AT_VB, pa0, pa1, pa2, pa3); at_partialSM(pA0, pA1, m_reg, mnA, alA);
        AT_RESC(alA); AT_SYNC();
    }
    AT_DMA_V(NT - 1, 1);
    SBAR(); { AT_KADDR(); at_qkt(pB0, pB1, Kn1, Kp1, qr, kbs, pbs); }
    at_finishSM(pA0, pA1, alA, l_reg, pa0, pa1, pa2, pa3); SBAR();
    at_pv(o, vb0, pa0, pa1, pa2, pa3); at_partialSM(pB0, pB1, m_reg, mnB, alB);
    AT_RESC(alB); AT_SYNC();
    at_finishSM(pB0, pB1, alB, l_reg, pa0, pa1, pa2, pa3); SBAR();
    at_pv(o, vb0 + AT_VB, pa0, pa1, pa2, pa3);
    if (hi == 0) li_l[r32] = l_reg; asm volatile("s_waitcnt lgkmcnt(0)" ::: "memory");
    float rli[16];
#pragma unroll
    for (int r = 0; r < 16; ++r) rli[r] = __builtin_amdgcn_rcpf(li_l[crow(r, hi)]);
    bf16* Ow = Orow0 + (size_t)(wid * 32) * D;
#pragma unroll
    for (int r = 0; r < 16; ++r) { const int orow = crow(r, hi);
#pragma unroll
        for (int d0 = 0; d0 < 4; ++d0) Ow[(size_t)orow * D + d0 * 32 + r32] = (bf16)f2bf(o[d0][r] * rli[r]); }
#undef AT_GLDS
#undef AT_OPQ
#undef AT_KADDR
#undef AT_DMA_K
#undef AT_DMA_V
#undef AT_RESC
#undef AT_SYNC
}
__device__ __forceinline__ void attn_phase(Frame& F, const Params& P, int li) {
    unsigned char* ws = PWS;
    const bf16* Q = (const bf16*)(ws + WS_Q); const bf16* KV = (const bf16*)(ws + WS_KV); const bf16* KPE = (const bf16*)(ws + WS_KPE) + (size_t)li * MKV * 64;
    bf16* OB = (bf16*)(ws + WS_HB); const float* ROPE = (const float*)(ws + WS_ROPE);
    for (int u = F.vcu; u < 256 + 128; u += F.G) {
        for (int k = 0; k < 2; ++k) {
            int qrow0, kvrow0, nkeys, h, tpos0;
            if (u < 256) { const int id = 2 * u + k, lb = id >> 6, qb = id & 7; h = (id >> 3) & 7; qrow0 = M_CTX + lb * L_LAT + qb * 256; kvrow0 = M_CTX + lb * LKV; nkeys = LKV; tpos0 = qb * 256; }
            else { if (k == 1) break; const int id = u - 256, b = id >> 3; h = id & 7; qrow0 = b * L_CTX; kvrow0 = b * L_CTX; nkeys = L_CTX; tpos0 = -1; }
            __syncthreads();
            attn_unit(F, Q + (size_t)qrow0 * 1536 + h * 192, KV + (size_t)kvrow0 * 2048 + h * 256, KPE + (size_t)kvrow0 * 64, OB + (size_t)qrow0 * D + h * 128, nkeys, ROPE, tpos0);
        }
    }
}

constexpr int N_PHASES = 2 + 2 * 15;
__global__ void __launch_bounds__(NWAVES * 64, 2) hyb_fwd(Params P) {
    extern __shared__ __attribute__((aligned(16))) unsigned char lds_raw[];
    Frame F;
    F.lds = (LAS unsigned char*)lds_raw;
    F.tid = threadIdx.x; F.lane = F.tid & 63; F.wave = __builtin_amdgcn_readfirstlane(F.tid >> 6);
    F.G = gridDim.x; { const int bx = blockIdx.x; F.vcu = (F.G % 8 == 0) ? (bx % 8) * (F.G / 8) + bx / 8 : bx; }
    volatile LAS unsigned* MISC = (volatile LAS unsigned*)(F.lds + LDS_MISC);
    if (F.tid < 64) MISC[F.tid] = 0u;
    if (F.tid < 30) { const unsigned long long v = F.tid < 28 ? (unsigned long long)P.in[F.tid] : (F.tid == 28 ? (unsigned long long)P.out : (unsigned long long)P.ws);
        volatile LAS unsigned* pt = (volatile LAS unsigned*)(F.lds + LDS_PT) + 2 * F.tid; pt[0] = (unsigned)v; pt[1] = (unsigned)(v >> 32); }
    __syncthreads();
    const int use_bar = P.use_bar, ph_hi = P.ph_hi;
    XcdBarrier bar; bar.bar = (unsigned*)(PWS + WS_CTL) + 4096; bar.x = 0; bar.st = nullptr;
    if (use_bar) bar = xcd_barrier_post((unsigned*)(PWS + WS_CTL) + 4096, MISC + 8);

    int dup_done = 0; (void)dup_done;
    for (int ph = P.ph_lo; ph < ph_hi; ++ph) {
#define REFRESH_ID() do { int t_ = threadIdx.x; asm volatile("" : "+v"(t_)); F.tid = t_; F.lane = t_ & 63; F.wave = __builtin_amdgcn_readfirstlane(t_ >> 6); \
          int g_ = gridDim.x, b_ = blockIdx.x; asm volatile("" : "+s"(g_), "+s"(b_)); F.G = g_; F.vcu = (g_ % 8 == 0) ? (b_ % 8) * (g_ / 8) + b_ / 8 : b_; F.bid = b_; } while (0)
        REFRESH_ID();
        unsigned char* ws = PWS;
        float* XO = POUT + OUT_Y;
        bf16* HB = (bf16*)(ws + WS_HB); bf16* YB = (bf16*)(ws + WS_Y); float* SS = (float*)(ws + WS_SS);
        const float* MOD = (const float*)(ws + WS_MOD);
        if (ph == 0) { p0_prologue(F, P); }
        else if (ph == 1) {
            const float* m0 = MOD;
            row_pass(F, PIN(I_XP), PIN(I_XS), nullptr, nullptr, nullptr, nullptr, nullptr, PIN(I_NMIXPRE), m0 + 1024, m0, HB, false, true);
        } else {
            const int q = ph - 2, pair = q / 15, r = q % 15; const bool odd = r >= 7; const int l = 2 * pair + (odd ? 1 : 0), k = odd ? r - 7 : r;
            const float* ml = MOD + (size_t)l * 9 * 6144;
            const int kind = odd ? (k == 0 ? 10 : k == 1 ? 11 : k == 2 ? 12 : k - 1) : k;
            if (kind == 0) {
                pg8::Gemm g{HB, (const bf16*)(ws + WS_WINE) + (size_t)pair * EVEN_NP * 1024, M, EVEN_NP, 1024}; pg8::StaticOrder S; S.init(M, EVEN_NP, F.G, F.bid);
                pg8::EpiBf16<0> E{(bf16*)(ws + WS_BIG), EVEN_NP};
                pg8::gemm_phase<pg8::EpiBf16<0>, pg8::StaticOrder, true, true>(F.lds, g, S, E, F.tid);
            } else if (kind == 1) {
                scan_phase(F, P, pair);
            } else if (kind == 2) {
                const bf16* W = odd ? (const bf16*)(ws + WS_WOUTO) + (size_t)pair * 1024 * 1024 : (const bf16*)(ws + WS_WOUTE) + (size_t)pair * 1024 * 1024;
                pg8::Gemm g{HB, W, M, 1024, 1024}; pg8::StaticOrder S; S.init(M, 1024, F.G, F.bid);
                pg8::EpiYss E{YB, SS};
                pg8::gemm_phase<pg8::EpiYss, pg8::StaticOrder, true, true>(F.lds, g, S, E, F.tid);
            } else if (kind == 3) {
                const float* xa = l == 0 ? PIN(I_XP) : XO; const float* xb = l == 0 ? PIN(I_XS) : XO + (size_t)M_CTX * D;
                row_pass(F, xa, xb, XO, YB, SS, PIN(I_NMIXPOST) + l * 1024, ml + 2048, PIN(I_NMLPPRE) + l * 1024, ml + 4096, ml + 3072, HB, true, true);
            } else if (kind == 4) {
                pg8::Gemm g{HB, (const bf16*)(ws + WS_W1) + (size_t)l * 4096 * 1024, M, FF, 1024}; pg8::StaticOrder S; S.init(M, FF, F.G, F.bid);
                pg8::EpiBf16<1> E{(bf16*)(ws + WS_BIG), FF};
                pg8::gemm_phase<pg8::EpiBf16<1>, pg8::StaticOrder, true, true>(F.lds, g, S, E, F.tid);
            } else if (kind == 5) {
                pg8::Gemm g{(const bf16*)(ws + WS_BIG), (const bf16*)(ws + WS_W2) + (size_t)l * 1024 * 4096, M, 1024, FF}; pg8::StaticOrder S; S.init(M, 1024, F.G, F.bid);
                pg8::EpiYss E{YB, SS};
                pg8::gemm_phase<pg8::EpiYss, pg8::StaticOrder, true, true>(F.lds, g, S, E, F.tid);
            } else if (kind == 6) {
                const bool last = l == 3; const float* mn = ml + 9 * 6144; const int ln = last ? 3 : l + 1;
                row_pass(F, XO, XO + (size_t)M_CTX * D, XO, YB, SS, PIN(I_NMLPPOST) + l * 1024, ml + 5120, PIN(I_NMIXPRE) + ln * 1024, mn + 1024, mn, HB, true, !last);
            } else if (kind == 10) {
                pg8::Gemm g{HB, (const bf16*)(ws + WS_WINO) + (size_t)pair * ODD_NP * 1024, M, ODD_NP, 1024}; pg8::StaticOrder S; S.init(M, ODD_NP, F.G, F.bid);
                pg8::EpiOddIn E{(bf16*)(ws + WS_QN), (bf16*)(ws + WS_ACKV) + (size_t)pair * MKV * 256, (float*)(ws + WS_Y), POUT + OUT_CKV, POUT + OUT_KPE,
                                PIN(I_QAN) + pair * 256, PIN(I_KVAN) + pair * 256, pair};
                pg8::gemm_phase<pg8::EpiOddIn, pg8::StaticOrder, false, true>(F.lds, g, S, E, F.tid);
            } else if (kind == 11) {
                kpe_pass(F, P, pair); REFRESH_ID();
                { pg8::Gemm g{(const bf16*)(ws + WS_QN), (const bf16*)(ws + WS_WQB) + (size_t)pair * 1536 * 256, M, 1536, 256}; pg8::StaticOrder S; S.init(M, 1536, F.G, F.bid);
                  pg8::EpiBf16<0> E{(bf16*)(ws + WS_Q), 1536};
                  pg8::gemm_phase<pg8::EpiBf16<0>, pg8::StaticOrder, true, true>(F.lds, g, S, E, F.tid); }
                REFRESH_ID();
                { pg8::Gemm g{(const bf16*)(ws + WS_ACKV) + (size_t)pair * MKV * 256, (const bf16*)(ws + WS_WKVB) + (size_t)pair * 2048 * 256, MKV, 2048, 256}; pg8::StaticOrder S; S.init(MKV, 2048, F.G, F.bid);
                  pg8::EpiBf16<0> E{(bf16*)(ws + WS_KV), 2048};
                  pg8::gemm_phase<pg8::EpiBf16<0>, pg8::StaticOrder, true, true>(F.lds, g, S, E, F.tid); }
            } else if (kind == 12) {
                attn_phase(F, P, pair);
            }
        }
#if defined(HYB_DUP_KIND)
        if (ph >= 2 && dup_done == 0) { const int q_ = ph - 2, r_ = q_ % 15; const bool odd_ = r_ >= 7; const int k_ = odd_ ? r_ - 7 : r_;
            const int kind_ = odd_ ? (k_ == 0 ? 10 : k_ == 1 ? 11 : k_ == 2 ? 12 : k_ - 1) : k_;
            if (kind_ == HYB_DUP_KIND) { dup_done = 1; if (use_bar) { bar.bar = (unsigned*)(PWS + WS_CTL) + 4096; xcd_barrier(bar); } else { VM_WAIT(); __syncthreads(); } --ph; continue; } }
        dup_done = 0;
#endif
        if (ph + 1 < ph_hi) { if (use_bar) { bar.bar = (unsigned*)(PWS + WS_CTL) + 4096; xcd_barrier(bar); } else { VM_WAIT(); __syncthreads(); } }
    }
}

#ifndef HYB_N_LAUNCHES
#define HYB_N_LAUNCHES 1
#endif
extern "C" void kernel_launch(void* const* d_in, const int* in_sizes, int n_in, void* d_out, int out_size, void* d_ws, size_t ws_size, hipStream_t stream) {
    static int grid = 0;
    if (grid == 0) {
        if (n_in != 28 || out_size != 27787264 || ws_size < WS_END) { fprintf(stderr, "kernel_launch: unexpected shapes: n_in %d out %d ws %zu (need >= %zu)\n", n_in, out_size, ws_size, (size_t)WS_END); grid = -1; return; }
        int dev = 0, cus = 0, per_cu = 0;
        if (hipGetDevice(&dev) != hipSuccess || hipDeviceGetAttribute(&cus, hipDeviceAttributeMultiprocessorCount, dev) != hipSuccess) { grid = -1; return; }
        if (hipFuncSetAttribute((const void*)hyb_fwd, hipFuncAttributeMaxDynamicSharedMemorySize, LDS_BYTES) != hipSuccess) { fprintf(stderr, "kernel_launch: hipFuncSetAttribute failed\n"); grid = -1; return; }
        if (hipOccupancyMaxActiveBlocksPerMultiprocessor(&per_cu, (const void*)hyb_fwd, NWAVES * 64, LDS_BYTES) != hipSuccess || per_cu < 1) { fprintf(stderr, "kernel_launch: occupancy query reports %d\n", per_cu); }
        (void)hipGetLastError();
        grid = cus;
    }
    if (grid < 0) return;
    (void)hipMemsetAsync((char*)d_ws + WS_CTL, 0, CTL_ZERO_BYTES, stream);
    Params a{};
    for (int i = 0; i < 28; ++i) a.in[i] = (const float*)d_in[i];
    a.out = (float*)d_out; a.ws = (unsigned char*)d_ws;
#if HYB_N_LAUNCHES == 1
    a.ph_lo = 0; a.ph_hi = N_PHASES; a.use_bar = 1; a.pad = 0;
    hipLaunchKernelGGL(hyb_fwd, dim3(grid), dim3(NWAVES * 64), LDS_BYTES, stream, a);
#else
    for (int ph = 0; ph < N_PHASES; ++ph) { a.ph_lo = ph; a.ph_hi = ph + 1; a.use_bar = 0; a.pad = 0;
        hipLaunchKernelGGL(hyb_fwd, dim3(grid), dim3(NWAVES * 64), LDS_BYTES, stream, a); }
#endif
    const hipError_t le = hipPeekAtLastError();
    if (le != hipSuccess) fprintf(stderr, "kernel_launch: launch failed: %s\n", hipGetErrorName(le));
}
```

```cpp
#include <hip/hip_runtime.h>
#include <hip/hip_bf16.h>
#include <cstdio>
#include <cstdint>
namespace pg8 {
#define PG8_LAS __attribute__((address_space(3)))
typedef unsigned short bf16_t;
typedef short bf16x8 __attribute__((ext_vector_type(8)));
typedef float f32x4 __attribute__((ext_vector_type(4)));
typedef unsigned u32x4 __attribute__((ext_vector_type(4)));
constexpr int BM = 256, BK = 64, HALF = 128, HTB = HALF * BK * 2  , STAGE_BYTES = 8 * HTB, NXCD = 8, WGM = 8;

__host__ __device__ __forceinline__ int lds_byte(int r, int c) { const int st = (r >> 4) * 2 + (c >> 5), rr = r & 15, cc = c & 31, ob = rr * 64 + cc * 2; return st * 1024 + (ob ^ (((ob >> 9) & 1) << 5)); }
__host__ __device__ __forceinline__ void stage_rc(int b, int& R, int& C) { const int st = b / 1024, sb = b % 1024, swz = sb ^ (((sb >> 9) & 1) << 5); R = (st >> 1) * 16 + swz / 64; C = (st & 1) * 32 + (swz % 64) / 2; }
__host__ __device__ __forceinline__ int perm32(int rho) { const int n = rho >> 4, i = rho & 15; return 8 * (i >> 2) + 4 * n + (i & 3); }

struct Unit { int pm, pn, ks, kt0, nt; };
struct Gemm { const bf16_t* A; const bf16_t* Bt; int M, N, K; };

struct StaticOrder {
    int nM, nN, nwg, G, c, ntk;
    __host__ __device__ void init(int M, int N, int G_, int c_, int K) { nM = M / BM; nN = N / BM; nwg = nM * nN; G = G_; c = c_; ntk = K / BK; }
    __host__ __device__ bool next(int i, Unit& u) const {
        const long L = (long)i * G + c; if (L >= nwg) return false;
        int wgid = (int)L; { const int q = nwg / NXCD, r = nwg % NXCD, xcd = wgid % NXCD, off = wgid / NXCD; wgid = (xcd < r ? xcd * (q + 1) : r * (q + 1) + (xcd - r) * q) + off; }
        const int nig = WGM * nN, gid = wgid / nig, fm = gid * WGM, gsz = (nM - fm) < WGM ? (nM - fm) : WGM;
        u.pm = fm + ((wgid % nig) % gsz); u.pn = (wgid % nig) / gsz; u.ks = -1; u.kt0 = 0; u.nt = ntk; return true;
    }
    __device__ __forceinline__ void a_ready(const Unit&) const {}
    __device__ __forceinline__ void done(const Unit&) const {}
};


struct TailSplitOrder {
    int c, ntk, mode;
    __device__ void init(int c_, int K, int mode_) { c = c_; ntk = K / BK; mode = mode_; }
    __device__ bool next(int i, Unit& u) const {
        const int xcd = c & 7, j = c >> 3;
        const int round = mode == 2 ? i + 1 : i;
        if (round == 0) { u.pm = xcd * 8 + (j & 7); u.pn = j >> 3; u.ks = -1; u.kt0 = 0; u.nt = ntk; return true; }
        if (round == 1 && mode != 1) { u.pm = 64 + xcd * 2 + (j & 1); u.pn = (j >> 1) & 3; u.ks = j >> 3; u.nt = ntk >> 2; u.kt0 = u.ks * u.nt; return true; }
        return false;
    }
    __device__ __forceinline__ void a_ready(const Unit&) const {}
    __device__ __forceinline__ void done(const Unit&) const {}
};

typedef float f32x2c_t __attribute__((ext_vector_type(2))); typedef __bf16 bf16x2c_t __attribute__((ext_vector_type(2)));
__device__ __forceinline__ unsigned cvt_pk_bf16(float lo, float hi) { f32x2c_t v = {lo, hi}; bf16x2c_t b = __builtin_convertvector(v, bf16x2c_t); return __builtin_bit_cast(unsigned, b); }

template <int ACT> struct EpiBf16 {
    static constexpr bool PERM = true, AFTER_DRAIN = false;
    bf16_t* O; int ldc;
    __device__ __forceinline__ void operator()(const f32x4 (&acc)[2][2][4][2], const Unit& u, int wr, int wc, int fr, int fq) const {
        const int row0 = u.pm * BM + wr * 64 + fr; const int col0 = u.pn * BM + wc * 32 + 8 * fq;
#pragma unroll
        for (int ai = 0; ai < 2; ++ai)
#pragma unroll
            for (int m = 0; m < 4; ++m) { bf16_t* rowp = O + (size_t)(row0 + ai * HALF + m * 16) * ldc + col0;
#pragma unroll
                for (int bj = 0; bj < 2; ++bj) { f32x4 v0 = acc[ai][bj][m][0], v1 = acc[ai][bj][m][1];
                    if (ACT == 1) {
#pragma unroll
                        for (int j = 0; j < 4; ++j) { const float a = fmaxf(v0[j], 0.f), b = fmaxf(v1[j], 0.f); v0[j] = a * a; v1[j] = b * b; } }
                    u32x4 w; w.x = cvt_pk_bf16(v0[0], v0[1]); w.y = cvt_pk_bf16(v0[2], v0[3]); w.z = cvt_pk_bf16(v1[0], v1[1]); w.w = cvt_pk_bf16(v1[2], v1[3]);
                    *(u32x4*)(rowp + bj * HALF) = w; } }
    }
};
struct EpiYsplit {
    static constexpr bool PERM = true, AFTER_DRAIN = false;
    bf16_t* Y; float* SL;
    __device__ __forceinline__ void operator()(const f32x4 (&acc)[2][2][4][2], const Unit& u, int wr, int wc, int fr, int fq) const {
        const int row0 = u.pm * BM + wr * 64 + fr; const int col0 = u.pn * BM + wc * 32 + 8 * fq;
        if (u.ks < 0) {
#pragma unroll
            for (int ai = 0; ai < 2; ++ai)
#pragma unroll
                for (int m = 0; m < 4; ++m) { bf16_t* rowp = Y + (size_t)(row0 + ai * HALF + m * 16) * 1024 + col0;
#pragma unroll
                    for (int bj = 0; bj < 2; ++bj) { const f32x4 v0 = acc[ai][bj][m][0], v1 = acc[ai][bj][m][1];
                        u32x4 w; w.x = cvt_pk_bf16(v0[0], v0[1]); w.y = cvt_pk_bf16(v0[2], v0[3]); w.z = cvt_pk_bf16(v1[0], v1[1]); w.w = cvt_pk_bf16(v1[2], v1[3]);
                        *(u32x4*)(rowp + bj * HALF) = w; } }
        } else {
            float* base = SL + (size_t)u.ks * (4096 * 1024);
#pragma unroll
            for (int ai = 0; ai < 2; ++ai)
#pragma unroll
                for (int m = 0; m < 4; ++m) { float* rowp = base + (size_t)(row0 - 16384 + ai * HALF + m * 16) * 1024 + col0;
#pragma unroll
                    for (int bj = 0; bj < 2; ++bj) { *(f32x4*)(rowp + bj * HALF) = acc[ai][bj][m][0]; *(f32x4*)(rowp + bj * HALF + 4) = acc[ai][bj][m][1]; } }
        }
    }
};
struct EpiOddIn {
    static constexpr bool PERM = false, AFTER_DRAIN = true;
    bf16_t* QN; bf16_t* ACKV; float* KPERAW; float* out_ckv; float* out_kpe; const float* gq; const float* gkv; int li;
    __device__ __forceinline__ void fused(f32x4 (&acc)[2][2][4][2], const Unit& u, int wr, int wc, int fr, int fq, PG8_LAS unsigned char* lds, int wid, int lane) const {
        PG8_LAS float* P = (PG8_LAS float*)lds;
        if (u.pn < 2) {
#pragma unroll
            for (int ai = 0; ai < 2; ++ai)
#pragma unroll
                for (int m = 0; m < 4; ++m) { float s = 0.f;
#pragma unroll
                    for (int bj = 0; bj < 2; ++bj)
#pragma unroll
                        for (int n = 0; n < 2; ++n) { const f32x4 x = acc[ai][bj][m][n]; s += (x[0] * x[0] + x[1] * x[1]) + (x[2] * x[2] + x[3] * x[3]); }
                    s += __shfl_xor(s, 16); s += __shfl_xor(s, 32);
                    if (fq == 0) P[(ai * HALF + wr * 64 + m * 16 + fr) * 4 + wc] = s; }
        }
        asm volatile("s_waitcnt lgkmcnt(0)" ::: "memory"); __builtin_amdgcn_s_barrier(); asm volatile("" ::: "memory");
        if (u.pn < 2) {
            const float* gv = u.pn == 0 ? gq : gkv;
#pragma unroll
            for (int ai = 0; ai < 2; ++ai)
#pragma unroll
                for (int m = 0; m < 4; ++m) { const int r = ai * HALF + wr * 64 + m * 16 + fr; const int grow = u.pm * BM + r;
                    const float tot = (P[r * 4 + 0] + P[r * 4 + 1]) + (P[r * 4 + 2] + P[r * 4 + 3]);
                    const float rstd = 1.0f / sqrtf(tot * (1.0f / 256.0f) + 1e-6f);
                    const int drow = grow < 4096 ? grow : 4096 + ((grow - 4096) >> 11) * 2304 + 256 + ((grow - 4096) & 2047);
#pragma unroll
                    for (int bj = 0; bj < 2; ++bj)
#pragma unroll
                        for (int n = 0; n < 2; ++n) { const int col = bj * HALF + wc * 32 + n * 16 + 4 * fq; const f32x4 g = *(const f32x4*)(gv + col);
                            const f32x4 v = acc[ai][bj][m][n] * rstd * g;
                            unsigned long long w = (unsigned long long)cvt_pk_bf16(v[0], v[1]) | ((unsigned long long)cvt_pk_bf16(v[2], v[3]) << 32);
                            if (u.pn == 0) *(unsigned long long*)(QN + (size_t)grow * 256 + col) = w;
                            else { *(unsigned long long*)(ACKV + (size_t)drow * 256 + col) = w;
                                   if (grow < 4096) *(f32x4*)(out_ckv + ((size_t)((grow >> 8) * 2 + li) * 256 + (grow & 255)) * 256 + col) = v; } } }
        } else if (wc < 2) {
#pragma unroll
            for (int ai = 0; ai < 2; ++ai)
#pragma unroll
                for (int m = 0; m < 4; ++m) { const int r = ai * HALF + wr * 64 + m * 16 + fr; const int grow = u.pm * BM + r;
#pragma unroll
                    for (int n = 0; n < 2; ++n) { const int col = wc * 32 + n * 16 + 4 * fq; const f32x4 v = acc[ai][0][m][n];
                        *(f32x4*)(KPERAW + (size_t)grow * 64 + col) = v;
                        if (grow < 4096) *(f32x4*)(out_kpe + ((size_t)((grow >> 8) * 2 + li) * 256 + (grow & 255)) * 64 + col) = v; } }
        }
    }
};

template <class Epi, class Sched, bool ALIGN_EPI = false, bool SP2 = false>
__device__ __forceinline__ void gemm_phase(PG8_LAS unsigned char* lds, const Gemm g, const Sched& S, const Epi& E, const int tid) {
    const int  wid = __builtin_amdgcn_readfirstlane(tid >> 6), lane = tid & 63, wr = wid >> 2, wc = wid & 3, fr = lane & 15, fq = lane >> 4;
    const int K = g.K;
    unsigned voffA[2], voffB[2];
#pragma unroll
    for (int i = 0; i < 2; ++i) { int R, C; stage_rc(tid * 16 + i * 8192, R, C); const int Rb = Epi::PERM ? ((R & ~31) + perm32(R & 31)) : R;
        voffA[i] = (unsigned)(R * K + C) * 2u; voffB[i] = (unsigned)(Rb * K + C) * 2u; }
    const size_t kstep = (size_t)(BK * 2);
    const size_t hstep = (size_t)HALF * K * 2;
    const size_t tstep = 2 * hstep;
    const unsigned ldsw = (unsigned)wid * 1024u;
    const int aoff = lds_byte(wr * 64 + fr, fq * 8), boff = lds_byte(wc * 32 + fr, fq * 8);
#define PG8_SA(b, h) (((b) * 2 + (h)) * HTB)
#define PG8_SB(b, h) ((4 + (b) * 2 + (h)) * HTB)
#define PG8_STAGE(bufoff, gbase, voff) do { _Pragma("unroll") for (int _i = 0; _i < 2; ++_i) \
        __builtin_amdgcn_global_load_lds((const unsigned*)((const char*)(gbase) + (voff)[_i]), (PG8_LAS unsigned*)(lds + (bufoff) + ldsw + _i * 8192), 16, 0, 0); } while (0)
#define PG8_LDA(dst, b, h) do { _Pragma("unroll") for (int m = 0; m < 4; ++m) _Pragma("unroll") for (int k = 0; k < 2; ++k) dst[m][k] = *(const PG8_LAS bf16x8*)(lds + PG8_SA(b, h) + aoff + m * 2048 + k * 1024); } while (0)
#define PG8_LDB(dst, b, h) do { _Pragma("unroll") for (int n = 0; n < 2; ++n) _Pragma("unroll") for (int k = 0; k < 2; ++k) dst[n][k] = *(const PG8_LAS bf16x8*)(lds + PG8_SB(b, h) + boff + n * 2048 + k * 1024); } while (0)
#define PG8_MMA(ai, bj, At, Bt) do { __builtin_amdgcn_s_setprio(1); _Pragma("unroll") for (int m = 0; m < 4; ++m) _Pragma("unroll") for (int n = 0; n < 2; ++n) _Pragma("unroll") for (int k = 0; k < 2; ++k) \
        acc[ai][bj][m][n] = __builtin_amdgcn_mfma_f32_16x16x32_bf16(Bt[n][k], At[m][k], acc[ai][bj][m][n], 0, 0, 0); __builtin_amdgcn_s_setprio(0); } while (0)
#define PG8_WAIT_V(n) asm volatile("s_waitcnt vmcnt(" #n ")" ::: "memory")
#define PG8_WAIT_L(n) asm volatile("s_waitcnt lgkmcnt(" #n ")" ::: "memory")
#define PG8_BAR __builtin_amdgcn_s_barrier()
#define PG8_SCHED __builtin_amdgcn_sched_barrier(0)
    Unit cur, nxt; int ui = 0;
    if (!S.next(0, cur)) return;
    f32x4 acc[2][2][4][2];
#pragma unroll
    for (int a = 0; a < 2; ++a)
#pragma unroll
        for (int b = 0; b < 2; ++b)
#pragma unroll
            for (int m = 0; m < 4; ++m)
#pragma unroll
                for (int n = 0; n < 2; ++n) acc[a][b][m][n] = (f32x4){0.f, 0.f, 0.f, 0.f};
    bf16x8 At[4][2], B0[2][2], B1[2][2];
    const char* cA = (const char*)g.A + (size_t)cur.pm * tstep + (size_t)cur.kt0 * kstep; const char* cB = (const char*)g.Bt + (size_t)cur.pn * tstep + (size_t)cur.kt0 * kstep;
    S.a_ready(cur);
    if constexpr (SP2) {
        PG8_STAGE(PG8_SB(0, 0), cB, voffB); PG8_STAGE(PG8_SB(0, 1), cB + hstep, voffB); PG8_STAGE(PG8_SA(0, 0), cA, voffA); PG8_STAGE(PG8_SA(0, 1), cA + hstep, voffA);
        if (wr == 1) PG8_BAR;
        PG8_WAIT_V(2); PG8_BAR;
        PG8_STAGE(PG8_SB(1, 0), cB + kstep, voffB); PG8_STAGE(PG8_SA(1, 0), cA + kstep, voffA); PG8_STAGE(PG8_SB(1, 1), cB + hstep + kstep, voffB);
        PG8_WAIT_V(6); PG8_BAR;
    } else {
        PG8_STAGE(PG8_SB(0, 0), cB, voffB); PG8_STAGE(PG8_SA(0, 0), cA, voffA); PG8_STAGE(PG8_SB(0, 1), cB + hstep, voffB); PG8_STAGE(PG8_SA(0, 1), cA + hstep, voffA);
        if (wr == 1) PG8_BAR;
        PG8_WAIT_V(4); PG8_BAR;
        PG8_STAGE(PG8_SB(1, 0), cB + kstep, voffB); PG8_STAGE(PG8_SA(1, 0), cA + kstep, voffA); PG8_STAGE(PG8_SB(1, 1), cB + hstep + kstep, voffB);
        PG8_WAIT_V(6); PG8_BAR;
    }
    for (;;) {
        const bool has_next = S.next(ui + 1, nxt);
        const char* nA = has_next ? (const char*)g.A + (size_t)nxt.pm * tstep + (size_t)nxt.kt0 * kstep : cA; const char* nB = has_next ? (const char*)g.Bt + (size_t)nxt.pn * tstep + (size_t)nxt.kt0 * kstep : cB;
        const int nt = cur.nt;
        for (int t = 0; t < nt; t += 2) {
            const bool last = (t == nt - 2);
            const char* a1 = cA + (size_t)(t + 1) * kstep;
            const char* a2 = last ? nA : cA + (size_t)(t + 2) * kstep; const char* b2 = last ? nB : cB + (size_t)(t + 2) * kstep;
            const char* a3 = a2 + kstep; const char* b3 = b2 + kstep;
            if (last && has_next) S.a_ready(nxt);
            if constexpr (SP2) {
            PG8_LDB(B0, 0, 0); PG8_LDB(B1, 0, 1); PG8_SCHED; PG8_LDA(At, 0, 0); PG8_STAGE(PG8_SA(1, 1), a1 + hstep, voffA);
            PG8_WAIT_V(8); PG8_WAIT_L(0); PG8_BAR; PG8_MMA(0, 0, At, B0); PG8_MMA(0, 1, At, B1); PG8_BAR; PG8_SCHED;
            PG8_LDA(At, 0, 1); PG8_STAGE(PG8_SB(0, 0), b2, voffB); PG8_STAGE(PG8_SB(0, 1), b2 + hstep, voffB); PG8_STAGE(PG8_SA(0, 0), a2, voffA);
            PG8_WAIT_V(8); PG8_WAIT_L(0); PG8_BAR; PG8_MMA(1, 0, At, B0); PG8_MMA(1, 1, At, B1); PG8_BAR; PG8_SCHED;
            PG8_LDB(B0, 1, 0); PG8_LDB(B1, 1, 1); PG8_SCHED; PG8_LDA(At, 1, 0); PG8_STAGE(PG8_SA(0, 1), a2 + hstep, voffA);
            PG8_WAIT_V(8); PG8_WAIT_L(0); PG8_BAR; PG8_MMA(0, 0, At, B0); PG8_MMA(0, 1, At, B1); PG8_BAR; PG8_SCHED;
            PG8_LDA(At, 1, 1); PG8_STAGE(PG8_SB(1, 0), b3, voffB); PG8_STAGE(PG8_SB(1, 1), b3 + hstep, voffB); PG8_STAGE(PG8_SA(1, 0), a3, voffA);
            PG8_WAIT_V(8); PG8_WAIT_L(0); PG8_BAR; PG8_MMA(1, 0, At, B0); PG8_MMA(1, 1, At, B1); PG8_BAR; PG8_SCHED;
            } else {
            PG8_LDB(B0, 0, 0); PG8_SCHED; PG8_LDA(At, 0, 0); PG8_STAGE(PG8_SA(1, 1), a1 + hstep, voffA);
            PG8_WAIT_L(8); PG8_BAR; PG8_WAIT_L(0); PG8_MMA(0, 0, At, B0); PG8_BAR; PG8_SCHED;
            PG8_LDB(B1, 0, 1); PG8_STAGE(PG8_SB(0, 0), b2, voffB);
            PG8_BAR; PG8_WAIT_L(0); PG8_MMA(0, 1, At, B1); PG8_BAR;
            PG8_LDA(At, 0, 1); PG8_STAGE(PG8_SA(0, 0), a2, voffA);
            PG8_BAR; PG8_WAIT_L(0); PG8_MMA(1, 0, At, B0); PG8_BAR; PG8_SCHED;
            PG8_STAGE(PG8_SB(0, 1), b2 + hstep, voffB);
            PG8_WAIT_V(6); PG8_BAR; PG8_MMA(1, 1, At, B1); PG8_BAR;
            PG8_LDB(B0, 1, 0); PG8_SCHED; PG8_LDA(At, 1, 0); PG8_STAGE(PG8_SA(0, 1), a2 + hstep, voffA);
            PG8_WAIT_L(8); PG8_BAR; PG8_WAIT_L(0); PG8_MMA(0, 0, At, B0); PG8_BAR; PG8_SCHED;
            PG8_LDB(B1, 1, 1); PG8_STAGE(PG8_SB(1, 0), b3, voffB);
            PG8_BAR; PG8_WAIT_L(0); PG8_MMA(0, 1, At, B1); PG8_BAR;
            PG8_LDA(At, 1, 1); PG8_STAGE(PG8_SA(1, 0), a3, voffA);
            PG8_BAR; PG8_WAIT_L(0); PG8_MMA(1, 0, At, B0); PG8_BAR; PG8_SCHED;
            PG8_STAGE(PG8_SB(1, 1), b3 + hstep, voffB);
            PG8_WAIT_V(6); PG8_BAR; PG8_MMA(1, 1, At, B1); PG8_BAR;
            }
        }
        if constexpr (ALIGN_EPI) { if (wr == 0) PG8_BAR; }
        if constexpr (!Epi::AFTER_DRAIN) { E(acc, cur, wr, wc, fr, fq); S.done(cur); }
        if (!has_next) break;
#pragma unroll
        for (int a = 0; a < 2; ++a)
#pragma unroll
            for (int b = 0; b < 2; ++b)
#pragma unroll
                for (int m = 0; m < 4; ++m)
#pragma unroll
                    for (int n = 0; n < 2; ++n) acc[a][b][m][n] = (f32x4){0.f, 0.f, 0.f, 0.f};
        cur = nxt; cA = nA; cB = nB; ++ui;
        if constexpr (ALIGN_EPI) { if (wr == 1) PG8_BAR; }
    }
    PG8_WAIT_V(0);
    if constexpr (!ALIGN_EPI) { if (wr == 0) PG8_BAR; }
    PG8_BAR;
    if constexpr (Epi::AFTER_DRAIN) { E.fused(acc, cur, wr, wc, fr, fq, lds, wid, lane); S.done(cur); }
#undef PG8_SA
#undef PG8_SB
#undef PG8_STAGE
#undef PG8_LDA
#undef PG8_LDB
#undef PG8_MMA
#undef PG8_WAIT_V
#undef PG8_WAIT_L
#undef PG8_BAR
#undef PG8_SCHED
}
}

constexpr int NWAVES = 8;
constexpr int D = 1024, FF = 4096, M_CTX = 4096, M_LAT = 16384, M = M_CTX + M_LAT;
constexpr int L_LAT = 2048, L_CTX = 256, PAST = 256, LKV = PAST + L_LAT;
constexpr int MKV = M_CTX + 8 * LKV;
constexpr int EVEN_N = 3104, EVEN_NP = 3328, ODD_N = 576, ODD_NP = 768;
constexpr float EPS = 1e-6f;
constexpr int PC_QA = 0, PC_KA = 256, PC_VA = 512, PC_GA = 1024, PC_QB = 1536, PC_KB = 1792, PC_VB = 2048, PC_GB = 2560, PC_GK = 3072;
constexpr size_t OUT_Y = 0, OUT_CKV = 20971520, OUT_KPE = 23068672, OUT_SGLA = 23592960, OUT_SRET = 25690112;

constexpr size_t MiB = 1u << 20;
constexpr size_t WS_CTL = 0, CTL_ZERO_BYTES = 64 * 1024;
constexpr size_t WS_MOD = 1 * MiB;
constexpr size_t WS_ROPE = 2 * MiB;
constexpr size_t WS_SS = 3 * MiB;
constexpr size_t WS_KPE = 5 * MiB;
constexpr size_t WS_ACKV = 11 * MiB;
constexpr size_t WS_WINE = 35 * MiB;
constexpr size_t WS_WOUTE = 48 * MiB;
constexpr size_t WS_WINO = 52 * MiB;
constexpr size_t WS_WQB = 55 * MiB;
constexpr size_t WS_WKVB = 57 * MiB;
constexpr size_t WS_WOUTO = 59 * MiB;
constexpr size_t WS_W1 = 63 * MiB;
constexpr size_t WS_W2 = 95 * MiB;
constexpr size_t WS_HB = 127 * MiB;
constexpr size_t WS_Y = 167 * MiB;
constexpr size_t WS_BIG = 207 * MiB;
constexpr size_t WS_Q = WS_BIG, WS_KV = WS_BIG + 60 * MiB, WS_QN = WS_BIG + 148 * MiB;
constexpr size_t WS_END = 367 * MiB;

constexpr int RING_BYTES = 131072;
constexpr int LDS_MISC = 155648;
constexpr int LDS_BYTES = 163840;

#define GAS __attribute__((address_space(1)))
#define LAS __attribute__((address_space(3)))
typedef unsigned short bf16;
typedef unsigned v4u __attribute__((ext_vector_type(4)));
typedef unsigned v2u __attribute__((ext_vector_type(2)));
typedef float f32x4 __attribute__((ext_vector_type(4)));
typedef float f32x16 __attribute__((ext_vector_type(16)));
typedef short bf16x8 __attribute__((ext_vector_type(8)));
typedef short s16x4 __attribute__((ext_vector_type(4)));
#define LDS_WAIT() asm volatile("s_waitcnt lgkmcnt(0)" ::: "memory")
#define VM_WAIT() asm volatile("s_waitcnt vmcnt(0)" ::: "memory")
typedef float f32x2_t __attribute__((ext_vector_type(2))); typedef __bf16 bf16x2_t __attribute__((ext_vector_type(2)));
__device__ __forceinline__ unsigned pk2(float lo, float hi) { f32x2_t v = {lo, hi}; bf16x2_t b = __builtin_convertvector(v, bf16x2_t); return __builtin_bit_cast(unsigned, b); }
__device__ __forceinline__ unsigned f2bf(float f) { return pk2(f, f) & 0xffffu; }
__device__ __forceinline__ float bflo(unsigned w) { return __builtin_bit_cast(float, w << 16); }
__device__ __forceinline__ float bfhi(unsigned w) { return __builtin_bit_cast(float, w & 0xffff0000u); }
__device__ __forceinline__ float wave_sum(float v) {
#pragma unroll
    for (int o = 1; o < 64; o <<= 1) v += __shfl_xor(v, o);
    return v;
}
__device__ __forceinline__ float siluf(float x) { return x * __builtin_amdgcn_rcpf(1.0f + __expf(-x)); }

#define XB_TMO      128
#define XB_XCNT(j)  (256  + 64 * (j))
#define XB_XSUB(j)  (1280 + 64 * (j))
#define XB_XGEN(j)  (2304 + 64 * (j))
#define XB_TOP      3328
#define XB_TOPGEN   3392
#define XCD_BAR_WORDS 3456
#define XB_SPIN_CAP (1u << 20)
__device__ __forceinline__ unsigned xb_ld(unsigned* p)              { return __hip_atomic_load(p, __ATOMIC_RELAXED, __HIP_MEMORY_SCOPE_AGENT); }
__device__ __forceinline__ unsigned xb_add(unsigned* p, unsigned v) { return __hip_atomic_fetch_add(p, v, __ATOMIC_RELAXED, __HIP_MEMORY_SCOPE_AGENT); }
__device__ __forceinline__ unsigned xb_xcc_id() { return (unsigned)__builtin_amdgcn_s_getreg((3 << 11) | 20) & 0xFu; }
#define XB_SPIN(cond, bar) do { unsigned _sp = 0; while (cond) { __builtin_amdgcn_s_sleep(1); \
    if ((++_sp & 255u) == 0u) { if (xb_ld(&(bar)[XB_TMO])) break; if (_sp > XB_SPIN_CAP) { atomicAdd(&(bar)[XB_TMO], 1u); break; } } } } while (0)
struct XcdBarrier { unsigned* bar; unsigned x; volatile LAS unsigned* st; };
__device__ __forceinline__ XcdBarrier xcd_barrier_post(unsigned* bar, volatile LAS unsigned* st) {
    XcdBarrier b; b.bar = bar; b.x = xb_xcc_id(); b.st = st;
    if (threadIdx.x == 0) (void)xb_add(&bar[XB_XCNT(b.x)], 1u);
    return b;
}
__device__ __forceinline__ void xcd_barrier_complete(unsigned* bar, unsigned x, unsigned& nloc, unsigned& nx) {
    const unsigned G = gridDim.x * gridDim.y * gridDim.z;
    unsigned sum, cnt, mine, sp = 0u;
    for (;;) {
        sum = 0u; cnt = 0u; mine = 0u;
#pragma unroll
        for (unsigned j = 0; j < 16; ++j) { const unsigned c = xb_ld(&bar[XB_XCNT(j)]); sum += c; cnt += (c > 0u) ? 1u : 0u; mine = (j == x) ? c : mine; }
        if (sum == G) break;
        __builtin_amdgcn_s_sleep(1);
        if ((++sp & 255u) == 0u) { if (xb_ld(&bar[XB_TMO])) break; if (sp > XB_SPIN_CAP) { atomicAdd(&bar[XB_TMO], 1u); break; } }
    }
    nloc = mine > 0u ? mine : 1u; nx = cnt > 0u ? cnt : 1u;
}
__device__ __forceinline__ void xcd_barrier(const XcdBarrier& b) {
    asm volatile("s_waitcnt vmcnt(0)" ::: "memory");
    __syncthreads();
    if (threadIdx.x == 0) {
        unsigned* bar = b.bar;
        __builtin_amdgcn_s_waitcnt(0);
        unsigned nloc = b.st[0], nx = b.st[1];
        if (nloc == 0u) { xcd_barrier_complete(bar, b.x, nloc, nx); b.st[0] = nloc; b.st[1] = nx; }
        const unsigned old = xb_add(&bar[XB_XSUB(b.x)], 1u);
        const unsigned gen = old / nloc;
        if (old + 1u == (gen + 1u) * nloc) {
            __builtin_amdgcn_fence(__ATOMIC_RELEASE, "agent");
            asm volatile("s_waitcnt vmcnt(0)" ::: "memory");
            const unsigned og = xb_add(&bar[XB_TOP], 1u);
            const unsigned tg = og / nx;
            if (og + 1u == (tg + 1u) * nx) xb_add(&bar[XB_TOPGEN], 1u);
            else XB_SPIN(xb_ld(&bar[XB_TOPGEN]) == tg, bar);
            __builtin_amdgcn_fence(__ATOMIC_ACQUIRE, "agent");
            xb_add(&bar[XB_XGEN(b.x)], 1u);
            asm volatile("s_waitcnt vmcnt(0)" ::: "memory");
        } else {
            XB_SPIN(xb_ld(&bar[XB_XGEN(b.x)]) == gen, bar);
            __builtin_amdgcn_fence(__ATOMIC_ACQUIRE, "agent");
            asm volatile("s_waitcnt vmcnt(0)" ::: "memory");
        }
    }
    __syncthreads();
}

struct Params { const float* in[28]; float* out; unsigned char* ws; int ph_lo, ph_hi, use_bar, pad; };
enum { I_XP = 0, I_XS, I_CCKV, I_CKPE, I_SGLA, I_SRET, I_C, I_CCTX, I_WADA, I_BADA, I_NMIXPRE, I_NMIXPOST, I_NMLPPRE, I_NMLPPOST,
       I_WINE, I_WGK2, I_BGK2, I_GLAN, I_RDEC, I_WOUTE, I_WINO, I_QAN, I_WQB, I_KVAN, I_WKVB, I_WOUTO, I_W1, I_W2 };
struct Frame { LAS unsigned char* lds; int tid, lane, wave, vcu, G, bid; };
constexpr int LDS_PT = LDS_MISC + 256;
__device__ __forceinline__ const void* ldp(LAS unsigned char* lds, int i) {
    const volatile LAS unsigned* p = (const volatile LAS unsigned*)(lds + LDS_PT) + 2 * i;
    const unsigned lo = __builtin_amdgcn_readfirstlane(p[0]), hi = __builtin_amdgcn_readfirstlane(p[1]);
    return (const void*)(const GAS void*)(((unsigned long long)hi << 32) | lo);
}
#define PIN(i) ((const float*)ldp(F.lds, (i)))
#define POUT ((float*)ldp(F.lds, 28))
#define PWS ((unsigned char*)ldp(F.lds, 29))

__device__ __forceinline__ void p0_transpose_item(const float* W, int K, int N, bf16* WT, int kb, int n0, int dn0, LAS float* scr, int lane) {
    const int k0 = 64 * kb;
#pragma unroll 8
    for (int i = 0; i < 32; ++i) { const int kk = 2 * i + (lane >> 5); scr[kk * 33 + (lane & 31)] = W[(size_t)(k0 + kk) * N + n0 + (lane & 31)]; }
    LDS_WAIT(); asm volatile("" ::: "memory");
    const int c = lane & 7;
#pragma unroll
    for (int j = 0; j < 4; ++j) { const int n = (lane >> 3) + 8 * j; const LAS float* s = scr + (8 * c) * 33 + n;
        v4u o; o.x = pk2(s[0 * 33], s[1 * 33]); o.y = pk2(s[2 * 33], s[3 * 33]); o.z = pk2(s[4 * 33], s[5 * 33]); o.w = pk2(s[6 * 33], s[7 * 33]);
        *(GAS v4u*)(WT + (size_t)(dn0 + n) * K + k0 + 8 * c) = o; }
    LDS_WAIT(); asm volatile("" ::: "memory");
}
__device__ __forceinline__ int even_col_map(int n0) { return n0 < 1536 ? n0 : (n0 < 1568 ? 3072 + (n0 - 1536) : n0 - 32); }

__device__ __forceinline__ void p0_prologue(Frame& F, const Params& P) {
    unsigned char* ws = PWS;
    LAS float* scr = (LAS float*)(F.lds + F.wave * 16384);
    const int gw = F.vcu * NWAVES + F.wave, NGW = F.G * NWAVES;
    {
        LAS float* S = (LAS float*)(F.lds);
        LAS float* R = (LAS float*)(F.lds + 40960);
        { const float* cp_ = PIN(I_C); const float* cc_ = PIN(I_CCTX);
          for (int i = F.tid; i < 9 * 1024; i += 512) { const int n = i >> 10, d = i & 1023; const float cv = n < 8 ? cp_[n * 1024 + d] : cc_[d]; S[i] = siluf(cv); } }
        const float* wada_ = PIN(I_WADA); const float* bada_ = PIN(I_BADA);
        __syncthreads();
        for (int u = F.vcu; u < 256; u += F.G) {
            const int l = u >> 6, cb = (u & 63) * 96;
            if (F.tid < 384) {
                const int c4 = (F.tid % 24) * 4, part = F.tid / 24;
                const float* Wp = wada_ + ((size_t)l * 1024 + part * 64) * 6144 + cb + c4;
                f32x4 a[9];
#pragma unroll
                for (int n = 0; n < 9; ++n) a[n] = (f32x4){0.f, 0.f, 0.f, 0.f};
#pragma unroll 4
                for (int d = 0; d < 64; ++d) { const f32x4 w = *(const f32x4*)(Wp + (size_t)d * 6144);
#pragma unroll
                    for (int n = 0; n < 9; ++n) a[n] += w * S[n * 1024 + part * 64 + d]; }
#pragma unroll
                for (int n = 0; n < 9; ++n) *(LAS f32x4*)(R + (part * 9 + n) * 96 + c4) = a[n];
            }
            __syncthreads();
            for (int i = F.tid; i < 9 * 96; i += 512) { const int n = i / 96, c = i % 96; float s = 0.f;
#pragma unroll
                for (int p = 0; p < 16; ++p) s += R[(p * 9 + n) * 96 + c];
                ((float*)(ws + WS_MOD))[((size_t)l * 9 + n) * 6144 + cb + c] = s + bada_[l * 6144 + cb + c]; }
            __syncthreads();
        }
    }
    {
        int it = gw;
        const int I_E = (1024 / 64) * (EVEN_N / 32), I_OE = 16 * 32, I_O = 16 * (ODD_N / 32), I_QB = 4 * 48, I_KVB = 4 * 64, I_M1 = 16 * 128, I_M2 = 64 * 32;
        const int T_E = 2 * I_E, T_OE = 2 * I_OE, T_O = 2 * I_O, T_QB = 2 * I_QB, T_KVB = 2 * I_KVB, T_OO = 2 * I_OE, T_M1 = 4 * I_M1, T_M2 = 4 * I_M2;
        const int TOTAL = T_E + T_OE + T_O + T_QB + T_KVB + T_OO + T_M1 + T_M2;
        for (; it < TOTAL; it += NGW) {
            int r = it;
            if (r < T_E) { const int l = r / I_E, q = r % I_E, nb = EVEN_N / 32, kb = q / nb, n0 = (q % nb) * 32;
                p0_transpose_item(PIN(I_WINE) + (size_t)l * 1024 * EVEN_N, 1024, EVEN_N, (bf16*)(ws + WS_WINE) + (size_t)l * EVEN_NP * 1024, kb, n0, even_col_map(n0), scr, F.lane); continue; } r -= T_E;
            if (r < T_OE) { const int l = r / I_OE, q = r % I_OE, kb = q / 32, n0 = (q % 32) * 32;
                p0_transpose_item(PIN(I_WOUTE) + (size_t)l * 1024 * 1024, 1024, 1024, (bf16*)(ws + WS_WOUTE) + (size_t)l * 1024 * 1024, kb, n0, n0, scr, F.lane); continue; } r -= T_OE;
            if (r < T_O) { const int l = r / I_O, q = r % I_O, nb = ODD_N / 32, kb = q / nb, n0 = (q % nb) * 32;
                p0_transpose_item(PIN(I_WINO) + (size_t)l * 1024 * ODD_N, 1024, ODD_N, (bf16*)(ws + WS_WINO) + (size_t)l * ODD_NP * 1024, kb, n0, n0, scr, F.lane); continue; } r -= T_O;
            if (r < T_QB) { const int l = r / I_QB, q = r % I_QB, kb = q / 48, n0 = (q % 48) * 32;
                p0_transpose_item(PIN(I_WQB) + (size_t)l * 256 * 1536, 256, 1536, (bf16*)(ws + WS_WQB) + (size_t)l * 1536 * 256, kb, n0, n0, scr, F.lane); continue; } r -= T_QB;
            if (r < T_KVB) { const int l = r / I_KVB, q = r % I_KVB, kb = q / 64, n0 = (q % 64) * 32;
                p0_transpose_item(PIN(I_WKVB) + (size_t)l * 256 * 2048, 256, 2048, (bf16*)(ws + WS_WKVB) + (size_t)l * 2048 * 256, kb, n0, n0, scr, F.lane); continue; } r -= T_KVB;
            if (r < T_OO) { const int l = r / I_OE, q = r % I_OE, kb = q / 32, n0 = (q % 32) * 32;
                p0_transpose_item(PIN(I_WOUTO) + (size_t)l * 1024 * 1024, 1024, 1024, (bf16*)(ws + WS_WOUTO) + (size_t)l * 1024 * 1024, kb, n0, n0, scr, F.lane); continue; } r -= T_OO;
            if (r < T_M1) { const int l = r / I_M1, q = r % I_M1, kb = q / 128, n0 = (q % 128) * 32;
                p0_transpose_item(PIN(I_W1) + (size_t)l * 1024 * 4096, 1024, 4096, (bf16*)(ws + WS_W1) + (size_t)l * 4096 * 1024, kb, n0, n0, scr, F.lane); continue; } r -= T_M1;
            { const int l = r / I_M2, q = r % I_M2, kb = q / 32, n0 = (q % 32) * 32;
                p0_transpose_item(PIN(I_W2) + (size_t)l * 4096 * 1024, 4096, 1024, (bf16*)(ws + WS_W2) + (size_t)l * 1024 * 4096, kb, n0, n0, scr, F.lane); }
        }
    }
    const int gt = F.vcu * 512 + F.tid, NGT = F.G * 512;
    for (int i = gt; i < 2 * 224 * 128; i += NGT) { const int l = i / (224 * 128), q = i % (224 * 128); *(GAS v4u*)((bf16*)(ws + WS_WINE) + ((size_t)l * EVEN_NP + EVEN_N) * 1024 + (size_t)q * 8) = (v4u){0u, 0u, 0u, 0u}; }
    for (int i = gt; i < 2 * 192 * 128; i += NGT) { const int l = i / (192 * 128), q = i % (192 * 128); *(GAS v4u*)((bf16*)(ws + WS_WINO) + ((size_t)l * ODD_NP + ODD_N) * 1024 + (size_t)q * 8) = (v4u){0u, 0u, 0u, 0u}; }
    const float* cckv_ = PIN(I_CCKV); const float* ckpe_ = PIN(I_CKPE);
    for (int i = gt; i < 8 * 2 * 256 * 32; i += NGT) { const int c8 = i & 31, t = (i >> 5) & 255, li = (i >> 13) & 1, b = i >> 14;
        const float* s = cckv_ + (size_t)i * 8; const f32x4 a = *(const f32x4*)s, c = *(const f32x4*)(s + 4);
        *(GAS v4u*)((bf16*)(ws + WS_ACKV) + ((size_t)li * MKV + 4096 + b * LKV + t) * 256 + c8 * 8) = (v4u){pk2(a[0], a[1]), pk2(a[2], a[3]), pk2(c[0], c[1]), pk2(c[2], c[3])}; }
    for (int i = gt; i < 8 * 2 * 256 * 8; i += NGT) { const int c8 = i & 7, t = (i >> 3) & 255, li = (i >> 11) & 1, b = i >> 12;
        const float* s = ckpe_ + (size_t)i * 8; const f32x4 a = *(const f32x4*)s, c = *(const f32x4*)(s + 4);
        *(GAS v4u*)((bf16*)(ws + WS_KPE) + ((size_t)li * MKV + 4096 + b * LKV + t) * 64 + c8 * 8) = (v4u){pk2(a[0], a[1]), pk2(a[2], a[3]), pk2(c[0], c[1]), pk2(c[2], c[3])}; }
    for (int i = gt; i < 2048 * 32; i += NGT) { const int t = i >> 5, j = i & 31; const float inv = powf(10000.0f, -(float)(j & 15) / 16.0f);
        const float ang = (float)(j < 16 ? (t >> 6) : (t & 63)) * inv;
        ((float*)(ws + WS_ROPE))[i] = cosf(ang); ((float*)(ws + WS_ROPE))[65536 + i] = sinf(ang); }
}

__device__ __forceinline__ void row_pass(Frame& F, const float* xa, const float* xb, float* xout, const bf16* Y, const float* SL, const float* g_post, const float* gate,
                                         const float* g_pre, const float* scale, const float* shift, bf16* H, bool has_post, bool has_pre) {
    const int gw = F.vcu * NWAVES + F.wave, NGW = F.G * NWAVES, l4 = F.lane * 4;
    for (int row = gw; row < M; row += NGW) {
        const int n = row < M_CTX ? 8 : ((row - M_CTX) >> 11);
        const float* xr = row < M_CTX ? xa + (size_t)row * D : xb + (size_t)(row - M_CTX) * D;
        f32x4 v[4];
#pragma unroll
        for (int j = 0; j < 4; ++j) v[j] = *(const f32x4*)(xr + l4 + 256 * j);
        if (has_post) {
            f32x4 yv[4];
            if (row < 16384) {
#pragma unroll
                for (int j = 0; j < 4; ++j) { const v2u yw = *(const v2u*)(Y + (size_t)row * D + l4 + 256 * j); yv[j] = (f32x4){bflo(yw.x), bfhi(yw.x), bflo(yw.y), bfhi(yw.y)}; }
            } else {
                const float* sp = SL + (size_t)(row - 16384) * D + l4;
#pragma unroll
                for (int j = 0; j < 4; ++j) yv[j] = (*(const f32x4*)(sp + 256 * j) + *(const f32x4*)(sp + 4194304 + 256 * j)) + (*(const f32x4*)(sp + 2 * 4194304 + 256 * j) + *(const f32x4*)(sp + 3 * 4194304 + 256 * j));
            }
            float s = 0.f;
#pragma unroll
            for (int j = 0; j < 4; ++j) s += (yv[j][0] * yv[j][0] + yv[j][1] * yv[j][1]) + (yv[j][2] * yv[j][2] + yv[j][3] * yv[j][3]);
            const float rstd = __builtin_amdgcn_rsqf(wave_sum(s) * (1.0f / 1024.0f) + EPS);
#pragma unroll
            for (int j = 0; j < 4; ++j) { const int c = l4 + 256 * j;
                const f32x4 gp = *(const f32x4*)(g_post + c), gt = *(const f32x4*)(gate + (size_t)n * 6144 + c);
                v[j] = v[j] + gt * ((yv[j] * rstd) * gp);
                *(f32x4*)(xout + (size_t)row * D + c) = v[j]; }
        }
        if (has_pre) {
            float s = 0.f;
#pragma unroll
            for (int j = 0; j < 4; ++j) s += (v[j][0] * v[j][0] + v[j][1] * v[j][1]) + (v[j][2] * v[j][2] + v[j][3] * v[j][3]);
            const float rstd = __builtin_amdgcn_rsqf(wave_sum(s) * (1.0f / 1024.0f) + EPS);
#pragma unroll
            for (int j = 0; j < 4; ++j) { const int c = l4 + 256 * j;
                const f32x4 gp = *(const f32x4*)(g_pre + c), sc = *(const f32x4*)(scale + (size_t)n * 6144 + c), sh = *(const f32x4*)(shift + (size_t)n * 6144 + c);
                const f32x4 h = ((v[j] * rstd) * gp) * (1.0f + sc) + sh;
                *(v2u*)(H + (size_t)row * D + c) = (v2u){pk2(h[0], h[1]), pk2(h[2], h[3])}; }
        }
    }
}

__device__ __forceinline__ int crow(int r, int hi) { return (r & 3) + 8 * (r >> 2) + 4 * hi; }
__device__ __forceinline__ unsigned cvtpk(float lo, float hi) { return pk2(lo, hi); }
#define SBAR() __builtin_amdgcn_sched_barrier(0)
__device__ __forceinline__ int vst_row(int k, int NB) { const int kk = (k & ~0xC) | ((k & 4) << 1) | ((k & 8) >> 1); return (kk >> 3) * NB * 512 + (kk & 7) * 64; }
__device__ __forceinline__ int vst(int k, int c, int NB) { return vst_row(k, NB) + (c >> 5) * 512 + (c & 31) * 2; }
__device__ __forceinline__ int v_rd_base(int lane) { return ((lane & 3) << 3) | (((lane >> 2) & 3) << 6) | (((lane >> 4) & 1) << 5) | (((lane >> 5) & 1) << 8); }
template <int OFF> __device__ __forceinline__ s16x4 tr_read(unsigned vb) { s16x4 r; asm volatile("ds_read_b64_tr_b16 %0, %1 offset:%2" : "=&v"(r) : "v"(vb), "i"(OFF) : "memory"); return r; }
#define PKF(L, H) ((bf16x8){L[0], L[1], L[2], L[3], H[0], H[1], H[2], H[3]})
#define PK4(P, BASE, OUT) do { unsigned a0_ = cvtpk(P[BASE + 0], P[BASE + 1]), a1_ = cvtpk(P[BASE + 2], P[BASE + 3]);   \
    unsigned b0_ = cvtpk(P[BASE + 4], P[BASE + 5]), b1_ = cvtpk(P[BASE + 6], P[BASE + 7]);                              \
    auto r0_ = __builtin_amdgcn_permlane32_swap(a0_, b0_, false, false); auto r1_ = __builtin_amdgcn_permlane32_swap(a1_, b1_, false, false); \
    v4u w_ = {r0_[0], r1_[0], r0_[1], r1_[1]}; OUT = __builtin_bit_cast(bf16x8, w_); } while (0)
__device__ __forceinline__ float logsig(float x) { return fminf(x, 0.f) - __logf(1.0f + __expf(-fabsf(x))); }

constexpr int SC_QD = 0, SC_KI = 8192, SC_VT = 16384, SC_ST = 32768, SC_BT = 49152, SC_GK = 65536, SC_TOT = 69632, SC_DL = 71680, SC_W2 = 71936;
__device__ __forceinline__ void scan_phase(Frame& F, const Params& P, int li) {
    unsigned char* ws = PWS;
    const bf16* PROJ = (const bf16*)(ws + WS_BIG);
    const float* ROPE = (const float*)(ws + WS_ROPE);
    LAS unsigned char* G = F.lds;
    const unsigned gaddr = (unsigned)(uintptr_t)G;
    const int ri = F.wave >> 2, dq = F.wave & 3;
    for (int u0 = F.bid; u0 < 256; u0 += F.G) for (int kk_ = 0; kk_ < (u0 < 128 ? 1 : 2); ++kk_) {
        __syncthreads();
        const bool lat = u0 < 128; const int u = lat ? u0 : 2 * (u0 - 128) + kk_;
        const int sb = u >> 4, hh = (u >> 1) & 7, dir = u & 1;
        const int L = lat ? L_LAT : L_CTX, row0 = lat ? M_CTX + sb * L_LAT : sb * L_CTX, NC = L / 64;
        const bool gla = hh < 4; const int h = hh & 3;
        const int qc = (gla ? PC_QA : PC_QB) + h * 64, kc = (gla ? PC_KA : PC_KB) + h * 64, vc = (gla ? PC_VA : PC_VB) + h * 128, gkc = PC_GK + dir * 16;
        bf16* OUT = (bf16*)(ws + (dir == 0 ? WS_Y : WS_HB));
        const float* rdec_p = PIN(I_RDEC); const float* wgk2_p = PIN(I_WGK2); const float* bgk2_p = PIN(I_BGK2);
        const float lgr = gla ? 0.f : -__expf(rdec_p[(li * 2 + dir) * 4 + h]);
        f32x16 sacc;
        { int t0_ = F.tid; asm volatile("" : "+v"(t0_)); const int lane = t0_ & 63, r32 = lane & 31, hi = lane >> 5;
          if (gla) { LAS float* W2 = (LAS float*)(G + SC_W2);
              for (int i = t0_; i < 16 * 64; i += 512) W2[i] = wgk2_p[((size_t)(li * 2 + dir) * 16 + (i >> 6)) * 256 + h * 64 + (i & 63)];
              if (t0_ < 64) W2[1024 + t0_] = bgk2_p[(li * 2 + dir) * 256 + h * 64 + t0_]; }
          else if (t0_ < 64) ((LAS float*)(G + SC_DL))[t0_] = __expf(64.0f * lgr);
          const float* S0 = (gla ? PIN(I_SGLA) : PIN(I_SRET)) + ((size_t)((sb * 2 + li) * 2 + dir) * 4 + h) * 8192;
          if (lat) {
#pragma unroll
              for (int r = 0; r < 16; ++r) sacc[r] = S0[(32 * ri + crow(r, hi)) * 128 + 32 * dq + r32];
          } else sacc = f32x16{};
#pragma unroll
          for (int r = 0; r < 16; r += 2) { const unsigned w = pk2(sacc[r], sacc[r + 1]);
              LAS unsigned char* sp_ = G + SC_ST + (hi + 4 * ri) * 2048 + dq * 512 + r32 * 2 + ((r >> 3) & 1) * 4096 + ((r & 3) + 4 * ((r >> 2) & 1)) * 64;
              *(LAS unsigned short*)sp_ = (unsigned short)w; *(LAS unsigned short*)(sp_ + 64) = (unsigned short)(w >> 16); } }
        v2u pq0, pq1, pk0, pk1; v4u pv0, pv1; unsigned pgk = 0;
#define SC_TOK(s, i) (dir == 0 ? 64 * (s) + (i) : L - 1 - (64 * (s) + (i)))
#define SC_LOAD(s) do { const unsigned ro_ = (unsigned)(row0 + SC_TOK(s, sti)) * (unsigned)(EVEN_NP * 2); const char* pc_ = (const char*)PROJ; \
        pq0 = *(const v2u*)(pc_ + (ro_ + (unsigned)(qc + 4 * c4) * 2u)); pq1 = *(const v2u*)(pc_ + (ro_ + (unsigned)(qc + 32 + 4 * c4) * 2u)); \
        pk0 = *(const v2u*)(pc_ + (ro_ + (unsigned)(kc + 4 * c4) * 2u)); pk1 = *(const v2u*)(pc_ + (ro_ + (unsigned)(kc + 32 + 4 * c4) * 2u)); \
        pv0 = *(const v4u*)(pc_ + (ro_ + (unsigned)(vc + 16 * c4) * 2u)); pv1 = *(const v4u*)(pc_ + (ro_ + (unsigned)(vc + 16 * c4 + 8) * 2u)); \
        if (gla) pgk = *(const unsigned*)(pc_ + (ro_ + (unsigned)(gkc + 2 * c4) * 2u)); } while (0)
        { int t0_ = F.tid; asm volatile("" : "+v"(t0_)); const int sti = t0_ >> 3, c4 = t0_ & 7; SC_LOAD(0); }
        for (int s = 0; s < NC; ++s) {
            int tid_o = F.tid; asm volatile("" : "+v"(tid_o));
            const int lane = tid_o & 63, r32 = lane & 31, hi = lane >> 5, sti = tid_o >> 3, c4 = tid_o & 7;
            const int tok = SC_TOK(s, sti);
            if (gla) {
                { LAS float* GK = (LAS float*)(G + SC_GK) + sti * 16 + 2 * c4; GK[0] = bflo(pgk); GK[1] = bfhi(pgk); }
                LDS_WAIT(); __syncthreads();
                const int k = tid_o & 63, tq = tid_o >> 6; float cs[8]; float run = 0.f;
                float w2[16]; const LAS float* W2 = (const LAS float*)(G + SC_W2);
#pragma unroll
                for (int r = 0; r < 16; ++r) w2[r] = W2[r * 64 + k];
                const float bias2 = W2[1024 + k];
#pragma unroll
                for (int j = 0; j < 8; ++j) { const LAS f32x4* gp = (const LAS f32x4*)((LAS float*)(G + SC_GK) + (8 * tq + j) * 16);
                    const f32x4 g0 = gp[0], g1 = gp[1], g2 = gp[2], g3 = gp[3];
                    float a = bias2;
                    a += g0[0] * w2[0] + g0[1] * w2[1] + g0[2] * w2[2] + g0[3] * w2[3];
                    a += g1[0] * w2[4] + g1[1] * w2[5] + g1[2] * w2[6] + g1[3] * w2[7];
                    a += g2[0] * w2[8] + g2[1] * w2[9] + g2[2] * w2[10] + g2[3] * w2[11];
                    a += g3[0] * w2[12] + g3[1] * w2[13] + g3[2] * w2[14] + g3[3] * w2[15];
                    run += logsig(a) * (1.0f / 16.0f); cs[j] = run; }
                ((LAS float*)(G + SC_TOT))[tq * 64 + k] = run;
                LDS_WAIT(); __syncthreads();
                float pre = 0.f;
#pragma unroll
                for (int q = 0; q < 7; ++q) { const float tv = ((LAS float*)(G + SC_TOT))[q * 64 + k]; pre += (q < tq) ? tv : 0.f; }
#pragma unroll
                for (int j = 0; j < 8; ++j) ((LAS float*)(G + SC_BT))[(8 * tq + j) * 64 + k] = pre + cs[j];
                if (tq == 7) ((LAS float*)(G + SC_DL))[k] = __expf(pre + cs[7]);
                LDS_WAIT(); __syncthreads();
            } else { __syncthreads(); }
            {
                float q[8], kk[8];
                q[0] = bflo(pq0.x); q[1] = bfhi(pq0.x); q[2] = bflo(pq0.y); q[3] = bfhi(pq0.y); q[4] = bflo(pq1.x); q[5] = bfhi(pq1.x); q[6] = bflo(pq1.y); q[7] = bfhi(pq1.y);
                kk[0] = bflo(pk0.x); kk[1] = bfhi(pk0.x); kk[2] = bflo(pk0.y); kk[3] = bfhi(pk0.y); kk[4] = bflo(pk1.x); kk[5] = bfhi(pk1.x); kk[6] = bflo(pk1.y); kk[7] = bfhi(pk1.y);
                if (gla) {
                    const f32x4 x0 = *(const LAS f32x4*)((LAS float*)(G + SC_BT) + sti * 64 + 4 * c4), x1 = *(const LAS f32x4*)((LAS float*)(G + SC_BT) + sti * 64 + 32 + 4 * c4);
#pragma unroll
                    for (int e = 0; e < 4; ++e) { const float e0 = __expf(x0[e]), e1 = __expf(x1[e]);
                        q[e] *= 0.125f * e0; kk[e] *= __builtin_amdgcn_rcpf(e0); q[4 + e] *= 0.125f * e1; kk[4 + e] *= __builtin_amdgcn_rcpf(e1); }
                } else {
                    if (lat) {
                        const float* cp = ROPE + (size_t)tok * 32 + 4 * c4; const f32x4 cv = *(const f32x4*)cp, sv = *(const f32x4*)(cp + 65536);
#pragma unroll
                        for (int e = 0; e < 4; ++e) { const float c = cv[e], sn = sv[e];
                            const float q1 = q[e], q2 = q[4 + e]; q[e] = q1 * c - q2 * sn; q[4 + e] = q1 * sn + q2 * c;
                            const float k1 = kk[e], k2 = kk[4 + e]; kk[e] = k1 * c - k2 * sn; kk[4 + e] = k1 * sn + k2 * c; }
                    }
                    const float bb = (float)(sti + 1) * lgr, eb = __expf(bb), ek = 0.125f * __builtin_amdgcn_rcpf(eb);
#pragma unroll
                    for (int e = 0; e < 8; ++e) { q[e] *= eb; kk[e] *= ek; }
                }
                *(LAS v2u*)(G + SC_QD + vst(sti, 4 * c4, 2)) = (v2u){pk2(q[0], q[1]), pk2(q[2], q[3])};
                *(LAS v2u*)(G + SC_QD + vst(sti, 32 + 4 * c4, 2)) = (v2u){pk2(q[4], q[5]), pk2(q[6], q[7])};
                *(LAS v2u*)(G + SC_KI + vst(sti, 4 * c4, 2)) = (v2u){pk2(kk[0], kk[1]), pk2(kk[2], kk[3])};
                *(LAS v2u*)(G + SC_KI + vst(sti, 32 + 4 * c4, 2)) = (v2u){pk2(kk[4], kk[5]), pk2(kk[6], kk[7])};
                *(LAS v4u*)(G + SC_VT + vst(sti, 16 * c4, 4)) = pv0; *(LAS v4u*)(G + SC_VT + vst(sti, 16 * c4 + 8, 4)) = pv1;
            }
            LDS_WAIT(); __syncthreads();
            if (s + 1 < NC) SC_LOAD(s + 1);
            bf16x8 qf[4]; bf16x8 pa0, pa1, pa2, pa3;
            { const int qb_ = vst_row(32 * ri + r32, 2) + 16 * hi;
              qf[0] = *(const LAS bf16x8*)(G + SC_QD + qb_); qf[1] = *(const LAS bf16x8*)(G + SC_QD + qb_ + 32); qf[2] = *(const LAS bf16x8*)(G + SC_QD + qb_ + 512); qf[3] = *(const LAS bf16x8*)(G + SC_QD + qb_ + 544); }
            { f32x16 p0 = {}, p1 = {};
              const int kb0 = vst_row(r32, 2) + 16 * hi, kb1 = vst_row(32 + r32, 2) + 16 * hi;
              { const bf16x8 a0 = *(const LAS bf16x8*)(G + SC_KI + kb0), a1 = *(const LAS bf16x8*)(G + SC_KI + kb0 + 32), a2 = *(const LAS bf16x8*)(G + SC_KI + kb0 + 512), a3 = *(const LAS bf16x8*)(G + SC_KI + kb0 + 544);
                p0 = __builtin_amdgcn_mfma_f32_32x32x16_bf16(a0, qf[0], p0, 0, 0, 0); p0 = __builtin_amdgcn_mfma_f32_32x32x16_bf16(a1, qf[1], p0, 0, 0, 0);
                p0 = __builtin_amdgcn_mfma_f32_32x32x16_bf16(a2, qf[2], p0, 0, 0, 0); p0 = __builtin_amdgcn_mfma_f32_32x32x16_bf16(a3, qf[3], p0, 0, 0, 0); }
              if (ri == 1) {
                  const bf16x8 c0 = *(const LAS bf16x8*)(G + SC_KI + kb1), c1 = *(const LAS bf16x8*)(G + SC_KI + kb1 + 32), c2 = *(const LAS bf16x8*)(G + SC_KI + kb1 + 512), c3 = *(const LAS bf16x8*)(G + SC_KI + kb1 + 544);
                  p1 = __builtin_amdgcn_mfma_f32_32x32x16_bf16(c0, qf[0], p1, 0, 0, 0); p1 = __builtin_amdgcn_mfma_f32_32x32x16_bf16(c1, qf[1], p1, 0, 0, 0);
                  p1 = __builtin_amdgcn_mfma_f32_32x32x16_bf16(c2, qf[2], p1, 0, 0, 0); p1 = __builtin_amdgcn_mfma_f32_32x32x16_bf16(c3, qf[3], p1, 0, 0, 0); }
#pragma unroll
              for (int r = 0; r < 16; ++r) { const bool keep = crow(r, hi) <= r32; if (ri == 0) { p0[r] = keep ? p0[r] : 0.f; } else { p1[r] = keep ? p1[r] : 0.f; } }
              PK4(p0, 0, pa0); PK4(p0, 8, pa1); PK4(p1, 0, pa2); PK4(p1, 8, pa3); }
            const unsigned vb = gaddr + SC_VT + v_rd_base(lane) + dq * 512, sbv = gaddr + SC_ST + v_rd_base(lane) + dq * 512;
#define SC_FR4(dst, base) do { const s16x4 l0_ = tr_read<0>(base), h0_ = tr_read<2048>(base), l1_ = tr_read<4096>(base), h1_ = tr_read<4096 + 2048>(base); \
              const s16x4 l2_ = tr_read<8192>(base), h2_ = tr_read<8192 + 2048>(base), l3_ = tr_read<12288>(base), h3_ = tr_read<12288 + 2048>(base); \
              asm volatile("s_waitcnt lgkmcnt(0)" ::: "memory"); SBAR(); \
              dst[0] = PKF(l0_, h0_); dst[1] = PKF(l1_, h1_); dst[2] = PKF(l2_, h2_); dst[3] = PKF(l3_, h3_); } while (0)
            bf16x8 vf_[4];
            { bf16x8 sf_[4]; SC_FR4(vf_, vb); SC_FR4(sf_, sbv); f32x16 o_ = {};
              o_ = __builtin_amdgcn_mfma_f32_32x32x16_bf16(pa0, vf_[0], o_, 0, 0, 0); o_ = __builtin_amdgcn_mfma_f32_32x32x16_bf16(pa1, vf_[1], o_, 0, 0, 0);
              if (ri == 1) { o_ = __builtin_amdgcn_mfma_f32_32x32x16_bf16(pa2, vf_[2], o_, 0, 0, 0); o_ = __builtin_amdgcn_mfma_f32_32x32x16_bf16(pa3, vf_[3], o_, 0, 0, 0); }
              o_ = __builtin_amdgcn_mfma_f32_32x32x16_bf16(qf[0], sf_[0], o_, 0, 0, 0); o_ = __builtin_amdgcn_mfma_f32_32x32x16_bf16(qf[1], sf_[1], o_, 0, 0, 0);
              o_ = __builtin_amdgcn_mfma_f32_32x32x16_bf16(qf[2], sf_[2], o_, 0, 0, 0); o_ = __builtin_amdgcn_mfma_f32_32x32x16_bf16(qf[3], sf_[3], o_, 0, 0, 0);
              char* dst_ = (char*)OUT;
#pragma unroll
              for (int r = 0; r < 16; r += 2) { const int i_ = 32 * ri + crow(r, hi); const int t_ = SC_TOK(s, i_); const unsigned w_ = pk2(o_[r], o_[r + 1]);
                  const unsigned a_ = (unsigned)(row0 + t_) * (unsigned)(D * 2) + (unsigned)(hh * 128 + 32 * dq + r32) * 2u;
                  *(bf16*)(dst_ + a_) = (bf16)w_; *(bf16*)(dst_ + (dir == 0 ? a_ + (unsigned)(D * 2) : a_ - (unsigned)(D * 2))) = (bf16)(w_ >> 16); } }
            __syncthreads();
            { const unsigned kt = gaddr + SC_KI + v_rd_base(lane) + ri * 512;
              bf16x8 kf[4];
              { const s16x4 l0_ = tr_read<0>(kt), h0_ = tr_read<1024>(kt), l1_ = tr_read<2048>(kt), h1_ = tr_read<2048 + 1024>(kt), l2_ = tr_read<4096>(kt), h2_ = tr_read<4096 + 1024>(kt), l3_ = tr_read<6144>(kt), h3_ = tr_read<6144 + 1024>(kt);
                asm volatile("s_waitcnt lgkmcnt(0)" ::: "memory"); SBAR();
                kf[0] = PKF(l0_, h0_); kf[1] = PKF(l1_, h1_); kf[2] = PKF(l2_, h2_); kf[3] = PKF(l3_, h3_); }
#pragma unroll
              for (int ks = 0; ks < 4; ++ks) sacc = __builtin_amdgcn_mfma_f32_32x32x16_bf16(kf[ks], vf_[ks], sacc, 0, 0, 0);
              const int stb_ = (hi + 4 * ri) * 2048 + dq * 512 + r32 * 2;
#pragma unroll
              for (int r = 0; r < 16; r += 2) { const int dk = 32 * ri + crow(r, hi); const float dl0 = ((LAS float*)(G + SC_DL))[dk], dl1 = ((LAS float*)(G + SC_DL))[dk + 1];
                  sacc[r] *= dl0; sacc[r + 1] *= dl1; const unsigned w_ = pk2(sacc[r], sacc[r + 1]);
                  LAS unsigned char* sp_ = G + SC_ST + stb_ + ((r >> 3) & 1) * 4096 + ((r & 3) + 4 * ((r >> 2) & 1)) * 64;
                  *(LAS unsigned short*)sp_ = (unsigned short)w_; *(LAS unsigned short*)(sp_ + 64) = (unsigned short)(w_ >> 16); } }
        }
        if (!lat) { int l2 = F.lane; asm volatile("" : "+v"(l2)); const int r32 = l2 & 31, hi = l2 >> 5; float* SO = POUT + (gla ? OUT_SGLA : OUT_SRET) + ((size_t)((sb * 2 + li) * 2 + dir) * 4 + h) * 8192;
#pragma unroll
            for (int r = 0; r < 16; ++r) SO[(32 * ri + crow(r, hi)) * 128 + 32 * dq + r32] = sacc[r]; }
    }
#undef SC_TOK
#undef SC_LOAD
#undef SC_FR4
}
__device__ __forceinline__ void scan_combine(Frame& F, const Params& P, int li) {
    unsigned char* ws = PWS;
    const char* PROJ = (const char*)(ws + WS_BIG); const char* OF = (const char*)(ws + WS_Y); char* OB = (char*)(ws + WS_HB);
    const int gw = F.vcu * NWAVES + F.wave, NGW = F.G * NWAVES, lane = F.lane, hh = lane >> 3, dv = (lane & 7) * 16;
    f32x4 gn[4];
    { const float* gp_ = PIN(I_GLAN) + li * 128 + dv;
#pragma unroll
      for (int j = 0; j < 4; ++j) gn[j] = hh < 4 ? *(const f32x4*)(gp_ + 4 * j) : (f32x4){1.f, 1.f, 1.f, 1.f}; }
    const unsigned gcol = (unsigned)((hh < 4 ? PC_GA : PC_GB) + (hh & 3) * 128 + dv) * 2u, ocol = (unsigned)(hh * 128 + dv) * 2u;
    for (int row = gw; row < M; row += 2 * NGW) {
        v4u a[2][2], b[2][2], g[2][2];
#pragma unroll
        for (int i = 0; i < 2; ++i) { const int r_ = row + i * NGW; if (r_ < M) {
            const unsigned off = (unsigned)r_ * (unsigned)(D * 2) + ocol, goff = (unsigned)r_ * (unsigned)(EVEN_NP * 2) + gcol;
            a[i][0] = *(const v4u*)(OF + off); a[i][1] = *(const v4u*)(OF + off + 16); b[i][0] = *(const v4u*)(OB + off); b[i][1] = *(const v4u*)(OB + off + 16);
            g[i][0] = *(const v4u*)(PROJ + goff); g[i][1] = *(const v4u*)(PROJ + goff + 16); } }
#pragma unroll
        for (int i = 0; i < 2; ++i) { const int r_ = row + i * NGW; if (r_ < M) {
            const unsigned off = (unsigned)r_ * (unsigned)(D * 2) + ocol;
            float x[16], gg[16];
#pragma unroll
            for (int hf = 0; hf < 2; ++hf)
#pragma unroll
                for (int e = 0; e < 4; ++e) { x[8 * hf + 2 * e] = bflo(a[i][hf][e]) + bflo(b[i][hf][e]); x[8 * hf + 2 * e + 1] = bfhi(a[i][hf][e]) + bfhi(b[i][hf][e]);
                    gg[8 * hf + 2 * e] = bflo(g[i][hf][e]); gg[8 * hf + 2 * e + 1] = bfhi(g[i][hf][e]); }
            float ss = 0.f;
#pragma unroll
            for (int e = 0; e < 16; ++e) ss += x[e] * x[e];
            ss += __shfl_xor(ss, 1); ss += __shfl_xor(ss, 2); ss += __shfl_xor(ss, 4);
            const float rstd = __builtin_amdgcn_rsqf(ss * (1.0f / 128.0f) + EPS);
#pragma unroll
            for (int e = 0; e < 16; ++e) x[e] = x[e] * rstd * gn[e >> 2][e & 3] * siluf(gg[e]);
            *(v4u*)(OB + off) = (v4u){pk2(x[0], x[1]), pk2(x[2], x[3]), pk2(x[4], x[5]), pk2(x[6], x[7])};
            *(v4u*)(OB + off + 16) = (v4u){pk2(x[8], x[9]), pk2(x[10], x[11]), pk2(x[12], x[13]), pk2(x[14], x[15])}; } }
    }
}

__device__ __forceinline__ void kpe_pass(Frame& F, const Params& P, int li) {
    unsigned char* ws = PWS;
    const float* KR = (const float*)(ws + WS_Y); const float* ROPE = (const float*)(ws + WS_ROPE);
    bf16* KPE = (bf16*)(ws + WS_KPE) + (size_t)li * MKV * 64;
    const int gt = F.vcu * 512 + F.tid, NGT = F.G * 512;
    for (int i = gt; i < M * 4; i += NGT) {
        const int row = i >> 2, c8 = i & 3;
        const float* s = KR + (size_t)row * 64 + 8 * c8;
        f32x4 a0 = *(const f32x4*)s, a1 = *(const f32x4*)(s + 4), b0 = *(const f32x4*)(s + 32), b1 = *(const f32x4*)(s + 36);
        int drow = row;
        if (row >= M_CTX) { const int lb = (row - M_CTX) >> 11, t = (row - M_CTX) & 2047; drow = M_CTX + lb * LKV + PAST + t;
            const float* cp = ROPE + (size_t)t * 32 + 8 * c8; const float* sp = cp + 65536;
            const f32x4 c0 = *(const f32x4*)cp, c1 = *(const f32x4*)(cp + 4), s0 = *(const f32x4*)sp, s1 = *(const f32x4*)(sp + 4);
            const f32x4 x0 = a0 * c0 - b0 * s0, x1 = a1 * c1 - b1 * s1, y0 = a0 * s0 + b0 * c0, y1 = a1 * s1 + b1 * c1;
            a0 = x0; a1 = x1; b0 = y0; b1 = y1; }
        bf16* d = KPE + (size_t)drow * 64 + 8 * c8;
        *(v4u*)d = (v4u){pk2(a0[0], a0[1]), pk2(a0[2], a0[3]), pk2(a1[0], a1[1]), pk2(a1[2], a1[3])};
        *(v4u*)(d + 32) = (v4u){pk2(b0[0], b0[1]), pk2(b0[2], b0[3]), pk2(b1[0], b1[1]), pk2(b1[2], b1[3])};
    }
}

constexpr float ATT_SCALE = 0.07216878364870322f;
constexpr float ATT_THR = 8.f;
constexpr int AT_V = 0, AT_KN = 32768, AT_KP = 65536, AT_WS = 81920, AT_VB = 16384, AT_KNB = 16384, AT_KPB = 8192;
#define KSWZ(row, colB) ((row) * 256 + ((colB) ^ (((row) & 7) << 4)))
#define KPSWZ(row, colB) ((row) * 128 + ((colB) ^ (((row) & 7) << 4)))
__device__ __forceinline__ void at_partialSM(f32x16& p0, f32x16& p1, float& m_reg, float& mn, float& alpha) {
    constexpr float C = ATT_SCALE * 1.4426950408889634f;
    float pmax = p0[0];
#pragma unroll
    for (int r = 1; r < 16; ++r) pmax = fmaxf(pmax, p0[r]);
#pragma unroll
    for (int r = 0; r < 16; ++r) pmax = fmaxf(pmax, p1[r]);
    { auto rr = __builtin_amdgcn_permlane32_swap(__float_as_uint(pmax), __float_as_uint(pmax), false, false); pmax = fmaxf(__uint_as_float(rr[0]), __uint_as_float(rr[1])); }
    if (__builtin_expect(__all(pmax - m_reg <= ATT_THR / ATT_SCALE), 1)) { mn = m_reg; alpha = 1.f; }
    else { mn = fmaxf(m_reg, pmax); alpha = __builtin_amdgcn_exp2f((m_reg - mn) * C); m_reg = mn; }
    const float mnC = -mn * C;
#pragma unroll
    for (int r = 0; r < 16; ++r) p0[r] = fmaf(p0[r], C, mnC);
#pragma unroll
    for (int r = 0; r < 16; ++r) p1[r] = fmaf(p1[r], C, mnC);
#pragma unroll
    for (int r = 0; r < 16; ++r) p0[r] = __builtin_amdgcn_exp2f(p0[r]);
}
__device__ __forceinline__ void at_finishSM(f32x16& p0, f32x16& p1, float alpha, float& l_reg, bf16x8& pa0, bf16x8& pa1, bf16x8& pa2, bf16x8& pa3) {
#pragma unroll
    for (int r = 0; r < 16; ++r) p1[r] = __builtin_amdgcn_exp2f(p1[r]);
    float ps = 0;
#pragma unroll
    for (int r = 0; r < 16; ++r) ps += p0[r];
#pragma unroll
    for (int r = 0; r < 16; ++r) ps += p1[r];
    { auto rr = __builtin_amdgcn_permlane32_swap(__float_as_uint(ps), __float_as_uint(ps), false, false); ps = __uint_as_float(rr[0]) + __uint_as_float(rr[1]); }
    l_reg = l_reg * alpha + ps;
    PK4(p0, 0, pa0); PK4(p0, 8, pa1); PK4(p1, 0, pa2); PK4(p1, 8, pa3);
}
__device__ __forceinline__ void at_qkt(f32x16& p0, f32x16& p1, const LAS unsigned char* Kn, const LAS unsigned char* Kp, const bf16x8* qr, const int* kb, const int* pb) {
    p0 = f32x16{}; p1 = f32x16{};
#pragma unroll
    for (int d0 = 0; d0 < 8; ++d0) {
        const bf16x8 b0 = *(const LAS bf16x8*)(Kn + kb[d0 & 3] + 128 * (d0 >> 2)), b1 = *(const LAS bf16x8*)(Kn + kb[d0 & 3] + 128 * (d0 >> 2) + 8192);
        p0 = __builtin_amdgcn_mfma_f32_32x32x16_bf16(b0, qr[d0], p0, 0, 0, 0);
        p1 = __builtin_amdgcn_mfma_f32_32x32x16_bf16(b1, qr[d0], p1, 0, 0, 0); }
#pragma unroll
    for (int d0 = 0; d0 < 4; ++d0) {
        const bf16x8 b0 = *(const LAS bf16x8*)(Kp + pb[d0]), b1 = *(const LAS bf16x8*)(Kp + pb[d0] + 4096);
        p0 = __builtin_amdgcn_mfma_f32_32x32x16_bf16(b0, qr[8 + d0], p0, 0, 0, 0);
        p1 = __builtin_amdgcn_mfma_f32_32x32x16_bf16(b1, qr[8 + d0], p1, 0, 0, 0); }
}
template <int D0> __device__ __forceinline__ void at_pv_one(f32x16& od, unsigned vb, bf16x8 pa0, bf16x8 pa1, bf16x8 pa2, bf16x8 pa3) {
    const s16x4 l0 = tr_read<D0 * 512>(vb), h0 = tr_read<D0 * 512 + 2048>(vb), l1 = tr_read<D0 * 512 + 4096>(vb), h1 = tr_read<D0 * 512 + 4096 + 2048>(vb);
    const s16x4 l2 = tr_read<D0 * 512 + 8192>(vb), h2 = tr_read<D0 * 512 + 8192 + 2048>(vb), l3 = tr_read<D0 * 512 + 12288>(vb), h3 = tr_read<D0 * 512 + 12288 + 2048>(vb);
    asm volatile("s_waitcnt lgkmcnt(0)" ::: "memory"); SBAR();
    od = __builtin_amdgcn_mfma_f32_32x32x16_bf16(pa0, PKF(l0, h0), od, 0, 0, 0);
    od = __builtin_amdgcn_mfma_f32_32x32x16_bf16(pa1, PKF(l1, h1), od, 0, 0, 0);
    od = __builtin_amdgcn_mfma_f32_32x32x16_bf16(pa2, PKF(l2, h2), od, 0, 0, 0);
    od = __builtin_amdgcn_mfma_f32_32x32x16_bf16(pa3, PKF(l3, h3), od, 0, 0, 0);
}
__device__ __forceinline__ void at_pv(f32x16* o, unsigned vb, bf16x8 pa0, bf16x8 pa1, bf16x8 pa2, bf16x8 pa3) {
    at_pv_one<0>(o[0], vb, pa0, pa1, pa2, pa3); at_pv_one<1>(o[1], vb, pa0, pa1, pa2, pa3); at_pv_one<2>(o[2], vb, pa0, pa1, pa2, pa3); at_pv_one<3>(o[3], vb, pa0, pa1, pa2, pa3);
}
__device__ __forceinline__ void attn_unit(Frame& F, const bf16* Qrow0  , const bf16* KVh  , const bf16* KPEs  ,
                                          bf16* Orow0, int nkeys, const float* ROPE, int tpos0  ) {
    LAS unsigned char* lds = F.lds;
    const int tid = F.tid, wid = F.wave, lane = F.lane, r32 = lane & 31, hi = lane >> 5;
    LAS float* wsf = (LAS float*)(lds + AT_WS) + wid * 64; LAS float* li_l = wsf; LAS float* al_l = wsf + 32;
    float m_reg = -1e30f, l_reg = 0; f32x16 o[4] = {}; bf16x8 qr[12];
    { const bf16* Qw = Qrow0 + (size_t)(wid * 32 + r32) * 1536 + hi * 8;
#pragma unroll
      for (int d0 = 0; d0 < 12; ++d0) qr[d0] = *(const bf16x8*)(Qw + d0 * 16);
      if (tpos0 >= 0) {
          const int t = tpos0 + wid * 32 + r32;
#pragma unroll
          for (int half = 0; half < 2; ++half) {
              const float* cp = ROPE + (size_t)t * 32 + 16 * half + 8 * hi; const float* sp = cp + 65536;
              const v4u xa = __builtin_bit_cast(v4u, qr[8 + half]), xb = __builtin_bit_cast(v4u, qr[10 + half]);
              float x1[8], x2[8];
              x1[0] = bflo(xa.x); x1[1] = bfhi(xa.x); x1[2] = bflo(xa.y); x1[3] = bfhi(xa.y); x1[4] = bflo(xa.z); x1[5] = bfhi(xa.z); x1[6] = bflo(xa.w); x1[7] = bfhi(xa.w);
              x2[0] = bflo(xb.x); x2[1] = bfhi(xb.x); x2[2] = bflo(xb.y); x2[3] = bfhi(xb.y); x2[4] = bflo(xb.z); x2[5] = bfhi(xb.z); x2[6] = bflo(xb.w); x2[7] = bfhi(xb.w);
              float y1[8], y2[8];
#pragma unroll
              for (int j = 0; j < 8; ++j) { const float c = cp[j], s = sp[j]; y1[j] = x1[j] * c - x2[j] * s; y2[j] = x1[j] * s + x2[j] * c; }
              const v4u wa = {pk2(y1[0], y1[1]), pk2(y1[2], y1[3]), pk2(y1[4], y1[5]), pk2(y1[6], y1[7])}, wb = {pk2(y2[0], y2[1]), pk2(y2[2], y2[3]), pk2(y2[4], y2[5]), pk2(y2[6], y2[7])};
              if (half == 0) { qr[8] = __builtin_bit_cast(bf16x8, wa); qr[10] = __builtin_bit_cast(bf16x8, wb); } else { qr[9] = __builtin_bit_cast(bf16x8, wa); qr[11] = __builtin_bit_cast(bf16x8, wb); }
          }
      } }
    const unsigned vb0 = (unsigned)(uintptr_t)(lds + AT_V) + v_rd_base(lane);
#define AT_OPQ() int l_ = lane; asm volatile("" : "+v"(l_))
#define AT_KADDR() int kbs[4], pbs[4]; { AT_OPQ(); _Pragma("unroll") for (int b = 0; b < 4; ++b) { const int x = (32 * b + 16 * (l_ >> 5)) ^ ((l_ & 7) << 4); kbs[b] = (l_ & 31) * 256 + x; pbs[b] = (l_ & 31) * 128 + x; } }
#define AT_GLDS(gp, ldsoff) __builtin_amdgcn_global_load_lds((const unsigned*)(gp), (LAS unsigned*)(lds + (ldsoff)), 16, 0, 0)
#define AT_DMA_K(t, b) do { AT_OPQ(); const char* kb_ = (const char*)KVh + (size_t)(t) * (64 * 4096); const char* pb_ = (const char*)KPEs + (size_t)(t) * (64 * 128); \
    const int row0_ = 4 * wid + (l_ >> 4), cB0_ = ((l_ & 15) * 16) ^ ((row0_ & 7) << 4), row1_ = row0_ + 32, rowp_ = 8 * wid + (l_ >> 3), cBp_ = ((l_ & 7) * 16) ^ ((rowp_ & 7) << 4); \
    AT_GLDS(kb_ + (unsigned)(row0_ * 4096 + cB0_), AT_KN + (b) * AT_KNB + wid * 1024); AT_GLDS(kb_ + (unsigned)(row1_ * 4096 + cB0_), AT_KN + (b) * AT_KNB + (wid + 8) * 1024); \
    AT_GLDS(pb_ + (unsigned)(rowp_ * 128 + cBp_), AT_KP + (b) * AT_KPB + wid * 1024); } while (0)
#define AT_DMA_V(t, b) do { AT_OPQ(); const char* vb_ = (const char*)KVh + (size_t)(t) * (64 * 4096); \
    const int st_ = 2 * wid + (l_ >> 5), kk_ = (st_ >> 2) * 8 + ((l_ & 31) >> 2), key_ = (kk_ & ~0xC) | ((kk_ & 4) << 1) | ((kk_ & 8) >> 1), col_ = (st_ & 3) * 32 + (l_ & 3) * 8; \
    AT_GLDS(vb_ + (unsigned)(key_ * 4096 + (128 + col_) * 2), AT_V + (b) * AT_VB + wid * 1024); AT_GLDS(vb_ + (unsigned)((key_ + 32) * 4096 + (128 + col_) * 2), AT_V + (b) * AT_VB + (wid + 8) * 1024); } while (0)
#define AT_RESC(a) do { if (__any((a) < 1.f)) { if (hi == 0) al_l[r32] = (a); asm volatile("s_waitcnt lgkmcnt(0)" ::: "memory"); \
    _Pragma("unroll") for (int d = 0; d < 4; ++d) _Pragma("unroll") for (int r = 0; r < 16; ++r) o[d][r] *= al_l[crow(r, hi)]; } } while (0)
#define AT_SYNC() do { VM_WAIT(); __syncthreads(); } while (0)
    f32x16 pA0, pA1, pB0, pB1; float mnA, mnB, alA, alB; bf16x8 pa0, pa1, pa2, pa3; const int NT = nkeys / 64;
    const LAS unsigned char* Kn0 = lds + AT_KN; const LAS unsigned char* Kn1 = lds + AT_KN + AT_KNB; const LAS unsigned char* Kp0 = lds + AT_KP; const LAS unsigned char* Kp1 = lds + AT_KP + AT_KPB;
    AT_DMA_K(0, 0); AT_SYNC();
    AT_DMA_K(1, 1); AT_DMA_V(0, 0);
    { AT_KADDR(); at_qkt(pA0, pA1, Kn0, Kp0, qr, kbs, pbs); } at_partialSM(pA0, pA1, m_reg, mnA, alA);
    AT_SYNC();
    for (int j = 1; j + 1 < NT; j += 2) {
        AT_DMA_K(j + 1, 0); AT_DMA_V(j, 1);
        SBAR(); { AT_KADDR(); at_qkt(pB0, pB1, Kn1, Kp1, qr, kbs, pbs); }
        at_finishSM(pA0, pA1, alA, l_reg, pa0, pa1, pa2, pa3); SBAR();
        at_pv(o, vb0, pa0, pa1, pa2, pa3); at_partialSM(pB0, pB1, m_reg, mnB, alB);
        AT_RESC(alB); AT_SYNC();
        AT_DMA_K(j + 2, 1); AT_DMA_V(j + 1, 0);
        SBAR(); { AT_KADDR(); at_qkt(pA0, pA1, Kn0, Kp0, qr, kbs, pbs); }
        at_finishSM(pB0, pB1, alB, l_reg, pa0, pa1, pa2, pa3); SBAR();
        at_pv(o, vb0 + AT_VB, pa0, pa1, pa2, pa3); at_partialSM(pA0, pA1, m_reg, mnA, alA);
        AT_RESC(alA); AT_SYNC();
    }
    AT_DMA_V(NT - 1, 1);
    SBAR(); { AT_KADDR(); at_qkt(pB0, pB1, Kn1, Kp1, qr, kbs, pbs); }
    at_finishSM(pA0, pA1, alA, l_reg, pa0, pa1, pa2, pa3); SBAR();
    at_pv(o, vb0, pa0, pa1, pa2, pa3); at_partialSM(pB0, pB1, m_reg, mnB, alB);
    AT_RESC(alB); AT_SYNC();
    at_finishSM(pB0, pB1, alB, l_reg, pa0, pa1, pa2, pa3); SBAR();
    at_pv(o, vb0 + AT_VB, pa0, pa1, pa2, pa3);
    if (hi == 0) li_l[r32] = l_reg; asm volatile("s_waitcnt lgkmcnt(0)" ::: "memory");
    float rli[16];
#pragma unroll
    for (int r = 0; r < 16; ++r) rli[r] = __builtin_amdgcn_rcpf(li_l[crow(r, hi)]);
    bf16* Ow = Orow0 + (size_t)(wid * 32) * D;
#pragma unroll
    for (int r = 0; r < 16; r += 2) { const int orow = crow(r, hi);
#pragma unroll
        for (int d0 = 0; d0 < 4; ++d0) { const unsigned w = pk2(o[d0][r] * rli[r], o[d0][r + 1] * rli[r + 1]);
            Ow[(size_t)orow * D + d0 * 32 + r32] = (bf16)w; Ow[(size_t)(orow + 1) * D + d0 * 32 + r32] = (bf16)(w >> 16); } }
#undef AT_GLDS
#undef AT_OPQ
#undef AT_KADDR
#undef AT_DMA_K
#undef AT_DMA_V
#undef AT_RESC
#undef AT_SYNC
}
__device__ __forceinline__ void attn_phase(Frame& F, const Params& P, int li) {
    unsigned char* ws = PWS;
    const bf16* Q = (const bf16*)(ws + WS_Q); const bf16* KV = (const bf16*)(ws + WS_KV); const bf16* KPE = (const bf16*)(ws + WS_KPE) + (size_t)li * MKV * 64;
    bf16* OB = (bf16*)(ws + WS_HB); const float* ROPE = (const float*)(ws + WS_ROPE);
    for (int u = F.vcu; u < 256 + 128; u += F.G) {
        for (int k = 0; k < 2; ++k) {
            int qrow0, kvrow0, nkeys, h, tpos0;
            if (u < 256) { const int id = 2 * u + k, lb = id >> 6, qb = id & 7; h = (id >> 3) & 7; qrow0 = M_CTX + lb * L_LAT + qb * 256; kvrow0 = M_CTX + lb * LKV; nkeys = LKV; tpos0 = qb * 256; }
            else { if (k == 1) break; const int id = u - 256, b = id >> 3; h = id & 7; qrow0 = b * L_CTX; kvrow0 = b * L_CTX; nkeys = L_CTX; tpos0 = -1; }
            __syncthreads();
            attn_unit(F, Q + (size_t)qrow0 * 1536 + h * 192, KV + (size_t)kvrow0 * 2048 + h * 256, KPE + (size_t)kvrow0 * 64, OB + (size_t)qrow0 * D + h * 128, nkeys, ROPE, tpos0);
        }
    }
}

constexpr int N_PHASES = 2 + 2 * 18;
__global__ void __launch_bounds__(NWAVES * 64, 2) hyb_fwd(Params P) {
    extern __shared__ __attribute__((aligned(16))) unsigned char lds_raw[];
    Frame F;
    F.lds = (LAS unsigned char*)lds_raw;
    F.tid = threadIdx.x; F.lane = F.tid & 63; F.wave = __builtin_amdgcn_readfirstlane(F.tid >> 6);
    F.G = gridDim.x; { const int bx = blockIdx.x; F.vcu = (F.G % 8 == 0) ? (bx % 8) * (F.G / 8) + bx / 8 : bx; }
    volatile LAS unsigned* MISC = (volatile LAS unsigned*)(F.lds + LDS_MISC);
    if (F.tid < 64) MISC[F.tid] = 0u;
    if (F.tid < 30) { const unsigned long long v = F.tid < 28 ? (unsigned long long)P.in[F.tid] : (F.tid == 28 ? (unsigned long long)P.out : (unsigned long long)P.ws);
        volatile LAS unsigned* pt = (volatile LAS unsigned*)(F.lds + LDS_PT) + 2 * F.tid; pt[0] = (unsigned)v; pt[1] = (unsigned)(v >> 32); }
    __syncthreads();
    const int use_bar = P.use_bar, ph_hi = P.ph_hi;
    XcdBarrier bar; bar.bar = (unsigned*)(PWS + WS_CTL) + 4096; bar.x = 0; bar.st = nullptr;
    if (use_bar) bar = xcd_barrier_post((unsigned*)(PWS + WS_CTL) + 4096, MISC + 8);

    int dup_done = 0; (void)dup_done;
    for (int ph = P.ph_lo; ph < ph_hi; ++ph) {
#define REFRESH_ID() do { int t_ = threadIdx.x; asm volatile("" : "+v"(t_)); F.tid = t_; F.lane = t_ & 63; F.wave = __builtin_amdgcn_readfirstlane(t_ >> 6); \
          int g_ = gridDim.x, b_ = blockIdx.x; asm volatile("" : "+s"(g_), "+s"(b_)); F.G = g_; F.vcu = (g_ % 8 == 0) ? (b_ % 8) * (g_ / 8) + b_ / 8 : b_; F.bid = b_; } while (0)
        REFRESH_ID();
        unsigned char* ws = PWS;
        float* XO = POUT + OUT_Y;
        bf16* HB = (bf16*)(ws + WS_HB); bf16* YB = (bf16*)(ws + WS_Y); const float* SL = (const float*)(ws + WS_BIG);
        const float* MOD = (const float*)(ws + WS_MOD);
#if defined(HYB_DUP_MASK)
#define ROWX_FOR(kb) ((((HYB_DUP_MASK >> (kb)) & 1) && dup_done == 0) ? (float*)(ws + WS_BIG + 64 * MiB) : XO)
#else
#define ROWX_FOR(kb) XO
#endif
        if (ph == 0) { p0_prologue(F, P); }
        else if (ph == 1) {
            const float* m0 = MOD;
            row_pass(F, PIN(I_XP), PIN(I_XS), nullptr, nullptr, nullptr, nullptr, nullptr, PIN(I_NMIXPRE), m0 + 1024, m0, HB, false, true);
        } else {
            const int q = ph - 2, pair = q / 18, r = q % 18; const bool odd = r >= 9; const int l = 2 * pair + (odd ? 1 : 0), k = odd ? r - 9 : r;
            const float* ml = MOD + (size_t)l * 9 * 6144;
            const int kind = k < 3 ? (odd ? 10 + k : (k == 2 ? 8 : k)) : (k == 3 ? 2 : k == 4 ? 3 : k == 5 ? 4 : k == 6 ? 5 : k == 7 ? 7 : 6);
            if (kind == 0) {
                pg8::Gemm g{HB, (const bf16*)(ws + WS_WINE) + (size_t)pair * EVEN_NP * 1024, M, EVEN_NP, 1024}; pg8::StaticOrder S; S.init(M, EVEN_NP, F.G, F.bid, 1024);
                pg8::EpiBf16<0> E{(bf16*)(ws + WS_BIG), EVEN_NP};
                pg8::gemm_phase<pg8::EpiBf16<0>, pg8::StaticOrder, true, true>(F.lds, g, S, E, F.tid);
            } else if (kind == 1) {
                scan_phase(F, P, pair);
            } else if (kind == 8) {
                scan_combine(F, P, pair);
            } else if (kind == 2) {
                const bf16* W = odd ? (const bf16*)(ws + WS_WOUTO) + (size_t)pair * 1024 * 1024 : (const bf16*)(ws + WS_WOUTE) + (size_t)pair * 1024 * 1024;
                { pg8::Gemm g{HB, W, M, 1024, 1024}; pg8::TailSplitOrder S; S.init(F.bid, 1024, 1);
                  pg8::EpiYsplit E{YB, (float*)(ws + WS_BIG)};
                  pg8::gemm_phase<pg8::EpiYsplit, pg8::TailSplitOrder, true, true>(F.lds, g, S, E, F.tid); }
                REFRESH_ID();
                { pg8::Gemm g{HB, W, M, 1024, 1024}; pg8::TailSplitOrder S; S.init(F.bid, 1024, 2);
                  pg8::EpiYsplit E{YB, (float*)(PWS + WS_BIG)};
                  pg8::gemm_phase<pg8::EpiYsplit, pg8::TailSplitOrder, true, true>(F.lds, g, S, E, F.tid); }
            } else if (kind == 3) {
                const float* xa = l == 0 ? PIN(I_XP) : XO; const float* xb = l == 0 ? PIN(I_XS) : XO + (size_t)M_CTX * D;
                row_pass(F, xa, xb, ROWX_FOR(3), YB, SL, PIN(I_NMIXPOST) + l * 1024, ml + 2048, PIN(I_NMLPPRE) + l * 1024, ml + 4096, ml + 3072, HB, true, true);
            } else if (kind == 4) {
                pg8::Gemm g{HB, (const bf16*)(ws + WS_W1) + (size_t)l * 4096 * 1024, M, FF, 1024}; pg8::StaticOrder S; S.init(M, FF, F.G, F.bid, 1024);
                pg8::EpiBf16<1> E{(bf16*)(ws + WS_BIG), FF};
                pg8::gemm_phase<pg8::EpiBf16<1>, pg8::StaticOrder, true, true>(F.lds, g, S, E, F.tid);
            } else if (kind == 5) {
                pg8::Gemm g{(const bf16*)(ws + WS_BIG), (const bf16*)(ws + WS_W2) + (size_t)l * 1024 * 4096, M, 1024, FF}; pg8::TailSplitOrder S; S.init(F.bid, FF, 1);
                pg8::EpiYsplit E{YB, (float*)(ws + WS_BIG)};
                pg8::gemm_phase<pg8::EpiYsplit, pg8::TailSplitOrder, true, true>(F.lds, g, S, E, F.tid);
            } else if (kind == 7) {
                pg8::Gemm g{(const bf16*)(ws + WS_BIG), (const bf16*)(ws + WS_W2) + (size_t)l * 1024 * 4096, M, 1024, FF}; pg8::TailSplitOrder S; S.init(F.bid, FF, 2);
                pg8::EpiYsplit E{YB, (float*)(ws + WS_BIG)};
                pg8::gemm_phase<pg8::EpiYsplit, pg8::TailSplitOrder, true, true>(F.lds, g, S, E, F.tid);
            } else if (kind == 6) {
                const bool last = l == 3; const float* mn = ml + 9 * 6144; const int ln = last ? 3 : l + 1;
                row_pass(F, XO, XO + (size_t)M_CTX * D, ROWX_FOR(6), YB, SL, PIN(I_NMLPPOST) + l * 1024, ml + 5120, PIN(I_NMIXPRE) + ln * 1024, mn + 1024, mn, HB, true, !last);
            } else if (kind == 10) {
                pg8::Gemm g{HB, (const bf16*)(ws + WS_WINO) + (size_t)pair * ODD_NP * 1024, M, ODD_NP, 1024}; pg8::StaticOrder S; S.init(M, ODD_NP, F.G, F.bid, 1024);
                pg8::EpiOddIn E{(bf16*)(ws + WS_QN), (bf16*)(ws + WS_ACKV) + (size_t)pair * MKV * 256, (float*)(ws + WS_Y), POUT + OUT_CKV, POUT + OUT_KPE,
                                PIN(I_QAN) + pair * 256, PIN(I_KVAN) + pair * 256, pair};
                pg8::gemm_phase<pg8::EpiOddIn, pg8::StaticOrder, false, true>(F.lds, g, S, E, F.tid);
            } else if (kind == 11) {
                kpe_pass(F, P, pair); REFRESH_ID();
                { pg8::Gemm g{(const bf16*)(ws + WS_QN), (const bf16*)(ws + WS_WQB) + (size_t)pair * 1536 * 256, M, 1536, 256}; pg8::StaticOrder S; S.init(M, 1536, F.G, F.bid, 256);
                  pg8::EpiBf16<0> E{(bf16*)(ws + WS_Q), 1536};
                  pg8::gemm_phase<pg8::EpiBf16<0>, pg8::StaticOrder, true, true>(F.lds, g, S, E, F.tid); }
                REFRESH_ID();
                { pg8::Gemm g{(const bf16*)(ws + WS_ACKV) + (size_t)pair * MKV * 256, (const bf16*)(ws + WS_WKVB) + (size_t)pair * 2048 * 256, MKV, 2048, 256}; pg8::StaticOrder S; S.init(MKV, 2048, F.G, F.bid, 256);
                  pg8::EpiBf16<0> E{(bf16*)(ws + WS_KV), 2048};
                  pg8::gemm_phase<pg8::EpiBf16<0>, pg8::StaticOrder, true, true>(F.lds, g, S, E, F.tid); }
            } else if (kind == 12) {
                attn_phase(F, P, pair);
            }
        }
#if defined(HYB_DUP_MASK)
        { int kind_ = -1;
          if (ph == 0) kind_ = 13;
          else if (ph >= 2) { const int q_ = ph - 2, r_ = q_ % 18; const bool odd_ = r_ >= 9; const int k_ = odd_ ? r_ - 9 : r_;
              kind_ = k_ < 3 ? (odd_ ? 10 + k_ : (k_ == 2 ? 8 : k_)) : (k_ == 3 ? 2 : k_ == 4 ? 3 : k_ == 5 ? 4 : k_ == 6 ? 5 : k_ == 7 ? 7 : 6); }
          if (kind_ >= 0 && ((HYB_DUP_MASK >> kind_) & 1) && dup_done == 0) { dup_done = 1; if (use_bar) { bar.bar = (unsigned*)(PWS + WS_CTL) + 4096; xcd_barrier(bar); } else { VM_WAIT(); __syncthreads(); } --ph; continue; } }
        dup_done = 0;
        if (((HYB_DUP_MASK >> 14) & 1) && ph + 1 < ph_hi && use_bar) { bar.bar = (unsigned*)(PWS + WS_CTL) + 4096; xcd_barrier(bar); }
#endif
        if (ph + 1 < ph_hi) { if (use_bar) { bar.bar = (unsigned*)(PWS + WS_CTL) + 4096; xcd_barrier(bar); } else { VM_WAIT(); __syncthreads(); } }
    }
}

#ifndef HYB_N_LAUNCHES
#define HYB_N_LAUNCHES 1
#endif
extern "C" void kernel_launch(void* const* d_in, const int* in_sizes, int n_in, void* d_out, int out_size, void* d_ws, size_t ws_size, hipStream_t stream) {
    static int grid = 0;
    if (grid == 0) {
        if (n_in != 28 || out_size != 27787264 || ws_size < WS_END) { fprintf(stderr, "kernel_launch: unexpected shapes: n_in %d out %d ws %zu (need >= %zu)\n", n_in, out_size, ws_size, (size_t)WS_END); grid = -1; return; }
        int dev = 0, cus = 0, per_cu = 0;
        if (hipGetDevice(&dev) != hipSuccess || hipDeviceGetAttribute(&cus, hipDeviceAttributeMultiprocessorCount, dev) != hipSuccess) { grid = -1; return; }
        if (hipFuncSetAttribute((const void*)hyb_fwd, hipFuncAttributeMaxDynamicSharedMemorySize, LDS_BYTES) != hipSuccess) { fprintf(stderr, "kernel_launch: hipFuncSetAttribute failed\n"); grid = -1; return; }
        if (hipOccupancyMaxActiveBlocksPerMultiprocessor(&per_cu, (const void*)hyb_fwd, NWAVES * 64, LDS_BYTES) != hipSuccess || per_cu < 1) { fprintf(stderr, "kernel_launch: occupancy query reports %d\n", per_cu); }
        (void)hipGetLastError();
        grid = cus;
    }
    if (grid < 0) return;
    (void)hipMemsetAsync((char*)d_ws + WS_CTL, 0, CTL_ZERO_BYTES, stream);
    Params a{};
    for (int i = 0; i < 28; ++i) a.in[i] = (const float*)d_in[i];
    a.out = (float*)d_out; a.ws = (unsigned char*)d_ws;
#if HYB_N_LAUNCHES == 1
    a.ph_lo = 0; a.ph_hi = N_PHASES; a.use_bar = 1; a.pad = 0;
    hipLaunchKernelGGL(hyb_fwd, dim3(grid), dim3(NWAVES * 64), LDS_BYTES, stream, a);
#else
    for (int ph = 0; ph < N_PHASES; ++ph) { a.ph_lo = ph; a.ph_hi = ph + 1; a.use_bar = 0; a.pad = 0;
        hipLaunchKernelGGL(hyb_fwd, dim3(grid), dim3(NWAVES * 64), LDS_BYTES, stream, a); }
#endif
    const hipError_t le = hipPeekAtLastError();
    if (le != hipSuccess) fprintf(stderr, "kernel_launch: launch failed: %s\n", hipGetErrorName(le));
}
```

```cpp
#include <hip/hip_runtime.h>
#include <hip/hip_bf16.h>
#include <cstdio>
#include <cstdint>
namespace pg8 {
#define PG8_LAS __attribute__((address_space(3)))
typedef unsigned short bf16_t;
typedef short bf16x8 __attribute__((ext_vector_type(8)));
typedef float f32x4 __attribute__((ext_vector_type(4)));
typedef unsigned u32x4 __attribute__((ext_vector_type(4)));
constexpr int BM = 256, BK = 64, HALF = 128, HTB = HALF * BK * 2  , STAGE_BYTES = 8 * HTB, NXCD = 8, WGM = 8;

__host__ __device__ __forceinline__ int lds_byte(int r, int c) { const int st = (r >> 4) * 2 + (c >> 5), rr = r & 15, cc = c & 31, ob = rr * 64 + cc * 2; return st * 1024 + (ob ^ (((ob >> 9) & 1) << 5)); }
__host__ __device__ __forceinline__ void stage_rc(int b, int& R, int& C) { const int st = b / 1024, sb = b % 1024, swz = sb ^ (((sb >> 9) & 1) << 5); R = (st >> 1) * 16 + swz / 64; C = (st & 1) * 32 + (swz % 64) / 2; }
__host__ __device__ __forceinline__ int perm32(int rho) { const int n = rho >> 4, i = rho & 15; return 8 * (i >> 2) + 4 * n + (i & 3); }

struct Unit { int pm, pn, ks, kt0, nt; };
struct Gemm { const bf16_t* A; const bf16_t* Bt; int M, N, K; };

struct StaticOrder {
    int nM, nN, nwg, G, c, ntk;
    __host__ __device__ void init(int M, int N, int G_, int c_, int K) { nM = M / BM; nN = N / BM; nwg = nM * nN; G = G_; c = c_; ntk = K / BK; }
    __host__ __device__ bool next(int i, Unit& u) const {
        const long L = (long)i * G + c; if (L >= nwg) return false;
        int wgid = (int)L; { const int q = nwg / NXCD, r = nwg % NXCD, xcd = wgid % NXCD, off = wgid / NXCD; wgid = (xcd < r ? xcd * (q + 1) : r * (q + 1) + (xcd - r) * q) + off; }
        const int nig = WGM * nN, gid = wgid / nig, fm = gid * WGM, gsz = (nM - fm) < WGM ? (nM - fm) : WGM;
        u.pm = fm + ((wgid % nig) % gsz); u.pn = (wgid % nig) / gsz; u.ks = -1; u.kt0 = 0; u.nt = ntk; return true;
    }
    __device__ __forceinline__ void a_ready(const Unit&) const {}
    __device__ __forceinline__ void done(const Unit&) const {}
};


struct TailSplitOrder {
    int c, ntk, mode;
    __device__ void init(int c_, int K, int mode_) { c = c_; ntk = K / BK; mode = mode_; }
    __device__ bool next(int i, Unit& u) const {
        const int xcd = c & 7, j = c >> 3;
        const int round = mode == 2 ? i + 1 : i;
        if (round == 0) { u.pm = xcd * 8 + (j & 7); u.pn = j >> 3; u.ks = -1; u.kt0 = 0; u.nt = ntk; return true; }
        if (round == 1 && mode != 1) { u.pm = 64 + xcd * 2 + (j & 1); u.pn = (j >> 1) & 3; u.ks = j >> 3; u.nt = ntk >> 2; u.kt0 = u.ks * u.nt; return true; }
        return false;
    }
    __device__ __forceinline__ void a_ready(const Unit&) const {}
    __device__ __forceinline__ void done(const Unit&) const {}
};

typedef float f32x2c_t __attribute__((ext_vector_type(2))); typedef __bf16 bf16x2c_t __attribute__((ext_vector_type(2)));
__device__ __forceinline__ unsigned cvt_pk_bf16(float lo, float hi) { f32x2c_t v = {lo, hi}; bf16x2c_t b = __builtin_convertvector(v, bf16x2c_t); return __builtin_bit_cast(unsigned, b); }

template <int ACT> struct EpiBf16 {
    static constexpr bool PERM = true, AFTER_DRAIN = false;
    bf16_t* O; int ldc;
    __device__ __forceinline__ void operator()(const f32x4 (&acc)[2][2][4][2], const Unit& u, int wr, int wc, int fr, int fq) const {
        const int row0 = u.pm * BM + wr * 64 + fr; const int col0 = u.pn * BM + wc * 32 + 8 * fq;
#pragma unroll
        for (int ai = 0; ai < 2; ++ai)
#pragma unroll
            for (int m = 0; m < 4; ++m) { bf16_t* rowp = O + (size_t)(row0 + ai * HALF + m * 16) * ldc + col0;
#pragma unroll
                for (int bj = 0; bj < 2; ++bj) { f32x4 v0 = acc[ai][bj][m][0], v1 = acc[ai][bj][m][1];
                    if (ACT == 1) {
#pragma unroll
                        for (int j = 0; j < 4; ++j) { const float a = fmaxf(v0[j], 0.f), b = fmaxf(v1[j], 0.f); v0[j] = a * a; v1[j] = b * b; } }
                    u32x4 w; w.x = cvt_pk_bf16(v0[0], v0[1]); w.y = cvt_pk_bf16(v0[2], v0[3]); w.z = cvt_pk_bf16(v1[0], v1[1]); w.w = cvt_pk_bf16(v1[2], v1[3]);
                    *(u32x4*)(rowp + bj * HALF) = w; } }
    }
};
struct EpiYsplit {
    static constexpr bool PERM = true, AFTER_DRAIN = false;
    bf16_t* Y; bf16_t* SL;
    __device__ __forceinline__ void operator()(const f32x4 (&acc)[2][2][4][2], const Unit& u, int wr, int wc, int fr, int fq) const {
        const int row0 = u.pm * BM + wr * 64 + fr; const int col0 = u.pn * BM + wc * 32 + 8 * fq;
        if (u.ks < 0) {
#pragma unroll
            for (int ai = 0; ai < 2; ++ai)
#pragma unroll
                for (int m = 0; m < 4; ++m) { bf16_t* rowp = Y + (size_t)(row0 + ai * HALF + m * 16) * 1024 + col0;
#pragma unroll
                    for (int bj = 0; bj < 2; ++bj) { const f32x4 v0 = acc[ai][bj][m][0], v1 = acc[ai][bj][m][1];
                        u32x4 w; w.x = cvt_pk_bf16(v0[0], v0[1]); w.y = cvt_pk_bf16(v0[2], v0[3]); w.z = cvt_pk_bf16(v1[0], v1[1]); w.w = cvt_pk_bf16(v1[2], v1[3]);
                        *(u32x4*)(rowp + bj * HALF) = w; } }
        } else {
            bf16_t* base = SL + (size_t)u.ks * (4096 * 1024);
#pragma unroll
            for (int ai = 0; ai < 2; ++ai)
#pragma unroll
                for (int m = 0; m < 4; ++m) { bf16_t* rowp = base + (size_t)(row0 - 16384 + ai * HALF + m * 16) * 1024 + col0;
#pragma unroll
                    for (int bj = 0; bj < 2; ++bj) { const f32x4 v0 = acc[ai][bj][m][0], v1 = acc[ai][bj][m][1];
                        u32x4 w; w.x = cvt_pk_bf16(v0[0], v0[1]); w.y = cvt_pk_bf16(v0[2], v0[3]); w.z = cvt_pk_bf16(v1[0], v1[1]); w.w = cvt_pk_bf16(v1[2], v1[3]);
                        *(u32x4*)(rowp + bj * HALF) = w; } }
        }
    }
};
struct EpiOddIn {
    static constexpr bool PERM = false, AFTER_DRAIN = true;
    bf16_t* QN; bf16_t* ACKV; float* KPERAW; float* out_ckv; float* out_kpe; const float* gq; const float* gkv; int li;
    __device__ __forceinline__ void fused(f32x4 (&acc)[2][2][4][2], const Unit& u, int wr, int wc, int fr, int fq, PG8_LAS unsigned char* lds, int wid, int lane) const {
        PG8_LAS float* P = (PG8_LAS float*)lds;
        if (u.pn < 2) {
#pragma unroll
            for (int ai = 0; ai < 2; ++ai)
#pragma unroll
                for (int m = 0; m < 4; ++m) { float s = 0.f;
#pragma unroll
                    for (int bj = 0; bj < 2; ++bj)
#pragma unroll
                        for (int n = 0; n < 2; ++n) { const f32x4 x = acc[ai][bj][m][n]; s += (x[0] * x[0] + x[1] * x[1]) + (x[2] * x[2] + x[3] * x[3]); }
                    s += __shfl_xor(s, 16); s += __shfl_xor(s, 32);
                    if (fq == 0) P[(ai * HALF + wr * 64 + m * 16 + fr) * 4 + wc] = s; }
        }
        asm volatile("s_waitcnt lgkmcnt(0)" ::: "memory"); __builtin_amdgcn_s_barrier(); asm volatile("" ::: "memory");
        if (u.pn < 2) {
            const float* gv = u.pn == 0 ? gq : gkv;
#pragma unroll
            for (int ai = 0; ai < 2; ++ai)
#pragma unroll
                for (int m = 0; m < 4; ++m) { const int r = ai * HALF + wr * 64 + m * 16 + fr; const int grow = u.pm * BM + r;
                    const float tot = (P[r * 4 + 0] + P[r * 4 + 1]) + (P[r * 4 + 2] + P[r * 4 + 3]);
                    const float rstd = 1.0f / sqrtf(tot * (1.0f / 256.0f) + 1e-6f);
                    const int drow = grow < 4096 ? grow : 4096 + ((grow - 4096) >> 11) * 2304 + 256 + ((grow - 4096) & 2047);
#pragma unroll
                    for (int bj = 0; bj < 2; ++bj)
#pragma unroll
                        for (int n = 0; n < 2; ++n) { const int col = bj * HALF + wc * 32 + n * 16 + 4 * fq; const f32x4 g = *(const f32x4*)(gv + col);
                            const f32x4 v = acc[ai][bj][m][n] * rstd * g;
                            unsigned long long w = (unsigned long long)cvt_pk_bf16(v[0], v[1]) | ((unsigned long long)cvt_pk_bf16(v[2], v[3]) << 32);
                            if (u.pn == 0) *(unsigned long long*)(QN + (size_t)grow * 256 + col) = w;
                            else { *(unsigned long long*)(ACKV + (size_t)drow * 256 + col) = w;
                                   if (grow < 4096) *(f32x4*)(out_ckv + ((size_t)((grow >> 8) * 2 + li) * 256 + (grow & 255)) * 256 + col) = v; } } }
        } else if (wc < 2) {
#pragma unroll
            for (int ai = 0; ai < 2; ++ai)
#pragma unroll
                for (int m = 0; m < 4; ++m) { const int r = ai * HALF + wr * 64 + m * 16 + fr; const int grow = u.pm * BM + r;
#pragma unroll
                    for (int n = 0; n < 2; ++n) { const int col = wc * 32 + n * 16 + 4 * fq; const f32x4 v = acc[ai][0][m][n];
                        *(f32x4*)(KPERAW + (size_t)grow * 64 + col) = v;
                        if (grow < 4096) *(f32x4*)(out_kpe + ((size_t)((grow >> 8) * 2 + li) * 256 + (grow & 255)) * 64 + col) = v; } }
        }
    }
};

template <class Epi, class Sched, bool ALIGN_EPI = false, bool SP2 = false>
__device__ __forceinline__ void gemm_phase(PG8_LAS unsigned char* lds, const Gemm g, const Sched& S, const Epi& E, const int tid) {
    const int  wid = __builtin_amdgcn_readfirstlane(tid >> 6), lane = tid & 63, wr = wid >> 2, wc = wid & 3, fr = lane & 15, fq = lane >> 4;
    const int K = g.K;
    unsigned voffA[2], voffB[2];
#pragma unroll
    for (int i = 0; i < 2; ++i) { int R, C; stage_rc(tid * 16 + i * 8192, R, C); const int Rb = Epi::PERM ? ((R & ~31) + perm32(R & 31)) : R;
        voffA[i] = (unsigned)(R * K + C) * 2u; voffB[i] = (unsigned)(Rb * K + C) * 2u; }
    const size_t kstep = (size_t)(BK * 2);
    const size_t hstep = (size_t)HALF * K * 2;
    const size_t tstep = 2 * hstep;
    const unsigned ldsw = (unsigned)wid * 1024u;
    const int aoff = lds_byte(wr * 64 + fr, fq * 8), boff = lds_byte(wc * 32 + fr, fq * 8);
#define PG8_SA(b, h) (((b) * 2 + (h)) * HTB)
#define PG8_SB(b, h) ((4 + (b) * 2 + (h)) * HTB)
#define PG8_STAGE(bufoff, gbase, voff) do { _Pragma("unroll") for (int _i = 0; _i < 2; ++_i) \
        __builtin_amdgcn_global_load_lds((const unsigned*)((const char*)(gbase) + (voff)[_i]), (PG8_LAS unsigned*)(lds + (bufoff) + ldsw + _i * 8192), 16, 0, 0); } while (0)
#define PG8_LDA(dst, b, h) do { _Pragma("unroll") for (int m = 0; m < 4; ++m) _Pragma("unroll") for (int k = 0; k < 2; ++k) dst[m][k] = *(const PG8_LAS bf16x8*)(lds + PG8_SA(b, h) + aoff + m * 2048 + k * 1024); } while (0)
#define PG8_LDB(dst, b, h) do { _Pragma("unroll") for (int n = 0; n < 2; ++n) _Pragma("unroll") for (int k = 0; k < 2; ++k) dst[n][k] = *(const PG8_LAS bf16x8*)(lds + PG8_SB(b, h) + boff + n * 2048 + k * 1024); } while (0)
#define PG8_MMA(ai, bj, At, Bt) do { __builtin_amdgcn_s_setprio(1); _Pragma("unroll") for (int m = 0; m < 4; ++m) _Pragma("unroll") for (int n = 0; n < 2; ++n) _Pragma("unroll") for (int k = 0; k < 2; ++k) \
        acc[ai][bj][m][n] = __builtin_amdgcn_mfma_f32_16x16x32_bf16(Bt[n][k], At[m][k], acc[ai][bj][m][n], 0, 0, 0); __builtin_amdgcn_s_setprio(0); } while (0)
#define PG8_WAIT_V(n) asm volatile("s_waitcnt vmcnt(" #n ")" ::: "memory")
#define PG8_WAIT_L(n) asm volatile("s_waitcnt lgkmcnt(" #n ")" ::: "memory")
#define PG8_BAR __builtin_amdgcn_s_barrier()
#define PG8_SCHED __builtin_amdgcn_sched_barrier(0)
    Unit cur, nxt; int ui = 0;
    if (!S.next(0, cur)) return;
    f32x4 acc[2][2][4][2];
#pragma unroll
    for (int a = 0; a < 2; ++a)
#pragma unroll
        for (int b = 0; b < 2; ++b)
#pragma unroll
            for (int m = 0; m < 4; ++m)
#pragma unroll
                for (int n = 0; n < 2; ++n) acc[a][b][m][n] = (f32x4){0.f, 0.f, 0.f, 0.f};
    bf16x8 At[4][2], B0[2][2], B1[2][2];
    const char* cA = (const char*)g.A + (size_t)cur.pm * tstep + (size_t)cur.kt0 * kstep; const char* cB = (const char*)g.Bt + (size_t)cur.pn * tstep + (size_t)cur.kt0 * kstep;
    S.a_ready(cur);
    if constexpr (SP2) {
        PG8_STAGE(PG8_SB(0, 0), cB, voffB); PG8_STAGE(PG8_SB(0, 1), cB + hstep, voffB); PG8_STAGE(PG8_SA(0, 0), cA, voffA); PG8_STAGE(PG8_SA(0, 1), cA + hstep, voffA);
        if (wr == 1) PG8_BAR;
        PG8_WAIT_V(2); PG8_BAR;
        PG8_STAGE(PG8_SB(1, 0), cB + kstep, voffB); PG8_STAGE(PG8_SA(1, 0), cA + kstep, voffA); PG8_STAGE(PG8_SB(1, 1), cB + hstep + kstep, voffB);
        PG8_WAIT_V(6); PG8_BAR;
    } else {
        PG8_STAGE(PG8_SB(0, 0), cB, voffB); PG8_STAGE(PG8_SA(0, 0), cA, voffA); PG8_STAGE(PG8_SB(0, 1), cB + hstep, voffB); PG8_STAGE(PG8_SA(0, 1), cA + hstep, voffA);
        if (wr == 1) PG8_BAR;
        PG8_WAIT_V(4); PG8_BAR;
        PG8_STAGE(PG8_SB(1, 0), cB + kstep, voffB); PG8_STAGE(PG8_SA(1, 0), cA + kstep, voffA); PG8_STAGE(PG8_SB(1, 1), cB + hstep + kstep, voffB);
        PG8_WAIT_V(6); PG8_BAR;
    }
    for (;;) {
        const bool has_next = S.next(ui + 1, nxt);
        const char* nA = has_next ? (const char*)g.A + (size_t)nxt.pm * tstep + (size_t)nxt.kt0 * kstep : cA; const char* nB = has_next ? (const char*)g.Bt + (size_t)nxt.pn * tstep + (size_t)nxt.kt0 * kstep : cB;
        const int nt = cur.nt;
        for (int t = 0; t < nt; t += 2) {
            const bool last = (t == nt - 2);
            const char* a1 = cA + (size_t)(t + 1) * kstep;
            const char* a2 = last ? nA : cA + (size_t)(t + 2) * kstep; const char* b2 = last ? nB : cB + (size_t)(t + 2) * kstep;
            const char* a3 = a2 + kstep; const char* b3 = b2 + kstep;
            if (last && has_next) S.a_ready(nxt);
            if constexpr (SP2) {
            PG8_LDB(B0, 0, 0); PG8_LDB(B1, 0, 1); PG8_SCHED; PG8_LDA(At, 0, 0); PG8_STAGE(PG8_SA(1, 1), a1 + hstep, voffA);
            PG8_WAIT_V(8); PG8_WAIT_L(0); PG8_BAR; PG8_MMA(0, 0, At, B0); PG8_MMA(0, 1, At, B1); PG8_BAR; PG8_SCHED;
            PG8_LDA(At, 0, 1); PG8_STAGE(PG8_SB(0, 0), b2, voffB); PG8_STAGE(PG8_SB(0, 1), b2 + hstep, voffB); PG8_STAGE(PG8_SA(0, 0), a2, voffA);
            PG8_WAIT_V(8); PG8_WAIT_L(0); PG8_BAR; PG8_MMA(1, 0, At, B0); PG8_MMA(1, 1, At, B1); PG8_BAR; PG8_SCHED;
            PG8_LDB(B0, 1, 0); PG8_LDB(B1, 1, 1); PG8_SCHED; PG8_LDA(At, 1, 0); PG8_STAGE(PG8_SA(0, 1), a2 + hstep, voffA);
            PG8_WAIT_V(8); PG8_WAIT_L(0); PG8_BAR; PG8_MMA(0, 0, At, B0); PG8_MMA(0, 1, At, B1); PG8_BAR; PG8_SCHED;
            PG8_LDA(At, 1, 1); PG8_STAGE(PG8_SB(1, 0), b3, voffB); PG8_STAGE(PG8_SB(1, 1), b3 + hstep, voffB); PG8_STAGE(PG8_SA(1, 0), a3, voffA);
            PG8_WAIT_V(8); PG8_WAIT_L(0); PG8_BAR; PG8_MMA(1, 0, At, B0); PG8_MMA(1, 1, At, B1); PG8_BAR; PG8_SCHED;
            } else {
            PG8_LDB(B0, 0, 0); PG8_SCHED; PG8_LDA(At, 0, 0); PG8_STAGE(PG8_SA(1, 1), a1 + hstep, voffA);
            PG8_WAIT_L(8); PG8_BAR; PG8_WAIT_L(0); PG8_MMA(0, 0, At, B0); PG8_BAR; PG8_SCHED;
            PG8_LDB(B1, 0, 1); PG8_STAGE(PG8_SB(0, 0), b2, voffB);
            PG8_BAR; PG8_WAIT_L(0); PG8_MMA(0, 1, At, B1); PG8_BAR;
            PG8_LDA(At, 0, 1); PG8_STAGE(PG8_SA(0, 0), a2, voffA);
            PG8_BAR; PG8_WAIT_L(0); PG8_MMA(1, 0, At, B0); PG8_BAR; PG8_SCHED;
            PG8_STAGE(PG8_SB(0, 1), b2 + hstep, voffB);
            PG8_WAIT_V(6); PG8_BAR; PG8_MMA(1, 1, At, B1); PG8_BAR;
            PG8_LDB(B0, 1, 0); PG8_SCHED; PG8_LDA(At, 1, 0); PG8_STAGE(PG8_SA(0, 1), a2 + hstep, voffA);
            PG8_WAIT_L(8); PG8_BAR; PG8_WAIT_L(0); PG8_MMA(0, 0, At, B0); PG8_BAR; PG8_SCHED;
            PG8_LDB(B1, 1, 1); PG8_STAGE(PG8_SB(1, 0), b3, voffB);
            PG8_BAR; PG8_WAIT_L(0); PG8_MMA(0, 1, At, B1); PG8_BAR;
            PG8_LDA(At, 1, 1); PG8_STAGE(PG8_SA(1, 0), a3, voffA);
            PG8_BAR; PG8_WAIT_L(0); PG8_MMA(1, 0, At, B0); PG8_BAR; PG8_SCHED;
            PG8_STAGE(PG8_SB(1, 1), b3 + hstep, voffB);
            PG8_WAIT_V(6); PG8_BAR; PG8_MMA(1, 1, At, B1); PG8_BAR;
            }
        }
        if constexpr (ALIGN_EPI) { if (wr == 0) PG8_BAR; }
        if constexpr (!Epi::AFTER_DRAIN) { E(acc, cur, wr, wc, fr, fq); S.done(cur); }
        if (!has_next) break;
#pragma unroll
        for (int a = 0; a < 2; ++a)
#pragma unroll
            for (int b = 0; b < 2; ++b)
#pragma unroll
                for (int m = 0; m < 4; ++m)
#pragma unroll
                    for (int n = 0; n < 2; ++n) acc[a][b][m][n] = (f32x4){0.f, 0.f, 0.f, 0.f};
        cur = nxt; cA = nA; cB = nB; ++ui;
        if constexpr (ALIGN_EPI) { if (wr == 1) PG8_BAR; }
    }
    PG8_WAIT_V(0);
    if constexpr (!ALIGN_EPI) { if (wr == 0) PG8_BAR; }
    PG8_BAR;
    if constexpr (Epi::AFTER_DRAIN) { E.fused(acc, cur, wr, wc, fr, fq, lds, wid, lane); S.done(cur); }
#undef PG8_SA
#undef PG8_SB
#undef PG8_STAGE
#undef PG8_LDA
#undef PG8_LDB
#undef PG8_MMA
#undef PG8_WAIT_V
#undef PG8_WAIT_L
#undef PG8_BAR
#undef PG8_SCHED
}
}

constexpr int NWAVES = 8;
constexpr int D = 1024, FF = 4096, M_CTX = 4096, M_LAT = 16384, M = M_CTX + M_LAT;
constexpr int L_LAT = 2048, L_CTX = 256, PAST = 256, LKV = PAST + L_LAT;
constexpr int MKV = M_CTX + 8 * LKV;
constexpr int EVEN_N = 3104, EVEN_NP = 3328, ODD_N = 576, ODD_NP = 768;
constexpr float EPS = 1e-6f;
constexpr int PC_QA = 0, PC_KA = 256, PC_VA = 512, PC_GA = 1024, PC_QB = 1536, PC_KB = 1792, PC_VB = 2048, PC_GB = 2560, PC_GK = 3072;
constexpr size_t OUT_Y = 0, OUT_CKV = 20971520, OUT_KPE = 23068672, OUT_SGLA = 23592960, OUT_SRET = 25690112;

constexpr size_t MiB = 1u << 20;
constexpr size_t WS_CTL = 0, CTL_ZERO_BYTES = 64 * 1024;
constexpr size_t WS_MOD = 1 * MiB;
constexpr size_t WS_ROPE = 2 * MiB;
constexpr size_t WS_KPE = 3 * MiB;
constexpr size_t WS_ACKV = 6 * MiB;
constexpr size_t WS_WINE = 18 * MiB;
constexpr size_t WS_WOUTE = 31 * MiB;
constexpr size_t WS_WINO = 35 * MiB;
constexpr size_t WS_WQB = 38 * MiB;
constexpr size_t WS_WKVB = 40 * MiB;
constexpr size_t WS_WOUTO = 42 * MiB;
constexpr size_t WS_W1 = 46 * MiB;
constexpr size_t WS_W2 = 78 * MiB;
constexpr size_t WS_HB = 110 * MiB;
constexpr size_t WS_Y = 150 * MiB;
constexpr size_t WS_BIG = 190 * MiB;
constexpr size_t WS_Q = WS_BIG, WS_KV = WS_BIG + 60 * MiB, WS_QN = WS_BIG + 148 * MiB;
constexpr size_t WS_SLAB = 350 * MiB;
constexpr size_t WS_END = 382 * MiB;

constexpr int RING_BYTES = 131072;
constexpr int LDS_MISC = 155648;
constexpr int LDS_BYTES = 163840;

#define GAS __attribute__((address_space(1)))
#define LAS __attribute__((address_space(3)))
typedef unsigned short bf16;
typedef unsigned v4u __attribute__((ext_vector_type(4)));
typedef unsigned v2u __attribute__((ext_vector_type(2)));
typedef float f32x4 __attribute__((ext_vector_type(4)));
typedef float f32x16 __attribute__((ext_vector_type(16)));
typedef short bf16x8 __attribute__((ext_vector_type(8)));
typedef short s16x4 __attribute__((ext_vector_type(4)));
#define LDS_WAIT() asm volatile("s_waitcnt lgkmcnt(0)" ::: "memory")
#define VM_WAIT() asm volatile("s_waitcnt vmcnt(0)" ::: "memory")
typedef float f32x2_t __attribute__((ext_vector_type(2))); typedef __bf16 bf16x2_t __attribute__((ext_vector_type(2)));
__device__ __forceinline__ unsigned pk2(float lo, float hi) { f32x2_t v = {lo, hi}; bf16x2_t b = __builtin_convertvector(v, bf16x2_t); return __builtin_bit_cast(unsigned, b); }
__device__ __forceinline__ unsigned f2bf(float f) { return pk2(f, f) & 0xffffu; }
__device__ __forceinline__ float bflo(unsigned w) { return __builtin_bit_cast(float, w << 16); }
__device__ __forceinline__ float bfhi(unsigned w) { return __builtin_bit_cast(float, w & 0xffff0000u); }
__device__ __forceinline__ float wave_sum(float v) {
#pragma unroll
    for (int o = 1; o < 64; o <<= 1) v += __shfl_xor(v, o);
    return v;
}
__device__ __forceinline__ float siluf(float x) { return x * __builtin_amdgcn_rcpf(1.0f + __expf(-x)); }

#define XB_TMO      128
#define XB_XCNT(j)  (256  + 64 * (j))
#define XB_XSUB(j)  (1280 + 64 * (j))
#define XB_XGEN(j)  (2304 + 64 * (j))
#define XB_TOP      3328
#define XB_TOPGEN   3392
#define XCD_BAR_WORDS 3456
#define XB_SPIN_CAP (1u << 20)
__device__ __forceinline__ unsigned xb_ld(unsigned* p)              { return __hip_atomic_load(p, __ATOMIC_RELAXED, __HIP_MEMORY_SCOPE_AGENT); }
__device__ __forceinline__ unsigned xb_add(unsigned* p, unsigned v) { return __hip_atomic_fetch_add(p, v, __ATOMIC_RELAXED, __HIP_MEMORY_SCOPE_AGENT); }
__device__ __forceinline__ unsigned xb_xcc_id() { return (unsigned)__builtin_amdgcn_s_getreg((3 << 11) | 20) & 0xFu; }
#define XB_SPIN(cond, bar) do { unsigned _sp = 0; while (cond) { __builtin_amdgcn_s_sleep(1); \
    if ((++_sp & 255u) == 0u) { if (xb_ld(&(bar)[XB_TMO])) break; if (_sp > XB_SPIN_CAP) { atomicAdd(&(bar)[XB_TMO], 1u); break; } } } } while (0)
struct XcdBarrier { unsigned* bar; unsigned x; volatile LAS unsigned* st; };
__device__ __forceinline__ XcdBarrier xcd_barrier_post(unsigned* bar, volatile LAS unsigned* st) {
    XcdBarrier b; b.bar = bar; b.x = xb_xcc_id(); b.st = st;
    if (threadIdx.x == 0) (void)xb_add(&bar[XB_XCNT(b.x)], 1u);
    return b;
}
__device__ __forceinline__ void xcd_barrier_complete(unsigned* bar, unsigned x, unsigned& nloc, unsigned& nx) {
    const unsigned G = gridDim.x * gridDim.y * gridDim.z;
    unsigned sum, cnt, mine, sp = 0u;
    for (;;) {
        sum = 0u; cnt = 0u; mine = 0u;
#pragma unroll
        for (unsigned j = 0; j < 16; ++j) { const unsigned c = xb_ld(&bar[XB_XCNT(j)]); sum += c; cnt += (c > 0u) ? 1u : 0u; mine = (j == x) ? c : mine; }
        if (sum == G) break;
        __builtin_amdgcn_s_sleep(1);
        if ((++sp & 255u) == 0u) { if (xb_ld(&bar[XB_TMO])) break; if (sp > XB_SPIN_CAP) { atomicAdd(&bar[XB_TMO], 1u); break; } }
    }
    nloc = mine > 0u ? mine : 1u; nx = cnt > 0u ? cnt : 1u;
}
__device__ __forceinline__ void xcd_barrier(const XcdBarrier& b) {
    asm volatile("s_waitcnt vmcnt(0)" ::: "memory");
    __syncthreads();
    if (threadIdx.x == 0) {
        unsigned* bar = b.bar;
        __builtin_amdgcn_s_waitcnt(0);
        unsigned nloc = b.st[0], nx = b.st[1];
        if (nloc == 0u) { xcd_barrier_complete(bar, b.x, nloc, nx); b.st[0] = nloc; b.st[1] = nx; }
        const unsigned old = xb_add(&bar[XB_XSUB(b.x)], 1u);
        const unsigned gen = old / nloc;
        if (old + 1u == (gen + 1u) * nloc) {
            __builtin_amdgcn_fence(__ATOMIC_RELEASE, "agent");
            asm volatile("s_waitcnt vmcnt(0)" ::: "memory");
            const unsigned og = xb_add(&bar[XB_TOP], 1u);
            const unsigned tg = og / nx;
            if (og + 1u == (tg + 1u) * nx) xb_add(&bar[XB_TOPGEN], 1u);
            else XB_SPIN(xb_ld(&bar[XB_TOPGEN]) == tg, bar);
            __builtin_amdgcn_fence(__ATOMIC_ACQUIRE, "agent");
            xb_add(&bar[XB_XGEN(b.x)], 1u);
            asm volatile("s_waitcnt vmcnt(0)" ::: "memory");
        } else {
            XB_SPIN(xb_ld(&bar[XB_XGEN(b.x)]) == gen, bar);
            __builtin_amdgcn_fence(__ATOMIC_ACQUIRE, "agent");
            asm volatile("s_waitcnt vmcnt(0)" ::: "memory");
        }
    }
    __syncthreads();
}

struct Params { const float* in[28]; float* out; unsigned char* ws; int ph_lo, ph_hi, use_bar, pad; };
enum { I_XP = 0, I_XS, I_CCKV, I_CKPE, I_SGLA, I_SRET, I_C, I_CCTX, I_WADA, I_BADA, I_NMIXPRE, I_NMIXPOST, I_NMLPPRE, I_NMLPPOST,
       I_WINE, I_WGK2, I_BGK2, I_GLAN, I_RDEC, I_WOUTE, I_WINO, I_QAN, I_WQB, I_KVAN, I_WKVB, I_WOUTO, I_W1, I_W2 };
struct Frame { LAS unsigned char* lds; int tid, lane, wave, vcu, G, bid; };
constexpr int LDS_PT = LDS_MISC + 256;
__device__ __forceinline__ const void* ldp(LAS unsigned char* lds, int i) {
    const volatile LAS unsigned* p = (const volatile LAS unsigned*)(lds + LDS_PT) + 2 * i;
    const unsigned lo = __builtin_amdgcn_readfirstlane(p[0]), hi = __builtin_amdgcn_readfirstlane(p[1]);
    return (const void*)(const GAS void*)(((unsigned long long)hi << 32) | lo);
}
#define PIN(i) ((const float*)ldp(F.lds, (i)))
#define POUT ((float*)ldp(F.lds, 28))
#define PWS ((unsigned char*)ldp(F.lds, 29))

__device__ __forceinline__ void p0_transpose_item(const float* W, int K, int N, bf16* WT, int kb, int n0, int dn0, LAS float* scr, int lane) {
    const int k0 = 64 * kb;
#pragma unroll 8
    for (int i = 0; i < 32; ++i) { const int kk = 2 * i + (lane >> 5); scr[kk * 33 + (lane & 31)] = W[(size_t)(k0 + kk) * N + n0 + (lane & 31)]; }
    LDS_WAIT(); asm volatile("" ::: "memory");
    const int c = lane & 7;
#pragma unroll
    for (int j = 0; j < 4; ++j) { const int n = (lane >> 3) + 8 * j; const LAS float* s = scr + (8 * c) * 33 + n;
        v4u o; o.x = pk2(s[0 * 33], s[1 * 33]); o.y = pk2(s[2 * 33], s[3 * 33]); o.z = pk2(s[4 * 33], s[5 * 33]); o.w = pk2(s[6 * 33], s[7 * 33]);
        *(GAS v4u*)(WT + (size_t)(dn0 + n) * K + k0 + 8 * c) = o; }
    LDS_WAIT(); asm volatile("" ::: "memory");
}
__device__ __forceinline__ int even_col_map(int n0) { return n0 < 1536 ? n0 : (n0 < 1568 ? 3072 + (n0 - 1536) : n0 - 32); }

__device__ __forceinline__ void p0_prologue(Frame& F, const Params& P) {
    unsigned char* ws = PWS;
    LAS float* scr = (LAS float*)(F.lds + F.wave * 16384);
    const int gw = F.vcu * NWAVES + F.wave, NGW = F.G * NWAVES;
    {
        LAS float* S = (LAS float*)(F.lds);
        LAS float* R = (LAS float*)(F.lds + 40960);
        { const float* cp_ = PIN(I_C); const float* cc_ = PIN(I_CCTX);
          for (int i = F.tid; i < 9 * 1024; i += 512) { const int n = i >> 10, d = i & 1023; const float cv = n < 8 ? cp_[n * 1024 + d] : cc_[d]; S[i] = siluf(cv); } }
        const float* wada_ = PIN(I_WADA); const float* bada_ = PIN(I_BADA);
        __syncthreads();
        for (int u = F.vcu; u < 256; u += F.G) {
            const int l = u >> 6, cb = (u & 63) * 96;
            if (F.tid < 384) {
                const int c4 = (F.tid % 24) * 4, part = F.tid / 24;
                const float* Wp = wada_ + ((size_t)l * 1024 + part * 64) * 6144 + cb + c4;
                f32x4 a[9];
#pragma unroll
                for (int n = 0; n < 9; ++n) a[n] = (f32x4){0.f, 0.f, 0.f, 0.f};
#pragma unroll 4
                for (int d = 0; d < 64; ++d) { const f32x4 w = *(const f32x4*)(Wp + (size_t)d * 6144);
#pragma unroll
                    for (int n = 0; n < 9; ++n) a[n] += w * S[n * 1024 + part * 64 + d]; }
#pragma unroll
                for (int n = 0; n < 9; ++n) *(LAS f32x4*)(R + (part * 9 + n) * 96 + c4) = a[n];
            }
            __syncthreads();
            for (int i = F.tid; i < 9 * 96; i += 512) { const int n = i / 96, c = i % 96; float s = 0.f;
#pragma unroll
                for (int p = 0; p < 16; ++p) s += R[(p * 9 + n) * 96 + c];
                ((float*)(ws + WS_MOD))[((size_t)l * 9 + n) * 6144 + cb + c] = s + bada_[l * 6144 + cb + c]; }
            __syncthreads();
        }
    }
    {
        int it = gw;
        const int I_E = (1024 / 64) * (EVEN_N / 32), I_OE = 16 * 32, I_O = 16 * (ODD_N / 32), I_QB = 4 * 48, I_KVB = 4 * 64, I_M1 = 16 * 128, I_M2 = 64 * 32;
        const int T_E = 2 * I_E, T_OE = 2 * I_OE, T_O = 2 * I_O, T_QB = 2 * I_QB, T_KVB = 2 * I_KVB, T_OO = 2 * I_OE, T_M1 = 4 * I_M1, T_M2 = 4 * I_M2;
        const int TOTAL = T_E + T_OE + T_O + T_QB + T_KVB + T_OO + T_M1 + T_M2;
        for (; it < TOTAL; it += NGW) {
            int r = it;
            if (r < T_E) { const int l = r / I_E, q = r % I_E, nb = EVEN_N / 32, kb = q / nb, n0 = (q % nb) * 32;
                p0_transpose_item(PIN(I_WINE) + (size_t)l * 1024 * EVEN_N, 1024, EVEN_N, (bf16*)(ws + WS_WINE) + (size_t)l * EVEN_NP * 1024, kb, n0, even_col_map(n0), scr, F.lane); continue; } r -= T_E;
            if (r < T_OE) { const int l = r / I_OE, q = r % I_OE, kb = q / 32, n0 = (q % 32) * 32;
                p0_transpose_item(PIN(I_WOUTE) + (size_t)l * 1024 * 1024, 1024, 1024, (bf16*)(ws + WS_WOUTE) + (size_t)l * 1024 * 1024, kb, n0, n0, scr, F.lane); continue; } r -= T_OE;
            if (r < T_O) { const int l = r / I_O, q = r % I_O, nb = ODD_N / 32, kb = q / nb, n0 = (q % nb) * 32;
                p0_transpose_item(PIN(I_WINO) + (size_t)l * 1024 * ODD_N, 1024, ODD_N, (bf16*)(ws + WS_WINO) + (size_t)l * ODD_NP * 1024, kb, n0, n0, scr, F.lane); continue; } r -= T_O;
            if (r < T_QB) { const int l = r / I_QB, q = r % I_QB, kb = q / 48, n0 = (q % 48) * 32;
                p0_transpose_item(PIN(I_WQB) + (size_t)l * 256 * 1536, 256, 1536, (bf16*)(ws + WS_WQB) + (size_t)l * 1536 * 256, kb, n0, n0, scr, F.lane); continue; } r -= T_QB;
            if (r < T_KVB) { const int l = r / I_KVB, q = r % I_KVB, kb = q / 64, n0 = (q % 64) * 32;
                p0_transpose_item(PIN(I_WKVB) + (size_t)l * 256 * 2048, 256, 2048, (bf16*)(ws + WS_WKVB) + (size_t)l * 2048 * 256, kb, n0, n0, scr, F.lane); continue; } r -= T_KVB;
            if (r < T_OO) { const int l = r / I_OE, q = r % I_OE, kb = q / 32, n0 = (q % 32) * 32;
                p0_transpose_item(PIN(I_WOUTO) + (size_t)l * 1024 * 1024, 1024, 1024, (bf16*)(ws + WS_WOUTO) + (size_t)l * 1024 * 1024, kb, n0, n0, scr, F.lane); continue; } r -= T_OO;
            if (r < T_M1) { const int l = r / I_M1, q = r % I_M1, kb = q / 128, n0 = (q % 128) * 32;
                p0_transpose_item(PIN(I_W1) + (size_t)l * 1024 * 4096, 1024, 4096, (bf16*)(ws + WS_W1) + (size_t)l * 4096 * 1024, kb, n0, n0, scr, F.lane); continue; } r -= T_M1;
            { const int l = r / I_M2, q = r % I_M2, kb = q / 32, n0 = (q % 32) * 32;
                p0_transpose_item(PIN(I_W2) + (size_t)l * 4096 * 1024, 4096, 1024, (bf16*)(ws + WS_W2) + (size_t)l * 1024 * 4096, kb, n0, n0, scr, F.lane); }
        }
    }
    const int gt = F.vcu * 512 + F.tid, NGT = F.G * 512;
    for (int i = gt; i < 2 * 224 * 128; i += NGT) { const int l = i / (224 * 128), q = i % (224 * 128); *(GAS v4u*)((bf16*)(ws + WS_WINE) + ((size_t)l * EVEN_NP + EVEN_N) * 1024 + (size_t)q * 8) = (v4u){0u, 0u, 0u, 0u}; }
    for (int i = gt; i < 2 * 192 * 128; i += NGT) { const int l = i / (192 * 128), q = i % (192 * 128); *(GAS v4u*)((bf16*)(ws + WS_WINO) + ((size_t)l * ODD_NP + ODD_N) * 1024 + (size_t)q * 8) = (v4u){0u, 0u, 0u, 0u}; }
    for (int i = gt; i < 2048 * 32; i += NGT) { const int t = i >> 5, j = i & 31; const float inv = powf(10000.0f, -(float)(j & 15) / 16.0f);
        const float ang = (float)(j < 16 ? (t >> 6) : (t & 63)) * inv;
        ((float*)(ws + WS_ROPE))[i] = cosf(ang); ((float*)(ws + WS_ROPE))[65536 + i] = sinf(ang); }
}

__device__ __forceinline__ void row_y(f32x4 (&yv)[4], const bf16* Y, const bf16* SL, int row, int l4) {
    if (row < 16384) {
#pragma unroll
        for (int j = 0; j < 4; ++j) { const v2u yw = *(const v2u*)(Y + (size_t)row * D + l4 + 256 * j); yv[j] = (f32x4){bflo(yw.x), bfhi(yw.x), bflo(yw.y), bfhi(yw.y)}; }
    } else {
        const bf16* sp = SL + (size_t)(row - 16384) * D + l4;
#pragma unroll
        for (int j = 0; j < 4; ++j) { const v2u w0 = *(const v2u*)(sp + 256 * j), w1 = *(const v2u*)(sp + 4194304 + 256 * j), w2 = *(const v2u*)(sp + 2 * 4194304 + 256 * j), w3 = *(const v2u*)(sp + 3 * 4194304 + 256 * j);
            yv[j] = ((f32x4){bflo(w0.x), bfhi(w0.x), bflo(w0.y), bfhi(w0.y)} + (f32x4){bflo(w1.x), bfhi(w1.x), bflo(w1.y), bfhi(w1.y)}) +
                    ((f32x4){bflo(w2.x), bfhi(w2.x), bflo(w2.y), bfhi(w2.y)} + (f32x4){bflo(w3.x), bfhi(w3.x), bflo(w3.y), bfhi(w3.y)}); }
    }
}
__device__ __forceinline__ void row_post(f32x4 (&v)[4], const f32x4 (&yv)[4], const float* g_post, const float* gate, int n, int l4) {
    float s = 0.f;
#pragma unroll
    for (int j = 0; j < 4; ++j) s += (yv[j][0] * yv[j][0] + yv[j][1] * yv[j][1]) + (yv[j][2] * yv[j][2] + yv[j][3] * yv[j][3]);
    const float rstd = __builtin_amdgcn_rsqf(wave_sum(s) * (1.0f / 1024.0f) + EPS);
#pragma unroll
    for (int j = 0; j < 4; ++j) { const int c = l4 + 256 * j;
        const f32x4 gp = *(const f32x4*)(g_post + c), gt = *(const f32x4*)(gate + (size_t)n * 6144 + c);
        v[j] = v[j] + gt * ((yv[j] * rstd) * gp); }
}
__device__ __forceinline__ void row_pass(Frame& F, const float* xa, const float* xb, bool xin_f32, bf16* XB, const bf16* Y, const bf16* SL, const float* g_post, const float* gate,
                                         const float* g_pre, const float* scale, const float* shift, bf16* H, bool has_post, bool has_pre) {
    const int gw = F.vcu * NWAVES + F.wave, NGW = F.G * NWAVES, l4 = F.lane * 4;
    for (int row = gw; row < M; row += NGW) {
        const int n = row < M_CTX ? 8 : ((row - M_CTX) >> 11);
        f32x4 v[4];
        if (xin_f32) { const float* xr = row < M_CTX ? xa + (size_t)row * D : xb + (size_t)(row - M_CTX) * D;
#pragma unroll
            for (int j = 0; j < 4; ++j) v[j] = *(const f32x4*)(xr + l4 + 256 * j);
        } else {
#pragma unroll
            for (int j = 0; j < 4; ++j) { const v2u xw = *(const v2u*)(XB + (size_t)row * D + l4 + 256 * j); v[j] = (f32x4){bflo(xw.x), bfhi(xw.x), bflo(xw.y), bfhi(xw.y)}; }
        }
        if (has_post) {
            f32x4 yv[4]; row_y(yv, Y, SL, row, l4); row_post(v, yv, g_post, gate, n, l4);
#pragma unroll
            for (int j = 0; j < 4; ++j) *(v2u*)(XB + (size_t)row * D + l4 + 256 * j) = (v2u){pk2(v[j][0], v[j][1]), pk2(v[j][2], v[j][3])};
        }
        if (has_pre) {
            float s = 0.f;
#pragma unroll
            for (int j = 0; j < 4; ++j) s += (v[j][0] * v[j][0] + v[j][1] * v[j][1]) + (v[j][2] * v[j][2] + v[j][3] * v[j][3]);
            const float rstd = __builtin_amdgcn_rsqf(wave_sum(s) * (1.0f / 1024.0f) + EPS);
#pragma unroll
            for (int j = 0; j < 4; ++j) { const int c = l4 + 256 * j;
                const f32x4 gp = *(const f32x4*)(g_post == nullptr ? g_pre + c : g_pre + c), sc = *(const f32x4*)(scale + (size_t)n * 6144 + c), sh = *(const f32x4*)(shift + (size_t)n * 6144 + c);
                const f32x4 h = ((v[j] * rstd) * gp) * (1.0f + sc) + sh;
                *(v2u*)(H + (size_t)row * D + c) = (v2u){pk2(h[0], h[1]), pk2(h[2], h[3])}; }
        }
    }
}
__device__ __forceinline__ void row_pass_final(Frame& F, const XcdBarrier& bar, const bf16* XB, float* OUT, const bf16* Y, const bf16* SL, const float* g_post, const float* gate) {
    const int gw = F.vcu * NWAVES + F.wave, NGW = F.G * NWAVES, l4 = F.lane * 4;
    v2u xw[10][4];
#pragma unroll
    for (int i = 0; i < 10; ++i) { const int row = gw + i * NGW;
        if (row < M) {
#pragma unroll
            for (int j = 0; j < 4; ++j) xw[i][j] = *(const v2u*)(XB + (size_t)row * D + l4 + 256 * j);
        } }
    xcd_barrier(bar);
#pragma unroll
    for (int i = 0; i < 10; ++i) { const int row = gw + i * NGW;
        if (row < M) {
            const int n = row < M_CTX ? 8 : ((row - M_CTX) >> 11);
            f32x4 v[4], yv[4];
#pragma unroll
            for (int j = 0; j < 4; ++j) v[j] = (f32x4){bflo(xw[i][j].x), bfhi(xw[i][j].x), bflo(xw[i][j].y), bfhi(xw[i][j].y)};
            row_y(yv, Y, SL, row, l4); row_post(v, yv, g_post, gate, n, l4);
#pragma unroll
            for (int j = 0; j < 4; ++j) *(f32x4*)(OUT + (size_t)row * D + l4 + 256 * j) = v[j];
        } }
}

__device__ __forceinline__ int crow(int r, int hi) { return (r & 3) + 8 * (r >> 2) + 4 * hi; }
__device__ __forceinline__ unsigned cvtpk(float lo, float hi) { return pk2(lo, hi); }
#define SBAR() __builtin_amdgcn_sched_barrier(0)
__device__ __forceinline__ int vst_row(int k, int NB) { const int kk = (k & ~0xC) | ((k & 4) << 1) | ((k & 8) >> 1); return (kk >> 3) * NB * 512 + (kk & 7) * 64; }
__device__ __forceinline__ int vst(int k, int c, int NB) { return vst_row(k, NB) + (c >> 5) * 512 + (c & 31) * 2; }
__device__ __forceinline__ int v_rd_base(int lane) { return ((lane & 3) << 3) | (((lane >> 2) & 3) << 6) | (((lane >> 4) & 1) << 5) | (((lane >> 5) & 1) << 8); }
template <int OFF> __device__ __forceinline__ s16x4 tr_read(unsigned vb) { s16x4 r; asm volatile("ds_read_b64_tr_b16 %0, %1 offset:%2" : "=&v"(r) : "v"(vb), "i"(OFF) : "memory"); return r; }
#define PKF(L, H) ((bf16x8){L[0], L[1], L[2], L[3], H[0], H[1], H[2], H[3]})
#define PK4(P, BASE, OUT) do { unsigned a0_ = cvtpk(P[BASE + 0], P[BASE + 1]), a1_ = cvtpk(P[BASE + 2], P[BASE + 3]);   \
    unsigned b0_ = cvtpk(P[BASE + 4], P[BASE + 5]), b1_ = cvtpk(P[BASE + 6], P[BASE + 7]);                              \
    auto r0_ = __builtin_amdgcn_permlane32_swap(a0_, b0_, false, false); auto r1_ = __builtin_amdgcn_permlane32_swap(a1_, b1_, false, false); \
    v4u w_ = {r0_[0], r1_[0], r0_[1], r1_[1]}; OUT = __builtin_bit_cast(bf16x8, w_); } while (0)
__device__ __forceinline__ float logsig(float x) { return fminf(x, 0.f) - __logf(1.0f + __expf(-fabsf(x))); }

constexpr int SC_QD = 0, SC_KI = 8192, SC_VT = 16384, SC_ST = 32768, SC_BT = 49152, SC_GK = 65536, SC_TOT = 69632, SC_DL = 71680, SC_W2 = 71936;
__device__ __forceinline__ void scan_phase(Frame& F, const Params& P, int li) {
    unsigned char* ws = PWS;
    const bf16* PROJ = (const bf16*)(ws + WS_BIG);
    const float* ROPE = (const float*)(ws + WS_ROPE);
    LAS unsigned char* G = F.lds;
    const unsigned gaddr = (unsigned)(uintptr_t)G;
    const int ri = F.wave >> 2, dq = F.wave & 3;
    for (int u0 = F.bid; u0 < 256; u0 += F.G) for (int kk_ = 0; kk_ < (u0 < 128 ? 1 : 2); ++kk_) {
        __syncthreads();
        const bool lat = u0 < 128; const int u = lat ? u0 : 2 * (u0 - 128) + kk_;
        const int sb = u >> 4, hh = (u >> 1) & 7, dir = u & 1;
        const int L = lat ? L_LAT : L_CTX, row0 = lat ? M_CTX + sb * L_LAT : sb * L_CTX, NC = L / 64;
        const bool gla = hh < 4; const int h = hh & 3;
        const int qc = (gla ? PC_QA : PC_QB) + h * 64, kc = (gla ? PC_KA : PC_KB) + h * 64, vc = (gla ? PC_VA : PC_VB) + h * 128, gkc = PC_GK + dir * 16;
        bf16* OUT = (bf16*)(ws + (dir == 0 ? WS_Y : WS_HB));
        const float* rdec_p = PIN(I_RDEC); const float* wgk2_p = PIN(I_WGK2); const float* bgk2_p = PIN(I_BGK2);
        const float lgr = gla ? 0.f : -__expf(rdec_p[(li * 2 + dir) * 4 + h]);
        f32x16 sacc;
        { int t0_ = F.tid; asm volatile("" : "+v"(t0_)); const int lane = t0_ & 63, r32 = lane & 31, hi = lane >> 5;
          if (gla) { LAS float* W2 = (LAS float*)(G + SC_W2);
              for (int i = t0_; i < 16 * 64; i += 512) W2[i] = wgk2_p[((size_t)(li * 2 + dir) * 16 + (i >> 6)) * 256 + h * 64 + (i & 63)];
              if (t0_ < 64) W2[1024 + t0_] = bgk2_p[(li * 2 + dir) * 256 + h * 64 + t0_]; }
          else if (t0_ < 64) ((LAS float*)(G + SC_DL))[t0_] = __expf(64.0f * lgr);
          const float* S0 = (gla ? PIN(I_SGLA) : PIN(I_SRET)) + ((size_t)((sb * 2 + li) * 2 + dir) * 4 + h) * 8192;
          if (lat) {
#pragma unroll
              for (int r = 0; r < 16; ++r) sacc[r] = S0[(32 * ri + crow(r, hi)) * 128 + 32 * dq + r32];
          } else sacc = f32x16{};
#pragma unroll
          for (int r = 0; r < 16; r += 2) { const unsigned w = pk2(sacc[r], sacc[r + 1]);
              LAS unsigned char* sp_ = G + SC_ST + (hi + 4 * ri) * 2048 + dq * 512 + r32 * 2 + ((r >> 3) & 1) * 4096 + ((r & 3) + 4 * ((r >> 2) & 1)) * 64;
              *(LAS unsigned short*)sp_ = (unsigned short)w; *(LAS unsigned short*)(sp_ + 64) = (unsigned short)(w >> 16); } }
        v2u pq0, pq1, pk0, pk1; v4u pv0, pv1; unsigned pgk = 0;
#define SC_TOK(s, i) (dir == 0 ? 64 * (s) + (i) : L - 1 - (64 * (s) + (i)))
#define SC_LOAD(s) do { const unsigned ro_ = (unsigned)(row0 + SC_TOK(s, sti)) * (unsigned)(EVEN_NP * 2); const char* pc_ = (const char*)PROJ; \
        pq0 = *(const v2u*)(pc_ + (ro_ + (unsigned)(qc + 4 * c4) * 2u)); pq1 = *(const v2u*)(pc_ + (ro_ + (unsigned)(qc + 32 + 4 * c4) * 2u)); \
        pk0 = *(const v2u*)(pc_ + (ro_ + (unsigned)(kc + 4 * c4) * 2u)); pk1 = *(const v2u*)(pc_ + (ro_ + (unsigned)(kc + 32 + 4 * c4) * 2u)); \
        pv0 = *(const v4u*)(pc_ + (ro_ + (unsigned)(vc + 16 * c4) * 2u)); pv1 = *(const v4u*)(pc_ + (ro_ + (unsigned)(vc + 16 * c4 + 8) * 2u)); \
        if (gla) pgk = *(const unsigned*)(pc_ + (ro_ + (unsigned)(gkc + 2 * c4) * 2u)); } while (0)
        { int t0_ = F.tid; asm volatile("" : "+v"(t0_)); const int sti = t0_ >> 3, c4 = t0_ & 7; SC_LOAD(0); }
        for (int s = 0; s < NC; ++s) {
            int tid_o = F.tid; asm volatile("" : "+v"(tid_o));
            const int lane = tid_o & 63, r32 = lane & 31, hi = lane >> 5, sti = tid_o >> 3, c4 = tid_o & 7;
            const int tok = SC_TOK(s, sti);
            if (gla) {
                { LAS float* GK = (LAS float*)(G + SC_GK) + sti * 16 + 2 * c4; GK[0] = bflo(pgk); GK[1] = bfhi(pgk); }
                LDS_WAIT(); __syncthreads();
                const int k = tid_o & 63, tq = tid_o >> 6; float cs[8]; float run = 0.f;
                float w2[16]; const LAS float* W2 = (const LAS float*)(G + SC_W2);
#pragma unroll
                for (int r = 0; r < 16; ++r) w2[r] = W2[r * 64 + k];
                const float bias2 = W2[1024 + k];
#pragma unroll
                for (int j = 0; j < 8; ++j) { const LAS f32x4* gp = (const LAS f32x4*)((LAS float*)(G + SC_GK) + (8 * tq + j) * 16);
                    const f32x4 g0 = gp[0], g1 = gp[1], g2 = gp[2], g3 = gp[3];
                    float a = bias2;
                    a += g0[0] * w2[0] + g0[1] * w2[1] + g0[2] * w2[2] + g0[3] * w2[3];
                    a += g1[0] * w2[4] + g1[1] * w2[5] + g1[2] * w2[6] + g1[3] * w2[7];
                    a += g2[0] * w2[8] + g2[1] * w2[9] + g2[2] * w2[10] + g2[3] * w2[11];
                    a += g3[0] * w2[12] + g3[1] * w2[13] + g3[2] * w2[14] + g3[3] * w2[15];
                    run += logsig(a) * (1.0f / 16.0f); cs[j] = run; }
                ((LAS float*)(G + SC_TOT))[tq * 64 + k] = run;
                LDS_WAIT(); __syncthreads();
                float pre = 0.f;
#pragma unroll
                for (int q = 0; q < 7; ++q) { const float tv = ((LAS float*)(G + SC_TOT))[q * 64 + k]; pre += (q < tq) ? tv : 0.f; }
#pragma unroll
                for (int j = 0; j < 8; ++j) ((LAS float*)(G + SC_BT))[(8 * tq + j) * 64 + k] = pre + cs[j];
                if (tq == 7) ((LAS float*)(G + SC_DL))[k] = __expf(pre + cs[7]);
                LDS_WAIT(); __syncthreads();
            } else { __syncthreads(); }
            {
                float q[8], kk[8];
                q[0] = bflo(pq0.x); q[1] = bfhi(pq0.x); q[2] = bflo(pq0.y); q[3] = bfhi(pq0.y); q[4] = bflo(pq1.x); q[5] = bfhi(pq1.x); q[6] = bflo(pq1.y); q[7] = bfhi(pq1.y);
                kk[0] = bflo(pk0.x); kk[1] = bfhi(pk0.x); kk[2] = bflo(pk0.y); kk[3] = bfhi(pk0.y); kk[4] = bflo(pk1.x); kk[5] = bfhi(pk1.x); kk[6] = bflo(pk1.y); kk[7] = bfhi(pk1.y);
                if (gla) {
                    const f32x4 x0 = *(const LAS f32x4*)((LAS float*)(G + SC_BT) + sti * 64 + 4 * c4), x1 = *(const LAS f32x4*)((LAS float*)(G + SC_BT) + sti * 64 + 32 + 4 * c4);
#pragma unroll
                    for (int e = 0; e < 4; ++e) { const float e0 = __expf(x0[e]), e1 = __expf(x1[e]);
                        q[e] *= 0.125f * e0; kk[e] *= __builtin_amdgcn_rcpf(e0); q[4 + e] *= 0.125f * e1; kk[4 + e] *= __builtin_amdgcn_rcpf(e1); }
                } else {
                    if (lat) {
                        const float* cp = ROPE + (size_t)tok * 32 + 4 * c4; const f32x4 cv = *(const f32x4*)cp, sv = *(const f32x4*)(cp + 65536);
#pragma unroll
                        for (int e = 0; e < 4; ++e) { const float c = cv[e], sn = sv[e];
                            const float q1 = q[e], q2 = q[4 + e]; q[e] = q1 * c - q2 * sn; q[4 + e] = q1 * sn + q2 * c;
                            const float k1 = kk[e], k2 = kk[4 + e]; kk[e] = k1 * c - k2 * sn; kk[4 + e] = k1 * sn + k2 * c; }
                    }
                    const float bb = (float)(sti + 1) * lgr, eb = __expf(bb), ek = 0.125f * __builtin_amdgcn_rcpf(eb);
#pragma unroll
                    for (int e = 0; e < 8; ++e) { q[e] *= eb; kk[e] *= ek; }
                }
                *(LAS v2u*)(G + SC_QD + vst(sti, 4 * c4, 2)) = (v2u){pk2(q[0], q[1]), pk2(q[2], q[3])};
                *(LAS v2u*)(G + SC_QD + vst(sti, 32 + 4 * c4, 2)) = (v2u){pk2(q[4], q[5]), pk2(q[6], q[7])};
                *(LAS v2u*)(G + SC_KI + vst(sti, 4 * c4, 2)) = (v2u){pk2(kk[0], kk[1]), pk2(kk[2], kk[3])};
                *(LAS v2u*)(G + SC_KI + vst(sti, 32 + 4 * c4, 2)) = (v2u){pk2(kk[4], kk[5]), pk2(kk[6], kk[7])};
                *(LAS v4u*)(G + SC_VT + vst(sti, 16 * c4, 4)) = pv0; *(LAS v4u*)(G + SC_VT + vst(sti, 16 * c4 + 8, 4)) = pv1;
            }
            LDS_WAIT(); __syncthreads();
            if (s + 1 < NC) SC_LOAD(s + 1);
            bf16x8 qf[4]; bf16x8 pa0, pa1, pa2, pa3;
            { const int qb_ = vst_row(32 * ri + r32, 2) + 16 * hi;
              qf[0] = *(const LAS bf16x8*)(G + SC_QD + qb_); qf[1] = *(const LAS bf16x8*)(G + SC_QD + qb_ + 32); qf[2] = *(const LAS bf16x8*)(G + SC_QD + qb_ + 512); qf[3] = *(const LAS bf16x8*)(G + SC_QD + qb_ + 544); }
            { f32x16 p0 = {}, p1 = {};
              const int kb0 = vst_row(r32, 2) + 16 * hi, kb1 = vst_row(32 + r32, 2) + 16 * hi;
              { const bf16x8 a0 = *(const LAS bf16x8*)(G + SC_KI + kb0), a1 = *(const LAS bf16x8*)(G + SC_KI + kb0 + 32), a2 = *(const LAS bf16x8*)(G + SC_KI + kb0 + 512), a3 = *(const LAS bf16x8*)(G + SC_KI + kb0 + 544);
                p0 = __builtin_amdgcn_mfma_f32_32x32x16_bf16(a0, qf[0], p0, 0, 0, 0); p0 = __builtin_amdgcn_mfma_f32_32x32x16_bf16(a1, qf[1], p0, 0, 0, 0);
                p0 = __builtin_amdgcn_mfma_f32_32x32x16_bf16(a2, qf[2], p0, 0, 0, 0); p0 = __builtin_amdgcn_mfma_f32_32x32x16_bf16(a3, qf[3], p0, 0, 0, 0); }
              if (ri == 1) {
                  const bf16x8 c0 = *(const LAS bf16x8*)(G + SC_KI + kb1), c1 = *(const LAS bf16x8*)(G + SC_KI + kb1 + 32), c2 = *(const LAS bf16x8*)(G + SC_KI + kb1 + 512), c3 = *(const LAS bf16x8*)(G + SC_KI + kb1 + 544);
                  p1 = __builtin_amdgcn_mfma_f32_32x32x16_bf16(c0, qf[0], p1, 0, 0, 0); p1 = __builtin_amdgcn_mfma_f32_32x32x16_bf16(c1, qf[1], p1, 0, 0, 0);
                  p1 = __builtin_amdgcn_mfma_f32_32x32x16_bf16(c2, qf[2], p1, 0, 0, 0); p1 = __builtin_amdgcn_mfma_f32_32x32x16_bf16(c3, qf[3], p1, 0, 0, 0); }
#pragma unroll
              for (int r = 0; r < 16; ++r) { const bool keep = crow(r, hi) <= r32; if (ri == 0) { p0[r] = keep ? p0[r] : 0.f; } else { p1[r] = keep ? p1[r] : 0.f; } }
              PK4(p0, 0, pa0); PK4(p0, 8, pa1); PK4(p1, 0, pa2); PK4(p1, 8, pa3); }
            const unsigned vb = gaddr + SC_VT + v_rd_base(lane) + dq * 512, sbv = gaddr + SC_ST + v_rd_base(lane) + dq * 512;
#define SC_FR4(dst, base) do { const s16x4 l0_ = tr_read<0>(base), h0_ = tr_read<2048>(base), l1_ = tr_read<4096>(base), h1_ = tr_read<4096 + 2048>(base); \
              const s16x4 l2_ = tr_read<8192>(base), h2_ = tr_read<8192 + 2048>(base), l3_ = tr_read<12288>(base), h3_ = tr_read<12288 + 2048>(base); \
              asm volatile("s_waitcnt lgkmcnt(0)" ::: "memory"); SBAR(); \
              dst[0] = PKF(l0_, h0_); dst[1] = PKF(l1_, h1_); dst[2] = PKF(l2_, h2_); dst[3] = PKF(l3_, h3_); } while (0)
            bf16x8 vf_[4];
            { bf16x8 sf_[4]; SC_FR4(vf_, vb); SC_FR4(sf_, sbv); f32x16 o_ = {};
              o_ = __builtin_amdgcn_mfma_f32_32x32x16_bf16(pa0, vf_[0], o_, 0, 0, 0); o_ = __builtin_amdgcn_mfma_f32_32x32x16_bf16(pa1, vf_[1], o_, 0, 0, 0);
              if (ri == 1) { o_ = __builtin_amdgcn_mfma_f32_32x32x16_bf16(pa2, vf_[2], o_, 0, 0, 0); o_ = __builtin_amdgcn_mfma_f32_32x32x16_bf16(pa3, vf_[3], o_, 0, 0, 0); }
              o_ = __builtin_amdgcn_mfma_f32_32x32x16_bf16(qf[0], sf_[0], o_, 0, 0, 0); o_ = __builtin_amdgcn_mfma_f32_32x32x16_bf16(qf[1], sf_[1], o_, 0, 0, 0);
              o_ = __builtin_amdgcn_mfma_f32_32x32x16_bf16(qf[2], sf_[2], o_, 0, 0, 0); o_ = __builtin_amdgcn_mfma_f32_32x32x16_bf16(qf[3], sf_[3], o_, 0, 0, 0);
              char* dst_ = (char*)OUT;
#pragma unroll
              for (int r = 0; r < 16; r += 2) { const int i_ = 32 * ri + crow(r, hi); const int t_ = SC_TOK(s, i_); const unsigned w_ = pk2(o_[r], o_[r + 1]);
                  const unsigned a_ = (unsigned)(row0 + t_) * (unsigned)(D * 2) + (unsigned)(hh * 128 + 32 * dq + r32) * 2u;
                  *(bf16*)(dst_ + a_) = (bf16)w_; *(bf16*)(dst_ + (dir == 0 ? a_ + (unsigned)(D * 2) : a_ - (unsigned)(D * 2))) = (bf16)(w_ >> 16); } }
            __syncthreads();
            { const unsigned kt = gaddr + SC_KI + v_rd_base(lane) + ri * 512;
              bf16x8 kf[4];
              { const s16x4 l0_ = tr_read<0>(kt), h0_ = tr_read<1024>(kt), l1_ = tr_read<2048>(kt), h1_ = tr_read<2048 + 1024>(kt), l2_ = tr_read<4096>(kt), h2_ = tr_read<4096 + 1024>(kt), l3_ = tr_read<6144>(kt), h3_ = tr_read<6144 + 1024>(kt);
                asm volatile("s_waitcnt lgkmcnt(0)" ::: "memory"); SBAR();
                kf[0] = PKF(l0_, h0_); kf[1] = PKF(l1_, h1_); kf[2] = PKF(l2_, h2_); kf[3] = PKF(l3_, h3_); }
#pragma unroll
              for (int ks = 0; ks < 4; ++ks) sacc = __builtin_amdgcn_mfma_f32_32x32x16_bf16(kf[ks], vf_[ks], sacc, 0, 0, 0);
              const int stb_ = (hi + 4 * ri) * 2048 + dq * 512 + r32 * 2;
#pragma unroll
              for (int r = 0; r < 16; r += 2) { const int dk = 32 * ri + crow(r, hi); const float dl0 = ((LAS float*)(G + SC_DL))[dk], dl1 = ((LAS float*)(G + SC_DL))[dk + 1];
                  sacc[r] *= dl0; sacc[r + 1] *= dl1; const unsigned w_ = pk2(sacc[r], sacc[r + 1]);
                  LAS unsigned char* sp_ = G + SC_ST + stb_ + ((r >> 3) & 1) * 4096 + ((r & 3) + 4 * ((r >> 2) & 1)) * 64;
                  *(LAS unsigned short*)sp_ = (unsigned short)w_; *(LAS unsigned short*)(sp_ + 64) = (unsigned short)(w_ >> 16); } }
        }
        if (!lat) { int l2 = F.lane; asm volatile("" : "+v"(l2)); const int r32 = l2 & 31, hi = l2 >> 5; float* SO = POUT + (gla ? OUT_SGLA : OUT_SRET) + ((size_t)((sb * 2 + li) * 2 + dir) * 4 + h) * 8192;
#pragma unroll
            for (int r = 0; r < 16; ++r) SO[(32 * ri + crow(r, hi)) * 128 + 32 * dq + r32] = sacc[r]; }
    }
#undef SC_TOK
#undef SC_LOAD
#undef SC_FR4
}
__device__ __forceinline__ void scan_combine(Frame& F, const Params& P, int li) {
    unsigned char* ws = PWS;
    const char* PROJ = (const char*)(ws + WS_BIG); const char* OF = (const char*)(ws + WS_Y); char* OB = (char*)(ws + WS_HB);
    const int gw = F.vcu * NWAVES + F.wave, NGW = F.G * NWAVES, lane = F.lane, hh = lane >> 3, dv = (lane & 7) * 16;
    f32x4 gn[4];
    { const float* gp_ = PIN(I_GLAN) + li * 128 + dv;
#pragma unroll
      for (int j = 0; j < 4; ++j) gn[j] = hh < 4 ? *(const f32x4*)(gp_ + 4 * j) : (f32x4){1.f, 1.f, 1.f, 1.f}; }
    const unsigned gcol = (unsigned)((hh < 4 ? PC_GA : PC_GB) + (hh & 3) * 128 + dv) * 2u, ocol = (unsigned)(hh * 128 + dv) * 2u;
    for (int row = gw; row < M; row += 2 * NGW) {
        v4u a[2][2], b[2][2], g[2][2];
#pragma unroll
        for (int i = 0; i < 2; ++i) { const int r_ = row + i * NGW; if (r_ < M) {
            const unsigned off = (unsigned)r_ * (unsigned)(D * 2) + ocol, goff = (unsigned)r_ * (unsigned)(EVEN_NP * 2) + gcol;
            a[i][0] = *(const v4u*)(OF + off); a[i][1] = *(const v4u*)(OF + off + 16); b[i][0] = *(const v4u*)(OB + off); b[i][1] = *(const v4u*)(OB + off + 16);
            g[i][0] = *(const v4u*)(PROJ + goff); g[i][1] = *(const v4u*)(PROJ + goff + 16); } }
#pragma unroll
        for (int i = 0; i < 2; ++i) { const int r_ = row + i * NGW; if (r_ < M) {
            const unsigned off = (unsigned)r_ * (unsigned)(D * 2) + ocol;
            float x[16], gg[16];
#pragma unroll
            for (int hf = 0; hf < 2; ++hf)
#pragma unroll
                for (int e = 0; e < 4; ++e) { x[8 * hf + 2 * e] = bflo(a[i][hf][e]) + bflo(b[i][hf][e]); x[8 * hf + 2 * e + 1] = bfhi(a[i][hf][e]) + bfhi(b[i][hf][e]);
                    gg[8 * hf + 2 * e] = bflo(g[i][hf][e]); gg[8 * hf + 2 * e + 1] = bfhi(g[i][hf][e]); }
            float ss = 0.f;
#pragma unroll
            for (int e = 0; e < 16; ++e) ss += x[e] * x[e];
            ss += __shfl_xor(ss, 1); ss += __shfl_xor(ss, 2); ss += __shfl_xor(ss, 4);
            const float rstd = __builtin_amdgcn_rsqf(ss * (1.0f / 128.0f) + EPS);
#pragma unroll
            for (int e = 0; e < 16; ++e) x[e] = x[e] * rstd * gn[e >> 2][e & 3] * siluf(gg[e]);
            *(v4u*)(OB + off) = (v4u){pk2(x[0], x[1]), pk2(x[2], x[3]), pk2(x[4], x[5]), pk2(x[6], x[7])};
            *(v4u*)(OB + off + 16) = (v4u){pk2(x[8], x[9]), pk2(x[10], x[11]), pk2(x[12], x[13]), pk2(x[14], x[15])}; } }
    }
}

__device__ __forceinline__ void cache_pass(Frame& F, const Params& P, int li) {
    unsigned char* ws = PWS;
    const int gt = F.vcu * 512 + F.tid, NGT = F.G * 512;
    const float* cckv_ = PIN(I_CCKV); const float* ckpe_ = PIN(I_CKPE);
    for (int i = gt; i < 8 * 256 * 32; i += NGT) { const int c8 = i & 31, t = (i >> 5) & 255, b = i >> 13;
        const float* s = cckv_ + ((size_t)((b * 2 + li) * 256 + t) * 32 + c8) * 8; const f32x4 a = *(const f32x4*)s, c = *(const f32x4*)(s + 4);
        *(GAS v4u*)((bf16*)(ws + WS_ACKV) + ((size_t)4096 + b * LKV + t) * 256 + c8 * 8) = (v4u){pk2(a[0], a[1]), pk2(a[2], a[3]), pk2(c[0], c[1]), pk2(c[2], c[3])}; }
    for (int i = gt; i < 8 * 256 * 8; i += NGT) { const int c8 = i & 7, t = (i >> 3) & 255, b = i >> 11;
        const float* s = ckpe_ + ((size_t)((b * 2 + li) * 256 + t) * 8 + c8) * 8; const f32x4 a = *(const f32x4*)s, c = *(const f32x4*)(s + 4);
        *(GAS v4u*)((bf16*)(ws + WS_KPE) + ((size_t)4096 + b * LKV + t) * 64 + c8 * 8) = (v4u){pk2(a[0], a[1]), pk2(a[2], a[3]), pk2(c[0], c[1]), pk2(c[2], c[3])}; }
}
__device__ __forceinline__ void kpe_pass(Frame& F, const Params& P, int li) {
    unsigned char* ws = PWS;
    const float* KR = (const float*)(ws + WS_Y); const float* ROPE = (const float*)(ws + WS_ROPE);
    bf16* KPE = (bf16*)(ws + WS_KPE);
    const int gt = F.vcu * 512 + F.tid, NGT = F.G * 512;
    for (int i = gt; i < M * 4; i += NGT) {
        const int row = i >> 2, c8 = i & 3;
        const float* s = KR + (size_t)row * 64 + 8 * c8;
        f32x4 a0 = *(const f32x4*)s, a1 = *(const f32x4*)(s + 4), b0 = *(const f32x4*)(s + 32), b1 = *(const f32x4*)(s + 36);
        int drow = row;
        if (row >= M_CTX) { const int lb = (row - M_CTX) >> 11, t = (row - M_CTX) & 2047; drow = M_CTX + lb * LKV + PAST + t;
            const float* cp = ROPE + (size_t)t * 32 + 8 * c8; const float* sp = cp + 65536;
            const f32x4 c0 = *(const f32x4*)cp, c1 = *(const f32x4*)(cp + 4), s0 = *(const f32x4*)sp, s1 = *(const f32x4*)(sp + 4);
            const f32x4 x0 = a0 * c0 - b0 * s0, x1 = a1 * c1 - b1 * s1, y0 = a0 * s0 + b0 * c0, y1 = a1 * s1 + b1 * c1;
            a0 = x0; a1 = x1; b0 = y0; b1 = y1; }
        bf16* d = KPE + (size_t)drow * 64 + 8 * c8;
        *(v4u*)d = (v4u){pk2(a0[0], a0[1]), pk2(a0[2], a0[3]), pk2(a1[0], a1[1]), pk2(a1[2], a1[3])};
        *(v4u*)(d + 32) = (v4u){pk2(b0[0], b0[1]), pk2(b0[2], b0[3]), pk2(b1[0], b1[1]), pk2(b1[2], b1[3])};
    }
}

constexpr float ATT_SCALE = 0.07216878364870322f;
constexpr float ATT_THR = 8.f;
constexpr int AT_V = 0, AT_KN = 49152, AT_KP = 98304, AT_WS = 122880, AT_VB = 16384, AT_KNB = 16384, AT_KPB = 8192;
#define KSWZ(row, colB) ((row) * 256 + ((colB) ^ (((row) & 7) << 4)))
#define KPSWZ(row, colB) ((row) * 128 + ((colB) ^ (((row) & 7) << 4)))
__device__ __forceinline__ void at_partialSM(f32x16& p0, f32x16& p1, float& m_reg, float& mn, float& alpha) {
    constexpr float C = ATT_SCALE * 1.4426950408889634f;
    float pmax = p0[0];
#pragma unroll
    for (int r = 1; r < 16; ++r) pmax = fmaxf(pmax, p0[r]);
#pragma unroll
    for (int r = 0; r < 16; ++r) pmax = fmaxf(pmax, p1[r]);
    { auto rr = __builtin_amdgcn_permlane32_swap(__float_as_uint(pmax), __float_as_uint(pmax), false, false); pmax = fmaxf(__uint_as_float(rr[0]), __uint_as_float(rr[1])); }
    if (__builtin_expect(__all(pmax - m_reg <= ATT_THR / ATT_SCALE), 1)) { mn = m_reg; alpha = 1.f; }
    else { mn = fmaxf(m_reg, pmax); alpha = __builtin_amdgcn_exp2f((m_reg - mn) * C); m_reg = mn; }
    const float mnC = -mn * C;
#pragma unroll
    for (int r = 0; r < 16; ++r) p0[r] = fmaf(p0[r], C, mnC);
#pragma unroll
    for (int r = 0; r < 16; ++r) p1[r] = fmaf(p1[r], C, mnC);
#pragma unroll
    for (int r = 0; r < 16; ++r) p0[r] = __builtin_amdgcn_exp2f(p0[r]);
}
__device__ __forceinline__ void at_finishSM(f32x16& p0, f32x16& p1, float alpha, float& l_reg, bf16x8& pa0, bf16x8& pa1, bf16x8& pa2, bf16x8& pa3) {
#pragma unroll
    for (int r = 0; r < 16; ++r) p1[r] = __builtin_amdgcn_exp2f(p1[r]);
    float ps = 0;
#pragma unroll
    for (int r = 0; r < 16; ++r) ps += p0[r];
#pragma unroll
    for (int r = 0; r < 16; ++r) ps += p1[r];
    { auto rr = __builtin_amdgcn_permlane32_swap(__float_as_uint(ps), __float_as_uint(ps), false, false); ps = __uint_as_float(rr[0]) + __uint_as_float(rr[1]); }
    l_reg = l_reg * alpha + ps;
    PK4(p0, 0, pa0); PK4(p0, 8, pa1); PK4(p1, 0, pa2); PK4(p1, 8, pa3);
}
__device__ __forceinline__ void at_qkt(f32x16& p0, f32x16& p1, const LAS unsigned char* Kn, const LAS unsigned char* Kp, const bf16x8* qr, const int* kb, const int* pb) {
    p0 = f32x16{}; p1 = f32x16{};
#pragma unroll
    for (int d0 = 0; d0 < 8; ++d0) {
        const bf16x8 b0 = *(const LAS bf16x8*)(Kn + kb[d0 & 3] + 128 * (d0 >> 2)), b1 = *(const LAS bf16x8*)(Kn + kb[d0 & 3] + 128 * (d0 >> 2) + 8192);
        p0 = __builtin_amdgcn_mfma_f32_32x32x16_bf16(b0, qr[d0], p0, 0, 0, 0);
        p1 = __builtin_amdgcn_mfma_f32_32x32x16_bf16(b1, qr[d0], p1, 0, 0, 0); }
#pragma unroll
    for (int d0 = 0; d0 < 4; ++d0) {
        const bf16x8 b0 = *(const LAS bf16x8*)(Kp + pb[d0]), b1 = *(const LAS bf16x8*)(Kp + pb[d0] + 4096);
        p0 = __builtin_amdgcn_mfma_f32_32x32x16_bf16(b0, qr[8 + d0], p0, 0, 0, 0);
        p1 = __builtin_amdgcn_mfma_f32_32x32x16_bf16(b1, qr[8 + d0], p1, 0, 0, 0); }
}
template <int D0> __device__ __forceinline__ void at_pv_one(f32x16& od, unsigned vb, bf16x8 pa0, bf16x8 pa1, bf16x8 pa2, bf16x8 pa3) {
    const s16x4 l0 = tr_read<D0 * 512>(vb), h0 = tr_read<D0 * 512 + 2048>(vb), l1 = tr_read<D0 * 512 + 4096>(vb), h1 = tr_read<D0 * 512 + 4096 + 2048>(vb);
    const s16x4 l2 = tr_read<D0 * 512 + 8192>(vb), h2 = tr_read<D0 * 512 + 8192 + 2048>(vb), l3 = tr_read<D0 * 512 + 12288>(vb), h3 = tr_read<D0 * 512 + 12288 + 2048>(vb);
    asm volatile("s_waitcnt lgkmcnt(0)" ::: "memory"); SBAR();
    od = __builtin_amdgcn_mfma_f32_32x32x16_bf16(pa0, PKF(l0, h0), od, 0, 0, 0);
    od = __builtin_amdgcn_mfma_f32_32x32x16_bf16(pa1, PKF(l1, h1), od, 0, 0, 0);
    od = __builtin_amdgcn_mfma_f32_32x32x16_bf16(pa2, PKF(l2, h2), od, 0, 0, 0);
    od = __builtin_amdgcn_mfma_f32_32x32x16_bf16(pa3, PKF(l3, h3), od, 0, 0, 0);
}
__device__ __forceinline__ void at_pv(f32x16* o, unsigned vb, bf16x8 pa0, bf16x8 pa1, bf16x8 pa2, bf16x8 pa3) {
    at_pv_one<0>(o[0], vb, pa0, pa1, pa2, pa3); at_pv_one<1>(o[1], vb, pa0, pa1, pa2, pa3); at_pv_one<2>(o[2], vb, pa0, pa1, pa2, pa3); at_pv_one<3>(o[3], vb, pa0, pa1, pa2, pa3);
}
__device__ __forceinline__ void attn_unit(Frame& F, const bf16* Qrow0  , const bf16* KVh  , const bf16* KPEs  ,
                                          bf16* Orow0, int nkeys, const float* ROPE, int tpos0  ) {
    LAS unsigned char* lds = F.lds;
    const int tid = F.tid, wid = F.wave, lane = F.lane, r32 = lane & 31, hi = lane >> 5;
    LAS float* wsf = (LAS float*)(lds + AT_WS) + wid * 64; LAS float* li_l = wsf; LAS float* al_l = wsf + 32;
    float m_reg = -1e30f, l_reg = 0; f32x16 o[4] = {}; bf16x8 qr[12];
    { const bf16* Qw = Qrow0 + (size_t)(wid * 32 + r32) * 1536 + hi * 8;
#pragma unroll
      for (int d0 = 0; d0 < 12; ++d0) qr[d0] = *(const bf16x8*)(Qw + d0 * 16);
      if (tpos0 >= 0) {
          const int t = tpos0 + wid * 32 + r32;
#pragma unroll
          for (int half = 0; half < 2; ++half) {
              const float* cp = ROPE + (size_t)t * 32 + 16 * half + 8 * hi; const float* sp = cp + 65536;
              const v4u xa = __builtin_bit_cast(v4u, qr[8 + half]), xb = __builtin_bit_cast(v4u, qr[10 + half]);
              float x1[8], x2[8];
              x1[0] = bflo(xa.x); x1[1] = bfhi(xa.x); x1[2] = bflo(xa.y); x1[3] = bfhi(xa.y); x1[4] = bflo(xa.z); x1[5] = bfhi(xa.z); x1[6] = bflo(xa.w); x1[7] = bfhi(xa.w);
              x2[0] = bflo(xb.x); x2[1] = bfhi(xb.x); x2[2] = bflo(xb.y); x2[3] = bfhi(xb.y); x2[4] = bflo(xb.z); x2[5] = bfhi(xb.z); x2[6] = bflo(xb.w); x2[7] = bfhi(xb.w);
              float y1[8], y2[8];
#pragma unroll
              for (int j = 0; j < 8; ++j) { const float c = cp[j], s = sp[j]; y1[j] = x1[j] * c - x2[j] * s; y2[j] = x1[j] * s + x2[j] * c; }
              const v4u wa = {pk2(y1[0], y1[1]), pk2(y1[2], y1[3]), pk2(y1[4], y1[5]), pk2(y1[6], y1[7])}, wb = {pk2(y2[0], y2[1]), pk2(y2[2], y2[3]), pk2(y2[4], y2[5]), pk2(y2[6], y2[7])};
              if (half == 0) { qr[8] = __builtin_bit_cast(bf16x8, wa); qr[10] = __builtin_bit_cast(bf16x8, wb); } else { qr[9] = __builtin_bit_cast(bf16x8, wa); qr[11] = __builtin_bit_cast(bf16x8, wb); }
          }
      } }
    const unsigned vb0 = (unsigned)(uintptr_t)(lds + AT_V) + v_rd_base(lane);
#define AT_OPQ() int l_ = lane; asm volatile("" : "+v"(l_))
#define AT_KADDR() int kbs[4], pbs[4]; { AT_OPQ(); _Pragma("unroll") for (int b = 0; b < 4; ++b) { const int x = (32 * b + 16 * (l_ >> 5)) ^ ((l_ & 7) << 4); kbs[b] = (l_ & 31) * 256 + x; pbs[b] = (l_ & 31) * 128 + x; } }
#define AT_GLDS(gp, ldsoff) __builtin_amdgcn_global_load_lds((const unsigned*)(gp), (LAS unsigned*)(lds + (ldsoff)), 16, 0, 0)
#define AT_DMA_K(t, b) do { AT_OPQ(); const char* kb_ = (const char*)KVh + (size_t)(t) * (64 * 4096); const char* pb_ = (const char*)KPEs + (size_t)(t) * (64 * 128); \
    const int row0_ = 4 * wid + (l_ >> 4), cB0_ = ((l_ & 15) * 16) ^ ((row0_ & 7) << 4), row1_ = row0_ + 32, rowp_ = 8 * wid + (l_ >> 3), cBp_ = ((l_ & 7) * 16) ^ ((rowp_ & 7) << 4); \
    AT_GLDS(kb_ + (unsigned)(row0_ * 4096 + cB0_), AT_KN + (b) * AT_KNB + wid * 1024); AT_GLDS(kb_ + (unsigned)(row1_ * 4096 + cB0_), AT_KN + (b) * AT_KNB + (wid + 8) * 1024); \
    AT_GLDS(pb_ + (unsigned)(rowp_ * 128 + cBp_), AT_KP + (b) * AT_KPB + wid * 1024); } while (0)
#define AT_DMA_V(t, b) do { AT_OPQ(); const char* vb_ = (const char*)KVh + (size_t)(t) * (64 * 4096); \
    const int st_ = 2 * wid + (l_ >> 5), kk_ = (st_ >> 2) * 8 + ((l_ & 31) >> 2), key_ = (kk_ & ~0xC) | ((kk_ & 4) << 1) | ((kk_ & 8) >> 1), col_ = (st_ & 3) * 32 + (l_ & 3) * 8; \
    AT_GLDS(vb_ + (unsigned)(key_ * 4096 + (128 + col_) * 2), AT_V + (b) * AT_VB + wid * 1024); AT_GLDS(vb_ + (unsigned)((key_ + 32) * 4096 + (128 + col_) * 2), AT_V + (b) * AT_VB + (wid + 8) * 1024); } while (0)
#define AT_RESC(a) do { if (__any((a) < 1.f)) { if (hi == 0) al_l[r32] = (a); asm volatile("s_waitcnt lgkmcnt(0)" ::: "memory"); \
    _Pragma("unroll") for (int d = 0; d < 4; ++d) _Pragma("unroll") for (int r = 0; r < 16; ++r) o[d][r] *= al_l[crow(r, hi)]; } } while (0)
#define AT_WAITBAR(N) do { asm volatile("s_waitcnt vmcnt(" #N ") lgkmcnt(0)" ::: "memory"); __builtin_amdgcn_s_barrier(); asm volatile("" ::: "memory"); } while (0)
    f32x16 pA0, pA1, pB0, pB1; float mnA, mnB, alA, alB; bf16x8 pa0, pa1, pa2, pa3; const int NT = nkeys / 64;
    AT_DMA_K(0, 0); AT_DMA_K(1, 1); AT_DMA_V(0, 0); AT_WAITBAR(0);
    int s = 0;
#define AT_S1 (s == 2 ? 0 : s + 1)
#define AT_S2 (s == 0 ? 2 : s - 1)
#define AT_STEP(CUR0, CUR1, MNC, ALC, PRV0, PRV1, ALP, t, MODE) do { \
        if (MODE == 2) { AT_DMA_K((t) + 2, AT_S2); } if (MODE >= 1) { AT_DMA_V((t) + 1, AT_S1); } \
        SBAR(); { AT_KADDR(); at_qkt(CUR0, CUR1, lds + AT_KN + s * AT_KNB, lds + AT_KP + s * AT_KPB, qr, kbs, pbs); } \
        at_finishSM(PRV0, PRV1, ALP, l_reg, pa0, pa1, pa2, pa3); SBAR(); \
        at_pv(o, vb0 + AT_S2 * AT_VB, pa0, pa1, pa2, pa3); at_partialSM(CUR0, CUR1, m_reg, MNC, ALC); \
        AT_RESC(ALC); if (MODE == 2) AT_WAITBAR(5); else if (MODE == 1) AT_WAITBAR(2); else AT_WAITBAR(0); s = AT_S1; } while (0)
    AT_DMA_K(2, 2); AT_DMA_V(1, 1);
    { AT_KADDR(); at_qkt(pA0, pA1, lds + AT_KN, lds + AT_KP, qr, kbs, pbs); } at_partialSM(pA0, pA1, m_reg, mnA, alA);
    AT_WAITBAR(5); s = 1;
    int t = 1;
    for (; t + 4 < NT; t += 2) {
        AT_STEP(pB0, pB1, mnB, alB, pA0, pA1, alA, t, 2);
        AT_STEP(pA0, pA1, mnA, alA, pB0, pB1, alB, t + 1, 2);
    }
    AT_STEP(pB0, pB1, mnB, alB, pA0, pA1, alA, NT - 3, 2);
    AT_STEP(pA0, pA1, mnA, alA, pB0, pB1, alB, NT - 2, 1);
    AT_STEP(pB0, pB1, mnB, alB, pA0, pA1, alA, NT - 1, 0);
    at_finishSM(pB0, pB1, alB, l_reg, pa0, pa1, pa2, pa3); SBAR();
    at_pv(o, vb0 + AT_S2 * AT_VB, pa0, pa1, pa2, pa3);
    if (hi == 0) li_l[r32] = l_reg; asm volatile("s_waitcnt lgkmcnt(0)" ::: "memory");
    float rli[16];
#pragma unroll
    for (int r = 0; r < 16; ++r) rli[r] = __builtin_amdgcn_rcpf(li_l[crow(r, hi)]);
    bf16* Ow = Orow0 + (size_t)(wid * 32) * D;
#pragma unroll
    for (int r = 0; r < 16; r += 2) { const int orow = crow(r, hi);
#pragma unroll
        for (int d0 = 0; d0 < 4; ++d0) { const unsigned w = pk2(o[d0][r] * rli[r], o[d0][r + 1] * rli[r + 1]);
            Ow[(size_t)orow * D + d0 * 32 + r32] = (bf16)w; Ow[(size_t)(orow + 1) * D + d0 * 32 + r32] = (bf16)(w >> 16); } }
#undef AT_GLDS
#undef AT_OPQ
#undef AT_KADDR
#undef AT_DMA_K
#undef AT_DMA_V
#undef AT_RESC
#undef AT_WAITBAR
#undef AT_S1
#undef AT_S2
#undef AT_STEP
}
__device__ __forceinline__ void attn_phase(Frame& F, const Params& P, int li) {
    unsigned char* ws = PWS;
    const bf16* Q = (const bf16*)(ws + WS_Q); const bf16* KV = (const bf16*)(ws + WS_KV); const bf16* KPE = (const bf16*)(ws + WS_KPE);
    bf16* OB = (bf16*)(ws + WS_HB); const float* ROPE = (const float*)(ws + WS_ROPE);
    for (int u = F.vcu; u < 256 + 128; u += F.G) {
        for (int k = 0; k < 2; ++k) {
            int qrow0, kvrow0, nkeys, h, tpos0;
            if (u < 256) { const int id = 2 * u + k, lb = id >> 6, qb = id & 7; h = (id >> 3) & 7; qrow0 = M_CTX + lb * L_LAT + qb * 256; kvrow0 = M_CTX + lb * LKV; nkeys = LKV; tpos0 = qb * 256; }
            else { if (k == 1) break; const int id = u - 256, b = id >> 3; h = id & 7; qrow0 = b * L_CTX; kvrow0 = b * L_CTX; nkeys = L_CTX; tpos0 = -1; }
            __syncthreads();
            attn_unit(F, Q + (size_t)qrow0 * 1536 + h * 192, KV + (size_t)kvrow0 * 2048 + h * 256, KPE + (size_t)kvrow0 * 64, OB + (size_t)qrow0 * D + h * 128, nkeys, ROPE, tpos0);
        }
    }
}

constexpr int N_PHASES = 2 + 2 * 16;
__global__ void __launch_bounds__(NWAVES * 64, 2) hyb_fwd(Params P) {
    extern __shared__ __attribute__((aligned(16))) unsigned char lds_raw[];
    Frame F;
    F.lds = (LAS unsigned char*)lds_raw;
    F.tid = threadIdx.x; F.lane = F.tid & 63; F.wave = __builtin_amdgcn_readfirstlane(F.tid >> 6);
    F.G = gridDim.x; { const int bx = blockIdx.x; F.vcu = (F.G % 8 == 0) ? (bx % 8) * (F.G / 8) + bx / 8 : bx; }
    volatile LAS unsigned* MISC = (volatile LAS unsigned*)(F.lds + LDS_MISC);
    if (F.tid < 64) MISC[F.tid] = 0u;
    if (F.tid < 30) { const unsigned long long v = F.tid < 28 ? (unsigned long long)P.in[F.tid] : (F.tid == 28 ? (unsigned long long)P.out : (unsigned long long)P.ws);
        volatile LAS unsigned* pt = (volatile LAS unsigned*)(F.lds + LDS_PT) + 2 * F.tid; pt[0] = (unsigned)v; pt[1] = (unsigned)(v >> 32); }
    __syncthreads();
    const int use_bar = P.use_bar, ph_hi = P.ph_hi;
    XcdBarrier bar; bar.bar = (unsigned*)(PWS + WS_CTL) + 4096; bar.x = 0; bar.st = nullptr;
    if (use_bar) bar = xcd_barrier_post((unsigned*)(PWS + WS_CTL) + 4096, MISC + 8);

    int dup_done = 0; (void)dup_done;
    for (int ph = P.ph_lo; ph < ph_hi; ++ph) {
#define REFRESH_ID() do { int t_ = threadIdx.x; asm volatile("" : "+v"(t_)); F.tid = t_; F.lane = t_ & 63; F.wave = __builtin_amdgcn_readfirstlane(t_ >> 6); \
          int g_ = gridDim.x, b_ = blockIdx.x; asm volatile("" : "+s"(g_), "+s"(b_)); F.G = g_; F.vcu = (g_ % 8 == 0) ? (b_ % 8) * (g_ / 8) + b_ / 8 : b_; F.bid = b_; } while (0)
        REFRESH_ID();
        unsigned char* ws = PWS;
        bf16* XBF = (bf16*)(POUT + OUT_Y);
        bf16* HB = (bf16*)(ws + WS_HB); bf16* YB = (bf16*)(ws + WS_Y); const bf16* SL = (const bf16*)(ws + WS_SLAB);
        const float* MOD = (const float*)(ws + WS_MOD);
        if (ph == 0) { p0_prologue(F, P); }
        else if (ph == 1) {
            const float* m0 = MOD;
            row_pass(F, PIN(I_XP), PIN(I_XS), true, nullptr, nullptr, nullptr, nullptr, nullptr, PIN(I_NMIXPRE), m0 + 1024, m0, HB, false, true);
        } else {
            const int q = ph - 2, pair = q / 16, r = q % 16; const bool odd = r >= 8; const int l = 2 * pair + (odd ? 1 : 0), k = odd ? r - 8 : r;
            const float* ml = MOD + (size_t)l * 9 * 6144;
            const int kind = k < 3 ? (odd ? 10 + k : (k == 2 ? 8 : k)) : (k == 3 ? 2 : k == 4 ? 3 : k == 5 ? 4 : k == 6 ? 5 : 6);
            if (kind == 0) {
                pg8::Gemm g{HB, (const bf16*)(ws + WS_WINE) + (size_t)pair * EVEN_NP * 1024, M, EVEN_NP, 1024}; pg8::StaticOrder S; S.init(M, EVEN_NP, F.G, F.bid, 1024);
                pg8::EpiBf16<0> E{(bf16*)(ws + WS_BIG), EVEN_NP};
                pg8::gemm_phase<pg8::EpiBf16<0>, pg8::StaticOrder, true, true>(F.lds, g, S, E, F.tid);
            } else if (kind == 1) {
                scan_phase(F, P, pair);
            } else if (kind == 8) {
                scan_combine(F, P, pair);
            } else if (kind == 2) {
                const bf16* W = odd ? (const bf16*)(ws + WS_WOUTO) + (size_t)pair * 1024 * 1024 : (const bf16*)(ws + WS_WOUTE) + (size_t)pair * 1024 * 1024;
                { pg8::Gemm g{HB, W, M, 1024, 1024}; pg8::TailSplitOrder S; S.init(F.bid, 1024, 1);
                  pg8::EpiYsplit E{YB, (bf16*)(ws + WS_SLAB)};
                  pg8::gemm_phase<pg8::EpiYsplit, pg8::TailSplitOrder, true, true>(F.lds, g, S, E, F.tid); }
                REFRESH_ID();
                { pg8::Gemm g{HB, W, M, 1024, 1024}; pg8::TailSplitOrder S; S.init(F.bid, 1024, 2);
                  pg8::EpiYsplit E{YB, (bf16*)(PWS + WS_SLAB)};
                  pg8::gemm_phase<pg8::EpiYsplit, pg8::TailSplitOrder, true, true>(F.lds, g, S, E, F.tid); }
            } else if (kind == 3) {
                row_pass(F, PIN(I_XP), PIN(I_XS), l == 0, XBF, YB, SL, PIN(I_NMIXPOST) + l * 1024, ml + 2048, PIN(I_NMLPPRE) + l * 1024, ml + 4096, ml + 3072, HB, true, true);
            } else if (kind == 4) {
                pg8::Gemm g{HB, (const bf16*)(ws + WS_W1) + (size_t)l * 4096 * 1024, M, FF, 1024}; pg8::StaticOrder S; S.init(M, FF, F.G, F.bid, 1024);
                pg8::EpiBf16<1> E{(bf16*)(ws + WS_BIG), FF};
                pg8::gemm_phase<pg8::EpiBf16<1>, pg8::StaticOrder, true, true>(F.lds, g, S, E, F.tid);
            } else if (kind == 5) {
                { pg8::Gemm g{(const bf16*)(ws + WS_BIG), (const bf16*)(ws + WS_W2) + (size_t)l * 1024 * 4096, M, 1024, FF}; pg8::TailSplitOrder S; S.init(F.bid, FF, 1);
                  pg8::EpiYsplit E{YB, (bf16*)(ws + WS_SLAB)};
                  pg8::gemm_phase<pg8::EpiYsplit, pg8::TailSplitOrder, true, true>(F.lds, g, S, E, F.tid); }
                REFRESH_ID();
                { pg8::Gemm g{(const bf16*)(PWS + WS_BIG), (const bf16*)(PWS + WS_W2) + (size_t)l * 1024 * 4096, M, 1024, FF}; pg8::TailSplitOrder S; S.init(F.bid, FF, 2);
                  pg8::EpiYsplit E{(bf16*)(PWS + WS_Y), (bf16*)(PWS + WS_SLAB)};
                  pg8::gemm_phase<pg8::EpiYsplit, pg8::TailSplitOrder, true, true>(F.lds, g, S, E, F.tid); }
            } else if (kind == 6) {
                const float* mn = ml + 9 * 6144;
                if (l < 3) row_pass(F, nullptr, nullptr, false, XBF, YB, SL, PIN(I_NMLPPOST) + l * 1024, ml + 5120, PIN(I_NMIXPRE) + (l + 1) * 1024, mn + 1024, mn, HB, true, true);
                else { bar.bar = (unsigned*)(PWS + WS_CTL) + 4096; row_pass_final(F, bar, XBF, POUT + OUT_Y, YB, SL, PIN(I_NMLPPOST) + l * 1024, ml + 5120); }
            } else if (kind == 10) {
                pg8::Gemm g{HB, (const bf16*)(ws + WS_WINO) + (size_t)pair * ODD_NP * 1024, M, ODD_NP, 1024}; pg8::StaticOrder S; S.init(M, ODD_NP, F.G, F.bid, 1024);
                pg8::EpiOddIn E{(bf16*)(ws + WS_QN), (bf16*)(ws + WS_ACKV), (float*)(ws + WS_Y), POUT + OUT_CKV, POUT + OUT_KPE,
                                PIN(I_QAN) + pair * 256, PIN(I_KVAN) + pair * 256, pair};
                pg8::gemm_phase<pg8::EpiOddIn, pg8::StaticOrder, false, true>(F.lds, g, S, E, F.tid);
                REFRESH_ID(); cache_pass(F, P, pair);
            } else if (kind == 11) {
                kpe_pass(F, P, pair); REFRESH_ID();
                { pg8::Gemm g{(const bf16*)(ws + WS_QN), (const bf16*)(ws + WS_WQB) + (size_t)pair * 1536 * 256, M, 1536, 256}; pg8::StaticOrder S; S.init(M, 1536, F.G, F.bid, 256);
                  pg8::EpiBf16<0> E{(bf16*)(ws + WS_Q), 1536};
                  pg8::gemm_phase<pg8::EpiBf16<0>, pg8::StaticOrder, true, true>(F.lds, g, S, E, F.tid); }
                REFRESH_ID();
                { pg8::Gemm g{(const bf16*)(ws + WS_ACKV), (const bf16*)(ws + WS_WKVB) + (size_t)pair * 2048 * 256, MKV, 2048, 256}; pg8::StaticOrder S; S.init(MKV, 2048, F.G, F.bid, 256);
                  pg8::EpiBf16<0> E{(bf16*)(ws + WS_KV), 2048};
                  pg8::gemm_phase<pg8::EpiBf16<0>, pg8::StaticOrder, true, true>(F.lds, g, S, E, F.tid); }
            } else if (kind == 12) {
                attn_phase(F, P, pair);
            }
        }
#if defined(HYB_DUP_MASK)
        { int kind_ = -1;
          if (ph == 0) kind_ = 13;
          else if (ph >= 2) { const int q_ = ph - 2, r_ = q_ % 16; const bool odd_ = r_ >= 8; const int k_ = odd_ ? r_ - 8 : r_;
              kind_ = k_ < 3 ? (odd_ ? 10 + k_ : (k_ == 2 ? 8 : k_)) : (k_ == 3 ? 2 : k_ == 4 ? 3 : k_ == 5 ? 4 : k_ == 6 ? 5 : 6); }
          if (kind_ >= 0 && ((HYB_DUP_MASK >> kind_) & 1) && dup_done == 0) { dup_done = 1; if (use_bar) { bar.bar = (unsigned*)(PWS + WS_CTL) + 4096; xcd_barrier(bar); } else { VM_WAIT(); __syncthreads(); } --ph; continue; } }
        dup_done = 0;
        if (((HYB_DUP_MASK >> 14) & 1) && ph + 1 < ph_hi && use_bar) { bar.bar = (unsigned*)(PWS + WS_CTL) + 4096; xcd_barrier(bar); }
#endif
        if (ph + 1 < ph_hi) { if (use_bar) { bar.bar = (unsigned*)(PWS + WS_CTL) + 4096; xcd_barrier(bar); } else { VM_WAIT(); __syncthreads(); } }
    }
}

extern "C" void kernel_launch(void* const* d_in, const int* in_sizes, int n_in, void* d_out, int out_size, void* d_ws, size_t ws_size, hipStream_t stream) {
    static int grid = 0;
    if (grid == 0) {
        if (n_in != 28 || out_size != 27787264 || ws_size < WS_END) { fprintf(stderr, "kernel_launch: unexpected shapes: n_in %d out %d ws %zu (need >= %zu)\n", n_in, out_size, ws_size, (size_t)WS_END); grid = -1; return; }
        int dev = 0, cus = 0, per_cu = 0;
        if (hipGetDevice(&dev) != hipSuccess || hipDeviceGetAttribute(&cus, hipDeviceAttributeMultiprocessorCount, dev) != hipSuccess) { grid = -1; return; }
        if (hipFuncSetAttribute((const void*)hyb_fwd, hipFuncAttributeMaxDynamicSharedMemorySize, LDS_BYTES) != hipSuccess) { fprintf(stderr, "kernel_launch: hipFuncSetAttribute failed\n"); grid = -1; return; }
        if (hipOccupancyMaxActiveBlocksPerMultiprocessor(&per_cu, (const void*)hyb_fwd, NWAVES * 64, LDS_BYTES) != hipSuccess || per_cu < 1) { fprintf(stderr, "kernel_launch: occupancy query reports %d\n", per_cu); }
        (void)hipGetLastError();
        grid = cus;
    }
    if (grid < 0) return;
    (void)hipMemsetAsync((char*)d_ws + WS_CTL, 0, CTL_ZERO_BYTES, stream);
    Params a{};
    for (int i = 0; i < 28; ++i) a.in[i] = (const float*)d_in[i];
    a.out = (float*)d_out; a.ws = (unsigned char*)d_ws;
    a.ph_lo = 0; a.ph_hi = N_PHASES; a.use_bar = 1; a.pad = 0;
    hipLaunchKernelGGL(hyb_fwd, dim3(grid), dim3(NWAVES * 64), LDS_BYTES, stream, a);
    const hipError_t le = hipPeekAtLastError();
    if (le != hipSuccess) fprintf(stderr, "kernel_launch: launch failed: %s\n", hipGetErrorName(le));
}
```

```cpp
#include <hip/hip_runtime.h>
#include <hip/hip_bf16.h>
#include <cstdio>
#include <cstdint>
namespace pg8 {
#define PG8_LAS __attribute__((address_space(3)))
typedef unsigned short bf16_t;
typedef short bf16x8 __attribute__((ext_vector_type(8)));
typedef float f32x4 __attribute__((ext_vector_type(4)));
typedef unsigned u32x4 __attribute__((ext_vector_type(4)));
constexpr int BM = 256, BK = 64, HALF = 128, HTB = HALF * BK * 2  , STAGE_BYTES = 8 * HTB, NXCD = 8, WGM = 8;

__host__ __device__ __forceinline__ int lds_byte(int r, int c) { const int st = (r >> 4) * 2 + (c >> 5), rr = r & 15, cc = c & 31, ob = rr * 64 + cc * 2; return st * 1024 + (ob ^ (((ob >> 9) & 1) << 5)); }
__host__ __device__ __forceinline__ void stage_rc(int b, int& R, int& C) { const int st = b / 1024, sb = b % 1024, swz = sb ^ (((sb >> 9) & 1) << 5); R = (st >> 1) * 16 + swz / 64; C = (st & 1) * 32 + (swz % 64) / 2; }
__host__ __device__ __forceinline__ int perm32(int rho) { const int n = rho >> 4, i = rho & 15; return 8 * (i >> 2) + 4 * n + (i & 3); }

struct Unit { int pm, pn, ks, kt0, nt; };
struct Gemm { const bf16_t* A; const bf16_t* Bt; int M, N, K; };

struct StaticOrder {
    int nM, nN, nwg, G, c, ntk;
    __host__ __device__ void init(int M, int N, int G_, int c_, int K) { nM = M / BM; nN = N / BM; nwg = nM * nN; G = G_; c = c_; ntk = K / BK; }
    __host__ __device__ bool next(int i, Unit& u) const {
        const long L = (long)i * G + c; if (L >= nwg) return false;
        int wgid = (int)L; { const int q = nwg / NXCD, r = nwg % NXCD, xcd = wgid % NXCD, off = wgid / NXCD; wgid = (xcd < r ? xcd * (q + 1) : r * (q + 1) + (xcd - r) * q) + off; }
        const int nig = WGM * nN, gid = wgid / nig, fm = gid * WGM, gsz = (nM - fm) < WGM ? (nM - fm) : WGM;
        u.pm = fm + ((wgid % nig) % gsz); u.pn = (wgid % nig) / gsz; u.ks = -1; u.kt0 = 0; u.nt = ntk; return true;
    }
    __device__ __forceinline__ void a_ready(const Unit&) const {}
    __device__ __forceinline__ void done(const Unit&) const {}
};


struct TailSplitOrder {
    int c, ntk, mode;
    __device__ void init(int c_, int K, int mode_) { c = c_; ntk = K / BK; mode = mode_; }
    __device__ bool next(int i, Unit& u) const {
        const int xcd = c & 7, j = c >> 3;
        const int round = mode == 2 ? i + 1 : i;
        if (round == 0) { u.pm = xcd * 8 + (j & 7); u.pn = j >> 3; u.ks = -1; u.kt0 = 0; u.nt = ntk; return true; }
        if (round == 1 && mode != 1) { u.pm = 64 + xcd * 2 + (j & 1); u.pn = (j >> 1) & 3; u.ks = j >> 3; u.nt = ntk >> 2; u.kt0 = u.ks * u.nt; return true; }
        return false;
    }
    __device__ __forceinline__ void a_ready(const Unit&) const {}
    __device__ __forceinline__ void done(const Unit&) const {}
};

typedef float f32x2c_t __attribute__((ext_vector_type(2))); typedef __bf16 bf16x2c_t __attribute__((ext_vector_type(2)));
__device__ __forceinline__ unsigned cvt_pk_bf16(float lo, float hi) { f32x2c_t v = {lo, hi}; bf16x2c_t b = __builtin_convertvector(v, bf16x2c_t); return __builtin_bit_cast(unsigned, b); }

template <int ACT> struct EpiBf16 {
    static constexpr bool PERM = true, AFTER_DRAIN = false;
    bf16_t* O; int ldc;
    __device__ __forceinline__ void operator()(const f32x4 (&acc)[2][2][4][2], const Unit& u, int wr, int wc, int fr, int fq) const {
        const int row0 = u.pm * BM + wr * 64 + fr; const int col0 = u.pn * BM + wc * 32 + 8 * fq;
#pragma unroll
        for (int ai = 0; ai < 2; ++ai)
#pragma unroll
            for (int m = 0; m < 4; ++m) { bf16_t* rowp = O + (size_t)(row0 + ai * HALF + m * 16) * ldc + col0;
#pragma unroll
                for (int bj = 0; bj < 2; ++bj) { f32x4 v0 = acc[ai][bj][m][0], v1 = acc[ai][bj][m][1];
                    if (ACT == 1) {
#pragma unroll
                        for (int j = 0; j < 4; ++j) { const float a = fmaxf(v0[j], 0.f), b = fmaxf(v1[j], 0.f); v0[j] = a * a; v1[j] = b * b; } }
                    u32x4 w; w.x = cvt_pk_bf16(v0[0], v0[1]); w.y = cvt_pk_bf16(v0[2], v0[3]); w.z = cvt_pk_bf16(v1[0], v1[1]); w.w = cvt_pk_bf16(v1[2], v1[3]);
                    *(u32x4*)(rowp + bj * HALF) = w; } }
    }
};
struct EpiYsplit {
    static constexpr bool PERM = true, AFTER_DRAIN = false;
    bf16_t* Y; bf16_t* SL;
    __device__ __forceinline__ void operator()(const f32x4 (&acc)[2][2][4][2], const Unit& u, int wr, int wc, int fr, int fq) const {
        const int row0 = u.pm * BM + wr * 64 + fr; const int col0 = u.pn * BM + wc * 32 + 8 * fq;
        if (u.ks < 0) {
#pragma unroll
            for (int ai = 0; ai < 2; ++ai)
#pragma unroll
                for (int m = 0; m < 4; ++m) { bf16_t* rowp = Y + (size_t)(row0 + ai * HALF + m * 16) * 1024 + col0;
#pragma unroll
                    for (int bj = 0; bj < 2; ++bj) { const f32x4 v0 = acc[ai][bj][m][0], v1 = acc[ai][bj][m][1];
                        u32x4 w; w.x = cvt_pk_bf16(v0[0], v0[1]); w.y = cvt_pk_bf16(v0[2], v0[3]); w.z = cvt_pk_bf16(v1[0], v1[1]); w.w = cvt_pk_bf16(v1[2], v1[3]);
                        *(u32x4*)(rowp + bj * HALF) = w; } }
        } else {
            bf16_t* base = SL + (size_t)u.ks * (4096 * 1024);
#pragma unroll
            for (int ai = 0; ai < 2; ++ai)
#pragma unroll
                for (int m = 0; m < 4; ++m) { bf16_t* rowp = base + (size_t)(row0 - 16384 + ai * HALF + m * 16) * 1024 + col0;
#pragma unroll
                    for (int bj = 0; bj < 2; ++bj) { const f32x4 v0 = acc[ai][bj][m][0], v1 = acc[ai][bj][m][1];
                        u32x4 w; w.x = cvt_pk_bf16(v0[0], v0[1]); w.y = cvt_pk_bf16(v0[2], v0[3]); w.z = cvt_pk_bf16(v1[0], v1[1]); w.w = cvt_pk_bf16(v1[2], v1[3]);
                        *(u32x4*)(rowp + bj * HALF) = w; } }
        }
    }
};
struct EpiOddIn {
    static constexpr bool PERM = false, AFTER_DRAIN = true;
    bf16_t* QN; bf16_t* ACKV; float* KPERAW; float* out_ckv; float* out_kpe; const float* gq; const float* gkv; int li;
    __device__ __forceinline__ void fused(f32x4 (&acc)[2][2][4][2], const Unit& u, int wr, int wc, int fr, int fq, PG8_LAS unsigned char* lds, int wid, int lane) const {
        PG8_LAS float* P = (PG8_LAS float*)lds;
        if (u.pn < 2) {
#pragma unroll
            for (int ai = 0; ai < 2; ++ai)
#pragma unroll
                for (int m = 0; m < 4; ++m) { float s = 0.f;
#pragma unroll
                    for (int bj = 0; bj < 2; ++bj)
#pragma unroll
                        for (int n = 0; n < 2; ++n) { const f32x4 x = acc[ai][bj][m][n]; s += (x[0] * x[0] + x[1] * x[1]) + (x[2] * x[2] + x[3] * x[3]); }
                    s += __shfl_xor(s, 16); s += __shfl_xor(s, 32);
                    if (fq == 0) P[(ai * HALF + wr * 64 + m * 16 + fr) * 4 + wc] = s; }
        }
        asm volatile("s_waitcnt lgkmcnt(0)" ::: "memory"); __builtin_amdgcn_s_barrier(); asm volatile("" ::: "memory");
        if (u.pn < 2) {
            const float* gv = u.pn == 0 ? gq : gkv;
#pragma unroll
            for (int ai = 0; ai < 2; ++ai)
#pragma unroll
                for (int m = 0; m < 4; ++m) { const int r = ai * HALF + wr * 64 + m * 16 + fr; const int grow = u.pm * BM + r;
                    const float tot = (P[r * 4 + 0] + P[r * 4 + 1]) + (P[r * 4 + 2] + P[r * 4 + 3]);
                    const float rstd = 1.0f / sqrtf(tot * (1.0f / 256.0f) + 1e-6f);
                    const int drow = grow < 4096 ? grow : 4096 + ((grow - 4096) >> 11) * 2304 + 256 + ((grow - 4096) & 2047);
#pragma unroll
                    for (int bj = 0; bj < 2; ++bj)
#pragma unroll
                        for (int n = 0; n < 2; ++n) { const int col = bj * HALF + wc * 32 + n * 16 + 4 * fq; const f32x4 g = *(const f32x4*)(gv + col);
                            const f32x4 v = acc[ai][bj][m][n] * rstd * g;
                            unsigned long long w = (unsigned long long)cvt_pk_bf16(v[0], v[1]) | ((unsigned long long)cvt_pk_bf16(v[2], v[3]) << 32);
                            if (u.pn == 0) *(unsigned long long*)(QN + (size_t)grow * 256 + col) = w;
                            else { *(unsigned long long*)(ACKV + (size_t)drow * 256 + col) = w;
                                   if (grow < 4096) *(f32x4*)(out_ckv + ((size_t)((grow >> 8) * 2 + li) * 256 + (grow & 255)) * 256 + col) = v; } } }
        } else if (wc < 2) {
#pragma unroll
            for (int ai = 0; ai < 2; ++ai)
#pragma unroll
                for (int m = 0; m < 4; ++m) { const int r = ai * HALF + wr * 64 + m * 16 + fr; const int grow = u.pm * BM + r;
#pragma unroll
                    for (int n = 0; n < 2; ++n) { const int col = wc * 32 + n * 16 + 4 * fq; const f32x4 v = acc[ai][0][m][n];
                        *(f32x4*)(KPERAW + (size_t)grow * 64 + col) = v;
                        if (grow < 4096) *(f32x4*)(out_kpe + ((size_t)((grow >> 8) * 2 + li) * 256 + (grow & 255)) * 64 + col) = v; } }
        }
    }
};

template <class Epi, class Sched, bool ALIGN_EPI = false, bool SP2 = false>
__device__ __forceinline__ void gemm_phase(PG8_LAS unsigned char* lds, const Gemm g, const Sched& S, const Epi& E, const int tid) {
    const int  wid = __builtin_amdgcn_readfirstlane(tid >> 6), lane = tid & 63, wr = wid >> 2, wc = wid & 3, fr = lane & 15, fq = lane >> 4;
    const int K = g.K;
    unsigned voffA[2], voffB[2];
#pragma unroll
    for (int i = 0; i < 2; ++i) { int R, C; stage_rc(tid * 16 + i * 8192, R, C); const int Rb = Epi::PERM ? ((R & ~31) + perm32(R & 31)) : R;
        voffA[i] = (unsigned)(R * K + C) * 2u; voffB[i] = (unsigned)(Rb * K + C) * 2u; }
    const size_t kstep = (size_t)(BK * 2);
    const size_t hstep = (size_t)HALF * K * 2;
    const size_t tstep = 2 * hstep;
    const unsigned ldsw = (unsigned)wid * 1024u;
    const int aoff = lds_byte(wr * 64 + fr, fq * 8), boff = lds_byte(wc * 32 + fr, fq * 8);
#define PG8_SA(b, h) (((b) * 2 + (h)) * HTB)
#define PG8_SB(b, h) ((4 + (b) * 2 + (h)) * HTB)
#define PG8_STAGE(bufoff, gbase, voff) do { _Pragma("unroll") for (int _i = 0; _i < 2; ++_i) \
        __builtin_amdgcn_global_load_lds((const unsigned*)((const char*)(gbase) + (voff)[_i]), (PG8_LAS unsigned*)(lds + (bufoff) + ldsw + _i * 8192), 16, 0, 0); } while (0)
#define PG8_LDA(dst, b, h) do { _Pragma("unroll") for (int m = 0; m < 4; ++m) _Pragma("unroll") for (int k = 0; k < 2; ++k) dst[m][k] = *(const PG8_LAS bf16x8*)(lds + PG8_SA(b, h) + aoff + m * 2048 + k * 1024); } while (0)
#define PG8_LDB(dst, b, h) do { _Pragma("unroll") for (int n = 0; n < 2; ++n) _Pragma("unroll") for (int k = 0; k < 2; ++k) dst[n][k] = *(const PG8_LAS bf16x8*)(lds + PG8_SB(b, h) + boff + n * 2048 + k * 1024); } while (0)
#define PG8_MMA(ai, bj, At, Bt) do { __builtin_amdgcn_s_setprio(1); _Pragma("unroll") for (int m = 0; m < 4; ++m) _Pragma("unroll") for (int n = 0; n < 2; ++n) _Pragma("unroll") for (int k = 0; k < 2; ++k) \
        acc[ai][bj][m][n] = __builtin_amdgcn_mfma_f32_16x16x32_bf16(Bt[n][k], At[m][k], acc[ai][bj][m][n], 0, 0, 0); __builtin_amdgcn_s_setprio(0); } while (0)
#define PG8_WAIT_V(n) asm volatile("s_waitcnt vmcnt(" #n ")" ::: "memory")
#define PG8_WAIT_L(n) asm volatile("s_waitcnt lgkmcnt(" #n ")" ::: "memory")
#define PG8_BAR __builtin_amdgcn_s_barrier()
#define PG8_SCHED __builtin_amdgcn_sched_barrier(0)
    Unit cur, nxt; int ui = 0;
    if (!S.next(0, cur)) return;
    f32x4 acc[2][2][4][2];
#pragma unroll
    for (int a = 0; a < 2; ++a)
#pragma unroll
        for (int b = 0; b < 2; ++b)
#pragma unroll
            for (int m = 0; m < 4; ++m)
#pragma unroll
                for (int n = 0; n < 2; ++n) acc[a][b][m][n] = (f32x4){0.f, 0.f, 0.f, 0.f};
    bf16x8 At[4][2], B0[2][2], B1[2][2];
    const char* cA = (const char*)g.A + (size_t)cur.pm * tstep + (size_t)cur.kt0 * kstep; const char* cB = (const char*)g.Bt + (size_t)cur.pn * tstep + (size_t)cur.kt0 * kstep;
    S.a_ready(cur);
    if constexpr (SP2) {
        PG8_STAGE(PG8_SB(0, 0), cB, voffB); PG8_STAGE(PG8_SB(0, 1), cB + hstep, voffB); PG8_STAGE(PG8_SA(0, 0), cA, voffA); PG8_STAGE(PG8_SA(0, 1), cA + hstep, voffA);
        if (wr == 1) PG8_BAR;
        PG8_WAIT_V(2); PG8_BAR;
        PG8_STAGE(PG8_SB(1, 0), cB + kstep, voffB); PG8_STAGE(PG8_SA(1, 0), cA + kstep, voffA); PG8_STAGE(PG8_SB(1, 1), cB + hstep + kstep, voffB);
        PG8_WAIT_V(6); PG8_BAR;
    } else {
        PG8_STAGE(PG8_SB(0, 0), cB, voffB); PG8_STAGE(PG8_SA(0, 0), cA, voffA); PG8_STAGE(PG8_SB(0, 1), cB + hstep, voffB); PG8_STAGE(PG8_SA(0, 1), cA + hstep, voffA);
        if (wr == 1) PG8_BAR;
        PG8_WAIT_V(4); PG8_BAR;
        PG8_STAGE(PG8_SB(1, 0), cB + kstep, voffB); PG8_STAGE(PG8_SA(1, 0), cA + kstep, voffA); PG8_STAGE(PG8_SB(1, 1), cB + hstep + kstep, voffB);
        PG8_WAIT_V(6); PG8_BAR;
    }
    for (;;) {
        const bool has_next = S.next(ui + 1, nxt);
        const char* nA = has_next ? (const char*)g.A + (size_t)nxt.pm * tstep + (size_t)nxt.kt0 * kstep : cA; const char* nB = has_next ? (const char*)g.Bt + (size_t)nxt.pn * tstep + (size_t)nxt.kt0 * kstep : cB;
        const int nt = cur.nt;
        for (int t = 0; t < nt; t += 2) {
            const bool last = (t == nt - 2);
            const char* a1 = cA + (size_t)(t + 1) * kstep;
            const char* a2 = last ? nA : cA + (size_t)(t + 2) * kstep; const char* b2 = last ? nB : cB + (size_t)(t + 2) * kstep;
            const char* a3 = a2 + kstep; const char* b3 = b2 + kstep;
            if (last && has_next) S.a_ready(nxt);
            if constexpr (SP2) {
            PG8_LDB(B0, 0, 0); PG8_LDB(B1, 0, 1); PG8_SCHED; PG8_LDA(At, 0, 0); PG8_STAGE(PG8_SA(1, 1), a1 + hstep, voffA);
            PG8_WAIT_V(8); PG8_WAIT_L(0); PG8_BAR; PG8_MMA(0, 0, At, B0); PG8_MMA(0, 1, At, B1); PG8_BAR; PG8_SCHED;
            PG8_LDA(At, 0, 1); PG8_STAGE(PG8_SB(0, 0), b2, voffB); PG8_STAGE(PG8_SB(0, 1), b2 + hstep, voffB); PG8_STAGE(PG8_SA(0, 0), a2, voffA);
            PG8_WAIT_V(8); PG8_WAIT_L(0); PG8_BAR; PG8_MMA(1, 0, At, B0); PG8_MMA(1, 1, At, B1); PG8_BAR; PG8_SCHED;
            PG8_LDB(B0, 1, 0); PG8_LDB(B1, 1, 1); PG8_SCHED; PG8_LDA(At, 1, 0); PG8_STAGE(PG8_SA(0, 1), a2 + hstep, voffA);
            PG8_WAIT_V(8); PG8_WAIT_L(0); PG8_BAR; PG8_MMA(0, 0, At, B0); PG8_MMA(0, 1, At, B1); PG8_BAR; PG8_SCHED;
            PG8_LDA(At, 1, 1); PG8_STAGE(PG8_SB(1, 0), b3, voffB); PG8_STAGE(PG8_SB(1, 1), b3 + hstep, voffB); PG8_STAGE(PG8_SA(1, 0), a3, voffA);
            PG8_WAIT_V(8); PG8_WAIT_L(0); PG8_BAR; PG8_MMA(1, 0, At, B0); PG8_MMA(1, 1, At, B1); PG8_BAR; PG8_SCHED;
            } else {
            PG8_LDB(B0, 0, 0); PG8_SCHED; PG8_LDA(At, 0, 0); PG8_STAGE(PG8_SA(1, 1), a1 + hstep, voffA);
            PG8_WAIT_L(8); PG8_BAR; PG8_WAIT_L(0); PG8_MMA(0, 0, At, B0); PG8_BAR; PG8_SCHED;
            PG8_LDB(B1, 0, 1); PG8_STAGE(PG8_SB(0, 0), b2, voffB);
            PG8_BAR; PG8_WAIT_L(0); PG8_MMA(0, 1, At, B1); PG8_BAR;
            PG8_LDA(At, 0, 1); PG8_STAGE(PG8_SA(0, 0), a2, voffA);
            PG8_BAR; PG8_WAIT_L(0); PG8_MMA(1, 0, At, B0); PG8_BAR; PG8_SCHED;
            PG8_STAGE(PG8_SB(0, 1), b2 + hstep, voffB);
            PG8_WAIT_V(6); PG8_BAR; PG8_MMA(1, 1, At, B1); PG8_BAR;
            PG8_LDB(B0, 1, 0); PG8_SCHED; PG8_LDA(At, 1, 0); PG8_STAGE(PG8_SA(0, 1), a2 + hstep, voffA);
            PG8_WAIT_L(8); PG8_BAR; PG8_WAIT_L(0); PG8_MMA(0, 0, At, B0); PG8_BAR; PG8_SCHED;
            PG8_LDB(B1, 1, 1); PG8_STAGE(PG8_SB(1, 0), b3, voffB);
            PG8_BAR; PG8_WAIT_L(0); PG8_MMA(0, 1, At, B1); PG8_BAR;
            PG8_LDA(At, 1, 1); PG8_STAGE(PG8_SA(1, 0), a3, voffA);
            PG8_BAR; PG8_WAIT_L(0); PG8_MMA(1, 0, At, B0); PG8_BAR; PG8_SCHED;
            PG8_STAGE(PG8_SB(1, 1), b3 + hstep, voffB);
            PG8_WAIT_V(6); PG8_BAR; PG8_MMA(1, 1, At, B1); PG8_BAR;
            }
        }
        if constexpr (ALIGN_EPI) { if (wr == 0) PG8_BAR; }
        if constexpr (!Epi::AFTER_DRAIN) { E(acc, cur, wr, wc, fr, fq); S.done(cur); }
        if (!has_next) break;
#pragma unroll
        for (int a = 0; a < 2; ++a)
#pragma unroll
            for (int b = 0; b < 2; ++b)
#pragma unroll
                for (int m = 0; m < 4; ++m)
#pragma unroll
                    for (int n = 0; n < 2; ++n) acc[a][b][m][n] = (f32x4){0.f, 0.f, 0.f, 0.f};
        cur = nxt; cA = nA; cB = nB; ++ui;
        if constexpr (ALIGN_EPI) { if (wr == 1) PG8_BAR; }
    }
    PG8_WAIT_V(0);
    if constexpr (!ALIGN_EPI) { if (wr == 0) PG8_BAR; }
    PG8_BAR;
    if constexpr (Epi::AFTER_DRAIN) { E.fused(acc, cur, wr, wc, fr, fq, lds, wid, lane); S.done(cur); }
#undef PG8_SA
#undef PG8_SB
#undef PG8_STAGE
#undef PG8_LDA
#undef PG8_LDB
#undef PG8_MMA
#undef PG8_WAIT_V
#undef PG8_WAIT_L
#undef PG8_BAR
#undef PG8_SCHED
}
}

constexpr int NWAVES = 8;
constexpr int D = 1024, FF = 4096, M_CTX = 4096, M_LAT = 16384, M = M_CTX + M_LAT;
constexpr int L_LAT = 2048, L_CTX = 256, PAST = 256, LKV = PAST + L_LAT;
constexpr int MKV = M_CTX + 8 * LKV;
constexpr int EVEN_N = 3104, EVEN_NP = 3328, ODD_N = 576, ODD_NP = 768;
constexpr float EPS = 1e-6f;
constexpr int PC_QA = 0, PC_KA = 256, PC_VA = 512, PC_GA = 1024, PC_QB = 1536, PC_KB = 1792, PC_VB = 2048, PC_GB = 2560, PC_GK = 3072;
constexpr size_t OUT_Y = 0, OUT_CKV = 20971520, OUT_KPE = 23068672, OUT_SGLA = 23592960, OUT_SRET = 25690112;

constexpr size_t MiB = 1u << 20;
constexpr size_t WS_CTL = 0, CTL_ZERO_BYTES = 64 * 1024;
constexpr size_t WS_MOD = 1 * MiB;
constexpr size_t WS_ROPE = 2 * MiB;
constexpr size_t WS_KPE = 3 * MiB;
constexpr size_t WS_ACKV = 6 * MiB;
constexpr size_t WS_WINE = 18 * MiB;
constexpr size_t WS_WOUTE = 31 * MiB;
constexpr size_t WS_WINO = 35 * MiB;
constexpr size_t WS_WQB = 38 * MiB;
constexpr size_t WS_WKVB = 40 * MiB;
constexpr size_t WS_WOUTO = 42 * MiB;
constexpr size_t WS_W1 = 46 * MiB;
constexpr size_t WS_W2 = 78 * MiB;
constexpr size_t WS_HB = 110 * MiB;
constexpr size_t WS_Y = 150 * MiB;
constexpr size_t WS_BIG = 190 * MiB;
constexpr size_t WS_Q = WS_BIG, WS_KV = WS_BIG + 60 * MiB, WS_QN = WS_BIG + 148 * MiB;
constexpr size_t WS_SLAB = 350 * MiB;
constexpr size_t WS_END = 382 * MiB;

constexpr int RING_BYTES = 131072;
constexpr int LDS_MISC = 155648;
constexpr int LDS_BYTES = 163840;

#define GAS __attribute__((address_space(1)))
#define LAS __attribute__((address_space(3)))
typedef unsigned short bf16;
typedef unsigned v4u __attribute__((ext_vector_type(4)));
typedef unsigned v2u __attribute__((ext_vector_type(2)));
typedef float f32x4 __attribute__((ext_vector_type(4)));
typedef float f32x16 __attribute__((ext_vector_type(16)));
typedef short bf16x8 __attribute__((ext_vector_type(8)));
typedef short s16x4 __attribute__((ext_vector_type(4)));
#define LDS_WAIT() asm volatile("s_waitcnt lgkmcnt(0)" ::: "memory")
#define VM_WAIT() asm volatile("s_waitcnt vmcnt(0)" ::: "memory")
typedef float f32x2_t __attribute__((ext_vector_type(2))); typedef __bf16 bf16x2_t __attribute__((ext_vector_type(2)));
__device__ __forceinline__ unsigned pk2(float lo, float hi) { f32x2_t v = {lo, hi}; bf16x2_t b = __builtin_convertvector(v, bf16x2_t); return __builtin_bit_cast(unsigned, b); }
__device__ __forceinline__ unsigned f2bf(float f) { return pk2(f, f) & 0xffffu; }
__device__ __forceinline__ float bflo(unsigned w) { return __builtin_bit_cast(float, w << 16); }
__device__ __forceinline__ float bfhi(unsigned w) { return __builtin_bit_cast(float, w & 0xffff0000u); }
__device__ __forceinline__ float wave_sum(float v) {
#pragma unroll
    for (int o = 1; o < 64; o <<= 1) v += __shfl_xor(v, o);
    return v;
}
__device__ __forceinline__ float siluf(float x) { return x * __builtin_amdgcn_rcpf(1.0f + __expf(-x)); }

#define XB_TMO      128
#define XB_XCNT(j)  (256  + 64 * (j))
#define XB_XSUB(j)  (1280 + 64 * (j))
#define XB_XGEN(j)  (2304 + 64 * (j))
#define XB_TOP      3328
#define XB_TOPGEN   3392
#define XCD_BAR_WORDS 3456
#define XB_SPIN_CAP (1u << 20)
__device__ __forceinline__ unsigned xb_ld(unsigned* p)              { return __hip_atomic_load(p, __ATOMIC_RELAXED, __HIP_MEMORY_SCOPE_AGENT); }
__device__ __forceinline__ unsigned xb_add(unsigned* p, unsigned v) { return __hip_atomic_fetch_add(p, v, __ATOMIC_RELAXED, __HIP_MEMORY_SCOPE_AGENT); }
__device__ __forceinline__ unsigned xb_xcc_id() { return (unsigned)__builtin_amdgcn_s_getreg((3 << 11) | 20) & 0xFu; }
#define XB_SPIN(cond, bar) do { unsigned _sp = 0; while (cond) { __builtin_amdgcn_s_sleep(1); \
    if ((++_sp & 255u) == 0u) { if (xb_ld(&(bar)[XB_TMO])) break; if (_sp > XB_SPIN_CAP) { atomicAdd(&(bar)[XB_TMO], 1u); break; } } } } while (0)
struct XcdBarrier { unsigned* bar; unsigned x; volatile LAS unsigned* st; };
__device__ __forceinline__ XcdBarrier xcd_barrier_post(unsigned* bar, volatile LAS unsigned* st) {
    XcdBarrier b; b.bar = bar; b.x = xb_xcc_id(); b.st = st;
    if (threadIdx.x == 0) (void)xb_add(&bar[XB_XCNT(b.x)], 1u);
    return b;
}
__device__ __forceinline__ void xcd_barrier_complete(unsigned* bar, unsigned x, unsigned& nloc, unsigned& nx) {
    const unsigned G = gridDim.x * gridDim.y * gridDim.z;
    unsigned sum, cnt, mine, sp = 0u;
    for (;;) {
        sum = 0u; cnt = 0u; mine = 0u;
#pragma unroll
        for (unsigned j = 0; j < 16; ++j) { const unsigned c = xb_ld(&bar[XB_XCNT(j)]); sum += c; cnt += (c > 0u) ? 1u : 0u; mine = (j == x) ? c : mine; }
        if (sum == G) break;
        __builtin_amdgcn_s_sleep(1);
        if ((++sp & 255u) == 0u) { if (xb_ld(&bar[XB_TMO])) break; if (sp > XB_SPIN_CAP) { atomicAdd(&bar[XB_TMO], 1u); break; } }
    }
    nloc = mine > 0u ? mine : 1u; nx = cnt > 0u ? cnt : 1u;
}
__device__ __forceinline__ void xcd_barrier(const XcdBarrier& b) {
    asm volatile("s_waitcnt vmcnt(0)" ::: "memory");
    __syncthreads();
    if (threadIdx.x == 0) {
        unsigned* bar = b.bar;
        __builtin_amdgcn_s_waitcnt(0);
        unsigned nloc = b.st[0], nx = b.st[1];
        if (nloc == 0u) { xcd_barrier_complete(bar, b.x, nloc, nx); b.st[0] = nloc; b.st[1] = nx; }
        const unsigned old = xb_add(&bar[XB_XSUB(b.x)], 1u);
        const unsigned gen = old / nloc;
        if (old + 1u == (gen + 1u) * nloc) {
            __builtin_amdgcn_fence(__ATOMIC_RELEASE, "agent");
            asm volatile("s_waitcnt vmcnt(0)" ::: "memory");
            const unsigned og = xb_add(&bar[XB_TOP], 1u);
            const unsigned tg = og / nx;
            if (og + 1u == (tg + 1u) * nx) xb_add(&bar[XB_TOPGEN], 1u);
            else XB_SPIN(xb_ld(&bar[XB_TOPGEN]) == tg, bar);
            __builtin_amdgcn_fence(__ATOMIC_ACQUIRE, "agent");
            xb_add(&bar[XB_XGEN(b.x)], 1u);
            asm volatile("s_waitcnt vmcnt(0)" ::: "memory");
        } else {
            XB_SPIN(xb_ld(&bar[XB_XGEN(b.x)]) == gen, bar);
            __builtin_amdgcn_fence(__ATOMIC_ACQUIRE, "agent");
            asm volatile("s_waitcnt vmcnt(0)" ::: "memory");
        }
    }
    __syncthreads();
}

struct Params { const float* in[28]; float* out; unsigned char* ws; int ph_lo, ph_hi, use_bar, pad; };
enum { I_XP = 0, I_XS, I_CCKV, I_CKPE, I_SGLA, I_SRET, I_C, I_CCTX, I_WADA, I_BADA, I_NMIXPRE, I_NMIXPOST, I_NMLPPRE, I_NMLPPOST,
       I_WINE, I_WGK2, I_BGK2, I_GLAN, I_RDEC, I_WOUTE, I_WINO, I_QAN, I_WQB, I_KVAN, I_WKVB, I_WOUTO, I_W1, I_W2 };
struct Frame { LAS unsigned char* lds; int tid, lane, wave, vcu, G, bid; };
constexpr int LDS_PT = LDS_MISC + 256;
__device__ __forceinline__ const void* ldp(LAS unsigned char* lds, int i) {
    const volatile LAS unsigned* p = (const volatile LAS unsigned*)(lds + LDS_PT) + 2 * i;
    const unsigned lo = __builtin_amdgcn_readfirstlane(p[0]), hi = __builtin_amdgcn_readfirstlane(p[1]);
    return (const void*)(const GAS void*)(((unsigned long long)hi << 32) | lo);
}
#define PIN(i) ((const float*)ldp(F.lds, (i)))
#define POUT ((float*)ldp(F.lds, 28))
#define PWS ((unsigned char*)ldp(F.lds, 29))

__device__ __forceinline__ void p0_transpose_item(const float* W, int K, int N, bf16* WT, int kb, int n0, int dn0, LAS float* scr, int lane) {
    const int k0 = 64 * kb;
#pragma unroll 8
    for (int i = 0; i < 32; ++i) { const int kk = 2 * i + (lane >> 5); scr[kk * 33 + (lane & 31)] = W[(size_t)(k0 + kk) * N + n0 + (lane & 31)]; }
    LDS_WAIT(); asm volatile("" ::: "memory");
    const int c = lane & 7;
#pragma unroll
    for (int j = 0; j < 4; ++j) { const int n = (lane >> 3) + 8 * j; const LAS float* s = scr + (8 * c) * 33 + n;
        v4u o; o.x = pk2(s[0 * 33], s[1 * 33]); o.y = pk2(s[2 * 33], s[3 * 33]); o.z = pk2(s[4 * 33], s[5 * 33]); o.w = pk2(s[6 * 33], s[7 * 33]);
        *(GAS v4u*)(WT + (size_t)(dn0 + n) * K + k0 + 8 * c) = o; }
    LDS_WAIT(); asm volatile("" ::: "memory");
}
__device__ __forceinline__ int even_col_map(int n0) { return n0 < 1536 ? n0 : (n0 < 1568 ? 3072 + (n0 - 1536) : n0 - 32); }

__device__ __forceinline__ void setup_work(Frame& F, const Params& P, int wgi, int nwg, int lmask, int emask, int omask) {
    unsigned char* ws = PWS;
    LAS float* scr = (LAS float*)(F.lds + F.wave * 16384);
    __syncthreads();
    {
        LAS float* S = (LAS float*)(F.lds);
        LAS float* R = (LAS float*)(F.lds + 40960);
        { const float* cp_ = PIN(I_C); const float* cc_ = PIN(I_CCTX);
          for (int i = F.tid; i < 9 * 1024; i += 512) { const int n = i >> 10, d = i & 1023; const float cv = n < 8 ? cp_[n * 1024 + d] : cc_[d]; S[i] = siluf(cv); } }
        const float* wada_ = PIN(I_WADA); const float* bada_ = PIN(I_BADA);
        __syncthreads();
        const int nl = __builtin_popcount(lmask);
        for (int uu = wgi; uu < nl * 64; uu += nwg) {
            int li_ = uu >> 6, l = 0; { int m_ = lmask; for (int k_ = 0; k_ < 4; ++k_) { if (m_ & 1) { if (li_ == 0) { l = k_; break; } --li_; } m_ >>= 1; } }
            const int cb = (uu & 63) * 96;
            if (F.tid < 384) {
                const int c4 = (F.tid % 24) * 4, part = F.tid / 24;
                const float* Wp = wada_ + ((size_t)l * 1024 + part * 64) * 6144 + cb + c4;
                f32x4 a[9];
#pragma unroll
                for (int n = 0; n < 9; ++n) a[n] = (f32x4){0.f, 0.f, 0.f, 0.f};
#pragma unroll 4
                for (int d = 0; d < 64; ++d) { const f32x4 w = *(const f32x4*)(Wp + (size_t)d * 6144);
#pragma unroll
                    for (int n = 0; n < 9; ++n) a[n] += w * S[n * 1024 + part * 64 + d]; }
#pragma unroll
                for (int n = 0; n < 9; ++n) *(LAS f32x4*)(R + (part * 9 + n) * 96 + c4) = a[n];
            }
            __syncthreads();
            for (int i = F.tid; i < 9 * 96; i += 512) { const int n = i / 96, c = i % 96; float s = 0.f;
#pragma unroll
                for (int p = 0; p < 16; ++p) s += R[(p * 9 + n) * 96 + c];
                ((float*)(ws + WS_MOD))[((size_t)l * 9 + n) * 6144 + cb + c] = s + bada_[l * 6144 + cb + c]; }
            __syncthreads();
        }
    }
    {
        const int wk = wgi * NWAVES + F.wave, NW = nwg * NWAVES; int base = 0;
#define SEG(sel, count, ...) do { if (sel) { for (int q = (wk + NW - base % NW) % NW; q < (count); q += NW) { __VA_ARGS__; } base += (count); } } while (0)
        const int I_E = (1024 / 64) * (EVEN_N / 32), I_OE = 16 * 32, I_O = 16 * (ODD_N / 32), I_QB = 4 * 48, I_KVB = 4 * 64, I_M1 = 16 * 128, I_M2 = 64 * 32;
#pragma unroll
        for (int l = 0; l < 2; ++l) {
            SEG((emask >> l) & 1, I_E, { const int nb = EVEN_N / 32, kb = q / nb, n0 = (q % nb) * 32;
                p0_transpose_item(PIN(I_WINE) + (size_t)l * 1024 * EVEN_N, 1024, EVEN_N, (bf16*)(ws + WS_WINE) + (size_t)l * EVEN_NP * 1024, kb, n0, even_col_map(n0), scr, F.lane); });
            SEG((emask >> l) & 1, I_OE, { const int kb = q / 32, n0 = (q % 32) * 32;
                p0_transpose_item(PIN(I_WOUTE) + (size_t)l * 1024 * 1024, 1024, 1024, (bf16*)(ws + WS_WOUTE) + (size_t)l * 1024 * 1024, kb, n0, n0, scr, F.lane); });
            SEG((omask >> l) & 1, I_O, { const int nb = ODD_N / 32, kb = q / nb, n0 = (q % nb) * 32;
                p0_transpose_item(PIN(I_WINO) + (size_t)l * 1024 * ODD_N, 1024, ODD_N, (bf16*)(ws + WS_WINO) + (size_t)l * ODD_NP * 1024, kb, n0, n0, scr, F.lane); });
            SEG((omask >> l) & 1, I_QB, { const int kb = q / 48, n0 = (q % 48) * 32;
                p0_transpose_item(PIN(I_WQB) + (size_t)l * 256 * 1536, 256, 1536, (bf16*)(ws + WS_WQB) + (size_t)l * 1536 * 256, kb, n0, n0, scr, F.lane); });
            SEG((omask >> l) & 1, I_KVB, { const int kb = q / 64, n0 = (q % 64) * 32;
                p0_transpose_item(PIN(I_WKVB) + (size_t)l * 256 * 2048, 256, 2048, (bf16*)(ws + WS_WKVB) + (size_t)l * 2048 * 256, kb, n0, n0, scr, F.lane); });
            SEG((omask >> l) & 1, I_OE, { const int kb = q / 32, n0 = (q % 32) * 32;
                p0_transpose_item(PIN(I_WOUTO) + (size_t)l * 1024 * 1024, 1024, 1024, (bf16*)(ws + WS_WOUTO) + (size_t)l * 1024 * 1024, kb, n0, n0, scr, F.lane); });
        }
#pragma unroll
        for (int l = 0; l < 4; ++l) {
            SEG((lmask >> l) & 1, I_M1, { const int kb = q / 128, n0 = (q % 128) * 32;
                p0_transpose_item(PIN(I_W1) + (size_t)l * 1024 * 4096, 1024, 4096, (bf16*)(ws + WS_W1) + (size_t)l * 4096 * 1024, kb, n0, n0, scr, F.lane); });
            SEG((lmask >> l) & 1, I_M2, { const int kb = q / 32, n0 = (q % 32) * 32;
                p0_transpose_item(PIN(I_W2) + (size_t)l * 4096 * 1024, 4096, 1024, (bf16*)(ws + WS_W2) + (size_t)l * 1024 * 4096, kb, n0, n0, scr, F.lane); });
        }
#undef SEG
    }
    const int gt = wgi * 512 + F.tid, NGT = nwg * 512;
#pragma unroll
    for (int l = 0; l < 2; ++l) {
        if ((emask >> l) & 1) for (int i = gt; i < 224 * 128; i += NGT) *(GAS v4u*)((bf16*)(ws + WS_WINE) + ((size_t)l * EVEN_NP + EVEN_N) * 1024 + (size_t)i * 8) = (v4u){0u, 0u, 0u, 0u};
        if ((omask >> l) & 1) for (int i = gt; i < 192 * 128; i += NGT) *(GAS v4u*)((bf16*)(ws + WS_WINO) + ((size_t)l * ODD_NP + ODD_N) * 1024 + (size_t)i * 8) = (v4u){0u, 0u, 0u, 0u};
    }
}
__device__ __forceinline__ void p0_prologue(Frame& F, const Params& P) {
    unsigned char* ws = PWS;
    setup_work(F, P, F.vcu, F.G, 0x5, 0x3, 0x0);
    const int gt = F.vcu * 512 + F.tid, NGT = F.G * 512;
    for (int i = gt; i < 2048 * 32; i += NGT) { const int t = i >> 5, j = i & 31; const float inv = powf(10000.0f, -(float)(j & 15) / 16.0f);
        const float ang = (float)(j < 16 ? (t >> 6) : (t & 63)) * inv;
        ((float*)(ws + WS_ROPE))[i] = cosf(ang); ((float*)(ws + WS_ROPE))[65536 + i] = sinf(ang); }
}

__device__ __forceinline__ void row_y(f32x4 (&yv)[4], const bf16* Y, const bf16* SL, int row, int l4) {
    if (row < 16384) {
#pragma unroll
        for (int j = 0; j < 4; ++j) { const v2u yw = *(const v2u*)(Y + (size_t)row * D + l4 + 256 * j); yv[j] = (f32x4){bflo(yw.x), bfhi(yw.x), bflo(yw.y), bfhi(yw.y)}; }
    } else {
        const bf16* sp = SL + (size_t)(row - 16384) * D + l4;
#pragma unroll
        for (int j = 0; j < 4; ++j) { const v2u w0 = *(const v2u*)(sp + 256 * j), w1 = *(const v2u*)(sp + 4194304 + 256 * j), w2 = *(const v2u*)(sp + 2 * 4194304 + 256 * j), w3 = *(const v2u*)(sp + 3 * 4194304 + 256 * j);
            yv[j] = ((f32x4){bflo(w0.x), bfhi(w0.x), bflo(w0.y), bfhi(w0.y)} + (f32x4){bflo(w1.x), bfhi(w1.x), bflo(w1.y), bfhi(w1.y)}) +
                    ((f32x4){bflo(w2.x), bfhi(w2.x), bflo(w2.y), bfhi(w2.y)} + (f32x4){bflo(w3.x), bfhi(w3.x), bflo(w3.y), bfhi(w3.y)}); }
    }
}
__device__ __forceinline__ void row_post(f32x4 (&v)[4], const f32x4 (&yv)[4], const float* g_post, const float* gate, int n, int l4) {
    float s = 0.f;
#pragma unroll
    for (int j = 0; j < 4; ++j) s += (yv[j][0] * yv[j][0] + yv[j][1] * yv[j][1]) + (yv[j][2] * yv[j][2] + yv[j][3] * yv[j][3]);
    const float rstd = __builtin_amdgcn_rsqf(wave_sum(s) * (1.0f / 1024.0f) + EPS);
#pragma unroll
    for (int j = 0; j < 4; ++j) { const int c = l4 + 256 * j;
        const f32x4 gp = *(const f32x4*)(g_post + c), gt = *(const f32x4*)(gate + (size_t)n * 6144 + c);
        v[j] = v[j] + gt * ((yv[j] * rstd) * gp); }
}
__device__ __forceinline__ void row_pass(Frame& F, const float* xa, const float* xb, bool xin_f32, bf16* XB, const bf16* Y, const bf16* SL, const float* g_post, const float* gate,
                                         const float* g_pre, const float* scale, const float* shift, bf16* H, bool has_post, bool has_pre) {
    const int gw = F.vcu * NWAVES + F.wave, NGW = F.G * NWAVES, l4 = F.lane * 4;
    for (int row = gw; row < M; row += NGW) {
        const int n = row < M_CTX ? 8 : ((row - M_CTX) >> 11);
        f32x4 v[4];
        if (xin_f32) { const float* xr = row < M_CTX ? xa + (size_t)row * D : xb + (size_t)(row - M_CTX) * D;
#pragma unroll
            for (int j = 0; j < 4; ++j) v[j] = *(const f32x4*)(xr + l4 + 256 * j);
        } else {
#pragma unroll
            for (int j = 0; j < 4; ++j) { const v2u xw = *(const v2u*)(XB + (size_t)row * D + l4 + 256 * j); v[j] = (f32x4){bflo(xw.x), bfhi(xw.x), bflo(xw.y), bfhi(xw.y)}; }
        }
        if (has_post) {
            f32x4 yv[4]; row_y(yv, Y, SL, row, l4); row_post(v, yv, g_post, gate, n, l4);
#pragma unroll
            for (int j = 0; j < 4; ++j) *(v2u*)(XB + (size_t)row * D + l4 + 256 * j) = (v2u){pk2(v[j][0], v[j][1]), pk2(v[j][2], v[j][3])};
        }
        if (has_pre) {
            float s = 0.f;
#pragma unroll
            for (int j = 0; j < 4; ++j) s += (v[j][0] * v[j][0] + v[j][1] * v[j][1]) + (v[j][2] * v[j][2] + v[j][3] * v[j][3]);
            const float rstd = __builtin_amdgcn_rsqf(wave_sum(s) * (1.0f / 1024.0f) + EPS);
#pragma unroll
            for (int j = 0; j < 4; ++j) { const int c = l4 + 256 * j;
                const f32x4 gp = *(const f32x4*)(g_post == nullptr ? g_pre + c : g_pre + c), sc = *(const f32x4*)(scale + (size_t)n * 6144 + c), sh = *(const f32x4*)(shift + (size_t)n * 6144 + c);
                const f32x4 h = ((v[j] * rstd) * gp) * (1.0f + sc) + sh;
                *(v2u*)(H + (size_t)row * D + c) = (v2u){pk2(h[0], h[1]), pk2(h[2], h[3])}; }
        }
    }
}
__device__ __forceinline__ void row_pass_final(Frame& F, const XcdBarrier& bar, const bf16* XB, float* OUT, const bf16* Y, const bf16* SL, const float* g_post, const float* gate) {
    const int gw = F.vcu * NWAVES + F.wave, NGW = F.G * NWAVES, l4 = F.lane * 4;
    v2u xw[10][4];
#pragma unroll
    for (int i = 0; i < 10; ++i) { const int row = gw + i * NGW;
        if (row < M) {
#pragma unroll
            for (int j = 0; j < 4; ++j) xw[i][j] = *(const v2u*)(XB + (size_t)row * D + l4 + 256 * j);
        } }
    xcd_barrier(bar);
#pragma unroll
    for (int i = 0; i < 10; ++i) { const int row = gw + i * NGW;
        if (row < M) {
            const int n = row < M_CTX ? 8 : ((row - M_CTX) >> 11);
            f32x4 v[4], yv[4];
#pragma unroll
            for (int j = 0; j < 4; ++j) v[j] = (f32x4){bflo(xw[i][j].x), bfhi(xw[i][j].x), bflo(xw[i][j].y), bfhi(xw[i][j].y)};
            row_y(yv, Y, SL, row, l4); row_post(v, yv, g_post, gate, n, l4);
#pragma unroll
            for (int j = 0; j < 4; ++j) *(f32x4*)(OUT + (size_t)row * D + l4 + 256 * j) = v[j];
        } }
}

__device__ __forceinline__ int crow(int r, int hi) { return (r & 3) + 8 * (r >> 2) + 4 * hi; }
__device__ __forceinline__ unsigned cvtpk(float lo, float hi) { return pk2(lo, hi); }
#define SBAR() __builtin_amdgcn_sched_barrier(0)
__device__ __forceinline__ int vst_row(int k, int NB) { const int kk = (k & ~0xC) | ((k & 4) << 1) | ((k & 8) >> 1); return (kk >> 3) * NB * 512 + (kk & 7) * 64; }
__device__ __forceinline__ int vst(int k, int c, int NB) { return vst_row(k, NB) + (c >> 5) * 512 + (c & 31) * 2; }
__device__ __forceinline__ int v_rd_base(int lane) { return ((lane & 3) << 3) | (((lane >> 2) & 3) << 6) | (((lane >> 4) & 1) << 5) | (((lane >> 5) & 1) << 8); }
template <int OFF> __device__ __forceinline__ s16x4 tr_read(unsigned vb) { s16x4 r; asm volatile("ds_read_b64_tr_b16 %0, %1 offset:%2" : "=&v"(r) : "v"(vb), "i"(OFF) : "memory"); return r; }
#define PKF(L, H) ((bf16x8){L[0], L[1], L[2], L[3], H[0], H[1], H[2], H[3]})
#define PK4(P, BASE, OUT) do { unsigned a0_ = cvtpk(P[BASE + 0], P[BASE + 1]), a1_ = cvtpk(P[BASE + 2], P[BASE + 3]);   \
    unsigned b0_ = cvtpk(P[BASE + 4], P[BASE + 5]), b1_ = cvtpk(P[BASE + 6], P[BASE + 7]);                              \
    auto r0_ = __builtin_amdgcn_permlane32_swap(a0_, b0_, false, false); auto r1_ = __builtin_amdgcn_permlane32_swap(a1_, b1_, false, false); \
    v4u w_ = {r0_[0], r1_[0], r0_[1], r1_[1]}; OUT = __builtin_bit_cast(bf16x8, w_); } while (0)
__device__ __forceinline__ float fexp(float x) { return __builtin_amdgcn_exp2f(x * 1.4426950408889634f); }
__device__ __forceinline__ float logsig(float x) { return fminf(x, 0.f) - 0.6931471805599453f * __builtin_amdgcn_logf(1.0f + __builtin_amdgcn_exp2f(-1.4426950408889634f * fabsf(x))); }

constexpr int SC_QD = 0, SC_KI = 8192, SC_VT = 16384, SC_ST = 32768, SC_BT = 49152, SC_GK = 65536, SC_TOT = 69632, SC_DL = 71680, SC_W2 = 71936;
__device__ __forceinline__ void scan_phase(Frame& F, const Params& P, int li) {
    unsigned char* ws = PWS;
    const bf16* PROJ = (const bf16*)(ws + WS_BIG);
    const float* ROPE = (const float*)(ws + WS_ROPE);
    LAS unsigned char* G = F.lds;
    const unsigned gaddr = (unsigned)(uintptr_t)G;
    const int ri = F.wave >> 2, dq = F.wave & 3;
    for (int u0 = F.bid; u0 < 256; u0 += F.G) for (int kk_ = 0; kk_ < (u0 < 128 ? 1 : 2); ++kk_) {
        __syncthreads();
        const bool lat = u0 < 128; const int u = lat ? u0 : 2 * (u0 - 128) + kk_;
        const int sb = u >> 4, hh = (u >> 1) & 7, dir = u & 1;
        const int L = lat ? L_LAT : L_CTX, row0 = lat ? M_CTX + sb * L_LAT : sb * L_CTX, NC = L / 64;
        const bool gla = hh < 4; const int h = hh & 3;
        const int qc = (gla ? PC_QA : PC_QB) + h * 64, kc = (gla ? PC_KA : PC_KB) + h * 64, vc = (gla ? PC_VA : PC_VB) + h * 128, gkc = PC_GK + dir * 16;
        bf16* OUT = (bf16*)(ws + (dir == 0 ? WS_Y : WS_HB));
        const float* rdec_p = PIN(I_RDEC); const float* wgk2_p = PIN(I_WGK2); const float* bgk2_p = PIN(I_BGK2);
        const float lgr = gla ? 0.f : -fexp(rdec_p[(li * 2 + dir) * 4 + h]);
        f32x16 sacc; v4u w2f = {0u, 0u, 0u, 0u}; float gbias = 0.f;
        { int t0_ = F.tid; asm volatile("" : "+v"(t0_)); const int lane = t0_ & 63, r32 = lane & 31, hi = lane >> 5;
          if (gla && F.wave < 4) { const int kcol = h * 64 + 32 * (F.wave & 1) + r32; const float* wp_ = wgk2_p + ((size_t)(li * 2 + dir) * 16 + 8 * hi) * 256 + kcol;
              w2f = (v4u){pk2(wp_[0], wp_[256]), pk2(wp_[512], wp_[768]), pk2(wp_[1024], wp_[1280]), pk2(wp_[1536], wp_[1792])};
              gbias = bgk2_p[(li * 2 + dir) * 256 + kcol]; }
          if (!gla && t0_ < 64) ((LAS float*)(G + SC_DL))[t0_] = fexp(64.0f * lgr);
          const float* S0 = (gla ? PIN(I_SGLA) : PIN(I_SRET)) + ((size_t)((sb * 2 + li) * 2 + dir) * 4 + h) * 8192;
          if (lat) {
#pragma unroll
              for (int r = 0; r < 16; ++r) sacc[r] = S0[(32 * ri + crow(r, hi)) * 128 + 32 * dq + r32];
          } else sacc = f32x16{};
#pragma unroll
          for (int r = 0; r < 16; r += 2) { const unsigned w = pk2(sacc[r], sacc[r + 1]);
              LAS unsigned char* sp_ = G + SC_ST + (hi + 4 * ri) * 2048 + dq * 512 + r32 * 2 + ((r >> 3) & 1) * 4096 + ((r & 3) + 4 * ((r >> 2) & 1)) * 64;
              *(LAS unsigned short*)sp_ = (unsigned short)w; *(LAS unsigned short*)(sp_ + 64) = (unsigned short)(w >> 16); } }
        v2u pq0, pq1, pk0, pk1; v4u pv0, pv1; v4u pga = {0u, 0u, 0u, 0u};
#define SC_TOK(s, i) (dir == 0 ? 64 * (s) + (i) : L - 1 - (64 * (s) + (i)))
#define SC_LOAD(s) do { const unsigned ro_ = (unsigned)(row0 + SC_TOK(s, sti)) * (unsigned)(EVEN_NP * 2); const char* pc_ = (const char*)PROJ; \
        pq0 = *(const v2u*)(pc_ + (ro_ + (unsigned)(qc + 4 * c4) * 2u)); pq1 = *(const v2u*)(pc_ + (ro_ + (unsigned)(qc + 32 + 4 * c4) * 2u)); \
        pk0 = *(const v2u*)(pc_ + (ro_ + (unsigned)(kc + 4 * c4) * 2u)); pk1 = *(const v2u*)(pc_ + (ro_ + (unsigned)(kc + 32 + 4 * c4) * 2u)); \
        pv0 = *(const v4u*)(pc_ + (ro_ + (unsigned)(vc + 16 * c4) * 2u)); pv1 = *(const v4u*)(pc_ + (ro_ + (unsigned)(vc + 16 * c4 + 8) * 2u)); \
        if (gla && F.wave < 4) pga = *(const v4u*)(pc_ + ((unsigned)(row0 + SC_TOK(s, 32 * (F.wave >> 1) + (lane & 31))) * (unsigned)(EVEN_NP * 2) + (unsigned)(gkc + 8 * (lane >> 5)) * 2u)); } while (0)
        { int t0_ = F.tid; asm volatile("" : "+v"(t0_)); const int sti = t0_ >> 3, c4 = t0_ & 7, lane = t0_ & 63; SC_LOAD(0); }
        for (int s = 0; s < NC; ++s) {
            int tid_o = F.tid; asm volatile("" : "+v"(tid_o));
            const int lane = tid_o & 63, r32 = lane & 31, hi = lane >> 5, sti = tid_o >> 3, c4 = tid_o & 7;
            const int tok = SC_TOK(s, sti);
            if (gla) {
                __syncthreads();
                float cs[16]; float tsum = 0.f; const int th = F.wave >> 1, kq = 32 * (F.wave & 1) + r32;
                if (F.wave < 4) {
                    f32x16 gp;
#pragma unroll
                    for (int r = 0; r < 16; ++r) gp[r] = gbias;
                    gp = __builtin_amdgcn_mfma_f32_32x32x16_bf16(__builtin_bit_cast(bf16x8, pga), __builtin_bit_cast(bf16x8, w2f), gp, 0, 0, 0);
                    float g4[4], o4[4];
#pragma unroll
                    for (int j = 0; j < 4; ++j) { float run = 0.f;
#pragma unroll
                        for (int e = 0; e < 4; ++e) { run += logsig(gp[4 * j + e]) * (1.0f / 16.0f); cs[4 * j + e] = run; }
                        g4[j] = run; }
#pragma unroll
                    for (int j = 0; j < 4; ++j) o4[j] = __shfl_xor(g4[j], 32);
                    float acc_ = 0.f;
#pragma unroll
                    for (int j = 0; j < 4; ++j) { const float off = acc_ + (hi ? o4[j] : 0.f);
#pragma unroll
                        for (int e = 0; e < 4; ++e) cs[4 * j + e] += off;
                        acc_ += g4[j] + o4[j]; }
                    tsum = acc_;
                    if (hi == 0) ((LAS float*)(G + SC_TOT))[th * 64 + kq] = tsum;
                }
                LDS_WAIT(); __syncthreads();
                if (F.wave < 4) {
                    const float t0v = ((LAS float*)(G + SC_TOT))[kq]; const float pre = th ? t0v : 0.f;
#pragma unroll
                    for (int r = 0; r < 16; ++r) ((LAS float*)(G + SC_BT))[(32 * th + crow(r, hi)) * 64 + kq] = pre + cs[r];
                    if (th == 1 && hi == 0) ((LAS float*)(G + SC_DL))[kq] = fexp(pre + tsum);
                }
                LDS_WAIT(); __syncthreads();
            } else { __syncthreads(); }
            {
                float q[8], kk[8];
                q[0] = bflo(pq0.x); q[1] = bfhi(pq0.x); q[2] = bflo(pq0.y); q[3] = bfhi(pq0.y); q[4] = bflo(pq1.x); q[5] = bfhi(pq1.x); q[6] = bflo(pq1.y); q[7] = bfhi(pq1.y);
                kk[0] = bflo(pk0.x); kk[1] = bfhi(pk0.x); kk[2] = bflo(pk0.y); kk[3] = bfhi(pk0.y); kk[4] = bflo(pk1.x); kk[5] = bfhi(pk1.x); kk[6] = bflo(pk1.y); kk[7] = bfhi(pk1.y);
                if (gla) {
                    const f32x4 x0 = *(const LAS f32x4*)((LAS float*)(G + SC_BT) + sti * 64 + 4 * c4), x1 = *(const LAS f32x4*)((LAS float*)(G + SC_BT) + sti * 64 + 32 + 4 * c4);
#pragma unroll
                    for (int e = 0; e < 4; ++e) { const float e0 = fexp(x0[e]), e1 = fexp(x1[e]);
                        q[e] *= 0.125f * e0; kk[e] *= __builtin_amdgcn_rcpf(e0); q[4 + e] *= 0.125f * e1; kk[4 + e] *= __builtin_amdgcn_rcpf(e1); }
                } else {
                    if (lat) {
                        const float* cp = ROPE + (size_t)tok * 32 + 4 * c4; const f32x4 cv = *(const f32x4*)cp, sv = *(const f32x4*)(cp + 65536);
#pragma unroll
                        for (int e = 0; e < 4; ++e) { const float c = cv[e], sn = sv[e];
                            const float q1 = q[e], q2 = q[4 + e]; q[e] = q1 * c - q2 * sn; q[4 + e] = q1 * sn + q2 * c;
                            const float k1 = kk[e], k2 = kk[4 + e]; kk[e] = k1 * c - k2 * sn; kk[4 + e] = k1 * sn + k2 * c; }
                    }
                    const float bb = (float)(sti + 1) * lgr, eb = fexp(bb), ek = 0.125f * __builtin_amdgcn_rcpf(eb);
#pragma unroll
                    for (int e = 0; e < 8; ++e) { q[e] *= eb; kk[e] *= ek; }
                }
                *(LAS v2u*)(G + SC_QD + vst(sti, 4 * c4, 2)) = (v2u){pk2(q[0], q[1]), pk2(q[2], q[3])};
                *(LAS v2u*)(G + SC_QD + vst(sti, 32 + 4 * c4, 2)) = (v2u){pk2(q[4], q[5]), pk2(q[6], q[7])};
                *(LAS v2u*)(G + SC_KI + vst(sti, 4 * c4, 2)) = (v2u){pk2(kk[0], kk[1]), pk2(kk[2], kk[3])};
                *(LAS v2u*)(G + SC_KI + vst(sti, 32 + 4 * c4, 2)) = (v2u){pk2(kk[4], kk[5]), pk2(kk[6], kk[7])};
                *(LAS v4u*)(G + SC_VT + vst(sti, 16 * c4, 4)) = pv0; *(LAS v4u*)(G + SC_VT + vst(sti, 16 * c4 + 8, 4)) = pv1;
            }
            LDS_WAIT(); __syncthreads();
            if (s + 1 < NC) SC_LOAD(s + 1);
            bf16x8 qf[4]; bf16x8 pa0, pa1, pa2, pa3;
            { const int qb_ = vst_row(32 * ri + r32, 2) + 16 * hi;
              qf[0] = *(const LAS bf16x8*)(G + SC_QD + qb_); qf[1] = *(const LAS bf16x8*)(G + SC_QD + qb_ + 32); qf[2] = *(const LAS bf16x8*)(G + SC_QD + qb_ + 512); qf[3] = *(const LAS bf16x8*)(G + SC_QD + qb_ + 544); }
            { f32x16 p0 = {}, p1 = {};
              const int kb0 = vst_row(r32, 2) + 16 * hi, kb1 = vst_row(32 + r32, 2) + 16 * hi;
              { const bf16x8 a0 = *(const LAS bf16x8*)(G + SC_KI + kb0), a1 = *(const LAS bf16x8*)(G + SC_KI + kb0 + 32), a2 = *(const LAS bf16x8*)(G + SC_KI + kb0 + 512), a3 = *(const LAS bf16x8*)(G + SC_KI + kb0 + 544);
                p0 = __builtin_amdgcn_mfma_f32_32x32x16_bf16(a0, qf[0], p0, 0, 0, 0); p0 = __builtin_amdgcn_mfma_f32_32x32x16_bf16(a1, qf[1], p0, 0, 0, 0);
                p0 = __builtin_amdgcn_mfma_f32_32x32x16_bf16(a2, qf[2], p0, 0, 0, 0); p0 = __builtin_amdgcn_mfma_f32_32x32x16_bf16(a3, qf[3], p0, 0, 0, 0); }
              if (ri == 1) {
                  const bf16x8 c0 = *(const LAS bf16x8*)(G + SC_KI + kb1), c1 = *(const LAS bf16x8*)(G + SC_KI + kb1 + 32), c2 = *(const LAS bf16x8*)(G + SC_KI + kb1 + 512), c3 = *(const LAS bf16x8*)(G + SC_KI + kb1 + 544);
                  p1 = __builtin_amdgcn_mfma_f32_32x32x16_bf16(c0, qf[0], p1, 0, 0, 0); p1 = __builtin_amdgcn_mfma_f32_32x32x16_bf16(c1, qf[1], p1, 0, 0, 0);
                  p1 = __builtin_amdgcn_mfma_f32_32x32x16_bf16(c2, qf[2], p1, 0, 0, 0); p1 = __builtin_amdgcn_mfma_f32_32x32x16_bf16(c3, qf[3], p1, 0, 0, 0); }
#pragma unroll
              for (int r = 0; r < 16; ++r) { const bool keep = crow(r, hi) <= r32; if (ri == 0) { p0[r] = keep ? p0[r] : 0.f; } else { p1[r] = keep ? p1[r] : 0.f; } }
              PK4(p0, 0, pa0); PK4(p0, 8, pa1); PK4(p1, 0, pa2); PK4(p1, 8, pa3); }
            const unsigned vb = gaddr + SC_VT + v_rd_base(lane) + dq * 512, sbv = gaddr + SC_ST + v_rd_base(lane) + dq * 512;
#define SC_FR4(dst, base) do { const s16x4 l0_ = tr_read<0>(base), h0_ = tr_read<2048>(base), l1_ = tr_read<4096>(base), h1_ = tr_read<4096 + 2048>(base); \
              const s16x4 l2_ = tr_read<8192>(base), h2_ = tr_read<8192 + 2048>(base), l3_ = tr_read<12288>(base), h3_ = tr_read<12288 + 2048>(base); \
              asm volatile("s_waitcnt lgkmcnt(0)" ::: "memory"); SBAR(); \
              dst[0] = PKF(l0_, h0_); dst[1] = PKF(l1_, h1_); dst[2] = PKF(l2_, h2_); dst[3] = PKF(l3_, h3_); } while (0)
            bf16x8 vf_[4];
            { bf16x8 sf_[4]; SC_FR4(vf_, vb); SC_FR4(sf_, sbv); f32x16 o_ = {};
              o_ = __builtin_amdgcn_mfma_f32_32x32x16_bf16(pa0, vf_[0], o_, 0, 0, 0); o_ = __builtin_amdgcn_mfma_f32_32x32x16_bf16(pa1, vf_[1], o_, 0, 0, 0);
              if (ri == 1) { o_ = __builtin_amdgcn_mfma_f32_32x32x16_bf16(pa2, vf_[2], o_, 0, 0, 0); o_ = __builtin_amdgcn_mfma_f32_32x32x16_bf16(pa3, vf_[3], o_, 0, 0, 0); }
              o_ = __builtin_amdgcn_mfma_f32_32x32x16_bf16(qf[0], sf_[0], o_, 0, 0, 0); o_ = __builtin_amdgcn_mfma_f32_32x32x16_bf16(qf[1], sf_[1], o_, 0, 0, 0);
              o_ = __builtin_amdgcn_mfma_f32_32x32x16_bf16(qf[2], sf_[2], o_, 0, 0, 0); o_ = __builtin_amdgcn_mfma_f32_32x32x16_bf16(qf[3], sf_[3], o_, 0, 0, 0);
              char* dst_ = (char*)OUT;
#pragma unroll
              for (int r = 0; r < 16; r += 2) { const int i_ = 32 * ri + crow(r, hi); const int t_ = SC_TOK(s, i_); const unsigned w_ = pk2(o_[r], o_[r + 1]);
                  const unsigned a_ = (unsigned)(row0 + t_) * (unsigned)(D * 2) + (unsigned)(hh * 128 + 32 * dq + r32) * 2u;
                  *(bf16*)(dst_ + a_) = (bf16)w_; *(bf16*)(dst_ + (dir == 0 ? a_ + (unsigned)(D * 2) : a_ - (unsigned)(D * 2))) = (bf16)(w_ >> 16); } }
            __syncthreads();
            { const unsigned kt = gaddr + SC_KI + v_rd_base(lane) + ri * 512;
              bf16x8 kf[4];
              { const s16x4 l0_ = tr_read<0>(kt), h0_ = tr_read<1024>(kt), l1_ = tr_read<2048>(kt), h1_ = tr_read<2048 + 1024>(kt), l2_ = tr_read<4096>(kt), h2_ = tr_read<4096 + 1024>(kt), l3_ = tr_read<6144>(kt), h3_ = tr_read<6144 + 1024>(kt);
                asm volatile("s_waitcnt lgkmcnt(0)" ::: "memory"); SBAR();
                kf[0] = PKF(l0_, h0_); kf[1] = PKF(l1_, h1_); kf[2] = PKF(l2_, h2_); kf[3] = PKF(l3_, h3_); }
#pragma unroll
              for (int ks = 0; ks < 4; ++ks) sacc = __builtin_amdgcn_mfma_f32_32x32x16_bf16(kf[ks], vf_[ks], sacc, 0, 0, 0);
              const int stb_ = (hi + 4 * ri) * 2048 + dq * 512 + r32 * 2;
#pragma unroll
              for (int r = 0; r < 16; r += 2) { const int dk = 32 * ri + crow(r, hi); const float dl0 = ((LAS float*)(G + SC_DL))[dk], dl1 = ((LAS float*)(G + SC_DL))[dk + 1];
                  sacc[r] *= dl0; sacc[r + 1] *= dl1; const unsigned w_ = pk2(sacc[r], sacc[r + 1]);
                  LAS unsigned char* sp_ = G + SC_ST + stb_ + ((r >> 3) & 1) * 4096 + ((r & 3) + 4 * ((r >> 2) & 1)) * 64;
                  *(LAS unsigned short*)sp_ = (unsigned short)w_; *(LAS unsigned short*)(sp_ + 64) = (unsigned short)(w_ >> 16); } }
        }
        if (!lat) { int l2 = F.lane; asm volatile("" : "+v"(l2)); const int r32 = l2 & 31, hi = l2 >> 5; float* SO = POUT + (gla ? OUT_SGLA : OUT_SRET) + ((size_t)((sb * 2 + li) * 2 + dir) * 4 + h) * 8192;
#pragma unroll
            for (int r = 0; r < 16; ++r) SO[(32 * ri + crow(r, hi)) * 128 + 32 * dq + r32] = sacc[r]; }
    }
#undef SC_TOK
#undef SC_LOAD
#undef SC_FR4
    if (F.G == 256 && F.bid >= 128) { if (li == 0) setup_work(F, P, F.bid - 128, 128, 0x2, 0x0, 0x1); else setup_work(F, P, F.bid - 128, 128, 0x8, 0x0, 0x2); }
    else if (F.G != 256) { if (li == 0) setup_work(F, P, F.bid, F.G, 0x2, 0x0, 0x1); else setup_work(F, P, F.bid, F.G, 0x8, 0x0, 0x2); }
}
__device__ __forceinline__ void scan_combine(Frame& F, const Params& P, int li) {
    unsigned char* ws = PWS;
    const char* PROJ = (const char*)(ws + WS_BIG); const char* OF = (const char*)(ws + WS_Y); char* OB = (char*)(ws + WS_HB);
    const int gw = F.vcu * NWAVES + F.wave, NGW = F.G * NWAVES, lane = F.lane, hh = lane >> 3, dv = (lane & 7) * 16;
    f32x4 gn[4];
    { const float* gp_ = PIN(I_GLAN) + li * 128 + dv;
#pragma unroll
      for (int j = 0; j < 4; ++j) gn[j] = hh < 4 ? *(const f32x4*)(gp_ + 4 * j) : (f32x4){1.f, 1.f, 1.f, 1.f}; }
    const unsigned gcol = (unsigned)((hh < 4 ? PC_GA : PC_GB) + (hh & 3) * 128 + dv) * 2u, ocol = (unsigned)(hh * 128 + dv) * 2u;
    for (int row = gw; row < M; row += 2 * NGW) {
        v4u a[2][2], b[2][2], g[2][2];
#pragma unroll
        for (int i = 0; i < 2; ++i) { const int r_ = row + i * NGW; if (r_ < M) {
            const unsigned off = (unsigned)r_ * (unsigned)(D * 2) + ocol, goff = (unsigned)r_ * (unsigned)(EVEN_NP * 2) + gcol;
            a[i][0] = *(const v4u*)(OF + off); a[i][1] = *(const v4u*)(OF + off + 16); b[i][0] = *(const v4u*)(OB + off); b[i][1] = *(const v4u*)(OB + off + 16);
            g[i][0] = *(const v4u*)(PROJ + goff); g[i][1] = *(const v4u*)(PROJ + goff + 16); } }
#pragma unroll
        for (int i = 0; i < 2; ++i) { const int r_ = row + i * NGW; if (r_ < M) {
            const unsigned off = (unsigned)r_ * (unsigned)(D * 2) + ocol;
            float x[16], gg[16];
#pragma unroll
            for (int hf = 0; hf < 2; ++hf)
#pragma unroll
                for (int e = 0; e < 4; ++e) { x[8 * hf + 2 * e] = bflo(a[i][hf][e]) + bflo(b[i][hf][e]); x[8 * hf + 2 * e + 1] = bfhi(a[i][hf][e]) + bfhi(b[i][hf][e]);
                    gg[8 * hf + 2 * e] = bflo(g[i][hf][e]); gg[8 * hf + 2 * e + 1] = bfhi(g[i][hf][e]); }
            float ss = 0.f;
#pragma unroll
            for (int e = 0; e < 16; ++e) ss += x[e] * x[e];
            ss += __shfl_xor(ss, 1); ss += __shfl_xor(ss, 2); ss += __shfl_xor(ss, 4);
            const float rstd = __builtin_amdgcn_rsqf(ss * (1.0f / 128.0f) + EPS);
#pragma unroll
            for (int e = 0; e < 16; ++e) x[e] = x[e] * rstd * gn[e >> 2][e & 3] * siluf(gg[e]);
            *(v4u*)(OB + off) = (v4u){pk2(x[0], x[1]), pk2(x[2], x[3]), pk2(x[4], x[5]), pk2(x[6], x[7])};
            *(v4u*)(OB + off + 16) = (v4u){pk2(x[8], x[9]), pk2(x[10], x[11]), pk2(x[12], x[13]), pk2(x[14], x[15])}; } }
    }
}

__device__ __forceinline__ void cache_pass(Frame& F, const Params& P, int li) {
    unsigned char* ws = PWS;
    const int gt = F.vcu * 512 + F.tid, NGT = F.G * 512;
    const float* cckv_ = PIN(I_CCKV); const float* ckpe_ = PIN(I_CKPE);
    for (int i = gt; i < 8 * 256 * 32; i += NGT) { const int c8 = i & 31, t = (i >> 5) & 255, b = i >> 13;
        const float* s = cckv_ + ((size_t)((b * 2 + li) * 256 + t) * 32 + c8) * 8; const f32x4 a = *(const f32x4*)s, c = *(const f32x4*)(s + 4);
        *(GAS v4u*)((bf16*)(ws + WS_ACKV) + ((size_t)4096 + b * LKV + t) * 256 + c8 * 8) = (v4u){pk2(a[0], a[1]), pk2(a[2], a[3]), pk2(c[0], c[1]), pk2(c[2], c[3])}; }
    for (int i = gt; i < 8 * 256 * 8; i += NGT) { const int c8 = i & 7, t = (i >> 3) & 255, b = i >> 11;
        const float* s = ckpe_ + ((size_t)((b * 2 + li) * 256 + t) * 8 + c8) * 8; const f32x4 a = *(const f32x4*)s, c = *(const f32x4*)(s + 4);
        *(GAS v4u*)((bf16*)(ws + WS_KPE) + ((size_t)4096 + b * LKV + t) * 64 + c8 * 8) = (v4u){pk2(a[0], a[1]), pk2(a[2], a[3]), pk2(c[0], c[1]), pk2(c[2], c[3])}; }
}
__device__ __forceinline__ void kpe_pass(Frame& F, const Params& P, int li) {
    unsigned char* ws = PWS;
    const float* KR = (const float*)(ws + WS_Y); const float* ROPE = (const float*)(ws + WS_ROPE);
    bf16* KPE = (bf16*)(ws + WS_KPE);
    const int gt = F.vcu * 512 + F.tid, NGT = F.G * 512;
    for (int i = gt; i < M * 4; i += NGT) {
        const int row = i >> 2, c8 = i & 3;
        const float* s = KR + (size_t)row * 64 + 8 * c8;
        f32x4 a0 = *(const f32x4*)s, a1 = *(const f32x4*)(s + 4), b0 = *(const f32x4*)(s + 32), b1 = *(const f32x4*)(s + 36);
        int drow = row;
        if (row >= M_CTX) { const int lb = (row - M_CTX) >> 11, t = (row - M_CTX) & 2047; drow = M_CTX + lb * LKV + PAST + t;
            const float* cp = ROPE + (size_t)t * 32 + 8 * c8; const float* sp = cp + 65536;
            const f32x4 c0 = *(const f32x4*)cp, c1 = *(const f32x4*)(cp + 4), s0 = *(const f32x4*)sp, s1 = *(const f32x4*)(sp + 4);
            const f32x4 x0 = a0 * c0 - b0 * s0, x1 = a1 * c1 - b1 * s1, y0 = a0 * s0 + b0 * c0, y1 = a1 * s1 + b1 * c1;
            a0 = x0; a1 = x1; b0 = y0; b1 = y1; }
        bf16* d = KPE + (size_t)drow * 64 + 8 * c8;
        *(v4u*)d = (v4u){pk2(a0[0], a0[1]), pk2(a0[2], a0[3]), pk2(a1[0], a1[1]), pk2(a1[2], a1[3])};
        *(v4u*)(d + 32) = (v4u){pk2(b0[0], b0[1]), pk2(b0[2], b0[3]), pk2(b1[0], b1[1]), pk2(b1[2], b1[3])};
    }
}

constexpr float ATT_SCALE = 0.07216878364870322f;
constexpr float ATT_THR = 8.f;
constexpr int AT_V = 0, AT_KN = 49152, AT_KP = 98304, AT_WS = 122880, AT_VB = 16384, AT_KNB = 16384, AT_KPB = 8192;
#define KSWZ(row, colB) ((row) * 256 + ((colB) ^ (((row) & 7) << 4)))
#define KPSWZ(row, colB) ((row) * 128 + ((colB) ^ (((row) & 7) << 4)))
__device__ __forceinline__ void at_partialSM(f32x16& p0, f32x16& p1, float& m_reg, float& mn, float& alpha) {
    constexpr float C = ATT_SCALE * 1.4426950408889634f;
    float pmax = p0[0];
#pragma unroll
    for (int r = 1; r < 16; ++r) pmax = fmaxf(pmax, p0[r]);
#pragma unroll
    for (int r = 0; r < 16; ++r) pmax = fmaxf(pmax, p1[r]);
    { auto rr = __builtin_amdgcn_permlane32_swap(__float_as_uint(pmax), __float_as_uint(pmax), false, false); pmax = fmaxf(__uint_as_float(rr[0]), __uint_as_float(rr[1])); }
    if (__builtin_expect(__all(pmax - m_reg <= ATT_THR / ATT_SCALE), 1)) { mn = m_reg; alpha = 1.f; }
    else { mn = fmaxf(m_reg, pmax); alpha = __builtin_amdgcn_exp2f((m_reg - mn) * C); m_reg = mn; }
    const float mnC = -mn * C;
#pragma unroll
    for (int r = 0; r < 16; ++r) p0[r] = fmaf(p0[r], C, mnC);
#pragma unroll
    for (int r = 0; r < 16; ++r) p1[r] = fmaf(p1[r], C, mnC);
#pragma unroll
    for (int r = 0; r < 16; ++r) p0[r] = __builtin_amdgcn_exp2f(p0[r]);
}
__device__ __forceinline__ void at_finishSM(f32x16& p0, f32x16& p1, float alpha, float& l_reg, bf16x8& pa0, bf16x8& pa1, bf16x8& pa2, bf16x8& pa3) {
#pragma unroll
    for (int r = 0; r < 16; ++r) p1[r] = __builtin_amdgcn_exp2f(p1[r]);
    float ps = 0;
#pragma unroll
    for (int r = 0; r < 16; ++r) ps += p0[r];
#pragma unroll
    for (int r = 0; r < 16; ++r) ps += p1[r];
    { auto rr = __builtin_amdgcn_permlane32_swap(__float_as_uint(ps), __float_as_uint(ps), false, false); ps = __uint_as_float(rr[0]) + __uint_as_float(rr[1]); }
    l_reg = l_reg * alpha + ps;
    PK4(p0, 0, pa0); PK4(p0, 8, pa1); PK4(p1, 0, pa2); PK4(p1, 8, pa3);
}
__device__ __forceinline__ void at_qkt(f32x16& p0, f32x16& p1, const LAS unsigned char* Kn, const LAS unsigned char* Kp, const bf16x8* qr, const int* kb, const int* pb) {
    p0 = f32x16{}; p1 = f32x16{};
#pragma unroll
    for (int d0 = 0; d0 < 8; ++d0) {
        const bf16x8 b0 = *(const LAS bf16x8*)(Kn + kb[d0 & 3] + 128 * (d0 >> 2)), b1 = *(const LAS bf16x8*)(Kn + kb[d0 & 3] + 128 * (d0 >> 2) + 8192);
        p0 = __builtin_amdgcn_mfma_f32_32x32x16_bf16(b0, qr[d0], p0, 0, 0, 0);
        p1 = __builtin_amdgcn_mfma_f32_32x32x16_bf16(b1, qr[d0], p1, 0, 0, 0); }
#pragma unroll
    for (int d0 = 0; d0 < 4; ++d0) {
        const bf16x8 b0 = *(const LAS bf16x8*)(Kp + pb[d0]), b1 = *(const LAS bf16x8*)(Kp + pb[d0] + 4096);
        p0 = __builtin_amdgcn_mfma_f32_32x32x16_bf16(b0, qr[8 + d0], p0, 0, 0, 0);
        p1 = __builtin_amdgcn_mfma_f32_32x32x16_bf16(b1, qr[8 + d0], p1, 0, 0, 0); }
}
template <int D0> __device__ __forceinline__ void at_pv_one(f32x16& od, unsigned vb, bf16x8 pa0, bf16x8 pa1, bf16x8 pa2, bf16x8 pa3) {
    const s16x4 l0 = tr_read<D0 * 512>(vb), h0 = tr_read<D0 * 512 + 2048>(vb), l1 = tr_read<D0 * 512 + 4096>(vb), h1 = tr_read<D0 * 512 + 4096 + 2048>(vb);
    const s16x4 l2 = tr_read<D0 * 512 + 8192>(vb), h2 = tr_read<D0 * 512 + 8192 + 2048>(vb), l3 = tr_read<D0 * 512 + 12288>(vb), h3 = tr_read<D0 * 512 + 12288 + 2048>(vb);
    asm volatile("s_waitcnt lgkmcnt(0)" ::: "memory"); SBAR();
    od = __builtin_amdgcn_mfma_f32_32x32x16_bf16(pa0, PKF(l0, h0), od, 0, 0, 0);
    od = __builtin_amdgcn_mfma_f32_32x32x16_bf16(pa1, PKF(l1, h1), od, 0, 0, 0);
    od = __builtin_amdgcn_mfma_f32_32x32x16_bf16(pa2, PKF(l2, h2), od, 0, 0, 0);
    od = __builtin_amdgcn_mfma_f32_32x32x16_bf16(pa3, PKF(l3, h3), od, 0, 0, 0);
}
__device__ __forceinline__ void at_pv(f32x16* o, unsigned vb, bf16x8 pa0, bf16x8 pa1, bf16x8 pa2, bf16x8 pa3) {
    at_pv_one<0>(o[0], vb, pa0, pa1, pa2, pa3); at_pv_one<1>(o[1], vb, pa0, pa1, pa2, pa3); at_pv_one<2>(o[2], vb, pa0, pa1, pa2, pa3); at_pv_one<3>(o[3], vb, pa0, pa1, pa2, pa3);
}
__device__ __forceinline__ void attn_unit(Frame& F, const bf16* Qrow0  , const bf16* KVh  , const bf16* KPEs  ,
                                          bf16* Orow0, int nkeys, const float* ROPE, int tpos0  ) {
    LAS unsigned char* lds = F.lds;
    const int tid = F.tid, wid = F.wave, lane = F.lane, r32 = lane & 31, hi = lane >> 5;
    LAS float* wsf = (LAS float*)(lds + AT_WS) + wid * 64; LAS float* li_l = wsf; LAS float* al_l = wsf + 32;
    float m_reg = -1e30f, l_reg = 0; f32x16 o[4] = {}; bf16x8 qr[12];
    { const bf16* Qw = Qrow0 + (size_t)(wid * 32 + r32) * 1536 + hi * 8;
#pragma unroll
      for (int d0 = 0; d0 < 12; ++d0) qr[d0] = *(const bf16x8*)(Qw + d0 * 16);
      if (tpos0 >= 0) {
          const int t = tpos0 + wid * 32 + r32;
#pragma unroll
          for (int half = 0; half < 2; ++half) {
              const float* cp = ROPE + (size_t)t * 32 + 16 * half + 8 * hi; const float* sp = cp + 65536;
              const v4u xa = __builtin_bit_cast(v4u, qr[8 + half]), xb = __builtin_bit_cast(v4u, qr[10 + half]);
              float x1[8], x2[8];
              x1[0] = bflo(xa.x); x1[1] = bfhi(xa.x); x1[2] = bflo(xa.y); x1[3] = bfhi(xa.y); x1[4] = bflo(xa.z); x1[5] = bfhi(xa.z); x1[6] = bflo(xa.w); x1[7] = bfhi(xa.w);
              x2[0] = bflo(xb.x); x2[1] = bfhi(xb.x); x2[2] = bflo(xb.y); x2[3] = bfhi(xb.y); x2[4] = bflo(xb.z); x2[5] = bfhi(xb.z); x2[6] = bflo(xb.w); x2[7] = bfhi(xb.w);
              float y1[8], y2[8];
#pragma unroll
              for (int j = 0; j < 8; ++j) { const float c = cp[j], s = sp[j]; y1[j] = x1[j] * c - x2[j] * s; y2[j] = x1[j] * s + x2[j] * c; }
              const v4u wa = {pk2(y1[0], y1[1]), pk2(y1[2], y1[3]), pk2(y1[4], y1[5]), pk2(y1[6], y1[7])}, wb = {pk2(y2[0], y2[1]), pk2(y2[2], y2[3]), pk2(y2[4], y2[5]), pk2(y2[6], y2[7])};
              if (half == 0) { qr[8] = __builtin_bit_cast(bf16x8, wa); qr[10] = __builtin_bit_cast(bf16x8, wb); } else { qr[9] = __builtin_bit_cast(bf16x8, wa); qr[11] = __builtin_bit_cast(bf16x8, wb); }
          }
      } }
    const unsigned vb0 = (unsigned)(uintptr_t)(lds + AT_V) + v_rd_base(lane);
#define AT_OPQ() int l_ = lane; asm volatile("" : "+v"(l_))
#define AT_KADDR() int kbs[4], pbs[4]; { AT_OPQ(); _Pragma("unroll") for (int b = 0; b < 4; ++b) { const int x = (32 * b + 16 * (l_ >> 5)) ^ ((l_ & 7) << 4); kbs[b] = (l_ & 31) * 256 + x; pbs[b] = (l_ & 31) * 128 + x; } }
#define AT_GLDS(gp, ldsoff) __builtin_amdgcn_global_load_lds((const unsigned*)(gp), (LAS unsigned*)(lds + (ldsoff)), 16, 0, 0)
#define AT_DMA_K(t, b) do { AT_OPQ(); const char* kb_ = (const char*)KVh + (size_t)(t) * (64 * 4096); const char* pb_ = (const char*)KPEs + (size_t)(t) * (64 * 128); \
    const int row0_ = 4 * wid + (l_ >> 4), cB0_ = ((l_ & 15) * 16) ^ ((row0_ & 7) << 4), row1_ = row0_ + 32, rowp_ = 8 * wid + (l_ >> 3), cBp_ = ((l_ & 7) * 16) ^ ((rowp_ & 7) << 4); \
    AT_GLDS(kb_ + (unsigned)(row0_ * 4096 + cB0_), AT_KN + (b) * AT_KNB + wid * 1024); AT_GLDS(kb_ + (unsigned)(row1_ * 4096 + cB0_), AT_KN + (b) * AT_KNB + (wid + 8) * 1024); \
    AT_GLDS(pb_ + (unsigned)(rowp_ * 128 + cBp_), AT_KP + (b) * AT_KPB + wid * 1024); } while (0)
#define AT_DMA_V(t, b) do { AT_OPQ(); const char* vb_ = (const char*)KVh + (size_t)(t) * (64 * 4096); \
    const int st_ = 2 * wid + (l_ >> 5), kk_ = (st_ >> 2) * 8 + ((l_ & 31) >> 2), key_ = (kk_ & ~0xC) | ((kk_ & 4) << 1) | ((kk_ & 8) >> 1), col_ = (st_ & 3) * 32 + (l_ & 3) * 8; \
    AT_GLDS(vb_ + (unsigned)(key_ * 4096 + (128 + col_) * 2), AT_V + (b) * AT_VB + wid * 1024); AT_GLDS(vb_ + (unsigned)((key_ + 32) * 4096 + (128 + col_) * 2), AT_V + (b) * AT_VB + (wid + 8) * 1024); } while (0)
#define AT_RESC(a) do { if (__any((a) < 1.f)) { if (hi == 0) al_l[r32] = (a); asm volatile("s_waitcnt lgkmcnt(0)" ::: "memory"); \
    _Pragma("unroll") for (int d = 0; d < 4; ++d) _Pragma("unroll") for (int r = 0; r < 16; ++r) o[d][r] *= al_l[crow(r, hi)]; } } while (0)
#define AT_WAITBAR(N) do { asm volatile("s_waitcnt vmcnt(" #N ") lgkmcnt(0)" ::: "memory"); __builtin_amdgcn_s_barrier(); asm volatile("" ::: "memory"); } while (0)
    f32x16 pA0, pA1, pB0, pB1; float mnA, mnB, alA, alB; bf16x8 pa0, pa1, pa2, pa3; const int NT = nkeys / 64;
    AT_DMA_K(0, 0); AT_DMA_K(1, 1); AT_DMA_V(0, 0); AT_WAITBAR(0);
    int s = 0;
#define AT_S1 (s == 2 ? 0 : s + 1)
#define AT_S2 (s == 0 ? 2 : s - 1)
#define AT_STEP(CUR0, CUR1, MNC, ALC, PRV0, PRV1, ALP, t, MODE) do { \
        if (MODE == 2) { AT_DMA_K((t) + 2, AT_S2); } if (MODE >= 1) { AT_DMA_V((t) + 1, AT_S1); } \
        SBAR(); { AT_KADDR(); at_qkt(CUR0, CUR1, lds + AT_KN + s * AT_KNB, lds + AT_KP + s * AT_KPB, qr, kbs, pbs); } \
        at_finishSM(PRV0, PRV1, ALP, l_reg, pa0, pa1, pa2, pa3); SBAR(); \
        at_pv(o, vb0 + AT_S2 * AT_VB, pa0, pa1, pa2, pa3); at_partialSM(CUR0, CUR1, m_reg, MNC, ALC); \
        AT_RESC(ALC); if (MODE == 2) AT_WAITBAR(5); else if (MODE == 1) AT_WAITBAR(2); else AT_WAITBAR(0); s = AT_S1; } while (0)
    AT_DMA_K(2, 2); AT_DMA_V(1, 1);
    { AT_KADDR(); at_qkt(pA0, pA1, lds + AT_KN, lds + AT_KP, qr, kbs, pbs); } at_partialSM(pA0, pA1, m_reg, mnA, alA);
    AT_WAITBAR(5); s = 1;
    int t = 1;
    for (; t + 4 < NT; t += 2) {
        AT_STEP(pB0, pB1, mnB, alB, pA0, pA1, alA, t, 2);
        AT_STEP(pA0, pA1, mnA, alA, pB0, pB1, alB, t + 1, 2);
    }
    AT_STEP(pB0, pB1, mnB, alB, pA0, pA1, alA, NT - 3, 2);
    AT_STEP(pA0, pA1, mnA, alA, pB0, pB1, alB, NT - 2, 1);
    AT_STEP(pB0, pB1, mnB, alB, pA0, pA1, alA, NT - 1, 0);
    at_finishSM(pB0, pB1, alB, l_reg, pa0, pa1, pa2, pa3); SBAR();
    at_pv(o, vb0 + AT_S2 * AT_VB, pa0, pa1, pa2, pa3);
    if (hi == 0) li_l[r32] = l_reg; asm volatile("s_waitcnt lgkmcnt(0)" ::: "memory");
    float rli[16];
#pragma unroll
    for (int r = 0; r < 16; ++r) rli[r] = __builtin_amdgcn_rcpf(li_l[crow(r, hi)]);
    bf16* Ow = Orow0 + (size_t)(wid * 32) * D;
#pragma unroll
    for (int r = 0; r < 16; r += 2) { const int orow = crow(r, hi);
#pragma unroll
        for (int d0 = 0; d0 < 4; ++d0) { const unsigned w = pk2(o[d0][r] * rli[r], o[d0][r + 1] * rli[r + 1]);
            Ow[(size_t)orow * D + d0 * 32 + r32] = (bf16)w; Ow[(size_t)(orow + 1) * D + d0 * 32 + r32] = (bf16)(w >> 16); } }
#undef AT_GLDS
#undef AT_OPQ
#undef AT_KADDR
#undef AT_DMA_K
#undef AT_DMA_V
#undef AT_RESC
#undef AT_WAITBAR
#undef AT_S1
#undef AT_S2
#undef AT_STEP
}
__device__ __forceinline__ void attn_phase(Frame& F, const Params& P, int li) {
    unsigned char* ws = PWS;
    const bf16* Q = (const bf16*)(ws + WS_Q); const bf16* KV = (const bf16*)(ws + WS_KV); const bf16* KPE = (const bf16*)(ws + WS_KPE);
    bf16* OB = (bf16*)(ws + WS_HB); const float* ROPE = (const float*)(ws + WS_ROPE);
    for (int u = F.vcu; u < 256 + 128; u += F.G) {
        for (int k = 0; k < 2; ++k) {
            int qrow0, kvrow0, nkeys, h, tpos0;
            if (u < 256) { const int id = 2 * u + k, lb = id >> 6, qb = id & 7; h = (id >> 3) & 7; qrow0 = M_CTX + lb * L_LAT + qb * 256; kvrow0 = M_CTX + lb * LKV; nkeys = LKV; tpos0 = qb * 256; }
            else { if (k == 1) break; const int id = u - 256, b = id >> 3; h = id & 7; qrow0 = b * L_CTX; kvrow0 = b * L_CTX; nkeys = L_CTX; tpos0 = -1; }
            __syncthreads();
            attn_unit(F, Q + (size_t)qrow0 * 1536 + h * 192, KV + (size_t)kvrow0 * 2048 + h * 256, KPE + (size_t)kvrow0 * 64, OB + (size_t)qrow0 * D + h * 128, nkeys, ROPE, tpos0);
        }
    }
}

constexpr int N_PHASES = 2 + 2 * 16;
__global__ void __launch_bounds__(NWAVES * 64, 2) hyb_fwd(Params P) {
    extern __shared__ __attribute__((aligned(16))) unsigned char lds_raw[];
    Frame F;
    F.lds = (LAS unsigned char*)lds_raw;
    F.tid = threadIdx.x; F.lane = F.tid & 63; F.wave = __builtin_amdgcn_readfirstlane(F.tid >> 6);
    F.G = gridDim.x; { const int bx = blockIdx.x; F.vcu = (F.G % 8 == 0) ? (bx % 8) * (F.G / 8) + bx / 8 : bx; }
    volatile LAS unsigned* MISC = (volatile LAS unsigned*)(F.lds + LDS_MISC);
    if (F.tid < 64) MISC[F.tid] = 0u;
    if (F.tid < 30) { const unsigned long long v = F.tid < 28 ? (unsigned long long)P.in[F.tid] : (F.tid == 28 ? (unsigned long long)P.out : (unsigned long long)P.ws);
        volatile LAS unsigned* pt = (volatile LAS unsigned*)(F.lds + LDS_PT) + 2 * F.tid; pt[0] = (unsigned)v; pt[1] = (unsigned)(v >> 32); }
    __syncthreads();
    const int use_bar = P.use_bar, ph_hi = P.ph_hi;
    XcdBarrier bar; bar.bar = (unsigned*)(PWS + WS_CTL) + 4096; bar.x = 0; bar.st = nullptr;
    if (use_bar) bar = xcd_barrier_post((unsigned*)(PWS + WS_CTL) + 4096, MISC + 8);

    int dup_done = 0; (void)dup_done;
    for (int ph = P.ph_lo; ph < ph_hi; ++ph) {
#define REFRESH_ID() do { int t_ = threadIdx.x; asm volatile("" : "+v"(t_)); F.tid = t_; F.lane = t_ & 63; F.wave = __builtin_amdgcn_readfirstlane(t_ >> 6); \
          int g_ = gridDim.x, b_ = blockIdx.x; asm volatile("" : "+s"(g_), "+s"(b_)); F.G = g_; F.vcu = (g_ % 8 == 0) ? (b_ % 8) * (g_ / 8) + b_ / 8 : b_; F.bid = b_; } while (0)
        REFRESH_ID();
        unsigned char* ws = PWS;
        bf16* XBF = (bf16*)(POUT + OUT_Y);
        bf16* HB = (bf16*)(ws + WS_HB); bf16* YB = (bf16*)(ws + WS_Y); const bf16* SL = (const bf16*)(ws + WS_SLAB);
        const float* MOD = (const float*)(ws + WS_MOD);
        if (ph == 0) { p0_prologue(F, P); }
        else if (ph == 1) {
            const float* m0 = MOD;
            row_pass(F, PIN(I_XP), PIN(I_XS), true, nullptr, nullptr, nullptr, nullptr, nullptr, PIN(I_NMIXPRE), m0 + 1024, m0, HB, false, true);
        } else {
            const int q = ph - 2, pair = q / 16, r = q % 16; const bool odd = r >= 8; const int l = 2 * pair + (odd ? 1 : 0), k = odd ? r - 8 : r;
            const float* ml = MOD + (size_t)l * 9 * 6144;
            const int kind = k < 3 ? (odd ? 10 + k : (k == 2 ? 8 : k)) : (k == 3 ? 2 : k == 4 ? 3 : k == 5 ? 4 : k == 6 ? 5 : 6);
            if (kind == 0) {
                pg8::Gemm g{HB, (const bf16*)(ws + WS_WINE) + (size_t)pair * EVEN_NP * 1024, M, EVEN_NP, 1024}; pg8::StaticOrder S; S.init(M, EVEN_NP, F.G, F.bid, 1024);
                pg8::EpiBf16<0> E{(bf16*)(ws + WS_BIG), EVEN_NP};
                pg8::gemm_phase<pg8::EpiBf16<0>, pg8::StaticOrder, true, true>(F.lds, g, S, E, F.tid);
            } else if (kind == 1) {
                scan_phase(F, P, pair);
            } else if (kind == 8) {
                scan_combine(F, P, pair);
            } else if (kind == 2) {
                const bf16* W = odd ? (const bf16*)(ws + WS_WOUTO) + (size_t)pair * 1024 * 1024 : (const bf16*)(ws + WS_WOUTE) + (size_t)pair * 1024 * 1024;
                { pg8::Gemm g{HB, W, M, 1024, 1024}; pg8::TailSplitOrder S; S.init(F.bid, 1024, 1);
                  pg8::EpiYsplit E{YB, (bf16*)(ws + WS_SLAB)};
                  pg8::gemm_phase<pg8::EpiYsplit, pg8::TailSplitOrder, true, true>(F.lds, g, S, E, F.tid); }
                REFRESH_ID();
                { pg8::Gemm g{HB, W, M, 1024, 1024}; pg8::TailSplitOrder S; S.init(F.bid, 1024, 2);
                  pg8::EpiYsplit E{YB, (bf16*)(PWS + WS_SLAB)};
                  pg8::gemm_phase<pg8::EpiYsplit, pg8::TailSplitOrder, true, true>(F.lds, g, S, E, F.tid); }
            } else if (kind == 3) {
                row_pass(F, PIN(I_XP), PIN(I_XS), l == 0, XBF, YB, SL, PIN(I_NMIXPOST) + l * 1024, ml + 2048, PIN(I_NMLPPRE) + l * 1024, ml + 4096, ml + 3072, HB, true, true);
            } else if (kind == 4) {
                pg8::Gemm g{HB, (const bf16*)(ws + WS_W1) + (size_t)l * 4096 * 1024, M, FF, 1024}; pg8::StaticOrder S; S.init(M, FF, F.G, F.bid, 1024);
                pg8::EpiBf16<1> E{(bf16*)(ws + WS_BIG), FF};
                pg8::gemm_phase<pg8::EpiBf16<1>, pg8::StaticOrder, true, true>(F.lds, g, S, E, F.tid);
            } else if (kind == 5) {
                { pg8::Gemm g{(const bf16*)(ws + WS_BIG), (const bf16*)(ws + WS_W2) + (size_t)l * 1024 * 4096, M, 1024, FF}; pg8::TailSplitOrder S; S.init(F.bid, FF, 1);
                  pg8::EpiYsplit E{YB, (bf16*)(ws + WS_SLAB)};
                  pg8::gemm_phase<pg8::EpiYsplit, pg8::TailSplitOrder, true, true>(F.lds, g, S, E, F.tid); }
                REFRESH_ID();
                { pg8::Gemm g{(const bf16*)(PWS + WS_BIG), (const bf16*)(PWS + WS_W2) + (size_t)l * 1024 * 4096, M, 1024, FF}; pg8::TailSplitOrder S; S.init(F.bid, FF, 2);
                  pg8::EpiYsplit E{(bf16*)(PWS + WS_Y), (bf16*)(PWS + WS_SLAB)};
                  pg8::gemm_phase<pg8::EpiYsplit, pg8::TailSplitOrder, true, true>(F.lds, g, S, E, F.tid); }
            } else if (kind == 6) {
                const float* mn = ml + 9 * 6144;
                if (l < 3) row_pass(F, nullptr, nullptr, false, XBF, YB, SL, PIN(I_NMLPPOST) + l * 1024, ml + 5120, PIN(I_NMIXPRE) + (l + 1) * 1024, mn + 1024, mn, HB, true, true);
                else { bar.bar = (unsigned*)(PWS + WS_CTL) + 4096; row_pass_final(F, bar, XBF, POUT + OUT_Y, YB, SL, PIN(I_NMLPPOST) + l * 1024, ml + 5120); }
            } else if (kind == 10) {
                pg8::Gemm g{HB, (const bf16*)(ws + WS_WINO) + (size_t)pair * ODD_NP * 1024, M, ODD_NP, 1024}; pg8::StaticOrder S; S.init(M, ODD_NP, F.G, F.bid, 1024);
                pg8::EpiOddIn E{(bf16*)(ws + WS_QN), (bf16*)(ws + WS_ACKV), (float*)(ws + WS_Y), POUT + OUT_CKV, POUT + OUT_KPE,
                                PIN(I_QAN) + pair * 256, PIN(I_KVAN) + pair * 256, pair};
                pg8::gemm_phase<pg8::EpiOddIn, pg8::StaticOrder, false, true>(F.lds, g, S, E, F.tid);
                REFRESH_ID(); cache_pass(F, P, pair);
            } else if (kind == 11) {
                kpe_pass(F, P, pair); REFRESH_ID();
                { pg8::Gemm g{(const bf16*)(ws + WS_QN), (const bf16*)(ws + WS_WQB) + (size_t)pair * 1536 * 256, M, 1536, 256}; pg8::StaticOrder S; S.init(M, 1536, F.G, F.bid, 256);
                  pg8::EpiBf16<0> E{(bf16*)(ws + WS_Q), 1536};
                  pg8::gemm_phase<pg8::EpiBf16<0>, pg8::StaticOrder, true, true>(F.lds, g, S, E, F.tid); }
                REFRESH_ID();
                { pg8::Gemm g{(const bf16*)(ws + WS_ACKV), (const bf16*)(ws + WS_WKVB) + (size_t)pair * 2048 * 256, MKV, 2048, 256}; pg8::StaticOrder S; S.init(MKV, 2048, F.G, F.bid, 256);
                  pg8::EpiBf16<0> E{(bf16*)(ws + WS_KV), 2048};
                  pg8::gemm_phase<pg8::EpiBf16<0>, pg8::StaticOrder, true, true>(F.lds, g, S, E, F.tid); }
            } else if (kind == 12) {
                attn_phase(F, P, pair);
            }
        }
#if defined(HYB_DUP_MASK)
        { int kind_ = -1;
          if (ph == 0) kind_ = 13;
          else if (ph >= 2) { const int q_ = ph - 2, r_ = q_ % 16; const bool odd_ = r_ >= 8; const int k_ = odd_ ? r_ - 8 : r_;
              kind_ = k_ < 3 ? (odd_ ? 10 + k_ : (k_ == 2 ? 8 : k_)) : (k_ == 3 ? 2 : k_ == 4 ? 3 : k_ == 5 ? 4 : k_ == 6 ? 5 : 6); }
          if (kind_ >= 0 && ((HYB_DUP_MASK >> kind_) & 1) && dup_done == 0) { dup_done = 1; if (use_bar) { bar.bar = (unsigned*)(PWS + WS_CTL) + 4096; xcd_barrier(bar); } else { VM_WAIT(); __syncthreads(); } --ph; continue; } }
        dup_done = 0;
        if (((HYB_DUP_MASK >> 14) & 1) && ph + 1 < ph_hi && use_bar) { bar.bar = (unsigned*)(PWS + WS_CTL) + 4096; xcd_barrier(bar); }
#endif
        if (ph + 1 < ph_hi) { if (use_bar) { bar.bar = (unsigned*)(PWS + WS_CTL) + 4096; xcd_barrier(bar); } else { VM_WAIT(); __syncthreads(); } }
    }
}

extern "C" void kernel_launch(void* const* d_in, const int* in_sizes, int n_in, void* d_out, int out_size, void* d_ws, size_t ws_size, hipStream_t stream) {
    static int grid = 0;
    if (grid == 0) {
        if (n_in != 28 || out_size != 27787264 || ws_size < WS_END) { fprintf(stderr, "kernel_launch: unexpected shapes: n_in %d out %d ws %zu (need >= %zu)\n", n_in, out_size, ws_size, (size_t)WS_END); grid = -1; return; }
        int dev = 0, cus = 0, per_cu = 0;
        if (hipGetDevice(&dev) != hipSuccess || hipDeviceGetAttribute(&cus, hipDeviceAttributeMultiprocessorCount, dev) != hipSuccess) { grid = -1; return; }
        if (hipFuncSetAttribute((const void*)hyb_fwd, hipFuncAttributeMaxDynamicSharedMemorySize, LDS_BYTES) != hipSuccess) { fprintf(stderr, "kernel_launch: hipFuncSetAttribute failed\n"); grid = -1; return; }
        if (hipOccupancyMaxActiveBlocksPerMultiprocessor(&per_cu, (const void*)hyb_fwd, NWAVES * 64, LDS_BYTES) != hipSuccess || per_cu < 1) { fprintf(stderr, "kernel_launch: occupancy query reports %d\n", per_cu); }
        (void)hipGetLastError();
        grid = cus;
    }
    if (grid < 0) return;
    (void)hipMemsetAsync((char*)d_ws + WS_CTL, 0, CTL_ZERO_BYTES, stream);
    Params a{};
    for (int i = 0; i < 28; ++i) a.in[i] = (const float*)d_in[i];
    a.out = (float*)d_out; a.ws = (unsigned char*)d_ws;
    a.ph_lo = 0; a.ph_hi = N_PHASES; a.use_bar = 1; a.pad = 0;
    hipLaunchKernelGGL(hyb_fwd, dim3(grid), dim3(NWAVES * 64), LDS_BYTES, stream, a);
    const hipError_t le = hipPeekAtLastError();
    if (le != hipSuccess) fprintf(stderr, "kernel_launch: launch failed: %s\n", hipGetErrorName(le));
}
```

```cpp
#include <hip/hip_runtime.h>
#include <hip/hip_bf16.h>
#include <cstdio>
#include <cstdint>
namespace pg8 {
#define PG8_LAS __attribute__((address_space(3)))
typedef unsigned short bf16_t;
typedef short bf16x8 __attribute__((ext_vector_type(8)));
typedef float f32x4 __attribute__((ext_vector_type(4)));
typedef unsigned u32x4 __attribute__((ext_vector_type(4)));
constexpr int BM = 256, BK = 64, HALF = 128, HTB = HALF * BK * 2  , STAGE_BYTES = 8 * HTB, NXCD = 8, WGM = 8;

__host__ __device__ __forceinline__ int lds_byte(int r, int c) { const int st = (r >> 4) * 2 + (c >> 5), rr = r & 15, cc = c & 31, ob = rr * 64 + cc * 2; return st * 1024 + (ob ^ (((ob >> 9) & 1) << 5)); }
__host__ __device__ __forceinline__ void stage_rc(int b, int& R, int& C) { const int st = b / 1024, sb = b % 1024, swz = sb ^ (((sb >> 9) & 1) << 5); R = (st >> 1) * 16 + swz / 64; C = (st & 1) * 32 + (swz % 64) / 2; }
__host__ __device__ __forceinline__ int perm32(int rho) { const int n = rho >> 4, i = rho & 15; return 8 * (i >> 2) + 4 * n + (i & 3); }

struct Unit { int pm, pn, ks, kt0, nt; };
struct Gemm { const bf16_t* A; const bf16_t* Bt; int M, N, K; };

struct StaticOrder {
    int nM, nN, nwg, G, c, ntk;
    __host__ __device__ void init(int M, int N, int G_, int c_, int K) { nM = M / BM; nN = N / BM; nwg = nM * nN; G = G_; c = c_; ntk = K / BK; }
    __host__ __device__ bool next(int i, Unit& u) const {
        const long L = (long)i * G + c; if (L >= nwg) return false;
        int wgid = (int)L; { const int q = nwg / NXCD, r = nwg % NXCD, xcd = wgid % NXCD, off = wgid / NXCD; wgid = (xcd < r ? xcd * (q + 1) : r * (q + 1) + (xcd - r) * q) + off; }
        const int nig = WGM * nN, gid = wgid / nig, fm = gid * WGM, gsz = (nM - fm) < WGM ? (nM - fm) : WGM;
        u.pm = fm + ((wgid % nig) % gsz); u.pn = (wgid % nig) / gsz; u.ks = -1; u.kt0 = 0; u.nt = ntk; return true;
    }
    __device__ __forceinline__ void a_ready(const Unit&) const {}
    __device__ __forceinline__ void done(const Unit&) const {}
};


struct TailSplitOrder {
    int c, ntk, mode;
    __device__ void init(int c_, int K, int mode_) { c = c_; ntk = K / BK; mode = mode_; }
    __device__ bool next(int i, Unit& u) const {
        const int xcd = c & 7, j = c >> 3;
        const int round = mode == 2 ? i + 1 : i;
        if (round == 0) { u.pm = xcd * 8 + (j & 7); u.pn = j >> 3; u.ks = -1; u.kt0 = 0; u.nt = ntk; return true; }
        if (round == 1 && mode != 1) { u.pm = 64 + xcd * 2 + (j & 1); u.pn = (j >> 1) & 3; u.ks = j >> 3; u.nt = ntk >> 2; u.kt0 = u.ks * u.nt; return true; }
        return false;
    }
    __device__ __forceinline__ void a_ready(const Unit&) const {}
    __device__ __forceinline__ void done(const Unit&) const {}
};

typedef float f32x2c_t __attribute__((ext_vector_type(2))); typedef __bf16 bf16x2c_t __attribute__((ext_vector_type(2)));
__device__ __forceinline__ unsigned cvt_pk_bf16(float lo, float hi) { f32x2c_t v = {lo, hi}; bf16x2c_t b = __builtin_convertvector(v, bf16x2c_t); return __builtin_bit_cast(unsigned, b); }

template <int ACT> struct EpiBf16 {
    static constexpr bool PERM = true, AFTER_DRAIN = false;
    bf16_t* O; int ldc;
    __device__ __forceinline__ void operator()(const f32x4 (&acc)[2][2][4][2], const Unit& u, int wr, int wc, int fr, int fq) const {
        const int row0 = u.pm * BM + wr * 64 + fr; const int col0 = u.pn * BM + wc * 32 + 8 * fq;
#if defined(HYB_EPI_REP)
        for (int rep_ = 0; rep_ < HYB_EPI_REP; ++rep_) { asm volatile("" ::: "memory");
#endif
#pragma unroll
        for (int ai = 0; ai < 2; ++ai)
#pragma unroll
            for (int m = 0; m < 4; ++m) { bf16_t* rowp = O + (size_t)(row0 + ai * HALF + m * 16) * ldc + col0;
#pragma unroll
                for (int bj = 0; bj < 2; ++bj) { f32x4 v0 = acc[ai][bj][m][0], v1 = acc[ai][bj][m][1];
                    if (ACT == 1) {
#pragma unroll
                        for (int j = 0; j < 4; ++j) { const float a = fmaxf(v0[j], 0.f), b = fmaxf(v1[j], 0.f); v0[j] = a * a; v1[j] = b * b; } }
                    u32x4 w; w.x = cvt_pk_bf16(v0[0], v0[1]); w.y = cvt_pk_bf16(v0[2], v0[3]); w.z = cvt_pk_bf16(v1[0], v1[1]); w.w = cvt_pk_bf16(v1[2], v1[3]);
#if defined(HYB_NT_STORE)
                    __builtin_nontemporal_store(w, (u32x4*)(rowp + bj * HALF)); } }
#else
                    *(u32x4*)(rowp + bj * HALF) = w; } }
#endif
#if defined(HYB_EPI_REP)
        }
#endif
    }
};
struct EpiYsplit {
    static constexpr bool PERM = true, AFTER_DRAIN = false;
    bf16_t* Y; bf16_t* SL;
    __device__ __forceinline__ void operator()(const f32x4 (&acc)[2][2][4][2], const Unit& u, int wr, int wc, int fr, int fq) const {
        const int row0 = u.pm * BM + wr * 64 + fr; const int col0 = u.pn * BM + wc * 32 + 8 * fq;
        if (u.ks < 0) {
#pragma unroll
            for (int ai = 0; ai < 2; ++ai)
#pragma unroll
                for (int m = 0; m < 4; ++m) { bf16_t* rowp = Y + (size_t)(row0 + ai * HALF + m * 16) * 1024 + col0;
#pragma unroll
                    for (int bj = 0; bj < 2; ++bj) { const f32x4 v0 = acc[ai][bj][m][0], v1 = acc[ai][bj][m][1];
                        u32x4 w; w.x = cvt_pk_bf16(v0[0], v0[1]); w.y = cvt_pk_bf16(v0[2], v0[3]); w.z = cvt_pk_bf16(v1[0], v1[1]); w.w = cvt_pk_bf16(v1[2], v1[3]);
                        *(u32x4*)(rowp + bj * HALF) = w; } }
        } else {
            bf16_t* base = SL + (size_t)u.ks * (4096 * 1024);
#pragma unroll
            for (int ai = 0; ai < 2; ++ai)
#pragma unroll
                for (int m = 0; m < 4; ++m) { bf16_t* rowp = base + (size_t)(row0 - 16384 + ai * HALF + m * 16) * 1024 + col0;
#pragma unroll
                    for (int bj = 0; bj < 2; ++bj) { const f32x4 v0 = acc[ai][bj][m][0], v1 = acc[ai][bj][m][1];
                        u32x4 w; w.x = cvt_pk_bf16(v0[0], v0[1]); w.y = cvt_pk_bf16(v0[2], v0[3]); w.z = cvt_pk_bf16(v1[0], v1[1]); w.w = cvt_pk_bf16(v1[2], v1[3]);
                        *(u32x4*)(rowp + bj * HALF) = w; } }
        }
    }
};
struct EpiOddIn {
    static constexpr bool PERM = false, AFTER_DRAIN = true;
    bf16_t* QN; bf16_t* ACKV; float* KPERAW; float* out_ckv; float* out_kpe; const float* gq; const float* gkv; int li;
    __device__ __forceinline__ void fused(f32x4 (&acc)[2][2][4][2], const Unit& u, int wr, int wc, int fr, int fq, PG8_LAS unsigned char* lds, int wid, int lane) const {
        PG8_LAS float* P = (PG8_LAS float*)lds;
        if (u.pn < 2) {
#pragma unroll
            for (int ai = 0; ai < 2; ++ai)
#pragma unroll
                for (int m = 0; m < 4; ++m) { float s = 0.f;
#pragma unroll
                    for (int bj = 0; bj < 2; ++bj)
#pragma unroll
                        for (int n = 0; n < 2; ++n) { const f32x4 x = acc[ai][bj][m][n]; s += (x[0] * x[0] + x[1] * x[1]) + (x[2] * x[2] + x[3] * x[3]); }
                    s += __shfl_xor(s, 16); s += __shfl_xor(s, 32);
                    if (fq == 0) P[(ai * HALF + wr * 64 + m * 16 + fr) * 4 + wc] = s; }
        }
        asm volatile("s_waitcnt lgkmcnt(0)" ::: "memory"); __builtin_amdgcn_s_barrier(); asm volatile("" ::: "memory");
        if (u.pn < 2) {
            const float* gv = u.pn == 0 ? gq : gkv;
#pragma unroll
            for (int ai = 0; ai < 2; ++ai)
#pragma unroll
                for (int m = 0; m < 4; ++m) { const int r = ai * HALF + wr * 64 + m * 16 + fr; const int grow = u.pm * BM + r;
                    const float tot = (P[r * 4 + 0] + P[r * 4 + 1]) + (P[r * 4 + 2] + P[r * 4 + 3]);
                    const float rstd = 1.0f / sqrtf(tot * (1.0f / 256.0f) + 1e-6f);
                    const int drow = grow < 4096 ? grow : 4096 + ((grow - 4096) >> 11) * 2304 + 256 + ((grow - 4096) & 2047);
#pragma unroll
                    for (int bj = 0; bj < 2; ++bj)
#pragma unroll
                        for (int n = 0; n < 2; ++n) { const int col = bj * HALF + wc * 32 + n * 16 + 4 * fq; const f32x4 g = *(const f32x4*)(gv + col);
                            const f32x4 v = acc[ai][bj][m][n] * rstd * g;
                            unsigned long long w = (unsigned long long)cvt_pk_bf16(v[0], v[1]) | ((unsigned long long)cvt_pk_bf16(v[2], v[3]) << 32);
                            if (u.pn == 0) *(unsigned long long*)(QN + (size_t)grow * 256 + col) = w;
                            else { *(unsigned long long*)(ACKV + (size_t)drow * 256 + col) = w;
                                   if (grow < 4096) *(f32x4*)(out_ckv + ((size_t)((grow >> 8) * 2 + li) * 256 + (grow & 255)) * 256 + col) = v; } } }
        } else if (wc < 2) {
#pragma unroll
            for (int ai = 0; ai < 2; ++ai)
#pragma unroll
                for (int m = 0; m < 4; ++m) { const int r = ai * HALF + wr * 64 + m * 16 + fr; const int grow = u.pm * BM + r;
#pragma unroll
                    for (int n = 0; n < 2; ++n) { const int col = wc * 32 + n * 16 + 4 * fq; const f32x4 v = acc[ai][0][m][n];
                        *(f32x4*)(KPERAW + (size_t)grow * 64 + col) = v;
                        if (grow < 4096) *(f32x4*)(out_kpe + ((size_t)((grow >> 8) * 2 + li) * 256 + (grow & 255)) * 64 + col) = v; } }
        }
    }
};

template <class Epi, class Sched, bool ALIGN_EPI = false, bool SP2 = false>
__device__ __forceinline__ void gemm_phase(PG8_LAS unsigned char* lds, const Gemm g, const Sched& S, const Epi& E, const int tid) {
    const int  wid = __builtin_amdgcn_readfirstlane(tid >> 6), lane = tid & 63, wr = wid >> 2, wc = wid & 3, fr = lane & 15, fq = lane >> 4;
    const int K = g.K;
    unsigned voffA[2], voffB[2];
#pragma unroll
    for (int i = 0; i < 2; ++i) { int R, C; stage_rc(tid * 16 + i * 8192, R, C); const int Rb = Epi::PERM ? ((R & ~31) + perm32(R & 31)) : R;
        voffA[i] = (unsigned)(R * K + C) * 2u; voffB[i] = (unsigned)(Rb * K + C) * 2u; }
    const size_t kstep = (size_t)(BK * 2);
    const size_t hstep = (size_t)HALF * K * 2;
    const size_t tstep = 2 * hstep;
    const unsigned ldsw = (unsigned)wid * 1024u;
    const int aoff = lds_byte(wr * 64 + fr, fq * 8), boff = lds_byte(wc * 32 + fr, fq * 8);
#define PG8_SA(b, h) (((b) * 2 + (h)) * HTB)
#define PG8_SB(b, h) ((4 + (b) * 2 + (h)) * HTB)
#define PG8_STAGE(bufoff, gbase, voff) do { _Pragma("unroll") for (int _i = 0; _i < 2; ++_i) \
        __builtin_amdgcn_global_load_lds((const unsigned*)((const char*)(gbase) + (voff)[_i]), (PG8_LAS unsigned*)(lds + (bufoff) + ldsw + _i * 8192), 16, 0, 0); } while (0)
#define PG8_LDA(dst, b, h) do { _Pragma("unroll") for (int m = 0; m < 4; ++m) _Pragma("unroll") for (int k = 0; k < 2; ++k) dst[m][k] = *(const PG8_LAS bf16x8*)(lds + PG8_SA(b, h) + aoff + m * 2048 + k * 1024); } while (0)
#define PG8_LDB(dst, b, h) do { _Pragma("unroll") for (int n = 0; n < 2; ++n) _Pragma("unroll") for (int k = 0; k < 2; ++k) dst[n][k] = *(const PG8_LAS bf16x8*)(lds + PG8_SB(b, h) + boff + n * 2048 + k * 1024); } while (0)
#define PG8_MMA(ai, bj, At, Bt) do { __builtin_amdgcn_s_setprio(1); _Pragma("unroll") for (int m = 0; m < 4; ++m) _Pragma("unroll") for (int n = 0; n < 2; ++n) _Pragma("unroll") for (int k = 0; k < 2; ++k) \
        acc[ai][bj][m][n] = __builtin_amdgcn_mfma_f32_16x16x32_bf16(Bt[n][k], At[m][k], acc[ai][bj][m][n], 0, 0, 0); __builtin_amdgcn_s_setprio(0); } while (0)
#define PG8_WAIT_V(n) asm volatile("s_waitcnt vmcnt(" #n ")" ::: "memory")
#define PG8_WAIT_L(n) asm volatile("s_waitcnt lgkmcnt(" #n ")" ::: "memory")
#define PG8_BAR __builtin_amdgcn_s_barrier()
#define PG8_SCHED __builtin_amdgcn_sched_barrier(0)
    Unit cur, nxt; int ui = 0;
    if (!S.next(0, cur)) return;
    f32x4 acc[2][2][4][2];
#pragma unroll
    for (int a = 0; a < 2; ++a)
#pragma unroll
        for (int b = 0; b < 2; ++b)
#pragma unroll
            for (int m = 0; m < 4; ++m)
#pragma unroll
                for (int n = 0; n < 2; ++n) acc[a][b][m][n] = (f32x4){0.f, 0.f, 0.f, 0.f};
    bf16x8 At[4][2], B0[2][2], B1[2][2];
    const char* cA = (const char*)g.A + (size_t)cur.pm * tstep + (size_t)cur.kt0 * kstep; const char* cB = (const char*)g.Bt + (size_t)cur.pn * tstep + (size_t)cur.kt0 * kstep;
    S.a_ready(cur);
    if constexpr (SP2) {
        PG8_STAGE(PG8_SB(0, 0), cB, voffB); PG8_STAGE(PG8_SB(0, 1), cB + hstep, voffB); PG8_STAGE(PG8_SA(0, 0), cA, voffA); PG8_STAGE(PG8_SA(0, 1), cA + hstep, voffA);
        if (wr == 1) PG8_BAR;
        PG8_WAIT_V(2); PG8_BAR;
        PG8_STAGE(PG8_SB(1, 0), cB + kstep, voffB); PG8_STAGE(PG8_SA(1, 0), cA + kstep, voffA); PG8_STAGE(PG8_SB(1, 1), cB + hstep + kstep, voffB);
        PG8_WAIT_V(6); PG8_BAR;
    } else {
        PG8_STAGE(PG8_SB(0, 0), cB, voffB); PG8_STAGE(PG8_SA(0, 0), cA, voffA); PG8_STAGE(PG8_SB(0, 1), cB + hstep, voffB); PG8_STAGE(PG8_SA(0, 1), cA + hstep, voffA);
        if (wr == 1) PG8_BAR;
        PG8_WAIT_V(4); PG8_BAR;
        PG8_STAGE(PG8_SB(1, 0), cB + kstep, voffB); PG8_STAGE(PG8_SA(1, 0), cA + kstep, voffA); PG8_STAGE(PG8_SB(1, 1), cB + hstep + kstep, voffB);
        PG8_WAIT_V(6); PG8_BAR;
    }
    for (;;) {
        const bool has_next = S.next(ui + 1, nxt);
        const char* nA = has_next ? (const char*)g.A + (size_t)nxt.pm * tstep + (size_t)nxt.kt0 * kstep : cA; const char* nB = has_next ? (const char*)g.Bt + (size_t)nxt.pn * tstep + (size_t)nxt.kt0 * kstep : cB;
        const int nt = cur.nt;
        for (int t = 0; t < nt; t += 2) {
            const bool last = (t == nt - 2);
            const char* a1 = cA + (size_t)(t + 1) * kstep;
            const char* a2 = last ? nA : cA + (size_t)(t + 2) * kstep; const char* b2 = last ? nB : cB + (size_t)(t + 2) * kstep;
            const char* a3 = a2 + kstep; const char* b3 = b2 + kstep;
            if (last && has_next) S.a_ready(nxt);
            if constexpr (SP2) {
            PG8_LDB(B0, 0, 0); PG8_LDB(B1, 0, 1); PG8_SCHED; PG8_LDA(At, 0, 0); PG8_STAGE(PG8_SA(1, 1), a1 + hstep, voffA);
            PG8_WAIT_V(8); PG8_WAIT_L(0); PG8_BAR; PG8_MMA(0, 0, At, B0); PG8_MMA(0, 1, At, B1); PG8_BAR; PG8_SCHED;
            PG8_LDA(At, 0, 1); PG8_STAGE(PG8_SB(0, 0), b2, voffB); PG8_STAGE(PG8_SB(0, 1), b2 + hstep, voffB); PG8_STAGE(PG8_SA(0, 0), a2, voffA);
            PG8_WAIT_V(8); PG8_WAIT_L(0); PG8_BAR; PG8_MMA(1, 0, At, B0); PG8_MMA(1, 1, At, B1); PG8_BAR; PG8_SCHED;
            PG8_LDB(B0, 1, 0); PG8_LDB(B1, 1, 1); PG8_SCHED; PG8_LDA(At, 1, 0); PG8_STAGE(PG8_SA(0, 1), a2 + hstep, voffA);
            PG8_WAIT_V(8); PG8_WAIT_L(0); PG8_BAR; PG8_MMA(0, 0, At, B0); PG8_MMA(0, 1, At, B1); PG8_BAR; PG8_SCHED;
            PG8_LDA(At, 1, 1); PG8_STAGE(PG8_SB(1, 0), b3, voffB); PG8_STAGE(PG8_SB(1, 1), b3 + hstep, voffB); PG8_STAGE(PG8_SA(1, 0), a3, voffA);
            PG8_WAIT_V(8); PG8_WAIT_L(0); PG8_BAR; PG8_MMA(1, 0, At, B0); PG8_MMA(1, 1, At, B1); PG8_BAR; PG8_SCHED;
            } else {
            PG8_LDB(B0, 0, 0); PG8_SCHED; PG8_LDA(At, 0, 0); PG8_STAGE(PG8_SA(1, 1), a1 + hstep, voffA);
            PG8_WAIT_L(8); PG8_BAR; PG8_WAIT_L(0); PG8_MMA(0, 0, At, B0); PG8_BAR; PG8_SCHED;
            PG8_LDB(B1, 0, 1); PG8_STAGE(PG8_SB(0, 0), b2, voffB);
            PG8_BAR; PG8_WAIT_L(0); PG8_MMA(0, 1, At, B1); PG8_BAR;
            PG8_LDA(At, 0, 1); PG8_STAGE(PG8_SA(0, 0), a2, voffA);
            PG8_BAR; PG8_WAIT_L(0); PG8_MMA(1, 0, At, B0); PG8_BAR; PG8_SCHED;
            PG8_STAGE(PG8_SB(0, 1), b2 + hstep, voffB);
            PG8_WAIT_V(6); PG8_BAR; PG8_MMA(1, 1, At, B1); PG8_BAR;
            PG8_LDB(B0, 1, 0); PG8_SCHED; PG8_LDA(At, 1, 0); PG8_STAGE(PG8_SA(0, 1), a2 + hstep, voffA);
            PG8_WAIT_L(8); PG8_BAR; PG8_WAIT_L(0); PG8_MMA(0, 0, At, B0); PG8_BAR; PG8_SCHED;
            PG8_LDB(B1, 1, 1); PG8_STAGE(PG8_SB(1, 0), b3, voffB);
            PG8_BAR; PG8_WAIT_L(0); PG8_MMA(0, 1, At, B1); PG8_BAR;
            PG8_LDA(At, 1, 1); PG8_STAGE(PG8_SA(1, 0), a3, voffA);
            PG8_BAR; PG8_WAIT_L(0); PG8_MMA(1, 0, At, B0); PG8_BAR; PG8_SCHED;
            PG8_STAGE(PG8_SB(1, 1), b3 + hstep, voffB);
            PG8_WAIT_V(6); PG8_BAR; PG8_MMA(1, 1, At, B1); PG8_BAR;
            }
        }
        if constexpr (ALIGN_EPI) { if (wr == 0) PG8_BAR; }
        if constexpr (!Epi::AFTER_DRAIN) { E(acc, cur, wr, wc, fr, fq); S.done(cur); }
        if (!has_next) break;
#pragma unroll
        for (int a = 0; a < 2; ++a)
#pragma unroll
            for (int b = 0; b < 2; ++b)
#pragma unroll
                for (int m = 0; m < 4; ++m)
#pragma unroll
                    for (int n = 0; n < 2; ++n) acc[a][b][m][n] = (f32x4){0.f, 0.f, 0.f, 0.f};
        cur = nxt; cA = nA; cB = nB; ++ui;
        if constexpr (ALIGN_EPI) { if (wr == 1) PG8_BAR; }
    }
    PG8_WAIT_V(0);
    if constexpr (!ALIGN_EPI) { if (wr == 0) PG8_BAR; }
    PG8_BAR;
    if constexpr (Epi::AFTER_DRAIN) { E.fused(acc, cur, wr, wc, fr, fq, lds, wid, lane); S.done(cur); }
#undef PG8_SA
#undef PG8_SB
#undef PG8_STAGE
#undef PG8_LDA
#undef PG8_LDB
#undef PG8_MMA
#undef PG8_WAIT_V
#undef PG8_WAIT_L
#undef PG8_BAR
#undef PG8_SCHED
}
}

constexpr int NWAVES = 8;
constexpr int D = 1024, FF = 4096, M_CTX = 4096, M_LAT = 16384, M = M_CTX + M_LAT;
constexpr int L_LAT = 2048, L_CTX = 256, PAST = 256, LKV = PAST + L_LAT;
constexpr int MKV = M_CTX + 8 * LKV;
constexpr int EVEN_N = 3104, EVEN_NP = 3328, ODD_N = 576, ODD_NP = 768;
constexpr float EPS = 1e-6f;
constexpr int PC_QA = 0, PC_KA = 256, PC_VA = 512, PC_GA = 1024, PC_QB = 1536, PC_KB = 1792, PC_VB = 2048, PC_GB = 2560, PC_GK = 3072;
constexpr size_t OUT_Y = 0, OUT_CKV = 20971520, OUT_KPE = 23068672, OUT_SGLA = 23592960, OUT_SRET = 25690112;

constexpr size_t MiB = 1u << 20;
constexpr size_t WS_CTL = 0, CTL_ZERO_BYTES = 64 * 1024;
constexpr size_t WS_MOD = 1 * MiB;
constexpr size_t WS_ROPE = 2 * MiB;
constexpr size_t WS_KPE = 3 * MiB;
constexpr size_t WS_ACKV = 6 * MiB;
constexpr size_t WS_WINE = 18 * MiB;
constexpr size_t WS_WOUTE = 31 * MiB;
constexpr size_t WS_WINO = 35 * MiB;
constexpr size_t WS_WQB = 38 * MiB;
constexpr size_t WS_WKVB = 40 * MiB;
constexpr size_t WS_WOUTO = 42 * MiB;
constexpr size_t WS_W1 = 46 * MiB;
constexpr size_t WS_W2 = 78 * MiB;
constexpr size_t WS_HB = 110 * MiB;
constexpr size_t WS_Y = 150 * MiB;
constexpr size_t WS_BIG = 190 * MiB;
constexpr size_t WS_Q = WS_BIG, WS_KV = WS_BIG + 60 * MiB, WS_QN = WS_BIG + 148 * MiB;
constexpr size_t WS_SLAB = 350 * MiB;
constexpr size_t WS_END = 382 * MiB;

constexpr int RING_BYTES = 131072;
constexpr int LDS_MISC = 155648;
constexpr int LDS_BYTES = 163840;

#define GAS __attribute__((address_space(1)))
#define LAS __attribute__((address_space(3)))
typedef unsigned short bf16;
typedef unsigned v4u __attribute__((ext_vector_type(4)));
typedef unsigned v2u __attribute__((ext_vector_type(2)));
typedef float f32x4 __attribute__((ext_vector_type(4)));
typedef float f32x16 __attribute__((ext_vector_type(16)));
typedef short bf16x8 __attribute__((ext_vector_type(8)));
typedef short s16x4 __attribute__((ext_vector_type(4)));
#define LDS_WAIT() asm volatile("s_waitcnt lgkmcnt(0)" ::: "memory")
#define VM_WAIT() asm volatile("s_waitcnt vmcnt(0)" ::: "memory")
typedef float f32x2_t __attribute__((ext_vector_type(2))); typedef __bf16 bf16x2_t __attribute__((ext_vector_type(2)));
__device__ __forceinline__ unsigned pk2(float lo, float hi) { f32x2_t v = {lo, hi}; bf16x2_t b = __builtin_convertvector(v, bf16x2_t); return __builtin_bit_cast(unsigned, b); }
__device__ __forceinline__ unsigned f2bf(float f) { return pk2(f, f) & 0xffffu; }
__device__ __forceinline__ float bflo(unsigned w) { return __builtin_bit_cast(float, w << 16); }
__device__ __forceinline__ float bfhi(unsigned w) { return __builtin_bit_cast(float, w & 0xffff0000u); }
__device__ __forceinline__ float wave_sum(float v) {
#pragma unroll
    for (int o = 1; o < 64; o <<= 1) v += __shfl_xor(v, o);
    return v;
}
__device__ __forceinline__ float siluf(float x) { return x * __builtin_amdgcn_rcpf(1.0f + __expf(-x)); }

#define XB_TMO      128
#define XB_XCNT(j)  (256  + 64 * (j))
#define XB_XSUB(j)  (1280 + 64 * (j))
#define XB_XGEN(j)  (2304 + 64 * (j))
#define XB_TOP      3328
#define XB_TOPGEN   3392
#define XCD_BAR_WORDS 3456
#define XB_SPIN_CAP (1u << 20)
__device__ __forceinline__ unsigned xb_ld(unsigned* p)              { return __hip_atomic_load(p, __ATOMIC_RELAXED, __HIP_MEMORY_SCOPE_AGENT); }
__device__ __forceinline__ unsigned xb_add(unsigned* p, unsigned v) { return __hip_atomic_fetch_add(p, v, __ATOMIC_RELAXED, __HIP_MEMORY_SCOPE_AGENT); }
__device__ __forceinline__ unsigned xb_xcc_id() { return (unsigned)__builtin_amdgcn_s_getreg((3 << 11) | 20) & 0xFu; }
#define XB_SPIN(cond, bar) do { unsigned _sp = 0; while (cond) { __builtin_amdgcn_s_sleep(1); \
    if ((++_sp & 255u) == 0u) { if (xb_ld(&(bar)[XB_TMO])) break; if (_sp > XB_SPIN_CAP) { atomicAdd(&(bar)[XB_TMO], 1u); break; } } } } while (0)
struct XcdBarrier { unsigned* bar; unsigned x; volatile LAS unsigned* st; };
__device__ __forceinline__ XcdBarrier xcd_barrier_post(unsigned* bar, volatile LAS unsigned* st) {
    XcdBarrier b; b.bar = bar; b.x = xb_xcc_id(); b.st = st;
    if (threadIdx.x == 0) (void)xb_add(&bar[XB_XCNT(b.x)], 1u);
    return b;
}
__device__ __forceinline__ void xcd_barrier_complete(unsigned* bar, unsigned x, unsigned& nloc, unsigned& nx) {
    const unsigned G = gridDim.x * gridDim.y * gridDim.z;
    unsigned sum, cnt, mine, sp = 0u;
    for (;;) {
        sum = 0u; cnt = 0u; mine = 0u;
#pragma unroll
        for (unsigned j = 0; j < 16; ++j) { const unsigned c = xb_ld(&bar[XB_XCNT(j)]); sum += c; cnt += (c > 0u) ? 1u : 0u; mine = (j == x) ? c : mine; }
        if (sum == G) break;
        __builtin_amdgcn_s_sleep(1);
        if ((++sp & 255u) == 0u) { if (xb_ld(&bar[XB_TMO])) break; if (sp > XB_SPIN_CAP) { atomicAdd(&bar[XB_TMO], 1u); break; } }
    }
    nloc = mine > 0u ? mine : 1u; nx = cnt > 0u ? cnt : 1u;
}
__device__ __forceinline__ void xcd_barrier(const XcdBarrier& b) {
    asm volatile("s_waitcnt vmcnt(0)" ::: "memory");
    __syncthreads();
    if (threadIdx.x == 0) {
        unsigned* bar = b.bar;
        __builtin_amdgcn_s_waitcnt(0);
        unsigned nloc = b.st[0], nx = b.st[1];
        if (nloc == 0u) { xcd_barrier_complete(bar, b.x, nloc, nx); b.st[0] = nloc; b.st[1] = nx; }
        const unsigned old = xb_add(&bar[XB_XSUB(b.x)], 1u);
        const unsigned gen = old / nloc;
        if (old + 1u == (gen + 1u) * nloc) {
            __builtin_amdgcn_fence(__ATOMIC_RELEASE, "agent");
            asm volatile("s_waitcnt vmcnt(0)" ::: "memory");
            const unsigned og = xb_add(&bar[XB_TOP], 1u);
            const unsigned tg = og / nx;
            if (og + 1u == (tg + 1u) * nx) xb_add(&bar[XB_TOPGEN], 1u);
            else XB_SPIN(xb_ld(&bar[XB_TOPGEN]) == tg, bar);
            __builtin_amdgcn_fence(__ATOMIC_ACQUIRE, "agent");
            xb_add(&bar[XB_XGEN(b.x)], 1u);
            asm volatile("s_waitcnt vmcnt(0)" ::: "memory");
        } else {
            XB_SPIN(xb_ld(&bar[XB_XGEN(b.x)]) == gen, bar);
            __builtin_amdgcn_fence(__ATOMIC_ACQUIRE, "agent");
            asm volatile("s_waitcnt vmcnt(0)" ::: "memory");
        }
    }
    __syncthreads();
}

struct Params { const float* in[28]; float* out; unsigned char* ws; int ph_lo, ph_hi, use_bar, pad; };
enum { I_XP = 0, I_XS, I_CCKV, I_CKPE, I_SGLA, I_SRET, I_C, I_CCTX, I_WADA, I_BADA, I_NMIXPRE, I_NMIXPOST, I_NMLPPRE, I_NMLPPOST,
       I_WINE, I_WGK2, I_BGK2, I_GLAN, I_RDEC, I_WOUTE, I_WINO, I_QAN, I_WQB, I_KVAN, I_WKVB, I_WOUTO, I_W1, I_W2 };
struct Frame { LAS unsigned char* lds; int tid, lane, wave, vcu, G, bid; };
constexpr int LDS_PT = LDS_MISC + 256;
__device__ __forceinline__ const void* ldp(LAS unsigned char* lds, int i) {
    const volatile LAS unsigned* p = (const volatile LAS unsigned*)(lds + LDS_PT) + 2 * i;
    const unsigned lo = __builtin_amdgcn_readfirstlane(p[0]), hi = __builtin_amdgcn_readfirstlane(p[1]);
    return (const void*)(const GAS void*)(((unsigned long long)hi << 32) | lo);
}
#define PIN(i) ((const float*)ldp(F.lds, (i)))
#define POUT ((float*)ldp(F.lds, 28))
#define PWS ((unsigned char*)ldp(F.lds, 29))

__device__ __forceinline__ void p0_transpose_item(const float* W, int K, int N, bf16* WT, int kb, int n0, int dn0, LAS float* scr, int lane) {
    const int k0 = 64 * kb;
#pragma unroll 8
    for (int i = 0; i < 32; ++i) { const int kk = 2 * i + (lane >> 5); scr[kk * 33 + (lane & 31)] = W[(size_t)(k0 + kk) * N + n0 + (lane & 31)]; }
    LDS_WAIT(); asm volatile("" ::: "memory");
    const int c = lane & 7;
#pragma unroll
    for (int j = 0; j < 4; ++j) { const int n = (lane >> 3) + 8 * j; const LAS float* s = scr + (8 * c) * 33 + n;
        v4u o; o.x = pk2(s[0 * 33], s[1 * 33]); o.y = pk2(s[2 * 33], s[3 * 33]); o.z = pk2(s[4 * 33], s[5 * 33]); o.w = pk2(s[6 * 33], s[7 * 33]);
        *(GAS v4u*)(WT + (size_t)(dn0 + n) * K + k0 + 8 * c) = o; }
    LDS_WAIT(); asm volatile("" ::: "memory");
}
__device__ __forceinline__ int even_col_map(int n0) { return n0 < 1536 ? n0 : (n0 < 1568 ? 3072 + (n0 - 1536) : n0 - 32); }

__device__ __forceinline__ void setup_work(Frame& F, const Params& P, int wgi, int nwg, int lmask, int emask, int omask) {
    unsigned char* ws = PWS;
    LAS float* scr = (LAS float*)(F.lds + F.wave * 16384);
    __syncthreads();
    {
        LAS float* S = (LAS float*)(F.lds);
        LAS float* R = (LAS float*)(F.lds + 40960);
        { const float* cp_ = PIN(I_C); const float* cc_ = PIN(I_CCTX);
          for (int i = F.tid; i < 9 * 1024; i += 512) { const int n = i >> 10, d = i & 1023; const float cv = n < 8 ? cp_[n * 1024 + d] : cc_[d]; S[i] = siluf(cv); } }
        const float* wada_ = PIN(I_WADA); const float* bada_ = PIN(I_BADA);
        __syncthreads();
        const int nl = __builtin_popcount(lmask);
        for (int uu = wgi; uu < nl * 64; uu += nwg) {
            int li_ = uu >> 6, l = 0; { int m_ = lmask; for (int k_ = 0; k_ < 4; ++k_) { if (m_ & 1) { if (li_ == 0) { l = k_; break; } --li_; } m_ >>= 1; } }
            const int cb = (uu & 63) * 96;
            if (F.tid < 384) {
                const int c4 = (F.tid % 24) * 4, part = F.tid / 24;
                const float* Wp = wada_ + ((size_t)l * 1024 + part * 64) * 6144 + cb + c4;
                f32x4 a[9];
#pragma unroll
                for (int n = 0; n < 9; ++n) a[n] = (f32x4){0.f, 0.f, 0.f, 0.f};
#pragma unroll 4
                for (int d = 0; d < 64; ++d) { const f32x4 w = *(const f32x4*)(Wp + (size_t)d * 6144);
#pragma unroll
                    for (int n = 0; n < 9; ++n) a[n] += w * S[n * 1024 + part * 64 + d]; }
#pragma unroll
                for (int n = 0; n < 9; ++n) *(LAS f32x4*)(R + (part * 9 + n) * 96 + c4) = a[n];
            }
            __syncthreads();
            for (int i = F.tid; i < 9 * 96; i += 512) { const int n = i / 96, c = i % 96; float s = 0.f;
#pragma unroll
                for (int p = 0; p < 16; ++p) s += R[(p * 9 + n) * 96 + c];
                ((float*)(ws + WS_MOD))[((size_t)l * 9 + n) * 6144 + cb + c] = s + bada_[l * 6144 + cb + c]; }
            __syncthreads();
        }
    }
    {
        const int wk = wgi * NWAVES + F.wave, NW = nwg * NWAVES; int base = 0;
#define SEG(sel, count, ...) do { if (sel) { for (int q = (wk + NW - base % NW) % NW; q < (count); q += NW) { __VA_ARGS__; } base += (count); } } while (0)
        const int I_E = (1024 / 64) * (EVEN_N / 32), I_OE = 16 * 32, I_O = 16 * (ODD_N / 32), I_QB = 4 * 48, I_KVB = 4 * 64, I_M1 = 16 * 128, I_M2 = 64 * 32;
#pragma unroll
        for (int l = 0; l < 2; ++l) {
            SEG((emask >> l) & 1, I_E, { const int nb = EVEN_N / 32, kb = q / nb, n0 = (q % nb) * 32;
                p0_transpose_item(PIN(I_WINE) + (size_t)l * 1024 * EVEN_N, 1024, EVEN_N, (bf16*)(ws + WS_WINE) + (size_t)l * EVEN_NP * 1024, kb, n0, even_col_map(n0), scr, F.lane); });
            SEG((emask >> l) & 1, I_OE, { const int kb = q / 32, n0 = (q % 32) * 32;
                p0_transpose_item(PIN(I_WOUTE) + (size_t)l * 1024 * 1024, 1024, 1024, (bf16*)(ws + WS_WOUTE) + (size_t)l * 1024 * 1024, kb, n0, n0, scr, F.lane); });
            SEG((omask >> l) & 1, I_O, { const int nb = ODD_N / 32, kb = q / nb, n0 = (q % nb) * 32;
                p0_transpose_item(PIN(I_WINO) + (size_t)l * 1024 * ODD_N, 1024, ODD_N, (bf16*)(ws + WS_WINO) + (size_t)l * ODD_NP * 1024, kb, n0, n0, scr, F.lane); });
            SEG((omask >> l) & 1, I_QB, { const int kb = q / 48, n0 = (q % 48) * 32;
                p0_transpose_item(PIN(I_WQB) + (size_t)l * 256 * 1536, 256, 1536, (bf16*)(ws + WS_WQB) + (size_t)l * 1536 * 256, kb, n0, n0, scr, F.lane); });
            SEG((omask >> l) & 1, I_KVB, { const int kb = q / 64, n0 = (q % 64) * 32;
                p0_transpose_item(PIN(I_WKVB) + (size_t)l * 256 * 2048, 256, 2048, (bf16*)(ws + WS_WKVB) + (size_t)l * 2048 * 256, kb, n0, n0, scr, F.lane); });
            SEG((omask >> l) & 1, I_OE, { const int kb = q / 32, n0 = (q % 32) * 32;
                p0_transpose_item(PIN(I_WOUTO) + (size_t)l * 1024 * 1024, 1024, 1024, (bf16*)(ws + WS_WOUTO) + (size_t)l * 1024 * 1024, kb, n0, n0, scr, F.lane); });
        }
#pragma unroll
        for (int l = 0; l < 4; ++l) {
            SEG((lmask >> l) & 1, I_M1, { const int kb = q / 128, n0 = (q % 128) * 32;
                p0_transpose_item(PIN(I_W1) + (size_t)l * 1024 * 4096, 1024, 4096, (bf16*)(ws + WS_W1) + (size_t)l * 4096 * 1024, kb, n0, n0, scr, F.lane); });
            SEG((lmask >> l) & 1, I_M2, { const int kb = q / 32, n0 = (q % 32) * 32;
                p0_transpose_item(PIN(I_W2) + (size_t)l * 4096 * 1024, 4096, 1024, (bf16*)(ws + WS_W2) + (size_t)l * 1024 * 4096, kb, n0, n0, scr, F.lane); });
        }
#undef SEG
    }
    const int gt = wgi * 512 + F.tid, NGT = nwg * 512;
#pragma unroll
    for (int l = 0; l < 2; ++l) {
        if ((emask >> l) & 1) for (int i = gt; i < 224 * 128; i += NGT) *(GAS v4u*)((bf16*)(ws + WS_WINE) + ((size_t)l * EVEN_NP + EVEN_N) * 1024 + (size_t)i * 8) = (v4u){0u, 0u, 0u, 0u};
        if ((omask >> l) & 1) for (int i = gt; i < 192 * 128; i += NGT) *(GAS v4u*)((bf16*)(ws + WS_WINO) + ((size_t)l * ODD_NP + ODD_N) * 1024 + (size_t)i * 8) = (v4u){0u, 0u, 0u, 0u};
    }
}
__device__ __forceinline__ void p0_prologue(Frame& F, const Params& P) {
    unsigned char* ws = PWS;
    setup_work(F, P, F.vcu, F.G, 0x5, 0x3, 0x0);
    const int gt = F.vcu * 512 + F.tid, NGT = F.G * 512;
    for (int i = gt; i < 2048 * 32; i += NGT) { const int t = i >> 5, j = i & 31; const float inv = powf(10000.0f, -(float)(j & 15) / 16.0f);
        const float ang = (float)(j < 16 ? (t >> 6) : (t & 63)) * inv;
        ((float*)(ws + WS_ROPE))[i] = cosf(ang); ((float*)(ws + WS_ROPE))[65536 + i] = sinf(ang); }
}

__device__ __forceinline__ void row_y(f32x4 (&yv)[4], const bf16* Y, const bf16* SL, int row, int l4) {
    if (row < 16384) {
#pragma unroll
        for (int j = 0; j < 4; ++j) { const v2u yw = *(const v2u*)(Y + (size_t)row * D + l4 + 256 * j); yv[j] = (f32x4){bflo(yw.x), bfhi(yw.x), bflo(yw.y), bfhi(yw.y)}; }
    } else {
        const bf16* sp = SL + (size_t)(row - 16384) * D + l4;
#pragma unroll
        for (int j = 0; j < 4; ++j) { const v2u w0 = *(const v2u*)(sp + 256 * j), w1 = *(const v2u*)(sp + 4194304 + 256 * j), w2 = *(const v2u*)(sp + 2 * 4194304 + 256 * j), w3 = *(const v2u*)(sp + 3 * 4194304 + 256 * j);
            yv[j] = ((f32x4){bflo(w0.x), bfhi(w0.x), bflo(w0.y), bfhi(w0.y)} + (f32x4){bflo(w1.x), bfhi(w1.x), bflo(w1.y), bfhi(w1.y)}) +
                    ((f32x4){bflo(w2.x), bfhi(w2.x), bflo(w2.y), bfhi(w2.y)} + (f32x4){bflo(w3.x), bfhi(w3.x), bflo(w3.y), bfhi(w3.y)}); }
    }
}
struct RowVec { f32x4 gp[4], gt[4], gq[4], sc[4], sh[4]; };
__device__ __forceinline__ void row_post(f32x4 (&v)[4], const f32x4 (&yv)[4], const RowVec& R) {
    float s = 0.f;
#pragma unroll
    for (int j = 0; j < 4; ++j) s += (yv[j][0] * yv[j][0] + yv[j][1] * yv[j][1]) + (yv[j][2] * yv[j][2] + yv[j][3] * yv[j][3]);
    const float rstd = __builtin_amdgcn_rsqf(wave_sum(s) * (1.0f / 1024.0f) + EPS);
#pragma unroll
    for (int j = 0; j < 4; ++j) v[j] = v[j] + R.gt[j] * ((yv[j] * rstd) * R.gp[j]);
}
__device__ __forceinline__ void row_pass(Frame& F, const float* xa, const float* xb, bool xin_f32, bf16* XB, const bf16* Y, const bf16* SL, const float* g_post, const float* gate,
                                         const float* g_pre, const float* scale, const float* shift, bf16* H, bool has_post, bool has_pre) {
    const int gw = F.vcu * NWAVES + F.wave, NGW = F.G * NWAVES, l4 = F.lane * 4;
    RowVec R; int ncur = -1;
#pragma unroll
    for (int j = 0; j < 4; ++j) { R.gp[j] = has_post ? *(const f32x4*)(g_post + l4 + 256 * j) : (f32x4){0.f, 0.f, 0.f, 0.f}; R.gq[j] = has_pre ? *(const f32x4*)(g_pre + l4 + 256 * j) : (f32x4){0.f, 0.f, 0.f, 0.f};
        R.gt[j] = R.gp[j]; R.sc[j] = R.gp[j]; R.sh[j] = R.gp[j]; }
    for (int blk = gw; blk * 10 < M; blk += NGW) for (int i = 0; i < 10; i += 2) {
        const int row0 = blk * 10 + i; if (row0 >= M) break;
        const int n = row0 < M_CTX ? 8 : ((row0 - M_CTX) >> 11);
        if (n != ncur) { ncur = n;
#pragma unroll
            for (int j = 0; j < 4; ++j) { const int c = l4 + 256 * j;
                if (has_post) R.gt[j] = *(const f32x4*)(gate + (size_t)n * 6144 + c);
                if (has_pre) { R.sc[j] = *(const f32x4*)(scale + (size_t)n * 6144 + c); R.sh[j] = *(const f32x4*)(shift + (size_t)n * 6144 + c); } } }
        f32x4 v[2][4], yv[2][4];
#pragma unroll
        for (int q = 0; q < 2; ++q) { const int row = row0 + q;
            if (xin_f32) { const float* xr = row < M_CTX ? xa + (size_t)row * D : xb + (size_t)(row - M_CTX) * D;
#pragma unroll
                for (int j = 0; j < 4; ++j) v[q][j] = *(const f32x4*)(xr + l4 + 256 * j);
            } else {
#pragma unroll
                for (int j = 0; j < 4; ++j) { const v2u xw = *(const v2u*)(XB + (size_t)row * D + l4 + 256 * j); v[q][j] = (f32x4){bflo(xw.x), bfhi(xw.x), bflo(xw.y), bfhi(xw.y)}; }
            }
            if (has_post) row_y(yv[q], Y, SL, row, l4); }
#pragma unroll
        for (int q = 0; q < 2; ++q) { const int row = row0 + q;
            if (has_post) {
                row_post(v[q], yv[q], R);
#pragma unroll
                for (int j = 0; j < 4; ++j) *(v2u*)(XB + (size_t)row * D + l4 + 256 * j) = (v2u){pk2(v[q][j][0], v[q][j][1]), pk2(v[q][j][2], v[q][j][3])};
            }
            if (has_pre) {
                float s = 0.f;
#pragma unroll
                for (int j = 0; j < 4; ++j) s += (v[q][j][0] * v[q][j][0] + v[q][j][1] * v[q][j][1]) + (v[q][j][2] * v[q][j][2] + v[q][j][3] * v[q][j][3]);
                const float rstd = __builtin_amdgcn_rsqf(wave_sum(s) * (1.0f / 1024.0f) + EPS);
#pragma unroll
                for (int j = 0; j < 4; ++j) { const f32x4 h = ((v[q][j] * rstd) * R.gq[j]) * (1.0f + R.sc[j]) + R.sh[j];
                    *(v2u*)(H + (size_t)row * D + l4 + 256 * j) = (v2u){pk2(h[0], h[1]), pk2(h[2], h[3])}; }
            } }
    }
}
__device__ __forceinline__ void row_pass_final(Frame& F, const XcdBarrier& bar, const bf16* XB, float* OUT, const bf16* Y, const bf16* SL, const float* g_post, const float* gate) {
    const int gw = F.vcu * NWAVES + F.wave, l4 = F.lane * 4;
    v2u xw[10][4];
#pragma unroll
    for (int i = 0; i < 10; ++i) { const int row = gw * 10 + i;
        if (row < M) {
#pragma unroll
            for (int j = 0; j < 4; ++j) xw[i][j] = *(const v2u*)(XB + (size_t)row * D + l4 + 256 * j);
        } }
    xcd_barrier(bar);
    RowVec R; int ncur = -1;
#pragma unroll
    for (int j = 0; j < 4; ++j) { R.gp[j] = *(const f32x4*)(g_post + l4 + 256 * j); R.gt[j] = R.gp[j]; }
#pragma unroll
    for (int i = 0; i < 10; ++i) { const int row = gw * 10 + i;
        if (row < M) {
            const int n = row < M_CTX ? 8 : ((row - M_CTX) >> 11);
            if (n != ncur) { ncur = n;
#pragma unroll
                for (int j = 0; j < 4; ++j) R.gt[j] = *(const f32x4*)(gate + (size_t)n * 6144 + l4 + 256 * j); }
            f32x4 v[4], yv[4];
#pragma unroll
            for (int j = 0; j < 4; ++j) v[j] = (f32x4){bflo(xw[i][j].x), bfhi(xw[i][j].x), bflo(xw[i][j].y), bfhi(xw[i][j].y)};
            row_y(yv, Y, SL, row, l4); row_post(v, yv, R);
#pragma unroll
            for (int j = 0; j < 4; ++j) *(f32x4*)(OUT + (size_t)row * D + l4 + 256 * j) = v[j];
        } }
}

__device__ __forceinline__ int crow(int r, int hi) { return (r & 3) + 8 * (r >> 2) + 4 * hi; }
__device__ __forceinline__ unsigned cvtpk(float lo, float hi) { return pk2(lo, hi); }
#define SBAR() __builtin_amdgcn_sched_barrier(0)
__device__ __forceinline__ int vst_row(int k, int NB) { const int kk = (k & ~0xC) | ((k & 4) << 1) | ((k & 8) >> 1); return (kk >> 3) * NB * 512 + (kk & 7) * 64; }
__device__ __forceinline__ int vst(int k, int c, int NB) { return vst_row(k, NB) + (c >> 5) * 512 + (c & 31) * 2; }
__device__ __forceinline__ int v_rd_base(int lane) { return ((lane & 3) << 3) | (((lane >> 2) & 3) << 6) | (((lane >> 4) & 1) << 5) | (((lane >> 5) & 1) << 8); }
template <int OFF> __device__ __forceinline__ s16x4 tr_read(unsigned vb) { s16x4 r; asm volatile("ds_read_b64_tr_b16 %0, %1 offset:%2" : "=&v"(r) : "v"(vb), "i"(OFF) : "memory"); return r; }
#define PKF(L, H) ((bf16x8){L[0], L[1], L[2], L[3], H[0], H[1], H[2], H[3]})
#define PK4(P, BASE, OUT) do { unsigned a0_ = cvtpk(P[BASE + 0], P[BASE + 1]), a1_ = cvtpk(P[BASE + 2], P[BASE + 3]);   \
    unsigned b0_ = cvtpk(P[BASE + 4], P[BASE + 5]), b1_ = cvtpk(P[BASE + 6], P[BASE + 7]);                              \
    auto r0_ = __builtin_amdgcn_permlane32_swap(a0_, b0_, false, false); auto r1_ = __builtin_amdgcn_permlane32_swap(a1_, b1_, false, false); \
    v4u w_ = {r0_[0], r1_[0], r0_[1], r1_[1]}; OUT = __builtin_bit_cast(bf16x8, w_); } while (0)
__device__ __forceinline__ float fexp(float x) { return __builtin_amdgcn_exp2f(x * 1.4426950408889634f); }
__device__ __forceinline__ float logsig(float x) { return fminf(x, 0.f) - 0.6931471805599453f * __builtin_amdgcn_logf(1.0f + __builtin_amdgcn_exp2f(-1.4426950408889634f * fabsf(x))); }

constexpr int SC_QD = 0, SC_KI = 8192, SC_VT = 16384, SC_ST = 32768, SC_BT = 49152, SC_GK = 65536, SC_TOT = 69632, SC_DL = 71680, SC_W2 = 71936;
__device__ __forceinline__ void scan_phase(Frame& F, const Params& P, int li) {
    unsigned char* ws = PWS;
    const bf16* PROJ = (const bf16*)(ws + WS_BIG);
    const float* ROPE = (const float*)(ws + WS_ROPE);
    LAS unsigned char* G = F.lds;
    const unsigned gaddr = (unsigned)(uintptr_t)G;
    const int ri = F.wave >> 2, dq = F.wave & 3;
    for (int u0 = F.bid; u0 < 256; u0 += F.G) for (int kk_ = 0; kk_ < (u0 < 128 ? 1 : 2); ++kk_) {
        __syncthreads();
        const bool lat = u0 < 128; const int u = lat ? u0 : 2 * (u0 - 128) + kk_;
        const int sb = u >> 4, hh = (u >> 1) & 7, dir = u & 1;
        const int L = lat ? L_LAT : L_CTX, row0 = lat ? M_CTX + sb * L_LAT : sb * L_CTX, NC = L / 64;
        const bool gla = hh < 4; const int h = hh & 3;
        const int qc = (gla ? PC_QA : PC_QB) + h * 64, kc = (gla ? PC_KA : PC_KB) + h * 64, vc = (gla ? PC_VA : PC_VB) + h * 128, gkc = PC_GK + dir * 16;
        bf16* OUT = (bf16*)(ws + (dir == 0 ? WS_Y : WS_HB));
        const float* rdec_p = PIN(I_RDEC); const float* wgk2_p = PIN(I_WGK2); const float* bgk2_p = PIN(I_BGK2);
        const float lgr = gla ? 0.f : -fexp(rdec_p[(li * 2 + dir) * 4 + h]);
        f32x16 sacc; v4u w2f = {0u, 0u, 0u, 0u}; float gbias = 0.f;
        { int t0_ = F.tid; asm volatile("" : "+v"(t0_)); const int lane = t0_ & 63, r32 = lane & 31, hi = lane >> 5;
          if (gla && F.wave < 4) { const int kcol = h * 64 + 32 * (F.wave & 1) + r32; const float* wp_ = wgk2_p + ((size_t)(li * 2 + dir) * 16 + 8 * hi) * 256 + kcol;
              w2f = (v4u){pk2(wp_[0], wp_[256]), pk2(wp_[512], wp_[768]), pk2(wp_[1024], wp_[1280]), pk2(wp_[1536], wp_[1792])};
              gbias = bgk2_p[(li * 2 + dir) * 256 + kcol]; }
          if (!gla && t0_ < 64) ((LAS float*)(G + SC_DL))[t0_] = fexp(64.0f * lgr);
          const float* S0 = (gla ? PIN(I_SGLA) : PIN(I_SRET)) + ((size_t)((sb * 2 + li) * 2 + dir) * 4 + h) * 8192;
          if (lat) {
#pragma unroll
              for (int r = 0; r < 16; ++r) sacc[r] = S0[(32 * ri + crow(r, hi)) * 128 + 32 * dq + r32];
          } else sacc = f32x16{};
#pragma unroll
          for (int r = 0; r < 16; r += 2) { const unsigned w = pk2(sacc[r], sacc[r + 1]);
              LAS unsigned char* sp_ = G + SC_ST + (hi + 4 * ri) * 2048 + dq * 512 + r32 * 2 + ((r >> 3) & 1) * 4096 + ((r & 3) + 4 * ((r >> 2) & 1)) * 64;
              *(LAS unsigned short*)sp_ = (unsigned short)w; *(LAS unsigned short*)(sp_ + 64) = (unsigned short)(w >> 16); } }
        v2u pq0, pq1, pk0, pk1; v4u pv0, pv1; v4u pga = {0u, 0u, 0u, 0u};
#define SC_TOK(s, i) (dir == 0 ? 64 * (s) + (i) : L - 1 - (64 * (s) + (i)))
#define SC_LOAD(s) do { const unsigned ro_ = (unsigned)(row0 + SC_TOK(s, sti)) * (unsigned)(EVEN_NP * 2); const char* pc_ = (const char*)PROJ; \
        pq0 = *(const v2u*)(pc_ + (ro_ + (unsigned)(qc + 4 * c4) * 2u)); pq1 = *(const v2u*)(pc_ + (ro_ + (unsigned)(qc + 32 + 4 * c4) * 2u)); \
        pk0 = *(const v2u*)(pc_ + (ro_ + (unsigned)(kc + 4 * c4) * 2u)); pk1 = *(const v2u*)(pc_ + (ro_ + (unsigned)(kc + 32 + 4 * c4) * 2u)); \
        pv0 = *(const v4u*)(pc_ + (ro_ + (unsigned)(vc + 16 * c4) * 2u)); pv1 = *(const v4u*)(pc_ + (ro_ + (unsigned)(vc + 16 * c4 + 8) * 2u)); \
        if (gla && F.wave < 4) pga = *(const v4u*)(pc_ + ((unsigned)(row0 + SC_TOK(s, 32 * (F.wave >> 1) + (lane & 31))) * (unsigned)(EVEN_NP * 2) + (unsigned)(gkc + 8 * (lane >> 5)) * 2u)); } while (0)
        { int t0_ = F.tid; asm volatile("" : "+v"(t0_)); const int sti = t0_ >> 3, c4 = t0_ & 7, lane = t0_ & 63; SC_LOAD(0); }
        for (int s = 0; s < NC; ++s) {
            int tid_o = F.tid; asm volatile("" : "+v"(tid_o));
            const int lane = tid_o & 63, r32 = lane & 31, hi = lane >> 5, sti = tid_o >> 3, c4 = tid_o & 7;
            const int tok = SC_TOK(s, sti);
            if (gla) {
                __syncthreads();
                float cs[16]; float tsum = 0.f; const int th = F.wave >> 1, kq = 32 * (F.wave & 1) + r32;
                if (F.wave < 4) {
                    f32x16 gp;
#pragma unroll
                    for (int r = 0; r < 16; ++r) gp[r] = gbias;
                    gp = __builtin_amdgcn_mfma_f32_32x32x16_bf16(__builtin_bit_cast(bf16x8, pga), __builtin_bit_cast(bf16x8, w2f), gp, 0, 0, 0);
                    float g4[4], o4[4];
#pragma unroll
                    for (int j = 0; j < 4; ++j) { float run = 0.f;
#pragma unroll
                        for (int e = 0; e < 4; ++e) { run += logsig(gp[4 * j + e]) * (1.0f / 16.0f); cs[4 * j + e] = run; }
                        g4[j] = run; }
#pragma unroll
                    for (int j = 0; j < 4; ++j) o4[j] = __shfl_xor(g4[j], 32);
                    float acc_ = 0.f;
#pragma unroll
                    for (int j = 0; j < 4; ++j) { const float off = acc_ + (hi ? o4[j] : 0.f);
#pragma unroll
                        for (int e = 0; e < 4; ++e) cs[4 * j + e] += off;
                        acc_ += g4[j] + o4[j]; }
                    tsum = acc_;
                    if (hi == 0) ((LAS float*)(G + SC_TOT))[th * 64 + kq] = tsum;
                }
                LDS_WAIT(); __syncthreads();
                if (F.wave < 4) {
                    const float t0v = ((LAS float*)(G + SC_TOT))[kq]; const float pre = th ? t0v : 0.f;
#pragma unroll
                    for (int r = 0; r < 16; ++r) ((LAS float*)(G + SC_BT))[(32 * th + crow(r, hi)) * 64 + kq] = pre + cs[r];
                    if (th == 1 && hi == 0) ((LAS float*)(G + SC_DL))[kq] = fexp(pre + tsum);
                }
                LDS_WAIT(); __syncthreads();
            } else { __syncthreads(); }
            {
                float q[8], kk[8];
                q[0] = bflo(pq0.x); q[1] = bfhi(pq0.x); q[2] = bflo(pq0.y); q[3] = bfhi(pq0.y); q[4] = bflo(pq1.x); q[5] = bfhi(pq1.x); q[6] = bflo(pq1.y); q[7] = bfhi(pq1.y);
                kk[0] = bflo(pk0.x); kk[1] = bfhi(pk0.x); kk[2] = bflo(pk0.y); kk[3] = bfhi(pk0.y); kk[4] = bflo(pk1.x); kk[5] = bfhi(pk1.x); kk[6] = bflo(pk1.y); kk[7] = bfhi(pk1.y);
                if (gla) {
                    const f32x4 x0 = *(const LAS f32x4*)((LAS float*)(G + SC_BT) + sti * 64 + 4 * c4), x1 = *(const LAS f32x4*)((LAS float*)(G + SC_BT) + sti * 64 + 32 + 4 * c4);
#pragma unroll
                    for (int e = 0; e < 4; ++e) { const float e0 = fexp(x0[e]), e1 = fexp(x1[e]);
                        q[e] *= 0.125f * e0; kk[e] *= __builtin_amdgcn_rcpf(e0); q[4 + e] *= 0.125f * e1; kk[4 + e] *= __builtin_amdgcn_rcpf(e1); }
                } else {
                    if (lat) {
                        const float* cp = ROPE + (size_t)tok * 32 + 4 * c4; const f32x4 cv = *(const f32x4*)cp, sv = *(const f32x4*)(cp + 65536);
#pragma unroll
                        for (int e = 0; e < 4; ++e) { const float c = cv[e], sn = sv[e];
                            const float q1 = q[e], q2 = q[4 + e]; q[e] = q1 * c - q2 * sn; q[4 + e] = q1 * sn + q2 * c;
                            const float k1 = kk[e], k2 = kk[4 + e]; kk[e] = k1 * c - k2 * sn; kk[4 + e] = k1 * sn + k2 * c; }
                    }
                    const float bb = (float)(sti + 1) * lgr, eb = fexp(bb), ek = 0.125f * __builtin_amdgcn_rcpf(eb);
#pragma unroll
                    for (int e = 0; e < 8; ++e) { q[e] *= eb; kk[e] *= ek; }
                }
                *(LAS v2u*)(G + SC_QD + vst(sti, 4 * c4, 2)) = (v2u){pk2(q[0], q[1]), pk2(q[2], q[3])};
                *(LAS v2u*)(G + SC_QD + vst(sti, 32 + 4 * c4, 2)) = (v2u){pk2(q[4], q[5]), pk2(q[6], q[7])};
                *(LAS v2u*)(G + SC_KI + vst(sti, 4 * c4, 2)) = (v2u){pk2(kk[0], kk[1]), pk2(kk[2], kk[3])};
                *(LAS v2u*)(G + SC_KI + vst(sti, 32 + 4 * c4, 2)) = (v2u){pk2(kk[4], kk[5]), pk2(kk[6], kk[7])};
                *(LAS v4u*)(G + SC_VT + vst(sti, 16 * c4, 4)) = pv0; *(LAS v4u*)(G + SC_VT + vst(sti, 16 * c4 + 8, 4)) = pv1;
            }
            LDS_WAIT(); __syncthreads();
            if (s + 1 < NC) SC_LOAD(s + 1);
            bf16x8 qf[4]; bf16x8 pa0, pa1, pa2, pa3;
            { const int qb_ = vst_row(32 * ri + r32, 2) + 16 * hi;
              qf[0] = *(const LAS bf16x8*)(G + SC_QD + qb_); qf[1] = *(const LAS bf16x8*)(G + SC_QD + qb_ + 32); qf[2] = *(const LAS bf16x8*)(G + SC_QD + qb_ + 512); qf[3] = *(const LAS bf16x8*)(G + SC_QD + qb_ + 544); }
            { f32x16 p0 = {}, p1 = {};
              const int kb0 = vst_row(r32, 2) + 16 * hi, kb1 = vst_row(32 + r32, 2) + 16 * hi;
              { const bf16x8 a0 = *(const LAS bf16x8*)(G + SC_KI + kb0), a1 = *(const LAS bf16x8*)(G + SC_KI + kb0 + 32), a2 = *(const LAS bf16x8*)(G + SC_KI + kb0 + 512), a3 = *(const LAS bf16x8*)(G + SC_KI + kb0 + 544);
                p0 = __builtin_amdgcn_mfma_f32_32x32x16_bf16(a0, qf[0], p0, 0, 0, 0); p0 = __builtin_amdgcn_mfma_f32_32x32x16_bf16(a1, qf[1], p0, 0, 0, 0);
                p0 = __builtin_amdgcn_mfma_f32_32x32x16_bf16(a2, qf[2], p0, 0, 0, 0); p0 = __builtin_amdgcn_mfma_f32_32x32x16_bf16(a3, qf[3], p0, 0, 0, 0); }
              if (ri == 1) {
                  const bf16x8 c0 = *(const LAS bf16x8*)(G + SC_KI + kb1), c1 = *(const LAS bf16x8*)(G + SC_KI + kb1 + 32), c2 = *(const LAS bf16x8*)(G + SC_KI + kb1 + 512), c3 = *(const LAS bf16x8*)(G + SC_KI + kb1 + 544);
                  p1 = __builtin_amdgcn_mfma_f32_32x32x16_bf16(c0, qf[0], p1, 0, 0, 0); p1 = __builtin_amdgcn_mfma_f32_32x32x16_bf16(c1, qf[1], p1, 0, 0, 0);
                  p1 = __builtin_amdgcn_mfma_f32_32x32x16_bf16(c2, qf[2], p1, 0, 0, 0); p1 = __builtin_amdgcn_mfma_f32_32x32x16_bf16(c3, qf[3], p1, 0, 0, 0); }
#pragma unroll
              for (int r = 0; r < 16; ++r) { const bool keep = crow(r, hi) <= r32; if (ri == 0) { p0[r] = keep ? p0[r] : 0.f; } else { p1[r] = keep ? p1[r] : 0.f; } }
              PK4(p0, 0, pa0); PK4(p0, 8, pa1); PK4(p1, 0, pa2); PK4(p1, 8, pa3); }
            const unsigned vb = gaddr + SC_VT + v_rd_base(lane) + dq * 512, sbv = gaddr + SC_ST + v_rd_base(lane) + dq * 512;
#define SC_FR4(dst, base) do { const s16x4 l0_ = tr_read<0>(base), h0_ = tr_read<2048>(base), l1_ = tr_read<4096>(base), h1_ = tr_read<4096 + 2048>(base); \
              const s16x4 l2_ = tr_read<8192>(base), h2_ = tr_read<8192 + 2048>(base), l3_ = tr_read<12288>(base), h3_ = tr_read<12288 + 2048>(base); \
              asm volatile("s_waitcnt lgkmcnt(0)" ::: "memory"); SBAR(); \
              dst[0] = PKF(l0_, h0_); dst[1] = PKF(l1_, h1_); dst[2] = PKF(l2_, h2_); dst[3] = PKF(l3_, h3_); } while (0)
            bf16x8 vf_[4];
            { bf16x8 sf_[4]; SC_FR4(vf_, vb); SC_FR4(sf_, sbv); f32x16 o_ = {};
              o_ = __builtin_amdgcn_mfma_f32_32x32x16_bf16(pa0, vf_[0], o_, 0, 0, 0); o_ = __builtin_amdgcn_mfma_f32_32x32x16_bf16(pa1, vf_[1], o_, 0, 0, 0);
              if (ri == 1) { o_ = __builtin_amdgcn_mfma_f32_32x32x16_bf16(pa2, vf_[2], o_, 0, 0, 0); o_ = __builtin_amdgcn_mfma_f32_32x32x16_bf16(pa3, vf_[3], o_, 0, 0, 0); }
              o_ = __builtin_amdgcn_mfma_f32_32x32x16_bf16(qf[0], sf_[0], o_, 0, 0, 0); o_ = __builtin_amdgcn_mfma_f32_32x32x16_bf16(qf[1], sf_[1], o_, 0, 0, 0);
              o_ = __builtin_amdgcn_mfma_f32_32x32x16_bf16(qf[2], sf_[2], o_, 0, 0, 0); o_ = __builtin_amdgcn_mfma_f32_32x32x16_bf16(qf[3], sf_[3], o_, 0, 0, 0);
              char* dst_ = (char*)OUT;
#pragma unroll
              for (int r = 0; r < 16; r += 2) { const int i_ = 32 * ri + crow(r, hi); const int t_ = SC_TOK(s, i_); const unsigned w_ = pk2(o_[r], o_[r + 1]);
                  const unsigned a_ = (unsigned)(row0 + t_) * (unsigned)(D * 2) + (unsigned)(hh * 128 + 32 * dq + r32) * 2u;
                  *(bf16*)(dst_ + a_) = (bf16)w_; *(bf16*)(dst_ + (dir == 0 ? a_ + (unsigned)(D * 2) : a_ - (unsigned)(D * 2))) = (bf16)(w_ >> 16); } }
            __syncthreads();
            { const unsigned kt = gaddr + SC_KI + v_rd_base(lane) + ri * 512;
              bf16x8 kf[4];
              { const s16x4 l0_ = tr_read<0>(kt), h0_ = tr_read<1024>(kt), l1_ = tr_read<2048>(kt), h1_ = tr_read<2048 + 1024>(kt), l2_ = tr_read<4096>(kt), h2_ = tr_read<4096 + 1024>(kt), l3_ = tr_read<6144>(kt), h3_ = tr_read<6144 + 1024>(kt);
                asm volatile("s_waitcnt lgkmcnt(0)" ::: "memory"); SBAR();
                kf[0] = PKF(l0_, h0_); kf[1] = PKF(l1_, h1_); kf[2] = PKF(l2_, h2_); kf[3] = PKF(l3_, h3_); }
#pragma unroll
              for (int ks = 0; ks < 4; ++ks) sacc = __builtin_amdgcn_mfma_f32_32x32x16_bf16(kf[ks], vf_[ks], sacc, 0, 0, 0);
              const int stb_ = (hi + 4 * ri) * 2048 + dq * 512 + r32 * 2;
#pragma unroll
              for (int r = 0; r < 16; r += 2) { const int dk = 32 * ri + crow(r, hi); const float dl0 = ((LAS float*)(G + SC_DL))[dk], dl1 = ((LAS float*)(G + SC_DL))[dk + 1];
                  sacc[r] *= dl0; sacc[r + 1] *= dl1; const unsigned w_ = pk2(sacc[r], sacc[r + 1]);
                  LAS unsigned char* sp_ = G + SC_ST + stb_ + ((r >> 3) & 1) * 4096 + ((r & 3) + 4 * ((r >> 2) & 1)) * 64;
                  *(LAS unsigned short*)sp_ = (unsigned short)w_; *(LAS unsigned short*)(sp_ + 64) = (unsigned short)(w_ >> 16); } }
        }
        if (!lat) { int l2 = F.lane; asm volatile("" : "+v"(l2)); const int r32 = l2 & 31, hi = l2 >> 5; float* SO = POUT + (gla ? OUT_SGLA : OUT_SRET) + ((size_t)((sb * 2 + li) * 2 + dir) * 4 + h) * 8192;
#pragma unroll
            for (int r = 0; r < 16; ++r) SO[(32 * ri + crow(r, hi)) * 128 + 32 * dq + r32] = sacc[r]; }
    }
#undef SC_TOK
#undef SC_LOAD
#undef SC_FR4
    if (F.G == 256 && F.bid >= 128) { if (li == 0) setup_work(F, P, F.bid - 128, 128, 0x2, 0x0, 0x1); else setup_work(F, P, F.bid - 128, 128, 0x8, 0x0, 0x2); }
    else if (F.G != 256) { if (li == 0) setup_work(F, P, F.bid, F.G, 0x2, 0x0, 0x1); else setup_work(F, P, F.bid, F.G, 0x8, 0x0, 0x2); }
}
__device__ __forceinline__ void scan_combine(Frame& F, const Params& P, int li) {
    unsigned char* ws = PWS;
    const char* PROJ = (const char*)(ws + WS_BIG); const char* OF = (const char*)(ws + WS_Y); char* OB = (char*)(ws + WS_HB);
    const int gw = F.vcu * NWAVES + F.wave, NGW = F.G * NWAVES, lane = F.lane, hh = lane >> 3, dv = (lane & 7) * 16;
    f32x4 gn[4];
    { const float* gp_ = PIN(I_GLAN) + li * 128 + dv;
#pragma unroll
      for (int j = 0; j < 4; ++j) gn[j] = hh < 4 ? *(const f32x4*)(gp_ + 4 * j) : (f32x4){1.f, 1.f, 1.f, 1.f}; }
    const unsigned gcol = (unsigned)((hh < 4 ? PC_GA : PC_GB) + (hh & 3) * 128 + dv) * 2u, ocol = (unsigned)(hh * 128 + dv) * 2u;
    for (int row = gw; row < M; row += 2 * NGW) {
        v4u a[2][2], b[2][2], g[2][2];
#pragma unroll
        for (int i = 0; i < 2; ++i) { const int r_ = row + i * NGW; if (r_ < M) {
            const unsigned off = (unsigned)r_ * (unsigned)(D * 2) + ocol, goff = (unsigned)r_ * (unsigned)(EVEN_NP * 2) + gcol;
            a[i][0] = *(const v4u*)(OF + off); a[i][1] = *(const v4u*)(OF + off + 16); b[i][0] = *(const v4u*)(OB + off); b[i][1] = *(const v4u*)(OB + off + 16);
            g[i][0] = *(const v4u*)(PROJ + goff); g[i][1] = *(const v4u*)(PROJ + goff + 16); } }
#pragma unroll
        for (int i = 0; i < 2; ++i) { const int r_ = row + i * NGW; if (r_ < M) {
            const unsigned off = (unsigned)r_ * (unsigned)(D * 2) + ocol;
            float x[16], gg[16];
#pragma unroll
            for (int hf = 0; hf < 2; ++hf)
#pragma unroll
                for (int e = 0; e < 4; ++e) { x[8 * hf + 2 * e] = bflo(a[i][hf][e]) + bflo(b[i][hf][e]); x[8 * hf + 2 * e + 1] = bfhi(a[i][hf][e]) + bfhi(b[i][hf][e]);
                    gg[8 * hf + 2 * e] = bflo(g[i][hf][e]); gg[8 * hf + 2 * e + 1] = bfhi(g[i][hf][e]); }
            float ss = 0.f;
#pragma unroll
            for (int e = 0; e < 16; ++e) ss += x[e] * x[e];
            ss += __shfl_xor(ss, 1); ss += __shfl_xor(ss, 2); ss += __shfl_xor(ss, 4);
            const float rstd = __builtin_amdgcn_rsqf(ss * (1.0f / 128.0f) + EPS);
#pragma unroll
            for (int e = 0; e < 16; ++e) x[e] = x[e] * rstd * gn[e >> 2][e & 3] * siluf(gg[e]);
            *(v4u*)(OB + off) = (v4u){pk2(x[0], x[1]), pk2(x[2], x[3]), pk2(x[4], x[5]), pk2(x[6], x[7])};
            *(v4u*)(OB + off + 16) = (v4u){pk2(x[8], x[9]), pk2(x[10], x[11]), pk2(x[12], x[13]), pk2(x[14], x[15])}; } }
    }
}

__device__ __forceinline__ void cache_pass(Frame& F, const Params& P, int li) {
    unsigned char* ws = PWS;
    const int gt = F.vcu * 512 + F.tid, NGT = F.G * 512;
    const float* cckv_ = PIN(I_CCKV); const float* ckpe_ = PIN(I_CKPE);
    for (int i = gt; i < 8 * 256 * 32; i += NGT) { const int c8 = i & 31, t = (i >> 5) & 255, b = i >> 13;
        const float* s = cckv_ + ((size_t)((b * 2 + li) * 256 + t) * 32 + c8) * 8; const f32x4 a = *(const f32x4*)s, c = *(const f32x4*)(s + 4);
        *(GAS v4u*)((bf16*)(ws + WS_ACKV) + ((size_t)4096 + b * LKV + t) * 256 + c8 * 8) = (v4u){pk2(a[0], a[1]), pk2(a[2], a[3]), pk2(c[0], c[1]), pk2(c[2], c[3])}; }
    for (int i = gt; i < 8 * 256 * 8; i += NGT) { const int c8 = i & 7, t = (i >> 3) & 255, b = i >> 11;
        const float* s = ckpe_ + ((size_t)((b * 2 + li) * 256 + t) * 8 + c8) * 8; const f32x4 a = *(const f32x4*)s, c = *(const f32x4*)(s + 4);
        *(GAS v4u*)((bf16*)(ws + WS_KPE) + ((size_t)4096 + b * LKV + t) * 64 + c8 * 8) = (v4u){pk2(a[0], a[1]), pk2(a[2], a[3]), pk2(c[0], c[1]), pk2(c[2], c[3])}; }
}
__device__ __forceinline__ void kpe_pass(Frame& F, const Params& P, int li) {
    unsigned char* ws = PWS;
    const float* KR = (const float*)(ws + WS_Y); const float* ROPE = (const float*)(ws + WS_ROPE);
    bf16* KPE = (bf16*)(ws + WS_KPE);
    const int gt = F.vcu * 512 + F.tid, NGT = F.G * 512;
    for (int i = gt; i < M * 4; i += NGT) {
        const int row = i >> 2, c8 = i & 3;
        const float* s = KR + (size_t)row * 64 + 8 * c8;
        f32x4 a0 = *(const f32x4*)s, a1 = *(const f32x4*)(s + 4), b0 = *(const f32x4*)(s + 32), b1 = *(const f32x4*)(s + 36);
        int drow = row;
        if (row >= M_CTX) { const int lb = (row - M_CTX) >> 11, t = (row - M_CTX) & 2047; drow = M_CTX + lb * LKV + PAST + t;
            const float* cp = ROPE + (size_t)t * 32 + 8 * c8; const float* sp = cp + 65536;
            const f32x4 c0 = *(const f32x4*)cp, c1 = *(const f32x4*)(cp + 4), s0 = *(const f32x4*)sp, s1 = *(const f32x4*)(sp + 4);
            const f32x4 x0 = a0 * c0 - b0 * s0, x1 = a1 * c1 - b1 * s1, y0 = a0 * s0 + b0 * c0, y1 = a1 * s1 + b1 * c1;
            a0 = x0; a1 = x1; b0 = y0; b1 = y1; }
        bf16* d = KPE + (size_t)drow * 64 + 8 * c8;
        *(v4u*)d = (v4u){pk2(a0[0], a0[1]), pk2(a0[2], a0[3]), pk2(a1[0], a1[1]), pk2(a1[2], a1[3])};
        *(v4u*)(d + 32) = (v4u){pk2(b0[0], b0[1]), pk2(b0[2], b0[3]), pk2(b1[0], b1[1]), pk2(b1[2], b1[3])};
    }
}

constexpr float ATT_SCALE = 0.07216878364870322f;
constexpr float ATT_THR = 8.f;
constexpr int AT_V = 0, AT_KN = 49152, AT_KP = 98304, AT_WS = 122880, AT_VB = 16384, AT_KNB = 16384, AT_KPB = 8192;
#define KSWZ(row, colB) ((row) * 256 + ((colB) ^ (((row) & 7) << 4)))
#define KPSWZ(row, colB) ((row) * 128 + ((colB) ^ (((row) & 7) << 4)))
__device__ __forceinline__ void at_partialSM(f32x16& p0, f32x16& p1, float& m_reg, float& mn, float& alpha) {
    constexpr float C = ATT_SCALE * 1.4426950408889634f;
    float pmax = p0[0];
#pragma unroll
    for (int r = 1; r < 16; ++r) pmax = fmaxf(pmax, p0[r]);
#pragma unroll
    for (int r = 0; r < 16; ++r) pmax = fmaxf(pmax, p1[r]);
    { auto rr = __builtin_amdgcn_permlane32_swap(__float_as_uint(pmax), __float_as_uint(pmax), false, false); pmax = fmaxf(__uint_as_float(rr[0]), __uint_as_float(rr[1])); }
    if (__builtin_expect(__all(pmax - m_reg <= ATT_THR / ATT_SCALE), 1)) { mn = m_reg; alpha = 1.f; }
    else { mn = fmaxf(m_reg, pmax); alpha = __builtin_amdgcn_exp2f((m_reg - mn) * C); m_reg = mn; }
    const float mnC = -mn * C;
#pragma unroll
    for (int r = 0; r < 16; ++r) p0[r] = fmaf(p0[r], C, mnC);
#pragma unroll
    for (int r = 0; r < 16; ++r) p1[r] = fmaf(p1[r], C, mnC);
#pragma unroll
    for (int r = 0; r < 16; ++r) p0[r] = __builtin_amdgcn_exp2f(p0[r]);
}
__device__ __forceinline__ void at_finishSM(f32x16& p0, f32x16& p1, float alpha, float& l_reg, bf16x8& pa0, bf16x8& pa1, bf16x8& pa2, bf16x8& pa3) {
#pragma unroll
    for (int r = 0; r < 16; ++r) p1[r] = __builtin_amdgcn_exp2f(p1[r]);
    float ps = 0;
#pragma unroll
    for (int r = 0; r < 16; ++r) ps += p0[r];
#pragma unroll
    for (int r = 0; r < 16; ++r) ps += p1[r];
    { auto rr = __builtin_amdgcn_permlane32_swap(__float_as_uint(ps), __float_as_uint(ps), false, false); ps = __uint_as_float(rr[0]) + __uint_as_float(rr[1]); }
    l_reg = l_reg * alpha + ps;
    PK4(p0, 0, pa0); PK4(p0, 8, pa1); PK4(p1, 0, pa2); PK4(p1, 8, pa3);
}
__device__ __forceinline__ void at_qkt(f32x16& p0, f32x16& p1, const LAS unsigned char* Kn, const LAS unsigned char* Kp, const bf16x8* qr, const int* kb, const int* pb) {
    p0 = f32x16{}; p1 = f32x16{};
#pragma unroll
    for (int d0 = 0; d0 < 8; ++d0) {
        const bf16x8 b0 = *(const LAS bf16x8*)(Kn + kb[d0 & 3] + 128 * (d0 >> 2)), b1 = *(const LAS bf16x8*)(Kn + kb[d0 & 3] + 128 * (d0 >> 2) + 8192);
        p0 = __builtin_amdgcn_mfma_f32_32x32x16_bf16(b0, qr[d0], p0, 0, 0, 0);
        p1 = __builtin_amdgcn_mfma_f32_32x32x16_bf16(b1, qr[d0], p1, 0, 0, 0); }
#pragma unroll
    for (int d0 = 0; d0 < 4; ++d0) {
        const bf16x8 b0 = *(const LAS bf16x8*)(Kp + pb[d0]), b1 = *(const LAS bf16x8*)(Kp + pb[d0] + 4096);
        p0 = __builtin_amdgcn_mfma_f32_32x32x16_bf16(b0, qr[8 + d0], p0, 0, 0, 0);
        p1 = __builtin_amdgcn_mfma_f32_32x32x16_bf16(b1, qr[8 + d0], p1, 0, 0, 0); }
}
template <int D0> __device__ __forceinline__ void at_pv_one(f32x16& od, unsigned vb, bf16x8 pa0, bf16x8 pa1, bf16x8 pa2, bf16x8 pa3) {
    const s16x4 l0 = tr_read<D0 * 512>(vb), h0 = tr_read<D0 * 512 + 2048>(vb), l1 = tr_read<D0 * 512 + 4096>(vb), h1 = tr_read<D0 * 512 + 4096 + 2048>(vb);
    const s16x4 l2 = tr_read<D0 * 512 + 8192>(vb), h2 = tr_read<D0 * 512 + 8192 + 2048>(vb), l3 = tr_read<D0 * 512 + 12288>(vb), h3 = tr_read<D0 * 512 + 12288 + 2048>(vb);
    asm volatile("s_waitcnt lgkmcnt(0)" ::: "memory"); SBAR();
    od = __builtin_amdgcn_mfma_f32_32x32x16_bf16(pa0, PKF(l0, h0), od, 0, 0, 0);
    od = __builtin_amdgcn_mfma_f32_32x32x16_bf16(pa1, PKF(l1, h1), od, 0, 0, 0);
    od = __builtin_amdgcn_mfma_f32_32x32x16_bf16(pa2, PKF(l2, h2), od, 0, 0, 0);
    od = __builtin_amdgcn_mfma_f32_32x32x16_bf16(pa3, PKF(l3, h3), od, 0, 0, 0);
}
__device__ __forceinline__ void at_pv(f32x16* o, unsigned vb, bf16x8 pa0, bf16x8 pa1, bf16x8 pa2, bf16x8 pa3) {
    at_pv_one<0>(o[0], vb, pa0, pa1, pa2, pa3); at_pv_one<1>(o[1], vb, pa0, pa1, pa2, pa3); at_pv_one<2>(o[2], vb, pa0, pa1, pa2, pa3); at_pv_one<3>(o[3], vb, pa0, pa1, pa2, pa3);
}
__device__ __forceinline__ void attn_unit(Frame& F, const bf16* Qrow0  , const bf16* KVh  , const bf16* KPEs  ,
                                          bf16* Orow0, int nkeys, const float* ROPE, int tpos0  ) {
    LAS unsigned char* lds = F.lds;
    const int tid = F.tid, wid = F.wave, lane = F.lane, r32 = lane & 31, hi = lane >> 5;
    LAS float* wsf = (LAS float*)(lds + AT_WS) + wid * 64; LAS float* li_l = wsf; LAS float* al_l = wsf + 32;
    float m_reg = -1e30f, l_reg = 0; f32x16 o[4] = {}; bf16x8 qr[12];
    { const bf16* Qw = Qrow0 + (size_t)(wid * 32 + r32) * 1536 + hi * 8;
#pragma unroll
      for (int d0 = 0; d0 < 12; ++d0) qr[d0] = *(const bf16x8*)(Qw + d0 * 16);
      if (tpos0 >= 0) {
          const int t = tpos0 + wid * 32 + r32;
#pragma unroll
          for (int half = 0; half < 2; ++half) {
              const float* cp = ROPE + (size_t)t * 32 + 16 * half + 8 * hi; const float* sp = cp + 65536;
              const v4u xa = __builtin_bit_cast(v4u, qr[8 + half]), xb = __builtin_bit_cast(v4u, qr[10 + half]);
              float x1[8], x2[8];
              x1[0] = bflo(xa.x); x1[1] = bfhi(xa.x); x1[2] = bflo(xa.y); x1[3] = bfhi(xa.y); x1[4] = bflo(xa.z); x1[5] = bfhi(xa.z); x1[6] = bflo(xa.w); x1[7] = bfhi(xa.w);
              x2[0] = bflo(xb.x); x2[1] = bfhi(xb.x); x2[2] = bflo(xb.y); x2[3] = bfhi(xb.y); x2[4] = bflo(xb.z); x2[5] = bfhi(xb.z); x2[6] = bflo(xb.w); x2[7] = bfhi(xb.w);
              float y1[8], y2[8];
#pragma unroll
              for (int j = 0; j < 8; ++j) { const float c = cp[j], s = sp[j]; y1[j] = x1[j] * c - x2[j] * s; y2[j] = x1[j] * s + x2[j] * c; }
              const v4u wa = {pk2(y1[0], y1[1]), pk2(y1[2], y1[3]), pk2(y1[4], y1[5]), pk2(y1[6], y1[7])}, wb = {pk2(y2[0], y2[1]), pk2(y2[2], y2[3]), pk2(y2[4], y2[5]), pk2(y2[6], y2[7])};
              if (half == 0) { qr[8] = __builtin_bit_cast(bf16x8, wa); qr[10] = __builtin_bit_cast(bf16x8, wb); } else { qr[9] = __builtin_bit_cast(bf16x8, wa); qr[11] = __builtin_bit_cast(bf16x8, wb); }
          }
      } }
    const unsigned vb0 = (unsigned)(uintptr_t)(lds + AT_V) + v_rd_base(lane);
#define AT_OPQ() int l_ = lane; asm volatile("" : "+v"(l_))
#define AT_KADDR() int kbs[4], pbs[4]; { AT_OPQ(); _Pragma("unroll") for (int b = 0; b < 4; ++b) { const int x = (32 * b + 16 * (l_ >> 5)) ^ ((l_ & 7) << 4); kbs[b] = (l_ & 31) * 256 + x; pbs[b] = (l_ & 31) * 128 + x; } }
#define AT_GLDS(gp, ldsoff) __builtin_amdgcn_global_load_lds((const unsigned*)(gp), (LAS unsigned*)(lds + (ldsoff)), 16, 0, 0)
#define AT_DMA_K(t, b) do { AT_OPQ(); const char* kb_ = (const char*)KVh + (size_t)(t) * (64 * 4096); const char* pb_ = (const char*)KPEs + (size_t)(t) * (64 * 128); \
    const int row0_ = 4 * wid + (l_ >> 4), cB0_ = ((l_ & 15) * 16) ^ ((row0_ & 7) << 4), row1_ = row0_ + 32, rowp_ = 8 * wid + (l_ >> 3), cBp_ = ((l_ & 7) * 16) ^ ((rowp_ & 7) << 4); \
    AT_GLDS(kb_ + (unsigned)(row0_ * 4096 + cB0_), AT_KN + (b) * AT_KNB + wid * 1024); AT_GLDS(kb_ + (unsigned)(row1_ * 4096 + cB0_), AT_KN + (b) * AT_KNB + (wid + 8) * 1024); \
    AT_GLDS(pb_ + (unsigned)(rowp_ * 128 + cBp_), AT_KP + (b) * AT_KPB + wid * 1024); } while (0)
#define AT_DMA_V(t, b) do { AT_OPQ(); const char* vb_ = (const char*)KVh + (size_t)(t) * (64 * 4096); \
    const int st_ = 2 * wid + (l_ >> 5), kk_ = (st_ >> 2) * 8 + ((l_ & 31) >> 2), key_ = (kk_ & ~0xC) | ((kk_ & 4) << 1) | ((kk_ & 8) >> 1), col_ = (st_ & 3) * 32 + (l_ & 3) * 8; \
    AT_GLDS(vb_ + (unsigned)(key_ * 4096 + (128 + col_) * 2), AT_V + (b) * AT_VB + wid * 1024); AT_GLDS(vb_ + (unsigned)((key_ + 32) * 4096 + (128 + col_) * 2), AT_V + (b) * AT_VB + (wid + 8) * 1024); } while (0)
#define AT_RESC(a) do { if (__any((a) < 1.f)) { if (hi == 0) al_l[r32] = (a); asm volatile("s_waitcnt lgkmcnt(0)" ::: "memory"); \
    _Pragma("unroll") for (int d = 0; d < 4; ++d) _Pragma("unroll") for (int r = 0; r < 16; ++r) o[d][r] *= al_l[crow(r, hi)]; } } while (0)
#define AT_WAITBAR(N) do { asm volatile("s_waitcnt vmcnt(" #N ") lgkmcnt(0)" ::: "memory"); __builtin_amdgcn_s_barrier(); asm volatile("" ::: "memory"); } while (0)
    f32x16 pA0, pA1, pB0, pB1; float mnA, mnB, alA, alB; bf16x8 pa0, pa1, pa2, pa3; const int NT = nkeys / 64;
    AT_DMA_K(0, 0); AT_DMA_K(1, 1); AT_DMA_V(0, 0); AT_WAITBAR(0);
    int s = 0;
#define AT_S1 (s == 2 ? 0 : s + 1)
#define AT_S2 (s == 0 ? 2 : s - 1)
#define AT_STEP(CUR0, CUR1, MNC, ALC, PRV0, PRV1, ALP, t, MODE) do { \
        if (MODE == 2) { AT_DMA_K((t) + 2, AT_S2); } if (MODE >= 1) { AT_DMA_V((t) + 1, AT_S1); } \
        SBAR(); { AT_KADDR(); at_qkt(CUR0, CUR1, lds + AT_KN + s * AT_KNB, lds + AT_KP + s * AT_KPB, qr, kbs, pbs); } \
        at_finishSM(PRV0, PRV1, ALP, l_reg, pa0, pa1, pa2, pa3); SBAR(); \
        at_pv(o, vb0 + AT_S2 * AT_VB, pa0, pa1, pa2, pa3); at_partialSM(CUR0, CUR1, m_reg, MNC, ALC); \
        AT_RESC(ALC); if (MODE == 2) AT_WAITBAR(5); else if (MODE == 1) AT_WAITBAR(2); else AT_WAITBAR(0); s = AT_S1; } while (0)
    AT_DMA_K(2, 2); AT_DMA_V(1, 1);
    { AT_KADDR(); at_qkt(pA0, pA1, lds + AT_KN, lds + AT_KP, qr, kbs, pbs); } at_partialSM(pA0, pA1, m_reg, mnA, alA);
    AT_WAITBAR(5); s = 1;
    int t = 1;
    for (; t + 4 < NT; t += 2) {
        AT_STEP(pB0, pB1, mnB, alB, pA0, pA1, alA, t, 2);
        AT_STEP(pA0, pA1, mnA, alA, pB0, pB1, alB, t + 1, 2);
    }
    AT_STEP(pB0, pB1, mnB, alB, pA0, pA1, alA, NT - 3, 2);
    AT_STEP(pA0, pA1, mnA, alA, pB0, pB1, alB, NT - 2, 1);
    AT_STEP(pB0, pB1, mnB, alB, pA0, pA1, alA, NT - 1, 0);
    at_finishSM(pB0, pB1, alB, l_reg, pa0, pa1, pa2, pa3); SBAR();
    at_pv(o, vb0 + AT_S2 * AT_VB, pa0, pa1, pa2, pa3);
    if (hi == 0) li_l[r32] = l_reg; asm volatile("s_waitcnt lgkmcnt(0)" ::: "memory");
    float rli[16];
#pragma unroll
    for (int r = 0; r < 16; ++r) rli[r] = __builtin_amdgcn_rcpf(li_l[crow(r, hi)]);
    bf16* Ow = Orow0 + (size_t)(wid * 32) * D;
#pragma unroll
    for (int r = 0; r < 16; r += 2) { const int orow = crow(r, hi);
#pragma unroll
        for (int d0 = 0; d0 < 4; ++d0) { const unsigned w = pk2(o[d0][r] * rli[r], o[d0][r + 1] * rli[r + 1]);
            Ow[(size_t)orow * D + d0 * 32 + r32] = (bf16)w; Ow[(size_t)(orow + 1) * D + d0 * 32 + r32] = (bf16)(w >> 16); } }
#undef AT_GLDS
#undef AT_OPQ
#undef AT_KADDR
#undef AT_DMA_K
#undef AT_DMA_V
#undef AT_RESC
#undef AT_WAITBAR
#undef AT_S1
#undef AT_S2
#undef AT_STEP
}
__device__ __forceinline__ void attn_phase(Frame& F, const Params& P, int li) {
    unsigned char* ws = PWS;
    const bf16* Q = (const bf16*)(ws + WS_Q); const bf16* KV = (const bf16*)(ws + WS_KV); const bf16* KPE = (const bf16*)(ws + WS_KPE);
    bf16* OB = (bf16*)(ws + WS_HB); const float* ROPE = (const float*)(ws + WS_ROPE);
    for (int u = F.vcu; u < 256 + 128; u += F.G) {
        for (int k = 0; k < 2; ++k) {
            int qrow0, kvrow0, nkeys, h, tpos0;
            if (u < 256) { const int id = 2 * u + k, lb = id >> 6, qb = id & 7; h = (id >> 3) & 7; qrow0 = M_CTX + lb * L_LAT + qb * 256; kvrow0 = M_CTX + lb * LKV; nkeys = LKV; tpos0 = qb * 256; }
            else { if (k == 1) break; const int id = u - 256, b = id >> 3; h = id & 7; qrow0 = b * L_CTX; kvrow0 = b * L_CTX; nkeys = L_CTX; tpos0 = -1; }
            __syncthreads();
            attn_unit(F, Q + (size_t)qrow0 * 1536 + h * 192, KV + (size_t)kvrow0 * 2048 + h * 256, KPE + (size_t)kvrow0 * 64, OB + (size_t)qrow0 * D + h * 128, nkeys, ROPE, tpos0);
        }
    }
}

constexpr int N_PHASES = 2 + 2 * 16;
__global__ void __launch_bounds__(NWAVES * 64, 2) hyb_fwd(Params P) {
    extern __shared__ __attribute__((aligned(16))) unsigned char lds_raw[];
    Frame F;
    F.lds = (LAS unsigned char*)lds_raw;
    F.tid = threadIdx.x; F.lane = F.tid & 63; F.wave = __builtin_amdgcn_readfirstlane(F.tid >> 6);
    F.G = gridDim.x; { const int bx = blockIdx.x; F.vcu = (F.G % 8 == 0) ? (bx % 8) * (F.G / 8) + bx / 8 : bx; }
    volatile LAS unsigned* MISC = (volatile LAS unsigned*)(F.lds + LDS_MISC);
    if (F.tid < 64) MISC[F.tid] = 0u;
    if (F.tid < 30) { const unsigned long long v = F.tid < 28 ? (unsigned long long)P.in[F.tid] : (F.tid == 28 ? (unsigned long long)P.out : (unsigned long long)P.ws);
        volatile LAS unsigned* pt = (volatile LAS unsigned*)(F.lds + LDS_PT) + 2 * F.tid; pt[0] = (unsigned)v; pt[1] = (unsigned)(v >> 32); }
    __syncthreads();
    const int use_bar = P.use_bar, ph_hi = P.ph_hi;
    XcdBarrier bar; bar.bar = (unsigned*)(PWS + WS_CTL) + 4096; bar.x = 0; bar.st = nullptr;
    if (use_bar) bar = xcd_barrier_post((unsigned*)(PWS + WS_CTL) + 4096, MISC + 8);

    int dup_done = 0; (void)dup_done;
    for (int ph = P.ph_lo; ph < ph_hi; ++ph) {
#define REFRESH_ID() do { int t_ = threadIdx.x; asm volatile("" : "+v"(t_)); F.tid = t_; F.lane = t_ & 63; F.wave = __builtin_amdgcn_readfirstlane(t_ >> 6); \
          int g_ = gridDim.x, b_ = blockIdx.x; asm volatile("" : "+s"(g_), "+s"(b_)); F.G = g_; F.vcu = (g_ % 8 == 0) ? (b_ % 8) * (g_ / 8) + b_ / 8 : b_; F.bid = b_; } while (0)
        REFRESH_ID();
        unsigned char* ws = PWS;
        bf16* XBF = (bf16*)(POUT + OUT_Y);
        bf16* HB = (bf16*)(ws + WS_HB); bf16* YB = (bf16*)(ws + WS_Y); const bf16* SL = (const bf16*)(ws + WS_SLAB);
        const float* MOD = (const float*)(ws + WS_MOD);
        if (ph == 0) { p0_prologue(F, P); }
        else if (ph == 1) {
            const float* m0 = MOD;
            row_pass(F, PIN(I_XP), PIN(I_XS), true, nullptr, nullptr, nullptr, nullptr, nullptr, PIN(I_NMIXPRE), m0 + 1024, m0, HB, false, true);
        } else {
            const int q = ph - 2, pair = q / 16, r = q % 16; const bool odd = r >= 8; const int l = 2 * pair + (odd ? 1 : 0), k = odd ? r - 8 : r;
            const float* ml = MOD + (size_t)l * 9 * 6144;
            const int kind = k < 3 ? (odd ? 10 + k : (k == 2 ? 8 : k)) : (k == 3 ? 2 : k == 4 ? 3 : k == 5 ? 4 : k == 6 ? 5 : 6);
            if (kind == 0) {
                pg8::Gemm g{HB, (const bf16*)(ws + WS_WINE) + (size_t)pair * EVEN_NP * 1024, M, EVEN_NP, 1024}; pg8::StaticOrder S; S.init(M, EVEN_NP, F.G, F.bid, 1024);
                pg8::EpiBf16<0> E{(bf16*)(ws + WS_BIG), EVEN_NP};
                pg8::gemm_phase<pg8::EpiBf16<0>, pg8::StaticOrder, true, true>(F.lds, g, S, E, F.tid);
            } else if (kind == 1) {
                scan_phase(F, P, pair);
            } else if (kind == 8) {
                scan_combine(F, P, pair);
            } else if (kind == 2) {
                const bf16* W = odd ? (const bf16*)(ws + WS_WOUTO) + (size_t)pair * 1024 * 1024 : (const bf16*)(ws + WS_WOUTE) + (size_t)pair * 1024 * 1024;
                { pg8::Gemm g{HB, W, M, 1024, 1024}; pg8::TailSplitOrder S; S.init(F.bid, 1024, 1);
                  pg8::EpiYsplit E{YB, (bf16*)(ws + WS_SLAB)};
                  pg8::gemm_phase<pg8::EpiYsplit, pg8::TailSplitOrder, true, true>(F.lds, g, S, E, F.tid); }
                REFRESH_ID();
                { pg8::Gemm g{HB, W, M, 1024, 1024}; pg8::TailSplitOrder S; S.init(F.bid, 1024, 2);
                  pg8::EpiYsplit E{YB, (bf16*)(PWS + WS_SLAB)};
                  pg8::gemm_phase<pg8::EpiYsplit, pg8::TailSplitOrder, true, true>(F.lds, g, S, E, F.tid); }
            } else if (kind == 3) {
                row_pass(F, PIN(I_XP), PIN(I_XS), l == 0, XBF, YB, SL, PIN(I_NMIXPOST) + l * 1024, ml + 2048, PIN(I_NMLPPRE) + l * 1024, ml + 4096, ml + 3072, HB, true, true);
            } else if (kind == 4) {
                pg8::Gemm g{HB, (const bf16*)(ws + WS_W1) + (size_t)l * 4096 * 1024, M, FF, 1024}; pg8::StaticOrder S; S.init(M, FF, F.G, F.bid, 1024);
                pg8::EpiBf16<1> E{(bf16*)(ws + WS_BIG), FF};
                pg8::gemm_phase<pg8::EpiBf16<1>, pg8::StaticOrder, true, true>(F.lds, g, S, E, F.tid);
            } else if (kind == 5) {
                { pg8::Gemm g{(const bf16*)(ws + WS_BIG), (const bf16*)(ws + WS_W2) + (size_t)l * 1024 * 4096, M, 1024, FF}; pg8::TailSplitOrder S; S.init(F.bid, FF, 1);
                  pg8::EpiYsplit E{YB, (bf16*)(ws + WS_SLAB)};
                  pg8::gemm_phase<pg8::EpiYsplit, pg8::TailSplitOrder, true, true>(F.lds, g, S, E, F.tid); }
                REFRESH_ID();
                { pg8::Gemm g{(const bf16*)(PWS + WS_BIG), (const bf16*)(PWS + WS_W2) + (size_t)l * 1024 * 4096, M, 1024, FF}; pg8::TailSplitOrder S; S.init(F.bid, FF, 2);
                  pg8::EpiYsplit E{(bf16*)(PWS + WS_Y), (bf16*)(PWS + WS_SLAB)};
                  pg8::gemm_phase<pg8::EpiYsplit, pg8::TailSplitOrder, true, true>(F.lds, g, S, E, F.tid); }
            } else if (kind == 6) {
                const float* mn = ml + 9 * 6144;
                if (l < 3) row_pass(F, nullptr, nullptr, false, XBF, YB, SL, PIN(I_NMLPPOST) + l * 1024, ml + 5120, PIN(I_NMIXPRE) + (l + 1) * 1024, mn + 1024, mn, HB, true, true);
                else { bar.bar = (unsigned*)(PWS + WS_CTL) + 4096; row_pass_final(F, bar, XBF, POUT + OUT_Y, YB, SL, PIN(I_NMLPPOST) + l * 1024, ml + 5120); }
            } else if (kind == 10) {
                pg8::Gemm g{HB, (const bf16*)(ws + WS_WINO) + (size_t)pair * ODD_NP * 1024, M, ODD_NP, 1024}; pg8::StaticOrder S; S.init(M, ODD_NP, F.G, F.bid, 1024);
                pg8::EpiOddIn E{(bf16*)(ws + WS_QN), (bf16*)(ws + WS_ACKV), (float*)(ws + WS_Y), POUT + OUT_CKV, POUT + OUT_KPE,
                                PIN(I_QAN) + pair * 256, PIN(I_KVAN) + pair * 256, pair};
                pg8::gemm_phase<pg8::EpiOddIn, pg8::StaticOrder, false, true>(F.lds, g, S, E, F.tid);
                REFRESH_ID(); cache_pass(F, P, pair);
            } else if (kind == 11) {
                kpe_pass(F, P, pair); REFRESH_ID();
                { pg8::Gemm g{(const bf16*)(ws + WS_QN), (const bf16*)(ws + WS_WQB) + (size_t)pair * 1536 * 256, M, 1536, 256}; pg8::StaticOrder S; S.init(M, 1536, F.G, F.bid, 256);
                  pg8::EpiBf16<0> E{(bf16*)(ws + WS_Q), 1536};
                  pg8::gemm_phase<pg8::EpiBf16<0>, pg8::StaticOrder, true, true>(F.lds, g, S, E, F.tid); }
                REFRESH_ID();
                { pg8::Gemm g{(const bf16*)(ws + WS_ACKV), (const bf16*)(ws + WS_WKVB) + (size_t)pair * 2048 * 256, MKV, 2048, 256}; pg8::StaticOrder S; S.init(MKV, 2048, F.G, F.bid, 256);
                  pg8::EpiBf16<0> E{(bf16*)(ws + WS_KV), 2048};
                  pg8::gemm_phase<pg8::EpiBf16<0>, pg8::StaticOrder, true, true>(F.lds, g, S, E, F.tid); }
            } else if (kind == 12) {
                attn_phase(F, P, pair);
            }
        }
#if defined(HYB_DUP_MASK)
        { int kind_ = -1;
          if (ph == 0) kind_ = 13;
          else if (ph >= 2) { const int q_ = ph - 2, r_ = q_ % 16; const bool odd_ = r_ >= 8; const int k_ = odd_ ? r_ - 8 : r_;
              kind_ = k_ < 3 ? (odd_ ? 10 + k_ : (k_ == 2 ? 8 : k_)) : (k_ == 3 ? 2 : k_ == 4 ? 3 : k_ == 5 ? 4 : k_ == 6 ? 5 : 6); }
          if (kind_ >= 0 && ((HYB_DUP_MASK >> kind_) & 1) && dup_done == 0) { dup_done = 1; if (use_bar) { bar.bar = (unsigned*)(PWS + WS_CTL) + 4096; xcd_barrier(bar); } else { VM_WAIT(); __syncthreads(); } --ph; continue; } }
        dup_done = 0;
        if (((HYB_DUP_MASK >> 14) & 1) && ph + 1 < ph_hi && use_bar) { bar.bar = (unsigned*)(PWS + WS_CTL) + 4096; xcd_barrier(bar); }
#endif
        if (ph + 1 < ph_hi) { if (use_bar) { bar.bar = (unsigned*)(PWS + WS_CTL) + 4096; xcd_barrier(bar); } else { VM_WAIT(); __syncthreads(); } }
    }
}

extern "C" void kernel_launch(void* const* d_in, const int* in_sizes, int n_in, void* d_out, int out_size, void* d_ws, size_t ws_size, hipStream_t stream) {
    static int grid = 0;
    if (grid == 0) {
        if (n_in != 28 || out_size != 27787264 || ws_size < WS_END) { fprintf(stderr, "kernel_launch: unexpected shapes: n_in %d out %d ws %zu (need >= %zu)\n", n_in, out_size, ws_size, (size_t)WS_END); grid = -1; return; }
        int dev = 0, cus = 0, per_cu = 0;
        if (hipGetDevice(&dev) != hipSuccess || hipDeviceGetAttribute(&cus, hipDeviceAttributeMultiprocessorCount, dev) != hipSuccess) { grid = -1; return; }
        if (hipFuncSetAttribute((const void*)hyb_fwd, hipFuncAttributeMaxDynamicSharedMemorySize, LDS_BYTES) != hipSuccess) { fprintf(stderr, "kernel_launch: hipFuncSetAttribute failed\n"); grid = -1; return; }
        if (hipOccupancyMaxActiveBlocksPerMultiprocessor(&per_cu, (const void*)hyb_fwd, NWAVES * 64, LDS_BYTES) != hipSuccess || per_cu < 1) { fprintf(stderr, "kernel_launch: occupancy query reports %d\n", per_cu); }
        (void)hipGetLastError();
        grid = cus;
    }
    if (grid < 0) return;
    (void)hipMemsetAsync((char*)d_ws + WS_CTL, 0, CTL_ZERO_BYTES, stream);
    Params a{};
    for (int i = 0; i < 28; ++i) a.in[i] = (const float*)d_in[i];
    a.out = (float*)d_out; a.ws = (unsigned char*)d_ws;
    a.ph_lo = 0; a.ph_hi = N_PHASES; a.use_bar = 1; a.pad = 0;
    hipLaunchKernelGGL(hyb_fwd, dim3(grid), dim3(NWAVES * 64), LDS_BYTES, stream, a);
    const hipError_t le = hipPeekAtLastError();
    if (le != hipSuccess) fprintf(stderr, "kernel_launch: launch failed: %s\n", hipGetErrorName(le));
}
```

```cpp
#include <hip/hip_runtime.h>
#include <hip/hip_bf16.h>
#include <cstdio>
#include <cstdint>
namespace pg8 {
#define PG8_LAS __attribute__((address_space(3)))
typedef unsigned short bf16_t;
typedef short bf16x8 __attribute__((ext_vector_type(8)));
typedef float f32x4 __attribute__((ext_vector_type(4)));
typedef unsigned u32x4 __attribute__((ext_vector_type(4)));
constexpr int BM = 256, BK = 64, HALF = 128, HTB = HALF * BK * 2  , STAGE_BYTES = 8 * HTB, NXCD = 8, WGM = 8;

__host__ __device__ __forceinline__ int lds_byte(int r, int c) { const int st = (r >> 4) * 2 + (c >> 5), rr = r & 15, cc = c & 31, ob = rr * 64 + cc * 2; return st * 1024 + (ob ^ (((ob >> 9) & 1) << 5)); }
__host__ __device__ __forceinline__ void stage_rc(int b, int& R, int& C) { const int st = b / 1024, sb = b % 1024, swz = sb ^ (((sb >> 9) & 1) << 5); R = (st >> 1) * 16 + swz / 64; C = (st & 1) * 32 + (swz % 64) / 2; }
__host__ __device__ __forceinline__ int perm32(int rho) { const int n = rho >> 4, i = rho & 15; return 8 * (i >> 2) + 4 * n + (i & 3); }

struct Unit { int pm, pn, ks, kt0, nt; };
struct Gemm { const bf16_t* A; const bf16_t* Bt; int M, N, K; };

struct StaticOrder {
    int nM, nN, nwg, G, c, ntk;
    __host__ __device__ void init(int M, int N, int G_, int c_, int K) { nM = M / BM; nN = N / BM; nwg = nM * nN; G = G_; c = c_; ntk = K / BK; }
    __host__ __device__ bool next(int i, Unit& u) const {
        const long L = (long)i * G + c; if (L >= nwg) return false;
        int wgid = (int)L; { const int q = nwg / NXCD, r = nwg % NXCD, xcd = wgid % NXCD, off = wgid / NXCD; wgid = (xcd < r ? xcd * (q + 1) : r * (q + 1) + (xcd - r) * q) + off; }
        const int nig = WGM * nN, gid = wgid / nig, fm = gid * WGM, gsz = (nM - fm) < WGM ? (nM - fm) : WGM;
        u.pm = fm + ((wgid % nig) % gsz); u.pn = (wgid % nig) / gsz; u.ks = -1; u.kt0 = 0; u.nt = ntk; return true;
    }
    __device__ __forceinline__ void a_ready(const Unit&) const {}
    __device__ __forceinline__ void done(const Unit&) const {}
};


struct TailSplitOrder {
    int c, ntk, mode;
    __device__ void init(int c_, int K, int mode_) { c = c_; ntk = K / BK; mode = mode_; }
    __device__ bool next(int i, Unit& u) const {
        const int xcd = c & 7, j = c >> 3;
        const int round = mode == 2 ? i + 1 : i;
        if (round == 0) { u.pm = xcd * 8 + (j & 7); u.pn = j >> 3; u.ks = -1; u.kt0 = 0; u.nt = ntk; return true; }
        if (round == 1 && mode != 1) { u.pm = 64 + xcd * 2 + (j & 1); u.pn = (j >> 1) & 3; u.ks = j >> 3; u.nt = ntk >> 2; u.kt0 = u.ks * u.nt; return true; }
        return false;
    }
    __device__ __forceinline__ void a_ready(const Unit&) const {}
    __device__ __forceinline__ void done(const Unit&) const {}
};

typedef float f32x2c_t __attribute__((ext_vector_type(2))); typedef __bf16 bf16x2c_t __attribute__((ext_vector_type(2)));
__device__ __forceinline__ unsigned cvt_pk_bf16(float lo, float hi) { f32x2c_t v = {lo, hi}; bf16x2c_t b = __builtin_convertvector(v, bf16x2c_t); return __builtin_bit_cast(unsigned, b); }

template <int ACT> struct EpiBf16 {
    static constexpr bool PERM = true, AFTER_DRAIN = false;
    bf16_t* O; int ldc;
    __device__ __forceinline__ void operator()(const f32x4 (&acc)[2][2][4][2], const Unit& u, int wr, int wc, int fr, int fq) const {
        const int row0 = u.pm * BM + wr * 64 + fr; const int col0 = u.pn * BM + wc * 32 + 8 * fq;
#if defined(HYB_EPI_REP)
        for (int rep_ = 0; rep_ < HYB_EPI_REP; ++rep_) { asm volatile("" ::: "memory");
#endif
#pragma unroll
        for (int ai = 0; ai < 2; ++ai)
#pragma unroll
            for (int m = 0; m < 4; ++m) { bf16_t* rowp = O + (size_t)(row0 + ai * HALF + m * 16) * ldc + col0;
#pragma unroll
                for (int bj = 0; bj < 2; ++bj) { f32x4 v0 = acc[ai][bj][m][0], v1 = acc[ai][bj][m][1];
                    if (ACT == 1) {
#pragma unroll
                        for (int j = 0; j < 4; ++j) { const float a = fmaxf(v0[j], 0.f), b = fmaxf(v1[j], 0.f); v0[j] = a * a; v1[j] = b * b; } }
                    u32x4 w; w.x = cvt_pk_bf16(v0[0], v0[1]); w.y = cvt_pk_bf16(v0[2], v0[3]); w.z = cvt_pk_bf16(v1[0], v1[1]); w.w = cvt_pk_bf16(v1[2], v1[3]);
#if defined(HYB_NT_STORE)
                    __builtin_nontemporal_store(w, (u32x4*)(rowp + bj * HALF)); } }
#elif defined(HYB_SC1_STORE)
                    asm volatile("global_store_dwordx4 %0, %1, off sc1\n\ts_nop 1" :: "v"((u32x4*)(rowp + bj * HALF)), "v"(w) : "memory"); } }
#else
                    *(u32x4*)(rowp + bj * HALF) = w; } }
#endif
#if defined(HYB_EPI_REP)
        }
#endif
    }
};
struct EpiYsplit {
    static constexpr bool PERM = true, AFTER_DRAIN = false;
    bf16_t* Y; bf16_t* SL;
    __device__ __forceinline__ void operator()(const f32x4 (&acc)[2][2][4][2], const Unit& u, int wr, int wc, int fr, int fq) const {
        const int row0 = u.pm * BM + wr * 64 + fr; const int col0 = u.pn * BM + wc * 32 + 8 * fq;
        if (u.ks < 0) {
#pragma unroll
            for (int ai = 0; ai < 2; ++ai)
#pragma unroll
                for (int m = 0; m < 4; ++m) { bf16_t* rowp = Y + (size_t)(row0 + ai * HALF + m * 16) * 1024 + col0;
#pragma unroll
                    for (int bj = 0; bj < 2; ++bj) { const f32x4 v0 = acc[ai][bj][m][0], v1 = acc[ai][bj][m][1];
                        u32x4 w; w.x = cvt_pk_bf16(v0[0], v0[1]); w.y = cvt_pk_bf16(v0[2], v0[3]); w.z = cvt_pk_bf16(v1[0], v1[1]); w.w = cvt_pk_bf16(v1[2], v1[3]);
                        *(u32x4*)(rowp + bj * HALF) = w; } }
        } else {
            bf16_t* base = SL + (size_t)u.ks * (4096 * 1024);
#pragma unroll
            for (int ai = 0; ai < 2; ++ai)
#pragma unroll
                for (int m = 0; m < 4; ++m) { bf16_t* rowp = base + (size_t)(row0 - 16384 + ai * HALF + m * 16) * 1024 + col0;
#pragma unroll
                    for (int bj = 0; bj < 2; ++bj) { const f32x4 v0 = acc[ai][bj][m][0], v1 = acc[ai][bj][m][1];
                        u32x4 w; w.x = cvt_pk_bf16(v0[0], v0[1]); w.y = cvt_pk_bf16(v0[2], v0[3]); w.z = cvt_pk_bf16(v1[0], v1[1]); w.w = cvt_pk_bf16(v1[2], v1[3]);
                        *(u32x4*)(rowp + bj * HALF) = w; } }
        }
    }
};
struct EpiOddIn {
    static constexpr bool PERM = false, AFTER_DRAIN = true;
    bf16_t* QN; bf16_t* ACKV; float* KPERAW; float* out_ckv; float* out_kpe; const float* gq; const float* gkv; int li;
    __device__ __forceinline__ void fused(f32x4 (&acc)[2][2][4][2], const Unit& u, int wr, int wc, int fr, int fq, PG8_LAS unsigned char* lds, int wid, int lane) const {
        PG8_LAS float* P = (PG8_LAS float*)lds;
        if (u.pn < 2) {
#pragma unroll
            for (int ai = 0; ai < 2; ++ai)
#pragma unroll
                for (int m = 0; m < 4; ++m) { float s = 0.f;
#pragma unroll
                    for (int bj = 0; bj < 2; ++bj)
#pragma unroll
                        for (int n = 0; n < 2; ++n) { const f32x4 x = acc[ai][bj][m][n]; s += (x[0] * x[0] + x[1] * x[1]) + (x[2] * x[2] + x[3] * x[3]); }
                    s += __shfl_xor(s, 16); s += __shfl_xor(s, 32);
                    if (fq == 0) P[(ai * HALF + wr * 64 + m * 16 + fr) * 4 + wc] = s; }
        }
        asm volatile("s_waitcnt lgkmcnt(0)" ::: "memory"); __builtin_amdgcn_s_barrier(); asm volatile("" ::: "memory");
        if (u.pn < 2) {
            const float* gv = u.pn == 0 ? gq : gkv;
#pragma unroll
            for (int ai = 0; ai < 2; ++ai)
#pragma unroll
                for (int m = 0; m < 4; ++m) { const int r = ai * HALF + wr * 64 + m * 16 + fr; const int grow = u.pm * BM + r;
                    const float tot = (P[r * 4 + 0] + P[r * 4 + 1]) + (P[r * 4 + 2] + P[r * 4 + 3]);
                    const float rstd = 1.0f / sqrtf(tot * (1.0f / 256.0f) + 1e-6f);
                    const int drow = grow < 4096 ? grow : 4096 + ((grow - 4096) >> 11) * 2304 + 256 + ((grow - 4096) & 2047);
#pragma unroll
                    for (int bj = 0; bj < 2; ++bj)
#pragma unroll
                        for (int n = 0; n < 2; ++n) { const int col = bj * HALF + wc * 32 + n * 16 + 4 * fq; const f32x4 g = *(const f32x4*)(gv + col);
                            const f32x4 v = acc[ai][bj][m][n] * rstd * g;
                            unsigned long long w = (unsigned long long)cvt_pk_bf16(v[0], v[1]) | ((unsigned long long)cvt_pk_bf16(v[2], v[3]) << 32);
                            if (u.pn == 0) *(unsigned long long*)(QN + (size_t)grow * 256 + col) = w;
                            else { *(unsigned long long*)(ACKV + (size_t)drow * 256 + col) = w;
                                   if (grow < 4096) *(f32x4*)(out_ckv + ((size_t)((grow >> 8) * 2 + li) * 256 + (grow & 255)) * 256 + col) = v; } } }
        } else if (wc < 2) {
#pragma unroll
            for (int ai = 0; ai < 2; ++ai)
#pragma unroll
                for (int m = 0; m < 4; ++m) { const int r = ai * HALF + wr * 64 + m * 16 + fr; const int grow = u.pm * BM + r;
#pragma unroll
                    for (int n = 0; n < 2; ++n) { const int col = wc * 32 + n * 16 + 4 * fq; const f32x4 v = acc[ai][0][m][n];
                        *(f32x4*)(KPERAW + (size_t)grow * 64 + col) = v;
                        if (grow < 4096) *(f32x4*)(out_kpe + ((size_t)((grow >> 8) * 2 + li) * 256 + (grow & 255)) * 64 + col) = v; } }
        }
    }
};

template <class Epi, class Sched, bool ALIGN_EPI = false, bool SP2 = false>
__device__ __forceinline__ void gemm_phase(PG8_LAS unsigned char* lds, const Gemm g, const Sched& S, const Epi& E, const int tid) {
    const int  wid = __builtin_amdgcn_readfirstlane(tid >> 6), lane = tid & 63, wr = wid >> 2, wc = wid & 3, fr = lane & 15, fq = lane >> 4;
    const int K = g.K;
    unsigned voffA[2], voffB[2];
#pragma unroll
    for (int i = 0; i < 2; ++i) { int R, C; stage_rc(tid * 16 + i * 8192, R, C); const int Rb = Epi::PERM ? ((R & ~31) + perm32(R & 31)) : R;
        voffA[i] = (unsigned)(R * K + C) * 2u; voffB[i] = (unsigned)(Rb * K + C) * 2u; }
    const size_t kstep = (size_t)(BK * 2);
    const size_t hstep = (size_t)HALF * K * 2;
    const size_t tstep = 2 * hstep;
    const unsigned ldsw = (unsigned)wid * 1024u;
    const int aoff = lds_byte(wr * 64 + fr, fq * 8), boff = lds_byte(wc * 32 + fr, fq * 8);
#define PG8_SA(b, h) (((b) * 2 + (h)) * HTB)
#define PG8_SB(b, h) ((4 + (b) * 2 + (h)) * HTB)
#define PG8_STAGE(bufoff, gbase, voff) do { _Pragma("unroll") for (int _i = 0; _i < 2; ++_i) \
        __builtin_amdgcn_global_load_lds((const unsigned*)((const char*)(gbase) + (voff)[_i]), (PG8_LAS unsigned*)(lds + (bufoff) + ldsw + _i * 8192), 16, 0, 0); } while (0)
#define PG8_LDA(dst, b, h) do { _Pragma("unroll") for (int m = 0; m < 4; ++m) _Pragma("unroll") for (int k = 0; k < 2; ++k) dst[m][k] = *(const PG8_LAS bf16x8*)(lds + PG8_SA(b, h) + aoff + m * 2048 + k * 1024); } while (0)
#define PG8_LDB(dst, b, h) do { _Pragma("unroll") for (int n = 0; n < 2; ++n) _Pragma("unroll") for (int k = 0; k < 2; ++k) dst[n][k] = *(const PG8_LAS bf16x8*)(lds + PG8_SB(b, h) + boff + n * 2048 + k * 1024); } while (0)
#define PG8_MMA(ai, bj, At, Bt) do { __builtin_amdgcn_s_setprio(1); _Pragma("unroll") for (int m = 0; m < 4; ++m) _Pragma("unroll") for (int n = 0; n < 2; ++n) _Pragma("unroll") for (int k = 0; k < 2; ++k) \
        acc[ai][bj][m][n] = __builtin_amdgcn_mfma_f32_16x16x32_bf16(Bt[n][k], At[m][k], acc[ai][bj][m][n], 0, 0, 0); __builtin_amdgcn_s_setprio(0); } while (0)
#define PG8_WAIT_V(n) asm volatile("s_waitcnt vmcnt(" #n ")" ::: "memory")
#define PG8_WAIT_L(n) asm volatile("s_waitcnt lgkmcnt(" #n ")" ::: "memory")
#define PG8_BAR __builtin_amdgcn_s_barrier()
#define PG8_SCHED __builtin_amdgcn_sched_barrier(0)
    Unit cur, nxt; int ui = 0;
    if (!S.next(0, cur)) return;
    f32x4 acc[2][2][4][2];
#pragma unroll
    for (int a = 0; a < 2; ++a)
#pragma unroll
        for (int b = 0; b < 2; ++b)
#pragma unroll
            for (int m = 0; m < 4; ++m)
#pragma unroll
                for (int n = 0; n < 2; ++n) acc[a][b][m][n] = (f32x4){0.f, 0.f, 0.f, 0.f};
    bf16x8 At[4][2], B0[2][2], B1[2][2];
    const char* cA = (const char*)g.A + (size_t)cur.pm * tstep + (size_t)cur.kt0 * kstep; const char* cB = (const char*)g.Bt + (size_t)cur.pn * tstep + (size_t)cur.kt0 * kstep;
    S.a_ready(cur);
    if constexpr (SP2) {
        PG8_STAGE(PG8_SB(0, 0), cB, voffB); PG8_STAGE(PG8_SB(0, 1), cB + hstep, voffB); PG8_STAGE(PG8_SA(0, 0), cA, voffA); PG8_STAGE(PG8_SA(0, 1), cA + hstep, voffA);
        if (wr == 1) PG8_BAR;
        PG8_WAIT_V(2); PG8_BAR;
        PG8_STAGE(PG8_SB(1, 0), cB + kstep, voffB); PG8_STAGE(PG8_SA(1, 0), cA + kstep, voffA); PG8_STAGE(PG8_SB(1, 1), cB + hstep + kstep, voffB);
        PG8_WAIT_V(6); PG8_BAR;
    } else {
        PG8_STAGE(PG8_SB(0, 0), cB, voffB); PG8_STAGE(PG8_SA(0, 0), cA, voffA); PG8_STAGE(PG8_SB(0, 1), cB + hstep, voffB); PG8_STAGE(PG8_SA(0, 1), cA + hstep, voffA);
        if (wr == 1) PG8_BAR;
        PG8_WAIT_V(4); PG8_BAR;
        PG8_STAGE(PG8_SB(1, 0), cB + kstep, voffB); PG8_STAGE(PG8_SA(1, 0), cA + kstep, voffA); PG8_STAGE(PG8_SB(1, 1), cB + hstep + kstep, voffB);
        PG8_WAIT_V(6); PG8_BAR;
    }
    for (;;) {
        const bool has_next = S.next(ui + 1, nxt);
        const char* nA = has_next ? (const char*)g.A + (size_t)nxt.pm * tstep + (size_t)nxt.kt0 * kstep : cA; const char* nB = has_next ? (const char*)g.Bt + (size_t)nxt.pn * tstep + (size_t)nxt.kt0 * kstep : cB;
        const int nt = cur.nt;
        for (int t = 0; t < nt; t += 2) {
            const bool last = (t == nt - 2);
            const char* a1 = cA + (size_t)(t + 1) * kstep;
            const char* a2 = last ? nA : cA + (size_t)(t + 2) * kstep; const char* b2 = last ? nB : cB + (size_t)(t + 2) * kstep;
            const char* a3 = a2 + kstep; const char* b3 = b2 + kstep;
            if (last && has_next) S.a_ready(nxt);
            if constexpr (SP2) {
            PG8_LDB(B0, 0, 0); PG8_LDB(B1, 0, 1); PG8_SCHED; PG8_LDA(At, 0, 0); PG8_STAGE(PG8_SA(1, 1), a1 + hstep, voffA);
            PG8_WAIT_V(8); PG8_WAIT_L(0); PG8_BAR; PG8_MMA(0, 0, At, B0); PG8_MMA(0, 1, At, B1); PG8_BAR; PG8_SCHED;
            PG8_LDA(At, 0, 1); PG8_STAGE(PG8_SB(0, 0), b2, voffB); PG8_STAGE(PG8_SB(0, 1), b2 + hstep, voffB); PG8_STAGE(PG8_SA(0, 0), a2, voffA);
            PG8_WAIT_V(8); PG8_WAIT_L(0); PG8_BAR; PG8_MMA(1, 0, At, B0); PG8_MMA(1, 1, At, B1); PG8_BAR; PG8_SCHED;
            PG8_LDB(B0, 1, 0); PG8_LDB(B1, 1, 1); PG8_SCHED; PG8_LDA(At, 1, 0); PG8_STAGE(PG8_SA(0, 1), a2 + hstep, voffA);
            PG8_WAIT_V(8); PG8_WAIT_L(0); PG8_BAR; PG8_MMA(0, 0, At, B0); PG8_MMA(0, 1, At, B1); PG8_BAR; PG8_SCHED;
            PG8_LDA(At, 1, 1); PG8_STAGE(PG8_SB(1, 0), b3, voffB); PG8_STAGE(PG8_SB(1, 1), b3 + hstep, voffB); PG8_STAGE(PG8_SA(1, 0), a3, voffA);
            PG8_WAIT_V(8); PG8_WAIT_L(0); PG8_BAR; PG8_MMA(1, 0, At, B0); PG8_MMA(1, 1, At, B1); PG8_BAR; PG8_SCHED;
            } else {
            PG8_LDB(B0, 0, 0); PG8_SCHED; PG8_LDA(At, 0, 0); PG8_STAGE(PG8_SA(1, 1), a1 + hstep, voffA);
            PG8_WAIT_L(8); PG8_BAR; PG8_WAIT_L(0); PG8_MMA(0, 0, At, B0); PG8_BAR; PG8_SCHED;
            PG8_LDB(B1, 0, 1); PG8_STAGE(PG8_SB(0, 0), b2, voffB);
            PG8_BAR; PG8_WAIT_L(0); PG8_MMA(0, 1, At, B1); PG8_BAR;
            PG8_LDA(At, 0, 1); PG8_STAGE(PG8_SA(0, 0), a2, voffA);
            PG8_BAR; PG8_WAIT_L(0); PG8_MMA(1, 0, At, B0); PG8_BAR; PG8_SCHED;
            PG8_STAGE(PG8_SB(0, 1), b2 + hstep, voffB);
            PG8_WAIT_V(6); PG8_BAR; PG8_MMA(1, 1, At, B1); PG8_BAR;
            PG8_LDB(B0, 1, 0); PG8_SCHED; PG8_LDA(At, 1, 0); PG8_STAGE(PG8_SA(0, 1), a2 + hstep, voffA);
            PG8_WAIT_L(8); PG8_BAR; PG8_WAIT_L(0); PG8_MMA(0, 0, At, B0); PG8_BAR; PG8_SCHED;
            PG8_LDB(B1, 1, 1); PG8_STAGE(PG8_SB(1, 0), b3, voffB);
            PG8_BAR; PG8_WAIT_L(0); PG8_MMA(0, 1, At, B1); PG8_BAR;
            PG8_LDA(At, 1, 1); PG8_STAGE(PG8_SA(1, 0), a3, voffA);
            PG8_BAR; PG8_WAIT_L(0); PG8_MMA(1, 0, At, B0); PG8_BAR; PG8_SCHED;
            PG8_STAGE(PG8_SB(1, 1), b3 + hstep, voffB);
            PG8_WAIT_V(6); PG8_BAR; PG8_MMA(1, 1, At, B1); PG8_BAR;
            }
        }
        if constexpr (ALIGN_EPI) { if (wr == 0) PG8_BAR; }
        if constexpr (!Epi::AFTER_DRAIN) { E(acc, cur, wr, wc, fr, fq); S.done(cur); }
        if (!has_next) break;
#pragma unroll
        for (int a = 0; a < 2; ++a)
#pragma unroll
            for (int b = 0; b < 2; ++b)
#pragma unroll
                for (int m = 0; m < 4; ++m)
#pragma unroll
                    for (int n = 0; n < 2; ++n) acc[a][b][m][n] = (f32x4){0.f, 0.f, 0.f, 0.f};
        cur = nxt; cA = nA; cB = nB; ++ui;
        if constexpr (ALIGN_EPI) { if (wr == 1) PG8_BAR; }
    }
    PG8_WAIT_V(0);
    if constexpr (!ALIGN_EPI) { if (wr == 0) PG8_BAR; }
    PG8_BAR;
    if constexpr (Epi::AFTER_DRAIN) { E.fused(acc, cur, wr, wc, fr, fq, lds, wid, lane); S.done(cur); }
#undef PG8_SA
#undef PG8_SB
#undef PG8_STAGE
#undef PG8_LDA
#undef PG8_LDB
#undef PG8_MMA
#undef PG8_WAIT_V
#undef PG8_WAIT_L
#undef PG8_BAR
#undef PG8_SCHED
}
}

constexpr int NWAVES = 8;
constexpr int D = 1024, FF = 4096, M_CTX = 4096, M_LAT = 16384, M = M_CTX + M_LAT;
constexpr int L_LAT = 2048, L_CTX = 256, PAST = 256, LKV = PAST + L_LAT;
constexpr int MKV = M_CTX + 8 * LKV;
constexpr int EVEN_N = 3104, EVEN_NP = 3328, ODD_N = 576, ODD_NP = 768;
constexpr float EPS = 1e-6f;
constexpr int PC_QA = 0, PC_KA = 256, PC_VA = 512, PC_GA = 1024, PC_QB = 1536, PC_KB = 1792, PC_VB = 2048, PC_GB = 2560, PC_GK = 3072;
constexpr size_t OUT_Y = 0, OUT_CKV = 20971520, OUT_KPE = 23068672, OUT_SGLA = 23592960, OUT_SRET = 25690112;

constexpr size_t MiB = 1u << 20;
constexpr size_t WS_CTL = 0, CTL_ZERO_BYTES = 64 * 1024;
constexpr size_t WS_MOD = 1 * MiB;
constexpr size_t WS_ROPE = 2 * MiB;
constexpr size_t WS_KPE = 3 * MiB;
constexpr size_t WS_ACKV = 6 * MiB;
constexpr size_t WS_WINE = 18 * MiB;
constexpr size_t WS_WOUTE = 31 * MiB;
constexpr size_t WS_WINO = 35 * MiB;
constexpr size_t WS_WQB = 38 * MiB;
constexpr size_t WS_WKVB = 40 * MiB;
constexpr size_t WS_WOUTO = 42 * MiB;
constexpr size_t WS_W1 = 46 * MiB;
constexpr size_t WS_W2 = 78 * MiB;
constexpr size_t WS_HB = 110 * MiB;
constexpr size_t WS_Y = 150 * MiB;
constexpr size_t WS_BIG = 190 * MiB;
constexpr size_t WS_Q = WS_BIG, WS_KV = WS_BIG + 60 * MiB, WS_QN = WS_BIG + 148 * MiB;
constexpr size_t WS_SLAB = 350 * MiB;
constexpr size_t WS_END = 382 * MiB;

constexpr int RING_BYTES = 131072;
constexpr int LDS_MISC = 155648;
constexpr int LDS_BYTES = 163840;

#define GAS __attribute__((address_space(1)))
#define LAS __attribute__((address_space(3)))
typedef unsigned short bf16;
typedef unsigned v4u __attribute__((ext_vector_type(4)));
typedef unsigned v2u __attribute__((ext_vector_type(2)));
typedef float f32x4 __attribute__((ext_vector_type(4)));
typedef float f32x16 __attribute__((ext_vector_type(16)));
typedef short bf16x8 __attribute__((ext_vector_type(8)));
typedef short s16x4 __attribute__((ext_vector_type(4)));
#define LDS_WAIT() asm volatile("s_waitcnt lgkmcnt(0)" ::: "memory")
#define VM_WAIT() asm volatile("s_waitcnt vmcnt(0)" ::: "memory")
typedef float f32x2_t __attribute__((ext_vector_type(2))); typedef __bf16 bf16x2_t __attribute__((ext_vector_type(2)));
__device__ __forceinline__ unsigned pk2(float lo, float hi) { f32x2_t v = {lo, hi}; bf16x2_t b = __builtin_convertvector(v, bf16x2_t); return __builtin_bit_cast(unsigned, b); }
__device__ __forceinline__ unsigned f2bf(float f) { return pk2(f, f) & 0xffffu; }
__device__ __forceinline__ float bflo(unsigned w) { return __builtin_bit_cast(float, w << 16); }
__device__ __forceinline__ float bfhi(unsigned w) { return __builtin_bit_cast(float, w & 0xffff0000u); }
__device__ __forceinline__ float wave_sum(float v) {
#pragma unroll
    for (int o = 1; o < 64; o <<= 1) v += __shfl_xor(v, o);
    return v;
}
__device__ __forceinline__ float siluf(float x) { return x * __builtin_amdgcn_rcpf(1.0f + __expf(-x)); }

#define XB_TMO      128
#define XB_XCNT(j)  (256  + 64 * (j))
#define XB_XSUB(j)  (1280 + 64 * (j))
#define XB_XGEN(j)  (2304 + 64 * (j))
#define XB_TOP      3328
#define XB_TOPGEN   3392
#define XCD_BAR_WORDS 3456
#define XB_SPIN_CAP (1u << 20)
__device__ __forceinline__ unsigned xb_ld(unsigned* p)              { return __hip_atomic_load(p, __ATOMIC_RELAXED, __HIP_MEMORY_SCOPE_AGENT); }
__device__ __forceinline__ unsigned xb_add(unsigned* p, unsigned v) { return __hip_atomic_fetch_add(p, v, __ATOMIC_RELAXED, __HIP_MEMORY_SCOPE_AGENT); }
__device__ __forceinline__ unsigned xb_xcc_id() { return (unsigned)__builtin_amdgcn_s_getreg((3 << 11) | 20) & 0xFu; }
#define XB_SPIN(cond, bar) do { unsigned _sp = 0; while (cond) { __builtin_amdgcn_s_sleep(1); \
    if ((++_sp & 255u) == 0u) { if (xb_ld(&(bar)[XB_TMO])) break; if (_sp > XB_SPIN_CAP) { atomicAdd(&(bar)[XB_TMO], 1u); break; } } } } while (0)
struct XcdBarrier { unsigned* bar; unsigned x; volatile LAS unsigned* st; };
__device__ __forceinline__ XcdBarrier xcd_barrier_post(unsigned* bar, volatile LAS unsigned* st) {
    XcdBarrier b; b.bar = bar; b.x = xb_xcc_id(); b.st = st;
    if (threadIdx.x == 0) (void)xb_add(&bar[XB_XCNT(b.x)], 1u);
    return b;
}
__device__ __forceinline__ void xcd_barrier_complete(unsigned* bar, unsigned x, unsigned& nloc, unsigned& nx) {
    const unsigned G = gridDim.x * gridDim.y * gridDim.z;
    unsigned sum, cnt, mine, sp = 0u;
    for (;;) {
        sum = 0u; cnt = 0u; mine = 0u;
#pragma unroll
        for (unsigned j = 0; j < 16; ++j) { const unsigned c = xb_ld(&bar[XB_XCNT(j)]); sum += c; cnt += (c > 0u) ? 1u : 0u; mine = (j == x) ? c : mine; }
        if (sum == G) break;
        __builtin_amdgcn_s_sleep(1);
        if ((++sp & 255u) == 0u) { if (xb_ld(&bar[XB_TMO])) break; if (sp > XB_SPIN_CAP) { atomicAdd(&bar[XB_TMO], 1u); break; } }
    }
    nloc = mine > 0u ? mine : 1u; nx = cnt > 0u ? cnt : 1u;
}
__device__ __forceinline__ void xcd_barrier(const XcdBarrier& b) {
    asm volatile("s_waitcnt vmcnt(0)" ::: "memory");
    __syncthreads();
    if (threadIdx.x == 0) {
        unsigned* bar = b.bar;
        __builtin_amdgcn_s_waitcnt(0);
        unsigned nloc = b.st[0], nx = b.st[1];
        if (nloc == 0u) { xcd_barrier_complete(bar, b.x, nloc, nx); b.st[0] = nloc; b.st[1] = nx; }
        const unsigned old = xb_add(&bar[XB_XSUB(b.x)], 1u);
        const unsigned gen = old / nloc;
        if (old + 1u == (gen + 1u) * nloc) {
            __builtin_amdgcn_fence(__ATOMIC_RELEASE, "agent");
            asm volatile("s_waitcnt vmcnt(0)" ::: "memory");
            const unsigned og = xb_add(&bar[XB_TOP], 1u);
            const unsigned tg = og / nx;
            if (og + 1u == (tg + 1u) * nx) xb_add(&bar[XB_TOPGEN], 1u);
            else XB_SPIN(xb_ld(&bar[XB_TOPGEN]) == tg, bar);
            __builtin_amdgcn_fence(__ATOMIC_ACQUIRE, "agent");
            xb_add(&bar[XB_XGEN(b.x)], 1u);
            asm volatile("s_waitcnt vmcnt(0)" ::: "memory");
        } else {
            XB_SPIN(xb_ld(&bar[XB_XGEN(b.x)]) == gen, bar);
            __builtin_amdgcn_fence(__ATOMIC_ACQUIRE, "agent");
            asm volatile("s_waitcnt vmcnt(0)" ::: "memory");
        }
    }
    __syncthreads();
}

struct Params { const float* in[28]; float* out; unsigned char* ws; int ph_lo, ph_hi, use_bar, pad; };
enum { I_XP = 0, I_XS, I_CCKV, I_CKPE, I_SGLA, I_SRET, I_C, I_CCTX, I_WADA, I_BADA, I_NMIXPRE, I_NMIXPOST, I_NMLPPRE, I_NMLPPOST,
       I_WINE, I_WGK2, I_BGK2, I_GLAN, I_RDEC, I_WOUTE, I_WINO, I_QAN, I_WQB, I_KVAN, I_WKVB, I_WOUTO, I_W1, I_W2 };
struct Frame { LAS unsigned char* lds; int tid, lane, wave, vcu, G, bid; };
constexpr int LDS_PT = LDS_MISC + 256;
__device__ __forceinline__ const void* ldp(LAS unsigned char* lds, int i) {
    const volatile LAS unsigned* p = (const volatile LAS unsigned*)(lds + LDS_PT) + 2 * i;
    const unsigned lo = __builtin_amdgcn_readfirstlane(p[0]), hi = __builtin_amdgcn_readfirstlane(p[1]);
    return (const void*)(const GAS void*)(((unsigned long long)hi << 32) | lo);
}
#define PIN(i) ((const float*)ldp(F.lds, (i)))
#define POUT ((float*)ldp(F.lds, 28))
#define PWS ((unsigned char*)ldp(F.lds, 29))

__device__ __forceinline__ void p0_transpose_item(const float* W, int K, int N, bf16* WT, int kb, int n0, int dn0, LAS float* scr, int lane) {
    const int k0 = 64 * kb;
    f32x4 wv[8];
#pragma unroll
    for (int i = 0; i < 8; ++i) wv[i] = *(const f32x4*)(W + (size_t)(k0 + 8 * i + (lane >> 3)) * N + n0 + 4 * (lane & 7));
#pragma unroll
    for (int i = 0; i < 8; ++i) { LAS float* d = scr + (8 * i + (lane >> 3)) * 33 + 4 * (lane & 7); d[0] = wv[i][0]; d[1] = wv[i][1]; d[2] = wv[i][2]; d[3] = wv[i][3]; }
    LDS_WAIT(); asm volatile("" ::: "memory");
    const int c = lane & 7;
#pragma unroll
    for (int j = 0; j < 4; ++j) { const int n = (lane >> 3) + 8 * j; const LAS float* s = scr + (8 * c) * 33 + n;
        v4u o; o.x = pk2(s[0 * 33], s[1 * 33]); o.y = pk2(s[2 * 33], s[3 * 33]); o.z = pk2(s[4 * 33], s[5 * 33]); o.w = pk2(s[6 * 33], s[7 * 33]);
        *(GAS v4u*)(WT + (size_t)(dn0 + n) * K + k0 + 8 * c) = o; }
    LDS_WAIT(); asm volatile("" ::: "memory");
}
__device__ __forceinline__ int even_col_map(int n0) { return n0 < 1536 ? n0 : (n0 < 1568 ? 3072 + (n0 - 1536) : n0 - 32); }

__device__ __forceinline__ void setup_work(Frame& F, const Params& P, int wgi, int nwg, int amask  , int mmask  , int eimask  , int eomask  , int omask  ) {
    unsigned char* ws = PWS;
    LAS float* scr = (LAS float*)(F.lds + F.wave * 16384);
    __syncthreads();
    {
        LAS float* S = (LAS float*)(F.lds);
        LAS float* R = (LAS float*)(F.lds + 40960);
        { const float* cp_ = PIN(I_C); const float* cc_ = PIN(I_CCTX);
          for (int i = F.tid; i < 9 * 1024; i += 512) { const int n = i >> 10, d = i & 1023; const float cv = n < 8 ? cp_[n * 1024 + d] : cc_[d]; S[i] = siluf(cv); } }
        const float* wada_ = PIN(I_WADA); const float* bada_ = PIN(I_BADA);
        __syncthreads();
        const int nl = __builtin_popcount(amask);
        for (int uu = wgi; uu < nl * 64; uu += nwg) {
            int li_ = uu >> 6, l = 0; { int m_ = amask; for (int k_ = 0; k_ < 4; ++k_) { if (m_ & 1) { if (li_ == 0) { l = k_; break; } --li_; } m_ >>= 1; } }
            const int cb = (uu & 63) * 96;
            if (F.tid < 384) {
                const int c4 = (F.tid % 24) * 4, part = F.tid / 24;
                const float* Wp = wada_ + ((size_t)l * 1024 + part * 64) * 6144 + cb + c4;
                f32x4 a[9];
#pragma unroll
                for (int n = 0; n < 9; ++n) a[n] = (f32x4){0.f, 0.f, 0.f, 0.f};
#pragma unroll 4
                for (int d = 0; d < 64; ++d) { const f32x4 w = *(const f32x4*)(Wp + (size_t)d * 6144);
#pragma unroll
                    for (int n = 0; n < 9; ++n) a[n] += w * S[n * 1024 + part * 64 + d]; }
#pragma unroll
                for (int n = 0; n < 9; ++n) *(LAS f32x4*)(R + (part * 9 + n) * 96 + c4) = a[n];
            }
            __syncthreads();
            for (int i = F.tid; i < 9 * 96; i += 512) { const int n = i / 96, c = i % 96; float s = 0.f;
#pragma unroll
                for (int p = 0; p < 16; ++p) s += R[(p * 9 + n) * 96 + c];
                ((float*)(ws + WS_MOD))[((size_t)l * 9 + n) * 6144 + cb + c] = s + bada_[l * 6144 + cb + c]; }
            __syncthreads();
        }
    }
    {
        const int wk = wgi * NWAVES + F.wave, NW = nwg * NWAVES; int base = 0;
#define SEG(sel, count, ...) do { if (sel) { for (int q = (wk + NW - base % NW) % NW; q < (count); q += NW) { __VA_ARGS__; } base += (count); } } while (0)
        const int I_E = (1024 / 64) * (EVEN_N / 32), I_OE = 16 * 32, I_O = 16 * (ODD_N / 32), I_QB = 4 * 48, I_KVB = 4 * 64, I_M1 = 16 * 128, I_M2 = 64 * 32;
#pragma unroll
        for (int l = 0; l < 2; ++l) {
            SEG((eimask >> l) & 1, I_E, { const int nb = EVEN_N / 32, kb = q / nb, n0 = (q % nb) * 32;
                p0_transpose_item(PIN(I_WINE) + (size_t)l * 1024 * EVEN_N, 1024, EVEN_N, (bf16*)(ws + WS_WINE) + (size_t)l * EVEN_NP * 1024, kb, n0, even_col_map(n0), scr, F.lane); });
            SEG((eomask >> l) & 1, I_OE, { const int kb = q / 32, n0 = (q % 32) * 32;
                p0_transpose_item(PIN(I_WOUTE) + (size_t)l * 1024 * 1024, 1024, 1024, (bf16*)(ws + WS_WOUTE) + (size_t)l * 1024 * 1024, kb, n0, n0, scr, F.lane); });
            SEG((omask >> l) & 1, I_O, { const int nb = ODD_N / 32, kb = q / nb, n0 = (q % nb) * 32;
                p0_transpose_item(PIN(I_WINO) + (size_t)l * 1024 * ODD_N, 1024, ODD_N, (bf16*)(ws + WS_WINO) + (size_t)l * ODD_NP * 1024, kb, n0, n0, scr, F.lane); });
            SEG((omask >> l) & 1, I_QB, { const int kb = q / 48, n0 = (q % 48) * 32;
                p0_transpose_item(PIN(I_WQB) + (size_t)l * 256 * 1536, 256, 1536, (bf16*)(ws + WS_WQB) + (size_t)l * 1536 * 256, kb, n0, n0, scr, F.lane); });
            SEG((omask >> l) & 1, I_KVB, { const int kb = q / 64, n0 = (q % 64) * 32;
                p0_transpose_item(PIN(I_WKVB) + (size_t)l * 256 * 2048, 256, 2048, (bf16*)(ws + WS_WKVB) + (size_t)l * 2048 * 256, kb, n0, n0, scr, F.lane); });
            SEG((omask >> l) & 1, I_OE, { const int kb = q / 32, n0 = (q % 32) * 32;
                p0_transpose_item(PIN(I_WOUTO) + (size_t)l * 1024 * 1024, 1024, 1024, (bf16*)(ws + WS_WOUTO) + (size_t)l * 1024 * 1024, kb, n0, n0, scr, F.lane); });
        }
#pragma unroll
        for (int l = 0; l < 4; ++l) {
            SEG((mmask >> l) & 1, I_M1, { const int kb = q / 128, n0 = (q % 128) * 32;
                p0_transpose_item(PIN(I_W1) + (size_t)l * 1024 * 4096, 1024, 4096, (bf16*)(ws + WS_W1) + (size_t)l * 4096 * 1024, kb, n0, n0, scr, F.lane); });
            SEG((mmask >> l) & 1, I_M2, { const int kb = q / 32, n0 = (q % 32) * 32;
                p0_transpose_item(PIN(I_W2) + (size_t)l * 4096 * 1024, 4096, 1024, (bf16*)(ws + WS_W2) + (size_t)l * 1024 * 4096, kb, n0, n0, scr, F.lane); });
        }
#undef SEG
    }
    const int gt = wgi * 512 + F.tid, NGT = nwg * 512;
#pragma unroll
    for (int l = 0; l < 2; ++l) {
        if ((eimask >> l) & 1) for (int i = gt; i < 224 * 128; i += NGT) *(GAS v4u*)((bf16*)(ws + WS_WINE) + ((size_t)l * EVEN_NP + EVEN_N) * 1024 + (size_t)i * 8) = (v4u){0u, 0u, 0u, 0u};
        if ((omask >> l) & 1) for (int i = gt; i < 192 * 128; i += NGT) *(GAS v4u*)((bf16*)(ws + WS_WINO) + ((size_t)l * ODD_NP + ODD_N) * 1024 + (size_t)i * 8) = (v4u){0u, 0u, 0u, 0u};
    }
}
__device__ __forceinline__ void p0_prologue(Frame& F, const Params& P) {
    unsigned char* ws = PWS;
    setup_work(F, P, F.vcu, F.G, 0x5, 0x5, 0x3, 0x3, 0x0);
    const int gt = F.vcu * 512 + F.tid, NGT = F.G * 512;
    for (int i = gt; i < 2048 * 32; i += NGT) { const int t = i >> 5, j = i & 31; const float inv = powf(10000.0f, -(float)(j & 15) / 16.0f);
        const float ang = (float)(j < 16 ? (t >> 6) : (t & 63)) * inv;
        ((float*)(ws + WS_ROPE))[i] = cosf(ang); ((float*)(ws + WS_ROPE))[65536 + i] = sinf(ang); }
}

__device__ __forceinline__ void row_y(f32x4 (&yv)[4], const bf16* Y, const bf16* SL, int row, int l4) {
    if (row < 16384) {
#pragma unroll
        for (int j = 0; j < 4; ++j) { const v2u yw = *(const v2u*)(Y + (size_t)row * D + l4 + 256 * j); yv[j] = (f32x4){bflo(yw.x), bfhi(yw.x), bflo(yw.y), bfhi(yw.y)}; }
    } else {
        const bf16* sp = SL + (size_t)(row - 16384) * D + l4;
#pragma unroll
        for (int j = 0; j < 4; ++j) { const v2u w0 = *(const v2u*)(sp + 256 * j), w1 = *(const v2u*)(sp + 4194304 + 256 * j), w2 = *(const v2u*)(sp + 2 * 4194304 + 256 * j), w3 = *(const v2u*)(sp + 3 * 4194304 + 256 * j);
            yv[j] = ((f32x4){bflo(w0.x), bfhi(w0.x), bflo(w0.y), bfhi(w0.y)} + (f32x4){bflo(w1.x), bfhi(w1.x), bflo(w1.y), bfhi(w1.y)}) +
                    ((f32x4){bflo(w2.x), bfhi(w2.x), bflo(w2.y), bfhi(w2.y)} + (f32x4){bflo(w3.x), bfhi(w3.x), bflo(w3.y), bfhi(w3.y)}); }
    }
}
struct RowVec { f32x4 gp[4], gt[4], gq[4], sc[4], sh[4]; };
__device__ __forceinline__ void row_post(f32x4 (&v)[4], const f32x4 (&yv)[4], const RowVec& R) {
    float s = 0.f;
#pragma unroll
    for (int j = 0; j < 4; ++j) s += (yv[j][0] * yv[j][0] + yv[j][1] * yv[j][1]) + (yv[j][2] * yv[j][2] + yv[j][3] * yv[j][3]);
    const float rstd = __builtin_amdgcn_rsqf(wave_sum(s) * (1.0f / 1024.0f) + EPS);
#pragma unroll
    for (int j = 0; j < 4; ++j) v[j] = v[j] + R.gt[j] * ((yv[j] * rstd) * R.gp[j]);
}
__device__ __forceinline__ void row_pass(Frame& F, const float* xa, const float* xb, bool xin_f32, bf16* XB, const bf16* Y, const bf16* SL, const float* g_post, const float* gate,
                                         const float* g_pre, const float* scale, const float* shift, bf16* H, bool has_post, bool has_pre) {
    const int gw = F.vcu * NWAVES + F.wave, NGW = F.G * NWAVES, l4 = F.lane * 4;
    RowVec R; int ncur = -1;
#pragma unroll
    for (int j = 0; j < 4; ++j) { R.gp[j] = has_post ? *(const f32x4*)(g_post + l4 + 256 * j) : (f32x4){0.f, 0.f, 0.f, 0.f}; R.gq[j] = has_pre ? *(const f32x4*)(g_pre + l4 + 256 * j) : (f32x4){0.f, 0.f, 0.f, 0.f};
        R.gt[j] = R.gp[j]; R.sc[j] = R.gp[j]; R.sh[j] = R.gp[j]; }
    for (int blk = gw; blk * 10 < M; blk += NGW) for (int i = 0; i < 10; i += 2) {
        const int row0 = blk * 10 + i; if (row0 >= M) break;
        const int n = row0 < M_CTX ? 8 : ((row0 - M_CTX) >> 11);
        if (n != ncur) { ncur = n;
#pragma unroll
            for (int j = 0; j < 4; ++j) { const int c = l4 + 256 * j;
                if (has_post) R.gt[j] = *(const f32x4*)(gate + (size_t)n * 6144 + c);
                if (has_pre) { R.sc[j] = *(const f32x4*)(scale + (size_t)n * 6144 + c); R.sh[j] = *(const f32x4*)(shift + (size_t)n * 6144 + c); } } }
        f32x4 v[2][4], yv[2][4];
#pragma unroll
        for (int q = 0; q < 2; ++q) { const int row = row0 + q;
            if (xin_f32) { const float* xr = row < M_CTX ? xa + (size_t)row * D : xb + (size_t)(row - M_CTX) * D;
#pragma unroll
                for (int j = 0; j < 4; ++j) v[q][j] = *(const f32x4*)(xr + l4 + 256 * j);
            } else {
#pragma unroll
                for (int j = 0; j < 4; ++j) { const v2u xw = *(const v2u*)(XB + (size_t)row * D + l4 + 256 * j); v[q][j] = (f32x4){bflo(xw.x), bfhi(xw.x), bflo(xw.y), bfhi(xw.y)}; }
            }
            if (has_post) row_y(yv[q], Y, SL, row, l4); }
#pragma unroll
        for (int q = 0; q < 2; ++q) { const int row = row0 + q;
            if (has_post) {
                row_post(v[q], yv[q], R);
#pragma unroll
                for (int j = 0; j < 4; ++j) *(v2u*)(XB + (size_t)row * D + l4 + 256 * j) = (v2u){pk2(v[q][j][0], v[q][j][1]), pk2(v[q][j][2], v[q][j][3])};
            }
            if (has_pre) {
                float s = 0.f;
#pragma unroll
                for (int j = 0; j < 4; ++j) s += (v[q][j][0] * v[q][j][0] + v[q][j][1] * v[q][j][1]) + (v[q][j][2] * v[q][j][2] + v[q][j][3] * v[q][j][3]);
                const float rstd = __builtin_amdgcn_rsqf(wave_sum(s) * (1.0f / 1024.0f) + EPS);
#pragma unroll
                for (int j = 0; j < 4; ++j) { const f32x4 h = ((v[q][j] * rstd) * R.gq[j]) * (1.0f + R.sc[j]) + R.sh[j];
                    *(v2u*)(H + (size_t)row * D + l4 + 256 * j) = (v2u){pk2(h[0], h[1]), pk2(h[2], h[3])}; }
            } }
    }
}
__device__ __forceinline__ void row_pass_final(Frame& F, const XcdBarrier& bar, const bf16* XB, float* OUT, const bf16* Y, const bf16* SL, const float* g_post, const float* gate) {
    const int gw = F.vcu * NWAVES + F.wave, l4 = F.lane * 4;
    v2u xw[10][4];
#pragma unroll
    for (int i = 0; i < 10; ++i) { const int row = gw * 10 + i;
        if (row < M) {
#pragma unroll
            for (int j = 0; j < 4; ++j) xw[i][j] = *(const v2u*)(XB + (size_t)row * D + l4 + 256 * j);
        } }
    xcd_barrier(bar);
    RowVec R; int ncur = -1;
#pragma unroll
    for (int j = 0; j < 4; ++j) { R.gp[j] = *(const f32x4*)(g_post + l4 + 256 * j); R.gt[j] = R.gp[j]; }
#pragma unroll
    for (int i = 0; i < 10; ++i) { const int row = gw * 10 + i;
        if (row < M) {
            const int n = row < M_CTX ? 8 : ((row - M_CTX) >> 11);
            if (n != ncur) { ncur = n;
#pragma unroll
                for (int j = 0; j < 4; ++j) R.gt[j] = *(const f32x4*)(gate + (size_t)n * 6144 + l4 + 256 * j); }
            f32x4 v[4], yv[4];
#pragma unroll
            for (int j = 0; j < 4; ++j) v[j] = (f32x4){bflo(xw[i][j].x), bfhi(xw[i][j].x), bflo(xw[i][j].y), bfhi(xw[i][j].y)};
            row_y(yv, Y, SL, row, l4); row_post(v, yv, R);
#pragma unroll
            for (int j = 0; j < 4; ++j) *(f32x4*)(OUT + (size_t)row * D + l4 + 256 * j) = v[j];
        } }
}

__device__ __forceinline__ int crow(int r, int hi) { return (r & 3) + 8 * (r >> 2) + 4 * hi; }
__device__ __forceinline__ unsigned cvtpk(float lo, float hi) { return pk2(lo, hi); }
#define SBAR() __builtin_amdgcn_sched_barrier(0)
__device__ __forceinline__ int vst_row(int k, int NB) { const int kk = (k & ~0xC) | ((k & 4) << 1) | ((k & 8) >> 1); return (kk >> 3) * NB * 512 + (kk & 7) * 64; }
__device__ __forceinline__ int vst(int k, int c, int NB) { return vst_row(k, NB) + (c >> 5) * 512 + (c & 31) * 2; }
__device__ __forceinline__ int v_rd_base(int lane) { return ((lane & 3) << 3) | (((lane >> 2) & 3) << 6) | (((lane >> 4) & 1) << 5) | (((lane >> 5) & 1) << 8); }
template <int OFF> __device__ __forceinline__ s16x4 tr_read(unsigned vb) { s16x4 r; asm volatile("ds_read_b64_tr_b16 %0, %1 offset:%2" : "=&v"(r) : "v"(vb), "i"(OFF) : "memory"); return r; }
#define PKF(L, H) ((bf16x8){L[0], L[1], L[2], L[3], H[0], H[1], H[2], H[3]})
#define PK4(P, BASE, OUT) do { unsigned a0_ = cvtpk(P[BASE + 0], P[BASE + 1]), a1_ = cvtpk(P[BASE + 2], P[BASE + 3]);   \
    unsigned b0_ = cvtpk(P[BASE + 4], P[BASE + 5]), b1_ = cvtpk(P[BASE + 6], P[BASE + 7]);                              \
    auto r0_ = __builtin_amdgcn_permlane32_swap(a0_, b0_, false, false); auto r1_ = __builtin_amdgcn_permlane32_swap(a1_, b1_, false, false); \
    v4u w_ = {r0_[0], r1_[0], r0_[1], r1_[1]}; OUT = __builtin_bit_cast(bf16x8, w_); } while (0)
__device__ __forceinline__ float fexp(float x) { return __builtin_amdgcn_exp2f(x * 1.4426950408889634f); }
__device__ __forceinline__ float logsig(float x) { return fminf(x, 0.f) - 0.6931471805599453f * __builtin_amdgcn_logf(1.0f + __builtin_amdgcn_exp2f(-1.4426950408889634f * fabsf(x))); }

constexpr int SC_T = 0  , SC_TSZ = 32768, SC_QD = 0, SC_KI = 8192, SC_VT = 16384, SC_ST = 65536, SC_BT = 81920  , SC_TOT = 114688, SC_DL = 115200  ;
__device__ __forceinline__ void scan_phase(Frame& F, const Params& P, int li) {
    unsigned char* ws = PWS;
    const bf16* PROJ = (const bf16*)(ws + WS_BIG);
    const float* ROPE = (const float*)(ws + WS_ROPE);
    LAS unsigned char* G = F.lds;
    const unsigned gaddr = (unsigned)(uintptr_t)G;
    const bool isP = F.wave >= 4; const int gw4 = F.wave & 3;
    const int ri = gw4 >> 1, dh = gw4 & 1;
#define SC_BAR() do { asm volatile("s_waitcnt lgkmcnt(0)" ::: "memory"); __builtin_amdgcn_s_barrier(); asm volatile("" ::: "memory"); } while (0)
#define SC_TOK(c, i) (dir == 0 ? 64 * (c) + (i) : L - 1 - (64 * (c) + (i)))
    for (int u0 = F.bid; u0 < 256; u0 += F.G) for (int kk_ = 0; kk_ < (u0 < 128 ? 1 : 2); ++kk_) {
        __syncthreads();
        const bool lat = u0 < 128; const int u = lat ? u0 : 2 * (u0 - 128) + kk_;
        const int sb = u >> 4, hh = (u >> 1) & 7, dir = u & 1;
        const int L = lat ? L_LAT : L_CTX, row0 = lat ? M_CTX + sb * L_LAT : sb * L_CTX, NC = L / 64;
        const bool gla = hh < 4; const int h = hh & 3;
        const int qc = (gla ? PC_QA : PC_QB) + h * 64, kc = (gla ? PC_KA : PC_KB) + h * 64, vc = (gla ? PC_VA : PC_VB) + h * 128, gkc = PC_GK + dir * 16;
        bf16* OUT = (bf16*)(ws + (dir == 0 ? WS_Y : WS_HB));
        const float* rdec_p = PIN(I_RDEC); const float* wgk2_p = PIN(I_WGK2); const float* bgk2_p = PIN(I_BGK2);
        const float lgr = gla ? 0.f : -fexp(rdec_p[(li * 2 + dir) * 4 + h]);
        f32x16 sacc[2]; sacc[0] = f32x16{}; sacc[1] = f32x16{}; v4u w2f = {0u, 0u, 0u, 0u}; float gbias = 0.f;
        { int t0_ = F.tid; asm volatile("" : "+v"(t0_)); const int lane = t0_ & 63, r32 = lane & 31, hi = lane >> 5;
          if (isP) {
              if (gla) { const int kcol = h * 64 + 32 * (gw4 & 1) + r32; const float* wp_ = wgk2_p + ((size_t)(li * 2 + dir) * 16 + 8 * hi) * 256 + kcol;
                  w2f = (v4u){pk2(wp_[0], wp_[256]), pk2(wp_[512], wp_[768]), pk2(wp_[1024], wp_[1280]), pk2(wp_[1536], wp_[1792])};
                  gbias = bgk2_p[(li * 2 + dir) * 256 + kcol]; }
              else if (t0_ < 256 + 192) ((LAS float*)(G + SC_DL))[t0_ - 256] = fexp(64.0f * lgr);
          } else {
              const float* S0 = (gla ? PIN(I_SGLA) : PIN(I_SRET)) + ((size_t)((sb * 2 + li) * 2 + dir) * 4 + h) * 8192;
              if (lat) {
#pragma unroll
                  for (int d = 0; d < 2; ++d)
#pragma unroll
                      for (int r = 0; r < 16; ++r) sacc[d][r] = S0[(32 * ri + crow(r, hi)) * 128 + 32 * (2 * dh + d) + r32];
              }
#pragma unroll
              for (int d = 0; d < 2; ++d)
#pragma unroll
                  for (int r = 0; r < 16; r += 2) { const unsigned w = pk2(sacc[d][r], sacc[d][r + 1]);
                      LAS unsigned char* sp_ = G + SC_ST + (hi + 4 * ri) * 2048 + (2 * dh + d) * 512 + r32 * 2 + ((r >> 3) & 1) * 4096 + ((r & 3) + 4 * ((r >> 2) & 1)) * 64;
                      *(LAS unsigned short*)sp_ = (unsigned short)w; *(LAS unsigned short*)(sp_ + 64) = (unsigned short)(w >> 16); }
          } }
        v4u pq0 = {}, pq1 = {}, pk0 = {}, pk1 = {}, pv[4] = {}; v4u pga = {0u, 0u, 0u, 0u}; float cs[16] = {}; float tsum = 0.f;
#define SC_LOADRAW(c) do { const unsigned ro_ = (unsigned)(row0 + SC_TOK(c, sti)) * (unsigned)(EVEN_NP * 2); const char* pc_ = (const char*)PROJ; \
        pq0 = *(const v4u*)(pc_ + (ro_ + (unsigned)(qc + 8 * c8) * 2u)); pq1 = *(const v4u*)(pc_ + (ro_ + (unsigned)(qc + 32 + 8 * c8) * 2u)); \
        pk0 = *(const v4u*)(pc_ + (ro_ + (unsigned)(kc + 8 * c8) * 2u)); pk1 = *(const v4u*)(pc_ + (ro_ + (unsigned)(kc + 32 + 8 * c8) * 2u)); \
        _Pragma("unroll") for (int m_ = 0; m_ < 4; ++m_) pv[m_] = *(const v4u*)(pc_ + (ro_ + (unsigned)(vc + c8 * 32 + 8 * m_) * 2u)); } while (0)
#define SC_LOADGK(c) do { pga = *(const v4u*)((const char*)PROJ + ((unsigned)(row0 + SC_TOK(c, 32 * (gw4 >> 1) + r32)) * (unsigned)(EVEN_NP * 2) + (unsigned)(gkc + 8 * hi) * 2u)); } while (0)
        if (isP && gla) { int t0_ = F.tid; asm volatile("" : "+v"(t0_)); const int r32 = t0_ & 31, hi = (t0_ >> 5) & 1; SC_LOADGK(0); }
        for (int s = -3; s < NC; ++s) {
            int tid_o = F.tid; asm volatile("" : "+v"(tid_o));
            const int lane = tid_o & 63, r32 = lane & 31, hi = lane >> 5, tgp = tid_o & 255, sti = tgp >> 2, c8 = tgp & 3;
            if (isP) {
                if (gla && s + 2 >= 0 && s + 2 < NC) {
                    const int th = gw4 >> 1, kq = 32 * (gw4 & 1) + r32; LAS float* BTw = (LAS float*)(G + SC_BT + ((s + 2) & 1) * 16384);
                    const float t0v = ((LAS float*)(G + SC_TOT))[kq]; const float pre = th ? t0v : 0.f;
#pragma unroll
                    for (int r = 0; r < 16; ++r) BTw[(32 * th + crow(r, hi)) * 64 + kq] = pre + cs[r];
                    if (th == 1 && hi == 0) ((LAS float*)(G + SC_DL))[((s + 2) % 3) * 64 + kq] = fexp(pre + tsum);
                }
                if (s + 1 >= 0 && s + 1 < NC) {
                    LAS unsigned char* T = G + SC_T + ((s + 1) & 1) * SC_TSZ;
                    float q[16], kk[16];
#define UNPK(dst, o, W_) do { const v4u w_ = (W_); dst[o + 0] = bflo(w_[0]); dst[o + 1] = bfhi(w_[0]); dst[o + 2] = bflo(w_[1]); dst[o + 3] = bfhi(w_[1]); dst[o + 4] = bflo(w_[2]); dst[o + 5] = bfhi(w_[2]); dst[o + 6] = bflo(w_[3]); dst[o + 7] = bfhi(w_[3]); } while (0)
                    UNPK(q, 0, pq0); UNPK(q, 8, pq1); UNPK(kk, 0, pk0); UNPK(kk, 8, pk1);
                    if (gla) {
                        const LAS float* BTr = (const LAS float*)(G + SC_BT + ((s + 1) & 1) * 16384) + sti * 64 + 8 * c8;
                        const f32x4 x0 = *(const LAS f32x4*)BTr, x1 = *(const LAS f32x4*)(BTr + 4), x2 = *(const LAS f32x4*)(BTr + 32), x3 = *(const LAS f32x4*)(BTr + 36);
#pragma unroll
                        for (int e = 0; e < 4; ++e) { const float e0 = fexp(x0[e]), e1 = fexp(x1[e]), e2 = fexp(x2[e]), e3 = fexp(x3[e]);
                            q[e] *= 0.125f * e0; kk[e] *= __builtin_amdgcn_rcpf(e0); q[4 + e] *= 0.125f * e1; kk[4 + e] *= __builtin_amdgcn_rcpf(e1);
                            q[8 + e] *= 0.125f * e2; kk[8 + e] *= __builtin_amdgcn_rcpf(e2); q[12 + e] *= 0.125f * e3; kk[12 + e] *= __builtin_amdgcn_rcpf(e3); }
                    } else {
                        if (lat) {
                            const float* cp = ROPE + (size_t)SC_TOK(s + 1, sti) * 32 + 8 * c8; const f32x4 c0 = *(const f32x4*)cp, c1 = *(const f32x4*)(cp + 4), s0 = *(const f32x4*)(cp + 65536), s1 = *(const f32x4*)(cp + 65540);
#pragma unroll
                            for (int e = 0; e < 8; ++e) { const float c = e < 4 ? c0[e & 3] : c1[e & 3], sn = e < 4 ? s0[e & 3] : s1[e & 3];
                                const float q1 = q[e], q2 = q[8 + e]; q[e] = q1 * c - q2 * sn; q[8 + e] = q1 * sn + q2 * c;
                                const float k1 = kk[e], k2 = kk[8 + e]; kk[e] = k1 * c - k2 * sn; kk[8 + e] = k1 * sn + k2 * c; }
                        }
                        const float bb = (float)(sti + 1) * lgr, eb = fexp(bb), ek = 0.125f * __builtin_amdgcn_rcpf(eb);
#pragma unroll
                        for (int e = 0; e < 16; ++e) { q[e] *= eb; kk[e] *= ek; }
                    }
                    *(LAS v4u*)(T + SC_QD + vst(sti, 8 * c8, 2)) = (v4u){pk2(q[0], q[1]), pk2(q[2], q[3]), pk2(q[4], q[5]), pk2(q[6], q[7])};
                    *(LAS v4u*)(T + SC_QD + vst(sti, 32 + 8 * c8, 2)) = (v4u){pk2(q[8], q[9]), pk2(q[10], q[11]), pk2(q[12], q[13]), pk2(q[14], q[15])};
                    *(LAS v4u*)(T + SC_KI + vst(sti, 8 * c8, 2)) = (v4u){pk2(kk[0], kk[1]), pk2(kk[2], kk[3]), pk2(kk[4], kk[5]), pk2(kk[6], kk[7])};
                    *(LAS v4u*)(T + SC_KI + vst(sti, 32 + 8 * c8, 2)) = (v4u){pk2(kk[8], kk[9]), pk2(kk[10], kk[11]), pk2(kk[12], kk[13]), pk2(kk[14], kk[15])};
#pragma unroll
                    for (int m = 0; m < 4; ++m) *(LAS v4u*)(T + SC_VT + vst(sti, c8 * 32 + 8 * m, 4)) = pv[m];
                }
                if (s + 2 >= 0 && s + 2 < NC) SC_LOADRAW(s + 2);
            } else if (s >= 0) {
                LAS unsigned char* T = G + SC_T + (s & 1) * SC_TSZ; const unsigned taddr = gaddr + SC_T + (s & 1) * SC_TSZ;
                bf16x8 qf[4]; bf16x8 pa0, pa1, pa2, pa3;
                { const int qb_ = vst_row(32 * ri + r32, 2) + 16 * hi;
                  qf[0] = *(const LAS bf16x8*)(T + SC_QD + qb_); qf[1] = *(const LAS bf16x8*)(T + SC_QD + qb_ + 32); qf[2] = *(const LAS bf16x8*)(T + SC_QD + qb_ + 512); qf[3] = *(const LAS bf16x8*)(T + SC_QD + qb_ + 544); }
                { f32x16 p0 = {}, p1 = {};
                  const int kb0 = vst_row(r32, 2) + 16 * hi, kb1 = vst_row(32 + r32, 2) + 16 * hi;
                  { const bf16x8 a0 = *(const LAS bf16x8*)(T + SC_KI + kb0), a1 = *(const LAS bf16x8*)(T + SC_KI + kb0 + 32), a2 = *(const LAS bf16x8*)(T + SC_KI + kb0 + 512), a3 = *(const LAS bf16x8*)(T + SC_KI + kb0 + 544);
                    p0 = __builtin_amdgcn_mfma_f32_32x32x16_bf16(a0, qf[0], p0, 0, 0, 0); p0 = __builtin_amdgcn_mfma_f32_32x32x16_bf16(a1, qf[1], p0, 0, 0, 0);
                    p0 = __builtin_amdgcn_mfma_f32_32x32x16_bf16(a2, qf[2], p0, 0, 0, 0); p0 = __builtin_amdgcn_mfma_f32_32x32x16_bf16(a3, qf[3], p0, 0, 0, 0); }
                  if (ri == 1) {
                      const bf16x8 c0 = *(const LAS bf16x8*)(T + SC_KI + kb1), c1 = *(const LAS bf16x8*)(T + SC_KI + kb1 + 32), c2 = *(const LAS bf16x8*)(T + SC_KI + kb1 + 512), c3 = *(const LAS bf16x8*)(T + SC_KI + kb1 + 544);
                      p1 = __builtin_amdgcn_mfma_f32_32x32x16_bf16(c0, qf[0], p1, 0, 0, 0); p1 = __builtin_amdgcn_mfma_f32_32x32x16_bf16(c1, qf[1], p1, 0, 0, 0);
                      p1 = __builtin_amdgcn_mfma_f32_32x32x16_bf16(c2, qf[2], p1, 0, 0, 0); p1 = __builtin_amdgcn_mfma_f32_32x32x16_bf16(c3, qf[3], p1, 0, 0, 0); }
#pragma unroll
                  for (int r = 0; r < 16; ++r) { const bool keep = crow(r, hi) <= r32; if (ri == 0) { p0[r] = keep ? p0[r] : 0.f; } else { p1[r] = keep ? p1[r] : 0.f; } }
                  PK4(p0, 0, pa0); PK4(p0, 8, pa1); PK4(p1, 0, pa2); PK4(p1, 8, pa3); }
                const unsigned vb = taddr + SC_VT + v_rd_base(lane) + dh * 1024, sbv = gaddr + SC_ST + v_rd_base(lane) + dh * 1024;
#define SC_FR4(dst, base, d) do { const s16x4 l0_ = tr_read<(d) * 512>(base), h0_ = tr_read<(d) * 512 + 2048>(base), l1_ = tr_read<(d) * 512 + 4096>(base), h1_ = tr_read<(d) * 512 + 4096 + 2048>(base); \
                  const s16x4 l2_ = tr_read<(d) * 512 + 8192>(base), h2_ = tr_read<(d) * 512 + 8192 + 2048>(base), l3_ = tr_read<(d) * 512 + 12288>(base), h3_ = tr_read<(d) * 512 + 12288 + 2048>(base); \
                  asm volatile("s_waitcnt lgkmcnt(0)" ::: "memory"); SBAR(); \
                  dst[0] = PKF(l0_, h0_); dst[1] = PKF(l1_, h1_); dst[2] = PKF(l2_, h2_); dst[3] = PKF(l3_, h3_); } while (0)
#define SC_OBLK(d) do { bf16x8 vf_[4], sf_[4]; SC_FR4(vf_, vb, d); SC_FR4(sf_, sbv, d); f32x16 o_ = {}; \
                  o_ = __builtin_amdgcn_mfma_f32_32x32x16_bf16(pa0, vf_[0], o_, 0, 0, 0); o_ = __builtin_amdgcn_mfma_f32_32x32x16_bf16(pa1, vf_[1], o_, 0, 0, 0); \
                  if (ri == 1) { o_ = __builtin_amdgcn_mfma_f32_32x32x16_bf16(pa2, vf_[2], o_, 0, 0, 0); o_ = __builtin_amdgcn_mfma_f32_32x32x16_bf16(pa3, vf_[3], o_, 0, 0, 0); } \
                  o_ = __builtin_amdgcn_mfma_f32_32x32x16_bf16(qf[0], sf_[0], o_, 0, 0, 0); o_ = __builtin_amdgcn_mfma_f32_32x32x16_bf16(qf[1], sf_[1], o_, 0, 0, 0); \
                  o_ = __builtin_amdgcn_mfma_f32_32x32x16_bf16(qf[2], sf_[2], o_, 0, 0, 0); o_ = __builtin_amdgcn_mfma_f32_32x32x16_bf16(qf[3], sf_[3], o_, 0, 0, 0); \
                  char* dst_ = (char*)OUT; \
                  _Pragma("unroll") for (int r = 0; r < 16; r += 2) { const int i_ = 32 * ri + crow(r, hi); const int t_ = SC_TOK(s, i_); const unsigned w_ = pk2(o_[r], o_[r + 1]); \
                      const unsigned a_ = (unsigned)(row0 + t_) * (unsigned)(D * 2) + (unsigned)(hh * 128 + 64 * dh + 32 * (d) + r32) * 2u; \
                      *(bf16*)(dst_ + a_) = (bf16)w_; *(bf16*)(dst_ + (dir == 0 ? a_ + (unsigned)(D * 2) : a_ - (unsigned)(D * 2))) = (bf16)(w_ >> 16); } SBAR(); } while (0)
                SC_OBLK(0); SC_OBLK(1);
            }
            SC_BAR();
            if (isP) {
                if (gla && s + 3 < NC) {
                    const int th = gw4 >> 1, kq = 32 * (gw4 & 1) + r32;
                    f32x16 gp;
#pragma unroll
                    for (int r = 0; r < 16; ++r) gp[r] = gbias;
                    gp = __builtin_amdgcn_mfma_f32_32x32x16_bf16(__builtin_bit_cast(bf16x8, pga), __builtin_bit_cast(bf16x8, w2f), gp, 0, 0, 0);
                    float g4[4], o4[4];
#pragma unroll
                    for (int j = 0; j < 4; ++j) { float run = 0.f;
#pragma unroll
                        for (int e = 0; e < 4; ++e) { run += logsig(gp[4 * j + e]) * (1.0f / 16.0f); cs[4 * j + e] = run; }
                        g4[j] = run; }
#pragma unroll
                    for (int j = 0; j < 4; ++j) o4[j] = __shfl_xor(g4[j], 32);
                    float acc_ = 0.f;
#pragma unroll
                    for (int j = 0; j < 4; ++j) { const float off = acc_ + (hi ? o4[j] : 0.f);
#pragma unroll
                        for (int e = 0; e < 4; ++e) cs[4 * j + e] += off;
                        acc_ += g4[j] + o4[j]; }
                    tsum = acc_;
                    if (hi == 0) ((LAS float*)(G + SC_TOT))[th * 64 + kq] = tsum;
                    if (s + 4 < NC) SC_LOADGK(s + 4);
                }
            } else if (s >= 0) {
                const unsigned taddr = gaddr + SC_T + (s & 1) * SC_TSZ;
                const unsigned vb = taddr + SC_VT + v_rd_base(lane) + dh * 1024, kt = taddr + SC_KI + v_rd_base(lane) + ri * 512;
                bf16x8 kf[4];
                { const s16x4 l0_ = tr_read<0>(kt), h0_ = tr_read<1024>(kt), l1_ = tr_read<2048>(kt), h1_ = tr_read<2048 + 1024>(kt), l2_ = tr_read<4096>(kt), h2_ = tr_read<4096 + 1024>(kt), l3_ = tr_read<6144>(kt), h3_ = tr_read<6144 + 1024>(kt);
                  asm volatile("s_waitcnt lgkmcnt(0)" ::: "memory"); SBAR();
                  kf[0] = PKF(l0_, h0_); kf[1] = PKF(l1_, h1_); kf[2] = PKF(l2_, h2_); kf[3] = PKF(l3_, h3_); }
                const int stb_ = (hi + 4 * ri) * 2048 + (2 * dh) * 512 + r32 * 2;
                const LAS float* DLr = (const LAS float*)(G + SC_DL) + (s % 3) * 64;
#define SC_SBLK(d) do { bf16x8 vf_[4]; SC_FR4(vf_, vb, d); \
                  _Pragma("unroll") for (int ks = 0; ks < 4; ++ks) sacc[d] = __builtin_amdgcn_mfma_f32_32x32x16_bf16(kf[ks], vf_[ks], sacc[d], 0, 0, 0); \
                  _Pragma("unroll") for (int r = 0; r < 16; r += 2) { const int dk = 32 * ri + crow(r, hi); const float dl0 = DLr[dk], dl1 = DLr[dk + 1]; \
                      sacc[d][r] *= dl0; sacc[d][r + 1] *= dl1; const unsigned w_ = pk2(sacc[d][r], sacc[d][r + 1]); \
                      LAS unsigned char* sp_ = G + SC_ST + stb_ + (d) * 512 + ((r >> 3) & 1) * 4096 + ((r & 3) + 4 * ((r >> 2) & 1)) * 64; \
                      *(LAS unsigned short*)sp_ = (unsigned short)w_; *(LAS unsigned short*)(sp_ + 64) = (unsigned short)(w_ >> 16); } SBAR(); } while (0)
                SC_SBLK(0); SC_SBLK(1);
            }
            SC_BAR();
        }
        if (!lat && !isP) { int l2 = F.lane; asm volatile("" : "+v"(l2)); const int r32 = l2 & 31, hi = l2 >> 5; float* SO = POUT + (gla ? OUT_SGLA : OUT_SRET) + ((size_t)((sb * 2 + li) * 2 + dir) * 4 + h) * 8192;
#pragma unroll
            for (int d = 0; d < 2; ++d)
#pragma unroll
                for (int r = 0; r < 16; ++r) SO[(32 * ri + crow(r, hi)) * 128 + 32 * (2 * dh + d) + r32] = sacc[d][r]; }
    }
#undef SC_TOK
#undef SC_BAR
#undef SC_LOADRAW
#undef SC_LOADGK
#undef UNPK
#undef SC_FR4
#undef SC_OBLK
#undef SC_SBLK
    if (F.G == 256 && F.bid >= 128) { if (li == 0) setup_work(F, P, F.bid - 128, 128, 0x2, 0x2, 0x0, 0x0, 0x1); else setup_work(F, P, F.bid - 128, 128, 0x8, 0x8, 0x0, 0x0, 0x2); }
    else if (F.G != 256) { if (li == 0) setup_work(F, P, F.bid, F.G, 0x2, 0x2, 0x0, 0x0, 0x1); else setup_work(F, P, F.bid, F.G, 0x8, 0x8, 0x0, 0x0, 0x2); }
}
__device__ __forceinline__ void scan_combine(Frame& F, const Params& P, int li) {
    unsigned char* ws = PWS;
    const char* PROJ = (const char*)(ws + WS_BIG); const char* OF = (const char*)(ws + WS_Y); char* OB = (char*)(ws + WS_HB);
    const int gw = F.vcu * NWAVES + F.wave, NGW = F.G * NWAVES, lane = F.lane, hh = lane >> 3, dv = (lane & 7) * 16;
    f32x4 gn[4];
    { const float* gp_ = PIN(I_GLAN) + li * 128 + dv;
#pragma unroll
      for (int j = 0; j < 4; ++j) gn[j] = hh < 4 ? *(const f32x4*)(gp_ + 4 * j) : (f32x4){1.f, 1.f, 1.f, 1.f}; }
    const unsigned gcol = (unsigned)((hh < 4 ? PC_GA : PC_GB) + (hh & 3) * 128 + dv) * 2u, ocol = (unsigned)(hh * 128 + dv) * 2u;
    for (int row = gw; row < M; row += 2 * NGW) {
        v4u a[2][2], b[2][2], g[2][2];
#pragma unroll
        for (int i = 0; i < 2; ++i) { const int r_ = row + i * NGW; if (r_ < M) {
            const unsigned off = (unsigned)r_ * (unsigned)(D * 2) + ocol, goff = (unsigned)r_ * (unsigned)(EVEN_NP * 2) + gcol;
            a[i][0] = *(const v4u*)(OF + off); a[i][1] = *(const v4u*)(OF + off + 16); b[i][0] = *(const v4u*)(OB + off); b[i][1] = *(const v4u*)(OB + off + 16);
            g[i][0] = *(const v4u*)(PROJ + goff); g[i][1] = *(const v4u*)(PROJ + goff + 16); } }
#pragma unroll
        for (int i = 0; i < 2; ++i) { const int r_ = row + i * NGW; if (r_ < M) {
            const unsigned off = (unsigned)r_ * (unsigned)(D * 2) + ocol;
            float x[16], gg[16];
#pragma unroll
            for (int hf = 0; hf < 2; ++hf)
#pragma unroll
                for (int e = 0; e < 4; ++e) { x[8 * hf + 2 * e] = bflo(a[i][hf][e]) + bflo(b[i][hf][e]); x[8 * hf + 2 * e + 1] = bfhi(a[i][hf][e]) + bfhi(b[i][hf][e]);
                    gg[8 * hf + 2 * e] = bflo(g[i][hf][e]); gg[8 * hf + 2 * e + 1] = bfhi(g[i][hf][e]); }
            float ss = 0.f;
#pragma unroll
            for (int e = 0; e < 16; ++e) ss += x[e] * x[e];
            ss += __shfl_xor(ss, 1); ss += __shfl_xor(ss, 2); ss += __shfl_xor(ss, 4);
            const float rstd = __builtin_amdgcn_rsqf(ss * (1.0f / 128.0f) + EPS);
#pragma unroll
            for (int e = 0; e < 16; ++e) x[e] = x[e] * rstd * gn[e >> 2][e & 3] * siluf(gg[e]);
            *(v4u*)(OB + off) = (v4u){pk2(x[0], x[1]), pk2(x[2], x[3]), pk2(x[4], x[5]), pk2(x[6], x[7])};
            *(v4u*)(OB + off + 16) = (v4u){pk2(x[8], x[9]), pk2(x[10], x[11]), pk2(x[12], x[13]), pk2(x[14], x[15])}; } }
    }
}

__device__ __forceinline__ void cache_pass(Frame& F, const Params& P, int li) {
    unsigned char* ws = PWS;
    const int gt = F.vcu * 512 + F.tid, NGT = F.G * 512;
    const float* cckv_ = PIN(I_CCKV); const float* ckpe_ = PIN(I_CKPE);
    for (int i = gt; i < 8 * 256 * 32; i += NGT) { const int c8 = i & 31, t = (i >> 5) & 255, b = i >> 13;
        const float* s = cckv_ + ((size_t)((b * 2 + li) * 256 + t) * 32 + c8) * 8; const f32x4 a = *(const f32x4*)s, c = *(const f32x4*)(s + 4);
        *(GAS v4u*)((bf16*)(ws + WS_ACKV) + ((size_t)4096 + b * LKV + t) * 256 + c8 * 8) = (v4u){pk2(a[0], a[1]), pk2(a[2], a[3]), pk2(c[0], c[1]), pk2(c[2], c[3])}; }
    for (int i = gt; i < 8 * 256 * 8; i += NGT) { const int c8 = i & 7, t = (i >> 3) & 255, b = i >> 11;
        const float* s = ckpe_ + ((size_t)((b * 2 + li) * 256 + t) * 8 + c8) * 8; const f32x4 a = *(const f32x4*)s, c = *(const f32x4*)(s + 4);
        *(GAS v4u*)((bf16*)(ws + WS_KPE) + ((size_t)4096 + b * LKV + t) * 64 + c8 * 8) = (v4u){pk2(a[0], a[1]), pk2(a[2], a[3]), pk2(c[0], c[1]), pk2(c[2], c[3])}; }
}
__device__ __forceinline__ void kpe_pass(Frame& F, const Params& P, int li) {
    unsigned char* ws = PWS;
    const float* KR = (const float*)(ws + WS_Y); const float* ROPE = (const float*)(ws + WS_ROPE);
    bf16* KPE = (bf16*)(ws + WS_KPE);
    const int gt = F.vcu * 512 + F.tid, NGT = F.G * 512;
    for (int i = gt; i < M * 4; i += NGT) {
        const int row = i >> 2, c8 = i & 3;
        const float* s = KR + (size_t)row * 64 + 8 * c8;
        f32x4 a0 = *(const f32x4*)s, a1 = *(const f32x4*)(s + 4), b0 = *(const f32x4*)(s + 32), b1 = *(const f32x4*)(s + 36);
        int drow = row;
        if (row >= M_CTX) { const int lb = (row - M_CTX) >> 11, t = (row - M_CTX) & 2047; drow = M_CTX + lb * LKV + PAST + t;
            const float* cp = ROPE + (size_t)t * 32 + 8 * c8; const float* sp = cp + 65536;
            const f32x4 c0 = *(const f32x4*)cp, c1 = *(const f32x4*)(cp + 4), s0 = *(const f32x4*)sp, s1 = *(const f32x4*)(sp + 4);
            const f32x4 x0 = a0 * c0 - b0 * s0, x1 = a1 * c1 - b1 * s1, y0 = a0 * s0 + b0 * c0, y1 = a1 * s1 + b1 * c1;
            a0 = x0; a1 = x1; b0 = y0; b1 = y1; }
        bf16* d = KPE + (size_t)drow * 64 + 8 * c8;
        *(v4u*)d = (v4u){pk2(a0[0], a0[1]), pk2(a0[2], a0[3]), pk2(a1[0], a1[1]), pk2(a1[2], a1[3])};
        *(v4u*)(d + 32) = (v4u){pk2(b0[0], b0[1]), pk2(b0[2], b0[3]), pk2(b1[0], b1[1]), pk2(b1[2], b1[3])};
    }
}

constexpr float ATT_SCALE = 0.07216878364870322f;
constexpr float ATT_THR = 8.f;
constexpr int AT_V = 0, AT_KN = 49152, AT_KP = 98304, AT_WS = 122880, AT_VB = 16384, AT_KNB = 16384, AT_KPB = 8192;
#define KSWZ(row, colB) ((row) * 256 + ((colB) ^ (((row) & 7) << 4)))
#define KPSWZ(row, colB) ((row) * 128 + ((colB) ^ (((row) & 7) << 4)))
__device__ __forceinline__ void at_partialSM(f32x16& p0, f32x16& p1, float& m_reg, float& mn, float& alpha) {
    constexpr float C = ATT_SCALE * 1.4426950408889634f;
    float pmax = p0[0];
#pragma unroll
    for (int r = 1; r < 16; ++r) pmax = fmaxf(pmax, p0[r]);
#pragma unroll
    for (int r = 0; r < 16; ++r) pmax = fmaxf(pmax, p1[r]);
    { auto rr = __builtin_amdgcn_permlane32_swap(__float_as_uint(pmax), __float_as_uint(pmax), false, false); pmax = fmaxf(__uint_as_float(rr[0]), __uint_as_float(rr[1])); }
    if (__builtin_expect(__all(pmax - m_reg <= ATT_THR / ATT_SCALE), 1)) { mn = m_reg; alpha = 1.f; }
    else { mn = fmaxf(m_reg, pmax); alpha = __builtin_amdgcn_exp2f((m_reg - mn) * C); m_reg = mn; }
    const float mnC = -mn * C;
#pragma unroll
    for (int r = 0; r < 16; ++r) p0[r] = fmaf(p0[r], C, mnC);
#pragma unroll
    for (int r = 0; r < 16; ++r) p1[r] = fmaf(p1[r], C, mnC);
#pragma unroll
    for (int r = 0; r < 16; ++r) p0[r] = __builtin_amdgcn_exp2f(p0[r]);
}
__device__ __forceinline__ void at_finishSM(f32x16& p0, f32x16& p1, float alpha, float& l_reg, bf16x8& pa0, bf16x8& pa1, bf16x8& pa2, bf16x8& pa3) {
#pragma unroll
    for (int r = 0; r < 16; ++r) p1[r] = __builtin_amdgcn_exp2f(p1[r]);
    float ps = 0;
#pragma unroll
    for (int r = 0; r < 16; ++r) ps += p0[r];
#pragma unroll
    for (int r = 0; r < 16; ++r) ps += p1[r];
    { auto rr = __builtin_amdgcn_permlane32_swap(__float_as_uint(ps), __float_as_uint(ps), false, false); ps = __uint_as_float(rr[0]) + __uint_as_float(rr[1]); }
    l_reg = l_reg * alpha + ps;
    PK4(p0, 0, pa0); PK4(p0, 8, pa1); PK4(p1, 0, pa2); PK4(p1, 8, pa3);
}
__device__ __forceinline__ void at_qkt(f32x16& p0, f32x16& p1, const LAS unsigned char* Kn, const LAS unsigned char* Kp, const bf16x8* qr, const int* kb, const int* pb) {
    p0 = f32x16{}; p1 = f32x16{};
#pragma unroll
    for (int d0 = 0; d0 < 8; ++d0) {
        const bf16x8 b0 = *(const LAS bf16x8*)(Kn + kb[d0 & 3] + 128 * (d0 >> 2)), b1 = *(const LAS bf16x8*)(Kn + kb[d0 & 3] + 128 * (d0 >> 2) + 8192);
        p0 = __builtin_amdgcn_mfma_f32_32x32x16_bf16(b0, qr[d0], p0, 0, 0, 0);
        p1 = __builtin_amdgcn_mfma_f32_32x32x16_bf16(b1, qr[d0], p1, 0, 0, 0); }
#pragma unroll
    for (int d0 = 0; d0 < 4; ++d0) {
        const bf16x8 b0 = *(const LAS bf16x8*)(Kp + pb[d0]), b1 = *(const LAS bf16x8*)(Kp + pb[d0] + 4096);
        p0 = __builtin_amdgcn_mfma_f32_32x32x16_bf16(b0, qr[8 + d0], p0, 0, 0, 0);
        p1 = __builtin_amdgcn_mfma_f32_32x32x16_bf16(b1, qr[8 + d0], p1, 0, 0, 0); }
}
template <int D0> __device__ __forceinline__ void at_pv_one(f32x16& od, unsigned vb, bf16x8 pa0, bf16x8 pa1, bf16x8 pa2, bf16x8 pa3) {
    const s16x4 l0 = tr_read<D0 * 512>(vb), h0 = tr_read<D0 * 512 + 2048>(vb), l1 = tr_read<D0 * 512 + 4096>(vb), h1 = tr_read<D0 * 512 + 4096 + 2048>(vb);
    const s16x4 l2 = tr_read<D0 * 512 + 8192>(vb), h2 = tr_read<D0 * 512 + 8192 + 2048>(vb), l3 = tr_read<D0 * 512 + 12288>(vb), h3 = tr_read<D0 * 512 + 12288 + 2048>(vb);
    asm volatile("s_waitcnt lgkmcnt(0)" ::: "memory"); SBAR();
    od = __builtin_amdgcn_mfma_f32_32x32x16_bf16(pa0, PKF(l0, h0), od, 0, 0, 0);
    od = __builtin_amdgcn_mfma_f32_32x32x16_bf16(pa1, PKF(l1, h1), od, 0, 0, 0);
    od = __builtin_amdgcn_mfma_f32_32x32x16_bf16(pa2, PKF(l2, h2), od, 0, 0, 0);
    od = __builtin_amdgcn_mfma_f32_32x32x16_bf16(pa3, PKF(l3, h3), od, 0, 0, 0);
}
__device__ __forceinline__ void at_pv(f32x16* o, unsigned vb, bf16x8 pa0, bf16x8 pa1, bf16x8 pa2, bf16x8 pa3) {
    at_pv_one<0>(o[0], vb, pa0, pa1, pa2, pa3); at_pv_one<1>(o[1], vb, pa0, pa1, pa2, pa3); at_pv_one<2>(o[2], vb, pa0, pa1, pa2, pa3); at_pv_one<3>(o[3], vb, pa0, pa1, pa2, pa3);
}
__device__ __forceinline__ void attn_unit(Frame& F, const bf16* Qrow0  , const bf16* KVh  , const bf16* KPEs  ,
                                          bf16* Orow0, int nkeys, const float* ROPE, int tpos0  ) {
    LAS unsigned char* lds = F.lds;
    const int tid = F.tid, wid = F.wave, lane = F.lane, r32 = lane & 31, hi = lane >> 5;
    LAS float* wsf = (LAS float*)(lds + AT_WS) + wid * 64; LAS float* li_l = wsf; LAS float* al_l = wsf + 32;
    float m_reg = -1e30f, l_reg = 0; f32x16 o[4] = {}; bf16x8 qr[12];
    { const bf16* Qw = Qrow0 + (size_t)(wid * 32 + r32) * 1536 + hi * 8;
#pragma unroll
      for (int d0 = 0; d0 < 12; ++d0) qr[d0] = *(const bf16x8*)(Qw + d0 * 16);
      if (tpos0 >= 0) {
          const int t = tpos0 + wid * 32 + r32;
#pragma unroll
          for (int half = 0; half < 2; ++half) {
              const float* cp = ROPE + (size_t)t * 32 + 16 * half + 8 * hi; const float* sp = cp + 65536;
              const v4u xa = __builtin_bit_cast(v4u, qr[8 + half]), xb = __builtin_bit_cast(v4u, qr[10 + half]);
              float x1[8], x2[8];
              x1[0] = bflo(xa.x); x1[1] = bfhi(xa.x); x1[2] = bflo(xa.y); x1[3] = bfhi(xa.y); x1[4] = bflo(xa.z); x1[5] = bfhi(xa.z); x1[6] = bflo(xa.w); x1[7] = bfhi(xa.w);
              x2[0] = bflo(xb.x); x2[1] = bfhi(xb.x); x2[2] = bflo(xb.y); x2[3] = bfhi(xb.y); x2[4] = bflo(xb.z); x2[5] = bfhi(xb.z); x2[6] = bflo(xb.w); x2[7] = bfhi(xb.w);
              float y1[8], y2[8];
#pragma unroll
              for (int j = 0; j < 8; ++j) { const float c = cp[j], s = sp[j]; y1[j] = x1[j] * c - x2[j] * s; y2[j] = x1[j] * s + x2[j] * c; }
              const v4u wa = {pk2(y1[0], y1[1]), pk2(y1[2], y1[3]), pk2(y1[4], y1[5]), pk2(y1[6], y1[7])}, wb = {pk2(y2[0], y2[1]), pk2(y2[2], y2[3]), pk2(y2[4], y2[5]), pk2(y2[6], y2[7])};
              if (half == 0) { qr[8] = __builtin_bit_cast(bf16x8, wa); qr[10] = __builtin_bit_cast(bf16x8, wb); } else { qr[9] = __builtin_bit_cast(bf16x8, wa); qr[11] = __builtin_bit_cast(bf16x8, wb); }
          }
      } }
    const unsigned vb0 = (unsigned)(uintptr_t)(lds + AT_V) + v_rd_base(lane);
#define AT_OPQ() int l_ = lane; asm volatile("" : "+v"(l_))
#define AT_KADDR() int kbs[4], pbs[4]; { AT_OPQ(); _Pragma("unroll") for (int b = 0; b < 4; ++b) { const int x = (32 * b + 16 * (l_ >> 5)) ^ ((l_ & 7) << 4); kbs[b] = (l_ & 31) * 256 + x; pbs[b] = (l_ & 31) * 128 + x; } }
#define AT_GLDS(gp, ldsoff) __builtin_amdgcn_global_load_lds((const unsigned*)(gp), (LAS unsigned*)(lds + (ldsoff)), 16, 0, 0)
#define AT_DMA_K(t, b) do { AT_OPQ(); const char* kb_ = (const char*)KVh + (size_t)(t) * (64 * 4096); const char* pb_ = (const char*)KPEs + (size_t)(t) * (64 * 128); \
    const int row0_ = 4 * wid + (l_ >> 4), cB0_ = ((l_ & 15) * 16) ^ ((row0_ & 7) << 4), row1_ = row0_ + 32, rowp_ = 8 * wid + (l_ >> 3), cBp_ = ((l_ & 7) * 16) ^ ((rowp_ & 7) << 4); \
    AT_GLDS(kb_ + (unsigned)(row0_ * 4096 + cB0_), AT_KN + (b) * AT_KNB + wid * 1024); AT_GLDS(kb_ + (unsigned)(row1_ * 4096 + cB0_), AT_KN + (b) * AT_KNB + (wid + 8) * 1024); \
    AT_GLDS(pb_ + (unsigned)(rowp_ * 128 + cBp_), AT_KP + (b) * AT_KPB + wid * 1024); } while (0)
#define AT_DMA_V(t, b) do { AT_OPQ(); const char* vb_ = (const char*)KVh + (size_t)(t) * (64 * 4096); \
    const int st_ = 2 * wid + (l_ >> 5), kk_ = (st_ >> 2) * 8 + ((l_ & 31) >> 2), key_ = (kk_ & ~0xC) | ((kk_ & 4) << 1) | ((kk_ & 8) >> 1), col_ = (st_ & 3) * 32 + (l_ & 3) * 8; \
    AT_GLDS(vb_ + (unsigned)(key_ * 4096 + (128 + col_) * 2), AT_V + (b) * AT_VB + wid * 1024); AT_GLDS(vb_ + (unsigned)((key_ + 32) * 4096 + (128 + col_) * 2), AT_V + (b) * AT_VB + (wid + 8) * 1024); } while (0)
#define AT_RESC(a) do { if (__any((a) < 1.f)) { if (hi == 0) al_l[r32] = (a); asm volatile("s_waitcnt lgkmcnt(0)" ::: "memory"); \
    _Pragma("unroll") for (int d = 0; d < 4; ++d) _Pragma("unroll") for (int r = 0; r < 16; ++r) o[d][r] *= al_l[crow(r, hi)]; } } while (0)
#define AT_WAITBAR(N) do { asm volatile("s_waitcnt vmcnt(" #N ") lgkmcnt(0)" ::: "memory"); __builtin_amdgcn_s_barrier(); asm volatile("" ::: "memory"); } while (0)
    f32x16 pA0, pA1, pB0, pB1; float mnA, mnB, alA, alB; bf16x8 pa0, pa1, pa2, pa3; const int NT = nkeys / 64;
    AT_DMA_K(0, 0); AT_DMA_K(1, 1); AT_DMA_V(0, 0); AT_WAITBAR(0);
    int s = 0;
#define AT_S1 (s == 2 ? 0 : s + 1)
#define AT_S2 (s == 0 ? 2 : s - 1)
#define AT_STEP(CUR0, CUR1, MNC, ALC, PRV0, PRV1, ALP, t, MODE) do { \
        if (MODE == 2) { AT_DMA_K((t) + 2, AT_S2); } if (MODE >= 1) { AT_DMA_V((t) + 1, AT_S1); } \
        SBAR(); { AT_KADDR(); at_qkt(CUR0, CUR1, lds + AT_KN + s * AT_KNB, lds + AT_KP + s * AT_KPB, qr, kbs, pbs); } \
        at_finishSM(PRV0, PRV1, ALP, l_reg, pa0, pa1, pa2, pa3); SBAR(); \
        at_pv(o, vb0 + AT_S2 * AT_VB, pa0, pa1, pa2, pa3); at_partialSM(CUR0, CUR1, m_reg, MNC, ALC); \
        AT_RESC(ALC); if (MODE == 2) AT_WAITBAR(5); else if (MODE == 1) AT_WAITBAR(2); else AT_WAITBAR(0); s = AT_S1; } while (0)
    AT_DMA_K(2, 2); AT_DMA_V(1, 1);
    { AT_KADDR(); at_qkt(pA0, pA1, lds + AT_KN, lds + AT_KP, qr, kbs, pbs); } at_partialSM(pA0, pA1, m_reg, mnA, alA);
    AT_WAITBAR(5); s = 1;
    int t = 1;
    for (; t + 4 < NT; t += 2) {
        AT_STEP(pB0, pB1, mnB, alB, pA0, pA1, alA, t, 2);
        AT_STEP(pA0, pA1, mnA, alA, pB0, pB1, alB, t + 1, 2);
    }
    AT_STEP(pB0, pB1, mnB, alB, pA0, pA1, alA, NT - 3, 2);
    AT_STEP(pA0, pA1, mnA, alA, pB0, pB1, alB, NT - 2, 1);
    AT_STEP(pB0, pB1, mnB, alB, pA0, pA1, alA, NT - 1, 0);
    at_finishSM(pB0, pB1, alB, l_reg, pa0, pa1, pa2, pa3); SBAR();
    at_pv(o, vb0 + AT_S2 * AT_VB, pa0, pa1, pa2, pa3);
    if (hi == 0) li_l[r32] = l_reg; asm volatile("s_waitcnt lgkmcnt(0)" ::: "memory");
    float rli[16];
#pragma unroll
    for (int r = 0; r < 16; ++r) rli[r] = __builtin_amdgcn_rcpf(li_l[crow(r, hi)]);
    bf16* Ow = Orow0 + (size_t)(wid * 32) * D;
#pragma unroll
    for (int r = 0; r < 16; r += 2) { const int orow = crow(r, hi);
#pragma unroll
        for (int d0 = 0; d0 < 4; ++d0) { const unsigned w = pk2(o[d0][r] * rli[r], o[d0][r + 1] * rli[r + 1]);
            Ow[(size_t)orow * D + d0 * 32 + r32] = (bf16)w; Ow[(size_t)(orow + 1) * D + d0 * 32 + r32] = (bf16)(w >> 16); } }
#undef AT_GLDS
#undef AT_OPQ
#undef AT_KADDR
#undef AT_DMA_K
#undef AT_DMA_V
#undef AT_RESC
#undef AT_WAITBAR
#undef AT_S1
#undef AT_S2
#undef AT_STEP
}
__device__ __forceinline__ void attn_phase(Frame& F, const Params& P, int li) {
    unsigned char* ws = PWS;
    const bf16* Q = (const bf16*)(ws + WS_Q); const bf16* KV = (const bf16*)(ws + WS_KV); const bf16* KPE = (const bf16*)(ws + WS_KPE);
    bf16* OB = (bf16*)(ws + WS_HB); const float* ROPE = (const float*)(ws + WS_ROPE);
    for (int u = F.vcu; u < 256 + 128; u += F.G) {
        for (int k = 0; k < 2; ++k) {
            int qrow0, kvrow0, nkeys, h, tpos0;
            if (u < 256) { const int id = 2 * u + k, lb = id >> 6, qb = id & 7; h = (id >> 3) & 7; qrow0 = M_CTX + lb * L_LAT + qb * 256; kvrow0 = M_CTX + lb * LKV; nkeys = LKV; tpos0 = qb * 256; }
            else { if (k == 1) break; const int id = u - 256, b = id >> 3; h = id & 7; qrow0 = b * L_CTX; kvrow0 = b * L_CTX; nkeys = L_CTX; tpos0 = -1; }
            __syncthreads();
            attn_unit(F, Q + (size_t)qrow0 * 1536 + h * 192, KV + (size_t)kvrow0 * 2048 + h * 256, KPE + (size_t)kvrow0 * 64, OB + (size_t)qrow0 * D + h * 128, nkeys, ROPE, tpos0);
        }
    }
}

constexpr int N_PHASES = 2 + 2 * 16;
__global__ void __launch_bounds__(NWAVES * 64, 2) hyb_fwd(Params P) {
    extern __shared__ __attribute__((aligned(16))) unsigned char lds_raw[];
    Frame F;
    F.lds = (LAS unsigned char*)lds_raw;
    F.tid = threadIdx.x; F.lane = F.tid & 63; F.wave = __builtin_amdgcn_readfirstlane(F.tid >> 6);
    F.G = gridDim.x; { const int bx = blockIdx.x; F.vcu = (F.G % 8 == 0) ? (bx % 8) * (F.G / 8) + bx / 8 : bx; }
    volatile LAS unsigned* MISC = (volatile LAS unsigned*)(F.lds + LDS_MISC);
    if (F.tid < 64) MISC[F.tid] = 0u;
    if (F.tid < 30) { const unsigned long long v = F.tid < 28 ? (unsigned long long)P.in[F.tid] : (F.tid == 28 ? (unsigned long long)P.out : (unsigned long long)P.ws);
        volatile LAS unsigned* pt = (volatile LAS unsigned*)(F.lds + LDS_PT) + 2 * F.tid; pt[0] = (unsigned)v; pt[1] = (unsigned)(v >> 32); }
    __syncthreads();
    const int use_bar = P.use_bar, ph_hi = P.ph_hi;
    XcdBarrier bar; bar.bar = (unsigned*)(PWS + WS_CTL) + 4096; bar.x = 0; bar.st = nullptr;
    if (use_bar) bar = xcd_barrier_post((unsigned*)(PWS + WS_CTL) + 4096, MISC + 8);

    int dup_done = 0; (void)dup_done;
    for (int ph = P.ph_lo; ph < ph_hi; ++ph) {
#define REFRESH_ID() do { int t_ = threadIdx.x; asm volatile("" : "+v"(t_)); F.tid = t_; F.lane = t_ & 63; F.wave = __builtin_amdgcn_readfirstlane(t_ >> 6); \
          int g_ = gridDim.x, b_ = blockIdx.x; asm volatile("" : "+s"(g_), "+s"(b_)); F.G = g_; F.vcu = (g_ % 8 == 0) ? (b_ % 8) * (g_ / 8) + b_ / 8 : b_; F.bid = b_; } while (0)
        REFRESH_ID();
        unsigned char* ws = PWS;
        bf16* XBF = (bf16*)(POUT + OUT_Y);
        bf16* HB = (bf16*)(ws + WS_HB); bf16* YB = (bf16*)(ws + WS_Y); const bf16* SL = (const bf16*)(ws + WS_SLAB);
        const float* MOD = (const float*)(ws + WS_MOD);
        if (ph == 0) { p0_prologue(F, P); }
        else if (ph == 1) {
            const float* m0 = MOD;
            row_pass(F, PIN(I_XP), PIN(I_XS), true, nullptr, nullptr, nullptr, nullptr, nullptr, PIN(I_NMIXPRE), m0 + 1024, m0, HB, false, true);
        } else {
            const int q = ph - 2, pair = q / 16, r = q % 16; const bool odd = r >= 8; const int l = 2 * pair + (odd ? 1 : 0), k = odd ? r - 8 : r;
            const float* ml = MOD + (size_t)l * 9 * 6144;
            const int kind = k < 3 ? (odd ? 10 + k : (k == 2 ? 8 : k)) : (k == 3 ? 2 : k == 4 ? 3 : k == 5 ? 4 : k == 6 ? 5 : 6);
            if (kind == 0) {
                pg8::Gemm g{HB, (const bf16*)(ws + WS_WINE) + (size_t)pair * EVEN_NP * 1024, M, EVEN_NP, 1024}; pg8::StaticOrder S; S.init(M, EVEN_NP, F.G, F.bid, 1024);
                pg8::EpiBf16<0> E{(bf16*)(ws + WS_BIG), EVEN_NP};
                pg8::gemm_phase<pg8::EpiBf16<0>, pg8::StaticOrder, true, true>(F.lds, g, S, E, F.tid);
            } else if (kind == 1) {
                scan_phase(F, P, pair);
            } else if (kind == 8) {
                scan_combine(F, P, pair);
            } else if (kind == 2) {
                const bf16* W = odd ? (const bf16*)(ws + WS_WOUTO) + (size_t)pair * 1024 * 1024 : (const bf16*)(ws + WS_WOUTE) + (size_t)pair * 1024 * 1024;
                { pg8::Gemm g{HB, W, M, 1024, 1024}; pg8::TailSplitOrder S; S.init(F.bid, 1024, 1);
                  pg8::EpiYsplit E{YB, (bf16*)(ws + WS_SLAB)};
                  pg8::gemm_phase<pg8::EpiYsplit, pg8::TailSplitOrder, true, true>(F.lds, g, S, E, F.tid); }
                REFRESH_ID();
                { pg8::Gemm g{HB, W, M, 1024, 1024}; pg8::TailSplitOrder S; S.init(F.bid, 1024, 2);
                  pg8::EpiYsplit E{YB, (bf16*)(PWS + WS_SLAB)};
                  pg8::gemm_phase<pg8::EpiYsplit, pg8::TailSplitOrder, true, true>(F.lds, g, S, E, F.tid); }
            } else if (kind == 3) {
                row_pass(F, PIN(I_XP), PIN(I_XS), l == 0, XBF, YB, SL, PIN(I_NMIXPOST) + l * 1024, ml + 2048, PIN(I_NMLPPRE) + l * 1024, ml + 4096, ml + 3072, HB, true, true);
            } else if (kind == 4) {
                pg8::Gemm g{HB, (const bf16*)(ws + WS_W1) + (size_t)l * 4096 * 1024, M, FF, 1024}; pg8::StaticOrder S; S.init(M, FF, F.G, F.bid, 1024);
                pg8::EpiBf16<1> E{(bf16*)(ws + WS_BIG), FF};
                pg8::gemm_phase<pg8::EpiBf16<1>, pg8::StaticOrder, true, true>(F.lds, g, S, E, F.tid);
            } else if (kind == 5) {
                { pg8::Gemm g{(const bf16*)(ws + WS_BIG), (const bf16*)(ws + WS_W2) + (size_t)l * 1024 * 4096, M, 1024, FF}; pg8::TailSplitOrder S; S.init(F.bid, FF, 1);
                  pg8::EpiYsplit E{YB, (bf16*)(ws + WS_SLAB)};
                  pg8::gemm_phase<pg8::EpiYsplit, pg8::TailSplitOrder, true, true>(F.lds, g, S, E, F.tid); }
                REFRESH_ID();
                { pg8::Gemm g{(const bf16*)(PWS + WS_BIG), (const bf16*)(PWS + WS_W2) + (size_t)l * 1024 * 4096, M, 1024, FF}; pg8::TailSplitOrder S; S.init(F.bid, FF, 2);
                  pg8::EpiYsplit E{(bf16*)(PWS + WS_Y), (bf16*)(PWS + WS_SLAB)};
                  pg8::gemm_phase<pg8::EpiYsplit, pg8::TailSplitOrder, true, true>(F.lds, g, S, E, F.tid); }
            } else if (kind == 6) {
                const float* mn = ml + 9 * 6144;
                if (l < 3) row_pass(F, nullptr, nullptr, false, XBF, YB, SL, PIN(I_NMLPPOST) + l * 1024, ml + 5120, PIN(I_NMIXPRE) + (l + 1) * 1024, mn + 1024, mn, HB, true, true);
                else { bar.bar = (unsigned*)(PWS + WS_CTL) + 4096; row_pass_final(F, bar, XBF, POUT + OUT_Y, YB, SL, PIN(I_NMLPPOST) + l * 1024, ml + 5120); }
            } else if (kind == 10) {
                pg8::Gemm g{HB, (const bf16*)(ws + WS_WINO) + (size_t)pair * ODD_NP * 1024, M, ODD_NP, 1024}; pg8::StaticOrder S; S.init(M, ODD_NP, F.G, F.bid, 1024);
                pg8::EpiOddIn E{(bf16*)(ws + WS_QN), (bf16*)(ws + WS_ACKV), (float*)(ws + WS_Y), POUT + OUT_CKV, POUT + OUT_KPE,
                                PIN(I_QAN) + pair * 256, PIN(I_KVAN) + pair * 256, pair};
                pg8::gemm_phase<pg8::EpiOddIn, pg8::StaticOrder, false, true>(F.lds, g, S, E, F.tid);
                REFRESH_ID(); cache_pass(F, P, pair);
            } else if (kind == 11) {
                kpe_pass(F, P, pair); REFRESH_ID();
                { pg8::Gemm g{(const bf16*)(ws + WS_QN), (const bf16*)(ws + WS_WQB) + (size_t)pair * 1536 * 256, M, 1536, 256}; pg8::StaticOrder S; S.init(M, 1536, F.G, F.bid, 256);
                  pg8::EpiBf16<0> E{(bf16*)(ws + WS_Q), 1536};
                  pg8::gemm_phase<pg8::EpiBf16<0>, pg8::StaticOrder, true, true>(F.lds, g, S, E, F.tid); }
                REFRESH_ID();
                { pg8::Gemm g{(const bf16*)(ws + WS_ACKV), (const bf16*)(ws + WS_WKVB) + (size_t)pair * 2048 * 256, MKV, 2048, 256}; pg8::StaticOrder S; S.init(MKV, 2048, F.G, F.bid, 256);
                  pg8::EpiBf16<0> E{(bf16*)(ws + WS_KV), 2048};
                  pg8::gemm_phase<pg8::EpiBf16<0>, pg8::StaticOrder, true, true>(F.lds, g, S, E, F.tid); }
            } else if (kind == 12) {
                attn_phase(F, P, pair);
            }
        }
#if defined(HYB_DUP_MASK)
        { int kind_ = -1;
          if (ph == 0) kind_ = 13;
          else if (ph >= 2) { const int q_ = ph - 2, r_ = q_ % 16; const bool odd_ = r_ >= 8; const int k_ = odd_ ? r_ - 8 : r_;
              kind_ = k_ < 3 ? (odd_ ? 10 + k_ : (k_ == 2 ? 8 : k_)) : (k_ == 3 ? 2 : k_ == 4 ? 3 : k_ == 5 ? 4 : k_ == 6 ? 5 : 6); }
          if (kind_ >= 0 && ((HYB_DUP_MASK >> kind_) & 1) && dup_done == 0) { dup_done = 1; if (use_bar) { bar.bar = (unsigned*)(PWS + WS_CTL) + 4096; xcd_barrier(bar); } else { VM_WAIT(); __syncthreads(); } --ph; continue; } }
        dup_done = 0;
        if (((HYB_DUP_MASK >> 14) & 1) && ph + 1 < ph_hi && use_bar) { bar.bar = (unsigned*)(PWS + WS_CTL) + 4096; xcd_barrier(bar); }
#endif
        if (ph + 1 < ph_hi) { if (use_bar) { bar.bar = (unsigned*)(PWS + WS_CTL) + 4096; xcd_barrier(bar); } else { VM_WAIT(); __syncthreads(); } }
    }
}

extern "C" void kernel_launch(void* const* d_in, const int* in_sizes, int n_in, void* d_out, int out_size, void* d_ws, size_t ws_size, hipStream_t stream) {
    static int grid = 0;
    if (grid == 0) {
        if (n_in != 28 || out_size != 27787264 || ws_size < WS_END) { fprintf(stderr, "kernel_launch: unexpected shapes: n_in %d out %d ws %zu (need >= %zu)\n", n_in, out_size, ws_size, (size_t)WS_END); grid = -1; return; }
        int dev = 0, cus = 0, per_cu = 0;
        if (hipGetDevice(&dev) != hipSuccess || hipDeviceGetAttribute(&cus, hipDeviceAttributeMultiprocessorCount, dev) != hipSuccess) { grid = -1; return; }
        if (hipFuncSetAttribute((const void*)hyb_fwd, hipFuncAttributeMaxDynamicSharedMemorySize, LDS_BYTES) != hipSuccess) { fprintf(stderr, "kernel_launch: hipFuncSetAttribute failed\n"); grid = -1; return; }
        if (hipOccupancyMaxActiveBlocksPerMultiprocessor(&per_cu, (const void*)hyb_fwd, NWAVES * 64, LDS_BYTES) != hipSuccess || per_cu < 1) { fprintf(stderr, "kernel_launch: occupancy query reports %d\n", per_cu); }
        (void)hipGetLastError();
        grid = cus;
    }
    if (grid < 0) return;
    (void)hipMemsetAsync((char*)d_ws + WS_CTL, 0, CTL_ZERO_BYTES, stream);
    Params a{};
    for (int i = 0; i < 28; ++i) a.in[i] = (const float*)d_in[i];
    a.out = (float*)d_out; a.ws = (unsigned char*)d_ws;
    a.ph_lo = 0; a.ph_hi = N_PHASES; a.use_bar = 1; a.pad = 0;
    hipLaunchKernelGGL(hyb_fwd, dim3(grid), dim3(NWAVES * 64), LDS_BYTES, stream, a);
    const hipError_t le = hipPeekAtLastError();
    if (le != hipSuccess) fprintf(stderr, "kernel_launch: launch failed: %s\n", hipGetErrorName(le));
}
```

```cpp
#include <hip/hip_runtime.h>
#include <hip/hip_bf16.h>
#include <cstdio>
#include <cstdint>
namespace pg8 {
#define PG8_LAS __attribute__((address_space(3)))
typedef unsigned short bf16_t;
typedef short bf16x8 __attribute__((ext_vector_type(8)));
typedef float f32x4 __attribute__((ext_vector_type(4)));
typedef unsigned u32x4 __attribute__((ext_vector_type(4)));
constexpr int BM = 256, BK = 64, HALF = 128, HTB = HALF * BK * 2  , STAGE_BYTES = 8 * HTB, NXCD = 8, WGM = 8;

__host__ __device__ __forceinline__ int lds_byte(int r, int c) { const int st = (r >> 4) * 2 + (c >> 5), rr = r & 15, cc = c & 31, ob = rr * 64 + cc * 2; return st * 1024 + (ob ^ (((ob >> 9) & 1) << 5)); }
__host__ __device__ __forceinline__ void stage_rc(int b, int& R, int& C) { const int st = b / 1024, sb = b % 1024, swz = sb ^ (((sb >> 9) & 1) << 5); R = (st >> 1) * 16 + swz / 64; C = (st & 1) * 32 + (swz % 64) / 2; }
__host__ __device__ __forceinline__ int perm32(int rho) { const int n = rho >> 4, i = rho & 15; return 8 * (i >> 2) + 4 * n + (i & 3); }

struct Unit { int pm, pn, ks, kt0, nt; };
struct Gemm { const bf16_t* A; const bf16_t* Bt; int M, N, K; };

struct StaticOrder {
    int nM, nN, nwg, G, c, ntk;
    __host__ __device__ void init(int M, int N, int G_, int c_, int K) { nM = M / BM; nN = N / BM; nwg = nM * nN; G = G_; c = c_; ntk = K / BK; }
    __host__ __device__ bool next(int i, Unit& u) const {
        const long L = (long)i * G + c; if (L >= nwg) return false;
        int wgid = (int)L; { const int q = nwg / NXCD, r = nwg % NXCD, xcd = wgid % NXCD, off = wgid / NXCD; wgid = (xcd < r ? xcd * (q + 1) : r * (q + 1) + (xcd - r) * q) + off; }
        const int nig = WGM * nN, gid = wgid / nig, fm = gid * WGM, gsz = (nM - fm) < WGM ? (nM - fm) : WGM;
        u.pm = fm + ((wgid % nig) % gsz); u.pn = (wgid % nig) / gsz; u.ks = -1; u.kt0 = 0; u.nt = ntk; return true;
    }
    __device__ __forceinline__ void a_ready(const Unit&) const {}
    __device__ __forceinline__ void done(const Unit&) const {}
};


struct TailSplitOrder {
    int c, ntk, mode;
    __device__ void init(int c_, int K, int mode_) { c = c_; ntk = K / BK; mode = mode_; }
    __device__ bool next(int i, Unit& u) const {
        const int xcd = c & 7, j = c >> 3;
        const int round = mode == 2 ? i + 1 : i;
        if (round == 0) { u.pm = xcd * 8 + (j & 7); u.pn = j >> 3; u.ks = -1; u.kt0 = 0; u.nt = ntk; return true; }
        if (round == 1 && mode != 1) { u.pm = 64 + xcd * 2 + (j & 1); u.pn = (j >> 1) & 3; u.ks = j >> 3; u.nt = ntk >> 2; u.kt0 = u.ks * u.nt; return true; }
        return false;
    }
    __device__ __forceinline__ void a_ready(const Unit&) const {}
    __device__ __forceinline__ void done(const Unit&) const {}
};

typedef float f32x2c_t __attribute__((ext_vector_type(2))); typedef __bf16 bf16x2c_t __attribute__((ext_vector_type(2)));
__device__ __forceinline__ unsigned cvt_pk_bf16(float lo, float hi) { f32x2c_t v = {lo, hi}; bf16x2c_t b = __builtin_convertvector(v, bf16x2c_t); return __builtin_bit_cast(unsigned, b); }

template <int ACT> struct EpiBf16 {
    static constexpr bool PERM = true, AFTER_DRAIN = false;
    bf16_t* O; int ldc;
    __device__ __forceinline__ void operator()(const f32x4 (&acc)[2][2][4][2], const Unit& u, int wr, int wc, int fr, int fq) const {
        const int row0 = u.pm * BM + wr * 64 + fr; const int col0 = u.pn * BM + wc * 32 + 8 * fq;
#pragma unroll
        for (int ai = 0; ai < 2; ++ai)
#pragma unroll
            for (int m = 0; m < 4; ++m) { bf16_t* rowp = O + (size_t)(row0 + ai * HALF + m * 16) * ldc + col0;
#pragma unroll
                for (int bj = 0; bj < 2; ++bj) { f32x4 v0 = acc[ai][bj][m][0], v1 = acc[ai][bj][m][1];
                    if (ACT == 1) {
#pragma unroll
                        for (int j = 0; j < 4; ++j) { const float a = fmaxf(v0[j], 0.f), b = fmaxf(v1[j], 0.f); v0[j] = a * a; v1[j] = b * b; } }
                    u32x4 w; w.x = cvt_pk_bf16(v0[0], v0[1]); w.y = cvt_pk_bf16(v0[2], v0[3]); w.z = cvt_pk_bf16(v1[0], v1[1]); w.w = cvt_pk_bf16(v1[2], v1[3]);
                    *(u32x4*)(rowp + bj * HALF) = w; } }
    }
};
struct EpiYsplit {
    static constexpr bool PERM = true, AFTER_DRAIN = false;
    bf16_t* Y; bf16_t* SL;
    __device__ __forceinline__ void operator()(const f32x4 (&acc)[2][2][4][2], const Unit& u, int wr, int wc, int fr, int fq) const {
        const int row0 = u.pm * BM + wr * 64 + fr; const int col0 = u.pn * BM + wc * 32 + 8 * fq;
        if (u.ks < 0) {
#pragma unroll
            for (int ai = 0; ai < 2; ++ai)
#pragma unroll
                for (int m = 0; m < 4; ++m) { bf16_t* rowp = Y + (size_t)(row0 + ai * HALF + m * 16) * 1024 + col0;
#pragma unroll
                    for (int bj = 0; bj < 2; ++bj) { const f32x4 v0 = acc[ai][bj][m][0], v1 = acc[ai][bj][m][1];
                        u32x4 w; w.x = cvt_pk_bf16(v0[0], v0[1]); w.y = cvt_pk_bf16(v0[2], v0[3]); w.z = cvt_pk_bf16(v1[0], v1[1]); w.w = cvt_pk_bf16(v1[2], v1[3]);
                        *(u32x4*)(rowp + bj * HALF) = w; } }
        } else {
            bf16_t* base = SL + (size_t)u.ks * (4096 * 1024);
#pragma unroll
            for (int ai = 0; ai < 2; ++ai)
#pragma unroll
                for (int m = 0; m < 4; ++m) { bf16_t* rowp = base + (size_t)(row0 - 16384 + ai * HALF + m * 16) * 1024 + col0;
#pragma unroll
                    for (int bj = 0; bj < 2; ++bj) { const f32x4 v0 = acc[ai][bj][m][0], v1 = acc[ai][bj][m][1];
                        u32x4 w; w.x = cvt_pk_bf16(v0[0], v0[1]); w.y = cvt_pk_bf16(v0[2], v0[3]); w.z = cvt_pk_bf16(v1[0], v1[1]); w.w = cvt_pk_bf16(v1[2], v1[3]);
                        *(u32x4*)(rowp + bj * HALF) = w; } }
        }
    }
};
struct EpiOddIn {
    static constexpr bool PERM = false, AFTER_DRAIN = true;
    bf16_t* QN; bf16_t* ACKV; float* KPERAW; float* out_ckv; float* out_kpe; const float* gq; const float* gkv; int li;
    __device__ __forceinline__ void fused(f32x4 (&acc)[2][2][4][2], const Unit& u, int wr, int wc, int fr, int fq, PG8_LAS unsigned char* lds, int wid, int lane) const {
        PG8_LAS float* P = (PG8_LAS float*)lds;
        if (u.pn < 2) {
#pragma unroll
            for (int ai = 0; ai < 2; ++ai)
#pragma unroll
                for (int m = 0; m < 4; ++m) { float s = 0.f;
#pragma unroll
                    for (int bj = 0; bj < 2; ++bj)
#pragma unroll
                        for (int n = 0; n < 2; ++n) { const f32x4 x = acc[ai][bj][m][n]; s += (x[0] * x[0] + x[1] * x[1]) + (x[2] * x[2] + x[3] * x[3]); }
                    s += __shfl_xor(s, 16); s += __shfl_xor(s, 32);
                    if (fq == 0) P[(ai * HALF + wr * 64 + m * 16 + fr) * 4 + wc] = s; }
        }
        asm volatile("s_waitcnt lgkmcnt(0)" ::: "memory"); __builtin_amdgcn_s_barrier(); asm volatile("" ::: "memory");
        if (u.pn < 2) {
            const float* gv = u.pn == 0 ? gq : gkv;
#pragma unroll
            for (int ai = 0; ai < 2; ++ai)
#pragma unroll
                for (int m = 0; m < 4; ++m) { const int r = ai * HALF + wr * 64 + m * 16 + fr; const int grow = u.pm * BM + r;
                    const float tot = (P[r * 4 + 0] + P[r * 4 + 1]) + (P[r * 4 + 2] + P[r * 4 + 3]);
                    const float rstd = 1.0f / sqrtf(tot * (1.0f / 256.0f) + 1e-6f);
                    const int drow = grow < 4096 ? grow : 4096 + ((grow - 4096) >> 11) * 2304 + 256 + ((grow - 4096) & 2047);
#pragma unroll
                    for (int bj = 0; bj < 2; ++bj)
#pragma unroll
                        for (int n = 0; n < 2; ++n) { const int col = bj * HALF + wc * 32 + n * 16 + 4 * fq; const f32x4 g = *(const f32x4*)(gv + col);
                            const f32x4 v = acc[ai][bj][m][n] * rstd * g;
                            unsigned long long w = (unsigned long long)cvt_pk_bf16(v[0], v[1]) | ((unsigned long long)cvt_pk_bf16(v[2], v[3]) << 32);
                            if (u.pn == 0) *(unsigned long long*)(QN + (size_t)grow * 256 + col) = w;
                            else { *(unsigned long long*)(ACKV + (size_t)drow * 256 + col) = w;
                                   if (grow < 4096) *(f32x4*)(out_ckv + ((size_t)((grow >> 8) * 2 + li) * 256 + (grow & 255)) * 256 + col) = v; } } }
        } else if (wc < 2) {
#pragma unroll
            for (int ai = 0; ai < 2; ++ai)
#pragma unroll
                for (int m = 0; m < 4; ++m) { const int r = ai * HALF + wr * 64 + m * 16 + fr; const int grow = u.pm * BM + r;
#pragma unroll
                    for (int n = 0; n < 2; ++n) { const int col = wc * 32 + n * 16 + 4 * fq; const f32x4 v = acc[ai][0][m][n];
                        *(f32x4*)(KPERAW + (size_t)grow * 64 + col) = v;
                        if (grow < 4096) *(f32x4*)(out_kpe + ((size_t)((grow >> 8) * 2 + li) * 256 + (grow & 255)) * 64 + col) = v; } }
        }
    }
};

template <class Epi, class Sched, bool ALIGN_EPI = false, bool SP2 = false>
__device__ __forceinline__ void gemm_phase(PG8_LAS unsigned char* lds, const Gemm g, const Sched& S, const Epi& E, const int tid) {
    const int  wid = __builtin_amdgcn_readfirstlane(tid >> 6), lane = tid & 63, wr = wid >> 2, wc = wid & 3, fr = lane & 15, fq = lane >> 4;
    const int K = g.K;
    unsigned voffA[2], voffB[2];
#pragma unroll
    for (int i = 0; i < 2; ++i) { int R, C; stage_rc(tid * 16 + i * 8192, R, C); const int Rb = Epi::PERM ? ((R & ~31) + perm32(R & 31)) : R;
        voffA[i] = (unsigned)(R * K + C) * 2u; voffB[i] = (unsigned)(Rb * K + C) * 2u; }
    const size_t kstep = (size_t)(BK * 2);
    const size_t hstep = (size_t)HALF * K * 2;
    const size_t tstep = 2 * hstep;
    const unsigned ldsw = (unsigned)wid * 1024u;
    const int aoff = lds_byte(wr * 64 + fr, fq * 8), boff = lds_byte(wc * 32 + fr, fq * 8);
#define PG8_SA(b, h) (((b) * 2 + (h)) * HTB)
#define PG8_SB(b, h) ((4 + (b) * 2 + (h)) * HTB)
#define PG8_STAGE(bufoff, gbase, voff) do { _Pragma("unroll") for (int _i = 0; _i < 2; ++_i) \
        __builtin_amdgcn_global_load_lds((const unsigned*)((const char*)(gbase) + (voff)[_i]), (PG8_LAS unsigned*)(lds + (bufoff) + ldsw + _i * 8192), 16, 0, 0); } while (0)
#define PG8_LDA(dst, b, h) do { _Pragma("unroll") for (int m = 0; m < 4; ++m) _Pragma("unroll") for (int k = 0; k < 2; ++k) dst[m][k] = *(const PG8_LAS bf16x8*)(lds + PG8_SA(b, h) + aoff + m * 2048 + k * 1024); } while (0)
#define PG8_LDB(dst, b, h) do { _Pragma("unroll") for (int n = 0; n < 2; ++n) _Pragma("unroll") for (int k = 0; k < 2; ++k) dst[n][k] = *(const PG8_LAS bf16x8*)(lds + PG8_SB(b, h) + boff + n * 2048 + k * 1024); } while (0)
#define PG8_MMA(ai, bj, At, Bt) do { __builtin_amdgcn_s_setprio(1); _Pragma("unroll") for (int m = 0; m < 4; ++m) _Pragma("unroll") for (int n = 0; n < 2; ++n) _Pragma("unroll") for (int k = 0; k < 2; ++k) \
        acc[ai][bj][m][n] = __builtin_amdgcn_mfma_f32_16x16x32_bf16(Bt[n][k], At[m][k], acc[ai][bj][m][n], 0, 0, 0); __builtin_amdgcn_s_setprio(0); } while (0)
#define PG8_WAIT_V(n) asm volatile("s_waitcnt vmcnt(" #n ")" ::: "memory")
#define PG8_WAIT_L(n) asm volatile("s_waitcnt lgkmcnt(" #n ")" ::: "memory")
#define PG8_BAR __builtin_amdgcn_s_barrier()
#define PG8_SCHED __builtin_amdgcn_sched_barrier(0)
    Unit cur, nxt; int ui = 0;
    if (!S.next(0, cur)) return;
    f32x4 acc[2][2][4][2];
#pragma unroll
    for (int a = 0; a < 2; ++a)
#pragma unroll
        for (int b = 0; b < 2; ++b)
#pragma unroll
            for (int m = 0; m < 4; ++m)
#pragma unroll
                for (int n = 0; n < 2; ++n) acc[a][b][m][n] = (f32x4){0.f, 0.f, 0.f, 0.f};
    bf16x8 At[4][2], B0[2][2], B1[2][2];
    const char* cA = (const char*)g.A + (size_t)cur.pm * tstep + (size_t)cur.kt0 * kstep; const char* cB = (const char*)g.Bt + (size_t)cur.pn * tstep + (size_t)cur.kt0 * kstep;
    S.a_ready(cur);
    if constexpr (SP2) {
        PG8_STAGE(PG8_SB(0, 0), cB, voffB); PG8_STAGE(PG8_SB(0, 1), cB + hstep, voffB); PG8_STAGE(PG8_SA(0, 0), cA, voffA); PG8_STAGE(PG8_SA(0, 1), cA + hstep, voffA);
        if (wr == 1) PG8_BAR;
        PG8_WAIT_V(2); PG8_BAR;
        PG8_STAGE(PG8_SB(1, 0), cB + kstep, voffB); PG8_STAGE(PG8_SA(1, 0), cA + kstep, voffA); PG8_STAGE(PG8_SB(1, 1), cB + hstep + kstep, voffB);
        PG8_WAIT_V(6); PG8_BAR;
    } else {
        PG8_STAGE(PG8_SB(0, 0), cB, voffB); PG8_STAGE(PG8_SA(0, 0), cA, voffA); PG8_STAGE(PG8_SB(0, 1), cB + hstep, voffB); PG8_STAGE(PG8_SA(0, 1), cA + hstep, voffA);
        if (wr == 1) PG8_BAR;
        PG8_WAIT_V(4); PG8_BAR;
        PG8_STAGE(PG8_SB(1, 0), cB + kstep, voffB); PG8_STAGE(PG8_SA(1, 0), cA + kstep, voffA); PG8_STAGE(PG8_SB(1, 1), cB + hstep + kstep, voffB);
        PG8_WAIT_V(6); PG8_BAR;
    }
    for (;;) {
        const bool has_next = S.next(ui + 1, nxt);
        const char* nA = has_next ? (const char*)g.A + (size_t)nxt.pm * tstep + (size_t)nxt.kt0 * kstep : cA; const char* nB = has_next ? (const char*)g.Bt + (size_t)nxt.pn * tstep + (size_t)nxt.kt0 * kstep : cB;
        const int nt = cur.nt;
        for (int t = 0; t < nt; t += 2) {
            const bool last = (t == nt - 2);
            const char* a1 = cA + (size_t)(t + 1) * kstep;
            const char* a2 = last ? nA : cA + (size_t)(t + 2) * kstep; const char* b2 = last ? nB : cB + (size_t)(t + 2) * kstep;
            const char* a3 = a2 + kstep; const char* b3 = b2 + kstep;
            if (last && has_next) S.a_ready(nxt);
            if constexpr (SP2) {
            PG8_LDB(B0, 0, 0); PG8_LDB(B1, 0, 1); PG8_SCHED; PG8_LDA(At, 0, 0); PG8_STAGE(PG8_SA(1, 1), a1 + hstep, voffA);
            PG8_WAIT_V(8); PG8_WAIT_L(0); PG8_BAR; PG8_MMA(0, 0, At, B0); PG8_MMA(0, 1, At, B1); PG8_BAR; PG8_SCHED;
            PG8_LDA(At, 0, 1); PG8_STAGE(PG8_SB(0, 0), b2, voffB); PG8_STAGE(PG8_SB(0, 1), b2 + hstep, voffB); PG8_STAGE(PG8_SA(0, 0), a2, voffA);
            PG8_WAIT_V(8); PG8_WAIT_L(0); PG8_BAR; PG8_MMA(1, 0, At, B0); PG8_MMA(1, 1, At, B1); PG8_BAR; PG8_SCHED;
            PG8_LDB(B0, 1, 0); PG8_LDB(B1, 1, 1); PG8_SCHED; PG8_LDA(At, 1, 0); PG8_STAGE(PG8_SA(0, 1), a2 + hstep, voffA);
            PG8_WAIT_V(8); PG8_WAIT_L(0); PG8_BAR; PG8_MMA(0, 0, At, B0); PG8_MMA(0, 1, At, B1); PG8_BAR; PG8_SCHED;
            PG8_LDA(At, 1, 1); PG8_STAGE(PG8_SB(1, 0), b3, voffB); PG8_STAGE(PG8_SB(1, 1), b3 + hstep, voffB); PG8_STAGE(PG8_SA(1, 0), a3, voffA);
            PG8_WAIT_V(8); PG8_WAIT_L(0); PG8_BAR; PG8_MMA(1, 0, At, B0); PG8_MMA(1, 1, At, B1); PG8_BAR; PG8_SCHED;
            } else {
            PG8_LDB(B0, 0, 0); PG8_SCHED; PG8_LDA(At, 0, 0); PG8_STAGE(PG8_SA(1, 1), a1 + hstep, voffA);
            PG8_WAIT_L(8); PG8_BAR; PG8_WAIT_L(0); PG8_MMA(0, 0, At, B0); PG8_BAR; PG8_SCHED;
            PG8_LDB(B1, 0, 1); PG8_STAGE(PG8_SB(0, 0), b2, voffB);
            PG8_BAR; PG8_WAIT_L(0); PG8_MMA(0, 1, At, B1); PG8_BAR;
            PG8_LDA(At, 0, 1); PG8_STAGE(PG8_SA(0, 0), a2, voffA);
            PG8_BAR; PG8_WAIT_L(0); PG8_MMA(1, 0, At, B0); PG8_BAR; PG8_SCHED;
            PG8_STAGE(PG8_SB(0, 1), b2 + hstep, voffB);
            PG8_WAIT_V(6); PG8_BAR; PG8_MMA(1, 1, At, B1); PG8_BAR;
            PG8_LDB(B0, 1, 0); PG8_SCHED; PG8_LDA(At, 1, 0); PG8_STAGE(PG8_SA(0, 1), a2 + hstep, voffA);
            PG8_WAIT_L(8); PG8_BAR; PG8_WAIT_L(0); PG8_MMA(0, 0, At, B0); PG8_BAR; PG8_SCHED;
            PG8_LDB(B1, 1, 1); PG8_STAGE(PG8_SB(1, 0), b3, voffB);
            PG8_BAR; PG8_WAIT_L(0); PG8_MMA(0, 1, At, B1); PG8_BAR;
            PG8_LDA(At, 1, 1); PG8_STAGE(PG8_SA(1, 0), a3, voffA);
            PG8_BAR; PG8_WAIT_L(0); PG8_MMA(1, 0, At, B0); PG8_BAR; PG8_SCHED;
            PG8_STAGE(PG8_SB(1, 1), b3 + hstep, voffB);
            PG8_WAIT_V(6); PG8_BAR; PG8_MMA(1, 1, At, B1); PG8_BAR;
            }
        }
        if constexpr (ALIGN_EPI) { if (wr == 0) PG8_BAR; }
        if constexpr (!Epi::AFTER_DRAIN) { E(acc, cur, wr, wc, fr, fq); S.done(cur); }
        if (!has_next) break;
#pragma unroll
        for (int a = 0; a < 2; ++a)
#pragma unroll
            for (int b = 0; b < 2; ++b)
#pragma unroll
                for (int m = 0; m < 4; ++m)
#pragma unroll
                    for (int n = 0; n < 2; ++n) acc[a][b][m][n] = (f32x4){0.f, 0.f, 0.f, 0.f};
        cur = nxt; cA = nA; cB = nB; ++ui;
        if constexpr (ALIGN_EPI) { if (wr == 1) PG8_BAR; }
    }
    PG8_WAIT_V(0);
    if constexpr (!ALIGN_EPI) { if (wr == 0) PG8_BAR; }
    PG8_BAR;
    if constexpr (Epi::AFTER_DRAIN) { E.fused(acc, cur, wr, wc, fr, fq, lds, wid, lane); S.done(cur); }
#undef PG8_SA
#undef PG8_SB
#undef PG8_STAGE
#undef PG8_LDA
#undef PG8_LDB
#undef PG8_MMA
#undef PG8_WAIT_V
#undef PG8_WAIT_L
#undef PG8_BAR
#undef PG8_SCHED
}
}

constexpr int NWAVES = 8;
constexpr int D = 1024, FF = 4096, M_CTX = 4096, M_LAT = 16384, M = M_CTX + M_LAT;
constexpr int L_LAT = 2048, L_CTX = 256, PAST = 256, LKV = PAST + L_LAT;
constexpr int MKV = M_CTX + 8 * LKV;
constexpr int EVEN_N = 3104, EVEN_NP = 3328, ODD_N = 576, ODD_NP = 768;
constexpr float EPS = 1e-6f;
constexpr int PC_QA = 0, PC_KA = 256, PC_VA = 512, PC_GA = 1024, PC_QB = 1536, PC_KB = 1792, PC_VB = 2048, PC_GB = 2560, PC_GK = 3072;
constexpr size_t OUT_Y = 0, OUT_CKV = 20971520, OUT_KPE = 23068672, OUT_SGLA = 23592960, OUT_SRET = 25690112;

constexpr size_t MiB = 1u << 20;
constexpr size_t WS_CTL = 0, CTL_ZERO_BYTES = 64 * 1024;
constexpr size_t WS_MOD = 1 * MiB;
constexpr size_t WS_ROPE = 2 * MiB;
constexpr size_t WS_KPE = 3 * MiB;
constexpr size_t WS_ACKV = 6 * MiB;
constexpr size_t WS_WINE = 18 * MiB;
constexpr size_t WS_WOUTE = 31 * MiB;
constexpr size_t WS_WINO = 35 * MiB;
constexpr size_t WS_WQB = 38 * MiB;
constexpr size_t WS_WKVB = 40 * MiB;
constexpr size_t WS_WOUTO = 42 * MiB;
constexpr size_t WS_W1 = 46 * MiB;
constexpr size_t WS_W2 = 78 * MiB;
constexpr size_t WS_HB = 110 * MiB;
constexpr size_t WS_Y = 150 * MiB;
constexpr size_t WS_BIG = 190 * MiB;
constexpr size_t WS_Q = WS_BIG, WS_KV = WS_BIG + 60 * MiB, WS_QN = WS_BIG + 148 * MiB;
constexpr size_t WS_SLAB = 350 * MiB;
constexpr size_t WS_END = 382 * MiB;

constexpr int RING_BYTES = 131072;
constexpr int LDS_MISC = 155648;
constexpr int LDS_BYTES = 163840;

#define GAS __attribute__((address_space(1)))
#define LAS __attribute__((address_space(3)))
typedef unsigned short bf16;
typedef unsigned v4u __attribute__((ext_vector_type(4)));
typedef unsigned v2u __attribute__((ext_vector_type(2)));
typedef float f32x4 __attribute__((ext_vector_type(4)));
typedef float f32x16 __attribute__((ext_vector_type(16)));
typedef short bf16x8 __attribute__((ext_vector_type(8)));
typedef short s16x4 __attribute__((ext_vector_type(4)));
#define LDS_WAIT() asm volatile("s_waitcnt lgkmcnt(0)" ::: "memory")
#define VM_WAIT() asm volatile("s_waitcnt vmcnt(0)" ::: "memory")
typedef float f32x2_t __attribute__((ext_vector_type(2))); typedef __bf16 bf16x2_t __attribute__((ext_vector_type(2)));
__device__ __forceinline__ unsigned pk2(float lo, float hi) { f32x2_t v = {lo, hi}; bf16x2_t b = __builtin_convertvector(v, bf16x2_t); return __builtin_bit_cast(unsigned, b); }
__device__ __forceinline__ unsigned f2bf(float f) { return pk2(f, f) & 0xffffu; }
__device__ __forceinline__ float bflo(unsigned w) { return __builtin_bit_cast(float, w << 16); }
__device__ __forceinline__ float bfhi(unsigned w) { return __builtin_bit_cast(float, w & 0xffff0000u); }
__device__ __forceinline__ float wave_sum(float v) {
#pragma unroll
    for (int o = 1; o < 64; o <<= 1) v += __shfl_xor(v, o);
    return v;
}
__device__ __forceinline__ float siluf(float x) { return x * __builtin_amdgcn_rcpf(1.0f + __expf(-x)); }

#define XB_TMO      128
#define XB_XCNT(j)  (256  + 64 * (j))
#define XB_XSUB(j)  (1280 + 64 * (j))
#define XB_XGEN(j)  (2304 + 64 * (j))
#define XB_TOP      3328
#define XB_TOPGEN   3392
#define XCD_BAR_WORDS 3456
#define XB_SPIN_CAP (1u << 20)
__device__ __forceinline__ unsigned xb_ld(unsigned* p)              { return __hip_atomic_load(p, __ATOMIC_RELAXED, __HIP_MEMORY_SCOPE_AGENT); }
__device__ __forceinline__ unsigned xb_add(unsigned* p, unsigned v) { return __hip_atomic_fetch_add(p, v, __ATOMIC_RELAXED, __HIP_MEMORY_SCOPE_AGENT); }
__device__ __forceinline__ unsigned xb_xcc_id() { return (unsigned)__builtin_amdgcn_s_getreg((3 << 11) | 20) & 0xFu; }
#define XB_SPIN(cond, bar) do { unsigned _sp = 0; while (cond) { __builtin_amdgcn_s_sleep(1); \
    if ((++_sp & 255u) == 0u) { if (xb_ld(&(bar)[XB_TMO])) break; if (_sp > XB_SPIN_CAP) { atomicAdd(&(bar)[XB_TMO], 1u); break; } } } } while (0)
struct XcdBarrier { unsigned* bar; unsigned x; volatile LAS unsigned* st; };
__device__ __forceinline__ XcdBarrier xcd_barrier_post(unsigned* bar, volatile LAS unsigned* st) {
    XcdBarrier b; b.bar = bar; b.x = xb_xcc_id(); b.st = st;
    if (threadIdx.x == 0) (void)xb_add(&bar[XB_XCNT(b.x)], 1u);
    return b;
}
__device__ __forceinline__ void xcd_barrier_complete(unsigned* bar, unsigned x, unsigned& nloc, unsigned& nx) {
    const unsigned G = gridDim.x * gridDim.y * gridDim.z;
    unsigned sum, cnt, mine, sp = 0u;
    for (;;) {
        sum = 0u; cnt = 0u; mine = 0u;
#pragma unroll
        for (unsigned j = 0; j < 16; ++j) { const unsigned c = xb_ld(&bar[XB_XCNT(j)]); sum += c; cnt += (c > 0u) ? 1u : 0u; mine = (j == x) ? c : mine; }
        if (sum == G) break;
        __builtin_amdgcn_s_sleep(1);
        if ((++sp & 255u) == 0u) { if (xb_ld(&bar[XB_TMO])) break; if (sp > XB_SPIN_CAP) { atomicAdd(&bar[XB_TMO], 1u); break; } }
    }
    nloc = mine > 0u ? mine : 1u; nx = cnt > 0u ? cnt : 1u;
}
__device__ __forceinline__ void xcd_barrier(const XcdBarrier& b) {
    asm volatile("s_waitcnt vmcnt(0)" ::: "memory");
    __syncthreads();
    if (threadIdx.x == 0) {
        unsigned* bar = b.bar;
        __builtin_amdgcn_s_waitcnt(0);
        unsigned nloc = b.st[0], nx = b.st[1];
        if (nloc == 0u) { xcd_barrier_complete(bar, b.x, nloc, nx); b.st[0] = nloc; b.st[1] = nx; }
        const unsigned old = xb_add(&bar[XB_XSUB(b.x)], 1u);
        const unsigned gen = old / nloc;
        if (old + 1u == (gen + 1u) * nloc) {
            __builtin_amdgcn_fence(__ATOMIC_RELEASE, "agent");
            asm volatile("s_waitcnt vmcnt(0)" ::: "memory");
            const unsigned og = xb_add(&bar[XB_TOP], 1u);
            const unsigned tg = og / nx;
            if (og + 1u == (tg + 1u) * nx) xb_add(&bar[XB_TOPGEN], 1u);
            else XB_SPIN(xb_ld(&bar[XB_TOPGEN]) == tg, bar);
            __builtin_amdgcn_fence(__ATOMIC_ACQUIRE, "agent");
            xb_add(&bar[XB_XGEN(b.x)], 1u);
            asm volatile("s_waitcnt vmcnt(0)" ::: "memory");
        } else {
            XB_SPIN(xb_ld(&bar[XB_XGEN(b.x)]) == gen, bar);
            __builtin_amdgcn_fence(__ATOMIC_ACQUIRE, "agent");
            asm volatile("s_waitcnt vmcnt(0)" ::: "memory");
        }
    }
    __syncthreads();
}

struct Params { const float* in[28]; float* out; unsigned char* ws; int ph_lo, ph_hi, use_bar, pad; };
enum { I_XP = 0, I_XS, I_CCKV, I_CKPE, I_SGLA, I_SRET, I_C, I_CCTX, I_WADA, I_BADA, I_NMIXPRE, I_NMIXPOST, I_NMLPPRE, I_NMLPPOST,
       I_WINE, I_WGK2, I_BGK2, I_GLAN, I_RDEC, I_WOUTE, I_WINO, I_QAN, I_WQB, I_KVAN, I_WKVB, I_WOUTO, I_W1, I_W2 };
struct Frame { LAS unsigned char* lds; int tid, lane, wave, vcu, G, bid; };
constexpr int LDS_PT = LDS_MISC + 256;
__device__ __forceinline__ const void* ldp(LAS unsigned char* lds, int i) {
    const volatile LAS unsigned* p = (const volatile LAS unsigned*)(lds + LDS_PT) + 2 * i;
    const unsigned lo = __builtin_amdgcn_readfirstlane(p[0]), hi = __builtin_amdgcn_readfirstlane(p[1]);
    return (const void*)(const GAS void*)(((unsigned long long)hi << 32) | lo);
}
#define PIN(i) ((const float*)ldp(F.lds, (i)))
#define POUT ((float*)ldp(F.lds, 28))
#define PWS ((unsigned char*)ldp(F.lds, 29))

__device__ __forceinline__ void p0_transpose_item(const float* W, int K, int N, bf16* WT, int kb, int n0, int dn0, LAS float* scr, int lane) {
    const int k0 = 64 * kb;
    f32x4 wv[8];
#pragma unroll
    for (int i = 0; i < 8; ++i) wv[i] = *(const f32x4*)(W + (size_t)(k0 + 8 * i + (lane >> 3)) * N + n0 + 4 * (lane & 7));
#pragma unroll
    for (int i = 0; i < 8; ++i) { LAS float* d = scr + (8 * i + (lane >> 3)) * 33 + 4 * (lane & 7); d[0] = wv[i][0]; d[1] = wv[i][1]; d[2] = wv[i][2]; d[3] = wv[i][3]; }
    LDS_WAIT(); asm volatile("" ::: "memory");
    const int c = lane & 7;
#pragma unroll
    for (int j = 0; j < 4; ++j) { const int n = (lane >> 3) + 8 * j; const LAS float* s = scr + (8 * c) * 33 + n;
        v4u o; o.x = pk2(s[0 * 33], s[1 * 33]); o.y = pk2(s[2 * 33], s[3 * 33]); o.z = pk2(s[4 * 33], s[5 * 33]); o.w = pk2(s[6 * 33], s[7 * 33]);
        *(GAS v4u*)(WT + (size_t)(dn0 + n) * K + k0 + 8 * c) = o; }
    LDS_WAIT(); asm volatile("" ::: "memory");
}
__device__ __forceinline__ int even_col_map(int n0) { return n0 < 1536 ? n0 : (n0 < 1568 ? 3072 + (n0 - 1536) : n0 - 32); }

__device__ __forceinline__ void setup_work(Frame& F, const Params& P, int wgi, int nwg, int amask  , int mmask  , int eimask  , int eomask  , int omask  ) {
    unsigned char* ws = PWS;
    LAS float* scr = (LAS float*)(F.lds + F.wave * 16384);
    __syncthreads();
    {
        LAS float* S = (LAS float*)(F.lds);
        LAS float* R = (LAS float*)(F.lds + 40960);
        { const float* cp_ = PIN(I_C); const float* cc_ = PIN(I_CCTX);
          for (int i = F.tid; i < 9 * 1024; i += 512) { const int n = i >> 10, d = i & 1023; const float cv = n < 8 ? cp_[n * 1024 + d] : cc_[d]; S[i] = siluf(cv); } }
        const float* wada_ = PIN(I_WADA); const float* bada_ = PIN(I_BADA);
        __syncthreads();
        const int nl = __builtin_popcount(amask);
        for (int uu = wgi; uu < nl * 64; uu += nwg) {
            int li_ = uu >> 6, l = 0; { int m_ = amask; for (int k_ = 0; k_ < 4; ++k_) { if (m_ & 1) { if (li_ == 0) { l = k_; break; } --li_; } m_ >>= 1; } }
            const int cb = (uu & 63) * 96;
            if (F.tid < 384) {
                const int c4 = (F.tid % 24) * 4, part = F.tid / 24;
                const float* Wp = wada_ + ((size_t)l * 1024 + part * 64) * 6144 + cb + c4;
                f32x4 a[9];
#pragma unroll
                for (int n = 0; n < 9; ++n) a[n] = (f32x4){0.f, 0.f, 0.f, 0.f};
#pragma unroll 4
                for (int d = 0; d < 64; ++d) { const f32x4 w = *(const f32x4*)(Wp + (size_t)d * 6144);
#pragma unroll
                    for (int n = 0; n < 9; ++n) a[n] += w * S[n * 1024 + part * 64 + d]; }
#pragma unroll
                for (int n = 0; n < 9; ++n) *(LAS f32x4*)(R + (part * 9 + n) * 96 + c4) = a[n];
            }
            __syncthreads();
            for (int i = F.tid; i < 9 * 96; i += 512) { const int n = i / 96, c = i % 96; float s = 0.f;
#pragma unroll
                for (int p = 0; p < 16; ++p) s += R[(p * 9 + n) * 96 + c];
                ((float*)(ws + WS_MOD))[((size_t)l * 9 + n) * 6144 + cb + c] = s + bada_[l * 6144 + cb + c]; }
            __syncthreads();
        }
    }
    {
        const int wk = wgi * NWAVES + F.wave, NW = nwg * NWAVES; int base = 0;
#define SEG(sel, count, ...) do { if (sel) { for (int q = (wk + NW - base % NW) % NW; q < (count); q += NW) { __VA_ARGS__; } base += (count); } } while (0)
        const int I_E = (1024 / 64) * (EVEN_N / 32), I_OE = 16 * 32, I_O = 16 * (ODD_N / 32), I_QB = 4 * 48, I_KVB = 4 * 64, I_M1 = 16 * 128, I_M2 = 64 * 32;
#pragma unroll
        for (int l = 0; l < 2; ++l) {
            SEG((eimask >> l) & 1, I_E, { const int nb = EVEN_N / 32, kb = q / nb, n0 = (q % nb) * 32;
                p0_transpose_item(PIN(I_WINE) + (size_t)l * 1024 * EVEN_N, 1024, EVEN_N, (bf16*)(ws + WS_WINE) + (size_t)l * EVEN_NP * 1024, kb, n0, even_col_map(n0), scr, F.lane); });
            SEG((eomask >> l) & 1, I_OE, { const int kb = q / 32, n0 = (q % 32) * 32;
                p0_transpose_item(PIN(I_WOUTE) + (size_t)l * 1024 * 1024, 1024, 1024, (bf16*)(ws + WS_WOUTE) + (size_t)l * 1024 * 1024, kb, n0, n0, scr, F.lane); });
            SEG((omask >> l) & 1, I_O, { const int nb = ODD_N / 32, kb = q / nb, n0 = (q % nb) * 32;
                p0_transpose_item(PIN(I_WINO) + (size_t)l * 1024 * ODD_N, 1024, ODD_N, (bf16*)(ws + WS_WINO) + (size_t)l * ODD_NP * 1024, kb, n0, n0, scr, F.lane); });
            SEG((omask >> l) & 1, I_QB, { const int kb = q / 48, n0 = (q % 48) * 32;
                p0_transpose_item(PIN(I_WQB) + (size_t)l * 256 * 1536, 256, 1536, (bf16*)(ws + WS_WQB) + (size_t)l * 1536 * 256, kb, n0, n0, scr, F.lane); });
            SEG((omask >> l) & 1, I_KVB, { const int kb = q / 64, n0 = (q % 64) * 32;
                p0_transpose_item(PIN(I_WKVB) + (size_t)l * 256 * 2048, 256, 2048, (bf16*)(ws + WS_WKVB) + (size_t)l * 2048 * 256, kb, n0, n0, scr, F.lane); });
            SEG((omask >> l) & 1, I_OE, { const int kb = q / 32, n0 = (q % 32) * 32;
                p0_transpose_item(PIN(I_WOUTO) + (size_t)l * 1024 * 1024, 1024, 1024, (bf16*)(ws + WS_WOUTO) + (size_t)l * 1024 * 1024, kb, n0, n0, scr, F.lane); });
        }
#pragma unroll
        for (int l = 0; l < 4; ++l) {
            SEG((mmask >> l) & 1, I_M1, { const int kb = q / 128, n0 = (q % 128) * 32;
                p0_transpose_item(PIN(I_W1) + (size_t)l * 1024 * 4096, 1024, 4096, (bf16*)(ws + WS_W1) + (size_t)l * 4096 * 1024, kb, n0, n0, scr, F.lane); });
            SEG((mmask >> l) & 1, I_M2, { const int kb = q / 32, n0 = (q % 32) * 32;
                p0_transpose_item(PIN(I_W2) + (size_t)l * 4096 * 1024, 4096, 1024, (bf16*)(ws + WS_W2) + (size_t)l * 1024 * 4096, kb, n0, n0, scr, F.lane); });
        }
#undef SEG
    }
    const int gt = wgi * 512 + F.tid, NGT = nwg * 512;
#pragma unroll
    for (int l = 0; l < 2; ++l) {
        if ((eimask >> l) & 1) for (int i = gt; i < 224 * 128; i += NGT) *(GAS v4u*)((bf16*)(ws + WS_WINE) + ((size_t)l * EVEN_NP + EVEN_N) * 1024 + (size_t)i * 8) = (v4u){0u, 0u, 0u, 0u};
        if ((omask >> l) & 1) for (int i = gt; i < 192 * 128; i += NGT) *(GAS v4u*)((bf16*)(ws + WS_WINO) + ((size_t)l * ODD_NP + ODD_N) * 1024 + (size_t)i * 8) = (v4u){0u, 0u, 0u, 0u};
    }
}
__device__ __forceinline__ void p0_prologue(Frame& F, const Params& P) {
    unsigned char* ws = PWS;
    setup_work(F, P, F.vcu, F.G, 0x5, 0x5, 0x3, 0x3, 0x0);
    const int gt = F.vcu * 512 + F.tid, NGT = F.G * 512;
    for (int i = gt; i < 2048 * 32; i += NGT) { const int t = i >> 5, j = i & 31; const float inv = powf(10000.0f, -(float)(j & 15) / 16.0f);
        const float ang = (float)(j < 16 ? (t >> 6) : (t & 63)) * inv;
        ((float*)(ws + WS_ROPE))[i] = cosf(ang); ((float*)(ws + WS_ROPE))[65536 + i] = sinf(ang); }
}

__device__ __forceinline__ void row_y(f32x4 (&yv)[4], const bf16* Y, const bf16* SL, int row, int l4) {
    if (row < 16384) {
#pragma unroll
        for (int j = 0; j < 4; ++j) { const v2u yw = *(const v2u*)(Y + (size_t)row * D + l4 + 256 * j); yv[j] = (f32x4){bflo(yw.x), bfhi(yw.x), bflo(yw.y), bfhi(yw.y)}; }
    } else {
        const bf16* sp = SL + (size_t)(row - 16384) * D + l4;
#pragma unroll
        for (int j = 0; j < 4; ++j) { const v2u w0 = *(const v2u*)(sp + 256 * j), w1 = *(const v2u*)(sp + 4194304 + 256 * j), w2 = *(const v2u*)(sp + 2 * 4194304 + 256 * j), w3 = *(const v2u*)(sp + 3 * 4194304 + 256 * j);
            yv[j] = ((f32x4){bflo(w0.x), bfhi(w0.x), bflo(w0.y), bfhi(w0.y)} + (f32x4){bflo(w1.x), bfhi(w1.x), bflo(w1.y), bfhi(w1.y)}) +
                    ((f32x4){bflo(w2.x), bfhi(w2.x), bflo(w2.y), bfhi(w2.y)} + (f32x4){bflo(w3.x), bfhi(w3.x), bflo(w3.y), bfhi(w3.y)}); }
    }
}
struct RowVec { f32x4 gp[4], gt[4], gq[4], sc[4], sh[4]; };
__device__ __forceinline__ void row_post(f32x4 (&v)[4], const f32x4 (&yv)[4], const RowVec& R) {
    float s = 0.f;
#pragma unroll
    for (int j = 0; j < 4; ++j) s += (yv[j][0] * yv[j][0] + yv[j][1] * yv[j][1]) + (yv[j][2] * yv[j][2] + yv[j][3] * yv[j][3]);
    const float rstd = __builtin_amdgcn_rsqf(wave_sum(s) * (1.0f / 1024.0f) + EPS);
#pragma unroll
    for (int j = 0; j < 4; ++j) v[j] = v[j] + R.gt[j] * ((yv[j] * rstd) * R.gp[j]);
}
__device__ __forceinline__ void row_pass(Frame& F, const float* xa, const float* xb, bool xin_f32, bf16* XB, const bf16* Y, const bf16* SL, const float* g_post, const float* gate,
                                         const float* g_pre, const float* scale, const float* shift, bf16* H, bool has_post, bool has_pre) {
    const int gw = F.vcu * NWAVES + F.wave, NGW = F.G * NWAVES, l4 = F.lane * 4;
    RowVec R; int ncur = -1;
#pragma unroll
    for (int j = 0; j < 4; ++j) { R.gp[j] = has_post ? *(const f32x4*)(g_post + l4 + 256 * j) : (f32x4){0.f, 0.f, 0.f, 0.f}; R.gq[j] = has_pre ? *(const f32x4*)(g_pre + l4 + 256 * j) : (f32x4){0.f, 0.f, 0.f, 0.f};
        R.gt[j] = R.gp[j]; R.sc[j] = R.gp[j]; R.sh[j] = R.gp[j]; }
    for (int blk = gw; blk * 10 < M; blk += NGW) for (int i = 0; i < 10; i += 2) {
        const int row0 = blk * 10 + i; if (row0 >= M) break;
        const int n = row0 < M_CTX ? 8 : ((row0 - M_CTX) >> 11);
        if (n != ncur) { ncur = n;
#pragma unroll
            for (int j = 0; j < 4; ++j) { const int c = l4 + 256 * j;
                if (has_post) R.gt[j] = *(const f32x4*)(gate + (size_t)n * 6144 + c);
                if (has_pre) { R.sc[j] = *(const f32x4*)(scale + (size_t)n * 6144 + c); R.sh[j] = *(const f32x4*)(shift + (size_t)n * 6144 + c); } } }
        f32x4 v[2][4], yv[2][4];
#pragma unroll
        for (int q = 0; q < 2; ++q) { const int row = row0 + q;
            if (xin_f32) { const float* xr = row < M_CTX ? xa + (size_t)row * D : xb + (size_t)(row - M_CTX) * D;
#pragma unroll
                for (int j = 0; j < 4; ++j) v[q][j] = *(const f32x4*)(xr + l4 + 256 * j);
            } else {
#pragma unroll
                for (int j = 0; j < 4; ++j) { const v2u xw = *(const v2u*)(XB + (size_t)row * D + l4 + 256 * j); v[q][j] = (f32x4){bflo(xw.x), bfhi(xw.x), bflo(xw.y), bfhi(xw.y)}; }
            }
            if (has_post) row_y(yv[q], Y, SL, row, l4); }
#pragma unroll
        for (int q = 0; q < 2; ++q) { const int row = row0 + q;
            if (has_post) {
                row_post(v[q], yv[q], R);
#pragma unroll
                for (int j = 0; j < 4; ++j) *(v2u*)(XB + (size_t)row * D + l4 + 256 * j) = (v2u){pk2(v[q][j][0], v[q][j][1]), pk2(v[q][j][2], v[q][j][3])};
            }
            if (has_pre) {
                float s = 0.f;
#pragma unroll
                for (int j = 0; j < 4; ++j) s += (v[q][j][0] * v[q][j][0] + v[q][j][1] * v[q][j][1]) + (v[q][j][2] * v[q][j][2] + v[q][j][3] * v[q][j][3]);
                const float rstd = __builtin_amdgcn_rsqf(wave_sum(s) * (1.0f / 1024.0f) + EPS);
#pragma unroll
                for (int j = 0; j < 4; ++j) { const f32x4 h = ((v[q][j] * rstd) * R.gq[j]) * (1.0f + R.sc[j]) + R.sh[j];
                    *(v2u*)(H + (size_t)row * D + l4 + 256 * j) = (v2u){pk2(h[0], h[1]), pk2(h[2], h[3])}; }
            } }
    }
}
__device__ __forceinline__ void row_pass_final(Frame& F, const XcdBarrier& bar, const bf16* XB, float* OUT, const bf16* Y, const bf16* SL, const float* g_post, const float* gate) {
    const int gw = F.vcu * NWAVES + F.wave, l4 = F.lane * 4;
    v2u xw[10][4];
#pragma unroll
    for (int i = 0; i < 10; ++i) { const int row = gw * 10 + i;
        if (row < M) {
#pragma unroll
            for (int j = 0; j < 4; ++j) xw[i][j] = *(const v2u*)(XB + (size_t)row * D + l4 + 256 * j);
        } }
    xcd_barrier(bar);
    RowVec R; int ncur = -1;
#pragma unroll
    for (int j = 0; j < 4; ++j) { R.gp[j] = *(const f32x4*)(g_post + l4 + 256 * j); R.gt[j] = R.gp[j]; }
#pragma unroll
    for (int i = 0; i < 10; ++i) { const int row = gw * 10 + i;
        if (row < M) {
            const int n = row < M_CTX ? 8 : ((row - M_CTX) >> 11);
            if (n != ncur) { ncur = n;
#pragma unroll
                for (int j = 0; j < 4; ++j) R.gt[j] = *(const f32x4*)(gate + (size_t)n * 6144 + l4 + 256 * j); }
            f32x4 v[4], yv[4];
#pragma unroll
            for (int j = 0; j < 4; ++j) v[j] = (f32x4){bflo(xw[i][j].x), bfhi(xw[i][j].x), bflo(xw[i][j].y), bfhi(xw[i][j].y)};
            row_y(yv, Y, SL, row, l4); row_post(v, yv, R);
#pragma unroll
            for (int j = 0; j < 4; ++j) *(f32x4*)(OUT + (size_t)row * D + l4 + 256 * j) = v[j];
        } }
}

__device__ __forceinline__ int crow(int r, int hi) { return (r & 3) + 8 * (r >> 2) + 4 * hi; }
__device__ __forceinline__ unsigned cvtpk(float lo, float hi) { return pk2(lo, hi); }
#define SBAR() __builtin_amdgcn_sched_barrier(0)
__device__ __forceinline__ int vst_row(int k, int NB) { const int kk = (k & ~0xC) | ((k & 4) << 1) | ((k & 8) >> 1); return (kk >> 3) * NB * 512 + (kk & 7) * 64; }
__device__ __forceinline__ int vst(int k, int c, int NB) { return vst_row(k, NB) + (c >> 5) * 512 + (c & 31) * 2; }
__device__ __forceinline__ int v_rd_base(int lane) { return ((lane & 3) << 3) | (((lane >> 2) & 3) << 6) | (((lane >> 4) & 1) << 5) | (((lane >> 5) & 1) << 8); }
template <int OFF> __device__ __forceinline__ s16x4 tr_read(unsigned vb) { s16x4 r; asm volatile("ds_read_b64_tr_b16 %0, %1 offset:%2" : "=&v"(r) : "v"(vb), "i"(OFF) : "memory"); return r; }
#define PKF(L, H) ((bf16x8){L[0], L[1], L[2], L[3], H[0], H[1], H[2], H[3]})
#define PK4(P, BASE, OUT) do { unsigned a0_ = cvtpk(P[BASE + 0], P[BASE + 1]), a1_ = cvtpk(P[BASE + 2], P[BASE + 3]);   \
    unsigned b0_ = cvtpk(P[BASE + 4], P[BASE + 5]), b1_ = cvtpk(P[BASE + 6], P[BASE + 7]);                              \
    auto r0_ = __builtin_amdgcn_permlane32_swap(a0_, b0_, false, false); auto r1_ = __builtin_amdgcn_permlane32_swap(a1_, b1_, false, false); \
    v4u w_ = {r0_[0], r1_[0], r0_[1], r1_[1]}; OUT = __builtin_bit_cast(bf16x8, w_); } while (0)
__device__ __forceinline__ float fexp(float x) { return __builtin_amdgcn_exp2f(x * 1.4426950408889634f); }
__device__ __forceinline__ float logsig(float x) { return fminf(x, 0.f) - 0.6931471805599453f * __builtin_amdgcn_logf(1.0f + __builtin_amdgcn_exp2f(-1.4426950408889634f * fabsf(x))); }

constexpr int SC_T = 0  , SC_TSZ = 32768, SC_QD = 0, SC_KI = 8192, SC_VT = 16384, SC_ST = 65536, SC_BT = 81920  , SC_TOT = 114688, SC_DL = 115200  ;
__device__ __forceinline__ void scan_phase(Frame& F, const Params& P, int li) {
    unsigned char* ws = PWS;
    const bf16* PROJ = (const bf16*)(ws + WS_BIG);
    const float* ROPE = (const float*)(ws + WS_ROPE);
    LAS unsigned char* G = F.lds;
    const unsigned gaddr = (unsigned)(uintptr_t)G;
    const bool isP = F.wave >= 4; const int gw4 = F.wave & 3;
    const int ri = gw4 >> 1, dh = gw4 & 1;
#define SC_BAR() do { asm volatile("s_waitcnt lgkmcnt(0)" ::: "memory"); __builtin_amdgcn_s_barrier(); asm volatile("" ::: "memory"); } while (0)
#define SC_TOK(c, i) (dir == 0 ? 64 * (c) + (i) : L - 1 - (64 * (c) + (i)))
    for (int u0 = F.bid; u0 < 256; u0 += F.G) for (int kk_ = 0; kk_ < (u0 < 128 ? 1 : 2); ++kk_) {
        __syncthreads();
        const bool lat = u0 < 128; const int u = lat ? u0 : 2 * (u0 - 128) + kk_;
        const int sb = u >> 4, hh = (u >> 1) & 7, dir = u & 1;
        const int L = lat ? L_LAT : L_CTX, row0 = lat ? M_CTX + sb * L_LAT : sb * L_CTX, NC = L / 64;
        const bool gla = hh < 4; const int h = hh & 3;
        const int qc = (gla ? PC_QA : PC_QB) + h * 64, kc = (gla ? PC_KA : PC_KB) + h * 64, vc = (gla ? PC_VA : PC_VB) + h * 128, gkc = PC_GK + dir * 16;
        bf16* OUT = (bf16*)(ws + (dir == 0 ? WS_Y : WS_HB));
        const float* rdec_p = PIN(I_RDEC); const float* wgk2_p = PIN(I_WGK2); const float* bgk2_p = PIN(I_BGK2);
        const float lgr = gla ? 0.f : -fexp(rdec_p[(li * 2 + dir) * 4 + h]);
        f32x16 sacc[2]; sacc[0] = f32x16{}; sacc[1] = f32x16{}; v4u w2f = {0u, 0u, 0u, 0u}; float gbias = 0.f;
        { int t0_ = F.tid; asm volatile("" : "+v"(t0_)); const int lane = t0_ & 63, r32 = lane & 31, hi = lane >> 5;
          if (isP) {
              if (gla) { const int kcol = h * 64 + 32 * (gw4 & 1) + r32; const float* wp_ = wgk2_p + ((size_t)(li * 2 + dir) * 16 + 8 * hi) * 256 + kcol;
                  w2f = (v4u){pk2(wp_[0], wp_[256]), pk2(wp_[512], wp_[768]), pk2(wp_[1024], wp_[1280]), pk2(wp_[1536], wp_[1792])};
                  gbias = bgk2_p[(li * 2 + dir) * 256 + kcol]; }
              else if (t0_ < 256 + 192) ((LAS float*)(G + SC_DL))[t0_ - 256] = fexp(64.0f * lgr);
          } else {
              const float* S0 = (gla ? PIN(I_SGLA) : PIN(I_SRET)) + ((size_t)((sb * 2 + li) * 2 + dir) * 4 + h) * 8192;
              if (lat) {
#pragma unroll
                  for (int d = 0; d < 2; ++d)
#pragma unroll
                      for (int r = 0; r < 16; ++r) sacc[d][r] = S0[(32 * ri + crow(r, hi)) * 128 + 32 * (2 * dh + d) + r32];
              }
#pragma unroll
              for (int d = 0; d < 2; ++d)
#pragma unroll
                  for (int r = 0; r < 16; r += 2) { const unsigned w = pk2(sacc[d][r], sacc[d][r + 1]);
                      LAS unsigned char* sp_ = G + SC_ST + (hi + 4 * ri) * 2048 + (2 * dh + d) * 512 + r32 * 2 + ((r >> 3) & 1) * 4096 + ((r & 3) + 4 * ((r >> 2) & 1)) * 64;
                      *(LAS unsigned short*)sp_ = (unsigned short)w; *(LAS unsigned short*)(sp_ + 64) = (unsigned short)(w >> 16); }
          } }
        v4u pq0 = {}, pq1 = {}, pk0 = {}, pk1 = {}, pv[4] = {}; v4u pga = {0u, 0u, 0u, 0u}; float cs[16] = {}; float tsum = 0.f;
#define SC_LOADRAW(c) do { const unsigned ro_ = (unsigned)(row0 + SC_TOK(c, sti)) * (unsigned)(EVEN_NP * 2); const char* pc_ = (const char*)PROJ; \
        pq0 = *(const v4u*)(pc_ + (ro_ + (unsigned)(qc + 8 * c8) * 2u)); pq1 = *(const v4u*)(pc_ + (ro_ + (unsigned)(qc + 32 + 8 * c8) * 2u)); \
        pk0 = *(const v4u*)(pc_ + (ro_ + (unsigned)(kc + 8 * c8) * 2u)); pk1 = *(const v4u*)(pc_ + (ro_ + (unsigned)(kc + 32 + 8 * c8) * 2u)); \
        _Pragma("unroll") for (int m_ = 0; m_ < 4; ++m_) pv[m_] = *(const v4u*)(pc_ + (ro_ + (unsigned)(vc + c8 * 32 + 8 * m_) * 2u)); } while (0)
#define SC_LOADGK(c) do { pga = *(const v4u*)((const char*)PROJ + ((unsigned)(row0 + SC_TOK(c, 32 * (gw4 >> 1) + r32)) * (unsigned)(EVEN_NP * 2) + (unsigned)(gkc + 8 * hi) * 2u)); } while (0)
        if (isP && gla) { int t0_ = F.tid; asm volatile("" : "+v"(t0_)); const int r32 = t0_ & 31, hi = (t0_ >> 5) & 1; SC_LOADGK(0); }
        for (int s = -3; s < NC; ++s) {
            int tid_o = F.tid; asm volatile("" : "+v"(tid_o));
            const int lane = tid_o & 63, r32 = lane & 31, hi = lane >> 5, tgp = tid_o & 255, sti = tgp >> 2, c8 = tgp & 3;
            if (isP) {
                if (gla && s + 2 >= 0 && s + 2 < NC) {
                    const int th = gw4 >> 1, kq = 32 * (gw4 & 1) + r32; LAS float* BTw = (LAS float*)(G + SC_BT + ((s + 2) & 1) * 16384);
                    const float t0v = ((LAS float*)(G + SC_TOT))[kq]; const float pre = th ? t0v : 0.f;
#pragma unroll
                    for (int r = 0; r < 16; ++r) BTw[(32 * th + crow(r, hi)) * 64 + kq] = pre + cs[r];
                    if (th == 1 && hi == 0) ((LAS float*)(G + SC_DL))[((s + 2) % 3) * 64 + kq] = fexp(pre + tsum);
                }
                if (s + 1 >= 0 && s + 1 < NC) {
                    LAS unsigned char* T = G + SC_T + ((s + 1) & 1) * SC_TSZ;
                    float q[16], kk[16];
#define UNPK(dst, o, W_) do { const v4u w_ = (W_); dst[o + 0] = bflo(w_[0]); dst[o + 1] = bfhi(w_[0]); dst[o + 2] = bflo(w_[1]); dst[o + 3] = bfhi(w_[1]); dst[o + 4] = bflo(w_[2]); dst[o + 5] = bfhi(w_[2]); dst[o + 6] = bflo(w_[3]); dst[o + 7] = bfhi(w_[3]); } while (0)
                    UNPK(q, 0, pq0); UNPK(q, 8, pq1); UNPK(kk, 0, pk0); UNPK(kk, 8, pk1);
                    if (gla) {
                        const LAS float* BTr = (const LAS float*)(G + SC_BT + ((s + 1) & 1) * 16384) + sti * 64 + 8 * c8;
                        const f32x4 x0 = *(const LAS f32x4*)BTr, x1 = *(const LAS f32x4*)(BTr + 4), x2 = *(const LAS f32x4*)(BTr + 32), x3 = *(const LAS f32x4*)(BTr + 36);
#pragma unroll
                        for (int e = 0; e < 4; ++e) { const float e0 = fexp(x0[e]), e1 = fexp(x1[e]), e2 = fexp(x2[e]), e3 = fexp(x3[e]);
                            q[e] *= 0.125f * e0; kk[e] *= __builtin_amdgcn_rcpf(e0); q[4 + e] *= 0.125f * e1; kk[4 + e] *= __builtin_amdgcn_rcpf(e1);
                            q[8 + e] *= 0.125f * e2; kk[8 + e] *= __builtin_amdgcn_rcpf(e2); q[12 + e] *= 0.125f * e3; kk[12 + e] *= __builtin_amdgcn_rcpf(e3); }
                    } else {
                        if (lat) {
                            const float* cp = ROPE + (size_t)SC_TOK(s + 1, sti) * 32 + 8 * c8; const f32x4 c0 = *(const f32x4*)cp, c1 = *(const f32x4*)(cp + 4), s0 = *(const f32x4*)(cp + 65536), s1 = *(const f32x4*)(cp + 65540);
#pragma unroll
                            for (int e = 0; e < 8; ++e) { const float c = e < 4 ? c0[e & 3] : c1[e & 3], sn = e < 4 ? s0[e & 3] : s1[e & 3];
                                const float q1 = q[e], q2 = q[8 + e]; q[e] = q1 * c - q2 * sn; q[8 + e] = q1 * sn + q2 * c;
                                const float k1 = kk[e], k2 = kk[8 + e]; kk[e] = k1 * c - k2 * sn; kk[8 + e] = k1 * sn + k2 * c; }
                        }
                        const float bb = (float)(sti + 1) * lgr, eb = fexp(bb), ek = 0.125f * __builtin_amdgcn_rcpf(eb);
#pragma unroll
                        for (int e = 0; e < 16; ++e) { q[e] *= eb; kk[e] *= ek; }
                    }
                    *(LAS v4u*)(T + SC_QD + vst(sti, 8 * c8, 2)) = (v4u){pk2(q[0], q[1]), pk2(q[2], q[3]), pk2(q[4], q[5]), pk2(q[6], q[7])};
                    *(LAS v4u*)(T + SC_QD + vst(sti, 32 + 8 * c8, 2)) = (v4u){pk2(q[8], q[9]), pk2(q[10], q[11]), pk2(q[12], q[13]), pk2(q[14], q[15])};
                    *(LAS v4u*)(T + SC_KI + vst(sti, 8 * c8, 2)) = (v4u){pk2(kk[0], kk[1]), pk2(kk[2], kk[3]), pk2(kk[4], kk[5]), pk2(kk[6], kk[7])};
                    *(LAS v4u*)(T + SC_KI + vst(sti, 32 + 8 * c8, 2)) = (v4u){pk2(kk[8], kk[9]), pk2(kk[10], kk[11]), pk2(kk[12], kk[13]), pk2(kk[14], kk[15])};
#pragma unroll
                    for (int m = 0; m < 4; ++m) *(LAS v4u*)(T + SC_VT + vst(sti, c8 * 32 + 8 * m, 4)) = pv[m];
                }
                if (s + 2 >= 0 && s + 2 < NC) SC_LOADRAW(s + 2);
            } else if (s >= 0) {
                LAS unsigned char* T = G + SC_T + (s & 1) * SC_TSZ; const unsigned taddr = gaddr + SC_T + (s & 1) * SC_TSZ;
                bf16x8 qf[4]; bf16x8 pa0, pa1, pa2, pa3;
                { const int qb_ = vst_row(32 * ri + r32, 2) + 16 * hi;
                  qf[0] = *(const LAS bf16x8*)(T + SC_QD + qb_); qf[1] = *(const LAS bf16x8*)(T + SC_QD + qb_ + 32); qf[2] = *(const LAS bf16x8*)(T + SC_QD + qb_ + 512); qf[3] = *(const LAS bf16x8*)(T + SC_QD + qb_ + 544); }
                { f32x16 p0 = {}, p1 = {};
                  const int kb0 = vst_row(r32, 2) + 16 * hi, kb1 = vst_row(32 + r32, 2) + 16 * hi;
                  { const bf16x8 a0 = *(const LAS bf16x8*)(T + SC_KI + kb0), a1 = *(const LAS bf16x8*)(T + SC_KI + kb0 + 32), a2 = *(const LAS bf16x8*)(T + SC_KI + kb0 + 512), a3 = *(const LAS bf16x8*)(T + SC_KI + kb0 + 544);
                    p0 = __builtin_amdgcn_mfma_f32_32x32x16_bf16(a0, qf[0], p0, 0, 0, 0); p0 = __builtin_amdgcn_mfma_f32_32x32x16_bf16(a1, qf[1], p0, 0, 0, 0);
                    p0 = __builtin_amdgcn_mfma_f32_32x32x16_bf16(a2, qf[2], p0, 0, 0, 0); p0 = __builtin_amdgcn_mfma_f32_32x32x16_bf16(a3, qf[3], p0, 0, 0, 0); }
                  if (ri == 1) {
                      const bf16x8 c0 = *(const LAS bf16x8*)(T + SC_KI + kb1), c1 = *(const LAS bf16x8*)(T + SC_KI + kb1 + 32), c2 = *(const LAS bf16x8*)(T + SC_KI + kb1 + 512), c3 = *(const LAS bf16x8*)(T + SC_KI + kb1 + 544);
                      p1 = __builtin_amdgcn_mfma_f32_32x32x16_bf16(c0, qf[0], p1, 0, 0, 0); p1 = __builtin_amdgcn_mfma_f32_32x32x16_bf16(c1, qf[1], p1, 0, 0, 0);
                      p1 = __builtin_amdgcn_mfma_f32_32x32x16_bf16(c2, qf[2], p1, 0, 0, 0); p1 = __builtin_amdgcn_mfma_f32_32x32x16_bf16(c3, qf[3], p1, 0, 0, 0); }
#pragma unroll
                  for (int r = 0; r < 16; ++r) { const bool keep = crow(r, hi) <= r32; if (ri == 0) { p0[r] = keep ? p0[r] : 0.f; } else { p1[r] = keep ? p1[r] : 0.f; } }
                  PK4(p0, 0, pa0); PK4(p0, 8, pa1); PK4(p1, 0, pa2); PK4(p1, 8, pa3); }
                const unsigned vb = taddr + SC_VT + v_rd_base(lane) + dh * 1024, sbv = gaddr + SC_ST + v_rd_base(lane) + dh * 1024;
#define SC_FR4(dst, base, d) do { const s16x4 l0_ = tr_read<(d) * 512>(base), h0_ = tr_read<(d) * 512 + 2048>(base), l1_ = tr_read<(d) * 512 + 4096>(base), h1_ = tr_read<(d) * 512 + 4096 + 2048>(base); \
                  const s16x4 l2_ = tr_read<(d) * 512 + 8192>(base), h2_ = tr_read<(d) * 512 + 8192 + 2048>(base), l3_ = tr_read<(d) * 512 + 12288>(base), h3_ = tr_read<(d) * 512 + 12288 + 2048>(base); \
                  asm volatile("s_waitcnt lgkmcnt(0)" ::: "memory"); SBAR(); \
                  dst[0] = PKF(l0_, h0_); dst[1] = PKF(l1_, h1_); dst[2] = PKF(l2_, h2_); dst[3] = PKF(l3_, h3_); } while (0)
#define SC_OBLK(d) do { bf16x8 vf_[4], sf_[4]; SC_FR4(vf_, vb, d); SC_FR4(sf_, sbv, d); f32x16 o_ = {}; \
                  o_ = __builtin_amdgcn_mfma_f32_32x32x16_bf16(pa0, vf_[0], o_, 0, 0, 0); o_ = __builtin_amdgcn_mfma_f32_32x32x16_bf16(pa1, vf_[1], o_, 0, 0, 0); \
                  if (ri == 1) { o_ = __builtin_amdgcn_mfma_f32_32x32x16_bf16(pa2, vf_[2], o_, 0, 0, 0); o_ = __builtin_amdgcn_mfma_f32_32x32x16_bf16(pa3, vf_[3], o_, 0, 0, 0); } \
                  o_ = __builtin_amdgcn_mfma_f32_32x32x16_bf16(qf[0], sf_[0], o_, 0, 0, 0); o_ = __builtin_amdgcn_mfma_f32_32x32x16_bf16(qf[1], sf_[1], o_, 0, 0, 0); \
                  o_ = __builtin_amdgcn_mfma_f32_32x32x16_bf16(qf[2], sf_[2], o_, 0, 0, 0); o_ = __builtin_amdgcn_mfma_f32_32x32x16_bf16(qf[3], sf_[3], o_, 0, 0, 0); \
                  char* dst_ = (char*)OUT; \
                  _Pragma("unroll") for (int r = 0; r < 16; r += 2) { const int i_ = 32 * ri + crow(r, hi); const int t_ = SC_TOK(s, i_); const unsigned w_ = pk2(o_[r], o_[r + 1]); \
                      const unsigned a_ = (unsigned)(row0 + t_) * (unsigned)(D * 2) + (unsigned)(hh * 128 + 64 * dh + 32 * (d) + r32) * 2u; \
                      *(bf16*)(dst_ + a_) = (bf16)w_; *(bf16*)(dst_ + (dir == 0 ? a_ + (unsigned)(D * 2) : a_ - (unsigned)(D * 2))) = (bf16)(w_ >> 16); } SBAR(); } while (0)
                SC_OBLK(0); SC_OBLK(1);
            }
            SC_BAR();
            if (isP) {
                if (gla && s + 3 < NC) {
                    const int th = gw4 >> 1, kq = 32 * (gw4 & 1) + r32;
                    f32x16 gp;
#pragma unroll
                    for (int r = 0; r < 16; ++r) gp[r] = gbias;
                    gp = __builtin_amdgcn_mfma_f32_32x32x16_bf16(__builtin_bit_cast(bf16x8, pga), __builtin_bit_cast(bf16x8, w2f), gp, 0, 0, 0);
                    float g4[4], o4[4];
#pragma unroll
                    for (int j = 0; j < 4; ++j) { float run = 0.f;
#pragma unroll
                        for (int e = 0; e < 4; ++e) { run += logsig(gp[4 * j + e]) * (1.0f / 16.0f); cs[4 * j + e] = run; }
                        g4[j] = run; }
#pragma unroll
                    for (int j = 0; j < 4; ++j) o4[j] = __shfl_xor(g4[j], 32);
                    float acc_ = 0.f;
#pragma unroll
                    for (int j = 0; j < 4; ++j) { const float off = acc_ + (hi ? o4[j] : 0.f);
#pragma unroll
                        for (int e = 0; e < 4; ++e) cs[4 * j + e] += off;
                        acc_ += g4[j] + o4[j]; }
                    tsum = acc_;
                    if (hi == 0) ((LAS float*)(G + SC_TOT))[th * 64 + kq] = tsum;
                    if (s + 4 < NC) SC_LOADGK(s + 4);
                }
            } else if (s >= 0) {
                const unsigned taddr = gaddr + SC_T + (s & 1) * SC_TSZ;
                const unsigned vb = taddr + SC_VT + v_rd_base(lane) + dh * 1024, kt = taddr + SC_KI + v_rd_base(lane) + ri * 512;
                bf16x8 kf[4];
                { const s16x4 l0_ = tr_read<0>(kt), h0_ = tr_read<1024>(kt), l1_ = tr_read<2048>(kt), h1_ = tr_read<2048 + 1024>(kt), l2_ = tr_read<4096>(kt), h2_ = tr_read<4096 + 1024>(kt), l3_ = tr_read<6144>(kt), h3_ = tr_read<6144 + 1024>(kt);
                  asm volatile("s_waitcnt lgkmcnt(0)" ::: "memory"); SBAR();
                  kf[0] = PKF(l0_, h0_); kf[1] = PKF(l1_, h1_); kf[2] = PKF(l2_, h2_); kf[3] = PKF(l3_, h3_); }
                const int stb_ = (hi + 4 * ri) * 2048 + (2 * dh) * 512 + r32 * 2;
                const LAS float* DLr = (const LAS float*)(G + SC_DL) + (s % 3) * 64;
#define SC_SBLK(d) do { bf16x8 vf_[4]; SC_FR4(vf_, vb, d); \
                  _Pragma("unroll") for (int ks = 0; ks < 4; ++ks) sacc[d] = __builtin_amdgcn_mfma_f32_32x32x16_bf16(kf[ks], vf_[ks], sacc[d], 0, 0, 0); \
                  _Pragma("unroll") for (int r = 0; r < 16; r += 2) { const int dk = 32 * ri + crow(r, hi); const float dl0 = DLr[dk], dl1 = DLr[dk + 1]; \
                      sacc[d][r] *= dl0; sacc[d][r + 1] *= dl1; const unsigned w_ = pk2(sacc[d][r], sacc[d][r + 1]); \
                      LAS unsigned char* sp_ = G + SC_ST + stb_ + (d) * 512 + ((r >> 3) & 1) * 4096 + ((r & 3) + 4 * ((r >> 2) & 1)) * 64; \
                      *(LAS unsigned short*)sp_ = (unsigned short)w_; *(LAS unsigned short*)(sp_ + 64) = (unsigned short)(w_ >> 16); } SBAR(); } while (0)
                SC_SBLK(0); SC_SBLK(1);
            }
            SC_BAR();
        }
        if (!lat && !isP) { int l2 = F.lane; asm volatile("" : "+v"(l2)); const int r32 = l2 & 31, hi = l2 >> 5; float* SO = POUT + (gla ? OUT_SGLA : OUT_SRET) + ((size_t)((sb * 2 + li) * 2 + dir) * 4 + h) * 8192;
#pragma unroll
            for (int d = 0; d < 2; ++d)
#pragma unroll
                for (int r = 0; r < 16; ++r) SO[(32 * ri + crow(r, hi)) * 128 + 32 * (2 * dh + d) + r32] = sacc[d][r]; }
    }
#undef SC_TOK
#undef SC_BAR
#undef SC_LOADRAW
#undef SC_LOADGK
#undef UNPK
#undef SC_FR4
#undef SC_OBLK
#undef SC_SBLK
    if (F.G == 256 && F.bid >= 128) { if (li == 0) setup_work(F, P, F.bid - 128, 128, 0x2, 0x2, 0x0, 0x0, 0x1); else setup_work(F, P, F.bid - 128, 128, 0x8, 0x8, 0x0, 0x0, 0x2); }
    else if (F.G != 256) { if (li == 0) setup_work(F, P, F.bid, F.G, 0x2, 0x2, 0x0, 0x0, 0x1); else setup_work(F, P, F.bid, F.G, 0x8, 0x8, 0x0, 0x0, 0x2); }
}
__device__ __forceinline__ void scan_combine(Frame& F, const Params& P, int li) {
    unsigned char* ws = PWS;
    const char* PROJ = (const char*)(ws + WS_BIG); const char* OF = (const char*)(ws + WS_Y); char* OB = (char*)(ws + WS_HB);
    const int gw = F.vcu * NWAVES + F.wave, NGW = F.G * NWAVES, lane = F.lane, hh = lane >> 3, dv = (lane & 7) * 16;
    f32x4 gn[4];
    { const float* gp_ = PIN(I_GLAN) + li * 128 + dv;
#pragma unroll
      for (int j = 0; j < 4; ++j) gn[j] = hh < 4 ? *(const f32x4*)(gp_ + 4 * j) : (f32x4){1.f, 1.f, 1.f, 1.f}; }
    const unsigned gcol = (unsigned)((hh < 4 ? PC_GA : PC_GB) + (hh & 3) * 128 + dv) * 2u, ocol = (unsigned)(hh * 128 + dv) * 2u;
    for (int row = gw; row < M; row += 2 * NGW) {
        v4u a[2][2], b[2][2], g[2][2];
#pragma unroll
        for (int i = 0; i < 2; ++i) { const int r_ = row + i * NGW; if (r_ < M) {
            const unsigned off = (unsigned)r_ * (unsigned)(D * 2) + ocol, goff = (unsigned)r_ * (unsigned)(EVEN_NP * 2) + gcol;
            a[i][0] = *(const v4u*)(OF + off); a[i][1] = *(const v4u*)(OF + off + 16); b[i][0] = *(const v4u*)(OB + off); b[i][1] = *(const v4u*)(OB + off + 16);
            g[i][0] = *(const v4u*)(PROJ + goff); g[i][1] = *(const v4u*)(PROJ + goff + 16); } }
#pragma unroll
        for (int i = 0; i < 2; ++i) { const int r_ = row + i * NGW; if (r_ < M) {
            const unsigned off = (unsigned)r_ * (unsigned)(D * 2) + ocol;
            float x[16], gg[16];
#pragma unroll
            for (int hf = 0; hf < 2; ++hf)
#pragma unroll
                for (int e = 0; e < 4; ++e) { x[8 * hf + 2 * e] = bflo(a[i][hf][e]) + bflo(b[i][hf][e]); x[8 * hf + 2 * e + 1] = bfhi(a[i][hf][e]) + bfhi(b[i][hf][e]);
                    gg[8 * hf + 2 * e] = bflo(g[i][hf][e]); gg[8 * hf + 2 * e + 1] = bfhi(g[i][hf][e]); }
            float ss = 0.f;
#pragma unroll
            for (int e = 0; e < 16; ++e) ss += x[e] * x[e];
            ss += __shfl_xor(ss, 1); ss += __shfl_xor(ss, 2); ss += __shfl_xor(ss, 4);
            const float rstd = __builtin_amdgcn_rsqf(ss * (1.0f / 128.0f) + EPS);
#pragma unroll
            for (int e = 0; e < 16; ++e) x[e] = x[e] * rstd * gn[e >> 2][e & 3] * siluf(gg[e]);
            *(v4u*)(OB + off) = (v4u){pk2(x[0], x[1]), pk2(x[2], x[3]), pk2(x[4], x[5]), pk2(x[6], x[7])};
            *(v4u*)(OB + off + 16) = (v4u){pk2(x[8], x[9]), pk2(x[10], x[11]), pk2(x[12], x[13]), pk2(x[14], x[15])}; } }
    }
}

__device__ __forceinline__ void cache_pass(Frame& F, const Params& P, int li) {
    unsigned char* ws = PWS;
    const int gt = F.vcu * 512 + F.tid, NGT = F.G * 512;
    const float* cckv_ = PIN(I_CCKV); const float* ckpe_ = PIN(I_CKPE);
    for (int i = gt; i < 8 * 256 * 32; i += NGT) { const int c8 = i & 31, t = (i >> 5) & 255, b = i >> 13;
        const float* s = cckv_ + ((size_t)((b * 2 + li) * 256 + t) * 32 + c8) * 8; const f32x4 a = *(const f32x4*)s, c = *(const f32x4*)(s + 4);
        *(GAS v4u*)((bf16*)(ws + WS_ACKV) + ((size_t)4096 + b * LKV + t) * 256 + c8 * 8) = (v4u){pk2(a[0], a[1]), pk2(a[2], a[3]), pk2(c[0], c[1]), pk2(c[2], c[3])}; }
    for (int i = gt; i < 8 * 256 * 8; i += NGT) { const int c8 = i & 7, t = (i >> 3) & 255, b = i >> 11;
        const float* s = ckpe_ + ((size_t)((b * 2 + li) * 256 + t) * 8 + c8) * 8; const f32x4 a = *(const f32x4*)s, c = *(const f32x4*)(s + 4);
        *(GAS v4u*)((bf16*)(ws + WS_KPE) + ((size_t)4096 + b * LKV + t) * 64 + c8 * 8) = (v4u){pk2(a[0], a[1]), pk2(a[2], a[3]), pk2(c[0], c[1]), pk2(c[2], c[3])}; }
}
__device__ __forceinline__ void kpe_pass(Frame& F, const Params& P, int li) {
    unsigned char* ws = PWS;
    const float* KR = (const float*)(ws + WS_Y); const float* ROPE = (const float*)(ws + WS_ROPE);
    bf16* KPE = (bf16*)(ws + WS_KPE);
    const int gt = F.vcu * 512 + F.tid, NGT = F.G * 512;
    for (int i = gt; i < M * 4; i += NGT) {
        const int row = i >> 2, c8 = i & 3;
        const float* s = KR + (size_t)row * 64 + 8 * c8;
        f32x4 a0 = *(const f32x4*)s, a1 = *(const f32x4*)(s + 4), b0 = *(const f32x4*)(s + 32), b1 = *(const f32x4*)(s + 36);
        int drow = row;
        if (row >= M_CTX) { const int lb = (row - M_CTX) >> 11, t = (row - M_CTX) & 2047; drow = M_CTX + lb * LKV + PAST + t;
            const float* cp = ROPE + (size_t)t * 32 + 8 * c8; const float* sp = cp + 65536;
            const f32x4 c0 = *(const f32x4*)cp, c1 = *(const f32x4*)(cp + 4), s0 = *(const f32x4*)sp, s1 = *(const f32x4*)(sp + 4);
            const f32x4 x0 = a0 * c0 - b0 * s0, x1 = a1 * c1 - b1 * s1, y0 = a0 * s0 + b0 * c0, y1 = a1 * s1 + b1 * c1;
            a0 = x0; a1 = x1; b0 = y0; b1 = y1; }
        bf16* d = KPE + (size_t)drow * 64 + 8 * c8;
        *(v4u*)d = (v4u){pk2(a0[0], a0[1]), pk2(a0[2], a0[3]), pk2(a1[0], a1[1]), pk2(a1[2], a1[3])};
        *(v4u*)(d + 32) = (v4u){pk2(b0[0], b0[1]), pk2(b0[2], b0[3]), pk2(b1[0], b1[1]), pk2(b1[2], b1[3])};
    }
}

constexpr float ATT_SCALE = 0.07216878364870322f;
constexpr float ATT_THR = 8.f;
constexpr int AT_V = 0, AT_KN = 49152, AT_KP = 98304, AT_WS = 122880, AT_VB = 16384, AT_KNB = 16384, AT_KPB = 8192;
#define KSWZ(row, colB) ((row) * 256 + ((colB) ^ (((row) & 7) << 4)))
#define KPSWZ(row, colB) ((row) * 128 + ((colB) ^ (((row) & 7) << 4)))
__device__ __forceinline__ void at_partialSM(f32x16& p0, f32x16& p1, float& m_reg, float& mn, float& alpha) {
    constexpr float C = ATT_SCALE * 1.4426950408889634f;
    float pmax = p0[0];
#pragma unroll
    for (int r = 1; r < 16; ++r) pmax = fmaxf(pmax, p0[r]);
#pragma unroll
    for (int r = 0; r < 16; ++r) pmax = fmaxf(pmax, p1[r]);
    { auto rr = __builtin_amdgcn_permlane32_swap(__float_as_uint(pmax), __float_as_uint(pmax), false, false); pmax = fmaxf(__uint_as_float(rr[0]), __uint_as_float(rr[1])); }
    if (__builtin_expect(__all(pmax - m_reg <= ATT_THR / ATT_SCALE), 1)) { mn = m_reg; alpha = 1.f; }
    else { mn = fmaxf(m_reg, pmax); alpha = __builtin_amdgcn_exp2f((m_reg - mn) * C); m_reg = mn; }
    const float mnC = -mn * C;
#pragma unroll
    for (int r = 0; r < 16; ++r) p0[r] = fmaf(p0[r], C, mnC);
#pragma unroll
    for (int r = 0; r < 16; ++r) p1[r] = fmaf(p1[r], C, mnC);
#pragma unroll
    for (int r = 0; r < 16; ++r) p0[r] = __builtin_amdgcn_exp2f(p0[r]);
}
__device__ __forceinline__ void at_finishSM(f32x16& p0, f32x16& p1, float alpha, float& l_reg, bf16x8& pa0, bf16x8& pa1, bf16x8& pa2, bf16x8& pa3) {
#pragma unroll
    for (int r = 0; r < 16; ++r) p1[r] = __builtin_amdgcn_exp2f(p1[r]);
    float ps = 0;
#pragma unroll
    for (int r = 0; r < 16; ++r) ps += p0[r];
#pragma unroll
    for (int r = 0; r < 16; ++r) ps += p1[r];
    { auto rr = __builtin_amdgcn_permlane32_swap(__float_as_uint(ps), __float_as_uint(ps), false, false); ps = __uint_as_float(rr[0]) + __uint_as_float(rr[1]); }
    l_reg = l_reg * alpha + ps;
    PK4(p0, 0, pa0); PK4(p0, 8, pa1); PK4(p1, 0, pa2); PK4(p1, 8, pa3);
}
__device__ __forceinline__ void at_qkt(f32x16& p0, f32x16& p1, const LAS unsigned char* Kn, const LAS unsigned char* Kp, const bf16x8* qr, const int* kb, const int* pb) {
    p0 = f32x16{}; p1 = f32x16{};
#pragma unroll
    for (int d0 = 0; d0 < 8; ++d0) {
        const bf16x8 b0 = *(const LAS bf16x8*)(Kn + kb[d0 & 3] + 128 * (d0 >> 2)), b1 = *(const LAS bf16x8*)(Kn + kb[d0 & 3] + 128 * (d0 >> 2) + 8192);
        p0 = __builtin_amdgcn_mfma_f32_32x32x16_bf16(b0, qr[d0], p0, 0, 0, 0);
        p1 = __builtin_amdgcn_mfma_f32_32x32x16_bf16(b1, qr[d0], p1, 0, 0, 0); }
#pragma unroll
    for (int d0 = 0; d0 < 4; ++d0) {
        const bf16x8 b0 = *(const LAS bf16x8*)(Kp + pb[d0]), b1 = *(const LAS bf16x8*)(Kp + pb[d0] + 4096);
        p0 = __builtin_amdgcn_mfma_f32_32x32x16_bf16(b0, qr[8 + d0], p0, 0, 0, 0);
        p1 = __builtin_amdgcn_mfma_f32_32x32x16_bf16(b1, qr[8 + d0], p1, 0, 0, 0); }
}
template <int D0> __device__ __forceinline__ void at_pv_one(f32x16& od, unsigned vb, bf16x8 pa0, bf16x8 pa1, bf16x8 pa2, bf16x8 pa3) {
    const s16x4 l0 = tr_read<D0 * 512>(vb), h0 = tr_read<D0 * 512 + 2048>(vb), l1 = tr_read<D0 * 512 + 4096>(vb), h1 = tr_read<D0 * 512 + 4096 + 2048>(vb);
    const s16x4 l2 = tr_read<D0 * 512 + 8192>(vb), h2 = tr_read<D0 * 512 + 8192 + 2048>(vb), l3 = tr_read<D0 * 512 + 12288>(vb), h3 = tr_read<D0 * 512 + 12288 + 2048>(vb);
    asm volatile("s_waitcnt lgkmcnt(0)" ::: "memory"); SBAR();
    od = __builtin_amdgcn_mfma_f32_32x32x16_bf16(pa0, PKF(l0, h0), od, 0, 0, 0);
    od = __builtin_amdgcn_mfma_f32_32x32x16_bf16(pa1, PKF(l1, h1), od, 0, 0, 0);
    od = __builtin_amdgcn_mfma_f32_32x32x16_bf16(pa2, PKF(l2, h2), od, 0, 0, 0);
    od = __builtin_amdgcn_mfma_f32_32x32x16_bf16(pa3, PKF(l3, h3), od, 0, 0, 0);
}
__device__ __forceinline__ void at_pv(f32x16* o, unsigned vb, bf16x8 pa0, bf16x8 pa1, bf16x8 pa2, bf16x8 pa3) {
    at_pv_one<0>(o[0], vb, pa0, pa1, pa2, pa3); at_pv_one<1>(o[1], vb, pa0, pa1, pa2, pa3); at_pv_one<2>(o[2], vb, pa0, pa1, pa2, pa3); at_pv_one<3>(o[3], vb, pa0, pa1, pa2, pa3);
}
__device__ __forceinline__ void attn_unit(Frame& F, const bf16* Qrow0  , const bf16* KVh  , const bf16* KPEs  ,
                                          bf16* Orow0, int nkeys, const float* ROPE, int tpos0  ) {
    LAS unsigned char* lds = F.lds;
    const int tid = F.tid, wid = F.wave, lane = F.lane, r32 = lane & 31, hi = lane >> 5;
    LAS float* wsf = (LAS float*)(lds + AT_WS) + wid * 64; LAS float* li_l = wsf; LAS float* al_l = wsf + 32;
    float m_reg = -1e30f, l_reg = 0; f32x16 o[4] = {}; bf16x8 qr[12];
    { const bf16* Qw = Qrow0 + (size_t)(wid * 32 + r32) * 1536 + hi * 8;
#pragma unroll
      for (int d0 = 0; d0 < 12; ++d0) qr[d0] = *(const bf16x8*)(Qw + d0 * 16);
      if (tpos0 >= 0) {
          const int t = tpos0 + wid * 32 + r32;
#pragma unroll
          for (int half = 0; half < 2; ++half) {
              const float* cp = ROPE + (size_t)t * 32 + 16 * half + 8 * hi; const float* sp = cp + 65536;
              const v4u xa = __builtin_bit_cast(v4u, qr[8 + half]), xb = __builtin_bit_cast(v4u, qr[10 + half]);
              float x1[8], x2[8];
              x1[0] = bflo(xa.x); x1[1] = bfhi(xa.x); x1[2] = bflo(xa.y); x1[3] = bfhi(xa.y); x1[4] = bflo(xa.z); x1[5] = bfhi(xa.z); x1[6] = bflo(xa.w); x1[7] = bfhi(xa.w);
              x2[0] = bflo(xb.x); x2[1] = bfhi(xb.x); x2[2] = bflo(xb.y); x2[3] = bfhi(xb.y); x2[4] = bflo(xb.z); x2[5] = bfhi(xb.z); x2[6] = bflo(xb.w); x2[7] = bfhi(xb.w);
              float y1[8], y2[8];
#pragma unroll
              for (int j = 0; j < 8; ++j) { const float c = cp[j], s = sp[j]; y1[j] = x1[j] * c - x2[j] * s; y2[j] = x1[j] * s + x2[j] * c; }
              const v4u wa = {pk2(y1[0], y1[1]), pk2(y1[2], y1[3]), pk2(y1[4], y1[5]), pk2(y1[6], y1[7])}, wb = {pk2(y2[0], y2[1]), pk2(y2[2], y2[3]), pk2(y2[4], y2[5]), pk2(y2[6], y2[7])};
              if (half == 0) { qr[8] = __builtin_bit_cast(bf16x8, wa); qr[10] = __builtin_bit_cast(bf16x8, wb); } else { qr[9] = __builtin_bit_cast(bf16x8, wa); qr[11] = __builtin_bit_cast(bf16x8, wb); }
          }
      } }
    const unsigned vb0 = (unsigned)(uintptr_t)(lds + AT_V) + v_rd_base(lane);
#define AT_OPQ() int l_ = lane; asm volatile("" : "+v"(l_))
#define AT_KADDR() int kbs[4], pbs[4]; { AT_OPQ(); _Pragma("unroll") for (int b = 0; b < 4; ++b) { const int x = (32 * b + 16 * (l_ >> 5)) ^ ((l_ & 7) << 4); kbs[b] = (l_ & 31) * 256 + x; pbs[b] = (l_ & 31) * 128 + x; } }
#define AT_GLDS(gp, ldsoff) __builtin_amdgcn_global_load_lds((const unsigned*)(gp), (LAS unsigned*)(lds + (ldsoff)), 16, 0, 0)
#define AT_DMA_K(t, b) do { AT_OPQ(); const char* kb_ = (const char*)KVh + (size_t)(t) * (64 * 4096); const char* pb_ = (const char*)KPEs + (size_t)(t) * (64 * 128); \
    const int row0_ = 4 * wid + (l_ >> 4), cB0_ = ((l_ & 15) * 16) ^ ((row0_ & 7) << 4), row1_ = row0_ + 32, rowp_ = 8 * wid + (l_ >> 3), cBp_ = ((l_ & 7) * 16) ^ ((rowp_ & 7) << 4); \
    AT_GLDS(kb_ + (unsigned)(row0_ * 4096 + cB0_), AT_KN + (b) * AT_KNB + wid * 1024); AT_GLDS(kb_ + (unsigned)(row1_ * 4096 + cB0_), AT_KN + (b) * AT_KNB + (wid + 8) * 1024); \
    AT_GLDS(pb_ + (unsigned)(rowp_ * 128 + cBp_), AT_KP + (b) * AT_KPB + wid * 1024); } while (0)
#define AT_DMA_V(t, b) do { AT_OPQ(); const char* vb_ = (const char*)KVh + (size_t)(t) * (64 * 4096); \
    const int st_ = 2 * wid + (l_ >> 5), kk_ = (st_ >> 2) * 8 + ((l_ & 31) >> 2), key_ = (kk_ & ~0xC) | ((kk_ & 4) << 1) | ((kk_ & 8) >> 1), col_ = (st_ & 3) * 32 + (l_ & 3) * 8; \
    AT_GLDS(vb_ + (unsigned)(key_ * 4096 + (128 + col_) * 2), AT_V + (b) * AT_VB + wid * 1024); AT_GLDS(vb_ + (unsigned)((key_ + 32) * 4096 + (128 + col_) * 2), AT_V + (b) * AT_VB + (wid + 8) * 1024); } while (0)
#define AT_RESC(a) do { if (__any((a) < 1.f)) { if (hi == 0) al_l[r32] = (a); asm volatile("s_waitcnt lgkmcnt(0)" ::: "memory"); \
    _Pragma("unroll") for (int d = 0; d < 4; ++d) _Pragma("unroll") for (int r = 0; r < 16; ++r) o[d][r] *= al_l[crow(r, hi)]; } } while (0)
#define AT_WAITBAR(N) do { asm volatile("s_waitcnt vmcnt(" #N ") lgkmcnt(0)" ::: "memory"); __builtin_amdgcn_s_barrier(); asm volatile("" ::: "memory"); } while (0)
    f32x16 pA0, pA1, pB0, pB1; float mnA, mnB, alA, alB; bf16x8 pa0, pa1, pa2, pa3; const int NT = nkeys / 64;
    AT_DMA_K(0, 0); AT_DMA_K(1, 1); AT_DMA_V(0, 0); AT_WAITBAR(0);
    int s = 0;
#define AT_S1 (s == 2 ? 0 : s + 1)
#define AT_S2 (s == 0 ? 2 : s - 1)
#define AT_STEP(CUR0, CUR1, MNC, ALC, PRV0, PRV1, ALP, t, MODE) do { \
        if (MODE == 2) { AT_DMA_K((t) + 2, AT_S2); } if (MODE >= 1) { AT_DMA_V((t) + 1, AT_S1); } \
        SBAR(); { AT_KADDR(); at_qkt(CUR0, CUR1, lds + AT_KN + s * AT_KNB, lds + AT_KP + s * AT_KPB, qr, kbs, pbs); } \
        at_finishSM(PRV0, PRV1, ALP, l_reg, pa0, pa1, pa2, pa3); SBAR(); \
        at_pv(o, vb0 + AT_S2 * AT_VB, pa0, pa1, pa2, pa3); at_partialSM(CUR0, CUR1, m_reg, MNC, ALC); \
        AT_RESC(ALC); if (MODE == 2) AT_WAITBAR(5); else if (MODE == 1) AT_WAITBAR(2); else AT_WAITBAR(0); s = AT_S1; } while (0)
    AT_DMA_K(2, 2); AT_DMA_V(1, 1);
    { AT_KADDR(); at_qkt(pA0, pA1, lds + AT_KN, lds + AT_KP, qr, kbs, pbs); } at_partialSM(pA0, pA1, m_reg, mnA, alA);
    AT_WAITBAR(5); s = 1;
    int t = 1;
    for (; t + 4 < NT; t += 2) {
        AT_STEP(pB0, pB1, mnB, alB, pA0, pA1, alA, t, 2);
        AT_STEP(pA0, pA1, mnA, alA, pB0, pB1, alB, t + 1, 2);
    }
    AT_STEP(pB0, pB1, mnB, alB, pA0, pA1, alA, NT - 3, 2);
    AT_STEP(pA0, pA1, mnA, alA, pB0, pB1, alB, NT - 2, 1);
    AT_STEP(pB0, pB1, mnB, alB, pA0, pA1, alA, NT - 1, 0);
    at_finishSM(pB0, pB1, alB, l_reg, pa0, pa1, pa2, pa3); SBAR();
    at_pv(o, vb0 + AT_S2 * AT_VB, pa0, pa1, pa2, pa3);
    if (hi == 0) li_l[r32] = l_reg; asm volatile("s_waitcnt lgkmcnt(0)" ::: "memory");
    float rli[16];
#pragma unroll
    for (int r = 0; r < 16; ++r) rli[r] = __builtin_amdgcn_rcpf(li_l[crow(r, hi)]);
    bf16* Ow = Orow0 + (size_t)(wid * 32) * D;
#pragma unroll
    for (int r = 0; r < 16; r += 2) { const int orow = crow(r, hi);
#pragma unroll
        for (int d0 = 0; d0 < 4; ++d0) { const unsigned w = pk2(o[d0][r] * rli[r], o[d0][r + 1] * rli[r + 1]);
            Ow[(size_t)orow * D + d0 * 32 + r32] = (bf16)w; Ow[(size_t)(orow + 1) * D + d0 * 32 + r32] = (bf16)(w >> 16); } }
#undef AT_GLDS
#undef AT_OPQ
#undef AT_KADDR
#undef AT_DMA_K
#undef AT_DMA_V
#undef AT_RESC
#undef AT_WAITBAR
#undef AT_S1
#undef AT_S2
#undef AT_STEP
}
__device__ __forceinline__ void attn_phase(Frame& F, const Params& P, int li) {
    unsigned char* ws = PWS;
    const bf16* Q = (const bf16*)(ws + WS_Q); const bf16* KV = (const bf16*)(ws + WS_KV); const bf16* KPE = (const bf16*)(ws + WS_KPE);
    bf16* OB = (bf16*)(ws + WS_HB); const float* ROPE = (const float*)(ws + WS_ROPE);
    for (int u = F.vcu; u < 256 + 128; u += F.G) {
        for (int k = 0; k < 2; ++k) {
            int qrow0, kvrow0, nkeys, h, tpos0;
            if (u < 256) { const int id = 2 * u + k, lb = id >> 6, qb = id & 7; h = (id >> 3) & 7; qrow0 = M_CTX + lb * L_LAT + qb * 256; kvrow0 = M_CTX + lb * LKV; nkeys = LKV; tpos0 = qb * 256; }
            else { if (k == 1) break; const int id = u - 256, b = id >> 3; h = id & 7; qrow0 = b * L_CTX; kvrow0 = b * L_CTX; nkeys = L_CTX; tpos0 = -1; }
            __syncthreads();
            attn_unit(F, Q + (size_t)qrow0 * 1536 + h * 192, KV + (size_t)kvrow0 * 2048 + h * 256, KPE + (size_t)kvrow0 * 64, OB + (size_t)qrow0 * D + h * 128, nkeys, ROPE, tpos0);
        }
    }
}

constexpr int N_PHASES = 2 + 2 * 16;
__global__ void __launch_bounds__(NWAVES * 64, 2) hyb_fwd(Params P) {
    extern __shared__ __attribute__((aligned(16))) unsigned char lds_raw[];
    Frame F;
    F.lds = (LAS unsigned char*)lds_raw;
    F.tid = threadIdx.x; F.lane = F.tid & 63; F.wave = __builtin_amdgcn_readfirstlane(F.tid >> 6);
    F.G = gridDim.x; { const int bx = blockIdx.x; F.vcu = (F.G % 8 == 0) ? (bx % 8) * (F.G / 8) + bx / 8 : bx; }
    volatile LAS unsigned* MISC = (volatile LAS unsigned*)(F.lds + LDS_MISC);
    if (F.tid < 64) MISC[F.tid] = 0u;
    if (F.tid < 30) { const unsigned long long v = F.tid < 28 ? (unsigned long long)P.in[F.tid] : (F.tid == 28 ? (unsigned long long)P.out : (unsigned long long)P.ws);
        volatile LAS unsigned* pt = (volatile LAS unsigned*)(F.lds + LDS_PT) + 2 * F.tid; pt[0] = (unsigned)v; pt[1] = (unsigned)(v >> 32); }
    __syncthreads();
    const int use_bar = P.use_bar, ph_hi = P.ph_hi;
    XcdBarrier bar; bar.bar = (unsigned*)(PWS + WS_CTL) + 4096; bar.x = 0; bar.st = nullptr;
    if (use_bar) bar = xcd_barrier_post((unsigned*)(PWS + WS_CTL) + 4096, MISC + 8);

    for (int ph = P.ph_lo; ph < ph_hi; ++ph) {
#define REFRESH_ID() do { int t_ = threadIdx.x; asm volatile("" : "+v"(t_)); F.tid = t_; F.lane = t_ & 63; F.wave = __builtin_amdgcn_readfirstlane(t_ >> 6); \
          int g_ = gridDim.x, b_ = blockIdx.x; asm volatile("" : "+s"(g_), "+s"(b_)); F.G = g_; F.vcu = (g_ % 8 == 0) ? (b_ % 8) * (g_ / 8) + b_ / 8 : b_; F.bid = b_; } while (0)
        REFRESH_ID();
        unsigned char* ws = PWS;
        bf16* XBF = (bf16*)(POUT + OUT_Y);
        bf16* HB = (bf16*)(ws + WS_HB); bf16* YB = (bf16*)(ws + WS_Y); const bf16* SL = (const bf16*)(ws + WS_SLAB);
        const float* MOD = (const float*)(ws + WS_MOD);
        if (ph == 0) { p0_prologue(F, P); }
        else if (ph == 1) {
            const float* m0 = MOD;
            row_pass(F, PIN(I_XP), PIN(I_XS), true, nullptr, nullptr, nullptr, nullptr, nullptr, PIN(I_NMIXPRE), m0 + 1024, m0, HB, false, true);
        } else {
            const int q = ph - 2, pair = q / 16, r = q % 16; const bool odd = r >= 8; const int l = 2 * pair + (odd ? 1 : 0), k = odd ? r - 8 : r;
            const float* ml = MOD + (size_t)l * 9 * 6144;
            const int kind = k < 3 ? (odd ? 10 + k : (k == 2 ? 8 : k)) : (k == 3 ? 2 : k == 4 ? 3 : k == 5 ? 4 : k == 6 ? 5 : 6);
            if (kind == 0) {
                pg8::Gemm g{HB, (const bf16*)(ws + WS_WINE) + (size_t)pair * EVEN_NP * 1024, M, EVEN_NP, 1024}; pg8::StaticOrder S; S.init(M, EVEN_NP, F.G, F.bid, 1024);
                pg8::EpiBf16<0> E{(bf16*)(ws + WS_BIG), EVEN_NP};
                pg8::gemm_phase<pg8::EpiBf16<0>, pg8::StaticOrder, true, true>(F.lds, g, S, E, F.tid);
            } else if (kind == 1) {
                scan_phase(F, P, pair);
            } else if (kind == 8) {
                scan_combine(F, P, pair);
            } else if (kind == 2) {
                const bf16* W = odd ? (const bf16*)(ws + WS_WOUTO) + (size_t)pair * 1024 * 1024 : (const bf16*)(ws + WS_WOUTE) + (size_t)pair * 1024 * 1024;
                { pg8::Gemm g{HB, W, M, 1024, 1024}; pg8::TailSplitOrder S; S.init(F.bid, 1024, 1);
                  pg8::EpiYsplit E{YB, (bf16*)(ws + WS_SLAB)};
                  pg8::gemm_phase<pg8::EpiYsplit, pg8::TailSplitOrder, true, true>(F.lds, g, S, E, F.tid); }
                REFRESH_ID();
                { pg8::Gemm g{HB, W, M, 1024, 1024}; pg8::TailSplitOrder S; S.init(F.bid, 1024, 2);
                  pg8::EpiYsplit E{YB, (bf16*)(PWS + WS_SLAB)};
                  pg8::gemm_phase<pg8::EpiYsplit, pg8::TailSplitOrder, true, true>(F.lds, g, S, E, F.tid); }
            } else if (kind == 3) {
                row_pass(F, PIN(I_XP), PIN(I_XS), l == 0, XBF, YB, SL, PIN(I_NMIXPOST) + l * 1024, ml + 2048, PIN(I_NMLPPRE) + l * 1024, ml + 4096, ml + 3072, HB, true, true);
            } else if (kind == 4) {
                pg8::Gemm g{HB, (const bf16*)(ws + WS_W1) + (size_t)l * 4096 * 1024, M, FF, 1024}; pg8::StaticOrder S; S.init(M, FF, F.G, F.bid, 1024);
                pg8::EpiBf16<1> E{(bf16*)(ws + WS_BIG), FF};
                pg8::gemm_phase<pg8::EpiBf16<1>, pg8::StaticOrder, true, true>(F.lds, g, S, E, F.tid);
            } else if (kind == 5) {
                { pg8::Gemm g{(const bf16*)(ws + WS_BIG), (const bf16*)(ws + WS_W2) + (size_t)l * 1024 * 4096, M, 1024, FF}; pg8::TailSplitOrder S; S.init(F.bid, FF, 1);
                  pg8::EpiYsplit E{YB, (bf16*)(ws + WS_SLAB)};
                  pg8::gemm_phase<pg8::EpiYsplit, pg8::TailSplitOrder, true, true>(F.lds, g, S, E, F.tid); }
                REFRESH_ID();
                { pg8::Gemm g{(const bf16*)(PWS + WS_BIG), (const bf16*)(PWS + WS_W2) + (size_t)l * 1024 * 4096, M, 1024, FF}; pg8::TailSplitOrder S; S.init(F.bid, FF, 2);
                  pg8::EpiYsplit E{(bf16*)(PWS + WS_Y), (bf16*)(PWS + WS_SLAB)};
                  pg8::gemm_phase<pg8::EpiYsplit, pg8::TailSplitOrder, true, true>(F.lds, g, S, E, F.tid); }
            } else if (kind == 6) {
                const float* mn = ml + 9 * 6144;
                if (l < 3) row_pass(F, nullptr, nullptr, false, XBF, YB, SL, PIN(I_NMLPPOST) + l * 1024, ml + 5120, PIN(I_NMIXPRE) + (l + 1) * 1024, mn + 1024, mn, HB, true, true);
                else { bar.bar = (unsigned*)(PWS + WS_CTL) + 4096; row_pass_final(F, bar, XBF, POUT + OUT_Y, YB, SL, PIN(I_NMLPPOST) + l * 1024, ml + 5120); }
            } else if (kind == 10) {
                pg8::Gemm g{HB, (const bf16*)(ws + WS_WINO) + (size_t)pair * ODD_NP * 1024, M, ODD_NP, 1024}; pg8::StaticOrder S; S.init(M, ODD_NP, F.G, F.bid, 1024);
                pg8::EpiOddIn E{(bf16*)(ws + WS_QN), (bf16*)(ws + WS_ACKV), (float*)(ws + WS_Y), POUT + OUT_CKV, POUT + OUT_KPE,
                                PIN(I_QAN) + pair * 256, PIN(I_KVAN) + pair * 256, pair};
                pg8::gemm_phase<pg8::EpiOddIn, pg8::StaticOrder, false, true>(F.lds, g, S, E, F.tid);
                REFRESH_ID(); cache_pass(F, P, pair);
            } else if (kind == 11) {
                kpe_pass(F, P, pair); REFRESH_ID();
                { pg8::Gemm g{(const bf16*)(ws + WS_QN), (const bf16*)(ws + WS_WQB) + (size_t)pair * 1536 * 256, M, 1536, 256}; pg8::StaticOrder S; S.init(M, 1536, F.G, F.bid, 256);
                  pg8::EpiBf16<0> E{(bf16*)(ws + WS_Q), 1536};
                  pg8::gemm_phase<pg8::EpiBf16<0>, pg8::StaticOrder, true, true>(F.lds, g, S, E, F.tid); }
                REFRESH_ID();
                { pg8::Gemm g{(const bf16*)(ws + WS_ACKV), (const bf16*)(ws + WS_WKVB) + (size_t)pair * 2048 * 256, MKV, 2048, 256}; pg8::StaticOrder S; S.init(MKV, 2048, F.G, F.bid, 256);
                  pg8::EpiBf16<0> E{(bf16*)(ws + WS_KV), 2048};
                  pg8::gemm_phase<pg8::EpiBf16<0>, pg8::StaticOrder, true, true>(F.lds, g, S, E, F.tid); }
            } else if (kind == 12) {
                attn_phase(F, P, pair);
            }
        }
        if (ph + 1 < ph_hi) { if (use_bar) { bar.bar = (unsigned*)(PWS + WS_CTL) + 4096; xcd_barrier(bar); } else { VM_WAIT(); __syncthreads(); } }
    }
}

extern "C" void kernel_launch(void* const* d_in, const int* in_sizes, int n_in, void* d_out, int out_size, void* d_ws, size_t ws_size, hipStream_t stream) {
    static int grid = 0;
    if (grid == 0) {
        if (n_in != 28 || out_size != 27787264 || ws_size < WS_END) { fprintf(stderr, "kernel_launch: unexpected shapes: n_in %d out %d ws %zu (need >= %zu)\n", n_in, out_size, ws_size, (size_t)WS_END); grid = -1; return; }
        int dev = 0, cus = 0, per_cu = 0;
        if (hipGetDevice(&dev) != hipSuccess || hipDeviceGetAttribute(&cus, hipDeviceAttributeMultiprocessorCount, dev) != hipSuccess) { grid = -1; return; }
        if (hipFuncSetAttribute((const void*)hyb_fwd, hipFuncAttributeMaxDynamicSharedMemorySize, LDS_BYTES) != hipSuccess) { fprintf(stderr, "kernel_launch: hipFuncSetAttribute failed\n"); grid = -1; return; }
        if (hipOccupancyMaxActiveBlocksPerMultiprocessor(&per_cu, (const void*)hyb_fwd, NWAVES * 64, LDS_BYTES) != hipSuccess || per_cu < 1) { fprintf(stderr, "kernel_launch: occupancy query reports %d\n", per_cu); }
        (void)hipGetLastError();
        grid = cus;
    }
    if (grid < 0) return;
    (void)hipMemsetAsync((char*)d_ws + WS_CTL, 0, CTL_ZERO_BYTES, stream);
    Params a{};
    for (int i = 0; i < 28; ++i) a.in[i] = (const float*)d_in[i];
    a.out = (float*)d_out; a.ws = (unsigned char*)d_ws;
    a.ph_lo = 0; a.ph_hi = N_PHASES; a.use_bar = 1; a.pad = 0;
    hipLaunchKernelGGL(hyb_fwd, dim3(grid), dim3(NWAVES * 64), LDS_BYTES, stream, a);
    const hipError_t le = hipPeekAtLastError();
    if (le != hipSuccess) fprintf(stderr, "kernel_launch: launch failed: %s\n", hipGetErrorName(le));
}
```

```cpp
#include <hip/hip_runtime.h>
#include <hip/hip_bf16.h>
#include <cstdio>
#include <cstdint>
namespace pg8 {
#define PG8_LAS __attribute__((address_space(3)))
typedef unsigned short bf16_t;
typedef short bf16x8 __attribute__((ext_vector_type(8)));
typedef float f32x4 __attribute__((ext_vector_type(4)));
typedef unsigned u32x4 __attribute__((ext_vector_type(4)));
constexpr int BM = 256, BK = 64, HALF = 128, HTB = HALF * BK * 2  , STAGE_BYTES = 8 * HTB, NXCD = 8, WGM = 8;

__host__ __device__ __forceinline__ int lds_byte(int r, int c) { const int st = (r >> 4) * 2 + (c >> 5), rr = r & 15, cc = c & 31, ob = rr * 64 + cc * 2; return st * 1024 + (ob ^ (((ob >> 9) & 1) << 5)); }
__host__ __device__ __forceinline__ void stage_rc(int b, int& R, int& C) { const int st = b / 1024, sb = b % 1024, swz = sb ^ (((sb >> 9) & 1) << 5); R = (st >> 1) * 16 + swz / 64; C = (st & 1) * 32 + (swz % 64) / 2; }
__host__ __device__ __forceinline__ int perm32(int rho) { const int n = rho >> 4, i = rho & 15; return 8 * (i >> 2) + 4 * n + (i & 3); }

struct Unit { int pm, pn, ks, kt0, nt; };
struct Gemm { const bf16_t* A; const bf16_t* Bt; int M, N, K; };

struct StaticOrder {
    int nM, nN, nwg, G, c, ntk;
    __host__ __device__ void init(int M, int N, int G_, int c_, int K) { nM = M / BM; nN = N / BM; nwg = nM * nN; G = G_; c = c_; ntk = K / BK; }
    __host__ __device__ bool next(int i, Unit& u) const {
        const long L = (long)i * G + c; if (L >= nwg) return false;
        int wgid = (int)L; { const int q = nwg / NXCD, r = nwg % NXCD, xcd = wgid % NXCD, off = wgid / NXCD; wgid = (xcd < r ? xcd * (q + 1) : r * (q + 1) + (xcd - r) * q) + off; }
        const int nig = WGM * nN, gid = wgid / nig, fm = gid * WGM, gsz = (nM - fm) < WGM ? (nM - fm) : WGM;
        u.pm = fm + ((wgid % nig) % gsz); u.pn = (wgid % nig) / gsz; u.ks = -1; u.kt0 = 0; u.nt = ntk; return true;
    }
    __device__ __forceinline__ void a_ready(const Unit&) const {}
    __device__ __forceinline__ void done(const Unit&) const {}
};


struct TailSplitOrder {
    int c, ntk, mode;
    __device__ void init(int c_, int K, int mode_) { c = c_; ntk = K / BK; mode = mode_; }
    __device__ bool next(int i, Unit& u) const {
        const int xcd = c & 7, j = c >> 3;
        const int round = mode == 2 ? i + 1 : i;
        if (round == 0) { u.pm = xcd * 8 + (j & 7); u.pn = j >> 3; u.ks = -1; u.kt0 = 0; u.nt = ntk; return true; }
        if (round == 1 && mode != 1) { u.pm = 64 + xcd * 2 + (j & 1); u.pn = (j >> 1) & 3; u.ks = j >> 3; u.nt = ntk >> 2; u.kt0 = u.ks * u.nt; return true; }
        return false;
    }
    __device__ __forceinline__ void a_ready(const Unit&) const {}
    __device__ __forceinline__ void done(const Unit&) const {}
};

typedef float f32x2c_t __attribute__((ext_vector_type(2))); typedef __bf16 bf16x2c_t __attribute__((ext_vector_type(2)));
__device__ __forceinline__ unsigned cvt_pk_bf16(float lo, float hi) { f32x2c_t v = {lo, hi}; bf16x2c_t b = __builtin_convertvector(v, bf16x2c_t); return __builtin_bit_cast(unsigned, b); }

template <int ACT> struct EpiBf16 {
    static constexpr bool PERM = true, AFTER_DRAIN = false;
    bf16_t* O; int ldc;
    __device__ __forceinline__ void operator()(const f32x4 (&acc)[2][2][4][2], const Unit& u, int wr, int wc, int fr, int fq) const {
        const int row0 = u.pm * BM + wr * 64 + fr; const int col0 = u.pn * BM + wc * 32 + 8 * fq;
#pragma unroll
        for (int ai = 0; ai < 2; ++ai)
#pragma unroll
            for (int m = 0; m < 4; ++m) { bf16_t* rowp = O + (size_t)(row0 + ai * HALF + m * 16) * ldc + col0;
#pragma unroll
                for (int bj = 0; bj < 2; ++bj) { f32x4 v0 = acc[ai][bj][m][0], v1 = acc[ai][bj][m][1];
                    if (ACT == 1) {
#pragma unroll
                        for (int j = 0; j < 4; ++j) { const float a = fmaxf(v0[j], 0.f), b = fmaxf(v1[j], 0.f); v0[j] = a * a; v1[j] = b * b; } }
                    u32x4 w; w.x = cvt_pk_bf16(v0[0], v0[1]); w.y = cvt_pk_bf16(v0[2], v0[3]); w.z = cvt_pk_bf16(v1[0], v1[1]); w.w = cvt_pk_bf16(v1[2], v1[3]);
                    *(u32x4*)(rowp + bj * HALF) = w; } }
    }
};
struct EpiYsplit {
    static constexpr bool PERM = true, AFTER_DRAIN = false;
    bf16_t* Y; bf16_t* SL;
    __device__ __forceinline__ void operator()(const f32x4 (&acc)[2][2][4][2], const Unit& u, int wr, int wc, int fr, int fq) const {
        const int row0 = u.pm * BM + wr * 64 + fr; const int col0 = u.pn * BM + wc * 32 + 8 * fq;
        if (u.ks < 0) {
#pragma unroll
            for (int ai = 0; ai < 2; ++ai)
#pragma unroll
                for (int m = 0; m < 4; ++m) { bf16_t* rowp = Y + (size_t)(row0 + ai * HALF + m * 16) * 1024 + col0;
#pragma unroll
                    for (int bj = 0; bj < 2; ++bj) { const f32x4 v0 = acc[ai][bj][m][0], v1 = acc[ai][bj][m][1];
                        u32x4 w; w.x = cvt_pk_bf16(v0[0], v0[1]); w.y = cvt_pk_bf16(v0[2], v0[3]); w.z = cvt_pk_bf16(v1[0], v1[1]); w.w = cvt_pk_bf16(v1[2], v1[3]);
                        *(u32x4*)(rowp + bj * HALF) = w; } }
        } else {
            bf16_t* base = SL + (size_t)u.ks * (4096 * 1024);
#pragma unroll
            for (int ai = 0; ai < 2; ++ai)
#pragma unroll
                for (int m = 0; m < 4; ++m) { bf16_t* rowp = base + (size_t)(row0 - 16384 + ai * HALF + m * 16) * 1024 + col0;
#pragma unroll
                    for (int bj = 0; bj < 2; ++bj) { const f32x4 v0 = acc[ai][bj][m][0], v1 = acc[ai][bj][m][1];
                        u32x4 w; w.x = cvt_pk_bf16(v0[0], v0[1]); w.y = cvt_pk_bf16(v0[2], v0[3]); w.z = cvt_pk_bf16(v1[0], v1[1]); w.w = cvt_pk_bf16(v1[2], v1[3]);
                        *(u32x4*)(rowp + bj * HALF) = w; } }
        }
    }
};
struct EpiOddIn {
    static constexpr bool PERM = false, AFTER_DRAIN = true;
    bf16_t* QN; bf16_t* ACKV; float* KPERAW; float* out_ckv; float* out_kpe; const float* gq; const float* gkv; int li;
    __device__ __forceinline__ void fused(f32x4 (&acc)[2][2][4][2], const Unit& u, int wr, int wc, int fr, int fq, PG8_LAS unsigned char* lds, int wid, int lane) const {
        PG8_LAS float* P = (PG8_LAS float*)lds;
        if (u.pn < 2) {
#pragma unroll
            for (int ai = 0; ai < 2; ++ai)
#pragma unroll
                for (int m = 0; m < 4; ++m) { float s = 0.f;
#pragma unroll
                    for (int bj = 0; bj < 2; ++bj)
#pragma unroll
                        for (int n = 0; n < 2; ++n) { const f32x4 x = acc[ai][bj][m][n]; s += (x[0] * x[0] + x[1] * x[1]) + (x[2] * x[2] + x[3] * x[3]); }
                    s += __shfl_xor(s, 16); s += __shfl_xor(s, 32);
                    if (fq == 0) P[(ai * HALF + wr * 64 + m * 16 + fr) * 4 + wc] = s; }
        }
        asm volatile("s_waitcnt lgkmcnt(0)" ::: "memory"); __builtin_amdgcn_s_barrier(); asm volatile("" ::: "memory");
        if (u.pn < 2) {
            const float* gv = u.pn == 0 ? gq : gkv;
#pragma unroll
            for (int ai = 0; ai < 2; ++ai)
#pragma unroll
                for (int m = 0; m < 4; ++m) { const int r = ai * HALF + wr * 64 + m * 16 + fr; const int grow = u.pm * BM + r;
                    const float tot = (P[r * 4 + 0] + P[r * 4 + 1]) + (P[r * 4 + 2] + P[r * 4 + 3]);
                    const float rstd = 1.0f / sqrtf(tot * (1.0f / 256.0f) + 1e-6f);
                    const int drow = grow < 4096 ? grow : 4096 + ((grow - 4096) >> 11) * 2304 + 256 + ((grow - 4096) & 2047);
#pragma unroll
                    for (int bj = 0; bj < 2; ++bj)
#pragma unroll
                        for (int n = 0; n < 2; ++n) { const int col = bj * HALF + wc * 32 + n * 16 + 4 * fq; const f32x4 g = *(const f32x4*)(gv + col);
                            const f32x4 v = acc[ai][bj][m][n] * rstd * g;
                            unsigned long long w = (unsigned long long)cvt_pk_bf16(v[0], v[1]) | ((unsigned long long)cvt_pk_bf16(v[2], v[3]) << 32);
                            if (u.pn == 0) *(unsigned long long*)(QN + (size_t)grow * 256 + col) = w;
                            else { *(unsigned long long*)(ACKV + (size_t)drow * 256 + col) = w;
                                   if (grow < 4096) *(f32x4*)(out_ckv + ((size_t)((grow >> 8) * 2 + li) * 256 + (grow & 255)) * 256 + col) = v; } } }
        } else if (wc < 2) {
#pragma unroll
            for (int ai = 0; ai < 2; ++ai)
#pragma unroll
                for (int m = 0; m < 4; ++m) { const int r = ai * HALF + wr * 64 + m * 16 + fr; const int grow = u.pm * BM + r;
#pragma unroll
                    for (int n = 0; n < 2; ++n) { const int col = wc * 32 + n * 16 + 4 * fq; const f32x4 v = acc[ai][0][m][n];
                        *(f32x4*)(KPERAW + (size_t)grow * 64 + col) = v;
                        if (grow < 4096) *(f32x4*)(out_kpe + ((size_t)((grow >> 8) * 2 + li) * 256 + (grow & 255)) * 64 + col) = v; } }
        }
    }
};

template <class Epi, class Sched, bool ALIGN_EPI = false, bool SP2 = false>
__device__ __forceinline__ void gemm_phase(PG8_LAS unsigned char* lds, const Gemm g, const Sched& S, const Epi& E, const int tid) {
    const int  wid = __builtin_amdgcn_readfirstlane(tid >> 6), lane = tid & 63, wr = wid >> 2, wc = wid & 3, fr = lane & 15, fq = lane >> 4;
    const int K = g.K;
    unsigned voffA[2], voffB[2];
#pragma unroll
    for (int i = 0; i < 2; ++i) { int R, C; stage_rc(tid * 16 + i * 8192, R, C); const int Rb = Epi::PERM ? ((R & ~31) + perm32(R & 31)) : R;
        voffA[i] = (unsigned)(R * K + C) * 2u; voffB[i] = (unsigned)(Rb * K + C) * 2u; }
    const size_t kstep = (size_t)(BK * 2);
    const size_t hstep = (size_t)HALF * K * 2;
    const size_t tstep = 2 * hstep;
    const unsigned ldsw = (unsigned)wid * 1024u;
    const int aoff = lds_byte(wr * 64 + fr, fq * 8), boff = lds_byte(wc * 32 + fr, fq * 8);
#define PG8_SA(b, h) (((b) * 2 + (h)) * HTB)
#define PG8_SB(b, h) ((4 + (b) * 2 + (h)) * HTB)
#define PG8_STAGE(bufoff, gbase, voff) do { _Pragma("unroll") for (int _i = 0; _i < 2; ++_i) \
        __builtin_amdgcn_global_load_lds((const unsigned*)((const char*)(gbase) + (voff)[_i]), (PG8_LAS unsigned*)(lds + (bufoff) + ldsw + _i * 8192), 16, 0, 0); } while (0)
#define PG8_LDA(dst, b, h) do { _Pragma("unroll") for (int m = 0; m < 4; ++m) _Pragma("unroll") for (int k = 0; k < 2; ++k) dst[m][k] = *(const PG8_LAS bf16x8*)(lds + PG8_SA(b, h) + aoff + m * 2048 + k * 1024); } while (0)
#define PG8_LDB(dst, b, h) do { _Pragma("unroll") for (int n = 0; n < 2; ++n) _Pragma("unroll") for (int k = 0; k < 2; ++k) dst[n][k] = *(const PG8_LAS bf16x8*)(lds + PG8_SB(b, h) + boff + n * 2048 + k * 1024); } while (0)
#define PG8_MMA(ai, bj, At, Bt) do { __builtin_amdgcn_s_setprio(1); _Pragma("unroll") for (int m = 0; m < 4; ++m) _Pragma("unroll") for (int n = 0; n < 2; ++n) _Pragma("unroll") for (int k = 0; k < 2; ++k) \
        acc[ai][bj][m][n] = __builtin_amdgcn_mfma_f32_16x16x32_bf16(Bt[n][k], At[m][k], acc[ai][bj][m][n], 0, 0, 0); __builtin_amdgcn_s_setprio(0); } while (0)
#define PG8_WAIT_V(n) asm volatile("s_waitcnt vmcnt(" #n ")" ::: "memory")
#define PG8_WAIT_L(n) asm volatile("s_waitcnt lgkmcnt(" #n ")" ::: "memory")
#define PG8_BAR __builtin_amdgcn_s_barrier()
#define PG8_SCHED __builtin_amdgcn_sched_barrier(0)
    Unit cur, nxt; int ui = 0;
    if (!S.next(0, cur)) return;
    f32x4 acc[2][2][4][2];
#pragma unroll
    for (int a = 0; a < 2; ++a)
#pragma unroll
        for (int b = 0; b < 2; ++b)
#pragma unroll
            for (int m = 0; m < 4; ++m)
#pragma unroll
                for (int n = 0; n < 2; ++n) acc[a][b][m][n] = (f32x4){0.f, 0.f, 0.f, 0.f};
    bf16x8 At[4][2], B0[2][2], B1[2][2];
    const char* cA = (const char*)g.A + (size_t)cur.pm * tstep + (size_t)cur.kt0 * kstep; const char* cB = (const char*)g.Bt + (size_t)cur.pn * tstep + (size_t)cur.kt0 * kstep;
    S.a_ready(cur);
    if constexpr (SP2) {
        PG8_STAGE(PG8_SB(0, 0), cB, voffB); PG8_STAGE(PG8_SB(0, 1), cB + hstep, voffB); PG8_STAGE(PG8_SA(0, 0), cA, voffA); PG8_STAGE(PG8_SA(0, 1), cA + hstep, voffA);
        if (wr == 1) PG8_BAR;
        PG8_WAIT_V(2); PG8_BAR;
        PG8_STAGE(PG8_SB(1, 0), cB + kstep, voffB); PG8_STAGE(PG8_SA(1, 0), cA + kstep, voffA); PG8_STAGE(PG8_SB(1, 1), cB + hstep + kstep, voffB);
        PG8_WAIT_V(6); PG8_BAR;
    } else {
        PG8_STAGE(PG8_SB(0, 0), cB, voffB); PG8_STAGE(PG8_SA(0, 0), cA, voffA); PG8_STAGE(PG8_SB(0, 1), cB + hstep, voffB); PG8_STAGE(PG8_SA(0, 1), cA + hstep, voffA);
        if (wr == 1) PG8_BAR;
        PG8_WAIT_V(4); PG8_BAR;
        PG8_STAGE(PG8_SB(1, 0), cB + kstep, voffB); PG8_STAGE(PG8_SA(1, 0), cA + kstep, voffA); PG8_STAGE(PG8_SB(1, 1), cB + hstep + kstep, voffB);
        PG8_WAIT_V(6); PG8_BAR;
    }
    for (;;) {
        const bool has_next = S.next(ui + 1, nxt);
        const char* nA = has_next ? (const char*)g.A + (size_t)nxt.pm * tstep + (size_t)nxt.kt0 * kstep : cA; const char* nB = has_next ? (const char*)g.Bt + (size_t)nxt.pn * tstep + (size_t)nxt.kt0 * kstep : cB;
        const int nt = cur.nt;
        for (int t = 0; t < nt; t += 2) {
            const bool last = (t == nt - 2);
            const char* a1 = cA + (size_t)(t + 1) * kstep;
            const char* a2 = last ? nA : cA + (size_t)(t + 2) * kstep; const char* b2 = last ? nB : cB + (size_t)(t + 2) * kstep;
            const char* a3 = a2 + kstep; const char* b3 = b2 + kstep;
            if (last && has_next) S.a_ready(nxt);
            if constexpr (SP2) {
            PG8_LDB(B0, 0, 0); PG8_LDB(B1, 0, 1); PG8_SCHED; PG8_LDA(At, 0, 0); PG8_STAGE(PG8_SA(1, 1), a1 + hstep, voffA);
            PG8_WAIT_V(8); PG8_WAIT_L(0); PG8_BAR; PG8_MMA(0, 0, At, B0); PG8_MMA(0, 1, At, B1); PG8_BAR; PG8_SCHED;
            PG8_LDA(At, 0, 1); PG8_STAGE(PG8_SB(0, 0), b2, voffB); PG8_STAGE(PG8_SB(0, 1), b2 + hstep, voffB); PG8_STAGE(PG8_SA(0, 0), a2, voffA);
            PG8_WAIT_V(8); PG8_WAIT_L(0); PG8_BAR; PG8_MMA(1, 0, At, B0); PG8_MMA(1, 1, At, B1); PG8_BAR; PG8_SCHED;
            PG8_LDB(B0, 1, 0); PG8_LDB(B1, 1, 1); PG8_SCHED; PG8_LDA(At, 1, 0); PG8_STAGE(PG8_SA(0, 1), a2 + hstep, voffA);
            PG8_WAIT_V(8); PG8_WAIT_L(0); PG8_BAR; PG8_MMA(0, 0, At, B0); PG8_MMA(0, 1, At, B1); PG8_BAR; PG8_SCHED;
            PG8_LDA(At, 1, 1); PG8_STAGE(PG8_SB(1, 0), b3, voffB); PG8_STAGE(PG8_SB(1, 1), b3 + hstep, voffB); PG8_STAGE(PG8_SA(1, 0), a3, voffA);
            PG8_WAIT_V(8); PG8_WAIT_L(0); PG8_BAR; PG8_MMA(1, 0, At, B0); PG8_MMA(1, 1, At, B1); PG8_BAR; PG8_SCHED;
            } else {
            PG8_LDB(B0, 0, 0); PG8_SCHED; PG8_LDA(At, 0, 0); PG8_STAGE(PG8_SA(1, 1), a1 + hstep, voffA);
            PG8_WAIT_L(8); PG8_BAR; PG8_WAIT_L(0); PG8_MMA(0, 0, At, B0); PG8_BAR; PG8_SCHED;
            PG8_LDB(B1, 0, 1); PG8_STAGE(PG8_SB(0, 0), b2, voffB);
            PG8_BAR; PG8_WAIT_L(0); PG8_MMA(0, 1, At, B1); PG8_BAR;
            PG8_LDA(At, 0, 1); PG8_STAGE(PG8_SA(0, 0), a2, voffA);
            PG8_BAR; PG8_WAIT_L(0); PG8_MMA(1, 0, At, B0); PG8_BAR; PG8_SCHED;
            PG8_STAGE(PG8_SB(0, 1), b2 + hstep, voffB);
            PG8_WAIT_V(6); PG8_BAR; PG8_MMA(1, 1, At, B1); PG8_BAR;
            PG8_LDB(B0, 1, 0); PG8_SCHED; PG8_LDA(At, 1, 0); PG8_STAGE(PG8_SA(0, 1), a2 + hstep, voffA);
            PG8_WAIT_L(8); PG8_BAR; PG8_WAIT_L(0); PG8_MMA(0, 0, At, B0); PG8_BAR; PG8_SCHED;
            PG8_LDB(B1, 1, 1); PG8_STAGE(PG8_SB(1, 0), b3, voffB);
            PG8_BAR; PG8_WAIT_L(0); PG8_MMA(0, 1, At, B1); PG8_BAR;
            PG8_LDA(At, 1, 1); PG8_STAGE(PG8_SA(1, 0), a3, voffA);
            PG8_BAR; PG8_WAIT_L(0); PG8_MMA(1, 0, At, B0); PG8_BAR; PG8_SCHED;
            PG8_STAGE(PG8_SB(1, 1), b3 + hstep, voffB);
            PG8_WAIT_V(6); PG8_BAR; PG8_MMA(1, 1, At, B1); PG8_BAR;
            }
        }
        if constexpr (ALIGN_EPI) { if (wr == 0) PG8_BAR; }
        if constexpr (!Epi::AFTER_DRAIN) { E(acc, cur, wr, wc, fr, fq); S.done(cur); }
        if (!has_next) break;
#pragma unroll
        for (int a = 0; a < 2; ++a)
#pragma unroll
            for (int b = 0; b < 2; ++b)
#pragma unroll
                for (int m = 0; m < 4; ++m)
#pragma unroll
                    for (int n = 0; n < 2; ++n) acc[a][b][m][n] = (f32x4){0.f, 0.f, 0.f, 0.f};
        cur = nxt; cA = nA; cB = nB; ++ui;
        if constexpr (ALIGN_EPI) { if (wr == 1) PG8_BAR; }
    }
    PG8_WAIT_V(0);
    if constexpr (!ALIGN_EPI) { if (wr == 0) PG8_BAR; }
    PG8_BAR;
    if constexpr (Epi::AFTER_DRAIN) { E.fused(acc, cur, wr, wc, fr, fq, lds, wid, lane); S.done(cur); }
#undef PG8_SA
#undef PG8_SB
#undef PG8_STAGE
#undef PG8_LDA
#undef PG8_LDB
#undef PG8_MMA
#undef PG8_WAIT_V
#undef PG8_WAIT_L
#undef PG8_BAR
#undef PG8_SCHED
}
}

constexpr int NWAVES = 8;
constexpr int D = 1024, FF = 4096, M_CTX = 4096, M_LAT = 16384, M = M_CTX + M_LAT;
constexpr int L_LAT = 2048, L_CTX = 256, PAST = 256, LKV = PAST + L_LAT;
constexpr int MKV = M_CTX + 8 * LKV;
constexpr int EVEN_N = 3104, EVEN_NP = 3328, ODD_N = 576, ODD_NP = 768;
constexpr float EPS = 1e-6f;
constexpr int PC_QA = 0, PC_KA = 256, PC_VA = 512, PC_GA = 1024, PC_QB = 1536, PC_KB = 1792, PC_VB = 2048, PC_GB = 2560, PC_GK = 3072;
constexpr size_t OUT_Y = 0, OUT_CKV = 20971520, OUT_KPE = 23068672, OUT_SGLA = 23592960, OUT_SRET = 25690112;

constexpr size_t MiB = 1u << 20;
constexpr size_t WS_CTL = 0, CTL_ZERO_BYTES = 64 * 1024;
constexpr size_t WS_MOD = 1 * MiB;
constexpr size_t WS_ROPE = 2 * MiB;
constexpr size_t WS_KPE = 3 * MiB;
constexpr size_t WS_ACKV = 6 * MiB;
constexpr size_t WS_WINE = 18 * MiB;
constexpr size_t WS_WOUTE = 31 * MiB;
constexpr size_t WS_WINO = 35 * MiB;
constexpr size_t WS_WQB = 38 * MiB;
constexpr size_t WS_WKVB = 40 * MiB;
constexpr size_t WS_WOUTO = 42 * MiB;
constexpr size_t WS_W1 = 46 * MiB;
constexpr size_t WS_W2 = 78 * MiB;
constexpr size_t WS_HB = 110 * MiB;
constexpr size_t WS_Y = 150 * MiB;
constexpr size_t WS_BIG = 190 * MiB;
constexpr size_t WS_Q = WS_BIG, WS_KV = WS_BIG + 60 * MiB, WS_QN = WS_BIG + 148 * MiB;
constexpr size_t WS_SLAB = 350 * MiB;
constexpr size_t WS_END = 382 * MiB;

constexpr int RING_BYTES = 131072;
constexpr int LDS_MISC = 155648;
constexpr int LDS_BYTES = 163840;

#define GAS __attribute__((address_space(1)))
#define LAS __attribute__((address_space(3)))
typedef unsigned short bf16;
typedef unsigned v4u __attribute__((ext_vector_type(4)));
typedef unsigned v2u __attribute__((ext_vector_type(2)));
typedef float f32x4 __attribute__((ext_vector_type(4)));
typedef float f32x16 __attribute__((ext_vector_type(16)));
typedef short bf16x8 __attribute__((ext_vector_type(8)));
typedef short s16x4 __attribute__((ext_vector_type(4)));
#define LDS_WAIT() asm volatile("s_waitcnt lgkmcnt(0)" ::: "memory")
#define VM_WAIT() asm volatile("s_waitcnt vmcnt(0)" ::: "memory")
typedef float f32x2_t __attribute__((ext_vector_type(2))); typedef __bf16 bf16x2_t __attribute__((ext_vector_type(2)));
__device__ __forceinline__ unsigned pk2(float lo, float hi) { f32x2_t v = {lo, hi}; bf16x2_t b = __builtin_convertvector(v, bf16x2_t); return __builtin_bit_cast(unsigned, b); }
__device__ __forceinline__ unsigned f2bf(float f) { return pk2(f, f) & 0xffffu; }
__device__ __forceinline__ float bflo(unsigned w) { return __builtin_bit_cast(float, w << 16); }
__device__ __forceinline__ float bfhi(unsigned w) { return __builtin_bit_cast(float, w & 0xffff0000u); }
__device__ __forceinline__ float wave_sum(float v) {
#pragma unroll
    for (int o = 1; o < 64; o <<= 1) v += __shfl_xor(v, o);
    return v;
}
__device__ __forceinline__ float siluf(float x) { return x * __builtin_amdgcn_rcpf(1.0f + __expf(-x)); }

#define XB_TMO      128
#define XB_XCNT(j)  (256  + 64 * (j))
#define XB_XSUB(j)  (1280 + 64 * (j))
#define XB_XGEN(j)  (2304 + 64 * (j))
#define XB_TOP      3328
#define XB_TOPGEN   3392
#define XCD_BAR_WORDS 3456
#define XB_SPIN_CAP (1u << 20)
__device__ __forceinline__ unsigned xb_ld(unsigned* p)              { return __hip_atomic_load(p, __ATOMIC_RELAXED, __HIP_MEMORY_SCOPE_AGENT); }
__device__ __forceinline__ unsigned xb_add(unsigned* p, unsigned v) { return __hip_atomic_fetch_add(p, v, __ATOMIC_RELAXED, __HIP_MEMORY_SCOPE_AGENT); }
__device__ __forceinline__ unsigned xb_xcc_id() { return (unsigned)__builtin_amdgcn_s_getreg((3 << 11) | 20) & 0xFu; }
#define XB_SPIN(cond, bar) do { unsigned _sp = 0; while (cond) { __builtin_amdgcn_s_sleep(1); \
    if ((++_sp & 255u) == 0u) { if (xb_ld(&(bar)[XB_TMO])) break; if (_sp > XB_SPIN_CAP) { atomicAdd(&(bar)[XB_TMO], 1u); break; } } } } while (0)
struct XcdBarrier { unsigned* bar; unsigned x; volatile LAS unsigned* st; };
__device__ __forceinline__ XcdBarrier xcd_barrier_post(unsigned* bar, volatile LAS unsigned* st) {
    XcdBarrier b; b.bar = bar; b.x = xb_xcc_id(); b.st = st;
    if (threadIdx.x == 0) (void)xb_add(&bar[XB_XCNT(b.x)], 1u);
    return b;
}
__device__ __forceinline__ void xcd_barrier_complete(unsigned* bar, unsigned x, unsigned& nloc, unsigned& nx) {
    const unsigned G = gridDim.x * gridDim.y * gridDim.z;
    unsigned sum, cnt, mine, sp = 0u;
    for (;;) {
        sum = 0u; cnt = 0u; mine = 0u;
#pragma unroll
        for (unsigned j = 0; j < 16; ++j) { const unsigned c = xb_ld(&bar[XB_XCNT(j)]); sum += c; cnt += (c > 0u) ? 1u : 0u; mine = (j == x) ? c : mine; }
        if (sum == G) break;
        __builtin_amdgcn_s_sleep(1);
        if ((++sp & 255u) == 0u) { if (xb_ld(&bar[XB_TMO])) break; if (sp > XB_SPIN_CAP) { atomicAdd(&bar[XB_TMO], 1u); break; } }
    }
    nloc = mine > 0u ? mine : 1u; nx = cnt > 0u ? cnt : 1u;
}
__device__ __forceinline__ void xcd_barrier(const XcdBarrier& b) {
    asm volatile("s_waitcnt vmcnt(0)" ::: "memory");
    __syncthreads();
    if (threadIdx.x == 0) {
        unsigned* bar = b.bar;
        __builtin_amdgcn_s_waitcnt(0);
        unsigned nloc = b.st[0], nx = b.st[1];
        if (nloc == 0u) { xcd_barrier_complete(bar, b.x, nloc, nx); b.st[0] = nloc; b.st[1] = nx; }
        const unsigned old = xb_add(&bar[XB_XSUB(b.x)], 1u);
        const unsigned gen = old / nloc;
        if (old + 1u == (gen + 1u) * nloc) {
            __builtin_amdgcn_fence(__ATOMIC_RELEASE, "agent");
            asm volatile("s_waitcnt vmcnt(0)" ::: "memory");
            const unsigned og = xb_add(&bar[XB_TOP], 1u);
            const unsigned tg = og / nx;
            if (og + 1u == (tg + 1u) * nx) xb_add(&bar[XB_TOPGEN], 1u);
            else XB_SPIN(xb_ld(&bar[XB_TOPGEN]) == tg, bar);
            __builtin_amdgcn_fence(__ATOMIC_ACQUIRE, "agent");
            xb_add(&bar[XB_XGEN(b.x)], 1u);
            asm volatile("s_waitcnt vmcnt(0)" ::: "memory");
        } else {
            XB_SPIN(xb_ld(&bar[XB_XGEN(b.x)]) == gen, bar);
            __builtin_amdgcn_fence(__ATOMIC_ACQUIRE, "agent");
            asm volatile("s_waitcnt vmcnt(0)" ::: "memory");
        }
    }
    __syncthreads();
}

struct Params { const float* in[28]; float* out; unsigned char* ws; int ph_lo, ph_hi, use_bar, pad; };
enum { I_XP = 0, I_XS, I_CCKV, I_CKPE, I_SGLA, I_SRET, I_C, I_CCTX, I_WADA, I_BADA, I_NMIXPRE, I_NMIXPOST, I_NMLPPRE, I_NMLPPOST,
       I_WINE, I_WGK2, I_BGK2, I_GLAN, I_RDEC, I_WOUTE, I_WINO, I_QAN, I_WQB, I_KVAN, I_WKVB, I_WOUTO, I_W1, I_W2 };
struct Frame { LAS unsigned char* lds; int tid, lane, wave, vcu, G, bid; };
constexpr int LDS_PT = LDS_MISC + 256;
__device__ __forceinline__ const void* ldp(LAS unsigned char* lds, int i) {
    const volatile LAS unsigned* p = (const volatile LAS unsigned*)(lds + LDS_PT) + 2 * i;
    const unsigned lo = __builtin_amdgcn_readfirstlane(p[0]), hi = __builtin_amdgcn_readfirstlane(p[1]);
    return (const void*)(const GAS void*)(((unsigned long long)hi << 32) | lo);
}
#define PIN(i) ((const float*)ldp(F.lds, (i)))
#define POUT ((float*)ldp(F.lds, 28))
#define PWS ((unsigned char*)ldp(F.lds, 29))

__device__ __forceinline__ void p0_transpose_item(const float* W, int K, int N, bf16* WT, int kb, int n0, int dn0, LAS float* scr, int lane) {
    const int k0 = 64 * kb;
    f32x4 wv[8];
#pragma unroll
    for (int i = 0; i < 8; ++i) wv[i] = __builtin_nontemporal_load((const f32x4*)(W + (size_t)(k0 + 8 * i + (lane >> 3)) * N + n0 + 4 * (lane & 7)));
#pragma unroll
    for (int i = 0; i < 8; ++i) { LAS float* d = scr + (8 * i + (lane >> 3)) * 33 + 4 * (lane & 7); d[0] = wv[i][0]; d[1] = wv[i][1]; d[2] = wv[i][2]; d[3] = wv[i][3]; }
    LDS_WAIT(); asm volatile("" ::: "memory");
    const int c = lane & 7;
#pragma unroll
    for (int j = 0; j < 4; ++j) { const int n = (lane >> 3) + 8 * j; const LAS float* s = scr + (8 * c) * 33 + n;
        v4u o; o.x = pk2(s[0 * 33], s[1 * 33]); o.y = pk2(s[2 * 33], s[3 * 33]); o.z = pk2(s[4 * 33], s[5 * 33]); o.w = pk2(s[6 * 33], s[7 * 33]);
        *(GAS v4u*)(WT + (size_t)(dn0 + n) * K + k0 + 8 * c) = o; }
    LDS_WAIT(); asm volatile("" ::: "memory");
}
__device__ __forceinline__ int even_col_map(int n0) { return n0 < 1536 ? n0 : (n0 < 1568 ? 3072 + (n0 - 1536) : n0 - 32); }

__device__ __forceinline__ void setup_work(Frame& F, const Params& P, int wgi, int nwg, int amask  , int mmask  , int eimask  , int eomask  , int omask  ) {
    unsigned char* ws = PWS;
    LAS float* scr = (LAS float*)(F.lds + F.wave * 16384);
    __syncthreads();
    {
        LAS float* S = (LAS float*)(F.lds);
        LAS float* R = (LAS float*)(F.lds + 40960);
        { const float* cp_ = PIN(I_C); const float* cc_ = PIN(I_CCTX);
          for (int i = F.tid; i < 9 * 1024; i += 512) { const int n = i >> 10, d = i & 1023; const float cv = n < 8 ? cp_[n * 1024 + d] : cc_[d]; S[i] = siluf(cv); } }
        const float* wada_ = PIN(I_WADA); const float* bada_ = PIN(I_BADA);
        __syncthreads();
        const int nl = __builtin_popcount(amask);
        for (int uu = wgi; uu < nl * 64; uu += nwg) {
            int li_ = uu >> 6, l = 0; { int m_ = amask; for (int k_ = 0; k_ < 4; ++k_) { if (m_ & 1) { if (li_ == 0) { l = k_; break; } --li_; } m_ >>= 1; } }
            const int cb = (uu & 63) * 96;
            if (F.tid < 384) {
                const int c4 = (F.tid % 24) * 4, part = F.tid / 24;
                const float* Wp = wada_ + ((size_t)l * 1024 + part * 64) * 6144 + cb + c4;
                f32x4 a[9];
#pragma unroll
                for (int n = 0; n < 9; ++n) a[n] = (f32x4){0.f, 0.f, 0.f, 0.f};
#pragma unroll 4
                for (int d = 0; d < 64; ++d) { const f32x4 w = __builtin_nontemporal_load((const f32x4*)(Wp + (size_t)d * 6144));
#pragma unroll
                    for (int n = 0; n < 9; ++n) a[n] += w * S[n * 1024 + part * 64 + d]; }
#pragma unroll
                for (int n = 0; n < 9; ++n) *(LAS f32x4*)(R + (part * 9 + n) * 96 + c4) = a[n];
            }
            __syncthreads();
            for (int i = F.tid; i < 9 * 96; i += 512) { const int n = i / 96, c = i % 96; float s = 0.f;
#pragma unroll
                for (int p = 0; p < 16; ++p) s += R[(p * 9 + n) * 96 + c];
                ((float*)(ws + WS_MOD))[((size_t)l * 9 + n) * 6144 + cb + c] = s + bada_[l * 6144 + cb + c]; }
            __syncthreads();
        }
    }
    {
        const int wk = wgi * NWAVES + F.wave, NW = nwg * NWAVES; int base = 0;
#define SEG(sel, count, ...) do { if (sel) { for (int q = (wk + NW - base % NW) % NW; q < (count); q += NW) { __VA_ARGS__; } base += (count); } } while (0)
        const int I_E = (1024 / 64) * (EVEN_N / 32), I_OE = 16 * 32, I_O = 16 * (ODD_N / 32), I_QB = 4 * 48, I_KVB = 4 * 64, I_M1 = 16 * 128, I_M2 = 64 * 32;
#pragma unroll
        for (int l = 0; l < 2; ++l) {
            SEG((eimask >> l) & 1, I_E, { const int nb = EVEN_N / 32, kb = q / nb, n0 = (q % nb) * 32;
                p0_transpose_item(PIN(I_WINE) + (size_t)l * 1024 * EVEN_N, 1024, EVEN_N, (bf16*)(ws + WS_WINE) + (size_t)l * EVEN_NP * 1024, kb, n0, even_col_map(n0), scr, F.lane); });
            SEG((eomask >> l) & 1, I_OE, { const int kb = q / 32, n0 = (q % 32) * 32;
                p0_transpose_item(PIN(I_WOUTE) + (size_t)l * 1024 * 1024, 1024, 1024, (bf16*)(ws + WS_WOUTE) + (size_t)l * 1024 * 1024, kb, n0, n0, scr, F.lane); });
            SEG((omask >> l) & 1, I_O, { const int nb = ODD_N / 32, kb = q / nb, n0 = (q % nb) * 32;
                p0_transpose_item(PIN(I_WINO) + (size_t)l * 1024 * ODD_N, 1024, ODD_N, (bf16*)(ws + WS_WINO) + (size_t)l * ODD_NP * 1024, kb, n0, n0, scr, F.lane); });
            SEG((omask >> l) & 1, I_QB, { const int kb = q / 48, n0 = (q % 48) * 32;
                p0_transpose_item(PIN(I_WQB) + (size_t)l * 256 * 1536, 256, 1536, (bf16*)(ws + WS_WQB) + (size_t)l * 1536 * 256, kb, n0, n0, scr, F.lane); });
            SEG((omask >> l) & 1, I_KVB, { const int kb = q / 64, n0 = (q % 64) * 32;
                p0_transpose_item(PIN(I_WKVB) + (size_t)l * 256 * 2048, 256, 2048, (bf16*)(ws + WS_WKVB) + (size_t)l * 2048 * 256, kb, n0, n0, scr, F.lane); });
            SEG((omask >> l) & 1, I_OE, { const int kb = q / 32, n0 = (q % 32) * 32;
                p0_transpose_item(PIN(I_WOUTO) + (size_t)l * 1024 * 1024, 1024, 1024, (bf16*)(ws + WS_WOUTO) + (size_t)l * 1024 * 1024, kb, n0, n0, scr, F.lane); });
        }
#pragma unroll
        for (int l = 0; l < 4; ++l) {
            SEG((mmask >> l) & 1, I_M1, { const int kb = q / 128, n0 = (q % 128) * 32;
                p0_transpose_item(PIN(I_W1) + (size_t)l * 1024 * 4096, 1024, 4096, (bf16*)(ws + WS_W1) + (size_t)l * 4096 * 1024, kb, n0, n0, scr, F.lane); });
            SEG((mmask >> l) & 1, I_M2, { const int kb = q / 32, n0 = (q % 32) * 32;
                p0_transpose_item(PIN(I_W2) + (size_t)l * 4096 * 1024, 4096, 1024, (bf16*)(ws + WS_W2) + (size_t)l * 1024 * 4096, kb, n0, n0, scr, F.lane); });
        }
#undef SEG
    }
    const int gt = wgi * 512 + F.tid, NGT = nwg * 512;
#pragma unroll
    for (int l = 0; l < 2; ++l) {
        if ((eimask >> l) & 1) for (int i = gt; i < 224 * 128; i += NGT) *(GAS v4u*)((bf16*)(ws + WS_WINE) + ((size_t)l * EVEN_NP + EVEN_N) * 1024 + (size_t)i * 8) = (v4u){0u, 0u, 0u, 0u};
        if ((omask >> l) & 1) for (int i = gt; i < 192 * 128; i += NGT) *(GAS v4u*)((bf16*)(ws + WS_WINO) + ((size_t)l * ODD_NP + ODD_N) * 1024 + (size_t)i * 8) = (v4u){0u, 0u, 0u, 0u};
    }
}
__device__ __forceinline__ void p0_prologue(Frame& F, const Params& P) {
    unsigned char* ws = PWS;
    setup_work(F, P, F.vcu, F.G, 0x5, 0x5, 0x3, 0x3, 0x0);
    const int gt = F.vcu * 512 + F.tid, NGT = F.G * 512;
    for (int i = gt; i < 2048 * 32; i += NGT) { const int t = i >> 5, j = i & 31; const float inv = powf(10000.0f, -(float)(j & 15) / 16.0f);
        const float ang = (float)(j < 16 ? (t >> 6) : (t & 63)) * inv;
        ((float*)(ws + WS_ROPE))[i] = cosf(ang); ((float*)(ws + WS_ROPE))[65536 + i] = sinf(ang); }
}

__device__ __forceinline__ void row_y(f32x4 (&yv)[4], const bf16* Y, const bf16* SL, int row, int l4) {
    if (row < 16384) {
#pragma unroll
        for (int j = 0; j < 4; ++j) { const v2u yw = __builtin_nontemporal_load((const v2u*)(Y + (size_t)row * D + l4 + 256 * j)); yv[j] = (f32x4){bflo(yw.x), bfhi(yw.x), bflo(yw.y), bfhi(yw.y)}; }
    } else {
        const bf16* sp = SL + (size_t)(row - 16384) * D + l4;
#pragma unroll
        for (int j = 0; j < 4; ++j) { const v2u w0 = __builtin_nontemporal_load((const v2u*)(sp + 256 * j)), w1 = __builtin_nontemporal_load((const v2u*)(sp + 4194304 + 256 * j)), w2 = __builtin_nontemporal_load((const v2u*)(sp + 2 * 4194304 + 256 * j)), w3 = __builtin_nontemporal_load((const v2u*)(sp + 3 * 4194304 + 256 * j));
            yv[j] = ((f32x4){bflo(w0.x), bfhi(w0.x), bflo(w0.y), bfhi(w0.y)} + (f32x4){bflo(w1.x), bfhi(w1.x), bflo(w1.y), bfhi(w1.y)}) +
                    ((f32x4){bflo(w2.x), bfhi(w2.x), bflo(w2.y), bfhi(w2.y)} + (f32x4){bflo(w3.x), bfhi(w3.x), bflo(w3.y), bfhi(w3.y)}); }
    }
}
struct RowVec { f32x4 gp[4], gt[4], gq[4], sc[4], sh[4]; };
__device__ __forceinline__ void row_post(f32x4 (&v)[4], const f32x4 (&yv)[4], const RowVec& R) {
    float s = 0.f;
#pragma unroll
    for (int j = 0; j < 4; ++j) s += (yv[j][0] * yv[j][0] + yv[j][1] * yv[j][1]) + (yv[j][2] * yv[j][2] + yv[j][3] * yv[j][3]);
    const float rstd = __builtin_amdgcn_rsqf(wave_sum(s) * (1.0f / 1024.0f) + EPS);
#pragma unroll
    for (int j = 0; j < 4; ++j) v[j] = v[j] + R.gt[j] * ((yv[j] * rstd) * R.gp[j]);
}
__device__ __forceinline__ void row_pass(Frame& F, const float* xa, const float* xb, bool xin_f32, bf16* XB, const bf16* Y, const bf16* SL, const float* g_post, const float* gate,
                                         const float* g_pre, const float* scale, const float* shift, bf16* H, bool has_post, bool has_pre) {
    const int gw = F.vcu * NWAVES + F.wave, NGW = F.G * NWAVES, l4 = F.lane * 4;
    RowVec R; int ncur = -1;
#pragma unroll
    for (int j = 0; j < 4; ++j) { R.gp[j] = has_post ? *(const f32x4*)(g_post + l4 + 256 * j) : (f32x4){0.f, 0.f, 0.f, 0.f}; R.gq[j] = has_pre ? *(const f32x4*)(g_pre + l4 + 256 * j) : (f32x4){0.f, 0.f, 0.f, 0.f};
        R.gt[j] = R.gp[j]; R.sc[j] = R.gp[j]; R.sh[j] = R.gp[j]; }
    for (int blk = gw; blk * 10 < M; blk += NGW) for (int i = 0; i < 10; i += 2) {
        const int row0 = blk * 10 + i; if (row0 >= M) break;
        const int n = row0 < M_CTX ? 8 : ((row0 - M_CTX) >> 11);
        if (n != ncur) { ncur = n;
#pragma unroll
            for (int j = 0; j < 4; ++j) { const int c = l4 + 256 * j;
                if (has_post) R.gt[j] = *(const f32x4*)(gate + (size_t)n * 6144 + c);
                if (has_pre) { R.sc[j] = *(const f32x4*)(scale + (size_t)n * 6144 + c); R.sh[j] = *(const f32x4*)(shift + (size_t)n * 6144 + c); } } }
        f32x4 v[2][4], yv[2][4];
#pragma unroll
        for (int q = 0; q < 2; ++q) { const int row = row0 + q;
            if (xin_f32) { const float* xr = row < M_CTX ? xa + (size_t)row * D : xb + (size_t)(row - M_CTX) * D;
#pragma unroll
                for (int j = 0; j < 4; ++j) v[q][j] = __builtin_nontemporal_load((const f32x4*)(xr + l4 + 256 * j));
            } else {
#pragma unroll
                for (int j = 0; j < 4; ++j) { const v2u xw = __builtin_nontemporal_load((const v2u*)(XB + (size_t)row * D + l4 + 256 * j)); v[q][j] = (f32x4){bflo(xw.x), bfhi(xw.x), bflo(xw.y), bfhi(xw.y)}; }
            }
            if (has_post) row_y(yv[q], Y, SL, row, l4); }
#pragma unroll
        for (int q = 0; q < 2; ++q) { const int row = row0 + q;
            if (has_post) {
                row_post(v[q], yv[q], R);
#pragma unroll
                for (int j = 0; j < 4; ++j) *(v2u*)(XB + (size_t)row * D + l4 + 256 * j) = (v2u){pk2(v[q][j][0], v[q][j][1]), pk2(v[q][j][2], v[q][j][3])};
            }
            if (has_pre) {
                float s = 0.f;
#pragma unroll
                for (int j = 0; j < 4; ++j) s += (v[q][j][0] * v[q][j][0] + v[q][j][1] * v[q][j][1]) + (v[q][j][2] * v[q][j][2] + v[q][j][3] * v[q][j][3]);
                const float rstd = __builtin_amdgcn_rsqf(wave_sum(s) * (1.0f / 1024.0f) + EPS);
#pragma unroll
                for (int j = 0; j < 4; ++j) { const f32x4 h = ((v[q][j] * rstd) * R.gq[j]) * (1.0f + R.sc[j]) + R.sh[j];
                    *(v2u*)(H + (size_t)row * D + l4 + 256 * j) = (v2u){pk2(h[0], h[1]), pk2(h[2], h[3])}; }
            } }
    }
}
__device__ __forceinline__ void row_pass_final(Frame& F, const XcdBarrier& bar, const bf16* XB, float* OUT, const bf16* Y, const bf16* SL, const float* g_post, const float* gate) {
    const int gw = F.vcu * NWAVES + F.wave, l4 = F.lane * 4;
    v2u xw[10][4];
#pragma unroll
    for (int i = 0; i < 10; ++i) { const int row = gw * 10 + i;
        if (row < M) {
#pragma unroll
            for (int j = 0; j < 4; ++j) xw[i][j] = __builtin_nontemporal_load((const v2u*)(XB + (size_t)row * D + l4 + 256 * j));
        } }
    xcd_barrier(bar);
    RowVec R; int ncur = -1;
#pragma unroll
    for (int j = 0; j < 4; ++j) { R.gp[j] = *(const f32x4*)(g_post + l4 + 256 * j); R.gt[j] = R.gp[j]; }
#pragma unroll
    for (int i = 0; i < 10; ++i) { const int row = gw * 10 + i;
        if (row < M) {
            const int n = row < M_CTX ? 8 : ((row - M_CTX) >> 11);
            if (n != ncur) { ncur = n;
#pragma unroll
                for (int j = 0; j < 4; ++j) R.gt[j] = *(const f32x4*)(gate + (size_t)n * 6144 + l4 + 256 * j); }
            f32x4 v[4], yv[4];
#pragma unroll
            for (int j = 0; j < 4; ++j) v[j] = (f32x4){bflo(xw[i][j].x), bfhi(xw[i][j].x), bflo(xw[i][j].y), bfhi(xw[i][j].y)};
            row_y(yv, Y, SL, row, l4); row_post(v, yv, R);
#pragma unroll
            for (int j = 0; j < 4; ++j) *(f32x4*)(OUT + (size_t)row * D + l4 + 256 * j) = v[j];
        } }
}

__device__ __forceinline__ int crow(int r, int hi) { return (r & 3) + 8 * (r >> 2) + 4 * hi; }
__device__ __forceinline__ unsigned cvtpk(float lo, float hi) { return pk2(lo, hi); }
#define SBAR() __builtin_amdgcn_sched_barrier(0)
__device__ __forceinline__ int vst_row(int k, int NB) { const int kk = (k & ~0xC) | ((k & 4) << 1) | ((k & 8) >> 1); return (kk >> 3) * NB * 512 + (kk & 7) * 64; }
__device__ __forceinline__ int vst(int k, int c, int NB) { return vst_row(k, NB) + (c >> 5) * 512 + (c & 31) * 2; }
__device__ __forceinline__ int v_rd_base(int lane) { return ((lane & 3) << 3) | (((lane >> 2) & 3) << 6) | (((lane >> 4) & 1) << 5) | (((lane >> 5) & 1) << 8); }
template <int OFF> __device__ __forceinline__ s16x4 tr_read(unsigned vb) { s16x4 r; asm volatile("ds_read_b64_tr_b16 %0, %1 offset:%2" : "=&v"(r) : "v"(vb), "i"(OFF) : "memory"); return r; }
#define PKF(L, H) ((bf16x8){L[0], L[1], L[2], L[3], H[0], H[1], H[2], H[3]})
#define PK4(P, BASE, OUT) do { unsigned a0_ = cvtpk(P[BASE + 0], P[BASE + 1]), a1_ = cvtpk(P[BASE + 2], P[BASE + 3]);   \
    unsigned b0_ = cvtpk(P[BASE + 4], P[BASE + 5]), b1_ = cvtpk(P[BASE + 6], P[BASE + 7]);                              \
    auto r0_ = __builtin_amdgcn_permlane32_swap(a0_, b0_, false, false); auto r1_ = __builtin_amdgcn_permlane32_swap(a1_, b1_, false, false); \
    v4u w_ = {r0_[0], r1_[0], r0_[1], r1_[1]}; OUT = __builtin_bit_cast(bf16x8, w_); } while (0)
__device__ __forceinline__ float fexp(float x) { return __builtin_amdgcn_exp2f(x * 1.4426950408889634f); }
__device__ __forceinline__ float logsig(float x) { return fminf(x, 0.f) - 0.6931471805599453f * __builtin_amdgcn_logf(1.0f + __builtin_amdgcn_exp2f(-1.4426950408889634f * fabsf(x))); }

constexpr int SC_T = 0  , SC_TSZ = 32768, SC_QD = 0, SC_KI = 8192, SC_VT = 16384, SC_ST = 65536, SC_BT = 81920  , SC_TOT = 114688, SC_DL = 115200  ;
__device__ __forceinline__ void scan_phase(Frame& F, const Params& P, int li) {
    unsigned char* ws = PWS;
    const bf16* PROJ = (const bf16*)(ws + WS_BIG);
    const float* ROPE = (const float*)(ws + WS_ROPE);
    LAS unsigned char* G = F.lds;
    const unsigned gaddr = (unsigned)(uintptr_t)G;
    const bool isP = F.wave >= 4; const int gw4 = F.wave & 3;
    const int ri = gw4 >> 1, dh = gw4 & 1;
#define SC_BAR() do { asm volatile("s_waitcnt lgkmcnt(0)" ::: "memory"); __builtin_amdgcn_s_barrier(); asm volatile("" ::: "memory"); } while (0)
#define SC_TOK(c, i) (dir == 0 ? 64 * (c) + (i) : L - 1 - (64 * (c) + (i)))
    for (int u0 = F.bid; u0 < 256; u0 += F.G) for (int kk_ = 0; kk_ < (u0 < 128 ? 1 : 2); ++kk_) {
        __syncthreads();
        const bool lat = u0 < 128; const int u = lat ? u0 : 2 * (u0 - 128) + kk_;
        const int sb = u >> 4, hh = (u >> 1) & 7, dir = u & 1;
        const int L = lat ? L_LAT : L_CTX, row0 = lat ? M_CTX + sb * L_LAT : sb * L_CTX, NC = L / 64;
        const bool gla = hh < 4; const int h = hh & 3;
        const int qc = (gla ? PC_QA : PC_QB) + h * 64, kc = (gla ? PC_KA : PC_KB) + h * 64, vc = (gla ? PC_VA : PC_VB) + h * 128, gkc = PC_GK + dir * 16;
        bf16* OUT = (bf16*)(ws + (dir == 0 ? WS_Y : WS_HB));
        const float* rdec_p = PIN(I_RDEC); const float* wgk2_p = PIN(I_WGK2); const float* bgk2_p = PIN(I_BGK2);
        const float lgr = gla ? 0.f : -fexp(rdec_p[(li * 2 + dir) * 4 + h]);
        f32x16 sacc[2]; sacc[0] = f32x16{}; sacc[1] = f32x16{}; v4u w2f = {0u, 0u, 0u, 0u}; float gbias = 0.f;
        { int t0_ = F.tid; asm volatile("" : "+v"(t0_)); const int lane = t0_ & 63, r32 = lane & 31, hi = lane >> 5;
          if (isP) {
              if (gla) { const int kcol = h * 64 + 32 * (gw4 & 1) + r32; const float* wp_ = wgk2_p + ((size_t)(li * 2 + dir) * 16 + 8 * hi) * 256 + kcol;
                  w2f = (v4u){pk2(wp_[0], wp_[256]), pk2(wp_[512], wp_[768]), pk2(wp_[1024], wp_[1280]), pk2(wp_[1536], wp_[1792])};
                  gbias = bgk2_p[(li * 2 + dir) * 256 + kcol]; }
              else if (t0_ < 256 + 192) ((LAS float*)(G + SC_DL))[t0_ - 256] = fexp(64.0f * lgr);
          } else {
              const float* S0 = (gla ? PIN(I_SGLA) : PIN(I_SRET)) + ((size_t)((sb * 2 + li) * 2 + dir) * 4 + h) * 8192;
              if (lat) {
#pragma unroll
                  for (int d = 0; d < 2; ++d)
#pragma unroll
                      for (int r = 0; r < 16; ++r) sacc[d][r] = S0[(32 * ri + crow(r, hi)) * 128 + 32 * (2 * dh + d) + r32];
              }
#pragma unroll
              for (int d = 0; d < 2; ++d)
#pragma unroll
                  for (int r = 0; r < 16; r += 2) { const unsigned w = pk2(sacc[d][r], sacc[d][r + 1]);
                      LAS unsigned char* sp_ = G + SC_ST + (hi + 4 * ri) * 2048 + (2 * dh + d) * 512 + r32 * 2 + ((r >> 3) & 1) * 4096 + ((r & 3) + 4 * ((r >> 2) & 1)) * 64;
                      *(LAS unsigned short*)sp_ = (unsigned short)w; *(LAS unsigned short*)(sp_ + 64) = (unsigned short)(w >> 16); }
          } }
        v4u pq0 = {}, pq1 = {}, pk0 = {}, pk1 = {}, pv[4] = {}; v4u pga = {0u, 0u, 0u, 0u}; float cs[16] = {}; float tsum = 0.f;
#define SC_LOADRAW(c) do { const unsigned ro_ = (unsigned)(row0 + SC_TOK(c, sti)) * (unsigned)(EVEN_NP * 2); const char* pc_ = (const char*)PROJ; \
        pq0 = *(const v4u*)(pc_ + (ro_ + (unsigned)(qc + 8 * c8) * 2u)); pq1 = *(const v4u*)(pc_ + (ro_ + (unsigned)(qc + 32 + 8 * c8) * 2u)); \
        pk0 = *(const v4u*)(pc_ + (ro_ + (unsigned)(kc + 8 * c8) * 2u)); pk1 = *(const v4u*)(pc_ + (ro_ + (unsigned)(kc + 32 + 8 * c8) * 2u)); \
        _Pragma("unroll") for (int m_ = 0; m_ < 4; ++m_) pv[m_] = *(const v4u*)(pc_ + (ro_ + (unsigned)(vc + c8 * 32 + 8 * m_) * 2u)); } while (0)
#define SC_LOADGK(c) do { pga = *(const v4u*)((const char*)PROJ + ((unsigned)(row0 + SC_TOK(c, 32 * (gw4 >> 1) + r32)) * (unsigned)(EVEN_NP * 2) + (unsigned)(gkc + 8 * hi) * 2u)); } while (0)
        if (isP && gla) { int t0_ = F.tid; asm volatile("" : "+v"(t0_)); const int r32 = t0_ & 31, hi = (t0_ >> 5) & 1; SC_LOADGK(0); }
        for (int s = -3; s < NC; ++s) {
            int tid_o = F.tid; asm volatile("" : "+v"(tid_o));
            const int lane = tid_o & 63, r32 = lane & 31, hi = lane >> 5, tgp = tid_o & 255, sti = tgp >> 2, c8 = tgp & 3;
            if (isP) {
                if (gla && s + 2 >= 0 && s + 2 < NC) {
                    const int th = gw4 >> 1, kq = 32 * (gw4 & 1) + r32; LAS float* BTw = (LAS float*)(G + SC_BT + ((s + 2) & 1) * 16384);
                    const float t0v = ((LAS float*)(G + SC_TOT))[kq]; const float pre = th ? t0v : 0.f;
#pragma unroll
                    for (int r = 0; r < 16; ++r) BTw[(32 * th + crow(r, hi)) * 64 + kq] = pre + cs[r];
                    if (th == 1 && hi == 0) ((LAS float*)(G + SC_DL))[((s + 2) % 3) * 64 + kq] = fexp(pre + tsum);
                }
                if (s + 1 >= 0 && s + 1 < NC) {
                    LAS unsigned char* T = G + SC_T + ((s + 1) & 1) * SC_TSZ;
                    float q[16], kk[16];
#define UNPK(dst, o, W_) do { const v4u w_ = (W_); dst[o + 0] = bflo(w_[0]); dst[o + 1] = bfhi(w_[0]); dst[o + 2] = bflo(w_[1]); dst[o + 3] = bfhi(w_[1]); dst[o + 4] = bflo(w_[2]); dst[o + 5] = bfhi(w_[2]); dst[o + 6] = bflo(w_[3]); dst[o + 7] = bfhi(w_[3]); } while (0)
                    UNPK(q, 0, pq0); UNPK(q, 8, pq1); UNPK(kk, 0, pk0); UNPK(kk, 8, pk1);
                    if (gla) {
                        const LAS float* BTr = (const LAS float*)(G + SC_BT + ((s + 1) & 1) * 16384) + sti * 64 + 8 * c8;
                        const f32x4 x0 = *(const LAS f32x4*)BTr, x1 = *(const LAS f32x4*)(BTr + 4), x2 = *(const LAS f32x4*)(BTr + 32), x3 = *(const LAS f32x4*)(BTr + 36);
#pragma unroll
                        for (int e = 0; e < 4; ++e) { const float e0 = fexp(x0[e]), e1 = fexp(x1[e]), e2 = fexp(x2[e]), e3 = fexp(x3[e]);
                            q[e] *= 0.125f * e0; kk[e] *= __builtin_amdgcn_rcpf(e0); q[4 + e] *= 0.125f * e1; kk[4 + e] *= __builtin_amdgcn_rcpf(e1);
                            q[8 + e] *= 0.125f * e2; kk[8 + e] *= __builtin_amdgcn_rcpf(e2); q[12 + e] *= 0.125f * e3; kk[12 + e] *= __builtin_amdgcn_rcpf(e3); }
                    } else {
                        if (lat) {
                            const float* cp = ROPE + (size_t)SC_TOK(s + 1, sti) * 32 + 8 * c8; const f32x4 c0 = *(const f32x4*)cp, c1 = *(const f32x4*)(cp + 4), s0 = *(const f32x4*)(cp + 65536), s1 = *(const f32x4*)(cp + 65540);
#pragma unroll
                            for (int e = 0; e < 8; ++e) { const float c = e < 4 ? c0[e & 3] : c1[e & 3], sn = e < 4 ? s0[e & 3] : s1[e & 3];
                                const float q1 = q[e], q2 = q[8 + e]; q[e] = q1 * c - q2 * sn; q[8 + e] = q1 * sn + q2 * c;
                                const float k1 = kk[e], k2 = kk[8 + e]; kk[e] = k1 * c - k2 * sn; kk[8 + e] = k1 * sn + k2 * c; }
                        }
                        const float bb = (float)(sti + 1) * lgr, eb = fexp(bb), ek = 0.125f * __builtin_amdgcn_rcpf(eb);
#pragma unroll
                        for (int e = 0; e < 16; ++e) { q[e] *= eb; kk[e] *= ek; }
                    }
                    *(LAS v4u*)(T + SC_QD + vst(sti, 8 * c8, 2)) = (v4u){pk2(q[0], q[1]), pk2(q[2], q[3]), pk2(q[4], q[5]), pk2(q[6], q[7])};
                    *(LAS v4u*)(T + SC_QD + vst(sti, 32 + 8 * c8, 2)) = (v4u){pk2(q[8], q[9]), pk2(q[10], q[11]), pk2(q[12], q[13]), pk2(q[14], q[15])};
                    *(LAS v4u*)(T + SC_KI + vst(sti, 8 * c8, 2)) = (v4u){pk2(kk[0], kk[1]), pk2(kk[2], kk[3]), pk2(kk[4], kk[5]), pk2(kk[6], kk[7])};
                    *(LAS v4u*)(T + SC_KI + vst(sti, 32 + 8 * c8, 2)) = (v4u){pk2(kk[8], kk[9]), pk2(kk[10], kk[11]), pk2(kk[12], kk[13]), pk2(kk[14], kk[15])};
#pragma unroll
                    for (int m = 0; m < 4; ++m) *(LAS v4u*)(T + SC_VT + vst(sti, c8 * 32 + 8 * m, 4)) = pv[m];
                }
                if (s + 2 >= 0 && s + 2 < NC) SC_LOADRAW(s + 2);
            } else if (s >= 0) {
                LAS unsigned char* T = G + SC_T + (s & 1) * SC_TSZ; const unsigned taddr = gaddr + SC_T + (s & 1) * SC_TSZ;
                bf16x8 qf[4]; bf16x8 pa0, pa1, pa2, pa3;
                { const int qb_ = vst_row(32 * ri + r32, 2) + 16 * hi;
                  qf[0] = *(const LAS bf16x8*)(T + SC_QD + qb_); qf[1] = *(const LAS bf16x8*)(T + SC_QD + qb_ + 32); qf[2] = *(const LAS bf16x8*)(T + SC_QD + qb_ + 512); qf[3] = *(const LAS bf16x8*)(T + SC_QD + qb_ + 544); }
                { f32x16 p0 = {}, p1 = {};
                  const int kb0 = vst_row(r32, 2) + 16 * hi, kb1 = vst_row(32 + r32, 2) + 16 * hi;
                  { const bf16x8 a0 = *(const LAS bf16x8*)(T + SC_KI + kb0), a1 = *(const LAS bf16x8*)(T + SC_KI + kb0 + 32), a2 = *(const LAS bf16x8*)(T + SC_KI + kb0 + 512), a3 = *(const LAS bf16x8*)(T + SC_KI + kb0 + 544);
                    p0 = __builtin_amdgcn_mfma_f32_32x32x16_bf16(a0, qf[0], p0, 0, 0, 0); p0 = __builtin_amdgcn_mfma_f32_32x32x16_bf16(a1, qf[1], p0, 0, 0, 0);
                    p0 = __builtin_amdgcn_mfma_f32_32x32x16_bf16(a2, qf[2], p0, 0, 0, 0); p0 = __builtin_amdgcn_mfma_f32_32x32x16_bf16(a3, qf[3], p0, 0, 0, 0); }
                  if (ri == 1) {
                      const bf16x8 c0 = *(const LAS bf16x8*)(T + SC_KI + kb1), c1 = *(const LAS bf16x8*)(T + SC_KI + kb1 + 32), c2 = *(const LAS bf16x8*)(T + SC_KI + kb1 + 512), c3 = *(const LAS bf16x8*)(T + SC_KI + kb1 + 544);
                      p1 = __builtin_amdgcn_mfma_f32_32x32x16_bf16(c0, qf[0], p1, 0, 0, 0); p1 = __builtin_amdgcn_mfma_f32_32x32x16_bf16(c1, qf[1], p1, 0, 0, 0);
                      p1 = __builtin_amdgcn_mfma_f32_32x32x16_bf16(c2, qf[2], p1, 0, 0, 0); p1 = __builtin_amdgcn_mfma_f32_32x32x16_bf16(c3, qf[3], p1, 0, 0, 0); }
#pragma unroll
                  for (int r = 0; r < 16; ++r) { const bool keep = crow(r, hi) <= r32; if (ri == 0) { p0[r] = keep ? p0[r] : 0.f; } else { p1[r] = keep ? p1[r] : 0.f; } }
                  PK4(p0, 0, pa0); PK4(p0, 8, pa1); PK4(p1, 0, pa2); PK4(p1, 8, pa3); }
                const unsigned vb = taddr + SC_VT + v_rd_base(lane) + dh * 1024, sbv = gaddr + SC_ST + v_rd_base(lane) + dh * 1024;
#define SC_FR4(dst, base, d) do { const s16x4 l0_ = tr_read<(d) * 512>(base), h0_ = tr_read<(d) * 512 + 2048>(base), l1_ = tr_read<(d) * 512 + 4096>(base), h1_ = tr_read<(d) * 512 + 4096 + 2048>(base); \
                  const s16x4 l2_ = tr_read<(d) * 512 + 8192>(base), h2_ = tr_read<(d) * 512 + 8192 + 2048>(base), l3_ = tr_read<(d) * 512 + 12288>(base), h3_ = tr_read<(d) * 512 + 12288 + 2048>(base); \
                  asm volatile("s_waitcnt lgkmcnt(0)" ::: "memory"); SBAR(); \
                  dst[0] = PKF(l0_, h0_); dst[1] = PKF(l1_, h1_); dst[2] = PKF(l2_, h2_); dst[3] = PKF(l3_, h3_); } while (0)
#define SC_OBLK(d) do { bf16x8 vf_[4], sf_[4]; SC_FR4(vf_, vb, d); SC_FR4(sf_, sbv, d); f32x16 o_ = {}; \
                  o_ = __builtin_amdgcn_mfma_f32_32x32x16_bf16(pa0, vf_[0], o_, 0, 0, 0); o_ = __builtin_amdgcn_mfma_f32_32x32x16_bf16(pa1, vf_[1], o_, 0, 0, 0); \
                  if (ri == 1) { o_ = __builtin_amdgcn_mfma_f32_32x32x16_bf16(pa2, vf_[2], o_, 0, 0, 0); o_ = __builtin_amdgcn_mfma_f32_32x32x16_bf16(pa3, vf_[3], o_, 0, 0, 0); } \
                  o_ = __builtin_amdgcn_mfma_f32_32x32x16_bf16(qf[0], sf_[0], o_, 0, 0, 0); o_ = __builtin_amdgcn_mfma_f32_32x32x16_bf16(qf[1], sf_[1], o_, 0, 0, 0); \
                  o_ = __builtin_amdgcn_mfma_f32_32x32x16_bf16(qf[2], sf_[2], o_, 0, 0, 0); o_ = __builtin_amdgcn_mfma_f32_32x32x16_bf16(qf[3], sf_[3], o_, 0, 0, 0); \
                  char* dst_ = (char*)OUT; \
                  _Pragma("unroll") for (int r = 0; r < 16; r += 2) { const int i_ = 32 * ri + crow(r, hi); const int t_ = SC_TOK(s, i_); const unsigned w_ = pk2(o_[r], o_[r + 1]); \
                      const unsigned a_ = (unsigned)(row0 + t_) * (unsigned)(D * 2) + (unsigned)(hh * 128 + 64 * dh + 32 * (d) + r32) * 2u; \
                      *(bf16*)(dst_ + a_) = (bf16)w_; *(bf16*)(dst_ + (dir == 0 ? a_ + (unsigned)(D * 2) : a_ - (unsigned)(D * 2))) = (bf16)(w_ >> 16); } SBAR(); } while (0)
                SC_OBLK(0); SC_OBLK(1);
            }
            SC_BAR();
            if (isP) {
                if (gla && s + 3 < NC) {
                    const int th = gw4 >> 1, kq = 32 * (gw4 & 1) + r32;
                    f32x16 gp;
#pragma unroll
                    for (int r = 0; r < 16; ++r) gp[r] = gbias;
                    gp = __builtin_amdgcn_mfma_f32_32x32x16_bf16(__builtin_bit_cast(bf16x8, pga), __builtin_bit_cast(bf16x8, w2f), gp, 0, 0, 0);
                    float g4[4], o4[4];
#pragma unroll
                    for (int j = 0; j < 4; ++j) { float run = 0.f;
#pragma unroll
                        for (int e = 0; e < 4; ++e) { run += logsig(gp[4 * j + e]) * (1.0f / 16.0f); cs[4 * j + e] = run; }
                        g4[j] = run; }
#pragma unroll
                    for (int j = 0; j < 4; ++j) o4[j] = __shfl_xor(g4[j], 32);
                    float acc_ = 0.f;
#pragma unroll
                    for (int j = 0; j < 4; ++j) { const float off = acc_ + (hi ? o4[j] : 0.f);
#pragma unroll
                        for (int e = 0; e < 4; ++e) cs[4 * j + e] += off;
                        acc_ += g4[j] + o4[j]; }
                    tsum = acc_;
                    if (hi == 0) ((LAS float*)(G + SC_TOT))[th * 64 + kq] = tsum;
                    if (s + 4 < NC) SC_LOADGK(s + 4);
                }
            } else if (s >= 0) {
                const unsigned taddr = gaddr + SC_T + (s & 1) * SC_TSZ;
                const unsigned vb = taddr + SC_VT + v_rd_base(lane) + dh * 1024, kt = taddr + SC_KI + v_rd_base(lane) + ri * 512;
                bf16x8 kf[4];
                { const s16x4 l0_ = tr_read<0>(kt), h0_ = tr_read<1024>(kt), l1_ = tr_read<2048>(kt), h1_ = tr_read<2048 + 1024>(kt), l2_ = tr_read<4096>(kt), h2_ = tr_read<4096 + 1024>(kt), l3_ = tr_read<6144>(kt), h3_ = tr_read<6144 + 1024>(kt);
                  asm volatile("s_waitcnt lgkmcnt(0)" ::: "memory"); SBAR();
                  kf[0] = PKF(l0_, h0_); kf[1] = PKF(l1_, h1_); kf[2] = PKF(l2_, h2_); kf[3] = PKF(l3_, h3_); }
                const int stb_ = (hi + 4 * ri) * 2048 + (2 * dh) * 512 + r32 * 2;
                const LAS float* DLr = (const LAS float*)(G + SC_DL) + (s % 3) * 64;
#define SC_SBLK(d) do { bf16x8 vf_[4]; SC_FR4(vf_, vb, d); \
                  _Pragma("unroll") for (int ks = 0; ks < 4; ++ks) sacc[d] = __builtin_amdgcn_mfma_f32_32x32x16_bf16(kf[ks], vf_[ks], sacc[d], 0, 0, 0); \
                  _Pragma("unroll") for (int r = 0; r < 16; r += 2) { const int dk = 32 * ri + crow(r, hi); const float dl0 = DLr[dk], dl1 = DLr[dk + 1]; \
                      sacc[d][r] *= dl0; sacc[d][r + 1] *= dl1; const unsigned w_ = pk2(sacc[d][r], sacc[d][r + 1]); \
                      LAS unsigned char* sp_ = G + SC_ST + stb_ + (d) * 512 + ((r >> 3) & 1) * 4096 + ((r & 3) + 4 * ((r >> 2) & 1)) * 64; \
                      *(LAS unsigned short*)sp_ = (unsigned short)w_; *(LAS unsigned short*)(sp_ + 64) = (unsigned short)(w_ >> 16); } SBAR(); } while (0)
                SC_SBLK(0); SC_SBLK(1);
            }
            SC_BAR();
        }
        if (!lat && !isP) { int l2 = F.lane; asm volatile("" : "+v"(l2)); const int r32 = l2 & 31, hi = l2 >> 5; float* SO = POUT + (gla ? OUT_SGLA : OUT_SRET) + ((size_t)((sb * 2 + li) * 2 + dir) * 4 + h) * 8192;
#pragma unroll
            for (int d = 0; d < 2; ++d)
#pragma unroll
                for (int r = 0; r < 16; ++r) SO[(32 * ri + crow(r, hi)) * 128 + 32 * (2 * dh + d) + r32] = sacc[d][r]; }
    }
#undef SC_TOK
#undef SC_BAR
#undef SC_LOADRAW
#undef SC_LOADGK
#undef UNPK
#undef SC_FR4
#undef SC_OBLK
#undef SC_SBLK
    if (F.G == 256 && F.bid >= 128) { if (li == 0) setup_work(F, P, F.bid - 128, 128, 0x2, 0x2, 0x0, 0x0, 0x1); else setup_work(F, P, F.bid - 128, 128, 0x8, 0x8, 0x0, 0x0, 0x2); }
    else if (F.G != 256) { if (li == 0) setup_work(F, P, F.bid, F.G, 0x2, 0x2, 0x0, 0x0, 0x1); else setup_work(F, P, F.bid, F.G, 0x8, 0x8, 0x0, 0x0, 0x2); }
}
__device__ __forceinline__ void scan_combine(Frame& F, const Params& P, int li) {
    unsigned char* ws = PWS;
    const char* PROJ = (const char*)(ws + WS_BIG); const char* OF = (const char*)(ws + WS_Y); char* OB = (char*)(ws + WS_HB);
    const int gw = F.vcu * NWAVES + F.wave, NGW = F.G * NWAVES, lane = F.lane, hh = lane >> 3, dv = (lane & 7) * 16;
    f32x4 gn[4];
    { const float* gp_ = PIN(I_GLAN) + li * 128 + dv;
#pragma unroll
      for (int j = 0; j < 4; ++j) gn[j] = hh < 4 ? *(const f32x4*)(gp_ + 4 * j) : (f32x4){1.f, 1.f, 1.f, 1.f}; }
    const unsigned gcol = (unsigned)((hh < 4 ? PC_GA : PC_GB) + (hh & 3) * 128 + dv) * 2u, ocol = (unsigned)(hh * 128 + dv) * 2u;
    for (int row = gw; row < M; row += 2 * NGW) {
        v4u a[2][2], b[2][2], g[2][2];
#pragma unroll
        for (int i = 0; i < 2; ++i) { const int r_ = row + i * NGW; if (r_ < M) {
            const unsigned off = (unsigned)r_ * (unsigned)(D * 2) + ocol, goff = (unsigned)r_ * (unsigned)(EVEN_NP * 2) + gcol;
            a[i][0] = __builtin_nontemporal_load((const v4u*)(OF + off)); a[i][1] = __builtin_nontemporal_load((const v4u*)(OF + off + 16)); b[i][0] = __builtin_nontemporal_load((const v4u*)(OB + off)); b[i][1] = __builtin_nontemporal_load((const v4u*)(OB + off + 16));
            g[i][0] = __builtin_nontemporal_load((const v4u*)(PROJ + goff)); g[i][1] = __builtin_nontemporal_load((const v4u*)(PROJ + goff + 16)); } }
#pragma unroll
        for (int i = 0; i < 2; ++i) { const int r_ = row + i * NGW; if (r_ < M) {
            const unsigned off = (unsigned)r_ * (unsigned)(D * 2) + ocol;
            float x[16], gg[16];
#pragma unroll
            for (int hf = 0; hf < 2; ++hf)
#pragma unroll
                for (int e = 0; e < 4; ++e) { x[8 * hf + 2 * e] = bflo(a[i][hf][e]) + bflo(b[i][hf][e]); x[8 * hf + 2 * e + 1] = bfhi(a[i][hf][e]) + bfhi(b[i][hf][e]);
                    gg[8 * hf + 2 * e] = bflo(g[i][hf][e]); gg[8 * hf + 2 * e + 1] = bfhi(g[i][hf][e]); }
            float ss = 0.f;
#pragma unroll
            for (int e = 0; e < 16; ++e) ss += x[e] * x[e];
            ss += __shfl_xor(ss, 1); ss += __shfl_xor(ss, 2); ss += __shfl_xor(ss, 4);
            const float rstd = __builtin_amdgcn_rsqf(ss * (1.0f / 128.0f) + EPS);
#pragma unroll
            for (int e = 0; e < 16; ++e) x[e] = x[e] * rstd * gn[e >> 2][e & 3] * siluf(gg[e]);
            *(v4u*)(OB + off) = (v4u){pk2(x[0], x[1]), pk2(x[2], x[3]), pk2(x[4], x[5]), pk2(x[6], x[7])};
            *(v4u*)(OB + off + 16) = (v4u){pk2(x[8], x[9]), pk2(x[10], x[11]), pk2(x[12], x[13]), pk2(x[14], x[15])}; } }
    }
}

__device__ __forceinline__ void cache_pass(Frame& F, const Params& P, int li) {
    unsigned char* ws = PWS;
    const int gt = F.vcu * 512 + F.tid, NGT = F.G * 512;
    const float* cckv_ = PIN(I_CCKV); const float* ckpe_ = PIN(I_CKPE);
    for (int i = gt; i < 8 * 256 * 32; i += NGT) { const int c8 = i & 31, t = (i >> 5) & 255, b = i >> 13;
        const float* s = cckv_ + ((size_t)((b * 2 + li) * 256 + t) * 32 + c8) * 8; const f32x4 a = *(const f32x4*)s, c = *(const f32x4*)(s + 4);
        *(GAS v4u*)((bf16*)(ws + WS_ACKV) + ((size_t)4096 + b * LKV + t) * 256 + c8 * 8) = (v4u){pk2(a[0], a[1]), pk2(a[2], a[3]), pk2(c[0], c[1]), pk2(c[2], c[3])}; }
    for (int i = gt; i < 8 * 256 * 8; i += NGT) { const int c8 = i & 7, t = (i >> 3) & 255, b = i >> 11;
        const float* s = ckpe_ + ((size_t)((b * 2 + li) * 256 + t) * 8 + c8) * 8; const f32x4 a = *(const f32x4*)s, c = *(const f32x4*)(s + 4);
        *(GAS v4u*)((bf16*)(ws + WS_KPE) + ((size_t)4096 + b * LKV + t) * 64 + c8 * 8) = (v4u){pk2(a[0], a[1]), pk2(a[2], a[3]), pk2(c[0], c[1]), pk2(c[2], c[3])}; }
}
__device__ __forceinline__ void kpe_pass(Frame& F, const Params& P, int li) {
    unsigned char* ws = PWS;
    const float* KR = (const float*)(ws + WS_Y); const float* ROPE = (const float*)(ws + WS_ROPE);
    bf16* KPE = (bf16*)(ws + WS_KPE);
    const int gt = F.vcu * 512 + F.tid, NGT = F.G * 512;
    for (int i = gt; i < M * 4; i += NGT) {
        const int row = i >> 2, c8 = i & 3;
        const float* s = KR + (size_t)row * 64 + 8 * c8;
        f32x4 a0 = *(const f32x4*)s, a1 = *(const f32x4*)(s + 4), b0 = *(const f32x4*)(s + 32), b1 = *(const f32x4*)(s + 36);
        int drow = row;
        if (row >= M_CTX) { const int lb = (row - M_CTX) >> 11, t = (row - M_CTX) & 2047; drow = M_CTX + lb * LKV + PAST + t;
            const float* cp = ROPE + (size_t)t * 32 + 8 * c8; const float* sp = cp + 65536;
            const f32x4 c0 = *(const f32x4*)cp, c1 = *(const f32x4*)(cp + 4), s0 = *(const f32x4*)sp, s1 = *(const f32x4*)(sp + 4);
            const f32x4 x0 = a0 * c0 - b0 * s0, x1 = a1 * c1 - b1 * s1, y0 = a0 * s0 + b0 * c0, y1 = a1 * s1 + b1 * c1;
            a0 = x0; a1 = x1; b0 = y0; b1 = y1; }
        bf16* d = KPE + (size_t)drow * 64 + 8 * c8;
        *(v4u*)d = (v4u){pk2(a0[0], a0[1]), pk2(a0[2], a0[3]), pk2(a1[0], a1[1]), pk2(a1[2], a1[3])};
        *(v4u*)(d + 32) = (v4u){pk2(b0[0], b0[1]), pk2(b0[2], b0[3]), pk2(b1[0], b1[1]), pk2(b1[2], b1[3])};
    }
}

constexpr float ATT_SCALE = 0.07216878364870322f;
constexpr float ATT_THR = 8.f;
constexpr int AT_V = 0, AT_KN = 49152, AT_KP = 98304, AT_WS = 122880, AT_VB = 16384, AT_KNB = 16384, AT_KPB = 8192;
#define KSWZ(row, colB) ((row) * 256 + ((colB) ^ (((row) & 7) << 4)))
#define KPSWZ(row, colB) ((row) * 128 + ((colB) ^ (((row) & 7) << 4)))
__device__ __forceinline__ void at_partialSM(f32x16& p0, f32x16& p1, float& m_reg, float& mn, float& alpha) {
    constexpr float C = ATT_SCALE * 1.4426950408889634f;
    float pmax = p0[0];
#pragma unroll
    for (int r = 1; r < 16; ++r) pmax = fmaxf(pmax, p0[r]);
#pragma unroll
    for (int r = 0; r < 16; ++r) pmax = fmaxf(pmax, p1[r]);
    { auto rr = __builtin_amdgcn_permlane32_swap(__float_as_uint(pmax), __float_as_uint(pmax), false, false); pmax = fmaxf(__uint_as_float(rr[0]), __uint_as_float(rr[1])); }
    if (__builtin_expect(__all(pmax - m_reg <= ATT_THR / ATT_SCALE), 1)) { mn = m_reg; alpha = 1.f; }
    else { mn = fmaxf(m_reg, pmax); alpha = __builtin_amdgcn_exp2f((m_reg - mn) * C); m_reg = mn; }
    const float mnC = -mn * C;
#pragma unroll
    for (int r = 0; r < 16; ++r) p0[r] = fmaf(p0[r], C, mnC);
#pragma unroll
    for (int r = 0; r < 16; ++r) p1[r] = fmaf(p1[r], C, mnC);
#pragma unroll
    for (int r = 0; r < 16; ++r) p0[r] = __builtin_amdgcn_exp2f(p0[r]);
}
__device__ __forceinline__ void at_finishSM(f32x16& p0, f32x16& p1, float alpha, float& l_reg, bf16x8& pa0, bf16x8& pa1, bf16x8& pa2, bf16x8& pa3) {
#pragma unroll
    for (int r = 0; r < 16; ++r) p1[r] = __builtin_amdgcn_exp2f(p1[r]);
    float ps = 0;
#pragma unroll
    for (int r = 0; r < 16; ++r) ps += p0[r];
#pragma unroll
    for (int r = 0; r < 16; ++r) ps += p1[r];
    { auto rr = __builtin_amdgcn_permlane32_swap(__float_as_uint(ps), __float_as_uint(ps), false, false); ps = __uint_as_float(rr[0]) + __uint_as_float(rr[1]); }
    l_reg = l_reg * alpha + ps;
    PK4(p0, 0, pa0); PK4(p0, 8, pa1); PK4(p1, 0, pa2); PK4(p1, 8, pa3);
}
__device__ __forceinline__ void at_qkt(f32x16& p0, f32x16& p1, const LAS unsigned char* Kn, const LAS unsigned char* Kp, const bf16x8* qr, const int* kb, const int* pb) {
    p0 = f32x16{}; p1 = f32x16{};
#pragma unroll
    for (int d0 = 0; d0 < 8; ++d0) {
        const bf16x8 b0 = *(const LAS bf16x8*)(Kn + kb[d0 & 3] + 128 * (d0 >> 2)), b1 = *(const LAS bf16x8*)(Kn + kb[d0 & 3] + 128 * (d0 >> 2) + 8192);
        p0 = __builtin_amdgcn_mfma_f32_32x32x16_bf16(b0, qr[d0], p0, 0, 0, 0);
        p1 = __builtin_amdgcn_mfma_f32_32x32x16_bf16(b1, qr[d0], p1, 0, 0, 0); }
#pragma unroll
    for (int d0 = 0; d0 < 4; ++d0) {
        const bf16x8 b0 = *(const LAS bf16x8*)(Kp + pb[d0]), b1 = *(const LAS bf16x8*)(Kp + pb[d0] + 4096);
        p0 = __builtin_amdgcn_mfma_f32_32x32x16_bf16(b0, qr[8 + d0], p0, 0, 0, 0);
        p1 = __builtin_amdgcn_mfma_f32_32x32x16_bf16(b1, qr[8 + d0], p1, 0, 0, 0); }
}
template <int D0> __device__ __forceinline__ void at_pv_one(f32x16& od, unsigned vb, bf16x8 pa0, bf16x8 pa1, bf16x8 pa2, bf16x8 pa3) {
    const s16x4 l0 = tr_read<D0 * 512>(vb), h0 = tr_read<D0 * 512 + 2048>(vb), l1 = tr_read<D0 * 512 + 4096>(vb), h1 = tr_read<D0 * 512 + 4096 + 2048>(vb);
    const s16x4 l2 = tr_read<D0 * 512 + 8192>(vb), h2 = tr_read<D0 * 512 + 8192 + 2048>(vb), l3 = tr_read<D0 * 512 + 12288>(vb), h3 = tr_read<D0 * 512 + 12288 + 2048>(vb);
    asm volatile("s_waitcnt lgkmcnt(0)" ::: "memory"); SBAR();
    od = __builtin_amdgcn_mfma_f32_32x32x16_bf16(pa0, PKF(l0, h0), od, 0, 0, 0);
    od = __builtin_amdgcn_mfma_f32_32x32x16_bf16(pa1, PKF(l1, h1), od, 0, 0, 0);
    od = __builtin_amdgcn_mfma_f32_32x32x16_bf16(pa2, PKF(l2, h2), od, 0, 0, 0);
    od = __builtin_amdgcn_mfma_f32_32x32x16_bf16(pa3, PKF(l3, h3), od, 0, 0, 0);
}
__device__ __forceinline__ void at_pv(f32x16* o, unsigned vb, bf16x8 pa0, bf16x8 pa1, bf16x8 pa2, bf16x8 pa3) {
    at_pv_one<0>(o[0], vb, pa0, pa1, pa2, pa3); at_pv_one<1>(o[1], vb, pa0, pa1, pa2, pa3); at_pv_one<2>(o[2], vb, pa0, pa1, pa2, pa3); at_pv_one<3>(o[3], vb, pa0, pa1, pa2, pa3);
}
__device__ __forceinline__ void attn_unit(Frame& F, const bf16* Qrow0  , const bf16* KVh  , const bf16* KPEs  ,
                                          bf16* Orow0, int nkeys, const float* ROPE, int tpos0  ) {
    LAS unsigned char* lds = F.lds;
    const int tid = F.tid, wid = F.wave, lane = F.lane, r32 = lane & 31, hi = lane >> 5;
    LAS float* wsf = (LAS float*)(lds + AT_WS) + wid * 64; LAS float* li_l = wsf; LAS float* al_l = wsf + 32;
    float m_reg = -1e30f, l_reg = 0; f32x16 o[4] = {}; bf16x8 qr[12];
    { const bf16* Qw = Qrow0 + (size_t)(wid * 32 + r32) * 1536 + hi * 8;
#pragma unroll
      for (int d0 = 0; d0 < 12; ++d0) qr[d0] = *(const bf16x8*)(Qw + d0 * 16);
      if (tpos0 >= 0) {
          const int t = tpos0 + wid * 32 + r32;
#pragma unroll
          for (int half = 0; half < 2; ++half) {
              const float* cp = ROPE + (size_t)t * 32 + 16 * half + 8 * hi; const float* sp = cp + 65536;
              const v4u xa = __builtin_bit_cast(v4u, qr[8 + half]), xb = __builtin_bit_cast(v4u, qr[10 + half]);
              float x1[8], x2[8];
              x1[0] = bflo(xa.x); x1[1] = bfhi(xa.x); x1[2] = bflo(xa.y); x1[3] = bfhi(xa.y); x1[4] = bflo(xa.z); x1[5] = bfhi(xa.z); x1[6] = bflo(xa.w); x1[7] = bfhi(xa.w);
              x2[0] = bflo(xb.x); x2[1] = bfhi(xb.x); x2[2] = bflo(xb.y); x2[3] = bfhi(xb.y); x2[4] = bflo(xb.z); x2[5] = bfhi(xb.z); x2[6] = bflo(xb.w); x2[7] = bfhi(xb.w);
              float y1[8], y2[8];
#pragma unroll
              for (int j = 0; j < 8; ++j) { const float c = cp[j], s = sp[j]; y1[j] = x1[j] * c - x2[j] * s; y2[j] = x1[j] * s + x2[j] * c; }
              const v4u wa = {pk2(y1[0], y1[1]), pk2(y1[2], y1[3]), pk2(y1[4], y1[5]), pk2(y1[6], y1[7])}, wb = {pk2(y2[0], y2[1]), pk2(y2[2], y2[3]), pk2(y2[4], y2[5]), pk2(y2[6], y2[7])};
              if (half == 0) { qr[8] = __builtin_bit_cast(bf16x8, wa); qr[10] = __builtin_bit_cast(bf16x8, wb); } else { qr[9] = __builtin_bit_cast(bf16x8, wa); qr[11] = __builtin_bit_cast(bf16x8, wb); }
          }
      } }
    const unsigned vb0 = (unsigned)(uintptr_t)(lds + AT_V) + v_rd_base(lane);
#define AT_OPQ() int l_ = lane; asm volatile("" : "+v"(l_))
#define AT_KADDR() int kbs[4], pbs[4]; { AT_OPQ(); _Pragma("unroll") for (int b = 0; b < 4; ++b) { const int x = (32 * b + 16 * (l_ >> 5)) ^ ((l_ & 7) << 4); kbs[b] = (l_ & 31) * 256 + x; pbs[b] = (l_ & 31) * 128 + x; } }
#define AT_GLDS(gp, ldsoff) __builtin_amdgcn_global_load_lds((const unsigned*)(gp), (LAS unsigned*)(lds + (ldsoff)), 16, 0, 0)
#define AT_DMA_K(t, b) do { AT_OPQ(); const char* kb_ = (const char*)KVh + (size_t)(t) * (64 * 4096); const char* pb_ = (const char*)KPEs + (size_t)(t) * (64 * 128); \
    const int row0_ = 4 * wid + (l_ >> 4), cB0_ = ((l_ & 15) * 16) ^ ((row0_ & 7) << 4), row1_ = row0_ + 32, rowp_ = 8 * wid + (l_ >> 3), cBp_ = ((l_ & 7) * 16) ^ ((rowp_ & 7) << 4); \
    AT_GLDS(kb_ + (unsigned)(row0_ * 4096 + cB0_), AT_KN + (b) * AT_KNB + wid * 1024); AT_GLDS(kb_ + (unsigned)(row1_ * 4096 + cB0_), AT_KN + (b) * AT_KNB + (wid + 8) * 1024); \
    AT_GLDS(pb_ + (unsigned)(rowp_ * 128 + cBp_), AT_KP + (b) * AT_KPB + wid * 1024); } while (0)
#define AT_DMA_V(t, b) do { AT_OPQ(); const char* vb_ = (const char*)KVh + (size_t)(t) * (64 * 4096); \
    const int st_ = 2 * wid + (l_ >> 5), kk_ = (st_ >> 2) * 8 + ((l_ & 31) >> 2), key_ = (kk_ & ~0xC) | ((kk_ & 4) << 1) | ((kk_ & 8) >> 1), col_ = (st_ & 3) * 32 + (l_ & 3) * 8; \
    AT_GLDS(vb_ + (unsigned)(key_ * 4096 + (128 + col_) * 2), AT_V + (b) * AT_VB + wid * 1024); AT_GLDS(vb_ + (unsigned)((key_ + 32) * 4096 + (128 + col_) * 2), AT_V + (b) * AT_VB + (wid + 8) * 1024); } while (0)
#define AT_RESC(a) do { if (__any((a) < 1.f)) { if (hi == 0) al_l[r32] = (a); asm volatile("s_waitcnt lgkmcnt(0)" ::: "memory"); \
    _Pragma("unroll") for (int d = 0; d < 4; ++d) _Pragma("unroll") for (int r = 0; r < 16; ++r) o[d][r] *= al_l[crow(r, hi)]; } } while (0)
#define AT_WAITBAR(N) do { asm volatile("s_waitcnt vmcnt(" #N ") lgkmcnt(0)" ::: "memory"); __builtin_amdgcn_s_barrier(); asm volatile("" ::: "memory"); } while (0)
    f32x16 pA0, pA1, pB0, pB1; float mnA, mnB, alA, alB; bf16x8 pa0, pa1, pa2, pa3; const int NT = nkeys / 64;
    AT_DMA_K(0, 0); AT_DMA_K(1, 1); AT_DMA_V(0, 0); AT_WAITBAR(0);
    int s = 0;
#define AT_S1 (s == 2 ? 0 : s + 1)
#define AT_S2 (s == 0 ? 2 : s - 1)
#define AT_STEP(CUR0, CUR1, MNC, ALC, PRV0, PRV1, ALP, t, MODE) do { \
        if (MODE == 2) { AT_DMA_K((t) + 2, AT_S2); } if (MODE >= 1) { AT_DMA_V((t) + 1, AT_S1); } \
        SBAR(); { AT_KADDR(); at_qkt(CUR0, CUR1, lds + AT_KN + s * AT_KNB, lds + AT_KP + s * AT_KPB, qr, kbs, pbs); } \
        at_finishSM(PRV0, PRV1, ALP, l_reg, pa0, pa1, pa2, pa3); SBAR(); \
        at_pv(o, vb0 + AT_S2 * AT_VB, pa0, pa1, pa2, pa3); at_partialSM(CUR0, CUR1, m_reg, MNC, ALC); \
        AT_RESC(ALC); if (MODE == 2) AT_WAITBAR(5); else if (MODE == 1) AT_WAITBAR(2); else AT_WAITBAR(0); s = AT_S1; } while (0)
    AT_DMA_K(2, 2); AT_DMA_V(1, 1);
    { AT_KADDR(); at_qkt(pA0, pA1, lds + AT_KN, lds + AT_KP, qr, kbs, pbs); } at_partialSM(pA0, pA1, m_reg, mnA, alA);
    AT_WAITBAR(5); s = 1;
    int t = 1;
    for (; t + 4 < NT; t += 2) {
        AT_STEP(pB0, pB1, mnB, alB, pA0, pA1, alA, t, 2);
        AT_STEP(pA0, pA1, mnA, alA, pB0, pB1, alB, t + 1, 2);
    }
    AT_STEP(pB0, pB1, mnB, alB, pA0, pA1, alA, NT - 3, 2);
    AT_STEP(pA0, pA1, mnA, alA, pB0, pB1, alB, NT - 2, 1);
    AT_STEP(pB0, pB1, mnB, alB, pA0, pA1, alA, NT - 1, 0);
    at_finishSM(pB0, pB1, alB, l_reg, pa0, pa1, pa2, pa3); SBAR();
    at_pv(o, vb0 + AT_S2 * AT_VB, pa0, pa1, pa2, pa3);
    if (hi == 0) li_l[r32] = l_reg; asm volatile("s_waitcnt lgkmcnt(0)" ::: "memory");
    float rli[16];
#pragma unroll
    for (int r = 0; r < 16; ++r) rli[r] = __builtin_amdgcn_rcpf(li_l[crow(r, hi)]);
    bf16* Ow = Orow0 + (size_t)(wid * 32) * D;
#pragma unroll
    for (int r = 0; r < 16; r += 2) { const int orow = crow(r, hi);
#pragma unroll
        for (int d0 = 0; d0 < 4; ++d0) { const unsigned w = pk2(o[d0][r] * rli[r], o[d0][r + 1] * rli[r + 1]);
            Ow[(size_t)orow * D + d0 * 32 + r32] = (bf16)w; Ow[(size_t)(orow + 1) * D + d0 * 32 + r32] = (bf16)(w >> 16); } }
#undef AT_GLDS
#undef AT_OPQ
#undef AT_KADDR
#undef AT_DMA_K
#undef AT_DMA_V
#undef AT_RESC
#undef AT_WAITBAR
#undef AT_S1
#undef AT_S2
#undef AT_STEP
}
__device__ __forceinline__ void attn_phase(Frame& F, const Params& P, int li) {
    unsigned char* ws = PWS;
    const bf16* Q = (const bf16*)(ws + WS_Q); const bf16* KV = (const bf16*)(ws + WS_KV); const bf16* KPE = (const bf16*)(ws + WS_KPE);
    bf16* OB = (bf16*)(ws + WS_HB); const float* ROPE = (const float*)(ws + WS_ROPE);
    for (int u = F.vcu; u < 256 + 128; u += F.G) {
        for (int k = 0; k < 2; ++k) {
            int qrow0, kvrow0, nkeys, h, tpos0;
            if (u < 256) { const int id = 2 * u + k, lb = id >> 6, qb = id & 7; h = (id >> 3) & 7; qrow0 = M_CTX + lb * L_LAT + qb * 256; kvrow0 = M_CTX + lb * LKV; nkeys = LKV; tpos0 = qb * 256; }
            else { if (k == 1) break; const int id = u - 256, b = id >> 3; h = id & 7; qrow0 = b * L_CTX; kvrow0 = b * L_CTX; nkeys = L_CTX; tpos0 = -1; }
            __syncthreads();
            attn_unit(F, Q + (size_t)qrow0 * 1536 + h * 192, KV + (size_t)kvrow0 * 2048 + h * 256, KPE + (size_t)kvrow0 * 64, OB + (size_t)qrow0 * D + h * 128, nkeys, ROPE, tpos0);
        }
    }
}

constexpr int N_PHASES = 2 + 2 * 16;
__global__ void __launch_bounds__(NWAVES * 64, 2) hyb_fwd(Params P) {
    extern __shared__ __attribute__((aligned(16))) unsigned char lds_raw[];
    Frame F;
    F.lds = (LAS unsigned char*)lds_raw;
    F.tid = threadIdx.x; F.lane = F.tid & 63; F.wave = __builtin_amdgcn_readfirstlane(F.tid >> 6);
    F.G = gridDim.x; { const int bx = blockIdx.x; F.vcu = (F.G % 8 == 0) ? (bx % 8) * (F.G / 8) + bx / 8 : bx; }
    volatile LAS unsigned* MISC = (volatile LAS unsigned*)(F.lds + LDS_MISC);
    if (F.tid < 64) MISC[F.tid] = 0u;
    if (F.tid < 30) { const unsigned long long v = F.tid < 28 ? (unsigned long long)P.in[F.tid] : (F.tid == 28 ? (unsigned long long)P.out : (unsigned long long)P.ws);
        volatile LAS unsigned* pt = (volatile LAS unsigned*)(F.lds + LDS_PT) + 2 * F.tid; pt[0] = (unsigned)v; pt[1] = (unsigned)(v >> 32); }
    __syncthreads();
    const int use_bar = P.use_bar, ph_hi = P.ph_hi;
    XcdBarrier bar; bar.bar = (unsigned*)(PWS + WS_CTL) + 4096; bar.x = 0; bar.st = nullptr;
    if (use_bar) bar = xcd_barrier_post((unsigned*)(PWS + WS_CTL) + 4096, MISC + 8);

    for (int ph = P.ph_lo; ph < ph_hi; ++ph) {
#define REFRESH_ID() do { int t_ = threadIdx.x; asm volatile("" : "+v"(t_)); F.tid = t_; F.lane = t_ & 63; F.wave = __builtin_amdgcn_readfirstlane(t_ >> 6); \
          int g_ = gridDim.x, b_ = blockIdx.x; asm volatile("" : "+s"(g_), "+s"(b_)); F.G = g_; F.vcu = (g_ % 8 == 0) ? (b_ % 8) * (g_ / 8) + b_ / 8 : b_; F.bid = b_; } while (0)
        REFRESH_ID();
        unsigned char* ws = PWS;
        bf16* XBF = (bf16*)(POUT + OUT_Y);
        bf16* HB = (bf16*)(ws + WS_HB); bf16* YB = (bf16*)(ws + WS_Y); const bf16* SL = (const bf16*)(ws + WS_SLAB);
        const float* MOD = (const float*)(ws + WS_MOD);
        if (ph == 0) { p0_prologue(F, P); }
        else if (ph == 1) {
            const float* m0 = MOD;
            row_pass(F, PIN(I_XP), PIN(I_XS), true, nullptr, nullptr, nullptr, nullptr, nullptr, PIN(I_NMIXPRE), m0 + 1024, m0, HB, false, true);
        } else {
            const int q = ph - 2, pair = q / 16, r = q % 16; const bool odd = r >= 8; const int l = 2 * pair + (odd ? 1 : 0), k = odd ? r - 8 : r;
            const float* ml = MOD + (size_t)l * 9 * 6144;
            const int kind = k < 3 ? (odd ? 10 + k : (k == 2 ? 8 : k)) : (k == 3 ? 2 : k == 4 ? 3 : k == 5 ? 4 : k == 6 ? 5 : 6);
            if (kind == 0) {
                pg8::Gemm g{HB, (const bf16*)(ws + WS_WINE) + (size_t)pair * EVEN_NP * 1024, M, EVEN_NP, 1024}; pg8::StaticOrder S; S.init(M, EVEN_NP, F.G, F.bid, 1024);
                pg8::EpiBf16<0> E{(bf16*)(ws + WS_BIG), EVEN_NP};
                pg8::gemm_phase<pg8::EpiBf16<0>, pg8::StaticOrder, true, true>(F.lds, g, S, E, F.tid);
            } else if (kind == 1) {
                scan_phase(F, P, pair);
            } else if (kind == 8) {
                scan_combine(F, P, pair);
            } else if (kind == 2) {
                const bf16* W = odd ? (const bf16*)(ws + WS_WOUTO) + (size_t)pair * 1024 * 1024 : (const bf16*)(ws + WS_WOUTE) + (size_t)pair * 1024 * 1024;
                { pg8::Gemm g{HB, W, M, 1024, 1024}; pg8::TailSplitOrder S; S.init(F.bid, 1024, 1);
                  pg8::EpiYsplit E{YB, (bf16*)(ws + WS_SLAB)};
                  pg8::gemm_phase<pg8::EpiYsplit, pg8::TailSplitOrder, true, true>(F.lds, g, S, E, F.tid); }
                REFRESH_ID();
                { pg8::Gemm g{HB, W, M, 1024, 1024}; pg8::TailSplitOrder S; S.init(F.bid, 1024, 2);
                  pg8::EpiYsplit E{YB, (bf16*)(PWS + WS_SLAB)};
                  pg8::gemm_phase<pg8::EpiYsplit, pg8::TailSplitOrder, true, true>(F.lds, g, S, E, F.tid); }
            } else if (kind == 3) {
                row_pass(F, PIN(I_XP), PIN(I_XS), l == 0, XBF, YB, SL, PIN(I_NMIXPOST) + l * 1024, ml + 2048, PIN(I_NMLPPRE) + l * 1024, ml + 4096, ml + 3072, HB, true, true);
            } else if (kind == 4) {
                pg8::Gemm g{HB, (const bf16*)(ws + WS_W1) + (size_t)l * 4096 * 1024, M, FF, 1024}; pg8::StaticOrder S; S.init(M, FF, F.G, F.bid, 1024);
                pg8::EpiBf16<1> E{(bf16*)(ws + WS_BIG), FF};
                pg8::gemm_phase<pg8::EpiBf16<1>, pg8::StaticOrder, true, true>(F.lds, g, S, E, F.tid);
            } else if (kind == 5) {
                { pg8::Gemm g{(const bf16*)(ws + WS_BIG), (const bf16*)(ws + WS_W2) + (size_t)l * 1024 * 4096, M, 1024, FF}; pg8::TailSplitOrder S; S.init(F.bid, FF, 1);
                  pg8::EpiYsplit E{YB, (bf16*)(ws + WS_SLAB)};
                  pg8::gemm_phase<pg8::EpiYsplit, pg8::TailSplitOrder, true, true>(F.lds, g, S, E, F.tid); }
                REFRESH_ID();
                { pg8::Gemm g{(const bf16*)(PWS + WS_BIG), (const bf16*)(PWS + WS_W2) + (size_t)l * 1024 * 4096, M, 1024, FF}; pg8::TailSplitOrder S; S.init(F.bid, FF, 2);
                  pg8::EpiYsplit E{(bf16*)(PWS + WS_Y), (bf16*)(PWS + WS_SLAB)};
                  pg8::gemm_phase<pg8::EpiYsplit, pg8::TailSplitOrder, true, true>(F.lds, g, S, E, F.tid); }
            } else if (kind == 6) {
                const float* mn = ml + 9 * 6144;
                if (l < 3) row_pass(F, nullptr, nullptr, false, XBF, YB, SL, PIN(I_NMLPPOST) + l * 1024, ml + 5120, PIN(I_NMIXPRE) + (l + 1) * 1024, mn + 1024, mn, HB, true, true);
                else { bar.bar = (unsigned*)(PWS + WS_CTL) + 4096; row_pass_final(F, bar, XBF, POUT + OUT_Y, YB, SL, PIN(I_NMLPPOST) + l * 1024, ml + 5120); }
            } else if (kind == 10) {
                pg8::Gemm g{HB, (const bf16*)(ws + WS_WINO) + (size_t)pair * ODD_NP * 1024, M, ODD_NP, 1024}; pg8::StaticOrder S; S.init(M, ODD_NP, F.G, F.bid, 1024);
                pg8::EpiOddIn E{(bf16*)(ws + WS_QN), (bf16*)(ws + WS_ACKV), (float*)(ws + WS_Y), POUT + OUT_CKV, POUT + OUT_KPE,
                                PIN(I_QAN) + pair * 256, PIN(I_KVAN) + pair * 256, pair};
                pg8::gemm_phase<pg8::EpiOddIn, pg8::StaticOrder, false, true>(F.lds, g, S, E, F.tid);
                REFRESH_ID(); cache_pass(F, P, pair);
            } else if (kind == 11) {
                kpe_pass(F, P, pair); REFRESH_ID();
                { pg8::Gemm g{(const bf16*)(ws + WS_QN), (const bf16*)(ws + WS_WQB) + (size_t)pair * 1536 * 256, M, 1536, 256}; pg8::StaticOrder S; S.init(M, 1536, F.G, F.bid, 256);
                  pg8::EpiBf16<0> E{(bf16*)(ws + WS_Q), 1536};
                  pg8::gemm_phase<pg8::EpiBf16<0>, pg8::StaticOrder, true, true>(F.lds, g, S, E, F.tid); }
                REFRESH_ID();
                { pg8::Gemm g{(const bf16*)(ws + WS_ACKV), (const bf16*)(ws + WS_WKVB) + (size_t)pair * 2048 * 256, MKV, 2048, 256}; pg8::StaticOrder S; S.init(MKV, 2048, F.G, F.bid, 256);
                  pg8::EpiBf16<0> E{(bf16*)(ws + WS_KV), 2048};
                  pg8::gemm_phase<pg8::EpiBf16<0>, pg8::StaticOrder, true, true>(F.lds, g, S, E, F.tid); }
            } else if (kind == 12) {
                attn_phase(F, P, pair);
            }
        }
        if (ph + 1 < ph_hi) { if (use_bar) { bar.bar = (unsigned*)(PWS + WS_CTL) + 4096; xcd_barrier(bar); } else { VM_WAIT(); __syncthreads(); } }
    }
}

extern "C" void kernel_launch(void* const* d_in, const int* in_sizes, int n_in, void* d_out, int out_size, void* d_ws, size_t ws_size, hipStream_t stream) {
    static int grid = 0;
    if (grid == 0) {
        if (n_in != 28 || out_size != 27787264 || ws_size < WS_END) { fprintf(stderr, "kernel_launch: unexpected shapes: n_in %d out %d ws %zu (need >= %zu)\n", n_in, out_size, ws_size, (size_t)WS_END); grid = -1; return; }
        int dev = 0, cus = 0, per_cu = 0;
        if (hipGetDevice(&dev) != hipSuccess || hipDeviceGetAttribute(&cus, hipDeviceAttributeMultiprocessorCount, dev) != hipSuccess) { grid = -1; return; }
        if (hipFuncSetAttribute((const void*)hyb_fwd, hipFuncAttributeMaxDynamicSharedMemorySize, LDS_BYTES) != hipSuccess) { fprintf(stderr, "kernel_launch: hipFuncSetAttribute failed\n"); grid = -1; return; }
        if (hipOccupancyMaxActiveBlocksPerMultiprocessor(&per_cu, (const void*)hyb_fwd, NWAVES * 64, LDS_BYTES) != hipSuccess || per_cu < 1) { fprintf(stderr, "kernel_launch: occupancy query reports %d\n", per_cu); }
        (void)hipGetLastError();
        grid = cus;
    }
    if (grid < 0) return;
    (void)hipMemsetAsync((char*)d_ws + WS_CTL, 0, CTL_ZERO_BYTES, stream);
    Params a{};
    for (int i = 0; i < 28; ++i) a.in[i] = (const float*)d_in[i];
    a.out = (float*)d_out; a.ws = (unsigned char*)d_ws;
    a.ph_lo = 0; a.ph_hi = N_PHASES; a.use_bar = 1; a.pad = 0;
    hipLaunchKernelGGL(hyb_fwd, dim3(grid), dim3(NWAVES * 64), LDS_BYTES, stream, a);
    const hipError_t le = hipPeekAtLastError();
    if (le != hipSuccess) fprintf(stderr, "kernel_launch: launch failed: %s\n", hipGetErrorName(le));
}
```

```cpp
#include <hip/hip_runtime.h>
#include <hip/hip_bf16.h>
#include <cstdio>
#include <cstdint>
namespace pg8 {
#define PG8_LAS __attribute__((address_space(3)))
typedef unsigned short bf16_t;
typedef short bf16x8 __attribute__((ext_vector_type(8)));
typedef float f32x4 __attribute__((ext_vector_type(4)));
typedef unsigned u32x4 __attribute__((ext_vector_type(4)));
constexpr int BM = 256, BK = 64, HALF = 128, HTB = HALF * BK * 2  , STAGE_BYTES = 8 * HTB, NXCD = 8, WGM = 8;

__host__ __device__ __forceinline__ int lds_byte(int r, int c) { const int st = (r >> 4) * 2 + (c >> 5), rr = r & 15, cc = c & 31, ob = rr * 64 + cc * 2; return st * 1024 + (ob ^ (((ob >> 9) & 1) << 5)); }
__host__ __device__ __forceinline__ void stage_rc(int b, int& R, int& C) { const int st = b / 1024, sb = b % 1024, swz = sb ^ (((sb >> 9) & 1) << 5); R = (st >> 1) * 16 + swz / 64; C = (st & 1) * 32 + (swz % 64) / 2; }
__host__ __device__ __forceinline__ int perm32(int rho) { const int n = rho >> 4, i = rho & 15; return 8 * (i >> 2) + 4 * n + (i & 3); }

struct Unit { int pm, pn, ks, kt0, nt; };
struct Gemm { const bf16_t* A; const bf16_t* Bt; int M, N, K; };

struct StaticOrder {
    int nM, nN, nwg, G, c, ntk;
    __host__ __device__ void init(int M, int N, int G_, int c_, int K) { nM = M / BM; nN = N / BM; nwg = nM * nN; G = G_; c = c_; ntk = K / BK; }
    __host__ __device__ bool next(int i, Unit& u) const {
        const long L = (long)i * G + c; if (L >= nwg) return false;
        int wgid = (int)L; { const int q = nwg / NXCD, r = nwg % NXCD, xcd = wgid % NXCD, off = wgid / NXCD; wgid = (xcd < r ? xcd * (q + 1) : r * (q + 1) + (xcd - r) * q) + off; }
        const int nig = WGM * nN, gid = wgid / nig, fm = gid * WGM, gsz = (nM - fm) < WGM ? (nM - fm) : WGM;
        u.pm = fm + ((wgid % nig) % gsz); u.pn = (wgid % nig) / gsz; u.ks = -1; u.kt0 = 0; u.nt = ntk; return true;
    }
    __device__ __forceinline__ void a_ready(const Unit&) const {}
    __device__ __forceinline__ void done(const Unit&) const {}
};


struct TailSplitOrder {
    int c, ntk, mode;
    __device__ void init(int c_, int K, int mode_) { c = c_; ntk = K / BK; mode = mode_; }
    __device__ __forceinline__ bool next(int i, Unit& u) const {
        const int xcd = c & 7, j = c >> 3;
        const int round = i + (mode == 2 ? 1 : 0); const bool tail = round != 0;
        u.pm = tail ? 64 + xcd * 2 + (j & 1) : xcd * 8 + (j & 7);
        u.pn = tail ? (j >> 1) & 3 : j >> 3;
        u.ks = tail ? j >> 3 : -1;
        u.nt = tail ? ntk >> 2 : ntk;
        u.kt0 = tail ? (j >> 3) * (ntk >> 2) : 0;
        return round == 0 ? mode != 2 : (round == 1 && mode != 1);
    }
    __device__ __forceinline__ void a_ready(const Unit&) const {}
    __device__ __forceinline__ void done(const Unit&) const {}
};

typedef float f32x2c_t __attribute__((ext_vector_type(2))); typedef __bf16 bf16x2c_t __attribute__((ext_vector_type(2)));
__device__ __forceinline__ unsigned cvt_pk_bf16(float lo, float hi) { f32x2c_t v = {lo, hi}; bf16x2c_t b = __builtin_convertvector(v, bf16x2c_t); return __builtin_bit_cast(unsigned, b); }

template <int ACT> struct EpiBf16 {
    static constexpr bool PERM = true, AFTER_DRAIN = false;
    bf16_t* O; int ldc;
    __device__ __forceinline__ void operator()(const f32x4 (&acc)[2][2][4][2], const Unit& u, int wr, int wc, int fr, int fq) const {
        const int row0 = u.pm * BM + wr * 64 + fr; const int col0 = u.pn * BM + wc * 32 + 8 * fq;
#pragma unroll
        for (int ai = 0; ai < 2; ++ai)
#pragma unroll
            for (int m = 0; m < 4; ++m) { bf16_t* rowp = O + (size_t)(row0 + ai * HALF + m * 16) * ldc + col0;
#pragma unroll
                for (int bj = 0; bj < 2; ++bj) { f32x4 v0 = acc[ai][bj][m][0], v1 = acc[ai][bj][m][1];
                    if (ACT == 1) {
#pragma unroll
                        for (int j = 0; j < 4; ++j) { const float a = fmaxf(v0[j], 0.f), b = fmaxf(v1[j], 0.f); v0[j] = a * a; v1[j] = b * b; } }
                    u32x4 w; w.x = cvt_pk_bf16(v0[0], v0[1]); w.y = cvt_pk_bf16(v0[2], v0[3]); w.z = cvt_pk_bf16(v1[0], v1[1]); w.w = cvt_pk_bf16(v1[2], v1[3]);
                    *(u32x4*)(rowp + bj * HALF) = w; } }
    }
};
struct EpiYsplit {
    static constexpr bool PERM = true, AFTER_DRAIN = false;
    bf16_t* Y; bf16_t* SL;
    __device__ __forceinline__ void operator()(const f32x4 (&acc)[2][2][4][2], const Unit& u, int wr, int wc, int fr, int fq) const {
        const int row0 = u.pm * BM + wr * 64 + fr; const int col0 = u.pn * BM + wc * 32 + 8 * fq;
        if (u.ks < 0) {
#pragma unroll
            for (int ai = 0; ai < 2; ++ai)
#pragma unroll
                for (int m = 0; m < 4; ++m) { bf16_t* rowp = Y + (size_t)(row0 + ai * HALF + m * 16) * 1024 + col0;
#pragma unroll
                    for (int bj = 0; bj < 2; ++bj) { const f32x4 v0 = acc[ai][bj][m][0], v1 = acc[ai][bj][m][1];
                        u32x4 w; w.x = cvt_pk_bf16(v0[0], v0[1]); w.y = cvt_pk_bf16(v0[2], v0[3]); w.z = cvt_pk_bf16(v1[0], v1[1]); w.w = cvt_pk_bf16(v1[2], v1[3]);
                        *(u32x4*)(rowp + bj * HALF) = w; } }
        } else {
            bf16_t* base = SL + (size_t)u.ks * (4096 * 1024);
#pragma unroll
            for (int ai = 0; ai < 2; ++ai)
#pragma unroll
                for (int m = 0; m < 4; ++m) { bf16_t* rowp = base + (size_t)(row0 - 16384 + ai * HALF + m * 16) * 1024 + col0;
#pragma unroll
                    for (int bj = 0; bj < 2; ++bj) { const f32x4 v0 = acc[ai][bj][m][0], v1 = acc[ai][bj][m][1];
                        u32x4 w; w.x = cvt_pk_bf16(v0[0], v0[1]); w.y = cvt_pk_bf16(v0[2], v0[3]); w.z = cvt_pk_bf16(v1[0], v1[1]); w.w = cvt_pk_bf16(v1[2], v1[3]);
                        *(u32x4*)(rowp + bj * HALF) = w; } }
        }
    }
};
struct EpiOddIn {
    static constexpr bool PERM = false, AFTER_DRAIN = true;
    bf16_t* QN; bf16_t* ACKV; float* KPERAW; float* out_ckv; float* out_kpe; const float* gq; const float* gkv; int li;
    __device__ __forceinline__ void fused(f32x4 (&acc)[2][2][4][2], const Unit& u, int wr, int wc, int fr, int fq, PG8_LAS unsigned char* lds, int wid, int lane) const {
        PG8_LAS float* P = (PG8_LAS float*)lds;
        if (u.pn < 2) {
#pragma unroll
            for (int ai = 0; ai < 2; ++ai)
#pragma unroll
                for (int m = 0; m < 4; ++m) { float s = 0.f;
#pragma unroll
                    for (int bj = 0; bj < 2; ++bj)
#pragma unroll
                        for (int n = 0; n < 2; ++n) { const f32x4 x = acc[ai][bj][m][n]; s += (x[0] * x[0] + x[1] * x[1]) + (x[2] * x[2] + x[3] * x[3]); }
                    s += __shfl_xor(s, 16); s += __shfl_xor(s, 32);
                    if (fq == 0) P[(ai * HALF + wr * 64 + m * 16 + fr) * 4 + wc] = s; }
        }
        asm volatile("s_waitcnt lgkmcnt(0)" ::: "memory"); __builtin_amdgcn_s_barrier(); asm volatile("" ::: "memory");
        if (u.pn < 2) {
            const float* gv = u.pn == 0 ? gq : gkv;
#pragma unroll
            for (int ai = 0; ai < 2; ++ai)
#pragma unroll
                for (int m = 0; m < 4; ++m) { const int r = ai * HALF + wr * 64 + m * 16 + fr; const int grow = u.pm * BM + r;
                    const float tot = (P[r * 4 + 0] + P[r * 4 + 1]) + (P[r * 4 + 2] + P[r * 4 + 3]);
                    const float rstd = 1.0f / sqrtf(tot * (1.0f / 256.0f) + 1e-6f);
                    const int drow = grow < 4096 ? grow : 4096 + ((grow - 4096) >> 11) * 2304 + 256 + ((grow - 4096) & 2047);
#pragma unroll
                    for (int bj = 0; bj < 2; ++bj)
#pragma unroll
                        for (int n = 0; n < 2; ++n) { const int col = bj * HALF + wc * 32 + n * 16 + 4 * fq; const f32x4 g = *(const f32x4*)(gv + col);
                            const f32x4 v = acc[ai][bj][m][n] * rstd * g;
                            unsigned long long w = (unsigned long long)cvt_pk_bf16(v[0], v[1]) | ((unsigned long long)cvt_pk_bf16(v[2], v[3]) << 32);
                            if (u.pn == 0) *(unsigned long long*)(QN + (size_t)grow * 256 + col) = w;
                            else { *(unsigned long long*)(ACKV + (size_t)drow * 256 + col) = w;
                                   if (grow < 4096) *(f32x4*)(out_ckv + ((size_t)((grow >> 8) * 2 + li) * 256 + (grow & 255)) * 256 + col) = v; } } }
        } else if (wc < 2) {
#pragma unroll
            for (int ai = 0; ai < 2; ++ai)
#pragma unroll
                for (int m = 0; m < 4; ++m) { const int r = ai * HALF + wr * 64 + m * 16 + fr; const int grow = u.pm * BM + r;
#pragma unroll
                    for (int n = 0; n < 2; ++n) { const int col = wc * 32 + n * 16 + 4 * fq; const f32x4 v = acc[ai][0][m][n];
                        *(f32x4*)(KPERAW + (size_t)grow * 64 + col) = v;
                        if (grow < 4096) *(f32x4*)(out_kpe + ((size_t)((grow >> 8) * 2 + li) * 256 + (grow & 255)) * 64 + col) = v; } }
        }
    }
};

template <class Epi, class Sched, bool ALIGN_EPI = false, bool SP2 = false>
__device__ __forceinline__ void gemm_phase(PG8_LAS unsigned char* lds, const Gemm g, const Sched& S, const Epi& E, const int tid) {
    const int  wid = __builtin_amdgcn_readfirstlane(tid >> 6), lane = tid & 63, wr = wid >> 2, wc = wid & 3, fr = lane & 15, fq = lane >> 4;
    const int K = g.K;
    unsigned voffA[2], voffB[2];
#pragma unroll
    for (int i = 0; i < 2; ++i) { int R, C; stage_rc(tid * 16 + i * 8192, R, C); const int Rb = Epi::PERM ? ((R & ~31) + perm32(R & 31)) : R;
        voffA[i] = (unsigned)(R * K + C) * 2u; voffB[i] = (unsigned)(Rb * K + C) * 2u; }
    const size_t kstep = (size_t)(BK * 2);
    const size_t hstep = (size_t)HALF * K * 2;
    const size_t tstep = 2 * hstep;
    const unsigned ldsw = (unsigned)wid * 1024u;
    const int aoff = lds_byte(wr * 64 + fr, fq * 8), boff = lds_byte(wc * 32 + fr, fq * 8);
#define PG8_SA(b, h) (((b) * 2 + (h)) * HTB)
#define PG8_SB(b, h) ((4 + (b) * 2 + (h)) * HTB)
#define PG8_STAGE(bufoff, gbase, voff) do { _Pragma("unroll") for (int _i = 0; _i < 2; ++_i) \
        __builtin_amdgcn_global_load_lds((const unsigned*)((const char*)(gbase) + (voff)[_i]), (PG8_LAS unsigned*)(lds + (bufoff) + ldsw + _i * 8192), 16, 0, 0); } while (0)
#define PG8_LDA(dst, b, h) do { _Pragma("unroll") for (int m = 0; m < 4; ++m) _Pragma("unroll") for (int k = 0; k < 2; ++k) dst[m][k] = *(const PG8_LAS bf16x8*)(lds + PG8_SA(b, h) + aoff + m * 2048 + k * 1024); } while (0)
#define PG8_LDB(dst, b, h) do { _Pragma("unroll") for (int n = 0; n < 2; ++n) _Pragma("unroll") for (int k = 0; k < 2; ++k) dst[n][k] = *(const PG8_LAS bf16x8*)(lds + PG8_SB(b, h) + boff + n * 2048 + k * 1024); } while (0)
#define PG8_MMA(ai, bj, At, Bt) do { __builtin_amdgcn_s_setprio(1); _Pragma("unroll") for (int m = 0; m < 4; ++m) _Pragma("unroll") for (int n = 0; n < 2; ++n) _Pragma("unroll") for (int k = 0; k < 2; ++k) \
        acc[ai][bj][m][n] = __builtin_amdgcn_mfma_f32_16x16x32_bf16(Bt[n][k], At[m][k], acc[ai][bj][m][n], 0, 0, 0); __builtin_amdgcn_s_setprio(0); } while (0)
#define PG8_WAIT_V(n) asm volatile("s_waitcnt vmcnt(" #n ")" ::: "memory")
#define PG8_WAIT_L(n) asm volatile("s_waitcnt lgkmcnt(" #n ")" ::: "memory")
#define PG8_BAR __builtin_amdgcn_s_barrier()
#define PG8_SCHED __builtin_amdgcn_sched_barrier(0)
    Unit cur, nxt; int ui = 0;
    if (!S.next(0, cur)) return;
    f32x4 acc[2][2][4][2];
#pragma unroll
    for (int a = 0; a < 2; ++a)
#pragma unroll
        for (int b = 0; b < 2; ++b)
#pragma unroll
            for (int m = 0; m < 4; ++m)
#pragma unroll
                for (int n = 0; n < 2; ++n) acc[a][b][m][n] = (f32x4){0.f, 0.f, 0.f, 0.f};
    bf16x8 At[4][2], B0[2][2], B1[2][2];
    const char* cA = (const char*)g.A + (size_t)cur.pm * tstep + (size_t)cur.kt0 * kstep; const char* cB = (const char*)g.Bt + (size_t)cur.pn * tstep + (size_t)cur.kt0 * kstep;
    S.a_ready(cur);
    if constexpr (SP2) {
        PG8_STAGE(PG8_SB(0, 0), cB, voffB); PG8_STAGE(PG8_SB(0, 1), cB + hstep, voffB); PG8_STAGE(PG8_SA(0, 0), cA, voffA); PG8_STAGE(PG8_SA(0, 1), cA + hstep, voffA);
        if (wr == 1) PG8_BAR;
        PG8_WAIT_V(2); PG8_BAR;
        PG8_STAGE(PG8_SB(1, 0), cB + kstep, voffB); PG8_STAGE(PG8_SA(1, 0), cA + kstep, voffA); PG8_STAGE(PG8_SB(1, 1), cB + hstep + kstep, voffB);
        PG8_WAIT_V(6); PG8_BAR;
    } else {
        PG8_STAGE(PG8_SB(0, 0), cB, voffB); PG8_STAGE(PG8_SA(0, 0), cA, voffA); PG8_STAGE(PG8_SB(0, 1), cB + hstep, voffB); PG8_STAGE(PG8_SA(0, 1), cA + hstep, voffA);
        if (wr == 1) PG8_BAR;
        PG8_WAIT_V(4); PG8_BAR;
        PG8_STAGE(PG8_SB(1, 0), cB + kstep, voffB); PG8_STAGE(PG8_SA(1, 0), cA + kstep, voffA); PG8_STAGE(PG8_SB(1, 1), cB + hstep + kstep, voffB);
        PG8_WAIT_V(6); PG8_BAR;
    }
    for (;;) {
        const bool has_next = S.next(ui + 1, nxt);
        const char* nA = has_next ? (const char*)g.A + (size_t)nxt.pm * tstep + (size_t)nxt.kt0 * kstep : cA; const char* nB = has_next ? (const char*)g.Bt + (size_t)nxt.pn * tstep + (size_t)nxt.kt0 * kstep : cB;
        const int nt = cur.nt;
        for (int t = 0; t < nt; t += 2) {
            const bool last = (t == nt - 2);
            const char* a1 = cA + (size_t)(t + 1) * kstep;
            const char* a2 = last ? nA : cA + (size_t)(t + 2) * kstep; const char* b2 = last ? nB : cB + (size_t)(t + 2) * kstep;
            const char* a3 = a2 + kstep; const char* b3 = b2 + kstep;
            if (last && has_next) S.a_ready(nxt);
            if constexpr (SP2) {
            PG8_LDB(B0, 0, 0); PG8_LDB(B1, 0, 1); PG8_SCHED; PG8_LDA(At, 0, 0); PG8_STAGE(PG8_SA(1, 1), a1 + hstep, voffA);
            PG8_WAIT_V(8); PG8_WAIT_L(0); PG8_BAR; PG8_MMA(0, 0, At, B0); PG8_MMA(0, 1, At, B1); PG8_BAR; PG8_SCHED;
            PG8_LDA(At, 0, 1); PG8_STAGE(PG8_SB(0, 0), b2, voffB); PG8_STAGE(PG8_SB(0, 1), b2 + hstep, voffB); PG8_STAGE(PG8_SA(0, 0), a2, voffA);
            PG8_WAIT_V(8); PG8_WAIT_L(0); PG8_BAR; PG8_MMA(1, 0, At, B0); PG8_MMA(1, 1, At, B1); PG8_BAR; PG8_SCHED;
            PG8_LDB(B0, 1, 0); PG8_LDB(B1, 1, 1); PG8_SCHED; PG8_LDA(At, 1, 0); PG8_STAGE(PG8_SA(0, 1), a2 + hstep, voffA);
            PG8_WAIT_V(8); PG8_WAIT_L(0); PG8_BAR; PG8_MMA(0, 0, At, B0); PG8_MMA(0, 1, At, B1); PG8_BAR; PG8_SCHED;
            PG8_LDA(At, 1, 1); PG8_STAGE(PG8_SB(1, 0), b3, voffB); PG8_STAGE(PG8_SB(1, 1), b3 + hstep, voffB); PG8_STAGE(PG8_SA(1, 0), a3, voffA);
            PG8_WAIT_V(8); PG8_WAIT_L(0); PG8_BAR; PG8_MMA(1, 0, At, B0); PG8_MMA(1, 1, At, B1); PG8_BAR; PG8_SCHED;
            } else {
            PG8_LDB(B0, 0, 0); PG8_SCHED; PG8_LDA(At, 0, 0); PG8_STAGE(PG8_SA(1, 1), a1 + hstep, voffA);
            PG8_WAIT_L(8); PG8_BAR; PG8_WAIT_L(0); PG8_MMA(0, 0, At, B0); PG8_BAR; PG8_SCHED;
            PG8_LDB(B1, 0, 1); PG8_STAGE(PG8_SB(0, 0), b2, voffB);
            PG8_BAR; PG8_WAIT_L(0); PG8_MMA(0, 1, At, B1); PG8_BAR;
            PG8_LDA(At, 0, 1); PG8_STAGE(PG8_SA(0, 0), a2, voffA);
            PG8_BAR; PG8_WAIT_L(0); PG8_MMA(1, 0, At, B0); PG8_BAR; PG8_SCHED;
            PG8_STAGE(PG8_SB(0, 1), b2 + hstep, voffB);
            PG8_WAIT_V(6); PG8_BAR; PG8_MMA(1, 1, At, B1); PG8_BAR;
            PG8_LDB(B0, 1, 0); PG8_SCHED; PG8_LDA(At, 1, 0); PG8_STAGE(PG8_SA(0, 1), a2 + hstep, voffA);
            PG8_WAIT_L(8); PG8_BAR; PG8_WAIT_L(0); PG8_MMA(0, 0, At, B0); PG8_BAR; PG8_SCHED;
            PG8_LDB(B1, 1, 1); PG8_STAGE(PG8_SB(1, 0), b3, voffB);
            PG8_BAR; PG8_WAIT_L(0); PG8_MMA(0, 1, At, B1); PG8_BAR;
            PG8_LDA(At, 1, 1); PG8_STAGE(PG8_SA(1, 0), a3, voffA);
            PG8_BAR; PG8_WAIT_L(0); PG8_MMA(1, 0, At, B0); PG8_BAR; PG8_SCHED;
            PG8_STAGE(PG8_SB(1, 1), b3 + hstep, voffB);
            PG8_WAIT_V(6); PG8_BAR; PG8_MMA(1, 1, At, B1); PG8_BAR;
            }
        }
        if constexpr (ALIGN_EPI) { if (wr == 0) PG8_BAR; }
        if constexpr (!Epi::AFTER_DRAIN) { E(acc, cur, wr, wc, fr, fq); S.done(cur); }
        if (!has_next) break;
#pragma unroll
        for (int a = 0; a < 2; ++a)
#pragma unroll
            for (int b = 0; b < 2; ++b)
#pragma unroll
                for (int m = 0; m < 4; ++m)
#pragma unroll
                    for (int n = 0; n < 2; ++n) acc[a][b][m][n] = (f32x4){0.f, 0.f, 0.f, 0.f};
        cur = nxt; cA = nA; cB = nB; ++ui;
        if constexpr (ALIGN_EPI) { if (wr == 1) PG8_BAR; }
    }
    PG8_WAIT_V(0);
    if constexpr (!ALIGN_EPI) { if (wr == 0) PG8_BAR; }
    PG8_BAR;
    if constexpr (Epi::AFTER_DRAIN) { E.fused(acc, cur, wr, wc, fr, fq, lds, wid, lane); S.done(cur); }
#undef PG8_SA
#undef PG8_SB
#undef PG8_STAGE
#undef PG8_LDA
#undef PG8_LDB
#undef PG8_MMA
#undef PG8_WAIT_V
#undef PG8_WAIT_L
#undef PG8_BAR
#undef PG8_SCHED
}
}

constexpr int NWAVES = 8;
constexpr int D = 1024, FF = 4096, M_CTX = 4096, M_LAT = 16384, M = M_CTX + M_LAT;
constexpr int L_LAT = 2048, L_CTX = 256, PAST = 256, LKV = PAST + L_LAT;
constexpr int MKV = M_CTX + 8 * LKV;
constexpr int EVEN_N = 3104, EVEN_NP = 3328, ODD_N = 576, ODD_NP = 768;
constexpr float EPS = 1e-6f;
constexpr int PC_QA = 0, PC_KA = 256, PC_VA = 512, PC_GA = 1024, PC_QB = 1536, PC_KB = 1792, PC_VB = 2048, PC_GB = 2560, PC_GK = 3072;
constexpr size_t OUT_Y = 0, OUT_CKV = 20971520, OUT_KPE = 23068672, OUT_SGLA = 23592960, OUT_SRET = 25690112;

constexpr size_t MiB = 1u << 20;
constexpr size_t WS_CTL = 0, CTL_ZERO_BYTES = 64 * 1024;
constexpr size_t WS_MOD = 1 * MiB;
constexpr size_t WS_ROPE = 2 * MiB;
constexpr size_t WS_KPE = 3 * MiB;
constexpr size_t WS_ACKV = 6 * MiB;
constexpr size_t WS_WINE = 18 * MiB;
constexpr size_t WS_WOUTE = 31 * MiB;
constexpr size_t WS_WINO = 35 * MiB;
constexpr size_t WS_WQB = 38 * MiB;
constexpr size_t WS_WKVB = 40 * MiB;
constexpr size_t WS_WOUTO = 42 * MiB;
constexpr size_t WS_W1 = 46 * MiB;
constexpr size_t WS_W2 = 78 * MiB;
constexpr size_t WS_HB = 110 * MiB;
constexpr size_t WS_Y = 150 * MiB;
constexpr size_t WS_BIG = 190 * MiB;
constexpr size_t WS_Q = WS_BIG, WS_KV = WS_BIG + 60 * MiB, WS_QN = WS_BIG + 148 * MiB;
constexpr size_t WS_SLAB = 350 * MiB;
constexpr size_t WS_END = 382 * MiB;

constexpr int RING_BYTES = 131072;
constexpr int LDS_MISC = 155648;
constexpr int LDS_BYTES = 163840;

#define GAS __attribute__((address_space(1)))
#define LAS __attribute__((address_space(3)))
typedef unsigned short bf16;
typedef unsigned v4u __attribute__((ext_vector_type(4)));
typedef unsigned v2u __attribute__((ext_vector_type(2)));
typedef float f32x4 __attribute__((ext_vector_type(4)));
typedef float f32x16 __attribute__((ext_vector_type(16)));
typedef short bf16x8 __attribute__((ext_vector_type(8)));
typedef short s16x4 __attribute__((ext_vector_type(4)));
#define LDS_WAIT() asm volatile("s_waitcnt lgkmcnt(0)" ::: "memory")
#define VM_WAIT() asm volatile("s_waitcnt vmcnt(0)" ::: "memory")
typedef float f32x2_t __attribute__((ext_vector_type(2))); typedef __bf16 bf16x2_t __attribute__((ext_vector_type(2)));
__device__ __forceinline__ unsigned pk2(float lo, float hi) { f32x2_t v = {lo, hi}; bf16x2_t b = __builtin_convertvector(v, bf16x2_t); return __builtin_bit_cast(unsigned, b); }
__device__ __forceinline__ unsigned f2bf(float f) { return pk2(f, f) & 0xffffu; }
__device__ __forceinline__ float bflo(unsigned w) { return __builtin_bit_cast(float, w << 16); }
__device__ __forceinline__ float bfhi(unsigned w) { return __builtin_bit_cast(float, w & 0xffff0000u); }
__device__ __forceinline__ float wave_sum(float v) {
#pragma unroll
    for (int o = 1; o < 64; o <<= 1) v += __shfl_xor(v, o);
    return v;
}
__device__ __forceinline__ float siluf(float x) { return x * __builtin_amdgcn_rcpf(1.0f + __expf(-x)); }

#define XB_TMO      128
#define XB_XCNT(j)  (256  + 64 * (j))
#define XB_XSUB(j)  (1280 + 64 * (j))
#define XB_XGEN(j)  (2304 + 64 * (j))
#define XB_TOP      3328
#define XB_TOPGEN   3392
#define XCD_BAR_WORDS 3456
#define XB_SPIN_CAP (1u << 20)
__device__ __forceinline__ unsigned xb_ld(unsigned* p)              { return __hip_atomic_load(p, __ATOMIC_RELAXED, __HIP_MEMORY_SCOPE_AGENT); }
__device__ __forceinline__ unsigned xb_add(unsigned* p, unsigned v) { return __hip_atomic_fetch_add(p, v, __ATOMIC_RELAXED, __HIP_MEMORY_SCOPE_AGENT); }
__device__ __forceinline__ unsigned xb_xcc_id() { return (unsigned)__builtin_amdgcn_s_getreg((3 << 11) | 20) & 0xFu; }
#define XB_SPIN(cond, bar) do { unsigned _sp = 0; while (cond) { __builtin_amdgcn_s_sleep(1); \
    if ((++_sp & 255u) == 0u) { if (xb_ld(&(bar)[XB_TMO])) break; if (_sp > XB_SPIN_CAP) { atomicAdd(&(bar)[XB_TMO], 1u); break; } } } } while (0)
struct XcdBarrier { unsigned* bar; unsigned x; volatile LAS unsigned* st; };
__device__ __forceinline__ XcdBarrier xcd_barrier_post(unsigned* bar, volatile LAS unsigned* st) {
    XcdBarrier b; b.bar = bar; b.x = xb_xcc_id(); b.st = st;
    if (threadIdx.x == 0) (void)xb_add(&bar[XB_XCNT(b.x)], 1u);
    return b;
}
__device__ __forceinline__ void xcd_barrier_complete(unsigned* bar, unsigned x, unsigned& nloc, unsigned& nx) {
    const unsigned G = gridDim.x * gridDim.y * gridDim.z;
    unsigned sum, cnt, mine, sp = 0u;
    for (;;) {
        sum = 0u; cnt = 0u; mine = 0u;
#pragma unroll
        for (unsigned j = 0; j < 16; ++j) { const unsigned c = xb_ld(&bar[XB_XCNT(j)]); sum += c; cnt += (c > 0u) ? 1u : 0u; mine = (j == x) ? c : mine; }
        if (sum == G) break;
        __builtin_amdgcn_s_sleep(1);
        if ((++sp & 255u) == 0u) { if (xb_ld(&bar[XB_TMO])) break; if (sp > XB_SPIN_CAP) { atomicAdd(&bar[XB_TMO], 1u); break; } }
    }
    nloc = mine > 0u ? mine : 1u; nx = cnt > 0u ? cnt : 1u;
}
__device__ __forceinline__ void xcd_barrier(const XcdBarrier& b) {
    asm volatile("s_waitcnt vmcnt(0)" ::: "memory");
    __syncthreads();
    if (threadIdx.x == 0) {
        unsigned* bar = b.bar;
        __builtin_amdgcn_s_waitcnt(0);
        unsigned nloc = b.st[0], nx = b.st[1];
        if (nloc == 0u) { xcd_barrier_complete(bar, b.x, nloc, nx); b.st[0] = nloc; b.st[1] = nx; }
        const unsigned old = xb_add(&bar[XB_XSUB(b.x)], 1u);
        const unsigned gen = old / nloc;
        if (old + 1u == (gen + 1u) * nloc) {
            __builtin_amdgcn_fence(__ATOMIC_RELEASE, "agent");
            asm volatile("s_waitcnt vmcnt(0)" ::: "memory");
            const unsigned og = xb_add(&bar[XB_TOP], 1u);
            const unsigned tg = og / nx;
            if (og + 1u == (tg + 1u) * nx) xb_add(&bar[XB_TOPGEN], 1u);
            else XB_SPIN(xb_ld(&bar[XB_TOPGEN]) == tg, bar);
            __builtin_amdgcn_fence(__ATOMIC_ACQUIRE, "agent");
            xb_add(&bar[XB_XGEN(b.x)], 1u);
            asm volatile("s_waitcnt vmcnt(0)" ::: "memory");
        } else {
            XB_SPIN(xb_ld(&bar[XB_XGEN(b.x)]) == gen, bar);
            __builtin_amdgcn_fence(__ATOMIC_ACQUIRE, "agent");
            asm volatile("s_waitcnt vmcnt(0)" ::: "memory");
        }
    }
    __syncthreads();
}

struct Params { const float* in[28]; float* out; unsigned char* ws; int ph_lo, ph_hi, use_bar, pad; };
enum { I_XP = 0, I_XS, I_CCKV, I_CKPE, I_SGLA, I_SRET, I_C, I_CCTX, I_WADA, I_BADA, I_NMIXPRE, I_NMIXPOST, I_NMLPPRE, I_NMLPPOST,
       I_WINE, I_WGK2, I_BGK2, I_GLAN, I_RDEC, I_WOUTE, I_WINO, I_QAN, I_WQB, I_KVAN, I_WKVB, I_WOUTO, I_W1, I_W2 };
struct Frame { LAS unsigned char* lds; int tid, lane, wave, vcu, G, bid; };
constexpr int LDS_PT = LDS_MISC + 256;
__device__ __forceinline__ const void* ldp(LAS unsigned char* lds, int i) {
    const volatile LAS unsigned* p = (const volatile LAS unsigned*)(lds + LDS_PT) + 2 * i;
    const unsigned lo = __builtin_amdgcn_readfirstlane(p[0]), hi = __builtin_amdgcn_readfirstlane(p[1]);
    return (const void*)(const GAS void*)(((unsigned long long)hi << 32) | lo);
}
#define PIN(i) ((const float*)ldp(F.lds, (i)))
#define POUT ((float*)ldp(F.lds, 28))
#define PWS ((unsigned char*)ldp(F.lds, 29))

__device__ __forceinline__ void p0_transpose_item(const float* W, int K, int N, bf16* WT, int kb, int n0, int dn0, LAS float* scr, int lane) {
    const int k0 = 64 * kb;
    f32x4 wv[8];
#pragma unroll
    for (int i = 0; i < 8; ++i) wv[i] = __builtin_nontemporal_load((const f32x4*)(W + (size_t)(k0 + 8 * i + (lane >> 3)) * N + n0 + 4 * (lane & 7)));
#pragma unroll
    for (int i = 0; i < 8; ++i) { LAS float* d = scr + (8 * i + (lane >> 3)) * 33 + 4 * (lane & 7); d[0] = wv[i][0]; d[1] = wv[i][1]; d[2] = wv[i][2]; d[3] = wv[i][3]; }
    LDS_WAIT(); asm volatile("" ::: "memory");
    const int c = lane & 7;
#pragma unroll
    for (int j = 0; j < 4; ++j) { const int n = (lane >> 3) + 8 * j; const LAS float* s = scr + (8 * c) * 33 + n;
        v4u o; o.x = pk2(s[0 * 33], s[1 * 33]); o.y = pk2(s[2 * 33], s[3 * 33]); o.z = pk2(s[4 * 33], s[5 * 33]); o.w = pk2(s[6 * 33], s[7 * 33]);
        *(GAS v4u*)(WT + (size_t)(dn0 + n) * K + k0 + 8 * c) = o; }
    LDS_WAIT(); asm volatile("" ::: "memory");
}
__device__ __forceinline__ int even_col_map(int n0) { return n0 < 1536 ? n0 : (n0 < 1568 ? 3072 + (n0 - 1536) : n0 - 32); }

__device__ __forceinline__ void setup_work(Frame& F, const Params& P, int wgi, int nwg, int amask  , int mmask  , int eimask  , int eomask  , int omask  ) {
    unsigned char* ws = PWS;
    LAS float* scr = (LAS float*)(F.lds + F.wave * 16384);
    __syncthreads();
    {
        LAS float* S = (LAS float*)(F.lds);
        LAS float* R = (LAS float*)(F.lds + 40960);
        { const float* cp_ = PIN(I_C); const float* cc_ = PIN(I_CCTX);
          for (int i = F.tid; i < 9 * 1024; i += 512) { const int n = i >> 10, d = i & 1023; const float cv = n < 8 ? cp_[n * 1024 + d] : cc_[d]; S[i] = siluf(cv); } }
        const float* wada_ = PIN(I_WADA); const float* bada_ = PIN(I_BADA);
        __syncthreads();
        const int nl = __builtin_popcount(amask);
        for (int uu = wgi; uu < nl * 64; uu += nwg) {
            int li_ = uu >> 6, l = 0; { int m_ = amask; for (int k_ = 0; k_ < 4; ++k_) { if (m_ & 1) { if (li_ == 0) { l = k_; break; } --li_; } m_ >>= 1; } }
            const int cb = (uu & 63) * 96;
            if (F.tid < 384) {
                const int c4 = (F.tid % 24) * 4, part = F.tid / 24;
                const float* Wp = wada_ + ((size_t)l * 1024 + part * 64) * 6144 + cb + c4;
                f32x4 a[9];
#pragma unroll
                for (int n = 0; n < 9; ++n) a[n] = (f32x4){0.f, 0.f, 0.f, 0.f};
#pragma unroll 4
                for (int d = 0; d < 64; ++d) { const f32x4 w = __builtin_nontemporal_load((const f32x4*)(Wp + (size_t)d * 6144));
#pragma unroll
                    for (int n = 0; n < 9; ++n) a[n] += w * S[n * 1024 + part * 64 + d]; }
#pragma unroll
                for (int n = 0; n < 9; ++n) *(LAS f32x4*)(R + (part * 9 + n) * 96 + c4) = a[n];
            }
            __syncthreads();
            for (int i = F.tid; i < 9 * 96; i += 512) { const int n = i / 96, c = i % 96; float s = 0.f;
#pragma unroll
                for (int p = 0; p < 16; ++p) s += R[(p * 9 + n) * 96 + c];
                ((float*)(ws + WS_MOD))[((size_t)l * 9 + n) * 6144 + cb + c] = s + bada_[l * 6144 + cb + c]; }
            __syncthreads();
        }
    }
    {
        const int wk = wgi * NWAVES + F.wave, NW = nwg * NWAVES; int base = 0;
#define SEG(sel, count, ...) do { if (sel) { for (int q = (wk + NW - base % NW) % NW; q < (count); q += NW) { __VA_ARGS__; } base += (count); } } while (0)
        const int I_E = (1024 / 64) * (EVEN_N / 32), I_OE = 16 * 32, I_O = 16 * (ODD_N / 32), I_QB = 4 * 48, I_KVB = 4 * 64, I_M1 = 16 * 128, I_M2 = 64 * 32;
#pragma unroll
        for (int l = 0; l < 2; ++l) {
            SEG((eimask >> l) & 1, I_E, { const int nb = EVEN_N / 32, kb = q / nb, n0 = (q % nb) * 32;
                p0_transpose_item(PIN(I_WINE) + (size_t)l * 1024 * EVEN_N, 1024, EVEN_N, (bf16*)(ws + WS_WINE) + (size_t)l * EVEN_NP * 1024, kb, n0, even_col_map(n0), scr, F.lane); });
            SEG((eomask >> l) & 1, I_OE, { const int kb = q / 32, n0 = (q % 32) * 32;
                p0_transpose_item(PIN(I_WOUTE) + (size_t)l * 1024 * 1024, 1024, 1024, (bf16*)(ws + WS_WOUTE) + (size_t)l * 1024 * 1024, kb, n0, n0, scr, F.lane); });
            SEG((omask >> l) & 1, I_O, { const int nb = ODD_N / 32, kb = q / nb, n0 = (q % nb) * 32;
                p0_transpose_item(PIN(I_WINO) + (size_t)l * 1024 * ODD_N, 1024, ODD_N, (bf16*)(ws + WS_WINO) + (size_t)l * ODD_NP * 1024, kb, n0, n0, scr, F.lane); });
            SEG((omask >> l) & 1, I_QB, { const int kb = q / 48, n0 = (q % 48) * 32;
                p0_transpose_item(PIN(I_WQB) + (size_t)l * 256 * 1536, 256, 1536, (bf16*)(ws + WS_WQB) + (size_t)l * 1536 * 256, kb, n0, n0, scr, F.lane); });
            SEG((omask >> l) & 1, I_KVB, { const int kb = q / 64, n0 = (q % 64) * 32;
                p0_transpose_item(PIN(I_WKVB) + (size_t)l * 256 * 2048, 256, 2048, (bf16*)(ws + WS_WKVB) + (size_t)l * 2048 * 256, kb, n0, n0, scr, F.lane); });
            SEG((omask >> l) & 1, I_OE, { const int kb = q / 32, n0 = (q % 32) * 32;
                p0_transpose_item(PIN(I_WOUTO) + (size_t)l * 1024 * 1024, 1024, 1024, (bf16*)(ws + WS_WOUTO) + (size_t)l * 1024 * 1024, kb, n0, n0, scr, F.lane); });
        }
#pragma unroll
        for (int l = 0; l < 4; ++l) {
            SEG((mmask >> l) & 1, I_M1, { const int kb = q / 128, n0 = (q % 128) * 32;
                p0_transpose_item(PIN(I_W1) + (size_t)l * 1024 * 4096, 1024, 4096, (bf16*)(ws + WS_W1) + (size_t)l * 4096 * 1024, kb, n0, n0, scr, F.lane); });
            SEG((mmask >> l) & 1, I_M2, { const int kb = q / 32, n0 = (q % 32) * 32;
                p0_transpose_item(PIN(I_W2) + (size_t)l * 4096 * 1024, 4096, 1024, (bf16*)(ws + WS_W2) + (size_t)l * 1024 * 4096, kb, n0, n0, scr, F.lane); });
        }
#undef SEG
    }
    const int gt = wgi * 512 + F.tid, NGT = nwg * 512;
#pragma unroll
    for (int l = 0; l < 2; ++l) {
        if ((eimask >> l) & 1) for (int i = gt; i < 224 * 128; i += NGT) *(GAS v4u*)((bf16*)(ws + WS_WINE) + ((size_t)l * EVEN_NP + EVEN_N) * 1024 + (size_t)i * 8) = (v4u){0u, 0u, 0u, 0u};
        if ((omask >> l) & 1) for (int i = gt; i < 192 * 128; i += NGT) *(GAS v4u*)((bf16*)(ws + WS_WINO) + ((size_t)l * ODD_NP + ODD_N) * 1024 + (size_t)i * 8) = (v4u){0u, 0u, 0u, 0u};
    }
}
__device__ __forceinline__ void p0_prologue(Frame& F, const Params& P) {
    unsigned char* ws = PWS;
    setup_work(F, P, F.vcu, F.G, 0x5, 0x5, 0x3, 0x3, 0x0);
    const int gt = F.vcu * 512 + F.tid, NGT = F.G * 512;
    for (int i = gt; i < 2048 * 32; i += NGT) { const int t = i >> 5, j = i & 31; const float inv = powf(10000.0f, -(float)(j & 15) / 16.0f);
        const float ang = (float)(j < 16 ? (t >> 6) : (t & 63)) * inv;
        ((float*)(ws + WS_ROPE))[i] = cosf(ang); ((float*)(ws + WS_ROPE))[65536 + i] = sinf(ang); }
}

__device__ __forceinline__ void row_y(f32x4 (&yv)[4], const bf16* Y, const bf16* SL, int row, int l4) {
    if (row < 16384) {
#pragma unroll
        for (int j = 0; j < 4; ++j) { const v2u yw = __builtin_nontemporal_load((const v2u*)(Y + (size_t)row * D + l4 + 256 * j)); yv[j] = (f32x4){bflo(yw.x), bfhi(yw.x), bflo(yw.y), bfhi(yw.y)}; }
    } else {
        const bf16* sp = SL + (size_t)(row - 16384) * D + l4;
#pragma unroll
        for (int j = 0; j < 4; ++j) { const v2u w0 = __builtin_nontemporal_load((const v2u*)(sp + 256 * j)), w1 = __builtin_nontemporal_load((const v2u*)(sp + 4194304 + 256 * j)), w2 = __builtin_nontemporal_load((const v2u*)(sp + 2 * 4194304 + 256 * j)), w3 = __builtin_nontemporal_load((const v2u*)(sp + 3 * 4194304 + 256 * j));
            yv[j] = ((f32x4){bflo(w0.x), bfhi(w0.x), bflo(w0.y), bfhi(w0.y)} + (f32x4){bflo(w1.x), bfhi(w1.x), bflo(w1.y), bfhi(w1.y)}) +
                    ((f32x4){bflo(w2.x), bfhi(w2.x), bflo(w2.y), bfhi(w2.y)} + (f32x4){bflo(w3.x), bfhi(w3.x), bflo(w3.y), bfhi(w3.y)}); }
    }
}
struct RowVec { f32x4 gp[4], gt[4], gq[4], sc[4], sh[4]; };
__device__ __forceinline__ void row_post(f32x4 (&v)[4], const f32x4 (&yv)[4], const RowVec& R) {
    float s = 0.f;
#pragma unroll
    for (int j = 0; j < 4; ++j) s += (yv[j][0] * yv[j][0] + yv[j][1] * yv[j][1]) + (yv[j][2] * yv[j][2] + yv[j][3] * yv[j][3]);
    const float rstd = __builtin_amdgcn_rsqf(wave_sum(s) * (1.0f / 1024.0f) + EPS);
#pragma unroll
    for (int j = 0; j < 4; ++j) v[j] = v[j] + R.gt[j] * ((yv[j] * rstd) * R.gp[j]);
}
__device__ __forceinline__ void row_pass(Frame& F, const float* xa, const float* xb, bool xin_f32, bf16* XB, const bf16* Y, const bf16* SL, const float* g_post, const float* gate,
                                         const float* g_pre, const float* scale, const float* shift, bf16* H, bool has_post, bool has_pre) {
    const int gw = F.vcu * NWAVES + F.wave, NGW = F.G * NWAVES, l4 = F.lane * 4;
    RowVec R; int ncur = -1;
#pragma unroll
    for (int j = 0; j < 4; ++j) { R.gp[j] = has_post ? *(const f32x4*)(g_post + l4 + 256 * j) : (f32x4){0.f, 0.f, 0.f, 0.f}; R.gq[j] = has_pre ? *(const f32x4*)(g_pre + l4 + 256 * j) : (f32x4){0.f, 0.f, 0.f, 0.f};
        R.gt[j] = R.gp[j]; R.sc[j] = R.gp[j]; R.sh[j] = R.gp[j]; }
    for (int blk = gw; blk * 10 < M; blk += NGW) for (int i = 0; i < 10; i += 2) {
        const int row0 = blk * 10 + i; if (row0 >= M) break;
        const int n = row0 < M_CTX ? 8 : ((row0 - M_CTX) >> 11);
        if (n != ncur) { ncur = n;
#pragma unroll
            for (int j = 0; j < 4; ++j) { const int c = l4 + 256 * j;
                if (has_post) R.gt[j] = *(const f32x4*)(gate + (size_t)n * 6144 + c);
                if (has_pre) { R.sc[j] = *(const f32x4*)(scale + (size_t)n * 6144 + c); R.sh[j] = *(const f32x4*)(shift + (size_t)n * 6144 + c); } } }
        f32x4 v[2][4], yv[2][4];
#pragma unroll
        for (int q = 0; q < 2; ++q) { const int row = row0 + q;
            if (xin_f32) { const float* xr = row < M_CTX ? xa + (size_t)row * D : xb + (size_t)(row - M_CTX) * D;
#pragma unroll
                for (int j = 0; j < 4; ++j) v[q][j] = __builtin_nontemporal_load((const f32x4*)(xr + l4 + 256 * j));
            } else {
#pragma unroll
                for (int j = 0; j < 4; ++j) { const v2u xw = __builtin_nontemporal_load((const v2u*)(XB + (size_t)row * D + l4 + 256 * j)); v[q][j] = (f32x4){bflo(xw.x), bfhi(xw.x), bflo(xw.y), bfhi(xw.y)}; }
            }
            if (has_post) row_y(yv[q], Y, SL, row, l4); }
#pragma unroll
        for (int q = 0; q < 2; ++q) { const int row = row0 + q;
            if (has_post) {
                row_post(v[q], yv[q], R);
#pragma unroll
                for (int j = 0; j < 4; ++j) *(v2u*)(XB + (size_t)row * D + l4 + 256 * j) = (v2u){pk2(v[q][j][0], v[q][j][1]), pk2(v[q][j][2], v[q][j][3])};
            }
            if (has_pre) {
                float s = 0.f;
#pragma unroll
                for (int j = 0; j < 4; ++j) s += (v[q][j][0] * v[q][j][0] + v[q][j][1] * v[q][j][1]) + (v[q][j][2] * v[q][j][2] + v[q][j][3] * v[q][j][3]);
                const float rstd = __builtin_amdgcn_rsqf(wave_sum(s) * (1.0f / 1024.0f) + EPS);
#pragma unroll
                for (int j = 0; j < 4; ++j) { const f32x4 h = ((v[q][j] * rstd) * R.gq[j]) * (1.0f + R.sc[j]) + R.sh[j];
                    *(v2u*)(H + (size_t)row * D + l4 + 256 * j) = (v2u){pk2(h[0], h[1]), pk2(h[2], h[3])}; }
            } }
    }
}
__device__ __forceinline__ void row_pass_final(Frame& F, const XcdBarrier& bar, const bf16* XB, float* OUT, const bf16* Y, const bf16* SL, const float* g_post, const float* gate) {
    const int gw = F.vcu * NWAVES + F.wave, l4 = F.lane * 4;
    v2u xw[10][4];
#pragma unroll
    for (int i = 0; i < 10; ++i) { const int row = gw * 10 + i;
        if (row < M) {
#pragma unroll
            for (int j = 0; j < 4; ++j) xw[i][j] = __builtin_nontemporal_load((const v2u*)(XB + (size_t)row * D + l4 + 256 * j));
        } }
    xcd_barrier(bar);
    RowVec R; int ncur = -1;
#pragma unroll
    for (int j = 0; j < 4; ++j) { R.gp[j] = *(const f32x4*)(g_post + l4 + 256 * j); R.gt[j] = R.gp[j]; }
#pragma unroll
    for (int i = 0; i < 10; ++i) { const int row = gw * 10 + i;
        if (row < M) {
            const int n = row < M_CTX ? 8 : ((row - M_CTX) >> 11);
            if (n != ncur) { ncur = n;
#pragma unroll
                for (int j = 0; j < 4; ++j) R.gt[j] = *(const f32x4*)(gate + (size_t)n * 6144 + l4 + 256 * j); }
            f32x4 v[4], yv[4];
#pragma unroll
            for (int j = 0; j < 4; ++j) v[j] = (f32x4){bflo(xw[i][j].x), bfhi(xw[i][j].x), bflo(xw[i][j].y), bfhi(xw[i][j].y)};
            row_y(yv, Y, SL, row, l4); row_post(v, yv, R);
#pragma unroll
            for (int j = 0; j < 4; ++j) *(f32x4*)(OUT + (size_t)row * D + l4 + 256 * j) = v[j];
        } }
}

__device__ __forceinline__ int crow(int r, int hi) { return (r & 3) + 8 * (r >> 2) + 4 * hi; }
__device__ __forceinline__ unsigned cvtpk(float lo, float hi) { return pk2(lo, hi); }
#define SBAR() __builtin_amdgcn_sched_barrier(0)
__device__ __forceinline__ int vst_row(int k, int NB) { const int kk = (k & ~0xC) | ((k & 4) << 1) | ((k & 8) >> 1); return (kk >> 3) * NB * 512 + (kk & 7) * 64; }
__device__ __forceinline__ int vst(int k, int c, int NB) { return vst_row(k, NB) + (c >> 5) * 512 + (c & 31) * 2; }
__device__ __forceinline__ int v_rd_base(int lane) { return ((lane & 3) << 3) | (((lane >> 2) & 3) << 6) | (((lane >> 4) & 1) << 5) | (((lane >> 5) & 1) << 8); }
template <int OFF> __device__ __forceinline__ s16x4 tr_read(unsigned vb) { s16x4 r; asm volatile("ds_read_b64_tr_b16 %0, %1 offset:%2" : "=&v"(r) : "v"(vb), "i"(OFF) : "memory"); return r; }
#define PKF(L, H) ((bf16x8){L[0], L[1], L[2], L[3], H[0], H[1], H[2], H[3]})
#define PK4(P, BASE, OUT) do { unsigned a0_ = cvtpk(P[BASE + 0], P[BASE + 1]), a1_ = cvtpk(P[BASE + 2], P[BASE + 3]);   \
    unsigned b0_ = cvtpk(P[BASE + 4], P[BASE + 5]), b1_ = cvtpk(P[BASE + 6], P[BASE + 7]);                              \
    auto r0_ = __builtin_amdgcn_permlane32_swap(a0_, b0_, false, false); auto r1_ = __builtin_amdgcn_permlane32_swap(a1_, b1_, false, false); \
    v4u w_ = {r0_[0], r1_[0], r0_[1], r1_[1]}; OUT = __builtin_bit_cast(bf16x8, w_); } while (0)
__device__ __forceinline__ float fexp(float x) { return __builtin_amdgcn_exp2f(x * 1.4426950408889634f); }
__device__ __forceinline__ float logsig(float x) { return fminf(x, 0.f) - 0.6931471805599453f * __builtin_amdgcn_logf(1.0f + __builtin_amdgcn_exp2f(-1.4426950408889634f * fabsf(x))); }

constexpr int SC_T = 0  , SC_TSZ = 32768, SC_QD = 0, SC_KI = 8192, SC_VT = 16384, SC_ST = 65536, SC_BT = 81920  , SC_TOT = 114688, SC_DL = 115200  ;
__device__ __forceinline__ void scan_phase(Frame& F, const Params& P, int li) {
    unsigned char* ws = PWS;
    const bf16* PROJ = (const bf16*)(ws + WS_BIG);
    const float* ROPE = (const float*)(ws + WS_ROPE);
    LAS unsigned char* G = F.lds;
    const unsigned gaddr = (unsigned)(uintptr_t)G;
    const bool isP = F.wave >= 4; const int gw4 = F.wave & 3;
    const int ri = gw4 >> 1, dh = gw4 & 1;
#define SC_BAR() do { asm volatile("s_waitcnt lgkmcnt(0)" ::: "memory"); __builtin_amdgcn_s_barrier(); asm volatile("" ::: "memory"); } while (0)
#define SC_TOK(c, i) (dir == 0 ? 64 * (c) + (i) : L - 1 - (64 * (c) + (i)))
    for (int u0 = F.bid; u0 < 256; u0 += F.G) for (int kk_ = 0; kk_ < (u0 < 128 ? 1 : 2); ++kk_) {
        __syncthreads();
        const bool lat = u0 < 128; const int u = lat ? u0 : 2 * (u0 - 128) + kk_;
        const int sb = u >> 4, hh = (u >> 1) & 7, dir = u & 1;
        const int L = lat ? L_LAT : L_CTX, row0 = lat ? M_CTX + sb * L_LAT : sb * L_CTX, NC = L / 64;
        const bool gla = hh < 4; const int h = hh & 3;
        const int qc = (gla ? PC_QA : PC_QB) + h * 64, kc = (gla ? PC_KA : PC_KB) + h * 64, vc = (gla ? PC_VA : PC_VB) + h * 128, gkc = PC_GK + dir * 16;
        bf16* OUT = (bf16*)(ws + (dir == 0 ? WS_Y : WS_HB));
        const float* rdec_p = PIN(I_RDEC); const float* wgk2_p = PIN(I_WGK2); const float* bgk2_p = PIN(I_BGK2);
        const float lgr = gla ? 0.f : -fexp(rdec_p[(li * 2 + dir) * 4 + h]);
        f32x16 sacc[2]; sacc[0] = f32x16{}; sacc[1] = f32x16{}; v4u w2f = {0u, 0u, 0u, 0u}; float gbias = 0.f;
        { int t0_ = F.tid; asm volatile("" : "+v"(t0_)); const int lane = t0_ & 63, r32 = lane & 31, hi = lane >> 5;
          if (isP) {
              if (gla) { const int kcol = h * 64 + 32 * (gw4 & 1) + r32; const float* wp_ = wgk2_p + ((size_t)(li * 2 + dir) * 16 + 8 * hi) * 256 + kcol;
                  w2f = (v4u){pk2(wp_[0], wp_[256]), pk2(wp_[512], wp_[768]), pk2(wp_[1024], wp_[1280]), pk2(wp_[1536], wp_[1792])};
                  gbias = bgk2_p[(li * 2 + dir) * 256 + kcol]; }
              else if (t0_ < 256 + 192) ((LAS float*)(G + SC_DL))[t0_ - 256] = fexp(64.0f * lgr);
          } else {
              const float* S0 = (gla ? PIN(I_SGLA) : PIN(I_SRET)) + ((size_t)((sb * 2 + li) * 2 + dir) * 4 + h) * 8192;
              if (lat) {
#pragma unroll
                  for (int d = 0; d < 2; ++d)
#pragma unroll
                      for (int r = 0; r < 16; ++r) sacc[d][r] = S0[(32 * ri + crow(r, hi)) * 128 + 32 * (2 * dh + d) + r32];
              }
#pragma unroll
              for (int d = 0; d < 2; ++d)
#pragma unroll
                  for (int r = 0; r < 16; r += 2) { const unsigned w = pk2(sacc[d][r], sacc[d][r + 1]);
                      LAS unsigned char* sp_ = G + SC_ST + (hi + 4 * ri) * 2048 + (2 * dh + d) * 512 + r32 * 2 + ((r >> 3) & 1) * 4096 + ((r & 3) + 4 * ((r >> 2) & 1)) * 64;
                      *(LAS unsigned short*)sp_ = (unsigned short)w; *(LAS unsigned short*)(sp_ + 64) = (unsigned short)(w >> 16); }
          } }
        v4u pq0 = {}, pq1 = {}, pk0 = {}, pk1 = {}, pv[4] = {}; v4u pga = {0u, 0u, 0u, 0u}; float cs[16] = {}; float tsum = 0.f;
#define SC_LOADRAW(c) do { const unsigned ro_ = (unsigned)(row0 + SC_TOK(c, sti)) * (unsigned)(EVEN_NP * 2); const char* pc_ = (const char*)PROJ; \
        pq0 = *(const v4u*)(pc_ + (ro_ + (unsigned)(qc + 8 * c8) * 2u)); pq1 = *(const v4u*)(pc_ + (ro_ + (unsigned)(qc + 32 + 8 * c8) * 2u)); \
        pk0 = *(const v4u*)(pc_ + (ro_ + (unsigned)(kc + 8 * c8) * 2u)); pk1 = *(const v4u*)(pc_ + (ro_ + (unsigned)(kc + 32 + 8 * c8) * 2u)); \
        _Pragma("unroll") for (int m_ = 0; m_ < 4; ++m_) pv[m_] = *(const v4u*)(pc_ + (ro_ + (unsigned)(vc + c8 * 32 + 8 * m_) * 2u)); } while (0)
#define SC_LOADGK(c) do { pga = *(const v4u*)((const char*)PROJ + ((unsigned)(row0 + SC_TOK(c, 32 * (gw4 >> 1) + r32)) * (unsigned)(EVEN_NP * 2) + (unsigned)(gkc + 8 * hi) * 2u)); } while (0)
        if (isP && gla) { int t0_ = F.tid; asm volatile("" : "+v"(t0_)); const int r32 = t0_ & 31, hi = (t0_ >> 5) & 1; SC_LOADGK(0); }
        for (int s = -3; s < NC; ++s) {
            int tid_o = F.tid; asm volatile("" : "+v"(tid_o));
            const int lane = tid_o & 63, r32 = lane & 31, hi = lane >> 5, tgp = tid_o & 255, sti = tgp >> 2, c8 = tgp & 3;
            if (isP) {
                if (gla && s + 2 >= 0 && s + 2 < NC) {
                    const int th = gw4 >> 1, kq = 32 * (gw4 & 1) + r32; LAS float* BTw = (LAS float*)(G + SC_BT + ((s + 2) & 1) * 16384);
                    const float t0v = ((LAS float*)(G + SC_TOT))[kq]; const float pre = th ? t0v : 0.f;
#pragma unroll
                    for (int r = 0; r < 16; ++r) BTw[(32 * th + crow(r, hi)) * 64 + kq] = pre + cs[r];
                    if (th == 1 && hi == 0) ((LAS float*)(G + SC_DL))[((s + 2) % 3) * 64 + kq] = fexp(pre + tsum);
                }
                if (s + 1 >= 0 && s + 1 < NC) {
                    LAS unsigned char* T = G + SC_T + ((s + 1) & 1) * SC_TSZ;
                    float q[16], kk[16];
#define UNPK(dst, o, W_) do { const v4u w_ = (W_); dst[o + 0] = bflo(w_[0]); dst[o + 1] = bfhi(w_[0]); dst[o + 2] = bflo(w_[1]); dst[o + 3] = bfhi(w_[1]); dst[o + 4] = bflo(w_[2]); dst[o + 5] = bfhi(w_[2]); dst[o + 6] = bflo(w_[3]); dst[o + 7] = bfhi(w_[3]); } while (0)
                    UNPK(q, 0, pq0); UNPK(q, 8, pq1); UNPK(kk, 0, pk0); UNPK(kk, 8, pk1);
                    if (gla) {
                        const LAS float* BTr = (const LAS float*)(G + SC_BT + ((s + 1) & 1) * 16384) + sti * 64 + 8 * c8;
                        const f32x4 x0 = *(const LAS f32x4*)BTr, x1 = *(const LAS f32x4*)(BTr + 4), x2 = *(const LAS f32x4*)(BTr + 32), x3 = *(const LAS f32x4*)(BTr + 36);
#pragma unroll
                        for (int e = 0; e < 4; ++e) { const float e0 = fexp(x0[e]), e1 = fexp(x1[e]), e2 = fexp(x2[e]), e3 = fexp(x3[e]);
                            q[e] *= 0.125f * e0; kk[e] *= __builtin_amdgcn_rcpf(e0); q[4 + e] *= 0.125f * e1; kk[4 + e] *= __builtin_amdgcn_rcpf(e1);
                            q[8 + e] *= 0.125f * e2; kk[8 + e] *= __builtin_amdgcn_rcpf(e2); q[12 + e] *= 0.125f * e3; kk[12 + e] *= __builtin_amdgcn_rcpf(e3); }
                    } else {
                        if (lat) {
                            const float* cp = ROPE + (size_t)SC_TOK(s + 1, sti) * 32 + 8 * c8; const f32x4 c0 = *(const f32x4*)cp, c1 = *(const f32x4*)(cp + 4), s0 = *(const f32x4*)(cp + 65536), s1 = *(const f32x4*)(cp + 65540);
#pragma unroll
                            for (int e = 0; e < 8; ++e) { const float c = e < 4 ? c0[e & 3] : c1[e & 3], sn = e < 4 ? s0[e & 3] : s1[e & 3];
                                const float q1 = q[e], q2 = q[8 + e]; q[e] = q1 * c - q2 * sn; q[8 + e] = q1 * sn + q2 * c;
                                const float k1 = kk[e], k2 = kk[8 + e]; kk[e] = k1 * c - k2 * sn; kk[8 + e] = k1 * sn + k2 * c; }
                        }
                        const float bb = (float)(sti + 1) * lgr, eb = fexp(bb), ek = 0.125f * __builtin_amdgcn_rcpf(eb);
#pragma unroll
                        for (int e = 0; e < 16; ++e) { q[e] *= eb; kk[e] *= ek; }
                    }
                    *(LAS v4u*)(T + SC_QD + vst(sti, 8 * c8, 2)) = (v4u){pk2(q[0], q[1]), pk2(q[2], q[3]), pk2(q[4], q[5]), pk2(q[6], q[7])};
                    *(LAS v4u*)(T + SC_QD + vst(sti, 32 + 8 * c8, 2)) = (v4u){pk2(q[8], q[9]), pk2(q[10], q[11]), pk2(q[12], q[13]), pk2(q[14], q[15])};
                    *(LAS v4u*)(T + SC_KI + vst(sti, 8 * c8, 2)) = (v4u){pk2(kk[0], kk[1]), pk2(kk[2], kk[3]), pk2(kk[4], kk[5]), pk2(kk[6], kk[7])};
                    *(LAS v4u*)(T + SC_KI + vst(sti, 32 + 8 * c8, 2)) = (v4u){pk2(kk[8], kk[9]), pk2(kk[10], kk[11]), pk2(kk[12], kk[13]), pk2(kk[14], kk[15])};
#pragma unroll
                    for (int m = 0; m < 4; ++m) *(LAS v4u*)(T + SC_VT + vst(sti, c8 * 32 + 8 * m, 4)) = pv[m];
                }
                if (s + 2 >= 0 && s + 2 < NC) SC_LOADRAW(s + 2);
            } else if (s >= 0) {
                LAS unsigned char* T = G + SC_T + (s & 1) * SC_TSZ; const unsigned taddr = gaddr + SC_T + (s & 1) * SC_TSZ;
                bf16x8 qf[4]; bf16x8 pa0, pa1, pa2, pa3;
                { const int qb_ = vst_row(32 * ri + r32, 2) + 16 * hi;
                  qf[0] = *(const LAS bf16x8*)(T + SC_QD + qb_); qf[1] = *(const LAS bf16x8*)(T + SC_QD + qb_ + 32); qf[2] = *(const LAS bf16x8*)(T + SC_QD + qb_ + 512); qf[3] = *(const LAS bf16x8*)(T + SC_QD + qb_ + 544); }
                { f32x16 p0 = {}, p1 = {};
                  const int kb0 = vst_row(r32, 2) + 16 * hi, kb1 = vst_row(32 + r32, 2) + 16 * hi;
                  { const bf16x8 a0 = *(const LAS bf16x8*)(T + SC_KI + kb0), a1 = *(const LAS bf16x8*)(T + SC_KI + kb0 + 32), a2 = *(const LAS bf16x8*)(T + SC_KI + kb0 + 512), a3 = *(const LAS bf16x8*)(T + SC_KI + kb0 + 544);
                    p0 = __builtin_amdgcn_mfma_f32_32x32x16_bf16(a0, qf[0], p0, 0, 0, 0); p0 = __builtin_amdgcn_mfma_f32_32x32x16_bf16(a1, qf[1], p0, 0, 0, 0);
                    p0 = __builtin_amdgcn_mfma_f32_32x32x16_bf16(a2, qf[2], p0, 0, 0, 0); p0 = __builtin_amdgcn_mfma_f32_32x32x16_bf16(a3, qf[3], p0, 0, 0, 0); }
                  if (ri == 1) {
                      const bf16x8 c0 = *(const LAS bf16x8*)(T + SC_KI + kb1), c1 = *(const LAS bf16x8*)(T + SC_KI + kb1 + 32), c2 = *(const LAS bf16x8*)(T + SC_KI + kb1 + 512), c3 = *(const LAS bf16x8*)(T + SC_KI + kb1 + 544);
                      p1 = __builtin_amdgcn_mfma_f32_32x32x16_bf16(c0, qf[0], p1, 0, 0, 0); p1 = __builtin_amdgcn_mfma_f32_32x32x16_bf16(c1, qf[1], p1, 0, 0, 0);
                      p1 = __builtin_amdgcn_mfma_f32_32x32x16_bf16(c2, qf[2], p1, 0, 0, 0); p1 = __builtin_amdgcn_mfma_f32_32x32x16_bf16(c3, qf[3], p1, 0, 0, 0); }
#pragma unroll
                  for (int r = 0; r < 16; ++r) { const bool keep = crow(r, hi) <= r32; if (ri == 0) { p0[r] = keep ? p0[r] : 0.f; } else { p1[r] = keep ? p1[r] : 0.f; } }
                  PK4(p0, 0, pa0); PK4(p0, 8, pa1); PK4(p1, 0, pa2); PK4(p1, 8, pa3); }
                const unsigned vb = taddr + SC_VT + v_rd_base(lane) + dh * 1024, sbv = gaddr + SC_ST + v_rd_base(lane) + dh * 1024;
#define SC_FR4(dst, base, d) do { const s16x4 l0_ = tr_read<(d) * 512>(base), h0_ = tr_read<(d) * 512 + 2048>(base), l1_ = tr_read<(d) * 512 + 4096>(base), h1_ = tr_read<(d) * 512 + 4096 + 2048>(base); \
                  const s16x4 l2_ = tr_read<(d) * 512 + 8192>(base), h2_ = tr_read<(d) * 512 + 8192 + 2048>(base), l3_ = tr_read<(d) * 512 + 12288>(base), h3_ = tr_read<(d) * 512 + 12288 + 2048>(base); \
                  asm volatile("s_waitcnt lgkmcnt(0)" ::: "memory"); SBAR(); \
                  dst[0] = PKF(l0_, h0_); dst[1] = PKF(l1_, h1_); dst[2] = PKF(l2_, h2_); dst[3] = PKF(l3_, h3_); } while (0)
#define SC_OBLK(d) do { bf16x8 vf_[4], sf_[4]; SC_FR4(vf_, vb, d); SC_FR4(sf_, sbv, d); f32x16 o_ = {}; \
                  o_ = __builtin_amdgcn_mfma_f32_32x32x16_bf16(pa0, vf_[0], o_, 0, 0, 0); o_ = __builtin_amdgcn_mfma_f32_32x32x16_bf16(pa1, vf_[1], o_, 0, 0, 0); \
                  if (ri == 1) { o_ = __builtin_amdgcn_mfma_f32_32x32x16_bf16(pa2, vf_[2], o_, 0, 0, 0); o_ = __builtin_amdgcn_mfma_f32_32x32x16_bf16(pa3, vf_[3], o_, 0, 0, 0); } \
                  o_ = __builtin_amdgcn_mfma_f32_32x32x16_bf16(qf[0], sf_[0], o_, 0, 0, 0); o_ = __builtin_amdgcn_mfma_f32_32x32x16_bf16(qf[1], sf_[1], o_, 0, 0, 0); \
                  o_ = __builtin_amdgcn_mfma_f32_32x32x16_bf16(qf[2], sf_[2], o_, 0, 0, 0); o_ = __builtin_amdgcn_mfma_f32_32x32x16_bf16(qf[3], sf_[3], o_, 0, 0, 0); \
                  char* dst_ = (char*)OUT; \
                  _Pragma("unroll") for (int r = 0; r < 16; r += 2) { const int i_ = 32 * ri + crow(r, hi); const int t_ = SC_TOK(s, i_); const unsigned w_ = pk2(o_[r], o_[r + 1]); \
                      const unsigned a_ = (unsigned)(row0 + t_) * (unsigned)(D * 2) + (unsigned)(hh * 128 + 64 * dh + 32 * (d) + r32) * 2u; \
                      *(bf16*)(dst_ + a_) = (bf16)w_; *(bf16*)(dst_ + (dir == 0 ? a_ + (unsigned)(D * 2) : a_ - (unsigned)(D * 2))) = (bf16)(w_ >> 16); } SBAR(); } while (0)
                SC_OBLK(0); SC_OBLK(1);
            }
            SC_BAR();
            if (isP) {
                if (gla && s + 3 < NC) {
                    const int th = gw4 >> 1, kq = 32 * (gw4 & 1) + r32;
                    f32x16 gp;
#pragma unroll
                    for (int r = 0; r < 16; ++r) gp[r] = gbias;
                    gp = __builtin_amdgcn_mfma_f32_32x32x16_bf16(__builtin_bit_cast(bf16x8, pga), __builtin_bit_cast(bf16x8, w2f), gp, 0, 0, 0);
                    float g4[4], o4[4];
#pragma unroll
                    for (int j = 0; j < 4; ++j) { float run = 0.f;
#pragma unroll
                        for (int e = 0; e < 4; ++e) { run += logsig(gp[4 * j + e]) * (1.0f / 16.0f); cs[4 * j + e] = run; }
                        g4[j] = run; }
#pragma unroll
                    for (int j = 0; j < 4; ++j) o4[j] = __shfl_xor(g4[j], 32);
                    float acc_ = 0.f;
#pragma unroll
                    for (int j = 0; j < 4; ++j) { const float off = acc_ + (hi ? o4[j] : 0.f);
#pragma unroll
                        for (int e = 0; e < 4; ++e) cs[4 * j + e] += off;
                        acc_ += g4[j] + o4[j]; }
                    tsum = acc_;
                    if (hi == 0) ((LAS float*)(G + SC_TOT))[th * 64 + kq] = tsum;
                    if (s + 4 < NC) SC_LOADGK(s + 4);
                }
            } else if (s >= 0) {
                const unsigned taddr = gaddr + SC_T + (s & 1) * SC_TSZ;
                const unsigned vb = taddr + SC_VT + v_rd_base(lane) + dh * 1024, kt = taddr + SC_KI + v_rd_base(lane) + ri * 512;
                bf16x8 kf[4];
                { const s16x4 l0_ = tr_read<0>(kt), h0_ = tr_read<1024>(kt), l1_ = tr_read<2048>(kt), h1_ = tr_read<2048 + 1024>(kt), l2_ = tr_read<4096>(kt), h2_ = tr_read<4096 + 1024>(kt), l3_ = tr_read<6144>(kt), h3_ = tr_read<6144 + 1024>(kt);
                  asm volatile("s_waitcnt lgkmcnt(0)" ::: "memory"); SBAR();
                  kf[0] = PKF(l0_, h0_); kf[1] = PKF(l1_, h1_); kf[2] = PKF(l2_, h2_); kf[3] = PKF(l3_, h3_); }
                const int stb_ = (hi + 4 * ri) * 2048 + (2 * dh) * 512 + r32 * 2;
                const LAS float* DLr = (const LAS float*)(G + SC_DL) + (s % 3) * 64;
#define SC_SBLK(d) do { bf16x8 vf_[4]; SC_FR4(vf_, vb, d); \
                  _Pragma("unroll") for (int ks = 0; ks < 4; ++ks) sacc[d] = __builtin_amdgcn_mfma_f32_32x32x16_bf16(kf[ks], vf_[ks], sacc[d], 0, 0, 0); \
                  _Pragma("unroll") for (int r = 0; r < 16; r += 2) { const int dk = 32 * ri + crow(r, hi); const float dl0 = DLr[dk], dl1 = DLr[dk + 1]; \
                      sacc[d][r] *= dl0; sacc[d][r + 1] *= dl1; const unsigned w_ = pk2(sacc[d][r], sacc[d][r + 1]); \
                      LAS unsigned char* sp_ = G + SC_ST + stb_ + (d) * 512 + ((r >> 3) & 1) * 4096 + ((r & 3) + 4 * ((r >> 2) & 1)) * 64; \
                      *(LAS unsigned short*)sp_ = (unsigned short)w_; *(LAS unsigned short*)(sp_ + 64) = (unsigned short)(w_ >> 16); } SBAR(); } while (0)
                SC_SBLK(0); SC_SBLK(1);
            }
            SC_BAR();
        }
        if (!lat && !isP) { int l2 = F.lane; asm volatile("" : "+v"(l2)); const int r32 = l2 & 31, hi = l2 >> 5; float* SO = POUT + (gla ? OUT_SGLA : OUT_SRET) + ((size_t)((sb * 2 + li) * 2 + dir) * 4 + h) * 8192;
#pragma unroll
            for (int d = 0; d < 2; ++d)
#pragma unroll
                for (int r = 0; r < 16; ++r) SO[(32 * ri + crow(r, hi)) * 128 + 32 * (2 * dh + d) + r32] = sacc[d][r]; }
    }
#undef SC_TOK
#undef SC_BAR
#undef SC_LOADRAW
#undef SC_LOADGK
#undef UNPK
#undef SC_FR4
#undef SC_OBLK
#undef SC_SBLK
    if (F.G == 256 && F.bid >= 128) { if (li == 0) setup_work(F, P, F.bid - 128, 128, 0x2, 0x2, 0x0, 0x0, 0x1); else setup_work(F, P, F.bid - 128, 128, 0x8, 0x8, 0x0, 0x0, 0x2); }
    else if (F.G != 256) { if (li == 0) setup_work(F, P, F.bid, F.G, 0x2, 0x2, 0x0, 0x0, 0x1); else setup_work(F, P, F.bid, F.G, 0x8, 0x8, 0x0, 0x0, 0x2); }
}
__device__ __forceinline__ void scan_combine(Frame& F, const Params& P, int li) {
    unsigned char* ws = PWS;
    const char* PROJ = (const char*)(ws + WS_BIG); const char* OF = (const char*)(ws + WS_Y); char* OB = (char*)(ws + WS_HB);
    const int gw = F.vcu * NWAVES + F.wave, NGW = F.G * NWAVES, lane = F.lane, hh = lane >> 3, dv = (lane & 7) * 16;
    f32x4 gn[4];
    { const float* gp_ = PIN(I_GLAN) + li * 128 + dv;
#pragma unroll
      for (int j = 0; j < 4; ++j) gn[j] = hh < 4 ? *(const f32x4*)(gp_ + 4 * j) : (f32x4){1.f, 1.f, 1.f, 1.f}; }
    const unsigned gcol = (unsigned)((hh < 4 ? PC_GA : PC_GB) + (hh & 3) * 128 + dv) * 2u, ocol = (unsigned)(hh * 128 + dv) * 2u;
    for (int row = gw; row < M; row += 2 * NGW) {
        v4u a[2][2], b[2][2], g[2][2];
#pragma unroll
        for (int i = 0; i < 2; ++i) { const int r_ = row + i * NGW; if (r_ < M) {
            const unsigned off = (unsigned)r_ * (unsigned)(D * 2) + ocol, goff = (unsigned)r_ * (unsigned)(EVEN_NP * 2) + gcol;
            a[i][0] = __builtin_nontemporal_load((const v4u*)(OF + off)); a[i][1] = __builtin_nontemporal_load((const v4u*)(OF + off + 16)); b[i][0] = __builtin_nontemporal_load((const v4u*)(OB + off)); b[i][1] = __builtin_nontemporal_load((const v4u*)(OB + off + 16));
            g[i][0] = __builtin_nontemporal_load((const v4u*)(PROJ + goff)); g[i][1] = __builtin_nontemporal_load((const v4u*)(PROJ + goff + 16)); } }
#pragma unroll
        for (int i = 0; i < 2; ++i) { const int r_ = row + i * NGW; if (r_ < M) {
            const unsigned off = (unsigned)r_ * (unsigned)(D * 2) + ocol;
            float x[16], gg[16];
#pragma unroll
            for (int hf = 0; hf < 2; ++hf)
#pragma unroll
                for (int e = 0; e < 4; ++e) { x[8 * hf + 2 * e] = bflo(a[i][hf][e]) + bflo(b[i][hf][e]); x[8 * hf + 2 * e + 1] = bfhi(a[i][hf][e]) + bfhi(b[i][hf][e]);
                    gg[8 * hf + 2 * e] = bflo(g[i][hf][e]); gg[8 * hf + 2 * e + 1] = bfhi(g[i][hf][e]); }
            float ss = 0.f;
#pragma unroll
            for (int e = 0; e < 16; ++e) ss += x[e] * x[e];
            ss += __shfl_xor(ss, 1); ss += __shfl_xor(ss, 2); ss += __shfl_xor(ss, 4);
            const float rstd = __builtin_amdgcn_rsqf(ss * (1.0f / 128.0f) + EPS);
#pragma unroll
            for (int e = 0; e < 16; ++e) x[e] = x[e] * rstd * gn[e >> 2][e & 3] * siluf(gg[e]);
            *(v4u*)(OB + off) = (v4u){pk2(x[0], x[1]), pk2(x[2], x[3]), pk2(x[4], x[5]), pk2(x[6], x[7])};
            *(v4u*)(OB + off + 16) = (v4u){pk2(x[8], x[9]), pk2(x[10], x[11]), pk2(x[12], x[13]), pk2(x[14], x[15])}; } }
    }
}

__device__ __forceinline__ void cache_pass(Frame& F, const Params& P, int li) {
    unsigned char* ws = PWS;
    const int gt = F.vcu * 512 + F.tid, NGT = F.G * 512;
    const float* cckv_ = PIN(I_CCKV); const float* ckpe_ = PIN(I_CKPE);
    for (int i = gt; i < 8 * 256 * 32; i += NGT) { const int c8 = i & 31, t = (i >> 5) & 255, b = i >> 13;
        const float* s = cckv_ + ((size_t)((b * 2 + li) * 256 + t) * 32 + c8) * 8; const f32x4 a = *(const f32x4*)s, c = *(const f32x4*)(s + 4);
        *(GAS v4u*)((bf16*)(ws + WS_ACKV) + ((size_t)4096 + b * LKV + t) * 256 + c8 * 8) = (v4u){pk2(a[0], a[1]), pk2(a[2], a[3]), pk2(c[0], c[1]), pk2(c[2], c[3])}; }
    for (int i = gt; i < 8 * 256 * 8; i += NGT) { const int c8 = i & 7, t = (i >> 3) & 255, b = i >> 11;
        const float* s = ckpe_ + ((size_t)((b * 2 + li) * 256 + t) * 8 + c8) * 8; const f32x4 a = *(const f32x4*)s, c = *(const f32x4*)(s + 4);
        *(GAS v4u*)((bf16*)(ws + WS_KPE) + ((size_t)4096 + b * LKV + t) * 64 + c8 * 8) = (v4u){pk2(a[0], a[1]), pk2(a[2], a[3]), pk2(c[0], c[1]), pk2(c[2], c[3])}; }
}
__device__ __forceinline__ void kpe_pass(Frame& F, const Params& P, int li) {
    unsigned char* ws = PWS;
    const float* KR = (const float*)(ws + WS_Y); const float* ROPE = (const float*)(ws + WS_ROPE);
    bf16* KPE = (bf16*)(ws + WS_KPE);
    const int gt = F.vcu * 512 + F.tid, NGT = F.G * 512;
    for (int i = gt; i < M * 4; i += NGT) {
        const int row = i >> 2, c8 = i & 3;
        const float* s = KR + (size_t)row * 64 + 8 * c8;
        f32x4 a0 = *(const f32x4*)s, a1 = *(const f32x4*)(s + 4), b0 = *(const f32x4*)(s + 32), b1 = *(const f32x4*)(s + 36);
        int drow = row;
        if (row >= M_CTX) { const int lb = (row - M_CTX) >> 11, t = (row - M_CTX) & 2047; drow = M_CTX + lb * LKV + PAST + t;
            const float* cp = ROPE + (size_t)t * 32 + 8 * c8; const float* sp = cp + 65536;
            const f32x4 c0 = *(const f32x4*)cp, c1 = *(const f32x4*)(cp + 4), s0 = *(const f32x4*)sp, s1 = *(const f32x4*)(sp + 4);
            const f32x4 x0 = a0 * c0 - b0 * s0, x1 = a1 * c1 - b1 * s1, y0 = a0 * s0 + b0 * c0, y1 = a1 * s1 + b1 * c1;
            a0 = x0; a1 = x1; b0 = y0; b1 = y1; }
        bf16* d = KPE + (size_t)drow * 64 + 8 * c8;
        *(v4u*)d = (v4u){pk2(a0[0], a0[1]), pk2(a0[2], a0[3]), pk2(a1[0], a1[1]), pk2(a1[2], a1[3])};
        *(v4u*)(d + 32) = (v4u){pk2(b0[0], b0[1]), pk2(b0[2], b0[3]), pk2(b1[0], b1[1]), pk2(b1[2], b1[3])};
    }
}

constexpr float ATT_SCALE = 0.07216878364870322f;
constexpr float ATT_THR = 8.f;
constexpr int AT_V = 0, AT_KN = 49152, AT_KP = 98304, AT_WS = 122880, AT_VB = 16384, AT_KNB = 16384, AT_KPB = 8192;
#define KSWZ(row, colB) ((row) * 256 + ((colB) ^ (((row) & 7) << 4)))
#define KPSWZ(row, colB) ((row) * 128 + ((colB) ^ (((row) & 7) << 4)))
__device__ __forceinline__ void at_partialSM(f32x16& p0, f32x16& p1, float& m_reg, float& mn, float& alpha) {
    constexpr float C = ATT_SCALE * 1.4426950408889634f;
    float pmax = p0[0];
#pragma unroll
    for (int r = 1; r < 16; ++r) pmax = fmaxf(pmax, p0[r]);
#pragma unroll
    for (int r = 0; r < 16; ++r) pmax = fmaxf(pmax, p1[r]);
    { auto rr = __builtin_amdgcn_permlane32_swap(__float_as_uint(pmax), __float_as_uint(pmax), false, false); pmax = fmaxf(__uint_as_float(rr[0]), __uint_as_float(rr[1])); }
    if (__builtin_expect(__all(pmax - m_reg <= ATT_THR / ATT_SCALE), 1)) { mn = m_reg; alpha = 1.f; }
    else { mn = fmaxf(m_reg, pmax); alpha = __builtin_amdgcn_exp2f((m_reg - mn) * C); m_reg = mn; }
    const float mnC = -mn * C;
#pragma unroll
    for (int r = 0; r < 16; ++r) p0[r] = fmaf(p0[r], C, mnC);
#pragma unroll
    for (int r = 0; r < 16; ++r) p1[r] = fmaf(p1[r], C, mnC);
#pragma unroll
    for (int r = 0; r < 16; ++r) p0[r] = __builtin_amdgcn_exp2f(p0[r]);
}
__device__ __forceinline__ void at_finishSM(f32x16& p0, f32x16& p1, float alpha, float& l_reg, bf16x8& pa0, bf16x8& pa1, bf16x8& pa2, bf16x8& pa3) {
#pragma unroll
    for (int r = 0; r < 16; ++r) p1[r] = __builtin_amdgcn_exp2f(p1[r]);
    float ps = 0;
#pragma unroll
    for (int r = 0; r < 16; ++r) ps += p0[r];
#pragma unroll
    for (int r = 0; r < 16; ++r) ps += p1[r];
    { auto rr = __builtin_amdgcn_permlane32_swap(__float_as_uint(ps), __float_as_uint(ps), false, false); ps = __uint_as_float(rr[0]) + __uint_as_float(rr[1]); }
    l_reg = l_reg * alpha + ps;
    PK4(p0, 0, pa0); PK4(p0, 8, pa1); PK4(p1, 0, pa2); PK4(p1, 8, pa3);
}
__device__ __forceinline__ void at_qkt(f32x16& p0, f32x16& p1, const LAS unsigned char* Kn, const LAS unsigned char* Kp, const bf16x8* qr, const int* kb, const int* pb) {
    p0 = f32x16{}; p1 = f32x16{};
#pragma unroll
    for (int d0 = 0; d0 < 8; ++d0) {
        const bf16x8 b0 = *(const LAS bf16x8*)(Kn + kb[d0 & 3] + 128 * (d0 >> 2)), b1 = *(const LAS bf16x8*)(Kn + kb[d0 & 3] + 128 * (d0 >> 2) + 8192);
        p0 = __builtin_amdgcn_mfma_f32_32x32x16_bf16(b0, qr[d0], p0, 0, 0, 0);
        p1 = __builtin_amdgcn_mfma_f32_32x32x16_bf16(b1, qr[d0], p1, 0, 0, 0); }
#pragma unroll
    for (int d0 = 0; d0 < 4; ++d0) {
        const bf16x8 b0 = *(const LAS bf16x8*)(Kp + pb[d0]), b1 = *(const LAS bf16x8*)(Kp + pb[d0] + 4096);
        p0 = __builtin_amdgcn_mfma_f32_32x32x16_bf16(b0, qr[8 + d0], p0, 0, 0, 0);
        p1 = __builtin_amdgcn_mfma_f32_32x32x16_bf16(b1, qr[8 + d0], p1, 0, 0, 0); }
}
template <int D0> __device__ __forceinline__ void at_pv_one(f32x16& od, unsigned vb, bf16x8 pa0, bf16x8 pa1, bf16x8 pa2, bf16x8 pa3) {
    const s16x4 l0 = tr_read<D0 * 512>(vb), h0 = tr_read<D0 * 512 + 2048>(vb), l1 = tr_read<D0 * 512 + 4096>(vb), h1 = tr_read<D0 * 512 + 4096 + 2048>(vb);
    const s16x4 l2 = tr_read<D0 * 512 + 8192>(vb), h2 = tr_read<D0 * 512 + 8192 + 2048>(vb), l3 = tr_read<D0 * 512 + 12288>(vb), h3 = tr_read<D0 * 512 + 12288 + 2048>(vb);
    asm volatile("s_waitcnt lgkmcnt(0)" ::: "memory"); SBAR();
    od = __builtin_amdgcn_mfma_f32_32x32x16_bf16(pa0, PKF(l0, h0), od, 0, 0, 0);
    od = __builtin_amdgcn_mfma_f32_32x32x16_bf16(pa1, PKF(l1, h1), od, 0, 0, 0);
    od = __builtin_amdgcn_mfma_f32_32x32x16_bf16(pa2, PKF(l2, h2), od, 0, 0, 0);
    od = __builtin_amdgcn_mfma_f32_32x32x16_bf16(pa3, PKF(l3, h3), od, 0, 0, 0);
}
__device__ __forceinline__ void at_pv(f32x16* o, unsigned vb, bf16x8 pa0, bf16x8 pa1, bf16x8 pa2, bf16x8 pa3) {
    at_pv_one<0>(o[0], vb, pa0, pa1, pa2, pa3); at_pv_one<1>(o[1], vb, pa0, pa1, pa2, pa3); at_pv_one<2>(o[2], vb, pa0, pa1, pa2, pa3); at_pv_one<3>(o[3], vb, pa0, pa1, pa2, pa3);
}
__device__ __forceinline__ void attn_unit(Frame& F, const bf16* Qrow0  , const bf16* KVh  , const bf16* KPEs  ,
                                          bf16* Orow0, int nkeys, const float* ROPE, int tpos0  ) {
    LAS unsigned char* lds = F.lds;
    const int tid = F.tid, wid = F.wave, lane = F.lane, r32 = lane & 31, hi = lane >> 5;
    LAS float* wsf = (LAS float*)(lds + AT_WS) + wid * 64; LAS float* li_l = wsf; LAS float* al_l = wsf + 32;
    float m_reg = -1e30f, l_reg = 0; f32x16 o[4] = {}; bf16x8 qr[12];
    { const bf16* Qw = Qrow0 + (size_t)(wid * 32 + r32) * 1536 + hi * 8;
#pragma unroll
      for (int d0 = 0; d0 < 12; ++d0) qr[d0] = *(const bf16x8*)(Qw + d0 * 16);
      if (tpos0 >= 0) {
          const int t = tpos0 + wid * 32 + r32;
#pragma unroll
          for (int half = 0; half < 2; ++half) {
              const float* cp = ROPE + (size_t)t * 32 + 16 * half + 8 * hi; const float* sp = cp + 65536;
              const v4u xa = __builtin_bit_cast(v4u, qr[8 + half]), xb = __builtin_bit_cast(v4u, qr[10 + half]);
              float x1[8], x2[8];
              x1[0] = bflo(xa.x); x1[1] = bfhi(xa.x); x1[2] = bflo(xa.y); x1[3] = bfhi(xa.y); x1[4] = bflo(xa.z); x1[5] = bfhi(xa.z); x1[6] = bflo(xa.w); x1[7] = bfhi(xa.w);
              x2[0] = bflo(xb.x); x2[1] = bfhi(xb.x); x2[2] = bflo(xb.y); x2[3] = bfhi(xb.y); x2[4] = bflo(xb.z); x2[5] = bfhi(xb.z); x2[6] = bflo(xb.w); x2[7] = bfhi(xb.w);
              float y1[8], y2[8];
#pragma unroll
              for (int j = 0; j < 8; ++j) { const float c = cp[j], s = sp[j]; y1[j] = x1[j] * c - x2[j] * s; y2[j] = x1[j] * s + x2[j] * c; }
              const v4u wa = {pk2(y1[0], y1[1]), pk2(y1[2], y1[3]), pk2(y1[4], y1[5]), pk2(y1[6], y1[7])}, wb = {pk2(y2[0], y2[1]), pk2(y2[2], y2[3]), pk2(y2[4], y2[5]), pk2(y2[6], y2[7])};
              if (half == 0) { qr[8] = __builtin_bit_cast(bf16x8, wa); qr[10] = __builtin_bit_cast(bf16x8, wb); } else { qr[9] = __builtin_bit_cast(bf16x8, wa); qr[11] = __builtin_bit_cast(bf16x8, wb); }
          }
      } }
    const unsigned vb0 = (unsigned)(uintptr_t)(lds + AT_V) + v_rd_base(lane);
#define AT_OPQ() int l_ = lane; asm volatile("" : "+v"(l_))
#define AT_KADDR() int kbs[4], pbs[4]; { AT_OPQ(); _Pragma("unroll") for (int b = 0; b < 4; ++b) { const int x = (32 * b + 16 * (l_ >> 5)) ^ ((l_ & 7) << 4); kbs[b] = (l_ & 31) * 256 + x; pbs[b] = (l_ & 31) * 128 + x; } }
#define AT_GLDS(gp, ldsoff) __builtin_amdgcn_global_load_lds((const unsigned*)(gp), (LAS unsigned*)(lds + (ldsoff)), 16, 0, 0)
#define AT_DMA_K(t, b) do { AT_OPQ(); const char* kb_ = (const char*)KVh + (size_t)(t) * (64 * 4096); const char* pb_ = (const char*)KPEs + (size_t)(t) * (64 * 128); \
    const int row0_ = 4 * wid + (l_ >> 4), cB0_ = ((l_ & 15) * 16) ^ ((row0_ & 7) << 4), row1_ = row0_ + 32, rowp_ = 8 * wid + (l_ >> 3), cBp_ = ((l_ & 7) * 16) ^ ((rowp_ & 7) << 4); \
    AT_GLDS(kb_ + (unsigned)(row0_ * 4096 + cB0_), AT_KN + (b) * AT_KNB + wid * 1024); AT_GLDS(kb_ + (unsigned)(row1_ * 4096 + cB0_), AT_KN + (b) * AT_KNB + (wid + 8) * 1024); \
    AT_GLDS(pb_ + (unsigned)(rowp_ * 128 + cBp_), AT_KP + (b) * AT_KPB + wid * 1024); } while (0)
#define AT_DMA_V(t, b) do { AT_OPQ(); const char* vb_ = (const char*)KVh + (size_t)(t) * (64 * 4096); \
    const int st_ = 2 * wid + (l_ >> 5), kk_ = (st_ >> 2) * 8 + ((l_ & 31) >> 2), key_ = (kk_ & ~0xC) | ((kk_ & 4) << 1) | ((kk_ & 8) >> 1), col_ = (st_ & 3) * 32 + (l_ & 3) * 8; \
    AT_GLDS(vb_ + (unsigned)(key_ * 4096 + (128 + col_) * 2), AT_V + (b) * AT_VB + wid * 1024); AT_GLDS(vb_ + (unsigned)((key_ + 32) * 4096 + (128 + col_) * 2), AT_V + (b) * AT_VB + (wid + 8) * 1024); } while (0)
#define AT_RESC(a) do { if (__any((a) < 1.f)) { if (hi == 0) al_l[r32] = (a); asm volatile("s_waitcnt lgkmcnt(0)" ::: "memory"); \
    _Pragma("unroll") for (int d = 0; d < 4; ++d) _Pragma("unroll") for (int r = 0; r < 16; ++r) o[d][r] *= al_l[crow(r, hi)]; } } while (0)
#define AT_WAITBAR(N) do { asm volatile("s_waitcnt vmcnt(" #N ") lgkmcnt(0)" ::: "memory"); __builtin_amdgcn_s_barrier(); asm volatile("" ::: "memory"); } while (0)
    f32x16 pA0, pA1, pB0, pB1; float mnA, mnB, alA, alB; bf16x8 pa0, pa1, pa2, pa3; const int NT = nkeys / 64;
    AT_DMA_K(0, 0); AT_DMA_K(1, 1); AT_DMA_V(0, 0); AT_WAITBAR(0);
    int s = 0;
#define AT_S1 (s == 2 ? 0 : s + 1)
#define AT_S2 (s == 0 ? 2 : s - 1)
#define AT_STEP(CUR0, CUR1, MNC, ALC, PRV0, PRV1, ALP, t, MODE) do { \
        if (MODE == 2) { AT_DMA_K((t) + 2, AT_S2); } if (MODE >= 1) { AT_DMA_V((t) + 1, AT_S1); } \
        SBAR(); { AT_KADDR(); at_qkt(CUR0, CUR1, lds + AT_KN + s * AT_KNB, lds + AT_KP + s * AT_KPB, qr, kbs, pbs); } \
        at_finishSM(PRV0, PRV1, ALP, l_reg, pa0, pa1, pa2, pa3); SBAR(); \
        at_pv(o, vb0 + AT_S2 * AT_VB, pa0, pa1, pa2, pa3); at_partialSM(CUR0, CUR1, m_reg, MNC, ALC); \
        AT_RESC(ALC); if (MODE == 2) AT_WAITBAR(5); else if (MODE == 1) AT_WAITBAR(2); else AT_WAITBAR(0); s = AT_S1; } while (0)
    AT_DMA_K(2, 2); AT_DMA_V(1, 1);
    { AT_KADDR(); at_qkt(pA0, pA1, lds + AT_KN, lds + AT_KP, qr, kbs, pbs); } at_partialSM(pA0, pA1, m_reg, mnA, alA);
    AT_WAITBAR(5); s = 1;
    int t = 1;
    for (; t + 4 < NT; t += 2) {
        AT_STEP(pB0, pB1, mnB, alB, pA0, pA1, alA, t, 2);
        AT_STEP(pA0, pA1, mnA, alA, pB0, pB1, alB, t + 1, 2);
    }
    AT_STEP(pB0, pB1, mnB, alB, pA0, pA1, alA, NT - 3, 2);
    AT_STEP(pA0, pA1, mnA, alA, pB0, pB1, alB, NT - 2, 1);
    AT_STEP(pB0, pB1, mnB, alB, pA0, pA1, alA, NT - 1, 0);
    at_finishSM(pB0, pB1, alB, l_reg, pa0, pa1, pa2, pa3); SBAR();
    at_pv(o, vb0 + AT_S2 * AT_VB, pa0, pa1, pa2, pa3);
    if (hi == 0) li_l[r32] = l_reg; asm volatile("s_waitcnt lgkmcnt(0)" ::: "memory");
    float rli[16];
#pragma unroll
    for (int r = 0; r < 16; ++r) rli[r] = __builtin_amdgcn_rcpf(li_l[crow(r, hi)]);
    bf16* Ow = Orow0 + (size_t)(wid * 32) * D;
#pragma unroll
    for (int r = 0; r < 16; r += 2) { const int orow = crow(r, hi);
#pragma unroll
        for (int d0 = 0; d0 < 4; ++d0) { const unsigned w = pk2(o[d0][r] * rli[r], o[d0][r + 1] * rli[r + 1]);
            Ow[(size_t)orow * D + d0 * 32 + r32] = (bf16)w; Ow[(size_t)(orow + 1) * D + d0 * 32 + r32] = (bf16)(w >> 16); } }
#undef AT_GLDS
#undef AT_OPQ
#undef AT_KADDR
#undef AT_DMA_K
#undef AT_DMA_V
#undef AT_RESC
#undef AT_WAITBAR
#undef AT_S1
#undef AT_S2
#undef AT_STEP
}
__device__ __forceinline__ void attn_phase(Frame& F, const Params& P, int li) {
    unsigned char* ws = PWS;
    const bf16* Q = (const bf16*)(ws + WS_Q); const bf16* KV = (const bf16*)(ws + WS_KV); const bf16* KPE = (const bf16*)(ws + WS_KPE);
    bf16* OB = (bf16*)(ws + WS_HB); const float* ROPE = (const float*)(ws + WS_ROPE);
    for (int u = F.vcu; u < 256 + 128; u += F.G) {
        for (int k = 0; k < 2; ++k) {
            int qrow0, kvrow0, nkeys, h, tpos0;
            if (u < 256) { const int id = 2 * u + k, lb = id >> 6, qb = id & 7; h = (id >> 3) & 7; qrow0 = M_CTX + lb * L_LAT + qb * 256; kvrow0 = M_CTX + lb * LKV; nkeys = LKV; tpos0 = qb * 256; }
            else { if (k == 1) break; const int id = u - 256, b = id >> 3; h = id & 7; qrow0 = b * L_CTX; kvrow0 = b * L_CTX; nkeys = L_CTX; tpos0 = -1; }
            __syncthreads();
            attn_unit(F, Q + (size_t)qrow0 * 1536 + h * 192, KV + (size_t)kvrow0 * 2048 + h * 256, KPE + (size_t)kvrow0 * 64, OB + (size_t)qrow0 * D + h * 128, nkeys, ROPE, tpos0);
        }
    }
}

constexpr int N_PHASES = 2 + 2 * 16;
__global__ void __launch_bounds__(NWAVES * 64, 2) hyb_fwd(Params P) {
    extern __shared__ __attribute__((aligned(16))) unsigned char lds_raw[];
    Frame F;
    F.lds = (LAS unsigned char*)lds_raw;
    F.tid = threadIdx.x; F.lane = F.tid & 63; F.wave = __builtin_amdgcn_readfirstlane(F.tid >> 6);
    F.G = gridDim.x; { const int bx = blockIdx.x; F.vcu = (F.G % 8 == 0) ? (bx % 8) * (F.G / 8) + bx / 8 : bx; }
    volatile LAS unsigned* MISC = (volatile LAS unsigned*)(F.lds + LDS_MISC);
    if (F.tid < 64) MISC[F.tid] = 0u;
    if (F.tid < 30) { const unsigned long long v = F.tid < 28 ? (unsigned long long)P.in[F.tid] : (F.tid == 28 ? (unsigned long long)P.out : (unsigned long long)P.ws);
        volatile LAS unsigned* pt = (volatile LAS unsigned*)(F.lds + LDS_PT) + 2 * F.tid; pt[0] = (unsigned)v; pt[1] = (unsigned)(v >> 32); }
    __syncthreads();
    const int use_bar = P.use_bar, ph_hi = P.ph_hi;
    XcdBarrier bar; bar.bar = (unsigned*)(PWS + WS_CTL) + 4096; bar.x = 0; bar.st = nullptr;
    if (use_bar) bar = xcd_barrier_post((unsigned*)(PWS + WS_CTL) + 4096, MISC + 8);

    for (int ph = P.ph_lo; ph < ph_hi; ++ph) {
#define REFRESH_ID() do { int t_ = threadIdx.x; asm volatile("" : "+v"(t_)); F.tid = t_; F.lane = t_ & 63; F.wave = __builtin_amdgcn_readfirstlane(t_ >> 6); \
          int g_ = gridDim.x, b_ = blockIdx.x; asm volatile("" : "+s"(g_), "+s"(b_)); F.G = g_; F.vcu = (g_ % 8 == 0) ? (b_ % 8) * (g_ / 8) + b_ / 8 : b_; F.bid = b_; } while (0)
        REFRESH_ID();
        unsigned char* ws = PWS;
        bf16* XBF = (bf16*)(POUT + OUT_Y);
        bf16* HB = (bf16*)(ws + WS_HB); bf16* YB = (bf16*)(ws + WS_Y); const bf16* SL = (const bf16*)(ws + WS_SLAB);
        const float* MOD = (const float*)(ws + WS_MOD);
        if (ph == 0) { p0_prologue(F, P); }
        else if (ph == 1) {
            const float* m0 = MOD;
            row_pass(F, PIN(I_XP), PIN(I_XS), true, nullptr, nullptr, nullptr, nullptr, nullptr, PIN(I_NMIXPRE), m0 + 1024, m0, HB, false, true);
        } else {
            const int q = ph - 2, pair = q / 16, r = q % 16; const bool odd = r >= 8; const int l = 2 * pair + (odd ? 1 : 0), k = odd ? r - 8 : r;
            const float* ml = MOD + (size_t)l * 9 * 6144;
            const int kind = k < 3 ? (odd ? 10 + k : (k == 2 ? 8 : k)) : (k == 3 ? 2 : k == 4 ? 3 : k == 5 ? 4 : k == 6 ? 5 : 6);
            if (kind == 0) {
                pg8::Gemm g{HB, (const bf16*)(ws + WS_WINE) + (size_t)pair * EVEN_NP * 1024, M, EVEN_NP, 1024}; pg8::StaticOrder S; S.init(M, EVEN_NP, F.G, F.bid, 1024);
                pg8::EpiBf16<0> E{(bf16*)(ws + WS_BIG), EVEN_NP};
                pg8::gemm_phase<pg8::EpiBf16<0>, pg8::StaticOrder, true, true>(F.lds, g, S, E, F.tid);
            } else if (kind == 1) {
                scan_phase(F, P, pair);
            } else if (kind == 8) {
                scan_combine(F, P, pair);
            } else if (kind == 2) {
                const bf16* W = odd ? (const bf16*)(ws + WS_WOUTO) + (size_t)pair * 1024 * 1024 : (const bf16*)(ws + WS_WOUTE) + (size_t)pair * 1024 * 1024;
                pg8::Gemm g{HB, W, M, 1024, 1024}; pg8::TailSplitOrder S; S.init(F.bid, 1024, 0);
                pg8::EpiYsplit E{YB, (bf16*)(ws + WS_SLAB)};
                pg8::gemm_phase<pg8::EpiYsplit, pg8::TailSplitOrder, true, true>(F.lds, g, S, E, F.tid);
            } else if (kind == 3) {
                row_pass(F, PIN(I_XP), PIN(I_XS), l == 0, XBF, YB, SL, PIN(I_NMIXPOST) + l * 1024, ml + 2048, PIN(I_NMLPPRE) + l * 1024, ml + 4096, ml + 3072, HB, true, true);
            } else if (kind == 4) {
                pg8::Gemm g{HB, (const bf16*)(ws + WS_W1) + (size_t)l * 4096 * 1024, M, FF, 1024}; pg8::StaticOrder S; S.init(M, FF, F.G, F.bid, 1024);
                pg8::EpiBf16<1> E{(bf16*)(ws + WS_BIG), FF};
                pg8::gemm_phase<pg8::EpiBf16<1>, pg8::StaticOrder, true, true>(F.lds, g, S, E, F.tid);
            } else if (kind == 5) {
                pg8::Gemm g{(const bf16*)(ws + WS_BIG), (const bf16*)(ws + WS_W2) + (size_t)l * 1024 * 4096, M, 1024, FF}; pg8::TailSplitOrder S; S.init(F.bid, FF, 0);
                pg8::EpiYsplit E{YB, (bf16*)(ws + WS_SLAB)};
                pg8::gemm_phase<pg8::EpiYsplit, pg8::TailSplitOrder, true, true>(F.lds, g, S, E, F.tid);
            } else if (kind == 6) {
                const float* mn = ml + 9 * 6144;
                if (l < 3) row_pass(F, nullptr, nullptr, false, XBF, YB, SL, PIN(I_NMLPPOST) + l * 1024, ml + 5120, PIN(I_NMIXPRE) + (l + 1) * 1024, mn + 1024, mn, HB, true, true);
                else { bar.bar = (unsigned*)(PWS + WS_CTL) + 4096; row_pass_final(F, bar, XBF, POUT + OUT_Y, YB, SL, PIN(I_NMLPPOST) + l * 1024, ml + 5120); }
            } else if (kind == 10) {
                pg8::Gemm g{HB, (const bf16*)(ws + WS_WINO) + (size_t)pair * ODD_NP * 1024, M, ODD_NP, 1024}; pg8::StaticOrder S; S.init(M, ODD_NP, F.G, F.bid, 1024);
                pg8::EpiOddIn E{(bf16*)(ws + WS_QN), (bf16*)(ws + WS_ACKV), (float*)(ws + WS_Y), POUT + OUT_CKV, POUT + OUT_KPE,
                                PIN(I_QAN) + pair * 256, PIN(I_KVAN) + pair * 256, pair};
                pg8::gemm_phase<pg8::EpiOddIn, pg8::StaticOrder, false, true>(F.lds, g, S, E, F.tid);
                REFRESH_ID(); cache_pass(F, P, pair);
            } else if (kind == 11) {
                kpe_pass(F, P, pair); REFRESH_ID();
                { pg8::Gemm g{(const bf16*)(ws + WS_QN), (const bf16*)(ws + WS_WQB) + (size_t)pair * 1536 * 256, M, 1536, 256}; pg8::StaticOrder S; S.init(M, 1536, F.G, F.bid, 256);
                  pg8::EpiBf16<0> E{(bf16*)(ws + WS_Q), 1536};
                  pg8::gemm_phase<pg8::EpiBf16<0>, pg8::StaticOrder, true, true>(F.lds, g, S, E, F.tid); }
                REFRESH_ID();
                { pg8::Gemm g{(const bf16*)(ws + WS_ACKV), (const bf16*)(ws + WS_WKVB) + (size_t)pair * 2048 * 256, MKV, 2048, 256}; pg8::StaticOrder S; S.init(MKV, 2048, F.G, F.bid, 256);
                  pg8::EpiBf16<0> E{(bf16*)(ws + WS_KV), 2048};
                  pg8::gemm_phase<pg8::EpiBf16<0>, pg8::StaticOrder, true, true>(F.lds, g, S, E, F.tid); }
            } else if (kind == 12) {
                attn_phase(F, P, pair);
            }
        }
        if (ph + 1 < ph_hi) { if (use_bar) { bar.bar = (unsigned*)(PWS + WS_CTL) + 4096; xcd_barrier(bar); } else { VM_WAIT(); __syncthreads(); } }
    }
}

extern "C" void kernel_launch(void* const* d_in, const int* in_sizes, int n_in, void* d_out, int out_size, void* d_ws, size_t ws_size, hipStream_t stream) {
    static int grid = 0;
    if (grid == 0) {
        if (n_in != 28 || out_size != 27787264 || ws_size < WS_END) { fprintf(stderr, "kernel_launch: unexpected shapes: n_in %d out %d ws %zu (need >= %zu)\n", n_in, out_size, ws_size, (size_t)WS_END); grid = -1; return; }
        int dev = 0, cus = 0, per_cu = 0;
        if (hipGetDevice(&dev) != hipSuccess || hipDeviceGetAttribute(&cus, hipDeviceAttributeMultiprocessorCount, dev) != hipSuccess) { grid = -1; return; }
        if (hipFuncSetAttribute((const void*)hyb_fwd, hipFuncAttributeMaxDynamicSharedMemorySize, LDS_BYTES) != hipSuccess) { fprintf(stderr, "kernel_launch: hipFuncSetAttribute failed\n"); grid = -1; return; }
        if (hipOccupancyMaxActiveBlocksPerMultiprocessor(&per_cu, (const void*)hyb_fwd, NWAVES * 64, LDS_BYTES) != hipSuccess || per_cu < 1) { fprintf(stderr, "kernel_launch: occupancy query reports %d\n", per_cu); }
        (void)hipGetLastError();
        grid = cus;
    }
    if (grid < 0) return;
    (void)hipMemsetAsync((char*)d_ws + WS_CTL, 0, CTL_ZERO_BYTES, stream);
    Params a{};
    for (int i = 0; i < 28; ++i) a.in[i] = (const float*)d_in[i];
    a.out = (float*)d_out; a.ws = (unsigned char*)d_ws;
    a.ph_lo = 0; a.ph_hi = N_PHASES; a.use_bar = 1; a.pad = 0;
    hipLaunchKernelGGL(hyb_fwd, dim3(grid), dim3(NWAVES * 64), LDS_BYTES, stream, a);
    const hipError_t le = hipPeekAtLastError();
    if (le != hipSuccess) fprintf(stderr, "kernel_launch: launch failed: %s\n", hipGetErrorName(le));
}
```

```cpp
#include <hip/hip_runtime.h>
#include <hip/hip_bf16.h>
#include <cstdio>
#include <cstdint>
namespace pg8 {
#define PG8_LAS __attribute__((address_space(3)))
typedef unsigned short bf16_t;
typedef short bf16x8 __attribute__((ext_vector_type(8)));
typedef float f32x4 __attribute__((ext_vector_type(4)));
typedef unsigned u32x4 __attribute__((ext_vector_type(4)));
constexpr int BM = 256, BK = 64, HALF = 128, HTB = HALF * BK * 2  , STAGE_BYTES = 8 * HTB, NXCD = 8, WGM = 8;

__host__ __device__ __forceinline__ int lds_byte(int r, int c) { const int st = (r >> 4) * 2 + (c >> 5), rr = r & 15, cc = c & 31, ob = rr * 64 + cc * 2; return st * 1024 + (ob ^ (((ob >> 9) & 1) << 5)); }
__host__ __device__ __forceinline__ void stage_rc(int b, int& R, int& C) { const int st = b / 1024, sb = b % 1024, swz = sb ^ (((sb >> 9) & 1) << 5); R = (st >> 1) * 16 + swz / 64; C = (st & 1) * 32 + (swz % 64) / 2; }
__host__ __device__ __forceinline__ int perm32(int rho) { const int n = rho >> 4, i = rho & 15; return 8 * (i >> 2) + 4 * n + (i & 3); }

struct Unit { int pm, pn, ks, kt0, nt; };
struct Gemm { const bf16_t* A; const bf16_t* Bt; int M, N, K; };

struct StaticOrder {
    int nM, nN, nwg, G, c, ntk;
    __host__ __device__ void init(int M, int N, int G_, int c_, int K) { nM = M / BM; nN = N / BM; nwg = nM * nN; G = G_; c = c_; ntk = K / BK; }
    __host__ __device__ bool next(int i, Unit& u) const {
        const long L = (long)i * G + c; if (L >= nwg) return false;
        int wgid = (int)L; { const int q = nwg / NXCD, r = nwg % NXCD, xcd = wgid % NXCD, off = wgid / NXCD; wgid = (xcd < r ? xcd * (q + 1) : r * (q + 1) + (xcd - r) * q) + off; }
        const int nig = WGM * nN, gid = wgid / nig, fm = gid * WGM, gsz = (nM - fm) < WGM ? (nM - fm) : WGM;
        u.pm = fm + ((wgid % nig) % gsz); u.pn = (wgid % nig) / gsz; u.ks = -1; u.kt0 = 0; u.nt = ntk; return true;
    }
    __device__ __forceinline__ void a_ready(const Unit&) const {}
    __device__ __forceinline__ void done(const Unit&) const {}
};


struct TailSplitOrder {
    int c, ntk, mode;
    __device__ void init(int c_, int K, int mode_) { c = c_; ntk = K / BK; mode = mode_; }
    __device__ __forceinline__ bool next(int i, Unit& u) const {
        const int xcd = c & 7, j = c >> 3;
        const int round = i + (mode == 2 ? 1 : 0); const bool tail = round != 0;
        u.pm = tail ? 64 + xcd * 2 + (j & 1) : xcd * 8 + (j & 7);
        u.pn = tail ? (j >> 1) & 3 : j >> 3;
        u.ks = tail ? j >> 3 : -1;
        u.nt = tail ? ntk >> 2 : ntk;
        u.kt0 = tail ? (j >> 3) * (ntk >> 2) : 0;
        return round == 0 ? mode != 2 : (round == 1 && mode != 1);
    }
    __device__ __forceinline__ void a_ready(const Unit&) const {}
    __device__ __forceinline__ void done(const Unit&) const {}
};

typedef float f32x2c_t __attribute__((ext_vector_type(2))); typedef __bf16 bf16x2c_t __attribute__((ext_vector_type(2)));
__device__ __forceinline__ unsigned cvt_pk_bf16(float lo, float hi) { f32x2c_t v = {lo, hi}; bf16x2c_t b = __builtin_convertvector(v, bf16x2c_t); return __builtin_bit_cast(unsigned, b); }

template <int ACT> struct EpiBf16 {
    static constexpr bool PERM = true, AFTER_DRAIN = false;
    bf16_t* O; int ldc;
    __device__ __forceinline__ void operator()(const f32x4 (&acc)[2][2][4][2], const Unit& u, int wr, int wc, int fr, int fq) const {
        const int row0 = u.pm * BM + wr * 64 + fr; const int col0 = u.pn * BM + wc * 32 + 8 * fq;
#pragma unroll
        for (int ai = 0; ai < 2; ++ai)
#pragma unroll
            for (int m = 0; m < 4; ++m) { bf16_t* rowp = O + (size_t)(row0 + ai * HALF + m * 16) * ldc + col0;
#pragma unroll
                for (int bj = 0; bj < 2; ++bj) { f32x4 v0 = acc[ai][bj][m][0], v1 = acc[ai][bj][m][1];
                    if (ACT == 1) {
#pragma unroll
                        for (int j = 0; j < 4; ++j) { const float a = fmaxf(v0[j], 0.f), b = fmaxf(v1[j], 0.f); v0[j] = a * a; v1[j] = b * b; } }
                    u32x4 w; w.x = cvt_pk_bf16(v0[0], v0[1]); w.y = cvt_pk_bf16(v0[2], v0[3]); w.z = cvt_pk_bf16(v1[0], v1[1]); w.w = cvt_pk_bf16(v1[2], v1[3]);
                    *(u32x4*)(rowp + bj * HALF) = w; } }
    }
};
struct EpiYsplit {
    static constexpr bool PERM = true, AFTER_DRAIN = false;
    bf16_t* Y; bf16_t* SL;
    __device__ __forceinline__ void operator()(const f32x4 (&acc)[2][2][4][2], const Unit& u, int wr, int wc, int fr, int fq) const {
        const int row0 = u.pm * BM + wr * 64 + fr; const int col0 = u.pn * BM + wc * 32 + 8 * fq;
        if (u.ks < 0) {
#pragma unroll
            for (int ai = 0; ai < 2; ++ai)
#pragma unroll
                for (int m = 0; m < 4; ++m) { bf16_t* rowp = Y + (size_t)(row0 + ai * HALF + m * 16) * 1024 + col0;
#pragma unroll
                    for (int bj = 0; bj < 2; ++bj) { const f32x4 v0 = acc[ai][bj][m][0], v1 = acc[ai][bj][m][1];
                        u32x4 w; w.x = cvt_pk_bf16(v0[0], v0[1]); w.y = cvt_pk_bf16(v0[2], v0[3]); w.z = cvt_pk_bf16(v1[0], v1[1]); w.w = cvt_pk_bf16(v1[2], v1[3]);
                        *(u32x4*)(rowp + bj * HALF) = w; } }
        } else {
            bf16_t* base = SL + (size_t)u.ks * (4096 * 1024);
#pragma unroll
            for (int ai = 0; ai < 2; ++ai)
#pragma unroll
                for (int m = 0; m < 4; ++m) { bf16_t* rowp = base + (size_t)(row0 - 16384 + ai * HALF + m * 16) * 1024 + col0;
#pragma unroll
                    for (int bj = 0; bj < 2; ++bj) { const f32x4 v0 = acc[ai][bj][m][0], v1 = acc[ai][bj][m][1];
                        u32x4 w; w.x = cvt_pk_bf16(v0[0], v0[1]); w.y = cvt_pk_bf16(v0[2], v0[3]); w.z = cvt_pk_bf16(v1[0], v1[1]); w.w = cvt_pk_bf16(v1[2], v1[3]);
                        *(u32x4*)(rowp + bj * HALF) = w; } }
        }
    }
};
struct EpiOddIn {
    static constexpr bool PERM = false, AFTER_DRAIN = true;
    bf16_t* QN; bf16_t* ACKV; float* KPERAW; float* out_ckv; float* out_kpe; const float* gq; const float* gkv; int li;
    __device__ __forceinline__ void fused(f32x4 (&acc)[2][2][4][2], const Unit& u, int wr, int wc, int fr, int fq, PG8_LAS unsigned char* lds, int wid, int lane) const {
        PG8_LAS float* P = (PG8_LAS float*)lds;
        if (u.pn < 2) {
#pragma unroll
            for (int ai = 0; ai < 2; ++ai)
#pragma unroll
                for (int m = 0; m < 4; ++m) { float s = 0.f;
#pragma unroll
                    for (int bj = 0; bj < 2; ++bj)
#pragma unroll
                        for (int n = 0; n < 2; ++n) { const f32x4 x = acc[ai][bj][m][n]; s += (x[0] * x[0] + x[1] * x[1]) + (x[2] * x[2] + x[3] * x[3]); }
                    s += __shfl_xor(s, 16); s += __shfl_xor(s, 32);
                    if (fq == 0) P[(ai * HALF + wr * 64 + m * 16 + fr) * 4 + wc] = s; }
        }
        asm volatile("s_waitcnt lgkmcnt(0)" ::: "memory"); __builtin_amdgcn_s_barrier(); asm volatile("" ::: "memory");
        if (u.pn < 2) {
            const float* gv = u.pn == 0 ? gq : gkv;
#pragma unroll
            for (int ai = 0; ai < 2; ++ai)
#pragma unroll
                for (int m = 0; m < 4; ++m) { const int r = ai * HALF + wr * 64 + m * 16 + fr; const int grow = u.pm * BM + r;
                    const float tot = (P[r * 4 + 0] + P[r * 4 + 1]) + (P[r * 4 + 2] + P[r * 4 + 3]);
                    const float rstd = 1.0f / sqrtf(tot * (1.0f / 256.0f) + 1e-6f);
                    const int drow = grow < 4096 ? grow : 4096 + ((grow - 4096) >> 11) * 2304 + 256 + ((grow - 4096) & 2047);
#pragma unroll
                    for (int bj = 0; bj < 2; ++bj)
#pragma unroll
                        for (int n = 0; n < 2; ++n) { const int col = bj * HALF + wc * 32 + n * 16 + 4 * fq; const f32x4 g = *(const f32x4*)(gv + col);
                            const f32x4 v = acc[ai][bj][m][n] * rstd * g;
                            unsigned long long w = (unsigned long long)cvt_pk_bf16(v[0], v[1]) | ((unsigned long long)cvt_pk_bf16(v[2], v[3]) << 32);
                            if (u.pn == 0) *(unsigned long long*)(QN + (size_t)grow * 256 + col) = w;
                            else { *(unsigned long long*)(ACKV + (size_t)drow * 256 + col) = w;
                                   if (grow < 4096) *(f32x4*)(out_ckv + ((size_t)((grow >> 8) * 2 + li) * 256 + (grow & 255)) * 256 + col) = v; } } }
        } else if (wc < 2) {
#pragma unroll
            for (int ai = 0; ai < 2; ++ai)
#pragma unroll
                for (int m = 0; m < 4; ++m) { const int r = ai * HALF + wr * 64 + m * 16 + fr; const int grow = u.pm * BM + r;
#pragma unroll
                    for (int n = 0; n < 2; ++n) { const int col = wc * 32 + n * 16 + 4 * fq; const f32x4 v = acc[ai][0][m][n];
                        *(f32x4*)(KPERAW + (size_t)grow * 64 + col) = v;
                        if (grow < 4096) *(f32x4*)(out_kpe + ((size_t)((grow >> 8) * 2 + li) * 256 + (grow & 255)) * 64 + col) = v; } }
        }
    }
};

template <class Epi, class Sched, bool ALIGN_EPI = false, bool SP2 = false>
__device__ __forceinline__ void gemm_phase(PG8_LAS unsigned char* lds, const Gemm g, const Sched& S, const Epi& E, const int tid) {
    const int  wid = __builtin_amdgcn_readfirstlane(tid >> 6), lane = tid & 63, wr = wid >> 2, wc = wid & 3, fr = lane & 15, fq = lane >> 4;
    const int K = g.K;
    unsigned voffA[2], voffB[2];
#pragma unroll
    for (int i = 0; i < 2; ++i) { int R, C; stage_rc(tid * 16 + i * 8192, R, C); const int Rb = Epi::PERM ? ((R & ~31) + perm32(R & 31)) : R;
        voffA[i] = (unsigned)(R * K + C) * 2u; voffB[i] = (unsigned)(Rb * K + C) * 2u; }
    const size_t kstep = (size_t)(BK * 2);
    const size_t hstep = (size_t)HALF * K * 2;
    const size_t tstep = 2 * hstep;
    const unsigned ldsw = (unsigned)wid * 1024u;
    const int aoff = lds_byte(wr * 64 + fr, fq * 8), boff = lds_byte(wc * 32 + fr, fq * 8);
#define PG8_SA(b, h) (((b) * 2 + (h)) * HTB)
#define PG8_SB(b, h) ((4 + (b) * 2 + (h)) * HTB)
#define PG8_STAGE(bufoff, gbase, voff) do { _Pragma("unroll") for (int _i = 0; _i < 2; ++_i) \
        __builtin_amdgcn_global_load_lds((const unsigned*)((const char*)(gbase) + (voff)[_i]), (PG8_LAS unsigned*)(lds + (bufoff) + ldsw + _i * 8192), 16, 0, 0); } while (0)
#define PG8_LDA(dst, b, h) do { _Pragma("unroll") for (int m = 0; m < 4; ++m) _Pragma("unroll") for (int k = 0; k < 2; ++k) dst[m][k] = *(const PG8_LAS bf16x8*)(lds + PG8_SA(b, h) + aoff + m * 2048 + k * 1024); } while (0)
#define PG8_LDB(dst, b, h) do { _Pragma("unroll") for (int n = 0; n < 2; ++n) _Pragma("unroll") for (int k = 0; k < 2; ++k) dst[n][k] = *(const PG8_LAS bf16x8*)(lds + PG8_SB(b, h) + boff + n * 2048 + k * 1024); } while (0)
#define PG8_MMA(ai, bj, At, Bt) do { __builtin_amdgcn_s_setprio(1); _Pragma("unroll") for (int m = 0; m < 4; ++m) _Pragma("unroll") for (int n = 0; n < 2; ++n) _Pragma("unroll") for (int k = 0; k < 2; ++k) \
        acc[ai][bj][m][n] = __builtin_amdgcn_mfma_f32_16x16x32_bf16(Bt[n][k], At[m][k], acc[ai][bj][m][n], 0, 0, 0); __builtin_amdgcn_s_setprio(0); } while (0)
#define PG8_WAIT_V(n) asm volatile("s_waitcnt vmcnt(" #n ")" ::: "memory")
#define PG8_WAIT_L(n) asm volatile("s_waitcnt lgkmcnt(" #n ")" ::: "memory")
#define PG8_BAR __builtin_amdgcn_s_barrier()
#define PG8_SCHED __builtin_amdgcn_sched_barrier(0)
    Unit cur, nxt; int ui = 0;
    if (!S.next(0, cur)) return;
    f32x4 acc[2][2][4][2];
#pragma unroll
    for (int a = 0; a < 2; ++a)
#pragma unroll
        for (int b = 0; b < 2; ++b)
#pragma unroll
            for (int m = 0; m < 4; ++m)
#pragma unroll
                for (int n = 0; n < 2; ++n) acc[a][b][m][n] = (f32x4){0.f, 0.f, 0.f, 0.f};
    bf16x8 At[4][2], B0[2][2], B1[2][2];
    const char* cA = (const char*)g.A + (size_t)cur.pm * tstep + (size_t)cur.kt0 * kstep; const char* cB = (const char*)g.Bt + (size_t)cur.pn * tstep + (size_t)cur.kt0 * kstep;
    S.a_ready(cur);
    if constexpr (SP2) {
        PG8_STAGE(PG8_SB(0, 0), cB, voffB); PG8_STAGE(PG8_SB(0, 1), cB + hstep, voffB); PG8_STAGE(PG8_SA(0, 0), cA, voffA); PG8_STAGE(PG8_SA(0, 1), cA + hstep, voffA);
        if (wr == 1) PG8_BAR;
        PG8_WAIT_V(2); PG8_BAR;
        PG8_STAGE(PG8_SB(1, 0), cB + kstep, voffB); PG8_STAGE(PG8_SA(1, 0), cA + kstep, voffA); PG8_STAGE(PG8_SB(1, 1), cB + hstep + kstep, voffB);
        PG8_WAIT_V(6); PG8_BAR;
    } else {
        PG8_STAGE(PG8_SB(0, 0), cB, voffB); PG8_STAGE(PG8_SA(0, 0), cA, voffA); PG8_STAGE(PG8_SB(0, 1), cB + hstep, voffB); PG8_STAGE(PG8_SA(0, 1), cA + hstep, voffA);
        if (wr == 1) PG8_BAR;
        PG8_WAIT_V(4); PG8_BAR;
        PG8_STAGE(PG8_SB(1, 0), cB + kstep, voffB); PG8_STAGE(PG8_SA(1, 0), cA + kstep, voffA); PG8_STAGE(PG8_SB(1, 1), cB + hstep + kstep, voffB);
        PG8_WAIT_V(6); PG8_BAR;
    }
    for (;;) {
        const bool has_next = S.next(ui + 1, nxt);
        const char* nA = has_next ? (const char*)g.A + (size_t)nxt.pm * tstep + (size_t)nxt.kt0 * kstep : cA; const char* nB = has_next ? (const char*)g.Bt + (size_t)nxt.pn * tstep + (size_t)nxt.kt0 * kstep : cB;
        const int nt = cur.nt;
        for (int t = 0; t < nt; t += 2) {
            const bool last = (t == nt - 2);
            const char* a1 = cA + (size_t)(t + 1) * kstep;
            const char* a2 = last ? nA : cA + (size_t)(t + 2) * kstep; const char* b2 = last ? nB : cB + (size_t)(t + 2) * kstep;
            const char* a3 = a2 + kstep; const char* b3 = b2 + kstep;
            if (last && has_next) S.a_ready(nxt);
            if constexpr (SP2) {
            PG8_LDB(B0, 0, 0); PG8_LDB(B1, 0, 1); PG8_SCHED; PG8_LDA(At, 0, 0); PG8_STAGE(PG8_SA(1, 1), a1 + hstep, voffA);
            PG8_WAIT_V(8); PG8_WAIT_L(0); PG8_BAR; PG8_MMA(0, 0, At, B0); PG8_MMA(0, 1, At, B1); PG8_BAR; PG8_SCHED;
            PG8_LDA(At, 0, 1); PG8_STAGE(PG8_SB(0, 0), b2, voffB); PG8_STAGE(PG8_SB(0, 1), b2 + hstep, voffB); PG8_STAGE(PG8_SA(0, 0), a2, voffA);
            PG8_WAIT_V(8); PG8_WAIT_L(0); PG8_BAR; PG8_MMA(1, 0, At, B0); PG8_MMA(1, 1, At, B1); PG8_BAR; PG8_SCHED;
            PG8_LDB(B0, 1, 0); PG8_LDB(B1, 1, 1); PG8_SCHED; PG8_LDA(At, 1, 0); PG8_STAGE(PG8_SA(0, 1), a2 + hstep, voffA);
            PG8_WAIT_V(8); PG8_WAIT_L(0); PG8_BAR; PG8_MMA(0, 0, At, B0); PG8_MMA(0, 1, At, B1); PG8_BAR; PG8_SCHED;
            PG8_LDA(At, 1, 1); PG8_STAGE(PG8_SB(1, 0), b3, voffB); PG8_STAGE(PG8_SB(1, 1), b3 + hstep, voffB); PG8_STAGE(PG8_SA(1, 0), a3, voffA);
            PG8_WAIT_V(8); PG8_WAIT_L(0); PG8_BAR; PG8_MMA(1, 0, At, B0); PG8_MMA(1, 1, At, B1); PG8_BAR; PG8_SCHED;
            } else {
            PG8_LDB(B0, 0, 0); PG8_SCHED; PG8_LDA(At, 0, 0); PG8_STAGE(PG8_SA(1, 1), a1 + hstep, voffA);
            PG8_WAIT_L(8); PG8_BAR; PG8_WAIT_L(0); PG8_MMA(0, 0, At, B0); PG8_BAR; PG8_SCHED;
            PG8_LDB(B1, 0, 1); PG8_STAGE(PG8_SB(0, 0), b2, voffB);
            PG8_BAR; PG8_WAIT_L(0); PG8_MMA(0, 1, At, B1); PG8_BAR;
            PG8_LDA(At, 0, 1); PG8_STAGE(PG8_SA(0, 0), a2, voffA);
            PG8_BAR; PG8_WAIT_L(0); PG8_MMA(1, 0, At, B0); PG8_BAR; PG8_SCHED;
            PG8_STAGE(PG8_SB(0, 1), b2 + hstep, voffB);
            PG8_WAIT_V(6); PG8_BAR; PG8_MMA(1, 1, At, B1); PG8_BAR;
            PG8_LDB(B0, 1, 0); PG8_SCHED; PG8_LDA(At, 1, 0); PG8_STAGE(PG8_SA(0, 1), a2 + hstep, voffA);
            PG8_WAIT_L(8); PG8_BAR; PG8_WAIT_L(0); PG8_MMA(0, 0, At, B0); PG8_BAR; PG8_SCHED;
            PG8_LDB(B1, 1, 1); PG8_STAGE(PG8_SB(1, 0), b3, voffB);
            PG8_BAR; PG8_WAIT_L(0); PG8_MMA(0, 1, At, B1); PG8_BAR;
            PG8_LDA(At, 1, 1); PG8_STAGE(PG8_SA(1, 0), a3, voffA);
            PG8_BAR; PG8_WAIT_L(0); PG8_MMA(1, 0, At, B0); PG8_BAR; PG8_SCHED;
            PG8_STAGE(PG8_SB(1, 1), b3 + hstep, voffB);
            PG8_WAIT_V(6); PG8_BAR; PG8_MMA(1, 1, At, B1); PG8_BAR;
            }
        }
        if constexpr (ALIGN_EPI) { if (wr == 0) PG8_BAR; }
        if constexpr (!Epi::AFTER_DRAIN) { E(acc, cur, wr, wc, fr, fq); S.done(cur); }
        if (!has_next) break;
#pragma unroll
        for (int a = 0; a < 2; ++a)
#pragma unroll
            for (int b = 0; b < 2; ++b)
#pragma unroll
                for (int m = 0; m < 4; ++m)
#pragma unroll
                    for (int n = 0; n < 2; ++n) acc[a][b][m][n] = (f32x4){0.f, 0.f, 0.f, 0.f};
        cur = nxt; cA = nA; cB = nB; ++ui;
        if constexpr (ALIGN_EPI) { if (wr == 1) PG8_BAR; }
    }
    PG8_WAIT_V(0);
    if constexpr (!ALIGN_EPI) { if (wr == 0) PG8_BAR; }
    PG8_BAR;
    if constexpr (Epi::AFTER_DRAIN) { E.fused(acc, cur, wr, wc, fr, fq, lds, wid, lane); S.done(cur); }
#undef PG8_SA
#undef PG8_SB
#undef PG8_STAGE
#undef PG8_LDA
#undef PG8_LDB
#undef PG8_MMA
#undef PG8_WAIT_V
#undef PG8_WAIT_L
#undef PG8_BAR
#undef PG8_SCHED
}
}

constexpr int NWAVES = 8;
constexpr int D = 1024, FF = 4096, M_CTX = 4096, M_LAT = 16384, M = M_CTX + M_LAT;
constexpr int L_LAT = 2048, L_CTX = 256, PAST = 256, LKV = PAST + L_LAT;
constexpr int MKV = M_CTX + 8 * LKV;
constexpr int EVEN_N = 3104, EVEN_NP = 3328, ODD_N = 576, ODD_NP = 768;
constexpr float EPS = 1e-6f;
constexpr int PC_QA = 0, PC_KA = 256, PC_VA = 512, PC_GA = 1024, PC_QB = 1536, PC_KB = 1792, PC_VB = 2048, PC_GB = 2560, PC_GK = 3072;
constexpr size_t OUT_Y = 0, OUT_CKV = 20971520, OUT_KPE = 23068672, OUT_SGLA = 23592960, OUT_SRET = 25690112;

constexpr size_t MiB = 1u << 20;
constexpr size_t WS_CTL = 0, CTL_ZERO_BYTES = 64 * 1024;
constexpr size_t WS_MOD = 1 * MiB;
constexpr size_t WS_ROPE = 2 * MiB;
constexpr size_t WS_KPE = 3 * MiB;
constexpr size_t WS_ACKV = 6 * MiB;
constexpr size_t WS_WINE = 18 * MiB;
constexpr size_t WS_WOUTE = 31 * MiB;
constexpr size_t WS_WINO = 35 * MiB;
constexpr size_t WS_WQB = 38 * MiB;
constexpr size_t WS_WKVB = 40 * MiB;
constexpr size_t WS_WOUTO = 42 * MiB;
constexpr size_t WS_W1 = 46 * MiB;
constexpr size_t WS_W2 = 78 * MiB;
constexpr size_t WS_HB = 110 * MiB;
constexpr size_t WS_Y = 150 * MiB;
constexpr size_t WS_BIG = 190 * MiB;
constexpr size_t WS_Q = WS_BIG, WS_KV = WS_BIG + 60 * MiB, WS_QN = WS_BIG + 148 * MiB;
constexpr size_t WS_SLAB = 350 * MiB;
constexpr size_t WS_END = 382 * MiB;

constexpr int RING_BYTES = 131072;
constexpr int LDS_MISC = 155648;
constexpr int LDS_BYTES = 163840;

#define GAS __attribute__((address_space(1)))
#define LAS __attribute__((address_space(3)))
typedef unsigned short bf16;
typedef unsigned v4u __attribute__((ext_vector_type(4)));
typedef unsigned v2u __attribute__((ext_vector_type(2)));
typedef float f32x4 __attribute__((ext_vector_type(4)));
typedef float f32x16 __attribute__((ext_vector_type(16)));
typedef short bf16x8 __attribute__((ext_vector_type(8)));
typedef short s16x4 __attribute__((ext_vector_type(4)));
#define LDS_WAIT() asm volatile("s_waitcnt lgkmcnt(0)" ::: "memory")
#define VM_WAIT() asm volatile("s_waitcnt vmcnt(0)" ::: "memory")
typedef float f32x2_t __attribute__((ext_vector_type(2))); typedef __bf16 bf16x2_t __attribute__((ext_vector_type(2)));
__device__ __forceinline__ unsigned pk2(float lo, float hi) { f32x2_t v = {lo, hi}; bf16x2_t b = __builtin_convertvector(v, bf16x2_t); return __builtin_bit_cast(unsigned, b); }
__device__ __forceinline__ unsigned f2bf(float f) { return pk2(f, f) & 0xffffu; }
__device__ __forceinline__ float bflo(unsigned w) { return __builtin_bit_cast(float, w << 16); }
__device__ __forceinline__ float bfhi(unsigned w) { return __builtin_bit_cast(float, w & 0xffff0000u); }
__device__ __forceinline__ float wave_sum(float v) {
#pragma unroll
    for (int o = 1; o < 64; o <<= 1) v += __shfl_xor(v, o);
    return v;
}
__device__ __forceinline__ float siluf(float x) { return x * __builtin_amdgcn_rcpf(1.0f + __expf(-x)); }

#define XB_TMO      128
#define XB_XCNT(j)  (256  + 64 * (j))
#define XB_XSUB(j)  (1280 + 64 * (j))
#define XB_XGEN(j)  (2304 + 64 * (j))
#define XB_TOP      3328
#define XB_TOPGEN   3392
#define XCD_BAR_WORDS 3456
#define XB_SPIN_CAP (1u << 20)
__device__ __forceinline__ unsigned xb_ld(unsigned* p)              { return __hip_atomic_load(p, __ATOMIC_RELAXED, __HIP_MEMORY_SCOPE_AGENT); }
__device__ __forceinline__ unsigned xb_add(unsigned* p, unsigned v) { return __hip_atomic_fetch_add(p, v, __ATOMIC_RELAXED, __HIP_MEMORY_SCOPE_AGENT); }
__device__ __forceinline__ unsigned xb_xcc_id() { return (unsigned)__builtin_amdgcn_s_getreg((3 << 11) | 20) & 0xFu; }
#define XB_SPIN(cond, bar) do { unsigned _sp = 0; while (cond) { __builtin_amdgcn_s_sleep(1); \
    if ((++_sp & 255u) == 0u) { if (xb_ld(&(bar)[XB_TMO])) break; if (_sp > XB_SPIN_CAP) { atomicAdd(&(bar)[XB_TMO], 1u); break; } } } } while (0)
struct XcdBarrier { unsigned* bar; unsigned x; volatile LAS unsigned* st; };
__device__ __forceinline__ XcdBarrier xcd_barrier_post(unsigned* bar, volatile LAS unsigned* st) {
    XcdBarrier b; b.bar = bar; b.x = xb_xcc_id(); b.st = st;
    if (threadIdx.x == 0) (void)xb_add(&bar[XB_XCNT(b.x)], 1u);
    return b;
}
__device__ __forceinline__ void xcd_barrier_complete(unsigned* bar, unsigned x, unsigned& nloc, unsigned& nx) {
    const unsigned G = gridDim.x * gridDim.y * gridDim.z;
    unsigned sum, cnt, mine, sp = 0u;
    for (;;) {
        sum = 0u; cnt = 0u; mine = 0u;
#pragma unroll
        for (unsigned j = 0; j < 16; ++j) { const unsigned c = xb_ld(&bar[XB_XCNT(j)]); sum += c; cnt += (c > 0u) ? 1u : 0u; mine = (j == x) ? c : mine; }
        if (sum == G) break;
        __builtin_amdgcn_s_sleep(1);
        if ((++sp & 255u) == 0u) { if (xb_ld(&bar[XB_TMO])) break; if (sp > XB_SPIN_CAP) { atomicAdd(&bar[XB_TMO], 1u); break; } }
    }
    nloc = mine > 0u ? mine : 1u; nx = cnt > 0u ? cnt : 1u;
}
__device__ __forceinline__ void xcd_barrier(const XcdBarrier& b) {
    asm volatile("s_waitcnt vmcnt(0)" ::: "memory");
    __syncthreads();
    if (threadIdx.x == 0) {
        unsigned* bar = b.bar;
        __builtin_amdgcn_s_waitcnt(0);
        unsigned nloc = b.st[0], nx = b.st[1];
        if (nloc == 0u) { xcd_barrier_complete(bar, b.x, nloc, nx); b.st[0] = nloc; b.st[1] = nx; }
        const unsigned old = xb_add(&bar[XB_XSUB(b.x)], 1u);
        const unsigned gen = old / nloc;
        if (old + 1u == (gen + 1u) * nloc) {
            __builtin_amdgcn_fence(__ATOMIC_RELEASE, "agent");
            __builtin_amdgcn_fence(__ATOMIC_ACQUIRE, "agent");
            asm volatile("s_waitcnt vmcnt(0)" ::: "memory");
            const unsigned og = xb_add(&bar[XB_TOP], 1u);
            const unsigned tg = og / nx;
            if (og + 1u == (tg + 1u) * nx) xb_add(&bar[XB_TOPGEN], 1u);
            else XB_SPIN(xb_ld(&bar[XB_TOPGEN]) == tg, bar);
            xb_add(&bar[XB_XGEN(b.x)], 1u);
        } else {
            __builtin_amdgcn_fence(__ATOMIC_ACQUIRE, "agent");
            asm volatile("s_waitcnt vmcnt(0)" ::: "memory");
            XB_SPIN(xb_ld(&bar[XB_XGEN(b.x)]) == gen, bar);
        }
        asm volatile("s_waitcnt vmcnt(0)" ::: "memory");
    }
    __syncthreads();
}

struct Params { const float* in[28]; float* out; unsigned char* ws; int ph_lo, ph_hi, use_bar, pad; };
enum { I_XP = 0, I_XS, I_CCKV, I_CKPE, I_SGLA, I_SRET, I_C, I_CCTX, I_WADA, I_BADA, I_NMIXPRE, I_NMIXPOST, I_NMLPPRE, I_NMLPPOST,
       I_WINE, I_WGK2, I_BGK2, I_GLAN, I_RDEC, I_WOUTE, I_WINO, I_QAN, I_WQB, I_KVAN, I_WKVB, I_WOUTO, I_W1, I_W2 };
struct Frame { LAS unsigned char* lds; int tid, lane, wave, vcu, G, bid; };
constexpr int LDS_PT = LDS_MISC + 256;
__device__ __forceinline__ const void* ldp(LAS unsigned char* lds, int i) {
    const volatile LAS unsigned* p = (const volatile LAS unsigned*)(lds + LDS_PT) + 2 * i;
    const unsigned lo = __builtin_amdgcn_readfirstlane(p[0]), hi = __builtin_amdgcn_readfirstlane(p[1]);
    return (const void*)(const GAS void*)(((unsigned long long)hi << 32) | lo);
}
#define PIN(i) ((const float*)ldp(F.lds, (i)))
#define POUT ((float*)ldp(F.lds, 28))
#define PWS ((unsigned char*)ldp(F.lds, 29))

__device__ __forceinline__ void p0_transpose_item(const float* W, int K, int N, bf16* WT, int kb, int n0, int dn0, LAS float* scr, int lane) {
    const int k0 = 64 * kb;
    f32x4 wv[8];
#pragma unroll
    for (int i = 0; i < 8; ++i) wv[i] = __builtin_nontemporal_load((const f32x4*)(W + (size_t)(k0 + 8 * i + (lane >> 3)) * N + n0 + 4 * (lane & 7)));
#pragma unroll
    for (int i = 0; i < 8; ++i) { LAS float* d = scr + (8 * i + (lane >> 3)) * 33 + 4 * (lane & 7); d[0] = wv[i][0]; d[1] = wv[i][1]; d[2] = wv[i][2]; d[3] = wv[i][3]; }
    LDS_WAIT(); asm volatile("" ::: "memory");
    const int c = lane & 7;
#pragma unroll
    for (int j = 0; j < 4; ++j) { const int n = (lane >> 3) + 8 * j; const LAS float* s = scr + (8 * c) * 33 + n;
        v4u o; o.x = pk2(s[0 * 33], s[1 * 33]); o.y = pk2(s[2 * 33], s[3 * 33]); o.z = pk2(s[4 * 33], s[5 * 33]); o.w = pk2(s[6 * 33], s[7 * 33]);
        *(GAS v4u*)(WT + (size_t)(dn0 + n) * K + k0 + 8 * c) = o; }
    LDS_WAIT(); asm volatile("" ::: "memory");
}
__device__ __forceinline__ int even_col_map(int n0) { return n0 < 1536 ? n0 : (n0 < 1568 ? 3072 + (n0 - 1536) : n0 - 32); }

__device__ __forceinline__ void setup_work(Frame& F, const Params& P, int wgi, int nwg, int amask  , int mmask  , int eimask  , int eomask  , int omask  ) {
    unsigned char* ws = PWS;
    LAS float* scr = (LAS float*)(F.lds + F.wave * 16384);
    __syncthreads();
    {
        LAS float* S = (LAS float*)(F.lds);
        LAS float* R = (LAS float*)(F.lds + 40960);
        { const float* cp_ = PIN(I_C); const float* cc_ = PIN(I_CCTX);
          for (int i = F.tid; i < 9 * 1024; i += 512) { const int n = i >> 10, d = i & 1023; const float cv = n < 8 ? cp_[n * 1024 + d] : cc_[d]; S[i] = siluf(cv); } }
        const float* wada_ = PIN(I_WADA); const float* bada_ = PIN(I_BADA);
        __syncthreads();
        const int nl = __builtin_popcount(amask);
        for (int uu = wgi; uu < nl * 64; uu += nwg) {
            int li_ = uu >> 6, l = 0; { int m_ = amask; for (int k_ = 0; k_ < 4; ++k_) { if (m_ & 1) { if (li_ == 0) { l = k_; break; } --li_; } m_ >>= 1; } }
            const int cb = (uu & 63) * 96;
            if (F.tid < 384) {
                const int c4 = (F.tid % 24) * 4, part = F.tid / 24;
                const float* Wp = wada_ + ((size_t)l * 1024 + part * 64) * 6144 + cb + c4;
                f32x4 a[9];
#pragma unroll
                for (int n = 0; n < 9; ++n) a[n] = (f32x4){0.f, 0.f, 0.f, 0.f};
#pragma unroll 4
                for (int d = 0; d < 64; ++d) { const f32x4 w = __builtin_nontemporal_load((const f32x4*)(Wp + (size_t)d * 6144));
#pragma unroll
                    for (int n = 0; n < 9; ++n) a[n] += w * S[n * 1024 + part * 64 + d]; }
#pragma unroll
                for (int n = 0; n < 9; ++n) *(LAS f32x4*)(R + (part * 9 + n) * 96 + c4) = a[n];
            }
            __syncthreads();
            for (int i = F.tid; i < 9 * 96; i += 512) { const int n = i / 96, c = i % 96; float s = 0.f;
#pragma unroll
                for (int p = 0; p < 16; ++p) s += R[(p * 9 + n) * 96 + c];
                ((float*)(ws + WS_MOD))[((size_t)l * 9 + n) * 6144 + cb + c] = s + bada_[l * 6144 + cb + c]; }
            __syncthreads();
        }
    }
    {
        const int wk = wgi * NWAVES + F.wave, NW = nwg * NWAVES; int base = 0;
#define SEG(sel, count, ...) do { if (sel) { for (int q = (wk + NW - base % NW) % NW; q < (count); q += NW) { __VA_ARGS__; } base += (count); } } while (0)
        const int I_E = (1024 / 64) * (EVEN_N / 32), I_OE = 16 * 32, I_O = 16 * (ODD_N / 32), I_QB = 4 * 48, I_KVB = 4 * 64, I_M1 = 16 * 128, I_M2 = 64 * 32;
#pragma unroll
        for (int l = 0; l < 2; ++l) {
            SEG((eimask >> l) & 1, I_E, { const int nb = EVEN_N / 32, kb = q / nb, n0 = (q % nb) * 32;
                p0_transpose_item(PIN(I_WINE) + (size_t)l * 1024 * EVEN_N, 1024, EVEN_N, (bf16*)(ws + WS_WINE) + (size_t)l * EVEN_NP * 1024, kb, n0, even_col_map(n0), scr, F.lane); });
            SEG((eomask >> l) & 1, I_OE, { const int kb = q / 32, n0 = (q % 32) * 32;
                p0_transpose_item(PIN(I_WOUTE) + (size_t)l * 1024 * 1024, 1024, 1024, (bf16*)(ws + WS_WOUTE) + (size_t)l * 1024 * 1024, kb, n0, n0, scr, F.lane); });
            SEG((omask >> l) & 1, I_O, { const int nb = ODD_N / 32, kb = q / nb, n0 = (q % nb) * 32;
                p0_transpose_item(PIN(I_WINO) + (size_t)l * 1024 * ODD_N, 1024, ODD_N, (bf16*)(ws + WS_WINO) + (size_t)l * ODD_NP * 1024, kb, n0, n0, scr, F.lane); });
            SEG((omask >> l) & 1, I_QB, { const int kb = q / 48, n0 = (q % 48) * 32;
                p0_transpose_item(PIN(I_WQB) + (size_t)l * 256 * 1536, 256, 1536, (bf16*)(ws + WS_WQB) + (size_t)l * 1536 * 256, kb, n0, n0, scr, F.lane); });
            SEG((omask >> l) & 1, I_KVB, { const int kb = q / 64, n0 = (q % 64) * 32;
                p0_transpose_item(PIN(I_WKVB) + (size_t)l * 256 * 2048, 256, 2048, (bf16*)(ws + WS_WKVB) + (size_t)l * 2048 * 256, kb, n0, n0, scr, F.lane); });
            SEG((omask >> l) & 1, I_OE, { const int kb = q / 32, n0 = (q % 32) * 32;
                p0_transpose_item(PIN(I_WOUTO) + (size_t)l * 1024 * 1024, 1024, 1024, (bf16*)(ws + WS_WOUTO) + (size_t)l * 1024 * 1024, kb, n0, n0, scr, F.lane); });
        }
#pragma unroll
        for (int l = 0; l < 4; ++l) {
            SEG((mmask >> l) & 1, I_M1, { const int kb = q / 128, n0 = (q % 128) * 32;
                p0_transpose_item(PIN(I_W1) + (size_t)l * 1024 * 4096, 1024, 4096, (bf16*)(ws + WS_W1) + (size_t)l * 4096 * 1024, kb, n0, n0, scr, F.lane); });
            SEG((mmask >> l) & 1, I_M2, { const int kb = q / 32, n0 = (q % 32) * 32;
                p0_transpose_item(PIN(I_W2) + (size_t)l * 4096 * 1024, 4096, 1024, (bf16*)(ws + WS_W2) + (size_t)l * 1024 * 4096, kb, n0, n0, scr, F.lane); });
        }
#undef SEG
    }
    const int gt = wgi * 512 + F.tid, NGT = nwg * 512;
#pragma unroll
    for (int l = 0; l < 2; ++l) {
        if ((eimask >> l) & 1) for (int i = gt; i < 224 * 128; i += NGT) *(GAS v4u*)((bf16*)(ws + WS_WINE) + ((size_t)l * EVEN_NP + EVEN_N) * 1024 + (size_t)i * 8) = (v4u){0u, 0u, 0u, 0u};
        if ((omask >> l) & 1) for (int i = gt; i < 192 * 128; i += NGT) *(GAS v4u*)((bf16*)(ws + WS_WINO) + ((size_t)l * ODD_NP + ODD_N) * 1024 + (size_t)i * 8) = (v4u){0u, 0u, 0u, 0u};
    }
}
__device__ __forceinline__ void p0_prologue(Frame& F, const Params& P) {
    unsigned char* ws = PWS;
    setup_work(F, P, F.vcu, F.G, 0x5, 0x5, 0x3, 0x3, 0x0);
    const int gt = F.vcu * 512 + F.tid, NGT = F.G * 512;
    for (int i = gt; i < 2048 * 32; i += NGT) { const int t = i >> 5, j = i & 31; const float inv = powf(10000.0f, -(float)(j & 15) / 16.0f);
        const float ang = (float)(j < 16 ? (t >> 6) : (t & 63)) * inv;
        ((float*)(ws + WS_ROPE))[i] = cosf(ang); ((float*)(ws + WS_ROPE))[65536 + i] = sinf(ang); }
}

__device__ __forceinline__ void row_y(f32x4 (&yv)[4], const bf16* Y, const bf16* SL, int row, int l4) {
    if (row < 16384) {
#pragma unroll
        for (int j = 0; j < 4; ++j) { const v2u yw = __builtin_nontemporal_load((const v2u*)(Y + (size_t)row * D + l4 + 256 * j)); yv[j] = (f32x4){bflo(yw.x), bfhi(yw.x), bflo(yw.y), bfhi(yw.y)}; }
    } else {
        const bf16* sp = SL + (size_t)(row - 16384) * D + l4;
#pragma unroll
        for (int j = 0; j < 4; ++j) { const v2u w0 = __builtin_nontemporal_load((const v2u*)(sp + 256 * j)), w1 = __builtin_nontemporal_load((const v2u*)(sp + 4194304 + 256 * j)), w2 = __builtin_nontemporal_load((const v2u*)(sp + 2 * 4194304 + 256 * j)), w3 = __builtin_nontemporal_load((const v2u*)(sp + 3 * 4194304 + 256 * j));
            yv[j] = ((f32x4){bflo(w0.x), bfhi(w0.x), bflo(w0.y), bfhi(w0.y)} + (f32x4){bflo(w1.x), bfhi(w1.x), bflo(w1.y), bfhi(w1.y)}) +
                    ((f32x4){bflo(w2.x), bfhi(w2.x), bflo(w2.y), bfhi(w2.y)} + (f32x4){bflo(w3.x), bfhi(w3.x), bflo(w3.y), bfhi(w3.y)}); }
    }
}
struct RowVec { f32x4 gp[4], gt[4], gq[4], sc[4], sh[4]; };
__device__ __forceinline__ void row_post(f32x4 (&v)[4], const f32x4 (&yv)[4], const RowVec& R) {
    float s = 0.f;
#pragma unroll
    for (int j = 0; j < 4; ++j) s += (yv[j][0] * yv[j][0] + yv[j][1] * yv[j][1]) + (yv[j][2] * yv[j][2] + yv[j][3] * yv[j][3]);
    const float rstd = __builtin_amdgcn_rsqf(wave_sum(s) * (1.0f / 1024.0f) + EPS);
#pragma unroll
    for (int j = 0; j < 4; ++j) v[j] = v[j] + R.gt[j] * ((yv[j] * rstd) * R.gp[j]);
}
__device__ __forceinline__ void row_pass(Frame& F, const float* xa, const float* xb, bool xin_f32, bf16* XB, const bf16* Y, const bf16* SL, const float* g_post, const float* gate,
                                         const float* g_pre, const float* scale, const float* shift, bf16* H, bool has_post, bool has_pre) {
    const int gw = F.vcu * NWAVES + F.wave, NGW = F.G * NWAVES, l4 = F.lane * 4;
    RowVec R; int ncur = -1;
#pragma unroll
    for (int j = 0; j < 4; ++j) { R.gp[j] = has_post ? *(const f32x4*)(g_post + l4 + 256 * j) : (f32x4){0.f, 0.f, 0.f, 0.f}; R.gq[j] = has_pre ? *(const f32x4*)(g_pre + l4 + 256 * j) : (f32x4){0.f, 0.f, 0.f, 0.f};
        R.gt[j] = R.gp[j]; R.sc[j] = R.gp[j]; R.sh[j] = R.gp[j]; }
    for (int blk = gw; blk * 10 < M; blk += NGW) for (int i = 0; i < 10; i += 2) {
        const int row0 = blk * 10 + i; if (row0 >= M) break;
        const int n = row0 < M_CTX ? 8 : ((row0 - M_CTX) >> 11);
        if (n != ncur) { ncur = n;
#pragma unroll
            for (int j = 0; j < 4; ++j) { const int c = l4 + 256 * j;
                if (has_post) R.gt[j] = *(const f32x4*)(gate + (size_t)n * 6144 + c);
                if (has_pre) { R.sc[j] = *(const f32x4*)(scale + (size_t)n * 6144 + c); R.sh[j] = *(const f32x4*)(shift + (size_t)n * 6144 + c); } } }
        f32x4 v[2][4], yv[2][4];
#pragma unroll
        for (int q = 0; q < 2; ++q) { const int row = row0 + q;
            if (xin_f32) { const float* xr = row < M_CTX ? xa + (size_t)row * D : xb + (size_t)(row - M_CTX) * D;
#pragma unroll
                for (int j = 0; j < 4; ++j) v[q][j] = __builtin_nontemporal_load((const f32x4*)(xr + l4 + 256 * j));
            } else {
#pragma unroll
                for (int j = 0; j < 4; ++j) { const v2u xw = __builtin_nontemporal_load((const v2u*)(XB + (size_t)row * D + l4 + 256 * j)); v[q][j] = (f32x4){bflo(xw.x), bfhi(xw.x), bflo(xw.y), bfhi(xw.y)}; }
            }
            if (has_post) row_y(yv[q], Y, SL, row, l4); }
#pragma unroll
        for (int q = 0; q < 2; ++q) { const int row = row0 + q;
            if (has_post) {
                row_post(v[q], yv[q], R);
#pragma unroll
                for (int j = 0; j < 4; ++j) *(v2u*)(XB + (size_t)row * D + l4 + 256 * j) = (v2u){pk2(v[q][j][0], v[q][j][1]), pk2(v[q][j][2], v[q][j][3])};
            }
            if (has_pre) {
                float s = 0.f;
#pragma unroll
                for (int j = 0; j < 4; ++j) s += (v[q][j][0] * v[q][j][0] + v[q][j][1] * v[q][j][1]) + (v[q][j][2] * v[q][j][2] + v[q][j][3] * v[q][j][3]);
                const float rstd = __builtin_amdgcn_rsqf(wave_sum(s) * (1.0f / 1024.0f) + EPS);
#pragma unroll
                for (int j = 0; j < 4; ++j) { const f32x4 h = ((v[q][j] * rstd) * R.gq[j]) * (1.0f + R.sc[j]) + R.sh[j];
                    *(v2u*)(H + (size_t)row * D + l4 + 256 * j) = (v2u){pk2(h[0], h[1]), pk2(h[2], h[3])}; }
            } }
    }
}
__device__ __forceinline__ void row_pass_final(Frame& F, const XcdBarrier& bar, const bf16* XB, float* OUT, const bf16* Y, const bf16* SL, const float* g_post, const float* gate) {
    const int gw = F.vcu * NWAVES + F.wave, l4 = F.lane * 4;
    v2u xw[10][4];
#pragma unroll
    for (int i = 0; i < 10; ++i) { const int row = gw * 10 + i;
        if (row < M) {
#pragma unroll
            for (int j = 0; j < 4; ++j) xw[i][j] = __builtin_nontemporal_load((const v2u*)(XB + (size_t)row * D + l4 + 256 * j));
        } }
    xcd_barrier(bar);
    RowVec R; int ncur = -1;
#pragma unroll
    for (int j = 0; j < 4; ++j) { R.gp[j] = *(const f32x4*)(g_post + l4 + 256 * j); R.gt[j] = R.gp[j]; }
#pragma unroll
    for (int i = 0; i < 10; ++i) { const int row = gw * 10 + i;
        if (row < M) {
            const int n = row < M_CTX ? 8 : ((row - M_CTX) >> 11);
            if (n != ncur) { ncur = n;
#pragma unroll
                for (int j = 0; j < 4; ++j) R.gt[j] = *(const f32x4*)(gate + (size_t)n * 6144 + l4 + 256 * j); }
            f32x4 v[4], yv[4];
#pragma unroll
            for (int j = 0; j < 4; ++j) v[j] = (f32x4){bflo(xw[i][j].x), bfhi(xw[i][j].x), bflo(xw[i][j].y), bfhi(xw[i][j].y)};
            row_y(yv, Y, SL, row, l4); row_post(v, yv, R);
#pragma unroll
            for (int j = 0; j < 4; ++j) *(f32x4*)(OUT + (size_t)row * D + l4 + 256 * j) = v[j];
        } }
}

__device__ __forceinline__ int crow(int r, int hi) { return (r & 3) + 8 * (r >> 2) + 4 * hi; }
__device__ __forceinline__ unsigned cvtpk(float lo, float hi) { return pk2(lo, hi); }
#define SBAR() __builtin_amdgcn_sched_barrier(0)
__device__ __forceinline__ int vst_row(int k, int NB) { const int kk = (k & ~0xC) | ((k & 4) << 1) | ((k & 8) >> 1); return (kk >> 3) * NB * 512 + (kk & 7) * 64; }
__device__ __forceinline__ int vst(int k, int c, int NB) { return vst_row(k, NB) + (c >> 5) * 512 + (c & 31) * 2; }
__device__ __forceinline__ int v_rd_base(int lane) { return ((lane & 3) << 3) | (((lane >> 2) & 3) << 6) | (((lane >> 4) & 1) << 5) | (((lane >> 5) & 1) << 8); }
template <int OFF> __device__ __forceinline__ s16x4 tr_read(unsigned vb) { s16x4 r; asm volatile("ds_read_b64_tr_b16 %0, %1 offset:%2" : "=&v"(r) : "v"(vb), "i"(OFF) : "memory"); return r; }
#define PKF(L, H) ((bf16x8){L[0], L[1], L[2], L[3], H[0], H[1], H[2], H[3]})
#define PK4(P, BASE, OUT) do { unsigned a0_ = cvtpk(P[BASE + 0], P[BASE + 1]), a1_ = cvtpk(P[BASE + 2], P[BASE + 3]);   \
    unsigned b0_ = cvtpk(P[BASE + 4], P[BASE + 5]), b1_ = cvtpk(P[BASE + 6], P[BASE + 7]);                              \
    auto r0_ = __builtin_amdgcn_permlane32_swap(a0_, b0_, false, false); auto r1_ = __builtin_amdgcn_permlane32_swap(a1_, b1_, false, false); \
    v4u w_ = {r0_[0], r1_[0], r0_[1], r1_[1]}; OUT = __builtin_bit_cast(bf16x8, w_); } while (0)
__device__ __forceinline__ float fexp(float x) { return __builtin_amdgcn_exp2f(x * 1.4426950408889634f); }
__device__ __forceinline__ float logsig(float x) { return fminf(x, 0.f) - 0.6931471805599453f * __builtin_amdgcn_logf(1.0f + __builtin_amdgcn_exp2f(-1.4426950408889634f * fabsf(x))); }

constexpr int SC_T = 0  , SC_TSZ = 32768, SC_QD = 0, SC_KI = 8192, SC_VT = 16384, SC_ST = 65536, SC_BT = 81920  , SC_TOT = 114688, SC_DL = 115200  ;
__device__ __forceinline__ void scan_phase(Frame& F, const Params& P, int li) {
    unsigned char* ws = PWS;
    const bf16* PROJ = (const bf16*)(ws + WS_BIG);
    const float* ROPE = (const float*)(ws + WS_ROPE);
    LAS unsigned char* G = F.lds;
    const unsigned gaddr = (unsigned)(uintptr_t)G;
    const bool isP = F.wave >= 4; const int gw4 = F.wave & 3;
    const int ri = gw4 >> 1, dh = gw4 & 1;
#define SC_BAR() do { asm volatile("s_waitcnt lgkmcnt(0)" ::: "memory"); __builtin_amdgcn_s_barrier(); asm volatile("" ::: "memory"); } while (0)
#define SC_TOK(c, i) (dir == 0 ? 64 * (c) + (i) : L - 1 - (64 * (c) + (i)))
    for (int u0 = F.bid; u0 < 256; u0 += F.G) for (int kk_ = 0; kk_ < (u0 < 128 ? 1 : 2); ++kk_) {
        __syncthreads();
        const bool lat = u0 < 128; const int u = lat ? u0 : 2 * (u0 - 128) + kk_;
        const int sb = u >> 4, hh = (u >> 1) & 7, dir = u & 1;
        const int L = lat ? L_LAT : L_CTX, row0 = lat ? M_CTX + sb * L_LAT : sb * L_CTX, NC = L / 64;
        const bool gla = hh < 4; const int h = hh & 3;
        const int qc = (gla ? PC_QA : PC_QB) + h * 64, kc = (gla ? PC_KA : PC_KB) + h * 64, vc = (gla ? PC_VA : PC_VB) + h * 128, gkc = PC_GK + dir * 16;
        bf16* OUT = (bf16*)(ws + (dir == 0 ? WS_Y : WS_HB));
        const float* rdec_p = PIN(I_RDEC); const float* wgk2_p = PIN(I_WGK2); const float* bgk2_p = PIN(I_BGK2);
        const float lgr = gla ? 0.f : -fexp(rdec_p[(li * 2 + dir) * 4 + h]);
        f32x16 sacc[2]; sacc[0] = f32x16{}; sacc[1] = f32x16{}; v4u w2f = {0u, 0u, 0u, 0u}; float gbias = 0.f;
        { int t0_ = F.tid; asm volatile("" : "+v"(t0_)); const int lane = t0_ & 63, r32 = lane & 31, hi = lane >> 5;
          if (isP) {
              if (gla) { const int kcol = h * 64 + 32 * (gw4 & 1) + r32; const float* wp_ = wgk2_p + ((size_t)(li * 2 + dir) * 16 + 8 * hi) * 256 + kcol;
                  w2f = (v4u){pk2(wp_[0], wp_[256]), pk2(wp_[512], wp_[768]), pk2(wp_[1024], wp_[1280]), pk2(wp_[1536], wp_[1792])};
                  gbias = bgk2_p[(li * 2 + dir) * 256 + kcol]; }
              else if (t0_ < 256 + 192) ((LAS float*)(G + SC_DL))[t0_ - 256] = fexp(64.0f * lgr);
          } else {
              const float* S0 = (gla ? PIN(I_SGLA) : PIN(I_SRET)) + ((size_t)((sb * 2 + li) * 2 + dir) * 4 + h) * 8192;
              if (lat) {
#pragma unroll
                  for (int d = 0; d < 2; ++d)
#pragma unroll
                      for (int r = 0; r < 16; ++r) sacc[d][r] = S0[(32 * ri + crow(r, hi)) * 128 + 32 * (2 * dh + d) + r32];
              }
#pragma unroll
              for (int d = 0; d < 2; ++d)
#pragma unroll
                  for (int r = 0; r < 16; r += 2) { const unsigned w = pk2(sacc[d][r], sacc[d][r + 1]);
                      LAS unsigned char* sp_ = G + SC_ST + (hi + 4 * ri) * 2048 + (2 * dh + d) * 512 + r32 * 2 + ((r >> 3) & 1) * 4096 + ((r & 3) + 4 * ((r >> 2) & 1)) * 64;
                      *(LAS unsigned short*)sp_ = (unsigned short)w; *(LAS unsigned short*)(sp_ + 64) = (unsigned short)(w >> 16); }
          } }
        v4u pq0 = {}, pq1 = {}, pk0 = {}, pk1 = {}, pv[4] = {}; v4u pga = {0u, 0u, 0u, 0u}; float cs[16] = {}; float tsum = 0.f;
#define SC_LOADRAW(c) do { const unsigned ro_ = (unsigned)(row0 + SC_TOK(c, sti)) * (unsigned)(EVEN_NP * 2); const char* pc_ = (const char*)PROJ; \
        pq0 = *(const v4u*)(pc_ + (ro_ + (unsigned)(qc + 8 * c8) * 2u)); pq1 = *(const v4u*)(pc_ + (ro_ + (unsigned)(qc + 32 + 8 * c8) * 2u)); \
        pk0 = *(const v4u*)(pc_ + (ro_ + (unsigned)(kc + 8 * c8) * 2u)); pk1 = *(const v4u*)(pc_ + (ro_ + (unsigned)(kc + 32 + 8 * c8) * 2u)); \
        _Pragma("unroll") for (int m_ = 0; m_ < 4; ++m_) pv[m_] = *(const v4u*)(pc_ + (ro_ + (unsigned)(vc + c8 * 32 + 8 * m_) * 2u)); } while (0)
#define SC_LOADGK(c) do { pga = *(const v4u*)((const char*)PROJ + ((unsigned)(row0 + SC_TOK(c, 32 * (gw4 >> 1) + r32)) * (unsigned)(EVEN_NP * 2) + (unsigned)(gkc + 8 * hi) * 2u)); } while (0)
        if (isP && gla) { int t0_ = F.tid; asm volatile("" : "+v"(t0_)); const int r32 = t0_ & 31, hi = (t0_ >> 5) & 1; SC_LOADGK(0); }
        for (int s = -3; s < NC; ++s) {
            int tid_o = F.tid; asm volatile("" : "+v"(tid_o));
            const int lane = tid_o & 63, r32 = lane & 31, hi = lane >> 5, tgp = tid_o & 255, sti = tgp >> 2, c8 = tgp & 3;
            if (isP) {
                if (gla && s + 2 >= 0 && s + 2 < NC) {
                    const int th = gw4 >> 1, kq = 32 * (gw4 & 1) + r32; LAS float* BTw = (LAS float*)(G + SC_BT + ((s + 2) & 1) * 16384);
                    const float t0v = ((LAS float*)(G + SC_TOT))[kq]; const float pre = th ? t0v : 0.f;
#pragma unroll
                    for (int r = 0; r < 16; ++r) BTw[(32 * th + crow(r, hi)) * 64 + kq] = pre + cs[r];
                    if (th == 1 && hi == 0) ((LAS float*)(G + SC_DL))[((s + 2) % 3) * 64 + kq] = fexp(pre + tsum);
                }
                if (s + 1 >= 0 && s + 1 < NC) {
                    LAS unsigned char* T = G + SC_T + ((s + 1) & 1) * SC_TSZ;
                    float q[16], kk[16];
#define UNPK(dst, o, W_) do { const v4u w_ = (W_); dst[o + 0] = bflo(w_[0]); dst[o + 1] = bfhi(w_[0]); dst[o + 2] = bflo(w_[1]); dst[o + 3] = bfhi(w_[1]); dst[o + 4] = bflo(w_[2]); dst[o + 5] = bfhi(w_[2]); dst[o + 6] = bflo(w_[3]); dst[o + 7] = bfhi(w_[3]); } while (0)
                    UNPK(q, 0, pq0); UNPK(q, 8, pq1); UNPK(kk, 0, pk0); UNPK(kk, 8, pk1);
                    if (gla) {
                        const LAS float* BTr = (const LAS float*)(G + SC_BT + ((s + 1) & 1) * 16384) + sti * 64 + 8 * c8;
                        const f32x4 x0 = *(const LAS f32x4*)BTr, x1 = *(const LAS f32x4*)(BTr + 4), x2 = *(const LAS f32x4*)(BTr + 32), x3 = *(const LAS f32x4*)(BTr + 36);
#pragma unroll
                        for (int e = 0; e < 4; ++e) { const float e0 = fexp(x0[e]), e1 = fexp(x1[e]), e2 = fexp(x2[e]), e3 = fexp(x3[e]);
                            q[e] *= 0.125f * e0; kk[e] *= __builtin_amdgcn_rcpf(e0); q[4 + e] *= 0.125f * e1; kk[4 + e] *= __builtin_amdgcn_rcpf(e1);
                            q[8 + e] *= 0.125f * e2; kk[8 + e] *= __builtin_amdgcn_rcpf(e2); q[12 + e] *= 0.125f * e3; kk[12 + e] *= __builtin_amdgcn_rcpf(e3); }
                    } else {
                        if (lat) {
                            const float* cp = ROPE + (size_t)SC_TOK(s + 1, sti) * 32 + 8 * c8; const f32x4 c0 = *(const f32x4*)cp, c1 = *(const f32x4*)(cp + 4), s0 = *(const f32x4*)(cp + 65536), s1 = *(const f32x4*)(cp + 65540);
#pragma unroll
                            for (int e = 0; e < 8; ++e) { const float c = e < 4 ? c0[e & 3] : c1[e & 3], sn = e < 4 ? s0[e & 3] : s1[e & 3];
                                const float q1 = q[e], q2 = q[8 + e]; q[e] = q1 * c - q2 * sn; q[8 + e] = q1 * sn + q2 * c;
                                const float k1 = kk[e], k2 = kk[8 + e]; kk[e] = k1 * c - k2 * sn; kk[8 + e] = k1 * sn + k2 * c; }
                        }
                        const float bb = (float)(sti + 1) * lgr, eb = fexp(bb), ek = 0.125f * __builtin_amdgcn_rcpf(eb);
#pragma unroll
                        for (int e = 0; e < 16; ++e) { q[e] *= eb; kk[e] *= ek; }
                    }
                    *(LAS v4u*)(T + SC_QD + vst(sti, 8 * c8, 2)) = (v4u){pk2(q[0], q[1]), pk2(q[2], q[3]), pk2(q[4], q[5]), pk2(q[6], q[7])};
                    *(LAS v4u*)(T + SC_QD + vst(sti, 32 + 8 * c8, 2)) = (v4u){pk2(q[8], q[9]), pk2(q[10], q[11]), pk2(q[12], q[13]), pk2(q[14], q[15])};
                    *(LAS v4u*)(T + SC_KI + vst(sti, 8 * c8, 2)) = (v4u){pk2(kk[0], kk[1]), pk2(kk[2], kk[3]), pk2(kk[4], kk[5]), pk2(kk[6], kk[7])};
                    *(LAS v4u*)(T + SC_KI + vst(sti, 32 + 8 * c8, 2)) = (v4u){pk2(kk[8], kk[9]), pk2(kk[10], kk[11]), pk2(kk[12], kk[13]), pk2(kk[14], kk[15])};
#pragma unroll
                    for (int m = 0; m < 4; ++m) *(LAS v4u*)(T + SC_VT + vst(sti, c8 * 32 + 8 * m, 4)) = pv[m];
                }
                if (s + 2 >= 0 && s + 2 < NC) SC_LOADRAW(s + 2);
            } else if (s >= 0) {
                LAS unsigned char* T = G + SC_T + (s & 1) * SC_TSZ; const unsigned taddr = gaddr + SC_T + (s & 1) * SC_TSZ;
                bf16x8 qf[4]; bf16x8 pa0, pa1, pa2, pa3;
                { const int qb_ = vst_row(32 * ri + r32, 2) + 16 * hi;
                  qf[0] = *(const LAS bf16x8*)(T + SC_QD + qb_); qf[1] = *(const LAS bf16x8*)(T + SC_QD + qb_ + 32); qf[2] = *(const LAS bf16x8*)(T + SC_QD + qb_ + 512); qf[3] = *(const LAS bf16x8*)(T + SC_QD + qb_ + 544); }
                { f32x16 p0 = {}, p1 = {};
                  const int kb0 = vst_row(r32, 2) + 16 * hi, kb1 = vst_row(32 + r32, 2) + 16 * hi;
                  { const bf16x8 a0 = *(const LAS bf16x8*)(T + SC_KI + kb0), a1 = *(const LAS bf16x8*)(T + SC_KI + kb0 + 32), a2 = *(const LAS bf16x8*)(T + SC_KI + kb0 + 512), a3 = *(const LAS bf16x8*)(T + SC_KI + kb0 + 544);
                    p0 = __builtin_amdgcn_mfma_f32_32x32x16_bf16(a0, qf[0], p0, 0, 0, 0); p0 = __builtin_amdgcn_mfma_f32_32x32x16_bf16(a1, qf[1], p0, 0, 0, 0);
                    p0 = __builtin_amdgcn_mfma_f32_32x32x16_bf16(a2, qf[2], p0, 0, 0, 0); p0 = __builtin_amdgcn_mfma_f32_32x32x16_bf16(a3, qf[3], p0, 0, 0, 0); }
                  if (ri == 1) {
                      const bf16x8 c0 = *(const LAS bf16x8*)(T + SC_KI + kb1), c1 = *(const LAS bf16x8*)(T + SC_KI + kb1 + 32), c2 = *(const LAS bf16x8*)(T + SC_KI + kb1 + 512), c3 = *(const LAS bf16x8*)(T + SC_KI + kb1 + 544);
                      p1 = __builtin_amdgcn_mfma_f32_32x32x16_bf16(c0, qf[0], p1, 0, 0, 0); p1 = __builtin_amdgcn_mfma_f32_32x32x16_bf16(c1, qf[1], p1, 0, 0, 0);
                      p1 = __builtin_amdgcn_mfma_f32_32x32x16_bf16(c2, qf[2], p1, 0, 0, 0); p1 = __builtin_amdgcn_mfma_f32_32x32x16_bf16(c3, qf[3], p1, 0, 0, 0); }
#pragma unroll
                  for (int r = 0; r < 16; ++r) { const bool keep = crow(r, hi) <= r32; if (ri == 0) { p0[r] = keep ? p0[r] : 0.f; } else { p1[r] = keep ? p1[r] : 0.f; } }
                  PK4(p0, 0, pa0); PK4(p0, 8, pa1); PK4(p1, 0, pa2); PK4(p1, 8, pa3); }
                const unsigned vb = taddr + SC_VT + v_rd_base(lane) + dh * 1024, sbv = gaddr + SC_ST + v_rd_base(lane) + dh * 1024;
#define SC_FR4(dst, base, d) do { const s16x4 l0_ = tr_read<(d) * 512>(base), h0_ = tr_read<(d) * 512 + 2048>(base), l1_ = tr_read<(d) * 512 + 4096>(base), h1_ = tr_read<(d) * 512 + 4096 + 2048>(base); \
                  const s16x4 l2_ = tr_read<(d) * 512 + 8192>(base), h2_ = tr_read<(d) * 512 + 8192 + 2048>(base), l3_ = tr_read<(d) * 512 + 12288>(base), h3_ = tr_read<(d) * 512 + 12288 + 2048>(base); \
                  asm volatile("s_waitcnt lgkmcnt(0)" ::: "memory"); SBAR(); \
                  dst[0] = PKF(l0_, h0_); dst[1] = PKF(l1_, h1_); dst[2] = PKF(l2_, h2_); dst[3] = PKF(l3_, h3_); } while (0)
#define SC_OBLK(d) do { bf16x8 vf_[4], sf_[4]; SC_FR4(vf_, vb, d); SC_FR4(sf_, sbv, d); f32x16 o_ = {}; \
                  o_ = __builtin_amdgcn_mfma_f32_32x32x16_bf16(pa0, vf_[0], o_, 0, 0, 0); o_ = __builtin_amdgcn_mfma_f32_32x32x16_bf16(pa1, vf_[1], o_, 0, 0, 0); \
                  if (ri == 1) { o_ = __builtin_amdgcn_mfma_f32_32x32x16_bf16(pa2, vf_[2], o_, 0, 0, 0); o_ = __builtin_amdgcn_mfma_f32_32x32x16_bf16(pa3, vf_[3], o_, 0, 0, 0); } \
                  o_ = __builtin_amdgcn_mfma_f32_32x32x16_bf16(qf[0], sf_[0], o_, 0, 0, 0); o_ = __builtin_amdgcn_mfma_f32_32x32x16_bf16(qf[1], sf_[1], o_, 0, 0, 0); \
                  o_ = __builtin_amdgcn_mfma_f32_32x32x16_bf16(qf[2], sf_[2], o_, 0, 0, 0); o_ = __builtin_amdgcn_mfma_f32_32x32x16_bf16(qf[3], sf_[3], o_, 0, 0, 0); \
                  char* dst_ = (char*)OUT; \
                  _Pragma("unroll") for (int r = 0; r < 16; r += 2) { const int i_ = 32 * ri + crow(r, hi); const int t_ = SC_TOK(s, i_); const unsigned w_ = pk2(o_[r], o_[r + 1]); \
                      const unsigned a_ = (unsigned)(row0 + t_) * (unsigned)(D * 2) + (unsigned)(hh * 128 + 64 * dh + 32 * (d) + r32) * 2u; \
                      *(bf16*)(dst_ + a_) = (bf16)w_; *(bf16*)(dst_ + (dir == 0 ? a_ + (unsigned)(D * 2) : a_ - (unsigned)(D * 2))) = (bf16)(w_ >> 16); } SBAR(); } while (0)
                SC_OBLK(0); SC_OBLK(1);
            }
            SC_BAR();
            if (isP) {
                if (gla && s + 3 < NC) {
                    const int th = gw4 >> 1, kq = 32 * (gw4 & 1) + r32;
                    f32x16 gp;
#pragma unroll
                    for (int r = 0; r < 16; ++r) gp[r] = gbias;
                    gp = __builtin_amdgcn_mfma_f32_32x32x16_bf16(__builtin_bit_cast(bf16x8, pga), __builtin_bit_cast(bf16x8, w2f), gp, 0, 0, 0);
                    float g4[4], o4[4];
#pragma unroll
                    for (int j = 0; j < 4; ++j) { float run = 0.f;
#pragma unroll
                        for (int e = 0; e < 4; ++e) { run += logsig(gp[4 * j + e]) * (1.0f / 16.0f); cs[4 * j + e] = run; }
                        g4[j] = run; }
#pragma unroll
                    for (int j = 0; j < 4; ++j) o4[j] = __shfl_xor(g4[j], 32);
                    float acc_ = 0.f;
#pragma unroll
                    for (int j = 0; j < 4; ++j) { const float off = acc_ + (hi ? o4[j] : 0.f);
#pragma unroll
                        for (int e = 0; e < 4; ++e) cs[4 * j + e] += off;
                        acc_ += g4[j] + o4[j]; }
                    tsum = acc_;
                    if (hi == 0) ((LAS float*)(G + SC_TOT))[th * 64 + kq] = tsum;
                    if (s + 4 < NC) SC_LOADGK(s + 4);
                }
            } else if (s >= 0) {
                const unsigned taddr = gaddr + SC_T + (s & 1) * SC_TSZ;
                const unsigned vb = taddr + SC_VT + v_rd_base(lane) + dh * 1024, kt = taddr + SC_KI + v_rd_base(lane) + ri * 512;
                bf16x8 kf[4];
                { const s16x4 l0_ = tr_read<0>(kt), h0_ = tr_read<1024>(kt), l1_ = tr_read<2048>(kt), h1_ = tr_read<2048 + 1024>(kt), l2_ = tr_read<4096>(kt), h2_ = tr_read<4096 + 1024>(kt), l3_ = tr_read<6144>(kt), h3_ = tr_read<6144 + 1024>(kt);
                  asm volatile("s_waitcnt lgkmcnt(0)" ::: "memory"); SBAR();
                  kf[0] = PKF(l0_, h0_); kf[1] = PKF(l1_, h1_); kf[2] = PKF(l2_, h2_); kf[3] = PKF(l3_, h3_); }
                const int stb_ = (hi + 4 * ri) * 2048 + (2 * dh) * 512 + r32 * 2;
                const LAS float* DLr = (const LAS float*)(G + SC_DL) + (s % 3) * 64;
#define SC_SBLK(d) do { bf16x8 vf_[4]; SC_FR4(vf_, vb, d); \
                  _Pragma("unroll") for (int ks = 0; ks < 4; ++ks) sacc[d] = __builtin_amdgcn_mfma_f32_32x32x16_bf16(kf[ks], vf_[ks], sacc[d], 0, 0, 0); \
                  _Pragma("unroll") for (int r = 0; r < 16; r += 2) { const int dk = 32 * ri + crow(r, hi); const float dl0 = DLr[dk], dl1 = DLr[dk + 1]; \
                      sacc[d][r] *= dl0; sacc[d][r + 1] *= dl1; const unsigned w_ = pk2(sacc[d][r], sacc[d][r + 1]); \
                      LAS unsigned char* sp_ = G + SC_ST + stb_ + (d) * 512 + ((r >> 3) & 1) * 4096 + ((r & 3) + 4 * ((r >> 2) & 1)) * 64; \
                      *(LAS unsigned short*)sp_ = (unsigned short)w_; *(LAS unsigned short*)(sp_ + 64) = (unsigned short)(w_ >> 16); } SBAR(); } while (0)
                SC_SBLK(0); SC_SBLK(1);
            }
            SC_BAR();
        }
        if (!lat && !isP) { int l2 = F.lane; asm volatile("" : "+v"(l2)); const int r32 = l2 & 31, hi = l2 >> 5; float* SO = POUT + (gla ? OUT_SGLA : OUT_SRET) + ((size_t)((sb * 2 + li) * 2 + dir) * 4 + h) * 8192;
#pragma unroll
            for (int d = 0; d < 2; ++d)
#pragma unroll
                for (int r = 0; r < 16; ++r) SO[(32 * ri + crow(r, hi)) * 128 + 32 * (2 * dh + d) + r32] = sacc[d][r]; }
    }
#undef SC_TOK
#undef SC_BAR
#undef SC_LOADRAW
#undef SC_LOADGK
#undef UNPK
#undef SC_FR4
#undef SC_OBLK
#undef SC_SBLK
    if (F.G == 256 && F.bid >= 128) { if (li == 0) setup_work(F, P, F.bid - 128, 128, 0x2, 0x2, 0x0, 0x0, 0x1); else setup_work(F, P, F.bid - 128, 128, 0x8, 0x8, 0x0, 0x0, 0x2); }
    else if (F.G != 256) { if (li == 0) setup_work(F, P, F.bid, F.G, 0x2, 0x2, 0x0, 0x0, 0x1); else setup_work(F, P, F.bid, F.G, 0x8, 0x8, 0x0, 0x0, 0x2); }
}
__device__ __forceinline__ void scan_combine(Frame& F, const Params& P, int li) {
    unsigned char* ws = PWS;
    const char* PROJ = (const char*)(ws + WS_BIG); const char* OF = (const char*)(ws + WS_Y); char* OB = (char*)(ws + WS_HB);
    const int gw = F.vcu * NWAVES + F.wave, NGW = F.G * NWAVES, lane = F.lane, hh = lane >> 3, dv = (lane & 7) * 16;
    f32x4 gn[4];
    { const float* gp_ = PIN(I_GLAN) + li * 128 + dv;
#pragma unroll
      for (int j = 0; j < 4; ++j) gn[j] = hh < 4 ? *(const f32x4*)(gp_ + 4 * j) : (f32x4){1.f, 1.f, 1.f, 1.f}; }
    const unsigned gcol = (unsigned)((hh < 4 ? PC_GA : PC_GB) + (hh & 3) * 128 + dv) * 2u, ocol = (unsigned)(hh * 128 + dv) * 2u;
    for (int row = gw; row < M; row += 2 * NGW) {
        v4u a[2][2], b[2][2], g[2][2];
#pragma unroll
        for (int i = 0; i < 2; ++i) { const int r_ = row + i * NGW; if (r_ < M) {
            const unsigned off = (unsigned)r_ * (unsigned)(D * 2) + ocol, goff = (unsigned)r_ * (unsigned)(EVEN_NP * 2) + gcol;
            a[i][0] = __builtin_nontemporal_load((const v4u*)(OF + off)); a[i][1] = __builtin_nontemporal_load((const v4u*)(OF + off + 16)); b[i][0] = __builtin_nontemporal_load((const v4u*)(OB + off)); b[i][1] = __builtin_nontemporal_load((const v4u*)(OB + off + 16));
            g[i][0] = __builtin_nontemporal_load((const v4u*)(PROJ + goff)); g[i][1] = __builtin_nontemporal_load((const v4u*)(PROJ + goff + 16)); } }
#pragma unroll
        for (int i = 0; i < 2; ++i) { const int r_ = row + i * NGW; if (r_ < M) {
            const unsigned off = (unsigned)r_ * (unsigned)(D * 2) + ocol;
            float x[16], gg[16];
#pragma unroll
            for (int hf = 0; hf < 2; ++hf)
#pragma unroll
                for (int e = 0; e < 4; ++e) { x[8 * hf + 2 * e] = bflo(a[i][hf][e]) + bflo(b[i][hf][e]); x[8 * hf + 2 * e + 1] = bfhi(a[i][hf][e]) + bfhi(b[i][hf][e]);
                    gg[8 * hf + 2 * e] = bflo(g[i][hf][e]); gg[8 * hf + 2 * e + 1] = bfhi(g[i][hf][e]); }
            float ss = 0.f;
#pragma unroll
            for (int e = 0; e < 16; ++e) ss += x[e] * x[e];
            ss += __shfl_xor(ss, 1); ss += __shfl_xor(ss, 2); ss += __shfl_xor(ss, 4);
            const float rstd = __builtin_amdgcn_rsqf(ss * (1.0f / 128.0f) + EPS);
#pragma unroll
            for (int e = 0; e < 16; ++e) x[e] = x[e] * rstd * gn[e >> 2][e & 3] * siluf(gg[e]);
            *(v4u*)(OB + off) = (v4u){pk2(x[0], x[1]), pk2(x[2], x[3]), pk2(x[4], x[5]), pk2(x[6], x[7])};
            *(v4u*)(OB + off + 16) = (v4u){pk2(x[8], x[9]), pk2(x[10], x[11]), pk2(x[12], x[13]), pk2(x[14], x[15])}; } }
    }
}

__device__ __forceinline__ void cache_pass(Frame& F, const Params& P, int li) {
    unsigned char* ws = PWS;
    const int gt = F.vcu * 512 + F.tid, NGT = F.G * 512;
    const float* cckv_ = PIN(I_CCKV); const float* ckpe_ = PIN(I_CKPE);
    for (int i = gt; i < 8 * 256 * 32; i += NGT) { const int c8 = i & 31, t = (i >> 5) & 255, b = i >> 13;
        const float* s = cckv_ + ((size_t)((b * 2 + li) * 256 + t) * 32 + c8) * 8; const f32x4 a = *(const f32x4*)s, c = *(const f32x4*)(s + 4);
        *(GAS v4u*)((bf16*)(ws + WS_ACKV) + ((size_t)4096 + b * LKV + t) * 256 + c8 * 8) = (v4u){pk2(a[0], a[1]), pk2(a[2], a[3]), pk2(c[0], c[1]), pk2(c[2], c[3])}; }
    for (int i = gt; i < 8 * 256 * 8; i += NGT) { const int c8 = i & 7, t = (i >> 3) & 255, b = i >> 11;
        const float* s = ckpe_ + ((size_t)((b * 2 + li) * 256 + t) * 8 + c8) * 8; const f32x4 a = *(const f32x4*)s, c = *(const f32x4*)(s + 4);
        *(GAS v4u*)((bf16*)(ws + WS_KPE) + ((size_t)4096 + b * LKV + t) * 64 + c8 * 8) = (v4u){pk2(a[0], a[1]), pk2(a[2], a[3]), pk2(c[0], c[1]), pk2(c[2], c[3])}; }
}
__device__ __forceinline__ void kpe_pass(Frame& F, const Params& P, int li) {
    unsigned char* ws = PWS;
    const float* KR = (const float*)(ws + WS_Y); const float* ROPE = (const float*)(ws + WS_ROPE);
    bf16* KPE = (bf16*)(ws + WS_KPE);
    const int gt = F.vcu * 512 + F.tid, NGT = F.G * 512;
    for (int i = gt; i < M * 4; i += NGT) {
        const int row = i >> 2, c8 = i & 3;
        const float* s = KR + (size_t)row * 64 + 8 * c8;
        f32x4 a0 = *(const f32x4*)s, a1 = *(const f32x4*)(s + 4), b0 = *(const f32x4*)(s + 32), b1 = *(const f32x4*)(s + 36);
        int drow = row;
        if (row >= M_CTX) { const int lb = (row - M_CTX) >> 11, t = (row - M_CTX) & 2047; drow = M_CTX + lb * LKV + PAST + t;
            const float* cp = ROPE + (size_t)t * 32 + 8 * c8; const float* sp = cp + 65536;
            const f32x4 c0 = *(const f32x4*)cp, c1 = *(const f32x4*)(cp + 4), s0 = *(const f32x4*)sp, s1 = *(const f32x4*)(sp + 4);
            const f32x4 x0 = a0 * c0 - b0 * s0, x1 = a1 * c1 - b1 * s1, y0 = a0 * s0 + b0 * c0, y1 = a1 * s1 + b1 * c1;
            a0 = x0; a1 = x1; b0 = y0; b1 = y1; }
        bf16* d = KPE + (size_t)drow * 64 + 8 * c8;
        *(v4u*)d = (v4u){pk2(a0[0], a0[1]), pk2(a0[2], a0[3]), pk2(a1[0], a1[1]), pk2(a1[2], a1[3])};
        *(v4u*)(d + 32) = (v4u){pk2(b0[0], b0[1]), pk2(b0[2], b0[3]), pk2(b1[0], b1[1]), pk2(b1[2], b1[3])};
    }
}

constexpr float ATT_SCALE = 0.07216878364870322f;
constexpr float ATT_THR = 8.f;
constexpr int AT_V = 0, AT_KN = 49152, AT_KP = 98304, AT_WS = 122880, AT_VB = 16384, AT_KNB = 16384, AT_KPB = 8192;
#define KSWZ(row, colB) ((row) * 256 + ((colB) ^ (((row) & 7) << 4)))
#define KPSWZ(row, colB) ((row) * 128 + ((colB) ^ (((row) & 7) << 4)))
__device__ __forceinline__ void at_partialSM(f32x16& p0, f32x16& p1, float& m_reg, float& mn, float& alpha) {
    constexpr float C = ATT_SCALE * 1.4426950408889634f;
    float pmax = p0[0];
#pragma unroll
    for (int r = 1; r < 16; ++r) pmax = fmaxf(pmax, p0[r]);
#pragma unroll
    for (int r = 0; r < 16; ++r) pmax = fmaxf(pmax, p1[r]);
    { auto rr = __builtin_amdgcn_permlane32_swap(__float_as_uint(pmax), __float_as_uint(pmax), false, false); pmax = fmaxf(__uint_as_float(rr[0]), __uint_as_float(rr[1])); }
    if (__builtin_expect(__all(pmax - m_reg <= ATT_THR / ATT_SCALE), 1)) { mn = m_reg; alpha = 1.f; }
    else { mn = fmaxf(m_reg, pmax); alpha = __builtin_amdgcn_exp2f((m_reg - mn) * C); m_reg = mn; }
    const float mnC = -mn * C;
#pragma unroll
    for (int r = 0; r < 16; ++r) p0[r] = fmaf(p0[r], C, mnC);
#pragma unroll
    for (int r = 0; r < 16; ++r) p1[r] = fmaf(p1[r], C, mnC);
#pragma unroll
    for (int r = 0; r < 16; ++r) p0[r] = __builtin_amdgcn_exp2f(p0[r]);
}
__device__ __forceinline__ void at_finishSM(f32x16& p0, f32x16& p1, float alpha, float& l_reg, bf16x8& pa0, bf16x8& pa1, bf16x8& pa2, bf16x8& pa3) {
#pragma unroll
    for (int r = 0; r < 16; ++r) p1[r] = __builtin_amdgcn_exp2f(p1[r]);
    float ps = 0;
#pragma unroll
    for (int r = 0; r < 16; ++r) ps += p0[r];
#pragma unroll
    for (int r = 0; r < 16; ++r) ps += p1[r];
    { auto rr = __builtin_amdgcn_permlane32_swap(__float_as_uint(ps), __float_as_uint(ps), false, false); ps = __uint_as_float(rr[0]) + __uint_as_float(rr[1]); }
    l_reg = l_reg * alpha + ps;
    PK4(p0, 0, pa0); PK4(p0, 8, pa1); PK4(p1, 0, pa2); PK4(p1, 8, pa3);
}
__device__ __forceinline__ void at_qkt(f32x16& p0, f32x16& p1, const LAS unsigned char* Kn, const LAS unsigned char* Kp, const bf16x8* qr, const int* kb, const int* pb) {
    p0 = f32x16{}; p1 = f32x16{};
#pragma unroll
    for (int d0 = 0; d0 < 8; ++d0) {
        const bf16x8 b0 = *(const LAS bf16x8*)(Kn + kb[d0 & 3] + 128 * (d0 >> 2)), b1 = *(const LAS bf16x8*)(Kn + kb[d0 & 3] + 128 * (d0 >> 2) + 8192);
        p0 = __builtin_amdgcn_mfma_f32_32x32x16_bf16(b0, qr[d0], p0, 0, 0, 0);
        p1 = __builtin_amdgcn_mfma_f32_32x32x16_bf16(b1, qr[d0], p1, 0, 0, 0); }
#pragma unroll
    for (int d0 = 0; d0 < 4; ++d0) {
        const bf16x8 b0 = *(const LAS bf16x8*)(Kp + pb[d0]), b1 = *(const LAS bf16x8*)(Kp + pb[d0] + 4096);
        p0 = __builtin_amdgcn_mfma_f32_32x32x16_bf16(b0, qr[8 + d0], p0, 0, 0, 0);
        p1 = __builtin_amdgcn_mfma_f32_32x32x16_bf16(b1, qr[8 + d0], p1, 0, 0, 0); }
}
template <int D0> __device__ __forceinline__ void at_pv_one(f32x16& od, unsigned vb, bf16x8 pa0, bf16x8 pa1, bf16x8 pa2, bf16x8 pa3) {
    const s16x4 l0 = tr_read<D0 * 512>(vb), h0 = tr_read<D0 * 512 + 2048>(vb), l1 = tr_read<D0 * 512 + 4096>(vb), h1 = tr_read<D0 * 512 + 4096 + 2048>(vb);
    const s16x4 l2 = tr_read<D0 * 512 + 8192>(vb), h2 = tr_read<D0 * 512 + 8192 + 2048>(vb), l3 = tr_read<D0 * 512 + 12288>(vb), h3 = tr_read<D0 * 512 + 12288 + 2048>(vb);
    asm volatile("s_waitcnt lgkmcnt(0)" ::: "memory"); SBAR();
    od = __builtin_amdgcn_mfma_f32_32x32x16_bf16(pa0, PKF(l0, h0), od, 0, 0, 0);
    od = __builtin_amdgcn_mfma_f32_32x32x16_bf16(pa1, PKF(l1, h1), od, 0, 0, 0);
    od = __builtin_amdgcn_mfma_f32_32x32x16_bf16(pa2, PKF(l2, h2), od, 0, 0, 0);
    od = __builtin_amdgcn_mfma_f32_32x32x16_bf16(pa3, PKF(l3, h3), od, 0, 0, 0);
}
__device__ __forceinline__ void at_pv(f32x16* o, unsigned vb, bf16x8 pa0, bf16x8 pa1, bf16x8 pa2, bf16x8 pa3) {
    at_pv_one<0>(o[0], vb, pa0, pa1, pa2, pa3); at_pv_one<1>(o[1], vb, pa0, pa1, pa2, pa3); at_pv_one<2>(o[2], vb, pa0, pa1, pa2, pa3); at_pv_one<3>(o[3], vb, pa0, pa1, pa2, pa3);
}
__device__ __forceinline__ void attn_unit(Frame& F, const bf16* Qrow0  , const bf16* KVh  , const bf16* KPEs  ,
                                          bf16* Orow0, int nkeys, const float* ROPE, int tpos0  ) {
    LAS unsigned char* lds = F.lds;
    const int tid = F.tid, wid = F.wave, lane = F.lane, r32 = lane & 31, hi = lane >> 5;
    LAS float* wsf = (LAS float*)(lds + AT_WS) + wid * 64; LAS float* li_l = wsf; LAS float* al_l = wsf + 32;
    float m_reg = -1e30f, l_reg = 0; f32x16 o[4] = {}; bf16x8 qr[12];
    { const bf16* Qw = Qrow0 + (size_t)(wid * 32 + r32) * 1536 + hi * 8;
#pragma unroll
      for (int d0 = 0; d0 < 12; ++d0) qr[d0] = *(const bf16x8*)(Qw + d0 * 16);
      if (tpos0 >= 0) {
          const int t = tpos0 + wid * 32 + r32;
#pragma unroll
          for (int half = 0; half < 2; ++half) {
              const float* cp = ROPE + (size_t)t * 32 + 16 * half + 8 * hi; const float* sp = cp + 65536;
              const v4u xa = __builtin_bit_cast(v4u, qr[8 + half]), xb = __builtin_bit_cast(v4u, qr[10 + half]);
              float x1[8], x2[8];
              x1[0] = bflo(xa.x); x1[1] = bfhi(xa.x); x1[2] = bflo(xa.y); x1[3] = bfhi(xa.y); x1[4] = bflo(xa.z); x1[5] = bfhi(xa.z); x1[6] = bflo(xa.w); x1[7] = bfhi(xa.w);
              x2[0] = bflo(xb.x); x2[1] = bfhi(xb.x); x2[2] = bflo(xb.y); x2[3] = bfhi(xb.y); x2[4] = bflo(xb.z); x2[5] = bfhi(xb.z); x2[6] = bflo(xb.w); x2[7] = bfhi(xb.w);
              float y1[8], y2[8];
#pragma unroll
              for (int j = 0; j < 8; ++j) { const float c = cp[j], s = sp[j]; y1[j] = x1[j] * c - x2[j] * s; y2[j] = x1[j] * s + x2[j] * c; }
              const v4u wa = {pk2(y1[0], y1[1]), pk2(y1[2], y1[3]), pk2(y1[4], y1[5]), pk2(y1[6], y1[7])}, wb = {pk2(y2[0], y2[1]), pk2(y2[2], y2[3]), pk2(y2[4], y2[5]), pk2(y2[6], y2[7])};
              if (half == 0) { qr[8] = __builtin_bit_cast(bf16x8, wa); qr[10] = __builtin_bit_cast(bf16x8, wb); } else { qr[9] = __builtin_bit_cast(bf16x8, wa); qr[11] = __builtin_bit_cast(bf16x8, wb); }
          }
      } }
    const unsigned vb0 = (unsigned)(uintptr_t)(lds + AT_V) + v_rd_base(lane);
#define AT_OPQ() int l_ = lane; asm volatile("" : "+v"(l_))
#define AT_KADDR() int kbs[4], pbs[4]; { AT_OPQ(); _Pragma("unroll") for (int b = 0; b < 4; ++b) { const int x = (32 * b + 16 * (l_ >> 5)) ^ ((l_ & 7) << 4); kbs[b] = (l_ & 31) * 256 + x; pbs[b] = (l_ & 31) * 128 + x; } }
#define AT_GLDS(gp, ldsoff) __builtin_amdgcn_global_load_lds((const unsigned*)(gp), (LAS unsigned*)(lds + (ldsoff)), 16, 0, 0)
#define AT_DMA_K(t, b) do { AT_OPQ(); const char* kb_ = (const char*)KVh + (size_t)(t) * (64 * 4096); const char* pb_ = (const char*)KPEs + (size_t)(t) * (64 * 128); \
    const int row0_ = 4 * wid + (l_ >> 4), cB0_ = ((l_ & 15) * 16) ^ ((row0_ & 7) << 4), row1_ = row0_ + 32, rowp_ = 8 * wid + (l_ >> 3), cBp_ = ((l_ & 7) * 16) ^ ((rowp_ & 7) << 4); \
    AT_GLDS(kb_ + (unsigned)(row0_ * 4096 + cB0_), AT_KN + (b) * AT_KNB + wid * 1024); AT_GLDS(kb_ + (unsigned)(row1_ * 4096 + cB0_), AT_KN + (b) * AT_KNB + (wid + 8) * 1024); \
    AT_GLDS(pb_ + (unsigned)(rowp_ * 128 + cBp_), AT_KP + (b) * AT_KPB + wid * 1024); } while (0)
#define AT_DMA_V(t, b) do { AT_OPQ(); const char* vb_ = (const char*)KVh + (size_t)(t) * (64 * 4096); \
    const int st_ = 2 * wid + (l_ >> 5), kk_ = (st_ >> 2) * 8 + ((l_ & 31) >> 2), key_ = (kk_ & ~0xC) | ((kk_ & 4) << 1) | ((kk_ & 8) >> 1), col_ = (st_ & 3) * 32 + (l_ & 3) * 8; \
    AT_GLDS(vb_ + (unsigned)(key_ * 4096 + (128 + col_) * 2), AT_V + (b) * AT_VB + wid * 1024); AT_GLDS(vb_ + (unsigned)((key_ + 32) * 4096 + (128 + col_) * 2), AT_V + (b) * AT_VB + (wid + 8) * 1024); } while (0)
#define AT_RESC(a) do { if (__any((a) < 1.f)) { if (hi == 0) al_l[r32] = (a); asm volatile("s_waitcnt lgkmcnt(0)" ::: "memory"); \
    _Pragma("unroll") for (int d = 0; d < 4; ++d) _Pragma("unroll") for (int r = 0; r < 16; ++r) o[d][r] *= al_l[crow(r, hi)]; } } while (0)
#define AT_WAITBAR(N) do { asm volatile("s_waitcnt vmcnt(" #N ") lgkmcnt(0)" ::: "memory"); __builtin_amdgcn_s_barrier(); asm volatile("" ::: "memory"); } while (0)
    f32x16 pA0, pA1, pB0, pB1; float mnA, mnB, alA, alB; bf16x8 pa0, pa1, pa2, pa3; const int NT = nkeys / 64;
    AT_DMA_K(0, 0); AT_DMA_K(1, 1); AT_DMA_V(0, 0); AT_WAITBAR(0);
    int s = 0;
#define AT_S1 (s == 2 ? 0 : s + 1)
#define AT_S2 (s == 0 ? 2 : s - 1)
#define AT_STEP(CUR0, CUR1, MNC, ALC, PRV0, PRV1, ALP, t, MODE) do { \
        if (MODE == 2) { AT_DMA_K((t) + 2, AT_S2); } if (MODE >= 1) { AT_DMA_V((t) + 1, AT_S1); } \
        SBAR(); { AT_KADDR(); at_qkt(CUR0, CUR1, lds + AT_KN + s * AT_KNB, lds + AT_KP + s * AT_KPB, qr, kbs, pbs); } \
        at_finishSM(PRV0, PRV1, ALP, l_reg, pa0, pa1, pa2, pa3); SBAR(); \
        at_pv(o, vb0 + AT_S2 * AT_VB, pa0, pa1, pa2, pa3); at_partialSM(CUR0, CUR1, m_reg, MNC, ALC); \
        AT_RESC(ALC); if (MODE == 2) AT_WAITBAR(5); else if (MODE == 1) AT_WAITBAR(2); else AT_WAITBAR(0); s = AT_S1; } while (0)
    AT_DMA_K(2, 2); AT_DMA_V(1, 1);
    { AT_KADDR(); at_qkt(pA0, pA1, lds + AT_KN, lds + AT_KP, qr, kbs, pbs); } at_partialSM(pA0, pA1, m_reg, mnA, alA);
    AT_WAITBAR(5); s = 1;
    int t = 1;
    for (; t + 4 < NT; t += 2) {
        AT_STEP(pB0, pB1, mnB, alB, pA0, pA1, alA, t, 2);
        AT_STEP(pA0, pA1, mnA, alA, pB0, pB1, alB, t + 1, 2);
    }
    AT_STEP(pB0, pB1, mnB, alB, pA0, pA1, alA, NT - 3, 2);
    AT_STEP(pA0, pA1, mnA, alA, pB0, pB1, alB, NT - 2, 1);
    AT_STEP(pB0, pB1, mnB, alB, pA0, pA1, alA, NT - 1, 0);
    at_finishSM(pB0, pB1, alB, l_reg, pa0, pa1, pa2, pa3); SBAR();
    at_pv(o, vb0 + AT_S2 * AT_VB, pa0, pa1, pa2, pa3);
    if (hi == 0) li_l[r32] = l_reg; asm volatile("s_waitcnt lgkmcnt(0)" ::: "memory");
    float rli[16];
#pragma unroll
    for (int r = 0; r < 16; ++r) rli[r] = __builtin_amdgcn_rcpf(li_l[crow(r, hi)]);
    bf16* Ow = Orow0 + (size_t)(wid * 32) * D;
#pragma unroll
    for (int r = 0; r < 16; r += 2) { const int orow = crow(r, hi);
#pragma unroll
        for (int d0 = 0; d0 < 4; ++d0) { const unsigned w = pk2(o[d0][r] * rli[r], o[d0][r + 1] * rli[r + 1]);
            Ow[(size_t)orow * D + d0 * 32 + r32] = (bf16)w; Ow[(size_t)(orow + 1) * D + d0 * 32 + r32] = (bf16)(w >> 16); } }
#undef AT_GLDS
#undef AT_OPQ
#undef AT_KADDR
#undef AT_DMA_K
#undef AT_DMA_V
#undef AT_RESC
#undef AT_WAITBAR
#undef AT_S1
#undef AT_S2
#undef AT_STEP
}
__device__ __forceinline__ void attn_phase(Frame& F, const Params& P, int li) {
    unsigned char* ws = PWS;
    const bf16* Q = (const bf16*)(ws + WS_Q); const bf16* KV = (const bf16*)(ws + WS_KV); const bf16* KPE = (const bf16*)(ws + WS_KPE);
    bf16* OB = (bf16*)(ws + WS_HB); const float* ROPE = (const float*)(ws + WS_ROPE);
    for (int u = F.vcu; u < 256 + 128; u += F.G) {
        for (int k = 0; k < 2; ++k) {
            int qrow0, kvrow0, nkeys, h, tpos0;
            if (u < 256) { const int id = 2 * u + k, lb = id >> 6, qb = id & 7; h = (id >> 3) & 7; qrow0 = M_CTX + lb * L_LAT + qb * 256; kvrow0 = M_CTX + lb * LKV; nkeys = LKV; tpos0 = qb * 256; }
            else { if (k == 1) break; const int id = u - 256, b = id >> 3; h = id & 7; qrow0 = b * L_CTX; kvrow0 = b * L_CTX; nkeys = L_CTX; tpos0 = -1; }
            __syncthreads();
            attn_unit(F, Q + (size_t)qrow0 * 1536 + h * 192, KV + (size_t)kvrow0 * 2048 + h * 256, KPE + (size_t)kvrow0 * 64, OB + (size_t)qrow0 * D + h * 128, nkeys, ROPE, tpos0);
        }
    }
}

constexpr int N_PHASES = 2 + 2 * 16;
__global__ void __launch_bounds__(NWAVES * 64, 2) hyb_fwd(Params P) {
    extern __shared__ __attribute__((aligned(16))) unsigned char lds_raw[];
    Frame F;
    F.lds = (LAS unsigned char*)lds_raw;
    F.tid = threadIdx.x; F.lane = F.tid & 63; F.wave = __builtin_amdgcn_readfirstlane(F.tid >> 6);
    F.G = gridDim.x; { const int bx = blockIdx.x; F.vcu = (F.G % 8 == 0) ? (bx % 8) * (F.G / 8) + bx / 8 : bx; }
    volatile LAS unsigned* MISC = (volatile LAS unsigned*)(F.lds + LDS_MISC);
    if (F.tid < 64) MISC[F.tid] = 0u;
    if (F.tid < 30) { const unsigned long long v = F.tid < 28 ? (unsigned long long)P.in[F.tid] : (F.tid == 28 ? (unsigned long long)P.out : (unsigned long long)P.ws);
        volatile LAS unsigned* pt = (volatile LAS unsigned*)(F.lds + LDS_PT) + 2 * F.tid; pt[0] = (unsigned)v; pt[1] = (unsigned)(v >> 32); }
    __syncthreads();
    const int use_bar = P.use_bar, ph_hi = P.ph_hi;
    XcdBarrier bar; bar.bar = (unsigned*)(PWS + WS_CTL) + 4096; bar.x = 0; bar.st = nullptr;
    if (use_bar) bar = xcd_barrier_post((unsigned*)(PWS + WS_CTL) + 4096, MISC + 8);

    for (int ph = P.ph_lo; ph < ph_hi; ++ph) {
#define REFRESH_ID() do { int t_ = threadIdx.x; asm volatile("" : "+v"(t_)); F.tid = t_; F.lane = t_ & 63; F.wave = __builtin_amdgcn_readfirstlane(t_ >> 6); \
          int g_ = gridDim.x, b_ = blockIdx.x; asm volatile("" : "+s"(g_), "+s"(b_)); F.G = g_; F.vcu = (g_ % 8 == 0) ? (b_ % 8) * (g_ / 8) + b_ / 8 : b_; F.bid = b_; } while (0)
        REFRESH_ID();
        unsigned char* ws = PWS;
        bf16* XBF = (bf16*)(POUT + OUT_Y);
        bf16* HB = (bf16*)(ws + WS_HB); bf16* YB = (bf16*)(ws + WS_Y); const bf16* SL = (const bf16*)(ws + WS_SLAB);
        const float* MOD = (const float*)(ws + WS_MOD);
        if (ph == 0) { p0_prologue(F, P); }
        else if (ph == 1) {
            const float* m0 = MOD;
            row_pass(F, PIN(I_XP), PIN(I_XS), true, nullptr, nullptr, nullptr, nullptr, nullptr, PIN(I_NMIXPRE), m0 + 1024, m0, HB, false, true);
        } else {
            const int q = ph - 2, pair = q / 16, r = q % 16; const bool odd = r >= 8; const int l = 2 * pair + (odd ? 1 : 0), k = odd ? r - 8 : r;
            const float* ml = MOD + (size_t)l * 9 * 6144;
            const int kind = k < 3 ? (odd ? 10 + k : (k == 2 ? 8 : k)) : (k == 3 ? 2 : k == 4 ? 3 : k == 5 ? 4 : k == 6 ? 5 : 6);
            if (kind == 0) {
                pg8::Gemm g{HB, (const bf16*)(ws + WS_WINE) + (size_t)pair * EVEN_NP * 1024, M, EVEN_NP, 1024}; pg8::StaticOrder S; S.init(M, EVEN_NP, F.G, F.bid, 1024);
                pg8::EpiBf16<0> E{(bf16*)(ws + WS_BIG), EVEN_NP};
                pg8::gemm_phase<pg8::EpiBf16<0>, pg8::StaticOrder, true, true>(F.lds, g, S, E, F.tid);
            } else if (kind == 1) {
                scan_phase(F, P, pair);
            } else if (kind == 8) {
                scan_combine(F, P, pair);
            } else if (kind == 2) {
                const bf16* W = odd ? (const bf16*)(ws + WS_WOUTO) + (size_t)pair * 1024 * 1024 : (const bf16*)(ws + WS_WOUTE) + (size_t)pair * 1024 * 1024;
                pg8::Gemm g{HB, W, M, 1024, 1024}; pg8::TailSplitOrder S; S.init(F.bid, 1024, 0);
                pg8::EpiYsplit E{YB, (bf16*)(ws + WS_SLAB)};
                pg8::gemm_phase<pg8::EpiYsplit, pg8::TailSplitOrder, true, true>(F.lds, g, S, E, F.tid);
            } else if (kind == 3) {
                row_pass(F, PIN(I_XP), PIN(I_XS), l == 0, XBF, YB, SL, PIN(I_NMIXPOST) + l * 1024, ml + 2048, PIN(I_NMLPPRE) + l * 1024, ml + 4096, ml + 3072, HB, true, true);
            } else if (kind == 4) {
                pg8::Gemm g{HB, (const bf16*)(ws + WS_W1) + (size_t)l * 4096 * 1024, M, FF, 1024}; pg8::StaticOrder S; S.init(M, FF, F.G, F.bid, 1024);
                pg8::EpiBf16<1> E{(bf16*)(ws + WS_BIG), FF};
                pg8::gemm_phase<pg8::EpiBf16<1>, pg8::StaticOrder, true, true>(F.lds, g, S, E, F.tid);
            } else if (kind == 5) {
                pg8::Gemm g{(const bf16*)(ws + WS_BIG), (const bf16*)(ws + WS_W2) + (size_t)l * 1024 * 4096, M, 1024, FF}; pg8::TailSplitOrder S; S.init(F.bid, FF, 0);
                pg8::EpiYsplit E{YB, (bf16*)(ws + WS_SLAB)};
                pg8::gemm_phase<pg8::EpiYsplit, pg8::TailSplitOrder, true, true>(F.lds, g, S, E, F.tid);
            } else if (kind == 6) {
                const float* mn = ml + 9 * 6144;
                if (l < 3) row_pass(F, nullptr, nullptr, false, XBF, YB, SL, PIN(I_NMLPPOST) + l * 1024, ml + 5120, PIN(I_NMIXPRE) + (l + 1) * 1024, mn + 1024, mn, HB, true, true);
                else { bar.bar = (unsigned*)(PWS + WS_CTL) + 4096; row_pass_final(F, bar, XBF, POUT + OUT_Y, YB, SL, PIN(I_NMLPPOST) + l * 1024, ml + 5120); }
            } else if (kind == 10) {
                pg8::Gemm g{HB, (const bf16*)(ws + WS_WINO) + (size_t)pair * ODD_NP * 1024, M, ODD_NP, 1024}; pg8::StaticOrder S; S.init(M, ODD_NP, F.G, F.bid, 1024);
                pg8::EpiOddIn E{(bf16*)(ws + WS_QN), (bf16*)(ws + WS_ACKV), (float*)(ws + WS_Y), POUT + OUT_CKV, POUT + OUT_KPE,
                                PIN(I_QAN) + pair * 256, PIN(I_KVAN) + pair * 256, pair};
                pg8::gemm_phase<pg8::EpiOddIn, pg8::StaticOrder, false, true>(F.lds, g, S, E, F.tid);
                REFRESH_ID(); cache_pass(F, P, pair);
            } else if (kind == 11) {
                kpe_pass(F, P, pair); REFRESH_ID();
                { pg8::Gemm g{(const bf16*)(ws + WS_QN), (const bf16*)(ws + WS_WQB) + (size_t)pair * 1536 * 256, M, 1536, 256}; pg8::StaticOrder S; S.init(M, 1536, F.G, F.bid, 256);
                  pg8::EpiBf16<0> E{(bf16*)(ws + WS_Q), 1536};
                  pg8::gemm_phase<pg8::EpiBf16<0>, pg8::StaticOrder, true, true>(F.lds, g, S, E, F.tid); }
                REFRESH_ID();
                { pg8::Gemm g{(const bf16*)(ws + WS_ACKV), (const bf16*)(ws + WS_WKVB) + (size_t)pair * 2048 * 256, MKV, 2048, 256}; pg8::StaticOrder S; S.init(MKV, 2048, F.G, F.bid, 256);
                  pg8::EpiBf16<0> E{(bf16*)(ws + WS_KV), 2048};
                  pg8::gemm_phase<pg8::EpiBf16<0>, pg8::StaticOrder, true, true>(F.lds, g, S, E, F.tid); }
            } else if (kind == 12) {
                attn_phase(F, P, pair);
            }
        }
        if (ph + 1 < ph_hi) { if (use_bar) { bar.bar = (unsigned*)(PWS + WS_CTL) + 4096; xcd_barrier(bar); } else { VM_WAIT(); __syncthreads(); } }
    }
}

extern "C" void kernel_launch(void* const* d_in, const int* in_sizes, int n_in, void* d_out, int out_size, void* d_ws, size_t ws_size, hipStream_t stream) {
    static int grid = 0;
    if (grid == 0) {
        if (n_in != 28 || out_size != 27787264 || ws_size < WS_END) { fprintf(stderr, "kernel_launch: unexpected shapes: n_in %d out %d ws %zu (need >= %zu)\n", n_in, out_size, ws_size, (size_t)WS_END); grid = -1; return; }
        int dev = 0, cus = 0, per_cu = 0;
        if (hipGetDevice(&dev) != hipSuccess || hipDeviceGetAttribute(&cus, hipDeviceAttributeMultiprocessorCount, dev) != hipSuccess) { grid = -1; return; }
        if (hipFuncSetAttribute((const void*)hyb_fwd, hipFuncAttributeMaxDynamicSharedMemorySize, LDS_BYTES) != hipSuccess) { fprintf(stderr, "kernel_launch: hipFuncSetAttribute failed\n"); grid = -1; return; }
        if (hipOccupancyMaxActiveBlocksPerMultiprocessor(&per_cu, (const void*)hyb_fwd, NWAVES * 64, LDS_BYTES) != hipSuccess || per_cu < 1) { fprintf(stderr, "kernel_launch: occupancy query reports %d\n", per_cu); }
        (void)hipGetLastError();
        grid = cus;
    }
    if (grid < 0) return;
    (void)hipMemsetAsync((char*)d_ws + WS_CTL, 0, CTL_ZERO_BYTES, stream);
    Params a{};
    for (int i = 0; i < 28; ++i) a.in[i] = (const float*)d_in[i];
    a.out = (float*)d_out; a.ws = (unsigned char*)d_ws;
    a.ph_lo = 0; a.ph_hi = N_PHASES; a.use_bar = 1; a.pad = 0;
    hipLaunchKernelGGL(hyb_fwd, dim3(grid), dim3(NWAVES * 64), LDS_BYTES, stream, a);
    const hipError_t le = hipPeekAtLastError();
    if (le != hipSuccess) fprintf(stderr, "kernel_launch: launch failed: %s\n", hipGetErrorName(le));
}
```

```cpp
#include <hip/hip_runtime.h>
#include <hip/hip_bf16.h>
#include <cstdio>
#include <cstdint>
namespace pg8 {
#define PG8_LAS __attribute__((address_space(3)))
typedef unsigned short bf16_t;
typedef short bf16x8 __attribute__((ext_vector_type(8)));
typedef float f32x4 __attribute__((ext_vector_type(4)));
typedef unsigned u32x4 __attribute__((ext_vector_type(4)));
constexpr int BM = 256, BK = 64, HALF = 128, HTB = HALF * BK * 2  , STAGE_BYTES = 8 * HTB, NXCD = 8, WGM = 8;

__host__ __device__ __forceinline__ int lds_byte(int r, int c) { const int st = (r >> 4) * 2 + (c >> 5), rr = r & 15, cc = c & 31, ob = rr * 64 + cc * 2; return st * 1024 + (ob ^ (((ob >> 9) & 1) << 5)); }
__host__ __device__ __forceinline__ void stage_rc(int b, int& R, int& C) { const int st = b / 1024, sb = b % 1024, swz = sb ^ (((sb >> 9) & 1) << 5); R = (st >> 1) * 16 + swz / 64; C = (st & 1) * 32 + (swz % 64) / 2; }
__host__ __device__ __forceinline__ int perm32(int rho) { const int n = rho >> 4, i = rho & 15; return 8 * (i >> 2) + 4 * n + (i & 3); }

struct Unit { int pm, pn, ks, kt0, nt; };
struct Gemm { const bf16_t* A; const bf16_t* Bt; int M, N, K; };

struct StaticOrder {
    int nM, nN, nwg, G, c, ntk;
    __host__ __device__ void init(int M, int N, int G_, int c_, int K) { nM = M / BM; nN = N / BM; nwg = nM * nN; G = G_; c = c_; ntk = K / BK; }
    __host__ __device__ bool next(int i, Unit& u) const { return map((long)i * G + c, u); }
    __host__ __device__ bool map(long L, Unit& u) const {
        if (L >= nwg) return false;
        int wgid = (int)L; { const int q = nwg / NXCD, r = nwg % NXCD, xcd = wgid % NXCD, off = wgid / NXCD; wgid = (xcd < r ? xcd * (q + 1) : r * (q + 1) + (xcd - r) * q) + off; }
        const int nig = WGM * nN, gid = wgid / nig, fm = gid * WGM, gsz = (nM - fm) < WGM ? (nM - fm) : WGM;
        u.pm = fm + ((wgid % nig) % gsz); u.pn = (wgid % nig) / gsz; u.ks = -1; u.kt0 = 0; u.nt = ntk; return true;
    }
    __device__ __forceinline__ void a_ready(const Unit&) const {}
    __device__ __forceinline__ void done(const Unit&) const {}
};


struct TailSplitOrder {
    int c, ntk, mode;
    __device__ void init(int c_, int K, int mode_) { c = c_; ntk = K / BK; mode = mode_; }
    __device__ __forceinline__ bool next(int i, Unit& u) const {
        const int xcd = c & 7, j = c >> 3;
        const int round = i + (mode == 2 ? 1 : 0); const bool tail = round != 0;
        u.pm = tail ? 64 + xcd * 2 + (j & 1) : xcd * 8 + (j & 7);
        u.pn = tail ? (j >> 1) & 3 : j >> 3;
        u.ks = tail ? j >> 3 : -1;
        u.nt = tail ? ntk >> 2 : ntk;
        u.kt0 = tail ? (j >> 3) * (ntk >> 2) : 0;
        return round == 0 ? mode != 2 : (round == 1 && mode != 1);
    }
    __device__ __forceinline__ void a_ready(const Unit&) const {}
    __device__ __forceinline__ void done(const Unit&) const {}
};

struct EvenInOrder {
    StaticOrder S12; int G, c;
    __device__ void init(int G_, int c_) { S12.init(20480, 3072, G_, c_, 1024); G = G_; c = c_; }
    __device__ __forceinline__ bool next(int i, Unit& u) const {
        const int L = i * G + c;
        Unit a; a.pm = 0; a.pn = 0; a.ks = -1; a.kt0 = 0; a.nt = 16; (void)S12.map(L < 960 ? L : 0, a);
        const int q = L - 1024;
        const bool full = L < 960, gkw = L >= 960 && L < 1024;
        u.pm = full ? a.pm : (gkw ? L - 960 : 64 + (q >> 2));
        u.pn = full ? a.pn : 12;
        u.ks = (full || gkw) ? -1 : (q & 3);
        u.nt = (full || gkw) ? 16 : 4;
        u.kt0 = (full || gkw) ? 0 : 4 * (q & 3);
        return L < 1088;
    }
    __device__ __forceinline__ void a_ready(const Unit&) const {}
    __device__ __forceinline__ void done(const Unit&) const {}
};

typedef float f32x2c_t __attribute__((ext_vector_type(2))); typedef __bf16 bf16x2c_t __attribute__((ext_vector_type(2)));
__device__ __forceinline__ unsigned cvt_pk_bf16(float lo, float hi) { f32x2c_t v = {lo, hi}; bf16x2c_t b = __builtin_convertvector(v, bf16x2c_t); return __builtin_bit_cast(unsigned, b); }

template <int ACT> struct EpiBf16 {
    static constexpr bool PERM = true, AFTER_DRAIN = false;
    bf16_t* O; int ldc;
    __device__ __forceinline__ void operator()(const f32x4 (&acc)[2][2][4][2], const Unit& u, int wr, int wc, int fr, int fq) const {
        const int row0 = u.pm * BM + wr * 64 + fr; const int col0 = u.pn * BM + wc * 32 + 8 * fq;
#pragma unroll
        for (int ai = 0; ai < 2; ++ai)
#pragma unroll
            for (int m = 0; m < 4; ++m) { bf16_t* rowp = O + (size_t)(row0 + ai * HALF + m * 16) * ldc + col0;
#pragma unroll
                for (int bj = 0; bj < 2; ++bj) { f32x4 v0 = acc[ai][bj][m][0], v1 = acc[ai][bj][m][1];
                    if (ACT == 1) {
#pragma unroll
                        for (int j = 0; j < 4; ++j) { const float a = fmaxf(v0[j], 0.f), b = fmaxf(v1[j], 0.f); v0[j] = a * a; v1[j] = b * b; } }
                    u32x4 w; w.x = cvt_pk_bf16(v0[0], v0[1]); w.y = cvt_pk_bf16(v0[2], v0[3]); w.z = cvt_pk_bf16(v1[0], v1[1]); w.w = cvt_pk_bf16(v1[2], v1[3]);
                    *(u32x4*)(rowp + bj * HALF) = w; } }
    }
};
struct EpiProj {
    static constexpr bool PERM = true, AFTER_DRAIN = false;
    bf16_t* O; int ldc;
    __device__ __forceinline__ void operator()(const f32x4 (&acc)[2][2][4][2], const Unit& u, int wr, int wc, int fr, int fq) const {
        const int row0 = u.pm * BM + wr * 64 + fr;
        if (u.pn < 12) {
            const int col0 = u.pn * BM + wc * 32 + 8 * fq;
#pragma unroll
            for (int ai = 0; ai < 2; ++ai)
#pragma unroll
                for (int m = 0; m < 4; ++m) { bf16_t* rowp = O + (size_t)(row0 + ai * HALF + m * 16) * ldc + col0;
#pragma unroll
                    for (int bj = 0; bj < 2; ++bj) { const f32x4 v0 = acc[ai][bj][m][0], v1 = acc[ai][bj][m][1];
                        u32x4 w; w.x = cvt_pk_bf16(v0[0], v0[1]); w.y = cvt_pk_bf16(v0[2], v0[3]); w.z = cvt_pk_bf16(v1[0], v1[1]); w.w = cvt_pk_bf16(v1[2], v1[3]);
                        *(u32x4*)(rowp + bj * HALF) = w; } }
        } else if (wc == 0) {
            const int col0 = 3072 + 32 * (u.ks < 0 ? 0 : u.ks) + 8 * fq;
#pragma unroll
            for (int ai = 0; ai < 2; ++ai)
#pragma unroll
                for (int m = 0; m < 4; ++m) { const f32x4 v0 = acc[ai][0][m][0], v1 = acc[ai][0][m][1];
                    u32x4 w; w.x = cvt_pk_bf16(v0[0], v0[1]); w.y = cvt_pk_bf16(v0[2], v0[3]); w.z = cvt_pk_bf16(v1[0], v1[1]); w.w = cvt_pk_bf16(v1[2], v1[3]);
                    *(u32x4*)(O + (size_t)(row0 + ai * HALF + m * 16) * ldc + col0) = w; }
        }
    }
};
struct EpiYsplit {
    static constexpr bool PERM = true, AFTER_DRAIN = false;
    bf16_t* Y; bf16_t* SL;
    __device__ __forceinline__ void operator()(const f32x4 (&acc)[2][2][4][2], const Unit& u, int wr, int wc, int fr, int fq) const {
        const int row0 = u.pm * BM + wr * 64 + fr; const int col0 = u.pn * BM + wc * 32 + 8 * fq;
        if (u.ks < 0) {
#pragma unroll
            for (int ai = 0; ai < 2; ++ai)
#pragma unroll
                for (int m = 0; m < 4; ++m) { bf16_t* rowp = Y + (size_t)(row0 + ai * HALF + m * 16) * 1024 + col0;
#pragma unroll
                    for (int bj = 0; bj < 2; ++bj) { const f32x4 v0 = acc[ai][bj][m][0], v1 = acc[ai][bj][m][1];
                        u32x4 w; w.x = cvt_pk_bf16(v0[0], v0[1]); w.y = cvt_pk_bf16(v0[2], v0[3]); w.z = cvt_pk_bf16(v1[0], v1[1]); w.w = cvt_pk_bf16(v1[2], v1[3]);
                        *(u32x4*)(rowp + bj * HALF) = w; } }
        } else {
            bf16_t* base = SL + (size_t)u.ks * (4096 * 1024);
#pragma unroll
            for (int ai = 0; ai < 2; ++ai)
#pragma unroll
                for (int m = 0; m < 4; ++m) { bf16_t* rowp = base + (size_t)(row0 - 16384 + ai * HALF + m * 16) * 1024 + col0;
#pragma unroll
                    for (int bj = 0; bj < 2; ++bj) { const f32x4 v0 = acc[ai][bj][m][0], v1 = acc[ai][bj][m][1];
                        u32x4 w; w.x = cvt_pk_bf16(v0[0], v0[1]); w.y = cvt_pk_bf16(v0[2], v0[3]); w.z = cvt_pk_bf16(v1[0], v1[1]); w.w = cvt_pk_bf16(v1[2], v1[3]);
                        *(u32x4*)(rowp + bj * HALF) = w; } }
        }
    }
};
struct EpiOddIn {
    static constexpr bool PERM = false, AFTER_DRAIN = true;
    bf16_t* QN; bf16_t* ACKV; float* KPERAW; float* out_ckv; float* out_kpe; const float* gq; const float* gkv; int li;
    __device__ __forceinline__ void fused(f32x4 (&acc)[2][2][4][2], const Unit& u, int wr, int wc, int fr, int fq, PG8_LAS unsigned char* lds, int wid, int lane) const {
        PG8_LAS float* P = (PG8_LAS float*)lds;
        if (u.pn < 2) {
#pragma unroll
            for (int ai = 0; ai < 2; ++ai)
#pragma unroll
                for (int m = 0; m < 4; ++m) { float s = 0.f;
#pragma unroll
                    for (int bj = 0; bj < 2; ++bj)
#pragma unroll
                        for (int n = 0; n < 2; ++n) { const f32x4 x = acc[ai][bj][m][n]; s += (x[0] * x[0] + x[1] * x[1]) + (x[2] * x[2] + x[3] * x[3]); }
                    s += __shfl_xor(s, 16); s += __shfl_xor(s, 32);
                    if (fq == 0) P[(ai * HALF + wr * 64 + m * 16 + fr) * 4 + wc] = s; }
        }
        asm volatile("s_waitcnt lgkmcnt(0)" ::: "memory"); __builtin_amdgcn_s_barrier(); asm volatile("" ::: "memory");
        if (u.pn < 2) {
            const float* gv = u.pn == 0 ? gq : gkv;
#pragma unroll
            for (int ai = 0; ai < 2; ++ai)
#pragma unroll
                for (int m = 0; m < 4; ++m) { const int r = ai * HALF + wr * 64 + m * 16 + fr; const int grow = u.pm * BM + r;
                    const float tot = (P[r * 4 + 0] + P[r * 4 + 1]) + (P[r * 4 + 2] + P[r * 4 + 3]);
                    const float rstd = 1.0f / sqrtf(tot * (1.0f / 256.0f) + 1e-6f);
                    const int drow = grow < 4096 ? grow : 4096 + ((grow - 4096) >> 11) * 2304 + 256 + ((grow - 4096) & 2047);
#pragma unroll
                    for (int bj = 0; bj < 2; ++bj)
#pragma unroll
                        for (int n = 0; n < 2; ++n) { const int col = bj * HALF + wc * 32 + n * 16 + 4 * fq; const f32x4 g = *(const f32x4*)(gv + col);
                            const f32x4 v = acc[ai][bj][m][n] * rstd * g;
                            unsigned long long w = (unsigned long long)cvt_pk_bf16(v[0], v[1]) | ((unsigned long long)cvt_pk_bf16(v[2], v[3]) << 32);
                            if (u.pn == 0) *(unsigned long long*)(QN + (size_t)grow * 256 + col) = w;
                            else { *(unsigned long long*)(ACKV + (size_t)drow * 256 + col) = w;
                                   if (grow < 4096) *(f32x4*)(out_ckv + ((size_t)((grow >> 8) * 2 + li) * 256 + (grow & 255)) * 256 + col) = v; } } }
        } else if (wc < 2) {
#pragma unroll
            for (int ai = 0; ai < 2; ++ai)
#pragma unroll
                for (int m = 0; m < 4; ++m) { const int r = ai * HALF + wr * 64 + m * 16 + fr; const int grow = u.pm * BM + r;
#pragma unroll
                    for (int n = 0; n < 2; ++n) { const int col = wc * 32 + n * 16 + 4 * fq; const f32x4 v = acc[ai][0][m][n];
                        *(f32x4*)(KPERAW + (size_t)grow * 64 + col) = v;
                        if (grow < 4096) *(f32x4*)(out_kpe + ((size_t)((grow >> 8) * 2 + li) * 256 + (grow & 255)) * 64 + col) = v; } }
        }
    }
};

template <class Epi, class Sched, bool ALIGN_EPI = false, bool SP2 = false>
__device__ __forceinline__ void gemm_phase(PG8_LAS unsigned char* lds, const Gemm g, const Sched& S, const Epi& E, const int tid) {
    const int  wid = __builtin_amdgcn_readfirstlane(tid >> 6), lane = tid & 63, wr = wid >> 2, wc = wid & 3, fr = lane & 15, fq = lane >> 4;
    const int K = g.K;
    unsigned voffA[2], voffB[2];
#pragma unroll
    for (int i = 0; i < 2; ++i) { int R, C; stage_rc(tid * 16 + i * 8192, R, C); const int Rb = Epi::PERM ? ((R & ~31) + perm32(R & 31)) : R;
        voffA[i] = (unsigned)(R * K + C) * 2u; voffB[i] = (unsigned)(Rb * K + C) * 2u; }
    const size_t kstep = (size_t)(BK * 2);
    const size_t hstep = (size_t)HALF * K * 2;
    const size_t tstep = 2 * hstep;
    const unsigned ldsw = (unsigned)wid * 1024u;
    const int aoff = lds_byte(wr * 64 + fr, fq * 8), boff = lds_byte(wc * 32 + fr, fq * 8);
#define PG8_SA(b, h) (((b) * 2 + (h)) * HTB)
#define PG8_SB(b, h) ((4 + (b) * 2 + (h)) * HTB)
#define PG8_STAGE(bufoff, gbase, voff) do { _Pragma("unroll") for (int _i = 0; _i < 2; ++_i) \
        __builtin_amdgcn_global_load_lds((const unsigned*)((const char*)(gbase) + (voff)[_i]), (PG8_LAS unsigned*)(lds + (bufoff) + ldsw + _i * 8192), 16, 0, 0); } while (0)
#define PG8_LDA(dst, b, h) do { _Pragma("unroll") for (int m = 0; m < 4; ++m) _Pragma("unroll") for (int k = 0; k < 2; ++k) dst[m][k] = *(const PG8_LAS bf16x8*)(lds + PG8_SA(b, h) + aoff + m * 2048 + k * 1024); } while (0)
#define PG8_LDB(dst, b, h) do { _Pragma("unroll") for (int n = 0; n < 2; ++n) _Pragma("unroll") for (int k = 0; k < 2; ++k) dst[n][k] = *(const PG8_LAS bf16x8*)(lds + PG8_SB(b, h) + boff + n * 2048 + k * 1024); } while (0)
#define PG8_MMA(ai, bj, At, Bt) do { __builtin_amdgcn_s_setprio(1); _Pragma("unroll") for (int m = 0; m < 4; ++m) _Pragma("unroll") for (int n = 0; n < 2; ++n) _Pragma("unroll") for (int k = 0; k < 2; ++k) \
        acc[ai][bj][m][n] = __builtin_amdgcn_mfma_f32_16x16x32_bf16(Bt[n][k], At[m][k], acc[ai][bj][m][n], 0, 0, 0); __builtin_amdgcn_s_setprio(0); } while (0)
#define PG8_WAIT_V(n) asm volatile("s_waitcnt vmcnt(" #n ")" ::: "memory")
#define PG8_WAIT_L(n) asm volatile("s_waitcnt lgkmcnt(" #n ")" ::: "memory")
#define PG8_BAR __builtin_amdgcn_s_barrier()
#define PG8_SCHED __builtin_amdgcn_sched_barrier(0)
    Unit cur, nxt; int ui = 0;
    if (!S.next(0, cur)) return;
    f32x4 acc[2][2][4][2];
#pragma unroll
    for (int a = 0; a < 2; ++a)
#pragma unroll
        for (int b = 0; b < 2; ++b)
#pragma unroll
            for (int m = 0; m < 4; ++m)
#pragma unroll
                for (int n = 0; n < 2; ++n) acc[a][b][m][n] = (f32x4){0.f, 0.f, 0.f, 0.f};
    bf16x8 At[4][2], B0[2][2], B1[2][2];
    const char* cA = (const char*)g.A + (size_t)cur.pm * tstep + (size_t)cur.kt0 * kstep; const char* cB = (const char*)g.Bt + (size_t)cur.pn * tstep + (size_t)cur.kt0 * kstep;
    S.a_ready(cur);
    if constexpr (SP2) {
        PG8_STAGE(PG8_SB(0, 0), cB, voffB); PG8_STAGE(PG8_SB(0, 1), cB + hstep, voffB); PG8_STAGE(PG8_SA(0, 0), cA, voffA); PG8_STAGE(PG8_SA(0, 1), cA + hstep, voffA);
        if (wr == 1) PG8_BAR;
        PG8_WAIT_V(2); PG8_BAR;
        PG8_STAGE(PG8_SB(1, 0), cB + kstep, voffB); PG8_STAGE(PG8_SA(1, 0), cA + kstep, voffA); PG8_STAGE(PG8_SB(1, 1), cB + hstep + kstep, voffB);
        PG8_WAIT_V(6); PG8_BAR;
    } else {
        PG8_STAGE(PG8_SB(0, 0), cB, voffB); PG8_STAGE(PG8_SA(0, 0), cA, voffA); PG8_STAGE(PG8_SB(0, 1), cB + hstep, voffB); PG8_STAGE(PG8_SA(0, 1), cA + hstep, voffA);
        if (wr == 1) PG8_BAR;
        PG8_WAIT_V(4); PG8_BAR;
        PG8_STAGE(PG8_SB(1, 0), cB + kstep, voffB); PG8_STAGE(PG8_SA(1, 0), cA + kstep, voffA); PG8_STAGE(PG8_SB(1, 1), cB + hstep + kstep, voffB);
        PG8_WAIT_V(6); PG8_BAR;
    }
    for (;;) {
        const bool has_next = S.next(ui + 1, nxt);
        const char* nA = has_next ? (const char*)g.A + (size_t)nxt.pm * tstep + (size_t)nxt.kt0 * kstep : cA; const char* nB = has_next ? (const char*)g.Bt + (size_t)nxt.pn * tstep + (size_t)nxt.kt0 * kstep : cB;
        const int nt = cur.nt;
        for (int t = 0; t < nt; t += 2) {
            const bool last = (t == nt - 2);
            const char* a1 = cA + (size_t)(t + 1) * kstep;
            const char* a2 = last ? nA : cA + (size_t)(t + 2) * kstep; const char* b2 = last ? nB : cB + (size_t)(t + 2) * kstep;
            const char* a3 = a2 + kstep; const char* b3 = b2 + kstep;
            if (last && has_next) S.a_ready(nxt);
            if constexpr (SP2) {
            PG8_LDB(B0, 0, 0); PG8_LDB(B1, 0, 1); PG8_SCHED; PG8_LDA(At, 0, 0); PG8_STAGE(PG8_SA(1, 1), a1 + hstep, voffA);
            PG8_WAIT_V(8); PG8_WAIT_L(0); PG8_BAR; PG8_MMA(0, 0, At, B0); PG8_MMA(0, 1, At, B1); PG8_BAR; PG8_SCHED;
            PG8_LDA(At, 0, 1); PG8_STAGE(PG8_SB(0, 0), b2, voffB); PG8_STAGE(PG8_SB(0, 1), b2 + hstep, voffB); PG8_STAGE(PG8_SA(0, 0), a2, voffA);
            PG8_WAIT_V(8); PG8_WAIT_L(0); PG8_BAR; PG8_MMA(1, 0, At, B0); PG8_MMA(1, 1, At, B1); PG8_BAR; PG8_SCHED;
            PG8_LDB(B0, 1, 0); PG8_LDB(B1, 1, 1); PG8_SCHED; PG8_LDA(At, 1, 0); PG8_STAGE(PG8_SA(0, 1), a2 + hstep, voffA);
            PG8_WAIT_V(8); PG8_WAIT_L(0); PG8_BAR; PG8_MMA(0, 0, At, B0); PG8_MMA(0, 1, At, B1); PG8_BAR; PG8_SCHED;
            PG8_LDA(At, 1, 1); PG8_STAGE(PG8_SB(1, 0), b3, voffB); PG8_STAGE(PG8_SB(1, 1), b3 + hstep, voffB); PG8_STAGE(PG8_SA(1, 0), a3, voffA);
            PG8_WAIT_V(8); PG8_WAIT_L(0); PG8_BAR; PG8_MMA(1, 0, At, B0); PG8_MMA(1, 1, At, B1); PG8_BAR; PG8_SCHED;
            } else {
            PG8_LDB(B0, 0, 0); PG8_SCHED; PG8_LDA(At, 0, 0); PG8_STAGE(PG8_SA(1, 1), a1 + hstep, voffA);
            PG8_WAIT_L(8); PG8_BAR; PG8_WAIT_L(0); PG8_MMA(0, 0, At, B0); PG8_BAR; PG8_SCHED;
            PG8_LDB(B1, 0, 1); PG8_STAGE(PG8_SB(0, 0), b2, voffB);
            PG8_BAR; PG8_WAIT_L(0); PG8_MMA(0, 1, At, B1); PG8_BAR;
            PG8_LDA(At, 0, 1); PG8_STAGE(PG8_SA(0, 0), a2, voffA);
            PG8_BAR; PG8_WAIT_L(0); PG8_MMA(1, 0, At, B0); PG8_BAR; PG8_SCHED;
            PG8_STAGE(PG8_SB(0, 1), b2 + hstep, voffB);
            PG8_WAIT_V(6); PG8_BAR; PG8_MMA(1, 1, At, B1); PG8_BAR;
            PG8_LDB(B0, 1, 0); PG8_SCHED; PG8_LDA(At, 1, 0); PG8_STAGE(PG8_SA(0, 1), a2 + hstep, voffA);
            PG8_WAIT_L(8); PG8_BAR; PG8_WAIT_L(0); PG8_MMA(0, 0, At, B0); PG8_BAR; PG8_SCHED;
            PG8_LDB(B1, 1, 1); PG8_STAGE(PG8_SB(1, 0), b3, voffB);
            PG8_BAR; PG8_WAIT_L(0); PG8_MMA(0, 1, At, B1); PG8_BAR;
            PG8_LDA(At, 1, 1); PG8_STAGE(PG8_SA(1, 0), a3, voffA);
            PG8_BAR; PG8_WAIT_L(0); PG8_MMA(1, 0, At, B0); PG8_BAR; PG8_SCHED;
            PG8_STAGE(PG8_SB(1, 1), b3 + hstep, voffB);
            PG8_WAIT_V(6); PG8_BAR; PG8_MMA(1, 1, At, B1); PG8_BAR;
            }
        }
        if constexpr (ALIGN_EPI) { if (wr == 0) PG8_BAR; }
        if constexpr (!Epi::AFTER_DRAIN) { E(acc, cur, wr, wc, fr, fq); S.done(cur); }
        if (!has_next) break;
#pragma unroll
        for (int a = 0; a < 2; ++a)
#pragma unroll
            for (int b = 0; b < 2; ++b)
#pragma unroll
                for (int m = 0; m < 4; ++m)
#pragma unroll
                    for (int n = 0; n < 2; ++n) acc[a][b][m][n] = (f32x4){0.f, 0.f, 0.f, 0.f};
        cur = nxt; cA = nA; cB = nB; ++ui;
        if constexpr (ALIGN_EPI) { if (wr == 1) PG8_BAR; }
    }
    PG8_WAIT_V(0);
    if constexpr (!ALIGN_EPI) { if (wr == 0) PG8_BAR; }
    PG8_BAR;
    if constexpr (Epi::AFTER_DRAIN) { E.fused(acc, cur, wr, wc, fr, fq, lds, wid, lane); S.done(cur); }
#undef PG8_SA
#undef PG8_SB
#undef PG8_STAGE
#undef PG8_LDA
#undef PG8_LDB
#undef PG8_MMA
#undef PG8_WAIT_V
#undef PG8_WAIT_L
#undef PG8_BAR
#undef PG8_SCHED
}
}

constexpr int NWAVES = 8;
constexpr int D = 1024, FF = 4096, M_CTX = 4096, M_LAT = 16384, M = M_CTX + M_LAT;
constexpr int L_LAT = 2048, L_CTX = 256, PAST = 256, LKV = PAST + L_LAT;
constexpr int MKV = M_CTX + 8 * LKV;
constexpr int EVEN_N = 3104, EVEN_NP = 3328, ODD_N = 576, ODD_NP = 768;
constexpr float EPS = 1e-6f;
constexpr int PC_QA = 0, PC_KA = 256, PC_VA = 512, PC_GA = 1024, PC_QB = 1536, PC_KB = 1792, PC_VB = 2048, PC_GB = 2560, PC_GK = 3072;
constexpr size_t OUT_Y = 0, OUT_CKV = 20971520, OUT_KPE = 23068672, OUT_SGLA = 23592960, OUT_SRET = 25690112;

constexpr size_t MiB = 1u << 20;
constexpr size_t WS_CTL = 0, CTL_ZERO_BYTES = 64 * 1024;
constexpr size_t WS_MOD = 1 * MiB;
constexpr size_t WS_ROPE = 2 * MiB;
constexpr size_t WS_KPE = 3 * MiB;
constexpr size_t WS_ACKV = 6 * MiB;
constexpr size_t WS_WINE = 18 * MiB;
constexpr size_t WS_WOUTE = 31 * MiB;
constexpr size_t WS_WINO = 35 * MiB;
constexpr size_t WS_WQB = 38 * MiB;
constexpr size_t WS_WKVB = 40 * MiB;
constexpr size_t WS_WOUTO = 42 * MiB;
constexpr size_t WS_W1 = 46 * MiB;
constexpr size_t WS_W2 = 78 * MiB;
constexpr size_t WS_HB = 110 * MiB;
constexpr size_t WS_Y = 150 * MiB;
constexpr size_t WS_BIG = 190 * MiB;
constexpr size_t WS_Q = WS_BIG, WS_KV = WS_BIG + 60 * MiB, WS_QN = WS_BIG + 148 * MiB;
constexpr size_t WS_SLAB = 350 * MiB;
constexpr size_t WS_END = 382 * MiB;

constexpr int RING_BYTES = 131072;
constexpr int LDS_MISC = 155648;
constexpr int LDS_BYTES = 163840;

#define GAS __attribute__((address_space(1)))
#define LAS __attribute__((address_space(3)))
typedef unsigned short bf16;
typedef unsigned v4u __attribute__((ext_vector_type(4)));
typedef unsigned v2u __attribute__((ext_vector_type(2)));
typedef float f32x4 __attribute__((ext_vector_type(4)));
typedef float f32x16 __attribute__((ext_vector_type(16)));
typedef short bf16x8 __attribute__((ext_vector_type(8)));
typedef short s16x4 __attribute__((ext_vector_type(4)));
#define LDS_WAIT() asm volatile("s_waitcnt lgkmcnt(0)" ::: "memory")
#define VM_WAIT() asm volatile("s_waitcnt vmcnt(0)" ::: "memory")
typedef float f32x2_t __attribute__((ext_vector_type(2))); typedef __bf16 bf16x2_t __attribute__((ext_vector_type(2)));
__device__ __forceinline__ unsigned pk2(float lo, float hi) { f32x2_t v = {lo, hi}; bf16x2_t b = __builtin_convertvector(v, bf16x2_t); return __builtin_bit_cast(unsigned, b); }
__device__ __forceinline__ unsigned f2bf(float f) { return pk2(f, f) & 0xffffu; }
__device__ __forceinline__ float bflo(unsigned w) { return __builtin_bit_cast(float, w << 16); }
__device__ __forceinline__ float bfhi(unsigned w) { return __builtin_bit_cast(float, w & 0xffff0000u); }
__device__ __forceinline__ float wave_sum(float v) {
#pragma unroll
    for (int o = 1; o < 64; o <<= 1) v += __shfl_xor(v, o);
    return v;
}
__device__ __forceinline__ float siluf(float x) { return x * __builtin_amdgcn_rcpf(1.0f + __expf(-x)); }

#define XB_TMO      128
#define XB_XCNT(j)  (256  + 64 * (j))
#define XB_XSUB(j)  (1280 + 64 * (j))
#define XB_XGEN(j)  (2304 + 64 * (j))
#define XB_TOP      3328
#define XB_TOPGEN   3392
#define XCD_BAR_WORDS 3456
#define XB_SPIN_CAP (1u << 20)
__device__ __forceinline__ unsigned xb_ld(unsigned* p)              { return __hip_atomic_load(p, __ATOMIC_RELAXED, __HIP_MEMORY_SCOPE_AGENT); }
__device__ __forceinline__ unsigned xb_add(unsigned* p, unsigned v) { return __hip_atomic_fetch_add(p, v, __ATOMIC_RELAXED, __HIP_MEMORY_SCOPE_AGENT); }
__device__ __forceinline__ unsigned xb_xcc_id() { return (unsigned)__builtin_amdgcn_s_getreg((3 << 11) | 20) & 0xFu; }
#define XB_SPIN(cond, bar) do { unsigned _sp = 0; while (cond) { __builtin_amdgcn_s_sleep(1); \
    if ((++_sp & 255u) == 0u) { if (xb_ld(&(bar)[XB_TMO])) break; if (_sp > XB_SPIN_CAP) { atomicAdd(&(bar)[XB_TMO], 1u); break; } } } } while (0)
struct XcdBarrier { unsigned* bar; unsigned x; volatile LAS unsigned* st; };
__device__ __forceinline__ XcdBarrier xcd_barrier_post(unsigned* bar, volatile LAS unsigned* st) {
    XcdBarrier b; b.bar = bar; b.x = xb_xcc_id(); b.st = st;
    if (threadIdx.x == 0) (void)xb_add(&bar[XB_XCNT(b.x)], 1u);
    return b;
}
__device__ __forceinline__ void xcd_barrier_complete(unsigned* bar, unsigned x, unsigned& nloc, unsigned& nx) {
    const unsigned G = gridDim.x * gridDim.y * gridDim.z;
    unsigned sum, cnt, mine, sp = 0u;
    for (;;) {
        sum = 0u; cnt = 0u; mine = 0u;
#pragma unroll
        for (unsigned j = 0; j < 16; ++j) { const unsigned c = xb_ld(&bar[XB_XCNT(j)]); sum += c; cnt += (c > 0u) ? 1u : 0u; mine = (j == x) ? c : mine; }
        if (sum == G) break;
        __builtin_amdgcn_s_sleep(1);
        if ((++sp & 255u) == 0u) { if (xb_ld(&bar[XB_TMO])) break; if (sp > XB_SPIN_CAP) { atomicAdd(&bar[XB_TMO], 1u); break; } }
    }
    nloc = mine > 0u ? mine : 1u; nx = cnt > 0u ? cnt : 1u;
}
__device__ __forceinline__ void xcd_barrier(const XcdBarrier& b) {
    asm volatile("s_waitcnt vmcnt(0)" ::: "memory");
    __syncthreads();
    if (threadIdx.x == 0) {
        unsigned* bar = b.bar;
        __builtin_amdgcn_s_waitcnt(0);
        unsigned nloc = b.st[0], nx = b.st[1];
        if (nloc == 0u) { xcd_barrier_complete(bar, b.x, nloc, nx); b.st[0] = nloc; b.st[1] = nx; }
        const unsigned old = xb_add(&bar[XB_XSUB(b.x)], 1u);
        const unsigned gen = old / nloc;
        if (old + 1u == (gen + 1u) * nloc) {
            __builtin_amdgcn_fence(__ATOMIC_RELEASE, "agent");
            __builtin_amdgcn_fence(__ATOMIC_ACQUIRE, "agent");
            asm volatile("s_waitcnt vmcnt(0)" ::: "memory");
            const unsigned og = xb_add(&bar[XB_TOP], 1u);
            const unsigned tg = og / nx;
            if (og + 1u == (tg + 1u) * nx) xb_add(&bar[XB_TOPGEN], 1u);
            else XB_SPIN(xb_ld(&bar[XB_TOPGEN]) == tg, bar);
            xb_add(&bar[XB_XGEN(b.x)], 1u);
        } else {
            __builtin_amdgcn_fence(__ATOMIC_ACQUIRE, "agent");
            asm volatile("s_waitcnt vmcnt(0)" ::: "memory");
            XB_SPIN(xb_ld(&bar[XB_XGEN(b.x)]) == gen, bar);
        }
        asm volatile("s_waitcnt vmcnt(0)" ::: "memory");
    }
    __syncthreads();
}

struct Params { const float* in[28]; float* out; unsigned char* ws; int ph_lo, ph_hi, use_bar, pad; };
enum { I_XP = 0, I_XS, I_CCKV, I_CKPE, I_SGLA, I_SRET, I_C, I_CCTX, I_WADA, I_BADA, I_NMIXPRE, I_NMIXPOST, I_NMLPPRE, I_NMLPPOST,
       I_WINE, I_WGK2, I_BGK2, I_GLAN, I_RDEC, I_WOUTE, I_WINO, I_QAN, I_WQB, I_KVAN, I_WKVB, I_WOUTO, I_W1, I_W2 };
struct Frame { LAS unsigned char* lds; int tid, lane, wave, vcu, G, bid; };
constexpr int LDS_PT = LDS_MISC + 256;
__device__ __forceinline__ const void* ldp(LAS unsigned char* lds, int i) {
    const volatile LAS unsigned* p = (const volatile LAS unsigned*)(lds + LDS_PT) + 2 * i;
    const unsigned lo = __builtin_amdgcn_readfirstlane(p[0]), hi = __builtin_amdgcn_readfirstlane(p[1]);
    return (const void*)(const GAS void*)(((unsigned long long)hi << 32) | lo);
}
#define PIN(i) ((const float*)ldp(F.lds, (i)))
#define POUT ((float*)ldp(F.lds, 28))
#define PWS ((unsigned char*)ldp(F.lds, 29))

__device__ __forceinline__ void p0_transpose_item(const float* W, int K, int N, bf16* WT, int kb, int n0, int dn0, LAS float* scr, int lane) {
    const int k0 = 64 * kb;
    f32x4 wv[8];
#pragma unroll
    for (int i = 0; i < 8; ++i) wv[i] = __builtin_nontemporal_load((const f32x4*)(W + (size_t)(k0 + 8 * i + (lane >> 3)) * N + n0 + 4 * (lane & 7)));
#pragma unroll
    for (int i = 0; i < 8; ++i) { LAS float* d = scr + (8 * i + (lane >> 3)) * 33 + 4 * (lane & 7); d[0] = wv[i][0]; d[1] = wv[i][1]; d[2] = wv[i][2]; d[3] = wv[i][3]; }
    LDS_WAIT(); asm volatile("" ::: "memory");
    const int c = lane & 7;
#pragma unroll
    for (int j = 0; j < 4; ++j) { const int n = (lane >> 3) + 8 * j; const LAS float* s = scr + (8 * c) * 33 + n;
        v4u o; o.x = pk2(s[0 * 33], s[1 * 33]); o.y = pk2(s[2 * 33], s[3 * 33]); o.z = pk2(s[4 * 33], s[5 * 33]); o.w = pk2(s[6 * 33], s[7 * 33]);
        *(GAS v4u*)(WT + (size_t)(dn0 + n) * K + k0 + 8 * c) = o; }
    LDS_WAIT(); asm volatile("" ::: "memory");
}
__device__ __forceinline__ int even_col_map(int n0) { return n0 < 1536 ? n0 : (n0 < 1568 ? 3072 + (n0 - 1536) : n0 - 32); }

__device__ __forceinline__ void setup_work(Frame& F, const Params& P, int wgi, int nwg, int amask  , int mmask  , int eimask  , int eomask  , int omask  ) {
    unsigned char* ws = PWS;
    LAS float* scr = (LAS float*)(F.lds + F.wave * 16384);
    __syncthreads();
    {
        LAS float* S = (LAS float*)(F.lds);
        LAS float* R = (LAS float*)(F.lds + 40960);
        { const float* cp_ = PIN(I_C); const float* cc_ = PIN(I_CCTX);
          for (int i = F.tid; i < 9 * 1024; i += 512) { const int n = i >> 10, d = i & 1023; const float cv = n < 8 ? cp_[n * 1024 + d] : cc_[d]; S[i] = siluf(cv); } }
        const float* wada_ = PIN(I_WADA); const float* bada_ = PIN(I_BADA);
        __syncthreads();
        const int nl = __builtin_popcount(amask);
        for (int uu = wgi; uu < nl * 64; uu += nwg) {
            int li_ = uu >> 6, l = 0; { int m_ = amask; for (int k_ = 0; k_ < 4; ++k_) { if (m_ & 1) { if (li_ == 0) { l = k_; break; } --li_; } m_ >>= 1; } }
            const int cb = (uu & 63) * 96;
            if (F.tid < 384) {
                const int c4 = (F.tid % 24) * 4, part = F.tid / 24;
                const float* Wp = wada_ + ((size_t)l * 1024 + part * 64) * 6144 + cb + c4;
                f32x4 a[9];
#pragma unroll
                for (int n = 0; n < 9; ++n) a[n] = (f32x4){0.f, 0.f, 0.f, 0.f};
#pragma unroll 4
                for (int d = 0; d < 64; ++d) { const f32x4 w = __builtin_nontemporal_load((const f32x4*)(Wp + (size_t)d * 6144));
#pragma unroll
                    for (int n = 0; n < 9; ++n) a[n] += w * S[n * 1024 + part * 64 + d]; }
#pragma unroll
                for (int n = 0; n < 9; ++n) *(LAS f32x4*)(R + (part * 9 + n) * 96 + c4) = a[n];
            }
            __syncthreads();
            for (int i = F.tid; i < 9 * 96; i += 512) { const int n = i / 96, c = i % 96; float s = 0.f;
#pragma unroll
                for (int p = 0; p < 16; ++p) s += R[(p * 9 + n) * 96 + c];
                ((float*)(ws + WS_MOD))[((size_t)l * 9 + n) * 6144 + cb + c] = s + bada_[l * 6144 + cb + c]; }
            __syncthreads();
        }
    }
    {
        const int wk = wgi * NWAVES + F.wave, NW = nwg * NWAVES; int base = 0;
#define SEG(sel, count, ...) do { if (sel) { for (int q = (wk + NW - base % NW) % NW; q < (count); q += NW) { __VA_ARGS__; } base += (count); } } while (0)
        const int I_E = (1024 / 64) * (EVEN_N / 32), I_OE = 16 * 32, I_O = 16 * (ODD_N / 32), I_QB = 4 * 48, I_KVB = 4 * 64, I_M1 = 16 * 128, I_M2 = 64 * 32;
#pragma unroll
        for (int l = 0; l < 2; ++l) {
            SEG((eimask >> l) & 1, I_E, { const int nb = EVEN_N / 32, kb = q / nb, n0 = (q % nb) * 32;
                p0_transpose_item(PIN(I_WINE) + (size_t)l * 1024 * EVEN_N, 1024, EVEN_N, (bf16*)(ws + WS_WINE) + (size_t)l * EVEN_NP * 1024, kb, n0, even_col_map(n0), scr, F.lane); });
            SEG((eomask >> l) & 1, I_OE, { const int kb = q / 32, n0 = (q % 32) * 32;
                p0_transpose_item(PIN(I_WOUTE) + (size_t)l * 1024 * 1024, 1024, 1024, (bf16*)(ws + WS_WOUTE) + (size_t)l * 1024 * 1024, kb, n0, n0, scr, F.lane); });
            SEG((omask >> l) & 1, I_O, { const int nb = ODD_N / 32, kb = q / nb, n0 = (q % nb) * 32;
                p0_transpose_item(PIN(I_WINO) + (size_t)l * 1024 * ODD_N, 1024, ODD_N, (bf16*)(ws + WS_WINO) + (size_t)l * ODD_NP * 1024, kb, n0, n0, scr, F.lane); });
            SEG((omask >> l) & 1, I_QB, { const int kb = q / 48, n0 = (q % 48) * 32;
                p0_transpose_item(PIN(I_WQB) + (size_t)l * 256 * 1536, 256, 1536, (bf16*)(ws + WS_WQB) + (size_t)l * 1536 * 256, kb, n0, n0, scr, F.lane); });
            SEG((omask >> l) & 1, I_KVB, { const int kb = q / 64, n0 = (q % 64) * 32;
                p0_transpose_item(PIN(I_WKVB) + (size_t)l * 256 * 2048, 256, 2048, (bf16*)(ws + WS_WKVB) + (size_t)l * 2048 * 256, kb, n0, n0, scr, F.lane); });
            SEG((omask >> l) & 1, I_OE, { const int kb = q / 32, n0 = (q % 32) * 32;
                p0_transpose_item(PIN(I_WOUTO) + (size_t)l * 1024 * 1024, 1024, 1024, (bf16*)(ws + WS_WOUTO) + (size_t)l * 1024 * 1024, kb, n0, n0, scr, F.lane); });
        }
#pragma unroll
        for (int l = 0; l < 4; ++l) {
            SEG((mmask >> l) & 1, I_M1, { const int kb = q / 128, n0 = (q % 128) * 32;
                p0_transpose_item(PIN(I_W1) + (size_t)l * 1024 * 4096, 1024, 4096, (bf16*)(ws + WS_W1) + (size_t)l * 4096 * 1024, kb, n0, n0, scr, F.lane); });
            SEG((mmask >> l) & 1, I_M2, { const int kb = q / 32, n0 = (q % 32) * 32;
                p0_transpose_item(PIN(I_W2) + (size_t)l * 4096 * 1024, 4096, 1024, (bf16*)(ws + WS_W2) + (size_t)l * 1024 * 4096, kb, n0, n0, scr, F.lane); });
        }
#undef SEG
    }
    const int gt = wgi * 512 + F.tid, NGT = nwg * 512;
#pragma unroll
    for (int l = 0; l < 2; ++l) {
        if ((eimask >> l) & 1) for (int i = gt; i < 224 * 128; i += NGT) *(GAS v4u*)((bf16*)(ws + WS_WINE) + ((size_t)l * EVEN_NP + EVEN_N) * 1024 + (size_t)i * 8) = (v4u){0u, 0u, 0u, 0u};
        if ((omask >> l) & 1) for (int i = gt; i < 192 * 128; i += NGT) *(GAS v4u*)((bf16*)(ws + WS_WINO) + ((size_t)l * ODD_NP + ODD_N) * 1024 + (size_t)i * 8) = (v4u){0u, 0u, 0u, 0u};
    }
}
__device__ __forceinline__ void p0_prologue(Frame& F, const Params& P) {
    unsigned char* ws = PWS;
    setup_work(F, P, F.vcu, F.G, 0x5, 0x5, 0x3, 0x3, 0x0);
    const int gt = F.vcu * 512 + F.tid, NGT = F.G * 512;
    for (int i = gt; i < 2048 * 32; i += NGT) { const int t = i >> 5, j = i & 31; const float inv = powf(10000.0f, -(float)(j & 15) / 16.0f);
        const float ang = (float)(j < 16 ? (t >> 6) : (t & 63)) * inv;
        ((float*)(ws + WS_ROPE))[i] = cosf(ang); ((float*)(ws + WS_ROPE))[65536 + i] = sinf(ang); }
}

__device__ __forceinline__ void row_y(f32x4 (&yv)[4], const bf16* Y, const bf16* SL, int row, int l4) {
    if (row < 16384) {
#pragma unroll
        for (int j = 0; j < 4; ++j) { const v2u yw = __builtin_nontemporal_load((const v2u*)(Y + (size_t)row * D + l4 + 256 * j)); yv[j] = (f32x4){bflo(yw.x), bfhi(yw.x), bflo(yw.y), bfhi(yw.y)}; }
    } else {
        const bf16* sp = SL + (size_t)(row - 16384) * D + l4;
#pragma unroll
        for (int j = 0; j < 4; ++j) { const v2u w0 = __builtin_nontemporal_load((const v2u*)(sp + 256 * j)), w1 = __builtin_nontemporal_load((const v2u*)(sp + 4194304 + 256 * j)), w2 = __builtin_nontemporal_load((const v2u*)(sp + 2 * 4194304 + 256 * j)), w3 = __builtin_nontemporal_load((const v2u*)(sp + 3 * 4194304 + 256 * j));
            yv[j] = ((f32x4){bflo(w0.x), bfhi(w0.x), bflo(w0.y), bfhi(w0.y)} + (f32x4){bflo(w1.x), bfhi(w1.x), bflo(w1.y), bfhi(w1.y)}) +
                    ((f32x4){bflo(w2.x), bfhi(w2.x), bflo(w2.y), bfhi(w2.y)} + (f32x4){bflo(w3.x), bfhi(w3.x), bflo(w3.y), bfhi(w3.y)}); }
    }
}
struct RowVec { f32x4 gp[4], gt[4], gq[4], sc[4], sh[4]; };
__device__ __forceinline__ void row_post(f32x4 (&v)[4], const f32x4 (&yv)[4], const RowVec& R) {
    float s = 0.f;
#pragma unroll
    for (int j = 0; j < 4; ++j) s += (yv[j][0] * yv[j][0] + yv[j][1] * yv[j][1]) + (yv[j][2] * yv[j][2] + yv[j][3] * yv[j][3]);
    const float rstd = __builtin_amdgcn_rsqf(wave_sum(s) * (1.0f / 1024.0f) + EPS);
#pragma unroll
    for (int j = 0; j < 4; ++j) v[j] = v[j] + R.gt[j] * ((yv[j] * rstd) * R.gp[j]);
}
__device__ __forceinline__ void row_pass(Frame& F, const float* xa, const float* xb, bool xin_f32, bf16* XB, const bf16* Y, const bf16* SL, const float* g_post, const float* gate,
                                         const float* g_pre, const float* scale, const float* shift, bf16* H, bool has_post, bool has_pre) {
    const int gw = F.vcu * NWAVES + F.wave, NGW = F.G * NWAVES, l4 = F.lane * 4;
    RowVec R; int ncur = -1;
#pragma unroll
    for (int j = 0; j < 4; ++j) { R.gp[j] = has_post ? *(const f32x4*)(g_post + l4 + 256 * j) : (f32x4){0.f, 0.f, 0.f, 0.f}; R.gq[j] = has_pre ? *(const f32x4*)(g_pre + l4 + 256 * j) : (f32x4){0.f, 0.f, 0.f, 0.f};
        R.gt[j] = R.gp[j]; R.sc[j] = R.gp[j]; R.sh[j] = R.gp[j]; }
    for (int blk = gw; blk * 10 < M; blk += NGW) for (int i = 0; i < 10; i += 2) {
        const int row0 = blk * 10 + i; if (row0 >= M) break;
        const int n = row0 < M_CTX ? 8 : ((row0 - M_CTX) >> 11);
        if (n != ncur) { ncur = n;
#pragma unroll
            for (int j = 0; j < 4; ++j) { const int c = l4 + 256 * j;
                if (has_post) R.gt[j] = *(const f32x4*)(gate + (size_t)n * 6144 + c);
                if (has_pre) { R.sc[j] = *(const f32x4*)(scale + (size_t)n * 6144 + c); R.sh[j] = *(const f32x4*)(shift + (size_t)n * 6144 + c); } } }
        f32x4 v[2][4], yv[2][4];
#pragma unroll
        for (int q = 0; q < 2; ++q) { const int row = row0 + q;
            if (xin_f32) { const float* xr = row < M_CTX ? xa + (size_t)row * D : xb + (size_t)(row - M_CTX) * D;
#pragma unroll
                for (int j = 0; j < 4; ++j) v[q][j] = __builtin_nontemporal_load((const f32x4*)(xr + l4 + 256 * j));
            } else {
#pragma unroll
                for (int j = 0; j < 4; ++j) { const v2u xw = __builtin_nontemporal_load((const v2u*)(XB + (size_t)row * D + l4 + 256 * j)); v[q][j] = (f32x4){bflo(xw.x), bfhi(xw.x), bflo(xw.y), bfhi(xw.y)}; }
            }
            if (has_post) row_y(yv[q], Y, SL, row, l4); }
#pragma unroll
        for (int q = 0; q < 2; ++q) { const int row = row0 + q;
            if (has_post) {
                row_post(v[q], yv[q], R);
#pragma unroll
                for (int j = 0; j < 4; ++j) *(v2u*)(XB + (size_t)row * D + l4 + 256 * j) = (v2u){pk2(v[q][j][0], v[q][j][1]), pk2(v[q][j][2], v[q][j][3])};
            }
            if (has_pre) {
                float s = 0.f;
#pragma unroll
                for (int j = 0; j < 4; ++j) s += (v[q][j][0] * v[q][j][0] + v[q][j][1] * v[q][j][1]) + (v[q][j][2] * v[q][j][2] + v[q][j][3] * v[q][j][3]);
                const float rstd = __builtin_amdgcn_rsqf(wave_sum(s) * (1.0f / 1024.0f) + EPS);
#pragma unroll
                for (int j = 0; j < 4; ++j) { const f32x4 h = ((v[q][j] * rstd) * R.gq[j]) * (1.0f + R.sc[j]) + R.sh[j];
                    *(v2u*)(H + (size_t)row * D + l4 + 256 * j) = (v2u){pk2(h[0], h[1]), pk2(h[2], h[3])}; }
            } }
    }
}
__device__ __forceinline__ void row_pass_final(Frame& F, const XcdBarrier& bar, const bf16* XB, float* OUT, const bf16* Y, const bf16* SL, const float* g_post, const float* gate) {
    const int gw = F.vcu * NWAVES + F.wave, l4 = F.lane * 4;
    v2u xw[10][4];
#pragma unroll
    for (int i = 0; i < 10; ++i) { const int row = gw * 10 + i;
        if (row < M) {
#pragma unroll
            for (int j = 0; j < 4; ++j) xw[i][j] = __builtin_nontemporal_load((const v2u*)(XB + (size_t)row * D + l4 + 256 * j));
        } }
    xcd_barrier(bar);
    RowVec R; int ncur = -1;
#pragma unroll
    for (int j = 0; j < 4; ++j) { R.gp[j] = *(const f32x4*)(g_post + l4 + 256 * j); R.gt[j] = R.gp[j]; }
#pragma unroll
    for (int i = 0; i < 10; ++i) { const int row = gw * 10 + i;
        if (row < M) {
            const int n = row < M_CTX ? 8 : ((row - M_CTX) >> 11);
            if (n != ncur) { ncur = n;
#pragma unroll
                for (int j = 0; j < 4; ++j) R.gt[j] = *(const f32x4*)(gate + (size_t)n * 6144 + l4 + 256 * j); }
            f32x4 v[4], yv[4];
#pragma unroll
            for (int j = 0; j < 4; ++j) v[j] = (f32x4){bflo(xw[i][j].x), bfhi(xw[i][j].x), bflo(xw[i][j].y), bfhi(xw[i][j].y)};
            row_y(yv, Y, SL, row, l4); row_post(v, yv, R);
#pragma unroll
            for (int j = 0; j < 4; ++j) *(f32x4*)(OUT + (size_t)row * D + l4 + 256 * j) = v[j];
        } }
}

__device__ __forceinline__ int crow(int r, int hi) { return (r & 3) + 8 * (r >> 2) + 4 * hi; }
__device__ __forceinline__ unsigned cvtpk(float lo, float hi) { return pk2(lo, hi); }
#define SBAR() __builtin_amdgcn_sched_barrier(0)
__device__ __forceinline__ int vst_row(int k, int NB) { const int kk = (k & ~0xC) | ((k & 4) << 1) | ((k & 8) >> 1); return (kk >> 3) * NB * 512 + (kk & 7) * 64; }
__device__ __forceinline__ int vst(int k, int c, int NB) { return vst_row(k, NB) + (c >> 5) * 512 + (c & 31) * 2; }
__device__ __forceinline__ int v_rd_base(int lane) { return ((lane & 3) << 3) | (((lane >> 2) & 3) << 6) | (((lane >> 4) & 1) << 5) | (((lane >> 5) & 1) << 8); }
template <int OFF> __device__ __forceinline__ s16x4 tr_read(unsigned vb) { s16x4 r; asm volatile("ds_read_b64_tr_b16 %0, %1 offset:%2" : "=&v"(r) : "v"(vb), "i"(OFF) : "memory"); return r; }
#define PKF(L, H) ((bf16x8){L[0], L[1], L[2], L[3], H[0], H[1], H[2], H[3]})
#define PK4(P, BASE, OUT) do { unsigned a0_ = cvtpk(P[BASE + 0], P[BASE + 1]), a1_ = cvtpk(P[BASE + 2], P[BASE + 3]);   \
    unsigned b0_ = cvtpk(P[BASE + 4], P[BASE + 5]), b1_ = cvtpk(P[BASE + 6], P[BASE + 7]);                              \
    auto r0_ = __builtin_amdgcn_permlane32_swap(a0_, b0_, false, false); auto r1_ = __builtin_amdgcn_permlane32_swap(a1_, b1_, false, false); \
    v4u w_ = {r0_[0], r1_[0], r0_[1], r1_[1]}; OUT = __builtin_bit_cast(bf16x8, w_); } while (0)
__device__ __forceinline__ float fexp(float x) { return __builtin_amdgcn_exp2f(x * 1.4426950408889634f); }
__device__ __forceinline__ float logsig(float x) { return fminf(x, 0.f) - 0.6931471805599453f * __builtin_amdgcn_logf(1.0f + __builtin_amdgcn_exp2f(-1.4426950408889634f * fabsf(x))); }

constexpr int SC_T = 0  , SC_TSZ = 32768, SC_QD = 0, SC_KI = 8192, SC_VT = 16384, SC_ST = 65536, SC_BT = 81920  , SC_TOT = 114688, SC_DL = 115200  ;
__device__ __forceinline__ void scan_phase(Frame& F, const Params& P, int li) {
    unsigned char* ws = PWS;
    const bf16* PROJ = (const bf16*)(ws + WS_BIG);
    const float* ROPE = (const float*)(ws + WS_ROPE);
    LAS unsigned char* G = F.lds;
    const unsigned gaddr = (unsigned)(uintptr_t)G;
    const bool isP = F.wave >= 4; const int gw4 = F.wave & 3;
    const int ri = gw4 >> 1, dh = gw4 & 1;
#define SC_BAR() do { asm volatile("s_waitcnt lgkmcnt(0)" ::: "memory"); __builtin_amdgcn_s_barrier(); asm volatile("" ::: "memory"); } while (0)
#define SC_TOK(c, i) (dir == 0 ? 64 * (c) + (i) : L - 1 - (64 * (c) + (i)))
    for (int u0 = F.bid; u0 < 256; u0 += F.G) for (int kk_ = 0; kk_ < (u0 < 128 ? 1 : 2); ++kk_) {
        __syncthreads();
        const bool lat = u0 < 128; const int u = lat ? u0 : 2 * (u0 - 128) + kk_;
        const int sb = u >> 4, hh = (u >> 1) & 7, dir = u & 1;
        const int L = lat ? L_LAT : L_CTX, row0 = lat ? M_CTX + sb * L_LAT : sb * L_CTX, NC = L / 64;
        const bool gla = hh < 4; const int h = hh & 3;
        const int qc = (gla ? PC_QA : PC_QB) + h * 64, kc = (gla ? PC_KA : PC_KB) + h * 64, vc = (gla ? PC_VA : PC_VB) + h * 128, gkc = PC_GK + dir * 16;
        bf16* OUT = (bf16*)(ws + (dir == 0 ? WS_Y : WS_HB));
        const float* rdec_p = PIN(I_RDEC); const float* wgk2_p = PIN(I_WGK2); const float* bgk2_p = PIN(I_BGK2);
        const float lgr = gla ? 0.f : -fexp(rdec_p[(li * 2 + dir) * 4 + h]);
        f32x16 sacc[2]; sacc[0] = f32x16{}; sacc[1] = f32x16{}; v4u w2f = {0u, 0u, 0u, 0u}; float gbias = 0.f;
        { int t0_ = F.tid; asm volatile("" : "+v"(t0_)); const int lane = t0_ & 63, r32 = lane & 31, hi = lane >> 5;
          if (isP) {
              if (gla) { const int kcol = h * 64 + 32 * (gw4 & 1) + r32; const float* wp_ = wgk2_p + ((size_t)(li * 2 + dir) * 16 + 8 * hi) * 256 + kcol;
                  w2f = (v4u){pk2(wp_[0], wp_[256]), pk2(wp_[512], wp_[768]), pk2(wp_[1024], wp_[1280]), pk2(wp_[1536], wp_[1792])};
                  gbias = bgk2_p[(li * 2 + dir) * 256 + kcol]; }
              else if (t0_ < 256 + 192) ((LAS float*)(G + SC_DL))[t0_ - 256] = fexp(64.0f * lgr);
          } else {
              const float* S0 = (gla ? PIN(I_SGLA) : PIN(I_SRET)) + ((size_t)((sb * 2 + li) * 2 + dir) * 4 + h) * 8192;
              if (lat) {
#pragma unroll
                  for (int d = 0; d < 2; ++d)
#pragma unroll
                      for (int r = 0; r < 16; ++r) sacc[d][r] = S0[(32 * ri + crow(r, hi)) * 128 + 32 * (2 * dh + d) + r32];
              }
#pragma unroll
              for (int d = 0; d < 2; ++d)
#pragma unroll
                  for (int r = 0; r < 16; r += 2) { const unsigned w = pk2(sacc[d][r], sacc[d][r + 1]);
                      LAS unsigned char* sp_ = G + SC_ST + (hi + 4 * ri) * 2048 + (2 * dh + d) * 512 + r32 * 2 + ((r >> 3) & 1) * 4096 + ((r & 3) + 4 * ((r >> 2) & 1)) * 64;
                      *(LAS unsigned short*)sp_ = (unsigned short)w; *(LAS unsigned short*)(sp_ + 64) = (unsigned short)(w >> 16); }
          } }
        v4u pq0 = {}, pq1 = {}, pk0 = {}, pk1 = {}, pv[4] = {}; v4u pga = {0u, 0u, 0u, 0u}; float cs[16] = {}; float tsum = 0.f;
#define SC_LOADRAW(c) do { const unsigned ro_ = (unsigned)(row0 + SC_TOK(c, sti)) * (unsigned)(EVEN_NP * 2); const char* pc_ = (const char*)PROJ; \
        pq0 = *(const v4u*)(pc_ + (ro_ + (unsigned)(qc + 8 * c8) * 2u)); pq1 = *(const v4u*)(pc_ + (ro_ + (unsigned)(qc + 32 + 8 * c8) * 2u)); \
        pk0 = *(const v4u*)(pc_ + (ro_ + (unsigned)(kc + 8 * c8) * 2u)); pk1 = *(const v4u*)(pc_ + (ro_ + (unsigned)(kc + 32 + 8 * c8) * 2u)); \
        _Pragma("unroll") for (int m_ = 0; m_ < 4; ++m_) pv[m_] = *(const v4u*)(pc_ + (ro_ + (unsigned)(vc + c8 * 32 + 8 * m_) * 2u)); } while (0)
#define SC_LOADGK(c) do { const char* gp_ = (const char*)PROJ + ((unsigned)(row0 + SC_TOK(c, 32 * (gw4 >> 1) + r32)) * (unsigned)(EVEN_NP * 2) + (unsigned)(gkc + 8 * hi) * 2u); \
        pga = *(const v4u*)gp_; \
        if (row0 >= 16384) { const v4u p1_ = *(const v4u*)(gp_ + 64), p2_ = *(const v4u*)(gp_ + 128), p3_ = *(const v4u*)(gp_ + 192); \
            _Pragma("unroll") for (int e_ = 0; e_ < 4; ++e_) pga[e_] = pk2((bflo(pga[e_]) + bflo(p1_[e_])) + (bflo(p2_[e_]) + bflo(p3_[e_])), (bfhi(pga[e_]) + bfhi(p1_[e_])) + (bfhi(p2_[e_]) + bfhi(p3_[e_]))); } } while (0)
        if (isP && gla) { int t0_ = F.tid; asm volatile("" : "+v"(t0_)); const int r32 = t0_ & 31, hi = (t0_ >> 5) & 1; SC_LOADGK(0); }
        for (int s = -3; s < NC; ++s) {
            int tid_o = F.tid; asm volatile("" : "+v"(tid_o));
            const int lane = tid_o & 63, r32 = lane & 31, hi = lane >> 5, tgp = tid_o & 255, sti = tgp >> 2, c8 = tgp & 3;
            if (isP) {
                if (gla && s + 2 >= 0 && s + 2 < NC) {
                    const int th = gw4 >> 1, kq = 32 * (gw4 & 1) + r32; LAS float* BTw = (LAS float*)(G + SC_BT + ((s + 2) & 1) * 16384);
                    const float t0v = ((LAS float*)(G + SC_TOT))[kq]; const float pre = th ? t0v : 0.f;
#pragma unroll
                    for (int r = 0; r < 16; ++r) BTw[(32 * th + crow(r, hi)) * 64 + kq] = pre + cs[r];
                    if (th == 1 && hi == 0) ((LAS float*)(G + SC_DL))[((s + 2) % 3) * 64 + kq] = fexp(pre + tsum);
                }
                if (s + 1 >= 0 && s + 1 < NC) {
                    LAS unsigned char* T = G + SC_T + ((s + 1) & 1) * SC_TSZ;
                    float q[16], kk[16];
#define UNPK(dst, o, W_) do { const v4u w_ = (W_); dst[o + 0] = bflo(w_[0]); dst[o + 1] = bfhi(w_[0]); dst[o + 2] = bflo(w_[1]); dst[o + 3] = bfhi(w_[1]); dst[o + 4] = bflo(w_[2]); dst[o + 5] = bfhi(w_[2]); dst[o + 6] = bflo(w_[3]); dst[o + 7] = bfhi(w_[3]); } while (0)
                    UNPK(q, 0, pq0); UNPK(q, 8, pq1); UNPK(kk, 0, pk0); UNPK(kk, 8, pk1);
                    if (gla) {
                        const LAS float* BTr = (const LAS float*)(G + SC_BT + ((s + 1) & 1) * 16384) + sti * 64 + 8 * c8;
                        const f32x4 x0 = *(const LAS f32x4*)BTr, x1 = *(const LAS f32x4*)(BTr + 4), x2 = *(const LAS f32x4*)(BTr + 32), x3 = *(const LAS f32x4*)(BTr + 36);
#pragma unroll
                        for (int e = 0; e < 4; ++e) { const float e0 = fexp(x0[e]), e1 = fexp(x1[e]), e2 = fexp(x2[e]), e3 = fexp(x3[e]);
                            q[e] *= 0.125f * e0; kk[e] *= __builtin_amdgcn_rcpf(e0); q[4 + e] *= 0.125f * e1; kk[4 + e] *= __builtin_amdgcn_rcpf(e1);
                            q[8 + e] *= 0.125f * e2; kk[8 + e] *= __builtin_amdgcn_rcpf(e2); q[12 + e] *= 0.125f * e3; kk[12 + e] *= __builtin_amdgcn_rcpf(e3); }
                    } else {
                        if (lat) {
                            const float* cp = ROPE + (size_t)SC_TOK(s + 1, sti) * 32 + 8 * c8; const f32x4 c0 = *(const f32x4*)cp, c1 = *(const f32x4*)(cp + 4), s0 = *(const f32x4*)(cp + 65536), s1 = *(const f32x4*)(cp + 65540);
#pragma unroll
                            for (int e = 0; e < 8; ++e) { const float c = e < 4 ? c0[e & 3] : c1[e & 3], sn = e < 4 ? s0[e & 3] : s1[e & 3];
                                const float q1 = q[e], q2 = q[8 + e]; q[e] = q1 * c - q2 * sn; q[8 + e] = q1 * sn + q2 * c;
                                const float k1 = kk[e], k2 = kk[8 + e]; kk[e] = k1 * c - k2 * sn; kk[8 + e] = k1 * sn + k2 * c; }
                        }
                        const float bb = (float)(sti + 1) * lgr, eb = fexp(bb), ek = 0.125f * __builtin_amdgcn_rcpf(eb);
#pragma unroll
                        for (int e = 0; e < 16; ++e) { q[e] *= eb; kk[e] *= ek; }
                    }
                    *(LAS v4u*)(T + SC_QD + vst(sti, 8 * c8, 2)) = (v4u){pk2(q[0], q[1]), pk2(q[2], q[3]), pk2(q[4], q[5]), pk2(q[6], q[7])};
                    *(LAS v4u*)(T + SC_QD + vst(sti, 32 + 8 * c8, 2)) = (v4u){pk2(q[8], q[9]), pk2(q[10], q[11]), pk2(q[12], q[13]), pk2(q[14], q[15])};
                    *(LAS v4u*)(T + SC_KI + vst(sti, 8 * c8, 2)) = (v4u){pk2(kk[0], kk[1]), pk2(kk[2], kk[3]), pk2(kk[4], kk[5]), pk2(kk[6], kk[7])};
                    *(LAS v4u*)(T + SC_KI + vst(sti, 32 + 8 * c8, 2)) = (v4u){pk2(kk[8], kk[9]), pk2(kk[10], kk[11]), pk2(kk[12], kk[13]), pk2(kk[14], kk[15])};
#pragma unroll
                    for (int m = 0; m < 4; ++m) *(LAS v4u*)(T + SC_VT + vst(sti, c8 * 32 + 8 * m, 4)) = pv[m];
                }
                if (s + 2 >= 0 && s + 2 < NC) SC_LOADRAW(s + 2);
            } else if (s >= 0) {
                LAS unsigned char* T = G + SC_T + (s & 1) * SC_TSZ; const unsigned taddr = gaddr + SC_T + (s & 1) * SC_TSZ;
                bf16x8 qf[4]; bf16x8 pa0, pa1, pa2, pa3;
                { const int qb_ = vst_row(32 * ri + r32, 2) + 16 * hi;
                  qf[0] = *(const LAS bf16x8*)(T + SC_QD + qb_); qf[1] = *(const LAS bf16x8*)(T + SC_QD + qb_ + 32); qf[2] = *(const LAS bf16x8*)(T + SC_QD + qb_ + 512); qf[3] = *(const LAS bf16x8*)(T + SC_QD + qb_ + 544); }
                { f32x16 p0 = {}, p1 = {};
                  const int kb0 = vst_row(r32, 2) + 16 * hi, kb1 = vst_row(32 + r32, 2) + 16 * hi;
                  { const bf16x8 a0 = *(const LAS bf16x8*)(T + SC_KI + kb0), a1 = *(const LAS bf16x8*)(T + SC_KI + kb0 + 32), a2 = *(const LAS bf16x8*)(T + SC_KI + kb0 + 512), a3 = *(const LAS bf16x8*)(T + SC_KI + kb0 + 544);
                    p0 = __builtin_amdgcn_mfma_f32_32x32x16_bf16(a0, qf[0], p0, 0, 0, 0); p0 = __builtin_amdgcn_mfma_f32_32x32x16_bf16(a1, qf[1], p0, 0, 0, 0);
                    p0 = __builtin_amdgcn_mfma_f32_32x32x16_bf16(a2, qf[2], p0, 0, 0, 0); p0 = __builtin_amdgcn_mfma_f32_32x32x16_bf16(a3, qf[3], p0, 0, 0, 0); }
                  if (ri == 1) {
                      const bf16x8 c0 = *(const LAS bf16x8*)(T + SC_KI + kb1), c1 = *(const LAS bf16x8*)(T + SC_KI + kb1 + 32), c2 = *(const LAS bf16x8*)(T + SC_KI + kb1 + 512), c3 = *(const LAS bf16x8*)(T + SC_KI + kb1 + 544);
                      p1 = __builtin_amdgcn_mfma_f32_32x32x16_bf16(c0, qf[0], p1, 0, 0, 0); p1 = __builtin_amdgcn_mfma_f32_32x32x16_bf16(c1, qf[1], p1, 0, 0, 0);
                      p1 = __builtin_amdgcn_mfma_f32_32x32x16_bf16(c2, qf[2], p1, 0, 0, 0); p1 = __builtin_amdgcn_mfma_f32_32x32x16_bf16(c3, qf[3], p1, 0, 0, 0); }
#pragma unroll
                  for (int r = 0; r < 16; ++r) { const bool keep = crow(r, hi) <= r32; if (ri == 0) { p0[r] = keep ? p0[r] : 0.f; } else { p1[r] = keep ? p1[r] : 0.f; } }
                  PK4(p0, 0, pa0); PK4(p0, 8, pa1); PK4(p1, 0, pa2); PK4(p1, 8, pa3); }
                const unsigned vb = taddr + SC_VT + v_rd_base(lane) + dh * 1024, sbv = gaddr + SC_ST + v_rd_base(lane) + dh * 1024;
#define SC_FR4(dst, base, d) do { const s16x4 l0_ = tr_read<(d) * 512>(base), h0_ = tr_read<(d) * 512 + 2048>(base), l1_ = tr_read<(d) * 512 + 4096>(base), h1_ = tr_read<(d) * 512 + 4096 + 2048>(base); \
                  const s16x4 l2_ = tr_read<(d) * 512 + 8192>(base), h2_ = tr_read<(d) * 512 + 8192 + 2048>(base), l3_ = tr_read<(d) * 512 + 12288>(base), h3_ = tr_read<(d) * 512 + 12288 + 2048>(base); \
                  asm volatile("s_waitcnt lgkmcnt(0)" ::: "memory"); SBAR(); \
                  dst[0] = PKF(l0_, h0_); dst[1] = PKF(l1_, h1_); dst[2] = PKF(l2_, h2_); dst[3] = PKF(l3_, h3_); } while (0)
#define SC_OBLK(d) do { bf16x8 vf_[4], sf_[4]; SC_FR4(vf_, vb, d); SC_FR4(sf_, sbv, d); f32x16 o_ = {}; \
                  o_ = __builtin_amdgcn_mfma_f32_32x32x16_bf16(pa0, vf_[0], o_, 0, 0, 0); o_ = __builtin_amdgcn_mfma_f32_32x32x16_bf16(pa1, vf_[1], o_, 0, 0, 0); \
                  if (ri == 1) { o_ = __builtin_amdgcn_mfma_f32_32x32x16_bf16(pa2, vf_[2], o_, 0, 0, 0); o_ = __builtin_amdgcn_mfma_f32_32x32x16_bf16(pa3, vf_[3], o_, 0, 0, 0); } \
                  o_ = __builtin_amdgcn_mfma_f32_32x32x16_bf16(qf[0], sf_[0], o_, 0, 0, 0); o_ = __builtin_amdgcn_mfma_f32_32x32x16_bf16(qf[1], sf_[1], o_, 0, 0, 0); \
                  o_ = __builtin_amdgcn_mfma_f32_32x32x16_bf16(qf[2], sf_[2], o_, 0, 0, 0); o_ = __builtin_amdgcn_mfma_f32_32x32x16_bf16(qf[3], sf_[3], o_, 0, 0, 0); \
                  char* dst_ = (char*)OUT; \
                  _Pragma("unroll") for (int r = 0; r < 16; r += 2) { const int i_ = 32 * ri + crow(r, hi); const int t_ = SC_TOK(s, i_); const unsigned w_ = pk2(o_[r], o_[r + 1]); \
                      const unsigned a_ = (unsigned)(row0 + t_) * (unsigned)(D * 2) + (unsigned)(hh * 128 + 64 * dh + 32 * (d) + r32) * 2u; \
                      *(bf16*)(dst_ + a_) = (bf16)w_; *(bf16*)(dst_ + (dir == 0 ? a_ + (unsigned)(D * 2) : a_ - (unsigned)(D * 2))) = (bf16)(w_ >> 16); } SBAR(); } while (0)
                SC_OBLK(0); SC_OBLK(1);
            }
            SC_BAR();
            if (isP) {
                if (gla && s + 3 < NC) {
                    const int th = gw4 >> 1, kq = 32 * (gw4 & 1) + r32;
                    f32x16 gp;
#pragma unroll
                    for (int r = 0; r < 16; ++r) gp[r] = gbias;
                    gp = __builtin_amdgcn_mfma_f32_32x32x16_bf16(__builtin_bit_cast(bf16x8, pga), __builtin_bit_cast(bf16x8, w2f), gp, 0, 0, 0);
                    float g4[4], o4[4];
#pragma unroll
                    for (int j = 0; j < 4; ++j) { float run = 0.f;
#pragma unroll
                        for (int e = 0; e < 4; ++e) { run += logsig(gp[4 * j + e]) * (1.0f / 16.0f); cs[4 * j + e] = run; }
                        g4[j] = run; }
#pragma unroll
                    for (int j = 0; j < 4; ++j) o4[j] = __shfl_xor(g4[j], 32);
                    float acc_ = 0.f;
#pragma unroll
                    for (int j = 0; j < 4; ++j) { const float off = acc_ + (hi ? o4[j] : 0.f);
#pragma unroll
                        for (int e = 0; e < 4; ++e) cs[4 * j + e] += off;
                        acc_ += g4[j] + o4[j]; }
                    tsum = acc_;
                    if (hi == 0) ((LAS float*)(G + SC_TOT))[th * 64 + kq] = tsum;
                    if (s + 4 < NC) SC_LOADGK(s + 4);
                }
            } else if (s >= 0) {
                const unsigned taddr = gaddr + SC_T + (s & 1) * SC_TSZ;
                const unsigned vb = taddr + SC_VT + v_rd_base(lane) + dh * 1024, kt = taddr + SC_KI + v_rd_base(lane) + ri * 512;
                bf16x8 kf[4];
                { const s16x4 l0_ = tr_read<0>(kt), h0_ = tr_read<1024>(kt), l1_ = tr_read<2048>(kt), h1_ = tr_read<2048 + 1024>(kt), l2_ = tr_read<4096>(kt), h2_ = tr_read<4096 + 1024>(kt), l3_ = tr_read<6144>(kt), h3_ = tr_read<6144 + 1024>(kt);
                  asm volatile("s_waitcnt lgkmcnt(0)" ::: "memory"); SBAR();
                  kf[0] = PKF(l0_, h0_); kf[1] = PKF(l1_, h1_); kf[2] = PKF(l2_, h2_); kf[3] = PKF(l3_, h3_); }
                const int stb_ = (hi + 4 * ri) * 2048 + (2 * dh) * 512 + r32 * 2;
                const LAS float* DLr = (const LAS float*)(G + SC_DL) + (s % 3) * 64;
#define SC_SBLK(d) do { bf16x8 vf_[4]; SC_FR4(vf_, vb, d); \
                  _Pragma("unroll") for (int ks = 0; ks < 4; ++ks) sacc[d] = __builtin_amdgcn_mfma_f32_32x32x16_bf16(kf[ks], vf_[ks], sacc[d], 0, 0, 0); \
                  _Pragma("unroll") for (int r = 0; r < 16; r += 2) { const int dk = 32 * ri + crow(r, hi); const float dl0 = DLr[dk], dl1 = DLr[dk + 1]; \
                      sacc[d][r] *= dl0; sacc[d][r + 1] *= dl1; const unsigned w_ = pk2(sacc[d][r], sacc[d][r + 1]); \
                      LAS unsigned char* sp_ = G + SC_ST + stb_ + (d) * 512 + ((r >> 3) & 1) * 4096 + ((r & 3) + 4 * ((r >> 2) & 1)) * 64; \
                      *(LAS unsigned short*)sp_ = (unsigned short)w_; *(LAS unsigned short*)(sp_ + 64) = (unsigned short)(w_ >> 16); } SBAR(); } while (0)
                SC_SBLK(0); SC_SBLK(1);
            }
            SC_BAR();
        }
        if (!lat && !isP) { int l2 = F.lane; asm volatile("" : "+v"(l2)); const int r32 = l2 & 31, hi = l2 >> 5; float* SO = POUT + (gla ? OUT_SGLA : OUT_SRET) + ((size_t)((sb * 2 + li) * 2 + dir) * 4 + h) * 8192;
#pragma unroll
            for (int d = 0; d < 2; ++d)
#pragma unroll
                for (int r = 0; r < 16; ++r) SO[(32 * ri + crow(r, hi)) * 128 + 32 * (2 * dh + d) + r32] = sacc[d][r]; }
    }
#undef SC_TOK
#undef SC_BAR
#undef SC_LOADRAW
#undef SC_LOADGK
#undef UNPK
#undef SC_FR4
#undef SC_OBLK
#undef SC_SBLK
    if (F.G == 256 && F.bid >= 128) { if (li == 0) setup_work(F, P, F.bid - 128, 128, 0x2, 0x2, 0x0, 0x0, 0x1); else setup_work(F, P, F.bid - 128, 128, 0x8, 0x8, 0x0, 0x0, 0x2); }
    else if (F.G != 256) { if (li == 0) setup_work(F, P, F.bid, F.G, 0x2, 0x2, 0x0, 0x0, 0x1); else setup_work(F, P, F.bid, F.G, 0x8, 0x8, 0x0, 0x0, 0x2); }
}
__device__ __forceinline__ void scan_combine(Frame& F, const Params& P, int li) {
    unsigned char* ws = PWS;
    const char* PROJ = (const char*)(ws + WS_BIG); const char* OF = (const char*)(ws + WS_Y); char* OB = (char*)(ws + WS_HB);
    const int gw = F.vcu * NWAVES + F.wave, NGW = F.G * NWAVES, lane = F.lane, hh = lane >> 3, dv = (lane & 7) * 16;
    f32x4 gn[4];
    { const float* gp_ = PIN(I_GLAN) + li * 128 + dv;
#pragma unroll
      for (int j = 0; j < 4; ++j) gn[j] = hh < 4 ? *(const f32x4*)(gp_ + 4 * j) : (f32x4){1.f, 1.f, 1.f, 1.f}; }
    const unsigned gcol = (unsigned)((hh < 4 ? PC_GA : PC_GB) + (hh & 3) * 128 + dv) * 2u, ocol = (unsigned)(hh * 128 + dv) * 2u;
    for (int row = gw; row < M; row += 2 * NGW) {
        v4u a[2][2], b[2][2], g[2][2];
#pragma unroll
        for (int i = 0; i < 2; ++i) { const int r_ = row + i * NGW; if (r_ < M) {
            const unsigned off = (unsigned)r_ * (unsigned)(D * 2) + ocol, goff = (unsigned)r_ * (unsigned)(EVEN_NP * 2) + gcol;
            a[i][0] = __builtin_nontemporal_load((const v4u*)(OF + off)); a[i][1] = __builtin_nontemporal_load((const v4u*)(OF + off + 16)); b[i][0] = __builtin_nontemporal_load((const v4u*)(OB + off)); b[i][1] = __builtin_nontemporal_load((const v4u*)(OB + off + 16));
            g[i][0] = __builtin_nontemporal_load((const v4u*)(PROJ + goff)); g[i][1] = __builtin_nontemporal_load((const v4u*)(PROJ + goff + 16)); } }
#pragma unroll
        for (int i = 0; i < 2; ++i) { const int r_ = row + i * NGW; if (r_ < M) {
            const unsigned off = (unsigned)r_ * (unsigned)(D * 2) + ocol;
            float x[16], gg[16];
#pragma unroll
            for (int hf = 0; hf < 2; ++hf)
#pragma unroll
                for (int e = 0; e < 4; ++e) { x[8 * hf + 2 * e] = bflo(a[i][hf][e]) + bflo(b[i][hf][e]); x[8 * hf + 2 * e + 1] = bfhi(a[i][hf][e]) + bfhi(b[i][hf][e]);
                    gg[8 * hf + 2 * e] = bflo(g[i][hf][e]); gg[8 * hf + 2 * e + 1] = bfhi(g[i][hf][e]); }
            float ss = 0.f;
#pragma unroll
            for (int e = 0; e < 16; ++e) ss += x[e] * x[e];
            ss += __shfl_xor(ss, 1); ss += __shfl_xor(ss, 2); ss += __shfl_xor(ss, 4);
            const float rstd = __builtin_amdgcn_rsqf(ss * (1.0f / 128.0f) + EPS);
#pragma unroll
            for (int e = 0; e < 16; ++e) x[e] = x[e] * rstd * gn[e >> 2][e & 3] * siluf(gg[e]);
            *(v4u*)(OB + off) = (v4u){pk2(x[0], x[1]), pk2(x[2], x[3]), pk2(x[4], x[5]), pk2(x[6], x[7])};
            *(v4u*)(OB + off + 16) = (v4u){pk2(x[8], x[9]), pk2(x[10], x[11]), pk2(x[12], x[13]), pk2(x[14], x[15])}; } }
    }
}

__device__ __forceinline__ void cache_pass(Frame& F, const Params& P, int li) {
    unsigned char* ws = PWS;
    const int gt = F.vcu * 512 + F.tid, NGT = F.G * 512;
    const float* cckv_ = PIN(I_CCKV); const float* ckpe_ = PIN(I_CKPE);
    for (int i = gt; i < 8 * 256 * 32; i += NGT) { const int c8 = i & 31, t = (i >> 5) & 255, b = i >> 13;
        const float* s = cckv_ + ((size_t)((b * 2 + li) * 256 + t) * 32 + c8) * 8; const f32x4 a = *(const f32x4*)s, c = *(const f32x4*)(s + 4);
        *(GAS v4u*)((bf16*)(ws + WS_ACKV) + ((size_t)4096 + b * LKV + t) * 256 + c8 * 8) = (v4u){pk2(a[0], a[1]), pk2(a[2], a[3]), pk2(c[0], c[1]), pk2(c[2], c[3])}; }
    for (int i = gt; i < 8 * 256 * 8; i += NGT) { const int c8 = i & 7, t = (i >> 3) & 255, b = i >> 11;
        const float* s = ckpe_ + ((size_t)((b * 2 + li) * 256 + t) * 8 + c8) * 8; const f32x4 a = *(const f32x4*)s, c = *(const f32x4*)(s + 4);
        *(GAS v4u*)((bf16*)(ws + WS_KPE) + ((size_t)4096 + b * LKV + t) * 64 + c8 * 8) = (v4u){pk2(a[0], a[1]), pk2(a[2], a[3]), pk2(c[0], c[1]), pk2(c[2], c[3])}; }
}
__device__ __forceinline__ void kpe_pass(Frame& F, const Params& P, int li) {
    unsigned char* ws = PWS;
    const float* KR = (const float*)(ws + WS_Y); const float* ROPE = (const float*)(ws + WS_ROPE);
    bf16* KPE = (bf16*)(ws + WS_KPE);
    const int gt = F.vcu * 512 + F.tid, NGT = F.G * 512;
    for (int i = gt; i < M * 4; i += NGT) {
        const int row = i >> 2, c8 = i & 3;
        const float* s = KR + (size_t)row * 64 + 8 * c8;
        f32x4 a0 = *(const f32x4*)s, a1 = *(const f32x4*)(s + 4), b0 = *(const f32x4*)(s + 32), b1 = *(const f32x4*)(s + 36);
        int drow = row;
        if (row >= M_CTX) { const int lb = (row - M_CTX) >> 11, t = (row - M_CTX) & 2047; drow = M_CTX + lb * LKV + PAST + t;
            const float* cp = ROPE + (size_t)t * 32 + 8 * c8; const float* sp = cp + 65536;
            const f32x4 c0 = *(const f32x4*)cp, c1 = *(const f32x4*)(cp + 4), s0 = *(const f32x4*)sp, s1 = *(const f32x4*)(sp + 4);
            const f32x4 x0 = a0 * c0 - b0 * s0, x1 = a1 * c1 - b1 * s1, y0 = a0 * s0 + b0 * c0, y1 = a1 * s1 + b1 * c1;
            a0 = x0; a1 = x1; b0 = y0; b1 = y1; }
        bf16* d = KPE + (size_t)drow * 64 + 8 * c8;
        *(v4u*)d = (v4u){pk2(a0[0], a0[1]), pk2(a0[2], a0[3]), pk2(a1[0], a1[1]), pk2(a1[2], a1[3])};
        *(v4u*)(d + 32) = (v4u){pk2(b0[0], b0[1]), pk2(b0[2], b0[3]), pk2(b1[0], b1[1]), pk2(b1[2], b1[3])};
    }
}

constexpr float ATT_SCALE = 0.07216878364870322f;
constexpr float ATT_THR = 8.f;
constexpr int AT_V = 0, AT_KN = 49152, AT_KP = 98304, AT_WS = 122880, AT_VB = 16384, AT_KNB = 16384, AT_KPB = 8192;
#define KSWZ(row, colB) ((row) * 256 + ((colB) ^ (((row) & 7) << 4)))
#define KPSWZ(row, colB) ((row) * 128 + ((colB) ^ (((row) & 7) << 4)))
__device__ __forceinline__ void at_partialSM(f32x16& p0, f32x16& p1, float& m_reg, float& mn, float& alpha) {
    constexpr float C = ATT_SCALE * 1.4426950408889634f;
    float pmax = p0[0];
#pragma unroll
    for (int r = 1; r < 16; ++r) pmax = fmaxf(pmax, p0[r]);
#pragma unroll
    for (int r = 0; r < 16; ++r) pmax = fmaxf(pmax, p1[r]);
    { auto rr = __builtin_amdgcn_permlane32_swap(__float_as_uint(pmax), __float_as_uint(pmax), false, false); pmax = fmaxf(__uint_as_float(rr[0]), __uint_as_float(rr[1])); }
    if (__builtin_expect(__all(pmax - m_reg <= ATT_THR / ATT_SCALE), 1)) { mn = m_reg; alpha = 1.f; }
    else { mn = fmaxf(m_reg, pmax); alpha = __builtin_amdgcn_exp2f((m_reg - mn) * C); m_reg = mn; }
    const float mnC = -mn * C;
#pragma unroll
    for (int r = 0; r < 16; ++r) p0[r] = fmaf(p0[r], C, mnC);
#pragma unroll
    for (int r = 0; r < 16; ++r) p1[r] = fmaf(p1[r], C, mnC);
#pragma unroll
    for (int r = 0; r < 16; ++r) p0[r] = __builtin_amdgcn_exp2f(p0[r]);
}
__device__ __forceinline__ void at_finishSM(f32x16& p0, f32x16& p1, float alpha, float& l_reg, bf16x8& pa0, bf16x8& pa1, bf16x8& pa2, bf16x8& pa3) {
#pragma unroll
    for (int r = 0; r < 16; ++r) p1[r] = __builtin_amdgcn_exp2f(p1[r]);
    float ps = 0;
#pragma unroll
    for (int r = 0; r < 16; ++r) ps += p0[r];
#pragma unroll
    for (int r = 0; r < 16; ++r) ps += p1[r];
    { auto rr = __builtin_amdgcn_permlane32_swap(__float_as_uint(ps), __float_as_uint(ps), false, false); ps = __uint_as_float(rr[0]) + __uint_as_float(rr[1]); }
    l_reg = l_reg * alpha + ps;
    PK4(p0, 0, pa0); PK4(p0, 8, pa1); PK4(p1, 0, pa2); PK4(p1, 8, pa3);
}
__device__ __forceinline__ void at_qkt(f32x16& p0, f32x16& p1, const LAS unsigned char* Kn, const LAS unsigned char* Kp, const bf16x8* qr, const int* kb, const int* pb) {
    p0 = f32x16{}; p1 = f32x16{};
#pragma unroll
    for (int d0 = 0; d0 < 8; ++d0) {
        const bf16x8 b0 = *(const LAS bf16x8*)(Kn + kb[d0 & 3] + 128 * (d0 >> 2)), b1 = *(const LAS bf16x8*)(Kn + kb[d0 & 3] + 128 * (d0 >> 2) + 8192);
        p0 = __builtin_amdgcn_mfma_f32_32x32x16_bf16(b0, qr[d0], p0, 0, 0, 0);
        p1 = __builtin_amdgcn_mfma_f32_32x32x16_bf16(b1, qr[d0], p1, 0, 0, 0); }
#pragma unroll
    for (int d0 = 0; d0 < 4; ++d0) {
        const bf16x8 b0 = *(const LAS bf16x8*)(Kp + pb[d0]), b1 = *(const LAS bf16x8*)(Kp + pb[d0] + 4096);
        p0 = __builtin_amdgcn_mfma_f32_32x32x16_bf16(b0, qr[8 + d0], p0, 0, 0, 0);
        p1 = __builtin_amdgcn_mfma_f32_32x32x16_bf16(b1, qr[8 + d0], p1, 0, 0, 0); }
}
template <int D0> __device__ __forceinline__ void at_pv_one(f32x16& od, unsigned vb, bf16x8 pa0, bf16x8 pa1, bf16x8 pa2, bf16x8 pa3) {
    const s16x4 l0 = tr_read<D0 * 512>(vb), h0 = tr_read<D0 * 512 + 2048>(vb), l1 = tr_read<D0 * 512 + 4096>(vb), h1 = tr_read<D0 * 512 + 4096 + 2048>(vb);
    const s16x4 l2 = tr_read<D0 * 512 + 8192>(vb), h2 = tr_read<D0 * 512 + 8192 + 2048>(vb), l3 = tr_read<D0 * 512 + 12288>(vb), h3 = tr_read<D0 * 512 + 12288 + 2048>(vb);
    asm volatile("s_waitcnt lgkmcnt(0)" ::: "memory"); SBAR();
    od = __builtin_amdgcn_mfma_f32_32x32x16_bf16(pa0, PKF(l0, h0), od, 0, 0, 0);
    od = __builtin_amdgcn_mfma_f32_32x32x16_bf16(pa1, PKF(l1, h1), od, 0, 0, 0);
    od = __builtin_amdgcn_mfma_f32_32x32x16_bf16(pa2, PKF(l2, h2), od, 0, 0, 0);
    od = __builtin_amdgcn_mfma_f32_32x32x16_bf16(pa3, PKF(l3, h3), od, 0, 0, 0);
}
__device__ __forceinline__ void at_pv(f32x16* o, unsigned vb, bf16x8 pa0, bf16x8 pa1, bf16x8 pa2, bf16x8 pa3) {
    at_pv_one<0>(o[0], vb, pa0, pa1, pa2, pa3); at_pv_one<1>(o[1], vb, pa0, pa1, pa2, pa3); at_pv_one<2>(o[2], vb, pa0, pa1, pa2, pa3); at_pv_one<3>(o[3], vb, pa0, pa1, pa2, pa3);
}
__device__ __forceinline__ void attn_unit(Frame& F, const bf16* Qrow0  , const bf16* KVh  , const bf16* KPEs  ,
                                          bf16* Orow0, int nkeys, const float* ROPE, int tpos0  ) {
    LAS unsigned char* lds = F.lds;
    const int tid = F.tid, wid = F.wave, lane = F.lane, r32 = lane & 31, hi = lane >> 5;
    LAS float* wsf = (LAS float*)(lds + AT_WS) + wid * 64; LAS float* li_l = wsf; LAS float* al_l = wsf + 32;
    float m_reg = -1e30f, l_reg = 0; f32x16 o[4] = {}; bf16x8 qr[12];
    { const bf16* Qw = Qrow0 + (size_t)(wid * 32 + r32) * 1536 + hi * 8;
#pragma unroll
      for (int d0 = 0; d0 < 12; ++d0) qr[d0] = *(const bf16x8*)(Qw + d0 * 16);
      if (tpos0 >= 0) {
          const int t = tpos0 + wid * 32 + r32;
#pragma unroll
          for (int half = 0; half < 2; ++half) {
              const float* cp = ROPE + (size_t)t * 32 + 16 * half + 8 * hi; const float* sp = cp + 65536;
              const v4u xa = __builtin_bit_cast(v4u, qr[8 + half]), xb = __builtin_bit_cast(v4u, qr[10 + half]);
              float x1[8], x2[8];
              x1[0] = bflo(xa.x); x1[1] = bfhi(xa.x); x1[2] = bflo(xa.y); x1[3] = bfhi(xa.y); x1[4] = bflo(xa.z); x1[5] = bfhi(xa.z); x1[6] = bflo(xa.w); x1[7] = bfhi(xa.w);
              x2[0] = bflo(xb.x); x2[1] = bfhi(xb.x); x2[2] = bflo(xb.y); x2[3] = bfhi(xb.y); x2[4] = bflo(xb.z); x2[5] = bfhi(xb.z); x2[6] = bflo(xb.w); x2[7] = bfhi(xb.w);
              float y1[8], y2[8];
#pragma unroll
              for (int j = 0; j < 8; ++j) { const float c = cp[j], s = sp[j]; y1[j] = x1[j] * c - x2[j] * s; y2[j] = x1[j] * s + x2[j] * c; }
              const v4u wa = {pk2(y1[0], y1[1]), pk2(y1[2], y1[3]), pk2(y1[4], y1[5]), pk2(y1[6], y1[7])}, wb = {pk2(y2[0], y2[1]), pk2(y2[2], y2[3]), pk2(y2[4], y2[5]), pk2(y2[6], y2[7])};
              if (half == 0) { qr[8] = __builtin_bit_cast(bf16x8, wa); qr[10] = __builtin_bit_cast(bf16x8, wb); } else { qr[9] = __builtin_bit_cast(bf16x8, wa); qr[11] = __builtin_bit_cast(bf16x8, wb); }
          }
      } }
    const unsigned vb0 = (unsigned)(uintptr_t)(lds + AT_V) + v_rd_base(lane);
#define AT_OPQ() int l_ = lane; asm volatile("" : "+v"(l_))
#define AT_KADDR() int kbs[4], pbs[4]; { AT_OPQ(); _Pragma("unroll") for (int b = 0; b < 4; ++b) { const int x = (32 * b + 16 * (l_ >> 5)) ^ ((l_ & 7) << 4); kbs[b] = (l_ & 31) * 256 + x; pbs[b] = (l_ & 31) * 128 + x; } }
#define AT_GLDS(gp, ldsoff) __builtin_amdgcn_global_load_lds((const unsigned*)(gp), (LAS unsigned*)(lds + (ldsoff)), 16, 0, 0)
#define AT_DMA_K(t, b) do { AT_OPQ(); const char* kb_ = (const char*)KVh + (size_t)(t) * (64 * 4096); const char* pb_ = (const char*)KPEs + (size_t)(t) * (64 * 128); \
    const int row0_ = 4 * wid + (l_ >> 4), cB0_ = ((l_ & 15) * 16) ^ ((row0_ & 7) << 4), row1_ = row0_ + 32, rowp_ = 8 * wid + (l_ >> 3), cBp_ = ((l_ & 7) * 16) ^ ((rowp_ & 7) << 4); \
    AT_GLDS(kb_ + (unsigned)(row0_ * 4096 + cB0_), AT_KN + (b) * AT_KNB + wid * 1024); AT_GLDS(kb_ + (unsigned)(row1_ * 4096 + cB0_), AT_KN + (b) * AT_KNB + (wid + 8) * 1024); \
    AT_GLDS(pb_ + (unsigned)(rowp_ * 128 + cBp_), AT_KP + (b) * AT_KPB + wid * 1024); } while (0)
#define AT_DMA_V(t, b) do { AT_OPQ(); const char* vb_ = (const char*)KVh + (size_t)(t) * (64 * 4096); \
    const int st_ = 2 * wid + (l_ >> 5), kk_ = (st_ >> 2) * 8 + ((l_ & 31) >> 2), key_ = (kk_ & ~0xC) | ((kk_ & 4) << 1) | ((kk_ & 8) >> 1), col_ = (st_ & 3) * 32 + (l_ & 3) * 8; \
    AT_GLDS(vb_ + (unsigned)(key_ * 4096 + (128 + col_) * 2), AT_V + (b) * AT_VB + wid * 1024); AT_GLDS(vb_ + (unsigned)((key_ + 32) * 4096 + (128 + col_) * 2), AT_V + (b) * AT_VB + (wid + 8) * 1024); } while (0)
#define AT_RESC(a) do { if (__any((a) < 1.f)) { if (hi == 0) al_l[r32] = (a); asm volatile("s_waitcnt lgkmcnt(0)" ::: "memory"); \
    _Pragma("unroll") for (int d = 0; d < 4; ++d) _Pragma("unroll") for (int r = 0; r < 16; ++r) o[d][r] *= al_l[crow(r, hi)]; } } while (0)
#define AT_WAITBAR(N) do { asm volatile("s_waitcnt vmcnt(" #N ") lgkmcnt(0)" ::: "memory"); __builtin_amdgcn_s_barrier(); asm volatile("" ::: "memory"); } while (0)
    f32x16 pA0, pA1, pB0, pB1; float mnA, mnB, alA, alB; bf16x8 pa0, pa1, pa2, pa3; const int NT = nkeys / 64;
    AT_DMA_K(0, 0); AT_DMA_K(1, 1); AT_DMA_V(0, 0); AT_WAITBAR(0);
    int s = 0;
#define AT_S1 (s == 2 ? 0 : s + 1)
#define AT_S2 (s == 0 ? 2 : s - 1)
#define AT_STEP(CUR0, CUR1, MNC, ALC, PRV0, PRV1, ALP, t, MODE) do { \
        if (MODE == 2) { AT_DMA_K((t) + 2, AT_S2); } if (MODE >= 1) { AT_DMA_V((t) + 1, AT_S1); } \
        SBAR(); { AT_KADDR(); at_qkt(CUR0, CUR1, lds + AT_KN + s * AT_KNB, lds + AT_KP + s * AT_KPB, qr, kbs, pbs); } \
        at_finishSM(PRV0, PRV1, ALP, l_reg, pa0, pa1, pa2, pa3); SBAR(); \
        at_pv(o, vb0 + AT_S2 * AT_VB, pa0, pa1, pa2, pa3); at_partialSM(CUR0, CUR1, m_reg, MNC, ALC); \
        AT_RESC(ALC); if (MODE == 2) AT_WAITBAR(5); else if (MODE == 1) AT_WAITBAR(2); else AT_WAITBAR(0); s = AT_S1; } while (0)
    AT_DMA_K(2, 2); AT_DMA_V(1, 1);
    { AT_KADDR(); at_qkt(pA0, pA1, lds + AT_KN, lds + AT_KP, qr, kbs, pbs); } at_partialSM(pA0, pA1, m_reg, mnA, alA);
    AT_WAITBAR(5); s = 1;
    int t = 1;
    for (; t + 4 < NT; t += 2) {
        AT_STEP(pB0, pB1, mnB, alB, pA0, pA1, alA, t, 2);
        AT_STEP(pA0, pA1, mnA, alA, pB0, pB1, alB, t + 1, 2);
    }
    AT_STEP(pB0, pB1, mnB, alB, pA0, pA1, alA, NT - 3, 2);
    AT_STEP(pA0, pA1, mnA, alA, pB0, pB1, alB, NT - 2, 1);
    AT_STEP(pB0, pB1, mnB, alB, pA0, pA1, alA, NT - 1, 0);
    at_finishSM(pB0, pB1, alB, l_reg, pa0, pa1, pa2, pa3); SBAR();
    at_pv(o, vb0 + AT_S2 * AT_VB, pa0, pa1, pa2, pa3);
    if (hi == 0) li_l[r32] = l_reg; asm volatile("s_waitcnt lgkmcnt(0)" ::: "memory");
    float rli[16];
#pragma unroll
    for (int r = 0; r < 16; ++r) rli[r] = __builtin_amdgcn_rcpf(li_l[crow(r, hi)]);
    bf16* Ow = Orow0 + (size_t)(wid * 32) * D;
#pragma unroll
    for (int r = 0; r < 16; r += 2) { const int orow = crow(r, hi);
#pragma unroll
        for (int d0 = 0; d0 < 4; ++d0) { const unsigned w = pk2(o[d0][r] * rli[r], o[d0][r + 1] * rli[r + 1]);
            Ow[(size_t)orow * D + d0 * 32 + r32] = (bf16)w; Ow[(size_t)(orow + 1) * D + d0 * 32 + r32] = (bf16)(w >> 16); } }
#undef AT_GLDS
#undef AT_OPQ
#undef AT_KADDR
#undef AT_DMA_K
#undef AT_DMA_V
#undef AT_RESC
#undef AT_WAITBAR
#undef AT_S1
#undef AT_S2
#undef AT_STEP
}
__device__ __forceinline__ void attn_phase(Frame& F, const Params& P, int li) {
    unsigned char* ws = PWS;
    const bf16* Q = (const bf16*)(ws + WS_Q); const bf16* KV = (const bf16*)(ws + WS_KV); const bf16* KPE = (const bf16*)(ws + WS_KPE);
    bf16* OB = (bf16*)(ws + WS_HB); const float* ROPE = (const float*)(ws + WS_ROPE);
    for (int u = F.vcu; u < 256 + 128; u += F.G) {
        for (int k = 0; k < 2; ++k) {
            int qrow0, kvrow0, nkeys, h, tpos0;
            if (u < 256) { const int id = 2 * u + k, lb = id >> 6, qb = id & 7; h = (id >> 3) & 7; qrow0 = M_CTX + lb * L_LAT + qb * 256; kvrow0 = M_CTX + lb * LKV; nkeys = LKV; tpos0 = qb * 256; }
            else { if (k == 1) break; const int id = u - 256, b = id >> 3; h = id & 7; qrow0 = b * L_CTX; kvrow0 = b * L_CTX; nkeys = L_CTX; tpos0 = -1; }
            __syncthreads();
            attn_unit(F, Q + (size_t)qrow0 * 1536 + h * 192, KV + (size_t)kvrow0 * 2048 + h * 256, KPE + (size_t)kvrow0 * 64, OB + (size_t)qrow0 * D + h * 128, nkeys, ROPE, tpos0);
        }
    }
}

constexpr int N_PHASES = 2 + 2 * 16;
__global__ void __launch_bounds__(NWAVES * 64, 2) hyb_fwd(Params P) {
    extern __shared__ __attribute__((aligned(16))) unsigned char lds_raw[];
    Frame F;
    F.lds = (LAS unsigned char*)lds_raw;
    F.tid = threadIdx.x; F.lane = F.tid & 63; F.wave = __builtin_amdgcn_readfirstlane(F.tid >> 6);
    F.G = gridDim.x; { const int bx = blockIdx.x; F.vcu = (F.G % 8 == 0) ? (bx % 8) * (F.G / 8) + bx / 8 : bx; }
    volatile LAS unsigned* MISC = (volatile LAS unsigned*)(F.lds + LDS_MISC);
    if (F.tid < 64) MISC[F.tid] = 0u;
    if (F.tid < 30) { const unsigned long long v = F.tid < 28 ? (unsigned long long)P.in[F.tid] : (F.tid == 28 ? (unsigned long long)P.out : (unsigned long long)P.ws);
        volatile LAS unsigned* pt = (volatile LAS unsigned*)(F.lds + LDS_PT) + 2 * F.tid; pt[0] = (unsigned)v; pt[1] = (unsigned)(v >> 32); }
    __syncthreads();
    const int use_bar = P.use_bar, ph_hi = P.ph_hi;
    XcdBarrier bar; bar.bar = (unsigned*)(PWS + WS_CTL) + 4096; bar.x = 0; bar.st = nullptr;
    if (use_bar) bar = xcd_barrier_post((unsigned*)(PWS + WS_CTL) + 4096, MISC + 8);

    for (int ph = P.ph_lo; ph < ph_hi; ++ph) {
#define REFRESH_ID() do { int t_ = threadIdx.x; asm volatile("" : "+v"(t_)); F.tid = t_; F.lane = t_ & 63; F.wave = __builtin_amdgcn_readfirstlane(t_ >> 6); \
          int g_ = gridDim.x, b_ = blockIdx.x; asm volatile("" : "+s"(g_), "+s"(b_)); F.G = g_; F.vcu = (g_ % 8 == 0) ? (b_ % 8) * (g_ / 8) + b_ / 8 : b_; F.bid = b_; } while (0)
        REFRESH_ID();
        unsigned char* ws = PWS;
        bf16* XBF = (bf16*)(POUT + OUT_Y);
        bf16* HB = (bf16*)(ws + WS_HB); bf16* YB = (bf16*)(ws + WS_Y); const bf16* SL = (const bf16*)(ws + WS_SLAB);
        const float* MOD = (const float*)(ws + WS_MOD);
        if (ph == 0) { p0_prologue(F, P); }
        else if (ph == 1) {
            const float* m0 = MOD;
            row_pass(F, PIN(I_XP), PIN(I_XS), true, nullptr, nullptr, nullptr, nullptr, nullptr, PIN(I_NMIXPRE), m0 + 1024, m0, HB, false, true);
        } else {
            const int q = ph - 2, pair = q / 16, r = q % 16; const bool odd = r >= 8; const int l = 2 * pair + (odd ? 1 : 0), k = odd ? r - 8 : r;
            const float* ml = MOD + (size_t)l * 9 * 6144;
            const int kind = k < 3 ? (odd ? 10 + k : (k == 2 ? 8 : k)) : (k == 3 ? 2 : k == 4 ? 3 : k == 5 ? 4 : k == 6 ? 5 : 6);
            if (kind == 0) {
                pg8::Gemm g{HB, (const bf16*)(ws + WS_WINE) + (size_t)pair * EVEN_NP * 1024, M, EVEN_NP, 1024}; pg8::EvenInOrder S; S.init(F.G, F.bid);
                pg8::EpiProj E{(bf16*)(ws + WS_BIG), EVEN_NP};
                pg8::gemm_phase<pg8::EpiProj, pg8::EvenInOrder, true, true>(F.lds, g, S, E, F.tid);
            } else if (kind == 1) {
                scan_phase(F, P, pair);
            } else if (kind == 8) {
                scan_combine(F, P, pair);
            } else if (kind == 2) {
                const bf16* W = odd ? (const bf16*)(ws + WS_WOUTO) + (size_t)pair * 1024 * 1024 : (const bf16*)(ws + WS_WOUTE) + (size_t)pair * 1024 * 1024;
                pg8::Gemm g{HB, W, M, 1024, 1024}; pg8::TailSplitOrder S; S.init(F.bid, 1024, 0);
                pg8::EpiYsplit E{YB, (bf16*)(ws + WS_SLAB)};
                pg8::gemm_phase<pg8::EpiYsplit, pg8::TailSplitOrder, true, true>(F.lds, g, S, E, F.tid);
            } else if (kind == 3) {
                row_pass(F, PIN(I_XP), PIN(I_XS), l == 0, XBF, YB, SL, PIN(I_NMIXPOST) + l * 1024, ml + 2048, PIN(I_NMLPPRE) + l * 1024, ml + 4096, ml + 3072, HB, true, true);
            } else if (kind == 4) {
                pg8::Gemm g{HB, (const bf16*)(ws + WS_W1) + (size_t)l * 4096 * 1024, M, FF, 1024}; pg8::StaticOrder S; S.init(M, FF, F.G, F.bid, 1024);
                pg8::EpiBf16<1> E{(bf16*)(ws + WS_BIG), FF};
                pg8::gemm_phase<pg8::EpiBf16<1>, pg8::StaticOrder, true, true>(F.lds, g, S, E, F.tid);
            } else if (kind == 5) {
                pg8::Gemm g{(const bf16*)(ws + WS_BIG), (const bf16*)(ws + WS_W2) + (size_t)l * 1024 * 4096, M, 1024, FF}; pg8::TailSplitOrder S; S.init(F.bid, FF, 0);
                pg8::EpiYsplit E{YB, (bf16*)(ws + WS_SLAB)};
                pg8::gemm_phase<pg8::EpiYsplit, pg8::TailSplitOrder, true, true>(F.lds, g, S, E, F.tid);
            } else if (kind == 6) {
                const float* mn = ml + 9 * 6144;
                if (l < 3) row_pass(F, nullptr, nullptr, false, XBF, YB, SL, PIN(I_NMLPPOST) + l * 1024, ml + 5120, PIN(I_NMIXPRE) + (l + 1) * 1024, mn + 1024, mn, HB, true, true);
                else { bar.bar = (unsigned*)(PWS + WS_CTL) + 4096; row_pass_final(F, bar, XBF, POUT + OUT_Y, YB, SL, PIN(I_NMLPPOST) + l * 1024, ml + 5120); }
            } else if (kind == 10) {
                pg8::Gemm g{HB, (const bf16*)(ws + WS_WINO) + (size_t)pair * ODD_NP * 1024, M, ODD_NP, 1024}; pg8::StaticOrder S; S.init(M, ODD_NP, F.G, F.bid, 1024);
                pg8::EpiOddIn E{(bf16*)(ws + WS_QN), (bf16*)(ws + WS_ACKV), (float*)(ws + WS_Y), POUT + OUT_CKV, POUT + OUT_KPE,
                                PIN(I_QAN) + pair * 256, PIN(I_KVAN) + pair * 256, pair};
                pg8::gemm_phase<pg8::EpiOddIn, pg8::StaticOrder, false, true>(F.lds, g, S, E, F.tid);
                REFRESH_ID(); cache_pass(F, P, pair);
            } else if (kind == 11) {
                kpe_pass(F, P, pair); REFRESH_ID();
                { pg8::Gemm g{(const bf16*)(ws + WS_QN), (const bf16*)(ws + WS_WQB) + (size_t)pair * 1536 * 256, M, 1536, 256}; pg8::StaticOrder S; S.init(M, 1536, F.G, F.bid, 256);
                  pg8::EpiBf16<0> E{(bf16*)(ws + WS_Q), 1536};
                  pg8::gemm_phase<pg8::EpiBf16<0>, pg8::StaticOrder, true, true>(F.lds, g, S, E, F.tid); }
                REFRESH_ID();
                { pg8::Gemm g{(const bf16*)(ws + WS_ACKV), (const bf16*)(ws + WS_WKVB) + (size_t)pair * 2048 * 256, MKV, 2048, 256}; pg8::StaticOrder S; S.init(MKV, 2048, F.G, F.bid, 256);
                  pg8::EpiBf16<0> E{(bf16*)(ws + WS_KV), 2048};
                  pg8::gemm_phase<pg8::EpiBf16<0>, pg8::StaticOrder, true, true>(F.lds, g, S, E, F.tid); }
            } else if (kind == 12) {
                attn_phase(F, P, pair);
            }
        }
        if (ph + 1 < ph_hi) { if (use_bar) { bar.bar = (unsigned*)(PWS + WS_CTL) + 4096; xcd_barrier(bar); } else { VM_WAIT(); __syncthreads(); } }
    }
}

extern "C" void kernel_launch(void* const* d_in, const int* in_sizes, int n_in, void* d_out, int out_size, void* d_ws, size_t ws_size, hipStream_t stream) {
    static int grid = 0;
    if (grid == 0) {
        if (n_in != 28 || out_size != 27787264 || ws_size < WS_END) { fprintf(stderr, "kernel_launch: unexpected shapes: n_in %d out %d ws %zu (need >= %zu)\n", n_in, out_size, ws_size, (size_t)WS_END); grid = -1; return; }
        int dev = 0, cus = 0, per_cu = 0;
        if (hipGetDevice(&dev) != hipSuccess || hipDeviceGetAttribute(&cus, hipDeviceAttributeMultiprocessorCount, dev) != hipSuccess) { grid = -1; return; }
        if (hipFuncSetAttribute((const void*)hyb_fwd, hipFuncAttributeMaxDynamicSharedMemorySize, LDS_BYTES) != hipSuccess) { fprintf(stderr, "kernel_launch: hipFuncSetAttribute failed\n"); grid = -1; return; }
        if (hipOccupancyMaxActiveBlocksPerMultiprocessor(&per_cu, (const void*)hyb_fwd, NWAVES * 64, LDS_BYTES) != hipSuccess || per_cu < 1) { fprintf(stderr, "kernel_launch: occupancy query reports %d\n", per_cu); }
        (void)hipGetLastError();
        grid = cus;
    }
    if (grid < 0) return;
    (void)hipMemsetAsync((char*)d_ws + WS_CTL, 0, CTL_ZERO_BYTES, stream);
    Params a{};
    for (int i = 0; i < 28; ++i) a.in[i] = (const float*)d_in[i];
    a.out = (float*)d_out; a.ws = (unsigned char*)d_ws;
    a.ph_lo = 0; a.ph_hi = N_PHASES; a.use_bar = 1; a.pad = 0;
    hipLaunchKernelGGL(hyb_fwd, dim3(grid), dim3(NWAVES * 64), LDS_BYTES, stream, a);
    const hipError_t le = hipPeekAtLastError();
    if (le != hipSuccess) fprintf(stderr, "kernel_launch: launch failed: %s\n", hipGetErrorName(le));
}
```

```cpp
#include <hip/hip_runtime.h>
#include <hip/hip_bf16.h>
#include <cstdio>
#include <cstdint>
namespace pg8 {
#define PG8_LAS __attribute__((address_space(3)))
typedef unsigned short bf16_t;
typedef short bf16x8 __attribute__((ext_vector_type(8)));
typedef float f32x4 __attribute__((ext_vector_type(4)));
typedef unsigned u32x4 __attribute__((ext_vector_type(4)));
constexpr int BM = 256, BK = 64, HALF = 128, HTB = HALF * BK * 2  , STAGE_BYTES = 8 * HTB, NXCD = 8, WGM = 8;

__host__ __device__ __forceinline__ int lds_byte(int r, int c) { const int st = (r >> 4) * 2 + (c >> 5), rr = r & 15, cc = c & 31, ob = rr * 64 + cc * 2; return st * 1024 + (ob ^ (((ob >> 9) & 1) << 5)); }
__host__ __device__ __forceinline__ void stage_rc(int b, int& R, int& C) { const int st = b / 1024, sb = b % 1024, swz = sb ^ (((sb >> 9) & 1) << 5); R = (st >> 1) * 16 + swz / 64; C = (st & 1) * 32 + (swz % 64) / 2; }
__host__ __device__ __forceinline__ int perm32(int rho) { const int n = rho >> 4, i = rho & 15; return 8 * (i >> 2) + 4 * n + (i & 3); }

struct Unit { int pm, pn, ks, kt0, nt; };
struct Gemm { const bf16_t* A; const bf16_t* Bt; int M, N, K; };

struct StaticOrder {
    int nM, nN, nwg, G, c, ntk;
    __host__ __device__ void init(int M, int N, int G_, int c_, int K) { nM = M / BM; nN = N / BM; nwg = nM * nN; G = G_; c = c_; ntk = K / BK; }
    __host__ __device__ bool next(int i, Unit& u) const { return map((long)i * G + c, u); }
    __host__ __device__ bool map(long L, Unit& u) const {
        if (L >= nwg) return false;
        int wgid = (int)L; { const int q = nwg / NXCD, r = nwg % NXCD, xcd = wgid % NXCD, off = wgid / NXCD; wgid = (xcd < r ? xcd * (q + 1) : r * (q + 1) + (xcd - r) * q) + off; }
        const int nig = WGM * nN, gid = wgid / nig, fm = gid * WGM, gsz = (nM - fm) < WGM ? (nM - fm) : WGM;
        u.pm = fm + ((wgid % nig) % gsz); u.pn = (wgid % nig) / gsz; u.ks = -1; u.kt0 = 0; u.nt = ntk; return true;
    }
    __device__ __forceinline__ void a_ready(const Unit&) const {}
    __device__ __forceinline__ void done(const Unit&) const {}
};


struct TailSplitOrder {
    int c, ntk, mode;
    __device__ void init(int c_, int K, int mode_) { c = c_; ntk = K / BK; mode = mode_; }
    __device__ __forceinline__ bool next(int i, Unit& u) const {
        const int xcd = c & 7, j = c >> 3;
        const int round = i + (mode == 2 ? 1 : 0); const bool tail = round != 0;
        u.pm = tail ? 64 + xcd * 2 + (j & 1) : xcd * 8 + (j & 7);
        u.pn = tail ? (j >> 1) & 3 : j >> 3;
        u.ks = tail ? j >> 3 : -1;
        u.nt = tail ? ntk >> 2 : ntk;
        u.kt0 = tail ? (j >> 3) * (ntk >> 2) : 0;
        return round == 0 ? mode != 2 : (round == 1 && mode != 1);
    }
    __device__ __forceinline__ void a_ready(const Unit&) const {}
    __device__ __forceinline__ void done(const Unit&) const {}
};

struct EvenInOrder {
    StaticOrder S12; int G, c;
    __device__ void init(int G_, int c_) { S12.init(20480, 3072, G_, c_, 1024); G = G_; c = c_; }
    __device__ __forceinline__ bool next(int i, Unit& u) const {
        const int L = i * G + c;
        Unit a; a.pm = 0; a.pn = 0; a.ks = -1; a.kt0 = 0; a.nt = 16; (void)S12.map(L < 960 ? L : 0, a);
        const int q = L - 1024;
        const bool full = L < 960, gkw = L >= 960 && L < 1024;
        u.pm = full ? a.pm : (gkw ? L - 960 : 64 + (q >> 2));
        u.pn = full ? a.pn : 12;
        u.ks = (full || gkw) ? -1 : (q & 3);
        u.nt = (full || gkw) ? 16 : 4;
        u.kt0 = (full || gkw) ? 0 : 4 * (q & 3);
        return L < 1088;
    }
    __device__ __forceinline__ void a_ready(const Unit&) const {}
    __device__ __forceinline__ void done(const Unit&) const {}
};

typedef float f32x2c_t __attribute__((ext_vector_type(2))); typedef __bf16 bf16x2c_t __attribute__((ext_vector_type(2)));
__device__ __forceinline__ unsigned cvt_pk_bf16(float lo, float hi) { f32x2c_t v = {lo, hi}; bf16x2c_t b = __builtin_convertvector(v, bf16x2c_t); return __builtin_bit_cast(unsigned, b); }

template <int ACT> struct EpiBf16 {
    static constexpr bool PERM = true, AFTER_DRAIN = false;
    bf16_t* O; int ldc;
    __device__ __forceinline__ void operator()(const f32x4 (&acc)[2][2][4][2], const Unit& u, int wr, int wc, int fr, int fq) const {
        const int row0 = u.pm * BM + wr * 64 + fr; const int col0 = u.pn * BM + wc * 32 + 8 * fq;
#pragma unroll
        for (int ai = 0; ai < 2; ++ai)
#pragma unroll
            for (int m = 0; m < 4; ++m) { bf16_t* rowp = O + (size_t)(row0 + ai * HALF + m * 16) * ldc + col0;
#pragma unroll
                for (int bj = 0; bj < 2; ++bj) { f32x4 v0 = acc[ai][bj][m][0], v1 = acc[ai][bj][m][1];
                    if (ACT == 1) {
#pragma unroll
                        for (int j = 0; j < 4; ++j) { const float a = fmaxf(v0[j], 0.f), b = fmaxf(v1[j], 0.f); v0[j] = a * a; v1[j] = b * b; } }
                    u32x4 w; w.x = cvt_pk_bf16(v0[0], v0[1]); w.y = cvt_pk_bf16(v0[2], v0[3]); w.z = cvt_pk_bf16(v1[0], v1[1]); w.w = cvt_pk_bf16(v1[2], v1[3]);
                    *(u32x4*)(rowp + bj * HALF) = w; } }
    }
};
struct EpiProj {
    static constexpr bool PERM = true, AFTER_DRAIN = false;
    bf16_t* O; int ldc;
    __device__ __forceinline__ void operator()(const f32x4 (&acc)[2][2][4][2], const Unit& u, int wr, int wc, int fr, int fq) const {
        const int row0 = u.pm * BM + wr * 64 + fr;
        if (u.ks < 0) {
            const int col0 = u.pn * BM + wc * 32 + 8 * fq;
#pragma unroll
            for (int ai = 0; ai < 2; ++ai)
#pragma unroll
                for (int m = 0; m < 4; ++m) { bf16_t* rowp = O + (size_t)(row0 + ai * HALF + m * 16) * ldc + col0;
#pragma unroll
                    for (int bj = 0; bj < 2; ++bj) { const f32x4 v0 = acc[ai][bj][m][0], v1 = acc[ai][bj][m][1];
                        u32x4 w; w.x = cvt_pk_bf16(v0[0], v0[1]); w.y = cvt_pk_bf16(v0[2], v0[3]); w.z = cvt_pk_bf16(v1[0], v1[1]); w.w = cvt_pk_bf16(v1[2], v1[3]);
                        *(u32x4*)(rowp + bj * HALF) = w; } }
        } else if (wc == 0) {
            const int col0 = 3072 + 32 * u.ks + 8 * fq;
#pragma unroll
            for (int ai = 0; ai < 2; ++ai)
#pragma unroll
                for (int m = 0; m < 4; ++m) { const f32x4 v0 = acc[ai][0][m][0], v1 = acc[ai][0][m][1];
                    u32x4 w; w.x = cvt_pk_bf16(v0[0], v0[1]); w.y = cvt_pk_bf16(v0[2], v0[3]); w.z = cvt_pk_bf16(v1[0], v1[1]); w.w = cvt_pk_bf16(v1[2], v1[3]);
                    *(u32x4*)(O + (size_t)(row0 + ai * HALF + m * 16) * ldc + col0) = w; }
        }
    }
};
struct EpiYsplit {
    static constexpr bool PERM = true, AFTER_DRAIN = false;
    bf16_t* Y; bf16_t* SL;
    __device__ __forceinline__ void operator()(const f32x4 (&acc)[2][2][4][2], const Unit& u, int wr, int wc, int fr, int fq) const {
        const int row0 = u.pm * BM + wr * 64 + fr; const int col0 = u.pn * BM + wc * 32 + 8 * fq;
        if (u.ks < 0) {
#pragma unroll
            for (int ai = 0; ai < 2; ++ai)
#pragma unroll
                for (int m = 0; m < 4; ++m) { bf16_t* rowp = Y + (size_t)(row0 + ai * HALF + m * 16) * 1024 + col0;
#pragma unroll
                    for (int bj = 0; bj < 2; ++bj) { const f32x4 v0 = acc[ai][bj][m][0], v1 = acc[ai][bj][m][1];
                        u32x4 w; w.x = cvt_pk_bf16(v0[0], v0[1]); w.y = cvt_pk_bf16(v0[2], v0[3]); w.z = cvt_pk_bf16(v1[0], v1[1]); w.w = cvt_pk_bf16(v1[2], v1[3]);
                        *(u32x4*)(rowp + bj * HALF) = w; } }
        } else {
            bf16_t* base = SL + (size_t)u.ks * (4096 * 1024);
#pragma unroll
            for (int ai = 0; ai < 2; ++ai)
#pragma unroll
                for (int m = 0; m < 4; ++m) { bf16_t* rowp = base + (size_t)(row0 - 16384 + ai * HALF + m * 16) * 1024 + col0;
#pragma unroll
                    for (int bj = 0; bj < 2; ++bj) { const f32x4 v0 = acc[ai][bj][m][0], v1 = acc[ai][bj][m][1];
                        u32x4 w; w.x = cvt_pk_bf16(v0[0], v0[1]); w.y = cvt_pk_bf16(v0[2], v0[3]); w.z = cvt_pk_bf16(v1[0], v1[1]); w.w = cvt_pk_bf16(v1[2], v1[3]);
                        *(u32x4*)(rowp + bj * HALF) = w; } }
        }
    }
};
struct EpiOddIn {
    static constexpr bool PERM = false, AFTER_DRAIN = true;
    bf16_t* QN; bf16_t* ACKV; float* KPERAW; float* out_ckv; float* out_kpe; const float* gq; const float* gkv; int li;
    __device__ __forceinline__ void fused(f32x4 (&acc)[2][2][4][2], const Unit& u, int wr, int wc, int fr, int fq, PG8_LAS unsigned char* lds, int wid, int lane) const {
        PG8_LAS float* P = (PG8_LAS float*)lds;
        if (u.pn < 2) {
#pragma unroll
            for (int ai = 0; ai < 2; ++ai)
#pragma unroll
                for (int m = 0; m < 4; ++m) { float s = 0.f;
#pragma unroll
                    for (int bj = 0; bj < 2; ++bj)
#pragma unroll
                        for (int n = 0; n < 2; ++n) { const f32x4 x = acc[ai][bj][m][n]; s += (x[0] * x[0] + x[1] * x[1]) + (x[2] * x[2] + x[3] * x[3]); }
                    s += __shfl_xor(s, 16); s += __shfl_xor(s, 32);
                    if (fq == 0) P[(ai * HALF + wr * 64 + m * 16 + fr) * 4 + wc] = s; }
        }
        asm volatile("s_waitcnt lgkmcnt(0)" ::: "memory"); __builtin_amdgcn_s_barrier(); asm volatile("" ::: "memory");
        if (u.pn < 2) {
            const float* gv = u.pn == 0 ? gq : gkv;
#pragma unroll
            for (int ai = 0; ai < 2; ++ai)
#pragma unroll
                for (int m = 0; m < 4; ++m) { const int r = ai * HALF + wr * 64 + m * 16 + fr; const int grow = u.pm * BM + r;
                    const float tot = (P[r * 4 + 0] + P[r * 4 + 1]) + (P[r * 4 + 2] + P[r * 4 + 3]);
                    const float rstd = 1.0f / sqrtf(tot * (1.0f / 256.0f) + 1e-6f);
                    const int drow = grow < 4096 ? grow : 4096 + ((grow - 4096) >> 11) * 2304 + 256 + ((grow - 4096) & 2047);
#pragma unroll
                    for (int bj = 0; bj < 2; ++bj)
#pragma unroll
                        for (int n = 0; n < 2; ++n) { const int col = bj * HALF + wc * 32 + n * 16 + 4 * fq; const f32x4 g = *(const f32x4*)(gv + col);
                            const f32x4 v = acc[ai][bj][m][n] * rstd * g;
                            unsigned long long w = (unsigned long long)cvt_pk_bf16(v[0], v[1]) | ((unsigned long long)cvt_pk_bf16(v[2], v[3]) << 32);
                            if (u.pn == 0) *(unsigned long long*)(QN + (size_t)grow * 256 + col) = w;
                            else { *(unsigned long long*)(ACKV + (size_t)drow * 256 + col) = w;
                                   if (grow < 4096) *(f32x4*)(out_ckv + ((size_t)((grow >> 8) * 2 + li) * 256 + (grow & 255)) * 256 + col) = v; } } }
        } else if (wc < 2) {
#pragma unroll
            for (int ai = 0; ai < 2; ++ai)
#pragma unroll
                for (int m = 0; m < 4; ++m) { const int r = ai * HALF + wr * 64 + m * 16 + fr; const int grow = u.pm * BM + r;
#pragma unroll
                    for (int n = 0; n < 2; ++n) { const int col = wc * 32 + n * 16 + 4 * fq; const f32x4 v = acc[ai][0][m][n];
                        *(f32x4*)(KPERAW + (size_t)grow * 64 + col) = v;
                        if (grow < 4096) *(f32x4*)(out_kpe + ((size_t)((grow >> 8) * 2 + li) * 256 + (grow & 255)) * 64 + col) = v; } }
        }
    }
};

template <class Epi, class Sched, bool ALIGN_EPI = false, bool SP2 = false>
__device__ __forceinline__ void gemm_phase(PG8_LAS unsigned char* lds, const Gemm g, const Sched& S, const Epi& E, const int tid, const void* scratch) {
    static_assert(SP2, "only the two-super-phase K-loop is kept");
    const int  wid = __builtin_amdgcn_readfirstlane(tid >> 6), lane = tid & 63, wr = wid >> 2, wc = wid & 3, fr = lane & 15, fq = lane >> 4;
    const int K = g.K;
    unsigned voffA[2], voffB[2];
#pragma unroll
    for (int i = 0; i < 2; ++i) { int R, C; stage_rc(tid * 16 + i * 8192, R, C); const int Rb = Epi::PERM ? ((R & ~31) + perm32(R & 31)) : R;
        voffA[i] = (unsigned)(R * K + C) * 2u; voffB[i] = (unsigned)(Rb * K + C) * 2u; }
    const size_t kstep = (size_t)(BK * 2);
    const size_t hstep = (size_t)HALF * K * 2;
    const size_t tstep = 2 * hstep;
    const unsigned ldsw = (unsigned)wid * 1024u;
    const unsigned ldsa = (unsigned)(size_t)lds + ldsw;
    const int aoff = lds_byte(wr * 64 + fr, fq * 8), boff = lds_byte(wc * 32 + fr, fq * 8);
#define PG8_SA(b, h) (((b) * 2 + (h)) * HTB)
#define PG8_SB(b, h) ((4 + (b) * 2 + (h)) * HTB)
#define PG8_STAGE(bufoff, gbase, voff) do { _Pragma("unroll") for (int _i = 0; _i < 2; ++_i) { unsigned sv_; \
        asm volatile("s_mov_b32 %0, m0\n\ts_mov_b32 m0, %3\n\ts_nop 0\n\tglobal_load_lds_dwordx4 %1, %2\n\ts_mov_b32 m0, %0" \
                     : "=&s"(sv_) : "v"((voff)[_i]), "s"((const char*)(gbase)), "s"(ldsa + (unsigned)((bufoff) + _i * 8192)) : "memory"); } } while (0)
#define PG8_LDA(dst, b, h) do { _Pragma("unroll") for (int m = 0; m < 4; ++m) _Pragma("unroll") for (int k = 0; k < 2; ++k) dst[m][k] = *(const PG8_LAS bf16x8*)(lds + PG8_SA(b, h) + aoff + m * 2048 + k * 1024); } while (0)
#define PG8_LDB(dst, b, h) do { _Pragma("unroll") for (int n = 0; n < 2; ++n) _Pragma("unroll") for (int k = 0; k < 2; ++k) dst[n][k] = *(const PG8_LAS bf16x8*)(lds + PG8_SB(b, h) + boff + n * 2048 + k * 1024); } while (0)
#define PG8_MMA(ai, bj, At, Bt) do { __builtin_amdgcn_s_setprio(1); _Pragma("unroll") for (int m = 0; m < 4; ++m) _Pragma("unroll") for (int n = 0; n < 2; ++n) _Pragma("unroll") for (int k = 0; k < 2; ++k) \
        acc[ai][bj][m][n] = __builtin_amdgcn_mfma_f32_16x16x32_bf16(Bt[n][k], At[m][k], acc[ai][bj][m][n], 0, 0, 0); __builtin_amdgcn_s_setprio(0); } while (0)
#define PG8_WAIT_V(n) asm volatile("s_waitcnt vmcnt(" #n ")" ::: "memory")
#define PG8_WAIT_L(n) asm volatile("s_waitcnt lgkmcnt(" #n ")" ::: "memory")
#define PG8_BAR __builtin_amdgcn_s_barrier()
#define PG8_SCHED __builtin_amdgcn_sched_barrier(0)
    Unit cur, nxt; int ui = 0;
    if (!S.next(0, cur)) return;
    f32x4 acc[2][2][4][2];
#pragma unroll
    for (int a = 0; a < 2; ++a)
#pragma unroll
        for (int b = 0; b < 2; ++b)
#pragma unroll
            for (int m = 0; m < 4; ++m)
#pragma unroll
                for (int n = 0; n < 2; ++n) acc[a][b][m][n] = (f32x4){0.f, 0.f, 0.f, 0.f};
    bf16x8 At[4][2], B0[2][2], B1[2][2];
    const char* cA = (const char*)g.A + (size_t)cur.pm * tstep + (size_t)cur.kt0 * kstep; const char* cB = (const char*)g.Bt + (size_t)cur.pn * tstep + (size_t)cur.kt0 * kstep;
    S.a_ready(cur);
    PG8_STAGE(PG8_SB(0, 0), cB, voffB); PG8_STAGE(PG8_SB(0, 1), cB + hstep, voffB); PG8_STAGE(PG8_SA(0, 0), cA, voffA); PG8_STAGE(PG8_SA(0, 1), cA + hstep, voffA);
    if (wr == 1) PG8_BAR;
    PG8_WAIT_V(2); PG8_BAR;
    PG8_STAGE(PG8_SB(1, 0), cB + kstep, voffB); PG8_STAGE(PG8_SA(1, 0), cA + kstep, voffA); PG8_STAGE(PG8_SB(1, 1), cB + hstep + kstep, voffB);
    PG8_WAIT_V(6); PG8_BAR;
    PG8_STAGE(PG8_SA(1, 1), cA + kstep + hstep, voffA);
    { const unsigned doff = ((unsigned)__builtin_amdgcn_workgroup_id_x() * 8u + (unsigned)wid) * 64u;
#pragma unroll
      for (int j = 0; j < 16; ++j) asm volatile("global_store_dword %0, %0, %1" :: "v"(doff), "s"(scratch) : "memory"); }
#define PG8_PAIR(WV) \
              \
            PG8_LDB(B0, 0, 0); PG8_LDB(B1, 0, 1); PG8_SCHED; PG8_LDA(At, 0, 0); \
            PG8_WAIT_V(WV); PG8_WAIT_L(0); PG8_BAR; PG8_MMA(0, 0, At, B0); PG8_MMA(0, 1, At, B1); PG8_BAR; PG8_SCHED; \
              \
            PG8_LDA(At, 0, 1); PG8_STAGE(PG8_SB(0, 0), b2, voffB); PG8_STAGE(PG8_SB(0, 1), b2 + hstep, voffB); PG8_STAGE(PG8_SA(0, 0), a2, voffA); \
            PG8_WAIT_V(WV); PG8_WAIT_L(0); PG8_BAR; PG8_MMA(1, 0, At, B0); PG8_MMA(1, 1, At, B1); PG8_BAR; PG8_SCHED; \
              \
            PG8_LDB(B0, 1, 0); PG8_LDB(B1, 1, 1); PG8_SCHED; PG8_LDA(At, 1, 0); PG8_STAGE(PG8_SA(0, 1), a2 + hstep, voffA); \
            PG8_WAIT_V(WV); PG8_WAIT_L(0); PG8_BAR; PG8_MMA(0, 0, At, B0); PG8_MMA(0, 1, At, B1); PG8_BAR; PG8_SCHED; \
              \
            PG8_LDA(At, 1, 1); PG8_STAGE(PG8_SB(1, 0), b3, voffB); PG8_STAGE(PG8_SB(1, 1), b3 + hstep, voffB); PG8_STAGE(PG8_SA(1, 0), a3, voffA); \
            PG8_WAIT_V(8); PG8_WAIT_L(0); PG8_BAR; PG8_MMA(1, 0, At, B0); PG8_MMA(1, 1, At, B1); PG8_BAR; PG8_SCHED; \
            PG8_STAGE(PG8_SA(1, 1), a3 + hstep, voffA); PG8_SCHED;
    for (;;) {
        const bool has_next = S.next(ui + 1, nxt);
        const char* nA = has_next ? (const char*)g.A + (size_t)nxt.pm * tstep + (size_t)nxt.kt0 * kstep : cA; const char* nB = has_next ? (const char*)g.Bt + (size_t)nxt.pn * tstep + (size_t)nxt.kt0 * kstep : cB;
        const int nt = cur.nt;
        {
            const char* a2 = cA + 2 * kstep; const char* b2 = cB + 2 * kstep; const char* a3 = a2 + kstep; const char* b3 = b2 + kstep;
            PG8_PAIR(24)
        }
        for (int t = 2; t < nt; t += 2) {
            const bool last = (t == nt - 2);
            const char* a2 = last ? nA : cA + (size_t)(t + 2) * kstep; const char* b2 = last ? nB : cB + (size_t)(t + 2) * kstep;
            const char* a3 = a2 + kstep; const char* b3 = b2 + kstep;
            if (last && has_next) S.a_ready(nxt);
            PG8_PAIR(8)
        }
        if constexpr (ALIGN_EPI) { if (wr == 0) PG8_BAR; }
        if constexpr (!Epi::AFTER_DRAIN) { int l_ = (int)__builtin_amdgcn_mbcnt_hi(~0u, __builtin_amdgcn_mbcnt_lo(~0u, 0u)); asm volatile("" : "+v"(l_));
            E(acc, cur, wr, wc, l_ & 15, l_ >> 4); S.done(cur); }
        if (!has_next) break;
#pragma unroll
        for (int a = 0; a < 2; ++a)
#pragma unroll
            for (int b = 0; b < 2; ++b)
#pragma unroll
                for (int m = 0; m < 4; ++m)
#pragma unroll
                    for (int n = 0; n < 2; ++n) acc[a][b][m][n] = (f32x4){0.f, 0.f, 0.f, 0.f};
        cur = nxt; cA = nA; cB = nB; ++ui;
        if constexpr (ALIGN_EPI) { if (wr == 1) PG8_BAR; }
    }
#undef PG8_PAIR
    PG8_WAIT_V(0);
    if constexpr (!ALIGN_EPI) { if (wr == 0) PG8_BAR; }
    PG8_BAR;
    if constexpr (Epi::AFTER_DRAIN) { E.fused(acc, cur, wr, wc, fr, fq, lds, wid, lane); S.done(cur); }
#undef PG8_SA
#undef PG8_SB
#undef PG8_STAGE
#undef PG8_LDA
#undef PG8_LDB
#undef PG8_MMA
#undef PG8_WAIT_V
#undef PG8_WAIT_L
#undef PG8_BAR
#undef PG8_SCHED
}
}

constexpr int NWAVES = 8;
constexpr int D = 1024, FF = 4096, M_CTX = 4096, M_LAT = 16384, M = M_CTX + M_LAT;
constexpr int L_LAT = 2048, L_CTX = 256, PAST = 256, LKV = PAST + L_LAT;
constexpr int MKV = M_CTX + 8 * LKV;
constexpr int EVEN_N = 3104, EVEN_NP = 3328, ODD_N = 576, ODD_NP = 768;
constexpr float EPS = 1e-6f;
constexpr int PC_QA = 0, PC_KA = 256, PC_VA = 512, PC_GA = 1024, PC_QB = 1536, PC_KB = 1792, PC_VB = 2048, PC_GB = 2560, PC_GK = 3072;
constexpr size_t OUT_Y = 0, OUT_CKV = 20971520, OUT_KPE = 23068672, OUT_SGLA = 23592960, OUT_SRET = 25690112;

constexpr size_t MiB = 1u << 20;
constexpr size_t WS_CTL = 0, CTL_ZERO_BYTES = 64 * 1024;
constexpr size_t WS_MOD = 1 * MiB;
constexpr size_t WS_ROPE = 2 * MiB;
constexpr size_t WS_KPE = 3 * MiB;
constexpr size_t WS_ACKV = 6 * MiB;
constexpr size_t WS_WINE = 18 * MiB;
constexpr size_t WS_WOUTE = 31 * MiB;
constexpr size_t WS_WINO = 35 * MiB;
constexpr size_t WS_WQB = 38 * MiB;
constexpr size_t WS_WKVB = 40 * MiB;
constexpr size_t WS_WOUTO = 42 * MiB;
constexpr size_t WS_W1 = 46 * MiB;
constexpr size_t WS_W2 = 78 * MiB;
constexpr size_t WS_HB = 110 * MiB;
constexpr size_t WS_Y = 150 * MiB;
constexpr size_t WS_BIG = 190 * MiB;
constexpr size_t WS_Q = WS_BIG, WS_KV = WS_BIG + 60 * MiB, WS_QN = WS_BIG + 148 * MiB;
constexpr size_t WS_SLAB = 350 * MiB;
constexpr size_t WS_END = 382 * MiB;

constexpr int RING_BYTES = 131072;
constexpr int LDS_MISC = 155648;
constexpr int LDS_BYTES = 163840;

#define GAS __attribute__((address_space(1)))
#define LAS __attribute__((address_space(3)))
typedef unsigned short bf16;
typedef unsigned v4u __attribute__((ext_vector_type(4)));
typedef unsigned v2u __attribute__((ext_vector_type(2)));
typedef float f32x4 __attribute__((ext_vector_type(4)));
typedef float f32x16 __attribute__((ext_vector_type(16)));
typedef short bf16x8 __attribute__((ext_vector_type(8)));
typedef short s16x4 __attribute__((ext_vector_type(4)));
#define LDS_WAIT() asm volatile("s_waitcnt lgkmcnt(0)" ::: "memory")
#define VM_WAIT() asm volatile("s_waitcnt vmcnt(0)" ::: "memory")
typedef float f32x2_t __attribute__((ext_vector_type(2))); typedef __bf16 bf16x2_t __attribute__((ext_vector_type(2)));
__device__ __forceinline__ unsigned pk2(float lo, float hi) { f32x2_t v = {lo, hi}; bf16x2_t b = __builtin_convertvector(v, bf16x2_t); return __builtin_bit_cast(unsigned, b); }
__device__ __forceinline__ unsigned f2bf(float f) { return pk2(f, f) & 0xffffu; }
__device__ __forceinline__ float bflo(unsigned w) { return __builtin_bit_cast(float, w << 16); }
__device__ __forceinline__ float bfhi(unsigned w) { return __builtin_bit_cast(float, w & 0xffff0000u); }
__device__ __forceinline__ float wave_sum(float v) {
#pragma unroll
    for (int o = 1; o < 64; o <<= 1) v += __shfl_xor(v, o);
    return v;
}
__device__ __forceinline__ float siluf(float x) { return x * __builtin_amdgcn_rcpf(1.0f + __expf(-x)); }

#define XB_TMO      128
#define XB_XCNT(j)  (256  + 64 * (j))
#define XB_XSUB(j)  (1280 + 64 * (j))
#define XB_XGEN(j)  (2304 + 64 * (j))
#define XB_TOP      3328
#define XB_TOPGEN   3392
#define XCD_BAR_WORDS 3456
#define XB_SPIN_CAP (1u << 20)
__device__ __forceinline__ unsigned xb_ld(unsigned* p)              { return __hip_atomic_load(p, __ATOMIC_RELAXED, __HIP_MEMORY_SCOPE_AGENT); }
__device__ __forceinline__ unsigned xb_add(unsigned* p, unsigned v) { return __hip_atomic_fetch_add(p, v, __ATOMIC_RELAXED, __HIP_MEMORY_SCOPE_AGENT); }
__device__ __forceinline__ unsigned xb_xcc_id() { return (unsigned)__builtin_amdgcn_s_getreg((3 << 11) | 20) & 0xFu; }
#define XB_SPIN(cond, bar) do { unsigned _sp = 0; while (cond) { __builtin_amdgcn_s_sleep(1); \
    if ((++_sp & 255u) == 0u) { if (xb_ld(&(bar)[XB_TMO])) break; if (_sp > XB_SPIN_CAP) { atomicAdd(&(bar)[XB_TMO], 1u); break; } } } } while (0)
struct XcdBarrier { unsigned* bar; unsigned x; volatile LAS unsigned* st; };
__device__ __forceinline__ XcdBarrier xcd_barrier_post(unsigned* bar, volatile LAS unsigned* st) {
    XcdBarrier b; b.bar = bar; b.x = xb_xcc_id(); b.st = st;
    if (threadIdx.x == 0) (void)xb_add(&bar[XB_XCNT(b.x)], 1u);
    return b;
}
__device__ __forceinline__ void xcd_barrier_complete(unsigned* bar, unsigned x, unsigned& nloc, unsigned& nx) {
    const unsigned G = gridDim.x * gridDim.y * gridDim.z;
    unsigned sum, cnt, mine, sp = 0u;
    for (;;) {
        sum = 0u; cnt = 0u; mine = 0u;
#pragma unroll
        for (unsigned j = 0; j < 16; ++j) { const unsigned c = xb_ld(&bar[XB_XCNT(j)]); sum += c; cnt += (c > 0u) ? 1u : 0u; mine = (j == x) ? c : mine; }
        if (sum == G) break;
        __builtin_amdgcn_s_sleep(1);
        if ((++sp & 255u) == 0u) { if (xb_ld(&bar[XB_TMO])) break; if (sp > XB_SPIN_CAP) { atomicAdd(&bar[XB_TMO], 1u); break; } }
    }
    nloc = mine > 0u ? mine : 1u; nx = cnt > 0u ? cnt : 1u;
}
__device__ __forceinline__ void xcd_barrier(const XcdBarrier& b) {
    asm volatile("s_waitcnt vmcnt(0)" ::: "memory");
    __syncthreads();
    if (threadIdx.x == 0) {
        unsigned* bar = b.bar;
        __builtin_amdgcn_s_waitcnt(0);
        unsigned nloc = b.st[0], nx = b.st[1];
        if (nloc == 0u) { xcd_barrier_complete(bar, b.x, nloc, nx); b.st[0] = nloc; b.st[1] = nx; }
        const unsigned old = xb_add(&bar[XB_XSUB(b.x)], 1u);
        const unsigned gen = old / nloc;
        if (old + 1u == (gen + 1u) * nloc) {
            __builtin_amdgcn_fence(__ATOMIC_RELEASE, "agent");
            __builtin_amdgcn_fence(__ATOMIC_ACQUIRE, "agent");
            asm volatile("s_waitcnt vmcnt(0)" ::: "memory");
            const unsigned og = xb_add(&bar[XB_TOP], 1u);
            const unsigned tg = og / nx;
            if (og + 1u == (tg + 1u) * nx) xb_add(&bar[XB_TOPGEN], 1u);
            else XB_SPIN(xb_ld(&bar[XB_TOPGEN]) == tg, bar);
            xb_add(&bar[XB_XGEN(b.x)], 1u);
        } else {
            __builtin_amdgcn_fence(__ATOMIC_ACQUIRE, "agent");
            asm volatile("s_waitcnt vmcnt(0)" ::: "memory");
            XB_SPIN(xb_ld(&bar[XB_XGEN(b.x)]) == gen, bar);
        }
        asm volatile("s_waitcnt vmcnt(0)" ::: "memory");
    }
    __syncthreads();
}

struct Params { const float* in[28]; float* out; unsigned char* ws; int ph_lo, ph_hi, use_bar, pad; };
enum { I_XP = 0, I_XS, I_CCKV, I_CKPE, I_SGLA, I_SRET, I_C, I_CCTX, I_WADA, I_BADA, I_NMIXPRE, I_NMIXPOST, I_NMLPPRE, I_NMLPPOST,
       I_WINE, I_WGK2, I_BGK2, I_GLAN, I_RDEC, I_WOUTE, I_WINO, I_QAN, I_WQB, I_KVAN, I_WKVB, I_WOUTO, I_W1, I_W2 };
struct Frame { LAS unsigned char* lds; int tid, lane, wave, vcu, G, bid; };
constexpr int LDS_PT = LDS_MISC + 256;
#define KAS __attribute__((address_space(4)))
__device__ __forceinline__ const void* ldp(LAS unsigned char*, int i) {
    unsigned off = (unsigned)i * 8u; asm volatile("" : "+s"(off));
    const KAS unsigned char* ka = (const KAS unsigned char*)__builtin_amdgcn_kernarg_segment_ptr();
    const unsigned long long v = *(const KAS unsigned long long*)(ka + off);
    return (const void*)(const GAS void*)v;
}
#define PIN(i) ((const float*)ldp(F.lds, (i)))
#define POUT ((float*)ldp(F.lds, 28))
#define PWS ((unsigned char*)ldp(F.lds, 29))

__device__ __forceinline__ void p0_transpose_item(const float* W, int K, int N, bf16* WT, int kb, int n0, int dn0, LAS float* scr, int lane) {
    const int k0 = 64 * kb;
    f32x4 wv[8];
#pragma unroll
    for (int i = 0; i < 8; ++i) wv[i] = __builtin_nontemporal_load((const f32x4*)(W + (size_t)(k0 + 8 * i + (lane >> 3)) * N + n0 + 4 * (lane & 7)));
#pragma unroll
    for (int i = 0; i < 8; ++i) { LAS float* d = scr + (8 * i + (lane >> 3)) * 33 + 4 * (lane & 7); d[0] = wv[i][0]; d[1] = wv[i][1]; d[2] = wv[i][2]; d[3] = wv[i][3]; }
    LDS_WAIT(); asm volatile("" ::: "memory");
    const int c = lane & 7;
#pragma unroll
    for (int j = 0; j < 4; ++j) { const int n = (lane >> 3) + 8 * j; const LAS float* s = scr + (8 * c) * 33 + n;
        v4u o; o.x = pk2(s[0 * 33], s[1 * 33]); o.y = pk2(s[2 * 33], s[3 * 33]); o.z = pk2(s[4 * 33], s[5 * 33]); o.w = pk2(s[6 * 33], s[7 * 33]);
        *(GAS v4u*)(WT + (size_t)(dn0 + n) * K + k0 + 8 * c) = o; }
    LDS_WAIT(); asm volatile("" ::: "memory");
}
__device__ __forceinline__ int even_col_map(int n0) { return n0 < 1536 ? n0 : (n0 < 1568 ? 3072 + (n0 - 1536) : n0 - 32); }

__device__ __forceinline__ void setup_work(Frame& F, const Params& P, int wgi, int nwg, int amask  , int mmask  , int eimask  , int eomask  , int omask  ) {
    unsigned char* ws = PWS;
    LAS float* scr = (LAS float*)(F.lds + F.wave * 16384);
    __syncthreads();
    {
        LAS float* S = (LAS float*)(F.lds);
        LAS float* R = (LAS float*)(F.lds + 40960);
        { const float* cp_ = PIN(I_C); const float* cc_ = PIN(I_CCTX);
          for (int i = F.tid; i < 9 * 1024; i += 512) { const int n = i >> 10, d = i & 1023; const float cv = n < 8 ? cp_[n * 1024 + d] : cc_[d]; S[i] = siluf(cv); } }
        const float* wada_ = PIN(I_WADA); const float* bada_ = PIN(I_BADA);
        __syncthreads();
        const int nl = __builtin_popcount(amask);
        for (int uu = wgi; uu < nl * 64; uu += nwg) {
            int li_ = uu >> 6, l = 0; { int m_ = amask; for (int k_ = 0; k_ < 4; ++k_) { if (m_ & 1) { if (li_ == 0) { l = k_; break; } --li_; } m_ >>= 1; } }
            const int cb = (uu & 63) * 96;
            if (F.tid < 384) {
                const int c4 = (F.tid % 24) * 4, part = F.tid / 24;
                const float* Wp = wada_ + ((size_t)l * 1024 + part * 64) * 6144 + cb + c4;
                f32x4 a[9];
#pragma unroll
                for (int n = 0; n < 9; ++n) a[n] = (f32x4){0.f, 0.f, 0.f, 0.f};
#pragma unroll 4
                for (int d = 0; d < 64; ++d) { const f32x4 w = __builtin_nontemporal_load((const f32x4*)(Wp + (size_t)d * 6144));
#pragma unroll
                    for (int n = 0; n < 9; ++n) a[n] += w * S[n * 1024 + part * 64 + d]; }
#pragma unroll
                for (int n = 0; n < 9; ++n) *(LAS f32x4*)(R + (part * 9 + n) * 96 + c4) = a[n];
            }
            __syncthreads();
            for (int i = F.tid; i < 9 * 96; i += 512) { const int n = i / 96, c = i % 96; float s = 0.f;
#pragma unroll
                for (int p = 0; p < 16; ++p) s += R[(p * 9 + n) * 96 + c];
                ((float*)(ws + WS_MOD))[((size_t)l * 9 + n) * 6144 + cb + c] = s + bada_[l * 6144 + cb + c]; }
            __syncthreads();
        }
    }
    {
        const int wk = wgi * NWAVES + F.wave, NW = nwg * NWAVES; int base = 0;
#define SEG(sel, count, ...) do { if (sel) { for (int q = (wk + NW - base % NW) % NW; q < (count); q += NW) { __VA_ARGS__; } base += (count); } } while (0)
        const int I_E = (1024 / 64) * (EVEN_N / 32), I_OE = 16 * 32, I_O = 16 * (ODD_N / 32), I_QB = 4 * 48, I_KVB = 4 * 64, I_M1 = 16 * 128, I_M2 = 64 * 32;
#pragma unroll
        for (int l = 0; l < 2; ++l) {
            SEG((eimask >> l) & 1, I_E, { const int nb = EVEN_N / 32, kb = q / nb, n0 = (q % nb) * 32;
                p0_transpose_item(PIN(I_WINE) + (size_t)l * 1024 * EVEN_N, 1024, EVEN_N, (bf16*)(ws + WS_WINE) + (size_t)l * EVEN_NP * 1024, kb, n0, even_col_map(n0), scr, F.lane); });
            SEG((eomask >> l) & 1, I_OE, { const int kb = q / 32, n0 = (q % 32) * 32;
                p0_transpose_item(PIN(I_WOUTE) + (size_t)l * 1024 * 1024, 1024, 1024, (bf16*)(ws + WS_WOUTE) + (size_t)l * 1024 * 1024, kb, n0, n0, scr, F.lane); });
            SEG((omask >> l) & 1, I_O, { const int nb = ODD_N / 32, kb = q / nb, n0 = (q % nb) * 32;
                p0_transpose_item(PIN(I_WINO) + (size_t)l * 1024 * ODD_N, 1024, ODD_N, (bf16*)(ws + WS_WINO) + (size_t)l * ODD_NP * 1024, kb, n0, n0, scr, F.lane); });
            SEG((omask >> l) & 1, I_QB, { const int kb = q / 48, n0 = (q % 48) * 32;
                p0_transpose_item(PIN(I_WQB) + (size_t)l * 256 * 1536, 256, 1536, (bf16*)(ws + WS_WQB) + (size_t)l * 1536 * 256, kb, n0, n0, scr, F.lane); });
            SEG((omask >> l) & 1, I_KVB, { const int kb = q / 64, n0 = (q % 64) * 32;
                p0_transpose_item(PIN(I_WKVB) + (size_t)l * 256 * 2048, 256, 2048, (bf16*)(ws + WS_WKVB) + (size_t)l * 2048 * 256, kb, n0, n0, scr, F.lane); });
            SEG((omask >> l) & 1, I_OE, { const int kb = q / 32, n0 = (q % 32) * 32;
                p0_transpose_item(PIN(I_WOUTO) + (size_t)l * 1024 * 1024, 1024, 1024, (bf16*)(ws + WS_WOUTO) + (size_t)l * 1024 * 1024, kb, n0, n0, scr, F.lane); });
        }
#pragma unroll
        for (int l = 0; l < 4; ++l) {
            SEG((mmask >> l) & 1, I_M1, { const int kb = q / 128, n0 = (q % 128) * 32;
                p0_transpose_item(PIN(I_W1) + (size_t)l * 1024 * 4096, 1024, 4096, (bf16*)(ws + WS_W1) + (size_t)l * 4096 * 1024, kb, n0, n0, scr, F.lane); });
            SEG((mmask >> l) & 1, I_M2, { const int kb = q / 32, n0 = (q % 32) * 32;
                p0_transpose_item(PIN(I_W2) + (size_t)l * 4096 * 1024, 4096, 1024, (bf16*)(ws + WS_W2) + (size_t)l * 1024 * 4096, kb, n0, n0, scr, F.lane); });
        }
#undef SEG
    }
    const int gt = wgi * 512 + F.tid, NGT = nwg * 512;
#pragma unroll
    for (int l = 0; l < 2; ++l) {
        if ((eimask >> l) & 1) { v4u z_ = {0u, 0u, 0u, 0u}; asm volatile("" : "+v"(z_)); for (int i = gt; i < 224 * 128; i += NGT) *(GAS v4u*)((bf16*)(ws + WS_WINE) + ((size_t)l * EVEN_NP + EVEN_N) * 1024 + (size_t)i * 8) = z_; }
        if ((omask >> l) & 1) { v4u z_ = {0u, 0u, 0u, 0u}; asm volatile("" : "+v"(z_)); for (int i = gt; i < 192 * 128; i += NGT) *(GAS v4u*)((bf16*)(ws + WS_WINO) + ((size_t)l * ODD_NP + ODD_N) * 1024 + (size_t)i * 8) = z_; }
    }
}
__device__ __forceinline__ void p0_prologue(Frame& F, const Params& P) {
    unsigned char* ws = PWS;
    setup_work(F, P, F.vcu, F.G, 0x5, 0x5, 0x3, 0x3, 0x0);
    const int gt = F.vcu * 512 + F.tid, NGT = F.G * 512;
    for (int i = gt; i < 2048 * 32; i += NGT) { const int t = i >> 5, j = i & 31; const float inv = powf(10000.0f, -(float)(j & 15) / 16.0f);
        const float ang = (float)(j < 16 ? (t >> 6) : (t & 63)) * inv;
        ((float*)(ws + WS_ROPE))[i] = cosf(ang); ((float*)(ws + WS_ROPE))[65536 + i] = sinf(ang); }
}

__device__ __forceinline__ void row_y(f32x4 (&yv)[4], const bf16* Y, const bf16* SL, int row, int l4) {
    if (row < 16384) {
#pragma unroll
        for (int j = 0; j < 4; ++j) { const v2u yw = __builtin_nontemporal_load((const v2u*)(Y + (size_t)row * D + l4 + 256 * j)); yv[j] = (f32x4){bflo(yw.x), bfhi(yw.x), bflo(yw.y), bfhi(yw.y)}; }
    } else {
        const bf16* sp = SL + (size_t)(row - 16384) * D + l4;
#pragma unroll
        for (int j = 0; j < 4; ++j) { const v2u w0 = __builtin_nontemporal_load((const v2u*)(sp + 256 * j)), w1 = __builtin_nontemporal_load((const v2u*)(sp + 4194304 + 256 * j)), w2 = __builtin_nontemporal_load((const v2u*)(sp + 2 * 4194304 + 256 * j)), w3 = __builtin_nontemporal_load((const v2u*)(sp + 3 * 4194304 + 256 * j));
            yv[j] = ((f32x4){bflo(w0.x), bfhi(w0.x), bflo(w0.y), bfhi(w0.y)} + (f32x4){bflo(w1.x), bfhi(w1.x), bflo(w1.y), bfhi(w1.y)}) +
                    ((f32x4){bflo(w2.x), bfhi(w2.x), bflo(w2.y), bfhi(w2.y)} + (f32x4){bflo(w3.x), bfhi(w3.x), bflo(w3.y), bfhi(w3.y)}); }
    }
}
struct RowVec { f32x4 gp[4], gt[4], gq[4], sc[4], sh[4]; };
__device__ __forceinline__ void row_post(f32x4 (&v)[4], const f32x4 (&yv)[4], const RowVec& R) {
    float s = 0.f;
#pragma unroll
    for (int j = 0; j < 4; ++j) s += (yv[j][0] * yv[j][0] + yv[j][1] * yv[j][1]) + (yv[j][2] * yv[j][2] + yv[j][3] * yv[j][3]);
    const float rstd = __builtin_amdgcn_rsqf(wave_sum(s) * (1.0f / 1024.0f) + EPS);
#pragma unroll
    for (int j = 0; j < 4; ++j) v[j] = v[j] + R.gt[j] * ((yv[j] * rstd) * R.gp[j]);
}
__device__ __forceinline__ void row_pass(Frame& F, const float* xa, const float* xb, bool xin_f32, bf16* XB, const bf16* Y, const bf16* SL, const float* g_post, const float* gate,
                                         const float* g_pre, const float* scale, const float* shift, bf16* H, bool has_post, bool has_pre) {
    const int gw = F.vcu * NWAVES + F.wave, NGW = F.G * NWAVES, l4 = F.lane * 4;
    RowVec R; int ncur = -1;
#pragma unroll
    for (int j = 0; j < 4; ++j) { R.gp[j] = has_post ? *(const f32x4*)(g_post + l4 + 256 * j) : (f32x4){0.f, 0.f, 0.f, 0.f}; R.gq[j] = has_pre ? *(const f32x4*)(g_pre + l4 + 256 * j) : (f32x4){0.f, 0.f, 0.f, 0.f};
        R.gt[j] = R.gp[j]; R.sc[j] = R.gp[j]; R.sh[j] = R.gp[j]; }
    for (int blk = gw; blk * 10 < M; blk += NGW) for (int i = 0; i < 10; i += 2) {
        const int row0 = blk * 10 + i; if (row0 >= M) break;
        const int n = row0 < M_CTX ? 8 : ((row0 - M_CTX) >> 11);
        if (n != ncur) { ncur = n;
#pragma unroll
            for (int j = 0; j < 4; ++j) { const int c = l4 + 256 * j;
                if (has_post) R.gt[j] = *(const f32x4*)(gate + (size_t)n * 6144 + c);
                if (has_pre) { R.sc[j] = *(const f32x4*)(scale + (size_t)n * 6144 + c); R.sh[j] = *(const f32x4*)(shift + (size_t)n * 6144 + c); } } }
        f32x4 v[2][4], yv[2][4];
#pragma unroll
        for (int q = 0; q < 2; ++q) { const int row = row0 + q;
            if (xin_f32) { const float* xr = row < M_CTX ? xa + (size_t)row * D : xb + (size_t)(row - M_CTX) * D;
#pragma unroll
                for (int j = 0; j < 4; ++j) v[q][j] = __builtin_nontemporal_load((const f32x4*)(xr + l4 + 256 * j));
            } else {
#pragma unroll
                for (int j = 0; j < 4; ++j) { const v2u xw = __builtin_nontemporal_load((const v2u*)(XB + (size_t)row * D + l4 + 256 * j)); v[q][j] = (f32x4){bflo(xw.x), bfhi(xw.x), bflo(xw.y), bfhi(xw.y)}; }
            }
            if (has_post) row_y(yv[q], Y, SL, row, l4); }
#pragma unroll
        for (int q = 0; q < 2; ++q) { const int row = row0 + q;
            if (has_post) {
                row_post(v[q], yv[q], R);
#pragma unroll
                for (int j = 0; j < 4; ++j) *(v2u*)(XB + (size_t)row * D + l4 + 256 * j) = (v2u){pk2(v[q][j][0], v[q][j][1]), pk2(v[q][j][2], v[q][j][3])};
            }
            if (has_pre) {
                float s = 0.f;
#pragma unroll
                for (int j = 0; j < 4; ++j) s += (v[q][j][0] * v[q][j][0] + v[q][j][1] * v[q][j][1]) + (v[q][j][2] * v[q][j][2] + v[q][j][3] * v[q][j][3]);
                const float rstd = __builtin_amdgcn_rsqf(wave_sum(s) * (1.0f / 1024.0f) + EPS);
#pragma unroll
                for (int j = 0; j < 4; ++j) { const f32x4 h = ((v[q][j] * rstd) * R.gq[j]) * (1.0f + R.sc[j]) + R.sh[j];
                    *(v2u*)(H + (size_t)row * D + l4 + 256 * j) = (v2u){pk2(h[0], h[1]), pk2(h[2], h[3])}; }
            } }
    }
}
__device__ __forceinline__ void row_pass_final(Frame& F, const XcdBarrier& bar, const bf16* XB, float* OUT, const bf16* Y, const bf16* SL, const float* g_post, const float* gate) {
    const int gw = F.vcu * NWAVES + F.wave, l4 = F.lane * 4;
    v2u xw[10][4];
#pragma unroll
    for (int i = 0; i < 10; ++i) { const int row = gw * 10 + i;
        if (row < M) {
#pragma unroll
            for (int j = 0; j < 4; ++j) xw[i][j] = __builtin_nontemporal_load((const v2u*)(XB + (size_t)row * D + l4 + 256 * j));
        } }
    xcd_barrier(bar);
    RowVec R; int ncur = -1;
#pragma unroll
    for (int j = 0; j < 4; ++j) { R.gp[j] = *(const f32x4*)(g_post + l4 + 256 * j); R.gt[j] = R.gp[j]; }
#pragma unroll
    for (int i = 0; i < 10; ++i) { const int row = gw * 10 + i;
        if (row < M) {
            const int n = row < M_CTX ? 8 : ((row - M_CTX) >> 11);
            if (n != ncur) { ncur = n;
#pragma unroll
                for (int j = 0; j < 4; ++j) R.gt[j] = *(const f32x4*)(gate + (size_t)n * 6144 + l4 + 256 * j); }
            f32x4 v[4], yv[4];
#pragma unroll
            for (int j = 0; j < 4; ++j) v[j] = (f32x4){bflo(xw[i][j].x), bfhi(xw[i][j].x), bflo(xw[i][j].y), bfhi(xw[i][j].y)};
            row_y(yv, Y, SL, row, l4); row_post(v, yv, R);
#pragma unroll
            for (int j = 0; j < 4; ++j) *(f32x4*)(OUT + (size_t)row * D + l4 + 256 * j) = v[j];
        } }
}

__device__ __forceinline__ int crow(int r, int hi) { return (r & 3) + 8 * (r >> 2) + 4 * hi; }
__device__ __forceinline__ unsigned cvtpk(float lo, float hi) { return pk2(lo, hi); }
#define SBAR() __builtin_amdgcn_sched_barrier(0)
__device__ __forceinline__ int vst_row(int k, int NB) { const int kk = (k & ~0xC) | ((k & 4) << 1) | ((k & 8) >> 1); return (kk >> 3) * NB * 512 + (kk & 7) * 64; }
__device__ __forceinline__ int vst(int k, int c, int NB) { return vst_row(k, NB) + (c >> 5) * 512 + (c & 31) * 2; }
__device__ __forceinline__ int v_rd_base(int lane) { return ((lane & 3) << 3) | (((lane >> 2) & 3) << 6) | (((lane >> 4) & 1) << 5) | (((lane >> 5) & 1) << 8); }
template <int OFF> __device__ __forceinline__ s16x4 tr_read(unsigned vb) { s16x4 r; asm volatile("ds_read_b64_tr_b16 %0, %1 offset:%2" : "=&v"(r) : "v"(vb), "i"(OFF) : "memory"); return r; }
#define PKF(L, H) ((bf16x8){L[0], L[1], L[2], L[3], H[0], H[1], H[2], H[3]})
#define PK4(P, BASE, OUT) do { unsigned a0_ = cvtpk(P[BASE + 0], P[BASE + 1]), a1_ = cvtpk(P[BASE + 2], P[BASE + 3]);   \
    unsigned b0_ = cvtpk(P[BASE + 4], P[BASE + 5]), b1_ = cvtpk(P[BASE + 6], P[BASE + 7]);                              \
    auto r0_ = __builtin_amdgcn_permlane32_swap(a0_, b0_, false, false); auto r1_ = __builtin_amdgcn_permlane32_swap(a1_, b1_, false, false); \
    v4u w_ = {r0_[0], r1_[0], r0_[1], r1_[1]}; OUT = __builtin_bit_cast(bf16x8, w_); } while (0)
__device__ __forceinline__ float fexp(float x) { return __builtin_amdgcn_exp2f(x * 1.4426950408889634f); }
__device__ __forceinline__ float logsig(float x) { return fminf(x, 0.f) - 0.6931471805599453f * __builtin_amdgcn_logf(1.0f + __builtin_amdgcn_exp2f(-1.4426950408889634f * fabsf(x))); }

constexpr int SC_T = 0  , SC_TSZ = 32768, SC_QD = 0, SC_KI = 8192, SC_VT = 16384, SC_ST = 65536, SC_BT = 81920  , SC_TOT = 114688, SC_DL = 115200  ;
__device__ __forceinline__ void scan_phase(Frame& F, const Params& P, int li) {
    unsigned char* ws = PWS;
    const bf16* PROJ = (const bf16*)(ws + WS_BIG);
    const float* ROPE = (const float*)(ws + WS_ROPE);
    LAS unsigned char* G = F.lds;
    const unsigned gaddr = (unsigned)(uintptr_t)G;
    const bool isP = F.wave >= 4; const int gw4 = F.wave & 3;
    const int ri = gw4 >> 1, dh = gw4 & 1;
#define SC_BAR() do { asm volatile("s_waitcnt lgkmcnt(0)" ::: "memory"); __builtin_amdgcn_s_barrier(); asm volatile("" ::: "memory"); } while (0)
#define SC_TOK(c, i) (dir == 0 ? 64 * (c) + (i) : L - 1 - (64 * (c) + (i)))
    for (int u0 = F.bid; u0 < 256; u0 += F.G) for (int kk_ = 0; kk_ < (u0 < 128 ? 1 : 2); ++kk_) {
        __syncthreads();
        const bool lat = u0 < 128; const int u = lat ? u0 : 2 * (u0 - 128) + kk_;
        const int sb = u >> 4, hh = (u >> 1) & 7, dir = u & 1;
        const int L = lat ? L_LAT : L_CTX, row0 = lat ? M_CTX + sb * L_LAT : sb * L_CTX, NC = L / 64;
        const bool gla = hh < 4; const int h = hh & 3;
        const int qc = (gla ? PC_QA : PC_QB) + h * 64, kc = (gla ? PC_KA : PC_KB) + h * 64, vc = (gla ? PC_VA : PC_VB) + h * 128, gkc = PC_GK + dir * 16;
        bf16* OUT = (bf16*)(ws + (dir == 0 ? WS_Y : WS_HB));
        const float* rdec_p = PIN(I_RDEC); const float* wgk2_p = PIN(I_WGK2); const float* bgk2_p = PIN(I_BGK2);
        const float lgr = gla ? 0.f : -fexp(rdec_p[(li * 2 + dir) * 4 + h]);
        f32x16 sacc[2]; sacc[0] = f32x16{}; sacc[1] = f32x16{}; v4u w2f = {0u, 0u, 0u, 0u}; float gbias = 0.f;
        { int t0_ = F.tid; asm volatile("" : "+v"(t0_)); const int lane = t0_ & 63, r32 = lane & 31, hi = lane >> 5;
          if (isP) {
              if (gla) { const int kcol = h * 64 + 32 * (gw4 & 1) + r32; const float* wp_ = wgk2_p + ((size_t)(li * 2 + dir) * 16 + 8 * hi) * 256 + kcol;
                  w2f = (v4u){pk2(wp_[0], wp_[256]), pk2(wp_[512], wp_[768]), pk2(wp_[1024], wp_[1280]), pk2(wp_[1536], wp_[1792])};
                  gbias = bgk2_p[(li * 2 + dir) * 256 + kcol]; }
              else if (t0_ < 256 + 192) ((LAS float*)(G + SC_DL))[t0_ - 256] = fexp(64.0f * lgr);
          } else {
              const float* S0 = (gla ? PIN(I_SGLA) : PIN(I_SRET)) + ((size_t)((sb * 2 + li) * 2 + dir) * 4 + h) * 8192;
              if (lat) {
#pragma unroll
                  for (int d = 0; d < 2; ++d)
#pragma unroll
                      for (int r = 0; r < 16; ++r) sacc[d][r] = S0[(32 * ri + crow(r, hi)) * 128 + 32 * (2 * dh + d) + r32];
              }
#pragma unroll
              for (int d = 0; d < 2; ++d)
#pragma unroll
                  for (int r = 0; r < 16; r += 2) { const unsigned w = pk2(sacc[d][r], sacc[d][r + 1]);
                      LAS unsigned char* sp_ = G + SC_ST + (hi + 4 * ri) * 2048 + (2 * dh + d) * 512 + r32 * 2 + ((r >> 3) & 1) * 4096 + ((r & 3) + 4 * ((r >> 2) & 1)) * 64;
                      *(LAS unsigned short*)sp_ = (unsigned short)w; *(LAS unsigned short*)(sp_ + 64) = (unsigned short)(w >> 16); }
          } }
        v4u pq0 = {}, pq1 = {}, pk0 = {}, pk1 = {}, pv[4] = {}; v4u pga = {0u, 0u, 0u, 0u}; float cs[16] = {}; float tsum = 0.f;
#define SC_LOADRAW(c) do { const unsigned ro_ = (unsigned)(row0 + SC_TOK(c, sti)) * (unsigned)(EVEN_NP * 2); const char* pc_ = (const char*)PROJ; \
        pq0 = *(const v4u*)(pc_ + (ro_ + (unsigned)(qc + 8 * c8) * 2u)); pq1 = *(const v4u*)(pc_ + (ro_ + (unsigned)(qc + 32 + 8 * c8) * 2u)); \
        pk0 = *(const v4u*)(pc_ + (ro_ + (unsigned)(kc + 8 * c8) * 2u)); pk1 = *(const v4u*)(pc_ + (ro_ + (unsigned)(kc + 32 + 8 * c8) * 2u)); \
        _Pragma("unroll") for (int m_ = 0; m_ < 4; ++m_) pv[m_] = *(const v4u*)(pc_ + (ro_ + (unsigned)(vc + c8 * 32 + 8 * m_) * 2u)); } while (0)
#define SC_LOADGK(c) do { const char* gp_ = (const char*)PROJ + ((unsigned)(row0 + SC_TOK(c, 32 * (gw4 >> 1) + r32)) * (unsigned)(EVEN_NP * 2) + (unsigned)(gkc + 8 * hi) * 2u); \
        pga = *(const v4u*)gp_; \
        if (row0 >= 16384) { const v4u p1_ = *(const v4u*)(gp_ + 64), p2_ = *(const v4u*)(gp_ + 128), p3_ = *(const v4u*)(gp_ + 192); \
            _Pragma("unroll") for (int e_ = 0; e_ < 4; ++e_) pga[e_] = pk2((bflo(pga[e_]) + bflo(p1_[e_])) + (bflo(p2_[e_]) + bflo(p3_[e_])), (bfhi(pga[e_]) + bfhi(p1_[e_])) + (bfhi(p2_[e_]) + bfhi(p3_[e_]))); } } while (0)
        if (isP && gla) { int t0_ = F.tid; asm volatile("" : "+v"(t0_)); const int r32 = t0_ & 31, hi = (t0_ >> 5) & 1; SC_LOADGK(0); }
        for (int s = -3; s < NC; ++s) {
            int tid_o = F.tid; asm volatile("" : "+v"(tid_o));
            const int lane = tid_o & 63, r32 = lane & 31, hi = lane >> 5, tgp = tid_o & 255, sti = tgp >> 2, c8 = tgp & 3;
            if (isP) {
                if (gla && s + 2 >= 0 && s + 2 < NC) {
                    const int th = gw4 >> 1, kq = 32 * (gw4 & 1) + r32; LAS float* BTw = (LAS float*)(G + SC_BT + ((s + 2) & 1) * 16384);
                    const float t0v = ((LAS float*)(G + SC_TOT))[kq]; const float pre = th ? t0v : 0.f;
#pragma unroll
                    for (int r = 0; r < 16; ++r) BTw[(32 * th + crow(r, hi)) * 64 + kq] = pre + cs[r];
                    if (th == 1 && hi == 0) ((LAS float*)(G + SC_DL))[((s + 2) % 3) * 64 + kq] = fexp(pre + tsum);
                }
                if (s + 1 >= 0 && s + 1 < NC) {
                    LAS unsigned char* T = G + SC_T + ((s + 1) & 1) * SC_TSZ;
                    float q[16], kk[16];
#define UNPK(dst, o, W_) do { const v4u w_ = (W_); dst[o + 0] = bflo(w_[0]); dst[o + 1] = bfhi(w_[0]); dst[o + 2] = bflo(w_[1]); dst[o + 3] = bfhi(w_[1]); dst[o + 4] = bflo(w_[2]); dst[o + 5] = bfhi(w_[2]); dst[o + 6] = bflo(w_[3]); dst[o + 7] = bfhi(w_[3]); } while (0)
                    UNPK(q, 0, pq0); UNPK(q, 8, pq1); UNPK(kk, 0, pk0); UNPK(kk, 8, pk1);
                    if (gla) {
                        const LAS float* BTr = (const LAS float*)(G + SC_BT + ((s + 1) & 1) * 16384) + sti * 64 + 8 * c8;
                        const f32x4 x0 = *(const LAS f32x4*)BTr, x1 = *(const LAS f32x4*)(BTr + 4), x2 = *(const LAS f32x4*)(BTr + 32), x3 = *(const LAS f32x4*)(BTr + 36);
#pragma unroll
                        for (int e = 0; e < 4; ++e) { const float e0 = fexp(x0[e]), e1 = fexp(x1[e]), e2 = fexp(x2[e]), e3 = fexp(x3[e]);
                            q[e] *= 0.125f * e0; kk[e] *= __builtin_amdgcn_rcpf(e0); q[4 + e] *= 0.125f * e1; kk[4 + e] *= __builtin_amdgcn_rcpf(e1);
                            q[8 + e] *= 0.125f * e2; kk[8 + e] *= __builtin_amdgcn_rcpf(e2); q[12 + e] *= 0.125f * e3; kk[12 + e] *= __builtin_amdgcn_rcpf(e3); }
                    } else {
                        if (lat) {
                            const float* cp = ROPE + (size_t)SC_TOK(s + 1, sti) * 32 + 8 * c8; const f32x4 c0 = *(const f32x4*)cp, c1 = *(const f32x4*)(cp + 4), s0 = *(const f32x4*)(cp + 65536), s1 = *(const f32x4*)(cp + 65540);
#pragma unroll
                            for (int e = 0; e < 8; ++e) { const float c = e < 4 ? c0[e & 3] : c1[e & 3], sn = e < 4 ? s0[e & 3] : s1[e & 3];
                                const float q1 = q[e], q2 = q[8 + e]; q[e] = q1 * c - q2 * sn; q[8 + e] = q1 * sn + q2 * c;
                                const float k1 = kk[e], k2 = kk[8 + e]; kk[e] = k1 * c - k2 * sn; kk[8 + e] = k1 * sn + k2 * c; }
                        }
                        const float bb = (float)(sti + 1) * lgr, eb = fexp(bb), ek = 0.125f * __builtin_amdgcn_rcpf(eb);
#pragma unroll
                        for (int e = 0; e < 16; ++e) { q[e] *= eb; kk[e] *= ek; }
                    }
                    *(LAS v4u*)(T + SC_QD + vst(sti, 8 * c8, 2)) = (v4u){pk2(q[0], q[1]), pk2(q[2], q[3]), pk2(q[4], q[5]), pk2(q[6], q[7])};
                    *(LAS v4u*)(T + SC_QD + vst(sti, 32 + 8 * c8, 2)) = (v4u){pk2(q[8], q[9]), pk2(q[10], q[11]), pk2(q[12], q[13]), pk2(q[14], q[15])};
                    *(LAS v4u*)(T + SC_KI + vst(sti, 8 * c8, 2)) = (v4u){pk2(kk[0], kk[1]), pk2(kk[2], kk[3]), pk2(kk[4], kk[5]), pk2(kk[6], kk[7])};
                    *(LAS v4u*)(T + SC_KI + vst(sti, 32 + 8 * c8, 2)) = (v4u){pk2(kk[8], kk[9]), pk2(kk[10], kk[11]), pk2(kk[12], kk[13]), pk2(kk[14], kk[15])};
#pragma unroll
                    for (int m = 0; m < 4; ++m) *(LAS v4u*)(T + SC_VT + vst(sti, c8 * 32 + 8 * m, 4)) = pv[m];
                }
                if (s + 2 >= 0 && s + 2 < NC) SC_LOADRAW(s + 2);
            } else if (s >= 0) {
                LAS unsigned char* T = G + SC_T + (s & 1) * SC_TSZ; const unsigned taddr = gaddr + SC_T + (s & 1) * SC_TSZ;
                bf16x8 qf[4]; bf16x8 pa0, pa1, pa2, pa3;
                { const int qb_ = vst_row(32 * ri + r32, 2) + 16 * hi;
                  qf[0] = *(const LAS bf16x8*)(T + SC_QD + qb_); qf[1] = *(const LAS bf16x8*)(T + SC_QD + qb_ + 32); qf[2] = *(const LAS bf16x8*)(T + SC_QD + qb_ + 512); qf[3] = *(const LAS bf16x8*)(T + SC_QD + qb_ + 544); }
                { f32x16 p0 = {}, p1 = {};
                  const int kb0 = vst_row(r32, 2) + 16 * hi, kb1 = vst_row(32 + r32, 2) + 16 * hi;
                  { const bf16x8 a0 = *(const LAS bf16x8*)(T + SC_KI + kb0), a1 = *(const LAS bf16x8*)(T + SC_KI + kb0 + 32), a2 = *(const LAS bf16x8*)(T + SC_KI + kb0 + 512), a3 = *(const LAS bf16x8*)(T + SC_KI + kb0 + 544);
                    p0 = __builtin_amdgcn_mfma_f32_32x32x16_bf16(a0, qf[0], p0, 0, 0, 0); p0 = __builtin_amdgcn_mfma_f32_32x32x16_bf16(a1, qf[1], p0, 0, 0, 0);
                    p0 = __builtin_amdgcn_mfma_f32_32x32x16_bf16(a2, qf[2], p0, 0, 0, 0); p0 = __builtin_amdgcn_mfma_f32_32x32x16_bf16(a3, qf[3], p0, 0, 0, 0); }
                  if (ri == 1) {
                      const bf16x8 c0 = *(const LAS bf16x8*)(T + SC_KI + kb1), c1 = *(const LAS bf16x8*)(T + SC_KI + kb1 + 32), c2 = *(const LAS bf16x8*)(T + SC_KI + kb1 + 512), c3 = *(const LAS bf16x8*)(T + SC_KI + kb1 + 544);
                      p1 = __builtin_amdgcn_mfma_f32_32x32x16_bf16(c0, qf[0], p1, 0, 0, 0); p1 = __builtin_amdgcn_mfma_f32_32x32x16_bf16(c1, qf[1], p1, 0, 0, 0);
                      p1 = __builtin_amdgcn_mfma_f32_32x32x16_bf16(c2, qf[2], p1, 0, 0, 0); p1 = __builtin_amdgcn_mfma_f32_32x32x16_bf16(c3, qf[3], p1, 0, 0, 0); }
#pragma unroll
                  for (int r = 0; r < 16; ++r) { const bool keep = crow(r, hi) <= r32; if (ri == 0) { p0[r] = keep ? p0[r] : 0.f; } else { p1[r] = keep ? p1[r] : 0.f; } }
                  PK4(p0, 0, pa0); PK4(p0, 8, pa1); PK4(p1, 0, pa2); PK4(p1, 8, pa3); }
                const unsigned vb = taddr + SC_VT + v_rd_base(lane) + dh * 1024, sbv = gaddr + SC_ST + v_rd_base(lane) + dh * 1024;
#define SC_FR4(dst, base, d) do { const s16x4 l0_ = tr_read<(d) * 512>(base), h0_ = tr_read<(d) * 512 + 2048>(base), l1_ = tr_read<(d) * 512 + 4096>(base), h1_ = tr_read<(d) * 512 + 4096 + 2048>(base); \
                  const s16x4 l2_ = tr_read<(d) * 512 + 8192>(base), h2_ = tr_read<(d) * 512 + 8192 + 2048>(base), l3_ = tr_read<(d) * 512 + 12288>(base), h3_ = tr_read<(d) * 512 + 12288 + 2048>(base); \
                  asm volatile("s_waitcnt lgkmcnt(0)" ::: "memory"); SBAR(); \
                  dst[0] = PKF(l0_, h0_); dst[1] = PKF(l1_, h1_); dst[2] = PKF(l2_, h2_); dst[3] = PKF(l3_, h3_); } while (0)
#define SC_OBLK(d) do { bf16x8 vf_[4], sf_[4]; SC_FR4(vf_, vb, d); SC_FR4(sf_, sbv, d); f32x16 o_ = {}; \
                  o_ = __builtin_amdgcn_mfma_f32_32x32x16_bf16(pa0, vf_[0], o_, 0, 0, 0); o_ = __builtin_amdgcn_mfma_f32_32x32x16_bf16(pa1, vf_[1], o_, 0, 0, 0); \
                  if (ri == 1) { o_ = __builtin_amdgcn_mfma_f32_32x32x16_bf16(pa2, vf_[2], o_, 0, 0, 0); o_ = __builtin_amdgcn_mfma_f32_32x32x16_bf16(pa3, vf_[3], o_, 0, 0, 0); } \
                  o_ = __builtin_amdgcn_mfma_f32_32x32x16_bf16(qf[0], sf_[0], o_, 0, 0, 0); o_ = __builtin_amdgcn_mfma_f32_32x32x16_bf16(qf[1], sf_[1], o_, 0, 0, 0); \
                  o_ = __builtin_amdgcn_mfma_f32_32x32x16_bf16(qf[2], sf_[2], o_, 0, 0, 0); o_ = __builtin_amdgcn_mfma_f32_32x32x16_bf16(qf[3], sf_[3], o_, 0, 0, 0); \
                  char* dst_ = (char*)OUT; \
                  _Pragma("unroll") for (int r = 0; r < 16; r += 2) { const int i_ = 32 * ri + crow(r, hi); const int t_ = SC_TOK(s, i_); const unsigned w_ = pk2(o_[r], o_[r + 1]); \
                      const unsigned a_ = (unsigned)(row0 + t_) * (unsigned)(D * 2) + (unsigned)(hh * 128 + 64 * dh + 32 * (d) + r32) * 2u; \
                      *(bf16*)(dst_ + a_) = (bf16)w_; *(bf16*)(dst_ + (dir == 0 ? a_ + (unsigned)(D * 2) : a_ - (unsigned)(D * 2))) = (bf16)(w_ >> 16); } SBAR(); } while (0)
                SC_OBLK(0); SC_OBLK(1);
            }
            SC_BAR();
            if (isP) {
                if (gla && s + 3 < NC) {
                    const int th = gw4 >> 1, kq = 32 * (gw4 & 1) + r32;
                    f32x16 gp;
#pragma unroll
                    for (int r = 0; r < 16; ++r) gp[r] = gbias;
                    gp = __builtin_amdgcn_mfma_f32_32x32x16_bf16(__builtin_bit_cast(bf16x8, pga), __builtin_bit_cast(bf16x8, w2f), gp, 0, 0, 0);
                    float g4[4], o4[4];
#pragma unroll
                    for (int j = 0; j < 4; ++j) { float run = 0.f;
#pragma unroll
                        for (int e = 0; e < 4; ++e) { run += logsig(gp[4 * j + e]) * (1.0f / 16.0f); cs[4 * j + e] = run; }
                        g4[j] = run; }
#pragma unroll
                    for (int j = 0; j < 4; ++j) o4[j] = __shfl_xor(g4[j], 32);
                    float acc_ = 0.f;
#pragma unroll
                    for (int j = 0; j < 4; ++j) { const float off = acc_ + (hi ? o4[j] : 0.f);
#pragma unroll
                        for (int e = 0; e < 4; ++e) cs[4 * j + e] += off;
                        acc_ += g4[j] + o4[j]; }
                    tsum = acc_;
                    if (hi == 0) ((LAS float*)(G + SC_TOT))[th * 64 + kq] = tsum;
                    if (s + 4 < NC) SC_LOADGK(s + 4);
                }
            } else if (s >= 0) {
                const unsigned taddr = gaddr + SC_T + (s & 1) * SC_TSZ;
                const unsigned vb = taddr + SC_VT + v_rd_base(lane) + dh * 1024, kt = taddr + SC_KI + v_rd_base(lane) + ri * 512;
                bf16x8 kf[4];
                { const s16x4 l0_ = tr_read<0>(kt), h0_ = tr_read<1024>(kt), l1_ = tr_read<2048>(kt), h1_ = tr_read<2048 + 1024>(kt), l2_ = tr_read<4096>(kt), h2_ = tr_read<4096 + 1024>(kt), l3_ = tr_read<6144>(kt), h3_ = tr_read<6144 + 1024>(kt);
                  asm volatile("s_waitcnt lgkmcnt(0)" ::: "memory"); SBAR();
                  kf[0] = PKF(l0_, h0_); kf[1] = PKF(l1_, h1_); kf[2] = PKF(l2_, h2_); kf[3] = PKF(l3_, h3_); }
                const int stb_ = (hi + 4 * ri) * 2048 + (2 * dh) * 512 + r32 * 2;
                const LAS float* DLr = (const LAS float*)(G + SC_DL) + (s % 3) * 64;
#define SC_SBLK(d) do { bf16x8 vf_[4]; SC_FR4(vf_, vb, d); \
                  _Pragma("unroll") for (int ks = 0; ks < 4; ++ks) sacc[d] = __builtin_amdgcn_mfma_f32_32x32x16_bf16(kf[ks], vf_[ks], sacc[d], 0, 0, 0); \
                  _Pragma("unroll") for (int r = 0; r < 16; r += 2) { const int dk = 32 * ri + crow(r, hi); const float dl0 = DLr[dk], dl1 = DLr[dk + 1]; \
                      sacc[d][r] *= dl0; sacc[d][r + 1] *= dl1; const unsigned w_ = pk2(sacc[d][r], sacc[d][r + 1]); \
                      LAS unsigned char* sp_ = G + SC_ST + stb_ + (d) * 512 + ((r >> 3) & 1) * 4096 + ((r & 3) + 4 * ((r >> 2) & 1)) * 64; \
                      *(LAS unsigned short*)sp_ = (unsigned short)w_; *(LAS unsigned short*)(sp_ + 64) = (unsigned short)(w_ >> 16); } SBAR(); } while (0)
                SC_SBLK(0); SC_SBLK(1);
            }
            SC_BAR();
        }
        if (!lat && !isP) { int l2 = F.lane; asm volatile("" : "+v"(l2)); const int r32 = l2 & 31, hi = l2 >> 5; float* SO = POUT + (gla ? OUT_SGLA : OUT_SRET) + ((size_t)((sb * 2 + li) * 2 + dir) * 4 + h) * 8192;
#pragma unroll
            for (int d = 0; d < 2; ++d)
#pragma unroll
                for (int r = 0; r < 16; ++r) SO[(32 * ri + crow(r, hi)) * 128 + 32 * (2 * dh + d) + r32] = sacc[d][r]; }
    }
#undef SC_TOK
#undef SC_BAR
#undef SC_LOADRAW
#undef SC_LOADGK
#undef UNPK
#undef SC_FR4
#undef SC_OBLK
#undef SC_SBLK
    if (F.G == 256 && F.bid >= 128) { if (li == 0) setup_work(F, P, F.bid - 128, 128, 0x2, 0x2, 0x0, 0x0, 0x1); else setup_work(F, P, F.bid - 128, 128, 0x8, 0x8, 0x0, 0x0, 0x2); }
    else if (F.G != 256) { if (li == 0) setup_work(F, P, F.bid, F.G, 0x2, 0x2, 0x0, 0x0, 0x1); else setup_work(F, P, F.bid, F.G, 0x8, 0x8, 0x0, 0x0, 0x2); }
}
__device__ __forceinline__ void scan_combine(Frame& F, const Params& P, int li) {
    unsigned char* ws = PWS;
    const char* PROJ = (const char*)(ws + WS_BIG); const char* OF = (const char*)(ws + WS_Y); char* OB = (char*)(ws + WS_HB);
    const int gw = F.vcu * NWAVES + F.wave, NGW = F.G * NWAVES, lane = F.lane, hh = lane >> 3, dv = (lane & 7) * 16;
    f32x4 gn[4];
    { const float* gp_ = PIN(I_GLAN) + li * 128 + dv;
#pragma unroll
      for (int j = 0; j < 4; ++j) gn[j] = hh < 4 ? *(const f32x4*)(gp_ + 4 * j) : (f32x4){1.f, 1.f, 1.f, 1.f}; }
    const unsigned gcol = (unsigned)((hh < 4 ? PC_GA : PC_GB) + (hh & 3) * 128 + dv) * 2u, ocol = (unsigned)(hh * 128 + dv) * 2u;
    for (int row = gw; row < M; row += 2 * NGW) {
        v4u a[2][2], b[2][2], g[2][2];
#pragma unroll
        for (int i = 0; i < 2; ++i) { const int r_ = row + i * NGW; if (r_ < M) {
            const unsigned off = (unsigned)r_ * (unsigned)(D * 2) + ocol, goff = (unsigned)r_ * (unsigned)(EVEN_NP * 2) + gcol;
            a[i][0] = __builtin_nontemporal_load((const v4u*)(OF + off)); a[i][1] = __builtin_nontemporal_load((const v4u*)(OF + off + 16)); b[i][0] = __builtin_nontemporal_load((const v4u*)(OB + off)); b[i][1] = __builtin_nontemporal_load((const v4u*)(OB + off + 16));
            g[i][0] = __builtin_nontemporal_load((const v4u*)(PROJ + goff)); g[i][1] = __builtin_nontemporal_load((const v4u*)(PROJ + goff + 16)); } }
#pragma unroll
        for (int i = 0; i < 2; ++i) { const int r_ = row + i * NGW; if (r_ < M) {
            const unsigned off = (unsigned)r_ * (unsigned)(D * 2) + ocol;
            float x[16], gg[16];
#pragma unroll
            for (int hf = 0; hf < 2; ++hf)
#pragma unroll
                for (int e = 0; e < 4; ++e) { x[8 * hf + 2 * e] = bflo(a[i][hf][e]) + bflo(b[i][hf][e]); x[8 * hf + 2 * e + 1] = bfhi(a[i][hf][e]) + bfhi(b[i][hf][e]);
                    gg[8 * hf + 2 * e] = bflo(g[i][hf][e]); gg[8 * hf + 2 * e + 1] = bfhi(g[i][hf][e]); }
            float ss = 0.f;
#pragma unroll
            for (int e = 0; e < 16; ++e) ss += x[e] * x[e];
            ss += __shfl_xor(ss, 1); ss += __shfl_xor(ss, 2); ss += __shfl_xor(ss, 4);
            const float rstd = __builtin_amdgcn_rsqf(ss * (1.0f / 128.0f) + EPS);
#pragma unroll
            for (int e = 0; e < 16; ++e) x[e] = x[e] * rstd * gn[e >> 2][e & 3] * siluf(gg[e]);
            *(v4u*)(OB + off) = (v4u){pk2(x[0], x[1]), pk2(x[2], x[3]), pk2(x[4], x[5]), pk2(x[6], x[7])};
            *(v4u*)(OB + off + 16) = (v4u){pk2(x[8], x[9]), pk2(x[10], x[11]), pk2(x[12], x[13]), pk2(x[14], x[15])}; } }
    }
}

__device__ __forceinline__ void cache_pass(Frame& F, const Params& P, int li) {
    unsigned char* ws = PWS;
    const int gt = F.vcu * 512 + F.tid, NGT = F.G * 512;
    const float* cckv_ = PIN(I_CCKV); const float* ckpe_ = PIN(I_CKPE);
    for (int i = gt; i < 8 * 256 * 32; i += NGT) { const int c8 = i & 31, t = (i >> 5) & 255, b = i >> 13;
        const float* s = cckv_ + ((size_t)((b * 2 + li) * 256 + t) * 32 + c8) * 8; const f32x4 a = *(const f32x4*)s, c = *(const f32x4*)(s + 4);
        *(GAS v4u*)((bf16*)(ws + WS_ACKV) + ((size_t)4096 + b * LKV + t) * 256 + c8 * 8) = (v4u){pk2(a[0], a[1]), pk2(a[2], a[3]), pk2(c[0], c[1]), pk2(c[2], c[3])}; }
    for (int i = gt; i < 8 * 256 * 8; i += NGT) { const int c8 = i & 7, t = (i >> 3) & 255, b = i >> 11;
        const float* s = ckpe_ + ((size_t)((b * 2 + li) * 256 + t) * 8 + c8) * 8; const f32x4 a = *(const f32x4*)s, c = *(const f32x4*)(s + 4);
        *(GAS v4u*)((bf16*)(ws + WS_KPE) + ((size_t)4096 + b * LKV + t) * 64 + c8 * 8) = (v4u){pk2(a[0], a[1]), pk2(a[2], a[3]), pk2(c[0], c[1]), pk2(c[2], c[3])}; }
}
__device__ __forceinline__ void kpe_pass(Frame& F, const Params& P, int li) {
    unsigned char* ws = PWS;
    const float* KR = (const float*)(ws + WS_Y); const float* ROPE = (const float*)(ws + WS_ROPE);
    bf16* KPE = (bf16*)(ws + WS_KPE);
    const int gt = F.vcu * 512 + F.tid, NGT = F.G * 512;
    for (int i = gt; i < M * 4; i += NGT) {
        const int row = i >> 2, c8 = i & 3;
        const float* s = KR + (size_t)row * 64 + 8 * c8;
        f32x4 a0 = *(const f32x4*)s, a1 = *(const f32x4*)(s + 4), b0 = *(const f32x4*)(s + 32), b1 = *(const f32x4*)(s + 36);
        int drow = row;
        if (row >= M_CTX) { const int lb = (row - M_CTX) >> 11, t = (row - M_CTX) & 2047; drow = M_CTX + lb * LKV + PAST + t;
            const float* cp = ROPE + (size_t)t * 32 + 8 * c8; const float* sp = cp + 65536;
            const f32x4 c0 = *(const f32x4*)cp, c1 = *(const f32x4*)(cp + 4), s0 = *(const f32x4*)sp, s1 = *(const f32x4*)(sp + 4);
            const f32x4 x0 = a0 * c0 - b0 * s0, x1 = a1 * c1 - b1 * s1, y0 = a0 * s0 + b0 * c0, y1 = a1 * s1 + b1 * c1;
            a0 = x0; a1 = x1; b0 = y0; b1 = y1; }
        bf16* d = KPE + (size_t)drow * 64 + 8 * c8;
        *(v4u*)d = (v4u){pk2(a0[0], a0[1]), pk2(a0[2], a0[3]), pk2(a1[0], a1[1]), pk2(a1[2], a1[3])};
        *(v4u*)(d + 32) = (v4u){pk2(b0[0], b0[1]), pk2(b0[2], b0[3]), pk2(b1[0], b1[1]), pk2(b1[2], b1[3])};
    }
}

constexpr float ATT_SCALE = 0.07216878364870322f;
constexpr float ATT_THR = 8.f;
constexpr int AT_V = 0, AT_KN = 49152, AT_KP = 98304, AT_WS = 122880, AT_VB = 16384, AT_KNB = 16384, AT_KPB = 8192;
#define KSWZ(row, colB) ((row) * 256 + ((colB) ^ (((row) & 7) << 4)))
#define KPSWZ(row, colB) ((row) * 128 + ((colB) ^ (((row) & 7) << 4)))
__device__ __forceinline__ void at_partialSM(f32x16& p0, f32x16& p1, float& m_reg, float& mn, float& alpha) {
    constexpr float C = ATT_SCALE * 1.4426950408889634f;
    float pmax = p0[0];
#pragma unroll
    for (int r = 1; r < 16; ++r) pmax = fmaxf(pmax, p0[r]);
#pragma unroll
    for (int r = 0; r < 16; ++r) pmax = fmaxf(pmax, p1[r]);
    { auto rr = __builtin_amdgcn_permlane32_swap(__float_as_uint(pmax), __float_as_uint(pmax), false, false); pmax = fmaxf(__uint_as_float(rr[0]), __uint_as_float(rr[1])); }
    if (__builtin_expect(__all(pmax - m_reg <= ATT_THR / ATT_SCALE), 1)) { mn = m_reg; alpha = 1.f; }
    else { mn = fmaxf(m_reg, pmax); alpha = __builtin_amdgcn_exp2f((m_reg - mn) * C); m_reg = mn; }
    const float mnC = -mn * C;
#pragma unroll
    for (int r = 0; r < 16; ++r) p0[r] = fmaf(p0[r], C, mnC);
#pragma unroll
    for (int r = 0; r < 16; ++r) p1[r] = fmaf(p1[r], C, mnC);
#pragma unroll
    for (int r = 0; r < 16; ++r) p0[r] = __builtin_amdgcn_exp2f(p0[r]);
}
__device__ __forceinline__ void at_finishSM(f32x16& p0, f32x16& p1, float alpha, float& l_reg, bf16x8& pa0, bf16x8& pa1, bf16x8& pa2, bf16x8& pa3) {
#pragma unroll
    for (int r = 0; r < 16; ++r) p1[r] = __builtin_amdgcn_exp2f(p1[r]);
    float ps = 0;
#pragma unroll
    for (int r = 0; r < 16; ++r) ps += p0[r];
#pragma unroll
    for (int r = 0; r < 16; ++r) ps += p1[r];
    { auto rr = __builtin_amdgcn_permlane32_swap(__float_as_uint(ps), __float_as_uint(ps), false, false); ps = __uint_as_float(rr[0]) + __uint_as_float(rr[1]); }
    l_reg = l_reg * alpha + ps;
    PK4(p0, 0, pa0); PK4(p0, 8, pa1); PK4(p1, 0, pa2); PK4(p1, 8, pa3);
}
__device__ __forceinline__ void at_qkt(f32x16& p0, f32x16& p1, const LAS unsigned char* Kn, const LAS unsigned char* Kp, const bf16x8* qr, const int* kb, const int* pb) {
    p0 = f32x16{}; p1 = f32x16{};
#pragma unroll
    for (int d0 = 0; d0 < 8; ++d0) {
        const bf16x8 b0 = *(const LAS bf16x8*)(Kn + kb[d0 & 3] + 128 * (d0 >> 2)), b1 = *(const LAS bf16x8*)(Kn + kb[d0 & 3] + 128 * (d0 >> 2) + 8192);
        p0 = __builtin_amdgcn_mfma_f32_32x32x16_bf16(b0, qr[d0], p0, 0, 0, 0);
        p1 = __builtin_amdgcn_mfma_f32_32x32x16_bf16(b1, qr[d0], p1, 0, 0, 0); }
#pragma unroll
    for (int d0 = 0; d0 < 4; ++d0) {
        const bf16x8 b0 = *(const LAS bf16x8*)(Kp + pb[d0]), b1 = *(const LAS bf16x8*)(Kp + pb[d0] + 4096);
        p0 = __builtin_amdgcn_mfma_f32_32x32x16_bf16(b0, qr[8 + d0], p0, 0, 0, 0);
        p1 = __builtin_amdgcn_mfma_f32_32x32x16_bf16(b1, qr[8 + d0], p1, 0, 0, 0); }
}
template <int D0> __device__ __forceinline__ void at_pv_one(f32x16& od, unsigned vb, bf16x8 pa0, bf16x8 pa1, bf16x8 pa2, bf16x8 pa3) {
    const s16x4 l0 = tr_read<D0 * 512>(vb), h0 = tr_read<D0 * 512 + 2048>(vb), l1 = tr_read<D0 * 512 + 4096>(vb), h1 = tr_read<D0 * 512 + 4096 + 2048>(vb);
    const s16x4 l2 = tr_read<D0 * 512 + 8192>(vb), h2 = tr_read<D0 * 512 + 8192 + 2048>(vb), l3 = tr_read<D0 * 512 + 12288>(vb), h3 = tr_read<D0 * 512 + 12288 + 2048>(vb);
    asm volatile("s_waitcnt lgkmcnt(0)" ::: "memory"); SBAR();
    od = __builtin_amdgcn_mfma_f32_32x32x16_bf16(pa0, PKF(l0, h0), od, 0, 0, 0);
    od = __builtin_amdgcn_mfma_f32_32x32x16_bf16(pa1, PKF(l1, h1), od, 0, 0, 0);
    od = __builtin_amdgcn_mfma_f32_32x32x16_bf16(pa2, PKF(l2, h2), od, 0, 0, 0);
    od = __builtin_amdgcn_mfma_f32_32x32x16_bf16(pa3, PKF(l3, h3), od, 0, 0, 0);
}
__device__ __forceinline__ void at_pv(f32x16* o, unsigned vb, bf16x8 pa0, bf16x8 pa1, bf16x8 pa2, bf16x8 pa3) {
    at_pv_one<0>(o[0], vb, pa0, pa1, pa2, pa3); at_pv_one<1>(o[1], vb, pa0, pa1, pa2, pa3); at_pv_one<2>(o[2], vb, pa0, pa1, pa2, pa3); at_pv_one<3>(o[3], vb, pa0, pa1, pa2, pa3);
}
__device__ __forceinline__ void attn_unit(Frame& F, const bf16* Qrow0  , const bf16* KVh  , const bf16* KPEs  ,
                                          bf16* Orow0, int nkeys, const float* ROPE, int tpos0  ) {
    LAS unsigned char* lds = F.lds;
    const int tid = F.tid, wid = F.wave, lane = F.lane, r32 = lane & 31, hi = lane >> 5;
    LAS float* wsf = (LAS float*)(lds + AT_WS) + wid * 64; LAS float* li_l = wsf; LAS float* al_l = wsf + 32;
    float m_reg = -1e30f, l_reg = 0; f32x16 o[4] = {}; bf16x8 qr[12];
    { const bf16* Qw = Qrow0 + (size_t)(wid * 32 + r32) * 1536 + hi * 8;
#pragma unroll
      for (int d0 = 0; d0 < 12; ++d0) qr[d0] = *(const bf16x8*)(Qw + d0 * 16);
      if (tpos0 >= 0) {
          const int t = tpos0 + wid * 32 + r32;
#pragma unroll
          for (int half = 0; half < 2; ++half) {
              const float* cp = ROPE + (size_t)t * 32 + 16 * half + 8 * hi; const float* sp = cp + 65536;
              const v4u xa = __builtin_bit_cast(v4u, qr[8 + half]), xb = __builtin_bit_cast(v4u, qr[10 + half]);
              float x1[8], x2[8];
              x1[0] = bflo(xa.x); x1[1] = bfhi(xa.x); x1[2] = bflo(xa.y); x1[3] = bfhi(xa.y); x1[4] = bflo(xa.z); x1[5] = bfhi(xa.z); x1[6] = bflo(xa.w); x1[7] = bfhi(xa.w);
              x2[0] = bflo(xb.x); x2[1] = bfhi(xb.x); x2[2] = bflo(xb.y); x2[3] = bfhi(xb.y); x2[4] = bflo(xb.z); x2[5] = bfhi(xb.z); x2[6] = bflo(xb.w); x2[7] = bfhi(xb.w);
              float y1[8], y2[8];
#pragma unroll
              for (int j = 0; j < 8; ++j) { const float c = cp[j], s = sp[j]; y1[j] = x1[j] * c - x2[j] * s; y2[j] = x1[j] * s + x2[j] * c; }
              const v4u wa = {pk2(y1[0], y1[1]), pk2(y1[2], y1[3]), pk2(y1[4], y1[5]), pk2(y1[6], y1[7])}, wb = {pk2(y2[0], y2[1]), pk2(y2[2], y2[3]), pk2(y2[4], y2[5]), pk2(y2[6], y2[7])};
              if (half == 0) { qr[8] = __builtin_bit_cast(bf16x8, wa); qr[10] = __builtin_bit_cast(bf16x8, wb); } else { qr[9] = __builtin_bit_cast(bf16x8, wa); qr[11] = __builtin_bit_cast(bf16x8, wb); }
          }
      } }
    const unsigned vb0 = (unsigned)(uintptr_t)(lds + AT_V) + v_rd_base(lane);
#define AT_OPQ() int l_ = lane; asm volatile("" : "+v"(l_))
#define AT_KADDR() int kbs[4], pbs[4]; { AT_OPQ(); _Pragma("unroll") for (int b = 0; b < 4; ++b) { const int x = (32 * b + 16 * (l_ >> 5)) ^ ((l_ & 7) << 4); kbs[b] = (l_ & 31) * 256 + x; pbs[b] = (l_ & 31) * 128 + x; } }
#define AT_GLDS(gp, ldsoff) __builtin_amdgcn_global_load_lds((const unsigned*)(gp), (LAS unsigned*)(lds + (ldsoff)), 16, 0, 0)
#define AT_DMA_K(t, b) do { AT_OPQ(); const char* kb_ = (const char*)KVh + (size_t)(t) * (64 * 4096); const char* pb_ = (const char*)KPEs + (size_t)(t) * (64 * 128); \
    const int row0_ = 4 * wid + (l_ >> 4), cB0_ = ((l_ & 15) * 16) ^ ((row0_ & 7) << 4), row1_ = row0_ + 32, rowp_ = 8 * wid + (l_ >> 3), cBp_ = ((l_ & 7) * 16) ^ ((rowp_ & 7) << 4); \
    AT_GLDS(kb_ + (unsigned)(row0_ * 4096 + cB0_), AT_KN + (b) * AT_KNB + wid * 1024); AT_GLDS(kb_ + (unsigned)(row1_ * 4096 + cB0_), AT_KN + (b) * AT_KNB + (wid + 8) * 1024); \
    AT_GLDS(pb_ + (unsigned)(rowp_ * 128 + cBp_), AT_KP + (b) * AT_KPB + wid * 1024); } while (0)
#define AT_DMA_V(t, b) do { AT_OPQ(); const char* vb_ = (const char*)KVh + (size_t)(t) * (64 * 4096); \
    const int st_ = 2 * wid + (l_ >> 5), kk_ = (st_ >> 2) * 8 + ((l_ & 31) >> 2), key_ = (kk_ & ~0xC) | ((kk_ & 4) << 1) | ((kk_ & 8) >> 1), col_ = (st_ & 3) * 32 + (l_ & 3) * 8; \
    AT_GLDS(vb_ + (unsigned)(key_ * 4096 + (128 + col_) * 2), AT_V + (b) * AT_VB + wid * 1024); AT_GLDS(vb_ + (unsigned)((key_ + 32) * 4096 + (128 + col_) * 2), AT_V + (b) * AT_VB + (wid + 8) * 1024); } while (0)
#define AT_RESC(a) do { if (__any((a) < 1.f)) { if (hi == 0) al_l[r32] = (a); asm volatile("s_waitcnt lgkmcnt(0)" ::: "memory"); \
    _Pragma("unroll") for (int d = 0; d < 4; ++d) _Pragma("unroll") for (int r = 0; r < 16; ++r) o[d][r] *= al_l[crow(r, hi)]; } } while (0)
#define AT_WAITBAR(N) do { asm volatile("s_waitcnt vmcnt(" #N ") lgkmcnt(0)" ::: "memory"); __builtin_amdgcn_s_barrier(); asm volatile("" ::: "memory"); } while (0)
    f32x16 pA0, pA1, pB0, pB1; float mnA, mnB, alA, alB; bf16x8 pa0, pa1, pa2, pa3; const int NT = nkeys / 64;
    AT_DMA_K(0, 0); AT_DMA_K(1, 1); AT_DMA_V(0, 0); AT_WAITBAR(0);
    int s = 0;
#define AT_S1 (s == 2 ? 0 : s + 1)
#define AT_S2 (s == 0 ? 2 : s - 1)
#define AT_STEP(CUR0, CUR1, MNC, ALC, PRV0, PRV1, ALP, t, MODE) do { \
        if (MODE == 2) { AT_DMA_K((t) + 2, AT_S2); } if (MODE >= 1) { AT_DMA_V((t) + 1, AT_S1); } \
        SBAR(); { AT_KADDR(); at_qkt(CUR0, CUR1, lds + AT_KN + s * AT_KNB, lds + AT_KP + s * AT_KPB, qr, kbs, pbs); } \
        at_finishSM(PRV0, PRV1, ALP, l_reg, pa0, pa1, pa2, pa3); SBAR(); \
        at_pv(o, vb0 + AT_S2 * AT_VB, pa0, pa1, pa2, pa3); at_partialSM(CUR0, CUR1, m_reg, MNC, ALC); \
        AT_RESC(ALC); if (MODE == 2) AT_WAITBAR(5); else if (MODE == 1) AT_WAITBAR(2); else AT_WAITBAR(0); s = AT_S1; } while (0)
    AT_DMA_K(2, 2); AT_DMA_V(1, 1);
    { AT_KADDR(); at_qkt(pA0, pA1, lds + AT_KN, lds + AT_KP, qr, kbs, pbs); } at_partialSM(pA0, pA1, m_reg, mnA, alA);
    AT_WAITBAR(5); s = 1;
    int t = 1;
    for (; t + 4 < NT; t += 2) {
        AT_STEP(pB0, pB1, mnB, alB, pA0, pA1, alA, t, 2);
        AT_STEP(pA0, pA1, mnA, alA, pB0, pB1, alB, t + 1, 2);
    }
    AT_STEP(pB0, pB1, mnB, alB, pA0, pA1, alA, NT - 3, 2);
    AT_STEP(pA0, pA1, mnA, alA, pB0, pB1, alB, NT - 2, 1);
    AT_STEP(pB0, pB1, mnB, alB, pA0, pA1, alA, NT - 1, 0);
    at_finishSM(pB0, pB1, alB, l_reg, pa0, pa1, pa2, pa3); SBAR();
    at_pv(o, vb0 + AT_S2 * AT_VB, pa0, pa1, pa2, pa3);
    if (hi == 0) li_l[r32] = l_reg; asm volatile("s_waitcnt lgkmcnt(0)" ::: "memory");
    float rli[16];
#pragma unroll
    for (int r = 0; r < 16; ++r) rli[r] = __builtin_amdgcn_rcpf(li_l[crow(r, hi)]);
    bf16* Ow = Orow0 + (size_t)(wid * 32) * D;
#pragma unroll
    for (int r = 0; r < 16; r += 2) { const int orow = crow(r, hi);
#pragma unroll
        for (int d0 = 0; d0 < 4; ++d0) { const unsigned w = pk2(o[d0][r] * rli[r], o[d0][r + 1] * rli[r + 1]);
            Ow[(size_t)orow * D + d0 * 32 + r32] = (bf16)w; Ow[(size_t)(orow + 1) * D + d0 * 32 + r32] = (bf16)(w >> 16); } }
#undef AT_GLDS
#undef AT_OPQ
#undef AT_KADDR
#undef AT_DMA_K
#undef AT_DMA_V
#undef AT_RESC
#undef AT_WAITBAR
#undef AT_S1
#undef AT_S2
#undef AT_STEP
}
__device__ __forceinline__ void attn_phase(Frame& F, const Params& P, int li) {
    unsigned char* ws = PWS;
    const bf16* Q = (const bf16*)(ws + WS_Q); const bf16* KV = (const bf16*)(ws + WS_KV); const bf16* KPE = (const bf16*)(ws + WS_KPE);
    bf16* OB = (bf16*)(ws + WS_HB); const float* ROPE = (const float*)(ws + WS_ROPE);
    for (int u = F.vcu; u < 256 + 128; u += F.G) {
        for (int k = 0; k < 2; ++k) {
            int qrow0, kvrow0, nkeys, h, tpos0;
            if (u < 256) { const int id = 2 * u + k, lb = id >> 6, qb = id & 7; h = (id >> 3) & 7; qrow0 = M_CTX + lb * L_LAT + qb * 256; kvrow0 = M_CTX + lb * LKV; nkeys = LKV; tpos0 = qb * 256; }
            else { if (k == 1) break; const int id = u - 256, b = id >> 3; h = id & 7; qrow0 = b * L_CTX; kvrow0 = b * L_CTX; nkeys = L_CTX; tpos0 = -1; }
            __syncthreads();
            attn_unit(F, Q + (size_t)qrow0 * 1536 + h * 192, KV + (size_t)kvrow0 * 2048 + h * 256, KPE + (size_t)kvrow0 * 64, OB + (size_t)qrow0 * D + h * 128, nkeys, ROPE, tpos0);
        }
    }
}

constexpr int N_PHASES = 2 + 2 * 16;
__global__ void __launch_bounds__(NWAVES * 64, 2) hyb_fwd(Params P) {
    extern __shared__ __attribute__((aligned(16))) unsigned char lds_raw[];
    Frame F;
    F.lds = (LAS unsigned char*)lds_raw;
    F.tid = threadIdx.x; F.lane = F.tid & 63; F.wave = __builtin_amdgcn_readfirstlane(F.tid >> 6);
    F.G = gridDim.x; { const int bx = blockIdx.x; F.vcu = (F.G % 8 == 0) ? (bx % 8) * (F.G / 8) + bx / 8 : bx; }
    volatile LAS unsigned* MISC = (volatile LAS unsigned*)(F.lds + LDS_MISC);
    if (F.tid < 64) MISC[F.tid] = 0u;
    __syncthreads();
    const int use_bar = P.use_bar, ph_hi = P.ph_hi;
    XcdBarrier bar; bar.bar = (unsigned*)(PWS + WS_CTL) + 4096; bar.x = 0; bar.st = nullptr;
    if (use_bar) bar = xcd_barrier_post((unsigned*)(PWS + WS_CTL) + 4096, MISC + 8);

    for (int ph = P.ph_lo; ph < ph_hi; ++ph) {
#define REFRESH_ID() do { int t_ = threadIdx.x; asm volatile("" : "+v"(t_)); F.tid = t_; F.lane = t_ & 63; F.wave = __builtin_amdgcn_readfirstlane(t_ >> 6); \
          int g_ = gridDim.x, b_ = blockIdx.x; asm volatile("" : "+s"(g_), "+s"(b_)); F.G = g_; F.vcu = (g_ % 8 == 0) ? (b_ % 8) * (g_ / 8) + b_ / 8 : b_; F.bid = b_; } while (0)
        REFRESH_ID();
        unsigned char* ws = PWS;
        bf16* XBF = (bf16*)(POUT + OUT_Y);
        bf16* HB = (bf16*)(ws + WS_HB); bf16* YB = (bf16*)(ws + WS_Y); const bf16* SL = (const bf16*)(ws + WS_SLAB);
        const float* MOD = (const float*)(ws + WS_MOD);
        if (ph == 0) { p0_prologue(F, P); }
        else if (ph == 1) {
            const float* m0 = MOD;
            row_pass(F, PIN(I_XP), PIN(I_XS), true, nullptr, nullptr, nullptr, nullptr, nullptr, PIN(I_NMIXPRE), m0 + 1024, m0, HB, false, true);
        } else {
            const int q = ph - 2, pair = q / 16, r = q % 16; const bool odd = r >= 8; const int l = 2 * pair + (odd ? 1 : 0), k = odd ? r - 8 : r;
            const float* ml = MOD + (size_t)l * 9 * 6144;
            const int kind = k < 3 ? (odd ? 10 + k : (k == 2 ? 8 : k)) : (k == 3 ? 2 : k == 4 ? 3 : k == 5 ? 4 : k == 6 ? 5 : 6);
            if (kind == 0) {
                pg8::Gemm g{HB, (const bf16*)(ws + WS_WINE) + (size_t)pair * EVEN_NP * 1024, M, EVEN_NP, 1024}; pg8::EvenInOrder S; S.init(F.G, F.bid);
                pg8::EpiProj E{(bf16*)(ws + WS_BIG), EVEN_NP};
                pg8::gemm_phase<pg8::EpiProj, pg8::EvenInOrder, true, true>(F.lds, g, S, E, F.tid, PWS + WS_CTL + 512 * 1024);
            } else if (kind == 1) {
                scan_phase(F, P, pair);
            } else if (kind == 8) {
                scan_combine(F, P, pair);
            } else if (kind == 2) {
                const bf16* W = odd ? (const bf16*)(ws + WS_WOUTO) + (size_t)pair * 1024 * 1024 : (const bf16*)(ws + WS_WOUTE) + (size_t)pair * 1024 * 1024;
                pg8::Gemm g{HB, W, M, 1024, 1024}; pg8::TailSplitOrder S; S.init(F.bid, 1024, 0);
                pg8::EpiYsplit E{YB, (bf16*)(ws + WS_SLAB)};
                pg8::gemm_phase<pg8::EpiYsplit, pg8::TailSplitOrder, true, true>(F.lds, g, S, E, F.tid, PWS + WS_CTL + 512 * 1024);
            } else if (kind == 3) {
                row_pass(F, PIN(I_XP), PIN(I_XS), l == 0, XBF, YB, SL, PIN(I_NMIXPOST) + l * 1024, ml + 2048, PIN(I_NMLPPRE) + l * 1024, ml + 4096, ml + 3072, HB, true, true);
            } else if (kind == 4) {
                pg8::Gemm g{HB, (const bf16*)(ws + WS_W1) + (size_t)l * 4096 * 1024, M, FF, 1024}; pg8::StaticOrder S; S.init(M, FF, F.G, F.bid, 1024);
                pg8::EpiBf16<1> E{(bf16*)(ws + WS_BIG), FF};
                pg8::gemm_phase<pg8::EpiBf16<1>, pg8::StaticOrder, true, true>(F.lds, g, S, E, F.tid, PWS + WS_CTL + 512 * 1024);
            } else if (kind == 5) {
                pg8::Gemm g{(const bf16*)(ws + WS_BIG), (const bf16*)(ws + WS_W2) + (size_t)l * 1024 * 4096, M, 1024, FF}; pg8::TailSplitOrder S; S.init(F.bid, FF, 0);
                pg8::EpiYsplit E{YB, (bf16*)(ws + WS_SLAB)};
                pg8::gemm_phase<pg8::EpiYsplit, pg8::TailSplitOrder, true, true>(F.lds, g, S, E, F.tid, PWS + WS_CTL + 512 * 1024);
            } else if (kind == 6) {
                const float* mn = ml + 9 * 6144;
                if (l < 3) row_pass(F, nullptr, nullptr, false, XBF, YB, SL, PIN(I_NMLPPOST) + l * 1024, ml + 5120, PIN(I_NMIXPRE) + (l + 1) * 1024, mn + 1024, mn, HB, true, true);
                else { bar.bar = (unsigned*)(PWS + WS_CTL) + 4096; row_pass_final(F, bar, XBF, POUT + OUT_Y, YB, SL, PIN(I_NMLPPOST) + l * 1024, ml + 5120); }
            } else if (kind == 10) {
                pg8::Gemm g{HB, (const bf16*)(ws + WS_WINO) + (size_t)pair * ODD_NP * 1024, M, ODD_NP, 1024}; pg8::StaticOrder S; S.init(M, ODD_NP, F.G, F.bid, 1024);
                pg8::EpiOddIn E{(bf16*)(ws + WS_QN), (bf16*)(ws + WS_ACKV), (float*)(ws + WS_Y), POUT + OUT_CKV, POUT + OUT_KPE,
                                PIN(I_QAN) + pair * 256, PIN(I_KVAN) + pair * 256, pair};
                pg8::gemm_phase<pg8::EpiOddIn, pg8::StaticOrder, false, true>(F.lds, g, S, E, F.tid, PWS + WS_CTL + 512 * 1024);
                REFRESH_ID(); cache_pass(F, P, pair);
            } else if (kind == 11) {
                kpe_pass(F, P, pair); REFRESH_ID();
                { pg8::Gemm g{(const bf16*)(ws + WS_QN), (const bf16*)(ws + WS_WQB) + (size_t)pair * 1536 * 256, M, 1536, 256}; pg8::StaticOrder S; S.init(M, 1536, F.G, F.bid, 256);
                  pg8::EpiBf16<0> E{(bf16*)(ws + WS_Q), 1536};
                  pg8::gemm_phase<pg8::EpiBf16<0>, pg8::StaticOrder, true, true>(F.lds, g, S, E, F.tid, PWS + WS_CTL + 512 * 1024); }
                REFRESH_ID();
                { pg8::Gemm g{(const bf16*)(ws + WS_ACKV), (const bf16*)(ws + WS_WKVB) + (size_t)pair * 2048 * 256, MKV, 2048, 256}; pg8::StaticOrder S; S.init(MKV, 2048, F.G, F.bid, 256);
                  pg8::EpiBf16<0> E{(bf16*)(ws + WS_KV), 2048};
                  pg8::gemm_phase<pg8::EpiBf16<0>, pg8::StaticOrder, true, true>(F.lds, g, S, E, F.tid, PWS + WS_CTL + 512 * 1024); }
            } else if (kind == 12) {
                attn_phase(F, P, pair);
            }
        }
        if (ph + 1 < ph_hi) { if (use_bar) { bar.bar = (unsigned*)(PWS + WS_CTL) + 4096; xcd_barrier(bar); } else { VM_WAIT(); __syncthreads(); } }
    }
}

extern "C" void kernel_launch(void* const* d_in, const int* in_sizes, int n_in, void* d_out, int out_size, void* d_ws, size_t ws_size, hipStream_t stream) {
    static int grid = 0;
    if (grid == 0) {
        if (n_in != 28 || out_size != 27787264 || ws_size < WS_END) { fprintf(stderr, "kernel_launch: unexpected shapes: n_in %d out %d ws %zu (need >= %zu)\n", n_in, out_size, ws_size, (size_t)WS_END); grid = -1; return; }
        int dev = 0, cus = 0, per_cu = 0;
        if (hipGetDevice(&dev) != hipSuccess || hipDeviceGetAttribute(&cus, hipDeviceAttributeMultiprocessorCount, dev) != hipSuccess) { grid = -1; return; }
        if (hipFuncSetAttribute((const void*)hyb_fwd, hipFuncAttributeMaxDynamicSharedMemorySize, LDS_BYTES) != hipSuccess) { fprintf(stderr, "kernel_launch: hipFuncSetAttribute failed\n"); grid = -1; return; }
        if (hipOccupancyMaxActiveBlocksPerMultiprocessor(&per_cu, (const void*)hyb_fwd, NWAVES * 64, LDS_BYTES) != hipSuccess || per_cu < 1) { fprintf(stderr, "kernel_launch: occupancy query reports %d\n", per_cu); }
        (void)hipGetLastError();
        grid = cus;
    }
    if (grid < 0) return;
    (void)hipMemsetAsync((char*)d_ws + WS_CTL, 0, CTL_ZERO_BYTES, stream);
    Params a{};
    for (int i = 0; i < 28; ++i) a.in[i] = (const float*)d_in[i];
    a.out = (float*)d_out; a.ws = (unsigned char*)d_ws;
    a.ph_lo = 0; a.ph_hi = N_PHASES; a.use_bar = 1; a.pad = 0;
    hipLaunchKernelGGL(hyb_fwd, dim3(grid), dim3(NWAVES * 64), LDS_BYTES, stream, a);
    const hipError_t le = hipPeekAtLastError();
    if (le != hipSuccess) fprintf(stderr, "kernel_launch: launch failed: %s\n", hipGetErrorName(le));
}
```

```cpp
#include <hip/hip_runtime.h>
#include <hip/hip_bf16.h>
#include <cstdio>
#include <cstdint>
namespace pg8 {
#define PG8_LAS __attribute__((address_space(3)))
typedef unsigned short bf16_t;
typedef short bf16x8 __attribute__((ext_vector_type(8)));
typedef float f32x4 __attribute__((ext_vector_type(4)));
typedef unsigned u32x4 __attribute__((ext_vector_type(4)));
constexpr int BM = 256, BK = 64, HALF = 128, HTB = HALF * BK * 2  , STAGE_BYTES = 8 * HTB, NXCD = 8, WGM = 8;

__host__ __device__ __forceinline__ int lds_byte(int r, int c) { const int st = (r >> 4) * 2 + (c >> 5), rr = r & 15, cc = c & 31, ob = rr * 64 + cc * 2; return st * 1024 + (ob ^ (((ob >> 9) & 1) << 5)); }
__host__ __device__ __forceinline__ void stage_rc(int b, int& R, int& C) { const int st = b / 1024, sb = b % 1024, swz = sb ^ (((sb >> 9) & 1) << 5); R = (st >> 1) * 16 + swz / 64; C = (st & 1) * 32 + (swz % 64) / 2; }
__host__ __device__ __forceinline__ int perm32(int rho) { const int n = rho >> 4, i = rho & 15; return 8 * (i >> 2) + 4 * n + (i & 3); }

struct Unit { int pm, pn, ks, kt0, nt; };
struct Gemm { const bf16_t* A; const bf16_t* Bt; int M, N, K; };

struct StaticOrder {
    int nM, nN, nwg, G, c, ntk;
    __host__ __device__ void init(int M, int N, int G_, int c_, int K) { nM = M / BM; nN = N / BM; nwg = nM * nN; G = G_; c = c_; ntk = K / BK; }
    __host__ __device__ bool next(int i, Unit& u) const { return map((long)i * G + c, u); }
    __host__ __device__ bool map(long L, Unit& u) const {
        if (L >= nwg) return false;
        int wgid = (int)L; { const int q = nwg / NXCD, r = nwg % NXCD, xcd = wgid % NXCD, off = wgid / NXCD; wgid = (xcd < r ? xcd * (q + 1) : r * (q + 1) + (xcd - r) * q) + off; }
        const int nig = WGM * nN, gid = wgid / nig, fm = gid * WGM, gsz = (nM - fm) < WGM ? (nM - fm) : WGM;
        u.pm = fm + ((wgid % nig) % gsz); u.pn = (wgid % nig) / gsz; u.ks = -1; u.kt0 = 0; u.nt = ntk; return true;
    }
    __device__ __forceinline__ void a_ready(const Unit&) const {}
    __device__ __forceinline__ void done(const Unit&) const {}
};


struct TailSplitOrder {
    int c, ntk, mode;
    __device__ void init(int c_, int K, int mode_) { c = c_; ntk = K / BK; mode = mode_; }
    __device__ __forceinline__ bool next(int i, Unit& u) const {
        const int xcd = c & 7, j = c >> 3;
        const int round = i + (mode == 2 ? 1 : 0); const bool tail = round != 0;
        u.pm = tail ? 64 + xcd * 2 + (j & 1) : xcd * 8 + (j & 7);
        u.pn = tail ? (j >> 1) & 3 : j >> 3;
        u.ks = tail ? j >> 3 : -1;
        u.nt = tail ? ntk >> 2 : ntk;
        u.kt0 = tail ? (j >> 3) * (ntk >> 2) : 0;
        return round == 0 ? mode != 2 : (round == 1 && mode != 1);
    }
    __device__ __forceinline__ void a_ready(const Unit&) const {}
    __device__ __forceinline__ void done(const Unit&) const {}
};

struct EvenInOrder {
    StaticOrder S12; int G, c;
    __device__ void init(int G_, int c_) { S12.init(20480, 3072, G_, c_, 1024); G = G_; c = c_; }
    __device__ __forceinline__ bool next(int i, Unit& u) const {
        const int L = i * G + c;
        Unit a; a.pm = 0; a.pn = 0; a.ks = -1; a.kt0 = 0; a.nt = 16; (void)S12.map(L < 960 ? L : 0, a);
        const int q = L - 1024;
        const bool full = L < 960, gkw = L >= 960 && L < 1024;
        u.pm = full ? a.pm : (gkw ? L - 960 : 64 + (q >> 2));
        u.pn = full ? a.pn : 12;
        u.ks = (full || gkw) ? -1 : (q & 3);
        u.nt = (full || gkw) ? 16 : 4;
        u.kt0 = (full || gkw) ? 0 : 4 * (q & 3);
        return L < 1088;
    }
    __device__ __forceinline__ void a_ready(const Unit&) const {}
    __device__ __forceinline__ void done(const Unit&) const {}
};

typedef float f32x2c_t __attribute__((ext_vector_type(2))); typedef __bf16 bf16x2c_t __attribute__((ext_vector_type(2)));
__device__ __forceinline__ unsigned cvt_pk_bf16(float lo, float hi) { f32x2c_t v = {lo, hi}; bf16x2c_t b = __builtin_convertvector(v, bf16x2c_t); return __builtin_bit_cast(unsigned, b); }

template <int ACT> struct EpiBf16 {
    static constexpr bool PERM = true, AFTER_DRAIN = false;
    bf16_t* O; int ldc;
    __device__ __forceinline__ void operator()(const f32x4 (&acc)[2][2][4][2], const Unit& u, int wr, int wc, int fr, int fq) const {
        const int row0 = u.pm * BM + wr * 64 + fr; const int col0 = u.pn * BM + wc * 32 + 8 * fq;
#pragma unroll
        for (int ai = 0; ai < 2; ++ai)
#pragma unroll
            for (int m = 0; m < 4; ++m) { bf16_t* rowp = O + (size_t)(row0 + ai * HALF + m * 16) * ldc + col0;
#pragma unroll
                for (int bj = 0; bj < 2; ++bj) { f32x4 v0 = acc[ai][bj][m][0], v1 = acc[ai][bj][m][1];
                    if (ACT == 1) {
#pragma unroll
                        for (int j = 0; j < 4; ++j) { const float a = fmaxf(v0[j], 0.f), b = fmaxf(v1[j], 0.f); v0[j] = a * a; v1[j] = b * b; } }
                    u32x4 w; w.x = cvt_pk_bf16(v0[0], v0[1]); w.y = cvt_pk_bf16(v0[2], v0[3]); w.z = cvt_pk_bf16(v1[0], v1[1]); w.w = cvt_pk_bf16(v1[2], v1[3]);
                    *(u32x4*)(rowp + bj * HALF) = w; } }
    }
};
struct EpiProj {
    static constexpr bool PERM = true, AFTER_DRAIN = false;
    bf16_t* O; int ldc;
    __device__ __forceinline__ void operator()(const f32x4 (&acc)[2][2][4][2], const Unit& u, int wr, int wc, int fr, int fq) const {
        const int row0 = u.pm * BM + wr * 64 + fr;
        if (u.ks < 0) {
            const int col0 = u.pn * BM + wc * 32 + 8 * fq;
#pragma unroll
            for (int ai = 0; ai < 2; ++ai)
#pragma unroll
                for (int m = 0; m < 4; ++m) { bf16_t* rowp = O + (size_t)(row0 + ai * HALF + m * 16) * ldc + col0;
#pragma unroll
                    for (int bj = 0; bj < 2; ++bj) { const f32x4 v0 = acc[ai][bj][m][0], v1 = acc[ai][bj][m][1];
                        u32x4 w; w.x = cvt_pk_bf16(v0[0], v0[1]); w.y = cvt_pk_bf16(v0[2], v0[3]); w.z = cvt_pk_bf16(v1[0], v1[1]); w.w = cvt_pk_bf16(v1[2], v1[3]);
                        *(u32x4*)(rowp + bj * HALF) = w; } }
        } else if (wc == 0) {
            const int col0 = 3072 + 32 * u.ks + 8 * fq;
#pragma unroll
            for (int ai = 0; ai < 2; ++ai)
#pragma unroll
                for (int m = 0; m < 4; ++m) { const f32x4 v0 = acc[ai][0][m][0], v1 = acc[ai][0][m][1];
                    u32x4 w; w.x = cvt_pk_bf16(v0[0], v0[1]); w.y = cvt_pk_bf16(v0[2], v0[3]); w.z = cvt_pk_bf16(v1[0], v1[1]); w.w = cvt_pk_bf16(v1[2], v1[3]);
                    *(u32x4*)(O + (size_t)(row0 + ai * HALF + m * 16) * ldc + col0) = w; }
        }
    }
};
struct EpiYsplit {
    static constexpr bool PERM = true, AFTER_DRAIN = false;
    bf16_t* Y; bf16_t* SL;
    __device__ __forceinline__ void operator()(const f32x4 (&acc)[2][2][4][2], const Unit& u, int wr, int wc, int fr, int fq) const {
        const int row0 = u.pm * BM + wr * 64 + fr; const int col0 = u.pn * BM + wc * 32 + 8 * fq;
        if (u.ks < 0) {
#pragma unroll
            for (int ai = 0; ai < 2; ++ai)
#pragma unroll
                for (int m = 0; m < 4; ++m) { bf16_t* rowp = Y + (size_t)(row0 + ai * HALF + m * 16) * 1024 + col0;
#pragma unroll
                    for (int bj = 0; bj < 2; ++bj) { const f32x4 v0 = acc[ai][bj][m][0], v1 = acc[ai][bj][m][1];
                        u32x4 w; w.x = cvt_pk_bf16(v0[0], v0[1]); w.y = cvt_pk_bf16(v0[2], v0[3]); w.z = cvt_pk_bf16(v1[0], v1[1]); w.w = cvt_pk_bf16(v1[2], v1[3]);
                        *(u32x4*)(rowp + bj * HALF) = w; } }
        } else {
            bf16_t* base = SL + (size_t)u.ks * (4096 * 1024);
#pragma unroll
            for (int ai = 0; ai < 2; ++ai)
#pragma unroll
                for (int m = 0; m < 4; ++m) { bf16_t* rowp = base + (size_t)(row0 - 16384 + ai * HALF + m * 16) * 1024 + col0;
#pragma unroll
                    for (int bj = 0; bj < 2; ++bj) { const f32x4 v0 = acc[ai][bj][m][0], v1 = acc[ai][bj][m][1];
                        u32x4 w; w.x = cvt_pk_bf16(v0[0], v0[1]); w.y = cvt_pk_bf16(v0[2], v0[3]); w.z = cvt_pk_bf16(v1[0], v1[1]); w.w = cvt_pk_bf16(v1[2], v1[3]);
                        *(u32x4*)(rowp + bj * HALF) = w; } }
        }
    }
};
struct EpiOddIn {
    static constexpr bool PERM = false, AFTER_DRAIN = true;
    bf16_t* QN; bf16_t* ACKV; float* KPERAW; float* out_ckv; float* out_kpe; const float* gq; const float* gkv; int li;
    __device__ __forceinline__ void fused(f32x4 (&acc)[2][2][4][2], const Unit& u, int wr, int wc, int fr, int fq, PG8_LAS unsigned char* lds, int wid, int lane) const {
        PG8_LAS float* P = (PG8_LAS float*)lds;
        if (u.pn < 2) {
#pragma unroll
            for (int ai = 0; ai < 2; ++ai)
#pragma unroll
                for (int m = 0; m < 4; ++m) { float s = 0.f;
#pragma unroll
                    for (int bj = 0; bj < 2; ++bj)
#pragma unroll
                        for (int n = 0; n < 2; ++n) { const f32x4 x = acc[ai][bj][m][n]; s += (x[0] * x[0] + x[1] * x[1]) + (x[2] * x[2] + x[3] * x[3]); }
                    s += __shfl_xor(s, 16); s += __shfl_xor(s, 32);
                    if (fq == 0) P[(ai * HALF + wr * 64 + m * 16 + fr) * 4 + wc] = s; }
        }
        asm volatile("s_waitcnt lgkmcnt(0)" ::: "memory"); __builtin_amdgcn_s_barrier(); asm volatile("" ::: "memory");
        if (u.pn < 2) {
            const float* gv = u.pn == 0 ? gq : gkv;
#pragma unroll
            for (int ai = 0; ai < 2; ++ai)
#pragma unroll
                for (int m = 0; m < 4; ++m) { const int r = ai * HALF + wr * 64 + m * 16 + fr; const int grow = u.pm * BM + r;
                    const float tot = (P[r * 4 + 0] + P[r * 4 + 1]) + (P[r * 4 + 2] + P[r * 4 + 3]);
                    const float rstd = 1.0f / sqrtf(tot * (1.0f / 256.0f) + 1e-6f);
                    const int drow = grow < 4096 ? grow : 4096 + ((grow - 4096) >> 11) * 2304 + 256 + ((grow - 4096) & 2047);
#pragma unroll
                    for (int bj = 0; bj < 2; ++bj)
#pragma unroll
                        for (int n = 0; n < 2; ++n) { const int col = bj * HALF + wc * 32 + n * 16 + 4 * fq; const f32x4 g = *(const f32x4*)(gv + col);
                            const f32x4 v = acc[ai][bj][m][n] * rstd * g;
                            unsigned long long w = (unsigned long long)cvt_pk_bf16(v[0], v[1]) | ((unsigned long long)cvt_pk_bf16(v[2], v[3]) << 32);
                            if (u.pn == 0) *(unsigned long long*)(QN + (size_t)grow * 256 + col) = w;
                            else { *(unsigned long long*)(ACKV + (size_t)drow * 256 + col) = w;
                                   if (grow < 4096) *(f32x4*)(out_ckv + ((size_t)((grow >> 8) * 2 + li) * 256 + (grow & 255)) * 256 + col) = v; } } }
        } else if (wc < 2) {
#pragma unroll
            for (int ai = 0; ai < 2; ++ai)
#pragma unroll
                for (int m = 0; m < 4; ++m) { const int r = ai * HALF + wr * 64 + m * 16 + fr; const int grow = u.pm * BM + r;
#pragma unroll
                    for (int n = 0; n < 2; ++n) { const int col = wc * 32 + n * 16 + 4 * fq; const f32x4 v = acc[ai][0][m][n];
                        *(f32x4*)(KPERAW + (size_t)grow * 64 + col) = v;
                        if (grow < 4096) *(f32x4*)(out_kpe + ((size_t)((grow >> 8) * 2 + li) * 256 + (grow & 255)) * 64 + col) = v; } }
        }
    }
};

#define PG8_NCONST const
#ifndef PG8_PROBE_MODE
#define PG8_PROBE_MODE 0
#endif
#define PG8_PM true
#define PG8_PL true
#define PG8_PG true
template <class Epi, class Sched, bool ALIGN_EPI = false, bool SP2 = false>
__device__ __forceinline__ void gemm_phase(PG8_LAS unsigned char* lds, const Gemm g, const Sched& S, const Epi& E, const int tid, const void* scratch) {
    static_assert(SP2, "only the two-super-phase K-loop is kept");
    const int  wid = __builtin_amdgcn_readfirstlane(tid >> 6), lane = tid & 63, wr = wid >> 2, wc = wid & 3, fr = lane & 15, fq = lane >> 4;
    const int K = g.K;
    unsigned voffA[2], voffB[2];
#pragma unroll
    for (int i = 0; i < 2; ++i) { int R, C; stage_rc(tid * 16 + i * 8192, R, C); const int Rb = Epi::PERM ? ((R & ~31) + perm32(R & 31)) : R;
        voffA[i] = (unsigned)(R * K + C) * 2u; voffB[i] = (unsigned)(Rb * K + C) * 2u; }
    const size_t kstep = (size_t)(BK * 2);
    const size_t hstep = (size_t)HALF * K * 2;
    const size_t tstep = 2 * hstep;
    const unsigned ldsw = (unsigned)wid * 1024u;
    const unsigned ldsa = (unsigned)(size_t)lds + ldsw;
    const int aoff = lds_byte(wr * 64 + fr, fq * 8), boff = lds_byte(wc * 32 + fr, fq * 8);
#define PG8_SA(b, h) (((b) * 2 + (h)) * HTB)
#define PG8_SB(b, h) ((4 + (b) * 2 + (h)) * HTB)
#define PG8_STAGE(bufoff, gbase, voff) do { if (PG8_PG) _Pragma("unroll") for (int _i = 0; _i < 2; ++_i) { unsigned sv_; \
        asm volatile("s_mov_b32 %0, m0\n\ts_mov_b32 m0, %3\n\ts_nop 0\n\tglobal_load_lds_dwordx4 %1, %2\n\ts_mov_b32 m0, %0" \
                     : "=&s"(sv_) : "v"((voff)[_i]), "s"((const char*)(gbase)), "s"(ldsa + (unsigned)((bufoff) + _i * 8192)) : "memory"); } } while (0)
#define PG8_LDA(dst, b, h) do { if (PG8_PL) _Pragma("unroll") for (int m = 0; m < 4; ++m) _Pragma("unroll") for (int k = 0; k < 2; ++k) dst[m][k] = *(const PG8_LAS bf16x8*)(lds + PG8_SA(b, h) + aoff + m * 2048 + k * 1024); } while (0)
#define PG8_LDB(dst, b, h) do { if (PG8_PL) _Pragma("unroll") for (int n = 0; n < 2; ++n) _Pragma("unroll") for (int k = 0; k < 2; ++k) dst[n][k] = *(const PG8_LAS bf16x8*)(lds + PG8_SB(b, h) + boff + n * 2048 + k * 1024); } while (0)
#define PG8_MMA(ai, bj, At, Bt) do { __builtin_amdgcn_s_setprio(1); if (PG8_PM) _Pragma("unroll") for (int k = 0; k < 2; ++k) _Pragma("unroll") for (int m = 0; m < 4; ++m) _Pragma("unroll") for (int n = 0; n < 2; ++n) \
        acc[ai][bj][m][n] = __builtin_amdgcn_mfma_f32_16x16x32_bf16(Bt[n][k], At[m][k], acc[ai][bj][m][n], 0, 0, 0); __builtin_amdgcn_s_setprio(0); } while (0)
#define PG8_WAIT_V(n) asm volatile("s_waitcnt vmcnt(" #n ")" ::: "memory")
#define PG8_WAIT_L(n) asm volatile("s_waitcnt lgkmcnt(" #n ")" ::: "memory")
#define PG8_BAR __builtin_amdgcn_s_barrier()
#define PG8_SCHED __builtin_amdgcn_sched_barrier(0)
    Unit cur, nxt; int ui = 0;
    if (!S.next(0, cur)) return;
    f32x4 acc[2][2][4][2];
#pragma unroll
    for (int a = 0; a < 2; ++a)
#pragma unroll
        for (int b = 0; b < 2; ++b)
#pragma unroll
            for (int m = 0; m < 4; ++m)
#pragma unroll
                for (int n = 0; n < 2; ++n) acc[a][b][m][n] = (f32x4){0.f, 0.f, 0.f, 0.f};
    bf16x8 At[4][2], B0[2][2], B1[2][2];
    const char* cA = (const char*)g.A + (size_t)cur.pm * tstep + (size_t)cur.kt0 * kstep; const char* cB = (const char*)g.Bt + (size_t)cur.pn * tstep + (size_t)cur.kt0 * kstep;
    S.a_ready(cur);
    PG8_STAGE(PG8_SB(0, 0), cB, voffB); PG8_STAGE(PG8_SB(0, 1), cB + hstep, voffB); PG8_STAGE(PG8_SA(0, 0), cA, voffA); PG8_STAGE(PG8_SA(0, 1), cA + hstep, voffA);
    if (wr == 1) PG8_BAR;
    PG8_WAIT_V(2); PG8_BAR;
    PG8_STAGE(PG8_SB(1, 0), cB + kstep, voffB); PG8_STAGE(PG8_SA(1, 0), cA + kstep, voffA); PG8_STAGE(PG8_SB(1, 1), cB + hstep + kstep, voffB);
    PG8_WAIT_V(6); PG8_BAR;
    PG8_STAGE(PG8_SA(1, 1), cA + kstep + hstep, voffA);
    { const unsigned doff = ((unsigned)__builtin_amdgcn_workgroup_id_x() * 8u + (unsigned)wid) * 64u;
#pragma unroll
      for (int j = 0; j < 16; ++j) asm volatile("global_store_dword %0, %0, %1" :: "v"(doff), "s"(scratch) : "memory"); }
#define PG8_PAIR(WV) \
              \
            PG8_LDB(B0, 0, 0); PG8_LDB(B1, 0, 1); PG8_SCHED; PG8_LDA(At, 0, 0); \
            PG8_WAIT_V(WV); PG8_WAIT_L(0); PG8_BAR; PG8_MMA(0, 0, At, B0); PG8_MMA(0, 1, At, B1); PG8_BAR; PG8_SCHED; \
              \
            PG8_LDA(At, 0, 1); PG8_STAGE(PG8_SB(0, 0), b2, voffB); PG8_STAGE(PG8_SB(0, 1), b2 + hstep, voffB); PG8_STAGE(PG8_SA(0, 0), a2, voffA); \
            PG8_WAIT_V(WV); PG8_WAIT_L(0); PG8_BAR; PG8_MMA(1, 0, At, B0); PG8_MMA(1, 1, At, B1); PG8_BAR; PG8_SCHED; \
              \
            PG8_LDB(B0, 1, 0); PG8_LDB(B1, 1, 1); PG8_SCHED; PG8_LDA(At, 1, 0); PG8_STAGE(PG8_SA(0, 1), a2 + hstep, voffA); \
            PG8_WAIT_V(WV); PG8_WAIT_L(0); PG8_BAR; PG8_MMA(0, 0, At, B0); PG8_MMA(0, 1, At, B1); PG8_BAR; PG8_SCHED; \
              \
            PG8_LDA(At, 1, 1); PG8_STAGE(PG8_SB(1, 0), b3, voffB); PG8_STAGE(PG8_SB(1, 1), b3 + hstep, voffB); PG8_STAGE(PG8_SA(1, 0), a3, voffA); \
            PG8_WAIT_V(8); PG8_WAIT_L(0); PG8_BAR; PG8_MMA(1, 0, At, B0); PG8_MMA(1, 1, At, B1); PG8_BAR; PG8_SCHED; \
            PG8_STAGE(PG8_SA(1, 1), a3 + hstep, voffA); PG8_SCHED;
    for (;;) {
        const bool has_next = S.next(ui + 1, nxt);
        PG8_NCONST char* nA = has_next ? (const char*)g.A + (size_t)nxt.pm * tstep + (size_t)nxt.kt0 * kstep : cA; PG8_NCONST char* nB = has_next ? (const char*)g.Bt + (size_t)nxt.pn * tstep + (size_t)nxt.kt0 * kstep : cB;
        const int nt = cur.nt;
#if PG8_PROBE_MODE > 0
        {
#define PG8_PM (PG8_PROBE_MODE != 1 && PG8_PROBE_MODE != 5)
#define PG8_PL (PG8_PROBE_MODE != 3 && PG8_PROBE_MODE != 5)
#define PG8_PG (PG8_PROBE_MODE < 2 || PG8_PROBE_MODE == 4)
            if (!PG8_PL) {
#pragma unroll
                for (int m = 0; m < 4; ++m)
#pragma unroll
                    for (int k = 0; k < 2; ++k) asm volatile("" : "=v"(At[m][k]));
#pragma unroll
                for (int n = 0; n < 2; ++n)
#pragma unroll
                    for (int k = 0; k < 2; ++k) { asm volatile("" : "=v"(B0[n][k])); asm volatile("" : "=v"(B1[n][k])); } }
            for (int t = 0; t < nt; t += 2) {
                const bool last = (t == nt - 2);
                const char* a2 = last ? cA : cA + (size_t)(t + 2) * kstep; const char* b2 = last ? cB : cB + (size_t)(t + 2) * kstep;
                const char* a3 = a2 + kstep; const char* b3 = b2 + kstep;
                PG8_PAIR(8)
            }
#pragma unroll
            for (int a = 0; a < 2; ++a)
#pragma unroll
                for (int b = 0; b < 2; ++b)
#pragma unroll
                    for (int m = 0; m < 4; ++m)
#pragma unroll
                        for (int n = 0; n < 2; ++n) asm volatile("" :: "v"(acc[a][b][m][n]));
#undef PG8_PM
#undef PG8_PL
#undef PG8_PG
#define PG8_PM true
#define PG8_PL true
#define PG8_PG true
#pragma unroll
            for (int a = 0; a < 2; ++a)
#pragma unroll
                for (int b = 0; b < 2; ++b)
#pragma unroll
                    for (int m = 0; m < 4; ++m)
#pragma unroll
                        for (int n = 0; n < 2; ++n) acc[a][b][m][n] = (f32x4){0.f, 0.f, 0.f, 0.f};
            { const unsigned doff = ((unsigned)__builtin_amdgcn_workgroup_id_x() * 8u + (unsigned)wid) * 64u;
#pragma unroll
              for (int j = 0; j < 16; ++j) asm volatile("global_store_dword %0, %0, %1" :: "v"(doff), "s"(scratch) : "memory"); }
        }
#endif
        {
            const char* a2 = cA + 2 * kstep; const char* b2 = cB + 2 * kstep; const char* a3 = a2 + kstep; const char* b3 = b2 + kstep;
            PG8_PAIR(24)
        }
        for (int t = 2; t < nt; t += 2) {
            const bool last = (t == nt - 2);
            const char* a2 = last ? nA : cA + (size_t)(t + 2) * kstep; const char* b2 = last ? nB : cB + (size_t)(t + 2) * kstep;
            const char* a3 = a2 + kstep; const char* b3 = b2 + kstep;
            if (last && has_next) S.a_ready(nxt);
            PG8_PAIR(8)
        }
        if constexpr (ALIGN_EPI) { if (wr == 0) PG8_BAR; }
        if constexpr (!Epi::AFTER_DRAIN) { int l_ = (int)__builtin_amdgcn_mbcnt_hi(~0u, __builtin_amdgcn_mbcnt_lo(~0u, 0u)); asm volatile("" : "+v"(l_));
            E(acc, cur, wr, wc, l_ & 15, l_ >> 4); S.done(cur); }
        if (!has_next) break;
#pragma unroll
        for (int a = 0; a < 2; ++a)
#pragma unroll
            for (int b = 0; b < 2; ++b)
#pragma unroll
                for (int m = 0; m < 4; ++m)
#pragma unroll
                    for (int n = 0; n < 2; ++n) acc[a][b][m][n] = (f32x4){0.f, 0.f, 0.f, 0.f};
        cur = nxt; cA = nA; cB = nB; ++ui;
        if constexpr (ALIGN_EPI) { if (wr == 1) PG8_BAR; }
    }
#undef PG8_PAIR
    PG8_WAIT_V(0);
    if constexpr (!ALIGN_EPI) { if (wr == 0) PG8_BAR; }
    PG8_BAR;
    if constexpr (Epi::AFTER_DRAIN) { E.fused(acc, cur, wr, wc, fr, fq, lds, wid, lane); S.done(cur); }
#undef PG8_SA
#undef PG8_SB
#undef PG8_STAGE
#undef PG8_LDA
#undef PG8_LDB
#undef PG8_MMA
#undef PG8_WAIT_V
#undef PG8_WAIT_L
#undef PG8_BAR
#undef PG8_SCHED
}
}

constexpr int NWAVES = 8;
constexpr int D = 1024, FF = 4096, M_CTX = 4096, M_LAT = 16384, M = M_CTX + M_LAT;
constexpr int L_LAT = 2048, L_CTX = 256, PAST = 256, LKV = PAST + L_LAT;
constexpr int MKV = M_CTX + 8 * LKV;
constexpr int EVEN_N = 3104, EVEN_NP = 3328, ODD_N = 576, ODD_NP = 768;
constexpr float EPS = 1e-6f;
constexpr int PC_QA = 0, PC_KA = 256, PC_VA = 512, PC_GA = 1024, PC_QB = 1536, PC_KB = 1792, PC_VB = 2048, PC_GB = 2560, PC_GK = 3072;
constexpr size_t OUT_Y = 0, OUT_CKV = 20971520, OUT_KPE = 23068672, OUT_SGLA = 23592960, OUT_SRET = 25690112;

constexpr size_t MiB = 1u << 20;
constexpr size_t WS_CTL = 0, CTL_ZERO_BYTES = 64 * 1024;
constexpr size_t WS_MOD = 1 * MiB;
constexpr size_t WS_ROPE = 2 * MiB;
constexpr size_t WS_KPE = 3 * MiB;
constexpr size_t WS_ACKV = 6 * MiB;
constexpr size_t WS_WINE = 18 * MiB;
constexpr size_t WS_WOUTE = 31 * MiB;
constexpr size_t WS_WINO = 35 * MiB;
constexpr size_t WS_WQB = 38 * MiB;
constexpr size_t WS_WKVB = 40 * MiB;
constexpr size_t WS_WOUTO = 42 * MiB;
constexpr size_t WS_W1 = 46 * MiB;
constexpr size_t WS_W2 = 78 * MiB;
constexpr size_t WS_HB = 110 * MiB;
constexpr size_t WS_Y = 150 * MiB;
constexpr size_t WS_BIG = 190 * MiB;
constexpr size_t WS_Q = WS_BIG, WS_KV = WS_BIG + 60 * MiB, WS_QN = WS_BIG + 148 * MiB;
constexpr size_t WS_SLAB = 350 * MiB;
constexpr size_t WS_END = 382 * MiB;

constexpr int RING_BYTES = 131072;
constexpr int LDS_MISC = 155648;
constexpr int LDS_BYTES = 163840;

#define GAS __attribute__((address_space(1)))
#define LAS __attribute__((address_space(3)))
typedef unsigned short bf16;
typedef unsigned v4u __attribute__((ext_vector_type(4)));
typedef unsigned v2u __attribute__((ext_vector_type(2)));
typedef float f32x4 __attribute__((ext_vector_type(4)));
typedef float f32x16 __attribute__((ext_vector_type(16)));
typedef short bf16x8 __attribute__((ext_vector_type(8)));
typedef short s16x4 __attribute__((ext_vector_type(4)));
#define LDS_WAIT() asm volatile("s_waitcnt lgkmcnt(0)" ::: "memory")
#define VM_WAIT() asm volatile("s_waitcnt vmcnt(0)" ::: "memory")
typedef float f32x2_t __attribute__((ext_vector_type(2))); typedef __bf16 bf16x2_t __attribute__((ext_vector_type(2)));
__device__ __forceinline__ unsigned pk2(float lo, float hi) { f32x2_t v = {lo, hi}; bf16x2_t b = __builtin_convertvector(v, bf16x2_t); return __builtin_bit_cast(unsigned, b); }
__device__ __forceinline__ unsigned f2bf(float f) { return pk2(f, f) & 0xffffu; }
__device__ __forceinline__ float bflo(unsigned w) { return __builtin_bit_cast(float, w << 16); }
__device__ __forceinline__ float bfhi(unsigned w) { return __builtin_bit_cast(float, w & 0xffff0000u); }
__device__ __forceinline__ float wave_sum(float v) {
#pragma unroll
    for (int o = 1; o < 64; o <<= 1) v += __shfl_xor(v, o);
    return v;
}
__device__ __forceinline__ float siluf(float x) { return x * __builtin_amdgcn_rcpf(1.0f + __expf(-x)); }

#define XB_TMO      128
#define XB_XCNT(j)  (256  + 64 * (j))
#define XB_XSUB(j)  (1280 + 64 * (j))
#define XB_XGEN(j)  (2304 + 64 * (j))
#define XB_TOP      3328
#define XB_TOPGEN   3392
#define XCD_BAR_WORDS 3456
#define XB_SPIN_CAP (1u << 20)
__device__ __forceinline__ unsigned xb_ld(unsigned* p)              { return __hip_atomic_load(p, __ATOMIC_RELAXED, __HIP_MEMORY_SCOPE_AGENT); }
__device__ __forceinline__ unsigned xb_add(unsigned* p, unsigned v) { return __hip_atomic_fetch_add(p, v, __ATOMIC_RELAXED, __HIP_MEMORY_SCOPE_AGENT); }
__device__ __forceinline__ unsigned xb_xcc_id() { return (unsigned)__builtin_amdgcn_s_getreg((3 << 11) | 20) & 0xFu; }
#define XB_SPIN(cond, bar) do { unsigned _sp = 0; while (cond) { __builtin_amdgcn_s_sleep(1); \
    if ((++_sp & 255u) == 0u) { if (xb_ld(&(bar)[XB_TMO])) break; if (_sp > XB_SPIN_CAP) { atomicAdd(&(bar)[XB_TMO], 1u); break; } } } } while (0)
struct XcdBarrier { unsigned* bar; unsigned x; volatile LAS unsigned* st; };
__device__ __forceinline__ XcdBarrier xcd_barrier_post(unsigned* bar, volatile LAS unsigned* st) {
    XcdBarrier b; b.bar = bar; b.x = xb_xcc_id(); b.st = st;
    if (threadIdx.x == 0) (void)xb_add(&bar[XB_XCNT(b.x)], 1u);
    return b;
}
__device__ __forceinline__ void xcd_barrier_complete(unsigned* bar, unsigned x, unsigned& nloc, unsigned& nx) {
    const unsigned G = gridDim.x * gridDim.y * gridDim.z;
    unsigned sum, cnt, mine, sp = 0u;
    for (;;) {
        sum = 0u; cnt = 0u; mine = 0u;
#pragma unroll
        for (unsigned j = 0; j < 16; ++j) { const unsigned c = xb_ld(&bar[XB_XCNT(j)]); sum += c; cnt += (c > 0u) ? 1u : 0u; mine = (j == x) ? c : mine; }
        if (sum == G) break;
        __builtin_amdgcn_s_sleep(1);
        if ((++sp & 255u) == 0u) { if (xb_ld(&bar[XB_TMO])) break; if (sp > XB_SPIN_CAP) { atomicAdd(&bar[XB_TMO], 1u); break; } }
    }
    nloc = mine > 0u ? mine : 1u; nx = cnt > 0u ? cnt : 1u;
}
__device__ __forceinline__ void xcd_barrier(const XcdBarrier& b) {
    asm volatile("s_waitcnt vmcnt(0)" ::: "memory");
    __syncthreads();
    if (threadIdx.x == 0) {
        unsigned* bar = b.bar;
        __builtin_amdgcn_s_waitcnt(0);
        unsigned nloc = b.st[0], nx = b.st[1];
        if (nloc == 0u) { xcd_barrier_complete(bar, b.x, nloc, nx); b.st[0] = nloc; b.st[1] = nx; }
        const unsigned old = xb_add(&bar[XB_XSUB(b.x)], 1u);
        const unsigned gen = old / nloc;
        if (old + 1u == (gen + 1u) * nloc) {
            __builtin_amdgcn_fence(__ATOMIC_RELEASE, "agent");
            __builtin_amdgcn_fence(__ATOMIC_ACQUIRE, "agent");
            asm volatile("s_waitcnt vmcnt(0)" ::: "memory");
            const unsigned og = xb_add(&bar[XB_TOP], 1u);
            const unsigned tg = og / nx;
            if (og + 1u == (tg + 1u) * nx) xb_add(&bar[XB_TOPGEN], 1u);
            else XB_SPIN(xb_ld(&bar[XB_TOPGEN]) == tg, bar);
            xb_add(&bar[XB_XGEN(b.x)], 1u);
        } else {
            __builtin_amdgcn_fence(__ATOMIC_ACQUIRE, "agent");
            asm volatile("s_waitcnt vmcnt(0)" ::: "memory");
            XB_SPIN(xb_ld(&bar[XB_XGEN(b.x)]) == gen, bar);
        }
        asm volatile("s_waitcnt vmcnt(0)" ::: "memory");
    }
    __syncthreads();
}

struct Params { const float* in[28]; float* out; unsigned char* ws; int ph_lo, ph_hi, use_bar, pad; };
enum { I_XP = 0, I_XS, I_CCKV, I_CKPE, I_SGLA, I_SRET, I_C, I_CCTX, I_WADA, I_BADA, I_NMIXPRE, I_NMIXPOST, I_NMLPPRE, I_NMLPPOST,
       I_WINE, I_WGK2, I_BGK2, I_GLAN, I_RDEC, I_WOUTE, I_WINO, I_QAN, I_WQB, I_KVAN, I_WKVB, I_WOUTO, I_W1, I_W2 };
struct Frame { LAS unsigned char* lds; int tid, lane, wave, vcu, G, bid; };
constexpr int LDS_PT = LDS_MISC + 256;
#define KAS __attribute__((address_space(4)))
__device__ __forceinline__ const void* ldp(LAS unsigned char*, int i) {
    unsigned off = (unsigned)i * 8u; asm volatile("" : "+s"(off));
    const KAS unsigned char* ka = (const KAS unsigned char*)__builtin_amdgcn_kernarg_segment_ptr();
    const unsigned long long v = *(const KAS unsigned long long*)(ka + off);
    return (const void*)(const GAS void*)v;
}
#define PIN(i) ((const float*)ldp(F.lds, (i)))
#define POUT ((float*)ldp(F.lds, 28))
#define PWS ((unsigned char*)ldp(F.lds, 29))

__device__ __forceinline__ void p0_transpose_item(const float* W, int K, int N, bf16* WT, int kb, int n0, int dn0, LAS float* scr, int lane) {
    const int k0 = 64 * kb;
    f32x4 wv[8];
#pragma unroll
    for (int i = 0; i < 8; ++i) wv[i] = __builtin_nontemporal_load((const f32x4*)(W + (size_t)(k0 + 8 * i + (lane >> 3)) * N + n0 + 4 * (lane & 7)));
#pragma unroll
    for (int i = 0; i < 8; ++i) { LAS float* d = scr + (8 * i + (lane >> 3)) * 33 + 4 * (lane & 7); d[0] = wv[i][0]; d[1] = wv[i][1]; d[2] = wv[i][2]; d[3] = wv[i][3]; }
    LDS_WAIT(); asm volatile("" ::: "memory");
    const int c = lane & 7;
#pragma unroll
    for (int j = 0; j < 4; ++j) { const int n = (lane >> 3) + 8 * j; const LAS float* s = scr + (8 * c) * 33 + n;
        v4u o; o.x = pk2(s[0 * 33], s[1 * 33]); o.y = pk2(s[2 * 33], s[3 * 33]); o.z = pk2(s[4 * 33], s[5 * 33]); o.w = pk2(s[6 * 33], s[7 * 33]);
        *(GAS v4u*)(WT + (size_t)(dn0 + n) * K + k0 + 8 * c) = o; }
    LDS_WAIT(); asm volatile("" ::: "memory");
}
__device__ __forceinline__ int even_col_map(int n0) { return n0 < 1536 ? n0 : (n0 < 1568 ? 3072 + (n0 - 1536) : n0 - 32); }

__device__ __forceinline__ void setup_work(Frame& F, const Params& P, int wgi, int nwg, int amask  , int mmask  , int eimask  , int eomask  , int omask  ) {
    unsigned char* ws = PWS;
    LAS float* scr = (LAS float*)(F.lds + F.wave * 16384);
    __syncthreads();
    {
        LAS float* S = (LAS float*)(F.lds);
        LAS float* R = (LAS float*)(F.lds + 40960);
        { const float* cp_ = PIN(I_C); const float* cc_ = PIN(I_CCTX);
          for (int i = F.tid; i < 9 * 1024; i += 512) { const int n = i >> 10, d = i & 1023; const float cv = n < 8 ? cp_[n * 1024 + d] : cc_[d]; S[i] = siluf(cv); } }
        const float* wada_ = PIN(I_WADA); const float* bada_ = PIN(I_BADA);
        __syncthreads();
        const int nl = __builtin_popcount(amask);
        for (int uu = wgi; uu < nl * 128; uu += nwg) {
            int li_ = uu >> 7, l = 0; { int m_ = amask; for (int k_ = 0; k_ < 4; ++k_) { if (m_ & 1) { if (li_ == 0) { l = k_; break; } --li_; } m_ >>= 1; } }
            const int cb = (uu & 127) * 48;
            if (F.tid < 384) {
                const int c4 = (F.tid % 12) * 4, part = F.tid / 12;
                const float* Wp = wada_ + ((size_t)l * 1024 + part * 32) * 6144 + cb + c4;
                f32x4 a[9];
#pragma unroll
                for (int n = 0; n < 9; ++n) a[n] = (f32x4){0.f, 0.f, 0.f, 0.f};
                for (int d0 = 0; d0 < 32; d0 += 16) { f32x4 w[16];
#pragma unroll
                    for (int dd = 0; dd < 16; ++dd) w[dd] = __builtin_nontemporal_load((const f32x4*)(Wp + (size_t)(d0 + dd) * 6144));
#pragma unroll
                    for (int dd = 0; dd < 16; ++dd)
#pragma unroll
                        for (int n = 0; n < 9; ++n) a[n] += w[dd] * S[n * 1024 + part * 32 + d0 + dd]; }
#pragma unroll
                for (int n = 0; n < 9; ++n) *(LAS f32x4*)(R + (part * 9 + n) * 48 + c4) = a[n];
            }
            __syncthreads();
            for (int i = F.tid; i < 9 * 48; i += 512) { const int n = i / 48, c = i % 48; float s = 0.f;
#pragma unroll
                for (int p = 0; p < 32; ++p) s += R[(p * 9 + n) * 48 + c];
                ((float*)(ws + WS_MOD))[((size_t)l * 9 + n) * 6144 + cb + c] = s + bada_[l * 6144 + cb + c]; }
            __syncthreads();
        }
    }
    {
        const int wk = wgi * NWAVES + F.wave, NW = nwg * NWAVES;
        const int I_E = (1024 / 64) * (EVEN_N / 32), I_OE = 16 * 32, I_O = 16 * (ODD_N / 32), I_QB = 4 * 48, I_KVB = 4 * 64, I_M1 = 16 * 128, I_M2 = 64 * 32;
        const float* itW; bf16* itT; int itK, itN, itkb, itn0, itdn0;
#define IT_TRY(sel, count, ...) if (sel) { if (g_ < base_ + (count)) { const int q = g_ - base_; __VA_ARGS__; itkb = kb; itn0 = n0; return_ = true; goto_done_ = true; } else base_ += (count); }
#define IT_DECODE(g, ok) do { const int g_ = (g); int base_ = 0; bool return_ = false, goto_done_ = false; \
        _Pragma("unroll") for (int l = 0; l < 2; ++l) { \
            if (!goto_done_) { IT_TRY((eimask >> l) & 1, I_E, const int nb = EVEN_N / 32, kb = q / nb, n0 = (q % nb) * 32; itW = PIN(I_WINE) + (size_t)l * 1024 * EVEN_N; itK = 1024; itN = EVEN_N; itT = (bf16*)(ws + WS_WINE) + (size_t)l * EVEN_NP * 1024; itdn0 = even_col_map(n0)) } \
            if (!goto_done_) { IT_TRY((eomask >> l) & 1, I_OE, const int kb = q / 32, n0 = (q % 32) * 32; itW = PIN(I_WOUTE) + (size_t)l * 1024 * 1024; itK = 1024; itN = 1024; itT = (bf16*)(ws + WS_WOUTE) + (size_t)l * 1024 * 1024; itdn0 = n0) } \
            if (!goto_done_) { IT_TRY((omask >> l) & 1, I_O, const int nb = ODD_N / 32, kb = q / nb, n0 = (q % nb) * 32; itW = PIN(I_WINO) + (size_t)l * 1024 * ODD_N; itK = 1024; itN = ODD_N; itT = (bf16*)(ws + WS_WINO) + (size_t)l * ODD_NP * 1024; itdn0 = n0) } \
            if (!goto_done_) { IT_TRY((omask >> l) & 1, I_QB, const int kb = q / 48, n0 = (q % 48) * 32; itW = PIN(I_WQB) + (size_t)l * 256 * 1536; itK = 256; itN = 1536; itT = (bf16*)(ws + WS_WQB) + (size_t)l * 1536 * 256; itdn0 = n0) } \
            if (!goto_done_) { IT_TRY((omask >> l) & 1, I_KVB, const int kb = q / 64, n0 = (q % 64) * 32; itW = PIN(I_WKVB) + (size_t)l * 256 * 2048; itK = 256; itN = 2048; itT = (bf16*)(ws + WS_WKVB) + (size_t)l * 2048 * 256; itdn0 = n0) } \
            if (!goto_done_) { IT_TRY((omask >> l) & 1, I_OE, const int kb = q / 32, n0 = (q % 32) * 32; itW = PIN(I_WOUTO) + (size_t)l * 1024 * 1024; itK = 1024; itN = 1024; itT = (bf16*)(ws + WS_WOUTO) + (size_t)l * 1024 * 1024; itdn0 = n0) } } \
        _Pragma("unroll") for (int l = 0; l < 4; ++l) { \
            if (!goto_done_) { IT_TRY((mmask >> l) & 1, I_M1, const int kb = q / 128, n0 = (q % 128) * 32; itW = PIN(I_W1) + (size_t)l * 1024 * 4096; itK = 1024; itN = 4096; itT = (bf16*)(ws + WS_W1) + (size_t)l * 4096 * 1024; itdn0 = n0) } \
            if (!goto_done_) { IT_TRY((mmask >> l) & 1, I_M2, const int kb = q / 32, n0 = (q % 32) * 32; itW = PIN(I_W2) + (size_t)l * 4096 * 1024; itK = 4096; itN = 1024; itT = (bf16*)(ws + WS_W2) + (size_t)l * 1024 * 4096; itdn0 = n0) } } \
        ok = return_; } while (0)
#define IT_LOAD(wv) do { _Pragma("unroll") for (int i = 0; i < 8; ++i) wv[i] = __builtin_nontemporal_load((const f32x4*)(itW + (size_t)(64 * itkb + 8 * i + (F.lane >> 3)) * itN + itn0 + 4 * (F.lane & 7))); } while (0)
#define IT_KEEP() const int cK = itK, ck0 = 64 * itkb, cdn0 = itdn0; bf16* const cT = itT
#define IT_PROC(wv) do { \
        _Pragma("unroll") for (int i = 0; i < 8; ++i) { LAS float* d = scr + (8 * i + (F.lane >> 3)) * 33 + 4 * (F.lane & 7); d[0] = wv[i][0]; d[1] = wv[i][1]; d[2] = wv[i][2]; d[3] = wv[i][3]; } \
        LDS_WAIT(); asm volatile("" ::: "memory"); \
        { const int c = F.lane & 7; \
          _Pragma("unroll") for (int j = 0; j < 4; ++j) { const int n = (F.lane >> 3) + 8 * j; const LAS float* s = scr + (8 * c) * 33 + n; \
              v4u o; o.x = pk2(s[0 * 33], s[1 * 33]); o.y = pk2(s[2 * 33], s[3 * 33]); o.z = pk2(s[4 * 33], s[5 * 33]); o.w = pk2(s[6 * 33], s[7 * 33]); \
              *(GAS v4u*)(cT + (size_t)(cdn0 + n) * cK + ck0 + 8 * c) = o; } } \
        LDS_WAIT(); asm volatile("" ::: "memory"); } while (0)
        f32x4 wa[8], wb[8]; bool ok; int g = wk;
        IT_DECODE(g, ok);
        if (ok) {
            IT_LOAD(wa);
            for (;;) {
                { IT_KEEP(); g += NW; IT_DECODE(g, ok);
                  if (ok) { IT_LOAD(wb); IT_PROC(wa); } else { IT_PROC(wa); break; } }
                { IT_KEEP(); g += NW; IT_DECODE(g, ok);
                  if (ok) { IT_LOAD(wa); IT_PROC(wb); } else { IT_PROC(wb); break; } }
            }
        }
#undef IT_TRY
#undef IT_DECODE
#undef IT_LOAD
#undef IT_KEEP
#undef IT_PROC
    }
    const int gt = wgi * 512 + F.tid, NGT = nwg * 512;
#pragma unroll
    for (int l = 0; l < 2; ++l) {
        if ((eimask >> l) & 1) { v4u z_ = {0u, 0u, 0u, 0u}; asm volatile("" : "+v"(z_)); for (int i = gt; i < 224 * 128; i += NGT) *(GAS v4u*)((bf16*)(ws + WS_WINE) + ((size_t)l * EVEN_NP + EVEN_N) * 1024 + (size_t)i * 8) = z_; }
        if ((omask >> l) & 1) { v4u z_ = {0u, 0u, 0u, 0u}; asm volatile("" : "+v"(z_)); for (int i = gt; i < 192 * 128; i += NGT) *(GAS v4u*)((bf16*)(ws + WS_WINO) + ((size_t)l * ODD_NP + ODD_N) * 1024 + (size_t)i * 8) = z_; }
    }
}
__device__ __forceinline__ void p0_prologue(Frame& F, const Params& P) {
    unsigned char* ws = PWS;
    setup_work(F, P, F.vcu, F.G, 0x5, 0x5, 0x3, 0x3, 0x0);
    const int gt = F.vcu * 512 + F.tid, NGT = F.G * 512;
    for (int i = gt; i < 2048 * 32; i += NGT) { const int t = i >> 5, j = i & 31; const float inv = powf(10000.0f, -(float)(j & 15) / 16.0f);
        const float ang = (float)(j < 16 ? (t >> 6) : (t & 63)) * inv;
        ((float*)(ws + WS_ROPE))[i] = cosf(ang); ((float*)(ws + WS_ROPE))[65536 + i] = sinf(ang); }
}

__device__ __forceinline__ void row_y(f32x4 (&yv)[4], const bf16* Y, const bf16* SL, int row, int l4) {
    if (row < 16384) {
#pragma unroll
        for (int j = 0; j < 4; ++j) { const v2u yw = __builtin_nontemporal_load((const v2u*)(Y + (size_t)row * D + l4 + 256 * j)); yv[j] = (f32x4){bflo(yw.x), bfhi(yw.x), bflo(yw.y), bfhi(yw.y)}; }
    } else {
        const bf16* sp = SL + (size_t)(row - 16384) * D + l4;
#pragma unroll
        for (int j = 0; j < 4; ++j) { const v2u w0 = __builtin_nontemporal_load((const v2u*)(sp + 256 * j)), w1 = __builtin_nontemporal_load((const v2u*)(sp + 4194304 + 256 * j)), w2 = __builtin_nontemporal_load((const v2u*)(sp + 2 * 4194304 + 256 * j)), w3 = __builtin_nontemporal_load((const v2u*)(sp + 3 * 4194304 + 256 * j));
            yv[j] = ((f32x4){bflo(w0.x), bfhi(w0.x), bflo(w0.y), bfhi(w0.y)} + (f32x4){bflo(w1.x), bfhi(w1.x), bflo(w1.y), bfhi(w1.y)}) +
                    ((f32x4){bflo(w2.x), bfhi(w2.x), bflo(w2.y), bfhi(w2.y)} + (f32x4){bflo(w3.x), bfhi(w3.x), bflo(w3.y), bfhi(w3.y)}); }
    }
}
struct RowVec { f32x4 gp[4], gt[4], gq[4], sc[4], sh[4]; };
__device__ __forceinline__ void row_post(f32x4 (&v)[4], const f32x4 (&yv)[4], const RowVec& R) {
    float s = 0.f;
#pragma unroll
    for (int j = 0; j < 4; ++j) s += (yv[j][0] * yv[j][0] + yv[j][1] * yv[j][1]) + (yv[j][2] * yv[j][2] + yv[j][3] * yv[j][3]);
    const float rstd = __builtin_amdgcn_rsqf(wave_sum(s) * (1.0f / 1024.0f) + EPS);
#pragma unroll
    for (int j = 0; j < 4; ++j) v[j] = v[j] + R.gt[j] * ((yv[j] * rstd) * R.gp[j]);
}
__device__ __forceinline__ void row_pass(Frame& F, const float* xa, const float* xb, bool xin_f32, bf16* XB, const bf16* Y, const bf16* SL, const float* g_post, const float* gate,
                                         const float* g_pre, const float* scale, const float* shift, bf16* H, bool has_post, bool has_pre) {
    const int gw = F.vcu * NWAVES + F.wave, NGW = F.G * NWAVES, l4 = F.lane * 4;
    RowVec R; int ncur = -1;
#pragma unroll
    for (int j = 0; j < 4; ++j) { R.gp[j] = has_post ? *(const f32x4*)(g_post + l4 + 256 * j) : (f32x4){0.f, 0.f, 0.f, 0.f}; R.gq[j] = has_pre ? *(const f32x4*)(g_pre + l4 + 256 * j) : (f32x4){0.f, 0.f, 0.f, 0.f};
        R.gt[j] = R.gp[j]; R.sc[j] = R.gp[j]; R.sh[j] = R.gp[j]; }
    for (int blk = gw; blk * 10 < M; blk += NGW) for (int i = 0; i < 10; i += 2) {
        const int row0 = blk * 10 + i; if (row0 >= M) break;
        const int n = row0 < M_CTX ? 8 : ((row0 - M_CTX) >> 11);
        if (n != ncur) { ncur = n;
#pragma unroll
            for (int j = 0; j < 4; ++j) { const int c = l4 + 256 * j;
                if (has_post) R.gt[j] = *(const f32x4*)(gate + (size_t)n * 6144 + c);
                if (has_pre) { R.sc[j] = *(const f32x4*)(scale + (size_t)n * 6144 + c); R.sh[j] = *(const f32x4*)(shift + (size_t)n * 6144 + c); } } }
        f32x4 v[2][4], yv[2][4];
#pragma unroll
        for (int q = 0; q < 2; ++q) { const int row = row0 + q;
            if (xin_f32) { const float* xr = row < M_CTX ? xa + (size_t)row * D : xb + (size_t)(row - M_CTX) * D;
#pragma unroll
                for (int j = 0; j < 4; ++j) v[q][j] = __builtin_nontemporal_load((const f32x4*)(xr + l4 + 256 * j));
            } else {
#pragma unroll
                for (int j = 0; j < 4; ++j) { const v2u xw = __builtin_nontemporal_load((const v2u*)(XB + (size_t)row * D + l4 + 256 * j)); v[q][j] = (f32x4){bflo(xw.x), bfhi(xw.x), bflo(xw.y), bfhi(xw.y)}; }
            }
            if (has_post) row_y(yv[q], Y, SL, row, l4); }
#pragma unroll
        for (int q = 0; q < 2; ++q) { const int row = row0 + q;
            if (has_post) {
                row_post(v[q], yv[q], R);
#pragma unroll
                for (int j = 0; j < 4; ++j) *(v2u*)(XB + (size_t)row * D + l4 + 256 * j) = (v2u){pk2(v[q][j][0], v[q][j][1]), pk2(v[q][j][2], v[q][j][3])};
            }
            if (has_pre) {
                float s = 0.f;
#pragma unroll
                for (int j = 0; j < 4; ++j) s += (v[q][j][0] * v[q][j][0] + v[q][j][1] * v[q][j][1]) + (v[q][j][2] * v[q][j][2] + v[q][j][3] * v[q][j][3]);
                const float rstd = __builtin_amdgcn_rsqf(wave_sum(s) * (1.0f / 1024.0f) + EPS);
#pragma unroll
                for (int j = 0; j < 4; ++j) { const f32x4 h = ((v[q][j] * rstd) * R.gq[j]) * (1.0f + R.sc[j]) + R.sh[j];
                    *(v2u*)(H + (size_t)row * D + l4 + 256 * j) = (v2u){pk2(h[0], h[1]), pk2(h[2], h[3])}; }
            } }
    }
}
struct RowDeal { int r0, cnt; bool tail; };
__device__ __forceinline__ RowDeal row_deal(int gw) { const int x = gw >> 8, w = gw & 255; RowDeal d;
    if (w < 171) { d.tail = false; d.r0 = 2048 * x + 12 * w; d.cnt = w < 170 ? 12 : 8; }
    else { const int u = w - 171; d.tail = true; d.r0 = 16384 + 512 * x + (u == 0 ? 0 : 8 + 6 * (u - 1)); d.cnt = u == 0 ? 8 : 6; }
    return d; }
struct RawN { v2u x[2][4], y[2][4]; };
struct RawT { v2u x[4], s[4][4]; };
__device__ __forceinline__ void row_mid_out(f32x4 (&v)[4], const f32x4 (&yv)[4], const RowVec& R, bf16* XB, bf16* H, int row, int l4) {
    row_post(v, yv, R);
#pragma unroll
    for (int j = 0; j < 4; ++j) *(v2u*)(XB + (size_t)row * D + l4 + 256 * j) = (v2u){pk2(v[j][0], v[j][1]), pk2(v[j][2], v[j][3])};
    float s = 0.f;
#pragma unroll
    for (int j = 0; j < 4; ++j) s += (v[j][0] * v[j][0] + v[j][1] * v[j][1]) + (v[j][2] * v[j][2] + v[j][3] * v[j][3]);
    const float rstd = __builtin_amdgcn_rsqf(wave_sum(s) * (1.0f / 1024.0f) + EPS);
#pragma unroll
    for (int j = 0; j < 4; ++j) { const f32x4 h = ((v[j] * rstd) * R.gq[j]) * (1.0f + R.sc[j]) + R.sh[j];
        *(v2u*)(H + (size_t)row * D + l4 + 256 * j) = (v2u){pk2(h[0], h[1]), pk2(h[2], h[3])}; }
}
__device__ __forceinline__ void row_pass_mid(Frame& F, bf16* XB, const bf16* Y, const bf16* SL, const float* g_post, const float* gate, const float* g_pre, const float* scale, const float* shift, bf16* H) {
    const int gw = F.vcu * NWAVES + F.wave, l4 = F.lane * 4;
    RowVec R; int ncur = -1;
#pragma unroll
    for (int j = 0; j < 4; ++j) { R.gp[j] = *(const f32x4*)(g_post + l4 + 256 * j); R.gq[j] = *(const f32x4*)(g_pre + l4 + 256 * j); R.gt[j] = R.gp[j]; R.sc[j] = R.gp[j]; R.sh[j] = R.gp[j]; }
#define RM_PARAMS(row) do { const int n_ = (row) < M_CTX ? 8 : (((row) - M_CTX) >> 11); if (n_ != ncur) { ncur = n_; \
        _Pragma("unroll") for (int j = 0; j < 4; ++j) { const int c = l4 + 256 * j; R.gt[j] = *(const f32x4*)(gate + (size_t)n_ * 6144 + c); R.sc[j] = *(const f32x4*)(scale + (size_t)n_ * 6144 + c); R.sh[j] = *(const f32x4*)(shift + (size_t)n_ * 6144 + c); } \
        __builtin_amdgcn_s_waitcnt(0x0F70); } } while (0)
#define RM_UNP(w) ((f32x4){bflo((w).x), bfhi((w).x), bflo((w).y), bfhi((w).y)})
#define RM_LOADN(S, row0) do { _Pragma("unroll") for (int q = 0; q < 2; ++q) _Pragma("unroll") for (int j = 0; j < 4; ++j) { \
            S.x[q][j] = __builtin_nontemporal_load((const v2u*)(XB + (size_t)((row0) + q) * D + l4 + 256 * j)); S.y[q][j] = __builtin_nontemporal_load((const v2u*)(Y + (size_t)((row0) + q) * D + l4 + 256 * j)); } } while (0)
#define RM_PROCN(S, row0) do { RM_PARAMS(row0); _Pragma("unroll") for (int q = 0; q < 2; ++q) { f32x4 v[4], yv[4]; \
            _Pragma("unroll") for (int j = 0; j < 4; ++j) { v[j] = RM_UNP(S.x[q][j]); yv[j] = RM_UNP(S.y[q][j]); } \
            row_mid_out(v, yv, R, XB, H, (row0) + q, l4); } } while (0)
#define RM_LOADT(S, row) do { const bf16* sp_ = SL + (size_t)((row) - 16384) * D + l4; _Pragma("unroll") for (int j = 0; j < 4; ++j) { \
            S.x[j] = __builtin_nontemporal_load((const v2u*)(XB + (size_t)(row) * D + l4 + 256 * j)); \
            _Pragma("unroll") for (int k = 0; k < 4; ++k) S.s[k][j] = __builtin_nontemporal_load((const v2u*)(sp_ + (size_t)k * 4194304 + 256 * j)); } } while (0)
#define RM_PROCT(S, row) do { RM_PARAMS(row); f32x4 v[4], yv[4]; \
            _Pragma("unroll") for (int j = 0; j < 4; ++j) { v[j] = RM_UNP(S.x[j]); yv[j] = (RM_UNP(S.s[0][j]) + RM_UNP(S.s[1][j])) + (RM_UNP(S.s[2][j]) + RM_UNP(S.s[3][j])); } \
            row_mid_out(v, yv, R, XB, H, (row), l4); } while (0)
    const RowDeal dl_ = row_deal(gw); const int r0 = dl_.r0, cnt = dl_.cnt;
    if (!dl_.tail) {
        RawN A, B;
        if (cnt == 12) {
            RM_LOADN(A, r0);
            RM_PARAMS(r0);
#pragma unroll
            for (int i = 0; i < 12; i += 4) {
                RM_LOADN(B, r0 + i + 2);
                RM_PROCN(A, r0 + i);
                if (i + 4 < 12) RM_LOADN(A, r0 + i + 4);
                RM_PROCN(B, r0 + i + 2);
            }
        } else {
            RM_PARAMS(r0);
            for (int i = 0; i < cnt; i += 2) { RM_LOADN(A, r0 + i); RM_PROCN(A, r0 + i); }
        }
    } else {
        RawT A, B;
        RM_LOADT(A, r0);
        RM_PARAMS(r0);
#pragma unroll
        for (int i = 0; i < 6; i += 2) {
            RM_LOADT(B, r0 + i + 1);
            RM_PROCT(A, r0 + i);
            if (i + 2 < 6) RM_LOADT(A, r0 + i + 2);
            RM_PROCT(B, r0 + i + 1);
        }
        for (int i = 6; i < cnt; ++i) { RM_LOADT(A, r0 + i); RM_PROCT(A, r0 + i); }
    }
#undef RM_LOADN
#undef RM_PROCN
#undef RM_LOADT
#undef RM_PROCT
#undef RM_UNP
#undef RM_PARAMS
}
template <bool POST>
__device__ __forceinline__ void row_pass_f32(Frame& F, const float* xa, const float* xb, bf16* XB, const bf16* Y, const bf16* SL, const float* g_post, const float* gate,
                                             const float* g_pre, const float* scale, const float* shift, bf16* H) {
    const int gw = F.vcu * NWAVES + F.wave, l4 = F.lane * 4;
    RowVec R; int ncur = -1;
#pragma unroll
    for (int j = 0; j < 4; ++j) { R.gq[j] = *(const f32x4*)(g_pre + l4 + 256 * j); R.gp[j] = POST ? *(const f32x4*)(g_post + l4 + 256 * j) : R.gq[j]; R.gt[j] = R.gq[j]; R.sc[j] = R.gq[j]; R.sh[j] = R.gq[j]; }
#define RX_PARAMS(row) do { const int n_ = (row) < M_CTX ? 8 : (((row) - M_CTX) >> 11); if (n_ != ncur) { ncur = n_; \
        _Pragma("unroll") for (int j = 0; j < 4; ++j) { const int c = l4 + 256 * j; if (POST) R.gt[j] = *(const f32x4*)(gate + (size_t)n_ * 6144 + c); R.sc[j] = *(const f32x4*)(scale + (size_t)n_ * 6144 + c); R.sh[j] = *(const f32x4*)(shift + (size_t)n_ * 6144 + c); } \
        __builtin_amdgcn_s_waitcnt(0x0F70); } } while (0)
#define RX_UNP(w) ((f32x4){bflo((w).x), bfhi((w).x), bflo((w).y), bfhi((w).y)})
#define RX_XROW(row) ((row) < M_CTX ? xa + (size_t)(row) * D : xb + (size_t)((row) - M_CTX) * D)
#define RX_OUT(v, yv, row) do { if (POST) { row_post(v, yv, R); \
            _Pragma("unroll") for (int j = 0; j < 4; ++j) *(v2u*)(XB + (size_t)(row) * D + l4 + 256 * j) = (v2u){pk2(v[j][0], v[j][1]), pk2(v[j][2], v[j][3])}; } \
        float s_ = 0.f; _Pragma("unroll") for (int j = 0; j < 4; ++j) s_ += (v[j][0] * v[j][0] + v[j][1] * v[j][1]) + (v[j][2] * v[j][2] + v[j][3] * v[j][3]); \
        const float rstd_ = __builtin_amdgcn_rsqf(wave_sum(s_) * (1.0f / 1024.0f) + EPS); \
        _Pragma("unroll") for (int j = 0; j < 4; ++j) { const f32x4 h = ((v[j] * rstd_) * R.gq[j]) * (1.0f + R.sc[j]) + R.sh[j]; \
            *(v2u*)(H + (size_t)(row) * D + l4 + 256 * j) = (v2u){pk2(h[0], h[1]), pk2(h[2], h[3])}; } } while (0)
    RowDeal dl_; if (POST) dl_ = row_deal(gw); else { dl_.tail = false; dl_.r0 = gw * 10; dl_.cnt = 10; }
    const int r0 = dl_.r0, cnt = dl_.cnt;
    if (!dl_.tail) {
        f32x4 xA[4], xB[4]; v2u yA[4], yB[4];
#define RX_LOADN(X, Yr, row) do { const float* xr_ = RX_XROW(row); _Pragma("unroll") for (int j = 0; j < 4; ++j) { \
            X[j] = __builtin_nontemporal_load((const f32x4*)(xr_ + l4 + 256 * j)); if (POST) Yr[j] = __builtin_nontemporal_load((const v2u*)(Y + (size_t)(row) * D + l4 + 256 * j)); } } while (0)
#define RX_PROCN(X, Yr, row) do { RX_PARAMS(row); f32x4 v[4], yv[4]; \
            _Pragma("unroll") for (int j = 0; j < 4; ++j) { v[j] = X[j]; yv[j] = POST ? RX_UNP(Yr[j]) : v[j]; } RX_OUT(v, yv, (row)); } while (0)
        if (cnt == 12) {
            RX_LOADN(xA, yA, r0);
            RX_PARAMS(r0);
#pragma unroll
            for (int i = 0; i < 12; i += 2) { RX_LOADN(xB, yB, r0 + i + 1); RX_PROCN(xA, yA, r0 + i); if (i + 2 < 12) RX_LOADN(xA, yA, r0 + i + 2); RX_PROCN(xB, yB, r0 + i + 1); }
        } else if (cnt == 10) {
            RX_LOADN(xA, yA, r0);
            RX_PARAMS(r0);
#pragma unroll
            for (int i = 0; i < 10; i += 2) { RX_LOADN(xB, yB, r0 + i + 1); RX_PROCN(xA, yA, r0 + i); if (i + 2 < 10) RX_LOADN(xA, yA, r0 + i + 2); RX_PROCN(xB, yB, r0 + i + 1); }
        } else {
            RX_PARAMS(r0);
            for (int i = 0; i < cnt; ++i) { RX_LOADN(xA, yA, r0 + i); RX_PROCN(xA, yA, r0 + i); }
        }
#undef RX_LOADN
#undef RX_PROCN
    } else {
        f32x4 xA[4]; v2u sA[4][4];
        RX_PARAMS(r0);
        for (int i = 0; i < cnt; ++i) { const int row = r0 + i; const float* xr_ = RX_XROW(row); const bf16* sp_ = SL + (size_t)(row - 16384) * D + l4;
#pragma unroll
            for (int j = 0; j < 4; ++j) { xA[j] = __builtin_nontemporal_load((const f32x4*)(xr_ + l4 + 256 * j));
#pragma unroll
                for (int k = 0; k < 4; ++k) sA[k][j] = __builtin_nontemporal_load((const v2u*)(sp_ + (size_t)k * 4194304 + 256 * j)); }
            RX_PARAMS(row); f32x4 v[4], yv[4];
#pragma unroll
            for (int j = 0; j < 4; ++j) { v[j] = xA[j]; yv[j] = (RX_UNP(sA[0][j]) + RX_UNP(sA[1][j])) + (RX_UNP(sA[2][j]) + RX_UNP(sA[3][j])); }
            RX_OUT(v, yv, row); }
    }
#undef RX_PARAMS
#undef RX_UNP
#undef RX_XROW
#undef RX_OUT
}
__device__ __forceinline__ void row_pass_final2(Frame& F, const XcdBarrier& bar, const bf16* XB, float* OUT, const bf16* Y, const bf16* SL, const float* g_post, const float* gate) {
    const int gw = F.vcu * NWAVES + F.wave, l4 = F.lane * 4;
    RowVec R; int ncur = -1;
#define RF_PARAMS(row) do { const int n_ = (row) < M_CTX ? 8 : (((row) - M_CTX) >> 11); if (n_ != ncur) { ncur = n_; \
        _Pragma("unroll") for (int j = 0; j < 4; ++j) R.gt[j] = *(const f32x4*)(gate + (size_t)n_ * 6144 + l4 + 256 * j); \
        __builtin_amdgcn_s_waitcnt(0x0F70); } } while (0)
#define RF_UNP(w) ((f32x4){bflo((w).x), bfhi((w).x), bflo((w).y), bfhi((w).y)})
#define RF_OUT(xr, yv, row) do { f32x4 v[4]; _Pragma("unroll") for (int j = 0; j < 4; ++j) v[j] = RF_UNP(xr[j]); row_post(v, yv, R); \
        _Pragma("unroll") for (int j = 0; j < 4; ++j) *(f32x4*)(OUT + (size_t)(row) * D + l4 + 256 * j) = v[j]; } while (0)
    const RowDeal dl_ = row_deal(gw); const int r0 = dl_.r0, cnt = dl_.cnt;
    if (!dl_.tail) {
        const bool full = cnt == 12;
        v2u xw[12][4];
#pragma unroll
        for (int i = 0; i < 12; ++i) if (full || i < 8) {
#pragma unroll
            for (int j = 0; j < 4; ++j) xw[i][j] = __builtin_nontemporal_load((const v2u*)(XB + (size_t)(r0 + i) * D + l4 + 256 * j)); }
        xcd_barrier(bar);
#pragma unroll
        for (int j = 0; j < 4; ++j) { R.gp[j] = *(const f32x4*)(g_post + l4 + 256 * j); R.gt[j] = R.gp[j]; }
#define RF_LOADN(S, row) do { _Pragma("unroll") for (int j = 0; j < 4; ++j) S[j] = __builtin_nontemporal_load((const v2u*)(Y + (size_t)(row) * D + l4 + 256 * j)); } while (0)
#define RF_PROCN(S, i, row) do { RF_PARAMS(row); f32x4 yv[4]; _Pragma("unroll") for (int j = 0; j < 4; ++j) yv[j] = RF_UNP(S[j]); RF_OUT(xw[i], yv, row); } while (0)
        v2u A[4], B[4], C[4];
        if (full) {
            RF_LOADN(A, r0); RF_LOADN(B, r0 + 1); RF_LOADN(C, r0 + 2);
            RF_PARAMS(r0);
#pragma unroll
            for (int i = 0; i < 12; i += 3) {
                RF_PROCN(A, i, r0 + i); if (i + 3 < 12) RF_LOADN(A, r0 + i + 3);
                RF_PROCN(B, i + 1, r0 + i + 1); if (i + 4 < 12) RF_LOADN(B, r0 + i + 4);
                RF_PROCN(C, i + 2, r0 + i + 2); if (i + 5 < 12) RF_LOADN(C, r0 + i + 5);
            }
        } else {
#pragma unroll
            RF_PARAMS(r0);
#pragma unroll
            for (int i = 0; i < 8; ++i) { RF_LOADN(A, r0 + i); RF_PROCN(A, i, r0 + i); }
        }
#undef RF_LOADN
#undef RF_PROCN
    } else {
        v2u xw[8][4];
#pragma unroll
        for (int i = 0; i < 8; ++i) if (i < cnt) {
#pragma unroll
            for (int j = 0; j < 4; ++j) xw[i][j] = __builtin_nontemporal_load((const v2u*)(XB + (size_t)(r0 + i) * D + l4 + 256 * j)); }
        xcd_barrier(bar);
#pragma unroll
        for (int j = 0; j < 4; ++j) { R.gp[j] = *(const f32x4*)(g_post + l4 + 256 * j); R.gt[j] = R.gp[j]; }
#define RF_LOADT(S, row) do { const bf16* sp_ = SL + (size_t)((row) - 16384) * D + l4; _Pragma("unroll") for (int k = 0; k < 4; ++k) _Pragma("unroll") for (int j = 0; j < 4; ++j) \
            S[k][j] = __builtin_nontemporal_load((const v2u*)(sp_ + (size_t)k * 4194304 + 256 * j)); } while (0)
#define RF_PROCT(S, i, row) do { RF_PARAMS(row); f32x4 yv[4]; _Pragma("unroll") for (int j = 0; j < 4; ++j) yv[j] = (RF_UNP(S[0][j]) + RF_UNP(S[1][j])) + (RF_UNP(S[2][j]) + RF_UNP(S[3][j])); RF_OUT(xw[i], yv, row); } while (0)
        v2u A[4][4], B[4][4];
        RF_LOADT(A, r0);
        RF_PARAMS(r0);
#pragma unroll
        for (int i = 0; i < 6; i += 2) {
            RF_LOADT(B, r0 + i + 1);
            RF_PROCT(A, i, r0 + i);
            if (i + 2 < 6) RF_LOADT(A, r0 + i + 2);
            RF_PROCT(B, i + 1, r0 + i + 1);
        }
        if (cnt == 8) { RF_LOADT(A, r0 + 6); RF_LOADT(B, r0 + 7); RF_PROCT(A, 6, r0 + 6); RF_PROCT(B, 7, r0 + 7); }
#undef RF_LOADT
#undef RF_PROCT
    }
#undef RF_PARAMS
#undef RF_UNP
#undef RF_OUT
}
__device__ __forceinline__ void row_pass_final(Frame& F, const XcdBarrier& bar, const bf16* XB, float* OUT, const bf16* Y, const bf16* SL, const float* g_post, const float* gate) {
    const int gw = F.vcu * NWAVES + F.wave, l4 = F.lane * 4;
    v2u xw[10][4];
#pragma unroll
    for (int i = 0; i < 10; ++i) { const int row = gw * 10 + i;
        if (row < M) {
#pragma unroll
            for (int j = 0; j < 4; ++j) xw[i][j] = __builtin_nontemporal_load((const v2u*)(XB + (size_t)row * D + l4 + 256 * j));
        } }
    xcd_barrier(bar);
    RowVec R; int ncur = -1;
#pragma unroll
    for (int j = 0; j < 4; ++j) { R.gp[j] = *(const f32x4*)(g_post + l4 + 256 * j); R.gt[j] = R.gp[j]; }
#pragma unroll
    for (int i = 0; i < 10; ++i) { const int row = gw * 10 + i;
        if (row < M) {
            const int n = row < M_CTX ? 8 : ((row - M_CTX) >> 11);
            if (n != ncur) { ncur = n;
#pragma unroll
                for (int j = 0; j < 4; ++j) R.gt[j] = *(const f32x4*)(gate + (size_t)n * 6144 + l4 + 256 * j); }
            f32x4 v[4], yv[4];
#pragma unroll
            for (int j = 0; j < 4; ++j) v[j] = (f32x4){bflo(xw[i][j].x), bfhi(xw[i][j].x), bflo(xw[i][j].y), bfhi(xw[i][j].y)};
            row_y(yv, Y, SL, row, l4); row_post(v, yv, R);
#pragma unroll
            for (int j = 0; j < 4; ++j) *(f32x4*)(OUT + (size_t)row * D + l4 + 256 * j) = v[j];
        } }
}

__device__ __forceinline__ int crow(int r, int hi) { return (r & 3) + 8 * (r >> 2) + 4 * hi; }
__device__ __forceinline__ unsigned cvtpk(float lo, float hi) { return pk2(lo, hi); }
#define SBAR() __builtin_amdgcn_sched_barrier(0)
__device__ __forceinline__ int vst_row(int k, int NB) { const int kk = (k & ~0xC) | ((k & 4) << 1) | ((k & 8) >> 1); return (kk >> 3) * NB * 512 + (kk & 7) * 64; }
__device__ __forceinline__ int vst(int k, int c, int NB) { return vst_row(k, NB) + (c >> 5) * 512 + (c & 31) * 2; }
__device__ __forceinline__ int v_rd_base(int lane) { return ((lane & 3) << 3) | (((lane >> 2) & 3) << 6) | (((lane >> 4) & 1) << 5) | (((lane >> 5) & 1) << 8); }
template <int OFF> __device__ __forceinline__ s16x4 tr_read(unsigned vb) { s16x4 r; asm volatile("ds_read_b64_tr_b16 %0, %1 offset:%2" : "=&v"(r) : "v"(vb), "i"(OFF) : "memory"); return r; }
#define PKF(L, H) ((bf16x8){L[0], L[1], L[2], L[3], H[0], H[1], H[2], H[3]})
#define PK4(P, BASE, OUT) do { unsigned a0_ = cvtpk(P[BASE + 0], P[BASE + 1]), a1_ = cvtpk(P[BASE + 2], P[BASE + 3]);   \
    unsigned b0_ = cvtpk(P[BASE + 4], P[BASE + 5]), b1_ = cvtpk(P[BASE + 6], P[BASE + 7]);                              \
    auto r0_ = __builtin_amdgcn_permlane32_swap(a0_, b0_, false, false); auto r1_ = __builtin_amdgcn_permlane32_swap(a1_, b1_, false, false); \
    v4u w_ = {r0_[0], r1_[0], r0_[1], r1_[1]}; OUT = __builtin_bit_cast(bf16x8, w_); } while (0)
__device__ __forceinline__ float fexp(float x) { return __builtin_amdgcn_exp2f(x * 1.4426950408889634f); }
__device__ __forceinline__ float logsig(float x) { return fminf(x, 0.f) - 0.6931471805599453f * __builtin_amdgcn_logf(1.0f + __builtin_amdgcn_exp2f(-1.4426950408889634f * fabsf(x))); }

constexpr int SC_T = 0  , SC_TSZ = 32768, SC_QD = 0, SC_KI = 8192, SC_VT = 16384, SC_ST = 65536, SC_BT = 81920  , SC_TOT = 114688, SC_DL = 115200  ;
__device__ __forceinline__ void scan_phase(Frame& F, const Params& P, int li) {
    unsigned char* ws = PWS;
    const bf16* PROJ = (const bf16*)(ws + WS_BIG);
    const float* ROPE = (const float*)(ws + WS_ROPE);
    LAS unsigned char* G = F.lds;
    const unsigned gaddr = (unsigned)(uintptr_t)G;
    const bool isP = F.wave >= 4; const int gw4 = F.wave & 3;
    const int ri = gw4 >> 1, dh = gw4 & 1;
#define SC_BAR() do { asm volatile("s_waitcnt lgkmcnt(0)" ::: "memory"); __builtin_amdgcn_s_barrier(); asm volatile("" ::: "memory"); } while (0)
#define SC_TOK(c, i) (dir == 0 ? 64 * (c) + (i) : L - 1 - (64 * (c) + (i)))
    for (int u0 = F.bid; u0 < 256; u0 += F.G) for (int kk_ = 0; kk_ < (u0 < 128 ? 1 : 2); ++kk_) {
        __syncthreads();
        const bool lat = u0 < 128; const int u = lat ? u0 : 2 * (u0 - 128) + kk_;
        const int sb = u >> 4, hh = (u >> 1) & 7, dir = u & 1;
        const int L = lat ? L_LAT : L_CTX, row0 = lat ? M_CTX + sb * L_LAT : sb * L_CTX, NC = L / 64;
        const bool gla = hh < 4; const int h = hh & 3;
        const int qc = (gla ? PC_QA : PC_QB) + h * 64, kc = (gla ? PC_KA : PC_KB) + h * 64, vc = (gla ? PC_VA : PC_VB) + h * 128, gkc = PC_GK + dir * 16;
        bf16* OUT = (bf16*)(ws + (dir == 0 ? WS_Y : WS_HB));
        const float* rdec_p = PIN(I_RDEC); const float* wgk2_p = PIN(I_WGK2); const float* bgk2_p = PIN(I_BGK2);
        const float lgr = gla ? 0.f : -fexp(rdec_p[(li * 2 + dir) * 4 + h]);
        f32x16 sacc[2]; sacc[0] = f32x16{}; sacc[1] = f32x16{}; v4u w2f = {0u, 0u, 0u, 0u}; float gbias = 0.f;
        { int t0_ = F.tid; asm volatile("" : "+v"(t0_)); const int lane = t0_ & 63, r32 = lane & 31, hi = lane >> 5;
          if (isP) {
              if (gla) { const int kcol = h * 64 + 32 * (gw4 & 1) + r32; const float* wp_ = wgk2_p + ((size_t)(li * 2 + dir) * 16 + 8 * hi) * 256 + kcol;
                  w2f = (v4u){pk2(wp_[0], wp_[256]), pk2(wp_[512], wp_[768]), pk2(wp_[1024], wp_[1280]), pk2(wp_[1536], wp_[1792])};
                  gbias = bgk2_p[(li * 2 + dir) * 256 + kcol]; }
              else if (t0_ < 256 + 192) ((LAS float*)(G + SC_DL))[t0_ - 256] = fexp(64.0f * lgr);
          } else {
              const float* S0 = (gla ? PIN(I_SGLA) : PIN(I_SRET)) + ((size_t)((sb * 2 + li) * 2 + dir) * 4 + h) * 8192;
              if (lat) {
#pragma unroll
                  for (int d = 0; d < 2; ++d)
#pragma unroll
                      for (int r = 0; r < 16; ++r) sacc[d][r] = S0[(32 * ri + crow(r, hi)) * 128 + 32 * (2 * dh + d) + r32];
              }
#pragma unroll
              for (int d = 0; d < 2; ++d)
#pragma unroll
                  for (int r = 0; r < 16; r += 2) { const unsigned w = pk2(sacc[d][r], sacc[d][r + 1]);
                      LAS unsigned char* sp_ = G + SC_ST + (hi + 4 * ri) * 2048 + (2 * dh + d) * 512 + r32 * 2 + ((r >> 3) & 1) * 4096 + ((r & 3) + 4 * ((r >> 2) & 1)) * 64;
                      *(LAS unsigned short*)sp_ = (unsigned short)w; *(LAS unsigned short*)(sp_ + 64) = (unsigned short)(w >> 16); }
          } }
        v4u pq0 = {}, pq1 = {}, pk0 = {}, pk1 = {}, pv[4] = {}; v4u pga = {0u, 0u, 0u, 0u}; float cs[16] = {}; float tsum = 0.f;
#define SC_LOADRAW(c) do { const unsigned ro_ = (unsigned)(row0 + SC_TOK(c, sti)) * (unsigned)(EVEN_NP * 2); const char* pc_ = (const char*)PROJ; \
        pq0 = *(const v4u*)(pc_ + (ro_ + (unsigned)(qc + 8 * c8) * 2u)); pq1 = *(const v4u*)(pc_ + (ro_ + (unsigned)(qc + 32 + 8 * c8) * 2u)); \
        pk0 = *(const v4u*)(pc_ + (ro_ + (unsigned)(kc + 8 * c8) * 2u)); pk1 = *(const v4u*)(pc_ + (ro_ + (unsigned)(kc + 32 + 8 * c8) * 2u)); \
        _Pragma("unroll") for (int m_ = 0; m_ < 4; ++m_) pv[m_] = *(const v4u*)(pc_ + (ro_ + (unsigned)(vc + c8 * 32 + 8 * m_) * 2u)); } while (0)
#define SC_LOADGK(c) do { const char* gp_ = (const char*)PROJ + ((unsigned)(row0 + SC_TOK(c, 32 * (gw4 >> 1) + r32)) * (unsigned)(EVEN_NP * 2) + (unsigned)(gkc + 8 * hi) * 2u); \
        pga = *(const v4u*)gp_; \
        if (row0 >= 16384) { const v4u p1_ = *(const v4u*)(gp_ + 64), p2_ = *(const v4u*)(gp_ + 128), p3_ = *(const v4u*)(gp_ + 192); \
            _Pragma("unroll") for (int e_ = 0; e_ < 4; ++e_) pga[e_] = pk2((bflo(pga[e_]) + bflo(p1_[e_])) + (bflo(p2_[e_]) + bflo(p3_[e_])), (bfhi(pga[e_]) + bfhi(p1_[e_])) + (bfhi(p2_[e_]) + bfhi(p3_[e_]))); } } while (0)
        if (isP && gla) { int t0_ = F.tid; asm volatile("" : "+v"(t0_)); const int r32 = t0_ & 31, hi = (t0_ >> 5) & 1; SC_LOADGK(0); }
        for (int s = -3; s < NC; ++s) {
            int tid_o = F.tid; asm volatile("" : "+v"(tid_o));
            const int lane = tid_o & 63, r32 = lane & 31, hi = lane >> 5, tgp = tid_o & 255, sti = tgp >> 2, c8 = tgp & 3;
            if (isP) {
                if (gla && s + 2 >= 0 && s + 2 < NC) {
                    const int th = gw4 >> 1, kq = 32 * (gw4 & 1) + r32; LAS float* BTw = (LAS float*)(G + SC_BT + ((s + 2) & 1) * 16384);
                    const float t0v = ((LAS float*)(G + SC_TOT))[kq]; const float pre = th ? t0v : 0.f;
#pragma unroll
                    for (int r = 0; r < 16; ++r) BTw[(32 * th + crow(r, hi)) * 64 + kq] = pre + cs[r];
                    if (th == 1 && hi == 0) ((LAS float*)(G + SC_DL))[((s + 2) % 3) * 64 + kq] = fexp(pre + tsum);
                }
                if (s + 1 >= 0 && s + 1 < NC) {
                    LAS unsigned char* T = G + SC_T + ((s + 1) & 1) * SC_TSZ;
                    float q[16], kk[16];
#define UNPK(dst, o, W_) do { const v4u w_ = (W_); dst[o + 0] = bflo(w_[0]); dst[o + 1] = bfhi(w_[0]); dst[o + 2] = bflo(w_[1]); dst[o + 3] = bfhi(w_[1]); dst[o + 4] = bflo(w_[2]); dst[o + 5] = bfhi(w_[2]); dst[o + 6] = bflo(w_[3]); dst[o + 7] = bfhi(w_[3]); } while (0)
                    UNPK(q, 0, pq0); UNPK(q, 8, pq1); UNPK(kk, 0, pk0); UNPK(kk, 8, pk1);
                    if (gla) {
                        const LAS float* BTr = (const LAS float*)(G + SC_BT + ((s + 1) & 1) * 16384) + sti * 64 + 8 * c8;
                        const f32x4 x0 = *(const LAS f32x4*)BTr, x1 = *(const LAS f32x4*)(BTr + 4), x2 = *(const LAS f32x4*)(BTr + 32), x3 = *(const LAS f32x4*)(BTr + 36);
#pragma unroll
                        for (int e = 0; e < 4; ++e) { const float e0 = fexp(x0[e]), e1 = fexp(x1[e]), e2 = fexp(x2[e]), e3 = fexp(x3[e]);
                            q[e] *= 0.125f * e0; kk[e] *= __builtin_amdgcn_rcpf(e0); q[4 + e] *= 0.125f * e1; kk[4 + e] *= __builtin_amdgcn_rcpf(e1);
                            q[8 + e] *= 0.125f * e2; kk[8 + e] *= __builtin_amdgcn_rcpf(e2); q[12 + e] *= 0.125f * e3; kk[12 + e] *= __builtin_amdgcn_rcpf(e3); }
                    } else {
                        if (lat) {
                            const float* cp = ROPE + (size_t)SC_TOK(s + 1, sti) * 32 + 8 * c8; const f32x4 c0 = *(const f32x4*)cp, c1 = *(const f32x4*)(cp + 4), s0 = *(const f32x4*)(cp + 65536), s1 = *(const f32x4*)(cp + 65540);
#pragma unroll
                            for (int e = 0; e < 8; ++e) { const float c = e < 4 ? c0[e & 3] : c1[e & 3], sn = e < 4 ? s0[e & 3] : s1[e & 3];
                                const float q1 = q[e], q2 = q[8 + e]; q[e] = q1 * c - q2 * sn; q[8 + e] = q1 * sn + q2 * c;
                                const float k1 = kk[e], k2 = kk[8 + e]; kk[e] = k1 * c - k2 * sn; kk[8 + e] = k1 * sn + k2 * c; }
                        }
                        const float bb = (float)(sti + 1) * lgr, eb = fexp(bb), ek = 0.125f * __builtin_amdgcn_rcpf(eb);
#pragma unroll
                        for (int e = 0; e < 16; ++e) { q[e] *= eb; kk[e] *= ek; }
                    }
                    *(LAS v4u*)(T + SC_QD + vst(sti, 8 * c8, 2)) = (v4u){pk2(q[0], q[1]), pk2(q[2], q[3]), pk2(q[4], q[5]), pk2(q[6], q[7])};
                    *(LAS v4u*)(T + SC_QD + vst(sti, 32 + 8 * c8, 2)) = (v4u){pk2(q[8], q[9]), pk2(q[10], q[11]), pk2(q[12], q[13]), pk2(q[14], q[15])};
                    *(LAS v4u*)(T + SC_KI + vst(sti, 8 * c8, 2)) = (v4u){pk2(kk[0], kk[1]), pk2(kk[2], kk[3]), pk2(kk[4], kk[5]), pk2(kk[6], kk[7])};
                    *(LAS v4u*)(T + SC_KI + vst(sti, 32 + 8 * c8, 2)) = (v4u){pk2(kk[8], kk[9]), pk2(kk[10], kk[11]), pk2(kk[12], kk[13]), pk2(kk[14], kk[15])};
#pragma unroll
                    for (int m = 0; m < 4; ++m) *(LAS v4u*)(T + SC_VT + vst(sti, c8 * 32 + 8 * m, 4)) = pv[m];
                }
                if (s + 2 >= 0 && s + 2 < NC) SC_LOADRAW(s + 2);
            } else if (s >= 0) {
                LAS unsigned char* T = G + SC_T + (s & 1) * SC_TSZ; const unsigned taddr = gaddr + SC_T + (s & 1) * SC_TSZ;
                bf16x8 qf[4]; bf16x8 pa0, pa1, pa2, pa3;
                { const int qb_ = vst_row(32 * ri + r32, 2) + 16 * hi;
                  qf[0] = *(const LAS bf16x8*)(T + SC_QD + qb_); qf[1] = *(const LAS bf16x8*)(T + SC_QD + qb_ + 32); qf[2] = *(const LAS bf16x8*)(T + SC_QD + qb_ + 512); qf[3] = *(const LAS bf16x8*)(T + SC_QD + qb_ + 544); }
                { f32x16 p0 = {}, p1 = {};
                  const int kb0 = vst_row(r32, 2) + 16 * hi, kb1 = vst_row(32 + r32, 2) + 16 * hi;
                  { const bf16x8 a0 = *(const LAS bf16x8*)(T + SC_KI + kb0), a1 = *(const LAS bf16x8*)(T + SC_KI + kb0 + 32), a2 = *(const LAS bf16x8*)(T + SC_KI + kb0 + 512), a3 = *(const LAS bf16x8*)(T + SC_KI + kb0 + 544);
                    p0 = __builtin_amdgcn_mfma_f32_32x32x16_bf16(a0, qf[0], p0, 0, 0, 0); p0 = __builtin_amdgcn_mfma_f32_32x32x16_bf16(a1, qf[1], p0, 0, 0, 0);
                    p0 = __builtin_amdgcn_mfma_f32_32x32x16_bf16(a2, qf[2], p0, 0, 0, 0); p0 = __builtin_amdgcn_mfma_f32_32x32x16_bf16(a3, qf[3], p0, 0, 0, 0); }
                  if (ri == 1) {
                      const bf16x8 c0 = *(const LAS bf16x8*)(T + SC_KI + kb1), c1 = *(const LAS bf16x8*)(T + SC_KI + kb1 + 32), c2 = *(const LAS bf16x8*)(T + SC_KI + kb1 + 512), c3 = *(const LAS bf16x8*)(T + SC_KI + kb1 + 544);
                      p1 = __builtin_amdgcn_mfma_f32_32x32x16_bf16(c0, qf[0], p1, 0, 0, 0); p1 = __builtin_amdgcn_mfma_f32_32x32x16_bf16(c1, qf[1], p1, 0, 0, 0);
                      p1 = __builtin_amdgcn_mfma_f32_32x32x16_bf16(c2, qf[2], p1, 0, 0, 0); p1 = __builtin_amdgcn_mfma_f32_32x32x16_bf16(c3, qf[3], p1, 0, 0, 0); }
#pragma unroll
                  for (int r = 0; r < 16; ++r) { const bool keep = crow(r, hi) <= r32; if (ri == 0) { p0[r] = keep ? p0[r] : 0.f; } else { p1[r] = keep ? p1[r] : 0.f; } }
                  PK4(p0, 0, pa0); PK4(p0, 8, pa1); PK4(p1, 0, pa2); PK4(p1, 8, pa3); }
                const unsigned vb = taddr + SC_VT + v_rd_base(lane) + dh * 1024, sbv = gaddr + SC_ST + v_rd_base(lane) + dh * 1024;
#define SC_RD8(raw, base, d) do { raw[0] = tr_read<(d) * 512>(base); raw[1] = tr_read<(d) * 512 + 2048>(base); raw[2] = tr_read<(d) * 512 + 4096>(base); raw[3] = tr_read<(d) * 512 + 4096 + 2048>(base); \
                  raw[4] = tr_read<(d) * 512 + 8192>(base); raw[5] = tr_read<(d) * 512 + 8192 + 2048>(base); raw[6] = tr_read<(d) * 512 + 12288>(base); raw[7] = tr_read<(d) * 512 + 12288 + 2048>(base); } while (0)
#define SC_LWAIT() do { asm volatile("s_waitcnt lgkmcnt(0)" ::: "memory"); SBAR(); } while (0)
#define SC_OBLK(d, rv, rs) do { f32x16 o_ = {}; \
                  o_ = __builtin_amdgcn_mfma_f32_32x32x16_bf16(pa0, PKF(rv[0], rv[1]), o_, 0, 0, 0); o_ = __builtin_amdgcn_mfma_f32_32x32x16_bf16(pa1, PKF(rv[2], rv[3]), o_, 0, 0, 0); \
                  if (ri == 1) { o_ = __builtin_amdgcn_mfma_f32_32x32x16_bf16(pa2, PKF(rv[4], rv[5]), o_, 0, 0, 0); o_ = __builtin_amdgcn_mfma_f32_32x32x16_bf16(pa3, PKF(rv[6], rv[7]), o_, 0, 0, 0); } \
                  o_ = __builtin_amdgcn_mfma_f32_32x32x16_bf16(qf[0], PKF(rs[0], rs[1]), o_, 0, 0, 0); o_ = __builtin_amdgcn_mfma_f32_32x32x16_bf16(qf[1], PKF(rs[2], rs[3]), o_, 0, 0, 0); \
                  o_ = __builtin_amdgcn_mfma_f32_32x32x16_bf16(qf[2], PKF(rs[4], rs[5]), o_, 0, 0, 0); o_ = __builtin_amdgcn_mfma_f32_32x32x16_bf16(qf[3], PKF(rs[6], rs[7]), o_, 0, 0, 0); \
                  char* dst_ = (char*)OUT; \
                  _Pragma("unroll") for (int r = 0; r < 16; r += 2) { const int i_ = 32 * ri + crow(r, hi); const int t_ = SC_TOK(s, i_); const unsigned w_ = pk2(o_[r], o_[r + 1]); \
                      const unsigned a_ = (unsigned)(row0 + t_) * (unsigned)(D * 2) + (unsigned)(hh * 128 + 64 * dh + 32 * (d) + r32) * 2u; \
                      *(bf16*)(dst_ + a_) = (bf16)w_; *(bf16*)(dst_ + (dir == 0 ? a_ + (unsigned)(D * 2) : a_ - (unsigned)(D * 2))) = (bf16)(w_ >> 16); } SBAR(); } while (0)
                { s16x4 rv0[8], rs0[8], rv1[8], rs1[8];
                  SC_RD8(rv0, vb, 0); SC_RD8(rs0, sbv, 0); SC_LWAIT();
                  SC_RD8(rv1, vb, 1); SC_RD8(rs1, sbv, 1);
                  SC_OBLK(0, rv0, rs0); SC_LWAIT();
                  SC_OBLK(1, rv1, rs1); }
            }
            SC_BAR();
            if (isP) {
                if (gla && s + 3 < NC) {
                    const int th = gw4 >> 1, kq = 32 * (gw4 & 1) + r32;
                    f32x16 gp;
#pragma unroll
                    for (int r = 0; r < 16; ++r) gp[r] = gbias;
                    gp = __builtin_amdgcn_mfma_f32_32x32x16_bf16(__builtin_bit_cast(bf16x8, pga), __builtin_bit_cast(bf16x8, w2f), gp, 0, 0, 0);
                    float g4[4], o4[4];
#pragma unroll
                    for (int j = 0; j < 4; ++j) { float run = 0.f;
#pragma unroll
                        for (int e = 0; e < 4; ++e) { run += logsig(gp[4 * j + e]) * (1.0f / 16.0f); cs[4 * j + e] = run; }
                        g4[j] = run; }
#pragma unroll
                    for (int j = 0; j < 4; ++j) o4[j] = __shfl_xor(g4[j], 32);
                    float acc_ = 0.f;
#pragma unroll
                    for (int j = 0; j < 4; ++j) { const float off = acc_ + (hi ? o4[j] : 0.f);
#pragma unroll
                        for (int e = 0; e < 4; ++e) cs[4 * j + e] += off;
                        acc_ += g4[j] + o4[j]; }
                    tsum = acc_;
                    if (hi == 0) ((LAS float*)(G + SC_TOT))[th * 64 + kq] = tsum;
                    if (s + 4 < NC) SC_LOADGK(s + 4);
                }
            } else if (s >= 0) {
                const unsigned taddr = gaddr + SC_T + (s & 1) * SC_TSZ;
                const unsigned vb = taddr + SC_VT + v_rd_base(lane) + dh * 1024, kt = taddr + SC_KI + v_rd_base(lane) + ri * 512;
                s16x4 rk[8], rv0[8], rv1[8];
                rk[0] = tr_read<0>(kt); rk[1] = tr_read<1024>(kt); rk[2] = tr_read<2048>(kt); rk[3] = tr_read<2048 + 1024>(kt); rk[4] = tr_read<4096>(kt); rk[5] = tr_read<4096 + 1024>(kt); rk[6] = tr_read<6144>(kt); rk[7] = tr_read<6144 + 1024>(kt);
                SC_RD8(rv0, vb, 0); SC_LWAIT();
                SC_RD8(rv1, vb, 1);
                bf16x8 kf[4]; kf[0] = PKF(rk[0], rk[1]); kf[1] = PKF(rk[2], rk[3]); kf[2] = PKF(rk[4], rk[5]); kf[3] = PKF(rk[6], rk[7]);
                const int stb_ = (hi + 4 * ri) * 2048 + (2 * dh) * 512 + r32 * 2;
                const LAS float* DLr = (const LAS float*)(G + SC_DL) + (s % 3) * 64;
#define SC_SBLK(d, rv) do { \
                  sacc[d] = __builtin_amdgcn_mfma_f32_32x32x16_bf16(kf[0], PKF(rv[0], rv[1]), sacc[d], 0, 0, 0); sacc[d] = __builtin_amdgcn_mfma_f32_32x32x16_bf16(kf[1], PKF(rv[2], rv[3]), sacc[d], 0, 0, 0); \
                  sacc[d] = __builtin_amdgcn_mfma_f32_32x32x16_bf16(kf[2], PKF(rv[4], rv[5]), sacc[d], 0, 0, 0); sacc[d] = __builtin_amdgcn_mfma_f32_32x32x16_bf16(kf[3], PKF(rv[6], rv[7]), sacc[d], 0, 0, 0); \
                  _Pragma("unroll") for (int r = 0; r < 16; r += 2) { const int dk = 32 * ri + crow(r, hi); const float dl0 = DLr[dk], dl1 = DLr[dk + 1]; \
                      sacc[d][r] *= dl0; sacc[d][r + 1] *= dl1; const unsigned w_ = pk2(sacc[d][r], sacc[d][r + 1]); \
                      LAS unsigned char* sp_ = G + SC_ST + stb_ + (d) * 512 + ((r >> 3) & 1) * 4096 + ((r & 3) + 4 * ((r >> 2) & 1)) * 64; \
                      *(LAS unsigned short*)sp_ = (unsigned short)w_; *(LAS unsigned short*)(sp_ + 64) = (unsigned short)(w_ >> 16); } SBAR(); } while (0)
                SC_SBLK(0, rv0); SC_LWAIT();
                SC_SBLK(1, rv1);
            }
            SC_BAR();
        }
        if (!lat && !isP) { int l2 = F.lane; asm volatile("" : "+v"(l2)); const int r32 = l2 & 31, hi = l2 >> 5; float* SO = POUT + (gla ? OUT_SGLA : OUT_SRET) + ((size_t)((sb * 2 + li) * 2 + dir) * 4 + h) * 8192;
#pragma unroll
            for (int d = 0; d < 2; ++d)
#pragma unroll
                for (int r = 0; r < 16; ++r) SO[(32 * ri + crow(r, hi)) * 128 + 32 * (2 * dh + d) + r32] = sacc[d][r]; }
    }
#undef SC_TOK
#undef SC_BAR
#undef SC_LOADRAW
#undef SC_LOADGK
#undef UNPK
#undef SC_RD8
#undef SC_LWAIT
#undef SC_OBLK
#undef SC_SBLK
    if (F.G == 256 && F.bid >= 128) { if (li == 0) setup_work(F, P, F.bid - 128, 128, 0x2, 0x2, 0x0, 0x0, 0x1); else setup_work(F, P, F.bid - 128, 128, 0x8, 0x8, 0x0, 0x0, 0x2); }
    else if (F.G != 256) { if (li == 0) setup_work(F, P, F.bid, F.G, 0x2, 0x2, 0x0, 0x0, 0x1); else setup_work(F, P, F.bid, F.G, 0x8, 0x8, 0x0, 0x0, 0x2); }
}
__device__ __forceinline__ void scan_combine(Frame& F, const Params& P, int li) {
    unsigned char* ws = PWS;
    const char* PROJ = (const char*)(ws + WS_BIG); const char* OF = (const char*)(ws + WS_Y); char* OB = (char*)(ws + WS_HB);
    const int gw = F.vcu * NWAVES + F.wave, NGW = F.G * NWAVES, lane = F.lane, hh = lane >> 3, dv = (lane & 7) * 16;
    f32x4 gn[4];
    { const float* gp_ = PIN(I_GLAN) + li * 128 + dv;
#pragma unroll
      for (int j = 0; j < 4; ++j) gn[j] = hh < 4 ? *(const f32x4*)(gp_ + 4 * j) : (f32x4){1.f, 1.f, 1.f, 1.f}; }
    const unsigned gcol = (unsigned)((hh < 4 ? PC_GA : PC_GB) + (hh & 3) * 128 + dv) * 2u, ocol = (unsigned)(hh * 128 + dv) * 2u;
#define CB_LOAD(S, r_) do { const unsigned off = (unsigned)(r_) * (unsigned)(D * 2) + ocol, goff = (unsigned)(r_) * (unsigned)(EVEN_NP * 2) + gcol; \
        S[0] = __builtin_nontemporal_load((const v4u*)(OF + off)); S[1] = __builtin_nontemporal_load((const v4u*)(OF + off + 16)); S[2] = __builtin_nontemporal_load((const v4u*)(OB + off)); S[3] = __builtin_nontemporal_load((const v4u*)(OB + off + 16)); \
        S[4] = __builtin_nontemporal_load((const v4u*)(PROJ + goff)); S[5] = __builtin_nontemporal_load((const v4u*)(PROJ + goff + 16)); } while (0)
#define CB_PROC(S, r_) do { const unsigned off = (unsigned)(r_) * (unsigned)(D * 2) + ocol; float x[16], gg[16]; \
        _Pragma("unroll") for (int hf = 0; hf < 2; ++hf) _Pragma("unroll") for (int e = 0; e < 4; ++e) { x[8 * hf + 2 * e] = bflo(S[hf][e]) + bflo(S[2 + hf][e]); x[8 * hf + 2 * e + 1] = bfhi(S[hf][e]) + bfhi(S[2 + hf][e]); \
            gg[8 * hf + 2 * e] = bflo(S[4 + hf][e]); gg[8 * hf + 2 * e + 1] = bfhi(S[4 + hf][e]); } \
        float ss = 0.f; _Pragma("unroll") for (int e = 0; e < 16; ++e) ss += x[e] * x[e]; \
        ss += __shfl_xor(ss, 1); ss += __shfl_xor(ss, 2); ss += __shfl_xor(ss, 4); \
        const float rstd = __builtin_amdgcn_rsqf(ss * (1.0f / 128.0f) + EPS); \
        _Pragma("unroll") for (int e = 0; e < 16; ++e) x[e] = x[e] * rstd * gn[e >> 2][e & 3] * siluf(gg[e]); \
        *(v4u*)(OB + off) = (v4u){pk2(x[0], x[1]), pk2(x[2], x[3]), pk2(x[4], x[5]), pk2(x[6], x[7])}; \
        *(v4u*)(OB + off + 16) = (v4u){pk2(x[8], x[9]), pk2(x[10], x[11]), pk2(x[12], x[13]), pk2(x[14], x[15])}; } while (0)
    if (NGW * 10 == M) {
        v4u A0[6], A1[6], B0[6], B1[6];
        CB_LOAD(A0, gw); CB_LOAD(A1, gw + NGW);
#pragma unroll
        for (int k = 0; k < 10; k += 4) {
            if (k + 2 < 10) { CB_LOAD(B0, gw + (k + 2) * NGW); CB_LOAD(B1, gw + (k + 3) * NGW); }
            CB_PROC(A0, gw + k * NGW); CB_PROC(A1, gw + (k + 1) * NGW);
            if (k + 4 < 10) { CB_LOAD(A0, gw + (k + 4) * NGW); CB_LOAD(A1, gw + (k + 5) * NGW); }
            if (k + 2 < 10) { CB_PROC(B0, gw + (k + 2) * NGW); CB_PROC(B1, gw + (k + 3) * NGW); }
        }
    } else {
        for (int row = gw; row < M; row += NGW) { v4u A0[6]; CB_LOAD(A0, row); CB_PROC(A0, row); }
    }
#undef CB_LOAD
#undef CB_PROC
}

__device__ __forceinline__ void cache_pass(Frame& F, const Params& P, int li, int wgi, int nwg) {
    unsigned char* ws = PWS;
    const int gt = wgi * 512 + F.tid, NGT = nwg * 512;
    const float* cckv_ = PIN(I_CCKV); const float* ckpe_ = PIN(I_CKPE);
    for (int i = gt; i < 8 * 256 * 32; i += NGT) { const int c8 = i & 31, t = (i >> 5) & 255, b = i >> 13;
        const float* s = cckv_ + ((size_t)((b * 2 + li) * 256 + t) * 32 + c8) * 8; const f32x4 a = *(const f32x4*)s, c = *(const f32x4*)(s + 4);
        *(GAS v4u*)((bf16*)(ws + WS_ACKV) + ((size_t)4096 + b * LKV + t) * 256 + c8 * 8) = (v4u){pk2(a[0], a[1]), pk2(a[2], a[3]), pk2(c[0], c[1]), pk2(c[2], c[3])}; }
    for (int i = gt; i < 8 * 256 * 8; i += NGT) { const int c8 = i & 7, t = (i >> 3) & 255, b = i >> 11;
        const float* s = ckpe_ + ((size_t)((b * 2 + li) * 256 + t) * 8 + c8) * 8; const f32x4 a = *(const f32x4*)s, c = *(const f32x4*)(s + 4);
        *(GAS v4u*)((bf16*)(ws + WS_KPE) + ((size_t)4096 + b * LKV + t) * 64 + c8 * 8) = (v4u){pk2(a[0], a[1]), pk2(a[2], a[3]), pk2(c[0], c[1]), pk2(c[2], c[3])}; }
}
__device__ __forceinline__ void kpe_pass(Frame& F, const Params& P, int li, int wgi, int nwg) {
    unsigned char* ws = PWS;
    const float* KR = (const float*)(ws + WS_Y); const float* ROPE = (const float*)(ws + WS_ROPE);
    bf16* KPE = (bf16*)(ws + WS_KPE);
    const int gt = wgi * 512 + F.tid, NGT = nwg * 512;
    for (int i = gt; i < M * 4; i += NGT) {
        const int row = i >> 2, c8 = i & 3;
        const float* s = KR + (size_t)row * 64 + 8 * c8;
        f32x4 a0 = *(const f32x4*)s, a1 = *(const f32x4*)(s + 4), b0 = *(const f32x4*)(s + 32), b1 = *(const f32x4*)(s + 36);
        int drow = row;
        if (row >= M_CTX) { const int lb = (row - M_CTX) >> 11, t = (row - M_CTX) & 2047; drow = M_CTX + lb * LKV + PAST + t;
            const float* cp = ROPE + (size_t)t * 32 + 8 * c8; const float* sp = cp + 65536;
            const f32x4 c0 = *(const f32x4*)cp, c1 = *(const f32x4*)(cp + 4), s0 = *(const f32x4*)sp, s1 = *(const f32x4*)(sp + 4);
            const f32x4 x0 = a0 * c0 - b0 * s0, x1 = a1 * c1 - b1 * s1, y0 = a0 * s0 + b0 * c0, y1 = a1 * s1 + b1 * c1;
            a0 = x0; a1 = x1; b0 = y0; b1 = y1; }
        bf16* d = KPE + (size_t)drow * 64 + 8 * c8;
        *(v4u*)d = (v4u){pk2(a0[0], a0[1]), pk2(a0[2], a0[3]), pk2(a1[0], a1[1]), pk2(a1[2], a1[3])};
        *(v4u*)(d + 32) = (v4u){pk2(b0[0], b0[1]), pk2(b0[2], b0[3]), pk2(b1[0], b1[1]), pk2(b1[2], b1[3])};
    }
}

constexpr float ATT_SCALE = 0.07216878364870322f;
constexpr float ATT_THR = 8.f;
constexpr int AT_V = 0, AT_KN = 49152, AT_KP = 98304, AT_WS = 122880, AT_VB = 16384, AT_KNB = 16384, AT_KPB = 8192;
#define KSWZ(row, colB) ((row) * 256 + ((colB) ^ (((row) & 7) << 4)))
#define KPSWZ(row, colB) ((row) * 128 + ((colB) ^ (((row) & 7) << 4)))
__device__ __forceinline__ void at_partialSM(f32x16& p0, f32x16& p1, float& m_reg, float& mn, float& alpha) {
    constexpr float C = ATT_SCALE * 1.4426950408889634f;
    float pmax = p0[0];
#pragma unroll
    for (int r = 1; r < 16; ++r) pmax = fmaxf(pmax, p0[r]);
#pragma unroll
    for (int r = 0; r < 16; ++r) pmax = fmaxf(pmax, p1[r]);
    { auto rr = __builtin_amdgcn_permlane32_swap(__float_as_uint(pmax), __float_as_uint(pmax), false, false); pmax = fmaxf(__uint_as_float(rr[0]), __uint_as_float(rr[1])); }
    if (__builtin_expect(__all(pmax - m_reg <= ATT_THR / ATT_SCALE), 1)) { mn = m_reg; alpha = 1.f; }
    else { mn = fmaxf(m_reg, pmax); alpha = __builtin_amdgcn_exp2f((m_reg - mn) * C); m_reg = mn; }
    const float mnC = -mn * C;
#pragma unroll
    for (int r = 0; r < 16; ++r) p0[r] = fmaf(p0[r], C, mnC);
#pragma unroll
    for (int r = 0; r < 16; ++r) p1[r] = fmaf(p1[r], C, mnC);
#pragma unroll
    for (int r = 0; r < 16; ++r) p0[r] = __builtin_amdgcn_exp2f(p0[r]);
}
__device__ __forceinline__ void at_finishSM(f32x16& p0, f32x16& p1, float alpha, float& l_reg, bf16x8& pa0, bf16x8& pa1, bf16x8& pa2, bf16x8& pa3) {
#pragma unroll
    for (int r = 0; r < 16; ++r) p1[r] = __builtin_amdgcn_exp2f(p1[r]);
    float ps = 0;
#pragma unroll
    for (int r = 0; r < 16; ++r) ps += p0[r];
#pragma unroll
    for (int r = 0; r < 16; ++r) ps += p1[r];
    { auto rr = __builtin_amdgcn_permlane32_swap(__float_as_uint(ps), __float_as_uint(ps), false, false); ps = __uint_as_float(rr[0]) + __uint_as_float(rr[1]); }
    l_reg = l_reg * alpha + ps;
    PK4(p0, 0, pa0); PK4(p0, 8, pa1); PK4(p1, 0, pa2); PK4(p1, 8, pa3);
}
__device__ __forceinline__ void at_qkt(f32x16& p0, f32x16& p1, const LAS unsigned char* Kn, const LAS unsigned char* Kp, const bf16x8* qr, const int* kb, const int* pb) {
    p0 = f32x16{}; p1 = f32x16{};
#pragma unroll
    for (int d0 = 0; d0 < 8; ++d0) {
        const bf16x8 b0 = *(const LAS bf16x8*)(Kn + kb[d0 & 3] + 128 * (d0 >> 2)), b1 = *(const LAS bf16x8*)(Kn + kb[d0 & 3] + 128 * (d0 >> 2) + 8192);
        p0 = __builtin_amdgcn_mfma_f32_32x32x16_bf16(b0, qr[d0], p0, 0, 0, 0);
        p1 = __builtin_amdgcn_mfma_f32_32x32x16_bf16(b1, qr[d0], p1, 0, 0, 0); }
#pragma unroll
    for (int d0 = 0; d0 < 4; ++d0) {
        const bf16x8 b0 = *(const LAS bf16x8*)(Kp + pb[d0]), b1 = *(const LAS bf16x8*)(Kp + pb[d0] + 4096);
        p0 = __builtin_amdgcn_mfma_f32_32x32x16_bf16(b0, qr[8 + d0], p0, 0, 0, 0);
        p1 = __builtin_amdgcn_mfma_f32_32x32x16_bf16(b1, qr[8 + d0], p1, 0, 0, 0); }
}
template <int D0> __device__ __forceinline__ void at_pv_one(f32x16& od, unsigned vb, bf16x8 pa0, bf16x8 pa1, bf16x8 pa2, bf16x8 pa3) {
    const s16x4 l0 = tr_read<D0 * 512>(vb), h0 = tr_read<D0 * 512 + 2048>(vb), l1 = tr_read<D0 * 512 + 4096>(vb), h1 = tr_read<D0 * 512 + 4096 + 2048>(vb);
    const s16x4 l2 = tr_read<D0 * 512 + 8192>(vb), h2 = tr_read<D0 * 512 + 8192 + 2048>(vb), l3 = tr_read<D0 * 512 + 12288>(vb), h3 = tr_read<D0 * 512 + 12288 + 2048>(vb);
    asm volatile("s_waitcnt lgkmcnt(0)" ::: "memory"); SBAR();
    od = __builtin_amdgcn_mfma_f32_32x32x16_bf16(pa0, PKF(l0, h0), od, 0, 0, 0);
    od = __builtin_amdgcn_mfma_f32_32x32x16_bf16(pa1, PKF(l1, h1), od, 0, 0, 0);
    od = __builtin_amdgcn_mfma_f32_32x32x16_bf16(pa2, PKF(l2, h2), od, 0, 0, 0);
    od = __builtin_amdgcn_mfma_f32_32x32x16_bf16(pa3, PKF(l3, h3), od, 0, 0, 0);
}
__device__ __forceinline__ void at_pv(f32x16* o, unsigned vb, bf16x8 pa0, bf16x8 pa1, bf16x8 pa2, bf16x8 pa3) {
    at_pv_one<0>(o[0], vb, pa0, pa1, pa2, pa3); at_pv_one<1>(o[1], vb, pa0, pa1, pa2, pa3); at_pv_one<2>(o[2], vb, pa0, pa1, pa2, pa3); at_pv_one<3>(o[3], vb, pa0, pa1, pa2, pa3);
}
__device__ __forceinline__ void attn_unit(Frame& F, const bf16* Qrow0  , const bf16* KVh  , const bf16* KPEs  ,
                                          bf16* Orow0, int nkeys, const float* ROPE, int tpos0  ) {
    LAS unsigned char* lds = F.lds;
    const int tid = F.tid, wid = F.wave, lane = F.lane, r32 = lane & 31, hi = lane >> 5;
    LAS float* wsf = (LAS float*)(lds + AT_WS) + wid * 64; LAS float* li_l = wsf; LAS float* al_l = wsf + 32;
    float m_reg = -1e30f, l_reg = 0; f32x16 o[4] = {}; bf16x8 qr[12];
    { const bf16* Qw = Qrow0 + (size_t)(wid * 32 + r32) * 1536 + hi * 8;
#pragma unroll
      for (int d0 = 0; d0 < 12; ++d0) qr[d0] = *(const bf16x8*)(Qw + d0 * 16);
      if (tpos0 >= 0) {
          const int t = tpos0 + wid * 32 + r32;
#pragma unroll
          for (int half = 0; half < 2; ++half) {
              const float* cp = ROPE + (size_t)t * 32 + 16 * half + 8 * hi; const float* sp = cp + 65536;
              const v4u xa = __builtin_bit_cast(v4u, qr[8 + half]), xb = __builtin_bit_cast(v4u, qr[10 + half]);
              float x1[8], x2[8];
              x1[0] = bflo(xa.x); x1[1] = bfhi(xa.x); x1[2] = bflo(xa.y); x1[3] = bfhi(xa.y); x1[4] = bflo(xa.z); x1[5] = bfhi(xa.z); x1[6] = bflo(xa.w); x1[7] = bfhi(xa.w);
              x2[0] = bflo(xb.x); x2[1] = bfhi(xb.x); x2[2] = bflo(xb.y); x2[3] = bfhi(xb.y); x2[4] = bflo(xb.z); x2[5] = bfhi(xb.z); x2[6] = bflo(xb.w); x2[7] = bfhi(xb.w);
              float y1[8], y2[8];
#pragma unroll
              for (int j = 0; j < 8; ++j) { const float c = cp[j], s = sp[j]; y1[j] = x1[j] * c - x2[j] * s; y2[j] = x1[j] * s + x2[j] * c; }
              const v4u wa = {pk2(y1[0], y1[1]), pk2(y1[2], y1[3]), pk2(y1[4], y1[5]), pk2(y1[6], y1[7])}, wb = {pk2(y2[0], y2[1]), pk2(y2[2], y2[3]), pk2(y2[4], y2[5]), pk2(y2[6], y2[7])};
              if (half == 0) { qr[8] = __builtin_bit_cast(bf16x8, wa); qr[10] = __builtin_bit_cast(bf16x8, wb); } else { qr[9] = __builtin_bit_cast(bf16x8, wa); qr[11] = __builtin_bit_cast(bf16x8, wb); }
          }
      } }
    const unsigned vb0 = (unsigned)(uintptr_t)(lds + AT_V) + v_rd_base(lane);
#define AT_OPQ() int l_ = lane; asm volatile("" : "+v"(l_))
#define AT_KADDR() int kbs[4], pbs[4]; { AT_OPQ(); _Pragma("unroll") for (int b = 0; b < 4; ++b) { const int x = (32 * b + 16 * (l_ >> 5)) ^ ((l_ & 7) << 4); kbs[b] = (l_ & 31) * 256 + x; pbs[b] = (l_ & 31) * 128 + x; } }
#define AT_GLDS(gp, ldsoff) __builtin_amdgcn_global_load_lds((const unsigned*)(gp), (LAS unsigned*)(lds + (ldsoff)), 16, 0, 0)
#define AT_DMA_K(t, b) do { AT_OPQ(); const char* kb_ = (const char*)KVh + (size_t)(t) * (64 * 4096); const char* pb_ = (const char*)KPEs + (size_t)(t) * (64 * 128); \
    const int row0_ = 4 * wid + (l_ >> 4), cB0_ = ((l_ & 15) * 16) ^ ((row0_ & 7) << 4), row1_ = row0_ + 32, rowp_ = 8 * wid + (l_ >> 3), cBp_ = ((l_ & 7) * 16) ^ ((rowp_ & 7) << 4); \
    AT_GLDS(kb_ + (unsigned)(row0_ * 4096 + cB0_), AT_KN + (b) * AT_KNB + wid * 1024); AT_GLDS(kb_ + (unsigned)(row1_ * 4096 + cB0_), AT_KN + (b) * AT_KNB + (wid + 8) * 1024); \
    AT_GLDS(pb_ + (unsigned)(rowp_ * 128 + cBp_), AT_KP + (b) * AT_KPB + wid * 1024); } while (0)
#define AT_DMA_V(t, b) do { AT_OPQ(); const char* vb_ = (const char*)KVh + (size_t)(t) * (64 * 4096); \
    const int st_ = 2 * wid + (l_ >> 5), kk_ = (st_ >> 2) * 8 + ((l_ & 31) >> 2), key_ = (kk_ & ~0xC) | ((kk_ & 4) << 1) | ((kk_ & 8) >> 1), col_ = (st_ & 3) * 32 + (l_ & 3) * 8; \
    AT_GLDS(vb_ + (unsigned)(key_ * 4096 + (128 + col_) * 2), AT_V + (b) * AT_VB + wid * 1024); AT_GLDS(vb_ + (unsigned)((key_ + 32) * 4096 + (128 + col_) * 2), AT_V + (b) * AT_VB + (wid + 8) * 1024); } while (0)
#define AT_RESC(a) do { if (__any((a) < 1.f)) { if (hi == 0) al_l[r32] = (a); asm volatile("s_waitcnt lgkmcnt(0)" ::: "memory"); \
    _Pragma("unroll") for (int d = 0; d < 4; ++d) _Pragma("unroll") for (int r = 0; r < 16; ++r) o[d][r] *= al_l[crow(r, hi)]; } } while (0)
#define AT_WAITBAR(N) do { asm volatile("s_waitcnt vmcnt(" #N ") lgkmcnt(0)" ::: "memory"); __builtin_amdgcn_s_barrier(); asm volatile("" ::: "memory"); } while (0)
    f32x16 pA0, pA1, pB0, pB1; float mnA, mnB, alA, alB; bf16x8 pa0, pa1, pa2, pa3; const int NT = nkeys / 64;
    AT_DMA_K(0, 0); AT_DMA_K(1, 1); AT_DMA_V(0, 0); AT_WAITBAR(0);
    int s = 0;
#define AT_S1 (s == 2 ? 0 : s + 1)
#define AT_S2 (s == 0 ? 2 : s - 1)
#define AT_STEP(CUR0, CUR1, MNC, ALC, PRV0, PRV1, ALP, t, MODE) do { \
        if (MODE == 2) { AT_DMA_K((t) + 2, AT_S2); } if (MODE >= 1) { AT_DMA_V((t) + 1, AT_S1); } \
        SBAR(); { AT_KADDR(); at_qkt(CUR0, CUR1, lds + AT_KN + s * AT_KNB, lds + AT_KP + s * AT_KPB, qr, kbs, pbs); } \
        at_finishSM(PRV0, PRV1, ALP, l_reg, pa0, pa1, pa2, pa3); SBAR(); \
        at_pv(o, vb0 + AT_S2 * AT_VB, pa0, pa1, pa2, pa3); at_partialSM(CUR0, CUR1, m_reg, MNC, ALC); \
        AT_RESC(ALC); if (MODE == 2) AT_WAITBAR(5); else if (MODE == 1) AT_WAITBAR(2); else AT_WAITBAR(0); s = AT_S1; } while (0)
    AT_DMA_K(2, 2); AT_DMA_V(1, 1);
    { AT_KADDR(); at_qkt(pA0, pA1, lds + AT_KN, lds + AT_KP, qr, kbs, pbs); } at_partialSM(pA0, pA1, m_reg, mnA, alA);
    AT_WAITBAR(5); s = 1;
    int t = 1;
    for (; t + 4 < NT; t += 2) {
        AT_STEP(pB0, pB1, mnB, alB, pA0, pA1, alA, t, 2);
        AT_STEP(pA0, pA1, mnA, alA, pB0, pB1, alB, t + 1, 2);
    }
    AT_STEP(pB0, pB1, mnB, alB, pA0, pA1, alA, NT - 3, 2);
    AT_STEP(pA0, pA1, mnA, alA, pB0, pB1, alB, NT - 2, 1);
    AT_STEP(pB0, pB1, mnB, alB, pA0, pA1, alA, NT - 1, 0);
    at_finishSM(pB0, pB1, alB, l_reg, pa0, pa1, pa2, pa3); SBAR();
    at_pv(o, vb0 + AT_S2 * AT_VB, pa0, pa1, pa2, pa3);
    if (hi == 0) li_l[r32] = l_reg; asm volatile("s_waitcnt lgkmcnt(0)" ::: "memory");
    float rli[16];
#pragma unroll
    for (int r = 0; r < 16; ++r) rli[r] = __builtin_amdgcn_rcpf(li_l[crow(r, hi)]);
    bf16* Ow = Orow0 + (size_t)(wid * 32) * D;
#pragma unroll
    for (int r = 0; r < 16; r += 2) { const int orow = crow(r, hi);
#pragma unroll
        for (int d0 = 0; d0 < 4; ++d0) { const unsigned w = pk2(o[d0][r] * rli[r], o[d0][r + 1] * rli[r + 1]);
            Ow[(size_t)orow * D + d0 * 32 + r32] = (bf16)w; Ow[(size_t)(orow + 1) * D + d0 * 32 + r32] = (bf16)(w >> 16); } }
#undef AT_GLDS
#undef AT_OPQ
#undef AT_KADDR
#undef AT_DMA_K
#undef AT_DMA_V
#undef AT_RESC
#undef AT_WAITBAR
#undef AT_S1
#undef AT_S2
#undef AT_STEP
}
__device__ __forceinline__ void attn_phase(Frame& F, const Params& P, int li) {
    unsigned char* ws = PWS;
    const bf16* Q = (const bf16*)(ws + WS_Q); const bf16* KV = (const bf16*)(ws + WS_KV); const bf16* KPE = (const bf16*)(ws + WS_KPE);
    bf16* OB = (bf16*)(ws + WS_HB); const float* ROPE = (const float*)(ws + WS_ROPE);
    for (int u = F.vcu; u < 256 + 128; u += F.G) {
        for (int k = 0; k < 2; ++k) {
            int qrow0, kvrow0, nkeys, h, tpos0;
            if (u < 256) { const int id = 2 * u + k, lb = id >> 6, qb = id & 7; h = (id >> 3) & 7; qrow0 = M_CTX + lb * L_LAT + qb * 256; kvrow0 = M_CTX + lb * LKV; nkeys = LKV; tpos0 = qb * 256; }
            else { if (k == 1) break; const int id = u - 256, b = id >> 3; h = id & 7; qrow0 = b * L_CTX; kvrow0 = b * L_CTX; nkeys = L_CTX; tpos0 = -1; }
            __syncthreads();
            attn_unit(F, Q + (size_t)qrow0 * 1536 + h * 192, KV + (size_t)kvrow0 * 2048 + h * 256, KPE + (size_t)kvrow0 * 64, OB + (size_t)qrow0 * D + h * 128, nkeys, ROPE, tpos0);
        }
    }
}

constexpr int N_PHASES = 2 + 2 * 16;
__global__ void __launch_bounds__(NWAVES * 64, 2) hyb_fwd(Params P) {
    extern __shared__ __attribute__((aligned(16))) unsigned char lds_raw[];
    Frame F;
    F.lds = (LAS unsigned char*)lds_raw;
    F.tid = threadIdx.x; F.lane = F.tid & 63; F.wave = __builtin_amdgcn_readfirstlane(F.tid >> 6);
    F.G = gridDim.x; { const int bx = blockIdx.x; F.vcu = (F.G % 8 == 0) ? (bx % 8) * (F.G / 8) + bx / 8 : bx; }
    volatile LAS unsigned* MISC = (volatile LAS unsigned*)(F.lds + LDS_MISC);
    if (F.tid < 64) MISC[F.tid] = 0u;
    __syncthreads();
    const int use_bar = P.use_bar, ph_hi = P.ph_hi;
    XcdBarrier bar; bar.bar = (unsigned*)(PWS + WS_CTL) + 4096; bar.x = 0; bar.st = nullptr;
    if (use_bar) bar = xcd_barrier_post((unsigned*)(PWS + WS_CTL) + 4096, MISC + 8);

    for (int ph = P.ph_lo; ph < ph_hi; ++ph) {
#define REFRESH_ID() do { int t_ = threadIdx.x; asm volatile("" : "+v"(t_)); F.tid = t_; F.lane = t_ & 63; F.wave = __builtin_amdgcn_readfirstlane(t_ >> 6); \
          int g_ = gridDim.x, b_ = blockIdx.x; asm volatile("" : "+s"(g_), "+s"(b_)); F.G = g_; F.vcu = (g_ % 8 == 0) ? (b_ % 8) * (g_ / 8) + b_ / 8 : b_; F.bid = b_; } while (0)
        REFRESH_ID();
        unsigned char* ws = PWS;
        bf16* XBF = (bf16*)(POUT + OUT_Y);
        bf16* HB = (bf16*)(ws + WS_HB); bf16* YB = (bf16*)(ws + WS_Y); const bf16* SL = (const bf16*)(ws + WS_SLAB);
        const float* MOD = (const float*)(ws + WS_MOD);
#ifdef HYB_PHPROBE
        if (F.tid == 0) { int pk_ = ph == 0 ? 20 : 21;
            if (ph >= 2) { const int q_ = ph - 2, r_ = q_ % 16; const bool o_ = r_ >= 8; const int k_ = o_ ? r_ - 8 : r_; pk_ = k_ < 3 ? (o_ ? 10 + k_ : (k_ == 2 ? 8 : k_)) : (k_ == 3 ? 2 : k_ == 4 ? 3 : k_ == 5 ? 4 : k_ == 6 ? 5 : 6); }
            const unsigned now_ = (unsigned)__builtin_amdgcn_s_memrealtime(); if (MISC[58]) MISC[60] += now_ - MISC[57]; MISC[57] = now_; MISC[58] = ((HYB_PHPROBE) >> pk_) & 1; }
#endif
        if (ph == 0) { p0_prologue(F, P); }
        else if (ph == 1) {
            const float* m0 = MOD;
            if (F.G == 256) row_pass_f32<false>(F, PIN(I_XP), PIN(I_XS), nullptr, nullptr, nullptr, nullptr, nullptr, PIN(I_NMIXPRE), m0 + 1024, m0, HB);
            else row_pass(F, PIN(I_XP), PIN(I_XS), true, nullptr, nullptr, nullptr, nullptr, nullptr, PIN(I_NMIXPRE), m0 + 1024, m0, HB, false, true);
        } else {
            const int q = ph - 2, pair = q / 16, r = q % 16; const bool odd = r >= 8; const int l = 2 * pair + (odd ? 1 : 0), k = odd ? r - 8 : r;
            const float* ml = MOD + (size_t)l * 9 * 6144;
            const int kind = k < 3 ? (odd ? 10 + k : (k == 2 ? 8 : k)) : (k == 3 ? 2 : k == 4 ? 3 : k == 5 ? 4 : k == 6 ? 5 : 6);
            if (kind == 0) {
                pg8::Gemm g{HB, (const bf16*)(ws + WS_WINE) + (size_t)pair * EVEN_NP * 1024, M, EVEN_NP, 1024}; pg8::EvenInOrder S; S.init(F.G, F.bid);
                pg8::EpiProj E{(bf16*)(ws + WS_BIG), EVEN_NP};
                pg8::gemm_phase<pg8::EpiProj, pg8::EvenInOrder, true, true>(F.lds, g, S, E, F.tid, PWS + WS_CTL + 512 * 1024);
            } else if (kind == 1) {
                scan_phase(F, P, pair);
            } else if (kind == 8) {
                scan_combine(F, P, pair);
            } else if (kind == 2) {
                const bf16* W = odd ? (const bf16*)(ws + WS_WOUTO) + (size_t)pair * 1024 * 1024 : (const bf16*)(ws + WS_WOUTE) + (size_t)pair * 1024 * 1024;
                pg8::Gemm g{HB, W, M, 1024, 1024}; pg8::TailSplitOrder S; S.init(F.bid, 1024, 0);
                pg8::EpiYsplit E{YB, (bf16*)(ws + WS_SLAB)};
                pg8::gemm_phase<pg8::EpiYsplit, pg8::TailSplitOrder, true, true>(F.lds, g, S, E, F.tid, PWS + WS_CTL + 512 * 1024);
            } else if (kind == 3) {
                if (l == 0 && F.G == 256) row_pass_f32<true>(F, PIN(I_XP), PIN(I_XS), XBF, YB, SL, PIN(I_NMIXPOST) + l * 1024, ml + 2048, PIN(I_NMLPPRE) + l * 1024, ml + 4096, ml + 3072, HB);
                else if (l != 0 && F.G == 256) row_pass_mid(F, XBF, YB, SL, PIN(I_NMIXPOST) + l * 1024, ml + 2048, PIN(I_NMLPPRE) + l * 1024, ml + 4096, ml + 3072, HB);
                else row_pass(F, PIN(I_XP), PIN(I_XS), l == 0, XBF, YB, SL, PIN(I_NMIXPOST) + l * 1024, ml + 2048, PIN(I_NMLPPRE) + l * 1024, ml + 4096, ml + 3072, HB, true, true);
            } else if (kind == 4) {
                pg8::Gemm g{HB, (const bf16*)(ws + WS_W1) + (size_t)l * 4096 * 1024, M, FF, 1024}; pg8::StaticOrder S; S.init(M, FF, F.G, F.bid, 1024);
                pg8::EpiBf16<1> E{(bf16*)(ws + WS_BIG), FF};
#ifdef HYB_CLKPROBE
                __builtin_amdgcn_s_barrier();
                if (F.tid == 0) { const unsigned long long c0 = __builtin_readcyclecounter(), r0 = __builtin_amdgcn_s_memrealtime(); MISC[56] = (unsigned)c0; MISC[57] = (unsigned)r0; }
#endif
                pg8::gemm_phase<pg8::EpiBf16<1>, pg8::StaticOrder, true, true>(F.lds, g, S, E, F.tid, PWS + WS_CTL + 512 * 1024);
#ifdef HYB_CLKPROBE
                if (F.tid == 0) { const unsigned long long c1 = __builtin_readcyclecounter(), r1 = __builtin_amdgcn_s_memrealtime(); MISC[60] += (unsigned)c1 - MISC[56]; MISC[61] += (unsigned)r1 - MISC[57]; }
#endif
            } else if (kind == 5) {
                pg8::Gemm g{(const bf16*)(ws + WS_BIG), (const bf16*)(ws + WS_W2) + (size_t)l * 1024 * 4096, M, 1024, FF}; pg8::TailSplitOrder S; S.init(F.bid, FF, 0);
                pg8::EpiYsplit E{YB, (bf16*)(ws + WS_SLAB)};
                pg8::gemm_phase<pg8::EpiYsplit, pg8::TailSplitOrder, true, true>(F.lds, g, S, E, F.tid, PWS + WS_CTL + 512 * 1024);
            } else if (kind == 6) {
                const float* mn = ml + 9 * 6144;
                if (l < 3 && F.G == 256) row_pass_mid(F, XBF, YB, SL, PIN(I_NMLPPOST) + l * 1024, ml + 5120, PIN(I_NMIXPRE) + (l + 1) * 1024, mn + 1024, mn, HB);
                else if (l < 3) row_pass(F, nullptr, nullptr, false, XBF, YB, SL, PIN(I_NMLPPOST) + l * 1024, ml + 5120, PIN(I_NMIXPRE) + (l + 1) * 1024, mn + 1024, mn, HB, true, true);
                else { bar.bar = (unsigned*)(PWS + WS_CTL) + 4096; if (F.G == 256) row_pass_final2(F, bar, XBF, POUT + OUT_Y, YB, SL, PIN(I_NMLPPOST) + l * 1024, ml + 5120);
                       else row_pass_final(F, bar, XBF, POUT + OUT_Y, YB, SL, PIN(I_NMLPPOST) + l * 1024, ml + 5120); }
            } else if (kind == 10) {
                pg8::Gemm g{HB, (const bf16*)(ws + WS_WINO) + (size_t)pair * ODD_NP * 1024, M, ODD_NP, 1024}; pg8::StaticOrder S; S.init(M, ODD_NP, F.G, F.bid, 1024);
                pg8::EpiOddIn E{(bf16*)(ws + WS_QN), (bf16*)(ws + WS_ACKV), (float*)(ws + WS_Y), POUT + OUT_CKV, POUT + OUT_KPE,
                                PIN(I_QAN) + pair * 256, PIN(I_KVAN) + pair * 256, pair};
                pg8::gemm_phase<pg8::EpiOddIn, pg8::StaticOrder, false, true>(F.lds, g, S, E, F.tid, PWS + WS_CTL + 512 * 1024);
                REFRESH_ID();
                if (F.G == 256) { if (F.bid >= 240) cache_pass(F, P, pair, F.bid - 240, 16); }
                else cache_pass(F, P, pair, F.vcu, F.G);
            } else if (kind == 11) {
                if (F.G != 256) { kpe_pass(F, P, pair, F.vcu, F.G); REFRESH_ID(); }
                { pg8::Gemm g{(const bf16*)(ws + WS_QN), (const bf16*)(ws + WS_WQB) + (size_t)pair * 1536 * 256, M, 1536, 256}; pg8::StaticOrder S; S.init(M, 1536, F.G, F.bid, 256);
                  pg8::EpiBf16<0> E{(bf16*)(ws + WS_Q), 1536};
                  pg8::gemm_phase<pg8::EpiBf16<0>, pg8::StaticOrder, true, true>(F.lds, g, S, E, F.tid, PWS + WS_CTL + 512 * 1024); }
                REFRESH_ID();
                { pg8::Gemm g{(const bf16*)(ws + WS_ACKV), (const bf16*)(ws + WS_WKVB) + (size_t)pair * 2048 * 256, MKV, 2048, 256}; pg8::StaticOrder S; S.init(MKV, 2048, F.G, F.bid, 256);
                  pg8::EpiBf16<0> E{(bf16*)(ws + WS_KV), 2048};
                  pg8::gemm_phase<pg8::EpiBf16<0>, pg8::StaticOrder, true, true>(F.lds, g, S, E, F.tid, PWS + WS_CTL + 512 * 1024); }
                if (F.G == 256 && F.bid >= 192) { REFRESH_ID(); kpe_pass(F, P, pair, F.bid - 192, 64); }
            } else if (kind == 12) {
                attn_phase(F, P, pair);
            }
        }
        if (ph + 1 < ph_hi) { if (use_bar) { bar.bar = (unsigned*)(PWS + WS_CTL) + 4096; xcd_barrier(bar); } else { VM_WAIT(); __syncthreads(); } }
    }
#ifdef HYB_PHPROBE
    if (blockIdx.x == 0 && threadIdx.x == 0) {
        unsigned now_ = (unsigned)__builtin_amdgcn_s_memrealtime(); if (MISC[58]) MISC[60] += now_ - MISC[57];
        #ifndef HYB_PHMULT
#define HYB_PHMULT 1
#endif
        const unsigned long long spin = (unsigned long long)MISC[60] * HYB_PHMULT; const unsigned long long t0 = __builtin_amdgcn_s_memrealtime();
        while (__builtin_amdgcn_s_memrealtime() - t0 < spin) __builtin_amdgcn_s_sleep(8);
    }
#endif
#ifdef HYB_CLKPROBE
    if (blockIdx.x == 0 && threadIdx.x == 0) {
        const unsigned c = MISC[60], r = MISC[61]; const unsigned long long spin = (unsigned long long)c * (unsigned long long)(HYB_CLKPROBE) / (r ? r : 1u);
        const unsigned long long t0 = __builtin_amdgcn_s_memrealtime();
        while (__builtin_amdgcn_s_memrealtime() - t0 < spin) __builtin_amdgcn_s_sleep(8);
    }
#endif
}

extern "C" void kernel_launch(void* const* d_in, const int* in_sizes, int n_in, void* d_out, int out_size, void* d_ws, size_t ws_size, hipStream_t stream) {
    static int grid = 0;
    if (grid == 0) {
        if (n_in != 28 || out_size != 27787264 || ws_size < WS_END) { fprintf(stderr, "kernel_launch: unexpected shapes: n_in %d out %d ws %zu (need >= %zu)\n", n_in, out_size, ws_size, (size_t)WS_END); grid = -1; return; }
        int dev = 0, cus = 0, per_cu = 0;
        if (hipGetDevice(&dev) != hipSuccess || hipDeviceGetAttribute(&cus, hipDeviceAttributeMultiprocessorCount, dev) != hipSuccess) { grid = -1; return; }
        if (hipFuncSetAttribute((const void*)hyb_fwd, hipFuncAttributeMaxDynamicSharedMemorySize, LDS_BYTES) != hipSuccess) { fprintf(stderr, "kernel_launch: hipFuncSetAttribute failed\n"); grid = -1; return; }
        if (hipOccupancyMaxActiveBlocksPerMultiprocessor(&per_cu, (const void*)hyb_fwd, NWAVES * 64, LDS_BYTES) != hipSuccess || per_cu < 1) { fprintf(stderr, "kernel_launch: occupancy query reports %d\n", per_cu); }
        (void)hipGetLastError();
        grid = cus;
    }
    if (grid < 0) return;
    (void)hipMemsetAsync((char*)d_ws + WS_CTL, 0, CTL_ZERO_BYTES, stream);
    Params a{};
    for (int i = 0; i < 28; ++i) a.in[i] = (const float*)d_in[i];
    a.out = (float*)d_out; a.ws = (unsigned char*)d_ws;
    a.ph_lo = 0; a.ph_hi = N_PHASES; a.use_bar = 1; a.pad = 0;
    hipLaunchKernelGGL(hyb_fwd, dim3(grid), dim3(NWAVES * 64), LDS_BYTES, stream, a);
    const hipError_t le = hipPeekAtLastError();
    if (le != hipSuccess) fprintf(stderr, "kernel_launch: launch failed: %s\n", hipGetErrorName(le));
}
```

```cpp
#include <hip/hip_runtime.h>
#include <hip/hip_bf16.h>
#include <cstdio>
#include <cstdint>
namespace pg8 {
#define PG8_LAS __attribute__((address_space(3)))
typedef unsigned short bf16_t;
typedef short bf16x8 __attribute__((ext_vector_type(8)));
typedef float f32x4 __attribute__((ext_vector_type(4)));
typedef unsigned u32x4 __attribute__((ext_vector_type(4)));
constexpr int BM = 256, BK = 64, HALF = 128, HTB = HALF * BK * 2  , STAGE_BYTES = 8 * HTB, NXCD = 8, WGM = 8;

__host__ __device__ __forceinline__ int lds_byte(int r, int c) { const int st = (r >> 4) * 2 + (c >> 5), rr = r & 15, cc = c & 31, ob = rr * 64 + cc * 2; return st * 1024 + (ob ^ (((ob >> 9) & 1) << 5)); }
__host__ __device__ __forceinline__ void stage_rc(int b, int& R, int& C) { const int st = b / 1024, sb = b % 1024, swz = sb ^ (((sb >> 9) & 1) << 5); R = (st >> 1) * 16 + swz / 64; C = (st & 1) * 32 + (swz % 64) / 2; }
__host__ __device__ __forceinline__ int perm32(int rho) { const int n = rho >> 4, i = rho & 15; return 8 * (i >> 2) + 4 * n + (i & 3); }

struct Unit { int pm, pn, ks, kt0, nt; };
struct Gemm { const bf16_t* A; const bf16_t* Bt; int M, N, K; };

struct StaticOrder {
    int nM, nN, nwg, G, c, ntk;
    __host__ __device__ void init(int M, int N, int G_, int c_, int K) { nM = M / BM; nN = N / BM; nwg = nM * nN; G = G_; c = c_; ntk = K / BK; }
    __host__ __device__ bool next(int i, Unit& u) const { return map((long)i * G + c, u); }
    __host__ __device__ bool map(long L, Unit& u) const {
        if (L >= nwg) return false;
        int wgid = (int)L; { const int q = nwg / NXCD, r = nwg % NXCD, xcd = wgid % NXCD, off = wgid / NXCD; wgid = (xcd < r ? xcd * (q + 1) : r * (q + 1) + (xcd - r) * q) + off; }
        const int nig = WGM * nN, gid = wgid / nig, fm = gid * WGM, gsz = (nM - fm) < WGM ? (nM - fm) : WGM;
        u.pm = fm + ((wgid % nig) % gsz); u.pn = (wgid % nig) / gsz; u.ks = -1; u.kt0 = 0; u.nt = ntk; return true;
    }
    __device__ __forceinline__ void a_ready(const Unit&) const {}
    __device__ __forceinline__ void done(const Unit&) const {}
};


struct TailSplitOrder {
    int c, ntk, mode;
    __device__ void init(int c_, int K, int mode_) { c = c_; ntk = K / BK; mode = mode_; }
    __device__ __forceinline__ bool next(int i, Unit& u) const {
        const int xcd = c & 7, j = c >> 3;
        const int round = i + (mode == 2 ? 1 : 0); const bool tail = round != 0;
        u.pm = tail ? 64 + xcd * 2 + (j & 1) : xcd * 8 + (j & 7);
        u.pn = tail ? (j >> 1) & 3 : j >> 3;
        u.ks = tail ? j >> 3 : -1;
        u.nt = tail ? ntk >> 2 : ntk;
        u.kt0 = tail ? (j >> 3) * (ntk >> 2) : 0;
        return round == 0 ? mode != 2 : (round == 1 && mode != 1);
    }
    __device__ __forceinline__ void a_ready(const Unit&) const {}
    __device__ __forceinline__ void done(const Unit&) const {}
};

struct EvenInOrder {
    StaticOrder S12; int G, c;
    __device__ void init(int G_, int c_) { S12.init(20480, 3072, G_, c_, 1024); G = G_; c = c_; }
    __device__ __forceinline__ bool next(int i, Unit& u) const {
        const int L = i * G + c;
        Unit a; a.pm = 0; a.pn = 0; a.ks = -1; a.kt0 = 0; a.nt = 16; (void)S12.map(L < 960 ? L : 0, a);
        const int q = L - 1024;
        const bool full = L < 960, gkw = L >= 960 && L < 1024;
        u.pm = full ? a.pm : (gkw ? L - 960 : 64 + (q >> 2));
        u.pn = full ? a.pn : 12;
        u.ks = (full || gkw) ? -1 : (q & 3);
        u.nt = (full || gkw) ? 16 : 4;
        u.kt0 = (full || gkw) ? 0 : 4 * (q & 3);
        return L < 1088;
    }
    __device__ __forceinline__ void a_ready(const Unit&) const {}
    __device__ __forceinline__ void done(const Unit&) const {}
};

typedef float f32x2c_t __attribute__((ext_vector_type(2))); typedef __bf16 bf16x2c_t __attribute__((ext_vector_type(2)));
__device__ __forceinline__ unsigned cvt_pk_bf16(float lo, float hi) { f32x2c_t v = {lo, hi}; bf16x2c_t b = __builtin_convertvector(v, bf16x2c_t); return __builtin_bit_cast(unsigned, b); }

template <int ACT> struct EpiBf16 {
    static constexpr bool PERM = true, AFTER_DRAIN = false;
    bf16_t* O; int ldc;
    __device__ __forceinline__ void operator()(const f32x4 (&acc)[2][2][4][2], const Unit& u, int wr, int wc, int fr, int fq) const {
        const int row0 = u.pm * BM + wr * 64 + fr; const int col0 = u.pn * BM + wc * 32 + 8 * fq;
#pragma unroll
        for (int ai = 0; ai < 2; ++ai)
#pragma unroll
            for (int m = 0; m < 4; ++m) { bf16_t* rowp = O + (size_t)(row0 + ai * HALF + m * 16) * ldc + col0;
#pragma unroll
                for (int bj = 0; bj < 2; ++bj) { f32x4 v0 = acc[ai][bj][m][0], v1 = acc[ai][bj][m][1];
                    if (ACT == 1) {
#pragma unroll
                        for (int j = 0; j < 4; ++j) { const float a = fmaxf(v0[j], 0.f), b = fmaxf(v1[j], 0.f); v0[j] = a * a; v1[j] = b * b; } }
                    u32x4 w; w.x = cvt_pk_bf16(v0[0], v0[1]); w.y = cvt_pk_bf16(v0[2], v0[3]); w.z = cvt_pk_bf16(v1[0], v1[1]); w.w = cvt_pk_bf16(v1[2], v1[3]);
                    *(u32x4*)(rowp + bj * HALF) = w; } }
    }
};
struct EpiProj {
    static constexpr bool PERM = true, AFTER_DRAIN = false;
    bf16_t* O; int ldc;
    __device__ __forceinline__ void operator()(const f32x4 (&acc)[2][2][4][2], const Unit& u, int wr, int wc, int fr, int fq) const {
        const int row0 = u.pm * BM + wr * 64 + fr;
        if (u.ks < 0) {
            const int col0 = u.pn * BM + wc * 32 + 8 * fq;
#pragma unroll
            for (int ai = 0; ai < 2; ++ai)
#pragma unroll
                for (int m = 0; m < 4; ++m) { bf16_t* rowp = O + (size_t)(row0 + ai * HALF + m * 16) * ldc + col0;
#pragma unroll
                    for (int bj = 0; bj < 2; ++bj) { const f32x4 v0 = acc[ai][bj][m][0], v1 = acc[ai][bj][m][1];
                        u32x4 w; w.x = cvt_pk_bf16(v0[0], v0[1]); w.y = cvt_pk_bf16(v0[2], v0[3]); w.z = cvt_pk_bf16(v1[0], v1[1]); w.w = cvt_pk_bf16(v1[2], v1[3]);
                        *(u32x4*)(rowp + bj * HALF) = w; } }
        } else if (wc == 0) {
            const int col0 = 3072 + 32 * u.ks + 8 * fq;
#pragma unroll
            for (int ai = 0; ai < 2; ++ai)
#pragma unroll
                for (int m = 0; m < 4; ++m) { const f32x4 v0 = acc[ai][0][m][0], v1 = acc[ai][0][m][1];
                    u32x4 w; w.x = cvt_pk_bf16(v0[0], v0[1]); w.y = cvt_pk_bf16(v0[2], v0[3]); w.z = cvt_pk_bf16(v1[0], v1[1]); w.w = cvt_pk_bf16(v1[2], v1[3]);
                    *(u32x4*)(O + (size_t)(row0 + ai * HALF + m * 16) * ldc + col0) = w; }
        }
    }
};
struct EpiYsplit {
    static constexpr bool PERM = true, AFTER_DRAIN = false;
    bf16_t* Y; bf16_t* SL;
    __device__ __forceinline__ void operator()(const f32x4 (&acc)[2][2][4][2], const Unit& u, int wr, int wc, int fr, int fq) const {
        const int row0 = u.pm * BM + wr * 64 + fr; const int col0 = u.pn * BM + wc * 32 + 8 * fq;
        if (u.ks < 0) {
#pragma unroll
            for (int ai = 0; ai < 2; ++ai)
#pragma unroll
                for (int m = 0; m < 4; ++m) { bf16_t* rowp = Y + (size_t)(row0 + ai * HALF + m * 16) * 1024 + col0;
#pragma unroll
                    for (int bj = 0; bj < 2; ++bj) { const f32x4 v0 = acc[ai][bj][m][0], v1 = acc[ai][bj][m][1];
                        u32x4 w; w.x = cvt_pk_bf16(v0[0], v0[1]); w.y = cvt_pk_bf16(v0[2], v0[3]); w.z = cvt_pk_bf16(v1[0], v1[1]); w.w = cvt_pk_bf16(v1[2], v1[3]);
                        *(u32x4*)(rowp + bj * HALF) = w; } }
        } else {
            bf16_t* base = SL + (size_t)u.ks * (4096 * 1024);
#pragma unroll
            for (int ai = 0; ai < 2; ++ai)
#pragma unroll
                for (int m = 0; m < 4; ++m) { bf16_t* rowp = base + (size_t)(row0 - 16384 + ai * HALF + m * 16) * 1024 + col0;
#pragma unroll
                    for (int bj = 0; bj < 2; ++bj) { const f32x4 v0 = acc[ai][bj][m][0], v1 = acc[ai][bj][m][1];
                        u32x4 w; w.x = cvt_pk_bf16(v0[0], v0[1]); w.y = cvt_pk_bf16(v0[2], v0[3]); w.z = cvt_pk_bf16(v1[0], v1[1]); w.w = cvt_pk_bf16(v1[2], v1[3]);
                        *(u32x4*)(rowp + bj * HALF) = w; } }
        }
    }
};
struct EpiOddIn {
    static constexpr bool PERM = false, AFTER_DRAIN = true;
    bf16_t* QN; bf16_t* ACKV; float* KPERAW; float* out_ckv; float* out_kpe; const float* gq; const float* gkv; int li;
    __device__ __forceinline__ void fused(f32x4 (&acc)[2][2][4][2], const Unit& u, int wr, int wc, int fr, int fq, PG8_LAS unsigned char* lds, int wid, int lane) const {
        PG8_LAS float* P = (PG8_LAS float*)lds;
        if (u.pn < 2) {
#pragma unroll
            for (int ai = 0; ai < 2; ++ai)
#pragma unroll
                for (int m = 0; m < 4; ++m) { float s = 0.f;
#pragma unroll
                    for (int bj = 0; bj < 2; ++bj)
#pragma unroll
                        for (int n = 0; n < 2; ++n) { const f32x4 x = acc[ai][bj][m][n]; s += (x[0] * x[0] + x[1] * x[1]) + (x[2] * x[2] + x[3] * x[3]); }
                    s += __shfl_xor(s, 16); s += __shfl_xor(s, 32);
                    if (fq == 0) P[(ai * HALF + wr * 64 + m * 16 + fr) * 4 + wc] = s; }
        }
        asm volatile("s_waitcnt lgkmcnt(0)" ::: "memory"); __builtin_amdgcn_s_barrier(); asm volatile("" ::: "memory");
        if (u.pn < 2) {
            const float* gv = u.pn == 0 ? gq : gkv;
#pragma unroll
            for (int ai = 0; ai < 2; ++ai)
#pragma unroll
                for (int m = 0; m < 4; ++m) { const int r = ai * HALF + wr * 64 + m * 16 + fr; const int grow = u.pm * BM + r;
                    const float tot = (P[r * 4 + 0] + P[r * 4 + 1]) + (P[r * 4 + 2] + P[r * 4 + 3]);
                    const float rstd = 1.0f / sqrtf(tot * (1.0f / 256.0f) + 1e-6f);
                    const int drow = grow < 4096 ? grow : 4096 + ((grow - 4096) >> 11) * 2304 + 256 + ((grow - 4096) & 2047);
#pragma unroll
                    for (int bj = 0; bj < 2; ++bj)
#pragma unroll
                        for (int n = 0; n < 2; ++n) { const int col = bj * HALF + wc * 32 + n * 16 + 4 * fq; const f32x4 g = *(const f32x4*)(gv + col);
                            const f32x4 v = acc[ai][bj][m][n] * rstd * g;
                            unsigned long long w = (unsigned long long)cvt_pk_bf16(v[0], v[1]) | ((unsigned long long)cvt_pk_bf16(v[2], v[3]) << 32);
                            if (u.pn == 0) *(unsigned long long*)(QN + (size_t)grow * 256 + col) = w;
                            else { *(unsigned long long*)(ACKV + (size_t)drow * 256 + col) = w;
                                   if (grow < 4096) *(f32x4*)(out_ckv + ((size_t)((grow >> 8) * 2 + li) * 256 + (grow & 255)) * 256 + col) = v; } } }
        } else if (wc < 2) {
#pragma unroll
            for (int ai = 0; ai < 2; ++ai)
#pragma unroll
                for (int m = 0; m < 4; ++m) { const int r = ai * HALF + wr * 64 + m * 16 + fr; const int grow = u.pm * BM + r;
#pragma unroll
                    for (int n = 0; n < 2; ++n) { const int col = wc * 32 + n * 16 + 4 * fq; const f32x4 v = acc[ai][0][m][n];
                        *(f32x4*)(KPERAW + (size_t)grow * 64 + col) = v;
                        if (grow < 4096) *(f32x4*)(out_kpe + ((size_t)((grow >> 8) * 2 + li) * 256 + (grow & 255)) * 64 + col) = v; } }
        }
    }
};

#define PG8_NCONST const
#ifndef PG8_PROBE_MODE
#define PG8_PROBE_MODE 0
#endif
#define PG8_PM true
#define PG8_PL true
#define PG8_PG true
template <class Epi, class Sched, bool ALIGN_EPI = false, bool SP2 = false>
__device__ __forceinline__ void gemm_phase(PG8_LAS unsigned char* lds, const Gemm g, const Sched& S, const Epi& E, const int tid, const void* scratch) {
    static_assert(SP2, "only the two-super-phase K-loop is kept");
    const int  wid = __builtin_amdgcn_readfirstlane(tid >> 6), lane = tid & 63, wr = wid >> 2, wc = wid & 3, fr = lane & 15, fq = lane >> 4;
    const int K = g.K;
    unsigned voffA[2], voffB[2];
#pragma unroll
    for (int i = 0; i < 2; ++i) { int R, C; stage_rc(tid * 16 + i * 8192, R, C); const int Rb = Epi::PERM ? ((R & ~31) + perm32(R & 31)) : R;
        voffA[i] = (unsigned)(R * K + C) * 2u; voffB[i] = (unsigned)(Rb * K + C) * 2u; }
    const size_t kstep = (size_t)(BK * 2);
    const size_t hstep = (size_t)HALF * K * 2;
    const size_t tstep = 2 * hstep;
    const unsigned ldsw = (unsigned)wid * 1024u;
    const unsigned ldsa = (unsigned)(size_t)lds + ldsw;
    const int aoff = lds_byte(wr * 64 + fr, fq * 8), boff = lds_byte(wc * 32 + fr, fq * 8);
#define PG8_SA(b, h) (((b) * 2 + (h)) * HTB)
#define PG8_SB(b, h) ((4 + (b) * 2 + (h)) * HTB)
#define PG8_STAGE(bufoff, gbase, voff) do { if (PG8_PG) _Pragma("unroll") for (int _i = 0; _i < 2; ++_i) { unsigned sv_; \
        asm volatile("s_mov_b32 %0, m0\n\ts_mov_b32 m0, %3\n\ts_nop 0\n\tglobal_load_lds_dwordx4 %1, %2\n\ts_mov_b32 m0, %0" \
                     : "=&s"(sv_) : "v"((voff)[_i]), "s"((const char*)(gbase)), "s"(ldsa + (unsigned)((bufoff) + _i * 8192)) : "memory"); } } while (0)
#define PG8_LDA(dst, b, h) do { if (PG8_PL) _Pragma("unroll") for (int m = 0; m < 4; ++m) _Pragma("unroll") for (int k = 0; k < 2; ++k) dst[m][k] = *(const PG8_LAS bf16x8*)(lds + PG8_SA(b, h) + aoff + m * 2048 + k * 1024); } while (0)
#define PG8_LDB(dst, b, h) do { if (PG8_PL) _Pragma("unroll") for (int n = 0; n < 2; ++n) _Pragma("unroll") for (int k = 0; k < 2; ++k) dst[n][k] = *(const PG8_LAS bf16x8*)(lds + PG8_SB(b, h) + boff + n * 2048 + k * 1024); } while (0)
#define PG8_MMA(ai, bj, At, Bt) do { __builtin_amdgcn_s_setprio(1); if (PG8_PM) _Pragma("unroll") for (int k = 0; k < 2; ++k) _Pragma("unroll") for (int m = 0; m < 4; ++m) _Pragma("unroll") for (int n = 0; n < 2; ++n) \
        acc[ai][bj][m][n] = __builtin_amdgcn_mfma_f32_16x16x32_bf16(Bt[n][k], At[m][k], acc[ai][bj][m][n], 0, 0, 0); __builtin_amdgcn_s_setprio(0); } while (0)
#define PG8_WAIT_V(n) asm volatile("s_waitcnt vmcnt(" #n ")" ::: "memory")
#define PG8_WAIT_L(n) asm volatile("s_waitcnt lgkmcnt(" #n ")" ::: "memory")
#define PG8_BAR __builtin_amdgcn_s_barrier()
#define PG8_SCHED __builtin_amdgcn_sched_barrier(0)
    Unit cur, nxt; int ui = 0;
    if (!S.next(0, cur)) return;
    f32x4 acc[2][2][4][2];
#pragma unroll
    for (int a = 0; a < 2; ++a)
#pragma unroll
        for (int b = 0; b < 2; ++b)
#pragma unroll
            for (int m = 0; m < 4; ++m)
#pragma unroll
                for (int n = 0; n < 2; ++n) acc[a][b][m][n] = (f32x4){0.f, 0.f, 0.f, 0.f};
    bf16x8 At[4][2], B0[2][2], B1[2][2];
    const char* cA = (const char*)g.A + (size_t)cur.pm * tstep + (size_t)cur.kt0 * kstep; const char* cB = (const char*)g.Bt + (size_t)cur.pn * tstep + (size_t)cur.kt0 * kstep;
    S.a_ready(cur);
    PG8_STAGE(PG8_SB(0, 0), cB, voffB); PG8_STAGE(PG8_SB(0, 1), cB + hstep, voffB); PG8_STAGE(PG8_SA(0, 0), cA, voffA); PG8_STAGE(PG8_SA(0, 1), cA + hstep, voffA);
    if (wr == 1) PG8_BAR;
    PG8_WAIT_V(2); PG8_BAR;
    PG8_STAGE(PG8_SB(1, 0), cB + kstep, voffB); PG8_STAGE(PG8_SA(1, 0), cA + kstep, voffA); PG8_STAGE(PG8_SB(1, 1), cB + hstep + kstep, voffB);
    PG8_WAIT_V(6); PG8_BAR;
    PG8_STAGE(PG8_SA(1, 1), cA + kstep + hstep, voffA);
    { const unsigned doff = ((unsigned)__builtin_amdgcn_workgroup_id_x() * 8u + (unsigned)wid) * 64u;
#pragma unroll
      for (int j = 0; j < 16; ++j) asm volatile("global_store_dword %0, %0, %1" :: "v"(doff), "s"(scratch) : "memory"); }
#define PG8_PAIR(WV) \
              \
            PG8_LDB(B0, 0, 0); PG8_LDB(B1, 0, 1); PG8_SCHED; PG8_LDA(At, 0, 0); \
            PG8_WAIT_V(WV); PG8_WAIT_L(0); PG8_BAR; PG8_MMA(0, 0, At, B0); PG8_MMA(0, 1, At, B1); PG8_BAR; PG8_SCHED; \
              \
            PG8_LDA(At, 0, 1); PG8_STAGE(PG8_SB(0, 0), b2, voffB); PG8_STAGE(PG8_SB(0, 1), b2 + hstep, voffB); PG8_STAGE(PG8_SA(0, 0), a2, voffA); \
            PG8_WAIT_V(WV); PG8_WAIT_L(0); PG8_BAR; PG8_MMA(1, 0, At, B0); PG8_MMA(1, 1, At, B1); PG8_BAR; PG8_SCHED; \
              \
            PG8_LDB(B0, 1, 0); PG8_LDB(B1, 1, 1); PG8_SCHED; PG8_LDA(At, 1, 0); PG8_STAGE(PG8_SA(0, 1), a2 + hstep, voffA); \
            PG8_WAIT_V(WV); PG8_WAIT_L(0); PG8_BAR; PG8_MMA(0, 0, At, B0); PG8_MMA(0, 1, At, B1); PG8_BAR; PG8_SCHED; \
              \
            PG8_LDA(At, 1, 1); PG8_STAGE(PG8_SB(1, 0), b3, voffB); PG8_STAGE(PG8_SB(1, 1), b3 + hstep, voffB); PG8_STAGE(PG8_SA(1, 0), a3, voffA); \
            PG8_WAIT_V(8); PG8_WAIT_L(0); PG8_BAR; PG8_MMA(1, 0, At, B0); PG8_MMA(1, 1, At, B1); PG8_BAR; PG8_SCHED; \
            PG8_STAGE(PG8_SA(1, 1), a3 + hstep, voffA); PG8_SCHED;
    for (;;) {
        const bool has_next = S.next(ui + 1, nxt);
        PG8_NCONST char* nA = has_next ? (const char*)g.A + (size_t)nxt.pm * tstep + (size_t)nxt.kt0 * kstep : cA; PG8_NCONST char* nB = has_next ? (const char*)g.Bt + (size_t)nxt.pn * tstep + (size_t)nxt.kt0 * kstep : cB;
        const int nt = cur.nt;
#if PG8_PROBE_MODE > 0
        {
#define PG8_PM (PG8_PROBE_MODE != 1 && PG8_PROBE_MODE != 5)
#define PG8_PL (PG8_PROBE_MODE != 3 && PG8_PROBE_MODE != 5)
#define PG8_PG (PG8_PROBE_MODE < 2 || PG8_PROBE_MODE == 4)
            if (!PG8_PL) {
#pragma unroll
                for (int m = 0; m < 4; ++m)
#pragma unroll
                    for (int k = 0; k < 2; ++k) asm volatile("" : "=v"(At[m][k]));
#pragma unroll
                for (int n = 0; n < 2; ++n)
#pragma unroll
                    for (int k = 0; k < 2; ++k) { asm volatile("" : "=v"(B0[n][k])); asm volatile("" : "=v"(B1[n][k])); } }
            for (int t = 0; t < nt; t += 2) {
                const bool last = (t == nt - 2);
                const char* a2 = last ? cA : cA + (size_t)(t + 2) * kstep; const char* b2 = last ? cB : cB + (size_t)(t + 2) * kstep;
                const char* a3 = a2 + kstep; const char* b3 = b2 + kstep;
                PG8_PAIR(8)
            }
#pragma unroll
            for (int a = 0; a < 2; ++a)
#pragma unroll
                for (int b = 0; b < 2; ++b)
#pragma unroll
                    for (int m = 0; m < 4; ++m)
#pragma unroll
                        for (int n = 0; n < 2; ++n) asm volatile("" :: "v"(acc[a][b][m][n]));
#undef PG8_PM
#undef PG8_PL
#undef PG8_PG
#define PG8_PM true
#define PG8_PL true
#define PG8_PG true
#pragma unroll
            for (int a = 0; a < 2; ++a)
#pragma unroll
                for (int b = 0; b < 2; ++b)
#pragma unroll
                    for (int m = 0; m < 4; ++m)
#pragma unroll
                        for (int n = 0; n < 2; ++n) acc[a][b][m][n] = (f32x4){0.f, 0.f, 0.f, 0.f};
            { const unsigned doff = ((unsigned)__builtin_amdgcn_workgroup_id_x() * 8u + (unsigned)wid) * 64u;
#pragma unroll
              for (int j = 0; j < 16; ++j) asm volatile("global_store_dword %0, %0, %1" :: "v"(doff), "s"(scratch) : "memory"); }
        }
#endif
        {
            const char* a2 = cA + 2 * kstep; const char* b2 = cB + 2 * kstep; const char* a3 = a2 + kstep; const char* b3 = b2 + kstep;
            PG8_PAIR(24)
        }
        for (int t = 2; t < nt; t += 2) {
            const bool last = (t == nt - 2);
            const char* a2 = last ? nA : cA + (size_t)(t + 2) * kstep; const char* b2 = last ? nB : cB + (size_t)(t + 2) * kstep;
            const char* a3 = a2 + kstep; const char* b3 = b2 + kstep;
            if (last && has_next) S.a_ready(nxt);
            PG8_PAIR(8)
        }
        if constexpr (ALIGN_EPI) { if (wr == 0) PG8_BAR; }
        if constexpr (!Epi::AFTER_DRAIN) { int l_ = (int)__builtin_amdgcn_mbcnt_hi(~0u, __builtin_amdgcn_mbcnt_lo(~0u, 0u)); asm volatile("" : "+v"(l_));
            E(acc, cur, wr, wc, l_ & 15, l_ >> 4); S.done(cur); }
        if (!has_next) break;
#pragma unroll
        for (int a = 0; a < 2; ++a)
#pragma unroll
            for (int b = 0; b < 2; ++b)
#pragma unroll
                for (int m = 0; m < 4; ++m)
#pragma unroll
                    for (int n = 0; n < 2; ++n) acc[a][b][m][n] = (f32x4){0.f, 0.f, 0.f, 0.f};
        cur = nxt; cA = nA; cB = nB; ++ui;
        if constexpr (ALIGN_EPI) { if (wr == 1) PG8_BAR; }
    }
#undef PG8_PAIR
    PG8_WAIT_V(0);
    if constexpr (!ALIGN_EPI) { if (wr == 0) PG8_BAR; }
    PG8_BAR;
    if constexpr (Epi::AFTER_DRAIN) { E.fused(acc, cur, wr, wc, fr, fq, lds, wid, lane); S.done(cur); }
#undef PG8_SA
#undef PG8_SB
#undef PG8_STAGE
#undef PG8_LDA
#undef PG8_LDB
#undef PG8_MMA
#undef PG8_WAIT_V
#undef PG8_WAIT_L
#undef PG8_BAR
#undef PG8_SCHED
}
}

constexpr int NWAVES = 8;
constexpr int D = 1024, FF = 4096, M_CTX = 4096, M_LAT = 16384, M = M_CTX + M_LAT;
constexpr int L_LAT = 2048, L_CTX = 256, PAST = 256, LKV = PAST + L_LAT;
constexpr int MKV = M_CTX + 8 * LKV;
constexpr int EVEN_N = 3104, EVEN_NP = 3328, ODD_N = 576, ODD_NP = 768;
constexpr float EPS = 1e-6f;
constexpr int PC_QA = 0, PC_KA = 256, PC_VA = 512, PC_GA = 1024, PC_QB = 1536, PC_KB = 1792, PC_VB = 2048, PC_GB = 2560, PC_GK = 3072;
constexpr size_t OUT_Y = 0, OUT_CKV = 20971520, OUT_KPE = 23068672, OUT_SGLA = 23592960, OUT_SRET = 25690112;

constexpr size_t MiB = 1u << 20;
constexpr size_t WS_CTL = 0, CTL_ZERO_BYTES = 64 * 1024;
constexpr size_t WS_MOD = 1 * MiB;
constexpr size_t WS_ROPE = 2 * MiB;
constexpr size_t WS_KPE = 3 * MiB;
constexpr size_t WS_ACKV = 6 * MiB;
constexpr size_t WS_WINE = 18 * MiB;
constexpr size_t WS_WOUTE = 31 * MiB;
constexpr size_t WS_WINO = 35 * MiB;
constexpr size_t WS_WQB = 38 * MiB;
constexpr size_t WS_WKVB = 40 * MiB;
constexpr size_t WS_WOUTO = 42 * MiB;
constexpr size_t WS_W1 = 46 * MiB;
constexpr size_t WS_W2 = 78 * MiB;
constexpr size_t WS_HB = 110 * MiB;
constexpr size_t WS_Y = 150 * MiB;
constexpr size_t WS_BIG = 190 * MiB;
constexpr size_t WS_Q = WS_BIG, WS_KV = WS_BIG + 60 * MiB, WS_QN = WS_BIG + 148 * MiB;
constexpr size_t WS_SLAB = 350 * MiB;
constexpr size_t WS_END = 382 * MiB;

constexpr int RING_BYTES = 131072;
constexpr int LDS_MISC = 155648;
constexpr int LDS_BYTES = 163840;

#define GAS __attribute__((address_space(1)))
#define LAS __attribute__((address_space(3)))
typedef unsigned short bf16;
typedef unsigned v4u __attribute__((ext_vector_type(4)));
typedef unsigned v2u __attribute__((ext_vector_type(2)));
typedef float f32x4 __attribute__((ext_vector_type(4)));
typedef float f32x16 __attribute__((ext_vector_type(16)));
typedef short bf16x8 __attribute__((ext_vector_type(8)));
typedef short s16x4 __attribute__((ext_vector_type(4)));
#define LDS_WAIT() asm volatile("s_waitcnt lgkmcnt(0)" ::: "memory")
#define VM_WAIT() asm volatile("s_waitcnt vmcnt(0)" ::: "memory")
typedef float f32x2_t __attribute__((ext_vector_type(2))); typedef __bf16 bf16x2_t __attribute__((ext_vector_type(2)));
__device__ __forceinline__ unsigned pk2(float lo, float hi) { f32x2_t v = {lo, hi}; bf16x2_t b = __builtin_convertvector(v, bf16x2_t); return __builtin_bit_cast(unsigned, b); }
__device__ __forceinline__ unsigned f2bf(float f) { return pk2(f, f) & 0xffffu; }
__device__ __forceinline__ float bflo(unsigned w) { return __builtin_bit_cast(float, w << 16); }
__device__ __forceinline__ float bfhi(unsigned w) { return __builtin_bit_cast(float, w & 0xffff0000u); }
__device__ __forceinline__ float wave_sum(float v) {
#pragma unroll
    for (int o = 1; o < 64; o <<= 1) v += __shfl_xor(v, o);
    return v;
}
__device__ __forceinline__ float siluf(float x) { return x * __builtin_amdgcn_rcpf(1.0f + __expf(-x)); }

#define XB_TMO      128
#define XB_XCNT(j)  (256  + 64 * (j))
#define XB_XSUB(j)  (1280 + 64 * (j))
#define XB_XGEN(j)  (2304 + 64 * (j))
#define XB_TOP      3328
#define XB_TOPGEN   3392
#define XCD_BAR_WORDS 3456
#define XB_SPIN_CAP (1u << 20)
__device__ __forceinline__ unsigned xb_ld(unsigned* p)              { return __hip_atomic_load(p, __ATOMIC_RELAXED, __HIP_MEMORY_SCOPE_AGENT); }
__device__ __forceinline__ unsigned xb_add(unsigned* p, unsigned v) { return __hip_atomic_fetch_add(p, v, __ATOMIC_RELAXED, __HIP_MEMORY_SCOPE_AGENT); }
__device__ __forceinline__ unsigned xb_xcc_id() { return (unsigned)__builtin_amdgcn_s_getreg((3 << 11) | 20) & 0xFu; }
#define XB_SPIN(cond, bar) do { unsigned _sp = 0; while (cond) { __builtin_amdgcn_s_sleep(1); \
    if ((++_sp & 255u) == 0u) { if (xb_ld(&(bar)[XB_TMO])) break; if (_sp > XB_SPIN_CAP) { atomicAdd(&(bar)[XB_TMO], 1u); break; } } } } while (0)
struct XcdBarrier { unsigned* bar; unsigned x; volatile LAS unsigned* st; };
__device__ __forceinline__ XcdBarrier xcd_barrier_post(unsigned* bar, volatile LAS unsigned* st) {
    XcdBarrier b; b.bar = bar; b.x = xb_xcc_id(); b.st = st;
    if (threadIdx.x == 0) (void)xb_add(&bar[XB_XCNT(b.x)], 1u);
    return b;
}
__device__ __forceinline__ void xcd_barrier_complete(unsigned* bar, unsigned x, unsigned& nloc, unsigned& nx) {
    const unsigned G = gridDim.x * gridDim.y * gridDim.z;
    unsigned sum, cnt, mine, sp = 0u;
    for (;;) {
        sum = 0u; cnt = 0u; mine = 0u;
#pragma unroll
        for (unsigned j = 0; j < 16; ++j) { const unsigned c = xb_ld(&bar[XB_XCNT(j)]); sum += c; cnt += (c > 0u) ? 1u : 0u; mine = (j == x) ? c : mine; }
        if (sum == G) break;
        __builtin_amdgcn_s_sleep(1);
        if ((++sp & 255u) == 0u) { if (xb_ld(&bar[XB_TMO])) break; if (sp > XB_SPIN_CAP) { atomicAdd(&bar[XB_TMO], 1u); break; } }
    }
    nloc = mine > 0u ? mine : 1u; nx = cnt > 0u ? cnt : 1u;
}
__device__ __forceinline__ void xcd_barrier(const XcdBarrier& b) {
    asm volatile("s_waitcnt vmcnt(0)" ::: "memory");
    __syncthreads();
    if (threadIdx.x == 0) {
        unsigned* bar = b.bar;
        __builtin_amdgcn_s_waitcnt(0);
        unsigned nloc = b.st[0], nx = b.st[1];
        if (nloc == 0u) { xcd_barrier_complete(bar, b.x, nloc, nx); b.st[0] = nloc; b.st[1] = nx; }
        const unsigned old = xb_add(&bar[XB_XSUB(b.x)], 1u);
        const unsigned gen = old / nloc;
        if (old + 1u == (gen + 1u) * nloc) {
            __builtin_amdgcn_fence(__ATOMIC_RELEASE, "agent");
            __builtin_amdgcn_fence(__ATOMIC_ACQUIRE, "agent");
            asm volatile("s_waitcnt vmcnt(0)" ::: "memory");
            const unsigned og = xb_add(&bar[XB_TOP], 1u);
            const unsigned tg = og / nx;
            if (og + 1u == (tg + 1u) * nx) xb_add(&bar[XB_TOPGEN], 1u);
            else XB_SPIN(xb_ld(&bar[XB_TOPGEN]) == tg, bar);
            xb_add(&bar[XB_XGEN(b.x)], 1u);
        } else {
            __builtin_amdgcn_fence(__ATOMIC_ACQUIRE, "agent");
            asm volatile("s_waitcnt vmcnt(0)" ::: "memory");
            XB_SPIN(xb_ld(&bar[XB_XGEN(b.x)]) == gen, bar);
        }
        asm volatile("s_waitcnt vmcnt(0)" ::: "memory");
    }
    __syncthreads();
}

struct Params { const float* in[28]; float* out; unsigned char* ws; int ph_lo, ph_hi, use_bar, pad; };
enum { I_XP = 0, I_XS, I_CCKV, I_CKPE, I_SGLA, I_SRET, I_C, I_CCTX, I_WADA, I_BADA, I_NMIXPRE, I_NMIXPOST, I_NMLPPRE, I_NMLPPOST,
       I_WINE, I_WGK2, I_BGK2, I_GLAN, I_RDEC, I_WOUTE, I_WINO, I_QAN, I_WQB, I_KVAN, I_WKVB, I_WOUTO, I_W1, I_W2 };
struct Frame { LAS unsigned char* lds; int tid, lane, wave, vcu, G, bid; };
constexpr int LDS_PT = LDS_MISC + 256;
#define KAS __attribute__((address_space(4)))
__device__ __forceinline__ const void* ldp(LAS unsigned char*, int i) {
    unsigned off = (unsigned)i * 8u; asm volatile("" : "+s"(off));
    const KAS unsigned char* ka = (const KAS unsigned char*)__builtin_amdgcn_kernarg_segment_ptr();
    const unsigned long long v = *(const KAS unsigned long long*)(ka + off);
    return (const void*)(const GAS void*)v;
}
#define PIN(i) ((const float*)ldp(F.lds, (i)))
#define POUT ((float*)ldp(F.lds, 28))
#define PWS ((unsigned char*)ldp(F.lds, 29))

__device__ __forceinline__ void p0_transpose_item(const float* W, int K, int N, bf16* WT, int kb, int n0, int dn0, LAS float* scr, int lane) {
    const int k0 = 64 * kb;
    f32x4 wv[8];
#pragma unroll
    for (int i = 0; i < 8; ++i) wv[i] = __builtin_nontemporal_load((const f32x4*)(W + (size_t)(k0 + 8 * i + (lane >> 3)) * N + n0 + 4 * (lane & 7)));
#pragma unroll
    for (int i = 0; i < 8; ++i) { LAS float* d = scr + (8 * i + (lane >> 3)) * 33 + 4 * (lane & 7); d[0] = wv[i][0]; d[1] = wv[i][1]; d[2] = wv[i][2]; d[3] = wv[i][3]; }
    LDS_WAIT(); asm volatile("" ::: "memory");
    const int c = lane & 7;
#pragma unroll
    for (int j = 0; j < 4; ++j) { const int n = (lane >> 3) + 8 * j; const LAS float* s = scr + (8 * c) * 33 + n;
        v4u o; o.x = pk2(s[0 * 33], s[1 * 33]); o.y = pk2(s[2 * 33], s[3 * 33]); o.z = pk2(s[4 * 33], s[5 * 33]); o.w = pk2(s[6 * 33], s[7 * 33]);
        *(GAS v4u*)(WT + (size_t)(dn0 + n) * K + k0 + 8 * c) = o; }
    LDS_WAIT(); asm volatile("" ::: "memory");
}
__device__ __forceinline__ int even_col_map(int n0) { return n0 < 1536 ? n0 : (n0 < 1568 ? 3072 + (n0 - 1536) : n0 - 32); }

__device__ __forceinline__ void setup_work(Frame& F, const Params& P, int wgi, int nwg, int amask  , int mmask  , int eimask  , int eomask  , int omask  ) {
    unsigned char* ws = PWS;
    LAS float* scr = (LAS float*)(F.lds + F.wave * 16384);
    __syncthreads();
    {
        LAS float* S = (LAS float*)(F.lds);
        LAS float* R = (LAS float*)(F.lds + 40960);
        { const float* cp_ = PIN(I_C); const float* cc_ = PIN(I_CCTX);
          for (int i = F.tid; i < 9 * 1024; i += 512) { const int n = i >> 10, d = i & 1023; const float cv = n < 8 ? cp_[n * 1024 + d] : cc_[d]; S[i] = siluf(cv); } }
        const float* wada_ = PIN(I_WADA); const float* bada_ = PIN(I_BADA);
        __syncthreads();
        const int nl = __builtin_popcount(amask);
        for (int uu = wgi; uu < nl * 128; uu += nwg) {
            int li_ = uu >> 7, l = 0; { int m_ = amask; for (int k_ = 0; k_ < 4; ++k_) { if (m_ & 1) { if (li_ == 0) { l = k_; break; } --li_; } m_ >>= 1; } }
            const int cb = (uu & 127) * 48;
            if (F.tid < 384) {
                const int c4 = (F.tid % 12) * 4, part = F.tid / 12;
                const float* Wp = wada_ + ((size_t)l * 1024 + part * 32) * 6144 + cb + c4;
                f32x4 a[9];
#pragma unroll
                for (int n = 0; n < 9; ++n) a[n] = (f32x4){0.f, 0.f, 0.f, 0.f};
                for (int d0 = 0; d0 < 32; d0 += 16) { f32x4 w[16];
#pragma unroll
                    for (int dd = 0; dd < 16; ++dd) w[dd] = __builtin_nontemporal_load((const f32x4*)(Wp + (size_t)(d0 + dd) * 6144));
#pragma unroll
                    for (int dd = 0; dd < 16; ++dd)
#pragma unroll
                        for (int n = 0; n < 9; ++n) a[n] += w[dd] * S[n * 1024 + part * 32 + d0 + dd]; }
#pragma unroll
                for (int n = 0; n < 9; ++n) *(LAS f32x4*)(R + (part * 9 + n) * 48 + c4) = a[n];
            }
            __syncthreads();
            for (int i = F.tid; i < 9 * 48; i += 512) { const int n = i / 48, c = i % 48; float s = 0.f;
#pragma unroll
                for (int p = 0; p < 32; ++p) s += R[(p * 9 + n) * 48 + c];
                ((float*)(ws + WS_MOD))[((size_t)l * 9 + n) * 6144 + cb + c] = s + bada_[l * 6144 + cb + c]; }
            __syncthreads();
        }
    }
    {
        const int wk = wgi * NWAVES + F.wave, NW = nwg * NWAVES;
        const int I_E = (1024 / 64) * (EVEN_N / 32), I_OE = 16 * 32, I_O = 16 * (ODD_N / 32), I_QB = 4 * 48, I_KVB = 4 * 64, I_M1 = 16 * 128, I_M2 = 64 * 32;
        const float* itW; bf16* itT; int itK, itN, itkb, itn0, itdn0;
#define IT_TRY(sel, count, ...) if (sel) { if (g_ < base_ + (count)) { const int q = g_ - base_; __VA_ARGS__; itkb = kb; itn0 = n0; return_ = true; goto_done_ = true; } else base_ += (count); }
#define IT_DECODE(g, ok) do { const int g_ = (g); int base_ = 0; bool return_ = false, goto_done_ = false; \
        _Pragma("unroll") for (int l = 0; l < 2; ++l) { \
            if (!goto_done_) { IT_TRY((eimask >> l) & 1, I_E, const int nb = EVEN_N / 32, kb = q / nb, n0 = (q % nb) * 32; itW = PIN(I_WINE) + (size_t)l * 1024 * EVEN_N; itK = 1024; itN = EVEN_N; itT = (bf16*)(ws + WS_WINE) + (size_t)l * EVEN_NP * 1024; itdn0 = even_col_map(n0)) } \
            if (!goto_done_) { IT_TRY((eomask >> l) & 1, I_OE, const int kb = q / 32, n0 = (q % 32) * 32; itW = PIN(I_WOUTE) + (size_t)l * 1024 * 1024; itK = 1024; itN = 1024; itT = (bf16*)(ws + WS_WOUTE) + (size_t)l * 1024 * 1024; itdn0 = n0) } \
            if (!goto_done_) { IT_TRY((omask >> l) & 1, I_O, const int nb = ODD_N / 32, kb = q / nb, n0 = (q % nb) * 32; itW = PIN(I_WINO) + (size_t)l * 1024 * ODD_N; itK = 1024; itN = ODD_N; itT = (bf16*)(ws + WS_WINO) + (size_t)l * ODD_NP * 1024; itdn0 = n0) } \
            if (!goto_done_) { IT_TRY((omask >> l) & 1, I_QB, const int kb = q / 48, n0 = (q % 48) * 32; itW = PIN(I_WQB) + (size_t)l * 256 * 1536; itK = 256; itN = 1536; itT = (bf16*)(ws + WS_WQB) + (size_t)l * 1536 * 256; itdn0 = n0) } \
            if (!goto_done_) { IT_TRY((omask >> l) & 1, I_KVB, const int kb = q / 64, n0 = (q % 64) * 32; itW = PIN(I_WKVB) + (size_t)l * 256 * 2048; itK = 256; itN = 2048; itT = (bf16*)(ws + WS_WKVB) + (size_t)l * 2048 * 256; itdn0 = n0) } \
            if (!goto_done_) { IT_TRY((omask >> l) & 1, I_OE, const int kb = q / 32, n0 = (q % 32) * 32; itW = PIN(I_WOUTO) + (size_t)l * 1024 * 1024; itK = 1024; itN = 1024; itT = (bf16*)(ws + WS_WOUTO) + (size_t)l * 1024 * 1024; itdn0 = n0) } } \
        _Pragma("unroll") for (int l = 0; l < 4; ++l) { \
            if (!goto_done_) { IT_TRY((mmask >> l) & 1, I_M1, const int kb = q / 128, n0 = (q % 128) * 32; itW = PIN(I_W1) + (size_t)l * 1024 * 4096; itK = 1024; itN = 4096; itT = (bf16*)(ws + WS_W1) + (size_t)l * 4096 * 1024; itdn0 = n0) } \
            if (!goto_done_) { IT_TRY((mmask >> l) & 1, I_M2, const int kb = q / 32, n0 = (q % 32) * 32; itW = PIN(I_W2) + (size_t)l * 4096 * 1024; itK = 4096; itN = 1024; itT = (bf16*)(ws + WS_W2) + (size_t)l * 1024 * 4096; itdn0 = n0) } } \
        ok = return_; } while (0)
#define IT_LOAD(wv) do { _Pragma("unroll") for (int i = 0; i < 8; ++i) wv[i] = __builtin_nontemporal_load((const f32x4*)(itW + (size_t)(64 * itkb + 8 * i + (F.lane >> 3)) * itN + itn0 + 4 * (F.lane & 7))); } while (0)
#define IT_KEEP() const int cK = itK, ck0 = 64 * itkb, cdn0 = itdn0; bf16* const cT = itT
#define IT_PROC(wv) do { \
        _Pragma("unroll") for (int i = 0; i < 8; ++i) { LAS float* d = scr + (8 * i + (F.lane >> 3)) * 33 + 4 * (F.lane & 7); d[0] = wv[i][0]; d[1] = wv[i][1]; d[2] = wv[i][2]; d[3] = wv[i][3]; } \
        LDS_WAIT(); asm volatile("" ::: "memory"); \
        { const int c = F.lane & 7; \
          _Pragma("unroll") for (int j = 0; j < 4; ++j) { const int n = (F.lane >> 3) + 8 * j; const LAS float* s = scr + (8 * c) * 33 + n; \
              v4u o; o.x = pk2(s[0 * 33], s[1 * 33]); o.y = pk2(s[2 * 33], s[3 * 33]); o.z = pk2(s[4 * 33], s[5 * 33]); o.w = pk2(s[6 * 33], s[7 * 33]); \
              *(GAS v4u*)(cT + (size_t)(cdn0 + n) * cK + ck0 + 8 * c) = o; } } \
        LDS_WAIT(); asm volatile("" ::: "memory"); } while (0)
        f32x4 wa[8], wb[8]; bool ok; int g = wk;
        IT_DECODE(g, ok);
        if (ok) {
            IT_LOAD(wa);
            for (;;) {
                { IT_KEEP(); g += NW; IT_DECODE(g, ok);
                  if (ok) { IT_LOAD(wb); IT_PROC(wa); } else { IT_PROC(wa); break; } }
                { IT_KEEP(); g += NW; IT_DECODE(g, ok);
                  if (ok) { IT_LOAD(wa); IT_PROC(wb); } else { IT_PROC(wb); break; } }
            }
        }
#undef IT_TRY
#undef IT_DECODE
#undef IT_LOAD
#undef IT_KEEP
#undef IT_PROC
    }
    const int gt = wgi * 512 + F.tid, NGT = nwg * 512;
#pragma unroll
    for (int l = 0; l < 2; ++l) {
        if ((eimask >> l) & 1) { v4u z_ = {0u, 0u, 0u, 0u}; asm volatile("" : "+v"(z_)); for (int i = gt; i < 224 * 128; i += NGT) *(GAS v4u*)((bf16*)(ws + WS_WINE) + ((size_t)l * EVEN_NP + EVEN_N) * 1024 + (size_t)i * 8) = z_; }
        if ((omask >> l) & 1) { v4u z_ = {0u, 0u, 0u, 0u}; asm volatile("" : "+v"(z_)); for (int i = gt; i < 192 * 128; i += NGT) *(GAS v4u*)((bf16*)(ws + WS_WINO) + ((size_t)l * ODD_NP + ODD_N) * 1024 + (size_t)i * 8) = z_; }
    }
}
__device__ __forceinline__ void p0_prologue(Frame& F, const Params& P) {
    unsigned char* ws = PWS;
    setup_work(F, P, F.vcu, F.G, 0x5, 0x5, 0x3, 0x3, 0x0);
    const int gt = F.vcu * 512 + F.tid, NGT = F.G * 512;
    for (int i = gt; i < 2048 * 32; i += NGT) { const int t = i >> 5, j = i & 31; const float inv = powf(10000.0f, -(float)(j & 15) / 16.0f);
        const float ang = (float)(j < 16 ? (t >> 6) : (t & 63)) * inv;
        ((float*)(ws + WS_ROPE))[i] = cosf(ang); ((float*)(ws + WS_ROPE))[65536 + i] = sinf(ang); }
}

__device__ __forceinline__ void row_y(f32x4 (&yv)[4], const bf16* Y, const bf16* SL, int row, int l4) {
    if (row < 16384) {
#pragma unroll
        for (int j = 0; j < 4; ++j) { const v2u yw = __builtin_nontemporal_load((const v2u*)(Y + (size_t)row * D + l4 + 256 * j)); yv[j] = (f32x4){bflo(yw.x), bfhi(yw.x), bflo(yw.y), bfhi(yw.y)}; }
    } else {
        const bf16* sp = SL + (size_t)(row - 16384) * D + l4;
#pragma unroll
        for (int j = 0; j < 4; ++j) { const v2u w0 = __builtin_nontemporal_load((const v2u*)(sp + 256 * j)), w1 = __builtin_nontemporal_load((const v2u*)(sp + 4194304 + 256 * j)), w2 = __builtin_nontemporal_load((const v2u*)(sp + 2 * 4194304 + 256 * j)), w3 = __builtin_nontemporal_load((const v2u*)(sp + 3 * 4194304 + 256 * j));
            yv[j] = ((f32x4){bflo(w0.x), bfhi(w0.x), bflo(w0.y), bfhi(w0.y)} + (f32x4){bflo(w1.x), bfhi(w1.x), bflo(w1.y), bfhi(w1.y)}) +
                    ((f32x4){bflo(w2.x), bfhi(w2.x), bflo(w2.y), bfhi(w2.y)} + (f32x4){bflo(w3.x), bfhi(w3.x), bflo(w3.y), bfhi(w3.y)}); }
    }
}
struct RowVec { f32x4 gp[4], gt[4], gq[4], sc[4], sh[4]; };
__device__ __forceinline__ void row_post(f32x4 (&v)[4], const f32x4 (&yv)[4], const RowVec& R) {
    float s = 0.f;
#pragma unroll
    for (int j = 0; j < 4; ++j) s += (yv[j][0] * yv[j][0] + yv[j][1] * yv[j][1]) + (yv[j][2] * yv[j][2] + yv[j][3] * yv[j][3]);
    const float rstd = __builtin_amdgcn_rsqf(wave_sum(s) * (1.0f / 1024.0f) + EPS);
#pragma unroll
    for (int j = 0; j < 4; ++j) v[j] = v[j] + R.gt[j] * ((yv[j] * rstd) * R.gp[j]);
}
__device__ __forceinline__ void row_pass(Frame& F, const float* xa, const float* xb, bool xin_f32, bf16* XB, const bf16* Y, const bf16* SL, const float* g_post, const float* gate,
                                         const float* g_pre, const float* scale, const float* shift, bf16* H, bool has_post, bool has_pre) {
    const int gw = F.vcu * NWAVES + F.wave, NGW = F.G * NWAVES, l4 = F.lane * 4;
    RowVec R; int ncur = -1;
#pragma unroll
    for (int j = 0; j < 4; ++j) { R.gp[j] = has_post ? *(const f32x4*)(g_post + l4 + 256 * j) : (f32x4){0.f, 0.f, 0.f, 0.f}; R.gq[j] = has_pre ? *(const f32x4*)(g_pre + l4 + 256 * j) : (f32x4){0.f, 0.f, 0.f, 0.f};
        R.gt[j] = R.gp[j]; R.sc[j] = R.gp[j]; R.sh[j] = R.gp[j]; }
    for (int blk = gw; blk * 10 < M; blk += NGW) for (int i = 0; i < 10; i += 2) {
        const int row0 = blk * 10 + i; if (row0 >= M) break;
        const int n = row0 < M_CTX ? 8 : ((row0 - M_CTX) >> 11);
        if (n != ncur) { ncur = n;
#pragma unroll
            for (int j = 0; j < 4; ++j) { const int c = l4 + 256 * j;
                if (has_post) R.gt[j] = *(const f32x4*)(gate + (size_t)n * 6144 + c);
                if (has_pre) { R.sc[j] = *(const f32x4*)(scale + (size_t)n * 6144 + c); R.sh[j] = *(const f32x4*)(shift + (size_t)n * 6144 + c); } } }
        f32x4 v[2][4], yv[2][4];
#pragma unroll
        for (int q = 0; q < 2; ++q) { const int row = row0 + q;
            if (xin_f32) { const float* xr = row < M_CTX ? xa + (size_t)row * D : xb + (size_t)(row - M_CTX) * D;
#pragma unroll
                for (int j = 0; j < 4; ++j) v[q][j] = __builtin_nontemporal_load((const f32x4*)(xr + l4 + 256 * j));
            } else {
#pragma unroll
                for (int j = 0; j < 4; ++j) { const v2u xw = __builtin_nontemporal_load((const v2u*)(XB + (size_t)row * D + l4 + 256 * j)); v[q][j] = (f32x4){bflo(xw.x), bfhi(xw.x), bflo(xw.y), bfhi(xw.y)}; }
            }
            if (has_post) row_y(yv[q], Y, SL, row, l4); }
#pragma unroll
        for (int q = 0; q < 2; ++q) { const int row = row0 + q;
            if (has_post) {
                row_post(v[q], yv[q], R);
#pragma unroll
                for (int j = 0; j < 4; ++j) *(v2u*)(XB + (size_t)row * D + l4 + 256 * j) = (v2u){pk2(v[q][j][0], v[q][j][1]), pk2(v[q][j][2], v[q][j][3])};
            }
            if (has_pre) {
                float s = 0.f;
#pragma unroll
                for (int j = 0; j < 4; ++j) s += (v[q][j][0] * v[q][j][0] + v[q][j][1] * v[q][j][1]) + (v[q][j][2] * v[q][j][2] + v[q][j][3] * v[q][j][3]);
                const float rstd = __builtin_amdgcn_rsqf(wave_sum(s) * (1.0f / 1024.0f) + EPS);
#pragma unroll
                for (int j = 0; j < 4; ++j) { const f32x4 h = ((v[q][j] * rstd) * R.gq[j]) * (1.0f + R.sc[j]) + R.sh[j];
                    *(v2u*)(H + (size_t)row * D + l4 + 256 * j) = (v2u){pk2(h[0], h[1]), pk2(h[2], h[3])}; }
            } }
    }
}
struct RowDeal { int r0, cnt; bool tail; };
__device__ __forceinline__ RowDeal row_deal(int gw) { const int x = gw >> 8, w = gw & 255; RowDeal d;
    if (w < 171) { d.tail = false; d.r0 = 2048 * x + 12 * w; d.cnt = w < 170 ? 12 : 8; }
    else { const int u = w - 171; d.tail = true; d.r0 = 16384 + 512 * x + (u == 0 ? 0 : 8 + 6 * (u - 1)); d.cnt = u == 0 ? 8 : 6; }
    return d; }
struct RawN { v2u x[2][4], y[2][4]; };
struct RawT { v2u x[4], s[4][4]; };
__device__ __forceinline__ void row_mid_out(f32x4 (&v)[4], const f32x4 (&yv)[4], const RowVec& R, bf16* XB, bf16* H, int row, int l4) {
    row_post(v, yv, R);
#pragma unroll
    for (int j = 0; j < 4; ++j) *(v2u*)(XB + (size_t)row * D + l4 + 256 * j) = (v2u){pk2(v[j][0], v[j][1]), pk2(v[j][2], v[j][3])};
    float s = 0.f;
#pragma unroll
    for (int j = 0; j < 4; ++j) s += (v[j][0] * v[j][0] + v[j][1] * v[j][1]) + (v[j][2] * v[j][2] + v[j][3] * v[j][3]);
    const float rstd = __builtin_amdgcn_rsqf(wave_sum(s) * (1.0f / 1024.0f) + EPS);
#pragma unroll
    for (int j = 0; j < 4; ++j) { const f32x4 h = ((v[j] * rstd) * R.gq[j]) * (1.0f + R.sc[j]) + R.sh[j];
        *(v2u*)(H + (size_t)row * D + l4 + 256 * j) = (v2u){pk2(h[0], h[1]), pk2(h[2], h[3])}; }
}
__device__ __forceinline__ void row_pass_mid(Frame& F, bf16* XB, const bf16* Y, const bf16* SL, const float* g_post, const float* gate, const float* g_pre, const float* scale, const float* shift, bf16* H) {
    const int gw = F.vcu * NWAVES + F.wave, l4 = F.lane * 4;
    RowVec R; int ncur = -1;
#pragma unroll
    for (int j = 0; j < 4; ++j) { R.gp[j] = *(const f32x4*)(g_post + l4 + 256 * j); R.gq[j] = *(const f32x4*)(g_pre + l4 + 256 * j); R.gt[j] = R.gp[j]; R.sc[j] = R.gp[j]; R.sh[j] = R.gp[j]; }
#define RM_PARAMS(row) do { const int n_ = (row) < M_CTX ? 8 : (((row) - M_CTX) >> 11); if (n_ != ncur) { ncur = n_; \
        _Pragma("unroll") for (int j = 0; j < 4; ++j) { const int c = l4 + 256 * j; R.gt[j] = *(const f32x4*)(gate + (size_t)n_ * 6144 + c); R.sc[j] = *(const f32x4*)(scale + (size_t)n_ * 6144 + c); R.sh[j] = *(const f32x4*)(shift + (size_t)n_ * 6144 + c); } \
        __builtin_amdgcn_s_waitcnt(0x0F70); } } while (0)
#define RM_UNP(w) ((f32x4){bflo((w).x), bfhi((w).x), bflo((w).y), bfhi((w).y)})
#define RM_LOADN(S, row0) do { _Pragma("unroll") for (int q = 0; q < 2; ++q) _Pragma("unroll") for (int j = 0; j < 4; ++j) { \
            S.x[q][j] = __builtin_nontemporal_load((const v2u*)(XB + (size_t)((row0) + q) * D + l4 + 256 * j)); S.y[q][j] = __builtin_nontemporal_load((const v2u*)(Y + (size_t)((row0) + q) * D + l4 + 256 * j)); } } while (0)
#define RM_PROCN(S, row0) do { RM_PARAMS(row0); _Pragma("unroll") for (int q = 0; q < 2; ++q) { f32x4 v[4], yv[4]; \
            _Pragma("unroll") for (int j = 0; j < 4; ++j) { v[j] = RM_UNP(S.x[q][j]); yv[j] = RM_UNP(S.y[q][j]); } \
            row_mid_out(v, yv, R, XB, H, (row0) + q, l4); } } while (0)
#define RM_LOADT(S, row) do { const bf16* sp_ = SL + (size_t)((row) - 16384) * D + l4; _Pragma("unroll") for (int j = 0; j < 4; ++j) { \
            S.x[j] = __builtin_nontemporal_load((const v2u*)(XB + (size_t)(row) * D + l4 + 256 * j)); \
            _Pragma("unroll") for (int k = 0; k < 4; ++k) S.s[k][j] = __builtin_nontemporal_load((const v2u*)(sp_ + (size_t)k * 4194304 + 256 * j)); } } while (0)
#define RM_PROCT(S, row) do { RM_PARAMS(row); f32x4 v[4], yv[4]; \
            _Pragma("unroll") for (int j = 0; j < 4; ++j) { v[j] = RM_UNP(S.x[j]); yv[j] = (RM_UNP(S.s[0][j]) + RM_UNP(S.s[1][j])) + (RM_UNP(S.s[2][j]) + RM_UNP(S.s[3][j])); } \
            row_mid_out(v, yv, R, XB, H, (row), l4); } while (0)
    const RowDeal dl_ = row_deal(gw); const int r0 = dl_.r0, cnt = dl_.cnt;
    if (!dl_.tail) {
        RawN A, B;
        if (cnt == 12) {
            RM_LOADN(A, r0);
            RM_PARAMS(r0);
#pragma unroll
            for (int i = 0; i < 12; i += 4) {
                RM_LOADN(B, r0 + i + 2);
                RM_PROCN(A, r0 + i);
                if (i + 4 < 12) RM_LOADN(A, r0 + i + 4);
                RM_PROCN(B, r0 + i + 2);
            }
        } else {
            RM_PARAMS(r0);
            for (int i = 0; i < cnt; i += 2) { RM_LOADN(A, r0 + i); RM_PROCN(A, r0 + i); }
        }
    } else {
        RawT A, B;
        RM_LOADT(A, r0);
        RM_PARAMS(r0);
#pragma unroll
        for (int i = 0; i < 6; i += 2) {
            RM_LOADT(B, r0 + i + 1);
            RM_PROCT(A, r0 + i);
            if (i + 2 < 6) RM_LOADT(A, r0 + i + 2);
            RM_PROCT(B, r0 + i + 1);
        }
        for (int i = 6; i < cnt; ++i) { RM_LOADT(A, r0 + i); RM_PROCT(A, r0 + i); }
    }
#undef RM_LOADN
#undef RM_PROCN
#undef RM_LOADT
#undef RM_PROCT
#undef RM_UNP
#undef RM_PARAMS
}
template <bool POST>
__device__ __forceinline__ void row_pass_f32(Frame& F, const float* xa, const float* xb, bf16* XB, const bf16* Y, const bf16* SL, const float* g_post, const float* gate,
                                             const float* g_pre, const float* scale, const float* shift, bf16* H) {
    const int gw = F.vcu * NWAVES + F.wave, l4 = F.lane * 4;
    RowVec R; int ncur = -1;
#pragma unroll
    for (int j = 0; j < 4; ++j) { R.gq[j] = *(const f32x4*)(g_pre + l4 + 256 * j); R.gp[j] = POST ? *(const f32x4*)(g_post + l4 + 256 * j) : R.gq[j]; R.gt[j] = R.gq[j]; R.sc[j] = R.gq[j]; R.sh[j] = R.gq[j]; }
#define RX_PARAMS(row) do { const int n_ = (row) < M_CTX ? 8 : (((row) - M_CTX) >> 11); if (n_ != ncur) { ncur = n_; \
        _Pragma("unroll") for (int j = 0; j < 4; ++j) { const int c = l4 + 256 * j; if (POST) R.gt[j] = *(const f32x4*)(gate + (size_t)n_ * 6144 + c); R.sc[j] = *(const f32x4*)(scale + (size_t)n_ * 6144 + c); R.sh[j] = *(const f32x4*)(shift + (size_t)n_ * 6144 + c); } \
        __builtin_amdgcn_s_waitcnt(0x0F70); } } while (0)
#define RX_UNP(w) ((f32x4){bflo((w).x), bfhi((w).x), bflo((w).y), bfhi((w).y)})
#define RX_XROW(row) ((row) < M_CTX ? xa + (size_t)(row) * D : xb + (size_t)((row) - M_CTX) * D)
#define RX_OUT(v, yv, row) do { if (POST) { row_post(v, yv, R); \
            _Pragma("unroll") for (int j = 0; j < 4; ++j) *(v2u*)(XB + (size_t)(row) * D + l4 + 256 * j) = (v2u){pk2(v[j][0], v[j][1]), pk2(v[j][2], v[j][3])}; } \
        float s_ = 0.f; _Pragma("unroll") for (int j = 0; j < 4; ++j) s_ += (v[j][0] * v[j][0] + v[j][1] * v[j][1]) + (v[j][2] * v[j][2] + v[j][3] * v[j][3]); \
        const float rstd_ = __builtin_amdgcn_rsqf(wave_sum(s_) * (1.0f / 1024.0f) + EPS); \
        _Pragma("unroll") for (int j = 0; j < 4; ++j) { const f32x4 h = ((v[j] * rstd_) * R.gq[j]) * (1.0f + R.sc[j]) + R.sh[j]; \
            *(v2u*)(H + (size_t)(row) * D + l4 + 256 * j) = (v2u){pk2(h[0], h[1]), pk2(h[2], h[3])}; } } while (0)
    RowDeal dl_; if (POST) dl_ = row_deal(gw); else { dl_.tail = false; dl_.r0 = gw * 10; dl_.cnt = 10; }
    const int r0 = dl_.r0, cnt = dl_.cnt;
    if (!dl_.tail) {
        f32x4 xA[4], xB[4]; v2u yA[4], yB[4];
#define RX_LOADN(X, Yr, row) do { const float* xr_ = RX_XROW(row); _Pragma("unroll") for (int j = 0; j < 4; ++j) { \
            X[j] = __builtin_nontemporal_load((const f32x4*)(xr_ + l4 + 256 * j)); if (POST) Yr[j] = __builtin_nontemporal_load((const v2u*)(Y + (size_t)(row) * D + l4 + 256 * j)); } } while (0)
#define RX_PROCN(X, Yr, row) do { RX_PARAMS(row); f32x4 v[4], yv[4]; \
            _Pragma("unroll") for (int j = 0; j < 4; ++j) { v[j] = X[j]; yv[j] = POST ? RX_UNP(Yr[j]) : v[j]; } RX_OUT(v, yv, (row)); } while (0)
        if (cnt == 12) {
            RX_LOADN(xA, yA, r0);
            RX_PARAMS(r0);
#pragma unroll
            for (int i = 0; i < 12; i += 2) { RX_LOADN(xB, yB, r0 + i + 1); RX_PROCN(xA, yA, r0 + i); if (i + 2 < 12) RX_LOADN(xA, yA, r0 + i + 2); RX_PROCN(xB, yB, r0 + i + 1); }
        } else if (cnt == 10) {
            RX_LOADN(xA, yA, r0);
            RX_PARAMS(r0);
#pragma unroll
            for (int i = 0; i < 10; i += 2) { RX_LOADN(xB, yB, r0 + i + 1); RX_PROCN(xA, yA, r0 + i); if (i + 2 < 10) RX_LOADN(xA, yA, r0 + i + 2); RX_PROCN(xB, yB, r0 + i + 1); }
        } else {
            RX_PARAMS(r0);
            for (int i = 0; i < cnt; ++i) { RX_LOADN(xA, yA, r0 + i); RX_PROCN(xA, yA, r0 + i); }
        }
#undef RX_LOADN
#undef RX_PROCN
    } else {
        f32x4 xA[4]; v2u sA[4][4];
        RX_PARAMS(r0);
        for (int i = 0; i < cnt; ++i) { const int row = r0 + i; const float* xr_ = RX_XROW(row); const bf16* sp_ = SL + (size_t)(row - 16384) * D + l4;
#pragma unroll
            for (int j = 0; j < 4; ++j) { xA[j] = __builtin_nontemporal_load((const f32x4*)(xr_ + l4 + 256 * j));
#pragma unroll
                for (int k = 0; k < 4; ++k) sA[k][j] = __builtin_nontemporal_load((const v2u*)(sp_ + (size_t)k * 4194304 + 256 * j)); }
            RX_PARAMS(row); f32x4 v[4], yv[4];
#pragma unroll
            for (int j = 0; j < 4; ++j) { v[j] = xA[j]; yv[j] = (RX_UNP(sA[0][j]) + RX_UNP(sA[1][j])) + (RX_UNP(sA[2][j]) + RX_UNP(sA[3][j])); }
            RX_OUT(v, yv, row); }
    }
#undef RX_PARAMS
#undef RX_UNP
#undef RX_XROW
#undef RX_OUT
}
__device__ __forceinline__ void row_pass_final2(Frame& F, const XcdBarrier& bar, const bf16* XB, float* OUT, const bf16* Y, const bf16* SL, const float* g_post, const float* gate) {
    const int gw = F.vcu * NWAVES + F.wave, l4 = F.lane * 4;
    RowVec R; int ncur = -1;
#define RF_PARAMS(row) do { const int n_ = (row) < M_CTX ? 8 : (((row) - M_CTX) >> 11); if (n_ != ncur) { ncur = n_; \
        _Pragma("unroll") for (int j = 0; j < 4; ++j) R.gt[j] = *(const f32x4*)(gate + (size_t)n_ * 6144 + l4 + 256 * j); \
        __builtin_amdgcn_s_waitcnt(0x0F70); } } while (0)
#define RF_UNP(w) ((f32x4){bflo((w).x), bfhi((w).x), bflo((w).y), bfhi((w).y)})
#define RF_OUT(xr, yv, row) do { f32x4 v[4]; _Pragma("unroll") for (int j = 0; j < 4; ++j) v[j] = RF_UNP(xr[j]); row_post(v, yv, R); \
        _Pragma("unroll") for (int j = 0; j < 4; ++j) *(f32x4*)(OUT + (size_t)(row) * D + l4 + 256 * j) = v[j]; } while (0)
    const RowDeal dl_ = row_deal(gw); const int r0 = dl_.r0, cnt = dl_.cnt;
    if (!dl_.tail) {
        const bool full = cnt == 12;
        v2u xw[12][4];
#pragma unroll
        for (int i = 0; i < 12; ++i) if (full || i < 8) {
#pragma unroll
            for (int j = 0; j < 4; ++j) xw[i][j] = __builtin_nontemporal_load((const v2u*)(XB + (size_t)(r0 + i) * D + l4 + 256 * j)); }
        xcd_barrier(bar);
#pragma unroll
        for (int j = 0; j < 4; ++j) { R.gp[j] = *(const f32x4*)(g_post + l4 + 256 * j); R.gt[j] = R.gp[j]; }
#define RF_LOADN(S, row) do { _Pragma("unroll") for (int j = 0; j < 4; ++j) S[j] = __builtin_nontemporal_load((const v2u*)(Y + (size_t)(row) * D + l4 + 256 * j)); } while (0)
#define RF_PROCN(S, i, row) do { RF_PARAMS(row); f32x4 yv[4]; _Pragma("unroll") for (int j = 0; j < 4; ++j) yv[j] = RF_UNP(S[j]); RF_OUT(xw[i], yv, row); } while (0)
        v2u A[4], B[4], C[4];
        if (full) {
            RF_LOADN(A, r0); RF_LOADN(B, r0 + 1); RF_LOADN(C, r0 + 2);
            RF_PARAMS(r0);
#pragma unroll
            for (int i = 0; i < 12; i += 3) {
                RF_PROCN(A, i, r0 + i); if (i + 3 < 12) RF_LOADN(A, r0 + i + 3);
                RF_PROCN(B, i + 1, r0 + i + 1); if (i + 4 < 12) RF_LOADN(B, r0 + i + 4);
                RF_PROCN(C, i + 2, r0 + i + 2); if (i + 5 < 12) RF_LOADN(C, r0 + i + 5);
            }
        } else {
#pragma unroll
            RF_PARAMS(r0);
#pragma unroll
            for (int i = 0; i < 8; ++i) { RF_LOADN(A, r0 + i); RF_PROCN(A, i, r0 + i); }
        }
#undef RF_LOADN
#undef RF_PROCN
    } else {
        v2u xw[8][4];
#pragma unroll
        for (int i = 0; i < 8; ++i) if (i < cnt) {
#pragma unroll
            for (int j = 0; j < 4; ++j) xw[i][j] = __builtin_nontemporal_load((const v2u*)(XB + (size_t)(r0 + i) * D + l4 + 256 * j)); }
        xcd_barrier(bar);
#pragma unroll
        for (int j = 0; j < 4; ++j) { R.gp[j] = *(const f32x4*)(g_post + l4 + 256 * j); R.gt[j] = R.gp[j]; }
#define RF_LOADT(S, row) do { const bf16* sp_ = SL + (size_t)((row) - 16384) * D + l4; _Pragma("unroll") for (int k = 0; k < 4; ++k) _Pragma("unroll") for (int j = 0; j < 4; ++j) \
            S[k][j] = __builtin_nontemporal_load((const v2u*)(sp_ + (size_t)k * 4194304 + 256 * j)); } while (0)
#define RF_PROCT(S, i, row) do { RF_PARAMS(row); f32x4 yv[4]; _Pragma("unroll") for (int j = 0; j < 4; ++j) yv[j] = (RF_UNP(S[0][j]) + RF_UNP(S[1][j])) + (RF_UNP(S[2][j]) + RF_UNP(S[3][j])); RF_OUT(xw[i], yv, row); } while (0)
        v2u A[4][4], B[4][4];
        RF_LOADT(A, r0);
        RF_PARAMS(r0);
#pragma unroll
        for (int i = 0; i < 6; i += 2) {
            RF_LOADT(B, r0 + i + 1);
            RF_PROCT(A, i, r0 + i);
            if (i + 2 < 6) RF_LOADT(A, r0 + i + 2);
            RF_PROCT(B, i + 1, r0 + i + 1);
        }
        if (cnt == 8) { RF_LOADT(A, r0 + 6); RF_LOADT(B, r0 + 7); RF_PROCT(A, 6, r0 + 6); RF_PROCT(B, 7, r0 + 7); }
#undef RF_LOADT
#undef RF_PROCT
    }
#undef RF_PARAMS
#undef RF_UNP
#undef RF_OUT
}
__device__ __forceinline__ void row_pass_final(Frame& F, const XcdBarrier& bar, const bf16* XB, float* OUT, const bf16* Y, const bf16* SL, const float* g_post, const float* gate) {
    const int gw = F.vcu * NWAVES + F.wave, l4 = F.lane * 4;
    v2u xw[10][4];
#pragma unroll
    for (int i = 0; i < 10; ++i) { const int row = gw * 10 + i;
        if (row < M) {
#pragma unroll
            for (int j = 0; j < 4; ++j) xw[i][j] = __builtin_nontemporal_load((const v2u*)(XB + (size_t)row * D + l4 + 256 * j));
        } }
    xcd_barrier(bar);
    RowVec R; int ncur = -1;
#pragma unroll
    for (int j = 0; j < 4; ++j) { R.gp[j] = *(const f32x4*)(g_post + l4 + 256 * j); R.gt[j] = R.gp[j]; }
#pragma unroll
    for (int i = 0; i < 10; ++i) { const int row = gw * 10 + i;
        if (row < M) {
            const int n = row < M_CTX ? 8 : ((row - M_CTX) >> 11);
            if (n != ncur) { ncur = n;
#pragma unroll
                for (int j = 0; j < 4; ++j) R.gt[j] = *(const f32x4*)(gate + (size_t)n * 6144 + l4 + 256 * j); }
            f32x4 v[4], yv[4];
#pragma unroll
            for (int j = 0; j < 4; ++j) v[j] = (f32x4){bflo(xw[i][j].x), bfhi(xw[i][j].x), bflo(xw[i][j].y), bfhi(xw[i][j].y)};
            row_y(yv, Y, SL, row, l4); row_post(v, yv, R);
#pragma unroll
            for (int j = 0; j < 4; ++j) *(f32x4*)(OUT + (size_t)row * D + l4 + 256 * j) = v[j];
        } }
}

__device__ __forceinline__ int crow(int r, int hi) { return (r & 3) + 8 * (r >> 2) + 4 * hi; }
__device__ __forceinline__ unsigned cvtpk(float lo, float hi) { return pk2(lo, hi); }
#define SBAR() __builtin_amdgcn_sched_barrier(0)
__device__ __forceinline__ int vst_row(int k, int NB) { const int kk = (k & ~0xC) | ((k & 4) << 1) | ((k & 8) >> 1); return (kk >> 3) * NB * 512 + (kk & 7) * 64; }
__device__ __forceinline__ int vst(int k, int c, int NB) { return vst_row(k, NB) + (c >> 5) * 512 + (c & 31) * 2; }
__device__ __forceinline__ int v_rd_base(int lane) { return ((lane & 3) << 3) | (((lane >> 2) & 3) << 6) | (((lane >> 4) & 1) << 5) | (((lane >> 5) & 1) << 8); }
template <int OFF> __device__ __forceinline__ s16x4 tr_read(unsigned vb) { s16x4 r; asm volatile("ds_read_b64_tr_b16 %0, %1 offset:%2" : "=&v"(r) : "v"(vb), "i"(OFF) : "memory"); return r; }
#define PKF(L, H) ((bf16x8){L[0], L[1], L[2], L[3], H[0], H[1], H[2], H[3]})
#define PK4(P, BASE, OUT) do { unsigned a0_ = cvtpk(P[BASE + 0], P[BASE + 1]), a1_ = cvtpk(P[BASE + 2], P[BASE + 3]);   \
    unsigned b0_ = cvtpk(P[BASE + 4], P[BASE + 5]), b1_ = cvtpk(P[BASE + 6], P[BASE + 7]);                              \
    auto r0_ = __builtin_amdgcn_permlane32_swap(a0_, b0_, false, false); auto r1_ = __builtin_amdgcn_permlane32_swap(a1_, b1_, false, false); \
    v4u w_ = {r0_[0], r1_[0], r0_[1], r1_[1]}; OUT = __builtin_bit_cast(bf16x8, w_); } while (0)
__device__ __forceinline__ float fexp(float x) { return __builtin_amdgcn_exp2f(x * 1.4426950408889634f); }
__device__ __forceinline__ float logsig(float x) { return fminf(x, 0.f) - 0.6931471805599453f * __builtin_amdgcn_logf(1.0f + __builtin_amdgcn_exp2f(-1.4426950408889634f * fabsf(x))); }

constexpr int SC_T = 0  , SC_TSZ = 32768, SC_QD = 0, SC_KI = 8192, SC_VT = 16384, SC_ST = 65536, SC_BT = 81920  , SC_TOT = 114688, SC_DL = 115200  ;
__device__ __forceinline__ void scan_phase(Frame& F, const Params& P, int li) {
    unsigned char* ws = PWS;
    const bf16* PROJ = (const bf16*)(ws + WS_BIG);
    const float* ROPE = (const float*)(ws + WS_ROPE);
    LAS unsigned char* G = F.lds;
    const unsigned gaddr = (unsigned)(uintptr_t)G;
    const bool isP = F.wave >= 4; const int gw4 = F.wave & 3;
    const int ri = gw4 >> 1, dh = gw4 & 1;
#define SC_BAR() do { asm volatile("s_waitcnt lgkmcnt(0)" ::: "memory"); __builtin_amdgcn_s_barrier(); asm volatile("" ::: "memory"); } while (0)
#define SC_TOK(c, i) (dir == 0 ? 64 * (c) + (i) : L - 1 - (64 * (c) + (i)))
    for (int u0 = F.bid; u0 < 256; u0 += F.G) for (int kk_ = 0; kk_ < (u0 < 128 ? 1 : 2); ++kk_) {
        __syncthreads();
        const bool lat = u0 < 128; const int u = lat ? u0 : 2 * (u0 - 128) + kk_;
        const int sb = u >> 4, hh = (u >> 1) & 7, dir = u & 1;
        const int L = lat ? L_LAT : L_CTX, row0 = lat ? M_CTX + sb * L_LAT : sb * L_CTX, NC = L / 64;
        const bool gla = hh < 4; const int h = hh & 3;
        const int qc = (gla ? PC_QA : PC_QB) + h * 64, kc = (gla ? PC_KA : PC_KB) + h * 64, vc = (gla ? PC_VA : PC_VB) + h * 128, gkc = PC_GK + dir * 16;
        bf16* OUT = (bf16*)(ws + (dir == 0 ? WS_Y : WS_HB));
        const float* rdec_p = PIN(I_RDEC); const float* wgk2_p = PIN(I_WGK2); const float* bgk2_p = PIN(I_BGK2);
        const float lgr = gla ? 0.f : -fexp(rdec_p[(li * 2 + dir) * 4 + h]);
        f32x16 sacc[2]; sacc[0] = f32x16{}; sacc[1] = f32x16{}; v4u w2f = {0u, 0u, 0u, 0u}; float gbias = 0.f;
        { int t0_ = F.tid; asm volatile("" : "+v"(t0_)); const int lane = t0_ & 63, r32 = lane & 31, hi = lane >> 5;
          if (isP) {
              if (gla) { const int kcol = h * 64 + 32 * (gw4 & 1) + r32; const float* wp_ = wgk2_p + ((size_t)(li * 2 + dir) * 16 + 8 * hi) * 256 + kcol;
                  w2f = (v4u){pk2(wp_[0], wp_[256]), pk2(wp_[512], wp_[768]), pk2(wp_[1024], wp_[1280]), pk2(wp_[1536], wp_[1792])};
                  gbias = bgk2_p[(li * 2 + dir) * 256 + kcol]; }
              else if (t0_ < 256 + 192) ((LAS float*)(G + SC_DL))[t0_ - 256] = fexp(64.0f * lgr);
          } else {
              const float* S0 = (gla ? PIN(I_SGLA) : PIN(I_SRET)) + ((size_t)((sb * 2 + li) * 2 + dir) * 4 + h) * 8192;
              if (lat) {
#pragma unroll
                  for (int d = 0; d < 2; ++d)
#pragma unroll
                      for (int r = 0; r < 16; ++r) sacc[d][r] = S0[(32 * ri + crow(r, hi)) * 128 + 32 * (2 * dh + d) + r32];
              }
#pragma unroll
              for (int d = 0; d < 2; ++d)
#pragma unroll
                  for (int r = 0; r < 16; r += 2) { const unsigned w = pk2(sacc[d][r], sacc[d][r + 1]);
                      LAS unsigned char* sp_ = G + SC_ST + (hi + 4 * ri) * 2048 + (2 * dh + d) * 512 + r32 * 2 + ((r >> 3) & 1) * 4096 + ((r & 3) + 4 * ((r >> 2) & 1)) * 64;
                      *(LAS unsigned short*)sp_ = (unsigned short)w; *(LAS unsigned short*)(sp_ + 64) = (unsigned short)(w >> 16); }
          } }
        v4u pq0 = {}, pq1 = {}, pk0 = {}, pk1 = {}, pv[4] = {}; v4u pga = {0u, 0u, 0u, 0u}; float cs[16] = {}; float tsum = 0.f;
#define SC_LOADRAW(c) do { const unsigned ro_ = (unsigned)(row0 + SC_TOK(c, sti)) * (unsigned)(EVEN_NP * 2); const char* pc_ = (const char*)PROJ; \
        pq0 = *(const v4u*)(pc_ + (ro_ + (unsigned)(qc + 8 * c8) * 2u)); pq1 = *(const v4u*)(pc_ + (ro_ + (unsigned)(qc + 32 + 8 * c8) * 2u)); \
        pk0 = *(const v4u*)(pc_ + (ro_ + (unsigned)(kc + 8 * c8) * 2u)); pk1 = *(const v4u*)(pc_ + (ro_ + (unsigned)(kc + 32 + 8 * c8) * 2u)); \
        _Pragma("unroll") for (int m_ = 0; m_ < 4; ++m_) pv[m_] = *(const v4u*)(pc_ + (ro_ + (unsigned)(vc + c8 * 32 + 8 * m_) * 2u)); } while (0)
#define SC_LOADGK(c) do { const char* gp_ = (const char*)PROJ + ((unsigned)(row0 + SC_TOK(c, 32 * (gw4 >> 1) + r32)) * (unsigned)(EVEN_NP * 2) + (unsigned)(gkc + 8 * hi) * 2u); \
        pga = *(const v4u*)gp_; \
        if (row0 >= 16384) { const v4u p1_ = *(const v4u*)(gp_ + 64), p2_ = *(const v4u*)(gp_ + 128), p3_ = *(const v4u*)(gp_ + 192); \
            _Pragma("unroll") for (int e_ = 0; e_ < 4; ++e_) pga[e_] = pk2((bflo(pga[e_]) + bflo(p1_[e_])) + (bflo(p2_[e_]) + bflo(p3_[e_])), (bfhi(pga[e_]) + bfhi(p1_[e_])) + (bfhi(p2_[e_]) + bfhi(p3_[e_]))); } } while (0)
        if (isP && gla) { int t0_ = F.tid; asm volatile("" : "+v"(t0_)); const int r32 = t0_ & 31, hi = (t0_ >> 5) & 1; SC_LOADGK(0); }
        for (int s = -3; s < NC; ++s) {
            int tid_o = F.tid; asm volatile("" : "+v"(tid_o));
            const int lane = tid_o & 63, r32 = lane & 31, hi = lane >> 5, tgp = tid_o & 255, sti = tgp >> 2, c8 = tgp & 3;
            if (isP) {
                if (gla && s + 2 >= 0 && s + 2 < NC) {
                    const int th = gw4 >> 1, kq = 32 * (gw4 & 1) + r32; LAS float* BTw = (LAS float*)(G + SC_BT + ((s + 2) & 1) * 16384);
                    const float t0v = ((LAS float*)(G + SC_TOT))[kq]; const float pre = th ? t0v : 0.f;
#pragma unroll
                    for (int r = 0; r < 16; ++r) BTw[(32 * th + crow(r, hi)) * 64 + kq] = pre + cs[r];
                    if (th == 1 && hi == 0) ((LAS float*)(G + SC_DL))[((s + 2) % 3) * 64 + kq] = fexp(pre + tsum);
                }
                if (s + 1 >= 0 && s + 1 < NC) {
                    LAS unsigned char* T = G + SC_T + ((s + 1) & 1) * SC_TSZ;
                    float q[16], kk[16];
#define UNPK(dst, o, W_) do { const v4u w_ = (W_); dst[o + 0] = bflo(w_[0]); dst[o + 1] = bfhi(w_[0]); dst[o + 2] = bflo(w_[1]); dst[o + 3] = bfhi(w_[1]); dst[o + 4] = bflo(w_[2]); dst[o + 5] = bfhi(w_[2]); dst[o + 6] = bflo(w_[3]); dst[o + 7] = bfhi(w_[3]); } while (0)
                    UNPK(q, 0, pq0); UNPK(q, 8, pq1); UNPK(kk, 0, pk0); UNPK(kk, 8, pk1);
                    if (gla) {
                        const LAS float* BTr = (const LAS float*)(G + SC_BT + ((s + 1) & 1) * 16384) + sti * 64 + 8 * c8;
                        const f32x4 x0 = *(const LAS f32x4*)BTr, x1 = *(const LAS f32x4*)(BTr + 4), x2 = *(const LAS f32x4*)(BTr + 32), x3 = *(const LAS f32x4*)(BTr + 36);
#pragma unroll
                        for (int e = 0; e < 4; ++e) { const float e0 = fexp(x0[e]), e1 = fexp(x1[e]), e2 = fexp(x2[e]), e3 = fexp(x3[e]);
                            q[e] *= 0.125f * e0; kk[e] *= __builtin_amdgcn_rcpf(e0); q[4 + e] *= 0.125f * e1; kk[4 + e] *= __builtin_amdgcn_rcpf(e1);
                            q[8 + e] *= 0.125f * e2; kk[8 + e] *= __builtin_amdgcn_rcpf(e2); q[12 + e] *= 0.125f * e3; kk[12 + e] *= __builtin_amdgcn_rcpf(e3); }
                    } else {
                        if (lat) {
                            const float* cp = ROPE + (size_t)SC_TOK(s + 1, sti) * 32 + 8 * c8; const f32x4 c0 = *(const f32x4*)cp, c1 = *(const f32x4*)(cp + 4), s0 = *(const f32x4*)(cp + 65536), s1 = *(const f32x4*)(cp + 65540);
#pragma unroll
                            for (int e = 0; e < 8; ++e) { const float c = e < 4 ? c0[e & 3] : c1[e & 3], sn = e < 4 ? s0[e & 3] : s1[e & 3];
                                const float q1 = q[e], q2 = q[8 + e]; q[e] = q1 * c - q2 * sn; q[8 + e] = q1 * sn + q2 * c;
                                const float k1 = kk[e], k2 = kk[8 + e]; kk[e] = k1 * c - k2 * sn; kk[8 + e] = k1 * sn + k2 * c; }
                        }
                        const float bb = (float)(sti + 1) * lgr, eb = fexp(bb), ek = 0.125f * __builtin_amdgcn_rcpf(eb);
#pragma unroll
                        for (int e = 0; e < 16; ++e) { q[e] *= eb; kk[e] *= ek; }
                    }
                    *(LAS v4u*)(T + SC_QD + vst(sti, 8 * c8, 2)) = (v4u){pk2(q[0], q[1]), pk2(q[2], q[3]), pk2(q[4], q[5]), pk2(q[6], q[7])};
                    *(LAS v4u*)(T + SC_QD + vst(sti, 32 + 8 * c8, 2)) = (v4u){pk2(q[8], q[9]), pk2(q[10], q[11]), pk2(q[12], q[13]), pk2(q[14], q[15])};
                    *(LAS v4u*)(T + SC_KI + vst(sti, 8 * c8, 2)) = (v4u){pk2(kk[0], kk[1]), pk2(kk[2], kk[3]), pk2(kk[4], kk[5]), pk2(kk[6], kk[7])};
                    *(LAS v4u*)(T + SC_KI + vst(sti, 32 + 8 * c8, 2)) = (v4u){pk2(kk[8], kk[9]), pk2(kk[10], kk[11]), pk2(kk[12], kk[13]), pk2(kk[14], kk[15])};
#pragma unroll
                    for (int m = 0; m < 4; ++m) *(LAS v4u*)(T + SC_VT + vst(sti, c8 * 32 + 8 * m, 4)) = pv[m];
                }
                if (s + 2 >= 0 && s + 2 < NC) SC_LOADRAW(s + 2);
            } else if (s >= 0) {
                LAS unsigned char* T = G + SC_T + (s & 1) * SC_TSZ; const unsigned taddr = gaddr + SC_T + (s & 1) * SC_TSZ;
                bf16x8 qf[4]; bf16x8 pa0, pa1, pa2, pa3;
                { const int qb_ = vst_row(32 * ri + r32, 2) + 16 * hi;
                  qf[0] = *(const LAS bf16x8*)(T + SC_QD + qb_); qf[1] = *(const LAS bf16x8*)(T + SC_QD + qb_ + 32); qf[2] = *(const LAS bf16x8*)(T + SC_QD + qb_ + 512); qf[3] = *(const LAS bf16x8*)(T + SC_QD + qb_ + 544); }
                { f32x16 p0 = {}, p1 = {};
                  const int kb0 = vst_row(r32, 2) + 16 * hi, kb1 = vst_row(32 + r32, 2) + 16 * hi;
                  { const bf16x8 a0 = *(const LAS bf16x8*)(T + SC_KI + kb0), a1 = *(const LAS bf16x8*)(T + SC_KI + kb0 + 32), a2 = *(const LAS bf16x8*)(T + SC_KI + kb0 + 512), a3 = *(const LAS bf16x8*)(T + SC_KI + kb0 + 544);
                    p0 = __builtin_amdgcn_mfma_f32_32x32x16_bf16(a0, qf[0], p0, 0, 0, 0); p0 = __builtin_amdgcn_mfma_f32_32x32x16_bf16(a1, qf[1], p0, 0, 0, 0);
                    p0 = __builtin_amdgcn_mfma_f32_32x32x16_bf16(a2, qf[2], p0, 0, 0, 0); p0 = __builtin_amdgcn_mfma_f32_32x32x16_bf16(a3, qf[3], p0, 0, 0, 0); }
                  if (ri == 1) {
                      const bf16x8 c0 = *(const LAS bf16x8*)(T + SC_KI + kb1), c1 = *(const LAS bf16x8*)(T + SC_KI + kb1 + 32), c2 = *(const LAS bf16x8*)(T + SC_KI + kb1 + 512), c3 = *(const LAS bf16x8*)(T + SC_KI + kb1 + 544);
                      p1 = __builtin_amdgcn_mfma_f32_32x32x16_bf16(c0, qf[0], p1, 0, 0, 0); p1 = __builtin_amdgcn_mfma_f32_32x32x16_bf16(c1, qf[1], p1, 0, 0, 0);
                      p1 = __builtin_amdgcn_mfma_f32_32x32x16_bf16(c2, qf[2], p1, 0, 0, 0); p1 = __builtin_amdgcn_mfma_f32_32x32x16_bf16(c3, qf[3], p1, 0, 0, 0); }
#pragma unroll
                  for (int r = 0; r < 16; ++r) { const bool keep = crow(r, hi) <= r32; if (ri == 0) { p0[r] = keep ? p0[r] : 0.f; } else { p1[r] = keep ? p1[r] : 0.f; } }
                  PK4(p0, 0, pa0); PK4(p0, 8, pa1); PK4(p1, 0, pa2); PK4(p1, 8, pa3); }
                const unsigned vb = taddr + SC_VT + v_rd_base(lane) + dh * 1024, sbv = gaddr + SC_ST + v_rd_base(lane) + dh * 1024;
#define SC_RD8(raw, base, d) do { raw[0] = tr_read<(d) * 512>(base); raw[1] = tr_read<(d) * 512 + 2048>(base); raw[2] = tr_read<(d) * 512 + 4096>(base); raw[3] = tr_read<(d) * 512 + 4096 + 2048>(base); \
                  raw[4] = tr_read<(d) * 512 + 8192>(base); raw[5] = tr_read<(d) * 512 + 8192 + 2048>(base); raw[6] = tr_read<(d) * 512 + 12288>(base); raw[7] = tr_read<(d) * 512 + 12288 + 2048>(base); } while (0)
#define SC_LWAIT() do { asm volatile("s_waitcnt lgkmcnt(0)" ::: "memory"); SBAR(); } while (0)
#define SC_OBLK(d, rv, rs) do { f32x16 o_ = {}; \
                  o_ = __builtin_amdgcn_mfma_f32_32x32x16_bf16(pa0, PKF(rv[0], rv[1]), o_, 0, 0, 0); o_ = __builtin_amdgcn_mfma_f32_32x32x16_bf16(pa1, PKF(rv[2], rv[3]), o_, 0, 0, 0); \
                  if (ri == 1) { o_ = __builtin_amdgcn_mfma_f32_32x32x16_bf16(pa2, PKF(rv[4], rv[5]), o_, 0, 0, 0); o_ = __builtin_amdgcn_mfma_f32_32x32x16_bf16(pa3, PKF(rv[6], rv[7]), o_, 0, 0, 0); } \
                  o_ = __builtin_amdgcn_mfma_f32_32x32x16_bf16(qf[0], PKF(rs[0], rs[1]), o_, 0, 0, 0); o_ = __builtin_amdgcn_mfma_f32_32x32x16_bf16(qf[1], PKF(rs[2], rs[3]), o_, 0, 0, 0); \
                  o_ = __builtin_amdgcn_mfma_f32_32x32x16_bf16(qf[2], PKF(rs[4], rs[5]), o_, 0, 0, 0); o_ = __builtin_amdgcn_mfma_f32_32x32x16_bf16(qf[3], PKF(rs[6], rs[7]), o_, 0, 0, 0); \
                  char* dst_ = (char*)OUT; \
                  _Pragma("unroll") for (int r = 0; r < 16; r += 2) { const int i_ = 32 * ri + crow(r, hi); const int t_ = SC_TOK(s, i_); const unsigned w_ = pk2(o_[r], o_[r + 1]); \
                      const unsigned a_ = (unsigned)(row0 + t_) * (unsigned)(D * 2) + (unsigned)(hh * 128 + 64 * dh + 32 * (d) + r32) * 2u; \
                      *(bf16*)(dst_ + a_) = (bf16)w_; *(bf16*)(dst_ + (dir == 0 ? a_ + (unsigned)(D * 2) : a_ - (unsigned)(D * 2))) = (bf16)(w_ >> 16); } SBAR(); } while (0)
                { s16x4 rv0[8], rs0[8], rv1[8], rs1[8];
                  SC_RD8(rv0, vb, 0); SC_RD8(rs0, sbv, 0); SC_LWAIT();
                  SC_RD8(rv1, vb, 1); SC_RD8(rs1, sbv, 1);
                  SC_OBLK(0, rv0, rs0); SC_LWAIT();
                  SC_OBLK(1, rv1, rs1); }
            }
            SC_BAR();
            if (isP) {
                if (gla && s + 3 < NC) {
                    const int th = gw4 >> 1, kq = 32 * (gw4 & 1) + r32;
                    f32x16 gp;
#pragma unroll
                    for (int r = 0; r < 16; ++r) gp[r] = gbias;
                    gp = __builtin_amdgcn_mfma_f32_32x32x16_bf16(__builtin_bit_cast(bf16x8, pga), __builtin_bit_cast(bf16x8, w2f), gp, 0, 0, 0);
                    float g4[4], o4[4];
#pragma unroll
                    for (int j = 0; j < 4; ++j) { float run = 0.f;
#pragma unroll
                        for (int e = 0; e < 4; ++e) { run += logsig(gp[4 * j + e]) * (1.0f / 16.0f); cs[4 * j + e] = run; }
                        g4[j] = run; }
#pragma unroll
                    for (int j = 0; j < 4; ++j) o4[j] = __shfl_xor(g4[j], 32);
                    float acc_ = 0.f;
#pragma unroll
                    for (int j = 0; j < 4; ++j) { const float off = acc_ + (hi ? o4[j] : 0.f);
#pragma unroll
                        for (int e = 0; e < 4; ++e) cs[4 * j + e] += off;
                        acc_ += g4[j] + o4[j]; }
                    tsum = acc_;
                    if (hi == 0) ((LAS float*)(G + SC_TOT))[th * 64 + kq] = tsum;
                    if (s + 4 < NC) SC_LOADGK(s + 4);
                }
            } else if (s >= 0) {
                const unsigned taddr = gaddr + SC_T + (s & 1) * SC_TSZ;
                const unsigned vb = taddr + SC_VT + v_rd_base(lane) + dh * 1024, kt = taddr + SC_KI + v_rd_base(lane) + ri * 512;
                s16x4 rk[8], rv0[8], rv1[8];
                rk[0] = tr_read<0>(kt); rk[1] = tr_read<1024>(kt); rk[2] = tr_read<2048>(kt); rk[3] = tr_read<2048 + 1024>(kt); rk[4] = tr_read<4096>(kt); rk[5] = tr_read<4096 + 1024>(kt); rk[6] = tr_read<6144>(kt); rk[7] = tr_read<6144 + 1024>(kt);
                SC_RD8(rv0, vb, 0); SC_LWAIT();
                SC_RD8(rv1, vb, 1);
                bf16x8 kf[4]; kf[0] = PKF(rk[0], rk[1]); kf[1] = PKF(rk[2], rk[3]); kf[2] = PKF(rk[4], rk[5]); kf[3] = PKF(rk[6], rk[7]);
                const int stb_ = (hi + 4 * ri) * 2048 + (2 * dh) * 512 + r32 * 2;
                const LAS float* DLr = (const LAS float*)(G + SC_DL) + (s % 3) * 64;
#define SC_SBLK(d, rv) do { \
                  sacc[d] = __builtin_amdgcn_mfma_f32_32x32x16_bf16(kf[0], PKF(rv[0], rv[1]), sacc[d], 0, 0, 0); sacc[d] = __builtin_amdgcn_mfma_f32_32x32x16_bf16(kf[1], PKF(rv[2], rv[3]), sacc[d], 0, 0, 0); \
                  sacc[d] = __builtin_amdgcn_mfma_f32_32x32x16_bf16(kf[2], PKF(rv[4], rv[5]), sacc[d], 0, 0, 0); sacc[d] = __builtin_amdgcn_mfma_f32_32x32x16_bf16(kf[3], PKF(rv[6], rv[7]), sacc[d], 0, 0, 0); \
                  _Pragma("unroll") for (int r = 0; r < 16; r += 2) { const int dk = 32 * ri + crow(r, hi); const float dl0 = DLr[dk], dl1 = DLr[dk + 1]; \
                      sacc[d][r] *= dl0; sacc[d][r + 1] *= dl1; const unsigned w_ = pk2(sacc[d][r], sacc[d][r + 1]); \
                      LAS unsigned char* sp_ = G + SC_ST + stb_ + (d) * 512 + ((r >> 3) & 1) * 4096 + ((r & 3) + 4 * ((r >> 2) & 1)) * 64; \
                      *(LAS unsigned short*)sp_ = (unsigned short)w_; *(LAS unsigned short*)(sp_ + 64) = (unsigned short)(w_ >> 16); } SBAR(); } while (0)
                SC_SBLK(0, rv0); SC_LWAIT();
                SC_SBLK(1, rv1);
            }
            SC_BAR();
        }
        if (!lat && !isP) { int l2 = F.lane; asm volatile("" : "+v"(l2)); const int r32 = l2 & 31, hi = l2 >> 5; float* SO = POUT + (gla ? OUT_SGLA : OUT_SRET) + ((size_t)((sb * 2 + li) * 2 + dir) * 4 + h) * 8192;
#pragma unroll
            for (int d = 0; d < 2; ++d)
#pragma unroll
                for (int r = 0; r < 16; ++r) SO[(32 * ri + crow(r, hi)) * 128 + 32 * (2 * dh + d) + r32] = sacc[d][r]; }
    }
#undef SC_TOK
#undef SC_BAR
#undef SC_LOADRAW
#undef SC_LOADGK
#undef UNPK
#undef SC_RD8
#undef SC_LWAIT
#undef SC_OBLK
#undef SC_SBLK
    if (F.G == 256 && F.bid >= 128) { if (li == 0) setup_work(F, P, F.bid - 128, 128, 0x2, 0x2, 0x0, 0x0, 0x1); else setup_work(F, P, F.bid - 128, 128, 0x8, 0x8, 0x0, 0x0, 0x2); }
    else if (F.G != 256) { if (li == 0) setup_work(F, P, F.bid, F.G, 0x2, 0x2, 0x0, 0x0, 0x1); else setup_work(F, P, F.bid, F.G, 0x8, 0x8, 0x0, 0x0, 0x2); }
}
__device__ __forceinline__ void scan_combine(Frame& F, const Params& P, int li) {
    unsigned char* ws = PWS;
    const char* PROJ = (const char*)(ws + WS_BIG); const char* OF = (const char*)(ws + WS_Y); char* OB = (char*)(ws + WS_HB);
    const int gw = F.vcu * NWAVES + F.wave, NGW = F.G * NWAVES, lane = F.lane, hh = lane >> 3, dv = (lane & 7) * 16;
    f32x4 gn[4];
    { const float* gp_ = PIN(I_GLAN) + li * 128 + dv;
#pragma unroll
      for (int j = 0; j < 4; ++j) gn[j] = hh < 4 ? *(const f32x4*)(gp_ + 4 * j) : (f32x4){1.f, 1.f, 1.f, 1.f}; }
    const unsigned gcol = (unsigned)((hh < 4 ? PC_GA : PC_GB) + (hh & 3) * 128 + dv) * 2u, ocol = (unsigned)(hh * 128 + dv) * 2u;
#define CB_LOAD(S, r_) do { const unsigned off = (unsigned)(r_) * (unsigned)(D * 2) + ocol, goff = (unsigned)(r_) * (unsigned)(EVEN_NP * 2) + gcol; \
        S[0] = __builtin_nontemporal_load((const v4u*)(OF + off)); S[1] = __builtin_nontemporal_load((const v4u*)(OF + off + 16)); S[2] = __builtin_nontemporal_load((const v4u*)(OB + off)); S[3] = __builtin_nontemporal_load((const v4u*)(OB + off + 16)); \
        S[4] = __builtin_nontemporal_load((const v4u*)(PROJ + goff)); S[5] = __builtin_nontemporal_load((const v4u*)(PROJ + goff + 16)); } while (0)
#define CB_PROC(S, r_) do { const unsigned off = (unsigned)(r_) * (unsigned)(D * 2) + ocol; float x[16], gg[16]; \
        _Pragma("unroll") for (int hf = 0; hf < 2; ++hf) _Pragma("unroll") for (int e = 0; e < 4; ++e) { x[8 * hf + 2 * e] = bflo(S[hf][e]) + bflo(S[2 + hf][e]); x[8 * hf + 2 * e + 1] = bfhi(S[hf][e]) + bfhi(S[2 + hf][e]); \
            gg[8 * hf + 2 * e] = bflo(S[4 + hf][e]); gg[8 * hf + 2 * e + 1] = bfhi(S[4 + hf][e]); } \
        float ss = 0.f; _Pragma("unroll") for (int e = 0; e < 16; ++e) ss += x[e] * x[e]; \
        ss += __shfl_xor(ss, 1); ss += __shfl_xor(ss, 2); ss += __shfl_xor(ss, 4); \
        const float rstd = __builtin_amdgcn_rsqf(ss * (1.0f / 128.0f) + EPS); \
        _Pragma("unroll") for (int e = 0; e < 16; ++e) x[e] = x[e] * rstd * gn[e >> 2][e & 3] * siluf(gg[e]); \
        *(v4u*)(OB + off) = (v4u){pk2(x[0], x[1]), pk2(x[2], x[3]), pk2(x[4], x[5]), pk2(x[6], x[7])}; \
        *(v4u*)(OB + off + 16) = (v4u){pk2(x[8], x[9]), pk2(x[10], x[11]), pk2(x[12], x[13]), pk2(x[14], x[15])}; } while (0)
    if (NGW * 10 == M) {
        v4u A0[6], A1[6], B0[6], B1[6];
        CB_LOAD(A0, gw); CB_LOAD(A1, gw + NGW);
#pragma unroll
        for (int k = 0; k < 10; k += 4) {
            if (k + 2 < 10) { CB_LOAD(B0, gw + (k + 2) * NGW); CB_LOAD(B1, gw + (k + 3) * NGW); }
            CB_PROC(A0, gw + k * NGW); CB_PROC(A1, gw + (k + 1) * NGW);
            if (k + 4 < 10) { CB_LOAD(A0, gw + (k + 4) * NGW); CB_LOAD(A1, gw + (k + 5) * NGW); }
            if (k + 2 < 10) { CB_PROC(B0, gw + (k + 2) * NGW); CB_PROC(B1, gw + (k + 3) * NGW); }
        }
    } else {
        for (int row = gw; row < M; row += NGW) { v4u A0[6]; CB_LOAD(A0, row); CB_PROC(A0, row); }
    }
#undef CB_LOAD
#undef CB_PROC
}

__device__ __forceinline__ void cache_pass(Frame& F, const Params& P, int li, int wgi, int nwg) {
    unsigned char* ws = PWS;
    const int gt = wgi * 512 + F.tid, NGT = nwg * 512;
    const float* cckv_ = PIN(I_CCKV); const float* ckpe_ = PIN(I_CKPE);
    for (int i = gt; i < 8 * 256 * 32; i += NGT) { const int c8 = i & 31, t = (i >> 5) & 255, b = i >> 13;
        const float* s = cckv_ + ((size_t)((b * 2 + li) * 256 + t) * 32 + c8) * 8; const f32x4 a = *(const f32x4*)s, c = *(const f32x4*)(s + 4);
        *(GAS v4u*)((bf16*)(ws + WS_ACKV) + ((size_t)4096 + b * LKV + t) * 256 + c8 * 8) = (v4u){pk2(a[0], a[1]), pk2(a[2], a[3]), pk2(c[0], c[1]), pk2(c[2], c[3])}; }
    for (int i = gt; i < 8 * 256 * 8; i += NGT) { const int c8 = i & 7, t = (i >> 3) & 255, b = i >> 11;
        const float* s = ckpe_ + ((size_t)((b * 2 + li) * 256 + t) * 8 + c8) * 8; const f32x4 a = *(const f32x4*)s, c = *(const f32x4*)(s + 4);
        *(GAS v4u*)((bf16*)(ws + WS_KPE) + ((size_t)4096 + b * LKV + t) * 64 + c8 * 8) = (v4u){pk2(a[0], a[1]), pk2(a[2], a[3]), pk2(c[0], c[1]), pk2(c[2], c[3])}; }
}
__device__ __forceinline__ void kpe_pass(Frame& F, const Params& P, int li, int wgi, int nwg) {
    unsigned char* ws = PWS;
    const float* KR = (const float*)(ws + WS_Y); const float* ROPE = (const float*)(ws + WS_ROPE);
    bf16* KPE = (bf16*)(ws + WS_KPE);
    const int gt = wgi * 512 + F.tid, NGT = nwg * 512;
    for (int i = gt; i < M * 4; i += NGT) {
        const int row = i >> 2, c8 = i & 3;
        const float* s = KR + (size_t)row * 64 + 8 * c8;
        f32x4 a0 = *(const f32x4*)s, a1 = *(const f32x4*)(s + 4), b0 = *(const f32x4*)(s + 32), b1 = *(const f32x4*)(s + 36);
        int drow = row;
        if (row >= M_CTX) { const int lb = (row - M_CTX) >> 11, t = (row - M_CTX) & 2047; drow = M_CTX + lb * LKV + PAST + t;
            const float* cp = ROPE + (size_t)t * 32 + 8 * c8; const float* sp = cp + 65536;
            const f32x4 c0 = *(const f32x4*)cp, c1 = *(const f32x4*)(cp + 4), s0 = *(const f32x4*)sp, s1 = *(const f32x4*)(sp + 4);
            const f32x4 x0 = a0 * c0 - b0 * s0, x1 = a1 * c1 - b1 * s1, y0 = a0 * s0 + b0 * c0, y1 = a1 * s1 + b1 * c1;
            a0 = x0; a1 = x1; b0 = y0; b1 = y1; }
        bf16* d = KPE + (size_t)drow * 64 + 8 * c8;
        *(v4u*)d = (v4u){pk2(a0[0], a0[1]), pk2(a0[2], a0[3]), pk2(a1[0], a1[1]), pk2(a1[2], a1[3])};
        *(v4u*)(d + 32) = (v4u){pk2(b0[0], b0[1]), pk2(b0[2], b0[3]), pk2(b1[0], b1[1]), pk2(b1[2], b1[3])};
    }
}

constexpr float ATT_SCALE = 0.07216878364870322f;
constexpr float ATT_THR = 8.f;
constexpr int AT_V = 0, AT_KN = 49152, AT_KP = 98304, AT_WS = 122880, AT_VB = 16384, AT_KNB = 16384, AT_KPB = 8192;
#define KSWZ(row, colB) ((row) * 256 + ((colB) ^ (((row) & 7) << 4)))
#define KPSWZ(row, colB) ((row) * 128 + ((colB) ^ (((row) & 7) << 4)))
__device__ __forceinline__ void at_partialSM(f32x16& p0, f32x16& p1, float& m_reg, float& mn, float& alpha) {
    constexpr float C = ATT_SCALE * 1.4426950408889634f;
    float pmax = p0[0];
#pragma unroll
    for (int r = 1; r < 16; ++r) pmax = fmaxf(pmax, p0[r]);
#pragma unroll
    for (int r = 0; r < 16; ++r) pmax = fmaxf(pmax, p1[r]);
    { auto rr = __builtin_amdgcn_permlane32_swap(__float_as_uint(pmax), __float_as_uint(pmax), false, false); pmax = fmaxf(__uint_as_float(rr[0]), __uint_as_float(rr[1])); }
    if (__builtin_expect(__all(pmax - m_reg <= ATT_THR / ATT_SCALE), 1)) { mn = m_reg; alpha = 1.f; }
    else { mn = fmaxf(m_reg, pmax); alpha = __builtin_amdgcn_exp2f((m_reg - mn) * C); m_reg = mn; }
    const float mnC = -mn * C;
#pragma unroll
    for (int r = 0; r < 16; ++r) p0[r] = fmaf(p0[r], C, mnC);
#pragma unroll
    for (int r = 0; r < 16; ++r) p1[r] = fmaf(p1[r], C, mnC);
#pragma unroll
    for (int r = 0; r < 16; ++r) p0[r] = __builtin_amdgcn_exp2f(p0[r]);
}
__device__ __forceinline__ void at_finishSM(f32x16& p0, f32x16& p1, float alpha, float& l_reg, bf16x8& pa0, bf16x8& pa1, bf16x8& pa2, bf16x8& pa3) {
#pragma unroll
    for (int r = 0; r < 16; ++r) p1[r] = __builtin_amdgcn_exp2f(p1[r]);
    float ps = 0;
#pragma unroll
    for (int r = 0; r < 16; ++r) ps += p0[r];
#pragma unroll
    for (int r = 0; r < 16; ++r) ps += p1[r];
    { auto rr = __builtin_amdgcn_permlane32_swap(__float_as_uint(ps), __float_as_uint(ps), false, false); ps = __uint_as_float(rr[0]) + __uint_as_float(rr[1]); }
    l_reg = l_reg * alpha + ps;
    PK4(p0, 0, pa0); PK4(p0, 8, pa1); PK4(p1, 0, pa2); PK4(p1, 8, pa3);
}
__device__ __forceinline__ void at_qkt(f32x16& p0, f32x16& p1, const LAS unsigned char* Kn, const LAS unsigned char* Kp, const bf16x8* qr, const int* kb, const int* pb) {
    p0 = f32x16{}; p1 = f32x16{};
#pragma unroll
    for (int d0 = 0; d0 < 8; ++d0) {
        const bf16x8 b0 = *(const LAS bf16x8*)(Kn + kb[d0 & 3] + 128 * (d0 >> 2)), b1 = *(const LAS bf16x8*)(Kn + kb[d0 & 3] + 128 * (d0 >> 2) + 8192);
        p0 = __builtin_amdgcn_mfma_f32_32x32x16_bf16(b0, qr[d0], p0, 0, 0, 0);
        p1 = __builtin_amdgcn_mfma_f32_32x32x16_bf16(b1, qr[d0], p1, 0, 0, 0); }
#pragma unroll
    for (int d0 = 0; d0 < 4; ++d0) {
        const bf16x8 b0 = *(const LAS bf16x8*)(Kp + pb[d0]), b1 = *(const LAS bf16x8*)(Kp + pb[d0] + 4096);
        p0 = __builtin_amdgcn_mfma_f32_32x32x16_bf16(b0, qr[8 + d0], p0, 0, 0, 0);
        p1 = __builtin_amdgcn_mfma_f32_32x32x16_bf16(b1, qr[8 + d0], p1, 0, 0, 0); }
}
template <int D0> __device__ __forceinline__ void at_pv_one(f32x16& od, unsigned vb, bf16x8 pa0, bf16x8 pa1, bf16x8 pa2, bf16x8 pa3) {
    const s16x4 l0 = tr_read<D0 * 512>(vb), h0 = tr_read<D0 * 512 + 2048>(vb), l1 = tr_read<D0 * 512 + 4096>(vb), h1 = tr_read<D0 * 512 + 4096 + 2048>(vb);
    const s16x4 l2 = tr_read<D0 * 512 + 8192>(vb), h2 = tr_read<D0 * 512 + 8192 + 2048>(vb), l3 = tr_read<D0 * 512 + 12288>(vb), h3 = tr_read<D0 * 512 + 12288 + 2048>(vb);
    asm volatile("s_waitcnt lgkmcnt(0)" ::: "memory"); SBAR();
    od = __builtin_amdgcn_mfma_f32_32x32x16_bf16(pa0, PKF(l0, h0), od, 0, 0, 0);
    od = __builtin_amdgcn_mfma_f32_32x32x16_bf16(pa1, PKF(l1, h1), od, 0, 0, 0);
    od = __builtin_amdgcn_mfma_f32_32x32x16_bf16(pa2, PKF(l2, h2), od, 0, 0, 0);
    od = __builtin_amdgcn_mfma_f32_32x32x16_bf16(pa3, PKF(l3, h3), od, 0, 0, 0);
}
__device__ __forceinline__ void at_pv(f32x16* o, unsigned vb, bf16x8 pa0, bf16x8 pa1, bf16x8 pa2, bf16x8 pa3) {
    at_pv_one<0>(o[0], vb, pa0, pa1, pa2, pa3); at_pv_one<1>(o[1], vb, pa0, pa1, pa2, pa3); at_pv_one<2>(o[2], vb, pa0, pa1, pa2, pa3); at_pv_one<3>(o[3], vb, pa0, pa1, pa2, pa3);
}
__device__ __forceinline__ void attn_unit(Frame& F, const bf16* Qrow0  , const bf16* KVh  , const bf16* KPEs  ,
                                          bf16* Orow0, int nkeys, const float* ROPE, int tpos0  ) {
    LAS unsigned char* lds = F.lds;
    const int tid = F.tid, wid = F.wave, lane = F.lane, r32 = lane & 31, hi = lane >> 5;
    LAS float* wsf = (LAS float*)(lds + AT_WS) + wid * 64; LAS float* li_l = wsf; LAS float* al_l = wsf + 32;
    float m_reg = -1e30f, l_reg = 0; f32x16 o[4] = {}; bf16x8 qr[12];
    { const bf16* Qw = Qrow0 + (size_t)(wid * 32 + r32) * 1536 + hi * 8;
#pragma unroll
      for (int d0 = 0; d0 < 12; ++d0) qr[d0] = *(const bf16x8*)(Qw + d0 * 16);
      if (tpos0 >= 0) {
          const int t = tpos0 + wid * 32 + r32;
#pragma unroll
          for (int half = 0; half < 2; ++half) {
              const float* cp = ROPE + (size_t)t * 32 + 16 * half + 8 * hi; const float* sp = cp + 65536;
              const v4u xa = __builtin_bit_cast(v4u, qr[8 + half]), xb = __builtin_bit_cast(v4u, qr[10 + half]);
              float x1[8], x2[8];
              x1[0] = bflo(xa.x); x1[1] = bfhi(xa.x); x1[2] = bflo(xa.y); x1[3] = bfhi(xa.y); x1[4] = bflo(xa.z); x1[5] = bfhi(xa.z); x1[6] = bflo(xa.w); x1[7] = bfhi(xa.w);
              x2[0] = bflo(xb.x); x2[1] = bfhi(xb.x); x2[2] = bflo(xb.y); x2[3] = bfhi(xb.y); x2[4] = bflo(xb.z); x2[5] = bfhi(xb.z); x2[6] = bflo(xb.w); x2[7] = bfhi(xb.w);
              float y1[8], y2[8];
#pragma unroll
              for (int j = 0; j < 8; ++j) { const float c = cp[j], s = sp[j]; y1[j] = x1[j] * c - x2[j] * s; y2[j] = x1[j] * s + x2[j] * c; }
              const v4u wa = {pk2(y1[0], y1[1]), pk2(y1[2], y1[3]), pk2(y1[4], y1[5]), pk2(y1[6], y1[7])}, wb = {pk2(y2[0], y2[1]), pk2(y2[2], y2[3]), pk2(y2[4], y2[5]), pk2(y2[6], y2[7])};
              if (half == 0) { qr[8] = __builtin_bit_cast(bf16x8, wa); qr[10] = __builtin_bit_cast(bf16x8, wb); } else { qr[9] = __builtin_bit_cast(bf16x8, wa); qr[11] = __builtin_bit_cast(bf16x8, wb); }
          }
      } }
    const unsigned vb0 = (unsigned)(uintptr_t)(lds + AT_V) + v_rd_base(lane);
#define AT_OPQ() int l_ = lane; asm volatile("" : "+v"(l_))
#define AT_KADDR() int kbs[4], pbs[4]; { AT_OPQ(); _Pragma("unroll") for (int b = 0; b < 4; ++b) { const int x = (32 * b + 16 * (l_ >> 5)) ^ ((l_ & 7) << 4); kbs[b] = (l_ & 31) * 256 + x; pbs[b] = (l_ & 31) * 128 + x; } }
#define AT_GLDS(gp, ldsoff) __builtin_amdgcn_global_load_lds((const unsigned*)(gp), (LAS unsigned*)(lds + (ldsoff)), 16, 0, 0)
    unsigned okv, okp, ov;
    { const int l_ = lane; const int row0_ = 4 * wid + (l_ >> 4), rowp_ = 8 * wid + (l_ >> 3);
      okv = (unsigned)(row0_ * 4096 + (((l_ & 15) * 16) ^ ((row0_ & 7) << 4))); okp = (unsigned)(rowp_ * 128 + (((l_ & 7) * 16) ^ ((rowp_ & 7) << 4)));
      const int st_ = 2 * wid + (l_ >> 5), kk_ = (st_ >> 2) * 8 + ((l_ & 31) >> 2), key_ = (kk_ & ~0xC) | ((kk_ & 4) << 1) | ((kk_ & 8) >> 1), col_ = (st_ & 3) * 32 + (l_ & 3) * 8;
      ov = (unsigned)(key_ * 4096 + (128 + col_) * 2); }
    const unsigned ldsu = (unsigned)(uintptr_t)lds + (unsigned)wid * 1024u;
#define AT_GLDS_S(voff, base, ldsoff) do { unsigned sv_; asm volatile("s_mov_b32 %0, m0\n\ts_mov_b32 m0, %3\n\ts_nop 0\n\tglobal_load_lds_dwordx4 %1, %2\n\ts_mov_b32 m0, %0" \
        : "=&s"(sv_) : "v"(voff), "s"((const char*)(base)), "s"(ldsu + (unsigned)(ldsoff)) : "memory"); } while (0)
#define AT_DMA_K(t, b) do { const char* kb_ = (const char*)KVh + (size_t)(t) * (64 * 4096); const char* pb_ = (const char*)KPEs + (size_t)(t) * (64 * 128); \
    AT_GLDS_S(okv, kb_, AT_KN + (b) * AT_KNB); AT_GLDS_S(okv, kb_ + 32 * 4096, AT_KN + (b) * AT_KNB + 8 * 1024); AT_GLDS_S(okp, pb_, AT_KP + (b) * AT_KPB); } while (0)
#define AT_DMA_V(t, b) do { const char* vb_ = (const char*)KVh + (size_t)(t) * (64 * 4096); \
    AT_GLDS_S(ov, vb_, AT_V + (b) * AT_VB); AT_GLDS_S(ov, vb_ + 32 * 4096, AT_V + (b) * AT_VB + 8 * 1024); } while (0)
#define AT_RESC(a) do { if (__any((a) < 1.f)) { if (hi == 0) al_l[r32] = (a); asm volatile("s_waitcnt lgkmcnt(0)" ::: "memory"); \
    _Pragma("unroll") for (int d = 0; d < 4; ++d) _Pragma("unroll") for (int r = 0; r < 16; ++r) o[d][r] *= al_l[crow(r, hi)]; } } while (0)
#define AT_WAITBAR(N) do { asm volatile("s_waitcnt vmcnt(" #N ") lgkmcnt(0)" ::: "memory"); __builtin_amdgcn_s_barrier(); asm volatile("" ::: "memory"); } while (0)
    f32x16 pA0, pA1, pB0, pB1; float mnA, mnB, alA, alB; bf16x8 pa0, pa1, pa2, pa3; const int NT = nkeys / 64;
    AT_DMA_K(0, 0); AT_DMA_K(1, 1); AT_DMA_V(0, 0); AT_WAITBAR(0);
    int s = 0;
#define AT_S1 (s == 2 ? 0 : s + 1)
#define AT_S2 (s == 0 ? 2 : s - 1)
#define AT_STEP(CUR0, CUR1, MNC, ALC, PRV0, PRV1, ALP, t, MODE) do { \
        if (MODE == 2) { AT_DMA_K((t) + 2, AT_S2); } if (MODE >= 1) { AT_DMA_V((t) + 1, AT_S1); } \
        SBAR(); { AT_KADDR(); at_qkt(CUR0, CUR1, lds + AT_KN + s * AT_KNB, lds + AT_KP + s * AT_KPB, qr, kbs, pbs); } \
        at_finishSM(PRV0, PRV1, ALP, l_reg, pa0, pa1, pa2, pa3); SBAR(); \
        at_pv(o, vb0 + AT_S2 * AT_VB, pa0, pa1, pa2, pa3); at_partialSM(CUR0, CUR1, m_reg, MNC, ALC); \
        AT_RESC(ALC); if (MODE == 2) AT_WAITBAR(5); else if (MODE == 1) AT_WAITBAR(2); else AT_WAITBAR(0); s = AT_S1; } while (0)
    AT_DMA_K(2, 2); AT_DMA_V(1, 1);
    { AT_KADDR(); at_qkt(pA0, pA1, lds + AT_KN, lds + AT_KP, qr, kbs, pbs); } at_partialSM(pA0, pA1, m_reg, mnA, alA);
    AT_WAITBAR(5); s = 1;
    int t = 1;
    for (; t + 4 < NT; t += 2) {
        AT_STEP(pB0, pB1, mnB, alB, pA0, pA1, alA, t, 2);
        AT_STEP(pA0, pA1, mnA, alA, pB0, pB1, alB, t + 1, 2);
    }
    AT_STEP(pB0, pB1, mnB, alB, pA0, pA1, alA, NT - 3, 2);
    AT_STEP(pA0, pA1, mnA, alA, pB0, pB1, alB, NT - 2, 1);
    AT_STEP(pB0, pB1, mnB, alB, pA0, pA1, alA, NT - 1, 0);
    at_finishSM(pB0, pB1, alB, l_reg, pa0, pa1, pa2, pa3); SBAR();
    at_pv(o, vb0 + AT_S2 * AT_VB, pa0, pa1, pa2, pa3);
    if (hi == 0) li_l[r32] = l_reg; asm volatile("s_waitcnt lgkmcnt(0)" ::: "memory");
    float rli[16];
#pragma unroll
    for (int r = 0; r < 16; ++r) rli[r] = __builtin_amdgcn_rcpf(li_l[crow(r, hi)]);
    bf16* Ow = Orow0 + (size_t)(wid * 32) * D;
#pragma unroll
    for (int r = 0; r < 16; r += 2) { const int orow = crow(r, hi);
#pragma unroll
        for (int d0 = 0; d0 < 4; ++d0) { const unsigned w = pk2(o[d0][r] * rli[r], o[d0][r + 1] * rli[r + 1]);
            Ow[(size_t)orow * D + d0 * 32 + r32] = (bf16)w; Ow[(size_t)(orow + 1) * D + d0 * 32 + r32] = (bf16)(w >> 16); } }
#undef AT_GLDS
#undef AT_GLDS_S
#undef AT_OPQ
#undef AT_KADDR
#undef AT_DMA_K
#undef AT_DMA_V
#undef AT_RESC
#undef AT_WAITBAR
#undef AT_S1
#undef AT_S2
#undef AT_STEP
}
__device__ __forceinline__ void attn_phase(Frame& F, const Params& P, int li) {
    unsigned char* ws = PWS;
    const bf16* Q = (const bf16*)(ws + WS_Q); const bf16* KV = (const bf16*)(ws + WS_KV); const bf16* KPE = (const bf16*)(ws + WS_KPE);
    bf16* OB = (bf16*)(ws + WS_HB); const float* ROPE = (const float*)(ws + WS_ROPE);
    for (int u = F.vcu; u < 256 + 128; u += F.G) {
        for (int k = 0; k < 2; ++k) {
            int qrow0, kvrow0, nkeys, h, tpos0;
            if (u < 256) { const int id = 2 * u + k, lb = id >> 6, qb = id & 7; h = (id >> 3) & 7; qrow0 = M_CTX + lb * L_LAT + qb * 256; kvrow0 = M_CTX + lb * LKV; nkeys = LKV; tpos0 = qb * 256; }
            else { if (k == 1) break; const int id = u - 256, b = id >> 3; h = id & 7; qrow0 = b * L_CTX; kvrow0 = b * L_CTX; nkeys = L_CTX; tpos0 = -1; }
            __syncthreads();
            attn_unit(F, Q + (size_t)qrow0 * 1536 + h * 192, KV + (size_t)kvrow0 * 2048 + h * 256, KPE + (size_t)kvrow0 * 64, OB + (size_t)qrow0 * D + h * 128, nkeys, ROPE, tpos0);
        }
    }
}

constexpr int N_PHASES = 2 + 2 * 16;
__global__ void __launch_bounds__(NWAVES * 64, 2) hyb_fwd(Params P) {
    extern __shared__ __attribute__((aligned(16))) unsigned char lds_raw[];
    Frame F;
    F.lds = (LAS unsigned char*)lds_raw;
    F.tid = threadIdx.x; F.lane = F.tid & 63; F.wave = __builtin_amdgcn_readfirstlane(F.tid >> 6);
    F.G = gridDim.x; { const int bx = blockIdx.x; F.vcu = (F.G % 8 == 0) ? (bx % 8) * (F.G / 8) + bx / 8 : bx; }
    volatile LAS unsigned* MISC = (volatile LAS unsigned*)(F.lds + LDS_MISC);
    if (F.tid < 64) MISC[F.tid] = 0u;
    __syncthreads();
    const int use_bar = P.use_bar, ph_hi = P.ph_hi;
    XcdBarrier bar; bar.bar = (unsigned*)(PWS + WS_CTL) + 4096; bar.x = 0; bar.st = nullptr;
    if (use_bar) bar = xcd_barrier_post((unsigned*)(PWS + WS_CTL) + 4096, MISC + 8);

    for (int ph = P.ph_lo; ph < ph_hi; ++ph) {
#define REFRESH_ID() do { int t_ = threadIdx.x; asm volatile("" : "+v"(t_)); F.tid = t_; F.lane = t_ & 63; F.wave = __builtin_amdgcn_readfirstlane(t_ >> 6); \
          int g_ = gridDim.x, b_ = blockIdx.x; asm volatile("" : "+s"(g_), "+s"(b_)); F.G = g_; F.vcu = (g_ % 8 == 0) ? (b_ % 8) * (g_ / 8) + b_ / 8 : b_; F.bid = b_; } while (0)
        REFRESH_ID();
        unsigned char* ws = PWS;
        bf16* XBF = (bf16*)(POUT + OUT_Y);
        bf16* HB = (bf16*)(ws + WS_HB); bf16* YB = (bf16*)(ws + WS_Y); const bf16* SL = (const bf16*)(ws + WS_SLAB);
        const float* MOD = (const float*)(ws + WS_MOD);
#ifdef HYB_PHPROBE
        if (F.tid == 0) { int pk_ = ph == 0 ? 20 : 21;
            if (ph >= 2) { const int q_ = ph - 2, r_ = q_ % 16; const bool o_ = r_ >= 8; const int k_ = o_ ? r_ - 8 : r_; pk_ = k_ < 3 ? (o_ ? 10 + k_ : (k_ == 2 ? 8 : k_)) : (k_ == 3 ? 2 : k_ == 4 ? 3 : k_ == 5 ? 4 : k_ == 6 ? 5 : 6); }
            const unsigned now_ = (unsigned)__builtin_amdgcn_s_memrealtime(); if (MISC[58]) MISC[60] += now_ - MISC[57]; MISC[57] = now_; MISC[58] = ((HYB_PHPROBE) >> pk_) & 1; }
#endif
        if (ph == 0) { p0_prologue(F, P); }
        else if (ph == 1) {
            const float* m0 = MOD;
            if (F.G == 256) row_pass_f32<false>(F, PIN(I_XP), PIN(I_XS), nullptr, nullptr, nullptr, nullptr, nullptr, PIN(I_NMIXPRE), m0 + 1024, m0, HB);
            else row_pass(F, PIN(I_XP), PIN(I_XS), true, nullptr, nullptr, nullptr, nullptr, nullptr, PIN(I_NMIXPRE), m0 + 1024, m0, HB, false, true);
        } else {
            const int q = ph - 2, pair = q / 16, r = q % 16; const bool odd = r >= 8; const int l = 2 * pair + (odd ? 1 : 0), k = odd ? r - 8 : r;
            const float* ml = MOD + (size_t)l * 9 * 6144;
            const int kind = k < 3 ? (odd ? 10 + k : (k == 2 ? 8 : k)) : (k == 3 ? 2 : k == 4 ? 3 : k == 5 ? 4 : k == 6 ? 5 : 6);
            if (kind == 0) {
                pg8::Gemm g{HB, (const bf16*)(ws + WS_WINE) + (size_t)pair * EVEN_NP * 1024, M, EVEN_NP, 1024}; pg8::EvenInOrder S; S.init(F.G, F.bid);
                pg8::EpiProj E{(bf16*)(ws + WS_BIG), EVEN_NP};
                pg8::gemm_phase<pg8::EpiProj, pg8::EvenInOrder, true, true>(F.lds, g, S, E, F.tid, PWS + WS_CTL + 512 * 1024);
            } else if (kind == 1) {
                scan_phase(F, P, pair);
            } else if (kind == 8) {
                scan_combine(F, P, pair);
            } else if (kind == 2) {
                const bf16* W = odd ? (const bf16*)(ws + WS_WOUTO) + (size_t)pair * 1024 * 1024 : (const bf16*)(ws + WS_WOUTE) + (size_t)pair * 1024 * 1024;
                pg8::Gemm g{HB, W, M, 1024, 1024}; pg8::TailSplitOrder S; S.init(F.bid, 1024, 0);
                pg8::EpiYsplit E{YB, (bf16*)(ws + WS_SLAB)};
                pg8::gemm_phase<pg8::EpiYsplit, pg8::TailSplitOrder, true, true>(F.lds, g, S, E, F.tid, PWS + WS_CTL + 512 * 1024);
            } else if (kind == 3) {
                if (l == 0 && F.G == 256) row_pass_f32<true>(F, PIN(I_XP), PIN(I_XS), XBF, YB, SL, PIN(I_NMIXPOST) + l * 1024, ml + 2048, PIN(I_NMLPPRE) + l * 1024, ml + 4096, ml + 3072, HB);
                else if (l != 0 && F.G == 256) row_pass_mid(F, XBF, YB, SL, PIN(I_NMIXPOST) + l * 1024, ml + 2048, PIN(I_NMLPPRE) + l * 1024, ml + 4096, ml + 3072, HB);
                else row_pass(F, PIN(I_XP), PIN(I_XS), l == 0, XBF, YB, SL, PIN(I_NMIXPOST) + l * 1024, ml + 2048, PIN(I_NMLPPRE) + l * 1024, ml + 4096, ml + 3072, HB, true, true);
            } else if (kind == 4) {
                pg8::Gemm g{HB, (const bf16*)(ws + WS_W1) + (size_t)l * 4096 * 1024, M, FF, 1024}; pg8::StaticOrder S; S.init(M, FF, F.G, F.bid, 1024);
                pg8::EpiBf16<1> E{(bf16*)(ws + WS_BIG), FF};
#ifdef HYB_CLKPROBE
                __builtin_amdgcn_s_barrier();
                if (F.tid == 0) { const unsigned long long c0 = __builtin_readcyclecounter(), r0 = __builtin_amdgcn_s_memrealtime(); MISC[56] = (unsigned)c0; MISC[57] = (unsigned)r0; }
#endif
                pg8::gemm_phase<pg8::EpiBf16<1>, pg8::StaticOrder, true, true>(F.lds, g, S, E, F.tid, PWS + WS_CTL + 512 * 1024);
#ifdef HYB_CLKPROBE
                if (F.tid == 0) { const unsigned long long c1 = __builtin_readcyclecounter(), r1 = __builtin_amdgcn_s_memrealtime(); MISC[60] += (unsigned)c1 - MISC[56]; MISC[61] += (unsigned)r1 - MISC[57]; }
#endif
            } else if (kind == 5) {
                pg8::Gemm g{(const bf16*)(ws + WS_BIG), (const bf16*)(ws + WS_W2) + (size_t)l * 1024 * 4096, M, 1024, FF}; pg8::TailSplitOrder S; S.init(F.bid, FF, 0);
                pg8::EpiYsplit E{YB, (bf16*)(ws + WS_SLAB)};
                pg8::gemm_phase<pg8::EpiYsplit, pg8::TailSplitOrder, true, true>(F.lds, g, S, E, F.tid, PWS + WS_CTL + 512 * 1024);
            } else if (kind == 6) {
                const float* mn = ml + 9 * 6144;
                if (l < 3 && F.G == 256) row_pass_mid(F, XBF, YB, SL, PIN(I_NMLPPOST) + l * 1024, ml + 5120, PIN(I_NMIXPRE) + (l + 1) * 1024, mn + 1024, mn, HB);
                else if (l < 3) row_pass(F, nullptr, nullptr, false, XBF, YB, SL, PIN(I_NMLPPOST) + l * 1024, ml + 5120, PIN(I_NMIXPRE) + (l + 1) * 1024, mn + 1024, mn, HB, true, true);
                else { bar.bar = (unsigned*)(PWS + WS_CTL) + 4096; if (F.G == 256) row_pass_final2(F, bar, XBF, POUT + OUT_Y, YB, SL, PIN(I_NMLPPOST) + l * 1024, ml + 5120);
                       else row_pass_final(F, bar, XBF, POUT + OUT_Y, YB, SL, PIN(I_NMLPPOST) + l * 1024, ml + 5120); }
            } else if (kind == 10) {
                pg8::Gemm g{HB, (const bf16*)(ws + WS_WINO) + (size_t)pair * ODD_NP * 1024, M, ODD_NP, 1024}; pg8::StaticOrder S; S.init(M, ODD_NP, F.G, F.bid, 1024);
                pg8::EpiOddIn E{(bf16*)(ws + WS_QN), (bf16*)(ws + WS_ACKV), (float*)(ws + WS_Y), POUT + OUT_CKV, POUT + OUT_KPE,
                                PIN(I_QAN) + pair * 256, PIN(I_KVAN) + pair * 256, pair};
                pg8::gemm_phase<pg8::EpiOddIn, pg8::StaticOrder, false, true>(F.lds, g, S, E, F.tid, PWS + WS_CTL + 512 * 1024);
                REFRESH_ID();
                if (F.G == 256) { if (F.bid >= 240) cache_pass(F, P, pair, F.bid - 240, 16); }
                else cache_pass(F, P, pair, F.vcu, F.G);
            } else if (kind == 11) {
                if (F.G != 256) { kpe_pass(F, P, pair, F.vcu, F.G); REFRESH_ID(); }
                { pg8::Gemm g{(const bf16*)(ws + WS_QN), (const bf16*)(ws + WS_WQB) + (size_t)pair * 1536 * 256, M, 1536, 256}; pg8::StaticOrder S; S.init(M, 1536, F.G, F.bid, 256);
                  pg8::EpiBf16<0> E{(bf16*)(ws + WS_Q), 1536};
                  pg8::gemm_phase<pg8::EpiBf16<0>, pg8::StaticOrder, true, true>(F.lds, g, S, E, F.tid, PWS + WS_CTL + 512 * 1024); }
                REFRESH_ID();
                { pg8::Gemm g{(const bf16*)(ws + WS_ACKV), (const bf16*)(ws + WS_WKVB) + (size_t)pair * 2048 * 256, MKV, 2048, 256}; pg8::StaticOrder S; S.init(MKV, 2048, F.G, F.bid, 256);
                  pg8::EpiBf16<0> E{(bf16*)(ws + WS_KV), 2048};
                  pg8::gemm_phase<pg8::EpiBf16<0>, pg8::StaticOrder, true, true>(F.lds, g, S, E, F.tid, PWS + WS_CTL + 512 * 1024); }
                if (F.G == 256 && F.bid >= 192) { REFRESH_ID(); kpe_pass(F, P, pair, F.bid - 192, 64); }
            } else if (kind == 12) {
                attn_phase(F, P, pair);
            }
        }
        if (ph + 1 < ph_hi) { if (use_bar) { bar.bar = (unsigned*)(PWS + WS_CTL) + 4096; xcd_barrier(bar); } else { VM_WAIT(); __syncthreads(); } }
    }
#ifdef HYB_PHPROBE
    if (blockIdx.x == 0 && threadIdx.x == 0) {
        unsigned now_ = (unsigned)__builtin_amdgcn_s_memrealtime(); if (MISC[58]) MISC[60] += now_ - MISC[57];
        #ifndef HYB_PHMULT
#define HYB_PHMULT 1
#endif
        const unsigned long long spin = (unsigned long long)MISC[60] * HYB_PHMULT; const unsigned long long t0 = __builtin_amdgcn_s_memrealtime();
        while (__builtin_amdgcn_s_memrealtime() - t0 < spin) __builtin_amdgcn_s_sleep(8);
    }
#endif
#ifdef HYB_CLKPROBE
    if (blockIdx.x == 0 && threadIdx.x == 0) {
        const unsigned c = MISC[60], r = MISC[61]; const unsigned long long spin = (unsigned long long)c * (unsigned long long)(HYB_CLKPROBE) / (r ? r : 1u);
        const unsigned long long t0 = __builtin_amdgcn_s_memrealtime();
        while (__builtin_amdgcn_s_memrealtime() - t0 < spin) __builtin_amdgcn_s_sleep(8);
    }
#endif
}

extern "C" void kernel_launch(void* const* d_in, const int* in_sizes, int n_in, void* d_out, int out_size, void* d_ws, size_t ws_size, hipStream_t stream) {
    static int grid = 0;
    if (grid == 0) {
        if (n_in != 28 || out_size != 27787264 || ws_size < WS_END) { fprintf(stderr, "kernel_launch: unexpected shapes: n_in %d out %d ws %zu (need >= %zu)\n", n_in, out_size, ws_size, (size_t)WS_END); grid = -1; return; }
        int dev = 0, cus = 0, per_cu = 0;
        if (hipGetDevice(&dev) != hipSuccess || hipDeviceGetAttribute(&cus, hipDeviceAttributeMultiprocessorCount, dev) != hipSuccess) { grid = -1; return; }
        if (hipFuncSetAttribute((const void*)hyb_fwd, hipFuncAttributeMaxDynamicSharedMemorySize, LDS_BYTES) != hipSuccess) { fprintf(stderr, "kernel_launch: hipFuncSetAttribute failed\n"); grid = -1; return; }
        if (hipOccupancyMaxActiveBlocksPerMultiprocessor(&per_cu, (const void*)hyb_fwd, NWAVES * 64, LDS_BYTES) != hipSuccess || per_cu < 1) { fprintf(stderr, "kernel_launch: occupancy query reports %d\n", per_cu); }
        (void)hipGetLastError();
        grid = cus;
    }
    if (grid < 0) return;
    (void)hipMemsetAsync((char*)d_ws + WS_CTL, 0, CTL_ZERO_BYTES, stream);
    Params a{};
    for (int i = 0; i < 28; ++i) a.in[i] = (const float*)d_in[i];
    a.out = (float*)d_out; a.ws = (unsigned char*)d_ws;
    a.ph_lo = 0; a.ph_hi = N_PHASES; a.use_bar = 1; a.pad = 0;
    hipLaunchKernelGGL(hyb_fwd, dim3(grid), dim3(NWAVES * 64), LDS_BYTES, stream, a);
    const hipError_t le = hipPeekAtLastError();
    if (le != hipSuccess) fprintf(stderr, "kernel_launch: launch failed: %s\n", hipGetErrorName(le));
}
```

```cpp
#include <hip/hip_runtime.h>
#include <hip/hip_bf16.h>
#include <cstdio>
#include <cstdint>
namespace pg8 {
#define PG8_LAS __attribute__((address_space(3)))
typedef unsigned short bf16_t;
typedef short bf16x8 __attribute__((ext_vector_type(8)));
typedef float f32x4 __attribute__((ext_vector_type(4)));
typedef unsigned u32x4 __attribute__((ext_vector_type(4)));
constexpr int BM = 256, BK = 64, HALF = 128, HTB = HALF * BK * 2  , STAGE_BYTES = 8 * HTB, NXCD = 8, WGM = 8;

__host__ __device__ __forceinline__ int lds_byte(int r, int c) { const int st = (r >> 4) * 2 + (c >> 5), rr = r & 15, cc = c & 31, ob = rr * 64 + cc * 2; return st * 1024 + (ob ^ (((ob >> 9) & 1) << 5)); }
__host__ __device__ __forceinline__ void stage_rc(int b, int& R, int& C) { const int st = b / 1024, sb = b % 1024, swz = sb ^ (((sb >> 9) & 1) << 5); R = (st >> 1) * 16 + swz / 64; C = (st & 1) * 32 + (swz % 64) / 2; }
__host__ __device__ __forceinline__ int perm32(int rho) { const int n = rho >> 4, i = rho & 15; return 8 * (i >> 2) + 4 * n + (i & 3); }

struct Unit { int pm, pn, ks, kt0, nt; };
struct Gemm { const bf16_t* A; const bf16_t* Bt; int M, N, K; };

struct StaticOrder {
    int nM, nN, nwg, G, c, ntk;
    __host__ __device__ void init(int M, int N, int G_, int c_, int K) { nM = M / BM; nN = N / BM; nwg = nM * nN; G = G_; c = c_; ntk = K / BK; }
    __host__ __device__ bool next(int i, Unit& u) const { return map((long)i * G + c, u); }
    __host__ __device__ bool map(long L, Unit& u) const {
        if (L >= nwg) return false;
        int wgid = (int)L; { const int q = nwg / NXCD, r = nwg % NXCD, xcd = wgid % NXCD, off = wgid / NXCD; wgid = (xcd < r ? xcd * (q + 1) : r * (q + 1) + (xcd - r) * q) + off; }
        const int nig = WGM * nN, gid = wgid / nig, fm = gid * WGM, gsz = (nM - fm) < WGM ? (nM - fm) : WGM;
        u.pm = fm + ((wgid % nig) % gsz); u.pn = (wgid % nig) / gsz; u.ks = -1; u.kt0 = 0; u.nt = ntk; return true;
    }
    __device__ __forceinline__ void a_ready(const Unit&) const {}
    __device__ __forceinline__ void done(const Unit&) const {}
};


struct TailSplitOrder {
    int c, ntk, mode;
    __device__ void init(int c_, int K, int mode_) { c = c_; ntk = K / BK; mode = mode_; }
    __device__ __forceinline__ bool next(int i, Unit& u) const {
        const int xcd = c & 7, j = c >> 3;
        const int round = i + (mode == 2 ? 1 : 0); const bool tail = round != 0;
        u.pm = tail ? 64 + xcd * 2 + (j & 1) : xcd * 8 + (j & 7);
        u.pn = tail ? (j >> 1) & 3 : j >> 3;
        u.ks = tail ? j >> 3 : -1;
        u.nt = tail ? ntk >> 2 : ntk;
        u.kt0 = tail ? (j >> 3) * (ntk >> 2) : 0;
        return round == 0 ? mode != 2 : (round == 1 && mode != 1);
    }
    __device__ __forceinline__ void a_ready(const Unit&) const {}
    __device__ __forceinline__ void done(const Unit&) const {}
};

struct EvenInOrder {
    StaticOrder S12; int G, c;
    __device__ void init(int G_, int c_) { S12.init(20480, 3072, G_, c_, 1024); G = G_; c = c_; }
    __device__ __forceinline__ bool next(int i, Unit& u) const {
        const int L = i * G + c;
        Unit a; a.pm = 0; a.pn = 0; a.ks = -1; a.kt0 = 0; a.nt = 16; (void)S12.map(L < 960 ? L : 0, a);
        const int q = L - 1024;
        const bool full = L < 960, gkw = L >= 960 && L < 1024;
        u.pm = full ? a.pm : (gkw ? L - 960 : 64 + (q >> 2));
        u.pn = full ? a.pn : 12;
        u.ks = (full || gkw) ? -1 : (q & 3);
        u.nt = (full || gkw) ? 16 : 4;
        u.kt0 = (full || gkw) ? 0 : 4 * (q & 3);
        return L < 1088;
    }
    __device__ __forceinline__ void a_ready(const Unit&) const {}
    __device__ __forceinline__ void done(const Unit&) const {}
};

typedef float f32x2c_t __attribute__((ext_vector_type(2))); typedef __bf16 bf16x2c_t __attribute__((ext_vector_type(2)));
__device__ __forceinline__ unsigned cvt_pk_bf16(float lo, float hi) { f32x2c_t v = {lo, hi}; bf16x2c_t b = __builtin_convertvector(v, bf16x2c_t); return __builtin_bit_cast(unsigned, b); }

template <int ACT> struct EpiBf16 {
    static constexpr bool PERM = true, AFTER_DRAIN = false;
    bf16_t* O; int ldc;
    __device__ __forceinline__ void operator()(const f32x4 (&acc)[2][2][4][2], const Unit& u, int wr, int wc, int fr, int fq) const {
        const int row0 = u.pm * BM + wr * 64 + fr; const int col0 = u.pn * BM + wc * 32 + 8 * fq;
#pragma unroll
        for (int ai = 0; ai < 2; ++ai)
#pragma unroll
            for (int m = 0; m < 4; ++m) { bf16_t* rowp = O + (size_t)(row0 + ai * HALF + m * 16) * ldc + col0;
#pragma unroll
                for (int bj = 0; bj < 2; ++bj) { f32x4 v0 = acc[ai][bj][m][0], v1 = acc[ai][bj][m][1];
                    if (ACT == 1) {
#pragma unroll
                        for (int j = 0; j < 4; ++j) { const float a = fmaxf(v0[j], 0.f), b = fmaxf(v1[j], 0.f); v0[j] = a * a; v1[j] = b * b; } }
                    u32x4 w; w.x = cvt_pk_bf16(v0[0], v0[1]); w.y = cvt_pk_bf16(v0[2], v0[3]); w.z = cvt_pk_bf16(v1[0], v1[1]); w.w = cvt_pk_bf16(v1[2], v1[3]);
                    *(u32x4*)(rowp + bj * HALF) = w; } }
    }
};
struct EpiProj {
    static constexpr bool PERM = true, AFTER_DRAIN = false;
    bf16_t* O; int ldc;
    __device__ __forceinline__ void operator()(const f32x4 (&acc)[2][2][4][2], const Unit& u, int wr, int wc, int fr, int fq) const {
        const int row0 = u.pm * BM + wr * 64 + fr;
        if (u.ks < 0) {
            const int col0 = u.pn * BM + wc * 32 + 8 * fq;
#pragma unroll
            for (int ai = 0; ai < 2; ++ai)
#pragma unroll
                for (int m = 0; m < 4; ++m) { bf16_t* rowp = O + (size_t)(row0 + ai * HALF + m * 16) * ldc + col0;
#pragma unroll
                    for (int bj = 0; bj < 2; ++bj) { const f32x4 v0 = acc[ai][bj][m][0], v1 = acc[ai][bj][m][1];
                        u32x4 w; w.x = cvt_pk_bf16(v0[0], v0[1]); w.y = cvt_pk_bf16(v0[2], v0[3]); w.z = cvt_pk_bf16(v1[0], v1[1]); w.w = cvt_pk_bf16(v1[2], v1[3]);
                        *(u32x4*)(rowp + bj * HALF) = w; } }
        } else if (wc == 0) {
            const int col0 = 3072 + 32 * u.ks + 8 * fq;
#pragma unroll
            for (int ai = 0; ai < 2; ++ai)
#pragma unroll
                for (int m = 0; m < 4; ++m) { const f32x4 v0 = acc[ai][0][m][0], v1 = acc[ai][0][m][1];
                    u32x4 w; w.x = cvt_pk_bf16(v0[0], v0[1]); w.y = cvt_pk_bf16(v0[2], v0[3]); w.z = cvt_pk_bf16(v1[0], v1[1]); w.w = cvt_pk_bf16(v1[2], v1[3]);
                    *(u32x4*)(O + (size_t)(row0 + ai * HALF + m * 16) * ldc + col0) = w; }
        }
    }
};
struct EpiYsplit {
    static constexpr bool PERM = true, AFTER_DRAIN = false;
    bf16_t* Y; bf16_t* SL;
    __device__ __forceinline__ void operator()(const f32x4 (&acc)[2][2][4][2], const Unit& u, int wr, int wc, int fr, int fq) const {
        const int row0 = u.pm * BM + wr * 64 + fr; const int col0 = u.pn * BM + wc * 32 + 8 * fq;
        if (u.ks < 0) {
#pragma unroll
            for (int ai = 0; ai < 2; ++ai)
#pragma unroll
                for (int m = 0; m < 4; ++m) { bf16_t* rowp = Y + (size_t)(row0 + ai * HALF + m * 16) * 1024 + col0;
#pragma unroll
                    for (int bj = 0; bj < 2; ++bj) { const f32x4 v0 = acc[ai][bj][m][0], v1 = acc[ai][bj][m][1];
                        u32x4 w; w.x = cvt_pk_bf16(v0[0], v0[1]); w.y = cvt_pk_bf16(v0[2], v0[3]); w.z = cvt_pk_bf16(v1[0], v1[1]); w.w = cvt_pk_bf16(v1[2], v1[3]);
                        *(u32x4*)(rowp + bj * HALF) = w; } }
        } else {
            bf16_t* base = SL + (size_t)u.ks * (4096 * 1024);
#pragma unroll
            for (int ai = 0; ai < 2; ++ai)
#pragma unroll
                for (int m = 0; m < 4; ++m) { bf16_t* rowp = base + (size_t)(row0 - 16384 + ai * HALF + m * 16) * 1024 + col0;
#pragma unroll
                    for (int bj = 0; bj < 2; ++bj) { const f32x4 v0 = acc[ai][bj][m][0], v1 = acc[ai][bj][m][1];
                        u32x4 w; w.x = cvt_pk_bf16(v0[0], v0[1]); w.y = cvt_pk_bf16(v0[2], v0[3]); w.z = cvt_pk_bf16(v1[0], v1[1]); w.w = cvt_pk_bf16(v1[2], v1[3]);
                        *(u32x4*)(rowp + bj * HALF) = w; } }
        }
    }
};
struct EpiOddIn {
    static constexpr bool PERM = false, AFTER_DRAIN = true;
    bf16_t* QN; bf16_t* ACKV; float* KPERAW; float* out_ckv; float* out_kpe; const float* gq; const float* gkv; int li;
    __device__ __forceinline__ void fused(f32x4 (&acc)[2][2][4][2], const Unit& u, int wr, int wc, int fr, int fq, PG8_LAS unsigned char* lds, int wid, int lane) const {
        PG8_LAS float* P = (PG8_LAS float*)lds;
        if (u.pn < 2) {
#pragma unroll
            for (int ai = 0; ai < 2; ++ai)
#pragma unroll
                for (int m = 0; m < 4; ++m) { float s = 0.f;
#pragma unroll
                    for (int bj = 0; bj < 2; ++bj)
#pragma unroll
                        for (int n = 0; n < 2; ++n) { const f32x4 x = acc[ai][bj][m][n]; s += (x[0] * x[0] + x[1] * x[1]) + (x[2] * x[2] + x[3] * x[3]); }
                    s += __shfl_xor(s, 16); s += __shfl_xor(s, 32);
                    if (fq == 0) P[(ai * HALF + wr * 64 + m * 16 + fr) * 4 + wc] = s; }
        }
        asm volatile("s_waitcnt lgkmcnt(0)" ::: "memory"); __builtin_amdgcn_s_barrier(); asm volatile("" ::: "memory");
        if (u.pn < 2) {
            const float* gv = u.pn == 0 ? gq : gkv;
#pragma unroll
            for (int ai = 0; ai < 2; ++ai)
#pragma unroll
                for (int m = 0; m < 4; ++m) { const int r = ai * HALF + wr * 64 + m * 16 + fr; const int grow = u.pm * BM + r;
                    const float tot = (P[r * 4 + 0] + P[r * 4 + 1]) + (P[r * 4 + 2] + P[r * 4 + 3]);
                    const float rstd = 1.0f / sqrtf(tot * (1.0f / 256.0f) + 1e-6f);
                    const int drow = grow < 4096 ? grow : 4096 + ((grow - 4096) >> 11) * 2304 + 256 + ((grow - 4096) & 2047);
#pragma unroll
                    for (int bj = 0; bj < 2; ++bj)
#pragma unroll
                        for (int n = 0; n < 2; ++n) { const int col = bj * HALF + wc * 32 + n * 16 + 4 * fq; const f32x4 g = *(const f32x4*)(gv + col);
                            const f32x4 v = acc[ai][bj][m][n] * rstd * g;
                            unsigned long long w = (unsigned long long)cvt_pk_bf16(v[0], v[1]) | ((unsigned long long)cvt_pk_bf16(v[2], v[3]) << 32);
                            if (u.pn == 0) *(unsigned long long*)(QN + (size_t)grow * 256 + col) = w;
                            else { *(unsigned long long*)(ACKV + (size_t)drow * 256 + col) = w;
                                   if (grow < 4096) *(f32x4*)(out_ckv + ((size_t)((grow >> 8) * 2 + li) * 256 + (grow & 255)) * 256 + col) = v; } } }
        } else if (wc < 2) {
#pragma unroll
            for (int ai = 0; ai < 2; ++ai)
#pragma unroll
                for (int m = 0; m < 4; ++m) { const int r = ai * HALF + wr * 64 + m * 16 + fr; const int grow = u.pm * BM + r;
#pragma unroll
                    for (int n = 0; n < 2; ++n) { const int col = wc * 32 + n * 16 + 4 * fq; const f32x4 v = acc[ai][0][m][n];
                        *(f32x4*)(KPERAW + (size_t)grow * 64 + col) = v;
                        if (grow < 4096) *(f32x4*)(out_kpe + ((size_t)((grow >> 8) * 2 + li) * 256 + (grow & 255)) * 64 + col) = v; } }
        }
    }
};

#define PG8_NCONST const
#ifndef PG8_PROBE_MODE
#define PG8_PROBE_MODE 0
#endif
#define PG8_PM true
#define PG8_PL true
#define PG8_PG true
template <class Epi, class Sched, bool ALIGN_EPI = false, bool SP2 = false>
__device__ __forceinline__ void gemm_phase(PG8_LAS unsigned char* lds, const Gemm g, const Sched& S, const Epi& E, const int tid, const void* scratch) {
    static_assert(SP2, "only the two-super-phase K-loop is kept");
    const int  wid = __builtin_amdgcn_readfirstlane(tid >> 6), lane = tid & 63, wr = wid >> 2, wc = wid & 3, fr = lane & 15, fq = lane >> 4;
    const int K = g.K;
    unsigned voffA[2], voffB[2];
#pragma unroll
    for (int i = 0; i < 2; ++i) { int R, C; stage_rc(tid * 16 + i * 8192, R, C); const int Rb = Epi::PERM ? ((R & ~31) + perm32(R & 31)) : R;
        voffA[i] = (unsigned)(R * K + C) * 2u; voffB[i] = (unsigned)(Rb * K + C) * 2u; }
    const size_t kstep = (size_t)(BK * 2);
    const size_t hstep = (size_t)HALF * K * 2;
    const size_t tstep = 2 * hstep;
    const unsigned ldsw = (unsigned)wid * 1024u;
    const unsigned ldsa = (unsigned)(size_t)lds + ldsw;
    const int aoff = lds_byte(wr * 64 + fr, fq * 8), boff = lds_byte(wc * 32 + fr, fq * 8);
#define PG8_SA(b, h) (((b) * 2 + (h)) * HTB)
#define PG8_SB(b, h) ((4 + (b) * 2 + (h)) * HTB)
#define PG8_STAGE(bufoff, gbase, voff) do { if (PG8_PG) _Pragma("unroll") for (int _i = 0; _i < 2; ++_i) { unsigned sv_; \
        asm volatile("s_mov_b32 %0, m0\n\ts_mov_b32 m0, %3\n\ts_nop 0\n\tglobal_load_lds_dwordx4 %1, %2\n\ts_mov_b32 m0, %0" \
                     : "=&s"(sv_) : "v"((voff)[_i]), "s"((const char*)(gbase)), "s"(ldsa + (unsigned)((bufoff) + _i * 8192)) : "memory"); } } while (0)
#define PG8_LDA(dst, b, h) do { if (PG8_PL) _Pragma("unroll") for (int m = 0; m < 4; ++m) _Pragma("unroll") for (int k = 0; k < 2; ++k) dst[m][k] = *(const PG8_LAS bf16x8*)(lds + PG8_SA(b, h) + aoff + m * 2048 + k * 1024); } while (0)
#define PG8_LDB(dst, b, h) do { if (PG8_PL) _Pragma("unroll") for (int n = 0; n < 2; ++n) _Pragma("unroll") for (int k = 0; k < 2; ++k) dst[n][k] = *(const PG8_LAS bf16x8*)(lds + PG8_SB(b, h) + boff + n * 2048 + k * 1024); } while (0)
#define PG8_MMA(ai, bj, At, Bt) do { __builtin_amdgcn_s_setprio(1); if (PG8_PM) _Pragma("unroll") for (int k = 0; k < 2; ++k) _Pragma("unroll") for (int m = 0; m < 4; ++m) _Pragma("unroll") for (int n = 0; n < 2; ++n) \
        acc[ai][bj][m][n] = __builtin_amdgcn_mfma_f32_16x16x32_bf16(Bt[n][k], At[m][k], acc[ai][bj][m][n], 0, 0, 0); __builtin_amdgcn_s_setprio(0); } while (0)
#define PG8_WAIT_V(n) asm volatile("s_waitcnt vmcnt(" #n ")" ::: "memory")
#define PG8_WAIT_L(n) asm volatile("s_waitcnt lgkmcnt(" #n ")" ::: "memory")
#define PG8_BAR __builtin_amdgcn_s_barrier()
#define PG8_SCHED __builtin_amdgcn_sched_barrier(0)
    Unit cur, nxt; int ui = 0;
    if (!S.next(0, cur)) return;
    f32x4 acc[2][2][4][2];
#pragma unroll
    for (int a = 0; a < 2; ++a)
#pragma unroll
        for (int b = 0; b < 2; ++b)
#pragma unroll
            for (int m = 0; m < 4; ++m)
#pragma unroll
                for (int n = 0; n < 2; ++n) acc[a][b][m][n] = (f32x4){0.f, 0.f, 0.f, 0.f};
    bf16x8 At[4][2], B0[2][2], B1[2][2];
    const char* cA = (const char*)g.A + (size_t)cur.pm * tstep + (size_t)cur.kt0 * kstep; const char* cB = (const char*)g.Bt + (size_t)cur.pn * tstep + (size_t)cur.kt0 * kstep;
    S.a_ready(cur);
    PG8_STAGE(PG8_SB(0, 0), cB, voffB); PG8_STAGE(PG8_SB(0, 1), cB + hstep, voffB); PG8_STAGE(PG8_SA(0, 0), cA, voffA); PG8_STAGE(PG8_SA(0, 1), cA + hstep, voffA);
    if (wr == 1) PG8_BAR;
    PG8_WAIT_V(2); PG8_BAR;
    PG8_STAGE(PG8_SB(1, 0), cB + kstep, voffB); PG8_STAGE(PG8_SA(1, 0), cA + kstep, voffA); PG8_STAGE(PG8_SB(1, 1), cB + hstep + kstep, voffB);
    PG8_WAIT_V(6); PG8_BAR;
    PG8_STAGE(PG8_SA(1, 1), cA + kstep + hstep, voffA);
    { const unsigned doff = ((unsigned)__builtin_amdgcn_workgroup_id_x() * 8u + (unsigned)wid) * 64u;
#pragma unroll
      for (int j = 0; j < 16; ++j) asm volatile("global_store_dword %0, %0, %1" :: "v"(doff), "s"(scratch) : "memory"); }
#define PG8_PAIR(WV) \
              \
            PG8_LDB(B0, 0, 0); PG8_LDB(B1, 0, 1); PG8_SCHED; PG8_LDA(At, 0, 0); \
            PG8_WAIT_V(WV); PG8_WAIT_L(0); PG8_BAR; PG8_MMA(0, 0, At, B0); PG8_MMA(0, 1, At, B1); PG8_BAR; PG8_SCHED; \
              \
            PG8_LDA(At, 0, 1); PG8_STAGE(PG8_SB(0, 0), b2, voffB); PG8_STAGE(PG8_SB(0, 1), b2 + hstep, voffB); PG8_STAGE(PG8_SA(0, 0), a2, voffA); \
            PG8_WAIT_V(WV); PG8_WAIT_L(0); PG8_BAR; PG8_MMA(1, 0, At, B0); PG8_MMA(1, 1, At, B1); PG8_BAR; PG8_SCHED; \
              \
            PG8_LDB(B0, 1, 0); PG8_LDB(B1, 1, 1); PG8_SCHED; PG8_LDA(At, 1, 0); PG8_STAGE(PG8_SA(0, 1), a2 + hstep, voffA); \
            PG8_WAIT_V(WV); PG8_WAIT_L(0); PG8_BAR; PG8_MMA(0, 0, At, B0); PG8_MMA(0, 1, At, B1); PG8_BAR; PG8_SCHED; \
              \
            PG8_LDA(At, 1, 1); PG8_STAGE(PG8_SB(1, 0), b3, voffB); PG8_STAGE(PG8_SB(1, 1), b3 + hstep, voffB); PG8_STAGE(PG8_SA(1, 0), a3, voffA); \
            PG8_WAIT_V(8); PG8_WAIT_L(0); PG8_BAR; PG8_MMA(1, 0, At, B0); PG8_MMA(1, 1, At, B1); PG8_BAR; PG8_SCHED; \
            PG8_STAGE(PG8_SA(1, 1), a3 + hstep, voffA); PG8_SCHED;
    for (;;) {
        const bool has_next = S.next(ui + 1, nxt);
        PG8_NCONST char* nA = has_next ? (const char*)g.A + (size_t)nxt.pm * tstep + (size_t)nxt.kt0 * kstep : cA; PG8_NCONST char* nB = has_next ? (const char*)g.Bt + (size_t)nxt.pn * tstep + (size_t)nxt.kt0 * kstep : cB;
        const int nt = cur.nt;
#if PG8_PROBE_MODE > 0
        {
#define PG8_PM (PG8_PROBE_MODE != 1 && PG8_PROBE_MODE != 5)
#define PG8_PL (PG8_PROBE_MODE != 3 && PG8_PROBE_MODE != 5)
#define PG8_PG (PG8_PROBE_MODE < 2 || PG8_PROBE_MODE == 4)
            if (!PG8_PL) {
#pragma unroll
                for (int m = 0; m < 4; ++m)
#pragma unroll
                    for (int k = 0; k < 2; ++k) asm volatile("" : "=v"(At[m][k]));
#pragma unroll
                for (int n = 0; n < 2; ++n)
#pragma unroll
                    for (int k = 0; k < 2; ++k) { asm volatile("" : "=v"(B0[n][k])); asm volatile("" : "=v"(B1[n][k])); } }
            for (int t = 0; t < nt; t += 2) {
                const bool last = (t == nt - 2);
                const char* a2 = last ? cA : cA + (size_t)(t + 2) * kstep; const char* b2 = last ? cB : cB + (size_t)(t + 2) * kstep;
                const char* a3 = a2 + kstep; const char* b3 = b2 + kstep;
                PG8_PAIR(8)
            }
#pragma unroll
            for (int a = 0; a < 2; ++a)
#pragma unroll
                for (int b = 0; b < 2; ++b)
#pragma unroll
                    for (int m = 0; m < 4; ++m)
#pragma unroll
                        for (int n = 0; n < 2; ++n) asm volatile("" :: "v"(acc[a][b][m][n]));
#undef PG8_PM
#undef PG8_PL
#undef PG8_PG
#define PG8_PM true
#define PG8_PL true
#define PG8_PG true
#pragma unroll
            for (int a = 0; a < 2; ++a)
#pragma unroll
                for (int b = 0; b < 2; ++b)
#pragma unroll
                    for (int m = 0; m < 4; ++m)
#pragma unroll
                        for (int n = 0; n < 2; ++n) acc[a][b][m][n] = (f32x4){0.f, 0.f, 0.f, 0.f};
            { const unsigned doff = ((unsigned)__builtin_amdgcn_workgroup_id_x() * 8u + (unsigned)wid) * 64u;
#pragma unroll
              for (int j = 0; j < 16; ++j) asm volatile("global_store_dword %0, %0, %1" :: "v"(doff), "s"(scratch) : "memory"); }
        }
#endif
        {
            const char* a2 = cA + 2 * kstep; const char* b2 = cB + 2 * kstep; const char* a3 = a2 + kstep; const char* b3 = b2 + kstep;
            PG8_PAIR(24)
        }
        for (int t = 2; t < nt; t += 2) {
            const bool last = (t == nt - 2);
            const char* a2 = last ? nA : cA + (size_t)(t + 2) * kstep; const char* b2 = last ? nB : cB + (size_t)(t + 2) * kstep;
            const char* a3 = a2 + kstep; const char* b3 = b2 + kstep;
            if (last && has_next) S.a_ready(nxt);
            PG8_PAIR(8)
        }
        if constexpr (ALIGN_EPI) { if (wr == 0) PG8_BAR; }
        if constexpr (!Epi::AFTER_DRAIN) { int l_ = (int)__builtin_amdgcn_mbcnt_hi(~0u, __builtin_amdgcn_mbcnt_lo(~0u, 0u)); asm volatile("" : "+v"(l_));
            E(acc, cur, wr, wc, l_ & 15, l_ >> 4); S.done(cur); }
        if (!has_next) break;
#pragma unroll
        for (int a = 0; a < 2; ++a)
#pragma unroll
            for (int b = 0; b < 2; ++b)
#pragma unroll
                for (int m = 0; m < 4; ++m)
#pragma unroll
                    for (int n = 0; n < 2; ++n) acc[a][b][m][n] = (f32x4){0.f, 0.f, 0.f, 0.f};
        cur = nxt; cA = nA; cB = nB; ++ui;
        if constexpr (ALIGN_EPI) { if (wr == 1) PG8_BAR; }
    }
#undef PG8_PAIR
    PG8_WAIT_V(0);
    if constexpr (!ALIGN_EPI) { if (wr == 0) PG8_BAR; }
    PG8_BAR;
    if constexpr (Epi::AFTER_DRAIN) { E.fused(acc, cur, wr, wc, fr, fq, lds, wid, lane); S.done(cur); }
#undef PG8_SA
#undef PG8_SB
#undef PG8_STAGE
#undef PG8_LDA
#undef PG8_LDB
#undef PG8_MMA
#undef PG8_WAIT_V
#undef PG8_WAIT_L
#undef PG8_BAR
#undef PG8_SCHED
}
}

constexpr int NWAVES = 8;
constexpr int D = 1024, FF = 4096, M_CTX = 4096, M_LAT = 16384, M = M_CTX + M_LAT;
constexpr int L_LAT = 2048, L_CTX = 256, PAST = 256, LKV = PAST + L_LAT;
constexpr int MKV = M_CTX + 8 * LKV;
constexpr int EVEN_N = 3104, EVEN_NP = 3328, ODD_N = 576, ODD_NP = 768;
constexpr float EPS = 1e-6f;
constexpr int PC_QA = 0, PC_KA = 256, PC_VA = 512, PC_GA = 1024, PC_QB = 1536, PC_KB = 1792, PC_VB = 2048, PC_GB = 2560, PC_GK = 3072;
constexpr size_t OUT_Y = 0, OUT_CKV = 20971520, OUT_KPE = 23068672, OUT_SGLA = 23592960, OUT_SRET = 25690112;

constexpr size_t MiB = 1u << 20;
constexpr size_t WS_CTL = 0, CTL_ZERO_BYTES = 64 * 1024;
constexpr size_t WS_MOD = 1 * MiB;
constexpr size_t WS_ROPE = 2 * MiB;
constexpr size_t WS_KPE = 3 * MiB;
constexpr size_t WS_ACKV = 6 * MiB;
constexpr size_t WS_WINE = 18 * MiB;
constexpr size_t WS_WOUTE = 31 * MiB;
constexpr size_t WS_WINO = 35 * MiB;
constexpr size_t WS_WQB = 38 * MiB;
constexpr size_t WS_WKVB = 40 * MiB;
constexpr size_t WS_WOUTO = 42 * MiB;
constexpr size_t WS_W1 = 46 * MiB;
constexpr size_t WS_W2 = 78 * MiB;
constexpr size_t WS_HB = 110 * MiB;
constexpr size_t WS_Y = 150 * MiB;
constexpr size_t WS_BIG = 190 * MiB;
constexpr size_t WS_Q = WS_BIG, WS_KV = WS_BIG + 60 * MiB, WS_QN = WS_BIG + 148 * MiB;
constexpr size_t WS_SLAB = 350 * MiB;
constexpr size_t WS_END = 382 * MiB;

constexpr int RING_BYTES = 131072;
constexpr int LDS_MISC = 155648;
constexpr int LDS_BYTES = 163840;

#define GAS __attribute__((address_space(1)))
#define LAS __attribute__((address_space(3)))
typedef unsigned short bf16;
typedef unsigned v4u __attribute__((ext_vector_type(4)));
typedef unsigned v2u __attribute__((ext_vector_type(2)));
typedef float f32x4 __attribute__((ext_vector_type(4)));
typedef float f32x16 __attribute__((ext_vector_type(16)));
typedef short bf16x8 __attribute__((ext_vector_type(8)));
typedef short s16x4 __attribute__((ext_vector_type(4)));
#define LDS_WAIT() asm volatile("s_waitcnt lgkmcnt(0)" ::: "memory")
#define VM_WAIT() asm volatile("s_waitcnt vmcnt(0)" ::: "memory")
typedef float f32x2_t __attribute__((ext_vector_type(2))); typedef __bf16 bf16x2_t __attribute__((ext_vector_type(2)));
__device__ __forceinline__ unsigned pk2(float lo, float hi) { f32x2_t v = {lo, hi}; bf16x2_t b = __builtin_convertvector(v, bf16x2_t); return __builtin_bit_cast(unsigned, b); }
__device__ __forceinline__ unsigned f2bf(float f) { return pk2(f, f) & 0xffffu; }
__device__ __forceinline__ float bflo(unsigned w) { return __builtin_bit_cast(float, w << 16); }
__device__ __forceinline__ float bfhi(unsigned w) { return __builtin_bit_cast(float, w & 0xffff0000u); }
__device__ __forceinline__ float wave_sum(float v) {
#pragma unroll
    for (int o = 1; o < 64; o <<= 1) v += __shfl_xor(v, o);
    return v;
}
__device__ __forceinline__ float siluf(float x) { return x * __builtin_amdgcn_rcpf(1.0f + __expf(-x)); }

#define XB_TMO      128
#define XB_XCNT(j)  (256  + 64 * (j))
#define XB_XSUB(j)  (1280 + 64 * (j))
#define XB_XGEN(j)  (2304 + 64 * (j))
#define XB_TOP      3328
#define XB_TOPGEN   3392
#define XCD_BAR_WORDS 3456
#define XB_SPIN_CAP (1u << 20)
__device__ __forceinline__ unsigned xb_ld(unsigned* p)              { return __hip_atomic_load(p, __ATOMIC_RELAXED, __HIP_MEMORY_SCOPE_AGENT); }
__device__ __forceinline__ unsigned xb_add(unsigned* p, unsigned v) { return __hip_atomic_fetch_add(p, v, __ATOMIC_RELAXED, __HIP_MEMORY_SCOPE_AGENT); }
__device__ __forceinline__ unsigned xb_xcc_id() { return (unsigned)__builtin_amdgcn_s_getreg((3 << 11) | 20) & 0xFu; }
#define XB_SPIN(cond, bar) do { unsigned _sp = 0; while (cond) { __builtin_amdgcn_s_sleep(1); \
    if ((++_sp & 255u) == 0u) { if (xb_ld(&(bar)[XB_TMO])) break; if (_sp > XB_SPIN_CAP) { atomicAdd(&(bar)[XB_TMO], 1u); break; } } } } while (0)
struct XcdBarrier { unsigned* bar; unsigned x; volatile LAS unsigned* st; };
__device__ __forceinline__ XcdBarrier xcd_barrier_post(unsigned* bar, volatile LAS unsigned* st) {
    XcdBarrier b; b.bar = bar; b.x = xb_xcc_id(); b.st = st;
    if (threadIdx.x == 0) (void)xb_add(&bar[XB_XCNT(b.x)], 1u);
    return b;
}
__device__ __forceinline__ void xcd_barrier_complete(unsigned* bar, unsigned x, unsigned& nloc, unsigned& nx) {
    const unsigned G = gridDim.x * gridDim.y * gridDim.z;
    unsigned sum, cnt, mine, sp = 0u;
    for (;;) {
        sum = 0u; cnt = 0u; mine = 0u;
#pragma unroll
        for (unsigned j = 0; j < 16; ++j) { const unsigned c = xb_ld(&bar[XB_XCNT(j)]); sum += c; cnt += (c > 0u) ? 1u : 0u; mine = (j == x) ? c : mine; }
        if (sum == G) break;
        __builtin_amdgcn_s_sleep(1);
        if ((++sp & 255u) == 0u) { if (xb_ld(&bar[XB_TMO])) break; if (sp > XB_SPIN_CAP) { atomicAdd(&bar[XB_TMO], 1u); break; } }
    }
    nloc = mine > 0u ? mine : 1u; nx = cnt > 0u ? cnt : 1u;
}
__device__ __forceinline__ void xcd_barrier(const XcdBarrier& b) {
    asm volatile("s_waitcnt vmcnt(0)" ::: "memory");
    __syncthreads();
    if (threadIdx.x == 0) {
        unsigned* bar = b.bar;
        __builtin_amdgcn_s_waitcnt(0);
        unsigned nloc = b.st[0], nx = b.st[1];
        if (nloc == 0u) { xcd_barrier_complete(bar, b.x, nloc, nx); b.st[0] = nloc; b.st[1] = nx; }
        const unsigned old = xb_add(&bar[XB_XSUB(b.x)], 1u);
        const unsigned gen = old / nloc;
        if (old + 1u == (gen + 1u) * nloc) {
            __builtin_amdgcn_fence(__ATOMIC_RELEASE, "agent");
            __builtin_amdgcn_fence(__ATOMIC_ACQUIRE, "agent");
            asm volatile("s_waitcnt vmcnt(0)" ::: "memory");
            const unsigned og = xb_add(&bar[XB_TOP], 1u);
            const unsigned tg = og / nx;
            if (og + 1u == (tg + 1u) * nx) xb_add(&bar[XB_TOPGEN], 1u);
            else XB_SPIN(xb_ld(&bar[XB_TOPGEN]) == tg, bar);
            xb_add(&bar[XB_XGEN(b.x)], 1u);
        } else {
            __builtin_amdgcn_fence(__ATOMIC_ACQUIRE, "agent");
            asm volatile("s_waitcnt vmcnt(0)" ::: "memory");
            XB_SPIN(xb_ld(&bar[XB_XGEN(b.x)]) == gen, bar);
        }
        asm volatile("s_waitcnt vmcnt(0)" ::: "memory");
    }
    __syncthreads();
}

struct Params { const float* in[28]; float* out; unsigned char* ws; int ph_lo, ph_hi, use_bar, pad; };
enum { I_XP = 0, I_XS, I_CCKV, I_CKPE, I_SGLA, I_SRET, I_C, I_CCTX, I_WADA, I_BADA, I_NMIXPRE, I_NMIXPOST, I_NMLPPRE, I_NMLPPOST,
       I_WINE, I_WGK2, I_BGK2, I_GLAN, I_RDEC, I_WOUTE, I_WINO, I_QAN, I_WQB, I_KVAN, I_WKVB, I_WOUTO, I_W1, I_W2 };
struct Frame { LAS unsigned char* lds; int tid, lane, wave, vcu, G, bid; };
constexpr int LDS_PT = LDS_MISC + 256;
#define KAS __attribute__((address_space(4)))
__device__ __forceinline__ const void* ldp(LAS unsigned char*, int i) {
    unsigned off = (unsigned)i * 8u; asm volatile("" : "+s"(off));
    const KAS unsigned char* ka = (const KAS unsigned char*)__builtin_amdgcn_kernarg_segment_ptr();
    const unsigned long long v = *(const KAS unsigned long long*)(ka + off);
    return (const void*)(const GAS void*)v;
}
#define PIN(i) ((const float*)ldp(F.lds, (i)))
#define POUT ((float*)ldp(F.lds, 28))
#define PWS ((unsigned char*)ldp(F.lds, 29))

__device__ __forceinline__ void p0_transpose_item(const float* W, int K, int N, bf16* WT, int kb, int n0, int dn0, LAS float* scr, int lane) {
    const int k0 = 64 * kb;
    f32x4 wv[8];
#pragma unroll
    for (int i = 0; i < 8; ++i) wv[i] = __builtin_nontemporal_load((const f32x4*)(W + (size_t)(k0 + 8 * i + (lane >> 3)) * N + n0 + 4 * (lane & 7)));
#pragma unroll
    for (int i = 0; i < 8; ++i) { LAS float* d = scr + (8 * i + (lane >> 3)) * 33 + 4 * (lane & 7); d[0] = wv[i][0]; d[1] = wv[i][1]; d[2] = wv[i][2]; d[3] = wv[i][3]; }
    LDS_WAIT(); asm volatile("" ::: "memory");
    const int c = lane & 7;
#pragma unroll
    for (int j = 0; j < 4; ++j) { const int n = (lane >> 3) + 8 * j; const LAS float* s = scr + (8 * c) * 33 + n;
        v4u o; o.x = pk2(s[0 * 33], s[1 * 33]); o.y = pk2(s[2 * 33], s[3 * 33]); o.z = pk2(s[4 * 33], s[5 * 33]); o.w = pk2(s[6 * 33], s[7 * 33]);
        *(GAS v4u*)(WT + (size_t)(dn0 + n) * K + k0 + 8 * c) = o; }
    LDS_WAIT(); asm volatile("" ::: "memory");
}
__device__ __forceinline__ int even_col_map(int n0) { return n0 < 1536 ? n0 : (n0 < 1568 ? 3072 + (n0 - 1536) : n0 - 32); }

__device__ __forceinline__ void setup_work(Frame& F, const Params& P, int wgi, int nwg, int amask  , int mmask  , int eimask  , int eomask  , int omask  ) {
    unsigned char* ws = PWS;
    LAS float* scr = (LAS float*)(F.lds + F.wave * 16384);
    __syncthreads();
    {
        LAS float* S = (LAS float*)(F.lds);
        LAS float* R = (LAS float*)(F.lds + 40960);
        { const float* cp_ = PIN(I_C); const float* cc_ = PIN(I_CCTX);
          for (int i = F.tid; i < 9 * 1024; i += 512) { const int n = i >> 10, d = i & 1023; const float cv = n < 8 ? cp_[n * 1024 + d] : cc_[d]; S[i] = siluf(cv); } }
        const float* wada_ = PIN(I_WADA); const float* bada_ = PIN(I_BADA);
        __syncthreads();
        const int nl = __builtin_popcount(amask);
        for (int uu = wgi; uu < nl * 128; uu += nwg) {
            int li_ = uu >> 7, l = 0; { int m_ = amask; for (int k_ = 0; k_ < 4; ++k_) { if (m_ & 1) { if (li_ == 0) { l = k_; break; } --li_; } m_ >>= 1; } }
            const int cb = (uu & 127) * 48;
            if (F.tid < 384) {
                const int c4 = (F.tid % 12) * 4, part = F.tid / 12;
                const float* Wp = wada_ + ((size_t)l * 1024 + part * 32) * 6144 + cb + c4;
                f32x4 a[9];
#pragma unroll
                for (int n = 0; n < 9; ++n) a[n] = (f32x4){0.f, 0.f, 0.f, 0.f};
                for (int d0 = 0; d0 < 32; d0 += 16) { f32x4 w[16];
#pragma unroll
                    for (int dd = 0; dd < 16; ++dd) w[dd] = __builtin_nontemporal_load((const f32x4*)(Wp + (size_t)(d0 + dd) * 6144));
#pragma unroll
                    for (int dd = 0; dd < 16; ++dd)
#pragma unroll
                        for (int n = 0; n < 9; ++n) a[n] += w[dd] * S[n * 1024 + part * 32 + d0 + dd]; }
#pragma unroll
                for (int n = 0; n < 9; ++n) *(LAS f32x4*)(R + (part * 9 + n) * 48 + c4) = a[n];
            }
            __syncthreads();
            for (int i = F.tid; i < 9 * 48; i += 512) { const int n = i / 48, c = i % 48; float s = 0.f;
#pragma unroll
                for (int p = 0; p < 32; ++p) s += R[(p * 9 + n) * 48 + c];
                ((float*)(ws + WS_MOD))[((size_t)l * 9 + n) * 6144 + cb + c] = s + bada_[l * 6144 + cb + c]; }
            __syncthreads();
        }
    }
    {
        const int wk = wgi * NWAVES + F.wave, NW = nwg * NWAVES;
        const int I_E = (1024 / 64) * (EVEN_N / 32), I_OE = 16 * 32, I_O = 16 * (ODD_N / 32), I_QB = 4 * 48, I_KVB = 4 * 64, I_M1 = 16 * 128, I_M2 = 64 * 32;
        const float* itW; bf16* itT; int itK, itN, itkb, itn0, itdn0;
#define IT_TRY(sel, count, ...) if (sel) { if (g_ < base_ + (count)) { const int q = g_ - base_; __VA_ARGS__; itkb = kb; itn0 = n0; return_ = true; goto_done_ = true; } else base_ += (count); }
#define IT_DECODE(g, ok) do { const int g_ = (g); int base_ = 0; bool return_ = false, goto_done_ = false; \
        _Pragma("unroll") for (int l = 0; l < 2; ++l) { \
            if (!goto_done_) { IT_TRY((eimask >> l) & 1, I_E, const int nb = EVEN_N / 32, kb = q / nb, n0 = (q % nb) * 32; itW = PIN(I_WINE) + (size_t)l * 1024 * EVEN_N; itK = 1024; itN = EVEN_N; itT = (bf16*)(ws + WS_WINE) + (size_t)l * EVEN_NP * 1024; itdn0 = even_col_map(n0)) } \
            if (!goto_done_) { IT_TRY((eomask >> l) & 1, I_OE, const int kb = q / 32, n0 = (q % 32) * 32; itW = PIN(I_WOUTE) + (size_t)l * 1024 * 1024; itK = 1024; itN = 1024; itT = (bf16*)(ws + WS_WOUTE) + (size_t)l * 1024 * 1024; itdn0 = n0) } \
            if (!goto_done_) { IT_TRY((omask >> l) & 1, I_O, const int nb = ODD_N / 32, kb = q / nb, n0 = (q % nb) * 32; itW = PIN(I_WINO) + (size_t)l * 1024 * ODD_N; itK = 1024; itN = ODD_N; itT = (bf16*)(ws + WS_WINO) + (size_t)l * ODD_NP * 1024; itdn0 = n0) } \
            if (!goto_done_) { IT_TRY((omask >> l) & 1, I_QB, const int kb = q / 48, n0 = (q % 48) * 32; itW = PIN(I_WQB) + (size_t)l * 256 * 1536; itK = 256; itN = 1536; itT = (bf16*)(ws + WS_WQB) + (size_t)l * 1536 * 256; itdn0 = n0) } \
            if (!goto_done_) { IT_TRY((omask >> l) & 1, I_KVB, const int kb = q / 64, n0 = (q % 64) * 32; itW = PIN(I_WKVB) + (size_t)l * 256 * 2048; itK = 256; itN = 2048; itT = (bf16*)(ws + WS_WKVB) + (size_t)l * 2048 * 256; itdn0 = n0) } \
            if (!goto_done_) { IT_TRY((omask >> l) & 1, I_OE, const int kb = q / 32, n0 = (q % 32) * 32; itW = PIN(I_WOUTO) + (size_t)l * 1024 * 1024; itK = 1024; itN = 1024; itT = (bf16*)(ws + WS_WOUTO) + (size_t)l * 1024 * 1024; itdn0 = n0) } } \
        _Pragma("unroll") for (int l = 0; l < 4; ++l) { \
            if (!goto_done_) { IT_TRY((mmask >> l) & 1, I_M1, const int kb = q / 128, n0 = (q % 128) * 32; itW = PIN(I_W1) + (size_t)l * 1024 * 4096; itK = 1024; itN = 4096; itT = (bf16*)(ws + WS_W1) + (size_t)l * 4096 * 1024; itdn0 = n0) } \
            if (!goto_done_) { IT_TRY((mmask >> l) & 1, I_M2, const int kb = q / 32, n0 = (q % 32) * 32; itW = PIN(I_W2) + (size_t)l * 4096 * 1024; itK = 4096; itN = 1024; itT = (bf16*)(ws + WS_W2) + (size_t)l * 1024 * 4096; itdn0 = n0) } } \
        ok = return_; } while (0)
#define IT_LOAD(wv) do { _Pragma("unroll") for (int i = 0; i < 8; ++i) wv[i] = __builtin_nontemporal_load((const f32x4*)(itW + (size_t)(64 * itkb + 8 * i + (F.lane >> 3)) * itN + itn0 + 4 * (F.lane & 7))); } while (0)
#define IT_KEEP() const int cK = itK, ck0 = 64 * itkb, cdn0 = itdn0; bf16* const cT = itT
#define IT_PROC(wv) do { \
        _Pragma("unroll") for (int i = 0; i < 8; ++i) { LAS float* d = scr + (8 * i + (F.lane >> 3)) * 33 + 4 * (F.lane & 7); d[0] = wv[i][0]; d[1] = wv[i][1]; d[2] = wv[i][2]; d[3] = wv[i][3]; } \
        LDS_WAIT(); asm volatile("" ::: "memory"); \
        { const int c = F.lane & 7; \
          _Pragma("unroll") for (int j = 0; j < 4; ++j) { const int n = (F.lane >> 3) + 8 * j; const LAS float* s = scr + (8 * c) * 33 + n; \
              v4u o; o.x = pk2(s[0 * 33], s[1 * 33]); o.y = pk2(s[2 * 33], s[3 * 33]); o.z = pk2(s[4 * 33], s[5 * 33]); o.w = pk2(s[6 * 33], s[7 * 33]); \
              *(GAS v4u*)(cT + (size_t)(cdn0 + n) * cK + ck0 + 8 * c) = o; } } \
        LDS_WAIT(); asm volatile("" ::: "memory"); } while (0)
        f32x4 wa[8], wb[8]; bool ok; int g = wk;
        IT_DECODE(g, ok);
        if (ok) {
            IT_LOAD(wa);
            for (;;) {
                { IT_KEEP(); g += NW; IT_DECODE(g, ok);
                  if (ok) { IT_LOAD(wb); IT_PROC(wa); } else { IT_PROC(wa); break; } }
                { IT_KEEP(); g += NW; IT_DECODE(g, ok);
                  if (ok) { IT_LOAD(wa); IT_PROC(wb); } else { IT_PROC(wb); break; } }
            }
        }
#undef IT_TRY
#undef IT_DECODE
#undef IT_LOAD
#undef IT_KEEP
#undef IT_PROC
    }
    const int gt = wgi * 512 + F.tid, NGT = nwg * 512;
#pragma unroll
    for (int l = 0; l < 2; ++l) {
        if ((eimask >> l) & 1) { v4u z_ = {0u, 0u, 0u, 0u}; asm volatile("" : "+v"(z_)); for (int i = gt; i < 224 * 128; i += NGT) *(GAS v4u*)((bf16*)(ws + WS_WINE) + ((size_t)l * EVEN_NP + EVEN_N) * 1024 + (size_t)i * 8) = z_; }
        if ((omask >> l) & 1) { v4u z_ = {0u, 0u, 0u, 0u}; asm volatile("" : "+v"(z_)); for (int i = gt; i < 192 * 128; i += NGT) *(GAS v4u*)((bf16*)(ws + WS_WINO) + ((size_t)l * ODD_NP + ODD_N) * 1024 + (size_t)i * 8) = z_; }
    }
}
__device__ __forceinline__ void p0_prologue(Frame& F, const Params& P) {
    unsigned char* ws = PWS;
    setup_work(F, P, F.vcu, F.G, 0x5, 0x5, 0x3, 0x3, 0x0);
    const int gt = F.vcu * 512 + F.tid, NGT = F.G * 512;
    for (int i = gt; i < 2048 * 32; i += NGT) { const int t = i >> 5, j = i & 31; const float inv = powf(10000.0f, -(float)(j & 15) / 16.0f);
        const float ang = (float)(j < 16 ? (t >> 6) : (t & 63)) * inv;
        ((float*)(ws + WS_ROPE))[i] = cosf(ang); ((float*)(ws + WS_ROPE))[65536 + i] = sinf(ang); }
}

__device__ __forceinline__ void row_y(f32x4 (&yv)[4], const bf16* Y, const bf16* SL, int row, int l4) {
    if (row < 16384) {
#pragma unroll
        for (int j = 0; j < 4; ++j) { const v2u yw = __builtin_nontemporal_load((const v2u*)(Y + (size_t)row * D + l4 + 256 * j)); yv[j] = (f32x4){bflo(yw.x), bfhi(yw.x), bflo(yw.y), bfhi(yw.y)}; }
    } else {
        const bf16* sp = SL + (size_t)(row - 16384) * D + l4;
#pragma unroll
        for (int j = 0; j < 4; ++j) { const v2u w0 = __builtin_nontemporal_load((const v2u*)(sp + 256 * j)), w1 = __builtin_nontemporal_load((const v2u*)(sp + 4194304 + 256 * j)), w2 = __builtin_nontemporal_load((const v2u*)(sp + 2 * 4194304 + 256 * j)), w3 = __builtin_nontemporal_load((const v2u*)(sp + 3 * 4194304 + 256 * j));
            yv[j] = ((f32x4){bflo(w0.x), bfhi(w0.x), bflo(w0.y), bfhi(w0.y)} + (f32x4){bflo(w1.x), bfhi(w1.x), bflo(w1.y), bfhi(w1.y)}) +
                    ((f32x4){bflo(w2.x), bfhi(w2.x), bflo(w2.y), bfhi(w2.y)} + (f32x4){bflo(w3.x), bfhi(w3.x), bflo(w3.y), bfhi(w3.y)}); }
    }
}
struct RowVec { f32x4 gp[4], gt[4], gq[4], sc[4], sh[4]; };
__device__ __forceinline__ void row_post(f32x4 (&v)[4], const f32x4 (&yv)[4], const RowVec& R) {
    float s = 0.f;
#pragma unroll
    for (int j = 0; j < 4; ++j) s += (yv[j][0] * yv[j][0] + yv[j][1] * yv[j][1]) + (yv[j][2] * yv[j][2] + yv[j][3] * yv[j][3]);
    const float rstd = __builtin_amdgcn_rsqf(wave_sum(s) * (1.0f / 1024.0f) + EPS);
#pragma unroll
    for (int j = 0; j < 4; ++j) v[j] = v[j] + R.gt[j] * ((yv[j] * rstd) * R.gp[j]);
}
__device__ __forceinline__ void row_pass(Frame& F, const float* xa, const float* xb, bool xin_f32, bf16* XB, const bf16* Y, const bf16* SL, const float* g_post, const float* gate,
                                         const float* g_pre, const float* scale, const float* shift, bf16* H, bool has_post, bool has_pre) {
    const int gw = F.vcu * NWAVES + F.wave, NGW = F.G * NWAVES, l4 = F.lane * 4;
    RowVec R; int ncur = -1;
#pragma unroll
    for (int j = 0; j < 4; ++j) { R.gp[j] = has_post ? *(const f32x4*)(g_post + l4 + 256 * j) : (f32x4){0.f, 0.f, 0.f, 0.f}; R.gq[j] = has_pre ? *(const f32x4*)(g_pre + l4 + 256 * j) : (f32x4){0.f, 0.f, 0.f, 0.f};
        R.gt[j] = R.gp[j]; R.sc[j] = R.gp[j]; R.sh[j] = R.gp[j]; }
    for (int blk = gw; blk * 10 < M; blk += NGW) for (int i = 0; i < 10; i += 2) {
        const int row0 = blk * 10 + i; if (row0 >= M) break;
        const int n = row0 < M_CTX ? 8 : ((row0 - M_CTX) >> 11);
        if (n != ncur) { ncur = n;
#pragma unroll
            for (int j = 0; j < 4; ++j) { const int c = l4 + 256 * j;
                if (has_post) R.gt[j] = *(const f32x4*)(gate + (size_t)n * 6144 + c);
                if (has_pre) { R.sc[j] = *(const f32x4*)(scale + (size_t)n * 6144 + c); R.sh[j] = *(const f32x4*)(shift + (size_t)n * 6144 + c); } } }
        f32x4 v[2][4], yv[2][4];
#pragma unroll
        for (int q = 0; q < 2; ++q) { const int row = row0 + q;
            if (xin_f32) { const float* xr = row < M_CTX ? xa + (size_t)row * D : xb + (size_t)(row - M_CTX) * D;
#pragma unroll
                for (int j = 0; j < 4; ++j) v[q][j] = __builtin_nontemporal_load((const f32x4*)(xr + l4 + 256 * j));
            } else {
#pragma unroll
                for (int j = 0; j < 4; ++j) { const v2u xw = __builtin_nontemporal_load((const v2u*)(XB + (size_t)row * D + l4 + 256 * j)); v[q][j] = (f32x4){bflo(xw.x), bfhi(xw.x), bflo(xw.y), bfhi(xw.y)}; }
            }
            if (has_post) row_y(yv[q], Y, SL, row, l4); }
#pragma unroll
        for (int q = 0; q < 2; ++q) { const int row = row0 + q;
            if (has_post) {
                row_post(v[q], yv[q], R);
#pragma unroll
                for (int j = 0; j < 4; ++j) *(v2u*)(XB + (size_t)row * D + l4 + 256 * j) = (v2u){pk2(v[q][j][0], v[q][j][1]), pk2(v[q][j][2], v[q][j][3])};
            }
            if (has_pre) {
                float s = 0.f;
#pragma unroll
                for (int j = 0; j < 4; ++j) s += (v[q][j][0] * v[q][j][0] + v[q][j][1] * v[q][j][1]) + (v[q][j][2] * v[q][j][2] + v[q][j][3] * v[q][j][3]);
                const float rstd = __builtin_amdgcn_rsqf(wave_sum(s) * (1.0f / 1024.0f) + EPS);
#pragma unroll
                for (int j = 0; j < 4; ++j) { const f32x4 h = ((v[q][j] * rstd) * R.gq[j]) * (1.0f + R.sc[j]) + R.sh[j];
                    *(v2u*)(H + (size_t)row * D + l4 + 256 * j) = (v2u){pk2(h[0], h[1]), pk2(h[2], h[3])}; }
            } }
    }
}
struct RowDeal { int r0, cnt; bool tail; };
__device__ __forceinline__ RowDeal row_deal(int gw) { const int x = gw >> 8, w = gw & 255; RowDeal d;
    if (w < 171) { d.tail = false; d.r0 = 2048 * x + 12 * w; d.cnt = w < 170 ? 12 : 8; }
    else { const int u = w - 171; d.tail = true; d.r0 = 16384 + 512 * x + (u == 0 ? 0 : 8 + 6 * (u - 1)); d.cnt = u == 0 ? 8 : 6; }
    return d; }
struct RawN { v2u x[2][4], y[2][4]; };
struct RawT { v2u x[4], s[4][4]; };
__device__ __forceinline__ void row_mid_out(f32x4 (&v)[4], const f32x4 (&yv)[4], const RowVec& R, bf16* XB, bf16* H, int row, int l4) {
    row_post(v, yv, R);
#pragma unroll
    for (int j = 0; j < 4; ++j) *(v2u*)(XB + (size_t)row * D + l4 + 256 * j) = (v2u){pk2(v[j][0], v[j][1]), pk2(v[j][2], v[j][3])};
    float s = 0.f;
#pragma unroll
    for (int j = 0; j < 4; ++j) s += (v[j][0] * v[j][0] + v[j][1] * v[j][1]) + (v[j][2] * v[j][2] + v[j][3] * v[j][3]);
    const float rstd = __builtin_amdgcn_rsqf(wave_sum(s) * (1.0f / 1024.0f) + EPS);
#pragma unroll
    for (int j = 0; j < 4; ++j) { const f32x4 h = ((v[j] * rstd) * R.gq[j]) * (1.0f + R.sc[j]) + R.sh[j];
        *(v2u*)(H + (size_t)row * D + l4 + 256 * j) = (v2u){pk2(h[0], h[1]), pk2(h[2], h[3])}; }
}
__device__ __forceinline__ void row_pass_mid(Frame& F, bf16* XB, const bf16* Y, const bf16* SL, const float* g_post, const float* gate, const float* g_pre, const float* scale, const float* shift, bf16* H) {
    const int gw = F.vcu * NWAVES + F.wave, l4 = F.lane * 4;
    RowVec R; int ncur = -1;
#pragma unroll
    for (int j = 0; j < 4; ++j) { R.gp[j] = *(const f32x4*)(g_post + l4 + 256 * j); R.gq[j] = *(const f32x4*)(g_pre + l4 + 256 * j); R.gt[j] = R.gp[j]; R.sc[j] = R.gp[j]; R.sh[j] = R.gp[j]; }
#define RM_PARAMS(row) do { const int n_ = (row) < M_CTX ? 8 : (((row) - M_CTX) >> 11); if (n_ != ncur) { ncur = n_; \
        _Pragma("unroll") for (int j = 0; j < 4; ++j) { const int c = l4 + 256 * j; R.gt[j] = *(const f32x4*)(gate + (size_t)n_ * 6144 + c); R.sc[j] = *(const f32x4*)(scale + (size_t)n_ * 6144 + c); R.sh[j] = *(const f32x4*)(shift + (size_t)n_ * 6144 + c); } \
        __builtin_amdgcn_s_waitcnt(0x0F70); } } while (0)
#define RM_UNP(w) ((f32x4){bflo((w).x), bfhi((w).x), bflo((w).y), bfhi((w).y)})
#define RM_LOADN(S, row0) do { _Pragma("unroll") for (int q = 0; q < 2; ++q) _Pragma("unroll") for (int j = 0; j < 4; ++j) { \
            S.x[q][j] = __builtin_nontemporal_load((const v2u*)(XB + (size_t)((row0) + q) * D + l4 + 256 * j)); S.y[q][j] = __builtin_nontemporal_load((const v2u*)(Y + (size_t)((row0) + q) * D + l4 + 256 * j)); } } while (0)
#define RM_PROCN(S, row0) do { RM_PARAMS(row0); _Pragma("unroll") for (int q = 0; q < 2; ++q) { f32x4 v[4], yv[4]; \
            _Pragma("unroll") for (int j = 0; j < 4; ++j) { v[j] = RM_UNP(S.x[q][j]); yv[j] = RM_UNP(S.y[q][j]); } \
            row_mid_out(v, yv, R, XB, H, (row0) + q, l4); } } while (0)
#define RM_LOADT(S, row) do { const bf16* sp_ = SL + (size_t)((row) - 16384) * D + l4; _Pragma("unroll") for (int j = 0; j < 4; ++j) { \
            S.x[j] = __builtin_nontemporal_load((const v2u*)(XB + (size_t)(row) * D + l4 + 256 * j)); \
            _Pragma("unroll") for (int k = 0; k < 4; ++k) S.s[k][j] = __builtin_nontemporal_load((const v2u*)(sp_ + (size_t)k * 4194304 + 256 * j)); } } while (0)
#define RM_PROCT(S, row) do { RM_PARAMS(row); f32x4 v[4], yv[4]; \
            _Pragma("unroll") for (int j = 0; j < 4; ++j) { v[j] = RM_UNP(S.x[j]); yv[j] = (RM_UNP(S.s[0][j]) + RM_UNP(S.s[1][j])) + (RM_UNP(S.s[2][j]) + RM_UNP(S.s[3][j])); } \
            row_mid_out(v, yv, R, XB, H, (row), l4); } while (0)
    const RowDeal dl_ = row_deal(gw); const int r0 = dl_.r0, cnt = dl_.cnt;
    if (!dl_.tail) {
        RawN A, B;
        if (cnt == 12) {
            RM_LOADN(A, r0);
            RM_PARAMS(r0);
#pragma unroll
            for (int i = 0; i < 12; i += 4) {
                RM_LOADN(B, r0 + i + 2);
                RM_PROCN(A, r0 + i);
                if (i + 4 < 12) RM_LOADN(A, r0 + i + 4);
                RM_PROCN(B, r0 + i + 2);
            }
        } else {
            RM_PARAMS(r0);
            for (int i = 0; i < cnt; i += 2) { RM_LOADN(A, r0 + i); RM_PROCN(A, r0 + i); }
        }
    } else {
        RawT A, B;
        RM_LOADT(A, r0);
        RM_PARAMS(r0);
#pragma unroll
        for (int i = 0; i < 6; i += 2) {
            RM_LOADT(B, r0 + i + 1);
            RM_PROCT(A, r0 + i);
            if (i + 2 < 6) RM_LOADT(A, r0 + i + 2);
            RM_PROCT(B, r0 + i + 1);
        }
        for (int i = 6; i < cnt; ++i) { RM_LOADT(A, r0 + i); RM_PROCT(A, r0 + i); }
    }
#undef RM_LOADN
#undef RM_PROCN
#undef RM_LOADT
#undef RM_PROCT
#undef RM_UNP
#undef RM_PARAMS
}
template <bool POST>
__device__ __forceinline__ void row_pass_f32(Frame& F, const float* xa, const float* xb, bf16* XB, const bf16* Y, const bf16* SL, const float* g_post, const float* gate,
                                             const float* g_pre, const float* scale, const float* shift, bf16* H) {
    const int gw = F.vcu * NWAVES + F.wave, l4 = F.lane * 4;
    RowVec R; int ncur = -1;
#pragma unroll
    for (int j = 0; j < 4; ++j) { R.gq[j] = *(const f32x4*)(g_pre + l4 + 256 * j); R.gp[j] = POST ? *(const f32x4*)(g_post + l4 + 256 * j) : R.gq[j]; R.gt[j] = R.gq[j]; R.sc[j] = R.gq[j]; R.sh[j] = R.gq[j]; }
#define RX_PARAMS(row) do { const int n_ = (row) < M_CTX ? 8 : (((row) - M_CTX) >> 11); if (n_ != ncur) { ncur = n_; \
        _Pragma("unroll") for (int j = 0; j < 4; ++j) { const int c = l4 + 256 * j; if (POST) R.gt[j] = *(const f32x4*)(gate + (size_t)n_ * 6144 + c); R.sc[j] = *(const f32x4*)(scale + (size_t)n_ * 6144 + c); R.sh[j] = *(const f32x4*)(shift + (size_t)n_ * 6144 + c); } \
        __builtin_amdgcn_s_waitcnt(0x0F70); } } while (0)
#define RX_UNP(w) ((f32x4){bflo((w).x), bfhi((w).x), bflo((w).y), bfhi((w).y)})
#define RX_XROW(row) ((row) < M_CTX ? xa + (size_t)(row) * D : xb + (size_t)((row) - M_CTX) * D)
#define RX_OUT(v, yv, row) do { if (POST) { row_post(v, yv, R); \
            _Pragma("unroll") for (int j = 0; j < 4; ++j) *(v2u*)(XB + (size_t)(row) * D + l4 + 256 * j) = (v2u){pk2(v[j][0], v[j][1]), pk2(v[j][2], v[j][3])}; } \
        float s_ = 0.f; _Pragma("unroll") for (int j = 0; j < 4; ++j) s_ += (v[j][0] * v[j][0] + v[j][1] * v[j][1]) + (v[j][2] * v[j][2] + v[j][3] * v[j][3]); \
        const float rstd_ = __builtin_amdgcn_rsqf(wave_sum(s_) * (1.0f / 1024.0f) + EPS); \
        _Pragma("unroll") for (int j = 0; j < 4; ++j) { const f32x4 h = ((v[j] * rstd_) * R.gq[j]) * (1.0f + R.sc[j]) + R.sh[j]; \
            *(v2u*)(H + (size_t)(row) * D + l4 + 256 * j) = (v2u){pk2(h[0], h[1]), pk2(h[2], h[3])}; } } while (0)
    RowDeal dl_; if (POST) dl_ = row_deal(gw); else { dl_.tail = false; dl_.r0 = gw * 10; dl_.cnt = 10; }
    const int r0 = dl_.r0, cnt = dl_.cnt;
    if (!dl_.tail) {
        f32x4 xA[4], xB[4]; v2u yA[4], yB[4];
#define RX_LOADN(X, Yr, row) do { const float* xr_ = RX_XROW(row); _Pragma("unroll") for (int j = 0; j < 4; ++j) { \
            X[j] = __builtin_nontemporal_load((const f32x4*)(xr_ + l4 + 256 * j)); if (POST) Yr[j] = __builtin_nontemporal_load((const v2u*)(Y + (size_t)(row) * D + l4 + 256 * j)); } } while (0)
#define RX_PROCN(X, Yr, row) do { RX_PARAMS(row); f32x4 v[4], yv[4]; \
            _Pragma("unroll") for (int j = 0; j < 4; ++j) { v[j] = X[j]; yv[j] = POST ? RX_UNP(Yr[j]) : v[j]; } RX_OUT(v, yv, (row)); } while (0)
        if (cnt == 12) {
            RX_LOADN(xA, yA, r0);
            RX_PARAMS(r0);
#pragma unroll
            for (int i = 0; i < 12; i += 2) { RX_LOADN(xB, yB, r0 + i + 1); RX_PROCN(xA, yA, r0 + i); if (i + 2 < 12) RX_LOADN(xA, yA, r0 + i + 2); RX_PROCN(xB, yB, r0 + i + 1); }
        } else if (cnt == 10) {
            RX_LOADN(xA, yA, r0);
            RX_PARAMS(r0);
#pragma unroll
            for (int i = 0; i < 10; i += 2) { RX_LOADN(xB, yB, r0 + i + 1); RX_PROCN(xA, yA, r0 + i); if (i + 2 < 10) RX_LOADN(xA, yA, r0 + i + 2); RX_PROCN(xB, yB, r0 + i + 1); }
        } else {
            RX_PARAMS(r0);
            for (int i = 0; i < cnt; ++i) { RX_LOADN(xA, yA, r0 + i); RX_PROCN(xA, yA, r0 + i); }
        }
#undef RX_LOADN
#undef RX_PROCN
    } else {
        f32x4 xA[4]; v2u sA[4][4];
        RX_PARAMS(r0);
        for (int i = 0; i < cnt; ++i) { const int row = r0 + i; const float* xr_ = RX_XROW(row); const bf16* sp_ = SL + (size_t)(row - 16384) * D + l4;
#pragma unroll
            for (int j = 0; j < 4; ++j) { xA[j] = __builtin_nontemporal_load((const f32x4*)(xr_ + l4 + 256 * j));
#pragma unroll
                for (int k = 0; k < 4; ++k) sA[k][j] = __builtin_nontemporal_load((const v2u*)(sp_ + (size_t)k * 4194304 + 256 * j)); }
            RX_PARAMS(row); f32x4 v[4], yv[4];
#pragma unroll
            for (int j = 0; j < 4; ++j) { v[j] = xA[j]; yv[j] = (RX_UNP(sA[0][j]) + RX_UNP(sA[1][j])) + (RX_UNP(sA[2][j]) + RX_UNP(sA[3][j])); }
            RX_OUT(v, yv, row); }
    }
#undef RX_PARAMS
#undef RX_UNP
#undef RX_XROW
#undef RX_OUT
}
__device__ __forceinline__ void row_pass_final2(Frame& F, const XcdBarrier& bar, const bf16* XB, float* OUT, const bf16* Y, const bf16* SL, const float* g_post, const float* gate) {
    const int gw = F.vcu * NWAVES + F.wave, l4 = F.lane * 4;
    RowVec R; int ncur = -1;
#define RF_PARAMS(row) do { const int n_ = (row) < M_CTX ? 8 : (((row) - M_CTX) >> 11); if (n_ != ncur) { ncur = n_; \
        _Pragma("unroll") for (int j = 0; j < 4; ++j) R.gt[j] = *(const f32x4*)(gate + (size_t)n_ * 6144 + l4 + 256 * j); \
        __builtin_amdgcn_s_waitcnt(0x0F70); } } while (0)
#define RF_UNP(w) ((f32x4){bflo((w).x), bfhi((w).x), bflo((w).y), bfhi((w).y)})
#define RF_OUT(xr, yv, row) do { f32x4 v[4]; _Pragma("unroll") for (int j = 0; j < 4; ++j) v[j] = RF_UNP(xr[j]); row_post(v, yv, R); \
        _Pragma("unroll") for (int j = 0; j < 4; ++j) *(f32x4*)(OUT + (size_t)(row) * D + l4 + 256 * j) = v[j]; } while (0)
    const RowDeal dl_ = row_deal(gw); const int r0 = dl_.r0, cnt = dl_.cnt;
    if (!dl_.tail) {
        const bool full = cnt == 12;
        v2u xw[12][4];
#pragma unroll
        for (int i = 0; i < 12; ++i) if (full || i < 8) {
#pragma unroll
            for (int j = 0; j < 4; ++j) xw[i][j] = __builtin_nontemporal_load((const v2u*)(XB + (size_t)(r0 + i) * D + l4 + 256 * j)); }
        xcd_barrier(bar);
#pragma unroll
        for (int j = 0; j < 4; ++j) { R.gp[j] = *(const f32x4*)(g_post + l4 + 256 * j); R.gt[j] = R.gp[j]; }
#define RF_LOADN(S, row) do { _Pragma("unroll") for (int j = 0; j < 4; ++j) S[j] = __builtin_nontemporal_load((const v2u*)(Y + (size_t)(row) * D + l4 + 256 * j)); } while (0)
#define RF_PROCN(S, i, row) do { RF_PARAMS(row); f32x4 yv[4]; _Pragma("unroll") for (int j = 0; j < 4; ++j) yv[j] = RF_UNP(S[j]); RF_OUT(xw[i], yv, row); } while (0)
        v2u A[4], B[4], C[4];
        if (full) {
            RF_LOADN(A, r0); RF_LOADN(B, r0 + 1); RF_LOADN(C, r0 + 2);
            RF_PARAMS(r0);
#pragma unroll
            for (int i = 0; i < 12; i += 3) {
                RF_PROCN(A, i, r0 + i); if (i + 3 < 12) RF_LOADN(A, r0 + i + 3);
                RF_PROCN(B, i + 1, r0 + i + 1); if (i + 4 < 12) RF_LOADN(B, r0 + i + 4);
                RF_PROCN(C, i + 2, r0 + i + 2); if (i + 5 < 12) RF_LOADN(C, r0 + i + 5);
            }
        } else {
#pragma unroll
            RF_PARAMS(r0);
#pragma unroll
            for (int i = 0; i < 8; ++i) { RF_LOADN(A, r0 + i); RF_PROCN(A, i, r0 + i); }
        }
#undef RF_LOADN
#undef RF_PROCN
    } else {
        v2u xw[8][4];
#pragma unroll
        for (int i = 0; i < 8; ++i) if (i < cnt) {
#pragma unroll
            for (int j = 0; j < 4; ++j) xw[i][j] = __builtin_nontemporal_load((const v2u*)(XB + (size_t)(r0 + i) * D + l4 + 256 * j)); }
        xcd_barrier(bar);
#pragma unroll
        for (int j = 0; j < 4; ++j) { R.gp[j] = *(const f32x4*)(g_post + l4 + 256 * j); R.gt[j] = R.gp[j]; }
#define RF_LOADT(S, row) do { const bf16* sp_ = SL + (size_t)((row) - 16384) * D + l4; _Pragma("unroll") for (int k = 0; k < 4; ++k) _Pragma("unroll") for (int j = 0; j < 4; ++j) \
            S[k][j] = __builtin_nontemporal_load((const v2u*)(sp_ + (size_t)k * 4194304 + 256 * j)); } while (0)
#define RF_PROCT(S, i, row) do { RF_PARAMS(row); f32x4 yv[4]; _Pragma("unroll") for (int j = 0; j < 4; ++j) yv[j] = (RF_UNP(S[0][j]) + RF_UNP(S[1][j])) + (RF_UNP(S[2][j]) + RF_UNP(S[3][j])); RF_OUT(xw[i], yv, row); } while (0)
        v2u A[4][4], B[4][4];
        RF_LOADT(A, r0);
        RF_PARAMS(r0);
#pragma unroll
        for (int i = 0; i < 6; i += 2) {
            RF_LOADT(B, r0 + i + 1);
            RF_PROCT(A, i, r0 + i);
            if (i + 2 < 6) RF_LOADT(A, r0 + i + 2);
            RF_PROCT(B, i + 1, r0 + i + 1);
        }
        if (cnt == 8) { RF_LOADT(A, r0 + 6); RF_LOADT(B, r0 + 7); RF_PROCT(A, 6, r0 + 6); RF_PROCT(B, 7, r0 + 7); }
#undef RF_LOADT
#undef RF_PROCT
    }
#undef RF_PARAMS
#undef RF_UNP
#undef RF_OUT
}
__device__ __forceinline__ void row_pass_final(Frame& F, const XcdBarrier& bar, const bf16* XB, float* OUT, const bf16* Y, const bf16* SL, const float* g_post, const float* gate) {
    const int gw = F.vcu * NWAVES + F.wave, l4 = F.lane * 4;
    v2u xw[10][4];
#pragma unroll
    for (int i = 0; i < 10; ++i) { const int row = gw * 10 + i;
        if (row < M) {
#pragma unroll
            for (int j = 0; j < 4; ++j) xw[i][j] = __builtin_nontemporal_load((const v2u*)(XB + (size_t)row * D + l4 + 256 * j));
        } }
    xcd_barrier(bar);
    RowVec R; int ncur = -1;
#pragma unroll
    for (int j = 0; j < 4; ++j) { R.gp[j] = *(const f32x4*)(g_post + l4 + 256 * j); R.gt[j] = R.gp[j]; }
#pragma unroll
    for (int i = 0; i < 10; ++i) { const int row = gw * 10 + i;
        if (row < M) {
            const int n = row < M_CTX ? 8 : ((row - M_CTX) >> 11);
            if (n != ncur) { ncur = n;
#pragma unroll
                for (int j = 0; j < 4; ++j) R.gt[j] = *(const f32x4*)(gate + (size_t)n * 6144 + l4 + 256 * j); }
            f32x4 v[4], yv[4];
#pragma unroll
            for (int j = 0; j < 4; ++j) v[j] = (f32x4){bflo(xw[i][j].x), bfhi(xw[i][j].x), bflo(xw[i][j].y), bfhi(xw[i][j].y)};
            row_y(yv, Y, SL, row, l4); row_post(v, yv, R);
#pragma unroll
            for (int j = 0; j < 4; ++j) *(f32x4*)(OUT + (size_t)row * D + l4 + 256 * j) = v[j];
        } }
}

__device__ __forceinline__ int crow(int r, int hi) { return (r & 3) + 8 * (r >> 2) + 4 * hi; }
__device__ __forceinline__ unsigned cvtpk(float lo, float hi) { return pk2(lo, hi); }
#define SBAR() __builtin_amdgcn_sched_barrier(0)
__device__ __forceinline__ int vst_row(int k, int NB) { const int kk = (k & ~0xC) | ((k & 4) << 1) | ((k & 8) >> 1); return (kk >> 3) * NB * 512 + (kk & 7) * 64; }
__device__ __forceinline__ int vst(int k, int c, int NB) { return vst_row(k, NB) + (c >> 5) * 512 + (c & 31) * 2; }
__device__ __forceinline__ int v_rd_base(int lane) { return ((lane & 3) << 3) | (((lane >> 2) & 3) << 6) | (((lane >> 4) & 1) << 5) | (((lane >> 5) & 1) << 8); }
template <int OFF> __device__ __forceinline__ s16x4 tr_read(unsigned vb) { s16x4 r; asm volatile("ds_read_b64_tr_b16 %0, %1 offset:%2" : "=&v"(r) : "v"(vb), "i"(OFF) : "memory"); return r; }
#define PKF(L, H) ((bf16x8){L[0], L[1], L[2], L[3], H[0], H[1], H[2], H[3]})
#define PK4(P, BASE, OUT) do { unsigned a0_ = cvtpk(P[BASE + 0], P[BASE + 1]), a1_ = cvtpk(P[BASE + 2], P[BASE + 3]);   \
    unsigned b0_ = cvtpk(P[BASE + 4], P[BASE + 5]), b1_ = cvtpk(P[BASE + 6], P[BASE + 7]);                              \
    auto r0_ = __builtin_amdgcn_permlane32_swap(a0_, b0_, false, false); auto r1_ = __builtin_amdgcn_permlane32_swap(a1_, b1_, false, false); \
    v4u w_ = {r0_[0], r1_[0], r0_[1], r1_[1]}; OUT = __builtin_bit_cast(bf16x8, w_); } while (0)
__device__ __forceinline__ float fexp(float x) { return __builtin_amdgcn_exp2f(x * 1.4426950408889634f); }
__device__ __forceinline__ float logsig(float x) { return fminf(x, 0.f) - 0.6931471805599453f * __builtin_amdgcn_logf(1.0f + __builtin_amdgcn_exp2f(-1.4426950408889634f * fabsf(x))); }

constexpr int SC_T = 0  , SC_TSZ = 32768, SC_QD = 0, SC_KI = 8192, SC_VT = 16384, SC_ST = 65536, SC_BT = 81920  , SC_TOT = 114688, SC_DL = 115200  ;
__device__ __forceinline__ void scan_phase(Frame& F, const Params& P, int li) {
    unsigned char* ws = PWS;
    const bf16* PROJ = (const bf16*)(ws + WS_BIG);
    const float* ROPE = (const float*)(ws + WS_ROPE);
    LAS unsigned char* G = F.lds;
    const unsigned gaddr = (unsigned)(uintptr_t)G;
    const bool isP = F.wave >= 4; const int gw4 = F.wave & 3;
    const int ri = gw4 >> 1, dh = gw4 & 1;
#define SC_BAR() do { asm volatile("s_waitcnt lgkmcnt(0)" ::: "memory"); __builtin_amdgcn_s_barrier(); asm volatile("" ::: "memory"); } while (0)
#define SC_TOK(c, i) (dir == 0 ? 64 * (c) + (i) : L - 1 - (64 * (c) + (i)))
    for (int u0 = F.bid; u0 < 256; u0 += F.G) for (int kk_ = 0; kk_ < (u0 < 128 ? 1 : 2); ++kk_) {
        __syncthreads();
        const bool lat = u0 < 128; const int u = lat ? u0 : 2 * (u0 - 128) + kk_;
        const int sb = u >> 4, hh = (u >> 1) & 7, dir = u & 1;
        const int L = lat ? L_LAT : L_CTX, row0 = lat ? M_CTX + sb * L_LAT : sb * L_CTX, NC = L / 64;
        const bool gla = hh < 4; const int h = hh & 3;
        const int qc = (gla ? PC_QA : PC_QB) + h * 64, kc = (gla ? PC_KA : PC_KB) + h * 64, vc = (gla ? PC_VA : PC_VB) + h * 128, gkc = PC_GK + dir * 16;
        bf16* OUT = (bf16*)(ws + (dir == 0 ? WS_Y : WS_HB));
        const float* rdec_p = PIN(I_RDEC); const float* wgk2_p = PIN(I_WGK2); const float* bgk2_p = PIN(I_BGK2);
        const float lgr = gla ? 0.f : -fexp(rdec_p[(li * 2 + dir) * 4 + h]);
        f32x16 sacc[2]; sacc[0] = f32x16{}; sacc[1] = f32x16{}; v4u w2f = {0u, 0u, 0u, 0u}; float gbias = 0.f;
        { int t0_ = F.tid; asm volatile("" : "+v"(t0_)); const int lane = t0_ & 63, r32 = lane & 31, hi = lane >> 5;
          if (isP) {
              if (gla) { const int kcol = h * 64 + 32 * (gw4 & 1) + r32; const float* wp_ = wgk2_p + ((size_t)(li * 2 + dir) * 16 + 8 * hi) * 256 + kcol;
                  w2f = (v4u){pk2(wp_[0], wp_[256]), pk2(wp_[512], wp_[768]), pk2(wp_[1024], wp_[1280]), pk2(wp_[1536], wp_[1792])};
                  gbias = bgk2_p[(li * 2 + dir) * 256 + kcol]; }
              else if (t0_ < 256 + 192) ((LAS float*)(G + SC_DL))[t0_ - 256] = fexp(64.0f * lgr);
          } else {
              const float* S0 = (gla ? PIN(I_SGLA) : PIN(I_SRET)) + ((size_t)((sb * 2 + li) * 2 + dir) * 4 + h) * 8192;
              if (lat) {
#pragma unroll
                  for (int d = 0; d < 2; ++d)
#pragma unroll
                      for (int r = 0; r < 16; ++r) sacc[d][r] = S0[(32 * ri + crow(r, hi)) * 128 + 32 * (2 * dh + d) + r32];
              }
#pragma unroll
              for (int d = 0; d < 2; ++d)
#pragma unroll
                  for (int r = 0; r < 16; r += 2) { const unsigned w = pk2(sacc[d][r], sacc[d][r + 1]);
                      LAS unsigned char* sp_ = G + SC_ST + (hi + 4 * ri) * 2048 + (2 * dh + d) * 512 + r32 * 2 + ((r >> 3) & 1) * 4096 + ((r & 3) + 4 * ((r >> 2) & 1)) * 64;
                      *(LAS unsigned short*)sp_ = (unsigned short)w; *(LAS unsigned short*)(sp_ + 64) = (unsigned short)(w >> 16); }
          } }
        v4u pq0 = {}, pq1 = {}, pk0 = {}, pk1 = {}, pv[4] = {}; v4u pga = {0u, 0u, 0u, 0u}; float cs[16] = {}; float tsum = 0.f;
#define SC_LOADRAW(c) do { const unsigned ro_ = (unsigned)(row0 + SC_TOK(c, sti)) * (unsigned)(EVEN_NP * 2); const char* pc_ = (const char*)PROJ; \
        pq0 = *(const v4u*)(pc_ + (ro_ + (unsigned)(qc + 8 * c8) * 2u)); pq1 = *(const v4u*)(pc_ + (ro_ + (unsigned)(qc + 32 + 8 * c8) * 2u)); \
        pk0 = *(const v4u*)(pc_ + (ro_ + (unsigned)(kc + 8 * c8) * 2u)); pk1 = *(const v4u*)(pc_ + (ro_ + (unsigned)(kc + 32 + 8 * c8) * 2u)); \
        _Pragma("unroll") for (int m_ = 0; m_ < 4; ++m_) pv[m_] = *(const v4u*)(pc_ + (ro_ + (unsigned)(vc + c8 * 32 + 8 * m_) * 2u)); } while (0)
#define SC_LOADGK(c) do { const char* gp_ = (const char*)PROJ + ((unsigned)(row0 + SC_TOK(c, 32 * (gw4 >> 1) + r32)) * (unsigned)(EVEN_NP * 2) + (unsigned)(gkc + 8 * hi) * 2u); \
        pga = *(const v4u*)gp_; \
        if (row0 >= 16384) { const v4u p1_ = *(const v4u*)(gp_ + 64), p2_ = *(const v4u*)(gp_ + 128), p3_ = *(const v4u*)(gp_ + 192); \
            _Pragma("unroll") for (int e_ = 0; e_ < 4; ++e_) pga[e_] = pk2((bflo(pga[e_]) + bflo(p1_[e_])) + (bflo(p2_[e_]) + bflo(p3_[e_])), (bfhi(pga[e_]) + bfhi(p1_[e_])) + (bfhi(p2_[e_]) + bfhi(p3_[e_]))); } } while (0)
        if (isP && gla) { int t0_ = F.tid; asm volatile("" : "+v"(t0_)); const int r32 = t0_ & 31, hi = (t0_ >> 5) & 1; SC_LOADGK(0); }
        for (int s = -3; s < NC; ++s) {
            int tid_o = F.tid; asm volatile("" : "+v"(tid_o));
            const int lane = tid_o & 63, r32 = lane & 31, hi = lane >> 5, tgp = tid_o & 255, sti = tgp >> 2, c8 = tgp & 3;
            if (isP) {
                if (gla && s + 2 >= 0 && s + 2 < NC) {
                    const int th = gw4 >> 1, kq = 32 * (gw4 & 1) + r32; LAS float* BTw = (LAS float*)(G + SC_BT + ((s + 2) & 1) * 16384);
                    const float t0v = ((LAS float*)(G + SC_TOT))[kq]; const float pre = th ? t0v : 0.f;
#pragma unroll
                    for (int r = 0; r < 16; ++r) BTw[(32 * th + crow(r, hi)) * 64 + kq] = pre + cs[r];
                    if (th == 1 && hi == 0) ((LAS float*)(G + SC_DL))[((s + 2) % 3) * 64 + kq] = fexp(pre + tsum);
                }
                if (s + 1 >= 0 && s + 1 < NC) {
                    LAS unsigned char* T = G + SC_T + ((s + 1) & 1) * SC_TSZ;
                    float q[16], kk[16];
#define UNPK(dst, o, W_) do { const v4u w_ = (W_); dst[o + 0] = bflo(w_[0]); dst[o + 1] = bfhi(w_[0]); dst[o + 2] = bflo(w_[1]); dst[o + 3] = bfhi(w_[1]); dst[o + 4] = bflo(w_[2]); dst[o + 5] = bfhi(w_[2]); dst[o + 6] = bflo(w_[3]); dst[o + 7] = bfhi(w_[3]); } while (0)
                    UNPK(q, 0, pq0); UNPK(q, 8, pq1); UNPK(kk, 0, pk0); UNPK(kk, 8, pk1);
                    if (gla) {
                        const LAS float* BTr = (const LAS float*)(G + SC_BT + ((s + 1) & 1) * 16384) + sti * 64 + 8 * c8;
                        const f32x4 x0 = *(const LAS f32x4*)BTr, x1 = *(const LAS f32x4*)(BTr + 4), x2 = *(const LAS f32x4*)(BTr + 32), x3 = *(const LAS f32x4*)(BTr + 36);
#pragma unroll
                        for (int e = 0; e < 4; ++e) { const float e0 = fexp(x0[e]), e1 = fexp(x1[e]), e2 = fexp(x2[e]), e3 = fexp(x3[e]);
                            q[e] *= 0.125f * e0; kk[e] *= __builtin_amdgcn_rcpf(e0); q[4 + e] *= 0.125f * e1; kk[4 + e] *= __builtin_amdgcn_rcpf(e1);
                            q[8 + e] *= 0.125f * e2; kk[8 + e] *= __builtin_amdgcn_rcpf(e2); q[12 + e] *= 0.125f * e3; kk[12 + e] *= __builtin_amdgcn_rcpf(e3); }
                    } else {
                        if (lat) {
                            const float* cp = ROPE + (size_t)SC_TOK(s + 1, sti) * 32 + 8 * c8; const f32x4 c0 = *(const f32x4*)cp, c1 = *(const f32x4*)(cp + 4), s0 = *(const f32x4*)(cp + 65536), s1 = *(const f32x4*)(cp + 65540);
#pragma unroll
                            for (int e = 0; e < 8; ++e) { const float c = e < 4 ? c0[e & 3] : c1[e & 3], sn = e < 4 ? s0[e & 3] : s1[e & 3];
                                const float q1 = q[e], q2 = q[8 + e]; q[e] = q1 * c - q2 * sn; q[8 + e] = q1 * sn + q2 * c;
                                const float k1 = kk[e], k2 = kk[8 + e]; kk[e] = k1 * c - k2 * sn; kk[8 + e] = k1 * sn + k2 * c; }
                        }
                        const float bb = (float)(sti + 1) * lgr, eb = fexp(bb), ek = 0.125f * __builtin_amdgcn_rcpf(eb);
#pragma unroll
                        for (int e = 0; e < 16; ++e) { q[e] *= eb; kk[e] *= ek; }
                    }
                    *(LAS v4u*)(T + SC_QD + vst(sti, 8 * c8, 2)) = (v4u){pk2(q[0], q[1]), pk2(q[2], q[3]), pk2(q[4], q[5]), pk2(q[6], q[7])};
                    *(LAS v4u*)(T + SC_QD + vst(sti, 32 + 8 * c8, 2)) = (v4u){pk2(q[8], q[9]), pk2(q[10], q[11]), pk2(q[12], q[13]), pk2(q[14], q[15])};
                    *(LAS v4u*)(T + SC_KI + vst(sti, 8 * c8, 2)) = (v4u){pk2(kk[0], kk[1]), pk2(kk[2], kk[3]), pk2(kk[4], kk[5]), pk2(kk[6], kk[7])};
                    *(LAS v4u*)(T + SC_KI + vst(sti, 32 + 8 * c8, 2)) = (v4u){pk2(kk[8], kk[9]), pk2(kk[10], kk[11]), pk2(kk[12], kk[13]), pk2(kk[14], kk[15])};
#pragma unroll
                    for (int m = 0; m < 4; ++m) *(LAS v4u*)(T + SC_VT + vst(sti, c8 * 32 + 8 * m, 4)) = pv[m];
                }
                if (s + 2 >= 0 && s + 2 < NC) SC_LOADRAW(s + 2);
            } else if (s >= 0) {
                LAS unsigned char* T = G + SC_T + (s & 1) * SC_TSZ; const unsigned taddr = gaddr + SC_T + (s & 1) * SC_TSZ;
                bf16x8 qf[4]; bf16x8 pa0, pa1, pa2, pa3;
                { const int qb_ = vst_row(32 * ri + r32, 2) + 16 * hi;
                  qf[0] = *(const LAS bf16x8*)(T + SC_QD + qb_); qf[1] = *(const LAS bf16x8*)(T + SC_QD + qb_ + 32); qf[2] = *(const LAS bf16x8*)(T + SC_QD + qb_ + 512); qf[3] = *(const LAS bf16x8*)(T + SC_QD + qb_ + 544); }
                { f32x16 p0 = {}, p1 = {};
                  const int kb0 = vst_row(r32, 2) + 16 * hi, kb1 = vst_row(32 + r32, 2) + 16 * hi;
                  { const bf16x8 a0 = *(const LAS bf16x8*)(T + SC_KI + kb0), a1 = *(const LAS bf16x8*)(T + SC_KI + kb0 + 32), a2 = *(const LAS bf16x8*)(T + SC_KI + kb0 + 512), a3 = *(const LAS bf16x8*)(T + SC_KI + kb0 + 544);
                    p0 = __builtin_amdgcn_mfma_f32_32x32x16_bf16(a0, qf[0], p0, 0, 0, 0); p0 = __builtin_amdgcn_mfma_f32_32x32x16_bf16(a1, qf[1], p0, 0, 0, 0);
                    p0 = __builtin_amdgcn_mfma_f32_32x32x16_bf16(a2, qf[2], p0, 0, 0, 0); p0 = __builtin_amdgcn_mfma_f32_32x32x16_bf16(a3, qf[3], p0, 0, 0, 0); }
                  if (ri == 1) {
                      const bf16x8 c0 = *(const LAS bf16x8*)(T + SC_KI + kb1), c1 = *(const LAS bf16x8*)(T + SC_KI + kb1 + 32), c2 = *(const LAS bf16x8*)(T + SC_KI + kb1 + 512), c3 = *(const LAS bf16x8*)(T + SC_KI + kb1 + 544);
                      p1 = __builtin_amdgcn_mfma_f32_32x32x16_bf16(c0, qf[0], p1, 0, 0, 0); p1 = __builtin_amdgcn_mfma_f32_32x32x16_bf16(c1, qf[1], p1, 0, 0, 0);
                      p1 = __builtin_amdgcn_mfma_f32_32x32x16_bf16(c2, qf[2], p1, 0, 0, 0); p1 = __builtin_amdgcn_mfma_f32_32x32x16_bf16(c3, qf[3], p1, 0, 0, 0); }
#pragma unroll
                  for (int r = 0; r < 16; ++r) { const bool keep = crow(r, hi) <= r32; if (ri == 0) { p0[r] = keep ? p0[r] : 0.f; } else { p1[r] = keep ? p1[r] : 0.f; } }
                  PK4(p0, 0, pa0); PK4(p0, 8, pa1); PK4(p1, 0, pa2); PK4(p1, 8, pa3); }
                const unsigned vb = taddr + SC_VT + v_rd_base(lane) + dh * 1024, sbv = gaddr + SC_ST + v_rd_base(lane) + dh * 1024;
#define SC_RD8(raw, base, d) do { raw[0] = tr_read<(d) * 512>(base); raw[1] = tr_read<(d) * 512 + 2048>(base); raw[2] = tr_read<(d) * 512 + 4096>(base); raw[3] = tr_read<(d) * 512 + 4096 + 2048>(base); \
                  raw[4] = tr_read<(d) * 512 + 8192>(base); raw[5] = tr_read<(d) * 512 + 8192 + 2048>(base); raw[6] = tr_read<(d) * 512 + 12288>(base); raw[7] = tr_read<(d) * 512 + 12288 + 2048>(base); } while (0)
#define SC_LWAIT() do { asm volatile("s_waitcnt lgkmcnt(0)" ::: "memory"); SBAR(); } while (0)
#define SC_OBLK(d, rv, rs) do { f32x16 o_ = {}; \
                  o_ = __builtin_amdgcn_mfma_f32_32x32x16_bf16(pa0, PKF(rv[0], rv[1]), o_, 0, 0, 0); o_ = __builtin_amdgcn_mfma_f32_32x32x16_bf16(pa1, PKF(rv[2], rv[3]), o_, 0, 0, 0); \
                  if (ri == 1) { o_ = __builtin_amdgcn_mfma_f32_32x32x16_bf16(pa2, PKF(rv[4], rv[5]), o_, 0, 0, 0); o_ = __builtin_amdgcn_mfma_f32_32x32x16_bf16(pa3, PKF(rv[6], rv[7]), o_, 0, 0, 0); } \
                  o_ = __builtin_amdgcn_mfma_f32_32x32x16_bf16(qf[0], PKF(rs[0], rs[1]), o_, 0, 0, 0); o_ = __builtin_amdgcn_mfma_f32_32x32x16_bf16(qf[1], PKF(rs[2], rs[3]), o_, 0, 0, 0); \
                  o_ = __builtin_amdgcn_mfma_f32_32x32x16_bf16(qf[2], PKF(rs[4], rs[5]), o_, 0, 0, 0); o_ = __builtin_amdgcn_mfma_f32_32x32x16_bf16(qf[3], PKF(rs[6], rs[7]), o_, 0, 0, 0); \
                  char* dst_ = (char*)OUT; \
                  _Pragma("unroll") for (int r = 0; r < 16; r += 2) { const int i_ = 32 * ri + crow(r, hi); const int t_ = SC_TOK(s, i_); const unsigned w_ = pk2(o_[r], o_[r + 1]); \
                      const unsigned a_ = (unsigned)(row0 + t_) * (unsigned)(D * 2) + (unsigned)(hh * 128 + 64 * dh + 32 * (d) + r32) * 2u; \
                      *(bf16*)(dst_ + a_) = (bf16)w_; *(bf16*)(dst_ + (dir == 0 ? a_ + (unsigned)(D * 2) : a_ - (unsigned)(D * 2))) = (bf16)(w_ >> 16); } SBAR(); } while (0)
                { s16x4 rv0[8], rs0[8], rv1[8], rs1[8];
                  SC_RD8(rv0, vb, 0); SC_RD8(rs0, sbv, 0); SC_LWAIT();
                  SC_RD8(rv1, vb, 1); SC_RD8(rs1, sbv, 1);
                  SC_OBLK(0, rv0, rs0); SC_LWAIT();
                  SC_OBLK(1, rv1, rs1); }
            }
            SC_BAR();
            if (isP) {
                if (gla && s + 3 < NC) {
                    const int th = gw4 >> 1, kq = 32 * (gw4 & 1) + r32;
                    f32x16 gp;
#pragma unroll
                    for (int r = 0; r < 16; ++r) gp[r] = gbias;
                    gp = __builtin_amdgcn_mfma_f32_32x32x16_bf16(__builtin_bit_cast(bf16x8, pga), __builtin_bit_cast(bf16x8, w2f), gp, 0, 0, 0);
                    float g4[4], o4[4];
#pragma unroll
                    for (int j = 0; j < 4; ++j) { float run = 0.f;
#pragma unroll
                        for (int e = 0; e < 4; ++e) { run += logsig(gp[4 * j + e]) * (1.0f / 16.0f); cs[4 * j + e] = run; }
                        g4[j] = run; }
#pragma unroll
                    for (int j = 0; j < 4; ++j) o4[j] = __shfl_xor(g4[j], 32);
                    float acc_ = 0.f;
#pragma unroll
                    for (int j = 0; j < 4; ++j) { const float off = acc_ + (hi ? o4[j] : 0.f);
#pragma unroll
                        for (int e = 0; e < 4; ++e) cs[4 * j + e] += off;
                        acc_ += g4[j] + o4[j]; }
                    tsum = acc_;
                    if (hi == 0) ((LAS float*)(G + SC_TOT))[th * 64 + kq] = tsum;
                    if (s + 4 < NC) SC_LOADGK(s + 4);
                }
            } else if (s >= 0) {
                const unsigned taddr = gaddr + SC_T + (s & 1) * SC_TSZ;
                const unsigned vb = taddr + SC_VT + v_rd_base(lane) + dh * 1024, kt = taddr + SC_KI + v_rd_base(lane) + ri * 512;
                s16x4 rk[8], rv0[8], rv1[8];
                rk[0] = tr_read<0>(kt); rk[1] = tr_read<1024>(kt); rk[2] = tr_read<2048>(kt); rk[3] = tr_read<2048 + 1024>(kt); rk[4] = tr_read<4096>(kt); rk[5] = tr_read<4096 + 1024>(kt); rk[6] = tr_read<6144>(kt); rk[7] = tr_read<6144 + 1024>(kt);
                SC_RD8(rv0, vb, 0); SC_LWAIT();
                SC_RD8(rv1, vb, 1);
                bf16x8 kf[4]; kf[0] = PKF(rk[0], rk[1]); kf[1] = PKF(rk[2], rk[3]); kf[2] = PKF(rk[4], rk[5]); kf[3] = PKF(rk[6], rk[7]);
                const int stb_ = (hi + 4 * ri) * 2048 + (2 * dh) * 512 + r32 * 2;
                const LAS float* DLr = (const LAS float*)(G + SC_DL) + (s % 3) * 64;
#define SC_SBLK(d, rv) do { \
                  sacc[d] = __builtin_amdgcn_mfma_f32_32x32x16_bf16(kf[0], PKF(rv[0], rv[1]), sacc[d], 0, 0, 0); sacc[d] = __builtin_amdgcn_mfma_f32_32x32x16_bf16(kf[1], PKF(rv[2], rv[3]), sacc[d], 0, 0, 0); \
                  sacc[d] = __builtin_amdgcn_mfma_f32_32x32x16_bf16(kf[2], PKF(rv[4], rv[5]), sacc[d], 0, 0, 0); sacc[d] = __builtin_amdgcn_mfma_f32_32x32x16_bf16(kf[3], PKF(rv[6], rv[7]), sacc[d], 0, 0, 0); \
                  _Pragma("unroll") for (int r = 0; r < 16; r += 2) { const int dk = 32 * ri + crow(r, hi); const float dl0 = DLr[dk], dl1 = DLr[dk + 1]; \
                      sacc[d][r] *= dl0; sacc[d][r + 1] *= dl1; const unsigned w_ = pk2(sacc[d][r], sacc[d][r + 1]); \
                      LAS unsigned char* sp_ = G + SC_ST + stb_ + (d) * 512 + ((r >> 3) & 1) * 4096 + ((r & 3) + 4 * ((r >> 2) & 1)) * 64; \
                      *(LAS unsigned short*)sp_ = (unsigned short)w_; *(LAS unsigned short*)(sp_ + 64) = (unsigned short)(w_ >> 16); } SBAR(); } while (0)
                SC_SBLK(0, rv0); SC_LWAIT();
                SC_SBLK(1, rv1);
            }
            SC_BAR();
        }
        if (!lat && !isP) { int l2 = F.lane; asm volatile("" : "+v"(l2)); const int r32 = l2 & 31, hi = l2 >> 5; float* SO = POUT + (gla ? OUT_SGLA : OUT_SRET) + ((size_t)((sb * 2 + li) * 2 + dir) * 4 + h) * 8192;
#pragma unroll
            for (int d = 0; d < 2; ++d)
#pragma unroll
                for (int r = 0; r < 16; ++r) SO[(32 * ri + crow(r, hi)) * 128 + 32 * (2 * dh + d) + r32] = sacc[d][r]; }
    }
#undef SC_TOK
#undef SC_BAR
#undef SC_LOADRAW
#undef SC_LOADGK
#undef UNPK
#undef SC_RD8
#undef SC_LWAIT
#undef SC_OBLK
#undef SC_SBLK
    if (F.G == 256 && F.bid >= 128) { if (li == 0) setup_work(F, P, F.bid - 128, 128, 0x2, 0x2, 0x0, 0x0, 0x1); else setup_work(F, P, F.bid - 128, 128, 0x8, 0x8, 0x0, 0x0, 0x2); }
    else if (F.G != 256) { if (li == 0) setup_work(F, P, F.bid, F.G, 0x2, 0x2, 0x0, 0x0, 0x1); else setup_work(F, P, F.bid, F.G, 0x8, 0x8, 0x0, 0x0, 0x2); }
}
__device__ __forceinline__ void scan_combine(Frame& F, const Params& P, int li) {
    unsigned char* ws = PWS;
    const char* PROJ = (const char*)(ws + WS_BIG); const char* OF = (const char*)(ws + WS_Y); char* OB = (char*)(ws + WS_HB);
    const int gw = F.vcu * NWAVES + F.wave, NGW = F.G * NWAVES, lane = F.lane, hh = lane >> 3, dv = (lane & 7) * 16;
    f32x4 gn[4];
    { const float* gp_ = PIN(I_GLAN) + li * 128 + dv;
#pragma unroll
      for (int j = 0; j < 4; ++j) gn[j] = hh < 4 ? *(const f32x4*)(gp_ + 4 * j) : (f32x4){1.f, 1.f, 1.f, 1.f}; }
    const unsigned gcol = (unsigned)((hh < 4 ? PC_GA : PC_GB) + (hh & 3) * 128 + dv) * 2u, ocol = (unsigned)(hh * 128 + dv) * 2u;
#define CB_LOAD(S, r_) do { const unsigned off = (unsigned)(r_) * (unsigned)(D * 2) + ocol, goff = (unsigned)(r_) * (unsigned)(EVEN_NP * 2) + gcol; \
        S[0] = __builtin_nontemporal_load((const v4u*)(OF + off)); S[1] = __builtin_nontemporal_load((const v4u*)(OF + off + 16)); S[2] = __builtin_nontemporal_load((const v4u*)(OB + off)); S[3] = __builtin_nontemporal_load((const v4u*)(OB + off + 16)); \
        S[4] = __builtin_nontemporal_load((const v4u*)(PROJ + goff)); S[5] = __builtin_nontemporal_load((const v4u*)(PROJ + goff + 16)); } while (0)
#define CB_PROC(S, r_) do { const unsigned off = (unsigned)(r_) * (unsigned)(D * 2) + ocol; float x[16], gg[16]; \
        _Pragma("unroll") for (int hf = 0; hf < 2; ++hf) _Pragma("unroll") for (int e = 0; e < 4; ++e) { x[8 * hf + 2 * e] = bflo(S[hf][e]) + bflo(S[2 + hf][e]); x[8 * hf + 2 * e + 1] = bfhi(S[hf][e]) + bfhi(S[2 + hf][e]); \
            gg[8 * hf + 2 * e] = bflo(S[4 + hf][e]); gg[8 * hf + 2 * e + 1] = bfhi(S[4 + hf][e]); } \
        float ss = 0.f; _Pragma("unroll") for (int e = 0; e < 16; ++e) ss += x[e] * x[e]; \
        ss += __shfl_xor(ss, 1); ss += __shfl_xor(ss, 2); ss += __shfl_xor(ss, 4); \
        const float rstd = __builtin_amdgcn_rsqf(ss * (1.0f / 128.0f) + EPS); \
        _Pragma("unroll") for (int e = 0; e < 16; ++e) x[e] = x[e] * rstd * gn[e >> 2][e & 3] * siluf(gg[e]); \
        *(v4u*)(OB + off) = (v4u){pk2(x[0], x[1]), pk2(x[2], x[3]), pk2(x[4], x[5]), pk2(x[6], x[7])}; \
        *(v4u*)(OB + off + 16) = (v4u){pk2(x[8], x[9]), pk2(x[10], x[11]), pk2(x[12], x[13]), pk2(x[14], x[15])}; } while (0)
    if (NGW * 10 == M) {
        v4u A0[6], A1[6], B0[6], B1[6];
        CB_LOAD(A0, gw); CB_LOAD(A1, gw + NGW);
#pragma unroll
        for (int k = 0; k < 10; k += 4) {
            if (k + 2 < 10) { CB_LOAD(B0, gw + (k + 2) * NGW); CB_LOAD(B1, gw + (k + 3) * NGW); }
            CB_PROC(A0, gw + k * NGW); CB_PROC(A1, gw + (k + 1) * NGW);
            if (k + 4 < 10) { CB_LOAD(A0, gw + (k + 4) * NGW); CB_LOAD(A1, gw + (k + 5) * NGW); }
            if (k + 2 < 10) { CB_PROC(B0, gw + (k + 2) * NGW); CB_PROC(B1, gw + (k + 3) * NGW); }
        }
    } else {
        for (int row = gw; row < M; row += NGW) { v4u A0[6]; CB_LOAD(A0, row); CB_PROC(A0, row); }
    }
#undef CB_LOAD
#undef CB_PROC
}

__device__ __forceinline__ void cache_pass(Frame& F, const Params& P, int li, int wgi, int nwg) {
    unsigned char* ws = PWS;
    const int gt = wgi * 512 + F.tid, NGT = nwg * 512;
    const float* cckv_ = PIN(I_CCKV); const float* ckpe_ = PIN(I_CKPE);
    for (int i = gt; i < 8 * 256 * 32; i += NGT) { const int c8 = i & 31, t = (i >> 5) & 255, b = i >> 13;
        const float* s = cckv_ + ((size_t)((b * 2 + li) * 256 + t) * 32 + c8) * 8; const f32x4 a = *(const f32x4*)s, c = *(const f32x4*)(s + 4);
        *(GAS v4u*)((bf16*)(ws + WS_ACKV) + ((size_t)4096 + b * LKV + t) * 256 + c8 * 8) = (v4u){pk2(a[0], a[1]), pk2(a[2], a[3]), pk2(c[0], c[1]), pk2(c[2], c[3])}; }
    for (int i = gt; i < 8 * 256 * 8; i += NGT) { const int c8 = i & 7, t = (i >> 3) & 255, b = i >> 11;
        const float* s = ckpe_ + ((size_t)((b * 2 + li) * 256 + t) * 8 + c8) * 8; const f32x4 a = *(const f32x4*)s, c = *(const f32x4*)(s + 4);
        *(GAS v4u*)((bf16*)(ws + WS_KPE) + ((size_t)4096 + b * LKV + t) * 64 + c8 * 8) = (v4u){pk2(a[0], a[1]), pk2(a[2], a[3]), pk2(c[0], c[1]), pk2(c[2], c[3])}; }
}
__device__ __forceinline__ void kpe_pass(Frame& F, const Params& P, int li, int wgi, int nwg) {
    unsigned char* ws = PWS;
    const float* KR = (const float*)(ws + WS_Y); const float* ROPE = (const float*)(ws + WS_ROPE);
    bf16* KPE = (bf16*)(ws + WS_KPE);
    const int gt = wgi * 512 + F.tid, NGT = nwg * 512;
    for (int i = gt; i < M * 4; i += NGT) {
        const int row = i >> 2, c8 = i & 3;
        const float* s = KR + (size_t)row * 64 + 8 * c8;
        f32x4 a0 = *(const f32x4*)s, a1 = *(const f32x4*)(s + 4), b0 = *(const f32x4*)(s + 32), b1 = *(const f32x4*)(s + 36);
        int drow = row;
        if (row >= M_CTX) { const int lb = (row - M_CTX) >> 11, t = (row - M_CTX) & 2047; drow = M_CTX + lb * LKV + PAST + t;
            const float* cp = ROPE + (size_t)t * 32 + 8 * c8; const float* sp = cp + 65536;
            const f32x4 c0 = *(const f32x4*)cp, c1 = *(const f32x4*)(cp + 4), s0 = *(const f32x4*)sp, s1 = *(const f32x4*)(sp + 4);
            const f32x4 x0 = a0 * c0 - b0 * s0, x1 = a1 * c1 - b1 * s1, y0 = a0 * s0 + b0 * c0, y1 = a1 * s1 + b1 * c1;
            a0 = x0; a1 = x1; b0 = y0; b1 = y1; }
        bf16* d = KPE + (size_t)drow * 64 + 8 * c8;
        *(v4u*)d = (v4u){pk2(a0[0], a0[1]), pk2(a0[2], a0[3]), pk2(a1[0], a1[1]), pk2(a1[2], a1[3])};
        *(v4u*)(d + 32) = (v4u){pk2(b0[0], b0[1]), pk2(b0[2], b0[3]), pk2(b1[0], b1[1]), pk2(b1[2], b1[3])};
    }
}

constexpr float ATT_SCALE = 0.07216878364870322f;
constexpr float ATT_THR = 8.f;
constexpr int AT_V = 0, AT_KN = 49152, AT_KP = 98304, AT_WS = 122880, AT_VB = 16384, AT_KNB = 16384, AT_KPB = 8192;
#define KSWZ(row, colB) ((row) * 256 + ((colB) ^ (((row) & 7) << 4)))
#define KPSWZ(row, colB) ((row) * 128 + ((colB) ^ (((row) & 7) << 4)))
__device__ __forceinline__ void at_partialSM(f32x16& p0, f32x16& p1, float& m_reg, float& mn, float& alpha) {
    constexpr float C = ATT_SCALE * 1.4426950408889634f;
    float pmax = p0[0];
#pragma unroll
    for (int r = 1; r < 16; ++r) pmax = fmaxf(pmax, p0[r]);
#pragma unroll
    for (int r = 0; r < 16; ++r) pmax = fmaxf(pmax, p1[r]);
    { auto rr = __builtin_amdgcn_permlane32_swap(__float_as_uint(pmax), __float_as_uint(pmax), false, false); pmax = fmaxf(__uint_as_float(rr[0]), __uint_as_float(rr[1])); }
    if (__builtin_expect(__all(pmax - m_reg <= ATT_THR / ATT_SCALE), 1)) { mn = m_reg; alpha = 1.f; }
    else { mn = fmaxf(m_reg, pmax); alpha = __builtin_amdgcn_exp2f((m_reg - mn) * C); m_reg = mn; }
    const float mnC = -mn * C;
#pragma unroll
    for (int r = 0; r < 16; ++r) p0[r] = fmaf(p0[r], C, mnC);
#pragma unroll
    for (int r = 0; r < 16; ++r) p1[r] = fmaf(p1[r], C, mnC);
#pragma unroll
    for (int r = 0; r < 16; ++r) p0[r] = __builtin_amdgcn_exp2f(p0[r]);
}
__device__ __forceinline__ void at_finishSM(f32x16& p0, f32x16& p1, float alpha, float& l_reg, bf16x8& pa0, bf16x8& pa1, bf16x8& pa2, bf16x8& pa3) {
#pragma unroll
    for (int r = 0; r < 16; ++r) p1[r] = __builtin_amdgcn_exp2f(p1[r]);
    float ps = 0;
#pragma unroll
    for (int r = 0; r < 16; ++r) ps += p0[r];
#pragma unroll
    for (int r = 0; r < 16; ++r) ps += p1[r];
    { auto rr = __builtin_amdgcn_permlane32_swap(__float_as_uint(ps), __float_as_uint(ps), false, false); ps = __uint_as_float(rr[0]) + __uint_as_float(rr[1]); }
    l_reg = l_reg * alpha + ps;
    PK4(p0, 0, pa0); PK4(p0, 8, pa1); PK4(p1, 0, pa2); PK4(p1, 8, pa3);
}
__device__ __forceinline__ void at_qkt(f32x16& p0, f32x16& p1, const LAS unsigned char* Kn, const LAS unsigned char* Kp, const bf16x8* qr, const int* kb, const int* pb) {
    p0 = f32x16{}; p1 = f32x16{};
#pragma unroll
    for (int d0 = 0; d0 < 8; ++d0) {
        const bf16x8 b0 = *(const LAS bf16x8*)(Kn + kb[d0 & 3] + 128 * (d0 >> 2)), b1 = *(const LAS bf16x8*)(Kn + kb[d0 & 3] + 128 * (d0 >> 2) + 8192);
        p0 = __builtin_amdgcn_mfma_f32_32x32x16_bf16(b0, qr[d0], p0, 0, 0, 0);
        p1 = __builtin_amdgcn_mfma_f32_32x32x16_bf16(b1, qr[d0], p1, 0, 0, 0); }
#pragma unroll
    for (int d0 = 0; d0 < 4; ++d0) {
        const bf16x8 b0 = *(const LAS bf16x8*)(Kp + pb[d0]), b1 = *(const LAS bf16x8*)(Kp + pb[d0] + 4096);
        p0 = __builtin_amdgcn_mfma_f32_32x32x16_bf16(b0, qr[8 + d0], p0, 0, 0, 0);
        p1 = __builtin_amdgcn_mfma_f32_32x32x16_bf16(b1, qr[8 + d0], p1, 0, 0, 0); }
}
template <int D0> __device__ __forceinline__ void at_pv_one(f32x16& od, unsigned vb, bf16x8 pa0, bf16x8 pa1, bf16x8 pa2, bf16x8 pa3) {
    const s16x4 l0 = tr_read<D0 * 512>(vb), h0 = tr_read<D0 * 512 + 2048>(vb), l1 = tr_read<D0 * 512 + 4096>(vb), h1 = tr_read<D0 * 512 + 4096 + 2048>(vb);
    const s16x4 l2 = tr_read<D0 * 512 + 8192>(vb), h2 = tr_read<D0 * 512 + 8192 + 2048>(vb), l3 = tr_read<D0 * 512 + 12288>(vb), h3 = tr_read<D0 * 512 + 12288 + 2048>(vb);
    asm volatile("s_waitcnt lgkmcnt(0)" ::: "memory"); SBAR();
    od = __builtin_amdgcn_mfma_f32_32x32x16_bf16(pa0, PKF(l0, h0), od, 0, 0, 0);
    od = __builtin_amdgcn_mfma_f32_32x32x16_bf16(pa1, PKF(l1, h1), od, 0, 0, 0);
    od = __builtin_amdgcn_mfma_f32_32x32x16_bf16(pa2, PKF(l2, h2), od, 0, 0, 0);
    od = __builtin_amdgcn_mfma_f32_32x32x16_bf16(pa3, PKF(l3, h3), od, 0, 0, 0);
}
__device__ __forceinline__ void at_pv(f32x16* o, unsigned vb, bf16x8 pa0, bf16x8 pa1, bf16x8 pa2, bf16x8 pa3) {
    at_pv_one<0>(o[0], vb, pa0, pa1, pa2, pa3); at_pv_one<1>(o[1], vb, pa0, pa1, pa2, pa3); at_pv_one<2>(o[2], vb, pa0, pa1, pa2, pa3); at_pv_one<3>(o[3], vb, pa0, pa1, pa2, pa3);
}
__device__ __forceinline__ void attn_unit(Frame& F, const bf16* Qrow0  , const bf16* KVh  , const bf16* KPEs  ,
                                          bf16* Orow0, int nkeys, const float* ROPE, int tpos0  ) {
    LAS unsigned char* lds = F.lds;
    const int tid = F.tid, wid = F.wave, lane = F.lane, r32 = lane & 31, hi = lane >> 5;
    LAS float* wsf = (LAS float*)(lds + AT_WS) + wid * 64; LAS float* li_l = wsf; LAS float* al_l = wsf + 32;
    float m_reg = -1e30f, l_reg = 0; f32x16 o[4] = {}; bf16x8 qr[12];
    { const bf16* Qw = Qrow0 + (size_t)(wid * 32 + r32) * 1536 + hi * 8;
#pragma unroll
      for (int d0 = 0; d0 < 12; ++d0) qr[d0] = *(const bf16x8*)(Qw + d0 * 16);
      if (tpos0 >= 0) {
          const int t = tpos0 + wid * 32 + r32;
#pragma unroll
          for (int half = 0; half < 2; ++half) {
              const float* cp = ROPE + (size_t)t * 32 + 16 * half + 8 * hi; const float* sp = cp + 65536;
              const v4u xa = __builtin_bit_cast(v4u, qr[8 + half]), xb = __builtin_bit_cast(v4u, qr[10 + half]);
              float x1[8], x2[8];
              x1[0] = bflo(xa.x); x1[1] = bfhi(xa.x); x1[2] = bflo(xa.y); x1[3] = bfhi(xa.y); x1[4] = bflo(xa.z); x1[5] = bfhi(xa.z); x1[6] = bflo(xa.w); x1[7] = bfhi(xa.w);
              x2[0] = bflo(xb.x); x2[1] = bfhi(xb.x); x2[2] = bflo(xb.y); x2[3] = bfhi(xb.y); x2[4] = bflo(xb.z); x2[5] = bfhi(xb.z); x2[6] = bflo(xb.w); x2[7] = bfhi(xb.w);
              float y1[8], y2[8];
#pragma unroll
              for (int j = 0; j < 8; ++j) { const float c = cp[j], s = sp[j]; y1[j] = x1[j] * c - x2[j] * s; y2[j] = x1[j] * s + x2[j] * c; }
              const v4u wa = {pk2(y1[0], y1[1]), pk2(y1[2], y1[3]), pk2(y1[4], y1[5]), pk2(y1[6], y1[7])}, wb = {pk2(y2[0], y2[1]), pk2(y2[2], y2[3]), pk2(y2[4], y2[5]), pk2(y2[6], y2[7])};
              if (half == 0) { qr[8] = __builtin_bit_cast(bf16x8, wa); qr[10] = __builtin_bit_cast(bf16x8, wb); } else { qr[9] = __builtin_bit_cast(bf16x8, wa); qr[11] = __builtin_bit_cast(bf16x8, wb); }
          }
      } }
    const unsigned vb0 = (unsigned)(uintptr_t)(lds + AT_V) + v_rd_base(lane);
#define AT_OPQ() int l_ = lane; asm volatile("" : "+v"(l_))
#define AT_KADDR() int kbs[4], pbs[4]; { AT_OPQ(); _Pragma("unroll") for (int b = 0; b < 4; ++b) { const int x = (32 * b + 16 * (l_ >> 5)) ^ ((l_ & 7) << 4); kbs[b] = (l_ & 31) * 256 + x; pbs[b] = (l_ & 31) * 128 + x; } }
#define AT_GLDS(gp, ldsoff) __builtin_amdgcn_global_load_lds((const unsigned*)(gp), (LAS unsigned*)(lds + (ldsoff)), 16, 0, 0)
    unsigned okv, okp, ov;
    { const int l_ = lane; const int row0_ = 4 * wid + (l_ >> 4), rowp_ = 8 * wid + (l_ >> 3);
      okv = (unsigned)(row0_ * 4096 + (((l_ & 15) * 16) ^ ((row0_ & 7) << 4))); okp = (unsigned)(rowp_ * 128 + (((l_ & 7) * 16) ^ ((rowp_ & 7) << 4)));
      const int st_ = 2 * wid + (l_ >> 5), kk_ = (st_ >> 2) * 8 + ((l_ & 31) >> 2), key_ = (kk_ & ~0xC) | ((kk_ & 4) << 1) | ((kk_ & 8) >> 1), col_ = (st_ & 3) * 32 + (l_ & 3) * 8;
      ov = (unsigned)(key_ * 4096 + (128 + col_) * 2); }
    const unsigned ldsu = (unsigned)(uintptr_t)lds + (unsigned)wid * 1024u;
#define AT_GLDS_S(voff, base, ldsoff) do { unsigned sv_; asm volatile("s_mov_b32 %0, m0\n\ts_mov_b32 m0, %3\n\ts_nop 0\n\tglobal_load_lds_dwordx4 %1, %2\n\ts_mov_b32 m0, %0" \
        : "=&s"(sv_) : "v"(voff), "s"((const char*)(base)), "s"(ldsu + (unsigned)(ldsoff)) : "memory"); } while (0)
#define AT_DMA_K(t, b) do { const char* kb_ = (const char*)KVh + (size_t)(t) * (64 * 4096); const char* pb_ = (const char*)KPEs + (size_t)(t) * (64 * 128); \
    AT_GLDS_S(okv, kb_, AT_KN + (b) * AT_KNB); AT_GLDS_S(okv, kb_ + 32 * 4096, AT_KN + (b) * AT_KNB + 8 * 1024); AT_GLDS_S(okp, pb_, AT_KP + (b) * AT_KPB); } while (0)
#define AT_DMA_V(t, b) do { const char* vb_ = (const char*)KVh + (size_t)(t) * (64 * 4096); \
    AT_GLDS_S(ov, vb_, AT_V + (b) * AT_VB); AT_GLDS_S(ov, vb_ + 32 * 4096, AT_V + (b) * AT_VB + 8 * 1024); } while (0)
#define AT_RESC(a) do { if (__any((a) < 1.f)) { if (hi == 0) al_l[r32] = (a); asm volatile("s_waitcnt lgkmcnt(0)" ::: "memory"); \
    _Pragma("unroll") for (int d = 0; d < 4; ++d) _Pragma("unroll") for (int r = 0; r < 16; ++r) o[d][r] *= al_l[crow(r, hi)]; } } while (0)
#define AT_WAITBAR(N) do { asm volatile("s_waitcnt vmcnt(" #N ") lgkmcnt(0)" ::: "memory"); __builtin_amdgcn_s_barrier(); asm volatile("" ::: "memory"); } while (0)
    f32x16 pA0, pA1, pB0, pB1; float mnA, mnB, alA, alB; bf16x8 pa0, pa1, pa2, pa3; const int NT = nkeys / 64;
    int kbs[4], pbs[4];
    { const int l_ = lane;
#pragma unroll
      for (int b = 0; b < 4; ++b) { const int x = (32 * b + 16 * (l_ >> 5)) ^ ((l_ & 7) << 4); kbs[b] = (l_ & 31) * 256 + x; pbs[b] = (l_ & 31) * 128 + x; } }
    AT_DMA_K(0, 0); AT_DMA_K(1, 1); AT_DMA_V(0, 0); AT_WAITBAR(0);
    int s = 0;
#define AT_S1 (s == 2 ? 0 : s + 1)
#define AT_S2 (s == 0 ? 2 : s - 1)
#define AT_STEP(CUR0, CUR1, MNC, ALC, PRV0, PRV1, ALP, t, MODE) do { \
        if (MODE == 2) { AT_DMA_K((t) + 2, AT_S2); } if (MODE >= 1) { AT_DMA_V((t) + 1, AT_S1); } \
        SBAR(); { at_qkt(CUR0, CUR1, lds + AT_KN + s * AT_KNB, lds + AT_KP + s * AT_KPB, qr, kbs, pbs); } \
        at_finishSM(PRV0, PRV1, ALP, l_reg, pa0, pa1, pa2, pa3); SBAR(); \
        at_pv(o, vb0 + AT_S2 * AT_VB, pa0, pa1, pa2, pa3); at_partialSM(CUR0, CUR1, m_reg, MNC, ALC); \
        AT_RESC(ALC); if (MODE == 2) AT_WAITBAR(5); else if (MODE == 1) AT_WAITBAR(2); else AT_WAITBAR(0); s = AT_S1; } while (0)
    AT_DMA_K(2, 2); AT_DMA_V(1, 1);
    { at_qkt(pA0, pA1, lds + AT_KN, lds + AT_KP, qr, kbs, pbs); } at_partialSM(pA0, pA1, m_reg, mnA, alA);
    AT_WAITBAR(5); s = 1;
    int t = 1;
    for (; t + 4 < NT; t += 2) {
        AT_STEP(pB0, pB1, mnB, alB, pA0, pA1, alA, t, 2);
        AT_STEP(pA0, pA1, mnA, alA, pB0, pB1, alB, t + 1, 2);
    }
    AT_STEP(pB0, pB1, mnB, alB, pA0, pA1, alA, NT - 3, 2);
    AT_STEP(pA0, pA1, mnA, alA, pB0, pB1, alB, NT - 2, 1);
    AT_STEP(pB0, pB1, mnB, alB, pA0, pA1, alA, NT - 1, 0);
    at_finishSM(pB0, pB1, alB, l_reg, pa0, pa1, pa2, pa3); SBAR();
    at_pv(o, vb0 + AT_S2 * AT_VB, pa0, pa1, pa2, pa3);
    if (hi == 0) li_l[r32] = l_reg; asm volatile("s_waitcnt lgkmcnt(0)" ::: "memory");
    float rli[16];
#pragma unroll
    for (int r = 0; r < 16; ++r) rli[r] = __builtin_amdgcn_rcpf(li_l[crow(r, hi)]);
    bf16* Ow = Orow0 + (size_t)(wid * 32) * D;
#pragma unroll
    for (int r = 0; r < 16; r += 2) { const int orow = crow(r, hi);
#pragma unroll
        for (int d0 = 0; d0 < 4; ++d0) { const unsigned w = pk2(o[d0][r] * rli[r], o[d0][r + 1] * rli[r + 1]);
            Ow[(size_t)orow * D + d0 * 32 + r32] = (bf16)w; Ow[(size_t)(orow + 1) * D + d0 * 32 + r32] = (bf16)(w >> 16); } }
#undef AT_GLDS
#undef AT_GLDS_S
#undef AT_OPQ
#undef AT_KADDR
#undef AT_DMA_K
#undef AT_DMA_V
#undef AT_RESC
#undef AT_WAITBAR
#undef AT_S1
#undef AT_S2
#undef AT_STEP
}
__device__ __forceinline__ void attn_phase(Frame& F, const Params& P, int li) {
    unsigned char* ws = PWS;
    const bf16* Q = (const bf16*)(ws + WS_Q); const bf16* KV = (const bf16*)(ws + WS_KV); const bf16* KPE = (const bf16*)(ws + WS_KPE);
    bf16* OB = (bf16*)(ws + WS_HB); const float* ROPE = (const float*)(ws + WS_ROPE);
    for (int u = F.vcu; u < 256 + 128; u += F.G) {
        for (int k = 0; k < 2; ++k) {
            int qrow0, kvrow0, nkeys, h, tpos0;
            if (u < 256) { const int id = 2 * u + k, lb = id >> 6, qb = id & 7; h = (id >> 3) & 7; qrow0 = M_CTX + lb * L_LAT + qb * 256; kvrow0 = M_CTX + lb * LKV; nkeys = LKV; tpos0 = qb * 256; }
            else { if (k == 1) break; const int id = u - 256, b = id >> 3; h = id & 7; qrow0 = b * L_CTX; kvrow0 = b * L_CTX; nkeys = L_CTX; tpos0 = -1; }
            __syncthreads();
            attn_unit(F, Q + (size_t)qrow0 * 1536 + h * 192, KV + (size_t)kvrow0 * 2048 + h * 256, KPE + (size_t)kvrow0 * 64, OB + (size_t)qrow0 * D + h * 128, nkeys, ROPE, tpos0);
        }
    }
}

constexpr int N_PHASES = 2 + 2 * 16;
__global__ void __launch_bounds__(NWAVES * 64, 2) hyb_fwd(Params P) {
    extern __shared__ __attribute__((aligned(16))) unsigned char lds_raw[];
    Frame F;
    F.lds = (LAS unsigned char*)lds_raw;
    F.tid = threadIdx.x; F.lane = F.tid & 63; F.wave = __builtin_amdgcn_readfirstlane(F.tid >> 6);
    F.G = gridDim.x; { const int bx = blockIdx.x; F.vcu = (F.G % 8 == 0) ? (bx % 8) * (F.G / 8) + bx / 8 : bx; }
    volatile LAS unsigned* MISC = (volatile LAS unsigned*)(F.lds + LDS_MISC);
    if (F.tid < 64) MISC[F.tid] = 0u;
    __syncthreads();
    const int use_bar = P.use_bar, ph_hi = P.ph_hi;
    XcdBarrier bar; bar.bar = (unsigned*)(PWS + WS_CTL) + 4096; bar.x = 0; bar.st = nullptr;
    if (use_bar) bar = xcd_barrier_post((unsigned*)(PWS + WS_CTL) + 4096, MISC + 8);

    for (int ph = P.ph_lo; ph < ph_hi; ++ph) {
#define REFRESH_ID() do { int t_ = threadIdx.x; asm volatile("" : "+v"(t_)); F.tid = t_; F.lane = t_ & 63; F.wave = __builtin_amdgcn_readfirstlane(t_ >> 6); \
          int g_ = gridDim.x, b_ = blockIdx.x; asm volatile("" : "+s"(g_), "+s"(b_)); F.G = g_; F.vcu = (g_ % 8 == 0) ? (b_ % 8) * (g_ / 8) + b_ / 8 : b_; F.bid = b_; } while (0)
        REFRESH_ID();
        unsigned char* ws = PWS;
        bf16* XBF = (bf16*)(POUT + OUT_Y);
        bf16* HB = (bf16*)(ws + WS_HB); bf16* YB = (bf16*)(ws + WS_Y); const bf16* SL = (const bf16*)(ws + WS_SLAB);
        const float* MOD = (const float*)(ws + WS_MOD);
#ifdef HYB_PHPROBE
        if (F.tid == 0) { int pk_ = ph == 0 ? 20 : 21;
            if (ph >= 2) { const int q_ = ph - 2, r_ = q_ % 16; const bool o_ = r_ >= 8; const int k_ = o_ ? r_ - 8 : r_; pk_ = k_ < 3 ? (o_ ? 10 + k_ : (k_ == 2 ? 8 : k_)) : (k_ == 3 ? 2 : k_ == 4 ? 3 : k_ == 5 ? 4 : k_ == 6 ? 5 : 6); }
            const unsigned now_ = (unsigned)__builtin_amdgcn_s_memrealtime(); if (MISC[58]) MISC[60] += now_ - MISC[57]; MISC[57] = now_; MISC[58] = ((HYB_PHPROBE) >> pk_) & 1; }
#endif
        if (ph == 0) { p0_prologue(F, P); }
        else if (ph == 1) {
            const float* m0 = MOD;
            if (F.G == 256) row_pass_f32<false>(F, PIN(I_XP), PIN(I_XS), nullptr, nullptr, nullptr, nullptr, nullptr, PIN(I_NMIXPRE), m0 + 1024, m0, HB);
            else row_pass(F, PIN(I_XP), PIN(I_XS), true, nullptr, nullptr, nullptr, nullptr, nullptr, PIN(I_NMIXPRE), m0 + 1024, m0, HB, false, true);
        } else {
            const int q = ph - 2, pair = q / 16, r = q % 16; const bool odd = r >= 8; const int l = 2 * pair + (odd ? 1 : 0), k = odd ? r - 8 : r;
            const float* ml = MOD + (size_t)l * 9 * 6144;
            const int kind = k < 3 ? (odd ? 10 + k : (k == 2 ? 8 : k)) : (k == 3 ? 2 : k == 4 ? 3 : k == 5 ? 4 : k == 6 ? 5 : 6);
            if (kind == 0) {
                pg8::Gemm g{HB, (const bf16*)(ws + WS_WINE) + (size_t)pair * EVEN_NP * 1024, M, EVEN_NP, 1024}; pg8::EvenInOrder S; S.init(F.G, F.bid);
                pg8::EpiProj E{(bf16*)(ws + WS_BIG), EVEN_NP};
                pg8::gemm_phase<pg8::EpiProj, pg8::EvenInOrder, true, true>(F.lds, g, S, E, F.tid, PWS + WS_CTL + 512 * 1024);
            } else if (kind == 1) {
                scan_phase(F, P, pair);
            } else if (kind == 8) {
                scan_combine(F, P, pair);
            } else if (kind == 2) {
                const bf16* W = odd ? (const bf16*)(ws + WS_WOUTO) + (size_t)pair * 1024 * 1024 : (const bf16*)(ws + WS_WOUTE) + (size_t)pair * 1024 * 1024;
                pg8::Gemm g{HB, W, M, 1024, 1024}; pg8::TailSplitOrder S; S.init(F.bid, 1024, 0);
                pg8::EpiYsplit E{YB, (bf16*)(ws + WS_SLAB)};
                pg8::gemm_phase<pg8::EpiYsplit, pg8::TailSplitOrder, true, true>(F.lds, g, S, E, F.tid, PWS + WS_CTL + 512 * 1024);
            } else if (kind == 3) {
                if (l == 0 && F.G == 256) row_pass_f32<true>(F, PIN(I_XP), PIN(I_XS), XBF, YB, SL, PIN(I_NMIXPOST) + l * 1024, ml + 2048, PIN(I_NMLPPRE) + l * 1024, ml + 4096, ml + 3072, HB);
                else if (l != 0 && F.G == 256) row_pass_mid(F, XBF, YB, SL, PIN(I_NMIXPOST) + l * 1024, ml + 2048, PIN(I_NMLPPRE) + l * 1024, ml + 4096, ml + 3072, HB);
                else row_pass(F, PIN(I_XP), PIN(I_XS), l == 0, XBF, YB, SL, PIN(I_NMIXPOST) + l * 1024, ml + 2048, PIN(I_NMLPPRE) + l * 1024, ml + 4096, ml + 3072, HB, true, true);
            } else if (kind == 4) {
                pg8::Gemm g{HB, (const bf16*)(ws + WS_W1) + (size_t)l * 4096 * 1024, M, FF, 1024}; pg8::StaticOrder S; S.init(M, FF, F.G, F.bid, 1024);
                pg8::EpiBf16<1> E{(bf16*)(ws + WS_BIG), FF};
#ifdef HYB_CLKPROBE
                __builtin_amdgcn_s_barrier();
                if (F.tid == 0) { const unsigned long long c0 = __builtin_readcyclecounter(), r0 = __builtin_amdgcn_s_memrealtime(); MISC[56] = (unsigned)c0; MISC[57] = (unsigned)r0; }
#endif
                pg8::gemm_phase<pg8::EpiBf16<1>, pg8::StaticOrder, true, true>(F.lds, g, S, E, F.tid, PWS + WS_CTL + 512 * 1024);
#ifdef HYB_CLKPROBE
                if (F.tid == 0) { const unsigned long long c1 = __builtin_readcyclecounter(), r1 = __builtin_amdgcn_s_memrealtime(); MISC[60] += (unsigned)c1 - MISC[56]; MISC[61] += (unsigned)r1 - MISC[57]; }
#endif
            } else if (kind == 5) {
                pg8::Gemm g{(const bf16*)(ws + WS_BIG), (const bf16*)(ws + WS_W2) + (size_t)l * 1024 * 4096, M, 1024, FF}; pg8::TailSplitOrder S; S.init(F.bid, FF, 0);
                pg8::EpiYsplit E{YB, (bf16*)(ws + WS_SLAB)};
                pg8::gemm_phase<pg8::EpiYsplit, pg8::TailSplitOrder, true, true>(F.lds, g, S, E, F.tid, PWS + WS_CTL + 512 * 1024);
            } else if (kind == 6) {
                const float* mn = ml + 9 * 6144;
                if (l < 3 && F.G == 256) row_pass_mid(F, XBF, YB, SL, PIN(I_NMLPPOST) + l * 1024, ml + 5120, PIN(I_NMIXPRE) + (l + 1) * 1024, mn + 1024, mn, HB);
                else if (l < 3) row_pass(F, nullptr, nullptr, false, XBF, YB, SL, PIN(I_NMLPPOST) + l * 1024, ml + 5120, PIN(I_NMIXPRE) + (l + 1) * 1024, mn + 1024, mn, HB, true, true);
                else { bar.bar = (unsigned*)(PWS + WS_CTL) + 4096; if (F.G == 256) row_pass_final2(F, bar, XBF, POUT + OUT_Y, YB, SL, PIN(I_NMLPPOST) + l * 1024, ml + 5120);
                       else row_pass_final(F, bar, XBF, POUT + OUT_Y, YB, SL, PIN(I_NMLPPOST) + l * 1024, ml + 5120); }
            } else if (kind == 10) {
                pg8::Gemm g{HB, (const bf16*)(ws + WS_WINO) + (size_t)pair * ODD_NP * 1024, M, ODD_NP, 1024}; pg8::StaticOrder S; S.init(M, ODD_NP, F.G, F.bid, 1024);
                pg8::EpiOddIn E{(bf16*)(ws + WS_QN), (bf16*)(ws + WS_ACKV), (float*)(ws + WS_Y), POUT + OUT_CKV, POUT + OUT_KPE,
                                PIN(I_QAN) + pair * 256, PIN(I_KVAN) + pair * 256, pair};
                pg8::gemm_phase<pg8::EpiOddIn, pg8::StaticOrder, false, true>(F.lds, g, S, E, F.tid, PWS + WS_CTL + 512 * 1024);
                REFRESH_ID();
                if (F.G == 256) { if (F.bid >= 240) cache_pass(F, P, pair, F.bid - 240, 16); }
                else cache_pass(F, P, pair, F.vcu, F.G);
            } else if (kind == 11) {
                if (F.G != 256) { kpe_pass(F, P, pair, F.vcu, F.G); REFRESH_ID(); }
                { pg8::Gemm g{(const bf16*)(ws + WS_QN), (const bf16*)(ws + WS_WQB) + (size_t)pair * 1536 * 256, M, 1536, 256}; pg8::StaticOrder S; S.init(M, 1536, F.G, F.bid, 256);
                  pg8::EpiBf16<0> E{(bf16*)(ws + WS_Q), 1536};
                  pg8::gemm_phase<pg8::EpiBf16<0>, pg8::StaticOrder, true, true>(F.lds, g, S, E, F.tid, PWS + WS_CTL + 512 * 1024); }
                REFRESH_ID();
                { pg8::Gemm g{(const bf16*)(ws + WS_ACKV), (const bf16*)(ws + WS_WKVB) + (size_t)pair * 2048 * 256, MKV, 2048, 256}; pg8::StaticOrder S; S.init(MKV, 2048, F.G, F.bid, 256);
                  pg8::EpiBf16<0> E{(bf16*)(ws + WS_KV), 2048};
                  pg8::gemm_phase<pg8::EpiBf16<0>, pg8::StaticOrder, true, true>(F.lds, g, S, E, F.tid, PWS + WS_CTL + 512 * 1024); }
                if (F.G == 256 && F.bid >= 192) { REFRESH_ID(); kpe_pass(F, P, pair, F.bid - 192, 64); }
            } else if (kind == 12) {
                attn_phase(F, P, pair);
            }
        }
        if (ph + 1 < ph_hi) { if (use_bar) { bar.bar = (unsigned*)(PWS + WS_CTL) + 4096; xcd_barrier(bar); } else { VM_WAIT(); __syncthreads(); } }
    }
#ifdef HYB_PHPROBE
    if (blockIdx.x == 0 && threadIdx.x == 0) {
        unsigned now_ = (unsigned)__builtin_amdgcn_s_memrealtime(); if (MISC[58]) MISC[60] += now_ - MISC[57];
        #ifndef HYB_PHMULT
#define HYB_PHMULT 1
#endif
        const unsigned long long spin = (unsigned long long)MISC[60] * HYB_PHMULT; const unsigned long long t0 = __builtin_amdgcn_s_memrealtime();
        while (__builtin_amdgcn_s_memrealtime() - t0 < spin) __builtin_amdgcn_s_sleep(8);
    }
#endif
#ifdef HYB_CLKPROBE
    if (blockIdx.x == 0 && threadIdx.x == 0) {
        const unsigned c = MISC[60], r = MISC[61]; const unsigned long long spin = (unsigned long long)c * (unsigned long long)(HYB_CLKPROBE) / (r ? r : 1u);
        const unsigned long long t0 = __builtin_amdgcn_s_memrealtime();
        while (__builtin_amdgcn_s_memrealtime() - t0 < spin) __builtin_amdgcn_s_sleep(8);
    }
#endif
}

extern "C" void kernel_launch(void* const* d_in, const int* in_sizes, int n_in, void* d_out, int out_size, void* d_ws, size_t ws_size, hipStream_t stream) {
    static int grid = 0;
    if (grid == 0) {
        if (n_in != 28 || out_size != 27787264 || ws_size < WS_END) { fprintf(stderr, "kernel_launch: unexpected shapes: n_in %d out %d ws %zu (need >= %zu)\n", n_in, out_size, ws_size, (size_t)WS_END); grid = -1; return; }
        int dev = 0, cus = 0, per_cu = 0;
        if (hipGetDevice(&dev) != hipSuccess || hipDeviceGetAttribute(&cus, hipDeviceAttributeMultiprocessorCount, dev) != hipSuccess) { grid = -1; return; }
        if (hipFuncSetAttribute((const void*)hyb_fwd, hipFuncAttributeMaxDynamicSharedMemorySize, LDS_BYTES) != hipSuccess) { fprintf(stderr, "kernel_launch: hipFuncSetAttribute failed\n"); grid = -1; return; }
        if (hipOccupancyMaxActiveBlocksPerMultiprocessor(&per_cu, (const void*)hyb_fwd, NWAVES * 64, LDS_BYTES) != hipSuccess || per_cu < 1) { fprintf(stderr, "kernel_launch: occupancy query reports %d\n", per_cu); }
        (void)hipGetLastError();
        grid = cus;
    }
    if (grid < 0) return;
    (void)hipMemsetAsync((char*)d_ws + WS_CTL, 0, CTL_ZERO_BYTES, stream);
    Params a{};
    for (int i = 0; i < 28; ++i) a.in[i] = (const float*)d_in[i];
    a.out = (float*)d_out; a.ws = (unsigned char*)d_ws;
    a.ph_lo = 0; a.ph_hi = N_PHASES; a.use_bar = 1; a.pad = 0;
    hipLaunchKernelGGL(hyb_fwd, dim3(grid), dim3(NWAVES * 64), LDS_BYTES, stream, a);
    const hipError_t le = hipPeekAtLastError();
    if (le != hipSuccess) fprintf(stderr, "kernel_launch: launch failed: %s\n", hipGetErrorName(le));
}
```
